# Optimizing an MI355X kernel written in HIP

```python
import jax, jax.numpy as jnp
from jax import lax
import numpy as np

D_MODEL = 1024
BATCH = 8
SEQ = 4096
DEPTH = 2

A_HEADS = 8
A_HEAD_DIM = 64
A_WIDTH = A_HEADS * A_HEAD_DIM
A_DECAY_LORA = 64
A_ICLR_LORA = 64
A_GATE_LORA = 128
A_GN_EPS = 64e-5
A_SIZES = (A_WIDTH, A_WIDTH, A_WIDTH, A_DECAY_LORA, A_ICLR_LORA, A_GATE_LORA)
A_COLS = sum(A_SIZES)

B_HEADS = 4
B_KEY_DIM = 64
B_VAL_DIM = 128
B_KEY_WIDTH = B_HEADS * B_KEY_DIM
B_VAL_WIDTH = B_HEADS * B_VAL_DIM
B_GATE_LORA = 16
B_GATE_TAU = 16.0
B_CHUNK = 64
B_NORM_EPS = 1e-5
B_SIZES = (B_KEY_WIDTH, B_KEY_WIDTH, B_VAL_WIDTH, B_VAL_WIDTH, B_GATE_LORA)
B_COLS = sum(B_SIZES)

EVEN_COLS = A_COLS + B_COLS
EVEN_OUT = A_WIDTH + B_VAL_WIDTH

C_HEADS = 8
C_HEAD_DIM = 128
C_WIDTH = C_HEADS * C_HEAD_DIM
C_IDX_HEADS = 4
C_IDX_DIM = 64
C_INDEX_TOPK = 256
C_QBLOCK = 128
C_SIZES = (C_WIDTH, C_HEAD_DIM, C_HEAD_DIM, C_IDX_HEADS * C_IDX_DIM, C_IDX_DIM, C_IDX_HEADS)
ODD_COLS = sum(C_SIZES)
ROPE_THETA = 10000.0

N_EXPERTS = 16
N_GROUPS = 4
EXPERTS_PER_GROUP = N_EXPERTS // N_GROUPS
TOP_K = 2
D_EXPERT = 256

DN_ALPHA = (2 * DEPTH) ** 0.25
DN_BETA = (8 * DEPTH) ** -0.25
LN_EPS = 1e-5
N_EVEN = (DEPTH + 1) // 2
N_ODD = DEPTH // 2

kernel_name = 'hybrid_rwkv7_gla_dsa_moe_deepnorm'


def _split_cols(p, sizes):
    return jnp.split(p, np.cumsum(sizes)[:-1].tolist(), axis=-1)


def _layer_norm(x, g, b, eps=LN_EPS):
    xf = x.astype(jnp.float32)
    mu = jnp.mean(xf, -1, keepdims=True)
    var = jnp.mean(jnp.square(xf - mu), -1, keepdims=True)
    return ((xf - mu) * lax.rsqrt(var + eps) * g + b).astype(x.dtype)


def _token_shift(z):
    return jnp.pad(z, ((0, 0), (1, 0), (0, 0)))[:, :-1]


def _rope(z, pos):
    half = z.shape[-1] // 2
    inv = ROPE_THETA ** (-jnp.arange(half, dtype=jnp.float32) / half)
    ang = pos[:, None] * inv[None, :]
    cos = jnp.cos(ang)[:, None, :].astype(z.dtype)
    sin = jnp.sin(ang)[:, None, :].astype(z.dtype)
    z1, z2 = z[..., :half], z[..., half:]
    return jnp.concatenate([z1 * cos - z2 * sin, z2 * cos + z1 * sin], axis=-1)


def _rwkv7_group(p, mu, w0, w2, a0, a2, g2, kk_scale, ka_scale, r_k, gn_g, gn_b):
    bsz, t, _ = p.shape
    f32 = jnp.float32
    pm = p + (_token_shift(p) - p) * mu
    r, k, v, xw, xa, xg = _split_cols(pm, A_SIZES)
    w_log = -jax.nn.softplus(-(w0 + jnp.tanh(xw) @ w2).astype(f32)) - 0.5
    decay = jnp.exp(-jnp.exp(w_log))
    a = jax.nn.sigmoid((a0 + xa @ a2).astype(f32))
    g = (jax.nn.sigmoid(xg) @ g2).astype(f32)
    heads = lambda z: z.astype(f32).reshape(bsz, t, A_HEADS, A_HEAD_DIM)
    kk = heads(k * kk_scale)
    kk = kk / jnp.maximum(jnp.linalg.norm(kk, axis=-1, keepdims=True), 1e-12)
    kh = heads(k.astype(f32) * (1.0 + (a - 1.0) * ka_scale))
    rh, vh, wh, ah = heads(r), heads(v), heads(decay), heads(a)

    def step(state, inp):
        r_t, w_t, k_t, v_t, kk_t, a_t = inp
        sa = jnp.einsum('bhvk,bhk->bhv', state, kk_t)
        state = (state * w_t[:, :, None, :] - sa[..., None] * (kk_t * a_t)[:, :, None, :]
                 + v_t[..., None] * k_t[:, :, None, :])
        return state, jnp.einsum('bhvk,bhk->bhv', state, r_t)

    xs = tuple(jnp.swapaxes(z, 0, 1) for z in (rh, wh, kh, vh, kk, ah))
    s0 = jnp.zeros((bsz, A_HEADS, A_HEAD_DIM, A_HEAD_DIM), f32)
    _, y = lax.scan(step, s0, xs)
    y = jnp.swapaxes(y, 0, 1)
    ym = jnp.mean(y, -1, keepdims=True)
    yv = jnp.mean(jnp.square(y - ym), -1, keepdims=True)
    yn = ((y - ym) * lax.rsqrt(yv + A_GN_EPS)).reshape(bsz, t, A_WIDTH) * gn_g + gn_b
    bonus = (jnp.sum(rh * kh * r_k, -1, keepdims=True) * vh).reshape(bsz, t, A_WIDTH)
    return ((yn + bonus) * g).astype(p.dtype)


def _gla_group(p, gate_w2, gate_b, norm_g):
    bsz, t, _ = p.shape
    f32 = jnp.float32
    nc = t // B_CHUNK
    q, k, v, g, xa = _split_cols(p, B_SIZES)
    log_a = jax.nn.log_sigmoid((xa @ gate_w2 + gate_b).astype(f32)) / B_GATE_TAU

    def chunks(z, d):
        return z.astype(f32).reshape(bsz, nc, B_CHUNK, B_HEADS, d).transpose(0, 3, 1, 2, 4)

    qc = chunks(q, B_KEY_DIM) * B_KEY_DIM ** -0.5
    kc = chunks(k, B_KEY_DIM)
    vc = chunks(v, B_VAL_DIM)
    bc = jnp.cumsum(chunks(log_a, B_KEY_DIM), axis=3)
    b_last = bc[:, :, :, -1:, :]
    q_dec = qc * jnp.exp(bc)
    k_inv = kc * jnp.exp(-bc)
    k_end = kc * jnp.exp(b_last - bc)
    causal = jnp.tril(jnp.ones((B_CHUNK, B_CHUNK), bool))
    att = jnp.where(causal, jnp.einsum('bhncd,bhnsd->bhncs', q_dec, k_inv), 0.0)
    o_intra = jnp.einsum('bhncs,bhnse->bhnce', att, vc)
    kv = jnp.einsum('bhncd,bhnce->bhnde', k_end, vc)

    def step(state, inp):
        d_n, kv_n = inp
        return d_n[..., None] * state + kv_n, state

    s0 = jnp.zeros((bsz, B_HEADS, B_KEY_DIM, B_VAL_DIM), f32)
    _, s_prev = lax.scan(step, s0, (jnp.moveaxis(jnp.exp(b_last[:, :, :, 0, :]), 2, 0),
                                    jnp.moveaxis(kv, 2, 0)))
    o_inter = jnp.einsum('bhncd,nbhde->bhnce', q_dec, s_prev)
    o = (o_intra + o_inter).transpose(0, 2, 3, 1, 4).reshape(bsz, t, B_HEADS, B_VAL_DIM)
    o = o * lax.rsqrt(jnp.mean(jnp.square(o), -1, keepdims=True) + B_NORM_EPS)
    o = o.reshape(bsz, t, B_VAL_WIDTH) * norm_g * jax.nn.silu(g.astype(f32))
    return o.astype(p.dtype)


def _dsa_mixer(p, ik_g, ik_b, k_top):
    bsz, t, _ = p.shape
    f32 = jnp.float32
    q, k, v, iq, ik, iw = _split_cols(p, C_SIZES)
    pos = jnp.arange(t, dtype=f32)
    q = _rope(q.reshape(bsz, t, C_HEADS, C_HEAD_DIM), pos)
    k = _rope(k.reshape(bsz, t, 1, C_HEAD_DIM), pos)[:, :, 0]
    iq = _rope(iq.reshape(bsz, t, C_IDX_HEADS, C_IDX_DIM), pos)
    ik = _rope(_layer_norm(ik, ik_g, ik_b).reshape(bsz, t, 1, C_IDX_DIM), pos)[:, :, 0]
    iw = iw.astype(f32) * C_IDX_HEADS ** -0.5
    nb = t // C_QBLOCK
    key_pos = jnp.arange(t)
    to_blocks = lambda z: jnp.swapaxes(z.reshape(bsz, nb, C_QBLOCK, *z.shape[2:]), 0, 1)
    gather_rows = jax.vmap(lambda src, idx: src[idx])

    def block(args):
        qb, iqb, iwb, qpos = args
        s = jnp.einsum('bqhd,bsd->bhqs', iqb, ik).astype(f32) * C_IDX_DIM ** -0.5
        score = jnp.einsum('bhqs,bqh->bqs', jax.nn.relu(s), iwb)
        score = jnp.where(key_pos[None, None, :] <= qpos[None, :, None], score, -jnp.inf)
        _, idx = lax.top_k(score, k_top)
        valid = idx <= qpos[None, :, None]
        k_sel = gather_rows(k, idx)
        v_sel = gather_rows(v, idx)
        logits = jnp.einsum('bqhd,bqkd->bqhk', qb, k_sel).astype(f32) * C_HEAD_DIM ** -0.5
        logits = jnp.where(valid[:, :, None, :], logits, -jnp.inf)
        prob = jax.nn.softmax(logits, axis=-1).astype(v_sel.dtype)
        return jnp.einsum('bqhk,bqkd->bqhd', prob, v_sel)

    out = lax.map(block, (to_blocks(q), to_blocks(iq), to_blocks(iw), key_pos.reshape(nb, C_QBLOCK)))
    return jnp.swapaxes(out, 0, 1).reshape(bsz, t, C_WIDTH)


def _moe(h, router_w, router_bias, w_gate, w_up, w_down):
    bsz, t, d = h.shape
    f32 = jnp.float32
    hf = h.reshape(-1, d)
    s = jax.nn.sigmoid((hf @ router_w).astype(f32))
    sel = s + router_bias
    group_score = lax.top_k(sel.reshape(-1, N_GROUPS, EXPERTS_PER_GROUP), TOP_K)[0].sum(-1)
    best = jnp.argmax(group_score, axis=-1)
    in_group = (jnp.arange(N_EXPERTS) // EXPERTS_PER_GROUP)[None, :] == best[:, None]
    _, eidx = lax.top_k(jnp.where(in_group, sel, -jnp.inf), TOP_K)
    gate = jnp.take_along_axis(s, eidx, axis=-1)
    gate = gate / jnp.sum(gate, -1, keepdims=True)
    comb = jnp.sum(jax.nn.one_hot(eidx, N_EXPERTS, dtype=f32) * gate[..., None], axis=1)
    y = jnp.zeros(hf.shape, f32)
    for e in range(N_EXPERTS):
        he = (jax.nn.silu(hf @ w_gate[e]) * (hf @ w_up[e])) @ w_down[e]
        y = y + comb[:, e:e + 1] * he.astype(f32)
    return y.astype(h.dtype).reshape(bsz, t, d)


def setup_inputs(seed: int = 0) -> dict:
    key = jax.random.key(seed)
    ks = list(jax.random.split(key, 32))
    f32 = jnp.float32
    nrm = lambda k, shape, scale: jax.random.normal(k, shape, f32) * scale
    uni = lambda k, shape, lo, hi: jax.random.uniform(k, shape, f32, lo, hi)
    x = nrm(ks[0], (BATCH, SEQ, D_MODEL), 1.0)
    bv0 = A_COLS + 2 * B_KEY_WIDTH
    even_scale = (jnp.ones((EVEN_COLS,), f32).at[2 * A_WIDTH:3 * A_WIDTH].set(DN_BETA)
                  .at[bv0:bv0 + B_VAL_WIDTH].set(DN_BETA))
    w_in_even = nrm(ks[1], (N_EVEN, D_MODEL, EVEN_COLS), D_MODEL ** -0.5) * even_scale
    a_mu = uni(ks[2], (N_EVEN, A_COLS), 0.0, 1.0)
    a_w0 = uni(ks[3], (N_EVEN, A_WIDTH), -6.0, 1.0)
    a_w2 = nrm(ks[4], (N_EVEN, A_DECAY_LORA, A_WIDTH), A_DECAY_LORA ** -0.5)
    a_a0 = nrm(ks[5], (N_EVEN, A_WIDTH), 0.5)
    a_a2 = nrm(ks[6], (N_EVEN, A_ICLR_LORA, A_WIDTH), 0.5 * A_ICLR_LORA ** -0.5)
    a_g2 = nrm(ks[7], (N_EVEN, A_GATE_LORA, A_WIDTH), A_GATE_LORA ** -0.5)
    a_kk_scale = 1.0 + nrm(ks[8], (N_EVEN, A_WIDTH), 0.1)
    a_ka_scale = 1.0 + nrm(ks[9], (N_EVEN, A_WIDTH), 0.1)
    a_r_k = nrm(ks[10], (N_EVEN, A_HEADS, A_HEAD_DIM), 0.1)
    a_gn_g = 1.0 + nrm(ks[11], (N_EVEN, A_WIDTH), 0.02)
    a_gn_b = nrm(ks[12], (N_EVEN, A_WIDTH), 0.02)
    b_gate_w2 = nrm(ks[13], (N_EVEN, B_GATE_LORA, B_KEY_WIDTH), B_GATE_LORA ** -0.5)
    b_gate_b = nrm(ks[14], (N_EVEN, B_KEY_WIDTH), 0.1)
    b_norm_g = 1.0 + nrm(ks[15], (N_EVEN, B_VAL_WIDTH), 0.02)
    w_out_even = nrm(ks[16], (N_EVEN, EVEN_OUT, D_MODEL), DN_BETA * EVEN_OUT ** -0.5)
    cv0 = C_WIDTH + C_HEAD_DIM
    odd_scale = jnp.ones((ODD_COLS,), f32).at[cv0:cv0 + C_HEAD_DIM].set(DN_BETA)
    w_in_odd = nrm(ks[17], (N_ODD, D_MODEL, ODD_COLS), D_MODEL ** -0.5) * odd_scale
    c_ik_ln_g = 1.0 + nrm(ks[18], (N_ODD, C_IDX_DIM), 0.02)
    c_ik_ln_b = nrm(ks[19], (N_ODD, C_IDX_DIM), 0.02)
    w_out_odd = nrm(ks[20], (N_ODD, C_WIDTH, D_MODEL), DN_BETA * C_WIDTH ** -0.5)
    ln1_g = 1.0 + nrm(ks[21], (DEPTH, D_MODEL), 0.02)
    ln1_b = nrm(ks[22], (DEPTH, D_MODEL), 0.02)
    ln2_g = 1.0 + nrm(ks[23], (DEPTH, D_MODEL), 0.02)
    ln2_b = nrm(ks[24], (DEPTH, D_MODEL), 0.02)
    router_w = nrm(ks[25], (D_MODEL, N_EXPERTS), D_MODEL ** -0.5)
    router_bias = nrm(ks[26], (N_EXPERTS,), 0.01)
    exp_w_gate = nrm(ks[27], (DEPTH, N_EXPERTS, D_MODEL, D_EXPERT), DN_BETA * D_MODEL ** -0.5)
    exp_w_up = nrm(ks[28], (DEPTH, N_EXPERTS, D_MODEL, D_EXPERT), DN_BETA * D_MODEL ** -0.5)
    exp_w_down = nrm(ks[29], (DEPTH, N_EXPERTS, D_EXPERT, D_MODEL), DN_BETA * D_EXPERT ** -0.5)
    return {'x': x, 'w_in_even': w_in_even, 'a_mu': a_mu, 'a_w0': a_w0, 'a_w2': a_w2,
            'a_a0': a_a0, 'a_a2': a_a2, 'a_g2': a_g2, 'a_kk_scale': a_kk_scale,
            'a_ka_scale': a_ka_scale, 'a_r_k': a_r_k, 'a_gn_g': a_gn_g, 'a_gn_b': a_gn_b,
            'b_gate_w2': b_gate_w2, 'b_gate_b': b_gate_b, 'b_norm_g': b_norm_g,
            'w_out_even': w_out_even, 'w_in_odd': w_in_odd, 'c_ik_ln_g': c_ik_ln_g,
            'c_ik_ln_b': c_ik_ln_b, 'w_out_odd': w_out_odd, 'ln1_g': ln1_g, 'ln1_b': ln1_b,
            'ln2_g': ln2_g, 'ln2_b': ln2_b, 'router_w': router_w, 'router_bias': router_bias,
            'exp_w_gate': exp_w_gate, 'exp_w_up': exp_w_up, 'exp_w_down': exp_w_down}


def reference(x, w_in_even, a_mu, a_w0, a_w2, a_a0, a_a2, a_g2, a_kk_scale, a_ka_scale, a_r_k,
              a_gn_g, a_gn_b, b_gate_w2, b_gate_b, b_norm_g, w_out_even, w_in_odd, c_ik_ln_g,
              c_ik_ln_b, w_out_odd, ln1_g, ln1_b, ln2_g, ln2_b, router_w, router_bias,
              exp_w_gate, exp_w_up, exp_w_down):
    k_top = min(C_INDEX_TOPK, x.shape[1] // 4)
    for l in range(DEPTH):
        i = l // 2
        if l % 2 == 0:
            p = x @ w_in_even[i]
            ya = _rwkv7_group(p[..., :A_COLS], a_mu[i], a_w0[i], a_w2[i], a_a0[i], a_a2[i],
                              a_g2[i], a_kk_scale[i], a_ka_scale[i], a_r_k[i], a_gn_g[i], a_gn_b[i])
            yb = _gla_group(p[..., A_COLS:], b_gate_w2[i], b_gate_b[i], b_norm_g[i])
            mix = jnp.concatenate([ya, yb], axis=-1) @ w_out_even[i]
        else:
            p = x @ w_in_odd[i]
            mix = _dsa_mixer(p, c_ik_ln_g[i], c_ik_ln_b[i], k_top) @ w_out_odd[i]
        h = _layer_norm(DN_ALPHA * x + mix, ln1_g[l], ln1_b[l])
        ffn = _moe(h, router_w, router_bias, exp_w_gate[l], exp_w_up[l], exp_w_down[l])
        x = _layer_norm(DN_ALPHA * h + ffn, ln2_g[l], ln2_b[l])
    return x
```

```cpp
#include <hip/hip_runtime.h>
#include <hip/hip_cooperative_groups.h>
#include <cstdio>
#include <cstdint>
namespace cg = cooperative_groups;

constexpr int NTOK = 32768, SEQ = 4096, NB = 8, DM = 1024;
constexpr int EVEN_COLS = 3344, ODD_COLS = 1604;
constexpr int NE_MAIN = 3328;
constexpr int NO_MAIN = 1792;
constexpr int NEXP = 16, DEXP = 256;
constexpr float DN_ALPHA = 1.4142135623730951f;
constexpr float LN_EPS = 1e-5f;
constexpr int MOE_ROWS = 65536 + 16 * 256;

typedef unsigned short bf16_t;
typedef short bf16x8 __attribute__((ext_vector_type(8)));
typedef float f32x4 __attribute__((ext_vector_type(4)));
typedef float f32x2 __attribute__((ext_vector_type(2)));
typedef unsigned u32x4 __attribute__((ext_vector_type(4)));
typedef unsigned u32x2 __attribute__((ext_vector_type(2)));
#define LAS __attribute__((address_space(3)))

__device__ __forceinline__ unsigned cvt_pk_bf16(float lo, float hi) { unsigned r; asm volatile("v_cvt_pk_bf16_f32 %0, %1, %2" : "=v"(r) : "v"(lo), "v"(hi)); return r; }
__device__ __forceinline__ bf16_t f2bf(float f) { return (bf16_t)(cvt_pk_bf16(f, 0.f) & 0xffffu); }
__device__ __forceinline__ float bf2f(bf16_t h) { return __uint_as_float(((unsigned)h) << 16); }
__device__ __forceinline__ float wave_sum(float v) {
#pragma unroll
    for (int o = 32; o > 0; o >>= 1) v += __shfl_xor(v, o);
    return v;
}

constexpr size_t MiB = 1024ull * 1024ull;
constexpr size_t OFF_WINE = 0;
constexpr size_t OFF_WOUTE = OFF_WINE + (size_t)NE_MAIN * 1024 * 2;
constexpr size_t OFF_WINO = OFF_WOUTE + 2 * MiB;
constexpr size_t OFF_WOUTO = OFF_WINO + (size_t)NO_MAIN * 1024 * 2;
constexpr size_t OFF_WGU = OFF_WOUTO + 2 * MiB;
constexpr size_t OFF_WD = OFF_WGU + 32 * MiB;
constexpr size_t OFF_ROPE = OFF_WD + 16 * MiB;
constexpr size_t OFF_MISC = OFF_ROPE + 3 * MiB;
constexpr size_t OFF_BUF64 = OFF_MISC + 4 * MiB;
constexpr size_t OFF_P = OFF_BUF64 + 64 * MiB;
constexpr size_t OFF_U = OFF_P + 208 * MiB;
constexpr size_t WS_NEED = OFF_U + 128 * MiB;
constexpr size_t OFF_HE = OFF_P;
constexpr size_t OFF_ACT = OFF_HE + (size_t)MOE_ROWS * 1024 * 2;
constexpr size_t OFF_PD = OFF_P;
constexpr size_t OFF_KR = OFF_P + 112 * MiB;
constexpr size_t OFF_VV = OFF_KR + 8 * MiB;
constexpr size_t OFF_IQR = OFF_VV + 8 * MiB;
constexpr size_t OFF_IKR = OFF_IQR + 16 * MiB;
constexpr size_t OFF_IW = OFF_IKR + 4 * MiB;
constexpr size_t OFF_IDX = OFF_IW + 1 * MiB;
constexpr size_t MISC_CNT = 0;
constexpr size_t MISC_TOKINFO = 4096;
constexpr size_t MISC_TOKGATE = MISC_TOKINFO + (size_t)NTOK * 16;
constexpr size_t MISC_LIST = MISC_TOKGATE + (size_t)NTOK * 8;

struct Params {
    const float* in[30];
    float* out;
    unsigned char* ws;
};
enum { I_X = 0, I_WINE, I_AMU, I_AW0, I_AW2, I_AA0, I_AA2, I_AG2, I_AKK, I_AKA, I_ARK, I_AGNG, I_AGNB, I_BGW2, I_BGB, I_BNG, I_WOUTE,
       I_WINO, I_CIKG, I_CIKB, I_WOUTO, I_LN1G, I_LN1B, I_LN2G, I_LN2B, I_RW, I_RB, I_EG, I_EU, I_ED };

namespace pg {
constexpr int BM = 256, BK = 64, HALF = 128, HTB = HALF * BK * 2, STAGE_BYTES = 8 * HTB;
__host__ __device__ __forceinline__ int lds_byte(int r, int c) { const int st = (r >> 4) * 2 + (c >> 5), rr = r & 15, cc = c & 31, ob = rr * 64 + cc * 2; return st * 1024 + (ob ^ (((ob >> 9) & 1) << 5)); }
__host__ __device__ __forceinline__ void stage_rc(int b, int& R, int& C) { const int st = b / 1024, sb = b % 1024, swz = sb ^ (((sb >> 9) & 1) << 5); R = (st >> 1) * 16 + swz / 64; C = (st & 1) * 32 + (swz % 64) / 2; }
__host__ __device__ __forceinline__ int perm32(int rho) { const int n = rho >> 4, i = rho & 15; return 8 * (i >> 2) + 4 * n + (i & 3); }

struct Unit { int pm, pn, e, rt, cnt; };

template <class Epi, class Sched>
__device__ __forceinline__ void gemm_phase(LAS unsigned char* lds, const int K, const Sched& S, const Epi& E) {
    const int tid = threadIdx.x, wid = __builtin_amdgcn_readfirstlane(tid >> 6), lane = tid & 63, wr = wid >> 2, wc = wid & 3, fr = lane & 15, fq = lane >> 4;
    const int nt = K / BK;
    unsigned voffB[2];
#pragma unroll
    for (int i = 0; i < 2; ++i) { int R, C; stage_rc(tid * 16 + i * 8192, R, C); const int Rb = Epi::PERM ? ((R & ~31) + perm32(R & 31)) : R; voffB[i] = (unsigned)(Rb * K + C) * 2u; }
    const size_t kstep = (size_t)(BK * 2);
    const size_t hstepB = (size_t)HALF * K * 2;
    const unsigned ldsw = (unsigned)wid * 1024u;
    const int aoff = lds_byte(wr * 64 + fr, fq * 8), boff = lds_byte(wc * 32 + fr, fq * 8);
#define PG_SA(b, h) (((b) * 2 + (h)) * HTB)
#define PG_SB(b, h) ((4 + (b) * 2 + (h)) * HTB)
#define PG_STAGE(bufoff, gbase, voff) do { _Pragma("unroll") for (int _i = 0; _i < 2; ++_i) \
        __builtin_amdgcn_global_load_lds((const unsigned*)((const char*)(gbase) + (voff)[_i]), (LAS unsigned*)(lds + (bufoff) + ldsw + _i * 8192), 16, 0, 0); } while (0)
#define PG_LDA(dst, b, h) do { _Pragma("unroll") for (int m = 0; m < 4; ++m) _Pragma("unroll") for (int k = 0; k < 2; ++k) dst[m][k] = *(const LAS bf16x8*)(lds + PG_SA(b, h) + aoff + m * 2048 + k * 1024); } while (0)
#define PG_LDB(dst, b, h) do { _Pragma("unroll") for (int n = 0; n < 2; ++n) _Pragma("unroll") for (int k = 0; k < 2; ++k) dst[n][k] = *(const LAS bf16x8*)(lds + PG_SB(b, h) + boff + n * 2048 + k * 1024); } while (0)
#define PG_MMA(ai, bj, At, Bt) do { __builtin_amdgcn_s_setprio(1); _Pragma("unroll") for (int m = 0; m < 4; ++m) _Pragma("unroll") for (int n = 0; n < 2; ++n) _Pragma("unroll") for (int k = 0; k < 2; ++k) \
        acc[ai][bj][m][n] = __builtin_amdgcn_mfma_f32_16x16x32_bf16(Bt[n][k], At[m][k], acc[ai][bj][m][n], 0, 0, 0); __builtin_amdgcn_s_setprio(0); } while (0)
#define PG_WAIT_V(n) asm volatile("s_waitcnt vmcnt(" #n ")" ::: "memory")
#define PG_WAIT_L(n) asm volatile("s_waitcnt lgkmcnt(" #n ")" ::: "memory")
#define PG_BAR __builtin_amdgcn_s_barrier()
#define PG_SCHED __builtin_amdgcn_sched_barrier(0)
#define PG_AOFF(dst0, dst1, u) do { _Pragma("unroll") for (int _i = 0; _i < 2; ++_i) { int _R, _C; stage_rc(tid * 16 + _i * 8192, _R, _C); \
        dst0[_i] = S.a_rowoff(u, 0, _R) + (unsigned)_C * 2u; dst1[_i] = S.a_rowoff(u, 1, _R) + (unsigned)_C * 2u; } } while (0)
    Unit cur, nxt; int ui = 0;
    if (!S.next(0, cur)) return;
    f32x4 acc[2][2][4][2];
#pragma unroll
    for (int a = 0; a < 2; ++a)
#pragma unroll
        for (int b = 0; b < 2; ++b)
#pragma unroll
            for (int m = 0; m < 4; ++m)
#pragma unroll
                for (int n = 0; n < 2; ++n) acc[a][b][m][n] = (f32x4){0.f, 0.f, 0.f, 0.f};
    bf16x8 At[4][2], B0[2][2], B1[2][2];
    const char* const Ab = S.a_base();
    unsigned aC0[2], aC1[2];
    PG_AOFF(aC0, aC1, cur);
    const char* cB = S.b_ptr(cur);
    PG_STAGE(PG_SB(0, 0), cB, voffB); PG_STAGE(PG_SA(0, 0), Ab, aC0); PG_STAGE(PG_SB(0, 1), cB + hstepB, voffB); PG_STAGE(PG_SA(0, 1), Ab, aC1);
    if (wr == 1) PG_BAR;
    PG_WAIT_V(4); PG_BAR;
    PG_STAGE(PG_SB(1, 0), cB + kstep, voffB); PG_STAGE(PG_SA(1, 0), Ab + kstep, aC0); PG_STAGE(PG_SB(1, 1), cB + hstepB + kstep, voffB);
    PG_WAIT_V(6); PG_BAR;
    for (;;) {
        const bool has_next = S.next(ui + 1, nxt);
        const char* nB = has_next ? S.b_ptr(nxt) : cB;
        for (int t = 0; t < nt; t += 2) {
            const bool last = (t == nt - 2);
            const char* a1 = Ab + (size_t)(t + 1) * kstep;
            const char* a2 = last ? Ab : Ab + (size_t)(t + 2) * kstep; const char* b2 = last ? nB : cB + (size_t)(t + 2) * kstep;
            const char* a3 = a2 + kstep; const char* b3 = b2 + kstep;
            PG_LDB(B0, 0, 0); PG_SCHED; PG_LDA(At, 0, 0); PG_STAGE(PG_SA(1, 1), a1, aC1);
            if (last && has_next) PG_AOFF(aC0, aC1, nxt);
            PG_WAIT_L(8); PG_BAR; PG_WAIT_L(0); PG_MMA(0, 0, At, B0); PG_BAR; PG_SCHED;
            PG_LDB(B1, 0, 1); PG_STAGE(PG_SB(0, 0), b2, voffB);
            PG_BAR; PG_WAIT_L(0); PG_MMA(0, 1, At, B1); PG_BAR;
            PG_LDA(At, 0, 1); PG_STAGE(PG_SA(0, 0), a2, aC0);
            PG_BAR; PG_WAIT_L(0); PG_MMA(1, 0, At, B0); PG_BAR; PG_SCHED;
            PG_STAGE(PG_SB(0, 1), b2 + hstepB, voffB);
            PG_WAIT_V(6); PG_BAR; PG_MMA(1, 1, At, B1); PG_BAR;
            PG_LDB(B0, 1, 0); PG_SCHED; PG_LDA(At, 1, 0); PG_STAGE(PG_SA(0, 1), a2, aC1);
            PG_WAIT_L(8); PG_BAR; PG_WAIT_L(0); PG_MMA(0, 0, At, B0); PG_BAR; PG_SCHED;
            PG_LDB(B1, 1, 1); PG_STAGE(PG_SB(1, 0), b3, voffB);
            PG_BAR; PG_WAIT_L(0); PG_MMA(0, 1, At, B1); PG_BAR;
            PG_LDA(At, 1, 1); PG_STAGE(PG_SA(1, 0), a3, aC0);
            PG_BAR; PG_WAIT_L(0); PG_MMA(1, 0, At, B0); PG_BAR; PG_SCHED;
            PG_STAGE(PG_SB(1, 1), b3 + hstepB, voffB);
            PG_WAIT_V(6); PG_BAR; PG_MMA(1, 1, At, B1); PG_BAR;
        }
        E(acc, cur, wr, wc, fr, fq);
        if (!has_next) break;
#pragma unroll
        for (int a = 0; a < 2; ++a)
#pragma unroll
            for (int b = 0; b < 2; ++b)
#pragma unroll
                for (int m = 0; m < 4; ++m)
#pragma unroll
                    for (int n = 0; n < 2; ++n) acc[a][b][m][n] = (f32x4){0.f, 0.f, 0.f, 0.f};
        cur = nxt; cB = nB; ++ui;
    }
    PG_WAIT_V(0);
    if (wr == 0) PG_BAR;
    PG_BAR;
#undef PG_SA
#undef PG_SB
#undef PG_STAGE
#undef PG_LDA
#undef PG_LDB
#undef PG_MMA
#undef PG_WAIT_V
#undef PG_WAIT_L
#undef PG_BAR
#undef PG_SCHED
#undef PG_AOFF
}

struct DenseSched {
    const char* A; const char* Bt; int K, nM, nN, nwg, G, c;
    __device__ void init(const void* A_, const void* Bt_, int M, int N, int K_, int G_, int c_) { A = (const char*)A_; Bt = (const char*)Bt_; K = K_; nM = M / BM; nN = N / BM; nwg = nM * nN; G = G_; c = c_; }
    __device__ __forceinline__ bool next(int i, Unit& u) const {
        const long L = (long)i * G + c; if (L >= nwg) return false;
        int wgid = (int)L; { const int q = nwg / 8, r = nwg % 8, xcd = wgid % 8, off = wgid / 8; wgid = (xcd < r ? xcd * (q + 1) : r * (q + 1) + (xcd - r) * q) + off; }
        const int nig = 8 * nN, gid = wgid / nig, fm = gid * 8, gsz = (nM - fm) < 8 ? (nM - fm) : 8;
        u.pm = fm + ((wgid % nig) % gsz); u.pn = (wgid % nig) / gsz; u.e = 0; u.rt = 0; u.cnt = 0; return true;
    }
    __device__ __forceinline__ const char* a_base() const { return A; }
    __device__ __forceinline__ unsigned a_rowoff(const Unit& u, int half, int R) const { return (unsigned)(u.pm * BM + half * HALF + R) * (unsigned)(K * 2); }
    __device__ __forceinline__ const char* b_ptr(const Unit& u) const { return Bt + (size_t)u.pn * BM * K * 2; }
};

__device__ __forceinline__ void moe_build_units(LAS int* tab, const int* cntp, int NCT, int G, int c) {
    const int i = threadIdx.x;
    if (i < 16) {
        const int L = i * G + c; int accu = 0, rtb = 0, found = 0, pm = 0, pn = 0, ee = 0, rt = 0, cn = 0;
        for (int e = 0; e < 16; ++e) { const int ce = cntp[e], nte = (ce + 255) >> 8, ue = nte * NCT;
            if (!found && L < accu + ue) { const int local = L - accu; ee = e; rt = local / NCT; pn = local % NCT; pm = rtb + rt; cn = ce; found = 1; }
            accu += ue; rtb += nte; }
        tab[i * 8 + 0] = found; tab[i * 8 + 1] = pm; tab[i * 8 + 2] = pn; tab[i * 8 + 3] = ee; tab[i * 8 + 4] = rt; tab[i * 8 + 5] = cn;
    }
    __syncthreads();
}
template <bool GATHER>
struct MoeSched {
    const char* A; const char* Bt; const int* list; int K; size_t wstride; LAS int* tab;
    __device__ void init(const void* A_, const void* Bt_, size_t wstride_bytes, const int* list_, int K_, LAS int* tab_) {
        A = (const char*)A_; Bt = (const char*)Bt_; wstride = wstride_bytes; list = list_; K = K_; tab = tab_; }
    __device__ __forceinline__ bool next(int i, Unit& u) const {
        if (i >= 16) return false;
        const int f = __builtin_amdgcn_readfirstlane(tab[i * 8 + 0]);
        u.pm = __builtin_amdgcn_readfirstlane(tab[i * 8 + 1]); u.pn = __builtin_amdgcn_readfirstlane(tab[i * 8 + 2]); u.e = __builtin_amdgcn_readfirstlane(tab[i * 8 + 3]);
        u.rt = __builtin_amdgcn_readfirstlane(tab[i * 8 + 4]); u.cnt = __builtin_amdgcn_readfirstlane(tab[i * 8 + 5]);
        return f != 0;
    }
    __device__ __forceinline__ const char* a_base() const { return A; }
    __device__ __forceinline__ unsigned a_rowoff(const Unit& u, int half, int R) const {
        if (GATHER) { const int slot = u.rt * BM + half * HALF + R; const int tok = slot < u.cnt ? list[u.e * NTOK + slot] : 0; return (unsigned)tok * (unsigned)(K * 2); }
        return (unsigned)(u.pm * BM + half * HALF + R) * (unsigned)(K * 2);
    }
    __device__ __forceinline__ const char* b_ptr(const Unit& u) const { return Bt + (size_t)u.e * wstride + (size_t)u.pn * BM * K * 2; }
};

struct EpiBf16 {
    static constexpr bool PERM = true;
    bf16_t* O; int ldc;
    __device__ __forceinline__ void operator()(const f32x4 (&acc)[2][2][4][2], const Unit& u, int wr, int wc, int fr, int fq) const {
        const int row0 = u.pm * BM + wr * 64 + fr, col0 = u.pn * BM + wc * 32 + 8 * fq;
#pragma unroll
        for (int ai = 0; ai < 2; ++ai)
#pragma unroll
            for (int m = 0; m < 4; ++m) { bf16_t* rowp = O + (size_t)(row0 + ai * HALF + m * 16) * ldc + col0;
#pragma unroll
                for (int bj = 0; bj < 2; ++bj) { const f32x4 v0 = acc[ai][bj][m][0], v1 = acc[ai][bj][m][1];
                    u32x4 w; w.x = cvt_pk_bf16(v0[0], v0[1]); w.y = cvt_pk_bf16(v0[2], v0[3]); w.z = cvt_pk_bf16(v1[0], v1[1]); w.w = cvt_pk_bf16(v1[2], v1[3]);
                    *(u32x4*)(rowp + bj * HALF) = w; } }
    }
};
struct EpiResid {
    static constexpr bool PERM = false;
    const float* X; float* U;
    __device__ __forceinline__ void operator()(const f32x4 (&acc)[2][2][4][2], const Unit& u, int wr, int wc, int fr, int fq) const {
        const int row0 = u.pm * BM + wr * 64 + fr, col0 = u.pn * BM + wc * 32 + 4 * fq;
#pragma unroll
        for (int ai = 0; ai < 2; ++ai)
#pragma unroll
            for (int m = 0; m < 4; ++m) { const size_t off = (size_t)(row0 + ai * HALF + m * 16) * DM + col0;
#pragma unroll
                for (int bj = 0; bj < 2; ++bj)
#pragma unroll
                    for (int n = 0; n < 2; ++n) { const f32x4 xv = *(const f32x4*)(X + off + bj * HALF + n * 16);
                        *(f32x4*)(U + off + bj * HALF + n * 16) = xv * DN_ALPHA + acc[ai][bj][m][n]; } }
    }
};
struct EpiSwiglu {
    static constexpr bool PERM = true;
    bf16_t* O;
    __device__ __forceinline__ void operator()(const f32x4 (&acc)[2][2][4][2], const Unit& u, int wr, int wc, int fr, int fq) const {
        const int row0 = u.pm * BM + wr * 64 + fr, col0 = u.pn * HALF + wc * 32 + 8 * fq;
#pragma unroll
        for (int ai = 0; ai < 2; ++ai)
#pragma unroll
            for (int m = 0; m < 4; ++m) { bf16_t* rowp = O + (size_t)(row0 + ai * HALF + m * 16) * DEXP + col0;
                float r[8];
#pragma unroll
                for (int n = 0; n < 2; ++n)
#pragma unroll
                    for (int j = 0; j < 4; ++j) { const float g = acc[ai][0][m][n][j], up = acc[ai][1][m][n][j]; r[n * 4 + j] = g / (1.0f + __expf(-g)) * up; }
                u32x4 w; w.x = cvt_pk_bf16(r[0], r[1]); w.y = cvt_pk_bf16(r[2], r[3]); w.z = cvt_pk_bf16(r[4], r[5]); w.w = cvt_pk_bf16(r[6], r[7]);
                *(u32x4*)rowp = w; }
    }
};
}

__device__ __forceinline__ void tr_tile(LAS float* tile  , const float* src, int ld, int k0, int c0, int ncols_valid, bf16_t* dst, int dstK, int drow0, int tid) {
    {
        const int r = tid >> 3, cc = (tid & 7) * 8;
        const float* sp = src + (size_t)(k0 + r) * ld + c0 + cc;
#pragma unroll
        for (int j = 0; j < 8; ++j) tile[r * 65 + cc + j] = (c0 + cc + j < ncols_valid) ? sp[j] : 0.f;
    }
    __syncthreads();
    {
        const int n = tid >> 3, kk = (tid & 7) * 8;
        u32x4 w;
        w.x = cvt_pk_bf16(tile[(kk + 0) * 65 + n], tile[(kk + 1) * 65 + n]); w.y = cvt_pk_bf16(tile[(kk + 2) * 65 + n], tile[(kk + 3) * 65 + n]);
        w.z = cvt_pk_bf16(tile[(kk + 4) * 65 + n], tile[(kk + 5) * 65 + n]); w.w = cvt_pk_bf16(tile[(kk + 6) * 65 + n], tile[(kk + 7) * 65 + n]);
        *(u32x4*)(dst + (size_t)(drow0 + n) * dstK + k0 + kk) = w;
    }
    __syncthreads();
}

__device__ __forceinline__ void phase_prep(const Params& p, LAS unsigned char* lds, int bid, int nb) {
    const int tid = threadIdx.x;
    LAS float* tile = (LAS float*)lds;
    unsigned char* ws = p.ws;
    const int T0 = 832, T1 = T0 + 256, T2 = T1 + 448, T3 = T2 + 256, T4 = T3 + 2048, T5 = T4 + 2048, T6 = T5 + 2048;
    for (int t = bid; t < T6; t += nb) {
        if (t < T0) { const int kt = t / 52, ct = t % 52; tr_tile(tile, p.in[I_WINE], EVEN_COLS, kt * 64, ct * 64, EVEN_COLS, (bf16_t*)(ws + OFF_WINE), 1024, ct * 64, tid); }
        else if (t < T1) { const int q = t - T0, kt = q / 16, ct = q % 16; tr_tile(tile, p.in[I_WOUTE], 1024, kt * 64, ct * 64, 1024, (bf16_t*)(ws + OFF_WOUTE), 1024, ct * 64, tid); }
        else if (t < T2) { const int q = t - T1, kt = q / 28, ct = q % 28; tr_tile(tile, p.in[I_WINO], ODD_COLS, kt * 64, ct * 64, ODD_COLS, (bf16_t*)(ws + OFF_WINO), 1024, ct * 64, tid); }
        else if (t < T3) { const int q = t - T2, kt = q / 16, ct = q % 16; tr_tile(tile, p.in[I_WOUTO], 1024, kt * 64, ct * 64, 1024, (bf16_t*)(ws + OFF_WOUTO), 1024, ct * 64, tid); }
        else if (t < T5) { const bool up = t >= T4; const int q = t - (up ? T4 : T3), le = q / 64, r = q % 64, kt = r / 4, ct = r % 4;
            const int c0 = ct * 64, drow0 = (c0 / 128) * 256 + (up ? 128 : 0) + (c0 % 128);
            tr_tile(tile, p.in[up ? I_EU : I_EG] + (size_t)le * 1024 * 256, 256, kt * 64, c0, 256, (bf16_t*)(ws + OFF_WGU) + (size_t)le * 512 * 1024, 1024, drow0, tid); }
        else { const int q = t - T5, le = q / 64, r = q % 64, kt = r / 16, ct = r % 16;
            tr_tile(tile, p.in[I_ED] + (size_t)le * 256 * 1024, 1024, kt * 64, ct * 64, 1024, (bf16_t*)(ws + OFF_WD) + (size_t)le * 1024 * 256, 256, ct * 64, tid); }
    }
    {
        const float* x = p.in[I_X]; bf16_t* xb = (bf16_t*)(ws + OFF_BUF64);
        const size_t n8 = (size_t)NTOK * DM / 8;
        for (size_t i = (size_t)bid * 512 + tid; i < n8; i += (size_t)nb * 512) {
            const f32x4 a = *(const f32x4*)(x + i * 8), b = *(const f32x4*)(x + i * 8 + 4);
            u32x4 w; w.x = cvt_pk_bf16(a[0], a[1]); w.y = cvt_pk_bf16(a[2], a[3]); w.z = cvt_pk_bf16(b[0], b[1]); w.w = cvt_pk_bf16(b[2], b[3]);
            *(u32x4*)(xb + i * 8) = w;
        }
    }
    {
        float* c64 = (float*)(ws + OFF_ROPE); float* s64 = c64 + 4096 * 64; float* c32 = s64 + 4096 * 64; float* s32 = c32 + 4096 * 32;
        for (int i = bid * 512 + tid; i < 4096 * 64; i += nb * 512) { const int pos = i >> 6, j = i & 63; const float inv = powf(10000.0f, -(float)j / 64.0f); const float ang = (float)pos * inv; c64[i] = cosf(ang); s64[i] = sinf(ang); }
        for (int i = bid * 512 + tid; i < 4096 * 32; i += nb * 512) { const int pos = i >> 5, j = i & 31; const float inv = powf(10000.0f, -(float)j / 32.0f); const float ang = (float)pos * inv; c32[i] = cosf(ang); s32[i] = sinf(ang); }
    }
    if (bid == 0 && tid < 64) ((int*)(ws + OFF_MISC + MISC_CNT))[tid] = 0;
}

__device__ __forceinline__ void phase_ln_route(const Params& p, LAS unsigned char* lds, int bid, int nb, int layer) {
    const int tid = threadIdx.x, wid = tid >> 6, lane = tid & 63;
    unsigned char* ws = p.ws;
    LAS float* rwT = (LAS float*)lds;
    for (int i = tid; i < 16 * 1024; i += 512) { const int e = i >> 10, k = i & 1023; rwT[i] = p.in[I_RW][k * 16 + e]; }
    __syncthreads();
    float* U = (float*)(ws + OFF_U); bf16_t* hb = (bf16_t*)(ws + OFF_BUF64);
    const float* g = p.in[I_LN1G] + layer * DM; const float* b = p.in[I_LN1B] + layer * DM;
    int* cnt = (int*)(ws + OFF_MISC + MISC_CNT) + layer * 16;
    int* tokinfo = (int*)(ws + OFF_MISC + MISC_TOKINFO); float* tokgate = (float*)(ws + OFF_MISC + MISC_TOKGATE); int* list = (int*)(ws + OFF_MISC + MISC_LIST);
    f32x4 gv[4], bv[4];
#pragma unroll
    for (int j = 0; j < 4; ++j) { gv[j] = *(const f32x4*)(g + j * 256 + lane * 4); bv[j] = *(const f32x4*)(b + j * 256 + lane * 4); }
    float rbias[16];
#pragma unroll
    for (int e = 0; e < 16; ++e) rbias[e] = p.in[I_RB][e];
    for (int tok = bid * 8 + wid; tok < NTOK; tok += nb * 8) {
        f32x4 v[4]; float s = 0.f;
#pragma unroll
        for (int j = 0; j < 4; ++j) { v[j] = *(const f32x4*)(U + (size_t)tok * DM + j * 256 + lane * 4); s += (v[j][0] + v[j][1]) + (v[j][2] + v[j][3]); }
        const float mean = wave_sum(s) * (1.0f / DM);
        float q = 0.f;
#pragma unroll
        for (int j = 0; j < 4; ++j) { v[j] -= mean; q += (v[j][0] * v[j][0] + v[j][1] * v[j][1]) + (v[j][2] * v[j][2] + v[j][3] * v[j][3]); }
        const float rstd = rsqrtf(wave_sum(q) * (1.0f / DM) + LN_EPS);
#pragma unroll
        for (int j = 0; j < 4; ++j) { v[j] = v[j] * rstd * gv[j] + bv[j];
            *(f32x4*)(U + (size_t)tok * DM + j * 256 + lane * 4) = v[j];
            u32x2 w; w.x = cvt_pk_bf16(v[j][0], v[j][1]); w.y = cvt_pk_bf16(v[j][2], v[j][3]);
            *(u32x2*)(hb + (size_t)tok * DM + j * 256 + lane * 4) = w; }
        float lg[16];
        asm volatile("" ::: "memory");
#pragma unroll
        for (int e = 0; e < 16; ++e) { float a = 0.f;
#pragma unroll
            for (int j = 0; j < 4; ++j) { const f32x4 w = *(const LAS f32x4*)(rwT + e * 1024 + j * 256 + lane * 4); a += (v[j][0] * w[0] + v[j][1] * w[1]) + (v[j][2] * w[2] + v[j][3] * w[3]); }
            lg[e] = wave_sum(a); }
        float sg[16], sel[16];
#pragma unroll
        for (int e = 0; e < 16; ++e) { sg[e] = 1.0f / (1.0f + expf(-lg[e])); sel[e] = sg[e] + rbias[e]; }
        int best = 0; float bestv = -INFINITY;
#pragma unroll
        for (int gI = 0; gI < 4; ++gI) { float m1 = -INFINITY, m2 = -INFINITY;
#pragma unroll
            for (int j = 0; j < 4; ++j) { const float x = sel[gI * 4 + j]; if (x > m1) { m2 = m1; m1 = x; } else if (x > m2) m2 = x; }
            const float gs = m1 + m2; if (gs > bestv) { bestv = gs; best = gI; } }
        int e0 = 0, e1 = 0; float v0 = -INFINITY, v1 = -INFINITY, s0 = 0.f, s1 = 0.f;
#pragma unroll
        for (int e = 0; e < 16; ++e) { if ((e >> 2) == best) { const float x = sel[e];
                if (x > v0) { v1 = v0; e1 = e0; s1 = s0; v0 = x; e0 = e; s0 = sg[e]; } else if (x > v1) { v1 = x; e1 = e; s1 = sg[e]; } } }
        const float gsum = s0 + s1; const float g0 = s0 / gsum, g1 = s1 / gsum;
        if (lane == 0) {
            const int sl0 = atomicAdd(cnt + e0, 1), sl1 = atomicAdd(cnt + e1, 1);
            list[e0 * NTOK + sl0] = tok; list[e1 * NTOK + sl1] = tok;
            tokinfo[tok * 4 + 0] = e0; tokinfo[tok * 4 + 1] = sl0; tokinfo[tok * 4 + 2] = e1; tokinfo[tok * 4 + 3] = sl1;
            tokgate[tok * 2 + 0] = g0; tokgate[tok * 2 + 1] = g1;
        }
    }
}

__device__ __forceinline__ void phase_ln2(const Params& p, int bid, int nb, int layer, float* dst, bool with_moe) {
    const int tid = threadIdx.x, wid = tid >> 6, lane = tid & 63;
    unsigned char* ws = p.ws;
    const float* U = (const float*)(ws + OFF_U); bf16_t* xb = (bf16_t*)(ws + OFF_BUF64);
    const bf16_t* he = (const bf16_t*)(ws + OFF_HE);
    const float* g = p.in[I_LN2G] + layer * DM; const float* b = p.in[I_LN2B] + layer * DM;
    const int* cnt = (const int*)(ws + OFF_MISC + MISC_CNT) + layer * 16;
    const int* tokinfo = (const int*)(ws + OFF_MISC + MISC_TOKINFO); const float* tokgate = (const float*)(ws + OFF_MISC + MISC_TOKGATE);
    int rowbase[16]; { int a = 0;
#pragma unroll
        for (int e = 0; e < 16; ++e) { rowbase[e] = a; a += ((cnt[e] + 255) >> 8) << 8; } }
    f32x4 gv[4], bv[4];
#pragma unroll
    for (int j = 0; j < 4; ++j) { gv[j] = *(const f32x4*)(g + j * 256 + lane * 4); bv[j] = *(const f32x4*)(b + j * 256 + lane * 4); }
    for (int tok = bid * 8 + wid; tok < NTOK; tok += nb * 8) {
        f32x4 v[4]; float s = 0.f;
        int r0 = 0, r1 = 0; float g0 = 0.f, g1 = 0.f;
        if (with_moe) { const int e0 = tokinfo[tok * 4 + 0], sl0 = tokinfo[tok * 4 + 1], e1 = tokinfo[tok * 4 + 2], sl1 = tokinfo[tok * 4 + 3];
            int rb0 = 0, rb1 = 0;
#pragma unroll
            for (int e = 0; e < 16; ++e) { if (e == e0) rb0 = rowbase[e]; if (e == e1) rb1 = rowbase[e]; }
            r0 = rb0 + sl0; r1 = rb1 + sl1; g0 = tokgate[tok * 2 + 0]; g1 = tokgate[tok * 2 + 1]; }
#pragma unroll
        for (int j = 0; j < 4; ++j) { v[j] = *(const f32x4*)(U + (size_t)tok * DM + j * 256 + lane * 4) * DN_ALPHA;
            if (with_moe) { const u32x2 a = *(const u32x2*)(he + (size_t)r0 * DM + j * 256 + lane * 4), c = *(const u32x2*)(he + (size_t)r1 * DM + j * 256 + lane * 4);
                v[j][0] += g0 * __uint_as_float(a.x << 16) + g1 * __uint_as_float(c.x << 16); v[j][1] += g0 * __uint_as_float(a.x & 0xffff0000u) + g1 * __uint_as_float(c.x & 0xffff0000u);
                v[j][2] += g0 * __uint_as_float(a.y << 16) + g1 * __uint_as_float(c.y << 16); v[j][3] += g0 * __uint_as_float(a.y & 0xffff0000u) + g1 * __uint_as_float(c.y & 0xffff0000u); }
            s += (v[j][0] + v[j][1]) + (v[j][2] + v[j][3]); }
        const float mean = wave_sum(s) * (1.0f / DM);
        float q = 0.f;
#pragma unroll
        for (int j = 0; j < 4; ++j) { v[j] -= mean; q += (v[j][0] * v[j][0] + v[j][1] * v[j][1]) + (v[j][2] * v[j][2] + v[j][3] * v[j][3]); }
        const float rstd = rsqrtf(wave_sum(q) * (1.0f / DM) + LN_EPS);
#pragma unroll
        for (int j = 0; j < 4; ++j) { v[j] = v[j] * rstd * gv[j] + bv[j];
            *(f32x4*)(dst + (size_t)tok * DM + j * 256 + lane * 4) = v[j];
            u32x2 w; w.x = cvt_pk_bf16(v[j][0], v[j][1]); w.y = cvt_pk_bf16(v[j][2], v[j][3]);
            *(u32x2*)(xb + (size_t)tok * DM + j * 256 + lane * 4) = w; }
    }
}

__device__ __forceinline__ void phase_resid_only(const Params& p, const float* X, int bid, int nb) {
    float* U = (float*)(p.ws + OFF_U);
    const size_t n4 = (size_t)NTOK * DM / 4;
    for (size_t i = (size_t)bid * 512 + threadIdx.x; i < n4; i += (size_t)nb * 512) *(f32x4*)(U + i * 4) = *(const f32x4*)(X + i * 4) * DN_ALPHA;
}

__device__ __forceinline__ void phase_moe_gateup(const Params& p, LAS unsigned char* lds, int bid, int nb, int layer) {
    unsigned char* ws = p.ws;
    LAS int* tab = (LAS int*)(lds + pg::STAGE_BYTES);
    pg::moe_build_units(tab, (const int*)(ws + OFF_MISC + MISC_CNT) + layer * 16, 2, nb, bid);
    pg::MoeSched<true> S; S.init(ws + OFF_BUF64, ws + OFF_WGU + (size_t)layer * 16 * 512 * 1024 * 2, (size_t)512 * 1024 * 2, (const int*)(ws + OFF_MISC + MISC_LIST), 1024, tab);
    pg::EpiSwiglu E; E.O = (bf16_t*)(ws + OFF_ACT);
    pg::gemm_phase(lds, 1024, S, E);
}
__device__ __forceinline__ void phase_moe_down(const Params& p, LAS unsigned char* lds, int bid, int nb, int layer) {
    unsigned char* ws = p.ws;
    LAS int* tab = (LAS int*)(lds + pg::STAGE_BYTES);
    pg::moe_build_units(tab, (const int*)(ws + OFF_MISC + MISC_CNT) + layer * 16, 4, nb, bid);
    pg::MoeSched<false> S; S.init(ws + OFF_ACT, ws + OFF_WD + (size_t)layer * 16 * 1024 * 256 * 2, (size_t)1024 * 256 * 2, nullptr, 256, tab);
    pg::EpiBf16 E; E.O = (bf16_t*)(ws + OFF_HE); E.ldc = 1024;
    pg::gemm_phase(lds, 256, S, E);
}

__device__ __forceinline__ void phase_gla_alpha(const Params& p, LAS unsigned char* lds, int bid, int nb) {
    const int tid = threadIdx.x, wid = tid >> 6, lane = tid & 63;
    LAS float* wT = (LAS float*)lds;
    for (int i = tid; i < 16 * 1024; i += 512) { const int e = i & 15, k = i >> 4; wT[e * 1024 + k] = p.in[I_WINE][(size_t)k * EVEN_COLS + NE_MAIN + e]; }
    __syncthreads();
    const float* x = p.in[I_X]; float* xa = (float*)(p.ws + OFF_U);
    for (int tok = bid * 8 + wid; tok < NTOK; tok += nb * 8) {
        f32x4 v[4];
        asm volatile("" ::: "memory");
#pragma unroll
        for (int j = 0; j < 4; ++j) v[j] = *(const f32x4*)(x + (size_t)tok * DM + j * 256 + lane * 4);
        float mine = 0.f;
#pragma unroll
        for (int e = 0; e < 16; ++e) { float a = 0.f;
#pragma unroll
            for (int j = 0; j < 4; ++j) { const f32x4 w = *(const LAS f32x4*)(wT + e * 1024 + j * 256 + lane * 4); a += (v[j][0] * w[0] + v[j][1] * w[1]) + (v[j][2] * w[2] + v[j][3] * w[3]); }
            a = wave_sum(a); if (lane == e) mine = a; }
        if (lane < 16) xa[(size_t)tok * 16 + lane] = mine;
    }
    __syncthreads();
}

template <int CTRL> __device__ __forceinline__ float dppf(float v) { return __builtin_bit_cast(float, __builtin_amdgcn_update_dpp(0, __builtin_bit_cast(int, v), CTRL, 0xf, 0xf, true)); }
__device__ __forceinline__ float red8(float v) { v += dppf<0xB1>(v); v += dppf<0x4E>(v); v += dppf<0x141>(v); return v; }

__device__ __forceinline__ void rwkv_item(const Params& p, LAS unsigned char* lds, int item) {
    constexpr int TC = 16;
    const int tid = threadIdx.x, lane = tid & 63, tg = tid >> 6;
    const int b = item >> 3, h = item & 7;
    const bf16_t* P0 = (const bf16_t*)(p.ws + OFF_P);
    bf16_t* mix = (bf16_t*)(p.ws + OFF_BUF64);
    LAS float* w2s = (LAS float*)lds;
    LAS float* a2s = w2s + 64 * 64;
    LAS float* g2s = a2s + 64 * 64;
    LAS float* tw = g2s + 128 * 64;
    LAS float* xa_s = tw + TC * 64;
    LAS float* sg = xa_s + TC * 64;
    LAS float* r_s = sg + TC * 128;
    LAS float* k_s = r_s + TC * 64;
    LAS float* v_s = k_s + TC * 64;
    LAS float* w_s = v_s + TC * 64;
    LAS float* kk_s = w_s + TC * 64;
    LAS float* kka_s = kk_s + TC * 64;
    LAS float* kh_s = kka_s + TC * 64;
    LAS float* g_s = kh_s + TC * 64;
    LAS float* y_s = g_s + TC * 64;
    LAS float* rk_s = y_s + TC * 64;
    const float* mu = p.in[I_AMU];
    for (int i = tid; i < 64 * 64; i += 512) { const int r = i >> 6, c = i & 63; w2s[i] = p.in[I_AW2][r * 512 + h * 64 + c]; a2s[i] = p.in[I_AA2][r * 512 + h * 64 + c]; }
    for (int i = tid; i < 128 * 64; i += 512) { const int r = i >> 6, c = i & 63; g2s[i] = p.in[I_AG2][r * 512 + h * 64 + c]; }
    const int j = lane;
    const float w0 = p.in[I_AW0][h * 64 + j], a0 = p.in[I_AA0][h * 64 + j], kksc = p.in[I_AKK][h * 64 + j], kasc = p.in[I_AKA][h * 64 + j], rkj = p.in[I_ARK][h * 64 + j];
    const float gng = p.in[I_AGNG][h * 64 + j], gnb = p.in[I_AGNB][h * 64 + j];
    float S[8];
#pragma unroll
    for (int i = 0; i < 8; ++i) S[i] = 0.f;
    const int row = tid >> 3, kq = tid & 7;
    __syncthreads();
    for (int t0 = 0; t0 < SEQ; t0 += TC) {
        for (int idx = tid; idx < TC * 448; idx += 512) {
            const int t = idx / 448, c = idx % 448; int col; LAS float* dst; int kind = 0;
            if (c < 64) { col = h * 64 + c; dst = r_s + t * 64 + c; }
            else if (c < 128) { col = 512 + h * 64 + (c - 64); dst = k_s + t * 64 + (c - 64); }
            else if (c < 192) { col = 1024 + h * 64 + (c - 128); dst = v_s + t * 64 + (c - 128); }
            else if (c < 256) { col = 1536 + (c - 192); dst = tw + t * 64 + (c - 192); kind = 1; }
            else if (c < 320) { col = 1600 + (c - 256); dst = xa_s + t * 64 + (c - 256); }
            else { col = 1664 + (c - 320); dst = sg + t * 128 + (c - 320); kind = 2; }
            const size_t n = (size_t)b * SEQ + t0 + t;
            const float cur = bf2f(P0[n * NE_MAIN + col]);
            const float prev = (t0 + t) > 0 ? bf2f(P0[(n - 1) * NE_MAIN + col]) : 0.f;
            float val = cur + (prev - cur) * mu[col];
            if (kind == 1) val = tanhf(val); else if (kind == 2) val = 1.0f / (1.0f + expf(-val));
            *dst = val;
        }
        __syncthreads();
#pragma unroll
        for (int tt = 0; tt < 2; ++tt) {
            const int t = tg + tt * 8;
            float aw = 0.f, aa = 0.f, ag = 0.f;
            asm volatile("" ::: "memory");
#pragma unroll 4
            for (int i = 0; i < 64; ++i) { aw += tw[t * 64 + i] * w2s[i * 64 + j]; aa += xa_s[t * 64 + i] * a2s[i * 64 + j]; }
            asm volatile("" ::: "memory");
#pragma unroll 4
            for (int i = 0; i < 128; ++i) ag += sg[t * 128 + i] * g2s[i * 64 + j];
            asm volatile("" ::: "memory");
            const float z = w0 + aw;
            const float sp = (-z > 20.f) ? -z : log1pf(expf(-z));
            const float wlog = -sp - 0.5f;
            const float decay = expf(-expf(wlog));
            const float a = 1.0f / (1.0f + expf(-(a0 + aa)));
            const float kraw = k_s[t * 64 + j];
            const float kkp = kraw * kksc;
            const float nrm = sqrtf(wave_sum(kkp * kkp));
            const float kk = kkp / fmaxf(nrm, 1e-12f);
            const float kh = kraw * (1.0f + (a - 1.0f) * kasc);
            const float rr = r_s[t * 64 + j];
            const float rk = wave_sum(rr * kh * rkj);
            w_s[t * 64 + j] = decay; kk_s[t * 64 + j] = kk; kka_s[t * 64 + j] = kk * a; kh_s[t * 64 + j] = kh; g_s[t * 64 + j] = ag;
            if (j == 0) rk_s[t] = rk;
        }
        __syncthreads();
        for (int t = 0; t < TC; ++t) {
            const f32x4 kk0 = *(const LAS f32x4*)(kk_s + t * 64 + kq * 8), kk1 = *(const LAS f32x4*)(kk_s + t * 64 + kq * 8 + 4);
            const f32x4 ww0 = *(const LAS f32x4*)(w_s + t * 64 + kq * 8), ww1 = *(const LAS f32x4*)(w_s + t * 64 + kq * 8 + 4);
            const f32x4 ka0 = *(const LAS f32x4*)(kka_s + t * 64 + kq * 8), ka1 = *(const LAS f32x4*)(kka_s + t * 64 + kq * 8 + 4);
            const f32x4 kh0 = *(const LAS f32x4*)(kh_s + t * 64 + kq * 8), kh1 = *(const LAS f32x4*)(kh_s + t * 64 + kq * 8 + 4);
            const f32x4 rr0 = *(const LAS f32x4*)(r_s + t * 64 + kq * 8), rr1 = *(const LAS f32x4*)(r_s + t * 64 + kq * 8 + 4);
            const float vv = v_s[t * 64 + row];
            float sa = 0.f;
#pragma unroll
            for (int i = 0; i < 4; ++i) { sa += S[i] * kk0[i]; sa += S[4 + i] * kk1[i]; }
            sa = red8(sa);
            float y = 0.f;
#pragma unroll
            for (int i = 0; i < 4; ++i) {
                S[i] = S[i] * ww0[i] - sa * ka0[i] + vv * kh0[i]; S[4 + i] = S[4 + i] * ww1[i] - sa * ka1[i] + vv * kh1[i];
                y += S[i] * rr0[i]; y += S[4 + i] * rr1[i]; }
            y = red8(y);
            if (kq == 0) y_s[t * 64 + row] = y;
        }
        __syncthreads();
#pragma unroll
        for (int tt = 0; tt < 2; ++tt) {
            const int t = tg + tt * 8;
            const float y = y_s[t * 64 + j];
            const float mean = wave_sum(y) * (1.0f / 64.0f);
            const float d = y - mean;
            const float var = wave_sum(d * d) * (1.0f / 64.0f);
            const float yn = d * rsqrtf(var + 64e-5f) * gng + gnb;
            const float o = (yn + rk_s[t] * v_s[t * 64 + j]) * g_s[t * 64 + j];
            mix[((size_t)b * SEQ + t0 + t) * DM + h * 64 + j] = f2bf(o);
        }
        __syncthreads();
    }
}

__device__ __forceinline__ void gla_item(const Params& p, LAS unsigned char* lds, int item) {
    const int tid = threadIdx.x, lane = tid & 63, tg = tid >> 6;
    const int b = item >> 2, h = item & 3;
    const bf16_t* P0 = (const bf16_t*)(p.ws + OFF_P) + 1792;
    const float* xa16 = (const float*)(p.ws + OFF_U);
    bf16_t* mix = (bf16_t*)(p.ws + OFF_BUF64);
    LAS float* qd = (LAS float*)lds;
    LAS float* ki = qd + 64 * 65;
    LAS float* att = ki + 64 * 65;
    LAS float* vs = att + 64 * 65;
    LAS float* St = vs + 64 * 128;
    LAS float* bl = St + 64 * 128;
    for (int i = tid; i < 64 * 128; i += 512) St[i] = 0.f;
    float gw2[16];
#pragma unroll
    for (int i = 0; i < 16; ++i) gw2[i] = p.in[I_BGW2][i * 256 + h * 64 + lane];
    const float gb = p.in[I_BGB][h * 64 + lane];
    __syncthreads();
    for (int c0 = 0; c0 < SEQ; c0 += 64) {
        const size_t n0 = (size_t)b * SEQ + c0;
        for (int tt = 0; tt < 8; ++tt) { const int c = tg * 8 + tt; float z = gb;
#pragma unroll
            for (int i = 0; i < 16; ++i) z += xa16[(n0 + c) * 16 + i] * gw2[i];
            const float ls = (z >= 0.f) ? -log1pf(expf(-z)) : (z - log1pf(expf(z)));
            att[c * 65 + lane] = ls * (1.0f / 16.0f); }
        for (int i = tid; i < 64 * 128; i += 512) { const int c = i >> 7, e = i & 127; vs[i] = bf2f(P0[(n0 + c) * NE_MAIN + 512 + h * 128 + e]); }
        __syncthreads();
        if (tid < 64) { float a = 0.f; for (int c = 0; c < 64; ++c) { a += att[c * 65 + tid]; att[c * 65 + tid] = a; } bl[tid] = a; }
        __syncthreads();
        for (int i = tid; i < 64 * 64; i += 512) { const int c = i >> 6, d = i & 63; const float bc = att[c * 65 + d];
            const float q = bf2f(P0[(n0 + c) * NE_MAIN + h * 64 + d]), k = bf2f(P0[(n0 + c) * NE_MAIN + 256 + h * 64 + d]);
            qd[c * 65 + d] = q * 0.125f * expf(bc); ki[c * 65 + d] = k * expf(-bc); }
        __syncthreads();
        { const int c = tid >> 3, sgp = tid & 7; float a[8];
#pragma unroll
            for (int i = 0; i < 8; ++i) a[i] = 0.f;
            for (int d = 0; d < 64; ++d) { const float qv = qd[c * 65 + d];
#pragma unroll
                for (int i = 0; i < 8; ++i) a[i] += qv * ki[(sgp * 8 + i) * 65 + d]; }
            __syncthreads();
#pragma unroll
            for (int i = 0; i < 8; ++i) att[c * 65 + sgp * 8 + i] = (sgp * 8 + i <= c) ? a[i] : 0.f; }
        __syncthreads();
        { const int c = tid >> 3, eg = tid & 7; float o[16];
#pragma unroll
            for (int i = 0; i < 16; ++i) o[i] = 0.f;
            for (int s = 0; s <= c; ++s) { const float a = att[c * 65 + s];
#pragma unroll
                for (int i = 0; i < 16; ++i) o[i] += a * vs[s * 128 + eg * 16 + i]; }
            for (int d = 0; d < 64; ++d) { const float qv = qd[c * 65 + d];
#pragma unroll
                for (int i = 0; i < 16; ++i) o[i] += qv * St[d * 128 + eg * 16 + i]; }
            float ss = 0.f;
#pragma unroll
            for (int i = 0; i < 16; ++i) ss += o[i] * o[i];
            ss = red8(ss);
            const float rs = rsqrtf(ss * (1.0f / 128.0f) + 1e-5f);
#pragma unroll
            for (int i = 0; i < 16; ++i) { const int e = eg * 16 + i; const float g = bf2f(P0[(n0 + c) * NE_MAIN + 1024 + h * 128 + e]);
                const float val = o[i] * rs * p.in[I_BNG][h * 128 + e] * (g / (1.0f + expf(-g)));
                mix[(n0 + c) * DM + 512 + h * 128 + e] = f2bf(val); } }
        __syncthreads();
        { const int d = tid >> 3, eg = tid & 7; float a[16];
#pragma unroll
            for (int i = 0; i < 16; ++i) a[i] = St[d * 128 + eg * 16 + i];
            for (int c = 0; c < 64; ++c) { const float kv = ki[c * 65 + d];
#pragma unroll
                for (int i = 0; i < 16; ++i) a[i] += kv * vs[c * 128 + eg * 16 + i]; }
            const float eb = expf(bl[d]);
#pragma unroll
            for (int i = 0; i < 16; ++i) St[d * 128 + eg * 16 + i] = a[i] * eb; }
        __syncthreads();
    }
}

__device__ __forceinline__ void phase_mixer_even(const Params& p, LAS unsigned char* lds, int bid, int nb) {
    for (int item = bid; item < 96; item += nb) {
        if (item < 64) rwkv_item(p, lds, item); else gla_item(p, lds, item - 64);
        __syncthreads();
    }
}

__device__ __forceinline__ void phase_rope(const Params& p, int bid, int nb) {
    const int tid = threadIdx.x, wid = tid >> 6, lane = tid & 63;
    unsigned char* ws = p.ws;
    const bf16_t* Pd = (const bf16_t*)(ws + OFF_PD);
    bf16_t* qr = (bf16_t*)(ws + OFF_BUF64); bf16_t* kr = (bf16_t*)(ws + OFF_KR); bf16_t* vv = (bf16_t*)(ws + OFF_VV);
    bf16_t* iqr = (bf16_t*)(ws + OFF_IQR); bf16_t* ikr = (bf16_t*)(ws + OFF_IKR); float* iw = (float*)(ws + OFF_IW);
    const float* c64 = (const float*)(ws + OFF_ROPE); const float* s64 = c64 + 4096 * 64; const float* c32 = s64 + 4096 * 64; const float* s32 = c32 + 4096 * 32;
    const float ikg = p.in[I_CIKG][lane], ikb = p.in[I_CIKB][lane];
    for (int n = bid * 8 + wid; n < NTOK; n += nb * 8) {
        const int pos = n & (SEQ - 1);
        const bf16_t* row = Pd + (size_t)n * NO_MAIN;
        const float c = c64[pos * 64 + lane], s = s64[pos * 64 + lane];
#pragma unroll
        for (int h = 0; h < 8; ++h) { const float z1 = bf2f(row[h * 128 + lane]), z2 = bf2f(row[h * 128 + 64 + lane]);
            qr[(size_t)n * 1024 + h * 128 + lane] = f2bf((z1 * c - z2 * s) * 0.08838834764831845f);
            qr[(size_t)n * 1024 + h * 128 + 64 + lane] = f2bf((z2 * c + z1 * s) * 0.08838834764831845f); }
        { const float z1 = bf2f(row[1024 + lane]), z2 = bf2f(row[1024 + 64 + lane]);
            kr[(size_t)n * 128 + lane] = f2bf(z1 * c - z2 * s); kr[(size_t)n * 128 + 64 + lane] = f2bf(z2 * c + z1 * s); }
        vv[(size_t)n * 128 + lane] = row[1152 + lane]; vv[(size_t)n * 128 + 64 + lane] = row[1152 + 64 + lane];
        const int j32 = lane & 31; const float cc = c32[pos * 32 + j32], ss = s32[pos * 32 + j32];
#pragma unroll
        for (int r = 0; r < 2; ++r) { const int h = (lane >> 5) + 2 * r; const float z1 = bf2f(row[1280 + h * 64 + j32]), z2 = bf2f(row[1280 + h * 64 + 32 + j32]);
            iqr[(size_t)n * 256 + h * 64 + j32] = f2bf((z1 * cc - z2 * ss) * 0.125f); iqr[(size_t)n * 256 + h * 64 + 32 + j32] = f2bf((z2 * cc + z1 * ss) * 0.125f); }
        { const float x = bf2f(row[1536 + lane]); const float mean = wave_sum(x) * (1.0f / 64.0f); const float d = x - mean; const float var = wave_sum(d * d) * (1.0f / 64.0f);
            const float y = d * rsqrtf(var + LN_EPS) * ikg + ikb; const float o = __shfl_xor(y, 32);
            const float res = lane < 32 ? (y * cc - o * ss) : (y * cc + o * ss);
            ikr[(size_t)n * 64 + lane] = f2bf(res); }
        if (lane < 4) iw[(size_t)n * 4 + lane] = bf2f(row[1600 + lane]) * 0.5f;
    }
}

__device__ __forceinline__ void phase_index(const Params& p, LAS unsigned char* lds, int bid, int nb) {
    const int tid = threadIdx.x, wid = tid >> 6, lane = tid & 63;
    unsigned char* ws = p.ws;
    const bf16_t* iqr = (const bf16_t*)(ws + OFF_IQR); const bf16_t* ikr = (const bf16_t*)(ws + OFF_IKR); const float* iw = (const float*)(ws + OFF_IW);
    unsigned short* idx = (unsigned short*)(ws + OFF_IDX);
    LAS unsigned* sc = (LAS unsigned*)lds + wid * 4096;
    LAS int* hist = (LAS int*)(lds + 131072) + wid * 256;
    LAS float* iqs = (LAS float*)(lds + 131072 + 8192) + wid * 256;
    const unsigned long long lt_mask = (1ull << lane) - 1ull;
    for (int n = bid * 8 + wid; n < NTOK; n += nb * 8) {
        const int t = n & (SEQ - 1), b = n >> 12, nv = t + 1;
        unsigned short* out = idx + (size_t)n * 256;
        if (nv <= 256) { for (int j = lane; j < 256; j += 64) out[j] = (unsigned short)(j < nv ? j : 0); continue; }
#pragma unroll
        for (int j = 0; j < 4; ++j) iqs[lane * 4 + j] = bf2f(iqr[(size_t)n * 256 + lane * 4 + j]);
        const float w0 = iw[(size_t)n * 4 + 0], w1 = iw[(size_t)n * 4 + 1], w2 = iw[(size_t)n * 4 + 2], w3 = iw[(size_t)n * 4 + 3];
        const int nvp = (nv + 63) & ~63;
        for (int c0 = 0; c0 < nvp; c0 += 64) {
            const int key = c0 + lane; const bool valid = key < nv;
            float kf[64];
            const u32x4* kp = (const u32x4*)(ikr + ((size_t)b * SEQ + (valid ? key : 0)) * 64);
#pragma unroll
            for (int q = 0; q < 8; ++q) { const u32x4 w = kp[q];
                kf[q * 8 + 0] = __uint_as_float(w.x << 16); kf[q * 8 + 1] = __uint_as_float(w.x & 0xffff0000u); kf[q * 8 + 2] = __uint_as_float(w.y << 16); kf[q * 8 + 3] = __uint_as_float(w.y & 0xffff0000u);
                kf[q * 8 + 4] = __uint_as_float(w.z << 16); kf[q * 8 + 5] = __uint_as_float(w.z & 0xffff0000u); kf[q * 8 + 6] = __uint_as_float(w.w << 16); kf[q * 8 + 7] = __uint_as_float(w.w & 0xffff0000u); }
            float sh[4];
#pragma unroll
            for (int h = 0; h < 4; ++h) { float a = 0.f;
#pragma unroll
                for (int d4 = 0; d4 < 16; ++d4) { const f32x4 qv = *(const LAS f32x4*)(iqs + h * 64 + d4 * 4); a += qv[0] * kf[d4 * 4] + qv[1] * kf[d4 * 4 + 1] + qv[2] * kf[d4 * 4 + 2] + qv[3] * kf[d4 * 4 + 3]; }
                sh[h] = fmaxf(a, 0.f); }
            float score = sh[0] * w0 + sh[1] * w1 + sh[2] * w2 + sh[3] * w3;
            score += 0.0f;
            unsigned u = __float_as_uint(score); u = (u & 0x80000000u) ? ~u : (u | 0x80000000u);
            sc[key] = valid ? u : 0u;
        }
        unsigned prefix = 0; int need = 256;
#pragma unroll 1
        for (int pass = 3; pass >= 0; --pass) {
            const int shift = pass * 8;
#pragma unroll
            for (int j = 0; j < 4; ++j) hist[lane * 4 + j] = 0;
            for (int c0 = 0; c0 < nvp; c0 += 64) { const unsigned u = sc[c0 + lane];
                const bool match = (c0 + lane < nv) && (pass == 3 || (u >> (shift + 8)) == prefix);
                if (match) __hip_atomic_fetch_add(hist + ((u >> shift) & 255u), 1, __ATOMIC_RELAXED, __HIP_MEMORY_SCOPE_WORKGROUP); }
            int hb[4];
#pragma unroll
            for (int j = 0; j < 4; ++j) hb[j] = hist[lane * 4 + j];
            const int tot = hb[0] + hb[1] + hb[2] + hb[3];
            int suf = tot;
#pragma unroll
            for (int off = 1; off < 64; off <<= 1) { const int v = __shfl_down(suf, off); if (lane + off < 64) suf += v; }
            const int above = suf - tot;
            const bool is = (above < need) && (need <= suf);
            int bin = 0, nneed = 0;
            if (is) { int c = above;
#pragma unroll
                for (int k = 3; k >= 0; --k) { if (nneed == 0) { if (need <= c + hb[k]) { bin = lane * 4 + k; nneed = need - c; } else c += hb[k]; } } }
            const unsigned long long bal = __ballot(is);
            const int src = __ffsll((long long)bal) - 1;
            bin = __shfl(bin, src); nneed = __shfl(nneed, src);
            prefix = (prefix << 8) | (unsigned)bin; need = nneed;
        }
        const unsigned T = prefix;
        int base = 0, ties = 0;
        for (int c0 = 0; c0 < nvp; c0 += 64) { const int key = c0 + lane; const unsigned u = sc[key]; const bool valid = key < nv;
            const bool gt = valid && u > T, eq = valid && u == T;
            const unsigned long long beq = __ballot(eq);
            const int rank = ties + __popcll(beq & lt_mask);
            const bool take = gt || (eq && rank < need);
            const unsigned long long bt = __ballot(take);
            const int pos = base + __popcll(bt & lt_mask);
            if (take && pos < 256) out[pos] = (unsigned short)key;
            base += __popcll(bt); ties += __popcll(beq); }
    }
}

__device__ __forceinline__ void phase_attn(const Params& p, LAS unsigned char* lds, int bid, int nb) {
    const int tid = threadIdx.x, wid = tid >> 6, lane = tid & 63;
    unsigned char* ws = p.ws;
    const bf16_t* qr = (const bf16_t*)(ws + OFF_BUF64); const bf16_t* kr = (const bf16_t*)(ws + OFF_KR); const bf16_t* vv = (const bf16_t*)(ws + OFF_VV);
    const unsigned short* idx = (const unsigned short*)(ws + OFF_IDX);
    bf16_t* ao = (bf16_t*)(ws + OFF_PD);
    LAS float* qs = (LAS float*)lds + wid * 1024;
    LAS float* ps = (LAS float*)(lds + 32768) + wid * 2048;
    LAS int* ks = (LAS int*)(lds + 32768 + 65536) + wid * 256;
    for (int n = bid * 8 + wid; n < NTOK; n += nb * 8) {
        const int t = n & (SEQ - 1), b = n >> 12, cnt = (t + 1) < 256 ? (t + 1) : 256;
        asm volatile("" ::: "memory");
#pragma unroll
        for (int j = 0; j < 16; ++j) qs[j * 64 + lane] = bf2f(qr[(size_t)n * 1024 + j * 64 + lane]);
#pragma unroll
        for (int r = 0; r < 4; ++r) ks[r * 64 + lane] = idx[(size_t)n * 256 + r * 64 + lane];
#pragma unroll 1
        for (int r = 0; r < 4; ++r) {
            const int j = r * 64 + lane; const bool valid = j < cnt; const int key = valid ? ks[j] : 0;
            const u32x4* kp = (const u32x4*)(kr + ((size_t)b * SEQ + key) * 128);
            float kf[128];
#pragma unroll
            for (int q = 0; q < 16; ++q) { const u32x4 w = kp[q];
                kf[q * 8 + 0] = __uint_as_float(w.x << 16); kf[q * 8 + 1] = __uint_as_float(w.x & 0xffff0000u); kf[q * 8 + 2] = __uint_as_float(w.y << 16); kf[q * 8 + 3] = __uint_as_float(w.y & 0xffff0000u);
                kf[q * 8 + 4] = __uint_as_float(w.z << 16); kf[q * 8 + 5] = __uint_as_float(w.z & 0xffff0000u); kf[q * 8 + 6] = __uint_as_float(w.w << 16); kf[q * 8 + 7] = __uint_as_float(w.w & 0xffff0000u); }
#pragma unroll 1
            for (int h = 0; h < 8; ++h) { float a = 0.f;
#pragma unroll
                for (int d4 = 0; d4 < 32; ++d4) { const f32x4 qv = *(const LAS f32x4*)(qs + h * 128 + d4 * 4);
                    a += qv[0] * kf[d4 * 4] + qv[1] * kf[d4 * 4 + 1] + qv[2] * kf[d4 * 4 + 2] + qv[3] * kf[d4 * 4 + 3]; }
                ps[h * 256 + j] = valid ? a : -INFINITY; }
        }
#pragma unroll
        for (int h = 0; h < 8; ++h) { float x[4]; float m = -INFINITY;
#pragma unroll
            for (int r = 0; r < 4; ++r) { x[r] = ps[h * 256 + r * 64 + lane]; m = fmaxf(m, x[r]); }
#pragma unroll
            for (int o = 32; o > 0; o >>= 1) m = fmaxf(m, __shfl_xor(m, o));
            float s = 0.f;
#pragma unroll
            for (int r = 0; r < 4; ++r) { x[r] = expf(x[r] - m); s += x[r]; }
            s = wave_sum(s); const float inv = 1.0f / s;
#pragma unroll
            for (int r = 0; r < 4; ++r) ps[h * 256 + r * 64 + lane] = x[r] * inv; }
        float o0[8], o1[8];
#pragma unroll
        for (int h = 0; h < 8; ++h) { o0[h] = 0.f; o1[h] = 0.f; }
        for (int j = 0; j < cnt; ++j) { const int key = ks[j];
            const unsigned w = *(const unsigned*)(vv + ((size_t)b * SEQ + key) * 128 + 2 * lane);
            const float v0 = __uint_as_float(w << 16), v1 = __uint_as_float(w & 0xffff0000u);
#pragma unroll
            for (int h = 0; h < 8; ++h) { const float pj = ps[h * 256 + j]; o0[h] += pj * v0; o1[h] += pj * v1; } }
#pragma unroll
        for (int h = 0; h < 8; ++h) *(unsigned*)(ao + (size_t)n * 1024 + h * 128 + 2 * lane) = cvt_pk_bf16(o0[h], o1[h]);
    }
}

__device__ __forceinline__ void phase_inproj_even(const Params& p, LAS unsigned char* lds, int bid, int nb) {
    unsigned char* ws = p.ws;
    pg::DenseSched S; S.init(ws + OFF_BUF64, ws + OFF_WINE, NTOK, NE_MAIN, 1024, nb, bid);
    pg::EpiBf16 E; E.O = (bf16_t*)(ws + OFF_P); E.ldc = NE_MAIN;
    pg::gemm_phase(lds, 1024, S, E);
}
__device__ __forceinline__ void phase_inproj_odd(const Params& p, LAS unsigned char* lds, int bid, int nb) {
    unsigned char* ws = p.ws;
    pg::DenseSched S; S.init(ws + OFF_BUF64, ws + OFF_WINO, NTOK, NO_MAIN, 1024, nb, bid);
    pg::EpiBf16 E; E.O = (bf16_t*)(ws + OFF_PD); E.ldc = NO_MAIN;
    pg::gemm_phase(lds, 1024, S, E);
}
__device__ __forceinline__ void phase_outproj(const Params& p, LAS unsigned char* lds, int bid, int nb, size_t aoff, size_t woff, const float* X) {
    unsigned char* ws = p.ws;
    pg::DenseSched S; S.init(ws + aoff, ws + woff, NTOK, 1024, 1024, nb, bid);
    pg::EpiResid E; E.X = X; E.U = (float*)(ws + OFF_U);
    pg::gemm_phase(lds, 1024, S, E);
}

#define KDEF(name, body) __global__ __launch_bounds__(512, 2) void name(Params p, int layer) { extern __shared__ __attribute__((aligned(16))) unsigned char smem[]; LAS unsigned char* lds = (LAS unsigned char*)smem; const int bid = blockIdx.x, nb = gridDim.x; (void)lds; (void)layer; body }
KDEF(k_prep, phase_prep(p, lds, bid, nb);)
KDEF(k_inproj_e, phase_inproj_even(p, lds, bid, nb);)
KDEF(k_alpha, phase_gla_alpha(p, lds, bid, nb);)
KDEF(k_mixer_e, phase_mixer_even(p, lds, bid, nb);)
KDEF(k_outproj, phase_outproj(p, lds, bid, nb, layer ? OFF_PD : OFF_BUF64, layer ? OFF_WOUTO : OFF_WOUTE, layer ? p.out : p.in[I_X]);)
KDEF(k_inproj_o, phase_inproj_odd(p, lds, bid, nb);)
KDEF(k_rope, phase_rope(p, bid, nb);)
KDEF(k_index, phase_index(p, lds, bid, nb);)
KDEF(k_attn, phase_attn(p, lds, bid, nb);)
KDEF(k_resid, phase_resid_only(p, layer ? p.out : p.in[I_X], bid, nb);)
KDEF(k_lnroute, phase_ln_route(p, lds, bid, nb, layer);)
KDEF(k_gateup, phase_moe_gateup(p, lds, bid, nb, layer);)
KDEF(k_down, phase_moe_down(p, lds, bid, nb, layer);)
KDEF(k_ln2, phase_ln2(p, bid, nb, layer, p.out, true);)

constexpr int LDS_BYTES = 160 * 1024;

extern "C" void kernel_launch(void* const* d_in, const int* in_sizes, int n_in, void* d_out, int out_size, void* d_ws, size_t ws_size, hipStream_t stream) {
    if (ws_size < WS_NEED) { fprintf(stderr, "workspace too small: %zu < %zu\n", ws_size, (size_t)WS_NEED); return; }
    Params p{};
    for (int i = 0; i < 30; ++i) p.in[i] = (const float*)d_in[i];
    p.out = (float*)d_out; p.ws = (unsigned char*)d_ws;
    static bool attr = false;
    if (!attr) {
#define SA(k) (void)hipFuncSetAttribute((const void*)k, hipFuncAttributeMaxDynamicSharedMemorySize, LDS_BYTES)
        SA(k_prep); SA(k_inproj_e); SA(k_alpha); SA(k_mixer_e); SA(k_inproj_o); SA(k_rope); SA(k_index); SA(k_attn); SA(k_outproj); SA(k_resid); SA(k_lnroute); SA(k_gateup); SA(k_down); SA(k_ln2);
#undef SA
        attr = true;
    }
    const dim3 G(256), B(512);
#define L(k, layer) hipLaunchKernelGGL(k, G, B, LDS_BYTES, stream, p, layer)
    L(k_prep, 0);
    for (int layer = 0; layer < 2; ++layer) {
        if (layer == 0) { L(k_inproj_e, 0); L(k_alpha, 0); L(k_mixer_e, 0); L(k_outproj, 0); }
        else { L(k_inproj_o, 1); L(k_rope, 1); L(k_index, 1); L(k_attn, 1); L(k_outproj, 1); }
        L(k_lnroute, layer); L(k_gateup, layer); L(k_down, layer); L(k_ln2, layer);
    }
#undef L
}
```

```cpp
#include <hip/hip_runtime.h>
#include <hip/hip_cooperative_groups.h>
#include <cstdio>
#include <cstdint>
namespace cg = cooperative_groups;

constexpr int NTOK = 32768, SEQ = 4096, NB = 8, DM = 1024;
constexpr int EVEN_COLS = 3344, ODD_COLS = 1604;
constexpr int NE_MAIN = 3328;
constexpr int NO_MAIN = 1792;
constexpr int NEXP = 16, DEXP = 256;
constexpr float DN_ALPHA = 1.4142135623730951f;
constexpr float LN_EPS = 1e-5f;
constexpr int MOE_ROWS = 65536 + 16 * 256;

typedef unsigned short bf16_t;
typedef short bf16x8 __attribute__((ext_vector_type(8)));
typedef float f32x4 __attribute__((ext_vector_type(4)));
typedef float f32x2 __attribute__((ext_vector_type(2)));
typedef unsigned u32x4 __attribute__((ext_vector_type(4)));
typedef unsigned u32x2 __attribute__((ext_vector_type(2)));
#define LAS __attribute__((address_space(3)))

__device__ __forceinline__ unsigned cvt_pk_bf16(float lo, float hi) { unsigned r; asm volatile("v_cvt_pk_bf16_f32 %0, %1, %2" : "=v"(r) : "v"(lo), "v"(hi)); return r; }
__device__ __forceinline__ bf16_t f2bf(float f) { return (bf16_t)(cvt_pk_bf16(f, 0.f) & 0xffffu); }
__device__ __forceinline__ float bf2f(bf16_t h) { return __uint_as_float(((unsigned)h) << 16); }
__device__ __forceinline__ int opaque_tid() { int t = threadIdx.x; asm volatile("" : "+v"(t)); return t; }
__device__ __forceinline__ float wave_sum(float v) {
#pragma unroll
    for (int o = 32; o > 0; o >>= 1) v += __shfl_xor(v, o);
    return v;
}

constexpr size_t MiB = 1024ull * 1024ull;
constexpr size_t OFF_WINE = 0;
constexpr size_t OFF_WOUTE = OFF_WINE + (size_t)NE_MAIN * 1024 * 2;
constexpr size_t OFF_WINO = OFF_WOUTE + 2 * MiB;
constexpr size_t OFF_WOUTO = OFF_WINO + (size_t)NO_MAIN * 1024 * 2;
constexpr size_t OFF_WGU = OFF_WOUTO + 2 * MiB;
constexpr size_t OFF_WD = OFF_WGU + 32 * MiB;
constexpr size_t OFF_ROPE = OFF_WD + 16 * MiB;
constexpr size_t OFF_MISC = OFF_ROPE + 3 * MiB;
constexpr size_t OFF_BUF64 = OFF_MISC + 4 * MiB;
constexpr size_t OFF_P = OFF_BUF64 + 64 * MiB;
constexpr size_t OFF_U = OFF_P + 208 * MiB;
constexpr size_t WS_NEED = OFF_U + 128 * MiB;
constexpr size_t OFF_HE = OFF_P;
constexpr size_t OFF_ACT = OFF_HE + (size_t)MOE_ROWS * 1024 * 2;
constexpr size_t OFF_PD = OFF_P;
constexpr size_t OFF_KR = OFF_P + 112 * MiB;
constexpr size_t OFF_VV = OFF_KR + 8 * MiB;
constexpr size_t OFF_IQR = OFF_VV + 8 * MiB;
constexpr size_t OFF_IKR = OFF_IQR + 16 * MiB;
constexpr size_t OFF_IW = OFF_IKR + 4 * MiB;
constexpr size_t OFF_IDX = OFF_IW + 1 * MiB;
constexpr size_t MISC_CNT = 0;
constexpr size_t MISC_TOKINFO = 4096;
constexpr size_t MISC_TOKGATE = MISC_TOKINFO + (size_t)NTOK * 16;
constexpr size_t MISC_LIST = MISC_TOKGATE + (size_t)NTOK * 8;

struct Params {
    const float* in[30];
    float* out;
    unsigned char* ws;
};
enum { I_X = 0, I_WINE, I_AMU, I_AW0, I_AW2, I_AA0, I_AA2, I_AG2, I_AKK, I_AKA, I_ARK, I_AGNG, I_AGNB, I_BGW2, I_BGB, I_BNG, I_WOUTE,
       I_WINO, I_CIKG, I_CIKB, I_WOUTO, I_LN1G, I_LN1B, I_LN2G, I_LN2B, I_RW, I_RB, I_EG, I_EU, I_ED };

namespace pg {
constexpr int BM = 256, BK = 64, HALF = 128, HTB = HALF * BK * 2, STAGE_BYTES = 8 * HTB;
__host__ __device__ __forceinline__ int lds_byte(int r, int c) { const int st = (r >> 4) * 2 + (c >> 5), rr = r & 15, cc = c & 31, ob = rr * 64 + cc * 2; return st * 1024 + (ob ^ (((ob >> 9) & 1) << 5)); }
__host__ __device__ __forceinline__ void stage_rc(int b, int& R, int& C) { const int st = b / 1024, sb = b % 1024, swz = sb ^ (((sb >> 9) & 1) << 5); R = (st >> 1) * 16 + swz / 64; C = (st & 1) * 32 + (swz % 64) / 2; }
__host__ __device__ __forceinline__ int perm32(int rho) { const int n = rho >> 4, i = rho & 15; return 8 * (i >> 2) + 4 * n + (i & 3); }

struct Unit { int pm, pn, e, rt, cnt; };

template <class Epi, class Sched>
__device__ __forceinline__ void gemm_phase(LAS unsigned char* lds, const int K, const Sched& S, const Epi& E) {
    const int tid = opaque_tid(), wid = __builtin_amdgcn_readfirstlane(tid >> 6), lane = tid & 63, wr = wid >> 2, wc = wid & 3, fr = lane & 15, fq = lane >> 4;
    const int nt = K / BK;
    unsigned voffB[2];
#pragma unroll
    for (int i = 0; i < 2; ++i) { int R, C; stage_rc(tid * 16 + i * 8192, R, C); const int Rb = Epi::PERM ? ((R & ~31) + perm32(R & 31)) : R; voffB[i] = (unsigned)(Rb * K + C) * 2u; }
    const size_t kstep = (size_t)(BK * 2);
    const size_t hstepB = (size_t)HALF * K * 2;
    const unsigned ldsw = (unsigned)wid * 1024u;
    const int aoff = lds_byte(wr * 64 + fr, fq * 8), boff = lds_byte(wc * 32 + fr, fq * 8);
#define PG_SA(b, h) (((b) * 2 + (h)) * HTB)
#define PG_SB(b, h) ((4 + (b) * 2 + (h)) * HTB)
#define PG_STAGE(bufoff, gbase, voff) do { _Pragma("unroll") for (int _i = 0; _i < 2; ++_i) \
        __builtin_amdgcn_global_load_lds((const unsigned*)((const char*)(gbase) + (voff)[_i]), (LAS unsigned*)(lds + (bufoff) + ldsw + _i * 8192), 16, 0, 0); } while (0)
#define PG_LDA(dst, b, h) do { _Pragma("unroll") for (int m = 0; m < 4; ++m) _Pragma("unroll") for (int k = 0; k < 2; ++k) dst[m][k] = *(const LAS bf16x8*)(lds + PG_SA(b, h) + aoff + m * 2048 + k * 1024); } while (0)
#define PG_LDB(dst, b, h) do { _Pragma("unroll") for (int n = 0; n < 2; ++n) _Pragma("unroll") for (int k = 0; k < 2; ++k) dst[n][k] = *(const LAS bf16x8*)(lds + PG_SB(b, h) + boff + n * 2048 + k * 1024); } while (0)
#define PG_MMA(ai, bj, At, Bt) do { __builtin_amdgcn_s_setprio(1); _Pragma("unroll") for (int m = 0; m < 4; ++m) _Pragma("unroll") for (int n = 0; n < 2; ++n) _Pragma("unroll") for (int k = 0; k < 2; ++k) \
        acc[ai][bj][m][n] = __builtin_amdgcn_mfma_f32_16x16x32_bf16(Bt[n][k], At[m][k], acc[ai][bj][m][n], 0, 0, 0); __builtin_amdgcn_s_setprio(0); } while (0)
#define PG_WAIT_V(n) asm volatile("s_waitcnt vmcnt(" #n ")" ::: "memory")
#define PG_WAIT_L(n) asm volatile("s_waitcnt lgkmcnt(" #n ")" ::: "memory")
#define PG_BAR __builtin_amdgcn_s_barrier()
#define PG_SCHED __builtin_amdgcn_sched_barrier(0)
#define PG_AOFF(dst0, dst1, u) do { _Pragma("unroll") for (int _i = 0; _i < 2; ++_i) { int _R, _C; stage_rc(tid * 16 + _i * 8192, _R, _C); \
        dst0[_i] = S.a_rowoff(u, 0, _R) + (unsigned)_C * 2u; dst1[_i] = S.a_rowoff(u, 1, _R) + (unsigned)_C * 2u; } } while (0)
    Unit cur, nxt; int ui = 0;
    if (!S.next(0, cur)) return;
    f32x4 acc[2][2][4][2];
#pragma unroll
    for (int a = 0; a < 2; ++a)
#pragma unroll
        for (int b = 0; b < 2; ++b)
#pragma unroll
            for (int m = 0; m < 4; ++m)
#pragma unroll
                for (int n = 0; n < 2; ++n) acc[a][b][m][n] = (f32x4){0.f, 0.f, 0.f, 0.f};
    bf16x8 At[4][2], B0[2][2], B1[2][2];
    const char* const Ab = S.a_base();
    unsigned aC0[2], aC1[2];
    PG_AOFF(aC0, aC1, cur);
    const char* cB = S.b_ptr(cur);
    PG_STAGE(PG_SB(0, 0), cB, voffB); PG_STAGE(PG_SA(0, 0), Ab, aC0); PG_STAGE(PG_SB(0, 1), cB + hstepB, voffB); PG_STAGE(PG_SA(0, 1), Ab, aC1);
    if (wr == 1) PG_BAR;
    PG_WAIT_V(4); PG_BAR;
    PG_STAGE(PG_SB(1, 0), cB + kstep, voffB); PG_STAGE(PG_SA(1, 0), Ab + kstep, aC0); PG_STAGE(PG_SB(1, 1), cB + hstepB + kstep, voffB);
    PG_WAIT_V(6); PG_BAR;
    for (;;) {
        const bool has_next = S.next(ui + 1, nxt);
        const char* nB = has_next ? S.b_ptr(nxt) : cB;
#pragma unroll 1
        for (int t = 0; t < nt; t += 2) {
            const bool last = (t == nt - 2);
            const char* a1 = Ab + (size_t)(t + 1) * kstep;
            const char* a2 = last ? Ab : Ab + (size_t)(t + 2) * kstep; const char* b2 = last ? nB : cB + (size_t)(t + 2) * kstep;
            const char* a3 = a2 + kstep; const char* b3 = b2 + kstep;
            PG_LDB(B0, 0, 0); PG_SCHED; PG_LDA(At, 0, 0); PG_STAGE(PG_SA(1, 1), a1, aC1);
            if (last && has_next) PG_AOFF(aC0, aC1, nxt);
            PG_WAIT_L(8); PG_BAR; PG_WAIT_L(0); PG_MMA(0, 0, At, B0); PG_BAR; PG_SCHED;
            PG_LDB(B1, 0, 1); PG_STAGE(PG_SB(0, 0), b2, voffB);
            PG_BAR; PG_WAIT_L(0); PG_MMA(0, 1, At, B1); PG_BAR;
            PG_LDA(At, 0, 1); PG_STAGE(PG_SA(0, 0), a2, aC0);
            PG_BAR; PG_WAIT_L(0); PG_MMA(1, 0, At, B0); PG_BAR; PG_SCHED;
            PG_STAGE(PG_SB(0, 1), b2 + hstepB, voffB);
            PG_WAIT_V(6); PG_BAR; PG_MMA(1, 1, At, B1); PG_BAR;
            PG_LDB(B0, 1, 0); PG_SCHED; PG_LDA(At, 1, 0); PG_STAGE(PG_SA(0, 1), a2, aC1);
            PG_WAIT_L(8); PG_BAR; PG_WAIT_L(0); PG_MMA(0, 0, At, B0); PG_BAR; PG_SCHED;
            PG_LDB(B1, 1, 1); PG_STAGE(PG_SB(1, 0), b3, voffB);
            PG_BAR; PG_WAIT_L(0); PG_MMA(0, 1, At, B1); PG_BAR;
            PG_LDA(At, 1, 1); PG_STAGE(PG_SA(1, 0), a3, aC0);
            PG_BAR; PG_WAIT_L(0); PG_MMA(1, 0, At, B0); PG_BAR; PG_SCHED;
            PG_STAGE(PG_SB(1, 1), b3 + hstepB, voffB);
            PG_WAIT_V(6); PG_BAR; PG_MMA(1, 1, At, B1); PG_BAR;
        }
        E(acc, cur, wr, wc, fr, fq);
        if (!has_next) break;
#pragma unroll
        for (int a = 0; a < 2; ++a)
#pragma unroll
            for (int b = 0; b < 2; ++b)
#pragma unroll
                for (int m = 0; m < 4; ++m)
#pragma unroll
                    for (int n = 0; n < 2; ++n) acc[a][b][m][n] = (f32x4){0.f, 0.f, 0.f, 0.f};
        cur = nxt; cB = nB; ++ui;
    }
    PG_WAIT_V(0);
    if (wr == 0) PG_BAR;
    PG_BAR;
#undef PG_SA
#undef PG_SB
#undef PG_STAGE
#undef PG_LDA
#undef PG_LDB
#undef PG_MMA
#undef PG_WAIT_V
#undef PG_WAIT_L
#undef PG_BAR
#undef PG_SCHED
#undef PG_AOFF
}

struct DenseSched {
    const char* A; const char* Bt; int K, nM, nN, nwg, G, c;
    __device__ void init(const void* A_, const void* Bt_, int M, int N, int K_, int G_, int c_) { A = (const char*)A_; Bt = (const char*)Bt_; K = K_; nM = M / BM; nN = N / BM; nwg = nM * nN; G = G_; c = c_; }
    __device__ __forceinline__ bool next(int i, Unit& u) const {
        const long L = (long)i * G + c; if (L >= nwg) return false;
        int wgid = (int)L; { const int q = nwg / 8, r = nwg % 8, xcd = wgid % 8, off = wgid / 8; wgid = (xcd < r ? xcd * (q + 1) : r * (q + 1) + (xcd - r) * q) + off; }
        const int nig = 8 * nN, gid = wgid / nig, fm = gid * 8, gsz = (nM - fm) < 8 ? (nM - fm) : 8;
        u.pm = fm + ((wgid % nig) % gsz); u.pn = (wgid % nig) / gsz; u.e = 0; u.rt = 0; u.cnt = 0; return true;
    }
    __device__ __forceinline__ const char* a_base() const { return A; }
    __device__ __forceinline__ unsigned a_rowoff(const Unit& u, int half, int R) const { return (unsigned)(u.pm * BM + half * HALF + R) * (unsigned)(K * 2); }
    __device__ __forceinline__ const char* b_ptr(const Unit& u) const { return Bt + (size_t)u.pn * BM * K * 2; }
};

__device__ __forceinline__ void moe_build_units(LAS int* tab, const int* cntp, int NCT, int G, int c) {
    const int i = opaque_tid();
    if (i < 16) {
        const int L = i * G + c; int accu = 0, rtb = 0, found = 0, pm = 0, pn = 0, ee = 0, rt = 0, cn = 0;
        for (int e = 0; e < 16; ++e) { const int ce = cntp[e], nte = (ce + 255) >> 8, ue = nte * NCT;
            if (!found && L < accu + ue) { const int local = L - accu; ee = e; rt = local / NCT; pn = local % NCT; pm = rtb + rt; cn = ce; found = 1; }
            accu += ue; rtb += nte; }
        tab[i * 8 + 0] = found; tab[i * 8 + 1] = pm; tab[i * 8 + 2] = pn; tab[i * 8 + 3] = ee; tab[i * 8 + 4] = rt; tab[i * 8 + 5] = cn;
    }
    __syncthreads();
}
template <bool GATHER>
struct MoeSched {
    const char* A; const char* Bt; const int* list; int K; size_t wstride; LAS int* tab;
    __device__ void init(const void* A_, const void* Bt_, size_t wstride_bytes, const int* list_, int K_, LAS int* tab_) {
        A = (const char*)A_; Bt = (const char*)Bt_; wstride = wstride_bytes; list = list_; K = K_; tab = tab_; }
    __device__ __forceinline__ bool next(int i, Unit& u) const {
        if (i >= 16) return false;
        const int f = __builtin_amdgcn_readfirstlane(tab[i * 8 + 0]);
        u.pm = __builtin_amdgcn_readfirstlane(tab[i * 8 + 1]); u.pn = __builtin_amdgcn_readfirstlane(tab[i * 8 + 2]); u.e = __builtin_amdgcn_readfirstlane(tab[i * 8 + 3]);
        u.rt = __builtin_amdgcn_readfirstlane(tab[i * 8 + 4]); u.cnt = __builtin_amdgcn_readfirstlane(tab[i * 8 + 5]);
        return f != 0;
    }
    __device__ __forceinline__ const char* a_base() const { return A; }
    __device__ __forceinline__ unsigned a_rowoff(const Unit& u, int half, int R) const {
        if (GATHER) { const int slot = u.rt * BM + half * HALF + R; const int tok = slot < u.cnt ? list[u.e * NTOK + slot] : 0; return (unsigned)tok * (unsigned)(K * 2); }
        return (unsigned)(u.pm * BM + half * HALF + R) * (unsigned)(K * 2);
    }
    __device__ __forceinline__ const char* b_ptr(const Unit& u) const { return Bt + (size_t)u.e * wstride + (size_t)u.pn * BM * K * 2; }
};

struct EpiBf16 {
    static constexpr bool PERM = true;
    bf16_t* O; int ldc;
    __device__ __forceinline__ void operator()(const f32x4 (&acc)[2][2][4][2], const Unit& u, int wr, int wc, int fr, int fq) const {
        const int row0 = u.pm * BM + wr * 64 + fr, col0 = u.pn * BM + wc * 32 + 8 * fq;
#pragma unroll
        for (int ai = 0; ai < 2; ++ai)
#pragma unroll
            for (int m = 0; m < 4; ++m) { bf16_t* rowp = O + (size_t)(row0 + ai * HALF + m * 16) * ldc + col0;
#pragma unroll
                for (int bj = 0; bj < 2; ++bj) { const f32x4 v0 = acc[ai][bj][m][0], v1 = acc[ai][bj][m][1];
                    u32x4 w; w.x = cvt_pk_bf16(v0[0], v0[1]); w.y = cvt_pk_bf16(v0[2], v0[3]); w.z = cvt_pk_bf16(v1[0], v1[1]); w.w = cvt_pk_bf16(v1[2], v1[3]);
                    *(u32x4*)(rowp + bj * HALF) = w; } }
    }
};
struct EpiResid {
    static constexpr bool PERM = false;
    const float* X; float* U;
    __device__ __forceinline__ void operator()(const f32x4 (&acc)[2][2][4][2], const Unit& u, int wr, int wc, int fr, int fq) const {
        const int row0 = u.pm * BM + wr * 64 + fr, col0 = u.pn * BM + wc * 32 + 4 * fq;
#pragma unroll
        for (int ai = 0; ai < 2; ++ai)
#pragma unroll
            for (int m = 0; m < 4; ++m) { const size_t off = (size_t)(row0 + ai * HALF + m * 16) * DM + col0;
#pragma unroll
                for (int bj = 0; bj < 2; ++bj)
#pragma unroll
                    for (int n = 0; n < 2; ++n) { const f32x4 xv = *(const f32x4*)(X + off + bj * HALF + n * 16);
                        *(f32x4*)(U + off + bj * HALF + n * 16) = xv * DN_ALPHA + acc[ai][bj][m][n]; } }
    }
};
struct EpiSwiglu {
    static constexpr bool PERM = true;
    bf16_t* O;
    __device__ __forceinline__ void operator()(const f32x4 (&acc)[2][2][4][2], const Unit& u, int wr, int wc, int fr, int fq) const {
        const int row0 = u.pm * BM + wr * 64 + fr, col0 = u.pn * HALF + wc * 32 + 8 * fq;
#pragma unroll
        for (int ai = 0; ai < 2; ++ai)
#pragma unroll
            for (int m = 0; m < 4; ++m) { bf16_t* rowp = O + (size_t)(row0 + ai * HALF + m * 16) * DEXP + col0;
                float r[8];
#pragma unroll
                for (int n = 0; n < 2; ++n)
#pragma unroll
                    for (int j = 0; j < 4; ++j) { const float g = acc[ai][0][m][n][j], up = acc[ai][1][m][n][j]; r[n * 4 + j] = g / (1.0f + __expf(-g)) * up; }
                u32x4 w; w.x = cvt_pk_bf16(r[0], r[1]); w.y = cvt_pk_bf16(r[2], r[3]); w.z = cvt_pk_bf16(r[4], r[5]); w.w = cvt_pk_bf16(r[6], r[7]);
                *(u32x4*)rowp = w; }
    }
};
}

__device__ __forceinline__ void tr_tile(LAS float* tile  , const float* src, int ld, int k0, int c0, int ncols_valid, bf16_t* dst, int dstK, int drow0, int tid) {
    {
        const int r = tid >> 3, cc = (tid & 7) * 8;
        const float* sp = src + (size_t)(k0 + r) * ld + c0 + cc;
#pragma unroll
        for (int j = 0; j < 8; ++j) tile[r * 65 + cc + j] = (c0 + cc + j < ncols_valid) ? sp[j] : 0.f;
    }
    __syncthreads();
    {
        const int n = tid >> 3, kk = (tid & 7) * 8;
        u32x4 w;
        w.x = cvt_pk_bf16(tile[(kk + 0) * 65 + n], tile[(kk + 1) * 65 + n]); w.y = cvt_pk_bf16(tile[(kk + 2) * 65 + n], tile[(kk + 3) * 65 + n]);
        w.z = cvt_pk_bf16(tile[(kk + 4) * 65 + n], tile[(kk + 5) * 65 + n]); w.w = cvt_pk_bf16(tile[(kk + 6) * 65 + n], tile[(kk + 7) * 65 + n]);
        *(u32x4*)(dst + (size_t)(drow0 + n) * dstK + k0 + kk) = w;
    }
    __syncthreads();
}

__device__ __forceinline__ void phase_prep(const Params& p, LAS unsigned char* lds, int bid, int nb) {
    const int tid = opaque_tid();
    LAS float* tile = (LAS float*)lds;
    unsigned char* ws = p.ws;
    const int T0 = 832, T1 = T0 + 256, T2 = T1 + 448, T3 = T2 + 256, T4 = T3 + 2048, T5 = T4 + 2048, T6 = T5 + 2048;
    for (int t = bid; t < T6; t += nb) {
        if (t < T0) { const int kt = t / 52, ct = t % 52; tr_tile(tile, p.in[I_WINE], EVEN_COLS, kt * 64, ct * 64, EVEN_COLS, (bf16_t*)(ws + OFF_WINE), 1024, ct * 64, tid); }
        else if (t < T1) { const int q = t - T0, kt = q / 16, ct = q % 16; tr_tile(tile, p.in[I_WOUTE], 1024, kt * 64, ct * 64, 1024, (bf16_t*)(ws + OFF_WOUTE), 1024, ct * 64, tid); }
        else if (t < T2) { const int q = t - T1, kt = q / 28, ct = q % 28; tr_tile(tile, p.in[I_WINO], ODD_COLS, kt * 64, ct * 64, ODD_COLS, (bf16_t*)(ws + OFF_WINO), 1024, ct * 64, tid); }
        else if (t < T3) { const int q = t - T2, kt = q / 16, ct = q % 16; tr_tile(tile, p.in[I_WOUTO], 1024, kt * 64, ct * 64, 1024, (bf16_t*)(ws + OFF_WOUTO), 1024, ct * 64, tid); }
        else if (t < T5) { const bool up = t >= T4; const int q = t - (up ? T4 : T3), le = q / 64, r = q % 64, kt = r / 4, ct = r % 4;
            const int c0 = ct * 64, drow0 = (c0 / 128) * 256 + (up ? 128 : 0) + (c0 % 128);
            tr_tile(tile, p.in[up ? I_EU : I_EG] + (size_t)le * 1024 * 256, 256, kt * 64, c0, 256, (bf16_t*)(ws + OFF_WGU) + (size_t)le * 512 * 1024, 1024, drow0, tid); }
        else { const int q = t - T5, le = q / 64, r = q % 64, kt = r / 16, ct = r % 16;
            tr_tile(tile, p.in[I_ED] + (size_t)le * 256 * 1024, 1024, kt * 64, ct * 64, 1024, (bf16_t*)(ws + OFF_WD) + (size_t)le * 1024 * 256, 256, ct * 64, tid); }
    }
    {
        const float* x = p.in[I_X]; bf16_t* xb = (bf16_t*)(ws + OFF_BUF64);
        const size_t n8 = (size_t)NTOK * DM / 8;
        for (size_t i = (size_t)bid * 512 + tid; i < n8; i += (size_t)nb * 512) {
            const f32x4 a = *(const f32x4*)(x + i * 8), b = *(const f32x4*)(x + i * 8 + 4);
            u32x4 w; w.x = cvt_pk_bf16(a[0], a[1]); w.y = cvt_pk_bf16(a[2], a[3]); w.z = cvt_pk_bf16(b[0], b[1]); w.w = cvt_pk_bf16(b[2], b[3]);
            *(u32x4*)(xb + i * 8) = w;
        }
    }
    {
        float* c64 = (float*)(ws + OFF_ROPE); float* s64 = c64 + 4096 * 64; float* c32 = s64 + 4096 * 64; float* s32 = c32 + 4096 * 32;
        for (int i = bid * 512 + tid; i < 4096 * 64; i += nb * 512) { const int pos = i >> 6, j = i & 63; const float inv = powf(10000.0f, -(float)j / 64.0f); const float ang = (float)pos * inv; c64[i] = cosf(ang); s64[i] = sinf(ang); }
        for (int i = bid * 512 + tid; i < 4096 * 32; i += nb * 512) { const int pos = i >> 5, j = i & 31; const float inv = powf(10000.0f, -(float)j / 32.0f); const float ang = (float)pos * inv; c32[i] = cosf(ang); s32[i] = sinf(ang); }
    }
    if (bid == 0 && tid < 64) ((int*)(ws + OFF_MISC + MISC_CNT))[tid] = 0;
}

__device__ __forceinline__ void phase_ln_route(const Params& p, LAS unsigned char* lds, int bid, int nb, int layer) {
    const int tid = opaque_tid(), wid = tid >> 6, lane = tid & 63;
    unsigned char* ws = p.ws;
    LAS float* rwT = (LAS float*)lds;
    for (int i = tid; i < 16 * 1024; i += 512) { const int e = i >> 10, k = i & 1023; rwT[i] = p.in[I_RW][k * 16 + e]; }
    __syncthreads();
    float* U = (float*)(ws + OFF_U); bf16_t* hb = (bf16_t*)(ws + OFF_BUF64);
    const float* g = p.in[I_LN1G] + layer * DM; const float* b = p.in[I_LN1B] + layer * DM;
    int* cnt = (int*)(ws + OFF_MISC + MISC_CNT) + layer * 16;
    int* tokinfo = (int*)(ws + OFF_MISC + MISC_TOKINFO); float* tokgate = (float*)(ws + OFF_MISC + MISC_TOKGATE); int* list = (int*)(ws + OFF_MISC + MISC_LIST);
    f32x4 gv[4], bv[4];
#pragma unroll
    for (int j = 0; j < 4; ++j) { gv[j] = *(const f32x4*)(g + j * 256 + lane * 4); bv[j] = *(const f32x4*)(b + j * 256 + lane * 4); }
    float rbias[16];
#pragma unroll
    for (int e = 0; e < 16; ++e) rbias[e] = p.in[I_RB][e];
    for (int tok = bid * 8 + wid; tok < NTOK; tok += nb * 8) {
        f32x4 v[4]; float s = 0.f;
#pragma unroll
        for (int j = 0; j < 4; ++j) { v[j] = *(const f32x4*)(U + (size_t)tok * DM + j * 256 + lane * 4); s += (v[j][0] + v[j][1]) + (v[j][2] + v[j][3]); }
        const float mean = wave_sum(s) * (1.0f / DM);
        float q = 0.f;
#pragma unroll
        for (int j = 0; j < 4; ++j) { v[j] -= mean; q += (v[j][0] * v[j][0] + v[j][1] * v[j][1]) + (v[j][2] * v[j][2] + v[j][3] * v[j][3]); }
        const float rstd = rsqrtf(wave_sum(q) * (1.0f / DM) + LN_EPS);
#pragma unroll
        for (int j = 0; j < 4; ++j) { v[j] = v[j] * rstd * gv[j] + bv[j];
            *(f32x4*)(U + (size_t)tok * DM + j * 256 + lane * 4) = v[j];
            u32x2 w; w.x = cvt_pk_bf16(v[j][0], v[j][1]); w.y = cvt_pk_bf16(v[j][2], v[j][3]);
            *(u32x2*)(hb + (size_t)tok * DM + j * 256 + lane * 4) = w; }
        float lg[16];
        asm volatile("" ::: "memory");
#pragma unroll
        for (int e = 0; e < 16; ++e) { float a = 0.f;
#pragma unroll
            for (int j = 0; j < 4; ++j) { const f32x4 w = *(const LAS f32x4*)(rwT + e * 1024 + j * 256 + lane * 4); a += (v[j][0] * w[0] + v[j][1] * w[1]) + (v[j][2] * w[2] + v[j][3] * w[3]); }
            lg[e] = wave_sum(a); }
        float sg[16], sel[16];
#pragma unroll
        for (int e = 0; e < 16; ++e) { sg[e] = 1.0f / (1.0f + expf(-lg[e])); sel[e] = sg[e] + rbias[e]; }
        int best = 0; float bestv = -INFINITY;
#pragma unroll
        for (int gI = 0; gI < 4; ++gI) { float m1 = -INFINITY, m2 = -INFINITY;
#pragma unroll
            for (int j = 0; j < 4; ++j) { const float x = sel[gI * 4 + j]; if (x > m1) { m2 = m1; m1 = x; } else if (x > m2) m2 = x; }
            const float gs = m1 + m2; if (gs > bestv) { bestv = gs; best = gI; } }
        int e0 = 0, e1 = 0; float v0 = -INFINITY, v1 = -INFINITY, s0 = 0.f, s1 = 0.f;
#pragma unroll
        for (int e = 0; e < 16; ++e) { if ((e >> 2) == best) { const float x = sel[e];
                if (x > v0) { v1 = v0; e1 = e0; s1 = s0; v0 = x; e0 = e; s0 = sg[e]; } else if (x > v1) { v1 = x; e1 = e; s1 = sg[e]; } } }
        const float gsum = s0 + s1; const float g0 = s0 / gsum, g1 = s1 / gsum;
        if (lane == 0) {
            const int sl0 = atomicAdd(cnt + e0, 1), sl1 = atomicAdd(cnt + e1, 1);
            list[e0 * NTOK + sl0] = tok; list[e1 * NTOK + sl1] = tok;
            tokinfo[tok * 4 + 0] = e0; tokinfo[tok * 4 + 1] = sl0; tokinfo[tok * 4 + 2] = e1; tokinfo[tok * 4 + 3] = sl1;
            tokgate[tok * 2 + 0] = g0; tokgate[tok * 2 + 1] = g1;
        }
    }
}

__device__ __forceinline__ void phase_ln2(const Params& p, int bid, int nb, int layer, float* dst, bool with_moe) {
    const int tid = opaque_tid(), wid = tid >> 6, lane = tid & 63;
    unsigned char* ws = p.ws;
    const float* U = (const float*)(ws + OFF_U); bf16_t* xb = (bf16_t*)(ws + OFF_BUF64);
    const bf16_t* he = (const bf16_t*)(ws + OFF_HE);
    const float* g = p.in[I_LN2G] + layer * DM; const float* b = p.in[I_LN2B] + layer * DM;
    const int* cnt = (const int*)(ws + OFF_MISC + MISC_CNT) + layer * 16;
    const int* tokinfo = (const int*)(ws + OFF_MISC + MISC_TOKINFO); const float* tokgate = (const float*)(ws + OFF_MISC + MISC_TOKGATE);
    int rowbase[16]; { int a = 0;
#pragma unroll
        for (int e = 0; e < 16; ++e) { rowbase[e] = a; a += ((cnt[e] + 255) >> 8) << 8; } }
    f32x4 gv[4], bv[4];
#pragma unroll
    for (int j = 0; j < 4; ++j) { gv[j] = *(const f32x4*)(g + j * 256 + lane * 4); bv[j] = *(const f32x4*)(b + j * 256 + lane * 4); }
    for (int tok = bid * 8 + wid; tok < NTOK; tok += nb * 8) {
        f32x4 v[4]; float s = 0.f;
        int r0 = 0, r1 = 0; float g0 = 0.f, g1 = 0.f;
        if (with_moe) { const int e0 = tokinfo[tok * 4 + 0], sl0 = tokinfo[tok * 4 + 1], e1 = tokinfo[tok * 4 + 2], sl1 = tokinfo[tok * 4 + 3];
            int rb0 = 0, rb1 = 0;
#pragma unroll
            for (int e = 0; e < 16; ++e) { if (e == e0) rb0 = rowbase[e]; if (e == e1) rb1 = rowbase[e]; }
            r0 = rb0 + sl0; r1 = rb1 + sl1; g0 = tokgate[tok * 2 + 0]; g1 = tokgate[tok * 2 + 1]; }
#pragma unroll
        for (int j = 0; j < 4; ++j) { v[j] = *(const f32x4*)(U + (size_t)tok * DM + j * 256 + lane * 4) * DN_ALPHA;
            if (with_moe) { const u32x2 a = *(const u32x2*)(he + (size_t)r0 * DM + j * 256 + lane * 4), c = *(const u32x2*)(he + (size_t)r1 * DM + j * 256 + lane * 4);
                v[j][0] += g0 * __uint_as_float(a.x << 16) + g1 * __uint_as_float(c.x << 16); v[j][1] += g0 * __uint_as_float(a.x & 0xffff0000u) + g1 * __uint_as_float(c.x & 0xffff0000u);
                v[j][2] += g0 * __uint_as_float(a.y << 16) + g1 * __uint_as_float(c.y << 16); v[j][3] += g0 * __uint_as_float(a.y & 0xffff0000u) + g1 * __uint_as_float(c.y & 0xffff0000u); }
            s += (v[j][0] + v[j][1]) + (v[j][2] + v[j][3]); }
        const float mean = wave_sum(s) * (1.0f / DM);
        float q = 0.f;
#pragma unroll
        for (int j = 0; j < 4; ++j) { v[j] -= mean; q += (v[j][0] * v[j][0] + v[j][1] * v[j][1]) + (v[j][2] * v[j][2] + v[j][3] * v[j][3]); }
        const float rstd = rsqrtf(wave_sum(q) * (1.0f / DM) + LN_EPS);
#pragma unroll
        for (int j = 0; j < 4; ++j) { v[j] = v[j] * rstd * gv[j] + bv[j];
            *(f32x4*)(dst + (size_t)tok * DM + j * 256 + lane * 4) = v[j];
            u32x2 w; w.x = cvt_pk_bf16(v[j][0], v[j][1]); w.y = cvt_pk_bf16(v[j][2], v[j][3]);
            *(u32x2*)(xb + (size_t)tok * DM + j * 256 + lane * 4) = w; }
    }
}

__device__ __forceinline__ void phase_resid_only(const Params& p, const float* X, int bid, int nb) {
    float* U = (float*)(p.ws + OFF_U);
    const size_t n4 = (size_t)NTOK * DM / 4;
    for (size_t i = (size_t)bid * 512 + threadIdx.x; i < n4; i += (size_t)nb * 512) *(f32x4*)(U + i * 4) = *(const f32x4*)(X + i * 4) * DN_ALPHA;
}

__device__ __forceinline__ void phase_moe_gateup(const Params& p, LAS unsigned char* lds, int bid, int nb, int layer) {
    unsigned char* ws = p.ws;
    LAS int* tab = (LAS int*)(lds + pg::STAGE_BYTES);
    pg::moe_build_units(tab, (const int*)(ws + OFF_MISC + MISC_CNT) + layer * 16, 2, nb, bid);
    pg::MoeSched<true> S; S.init(ws + OFF_BUF64, ws + OFF_WGU + (size_t)layer * 16 * 512 * 1024 * 2, (size_t)512 * 1024 * 2, (const int*)(ws + OFF_MISC + MISC_LIST), 1024, tab);
    pg::EpiSwiglu E; E.O = (bf16_t*)(ws + OFF_ACT);
    pg::gemm_phase(lds, 1024, S, E);
}
__device__ __forceinline__ void phase_moe_down(const Params& p, LAS unsigned char* lds, int bid, int nb, int layer) {
    unsigned char* ws = p.ws;
    LAS int* tab = (LAS int*)(lds + pg::STAGE_BYTES);
    pg::moe_build_units(tab, (const int*)(ws + OFF_MISC + MISC_CNT) + layer * 16, 4, nb, bid);
    pg::MoeSched<false> S; S.init(ws + OFF_ACT, ws + OFF_WD + (size_t)layer * 16 * 1024 * 256 * 2, (size_t)1024 * 256 * 2, nullptr, 256, tab);
    pg::EpiBf16 E; E.O = (bf16_t*)(ws + OFF_HE); E.ldc = 1024;
    pg::gemm_phase(lds, 256, S, E);
}

__device__ __forceinline__ void phase_gla_alpha(const Params& p, LAS unsigned char* lds, int bid, int nb) {
    const int tid = opaque_tid(), wid = tid >> 6, lane = tid & 63;
    LAS float* wT = (LAS float*)lds;
    for (int i = tid; i < 16 * 1024; i += 512) { const int e = i & 15, k = i >> 4; wT[e * 1024 + k] = p.in[I_WINE][(size_t)k * EVEN_COLS + NE_MAIN + e]; }
    __syncthreads();
    const float* x = p.in[I_X]; float* xa = (float*)(p.ws + OFF_U);
    for (int tok = bid * 8 + wid; tok < NTOK; tok += nb * 8) {
        f32x4 v[4];
        asm volatile("" ::: "memory");
#pragma unroll
        for (int j = 0; j < 4; ++j) v[j] = *(const f32x4*)(x + (size_t)tok * DM + j * 256 + lane * 4);
        float mine = 0.f;
#pragma unroll
        for (int e = 0; e < 16; ++e) { float a = 0.f;
#pragma unroll
            for (int j = 0; j < 4; ++j) { const f32x4 w = *(const LAS f32x4*)(wT + e * 1024 + j * 256 + lane * 4); a += (v[j][0] * w[0] + v[j][1] * w[1]) + (v[j][2] * w[2] + v[j][3] * w[3]); }
            a = wave_sum(a); if (lane == e) mine = a; }
        if (lane < 16) xa[(size_t)tok * 16 + lane] = mine;
    }
    __syncthreads();
}

template <int CTRL> __device__ __forceinline__ float dppf(float v) { return __builtin_bit_cast(float, __builtin_amdgcn_update_dpp(0, __builtin_bit_cast(int, v), CTRL, 0xf, 0xf, true)); }
__device__ __forceinline__ float red8(float v) { v += dppf<0xB1>(v); v += dppf<0x4E>(v); v += dppf<0x141>(v); return v; }

__device__ __forceinline__ void rwkv_item(const Params& p, LAS unsigned char* lds, int item) {
    constexpr int TC = 16;
    const int tid = opaque_tid(), lane = tid & 63, tg = tid >> 6;
    const int b = item >> 3, h = item & 7;
    const bf16_t* P0 = (const bf16_t*)(p.ws + OFF_P);
    bf16_t* mix = (bf16_t*)(p.ws + OFF_BUF64);
    LAS float* w2s = (LAS float*)lds;
    LAS float* a2s = w2s + 64 * 64;
    LAS float* g2s = a2s + 64 * 64;
    LAS float* tw = g2s + 128 * 64;
    LAS float* xa_s = tw + TC * 64;
    LAS float* sg = xa_s + TC * 64;
    LAS float* r_s = sg + TC * 128;
    LAS float* k_s = r_s + TC * 64;
    LAS float* v_s = k_s + TC * 64;
    LAS float* w_s = v_s + TC * 64;
    LAS float* kk_s = w_s + TC * 64;
    LAS float* kka_s = kk_s + TC * 64;
    LAS float* kh_s = kka_s + TC * 64;
    LAS float* g_s = kh_s + TC * 64;
    LAS float* y_s = g_s + TC * 64;
    LAS float* rk_s = y_s + TC * 64;
    const float* mu = p.in[I_AMU];
    for (int i = tid; i < 64 * 64; i += 512) { const int r = i >> 6, c = i & 63; w2s[i] = p.in[I_AW2][r * 512 + h * 64 + c]; a2s[i] = p.in[I_AA2][r * 512 + h * 64 + c]; }
    for (int i = tid; i < 128 * 64; i += 512) { const int r = i >> 6, c = i & 63; g2s[i] = p.in[I_AG2][r * 512 + h * 64 + c]; }
    const int j = lane;
    const float w0 = p.in[I_AW0][h * 64 + j], a0 = p.in[I_AA0][h * 64 + j], kksc = p.in[I_AKK][h * 64 + j], kasc = p.in[I_AKA][h * 64 + j], rkj = p.in[I_ARK][h * 64 + j];
    const float gng = p.in[I_AGNG][h * 64 + j], gnb = p.in[I_AGNB][h * 64 + j];
    float S[8];
#pragma unroll
    for (int i = 0; i < 8; ++i) S[i] = 0.f;
    const int row = tid >> 3, kq = tid & 7;
    __syncthreads();
    for (int t0 = 0; t0 < SEQ; t0 += TC) {
        for (int idx = tid; idx < TC * 448; idx += 512) {
            const int t = idx / 448, c = idx % 448; int col; LAS float* dst; int kind = 0;
            if (c < 64) { col = h * 64 + c; dst = r_s + t * 64 + c; }
            else if (c < 128) { col = 512 + h * 64 + (c - 64); dst = k_s + t * 64 + (c - 64); }
            else if (c < 192) { col = 1024 + h * 64 + (c - 128); dst = v_s + t * 64 + (c - 128); }
            else if (c < 256) { col = 1536 + (c - 192); dst = tw + t * 64 + (c - 192); kind = 1; }
            else if (c < 320) { col = 1600 + (c - 256); dst = xa_s + t * 64 + (c - 256); }
            else { col = 1664 + (c - 320); dst = sg + t * 128 + (c - 320); kind = 2; }
            const size_t n = (size_t)b * SEQ + t0 + t;
            const float cur = bf2f(P0[n * NE_MAIN + col]);
            const float prev = (t0 + t) > 0 ? bf2f(P0[(n - 1) * NE_MAIN + col]) : 0.f;
            float val = cur + (prev - cur) * mu[col];
            if (kind == 1) val = tanhf(val); else if (kind == 2) val = 1.0f / (1.0f + expf(-val));
            *dst = val;
        }
        __syncthreads();
#pragma unroll
        for (int tt = 0; tt < 2; ++tt) {
            const int t = tg + tt * 8;
            float aw = 0.f, aa = 0.f, ag = 0.f;
            asm volatile("" ::: "memory");
#pragma unroll 4
            for (int i = 0; i < 64; ++i) { aw += tw[t * 64 + i] * w2s[i * 64 + j]; aa += xa_s[t * 64 + i] * a2s[i * 64 + j]; }
            asm volatile("" ::: "memory");
#pragma unroll 4
            for (int i = 0; i < 128; ++i) ag += sg[t * 128 + i] * g2s[i * 64 + j];
            asm volatile("" ::: "memory");
            const float z = w0 + aw;
            const float sp = (-z > 20.f) ? -z : log1pf(expf(-z));
            const float wlog = -sp - 0.5f;
            const float decay = expf(-expf(wlog));
            const float a = 1.0f / (1.0f + expf(-(a0 + aa)));
            const float kraw = k_s[t * 64 + j];
            const float kkp = kraw * kksc;
            const float nrm = sqrtf(wave_sum(kkp * kkp));
            const float kk = kkp / fmaxf(nrm, 1e-12f);
            const float kh = kraw * (1.0f + (a - 1.0f) * kasc);
            const float rr = r_s[t * 64 + j];
            const float rk = wave_sum(rr * kh * rkj);
            w_s[t * 64 + j] = decay; kk_s[t * 64 + j] = kk; kka_s[t * 64 + j] = kk * a; kh_s[t * 64 + j] = kh; g_s[t * 64 + j] = ag;
            if (j == 0) rk_s[t] = rk;
        }
        __syncthreads();
        for (int t = 0; t < TC; ++t) {
            const f32x4 kk0 = *(const LAS f32x4*)(kk_s + t * 64 + kq * 8), kk1 = *(const LAS f32x4*)(kk_s + t * 64 + kq * 8 + 4);
            const f32x4 ww0 = *(const LAS f32x4*)(w_s + t * 64 + kq * 8), ww1 = *(const LAS f32x4*)(w_s + t * 64 + kq * 8 + 4);
            const f32x4 ka0 = *(const LAS f32x4*)(kka_s + t * 64 + kq * 8), ka1 = *(const LAS f32x4*)(kka_s + t * 64 + kq * 8 + 4);
            const f32x4 kh0 = *(const LAS f32x4*)(kh_s + t * 64 + kq * 8), kh1 = *(const LAS f32x4*)(kh_s + t * 64 + kq * 8 + 4);
            const f32x4 rr0 = *(const LAS f32x4*)(r_s + t * 64 + kq * 8), rr1 = *(const LAS f32x4*)(r_s + t * 64 + kq * 8 + 4);
            const float vv = v_s[t * 64 + row];
            float sa = 0.f;
#pragma unroll
            for (int i = 0; i < 4; ++i) { sa += S[i] * kk0[i]; sa += S[4 + i] * kk1[i]; }
            sa = red8(sa);
            float y = 0.f;
#pragma unroll
            for (int i = 0; i < 4; ++i) {
                S[i] = S[i] * ww0[i] - sa * ka0[i] + vv * kh0[i]; S[4 + i] = S[4 + i] * ww1[i] - sa * ka1[i] + vv * kh1[i];
                y += S[i] * rr0[i]; y += S[4 + i] * rr1[i]; }
            y = red8(y);
            if (kq == 0) y_s[t * 64 + row] = y;
        }
        __syncthreads();
#pragma unroll
        for (int tt = 0; tt < 2; ++tt) {
            const int t = tg + tt * 8;
            const float y = y_s[t * 64 + j];
            const float mean = wave_sum(y) * (1.0f / 64.0f);
            const float d = y - mean;
            const float var = wave_sum(d * d) * (1.0f / 64.0f);
            const float yn = d * rsqrtf(var + 64e-5f) * gng + gnb;
            const float o = (yn + rk_s[t] * v_s[t * 64 + j]) * g_s[t * 64 + j];
            mix[((size_t)b * SEQ + t0 + t) * DM + h * 64 + j] = f2bf(o);
        }
        __syncthreads();
    }
}

__device__ __forceinline__ void gla_item(const Params& p, LAS unsigned char* lds, int item) {
    const int tid = opaque_tid(), lane = tid & 63, tg = tid >> 6;
    const int b = item >> 2, h = item & 3;
    const bf16_t* P0 = (const bf16_t*)(p.ws + OFF_P) + 1792;
    const float* xa16 = (const float*)(p.ws + OFF_U);
    bf16_t* mix = (bf16_t*)(p.ws + OFF_BUF64);
    LAS float* qd = (LAS float*)lds;
    LAS float* ki = qd + 64 * 65;
    LAS float* att = ki + 64 * 65;
    LAS float* vs = att + 64 * 65;
    LAS float* St = vs + 64 * 128;
    LAS float* bl = St + 64 * 128;
    for (int i = tid; i < 64 * 128; i += 512) St[i] = 0.f;
    float gw2[16];
#pragma unroll
    for (int i = 0; i < 16; ++i) gw2[i] = p.in[I_BGW2][i * 256 + h * 64 + lane];
    const float gb = p.in[I_BGB][h * 64 + lane];
    __syncthreads();
    for (int c0 = 0; c0 < SEQ; c0 += 64) {
        const size_t n0 = (size_t)b * SEQ + c0;
        for (int tt = 0; tt < 8; ++tt) { const int c = tg * 8 + tt; float z = gb;
#pragma unroll
            for (int i = 0; i < 16; ++i) z += xa16[(n0 + c) * 16 + i] * gw2[i];
            const float ls = (z >= 0.f) ? -log1pf(expf(-z)) : (z - log1pf(expf(z)));
            att[c * 65 + lane] = ls * (1.0f / 16.0f); }
        for (int i = tid; i < 64 * 128; i += 512) { const int c = i >> 7, e = i & 127; vs[i] = bf2f(P0[(n0 + c) * NE_MAIN + 512 + h * 128 + e]); }
        __syncthreads();
        if (tid < 64) { float a = 0.f; for (int c = 0; c < 64; ++c) { a += att[c * 65 + tid]; att[c * 65 + tid] = a; } bl[tid] = a; }
        __syncthreads();
        for (int i = tid; i < 64 * 64; i += 512) { const int c = i >> 6, d = i & 63; const float bc = att[c * 65 + d];
            const float q = bf2f(P0[(n0 + c) * NE_MAIN + h * 64 + d]), k = bf2f(P0[(n0 + c) * NE_MAIN + 256 + h * 64 + d]);
            qd[c * 65 + d] = q * 0.125f * expf(bc); ki[c * 65 + d] = k * expf(-bc); }
        __syncthreads();
        { const int c = tid >> 3, sgp = tid & 7; float a[8];
#pragma unroll
            for (int i = 0; i < 8; ++i) a[i] = 0.f;
            for (int d = 0; d < 64; ++d) { const float qv = qd[c * 65 + d];
#pragma unroll
                for (int i = 0; i < 8; ++i) a[i] += qv * ki[(sgp * 8 + i) * 65 + d]; }
            __syncthreads();
#pragma unroll
            for (int i = 0; i < 8; ++i) att[c * 65 + sgp * 8 + i] = (sgp * 8 + i <= c) ? a[i] : 0.f; }
        __syncthreads();
        { const int c = tid >> 3, eg = tid & 7; float o[16];
#pragma unroll
            for (int i = 0; i < 16; ++i) o[i] = 0.f;
            for (int s = 0; s <= c; ++s) { const float a = att[c * 65 + s];
#pragma unroll
                for (int i = 0; i < 16; ++i) o[i] += a * vs[s * 128 + eg * 16 + i]; }
            for (int d = 0; d < 64; ++d) { const float qv = qd[c * 65 + d];
#pragma unroll
                for (int i = 0; i < 16; ++i) o[i] += qv * St[d * 128 + eg * 16 + i]; }
            float ss = 0.f;
#pragma unroll
            for (int i = 0; i < 16; ++i) ss += o[i] * o[i];
            ss = red8(ss);
            const float rs = rsqrtf(ss * (1.0f / 128.0f) + 1e-5f);
#pragma unroll
            for (int i = 0; i < 16; ++i) { const int e = eg * 16 + i; const float g = bf2f(P0[(n0 + c) * NE_MAIN + 1024 + h * 128 + e]);
                const float val = o[i] * rs * p.in[I_BNG][h * 128 + e] * (g / (1.0f + expf(-g)));
                mix[(n0 + c) * DM + 512 + h * 128 + e] = f2bf(val); } }
        __syncthreads();
        { const int d = tid >> 3, eg = tid & 7; float a[16];
#pragma unroll
            for (int i = 0; i < 16; ++i) a[i] = St[d * 128 + eg * 16 + i];
            for (int c = 0; c < 64; ++c) { const float kv = ki[c * 65 + d];
#pragma unroll
                for (int i = 0; i < 16; ++i) a[i] += kv * vs[c * 128 + eg * 16 + i]; }
            const float eb = expf(bl[d]);
#pragma unroll
            for (int i = 0; i < 16; ++i) St[d * 128 + eg * 16 + i] = a[i] * eb; }
        __syncthreads();
    }
}

__device__ __forceinline__ void phase_mixer_even(const Params& p, LAS unsigned char* lds, int bid, int nb) {
    for (int item = bid; item < 96; item += nb) {
        if (item < 64) rwkv_item(p, lds, item); else gla_item(p, lds, item - 64);
        __syncthreads();
    }
}

__device__ __forceinline__ void phase_rope(const Params& p, int bid, int nb) {
    const int tid = opaque_tid(), wid = tid >> 6, lane = tid & 63;
    unsigned char* ws = p.ws;
    const bf16_t* Pd = (const bf16_t*)(ws + OFF_PD);
    bf16_t* qr = (bf16_t*)(ws + OFF_BUF64); bf16_t* kr = (bf16_t*)(ws + OFF_KR); bf16_t* vv = (bf16_t*)(ws + OFF_VV);
    bf16_t* iqr = (bf16_t*)(ws + OFF_IQR); bf16_t* ikr = (bf16_t*)(ws + OFF_IKR); float* iw = (float*)(ws + OFF_IW);
    const float* c64 = (const float*)(ws + OFF_ROPE); const float* s64 = c64 + 4096 * 64; const float* c32 = s64 + 4096 * 64; const float* s32 = c32 + 4096 * 32;
    const float ikg = p.in[I_CIKG][lane], ikb = p.in[I_CIKB][lane];
    for (int n = bid * 8 + wid; n < NTOK; n += nb * 8) {
        const int pos = n & (SEQ - 1);
        const bf16_t* row = Pd + (size_t)n * NO_MAIN;
        const float c = c64[pos * 64 + lane], s = s64[pos * 64 + lane];
#pragma unroll
        for (int h = 0; h < 8; ++h) { const float z1 = bf2f(row[h * 128 + lane]), z2 = bf2f(row[h * 128 + 64 + lane]);
            qr[(size_t)n * 1024 + h * 128 + lane] = f2bf((z1 * c - z2 * s) * 0.08838834764831845f);
            qr[(size_t)n * 1024 + h * 128 + 64 + lane] = f2bf((z2 * c + z1 * s) * 0.08838834764831845f); }
        { const float z1 = bf2f(row[1024 + lane]), z2 = bf2f(row[1024 + 64 + lane]);
            kr[(size_t)n * 128 + lane] = f2bf(z1 * c - z2 * s); kr[(size_t)n * 128 + 64 + lane] = f2bf(z2 * c + z1 * s); }
        vv[(size_t)n * 128 + lane] = row[1152 + lane]; vv[(size_t)n * 128 + 64 + lane] = row[1152 + 64 + lane];
        const int j32 = lane & 31; const float cc = c32[pos * 32 + j32], ss = s32[pos * 32 + j32];
#pragma unroll
        for (int r = 0; r < 2; ++r) { const int h = (lane >> 5) + 2 * r; const float z1 = bf2f(row[1280 + h * 64 + j32]), z2 = bf2f(row[1280 + h * 64 + 32 + j32]);
            iqr[(size_t)n * 256 + h * 64 + j32] = f2bf((z1 * cc - z2 * ss) * 0.125f); iqr[(size_t)n * 256 + h * 64 + 32 + j32] = f2bf((z2 * cc + z1 * ss) * 0.125f); }
        { const float x = bf2f(row[1536 + lane]); const float mean = wave_sum(x) * (1.0f / 64.0f); const float d = x - mean; const float var = wave_sum(d * d) * (1.0f / 64.0f);
            const float y = d * rsqrtf(var + LN_EPS) * ikg + ikb; const float o = __shfl_xor(y, 32);
            const float res = lane < 32 ? (y * cc - o * ss) : (y * cc + o * ss);
            ikr[(size_t)n * 64 + lane] = f2bf(res); }
        if (lane < 4) iw[(size_t)n * 4 + lane] = bf2f(row[1600 + lane]) * 0.5f;
    }
}

__device__ __forceinline__ void phase_index(const Params& p, LAS unsigned char* lds, int bid, int nb) {
    const int tid = opaque_tid(), wid = tid >> 6, lane = tid & 63;
    unsigned char* ws = p.ws;
    const bf16_t* iqr = (const bf16_t*)(ws + OFF_IQR); const bf16_t* ikr = (const bf16_t*)(ws + OFF_IKR); const float* iw = (const float*)(ws + OFF_IW);
    unsigned short* idx = (unsigned short*)(ws + OFF_IDX);
    LAS unsigned* sc = (LAS unsigned*)lds + wid * 4096;
    LAS int* hist = (LAS int*)(lds + 131072) + wid * 256;
    LAS float* iqs = (LAS float*)(lds + 131072 + 8192) + wid * 256;
    const unsigned long long lt_mask = (1ull << lane) - 1ull;
    for (int n = bid * 8 + wid; n < NTOK; n += nb * 8) {
        const int t = n & (SEQ - 1), b = n >> 12, nv = t + 1;
        unsigned short* out = idx + (size_t)n * 256;
        if (nv <= 256) { for (int j = lane; j < 256; j += 64) out[j] = (unsigned short)(j < nv ? j : 0); continue; }
#pragma unroll
        for (int j = 0; j < 4; ++j) iqs[lane * 4 + j] = bf2f(iqr[(size_t)n * 256 + lane * 4 + j]);
        const float w0 = iw[(size_t)n * 4 + 0], w1 = iw[(size_t)n * 4 + 1], w2 = iw[(size_t)n * 4 + 2], w3 = iw[(size_t)n * 4 + 3];
        const int nvp = (nv + 63) & ~63;
        for (int c0 = 0; c0 < nvp; c0 += 64) {
            const int key = c0 + lane; const bool valid = key < nv;
            float kf[64];
            const u32x4* kp = (const u32x4*)(ikr + ((size_t)b * SEQ + (valid ? key : 0)) * 64);
#pragma unroll
            for (int q = 0; q < 8; ++q) { const u32x4 w = kp[q];
                kf[q * 8 + 0] = __uint_as_float(w.x << 16); kf[q * 8 + 1] = __uint_as_float(w.x & 0xffff0000u); kf[q * 8 + 2] = __uint_as_float(w.y << 16); kf[q * 8 + 3] = __uint_as_float(w.y & 0xffff0000u);
                kf[q * 8 + 4] = __uint_as_float(w.z << 16); kf[q * 8 + 5] = __uint_as_float(w.z & 0xffff0000u); kf[q * 8 + 6] = __uint_as_float(w.w << 16); kf[q * 8 + 7] = __uint_as_float(w.w & 0xffff0000u); }
            float sh[4];
#pragma unroll
            for (int h = 0; h < 4; ++h) { float a = 0.f;
#pragma unroll
                for (int d4 = 0; d4 < 16; ++d4) { const f32x4 qv = *(const LAS f32x4*)(iqs + h * 64 + d4 * 4); a += qv[0] * kf[d4 * 4] + qv[1] * kf[d4 * 4 + 1] + qv[2] * kf[d4 * 4 + 2] + qv[3] * kf[d4 * 4 + 3]; }
                sh[h] = fmaxf(a, 0.f); }
            float score = sh[0] * w0 + sh[1] * w1 + sh[2] * w2 + sh[3] * w3;
            score += 0.0f;
            unsigned u = __float_as_uint(score); u = (u & 0x80000000u) ? ~u : (u | 0x80000000u);
            sc[key] = valid ? u : 0u;
        }
        unsigned prefix = 0; int need = 256;
#pragma unroll 1
        for (int pass = 3; pass >= 0; --pass) {
            const int shift = pass * 8;
#pragma unroll
            for (int j = 0; j < 4; ++j) hist[lane * 4 + j] = 0;
            for (int c0 = 0; c0 < nvp; c0 += 64) { const unsigned u = sc[c0 + lane];
                const bool match = (c0 + lane < nv) && (pass == 3 || (u >> (shift + 8)) == prefix);
                if (match) __hip_atomic_fetch_add(hist + ((u >> shift) & 255u), 1, __ATOMIC_RELAXED, __HIP_MEMORY_SCOPE_WORKGROUP); }
            int hb[4];
#pragma unroll
            for (int j = 0; j < 4; ++j) hb[j] = hist[lane * 4 + j];
            const int tot = hb[0] + hb[1] + hb[2] + hb[3];
            int suf = tot;
#pragma unroll
            for (int off = 1; off < 64; off <<= 1) { const int v = __shfl_down(suf, off); if (lane + off < 64) suf += v; }
            const int above = suf - tot;
            const bool is = (above < need) && (need <= suf);
            int bin = 0, nneed = 0;
            if (is) { int c = above;
#pragma unroll
                for (int k = 3; k >= 0; --k) { if (nneed == 0) { if (need <= c + hb[k]) { bin = lane * 4 + k; nneed = need - c; } else c += hb[k]; } } }
            const unsigned long long bal = __ballot(is);
            const int src = __ffsll((long long)bal) - 1;
            bin = __shfl(bin, src); nneed = __shfl(nneed, src);
            prefix = (prefix << 8) | (unsigned)bin; need = nneed;
        }
        const unsigned T = prefix;
        int base = 0, ties = 0;
        for (int c0 = 0; c0 < nvp; c0 += 64) { const int key = c0 + lane; const unsigned u = sc[key]; const bool valid = key < nv;
            const bool gt = valid && u > T, eq = valid && u == T;
            const unsigned long long beq = __ballot(eq);
            const int rank = ties + __popcll(beq & lt_mask);
            const bool take = gt || (eq && rank < need);
            const unsigned long long bt = __ballot(take);
            const int pos = base + __popcll(bt & lt_mask);
            if (take && pos < 256) out[pos] = (unsigned short)key;
            base += __popcll(bt); ties += __popcll(beq); }
    }
}

__device__ __forceinline__ void phase_attn(const Params& p, LAS unsigned char* lds, int bid, int nb) {
    const int tid = opaque_tid(), wid = tid >> 6, lane = tid & 63;
    unsigned char* ws = p.ws;
    const bf16_t* qr = (const bf16_t*)(ws + OFF_BUF64); const bf16_t* kr = (const bf16_t*)(ws + OFF_KR); const bf16_t* vv = (const bf16_t*)(ws + OFF_VV);
    const unsigned short* idx = (const unsigned short*)(ws + OFF_IDX);
    bf16_t* ao = (bf16_t*)(ws + OFF_PD);
    LAS float* qs = (LAS float*)lds + wid * 1024;
    LAS float* ps = (LAS float*)(lds + 32768) + wid * 2048;
    LAS int* ks = (LAS int*)(lds + 32768 + 65536) + wid * 256;
    for (int n = bid * 8 + wid; n < NTOK; n += nb * 8) {
        const int t = n & (SEQ - 1), b = n >> 12, cnt = (t + 1) < 256 ? (t + 1) : 256;
        asm volatile("" ::: "memory");
#pragma unroll
        for (int j = 0; j < 16; ++j) qs[j * 64 + lane] = bf2f(qr[(size_t)n * 1024 + j * 64 + lane]);
#pragma unroll
        for (int r = 0; r < 4; ++r) ks[r * 64 + lane] = idx[(size_t)n * 256 + r * 64 + lane];
#pragma unroll 1
        for (int r = 0; r < 4; ++r) {
            const int j = r * 64 + lane; const bool valid = j < cnt; const int key = valid ? ks[j] : 0;
            const u32x4* kp = (const u32x4*)(kr + ((size_t)b * SEQ + key) * 128);
            float kf[128];
#pragma unroll
            for (int q = 0; q < 16; ++q) { const u32x4 w = kp[q];
                kf[q * 8 + 0] = __uint_as_float(w.x << 16); kf[q * 8 + 1] = __uint_as_float(w.x & 0xffff0000u); kf[q * 8 + 2] = __uint_as_float(w.y << 16); kf[q * 8 + 3] = __uint_as_float(w.y & 0xffff0000u);
                kf[q * 8 + 4] = __uint_as_float(w.z << 16); kf[q * 8 + 5] = __uint_as_float(w.z & 0xffff0000u); kf[q * 8 + 6] = __uint_as_float(w.w << 16); kf[q * 8 + 7] = __uint_as_float(w.w & 0xffff0000u); }
#pragma unroll 1
            for (int h = 0; h < 8; ++h) { float a = 0.f;
#pragma unroll
                for (int d4 = 0; d4 < 32; ++d4) { const f32x4 qv = *(const LAS f32x4*)(qs + h * 128 + d4 * 4);
                    a += qv[0] * kf[d4 * 4] + qv[1] * kf[d4 * 4 + 1] + qv[2] * kf[d4 * 4 + 2] + qv[3] * kf[d4 * 4 + 3]; }
                ps[h * 256 + j] = valid ? a : -INFINITY; }
        }
#pragma unroll
        for (int h = 0; h < 8; ++h) { float x[4]; float m = -INFINITY;
#pragma unroll
            for (int r = 0; r < 4; ++r) { x[r] = ps[h * 256 + r * 64 + lane]; m = fmaxf(m, x[r]); }
#pragma unroll
            for (int o = 32; o > 0; o >>= 1) m = fmaxf(m, __shfl_xor(m, o));
            float s = 0.f;
#pragma unroll
            for (int r = 0; r < 4; ++r) { x[r] = expf(x[r] - m); s += x[r]; }
            s = wave_sum(s); const float inv = 1.0f / s;
#pragma unroll
            for (int r = 0; r < 4; ++r) ps[h * 256 + r * 64 + lane] = x[r] * inv; }
        float o0[8], o1[8];
#pragma unroll
        for (int h = 0; h < 8; ++h) { o0[h] = 0.f; o1[h] = 0.f; }
        for (int j = 0; j < cnt; ++j) { const int key = ks[j];
            const unsigned w = *(const unsigned*)(vv + ((size_t)b * SEQ + key) * 128 + 2 * lane);
            const float v0 = __uint_as_float(w << 16), v1 = __uint_as_float(w & 0xffff0000u);
#pragma unroll
            for (int h = 0; h < 8; ++h) { const float pj = ps[h * 256 + j]; o0[h] += pj * v0; o1[h] += pj * v1; } }
#pragma unroll
        for (int h = 0; h < 8; ++h) *(unsigned*)(ao + (size_t)n * 1024 + h * 128 + 2 * lane) = cvt_pk_bf16(o0[h], o1[h]);
    }
}

__device__ __forceinline__ void phase_inproj_even(const Params& p, LAS unsigned char* lds, int bid, int nb) {
    unsigned char* ws = p.ws;
    pg::DenseSched S; S.init(ws + OFF_BUF64, ws + OFF_WINE, NTOK, NE_MAIN, 1024, nb, bid);
    pg::EpiBf16 E; E.O = (bf16_t*)(ws + OFF_P); E.ldc = NE_MAIN;
    pg::gemm_phase(lds, 1024, S, E);
}
__device__ __forceinline__ void phase_inproj_odd(const Params& p, LAS unsigned char* lds, int bid, int nb) {
    unsigned char* ws = p.ws;
    pg::DenseSched S; S.init(ws + OFF_BUF64, ws + OFF_WINO, NTOK, NO_MAIN, 1024, nb, bid);
    pg::EpiBf16 E; E.O = (bf16_t*)(ws + OFF_PD); E.ldc = NO_MAIN;
    pg::gemm_phase(lds, 1024, S, E);
}
__device__ __forceinline__ void phase_outproj(const Params& p, LAS unsigned char* lds, int bid, int nb, size_t aoff, size_t woff, const float* X) {
    unsigned char* ws = p.ws;
    pg::DenseSched S; S.init(ws + aoff, ws + woff, NTOK, 1024, 1024, nb, bid);
    pg::EpiResid E; E.X = X; E.U = (float*)(ws + OFF_U);
    pg::gemm_phase(lds, 1024, S, E);
}

constexpr int LDS_BYTES = 160 * 1024;
#define GSYNC() grid.sync()
__global__ __launch_bounds__(512, 2) void mega(Params p) {
    extern __shared__ __attribute__((aligned(16))) unsigned char smem[];
    LAS unsigned char* lds = (LAS unsigned char*)smem;
    cg::grid_group grid = cg::this_grid();
    const int bid0 = blockIdx.x, nb0 = gridDim.x;
    int bid, nb;
#define FRESH() do { bid = bid0; nb = nb0; asm volatile("" : "+s"(bid), "+s"(nb)); } while (0)
    FRESH(); phase_prep(p, lds, bid, nb);
    GSYNC();
#pragma unroll 1
    for (int layer = 0; layer < 2; ++layer) {
        if (layer == 0) {
            FRESH(); phase_inproj_even(p, lds, bid, nb);
            FRESH(); phase_gla_alpha(p, lds, bid, nb);
            GSYNC();
            FRESH(); phase_mixer_even(p, lds, bid, nb);
            GSYNC();
        } else {
            FRESH(); phase_inproj_odd(p, lds, bid, nb);
            GSYNC();
            FRESH(); phase_rope(p, bid, nb);
            GSYNC();
            FRESH(); phase_index(p, lds, bid, nb);
            GSYNC();
            FRESH(); phase_attn(p, lds, bid, nb);
            GSYNC();
        }
        FRESH(); phase_outproj(p, lds, bid, nb, layer ? OFF_PD : OFF_BUF64, layer ? OFF_WOUTO : OFF_WOUTE, layer ? p.out : p.in[I_X]);
        GSYNC();
        FRESH(); phase_ln_route(p, lds, bid, nb, layer);
        GSYNC();
        FRESH(); phase_moe_gateup(p, lds, bid, nb, layer);
        GSYNC();
        FRESH(); phase_moe_down(p, lds, bid, nb, layer);
        GSYNC();
        FRESH(); phase_ln2(p, bid, nb, layer, p.out, true);
        GSYNC();
    }
}

extern "C" void kernel_launch(void* const* d_in, const int* in_sizes, int n_in, void* d_out, int out_size, void* d_ws, size_t ws_size, hipStream_t stream) {
    if (ws_size < WS_NEED) { fprintf(stderr, "workspace too small: %zu < %zu\n", ws_size, (size_t)WS_NEED); return; }
    Params p{};
    for (int i = 0; i < 30; ++i) p.in[i] = (const float*)d_in[i];
    p.out = (float*)d_out; p.ws = (unsigned char*)d_ws;
    static int grid_blocks = 0;
    if (!grid_blocks) {
        (void)hipFuncSetAttribute((const void*)mega, hipFuncAttributeMaxDynamicSharedMemorySize, LDS_BYTES);
        int dev = 0, cus = 0, per_cu = 0;
        (void)hipGetDevice(&dev);
        (void)hipDeviceGetAttribute(&cus, hipDeviceAttributeMultiprocessorCount, dev);
        (void)hipOccupancyMaxActiveBlocksPerMultiprocessor(&per_cu, mega, 512, LDS_BYTES);
        if (per_cu < 1) { fprintf(stderr, "occupancy query returned %d\n", per_cu); per_cu = 1; }
        grid_blocks = cus;
    }
    void* args[] = {&p};
    hipError_t e = hipLaunchCooperativeKernel((void*)mega, dim3(grid_blocks), dim3(512), args, LDS_BYTES, stream);
    if (e != hipSuccess) fprintf(stderr, "cooperative launch failed: %s (grid %d)\n", hipGetErrorString(e), grid_blocks);
}
```

```cpp
#include <hip/hip_runtime.h>
#include <hip/hip_cooperative_groups.h>
#include <cstdio>
#include <cstdint>
namespace cg = cooperative_groups;

constexpr int NTOK = 32768, SEQ = 4096, NB = 8, DM = 1024;
constexpr int EVEN_COLS = 3344, ODD_COLS = 1604;
constexpr int NE_MAIN = 3328;
constexpr int NO_MAIN = 1792;
constexpr int NEXP = 16, DEXP = 256;
constexpr float DN_ALPHA = 1.4142135623730951f;
constexpr float LN_EPS = 1e-5f;
constexpr int MOE_ROWS = 65536 + 16 * 256;

typedef unsigned short bf16_t;
typedef short bf16x8 __attribute__((ext_vector_type(8)));
typedef float f32x4 __attribute__((ext_vector_type(4)));
typedef float f32x2 __attribute__((ext_vector_type(2)));
typedef unsigned u32x4 __attribute__((ext_vector_type(4)));
typedef unsigned u32x2 __attribute__((ext_vector_type(2)));
#define LAS __attribute__((address_space(3)))

__device__ __forceinline__ unsigned cvt_pk_bf16(float lo, float hi) { unsigned r; asm volatile("v_cvt_pk_bf16_f32 %0, %1, %2" : "=v"(r) : "v"(lo), "v"(hi)); return r; }
__device__ __forceinline__ bf16_t f2bf(float f) { return (bf16_t)(cvt_pk_bf16(f, 0.f) & 0xffffu); }
__device__ __forceinline__ float bf2f(bf16_t h) { return __uint_as_float(((unsigned)h) << 16); }
constexpr int LDS_BYTES = 160 * 1024;
constexpr int PTAB_OFF = LDS_BYTES - 256;
constexpr int WTAB_OFF = LDS_BYTES - 512;
__device__ __forceinline__ int hw_slot() { return (int)(__builtin_amdgcn_s_getreg(0x2804) & 63u); }
__device__ __forceinline__ int opaque_tid() {
    extern __shared__ __attribute__((aligned(16))) unsigned char smem_[];
    const int w = __builtin_amdgcn_readfirstlane(((LAS const int*)((LAS unsigned char*)smem_ + WTAB_OFF))[hw_slot()]);
    int l; asm volatile("v_mbcnt_lo_u32_b32 %0, -1, 0\n\tv_mbcnt_hi_u32_b32 %0, -1, %0" : "=v"(l));
    return (w << 6) | l; }
__device__ __forceinline__ float wave_sum(float v) {
#pragma unroll
    for (int o = 32; o > 0; o >>= 1) v += __shfl_xor(v, o);
    return v;
}

constexpr size_t MiB = 1024ull * 1024ull;
constexpr size_t OFF_WINE = 0;
constexpr size_t OFF_WOUTE = OFF_WINE + (size_t)NE_MAIN * 1024 * 2;
constexpr size_t OFF_WINO = OFF_WOUTE + 2 * MiB;
constexpr size_t OFF_WOUTO = OFF_WINO + (size_t)NO_MAIN * 1024 * 2;
constexpr size_t OFF_WGU = OFF_WOUTO + 2 * MiB;
constexpr size_t OFF_WD = OFF_WGU + 32 * MiB;
constexpr size_t OFF_ROPE = OFF_WD + 16 * MiB;
constexpr size_t OFF_MISC = OFF_ROPE + 3 * MiB;
constexpr size_t OFF_BUF64 = OFF_MISC + 4 * MiB;
constexpr size_t OFF_P = OFF_BUF64 + 64 * MiB;
constexpr size_t OFF_U = OFF_P + 208 * MiB;
constexpr size_t WS_NEED = OFF_U + 128 * MiB;
constexpr size_t OFF_HE = OFF_P;
constexpr size_t OFF_ACT = OFF_HE + (size_t)MOE_ROWS * 1024 * 2;
constexpr size_t OFF_PD = OFF_P;
constexpr size_t OFF_KR = OFF_P + 112 * MiB;
constexpr size_t OFF_VV = OFF_KR + 8 * MiB;
constexpr size_t OFF_IQR = OFF_VV + 8 * MiB;
constexpr size_t OFF_IKR = OFF_IQR + 16 * MiB;
constexpr size_t OFF_IW = OFF_IKR + 4 * MiB;
constexpr size_t OFF_IDX = OFF_IW + 1 * MiB;
constexpr size_t MISC_CNT = 0;
constexpr size_t MISC_TOKINFO = 4096;
constexpr size_t MISC_TOKGATE = MISC_TOKINFO + (size_t)NTOK * 16;
constexpr size_t MISC_LIST = MISC_TOKGATE + (size_t)NTOK * 8;

struct InTab { LAS const unsigned long long* t;
    __device__ __forceinline__ const float* operator[](int i) const { const unsigned long long v = t[i];
        const unsigned lo = __builtin_amdgcn_readfirstlane((unsigned)v), hi = __builtin_amdgcn_readfirstlane((unsigned)(v >> 32));
        return (const float*)(((unsigned long long)hi << 32) | lo); } };
struct Params { InTab in; float* out; unsigned char* ws; };
struct KArgs { const float* in[30]; float* out; unsigned char* ws; };
enum { I_X = 0, I_WINE, I_AMU, I_AW0, I_AW2, I_AA0, I_AA2, I_AG2, I_AKK, I_AKA, I_ARK, I_AGNG, I_AGNB, I_BGW2, I_BGB, I_BNG, I_WOUTE,
       I_WINO, I_CIKG, I_CIKB, I_WOUTO, I_LN1G, I_LN1B, I_LN2G, I_LN2B, I_RW, I_RB, I_EG, I_EU, I_ED };

namespace pg {
constexpr int BM = 256, BK = 64, HALF = 128, HTB = HALF * BK * 2, STAGE_BYTES = 8 * HTB;
__host__ __device__ __forceinline__ int lds_byte(int r, int c) { const int st = (r >> 4) * 2 + (c >> 5), rr = r & 15, cc = c & 31, ob = rr * 64 + cc * 2; return st * 1024 + (ob ^ (((ob >> 9) & 1) << 5)); }
__host__ __device__ __forceinline__ void stage_rc(int b, int& R, int& C) { const int st = b / 1024, sb = b % 1024, swz = sb ^ (((sb >> 9) & 1) << 5); R = (st >> 1) * 16 + swz / 64; C = (st & 1) * 32 + (swz % 64) / 2; }
__host__ __device__ __forceinline__ int perm32(int rho) { const int n = rho >> 4, i = rho & 15; return 8 * (i >> 2) + 4 * n + (i & 3); }

struct Unit { int pm, pn, e, rt, cnt; };

template <class Epi, class Sched>
__device__ __forceinline__ void gemm_phase(LAS unsigned char* lds, const int K, const Sched& S, const Epi& E) {
    const int tid = opaque_tid(), wid = __builtin_amdgcn_readfirstlane(tid >> 6), lane = tid & 63, wr = wid >> 2, wc = wid & 3, fr = lane & 15, fq = lane >> 4;
    const int nt = K / BK;
    unsigned voffB[2];
#pragma unroll
    for (int i = 0; i < 2; ++i) { int R, C; stage_rc(tid * 16 + i * 8192, R, C); const int Rb = Epi::PERM ? ((R & ~31) + perm32(R & 31)) : R; voffB[i] = (unsigned)(Rb * K + C) * 2u; }
    const size_t kstep = (size_t)(BK * 2);
    const size_t hstepB = (size_t)HALF * K * 2;
    const unsigned ldsw = (unsigned)wid * 1024u;
    const int aoff = lds_byte(wr * 64 + fr, fq * 8), boff = lds_byte(wc * 32 + fr, fq * 8);
#define PG_SA(b, h) (((b) * 2 + (h)) * HTB)
#define PG_SB(b, h) ((4 + (b) * 2 + (h)) * HTB)
#define PG_STAGE(bufoff, gbase, voff) do { _Pragma("unroll") for (int _i = 0; _i < 2; ++_i) \
        __builtin_amdgcn_global_load_lds((const unsigned*)((const char*)(gbase) + (voff)[_i]), (LAS unsigned*)(lds + (bufoff) + ldsw + _i * 8192), 16, 0, 0); } while (0)
#define PG_LDA(dst, b, h) do { _Pragma("unroll") for (int m = 0; m < 4; ++m) _Pragma("unroll") for (int k = 0; k < 2; ++k) dst[m][k] = *(const LAS bf16x8*)(lds + PG_SA(b, h) + aoff + m * 2048 + k * 1024); } while (0)
#define PG_LDB(dst, b, h) do { _Pragma("unroll") for (int n = 0; n < 2; ++n) _Pragma("unroll") for (int k = 0; k < 2; ++k) dst[n][k] = *(const LAS bf16x8*)(lds + PG_SB(b, h) + boff + n * 2048 + k * 1024); } while (0)
#define PG_MMA(ai, bj, At, Bt) do { __builtin_amdgcn_s_setprio(1); _Pragma("unroll") for (int m = 0; m < 4; ++m) _Pragma("unroll") for (int n = 0; n < 2; ++n) _Pragma("unroll") for (int k = 0; k < 2; ++k) \
        acc[ai][bj][m][n] = __builtin_amdgcn_mfma_f32_16x16x32_bf16(Bt[n][k], At[m][k], acc[ai][bj][m][n], 0, 0, 0); __builtin_amdgcn_s_setprio(0); } while (0)
#define PG_WAIT_V(n) asm volatile("s_waitcnt vmcnt(" #n ")" ::: "memory")
#define PG_WAIT_L(n) asm volatile("s_waitcnt lgkmcnt(" #n ")" ::: "memory")
#define PG_BAR __builtin_amdgcn_s_barrier()
#define PG_SCHED __builtin_amdgcn_sched_barrier(0)
#define PG_AOFF(dst0, dst1, u) do { _Pragma("unroll") for (int _i = 0; _i < 2; ++_i) { int _R, _C; stage_rc(tid * 16 + _i * 8192, _R, _C); \
        dst0[_i] = S.a_rowoff(u, 0, _R) + (unsigned)_C * 2u; dst1[_i] = S.a_rowoff(u, 1, _R) + (unsigned)_C * 2u; } } while (0)
    Unit cur, nxt; int ui = 0;
    if (!S.next(0, cur)) return;
    f32x4 acc[2][2][4][2];
#pragma unroll
    for (int a = 0; a < 2; ++a)
#pragma unroll
        for (int b = 0; b < 2; ++b)
#pragma unroll
            for (int m = 0; m < 4; ++m)
#pragma unroll
                for (int n = 0; n < 2; ++n) acc[a][b][m][n] = (f32x4){0.f, 0.f, 0.f, 0.f};
    bf16x8 At[4][2], B0[2][2], B1[2][2];
    const char* const Ab = S.a_base();
    unsigned aC0[2], aC1[2];
    PG_AOFF(aC0, aC1, cur);
    const char* cB = S.b_ptr(cur);
    PG_STAGE(PG_SB(0, 0), cB, voffB); PG_STAGE(PG_SA(0, 0), Ab, aC0); PG_STAGE(PG_SB(0, 1), cB + hstepB, voffB); PG_STAGE(PG_SA(0, 1), Ab, aC1);
    if (wr == 1) PG_BAR;
    PG_WAIT_V(4); PG_BAR;
    PG_STAGE(PG_SB(1, 0), cB + kstep, voffB); PG_STAGE(PG_SA(1, 0), Ab + kstep, aC0); PG_STAGE(PG_SB(1, 1), cB + hstepB + kstep, voffB);
    PG_WAIT_V(6); PG_BAR;
    for (;;) {
        const bool has_next = S.next(ui + 1, nxt);
        const char* nB = has_next ? S.b_ptr(nxt) : cB;
#pragma unroll 1
        for (int t = 0; t < nt; t += 2) {
            const bool last = (t == nt - 2);
            const char* a1 = Ab + (size_t)(t + 1) * kstep;
            const char* a2 = last ? Ab : Ab + (size_t)(t + 2) * kstep; const char* b2 = last ? nB : cB + (size_t)(t + 2) * kstep;
            const char* a3 = a2 + kstep; const char* b3 = b2 + kstep;
            PG_LDB(B0, 0, 0); PG_SCHED; PG_LDA(At, 0, 0); PG_STAGE(PG_SA(1, 1), a1, aC1);
            if (last && has_next) PG_AOFF(aC0, aC1, nxt);
            PG_WAIT_L(8); PG_BAR; PG_WAIT_L(0); PG_MMA(0, 0, At, B0); PG_BAR; PG_SCHED;
            PG_LDB(B1, 0, 1); PG_STAGE(PG_SB(0, 0), b2, voffB);
            PG_BAR; PG_WAIT_L(0); PG_MMA(0, 1, At, B1); PG_BAR;
            PG_LDA(At, 0, 1); PG_STAGE(PG_SA(0, 0), a2, aC0);
            PG_BAR; PG_WAIT_L(0); PG_MMA(1, 0, At, B0); PG_BAR; PG_SCHED;
            PG_STAGE(PG_SB(0, 1), b2 + hstepB, voffB);
            PG_WAIT_V(6); PG_BAR; PG_MMA(1, 1, At, B1); PG_BAR;
            PG_LDB(B0, 1, 0); PG_SCHED; PG_LDA(At, 1, 0); PG_STAGE(PG_SA(0, 1), a2, aC1);
            PG_WAIT_L(8); PG_BAR; PG_WAIT_L(0); PG_MMA(0, 0, At, B0); PG_BAR; PG_SCHED;
            PG_LDB(B1, 1, 1); PG_STAGE(PG_SB(1, 0), b3, voffB);
            PG_BAR; PG_WAIT_L(0); PG_MMA(0, 1, At, B1); PG_BAR;
            PG_LDA(At, 1, 1); PG_STAGE(PG_SA(1, 0), a3, aC0);
            PG_BAR; PG_WAIT_L(0); PG_MMA(1, 0, At, B0); PG_BAR; PG_SCHED;
            PG_STAGE(PG_SB(1, 1), b3 + hstepB, voffB);
            PG_WAIT_V(6); PG_BAR; PG_MMA(1, 1, At, B1); PG_BAR;
        }
        E(acc, cur, wr, wc, fr, fq);
        if (!has_next) break;
#pragma unroll
        for (int a = 0; a < 2; ++a)
#pragma unroll
            for (int b = 0; b < 2; ++b)
#pragma unroll
                for (int m = 0; m < 4; ++m)
#pragma unroll
                    for (int n = 0; n < 2; ++n) acc[a][b][m][n] = (f32x4){0.f, 0.f, 0.f, 0.f};
        cur = nxt; cB = nB; ++ui;
    }
    PG_WAIT_V(0);
    if (wr == 0) PG_BAR;
    PG_BAR;
#undef PG_SA
#undef PG_SB
#undef PG_STAGE
#undef PG_LDA
#undef PG_LDB
#undef PG_MMA
#undef PG_WAIT_V
#undef PG_WAIT_L
#undef PG_BAR
#undef PG_SCHED
#undef PG_AOFF
}

struct DenseSched {
    const char* A; const char* Bt; int K, nM, nN, nwg, G, c;
    __device__ void init(const void* A_, const void* Bt_, int M, int N, int K_, int G_, int c_) { A = (const char*)A_; Bt = (const char*)Bt_; K = K_; nM = M / BM; nN = N / BM; nwg = nM * nN; G = G_; c = c_; }
    __device__ __forceinline__ bool next(int i, Unit& u) const {
        const long L = (long)i * G + c; if (L >= nwg) return false;
        int wgid = (int)L; { const int q = nwg / 8, r = nwg % 8, xcd = wgid % 8, off = wgid / 8; wgid = (xcd < r ? xcd * (q + 1) : r * (q + 1) + (xcd - r) * q) + off; }
        const int nig = 8 * nN, gid = wgid / nig, fm = gid * 8, gsz = (nM - fm) < 8 ? (nM - fm) : 8;
        u.pm = fm + ((wgid % nig) % gsz); u.pn = (wgid % nig) / gsz; u.e = 0; u.rt = 0; u.cnt = 0; return true;
    }
    __device__ __forceinline__ const char* a_base() const { return A; }
    __device__ __forceinline__ unsigned a_rowoff(const Unit& u, int half, int R) const { return (unsigned)(u.pm * BM + half * HALF + R) * (unsigned)(K * 2); }
    __device__ __forceinline__ const char* b_ptr(const Unit& u) const { return Bt + (size_t)u.pn * BM * K * 2; }
};

__device__ __forceinline__ void moe_build_units(LAS int* tab, const int* cntp, int NCT, int G, int c) {
    const int i = opaque_tid();
    if (i < 16) {
        const int L = i * G + c; int accu = 0, rtb = 0, found = 0, pm = 0, pn = 0, ee = 0, rt = 0, cn = 0;
        for (int e = 0; e < 16; ++e) { const int ce = cntp[e], nte = (ce + 255) >> 8, ue = nte * NCT;
            if (!found && L < accu + ue) { const int local = L - accu; ee = e; rt = local / NCT; pn = local % NCT; pm = rtb + rt; cn = ce; found = 1; }
            accu += ue; rtb += nte; }
        tab[i * 8 + 0] = found; tab[i * 8 + 1] = pm; tab[i * 8 + 2] = pn; tab[i * 8 + 3] = ee; tab[i * 8 + 4] = rt; tab[i * 8 + 5] = cn;
    }
    __syncthreads();
}
template <bool GATHER>
struct MoeSched {
    const char* A; const char* Bt; const int* list; int K; size_t wstride; LAS int* tab;
    __device__ void init(const void* A_, const void* Bt_, size_t wstride_bytes, const int* list_, int K_, LAS int* tab_) {
        A = (const char*)A_; Bt = (const char*)Bt_; wstride = wstride_bytes; list = list_; K = K_; tab = tab_; }
    __device__ __forceinline__ bool next(int i, Unit& u) const {
        if (i >= 16) return false;
        const int f = __builtin_amdgcn_readfirstlane(tab[i * 8 + 0]);
        u.pm = __builtin_amdgcn_readfirstlane(tab[i * 8 + 1]); u.pn = __builtin_amdgcn_readfirstlane(tab[i * 8 + 2]); u.e = __builtin_amdgcn_readfirstlane(tab[i * 8 + 3]);
        u.rt = __builtin_amdgcn_readfirstlane(tab[i * 8 + 4]); u.cnt = __builtin_amdgcn_readfirstlane(tab[i * 8 + 5]);
        return f != 0;
    }
    __device__ __forceinline__ const char* a_base() const { return A; }
    __device__ __forceinline__ unsigned a_rowoff(const Unit& u, int half, int R) const {
        if (GATHER) { const int slot = u.rt * BM + half * HALF + R; const int tok = slot < u.cnt ? list[u.e * NTOK + slot] : 0; return (unsigned)tok * (unsigned)(K * 2); }
        return (unsigned)(u.pm * BM + half * HALF + R) * (unsigned)(K * 2);
    }
    __device__ __forceinline__ const char* b_ptr(const Unit& u) const { return Bt + (size_t)u.e * wstride + (size_t)u.pn * BM * K * 2; }
};

struct EpiBf16 {
    static constexpr bool PERM = true;
    bf16_t* O; int ldc;
    __device__ __forceinline__ void operator()(const f32x4 (&acc)[2][2][4][2], const Unit& u, int wr, int wc, int fr, int fq) const {
        const int row0 = u.pm * BM + wr * 64 + fr, col0 = u.pn * BM + wc * 32 + 8 * fq;
#pragma unroll
        for (int ai = 0; ai < 2; ++ai)
#pragma unroll
            for (int m = 0; m < 4; ++m) { bf16_t* rowp = O + (size_t)(row0 + ai * HALF + m * 16) * ldc + col0;
#pragma unroll
                for (int bj = 0; bj < 2; ++bj) { const f32x4 v0 = acc[ai][bj][m][0], v1 = acc[ai][bj][m][1];
                    u32x4 w; w.x = cvt_pk_bf16(v0[0], v0[1]); w.y = cvt_pk_bf16(v0[2], v0[3]); w.z = cvt_pk_bf16(v1[0], v1[1]); w.w = cvt_pk_bf16(v1[2], v1[3]);
                    *(u32x4*)(rowp + bj * HALF) = w; } }
    }
};
struct EpiResid {
    static constexpr bool PERM = false;
    const float* X; float* U;
    __device__ __forceinline__ void operator()(const f32x4 (&acc)[2][2][4][2], const Unit& u, int wr, int wc, int fr, int fq) const {
        const int row0 = u.pm * BM + wr * 64 + fr, col0 = u.pn * BM + wc * 32 + 4 * fq;
#pragma unroll
        for (int ai = 0; ai < 2; ++ai)
#pragma unroll
            for (int m = 0; m < 4; ++m) { const size_t off = (size_t)(row0 + ai * HALF + m * 16) * DM + col0;
#pragma unroll
                for (int bj = 0; bj < 2; ++bj)
#pragma unroll
                    for (int n = 0; n < 2; ++n) { const f32x4 xv = *(const f32x4*)(X + off + bj * HALF + n * 16);
                        *(f32x4*)(U + off + bj * HALF + n * 16) = xv * DN_ALPHA + acc[ai][bj][m][n]; } }
    }
};
struct EpiSwiglu {
    static constexpr bool PERM = true;
    bf16_t* O;
    __device__ __forceinline__ void operator()(const f32x4 (&acc)[2][2][4][2], const Unit& u, int wr, int wc, int fr, int fq) const {
        const int row0 = u.pm * BM + wr * 64 + fr, col0 = u.pn * HALF + wc * 32 + 8 * fq;
#pragma unroll
        for (int ai = 0; ai < 2; ++ai)
#pragma unroll
            for (int m = 0; m < 4; ++m) { bf16_t* rowp = O + (size_t)(row0 + ai * HALF + m * 16) * DEXP + col0;
                float r[8];
#pragma unroll
                for (int n = 0; n < 2; ++n)
#pragma unroll
                    for (int j = 0; j < 4; ++j) { const float g = acc[ai][0][m][n][j], up = acc[ai][1][m][n][j]; r[n * 4 + j] = g / (1.0f + __expf(-g)) * up; }
                u32x4 w; w.x = cvt_pk_bf16(r[0], r[1]); w.y = cvt_pk_bf16(r[2], r[3]); w.z = cvt_pk_bf16(r[4], r[5]); w.w = cvt_pk_bf16(r[6], r[7]);
                *(u32x4*)rowp = w; }
    }
};
}

__device__ __forceinline__ void tr_tile(LAS float* tile  , const float* src, int ld, int k0, int c0, int ncols_valid, bf16_t* dst, int dstK, int drow0, int tid) {
    {
        const int r = tid >> 3, cc = (tid & 7) * 8;
        const float* sp = src + (size_t)(k0 + r) * ld + c0 + cc;
#pragma unroll
        for (int j = 0; j < 8; ++j) tile[r * 65 + cc + j] = (c0 + cc + j < ncols_valid) ? sp[j] : 0.f;
    }
    __syncthreads();
    {
        const int n = tid >> 3, kk = (tid & 7) * 8;
        u32x4 w;
        w.x = cvt_pk_bf16(tile[(kk + 0) * 65 + n], tile[(kk + 1) * 65 + n]); w.y = cvt_pk_bf16(tile[(kk + 2) * 65 + n], tile[(kk + 3) * 65 + n]);
        w.z = cvt_pk_bf16(tile[(kk + 4) * 65 + n], tile[(kk + 5) * 65 + n]); w.w = cvt_pk_bf16(tile[(kk + 6) * 65 + n], tile[(kk + 7) * 65 + n]);
        *(u32x4*)(dst + (size_t)(drow0 + n) * dstK + k0 + kk) = w;
    }
    __syncthreads();
}

__device__ __forceinline__ void phase_prep(const Params& p, LAS unsigned char* lds, int bid, int nb) {
    const int tid = opaque_tid();
    LAS float* tile = (LAS float*)lds;
    unsigned char* ws = p.ws;
    const int T0 = 832, T1 = T0 + 256, T2 = T1 + 448, T3 = T2 + 256, T4 = T3 + 2048, T5 = T4 + 2048, T6 = T5 + 2048;
    for (int t = bid; t < T6; t += nb) {
        if (t < T0) { const int kt = t / 52, ct = t % 52; tr_tile(tile, p.in[I_WINE], EVEN_COLS, kt * 64, ct * 64, EVEN_COLS, (bf16_t*)(ws + OFF_WINE), 1024, ct * 64, tid); }
        else if (t < T1) { const int q = t - T0, kt = q / 16, ct = q % 16; tr_tile(tile, p.in[I_WOUTE], 1024, kt * 64, ct * 64, 1024, (bf16_t*)(ws + OFF_WOUTE), 1024, ct * 64, tid); }
        else if (t < T2) { const int q = t - T1, kt = q / 28, ct = q % 28; tr_tile(tile, p.in[I_WINO], ODD_COLS, kt * 64, ct * 64, ODD_COLS, (bf16_t*)(ws + OFF_WINO), 1024, ct * 64, tid); }
        else if (t < T3) { const int q = t - T2, kt = q / 16, ct = q % 16; tr_tile(tile, p.in[I_WOUTO], 1024, kt * 64, ct * 64, 1024, (bf16_t*)(ws + OFF_WOUTO), 1024, ct * 64, tid); }
        else if (t < T5) { const bool up = t >= T4; const int q = t - (up ? T4 : T3), le = q / 64, r = q % 64, kt = r / 4, ct = r % 4;
            const int c0 = ct * 64, drow0 = (c0 / 128) * 256 + (up ? 128 : 0) + (c0 % 128);
            tr_tile(tile, p.in[up ? I_EU : I_EG] + (size_t)le * 1024 * 256, 256, kt * 64, c0, 256, (bf16_t*)(ws + OFF_WGU) + (size_t)le * 512 * 1024, 1024, drow0, tid); }
        else { const int q = t - T5, le = q / 64, r = q % 64, kt = r / 16, ct = r % 16;
            tr_tile(tile, p.in[I_ED] + (size_t)le * 256 * 1024, 1024, kt * 64, ct * 64, 1024, (bf16_t*)(ws + OFF_WD) + (size_t)le * 1024 * 256, 256, ct * 64, tid); }
    }
    {
        const float* x = p.in[I_X]; bf16_t* xb = (bf16_t*)(ws + OFF_BUF64);
        const size_t n8 = (size_t)NTOK * DM / 8;
        for (size_t i = (size_t)bid * 512 + tid; i < n8; i += (size_t)nb * 512) {
            const f32x4 a = *(const f32x4*)(x + i * 8), b = *(const f32x4*)(x + i * 8 + 4);
            u32x4 w; w.x = cvt_pk_bf16(a[0], a[1]); w.y = cvt_pk_bf16(a[2], a[3]); w.z = cvt_pk_bf16(b[0], b[1]); w.w = cvt_pk_bf16(b[2], b[3]);
            *(u32x4*)(xb + i * 8) = w;
        }
    }
    {
        float* c64 = (float*)(ws + OFF_ROPE); float* s64 = c64 + 4096 * 64; float* c32 = s64 + 4096 * 64; float* s32 = c32 + 4096 * 32;
        for (int i = bid * 512 + tid; i < 4096 * 64; i += nb * 512) { const int pos = i >> 6, j = i & 63; const float inv = powf(10000.0f, -(float)j / 64.0f); const float ang = (float)pos * inv; c64[i] = cosf(ang); s64[i] = sinf(ang); }
        for (int i = bid * 512 + tid; i < 4096 * 32; i += nb * 512) { const int pos = i >> 5, j = i & 31; const float inv = powf(10000.0f, -(float)j / 32.0f); const float ang = (float)pos * inv; c32[i] = cosf(ang); s32[i] = sinf(ang); }
    }
    if (bid == 0 && tid < 64) ((int*)(ws + OFF_MISC + MISC_CNT))[tid] = 0;
}

__device__ __forceinline__ void phase_ln_route(const Params& p, LAS unsigned char* lds, int bid, int nb, int layer) {
    const int tid = opaque_tid(), wid = tid >> 6, lane = tid & 63;
    unsigned char* ws = p.ws;
    LAS float* rwT = (LAS float*)lds;
    for (int i = tid; i < 16 * 1024; i += 512) { const int e = i >> 10, k = i & 1023; rwT[i] = p.in[I_RW][k * 16 + e]; }
    __syncthreads();
    float* U = (float*)(ws + OFF_U); bf16_t* hb = (bf16_t*)(ws + OFF_BUF64);
    const float* g = p.in[I_LN1G] + layer * DM; const float* b = p.in[I_LN1B] + layer * DM;
    int* cnt = (int*)(ws + OFF_MISC + MISC_CNT) + layer * 16;
    int* tokinfo = (int*)(ws + OFF_MISC + MISC_TOKINFO); float* tokgate = (float*)(ws + OFF_MISC + MISC_TOKGATE); int* list = (int*)(ws + OFF_MISC + MISC_LIST);
    f32x4 gv[4], bv[4];
#pragma unroll
    for (int j = 0; j < 4; ++j) { gv[j] = *(const f32x4*)(g + j * 256 + lane * 4); bv[j] = *(const f32x4*)(b + j * 256 + lane * 4); }
    float rbias[16];
#pragma unroll
    for (int e = 0; e < 16; ++e) rbias[e] = p.in[I_RB][e];
    for (int tok = bid * 8 + wid; tok < NTOK; tok += nb * 8) {
        f32x4 v[4]; float s = 0.f;
#pragma unroll
        for (int j = 0; j < 4; ++j) { v[j] = *(const f32x4*)(U + (size_t)tok * DM + j * 256 + lane * 4); s += (v[j][0] + v[j][1]) + (v[j][2] + v[j][3]); }
        const float mean = wave_sum(s) * (1.0f / DM);
        float q = 0.f;
#pragma unroll
        for (int j = 0; j < 4; ++j) { v[j] -= mean; q += (v[j][0] * v[j][0] + v[j][1] * v[j][1]) + (v[j][2] * v[j][2] + v[j][3] * v[j][3]); }
        const float rstd = rsqrtf(wave_sum(q) * (1.0f / DM) + LN_EPS);
#pragma unroll
        for (int j = 0; j < 4; ++j) { v[j] = v[j] * rstd * gv[j] + bv[j];
            *(f32x4*)(U + (size_t)tok * DM + j * 256 + lane * 4) = v[j];
            u32x2 w; w.x = cvt_pk_bf16(v[j][0], v[j][1]); w.y = cvt_pk_bf16(v[j][2], v[j][3]);
            *(u32x2*)(hb + (size_t)tok * DM + j * 256 + lane * 4) = w; }
        float lg[16];
        asm volatile("" ::: "memory");
#pragma unroll
        for (int e = 0; e < 16; ++e) { float a = 0.f;
#pragma unroll
            for (int j = 0; j < 4; ++j) { const f32x4 w = *(const LAS f32x4*)(rwT + e * 1024 + j * 256 + lane * 4); a += (v[j][0] * w[0] + v[j][1] * w[1]) + (v[j][2] * w[2] + v[j][3] * w[3]); }
            lg[e] = wave_sum(a); }
        float sg[16], sel[16];
#pragma unroll
        for (int e = 0; e < 16; ++e) { sg[e] = 1.0f / (1.0f + expf(-lg[e])); sel[e] = sg[e] + rbias[e]; }
        int best = 0; float bestv = -INFINITY;
#pragma unroll
        for (int gI = 0; gI < 4; ++gI) { float m1 = -INFINITY, m2 = -INFINITY;
#pragma unroll
            for (int j = 0; j < 4; ++j) { const float x = sel[gI * 4 + j]; if (x > m1) { m2 = m1; m1 = x; } else if (x > m2) m2 = x; }
            const float gs = m1 + m2; if (gs > bestv) { bestv = gs; best = gI; } }
        int e0 = 0, e1 = 0; float v0 = -INFINITY, v1 = -INFINITY, s0 = 0.f, s1 = 0.f;
#pragma unroll
        for (int e = 0; e < 16; ++e) { if ((e >> 2) == best) { const float x = sel[e];
                if (x > v0) { v1 = v0; e1 = e0; s1 = s0; v0 = x; e0 = e; s0 = sg[e]; } else if (x > v1) { v1 = x; e1 = e; s1 = sg[e]; } } }
        const float gsum = s0 + s1; const float g0 = s0 / gsum, g1 = s1 / gsum;
        if (lane == 0) {
            const int sl0 = atomicAdd(cnt + e0, 1), sl1 = atomicAdd(cnt + e1, 1);
            list[e0 * NTOK + sl0] = tok; list[e1 * NTOK + sl1] = tok;
            tokinfo[tok * 4 + 0] = e0; tokinfo[tok * 4 + 1] = sl0; tokinfo[tok * 4 + 2] = e1; tokinfo[tok * 4 + 3] = sl1;
            tokgate[tok * 2 + 0] = g0; tokgate[tok * 2 + 1] = g1;
        }
    }
}

__device__ __forceinline__ void phase_ln2(const Params& p, int bid, int nb, int layer, float* dst, bool with_moe) {
    const int tid = opaque_tid(), wid = tid >> 6, lane = tid & 63;
    unsigned char* ws = p.ws;
    const float* U = (const float*)(ws + OFF_U); bf16_t* xb = (bf16_t*)(ws + OFF_BUF64);
    const bf16_t* he = (const bf16_t*)(ws + OFF_HE);
    const float* g = p.in[I_LN2G] + layer * DM; const float* b = p.in[I_LN2B] + layer * DM;
    const int* cnt = (const int*)(ws + OFF_MISC + MISC_CNT) + layer * 16;
    const int* tokinfo = (const int*)(ws + OFF_MISC + MISC_TOKINFO); const float* tokgate = (const float*)(ws + OFF_MISC + MISC_TOKGATE);
    int rowbase[16]; { int a = 0;
#pragma unroll
        for (int e = 0; e < 16; ++e) { rowbase[e] = a; a += ((cnt[e] + 255) >> 8) << 8; } }
    f32x4 gv[4], bv[4];
#pragma unroll
    for (int j = 0; j < 4; ++j) { gv[j] = *(const f32x4*)(g + j * 256 + lane * 4); bv[j] = *(const f32x4*)(b + j * 256 + lane * 4); }
    for (int tok = bid * 8 + wid; tok < NTOK; tok += nb * 8) {
        f32x4 v[4]; float s = 0.f;
        int r0 = 0, r1 = 0; float g0 = 0.f, g1 = 0.f;
        if (with_moe) { const int e0 = tokinfo[tok * 4 + 0], sl0 = tokinfo[tok * 4 + 1], e1 = tokinfo[tok * 4 + 2], sl1 = tokinfo[tok * 4 + 3];
            int rb0 = 0, rb1 = 0;
#pragma unroll
            for (int e = 0; e < 16; ++e) { if (e == e0) rb0 = rowbase[e]; if (e == e1) rb1 = rowbase[e]; }
            r0 = rb0 + sl0; r1 = rb1 + sl1; g0 = tokgate[tok * 2 + 0]; g1 = tokgate[tok * 2 + 1]; }
#pragma unroll
        for (int j = 0; j < 4; ++j) { v[j] = *(const f32x4*)(U + (size_t)tok * DM + j * 256 + lane * 4) * DN_ALPHA;
            if (with_moe) { const u32x2 a = *(const u32x2*)(he + (size_t)r0 * DM + j * 256 + lane * 4), c = *(const u32x2*)(he + (size_t)r1 * DM + j * 256 + lane * 4);
                v[j][0] += g0 * __uint_as_float(a.x << 16) + g1 * __uint_as_float(c.x << 16); v[j][1] += g0 * __uint_as_float(a.x & 0xffff0000u) + g1 * __uint_as_float(c.x & 0xffff0000u);
                v[j][2] += g0 * __uint_as_float(a.y << 16) + g1 * __uint_as_float(c.y << 16); v[j][3] += g0 * __uint_as_float(a.y & 0xffff0000u) + g1 * __uint_as_float(c.y & 0xffff0000u); }
            s += (v[j][0] + v[j][1]) + (v[j][2] + v[j][3]); }
        const float mean = wave_sum(s) * (1.0f / DM);
        float q = 0.f;
#pragma unroll
        for (int j = 0; j < 4; ++j) { v[j] -= mean; q += (v[j][0] * v[j][0] + v[j][1] * v[j][1]) + (v[j][2] * v[j][2] + v[j][3] * v[j][3]); }
        const float rstd = rsqrtf(wave_sum(q) * (1.0f / DM) + LN_EPS);
#pragma unroll
        for (int j = 0; j < 4; ++j) { v[j] = v[j] * rstd * gv[j] + bv[j];
            *(f32x4*)(dst + (size_t)tok * DM + j * 256 + lane * 4) = v[j];
            u32x2 w; w.x = cvt_pk_bf16(v[j][0], v[j][1]); w.y = cvt_pk_bf16(v[j][2], v[j][3]);
            *(u32x2*)(xb + (size_t)tok * DM + j * 256 + lane * 4) = w; }
    }
}

__device__ __forceinline__ void phase_resid_only(const Params& p, const float* X, int bid, int nb) {
    float* U = (float*)(p.ws + OFF_U);
    const size_t n4 = (size_t)NTOK * DM / 4;
    for (size_t i = (size_t)bid * 512 + threadIdx.x; i < n4; i += (size_t)nb * 512) *(f32x4*)(U + i * 4) = *(const f32x4*)(X + i * 4) * DN_ALPHA;
}

__device__ __forceinline__ void phase_moe_gateup(const Params& p, LAS unsigned char* lds, int bid, int nb, int layer) {
    unsigned char* ws = p.ws;
    LAS int* tab = (LAS int*)(lds + pg::STAGE_BYTES);
    pg::moe_build_units(tab, (const int*)(ws + OFF_MISC + MISC_CNT) + layer * 16, 2, nb, bid);
    pg::MoeSched<true> S; S.init(ws + OFF_BUF64, ws + OFF_WGU + (size_t)layer * 16 * 512 * 1024 * 2, (size_t)512 * 1024 * 2, (const int*)(ws + OFF_MISC + MISC_LIST), 1024, tab);
    pg::EpiSwiglu E; E.O = (bf16_t*)(ws + OFF_ACT);
    pg::gemm_phase(lds, 1024, S, E);
}
__device__ __forceinline__ void phase_moe_down(const Params& p, LAS unsigned char* lds, int bid, int nb, int layer) {
    unsigned char* ws = p.ws;
    LAS int* tab = (LAS int*)(lds + pg::STAGE_BYTES);
    pg::moe_build_units(tab, (const int*)(ws + OFF_MISC + MISC_CNT) + layer * 16, 4, nb, bid);
    pg::MoeSched<false> S; S.init(ws + OFF_ACT, ws + OFF_WD + (size_t)layer * 16 * 1024 * 256 * 2, (size_t)1024 * 256 * 2, nullptr, 256, tab);
    pg::EpiBf16 E; E.O = (bf16_t*)(ws + OFF_HE); E.ldc = 1024;
    pg::gemm_phase(lds, 256, S, E);
}

__device__ __forceinline__ void phase_gla_alpha(const Params& p, LAS unsigned char* lds, int bid, int nb) {
    const int tid = opaque_tid(), wid = tid >> 6, lane = tid & 63;
    LAS float* wT = (LAS float*)lds;
    for (int i = tid; i < 16 * 1024; i += 512) { const int e = i & 15, k = i >> 4; wT[e * 1024 + k] = p.in[I_WINE][(size_t)k * EVEN_COLS + NE_MAIN + e]; }
    __syncthreads();
    const float* x = p.in[I_X]; float* xa = (float*)(p.ws + OFF_U);
    for (int tok = bid * 8 + wid; tok < NTOK; tok += nb * 8) {
        f32x4 v[4];
        asm volatile("" ::: "memory");
#pragma unroll
        for (int j = 0; j < 4; ++j) v[j] = *(const f32x4*)(x + (size_t)tok * DM + j * 256 + lane * 4);
        float mine = 0.f;
#pragma unroll
        for (int e = 0; e < 16; ++e) { float a = 0.f;
#pragma unroll
            for (int j = 0; j < 4; ++j) { const f32x4 w = *(const LAS f32x4*)(wT + e * 1024 + j * 256 + lane * 4); a += (v[j][0] * w[0] + v[j][1] * w[1]) + (v[j][2] * w[2] + v[j][3] * w[3]); }
            a = wave_sum(a); if (lane == e) mine = a; }
        if (lane < 16) xa[(size_t)tok * 16 + lane] = mine;
    }
    __syncthreads();
}

template <int CTRL> __device__ __forceinline__ float dppf(float v) { return __builtin_bit_cast(float, __builtin_amdgcn_update_dpp(0, __builtin_bit_cast(int, v), CTRL, 0xf, 0xf, true)); }
__device__ __forceinline__ float red8(float v) { v += dppf<0xB1>(v); v += dppf<0x4E>(v); v += dppf<0x141>(v); return v; }

__device__ __forceinline__ void rwkv_item(const Params& p, LAS unsigned char* lds, int item) {
    constexpr int TC = 16;
    const int tid = opaque_tid(), lane = tid & 63, tg = tid >> 6;
    const int b = item >> 3, h = item & 7;
    const bf16_t* P0 = (const bf16_t*)(p.ws + OFF_P);
    bf16_t* mix = (bf16_t*)(p.ws + OFF_BUF64);
    LAS float* w2s = (LAS float*)lds;
    LAS float* a2s = w2s + 64 * 64;
    LAS float* g2s = a2s + 64 * 64;
    LAS float* tw = g2s + 128 * 64;
    LAS float* xa_s = tw + TC * 64;
    LAS float* sg = xa_s + TC * 64;
    LAS float* r_s = sg + TC * 128;
    LAS float* k_s = r_s + TC * 64;
    LAS float* v_s = k_s + TC * 64;
    LAS float* w_s = v_s + TC * 64;
    LAS float* kk_s = w_s + TC * 64;
    LAS float* kka_s = kk_s + TC * 64;
    LAS float* kh_s = kka_s + TC * 64;
    LAS float* g_s = kh_s + TC * 64;
    LAS float* y_s = g_s + TC * 64;
    LAS float* rk_s = y_s + TC * 64;
    const float* mu = p.in[I_AMU];
    for (int i = tid; i < 64 * 64; i += 512) { const int r = i >> 6, c = i & 63; w2s[i] = p.in[I_AW2][r * 512 + h * 64 + c]; a2s[i] = p.in[I_AA2][r * 512 + h * 64 + c]; }
    for (int i = tid; i < 128 * 64; i += 512) { const int r = i >> 6, c = i & 63; g2s[i] = p.in[I_AG2][r * 512 + h * 64 + c]; }
    const int j = lane;
    const float w0 = p.in[I_AW0][h * 64 + j], a0 = p.in[I_AA0][h * 64 + j], kksc = p.in[I_AKK][h * 64 + j], kasc = p.in[I_AKA][h * 64 + j], rkj = p.in[I_ARK][h * 64 + j];
    const float gng = p.in[I_AGNG][h * 64 + j], gnb = p.in[I_AGNB][h * 64 + j];
    float S[8];
#pragma unroll
    for (int i = 0; i < 8; ++i) S[i] = 0.f;
    const int row = tid >> 3, kq = tid & 7;
    __syncthreads();
    for (int t0 = 0; t0 < SEQ; t0 += TC) {
        for (int idx = tid; idx < TC * 448; idx += 512) {
            const int t = idx / 448, c = idx % 448; int col; LAS float* dst; int kind = 0;
            if (c < 64) { col = h * 64 + c; dst = r_s + t * 64 + c; }
            else if (c < 128) { col = 512 + h * 64 + (c - 64); dst = k_s + t * 64 + (c - 64); }
            else if (c < 192) { col = 1024 + h * 64 + (c - 128); dst = v_s + t * 64 + (c - 128); }
            else if (c < 256) { col = 1536 + (c - 192); dst = tw + t * 64 + (c - 192); kind = 1; }
            else if (c < 320) { col = 1600 + (c - 256); dst = xa_s + t * 64 + (c - 256); }
            else { col = 1664 + (c - 320); dst = sg + t * 128 + (c - 320); kind = 2; }
            const size_t n = (size_t)b * SEQ + t0 + t;
            const float cur = bf2f(P0[n * NE_MAIN + col]);
            const float prev = (t0 + t) > 0 ? bf2f(P0[(n - 1) * NE_MAIN + col]) : 0.f;
            float val = cur + (prev - cur) * mu[col];
            if (kind == 1) val = tanhf(val); else if (kind == 2) val = 1.0f / (1.0f + expf(-val));
            *dst = val;
        }
        __syncthreads();
#pragma unroll
        for (int tt = 0; tt < 2; ++tt) {
            const int t = tg + tt * 8;
            float aw = 0.f, aa = 0.f, ag = 0.f;
            asm volatile("" ::: "memory");
#pragma unroll 4
            for (int i = 0; i < 64; ++i) { aw += tw[t * 64 + i] * w2s[i * 64 + j]; aa += xa_s[t * 64 + i] * a2s[i * 64 + j]; }
            asm volatile("" ::: "memory");
#pragma unroll 4
            for (int i = 0; i < 128; ++i) ag += sg[t * 128 + i] * g2s[i * 64 + j];
            asm volatile("" ::: "memory");
            const float z = w0 + aw;
            const float sp = (-z > 20.f) ? -z : log1pf(expf(-z));
            const float wlog = -sp - 0.5f;
            const float decay = expf(-expf(wlog));
            const float a = 1.0f / (1.0f + expf(-(a0 + aa)));
            const float kraw = k_s[t * 64 + j];
            const float kkp = kraw * kksc;
            const float nrm = sqrtf(wave_sum(kkp * kkp));
            const float kk = kkp / fmaxf(nrm, 1e-12f);
            const float kh = kraw * (1.0f + (a - 1.0f) * kasc);
            const float rr = r_s[t * 64 + j];
            const float rk = wave_sum(rr * kh * rkj);
            w_s[t * 64 + j] = decay; kk_s[t * 64 + j] = kk; kka_s[t * 64 + j] = kk * a; kh_s[t * 64 + j] = kh; g_s[t * 64 + j] = ag;
            if (j == 0) rk_s[t] = rk;
        }
        __syncthreads();
        for (int t = 0; t < TC; ++t) {
            const f32x4 kk0 = *(const LAS f32x4*)(kk_s + t * 64 + kq * 8), kk1 = *(const LAS f32x4*)(kk_s + t * 64 + kq * 8 + 4);
            const f32x4 ww0 = *(const LAS f32x4*)(w_s + t * 64 + kq * 8), ww1 = *(const LAS f32x4*)(w_s + t * 64 + kq * 8 + 4);
            const f32x4 ka0 = *(const LAS f32x4*)(kka_s + t * 64 + kq * 8), ka1 = *(const LAS f32x4*)(kka_s + t * 64 + kq * 8 + 4);
            const f32x4 kh0 = *(const LAS f32x4*)(kh_s + t * 64 + kq * 8), kh1 = *(const LAS f32x4*)(kh_s + t * 64 + kq * 8 + 4);
            const f32x4 rr0 = *(const LAS f32x4*)(r_s + t * 64 + kq * 8), rr1 = *(const LAS f32x4*)(r_s + t * 64 + kq * 8 + 4);
            const float vv = v_s[t * 64 + row];
            float sa = 0.f;
#pragma unroll
            for (int i = 0; i < 4; ++i) { sa += S[i] * kk0[i]; sa += S[4 + i] * kk1[i]; }
            sa = red8(sa);
            float y = 0.f;
#pragma unroll
            for (int i = 0; i < 4; ++i) {
                S[i] = S[i] * ww0[i] - sa * ka0[i] + vv * kh0[i]; S[4 + i] = S[4 + i] * ww1[i] - sa * ka1[i] + vv * kh1[i];
                y += S[i] * rr0[i]; y += S[4 + i] * rr1[i]; }
            y = red8(y);
            if (kq == 0) y_s[t * 64 + row] = y;
        }
        __syncthreads();
#pragma unroll
        for (int tt = 0; tt < 2; ++tt) {
            const int t = tg + tt * 8;
            const float y = y_s[t * 64 + j];
            const float mean = wave_sum(y) * (1.0f / 64.0f);
            const float d = y - mean;
            const float var = wave_sum(d * d) * (1.0f / 64.0f);
            const float yn = d * rsqrtf(var + 64e-5f) * gng + gnb;
            const float o = (yn + rk_s[t] * v_s[t * 64 + j]) * g_s[t * 64 + j];
            mix[((size_t)b * SEQ + t0 + t) * DM + h * 64 + j] = f2bf(o);
        }
        __syncthreads();
    }
}

__device__ __forceinline__ void gla_item(const Params& p, LAS unsigned char* lds, int item) {
    const int tid = opaque_tid(), lane = tid & 63, tg = tid >> 6;
    const int b = item >> 2, h = item & 3;
    const bf16_t* P0 = (const bf16_t*)(p.ws + OFF_P) + 1792;
    const float* xa16 = (const float*)(p.ws + OFF_U);
    bf16_t* mix = (bf16_t*)(p.ws + OFF_BUF64);
    LAS float* qd = (LAS float*)lds;
    LAS float* ki = qd + 64 * 65;
    LAS float* att = ki + 64 * 65;
    LAS float* vs = att + 64 * 65;
    LAS float* St = vs + 64 * 128;
    LAS float* bl = St + 64 * 128;
    for (int i = tid; i < 64 * 128; i += 512) St[i] = 0.f;
    float gw2[16];
#pragma unroll
    for (int i = 0; i < 16; ++i) gw2[i] = p.in[I_BGW2][i * 256 + h * 64 + lane];
    const float gb = p.in[I_BGB][h * 64 + lane];
    const float* bng = p.in[I_BNG];
    __syncthreads();
    for (int c0 = 0; c0 < SEQ; c0 += 64) {
        const size_t n0 = (size_t)b * SEQ + c0;
        for (int tt = 0; tt < 8; ++tt) { const int c = tg * 8 + tt; float z = gb;
#pragma unroll
            for (int i = 0; i < 16; ++i) z += xa16[(n0 + c) * 16 + i] * gw2[i];
            const float ls = (z >= 0.f) ? -log1pf(expf(-z)) : (z - log1pf(expf(z)));
            att[c * 65 + lane] = ls * (1.0f / 16.0f); }
        for (int i = tid; i < 64 * 128; i += 512) { const int c = i >> 7, e = i & 127; vs[i] = bf2f(P0[(n0 + c) * NE_MAIN + 512 + h * 128 + e]); }
        __syncthreads();
        if (tid < 64) { float a = 0.f; for (int c = 0; c < 64; ++c) { a += att[c * 65 + tid]; att[c * 65 + tid] = a; } bl[tid] = a; }
        __syncthreads();
        for (int i = tid; i < 64 * 64; i += 512) { const int c = i >> 6, d = i & 63; const float bc = att[c * 65 + d];
            const float q = bf2f(P0[(n0 + c) * NE_MAIN + h * 64 + d]), k = bf2f(P0[(n0 + c) * NE_MAIN + 256 + h * 64 + d]);
            qd[c * 65 + d] = q * 0.125f * expf(bc); ki[c * 65 + d] = k * expf(-bc); }
        __syncthreads();
        { const int c = tid >> 3, sgp = tid & 7; float a[8];
#pragma unroll
            for (int i = 0; i < 8; ++i) a[i] = 0.f;
            for (int d = 0; d < 64; ++d) { const float qv = qd[c * 65 + d];
#pragma unroll
                for (int i = 0; i < 8; ++i) a[i] += qv * ki[(sgp * 8 + i) * 65 + d]; }
            __syncthreads();
#pragma unroll
            for (int i = 0; i < 8; ++i) att[c * 65 + sgp * 8 + i] = (sgp * 8 + i <= c) ? a[i] : 0.f; }
        __syncthreads();
        { const int c = tid >> 3, eg = tid & 7; float o[16];
#pragma unroll
            for (int i = 0; i < 16; ++i) o[i] = 0.f;
            for (int s = 0; s <= c; ++s) { const float a = att[c * 65 + s];
#pragma unroll
                for (int i = 0; i < 16; ++i) o[i] += a * vs[s * 128 + eg * 16 + i]; }
            for (int d = 0; d < 64; ++d) { const float qv = qd[c * 65 + d];
#pragma unroll
                for (int i = 0; i < 16; ++i) o[i] += qv * St[d * 128 + eg * 16 + i]; }
            float ss = 0.f;
#pragma unroll
            for (int i = 0; i < 16; ++i) ss += o[i] * o[i];
            ss = red8(ss);
            const float rs = rsqrtf(ss * (1.0f / 128.0f) + 1e-5f);
#pragma unroll
            for (int i = 0; i < 16; ++i) { const int e = eg * 16 + i; const float g = bf2f(P0[(n0 + c) * NE_MAIN + 1024 + h * 128 + e]);
                const float val = o[i] * rs * bng[h * 128 + e] * (g / (1.0f + expf(-g)));
                mix[(n0 + c) * DM + 512 + h * 128 + e] = f2bf(val); } }
        __syncthreads();
        { const int d = tid >> 3, eg = tid & 7; float a[16];
#pragma unroll
            for (int i = 0; i < 16; ++i) a[i] = St[d * 128 + eg * 16 + i];
            for (int c = 0; c < 64; ++c) { const float kv = ki[c * 65 + d];
#pragma unroll
                for (int i = 0; i < 16; ++i) a[i] += kv * vs[c * 128 + eg * 16 + i]; }
            const float eb = expf(bl[d]);
#pragma unroll
            for (int i = 0; i < 16; ++i) St[d * 128 + eg * 16 + i] = a[i] * eb; }
        __syncthreads();
    }
}

__device__ __forceinline__ void phase_mixer_even(const Params& p, LAS unsigned char* lds, int bid, int nb) {
    for (int item = bid; item < 96; item += nb) {
        if (item < 64) rwkv_item(p, lds, item); else gla_item(p, lds, item - 64);
        __syncthreads();
    }
}

__device__ __forceinline__ void phase_rope(const Params& p, int bid, int nb) {
    const int tid = opaque_tid(), wid = tid >> 6, lane = tid & 63;
    unsigned char* ws = p.ws;
    const bf16_t* Pd = (const bf16_t*)(ws + OFF_PD);
    bf16_t* qr = (bf16_t*)(ws + OFF_BUF64); bf16_t* kr = (bf16_t*)(ws + OFF_KR); bf16_t* vv = (bf16_t*)(ws + OFF_VV);
    bf16_t* iqr = (bf16_t*)(ws + OFF_IQR); bf16_t* ikr = (bf16_t*)(ws + OFF_IKR); float* iw = (float*)(ws + OFF_IW);
    const float* c64 = (const float*)(ws + OFF_ROPE); const float* s64 = c64 + 4096 * 64; const float* c32 = s64 + 4096 * 64; const float* s32 = c32 + 4096 * 32;
    const float ikg = p.in[I_CIKG][lane], ikb = p.in[I_CIKB][lane];
    for (int n = bid * 8 + wid; n < NTOK; n += nb * 8) {
        const int pos = n & (SEQ - 1);
        const bf16_t* row = Pd + (size_t)n * NO_MAIN;
        const float c = c64[pos * 64 + lane], s = s64[pos * 64 + lane];
#pragma unroll
        for (int h = 0; h < 8; ++h) { const float z1 = bf2f(row[h * 128 + lane]), z2 = bf2f(row[h * 128 + 64 + lane]);
            qr[(size_t)n * 1024 + h * 128 + lane] = f2bf((z1 * c - z2 * s) * 0.08838834764831845f);
            qr[(size_t)n * 1024 + h * 128 + 64 + lane] = f2bf((z2 * c + z1 * s) * 0.08838834764831845f); }
        { const float z1 = bf2f(row[1024 + lane]), z2 = bf2f(row[1024 + 64 + lane]);
            kr[(size_t)n * 128 + lane] = f2bf(z1 * c - z2 * s); kr[(size_t)n * 128 + 64 + lane] = f2bf(z2 * c + z1 * s); }
        vv[(size_t)n * 128 + lane] = row[1152 + lane]; vv[(size_t)n * 128 + 64 + lane] = row[1152 + 64 + lane];
        const int j32 = lane & 31; const float cc = c32[pos * 32 + j32], ss = s32[pos * 32 + j32];
#pragma unroll
        for (int r = 0; r < 2; ++r) { const int h = (lane >> 5) + 2 * r; const float z1 = bf2f(row[1280 + h * 64 + j32]), z2 = bf2f(row[1280 + h * 64 + 32 + j32]);
            iqr[(size_t)n * 256 + h * 64 + j32] = f2bf((z1 * cc - z2 * ss) * 0.125f); iqr[(size_t)n * 256 + h * 64 + 32 + j32] = f2bf((z2 * cc + z1 * ss) * 0.125f); }
        { const float x = bf2f(row[1536 + lane]); const float mean = wave_sum(x) * (1.0f / 64.0f); const float d = x - mean; const float var = wave_sum(d * d) * (1.0f / 64.0f);
            const float y = d * rsqrtf(var + LN_EPS) * ikg + ikb; const float o = __shfl_xor(y, 32);
            const float res = lane < 32 ? (y * cc - o * ss) : (y * cc + o * ss);
            ikr[(size_t)n * 64 + lane] = f2bf(res); }
        if (lane < 4) iw[(size_t)n * 4 + lane] = bf2f(row[1600 + lane]) * 0.5f;
    }
}

__device__ __forceinline__ void phase_index(const Params& p, LAS unsigned char* lds, int bid, int nb) {
    const int tid = opaque_tid(), wid = tid >> 6, lane = tid & 63;
    unsigned char* ws = p.ws;
    const bf16_t* iqr = (const bf16_t*)(ws + OFF_IQR); const bf16_t* ikr = (const bf16_t*)(ws + OFF_IKR); const float* iw = (const float*)(ws + OFF_IW);
    unsigned short* idx = (unsigned short*)(ws + OFF_IDX);
    LAS unsigned* sc = (LAS unsigned*)lds + wid * 4096;
    LAS int* hist = (LAS int*)(lds + 131072) + wid * 256;
    LAS float* iqs = (LAS float*)(lds + 131072 + 8192) + wid * 256;
    const unsigned long long lt_mask = (1ull << lane) - 1ull;
    for (int n = bid * 8 + wid; n < NTOK; n += nb * 8) {
        const int t = n & (SEQ - 1), b = n >> 12, nv = t + 1;
        unsigned short* out = idx + (size_t)n * 256;
        if (nv <= 256) { for (int j = lane; j < 256; j += 64) out[j] = (unsigned short)(j < nv ? j : 0); continue; }
#pragma unroll
        for (int j = 0; j < 4; ++j) iqs[lane * 4 + j] = bf2f(iqr[(size_t)n * 256 + lane * 4 + j]);
        const float w0 = iw[(size_t)n * 4 + 0], w1 = iw[(size_t)n * 4 + 1], w2 = iw[(size_t)n * 4 + 2], w3 = iw[(size_t)n * 4 + 3];
        const int nvp = (nv + 63) & ~63;
        for (int c0 = 0; c0 < nvp; c0 += 64) {
            const int key = c0 + lane; const bool valid = key < nv;
            float kf[64];
            const u32x4* kp = (const u32x4*)(ikr + ((size_t)b * SEQ + (valid ? key : 0)) * 64);
#pragma unroll
            for (int q = 0; q < 8; ++q) { const u32x4 w = kp[q];
                kf[q * 8 + 0] = __uint_as_float(w.x << 16); kf[q * 8 + 1] = __uint_as_float(w.x & 0xffff0000u); kf[q * 8 + 2] = __uint_as_float(w.y << 16); kf[q * 8 + 3] = __uint_as_float(w.y & 0xffff0000u);
                kf[q * 8 + 4] = __uint_as_float(w.z << 16); kf[q * 8 + 5] = __uint_as_float(w.z & 0xffff0000u); kf[q * 8 + 6] = __uint_as_float(w.w << 16); kf[q * 8 + 7] = __uint_as_float(w.w & 0xffff0000u); }
            float sh[4];
#pragma unroll
            for (int h = 0; h < 4; ++h) { float a = 0.f;
#pragma unroll
                for (int d4 = 0; d4 < 16; ++d4) { const f32x4 qv = *(const LAS f32x4*)(iqs + h * 64 + d4 * 4); a += qv[0] * kf[d4 * 4] + qv[1] * kf[d4 * 4 + 1] + qv[2] * kf[d4 * 4 + 2] + qv[3] * kf[d4 * 4 + 3]; }
                sh[h] = fmaxf(a, 0.f); }
            float score = sh[0] * w0 + sh[1] * w1 + sh[2] * w2 + sh[3] * w3;
            score += 0.0f;
            unsigned u = __float_as_uint(score); u = (u & 0x80000000u) ? ~u : (u | 0x80000000u);
            sc[key] = valid ? u : 0u;
        }
        unsigned prefix = 0; int need = 256;
#pragma unroll 1
        for (int pass = 3; pass >= 0; --pass) {
            const int shift = pass * 8;
#pragma unroll
            for (int j = 0; j < 4; ++j) hist[lane * 4 + j] = 0;
            for (int c0 = 0; c0 < nvp; c0 += 64) { const unsigned u = sc[c0 + lane];
                const bool match = (c0 + lane < nv) && (pass == 3 || (u >> (shift + 8)) == prefix);
                if (match) __hip_atomic_fetch_add(hist + ((u >> shift) & 255u), 1, __ATOMIC_RELAXED, __HIP_MEMORY_SCOPE_WORKGROUP); }
            int hb[4];
#pragma unroll
            for (int j = 0; j < 4; ++j) hb[j] = hist[lane * 4 + j];
            const int tot = hb[0] + hb[1] + hb[2] + hb[3];
            int suf = tot;
#pragma unroll
            for (int off = 1; off < 64; off <<= 1) { const int v = __shfl_down(suf, off); if (lane + off < 64) suf += v; }
            const int above = suf - tot;
            const bool is = (above < need) && (need <= suf);
            int bin = 0, nneed = 0;
            if (is) { int c = above;
#pragma unroll
                for (int k = 3; k >= 0; --k) { if (nneed == 0) { if (need <= c + hb[k]) { bin = lane * 4 + k; nneed = need - c; } else c += hb[k]; } } }
            const unsigned long long bal = __ballot(is);
            const int src = __ffsll((long long)bal) - 1;
            bin = __shfl(bin, src); nneed = __shfl(nneed, src);
            prefix = (prefix << 8) | (unsigned)bin; need = nneed;
        }
        const unsigned T = prefix;
        int base = 0, ties = 0;
        for (int c0 = 0; c0 < nvp; c0 += 64) { const int key = c0 + lane; const unsigned u = sc[key]; const bool valid = key < nv;
            const bool gt = valid && u > T, eq = valid && u == T;
            const unsigned long long beq = __ballot(eq);
            const int rank = ties + __popcll(beq & lt_mask);
            const bool take = gt || (eq && rank < need);
            const unsigned long long bt = __ballot(take);
            const int pos = base + __popcll(bt & lt_mask);
            if (take && pos < 256) out[pos] = (unsigned short)key;
            base += __popcll(bt); ties += __popcll(beq); }
    }
}

__device__ __forceinline__ void phase_attn(const Params& p, LAS unsigned char* lds, int bid, int nb) {
    const int tid = opaque_tid(), wid = tid >> 6, lane = tid & 63;
    unsigned char* ws = p.ws;
    const bf16_t* qr = (const bf16_t*)(ws + OFF_BUF64); const bf16_t* kr = (const bf16_t*)(ws + OFF_KR); const bf16_t* vv = (const bf16_t*)(ws + OFF_VV);
    const unsigned short* idx = (const unsigned short*)(ws + OFF_IDX);
    bf16_t* ao = (bf16_t*)(ws + OFF_PD);
    LAS float* qs = (LAS float*)lds + wid * 1024;
    LAS float* ps = (LAS float*)(lds + 32768) + wid * 2048;
    LAS int* ks = (LAS int*)(lds + 32768 + 65536) + wid * 256;
    for (int n = bid * 8 + wid; n < NTOK; n += nb * 8) {
        const int t = n & (SEQ - 1), b = n >> 12, cnt = (t + 1) < 256 ? (t + 1) : 256;
        asm volatile("" ::: "memory");
#pragma unroll
        for (int j = 0; j < 16; ++j) qs[j * 64 + lane] = bf2f(qr[(size_t)n * 1024 + j * 64 + lane]);
#pragma unroll
        for (int r = 0; r < 4; ++r) ks[r * 64 + lane] = idx[(size_t)n * 256 + r * 64 + lane];
#pragma unroll 1
        for (int r = 0; r < 4; ++r) {
            const int j = r * 64 + lane; const bool valid = j < cnt; const int key = valid ? ks[j] : 0;
            const u32x4* kp = (const u32x4*)(kr + ((size_t)b * SEQ + key) * 128);
            float kf[128];
#pragma unroll
            for (int q = 0; q < 16; ++q) { const u32x4 w = kp[q];
                kf[q * 8 + 0] = __uint_as_float(w.x << 16); kf[q * 8 + 1] = __uint_as_float(w.x & 0xffff0000u); kf[q * 8 + 2] = __uint_as_float(w.y << 16); kf[q * 8 + 3] = __uint_as_float(w.y & 0xffff0000u);
                kf[q * 8 + 4] = __uint_as_float(w.z << 16); kf[q * 8 + 5] = __uint_as_float(w.z & 0xffff0000u); kf[q * 8 + 6] = __uint_as_float(w.w << 16); kf[q * 8 + 7] = __uint_as_float(w.w & 0xffff0000u); }
#pragma unroll 1
            for (int h = 0; h < 8; ++h) { float a = 0.f;
#pragma unroll
                for (int d4 = 0; d4 < 32; ++d4) { const f32x4 qv = *(const LAS f32x4*)(qs + h * 128 + d4 * 4);
                    a += qv[0] * kf[d4 * 4] + qv[1] * kf[d4 * 4 + 1] + qv[2] * kf[d4 * 4 + 2] + qv[3] * kf[d4 * 4 + 3]; }
                ps[h * 256 + j] = valid ? a : -INFINITY; }
        }
#pragma unroll
        for (int h = 0; h < 8; ++h) { float x[4]; float m = -INFINITY;
#pragma unroll
            for (int r = 0; r < 4; ++r) { x[r] = ps[h * 256 + r * 64 + lane]; m = fmaxf(m, x[r]); }
#pragma unroll
            for (int o = 32; o > 0; o >>= 1) m = fmaxf(m, __shfl_xor(m, o));
            float s = 0.f;
#pragma unroll
            for (int r = 0; r < 4; ++r) { x[r] = expf(x[r] - m); s += x[r]; }
            s = wave_sum(s); const float inv = 1.0f / s;
#pragma unroll
            for (int r = 0; r < 4; ++r) ps[h * 256 + r * 64 + lane] = x[r] * inv; }
        float o0[8], o1[8];
#pragma unroll
        for (int h = 0; h < 8; ++h) { o0[h] = 0.f; o1[h] = 0.f; }
        for (int j = 0; j < cnt; ++j) { const int key = ks[j];
            const unsigned w = *(const unsigned*)(vv + ((size_t)b * SEQ + key) * 128 + 2 * lane);
            const float v0 = __uint_as_float(w << 16), v1 = __uint_as_float(w & 0xffff0000u);
#pragma unroll
            for (int h = 0; h < 8; ++h) { const float pj = ps[h * 256 + j]; o0[h] += pj * v0; o1[h] += pj * v1; } }
#pragma unroll
        for (int h = 0; h < 8; ++h) *(unsigned*)(ao + (size_t)n * 1024 + h * 128 + 2 * lane) = cvt_pk_bf16(o0[h], o1[h]);
    }
}

__device__ __forceinline__ int idx_bin(float s, float lo, float scale) { int b = (int)((s - lo) * scale); b = b < 0 ? 0 : b; return b > 255 ? 255 : b; }
__device__ __forceinline__ void phase_index2(const Params& p, LAS unsigned char* lds, int bid, int nb) {
    const int tid = opaque_tid(), wid = tid >> 6, lane = tid & 63, fr = lane & 15, g = lane >> 4;
    unsigned char* ws = p.ws;
    const bf16_t* iqr = (const bf16_t*)(ws + OFF_IQR); const bf16_t* ikr = (const bf16_t*)(ws + OFF_IKR); const float* iw = (const float*)(ws + OFF_IW);
    unsigned short* idx = (unsigned short*)(ws + OFF_IDX);
    LAS float* sc = (LAS float*)lds;
    LAS int* hist = (LAS int*)(lds + 131072) + wid * 256;
    LAS float* cand = (LAS float*)(lds + 131072 + 8192) + wid * 64;
    const unsigned long long lt_mask = (1ull << lane) - 1ull;
    for (int qt = bid; qt < NTOK / 8; qt += nb) {
        const int n0 = qt * 8, t0 = n0 & (SEQ - 1), b = n0 >> 12;
        asm volatile("" ::: "memory");
        if (t0 + 8 > 256) {
            bf16x8 af[2][2];
#pragma unroll
            for (int hh = 0; hh < 2; ++hh)
#pragma unroll
                for (int s = 0; s < 2; ++s) af[hh][s] = *(const bf16x8*)(iqr + (size_t)(n0 + (fr & 7)) * 256 + (2 * hh + (fr >> 3)) * 64 + s * 32 + g * 8);
            float w0[4], w1[4];
#pragma unroll
            for (int r = 0; r < 4; ++r) { const int q = 4 * (g & 1) + r; w0[r] = iw[(size_t)(n0 + q) * 4 + (g >> 1)]; w1[r] = iw[(size_t)(n0 + q) * 4 + 2 + (g >> 1)]; }
            const int nkt = (t0 + 8 + 15) >> 4;
            const bf16_t* kb = ikr + (size_t)b * SEQ * 64;
            for (int kt = wid; kt < nkt; kt += 8) {
                const bf16_t* kp = kb + (size_t)(kt * 16 + fr) * 64 + g * 8;
                const bf16x8 b0 = *(const bf16x8*)kp, b1 = *(const bf16x8*)(kp + 32);
                f32x4 d0 = (f32x4){0.f, 0.f, 0.f, 0.f}, d1 = (f32x4){0.f, 0.f, 0.f, 0.f};
                d0 = __builtin_amdgcn_mfma_f32_16x16x32_bf16(af[0][0], b0, d0, 0, 0, 0); d0 = __builtin_amdgcn_mfma_f32_16x16x32_bf16(af[0][1], b1, d0, 0, 0, 0);
                d1 = __builtin_amdgcn_mfma_f32_16x16x32_bf16(af[1][0], b0, d1, 0, 0, 0); d1 = __builtin_amdgcn_mfma_f32_16x16x32_bf16(af[1][1], b1, d1, 0, 0, 0);
#pragma unroll
                for (int r = 0; r < 4; ++r) { float v = fmaxf(d0[r], 0.f) * w0[r] + fmaxf(d1[r], 0.f) * w1[r]; v += __shfl_xor(v, 32); v += 0.0f;
                    if (g < 2) sc[(4 * g + r) * 4096 + kt * 16 + fr] = v; }
            }
        }
        __syncthreads();
        {
            const int n = n0 + wid, t = t0 + wid, nv = t + 1;
            unsigned short* out = idx + (size_t)n * 256;
            if (nv <= 256) { for (int j = lane; j < 256; j += 64) out[j] = (unsigned short)(j < nv ? j : 0); }
            else {
                LAS const float* srow = sc + wid * 4096;
                const int nvp = (nv + 63) & ~63;
                float lo, hi;
                { float mn = INFINITY, mx = -INFINITY;
                    for (int c0 = 0; c0 < nvp; c0 += 64) { const float s = srow[c0 + lane]; if (c0 + lane < nv) { mn = fminf(mn, s); mx = fmaxf(mx, s); } }
#pragma unroll
                    for (int o = 32; o > 0; o >>= 1) { mn = fminf(mn, __shfl_xor(mn, o)); mx = fmaxf(mx, __shfl_xor(mx, o)); }
                    lo = mn; hi = mx; }
                float lo1 = 0.f, sc1 = 0.f, lo2 = 0.f, sc2 = 0.f, lo3 = 0.f, sc3 = 0.f; int b1 = 0, b2 = 0, b3 = 0, nlev = 0;
                int m = nv, need = 256;
#define IDX_CLASSIFY(s, cls) do { cls = 1; \
                    if (nlev >= 1) { const int bb = idx_bin(s, lo1, sc1); if (bb != b1) cls = bb > b1 ? 2 : 0; } \
                    if (cls == 1 && nlev >= 2) { const int bb = idx_bin(s, lo2, sc2); if (bb != b2) cls = bb > b2 ? 2 : 0; } \
                    if (cls == 1 && nlev >= 3) { const int bb = idx_bin(s, lo3, sc3); if (bb != b3) cls = bb > b3 ? 2 : 0; } } while (0)
#pragma unroll 1
                while (m > 64 && nlev < 3 && (hi - lo) > 1e-30f) {
                    const float width = hi - lo, scale = 256.0f / width;
#pragma unroll
                    for (int j = 0; j < 4; ++j) hist[lane * 4 + j] = 0;
                    for (int c0 = 0; c0 < nvp; c0 += 64) { const float s = srow[c0 + lane]; int cls; IDX_CLASSIFY(s, cls);
                        if (c0 + lane < nv && cls == 1) __hip_atomic_fetch_add(hist + idx_bin(s, lo, scale), 1, __ATOMIC_RELAXED, __HIP_MEMORY_SCOPE_WORKGROUP); }
                    int hb[4];
#pragma unroll
                    for (int j = 0; j < 4; ++j) hb[j] = hist[lane * 4 + j];
                    const int tot = hb[0] + hb[1] + hb[2] + hb[3];
                    int suf = tot;
#pragma unroll
                    for (int off = 1; off < 64; off <<= 1) { const int v = __shfl_down(suf, off); if (lane + off < 64) suf += v; }
                    const int above = suf - tot;
                    const bool is = (above < need) && (need <= suf);
                    int bin = 0, nneed = 0, mm = 0;
                    if (is) { int c = above;
#pragma unroll
                        for (int k = 3; k >= 0; --k) { if (nneed == 0) { if (need <= c + hb[k]) { bin = lane * 4 + k; nneed = need - c; mm = hb[k]; } else c += hb[k]; } } }
                    const unsigned long long bal = __ballot(is);
                    const int srcl = __ffsll((long long)bal) - 1;
                    bin = __shfl(bin, srcl); nneed = __shfl(nneed, srcl); mm = __shfl(mm, srcl);
                    if (nlev == 0) { lo1 = lo; sc1 = scale; b1 = bin; } else if (nlev == 1) { lo2 = lo; sc2 = scale; b2 = bin; } else { lo3 = lo; sc3 = scale; b3 = bin; }
                    ++nlev; need = nneed; m = mm;
                    const float w = width * (1.0f / 256.0f); lo = lo + (float)bin * w; hi = lo + w;
                }
                float T = -INFINITY; int need_t = need; const bool exact = (m <= 64);
                if (exact) {
                    int base = 0;
                    for (int c0 = 0; c0 < nvp; c0 += 64) { const float s = srow[c0 + lane]; int cls; IDX_CLASSIFY(s, cls);
                        const bool isc = (c0 + lane < nv) && cls == 1; const unsigned long long bc = __ballot(isc);
                        if (isc) { const int pos = base + __popcll(bc & lt_mask); if (pos < 64) cand[pos] = s; }
                        base += __popcll(bc); }
                    const float mine = lane < m ? cand[lane] : -INFINITY;
                    int cgt = 0, cge = 0;
                    for (int j = 0; j < m; ++j) { const float vj = cand[j]; cgt += vj > mine ? 1 : 0; cge += vj >= mine ? 1 : 0; }
                    const bool isT = (lane < m) && (cgt < need) && (need <= cge);
                    const unsigned long long bT = __ballot(isT);
                    const int sl = __ffsll((long long)bT) - 1;
                    T = __shfl(mine, sl); need_t = need - __shfl(cgt, sl);
                }
                int base = 0, ties = 0;
                for (int c0 = 0; c0 < nvp; c0 += 64) { const int key = c0 + lane; const float s = srow[key]; const bool valid = key < nv; int cls; IDX_CLASSIFY(s, cls);
                    const bool sure = valid && (cls == 2 || (cls == 1 && exact && s > T));
                    const bool tie = valid && cls == 1 && (exact ? (s == T) : true);
                    const unsigned long long beq = __ballot(tie);
                    const int rank = ties + __popcll(beq & lt_mask);
                    const bool take = sure || (tie && rank < need_t);
                    const unsigned long long bt = __ballot(take);
                    const int pos = base + __popcll(bt & lt_mask);
                    if (take && pos < 256) out[pos] = (unsigned short)key;
                    base += __popcll(bt); ties += __popcll(beq); }
#undef IDX_CLASSIFY
            }
        }
        __syncthreads();
    }
}

typedef short s16x4 __attribute__((ext_vector_type(4)));
__device__ __forceinline__ void phase_attn2(const Params& p, LAS unsigned char* lds, int bid, int nb) {
    const int tid = opaque_tid(), wid = tid >> 6, lane = tid & 63, fr = lane & 15, g = lane >> 4;
    unsigned char* ws = p.ws;
    const bf16_t* qr = (const bf16_t*)(ws + OFF_BUF64); const bf16_t* kr = (const bf16_t*)(ws + OFF_KR); const bf16_t* vv = (const bf16_t*)(ws + OFF_VV);
    const unsigned short* idx = (const unsigned short*)(ws + OFF_IDX);
    bf16_t* ao = (bf16_t*)(ws + OFF_PD);
    LAS unsigned char* vbuf = lds + wid * 16384;
    LAS unsigned short* ks = (LAS unsigned short*)(lds + 131072) + wid * 256;
    const int q4 = fr >> 2, p4 = fr & 3;
    for (int n = bid * 8 + wid; n < NTOK; n += nb * 8) {
        const int t = n & (SEQ - 1), b = n >> 12, cnt = (t + 1) < 256 ? (t + 1) : 256;
        asm volatile("" ::: "memory");
        *(LAS u32x2*)(ks + lane * 4) = *(const u32x2*)(idx + (size_t)n * 256 + lane * 4);
        bf16x8 qf[4];
#pragma unroll
        for (int s = 0; s < 4; ++s) { qf[s] = (bf16x8){0, 0, 0, 0, 0, 0, 0, 0}; if (fr < 8) qf[s] = *(const bf16x8*)(qr + (size_t)n * 1024 + fr * 128 + s * 32 + g * 8); }
        const bf16_t* kbase = kr + (size_t)b * SEQ * 128; const bf16_t* vbase = vv + (size_t)b * SEQ * 128;
        f32x4 acc[16];
#pragma unroll
        for (int tl = 0; tl < 16; ++tl) {
            const int j = tl * 16 + fr; const int key = j < cnt ? (int)ks[j] : 0;
            const bf16_t* kp = kbase + (size_t)key * 128 + g * 8;
            bf16x8 kf[4];
#pragma unroll
            for (int s = 0; s < 4; ++s) kf[s] = *(const bf16x8*)(kp + s * 32);
            f32x4 a = (f32x4){0.f, 0.f, 0.f, 0.f};
#pragma unroll
            for (int s = 0; s < 4; ++s) a = __builtin_amdgcn_mfma_f32_16x16x32_bf16(kf[s], qf[s], a, 0, 0, 0);
            acc[tl] = a;
        }
        float m = -INFINITY;
#pragma unroll
        for (int tl = 0; tl < 16; ++tl)
#pragma unroll
            for (int r = 0; r < 4; ++r) { if (tl * 16 + g * 4 + r >= cnt) acc[tl][r] = -INFINITY; m = fmaxf(m, acc[tl][r]); }
        m = fmaxf(m, __shfl_xor(m, 16)); m = fmaxf(m, __shfl_xor(m, 32));
        float sum = 0.f;
#pragma unroll
        for (int tl = 0; tl < 16; ++tl)
#pragma unroll
            for (int r = 0; r < 4; ++r) { const float e = __expf(acc[tl][r] - m); acc[tl][r] = e; sum += e; }
        sum += __shfl_xor(sum, 16); sum += __shfl_xor(sum, 32);
        const float inv = 1.0f / sum;
        bf16x8 pf[8];
#pragma unroll
        for (int s = 0; s < 8; ++s) { u32x4 w; w.x = cvt_pk_bf16(acc[2 * s][0], acc[2 * s][1]); w.y = cvt_pk_bf16(acc[2 * s][2], acc[2 * s][3]);
            w.z = cvt_pk_bf16(acc[2 * s + 1][0], acc[2 * s + 1][1]); w.w = cvt_pk_bf16(acc[2 * s + 1][2], acc[2 * s + 1][3]); pf[s] = __builtin_bit_cast(bf16x8, w); }
        f32x4 o[8];
#pragma unroll
        for (int dt = 0; dt < 8; ++dt) o[dt] = (f32x4){0.f, 0.f, 0.f, 0.f};
#pragma unroll
        for (int s = 0; s < 8; ++s) {
            LAS unsigned char* vb = vbuf + (s & 1) * 8192;
#pragma unroll
            for (int i = 0; i < 8; ++i) { const int kl = i * 4 + g, cp = fr; const int jj = s * 32 + kl; const int key = jj < cnt ? (int)ks[jj] : 0;
                const int c = cp ^ ((kl & 7) << 1);
                const u32x4 val = *(const u32x4*)(vbase + (size_t)key * 128 + c * 8);
                *(LAS u32x4*)(vb + kl * 256 + cp * 16) = val; }
            const int kl1 = 4 * g + q4, kl2 = 16 + 4 * g + q4;
#pragma unroll
            for (int dt = 0; dt < 8; ++dt) {
                const int c = 2 * dt + (p4 >> 1);
                const s16x4 lo = __builtin_amdgcn_ds_read_tr16_b64_v4i16((LAS s16x4*)(vb + kl1 * 256 + ((c ^ ((kl1 & 7) << 1)) * 16) + (p4 & 1) * 8));
                const s16x4 hi = __builtin_amdgcn_ds_read_tr16_b64_v4i16((LAS s16x4*)(vb + kl2 * 256 + ((c ^ ((kl2 & 7) << 1)) * 16) + (p4 & 1) * 8));
                const bf16x8 af = (bf16x8){lo[0], lo[1], lo[2], lo[3], hi[0], hi[1], hi[2], hi[3]};
                o[dt] = __builtin_amdgcn_mfma_f32_16x16x32_bf16(af, pf[s], o[dt], 0, 0, 0);
            }
        }
        if (fr < 8) {
#pragma unroll
            for (int dt = 0; dt < 8; ++dt) { u32x2 w; w.x = cvt_pk_bf16(o[dt][0] * inv, o[dt][1] * inv); w.y = cvt_pk_bf16(o[dt][2] * inv, o[dt][3] * inv);
                *(u32x2*)(ao + (size_t)n * 1024 + fr * 128 + dt * 16 + g * 4) = w; }
        }
    }
}

__device__ __forceinline__ void phase_inproj_even(const Params& p, LAS unsigned char* lds, int bid, int nb) {
    unsigned char* ws = p.ws;
    pg::DenseSched S; S.init(ws + OFF_BUF64, ws + OFF_WINE, NTOK, NE_MAIN, 1024, nb, bid);
    pg::EpiBf16 E; E.O = (bf16_t*)(ws + OFF_P); E.ldc = NE_MAIN;
    pg::gemm_phase(lds, 1024, S, E);
}
__device__ __forceinline__ void phase_inproj_odd(const Params& p, LAS unsigned char* lds, int bid, int nb) {
    unsigned char* ws = p.ws;
    pg::DenseSched S; S.init(ws + OFF_BUF64, ws + OFF_WINO, NTOK, NO_MAIN, 1024, nb, bid);
    pg::EpiBf16 E; E.O = (bf16_t*)(ws + OFF_PD); E.ldc = NO_MAIN;
    pg::gemm_phase(lds, 1024, S, E);
}
__device__ __forceinline__ void phase_outproj(const Params& p, LAS unsigned char* lds, int bid, int nb, size_t aoff, size_t woff, const float* X) {
    unsigned char* ws = p.ws;
    pg::DenseSched S; S.init(ws + aoff, ws + woff, NTOK, 1024, 1024, nb, bid);
    pg::EpiResid E; E.X = X; E.U = (float*)(ws + OFF_U);
    pg::gemm_phase(lds, 1024, S, E);
}

#ifndef DUP
#define DUP 0
#endif
#define GSYNC() grid.sync()
__global__ __launch_bounds__(512, 2) void mega(KArgs a) {
    extern __shared__ __attribute__((aligned(16))) unsigned char smem[];
    LAS unsigned char* lds = (LAS unsigned char*)smem;
    Params p; p.in.t = (LAS const unsigned long long*)(lds + PTAB_OFF); p.out = a.out; p.ws = a.ws;
    if ((threadIdx.x & 63) == 0) ((LAS int*)(lds + WTAB_OFF))[hw_slot()] = threadIdx.x >> 6;
    if (threadIdx.x == 0) { LAS unsigned long long* tw_ = (LAS unsigned long long*)(lds + PTAB_OFF);
#pragma unroll
        for (int i = 0; i < 30; ++i) tw_[i] = (unsigned long long)a.in[i]; }
    __syncthreads();
    cg::grid_group grid = cg::this_grid();
    const int bid0 = blockIdx.x, nb0 = gridDim.x;
    int bid, nb;
#define FRESH() do { bid = bid0; nb = nb0; asm volatile("" : "+s"(bid), "+s"(nb)); } while (0)
    FRESH(); phase_prep(p, lds, bid, nb);
    GSYNC();
#pragma unroll 1
    for (int layer = 0; layer < 2; ++layer) {
        if (layer == 0) {
            FRESH(); phase_inproj_even(p, lds, bid, nb);
            FRESH(); phase_gla_alpha(p, lds, bid, nb);
            GSYNC();
            FRESH(); phase_mixer_even(p, lds, bid, nb);
            GSYNC();
#if DUP == 1
            FRESH(); phase_mixer_even(p, lds, bid, nb);
            GSYNC();
#endif
        } else {
            FRESH(); phase_inproj_odd(p, lds, bid, nb);
            GSYNC();
            FRESH(); phase_rope(p, bid, nb);
            GSYNC();
            FRESH(); phase_index2(p, lds, bid, nb);
            GSYNC();
#if DUP == 2
            FRESH(); phase_index2(p, lds, bid, nb);
            GSYNC();
#endif
            FRESH(); phase_attn2(p, lds, bid, nb);
            GSYNC();
#if DUP == 3
            FRESH(); phase_attn2(p, lds, bid, nb);
            GSYNC();
#endif
        }
        FRESH(); phase_outproj(p, lds, bid, nb, layer ? OFF_PD : OFF_BUF64, layer ? OFF_WOUTO : OFF_WOUTE, layer ? p.out : p.in[I_X]);
        GSYNC();
        FRESH(); phase_ln_route(p, lds, bid, nb, layer);
        GSYNC();
        FRESH(); phase_moe_gateup(p, lds, bid, nb, layer);
        GSYNC();
        FRESH(); phase_moe_down(p, lds, bid, nb, layer);
        GSYNC();
        FRESH(); phase_ln2(p, bid, nb, layer, p.out, true);
        GSYNC();
    }
}

extern "C" void kernel_launch(void* const* d_in, const int* in_sizes, int n_in, void* d_out, int out_size, void* d_ws, size_t ws_size, hipStream_t stream) {
    if (ws_size < WS_NEED) { fprintf(stderr, "workspace too small: %zu < %zu\n", ws_size, (size_t)WS_NEED); return; }
    KArgs p{};
    for (int i = 0; i < 30; ++i) p.in[i] = (const float*)d_in[i];
    p.out = (float*)d_out; p.ws = (unsigned char*)d_ws;
    static int grid_blocks = 0;
    if (!grid_blocks) {
        (void)hipFuncSetAttribute((const void*)mega, hipFuncAttributeMaxDynamicSharedMemorySize, LDS_BYTES);
        int dev = 0, cus = 0, per_cu = 0;
        (void)hipGetDevice(&dev);
        (void)hipDeviceGetAttribute(&cus, hipDeviceAttributeMultiprocessorCount, dev);
        (void)hipOccupancyMaxActiveBlocksPerMultiprocessor(&per_cu, mega, 512, LDS_BYTES);
        if (per_cu < 1) { fprintf(stderr, "occupancy query returned %d\n", per_cu); per_cu = 1; }
        grid_blocks = cus;
    }
    void* args[] = {&p};
    hipError_t e = hipLaunchCooperativeKernel((void*)mega, dim3(grid_blocks), dim3(512), args, LDS_BYTES, stream);
    if (e != hipSuccess) fprintf(stderr, "cooperative launch failed: %s (grid %d)\n", hipGetErrorString(e), grid_blocks);
}
```

```cpp
#include <hip/hip_runtime.h>
#include <hip/hip_cooperative_groups.h>
#include <cstdio>
#include <cstdint>
namespace cg = cooperative_groups;

#ifndef PREP_REP
#define PREP_REP 1
#endif
constexpr int NTOK = 32768, SEQ = 4096, NB = 8, DM = 1024;
constexpr int EVEN_COLS = 3344, ODD_COLS = 1604;
constexpr int NE_MAIN = 3328;
constexpr int NO_MAIN = 1792;
constexpr int NEXP = 16, DEXP = 256;
constexpr float DN_ALPHA = 1.4142135623730951f;
constexpr float LN_EPS = 1e-5f;
constexpr int MOE_ROWS = 65536 + 16 * 256;

typedef unsigned short bf16_t;
typedef short bf16x8 __attribute__((ext_vector_type(8)));
typedef float f32x4 __attribute__((ext_vector_type(4)));
typedef short s16x4 __attribute__((ext_vector_type(4)));
typedef float f32x2 __attribute__((ext_vector_type(2)));
typedef unsigned u32x4 __attribute__((ext_vector_type(4)));
typedef unsigned u32x2 __attribute__((ext_vector_type(2)));
#define LAS __attribute__((address_space(3)))

__device__ __forceinline__ unsigned cvt_pk_bf16(float lo, float hi) { unsigned r; asm volatile("v_cvt_pk_bf16_f32 %0, %1, %2" : "=v"(r) : "v"(lo), "v"(hi)); return r; }
__device__ __forceinline__ bf16_t f2bf(float f) { return (bf16_t)(cvt_pk_bf16(f, 0.f) & 0xffffu); }
__device__ __forceinline__ float bf2f(bf16_t h) { return __uint_as_float(((unsigned)h) << 16); }
constexpr int LDS_BYTES = 160 * 1024;
constexpr int PTAB_OFF = LDS_BYTES - 256;
constexpr int WTAB_OFF = LDS_BYTES - 512;
__device__ __forceinline__ int hw_slot() { return (int)(__builtin_amdgcn_s_getreg(0x2804) & 63u); }
__device__ __forceinline__ int opaque_tid() {
    extern __shared__ __attribute__((aligned(16))) unsigned char smem_[];
    const int w = __builtin_amdgcn_readfirstlane(((LAS const int*)((LAS unsigned char*)smem_ + WTAB_OFF))[hw_slot()]);
    int l; asm volatile("v_mbcnt_lo_u32_b32 %0, -1, 0\n\tv_mbcnt_hi_u32_b32 %0, -1, %0" : "=v"(l));
    return (w << 6) | l; }
__device__ __forceinline__ float wave_sum(float v) {
#pragma unroll
    for (int o = 32; o > 0; o >>= 1) v += __shfl_xor(v, o);
    return v;
}

constexpr size_t MiB = 1024ull * 1024ull;
constexpr size_t OFF_WINE = 0;
constexpr size_t OFF_WOUTE = OFF_WINE + (size_t)NE_MAIN * 1024 * 2;
constexpr size_t OFF_WINO = OFF_WOUTE + 2 * MiB;
constexpr size_t OFF_WOUTO = OFF_WINO + (size_t)NO_MAIN * 1024 * 2;
constexpr size_t OFF_WGU = OFF_WOUTO + 2 * MiB;
constexpr size_t OFF_WD = OFF_WGU + 32 * MiB;
constexpr size_t OFF_ROPE = OFF_WD + 16 * MiB;
constexpr size_t OFF_MISC = OFF_ROPE + 3 * MiB;
constexpr size_t OFF_BUF64 = OFF_MISC + 4 * MiB;
constexpr size_t OFF_P = OFF_BUF64 + 64 * MiB;
constexpr size_t OFF_U = OFF_P + 208 * MiB;
constexpr size_t WS_NEED = OFF_U + 128 * MiB;
constexpr size_t OFF_HE = OFF_P;
constexpr size_t OFF_ACT = OFF_HE + (size_t)MOE_ROWS * 1024 * 2;
constexpr size_t OFF_PD = OFF_P;
constexpr size_t OFF_KR = OFF_P + 112 * MiB;
constexpr size_t OFF_VV = OFF_KR + 8 * MiB;
constexpr size_t OFF_IQR = OFF_VV + 8 * MiB;
constexpr size_t OFF_IKR = OFF_IQR + 16 * MiB;
constexpr size_t OFF_IW = OFF_IKR + 4 * MiB;
constexpr size_t OFF_IDX = OFF_IW + 1 * MiB;
constexpr size_t MISC_CNT = 0;
constexpr size_t MISC_TOKINFO = 4096;
constexpr size_t MISC_TOKGATE = MISC_TOKINFO + (size_t)NTOK * 16;
constexpr size_t MISC_LIST = MISC_TOKGATE + (size_t)NTOK * 8;
constexpr size_t MISC_BAR = 2048;
constexpr size_t MISC_W2T = 3 * MiB;
constexpr size_t MISC_A2T = MISC_W2T + 65536;
constexpr size_t MISC_G2T = MISC_A2T + 65536;

struct InTab { LAS const unsigned long long* t;
    __device__ __forceinline__ const float* operator[](int i) const { const unsigned long long v = t[i];
        const unsigned lo = __builtin_amdgcn_readfirstlane((unsigned)v), hi = __builtin_amdgcn_readfirstlane((unsigned)(v >> 32));
        return (const float*)(((unsigned long long)hi << 32) | lo); } };
struct Params { InTab in; float* out; unsigned char* ws; };
struct KArgs { const float* in[30]; float* out; unsigned char* ws; };
enum { I_X = 0, I_WINE, I_AMU, I_AW0, I_AW2, I_AA0, I_AA2, I_AG2, I_AKK, I_AKA, I_ARK, I_AGNG, I_AGNB, I_BGW2, I_BGB, I_BNG, I_WOUTE,
       I_WINO, I_CIKG, I_CIKB, I_WOUTO, I_LN1G, I_LN1B, I_LN2G, I_LN2B, I_RW, I_RB, I_EG, I_EU, I_ED };

namespace pg {
constexpr int BM = 256, BK = 64, HALF = 128, HTB = HALF * BK * 2, STAGE_BYTES = 8 * HTB;
__host__ __device__ __forceinline__ int lds_byte(int r, int c) { const int st = (r >> 4) * 2 + (c >> 5), rr = r & 15, cc = c & 31, ob = rr * 64 + cc * 2; return st * 1024 + (ob ^ (((ob >> 9) & 1) << 5)); }
__host__ __device__ __forceinline__ void stage_rc(int b, int& R, int& C) { const int st = b / 1024, sb = b % 1024, swz = sb ^ (((sb >> 9) & 1) << 5); R = (st >> 1) * 16 + swz / 64; C = (st & 1) * 32 + (swz % 64) / 2; }
__host__ __device__ __forceinline__ int perm32(int rho) { const int n = rho >> 4, i = rho & 15; return 8 * (i >> 2) + 4 * n + (i & 3); }

struct Unit { int pm, pn, e, rt, cnt; };

template <class Epi, class Sched>
__device__ __forceinline__ void gemm_phase(LAS unsigned char* lds, const int K, const Sched& S, const Epi& E) {
    const int tid = opaque_tid(), wid = __builtin_amdgcn_readfirstlane(tid >> 6), lane = tid & 63, wr = wid >> 2, wc = wid & 3, fr = lane & 15, fq = lane >> 4;
    const int nt = K / BK;
    unsigned voffB[2];
#pragma unroll
    for (int i = 0; i < 2; ++i) { int R, C; stage_rc(tid * 16 + i * 8192, R, C); const int Rb = Epi::PERM ? ((R & ~31) + perm32(R & 31)) : R; voffB[i] = (unsigned)(Rb * K + C) * 2u; }
    const size_t kstep = (size_t)(BK * 2);
    const size_t hstepB = (size_t)HALF * K * 2;
    const unsigned ldsw = (unsigned)wid * 1024u;
    const int aoff = lds_byte(wr * 64 + fr, fq * 8), boff = lds_byte(wc * 32 + fr, fq * 8);
#define PG_SA(b, h) (((b) * 2 + (h)) * HTB)
#define PG_SB(b, h) ((4 + (b) * 2 + (h)) * HTB)
#define PG_STAGE(bufoff, gbase, voff) do { _Pragma("unroll") for (int _i = 0; _i < 2; ++_i) \
        __builtin_amdgcn_global_load_lds((const unsigned*)((const char*)(gbase) + (voff)[_i]), (LAS unsigned*)(lds + (bufoff) + ldsw + _i * 8192), 16, 0, 0); } while (0)
#define PG_LDA(dst, b, h) do { _Pragma("unroll") for (int m = 0; m < 4; ++m) _Pragma("unroll") for (int k = 0; k < 2; ++k) dst[m][k] = *(const LAS bf16x8*)(lds + PG_SA(b, h) + aoff + m * 2048 + k * 1024); } while (0)
#define PG_LDB(dst, b, h) do { _Pragma("unroll") for (int n = 0; n < 2; ++n) _Pragma("unroll") for (int k = 0; k < 2; ++k) dst[n][k] = *(const LAS bf16x8*)(lds + PG_SB(b, h) + boff + n * 2048 + k * 1024); } while (0)
#define PG_MMA(ai, bj, At, Bt) do { __builtin_amdgcn_s_setprio(1); _Pragma("unroll") for (int m = 0; m < 4; ++m) _Pragma("unroll") for (int n = 0; n < 2; ++n) _Pragma("unroll") for (int k = 0; k < 2; ++k) \
        acc[ai][bj][m][n] = __builtin_amdgcn_mfma_f32_16x16x32_bf16(Bt[n][k], At[m][k], acc[ai][bj][m][n], 0, 0, 0); __builtin_amdgcn_s_setprio(0); } while (0)
#define PG_WAIT_V(n) asm volatile("s_waitcnt vmcnt(" #n ")" ::: "memory")
#define PG_WAIT_L(n) asm volatile("s_waitcnt lgkmcnt(" #n ")" ::: "memory")
#define PG_BAR __builtin_amdgcn_s_barrier()
#define PG_SCHED __builtin_amdgcn_sched_barrier(0)
#define PG_AOFF(dst0, dst1, u) do { _Pragma("unroll") for (int _i = 0; _i < 2; ++_i) { int _R, _C; stage_rc(tid * 16 + _i * 8192, _R, _C); \
        dst0[_i] = S.a_rowoff(u, 0, _R) + (unsigned)_C * 2u; dst1[_i] = S.a_rowoff(u, 1, _R) + (unsigned)_C * 2u; } } while (0)
    Unit cur, nxt; int ui = 0;
    if (!S.next(0, cur)) return;
    f32x4 acc[2][2][4][2];
#pragma unroll
    for (int a = 0; a < 2; ++a)
#pragma unroll
        for (int b = 0; b < 2; ++b)
#pragma unroll
            for (int m = 0; m < 4; ++m)
#pragma unroll
                for (int n = 0; n < 2; ++n) acc[a][b][m][n] = (f32x4){0.f, 0.f, 0.f, 0.f};
    bf16x8 At[4][2], B0[2][2], B1[2][2];
    const char* const Ab = S.a_base();
    unsigned aC0[2], aC1[2];
    PG_AOFF(aC0, aC1, cur);
    const char* cB = S.b_ptr(cur);
    PG_STAGE(PG_SB(0, 0), cB, voffB); PG_STAGE(PG_SA(0, 0), Ab, aC0); PG_STAGE(PG_SB(0, 1), cB + hstepB, voffB); PG_STAGE(PG_SA(0, 1), Ab, aC1);
    if (wr == 1) PG_BAR;
    PG_WAIT_V(4); PG_BAR;
    PG_STAGE(PG_SB(1, 0), cB + kstep, voffB); PG_STAGE(PG_SA(1, 0), Ab + kstep, aC0); PG_STAGE(PG_SB(1, 1), cB + hstepB + kstep, voffB);
    PG_WAIT_V(6); PG_BAR;
    for (;;) {
        const bool has_next = S.next(ui + 1, nxt);
        const char* nB = has_next ? S.b_ptr(nxt) : cB;
#pragma unroll 1
        for (int t = 0; t < nt; t += 2) {
            const bool last = (t == nt - 2);
            const char* a1 = Ab + (size_t)(t + 1) * kstep;
            const char* a2 = last ? Ab : Ab + (size_t)(t + 2) * kstep; const char* b2 = last ? nB : cB + (size_t)(t + 2) * kstep;
            const char* a3 = a2 + kstep; const char* b3 = b2 + kstep;
            PG_LDB(B0, 0, 0); PG_SCHED; PG_LDA(At, 0, 0); PG_STAGE(PG_SA(1, 1), a1, aC1);
            if (last && has_next) PG_AOFF(aC0, aC1, nxt);
            PG_WAIT_L(8); PG_BAR; PG_WAIT_L(0); PG_MMA(0, 0, At, B0); PG_BAR; PG_SCHED;
            PG_LDB(B1, 0, 1); PG_STAGE(PG_SB(0, 0), b2, voffB);
            PG_BAR; PG_WAIT_L(0); PG_MMA(0, 1, At, B1); PG_BAR;
            PG_LDA(At, 0, 1); PG_STAGE(PG_SA(0, 0), a2, aC0);
            PG_BAR; PG_WAIT_L(0); PG_MMA(1, 0, At, B0); PG_BAR; PG_SCHED;
            PG_STAGE(PG_SB(0, 1), b2 + hstepB, voffB);
            PG_WAIT_V(6); PG_BAR; PG_MMA(1, 1, At, B1); PG_BAR;
            PG_LDB(B0, 1, 0); PG_SCHED; PG_LDA(At, 1, 0); PG_STAGE(PG_SA(0, 1), a2, aC1);
            PG_WAIT_L(8); PG_BAR; PG_WAIT_L(0); PG_MMA(0, 0, At, B0); PG_BAR; PG_SCHED;
            PG_LDB(B1, 1, 1); PG_STAGE(PG_SB(1, 0), b3, voffB);
            PG_BAR; PG_WAIT_L(0); PG_MMA(0, 1, At, B1); PG_BAR;
            PG_LDA(At, 1, 1); PG_STAGE(PG_SA(1, 0), a3, aC0);
            PG_BAR; PG_WAIT_L(0); PG_MMA(1, 0, At, B0); PG_BAR; PG_SCHED;
            PG_STAGE(PG_SB(1, 1), b3 + hstepB, voffB);
            PG_WAIT_V(6); PG_BAR; PG_MMA(1, 1, At, B1); PG_BAR;
        }
        E(acc, cur, wr, wc, fr, fq);
        if (!has_next) break;
#pragma unroll
        for (int a = 0; a < 2; ++a)
#pragma unroll
            for (int b = 0; b < 2; ++b)
#pragma unroll
                for (int m = 0; m < 4; ++m)
#pragma unroll
                    for (int n = 0; n < 2; ++n) acc[a][b][m][n] = (f32x4){0.f, 0.f, 0.f, 0.f};
        cur = nxt; cB = nB; ++ui;
    }
    PG_WAIT_V(0);
    if (wr == 0) PG_BAR;
    PG_BAR;
#undef PG_SA
#undef PG_SB
#undef PG_STAGE
#undef PG_LDA
#undef PG_LDB
#undef PG_MMA
#undef PG_WAIT_V
#undef PG_WAIT_L
#undef PG_BAR
#undef PG_SCHED
#undef PG_AOFF
}

struct DenseSched {
    const char* A; const char* Bt; int K, nM, nN, nwg, G, c;
    __device__ void init(const void* A_, const void* Bt_, int M, int N, int K_, int G_, int c_) { A = (const char*)A_; Bt = (const char*)Bt_; K = K_; nM = M / BM; nN = N / BM; nwg = nM * nN; G = G_; c = c_; }
    __device__ __forceinline__ bool next(int i, Unit& u) const {
        const long L = (long)i * G + c; if (L >= nwg) return false;
        int wgid = (int)L; { const int q = nwg / 8, r = nwg % 8, xcd = wgid % 8, off = wgid / 8; wgid = (xcd < r ? xcd * (q + 1) : r * (q + 1) + (xcd - r) * q) + off; }
        const int nig = 8 * nN, gid = wgid / nig, fm = gid * 8, gsz = (nM - fm) < 8 ? (nM - fm) : 8;
        u.pm = fm + ((wgid % nig) % gsz); u.pn = (wgid % nig) / gsz; u.e = 0; u.rt = 0; u.cnt = 0; return true;
    }
    __device__ __forceinline__ const char* a_base() const { return A; }
    __device__ __forceinline__ unsigned a_rowoff(const Unit& u, int half, int R) const { return (unsigned)(u.pm * BM + half * HALF + R) * (unsigned)(K * 2); }
    __device__ __forceinline__ const char* b_ptr(const Unit& u) const { return Bt + (size_t)u.pn * BM * K * 2; }
};

__device__ __forceinline__ void moe_build_units(LAS int* tab, const int* cntp, int NCT, int G, int c) {
    const int i = opaque_tid();
    if (i < 16) {
        const int L = i * G + c; int accu = 0, rtb = 0, found = 0, pm = 0, pn = 0, ee = 0, rt = 0, cn = 0;
        for (int e = 0; e < 16; ++e) { const int ce = cntp[e], nte = (ce + 255) >> 8, ue = nte * NCT;
            if (!found && L < accu + ue) { const int local = L - accu; ee = e; rt = local / NCT; pn = local % NCT; pm = rtb + rt; cn = ce; found = 1; }
            accu += ue; rtb += nte; }
        tab[i * 8 + 0] = found; tab[i * 8 + 1] = pm; tab[i * 8 + 2] = pn; tab[i * 8 + 3] = ee; tab[i * 8 + 4] = rt; tab[i * 8 + 5] = cn;
    }
    __syncthreads();
}
template <bool GATHER>
struct MoeSched {
    const char* A; const char* Bt; const int* list; int K; size_t wstride; LAS int* tab;
    __device__ void init(const void* A_, const void* Bt_, size_t wstride_bytes, const int* list_, int K_, LAS int* tab_) {
        A = (const char*)A_; Bt = (const char*)Bt_; wstride = wstride_bytes; list = list_; K = K_; tab = tab_; }
    __device__ __forceinline__ bool next(int i, Unit& u) const {
        if (i >= 16) return false;
        const int f = __builtin_amdgcn_readfirstlane(tab[i * 8 + 0]);
        u.pm = __builtin_amdgcn_readfirstlane(tab[i * 8 + 1]); u.pn = __builtin_amdgcn_readfirstlane(tab[i * 8 + 2]); u.e = __builtin_amdgcn_readfirstlane(tab[i * 8 + 3]);
        u.rt = __builtin_amdgcn_readfirstlane(tab[i * 8 + 4]); u.cnt = __builtin_amdgcn_readfirstlane(tab[i * 8 + 5]);
        return f != 0;
    }
    __device__ __forceinline__ const char* a_base() const { return A; }
    __device__ __forceinline__ unsigned a_rowoff(const Unit& u, int half, int R) const {
        if (GATHER) { const int slot = u.rt * BM + half * HALF + R; const int tok = slot < u.cnt ? list[u.e * NTOK + slot] : 0; return (unsigned)tok * (unsigned)(K * 2); }
        return (unsigned)(u.pm * BM + half * HALF + R) * (unsigned)(K * 2);
    }
    __device__ __forceinline__ const char* b_ptr(const Unit& u) const { return Bt + (size_t)u.e * wstride + (size_t)u.pn * BM * K * 2; }
};

struct EpiBf16 {
    static constexpr bool PERM = true;
    bf16_t* O; int ldc;
    __device__ __forceinline__ void operator()(const f32x4 (&acc)[2][2][4][2], const Unit& u, int wr, int wc, int fr, int fq) const {
        const int row0 = u.pm * BM + wr * 64 + fr, col0 = u.pn * BM + wc * 32 + 8 * fq;
#pragma unroll
        for (int ai = 0; ai < 2; ++ai)
#pragma unroll
            for (int m = 0; m < 4; ++m) { bf16_t* rowp = O + (size_t)(row0 + ai * HALF + m * 16) * ldc + col0;
#pragma unroll
                for (int bj = 0; bj < 2; ++bj) { const f32x4 v0 = acc[ai][bj][m][0], v1 = acc[ai][bj][m][1];
                    u32x4 w; w.x = cvt_pk_bf16(v0[0], v0[1]); w.y = cvt_pk_bf16(v0[2], v0[3]); w.z = cvt_pk_bf16(v1[0], v1[1]); w.w = cvt_pk_bf16(v1[2], v1[3]);
                    *(u32x4*)(rowp + bj * HALF) = w; } }
    }
};
struct EpiResid {
    static constexpr bool PERM = false;
    const float* X; float* U;
    __device__ __forceinline__ void operator()(const f32x4 (&acc)[2][2][4][2], const Unit& u, int wr, int wc, int fr, int fq) const {
        const int row0 = u.pm * BM + wr * 64 + fr, col0 = u.pn * BM + wc * 32 + 4 * fq;
#pragma unroll
        for (int ai = 0; ai < 2; ++ai)
#pragma unroll
            for (int m = 0; m < 4; ++m) { const size_t off = (size_t)(row0 + ai * HALF + m * 16) * DM + col0;
#pragma unroll
                for (int bj = 0; bj < 2; ++bj)
#pragma unroll
                    for (int n = 0; n < 2; ++n) { const f32x4 xv = *(const f32x4*)(X + off + bj * HALF + n * 16);
                        *(f32x4*)(U + off + bj * HALF + n * 16) = xv * DN_ALPHA + acc[ai][bj][m][n]; } }
    }
};
struct EpiSwiglu {
    static constexpr bool PERM = true;
    bf16_t* O;
    __device__ __forceinline__ void operator()(const f32x4 (&acc)[2][2][4][2], const Unit& u, int wr, int wc, int fr, int fq) const {
        const int row0 = u.pm * BM + wr * 64 + fr, col0 = u.pn * HALF + wc * 32 + 8 * fq;
#pragma unroll
        for (int ai = 0; ai < 2; ++ai)
#pragma unroll
            for (int m = 0; m < 4; ++m) { bf16_t* rowp = O + (size_t)(row0 + ai * HALF + m * 16) * DEXP + col0;
                float r[8];
#pragma unroll
                for (int n = 0; n < 2; ++n)
#pragma unroll
                    for (int j = 0; j < 4; ++j) { const float g = acc[ai][0][m][n][j], up = acc[ai][1][m][n][j]; r[n * 4 + j] = g / (1.0f + __expf(-g)) * up; }
                u32x4 w; w.x = cvt_pk_bf16(r[0], r[1]); w.y = cvt_pk_bf16(r[2], r[3]); w.z = cvt_pk_bf16(r[4], r[5]); w.w = cvt_pk_bf16(r[6], r[7]);
                *(u32x4*)rowp = w; }
    }
};
}

__device__ __forceinline__ void tr_tile(LAS float* tile  , const float* src, int ld, int k0, int c0, int ncols_valid, bf16_t* dst, int dstK, int drow0, int tid) {
    {
        const int r = tid >> 3, cc = (tid & 7) * 8;
        const float* sp = src + (size_t)(k0 + r) * ld + c0 + cc;
#pragma unroll
        for (int j = 0; j < 8; ++j) tile[r * 65 + cc + j] = (c0 + cc + j < ncols_valid) ? sp[j] : 0.f;
    }
    __syncthreads();
    {
        const int n = tid >> 3, kk = (tid & 7) * 8;
        u32x4 w;
        w.x = cvt_pk_bf16(tile[(kk + 0) * 65 + n], tile[(kk + 1) * 65 + n]); w.y = cvt_pk_bf16(tile[(kk + 2) * 65 + n], tile[(kk + 3) * 65 + n]);
        w.z = cvt_pk_bf16(tile[(kk + 4) * 65 + n], tile[(kk + 5) * 65 + n]); w.w = cvt_pk_bf16(tile[(kk + 6) * 65 + n], tile[(kk + 7) * 65 + n]);
        *(u32x4*)(dst + (size_t)(drow0 + n) * dstK + k0 + kk) = w;
    }
    __syncthreads();
}

__device__ __forceinline__ void phase_prep(const Params& p, LAS unsigned char* lds, int bid, int nb) {
    const int tid = opaque_tid();
    LAS float* tile = (LAS float*)lds;
    unsigned char* ws = p.ws;
    const int T0 = 832, T1 = T0 + 256, T2 = T1 + 448, T3 = T2 + 256, T4 = T3 + 2048, T5 = T4 + 2048, T6 = T5 + 2048, T7 = T6 + 32;
    for (int t = bid; t < T7; t += nb) {
        if (t >= T6) { const int q = t - T6;
            if (q < 8) tr_tile(tile, p.in[I_AW2], 512, 0, q * 64, 512, (bf16_t*)(ws + OFF_MISC + MISC_W2T), 64, q * 64, tid);
            else if (q < 16) tr_tile(tile, p.in[I_AA2], 512, 0, (q - 8) * 64, 512, (bf16_t*)(ws + OFF_MISC + MISC_A2T), 64, (q - 8) * 64, tid);
            else { const int r = q - 16; tr_tile(tile, p.in[I_AG2], 512, (r >> 3) * 64, (r & 7) * 64, 512, (bf16_t*)(ws + OFF_MISC + MISC_G2T), 128, (r & 7) * 64, tid); }
            continue; }
        if (t < T0) { const int kt = t / 52, ct = t % 52; tr_tile(tile, p.in[I_WINE], EVEN_COLS, kt * 64, ct * 64, EVEN_COLS, (bf16_t*)(ws + OFF_WINE), 1024, ct * 64, tid); }
        else if (t < T1) { const int q = t - T0, kt = q / 16, ct = q % 16; tr_tile(tile, p.in[I_WOUTE], 1024, kt * 64, ct * 64, 1024, (bf16_t*)(ws + OFF_WOUTE), 1024, ct * 64, tid); }
        else if (t < T2) { const int q = t - T1, kt = q / 28, ct = q % 28; tr_tile(tile, p.in[I_WINO], ODD_COLS, kt * 64, ct * 64, ODD_COLS, (bf16_t*)(ws + OFF_WINO), 1024, ct * 64, tid); }
        else if (t < T3) { const int q = t - T2, kt = q / 16, ct = q % 16; tr_tile(tile, p.in[I_WOUTO], 1024, kt * 64, ct * 64, 1024, (bf16_t*)(ws + OFF_WOUTO), 1024, ct * 64, tid); }
        else if (t < T5) { const bool up = t >= T4; const int q = t - (up ? T4 : T3), le = q / 64, r = q % 64, kt = r / 4, ct = r % 4;
            const int c0 = ct * 64, drow0 = (c0 / 128) * 256 + (up ? 128 : 0) + (c0 % 128);
            tr_tile(tile, p.in[up ? I_EU : I_EG] + (size_t)le * 1024 * 256, 256, kt * 64, c0, 256, (bf16_t*)(ws + OFF_WGU) + (size_t)le * 512 * 1024, 1024, drow0, tid); }
        else { const int q = t - T5, le = q / 64, r = q % 64, kt = r / 16, ct = r % 16;
            tr_tile(tile, p.in[I_ED] + (size_t)le * 256 * 1024, 1024, kt * 64, ct * 64, 1024, (bf16_t*)(ws + OFF_WD) + (size_t)le * 1024 * 256, 256, ct * 64, tid); }
    }
    {
        const float* x = p.in[I_X]; bf16_t* xb = (bf16_t*)(ws + OFF_BUF64);
        const size_t n8 = (size_t)NTOK * DM / 8;
        for (size_t i = (size_t)bid * 512 + tid; i < n8; i += (size_t)nb * 512) {
            const f32x4 a = *(const f32x4*)(x + i * 8), b = *(const f32x4*)(x + i * 8 + 4);
            u32x4 w; w.x = cvt_pk_bf16(a[0], a[1]); w.y = cvt_pk_bf16(a[2], a[3]); w.z = cvt_pk_bf16(b[0], b[1]); w.w = cvt_pk_bf16(b[2], b[3]);
            *(u32x4*)(xb + i * 8) = w;
        }
    }
    {
        float* c64 = (float*)(ws + OFF_ROPE); float* s64 = c64 + 4096 * 64; float* c32 = s64 + 4096 * 64; float* s32 = c32 + 4096 * 32;
        for (int i = bid * 512 + tid; i < 4096 * 64; i += nb * 512) { const int pos = i >> 6, j = i & 63; const float inv = powf(10000.0f, -(float)j / 64.0f); const float ang = (float)pos * inv; c64[i] = cosf(ang); s64[i] = sinf(ang); }
        for (int i = bid * 512 + tid; i < 4096 * 32; i += nb * 512) { const int pos = i >> 5, j = i & 31; const float inv = powf(10000.0f, -(float)j / 32.0f); const float ang = (float)pos * inv; c32[i] = cosf(ang); s32[i] = sinf(ang); }
    }
    if (bid == 0 && tid < 64) ((int*)(ws + OFF_MISC + MISC_CNT))[tid] = 0;
}

__device__ __forceinline__ void phase_ln_route(const Params& p, LAS unsigned char* lds, int bid, int nb, int layer) {
    const int tid = opaque_tid(), wid = tid >> 6, lane = tid & 63;
    unsigned char* ws = p.ws;
    LAS float* rwT = (LAS float*)lds;
    for (int i = tid; i < 16 * 1024; i += 512) { const int e = i >> 10, k = i & 1023; rwT[i] = p.in[I_RW][k * 16 + e]; }
    __syncthreads();
    float* U = (float*)(ws + OFF_U); bf16_t* hb = (bf16_t*)(ws + OFF_BUF64);
    const float* g = p.in[I_LN1G] + layer * DM; const float* b = p.in[I_LN1B] + layer * DM;
    int* cnt = (int*)(ws + OFF_MISC + MISC_CNT) + layer * 16;
    int* tokinfo = (int*)(ws + OFF_MISC + MISC_TOKINFO); float* tokgate = (float*)(ws + OFF_MISC + MISC_TOKGATE); int* list = (int*)(ws + OFF_MISC + MISC_LIST);
    f32x4 gv[4], bv[4];
#pragma unroll
    for (int j = 0; j < 4; ++j) { gv[j] = *(const f32x4*)(g + j * 256 + lane * 4); bv[j] = *(const f32x4*)(b + j * 256 + lane * 4); }
    float rbias[16];
#pragma unroll
    for (int e = 0; e < 16; ++e) rbias[e] = p.in[I_RB][e];
    for (int tok = bid * 8 + wid; tok < NTOK; tok += nb * 8) {
        f32x4 v[4]; float s = 0.f;
#pragma unroll
        for (int j = 0; j < 4; ++j) { v[j] = *(const f32x4*)(U + (size_t)tok * DM + j * 256 + lane * 4); s += (v[j][0] + v[j][1]) + (v[j][2] + v[j][3]); }
        const float mean = wave_sum(s) * (1.0f / DM);
        float q = 0.f;
#pragma unroll
        for (int j = 0; j < 4; ++j) { v[j] -= mean; q += (v[j][0] * v[j][0] + v[j][1] * v[j][1]) + (v[j][2] * v[j][2] + v[j][3] * v[j][3]); }
        const float rstd = rsqrtf(wave_sum(q) * (1.0f / DM) + LN_EPS);
#pragma unroll
        for (int j = 0; j < 4; ++j) { v[j] = v[j] * rstd * gv[j] + bv[j];
            *(f32x4*)(U + (size_t)tok * DM + j * 256 + lane * 4) = v[j];
            u32x2 w; w.x = cvt_pk_bf16(v[j][0], v[j][1]); w.y = cvt_pk_bf16(v[j][2], v[j][3]);
            *(u32x2*)(hb + (size_t)tok * DM + j * 256 + lane * 4) = w; }
        float lg[16];
        asm volatile("" ::: "memory");
#pragma unroll
        for (int e = 0; e < 16; ++e) { float a = 0.f;
#pragma unroll
            for (int j = 0; j < 4; ++j) { const f32x4 w = *(const LAS f32x4*)(rwT + e * 1024 + j * 256 + lane * 4); a += (v[j][0] * w[0] + v[j][1] * w[1]) + (v[j][2] * w[2] + v[j][3] * w[3]); }
            lg[e] = wave_sum(a); }
        float sg[16], sel[16];
#pragma unroll
        for (int e = 0; e < 16; ++e) { sg[e] = 1.0f / (1.0f + expf(-lg[e])); sel[e] = sg[e] + rbias[e]; }
        int best = 0; float bestv = -INFINITY;
#pragma unroll
        for (int gI = 0; gI < 4; ++gI) { float m1 = -INFINITY, m2 = -INFINITY;
#pragma unroll
            for (int j = 0; j < 4; ++j) { const float x = sel[gI * 4 + j]; if (x > m1) { m2 = m1; m1 = x; } else if (x > m2) m2 = x; }
            const float gs = m1 + m2; if (gs > bestv) { bestv = gs; best = gI; } }
        int e0 = 0, e1 = 0; float v0 = -INFINITY, v1 = -INFINITY, s0 = 0.f, s1 = 0.f;
#pragma unroll
        for (int e = 0; e < 16; ++e) { if ((e >> 2) == best) { const float x = sel[e];
                if (x > v0) { v1 = v0; e1 = e0; s1 = s0; v0 = x; e0 = e; s0 = sg[e]; } else if (x > v1) { v1 = x; e1 = e; s1 = sg[e]; } } }
        const float gsum = s0 + s1; const float g0 = s0 / gsum, g1 = s1 / gsum;
        if (lane == 0) {
            const int sl0 = atomicAdd(cnt + e0, 1), sl1 = atomicAdd(cnt + e1, 1);
            list[e0 * NTOK + sl0] = tok; list[e1 * NTOK + sl1] = tok;
            tokinfo[tok * 4 + 0] = e0; tokinfo[tok * 4 + 1] = sl0; tokinfo[tok * 4 + 2] = e1; tokinfo[tok * 4 + 3] = sl1;
            tokgate[tok * 2 + 0] = g0; tokgate[tok * 2 + 1] = g1;
        }
    }
}

__device__ __forceinline__ void phase_ln2(const Params& p, int bid, int nb, int layer, float* dst, bool with_moe) {
    const int tid = opaque_tid(), wid = tid >> 6, lane = tid & 63;
    unsigned char* ws = p.ws;
    const float* U = (const float*)(ws + OFF_U); bf16_t* xb = (bf16_t*)(ws + OFF_BUF64);
    const bf16_t* he = (const bf16_t*)(ws + OFF_HE);
    const float* g = p.in[I_LN2G] + layer * DM; const float* b = p.in[I_LN2B] + layer * DM;
    const int* cnt = (const int*)(ws + OFF_MISC + MISC_CNT) + layer * 16;
    const int* tokinfo = (const int*)(ws + OFF_MISC + MISC_TOKINFO); const float* tokgate = (const float*)(ws + OFF_MISC + MISC_TOKGATE);
    int rowbase[16]; { int a = 0;
#pragma unroll
        for (int e = 0; e < 16; ++e) { rowbase[e] = a; a += ((cnt[e] + 255) >> 8) << 8; } }
    f32x4 gv[4], bv[4];
#pragma unroll
    for (int j = 0; j < 4; ++j) { gv[j] = *(const f32x4*)(g + j * 256 + lane * 4); bv[j] = *(const f32x4*)(b + j * 256 + lane * 4); }
    for (int tok = bid * 8 + wid; tok < NTOK; tok += nb * 8) {
        f32x4 v[4]; float s = 0.f;
        int r0 = 0, r1 = 0; float g0 = 0.f, g1 = 0.f;
        if (with_moe) { const int e0 = tokinfo[tok * 4 + 0], sl0 = tokinfo[tok * 4 + 1], e1 = tokinfo[tok * 4 + 2], sl1 = tokinfo[tok * 4 + 3];
            int rb0 = 0, rb1 = 0;
#pragma unroll
            for (int e = 0; e < 16; ++e) { if (e == e0) rb0 = rowbase[e]; if (e == e1) rb1 = rowbase[e]; }
            r0 = rb0 + sl0; r1 = rb1 + sl1; g0 = tokgate[tok * 2 + 0]; g1 = tokgate[tok * 2 + 1]; }
#pragma unroll
        for (int j = 0; j < 4; ++j) { v[j] = *(const f32x4*)(U + (size_t)tok * DM + j * 256 + lane * 4) * DN_ALPHA;
            if (with_moe) { const u32x2 a = *(const u32x2*)(he + (size_t)r0 * DM + j * 256 + lane * 4), c = *(const u32x2*)(he + (size_t)r1 * DM + j * 256 + lane * 4);
                v[j][0] += g0 * __uint_as_float(a.x << 16) + g1 * __uint_as_float(c.x << 16); v[j][1] += g0 * __uint_as_float(a.x & 0xffff0000u) + g1 * __uint_as_float(c.x & 0xffff0000u);
                v[j][2] += g0 * __uint_as_float(a.y << 16) + g1 * __uint_as_float(c.y << 16); v[j][3] += g0 * __uint_as_float(a.y & 0xffff0000u) + g1 * __uint_as_float(c.y & 0xffff0000u); }
            s += (v[j][0] + v[j][1]) + (v[j][2] + v[j][3]); }
        const float mean = wave_sum(s) * (1.0f / DM);
        float q = 0.f;
#pragma unroll
        for (int j = 0; j < 4; ++j) { v[j] -= mean; q += (v[j][0] * v[j][0] + v[j][1] * v[j][1]) + (v[j][2] * v[j][2] + v[j][3] * v[j][3]); }
        const float rstd = rsqrtf(wave_sum(q) * (1.0f / DM) + LN_EPS);
#pragma unroll
        for (int j = 0; j < 4; ++j) { v[j] = v[j] * rstd * gv[j] + bv[j];
            *(f32x4*)(dst + (size_t)tok * DM + j * 256 + lane * 4) = v[j];
            u32x2 w; w.x = cvt_pk_bf16(v[j][0], v[j][1]); w.y = cvt_pk_bf16(v[j][2], v[j][3]);
            *(u32x2*)(xb + (size_t)tok * DM + j * 256 + lane * 4) = w; }
    }
}

__device__ __forceinline__ void phase_resid_only(const Params& p, const float* X, int bid, int nb) {
    float* U = (float*)(p.ws + OFF_U);
    const size_t n4 = (size_t)NTOK * DM / 4;
    for (size_t i = (size_t)bid * 512 + threadIdx.x; i < n4; i += (size_t)nb * 512) *(f32x4*)(U + i * 4) = *(const f32x4*)(X + i * 4) * DN_ALPHA;
}

__device__ __forceinline__ void phase_moe_gateup(const Params& p, LAS unsigned char* lds, int bid, int nb, int layer) {
    unsigned char* ws = p.ws;
    LAS int* tab = (LAS int*)(lds + pg::STAGE_BYTES);
    pg::moe_build_units(tab, (const int*)(ws + OFF_MISC + MISC_CNT) + layer * 16, 2, nb, bid);
    pg::MoeSched<true> S; S.init(ws + OFF_BUF64, ws + OFF_WGU + (size_t)layer * 16 * 512 * 1024 * 2, (size_t)512 * 1024 * 2, (const int*)(ws + OFF_MISC + MISC_LIST), 1024, tab);
    pg::EpiSwiglu E; E.O = (bf16_t*)(ws + OFF_ACT);
    pg::gemm_phase(lds, 1024, S, E);
}
__device__ __forceinline__ void phase_moe_down(const Params& p, LAS unsigned char* lds, int bid, int nb, int layer) {
    unsigned char* ws = p.ws;
    LAS int* tab = (LAS int*)(lds + pg::STAGE_BYTES);
    pg::moe_build_units(tab, (const int*)(ws + OFF_MISC + MISC_CNT) + layer * 16, 4, nb, bid);
    pg::MoeSched<false> S; S.init(ws + OFF_ACT, ws + OFF_WD + (size_t)layer * 16 * 1024 * 256 * 2, (size_t)1024 * 256 * 2, nullptr, 256, tab);
    pg::EpiBf16 E; E.O = (bf16_t*)(ws + OFF_HE); E.ldc = 1024;
    pg::gemm_phase(lds, 256, S, E);
}

__device__ __forceinline__ void phase_gla_alpha(const Params& p, LAS unsigned char* lds, int bid, int nb) {
    const int tid = opaque_tid(), wid = tid >> 6, lane = tid & 63;
    LAS float* wT = (LAS float*)lds;
    for (int i = tid; i < 16 * 1024; i += 512) { const int e = i & 15, k = i >> 4; wT[e * 1024 + k] = p.in[I_WINE][(size_t)k * EVEN_COLS + NE_MAIN + e]; }
    __syncthreads();
    const float* x = p.in[I_X]; float* xa = (float*)(p.ws + OFF_U);
    for (int tok = bid * 8 + wid; tok < NTOK; tok += nb * 8) {
        f32x4 v[4];
        asm volatile("" ::: "memory");
#pragma unroll
        for (int j = 0; j < 4; ++j) v[j] = *(const f32x4*)(x + (size_t)tok * DM + j * 256 + lane * 4);
        float mine = 0.f;
#pragma unroll
        for (int e = 0; e < 16; ++e) { float a = 0.f;
#pragma unroll
            for (int j = 0; j < 4; ++j) { const f32x4 w = *(const LAS f32x4*)(wT + e * 1024 + j * 256 + lane * 4); a += (v[j][0] * w[0] + v[j][1] * w[1]) + (v[j][2] * w[2] + v[j][3] * w[3]); }
            a = wave_sum(a); if (lane == e) mine = a; }
        if (lane < 16) xa[(size_t)tok * 16 + lane] = mine;
    }
    __syncthreads();
}

template <int CTRL> __device__ __forceinline__ float dppf(float v) { return __builtin_bit_cast(float, __builtin_amdgcn_update_dpp(0, __builtin_bit_cast(int, v), CTRL, 0xf, 0xf, true)); }
__device__ __forceinline__ float red8(float v) { v += dppf<0xB1>(v); v += dppf<0x4E>(v); v += dppf<0x141>(v); return v; }

__device__ __forceinline__ void rwkv_item(const Params& p, LAS unsigned char* lds, int item) {
    constexpr int TC = 16;
    const int tid = opaque_tid(), lane = tid & 63, tg = tid >> 6;
    const int b = item >> 3, h = item & 7;
    const bf16_t* P0 = (const bf16_t*)(p.ws + OFF_P);
    bf16_t* mix = (bf16_t*)(p.ws + OFF_BUF64);
    LAS float* w2s = (LAS float*)lds;
    LAS float* a2s = w2s + 64 * 64;
    LAS float* g2s = a2s + 64 * 64;
    LAS float* tw = g2s + 128 * 64;
    LAS float* xa_s = tw + TC * 64;
    LAS float* sg = xa_s + TC * 64;
    LAS float* r_s = sg + TC * 128;
    LAS float* k_s = r_s + TC * 64;
    LAS float* v_s = k_s + TC * 64;
    LAS float* w_s = v_s + TC * 64;
    LAS float* kk_s = w_s + TC * 64;
    LAS float* kka_s = kk_s + TC * 64;
    LAS float* kh_s = kka_s + TC * 64;
    LAS float* g_s = kh_s + TC * 64;
    LAS float* y_s = g_s + TC * 64;
    LAS float* rk_s = y_s + TC * 64;
    const float* mu = p.in[I_AMU];
    for (int i = tid; i < 64 * 64; i += 512) { const int r = i >> 6, c = i & 63; w2s[i] = p.in[I_AW2][r * 512 + h * 64 + c]; a2s[i] = p.in[I_AA2][r * 512 + h * 64 + c]; }
    for (int i = tid; i < 128 * 64; i += 512) { const int r = i >> 6, c = i & 63; g2s[i] = p.in[I_AG2][r * 512 + h * 64 + c]; }
    const int j = lane;
    const float w0 = p.in[I_AW0][h * 64 + j], a0 = p.in[I_AA0][h * 64 + j], kksc = p.in[I_AKK][h * 64 + j], kasc = p.in[I_AKA][h * 64 + j], rkj = p.in[I_ARK][h * 64 + j];
    const float gng = p.in[I_AGNG][h * 64 + j], gnb = p.in[I_AGNB][h * 64 + j];
    float S[8];
#pragma unroll
    for (int i = 0; i < 8; ++i) S[i] = 0.f;
    const int row = tid >> 3, kq = tid & 7;
    __syncthreads();
    for (int t0 = 0; t0 < SEQ; t0 += TC) {
        for (int idx = tid; idx < TC * 448; idx += 512) {
            const int t = idx / 448, c = idx % 448; int col; LAS float* dst; int kind = 0;
            if (c < 64) { col = h * 64 + c; dst = r_s + t * 64 + c; }
            else if (c < 128) { col = 512 + h * 64 + (c - 64); dst = k_s + t * 64 + (c - 64); }
            else if (c < 192) { col = 1024 + h * 64 + (c - 128); dst = v_s + t * 64 + (c - 128); }
            else if (c < 256) { col = 1536 + (c - 192); dst = tw + t * 64 + (c - 192); kind = 1; }
            else if (c < 320) { col = 1600 + (c - 256); dst = xa_s + t * 64 + (c - 256); }
            else { col = 1664 + (c - 320); dst = sg + t * 128 + (c - 320); kind = 2; }
            const size_t n = (size_t)b * SEQ + t0 + t;
            const float cur = bf2f(P0[n * NE_MAIN + col]);
            const float prev = (t0 + t) > 0 ? bf2f(P0[(n - 1) * NE_MAIN + col]) : 0.f;
            float val = cur + (prev - cur) * mu[col];
            if (kind == 1) val = tanhf(val); else if (kind == 2) val = 1.0f / (1.0f + expf(-val));
            *dst = val;
        }
        __syncthreads();
#pragma unroll
        for (int tt = 0; tt < 2; ++tt) {
            const int t = tg + tt * 8;
            float aw = 0.f, aa = 0.f, ag = 0.f;
            asm volatile("" ::: "memory");
#pragma unroll 4
            for (int i = 0; i < 64; ++i) { aw += tw[t * 64 + i] * w2s[i * 64 + j]; aa += xa_s[t * 64 + i] * a2s[i * 64 + j]; }
            asm volatile("" ::: "memory");
#pragma unroll 4
            for (int i = 0; i < 128; ++i) ag += sg[t * 128 + i] * g2s[i * 64 + j];
            asm volatile("" ::: "memory");
            const float z = w0 + aw;
            const float sp = (-z > 20.f) ? -z : log1pf(expf(-z));
            const float wlog = -sp - 0.5f;
            const float decay = expf(-expf(wlog));
            const float a = 1.0f / (1.0f + expf(-(a0 + aa)));
            const float kraw = k_s[t * 64 + j];
            const float kkp = kraw * kksc;
            const float nrm = sqrtf(wave_sum(kkp * kkp));
            const float kk = kkp / fmaxf(nrm, 1e-12f);
            const float kh = kraw * (1.0f + (a - 1.0f) * kasc);
            const float rr = r_s[t * 64 + j];
            const float rk = wave_sum(rr * kh * rkj);
            w_s[t * 64 + j] = decay; kk_s[t * 64 + j] = kk; kka_s[t * 64 + j] = kk * a; kh_s[t * 64 + j] = kh; g_s[t * 64 + j] = ag;
            if (j == 0) rk_s[t] = rk;
        }
        __syncthreads();
        for (int t = 0; t < TC; ++t) {
            const f32x4 kk0 = *(const LAS f32x4*)(kk_s + t * 64 + kq * 8), kk1 = *(const LAS f32x4*)(kk_s + t * 64 + kq * 8 + 4);
            const f32x4 ww0 = *(const LAS f32x4*)(w_s + t * 64 + kq * 8), ww1 = *(const LAS f32x4*)(w_s + t * 64 + kq * 8 + 4);
            const f32x4 ka0 = *(const LAS f32x4*)(kka_s + t * 64 + kq * 8), ka1 = *(const LAS f32x4*)(kka_s + t * 64 + kq * 8 + 4);
            const f32x4 kh0 = *(const LAS f32x4*)(kh_s + t * 64 + kq * 8), kh1 = *(const LAS f32x4*)(kh_s + t * 64 + kq * 8 + 4);
            const f32x4 rr0 = *(const LAS f32x4*)(r_s + t * 64 + kq * 8), rr1 = *(const LAS f32x4*)(r_s + t * 64 + kq * 8 + 4);
            const float vv = v_s[t * 64 + row];
            float sa = 0.f;
#pragma unroll
            for (int i = 0; i < 4; ++i) { sa += S[i] * kk0[i]; sa += S[4 + i] * kk1[i]; }
            sa = red8(sa);
            float y = 0.f;
#pragma unroll
            for (int i = 0; i < 4; ++i) {
                S[i] = S[i] * ww0[i] - sa * ka0[i] + vv * kh0[i]; S[4 + i] = S[4 + i] * ww1[i] - sa * ka1[i] + vv * kh1[i];
                y += S[i] * rr0[i]; y += S[4 + i] * rr1[i]; }
            y = red8(y);
            if (kq == 0) y_s[t * 64 + row] = y;
        }
        __syncthreads();
#pragma unroll
        for (int tt = 0; tt < 2; ++tt) {
            const int t = tg + tt * 8;
            const float y = y_s[t * 64 + j];
            const float mean = wave_sum(y) * (1.0f / 64.0f);
            const float d = y - mean;
            const float var = wave_sum(d * d) * (1.0f / 64.0f);
            const float yn = d * rsqrtf(var + 64e-5f) * gng + gnb;
            const float o = (yn + rk_s[t] * v_s[t * 64 + j]) * g_s[t * 64 + j];
            mix[((size_t)b * SEQ + t0 + t) * DM + h * 64 + j] = f2bf(o);
        }
        __syncthreads();
    }
}

__device__ __forceinline__ void gla_item(const Params& p, LAS unsigned char* lds, int item) {
    const int tid = opaque_tid(), lane = tid & 63, tg = tid >> 6;
    const int b = item >> 2, h = item & 3;
    const bf16_t* P0 = (const bf16_t*)(p.ws + OFF_P) + 1792;
    const float* xa16 = (const float*)(p.ws + OFF_U);
    bf16_t* mix = (bf16_t*)(p.ws + OFF_BUF64);
    LAS float* qd = (LAS float*)lds;
    LAS float* ki = qd + 64 * 65;
    LAS float* att = ki + 64 * 65;
    LAS float* vs = att + 64 * 65;
    LAS float* St = vs + 64 * 128;
    LAS float* bl = St + 64 * 128;
    for (int i = tid; i < 64 * 128; i += 512) St[i] = 0.f;
    float gw2[16];
#pragma unroll
    for (int i = 0; i < 16; ++i) gw2[i] = p.in[I_BGW2][i * 256 + h * 64 + lane];
    const float gb = p.in[I_BGB][h * 64 + lane];
    const float* bng = p.in[I_BNG];
    __syncthreads();
    for (int c0 = 0; c0 < SEQ; c0 += 64) {
        const size_t n0 = (size_t)b * SEQ + c0;
        for (int tt = 0; tt < 8; ++tt) { const int c = tg * 8 + tt; float z = gb;
#pragma unroll
            for (int i = 0; i < 16; ++i) z += xa16[(n0 + c) * 16 + i] * gw2[i];
            const float ls = (z >= 0.f) ? -log1pf(expf(-z)) : (z - log1pf(expf(z)));
            att[c * 65 + lane] = ls * (1.0f / 16.0f); }
        for (int i = tid; i < 64 * 128; i += 512) { const int c = i >> 7, e = i & 127; vs[i] = bf2f(P0[(n0 + c) * NE_MAIN + 512 + h * 128 + e]); }
        __syncthreads();
        if (tid < 64) { float a = 0.f; for (int c = 0; c < 64; ++c) { a += att[c * 65 + tid]; att[c * 65 + tid] = a; } bl[tid] = a; }
        __syncthreads();
        for (int i = tid; i < 64 * 64; i += 512) { const int c = i >> 6, d = i & 63; const float bc = att[c * 65 + d];
            const float q = bf2f(P0[(n0 + c) * NE_MAIN + h * 64 + d]), k = bf2f(P0[(n0 + c) * NE_MAIN + 256 + h * 64 + d]);
            qd[c * 65 + d] = q * 0.125f * expf(bc); ki[c * 65 + d] = k * expf(-bc); }
        __syncthreads();
        { const int c = tid >> 3, sgp = tid & 7; float a[8];
#pragma unroll
            for (int i = 0; i < 8; ++i) a[i] = 0.f;
            for (int d = 0; d < 64; ++d) { const float qv = qd[c * 65 + d];
#pragma unroll
                for (int i = 0; i < 8; ++i) a[i] += qv * ki[(sgp * 8 + i) * 65 + d]; }
            __syncthreads();
#pragma unroll
            for (int i = 0; i < 8; ++i) att[c * 65 + sgp * 8 + i] = (sgp * 8 + i <= c) ? a[i] : 0.f; }
        __syncthreads();
        { const int c = tid >> 3, eg = tid & 7; float o[16];
#pragma unroll
            for (int i = 0; i < 16; ++i) o[i] = 0.f;
            for (int s = 0; s <= c; ++s) { const float a = att[c * 65 + s];
#pragma unroll
                for (int i = 0; i < 16; ++i) o[i] += a * vs[s * 128 + eg * 16 + i]; }
            for (int d = 0; d < 64; ++d) { const float qv = qd[c * 65 + d];
#pragma unroll
                for (int i = 0; i < 16; ++i) o[i] += qv * St[d * 128 + eg * 16 + i]; }
            float ss = 0.f;
#pragma unroll
            for (int i = 0; i < 16; ++i) ss += o[i] * o[i];
            ss = red8(ss);
            const float rs = rsqrtf(ss * (1.0f / 128.0f) + 1e-5f);
#pragma unroll
            for (int i = 0; i < 16; ++i) { const int e = eg * 16 + i; const float g = bf2f(P0[(n0 + c) * NE_MAIN + 1024 + h * 128 + e]);
                const float val = o[i] * rs * bng[h * 128 + e] * (g / (1.0f + expf(-g)));
                mix[(n0 + c) * DM + 512 + h * 128 + e] = f2bf(val); } }
        __syncthreads();
        { const int d = tid >> 3, eg = tid & 7; float a[16];
#pragma unroll
            for (int i = 0; i < 16; ++i) a[i] = St[d * 128 + eg * 16 + i];
            for (int c = 0; c < 64; ++c) { const float kv = ki[c * 65 + d];
#pragma unroll
                for (int i = 0; i < 16; ++i) a[i] += kv * vs[c * 128 + eg * 16 + i]; }
            const float eb = expf(bl[d]);
#pragma unroll
            for (int i = 0; i < 16; ++i) St[d * 128 + eg * 16 + i] = a[i] * eb; }
        __syncthreads();
    }
}

__device__ __forceinline__ float red16(float v) { v += dppf<0xB1>(v); v += dppf<0x4E>(v); v += dppf<0x141>(v); v += dppf<0x140>(v); return v; }
__device__ __forceinline__ float fast_rcp(float x) { return __builtin_amdgcn_rcpf(x); }
__device__ __forceinline__ float fast_sigmoid(float x) { return fast_rcp(1.0f + __expf(-x)); }
__device__ __forceinline__ float fast_tanh(float x) { const float e = __expf(2.0f * x); return 1.0f - 2.0f * fast_rcp(1.0f + e); }
__device__ __forceinline__ void rwkv2_item(const Params& p, LAS unsigned char* lds, int item) {
    constexpr int TC = 32;
    const int tid = opaque_tid(), lane = tid & 63, wid = tid >> 6, fr = lane & 15, g = lane >> 4;
    const int b = item >> 4, h = (item >> 1) & 7, rq = item & 1;
    unsigned char* ws = p.ws;
    const bf16_t* P0 = (const bf16_t*)(ws + OFF_P);
    float* yraw = p.out;
    bf16_t* e1g = (bf16_t*)(p.out + (size_t)NTOK * 512);
    bf16_t* gg = e1g + (size_t)NTOK * 512;
    LAS float* kk_s = (LAS float*)lds;
    LAS float* w_s = kk_s + TC * 64;
    LAS float* b_s = w_s + TC * 64;
    LAS float* kh_s = b_s + TC * 64;
    LAS float* wr_s = kh_s + TC * 64;
    LAS float* wpre = wr_s + TC * 64;
    LAS float* apre = wpre + TC * 64;
    LAS float* gpre = apre + TC * 64;
    LAS float* v_s = gpre + TC * 32;
    LAS float* y_s = v_s + TC * 32;
    LAS float* sc_s = y_s + TC * 32;
    LAS unsigned char* tw_i = (LAS unsigned char*)(sc_s + TC * 2);
    LAS unsigned char* xa_i = tw_i + TC * 128;
    LAS unsigned char* sg_i = xa_i + TC * 128;
    const float* mu = p.in[I_AMU];
    const bf16_t* w2t = (const bf16_t*)(ws + OFF_MISC + MISC_W2T); const bf16_t* a2t = (const bf16_t*)(ws + OFF_MISC + MISC_A2T); const bf16_t* g2t = (const bf16_t*)(ws + OFF_MISC + MISC_G2T);
    const int mrt = wid >> 2, mct = wid & 3;
    bf16x8 wf[2], af[2], gf[4];
#pragma unroll
    for (int s = 0; s < 2; ++s) { wf[s] = *(const bf16x8*)(w2t + (size_t)(h * 64 + mct * 16 + fr) * 64 + s * 32 + g * 8); af[s] = *(const bf16x8*)(a2t + (size_t)(h * 64 + mct * 16 + fr) * 64 + s * 32 + g * 8); }
    const int grt = (wid >> 1) & 1, gct = wid & 1;
#pragma unroll
    for (int s = 0; s < 4; ++s) gf[s] = *(const bf16x8*)(g2t + (size_t)(h * 64 + rq * 32 + gct * 16 + fr) * 128 + s * 32 + g * 8);
    const int et = tid >> 4, ec = tid & 15;
    const f32x4 w0v = *(const f32x4*)(p.in[I_AW0] + h * 64 + ec * 4), a0v = *(const f32x4*)(p.in[I_AA0] + h * 64 + ec * 4);
    const f32x4 kksc = *(const f32x4*)(p.in[I_AKK] + h * 64 + ec * 4), kasc = *(const f32x4*)(p.in[I_AKA] + h * 64 + ec * 4), rkv = *(const f32x4*)(p.in[I_ARK] + h * 64 + ec * 4);
    const f32x4 mur = *(const f32x4*)(mu + h * 64 + ec * 4), muk = *(const f32x4*)(mu + 512 + h * 64 + ec * 4);
    const f32x2 muv = *(const f32x2*)(mu + 1024 + h * 64 + rq * 32 + ec * 2);
    const int p1tok0 = tid >> 5, p1cc = tid & 31, p1col = 1536 + p1cc * 8;
    const f32x4 p1m0 = *(const f32x4*)(mu + p1col), p1m1 = *(const f32x4*)(mu + p1col + 4);
    float S[4] = {0.f, 0.f, 0.f, 0.f};
    const int rl = wid * 4 + g, kq = fr;
    const size_t nb0 = (size_t)b * SEQ;
    u32x4 l_cu[2], l_pv[2]; u32x2 l_rc, l_kc, l_rp, l_kp; unsigned l_vc, l_vp;
#define RW_ISSUE(t0n) do { \
        _Pragma("unroll") for (int _i = 0; _i < 2; ++_i) { const size_t _n = nb0 + (t0n) + p1tok0 + _i * 16; \
            l_cu[_i] = *(const u32x4*)(P0 + _n * NE_MAIN + p1col); l_pv[_i] = (u32x4){0u, 0u, 0u, 0u}; \
            if ((t0n) + p1tok0 + _i * 16 > 0) l_pv[_i] = *(const u32x4*)(P0 + (_n - 1) * NE_MAIN + p1col); } \
        { const size_t _n = nb0 + (t0n) + et; const bool _hp = ((t0n) + et) > 0; \
            l_rc = *(const u32x2*)(P0 + _n * NE_MAIN + h * 64 + ec * 4); l_kc = *(const u32x2*)(P0 + _n * NE_MAIN + 512 + h * 64 + ec * 4); \
            l_vc = *(const unsigned*)(P0 + _n * NE_MAIN + 1024 + h * 64 + rq * 32 + ec * 2); \
            l_rp = (u32x2){0u, 0u}; l_kp = (u32x2){0u, 0u}; l_vp = 0u; \
            if (_hp) { l_rp = *(const u32x2*)(P0 + (_n - 1) * NE_MAIN + h * 64 + ec * 4); l_kp = *(const u32x2*)(P0 + (_n - 1) * NE_MAIN + 512 + h * 64 + ec * 4); \
                l_vp = *(const unsigned*)(P0 + (_n - 1) * NE_MAIN + 1024 + h * 64 + rq * 32 + ec * 2); } } } while (0)
#define MIX2(wc, wp, mA, mB, o0, o1) { const float c0 = __uint_as_float((wc) << 16), c1 = __uint_as_float((wc) & 0xffff0000u), q0 = __uint_as_float((wp) << 16), q1 = __uint_as_float((wp) & 0xffff0000u); o0 = c0 + (q0 - c0) * (mA); o1 = c1 + (q1 - c1) * (mB); }
    RW_ISSUE(0);
    for (int t0 = 0; t0 < SEQ; t0 += TC) {
#pragma unroll 1
        for (int prep_rep = 0; prep_rep < PREP_REP; ++prep_rep) {
#pragma unroll
        for (int i = 0; i < 2; ++i) {
            const int tok = p1tok0 + i * 16, cc = p1cc;
            const u32x4 cu = l_cu[i], pv = l_pv[i];
            float x[8];
            MIX2(cu.x, pv.x, p1m0[0], p1m0[1], x[0], x[1]) MIX2(cu.y, pv.y, p1m0[2], p1m0[3], x[2], x[3]) MIX2(cu.z, pv.z, p1m1[0], p1m1[1], x[4], x[5]) MIX2(cu.w, pv.w, p1m1[2], p1m1[3], x[6], x[7])
            if (cc < 8) {
#pragma unroll
                for (int j = 0; j < 8; ++j) x[j] = fast_tanh(x[j]); }
            else if (cc >= 16) {
#pragma unroll
                for (int j = 0; j < 8; ++j) x[j] = fast_sigmoid(x[j]); }
            u32x4 o; o.x = cvt_pk_bf16(x[0], x[1]); o.y = cvt_pk_bf16(x[2], x[3]); o.z = cvt_pk_bf16(x[4], x[5]); o.w = cvt_pk_bf16(x[6], x[7]);
            if (cc < 8) *(LAS u32x4*)(tw_i + tok * 128 + ((cc ^ (tok & 7)) * 16)) = o;
            else if (cc < 16) *(LAS u32x4*)(xa_i + tok * 128 + (((cc - 8) ^ (tok & 7)) * 16)) = o;
            else *(LAS u32x4*)(sg_i + tok * 256 + (((cc - 16) ^ (tok & 7)) * 16)) = o;
        }
        __syncthreads();
        {
            f32x4 dw = (f32x4){0.f, 0.f, 0.f, 0.f}, da = (f32x4){0.f, 0.f, 0.f, 0.f};
            const int row = mrt * 16 + fr;
#pragma unroll
            for (int s = 0; s < 2; ++s) {
                const bf16x8 ta = *(const LAS bf16x8*)(tw_i + row * 128 + (((s * 4 + g) ^ (row & 7)) * 16));
                const bf16x8 xa = *(const LAS bf16x8*)(xa_i + row * 128 + (((s * 4 + g) ^ (row & 7)) * 16));
                dw = __builtin_amdgcn_mfma_f32_16x16x32_bf16(ta, wf[s], dw, 0, 0, 0);
                da = __builtin_amdgcn_mfma_f32_16x16x32_bf16(xa, af[s], da, 0, 0, 0);
            }
#pragma unroll
            for (int r = 0; r < 4; ++r) { wpre[(mrt * 16 + g * 4 + r) * 64 + mct * 16 + fr] = dw[r]; apre[(mrt * 16 + g * 4 + r) * 64 + mct * 16 + fr] = da[r]; }
            if (wid < 4) {
                f32x4 dg = (f32x4){0.f, 0.f, 0.f, 0.f};
                const int grow = grt * 16 + fr;
#pragma unroll
                for (int s = 0; s < 4; ++s) { const bf16x8 sa_ = *(const LAS bf16x8*)(sg_i + grow * 256 + (((s * 4 + g) ^ (grow & 7)) * 16));
                    dg = __builtin_amdgcn_mfma_f32_16x16x32_bf16(sa_, gf[s], dg, 0, 0, 0); }
#pragma unroll
                for (int r = 0; r < 4; ++r) gpre[(grt * 16 + g * 4 + r) * 32 + gct * 16 + fr] = dg[r];
            }
        }
        __syncthreads();
        {
            const size_t n = nb0 + t0 + et;
            float rr[4], kr_[4];
            MIX2(l_rc.x, l_rp.x, mur[0], mur[1], rr[0], rr[1]) MIX2(l_rc.y, l_rp.y, mur[2], mur[3], rr[2], rr[3])
            MIX2(l_kc.x, l_kp.x, muk[0], muk[1], kr_[0], kr_[1]) MIX2(l_kc.y, l_kp.y, muk[2], muk[3], kr_[2], kr_[3])
            const f32x4 wp = *(const LAS f32x4*)(wpre + et * 64 + ec * 4), ap = *(const LAS f32x4*)(apre + et * 64 + ec * 4);
            float dec[4], aa[4], kkp[4], nsq = 0.f;
#pragma unroll
            for (int j = 0; j < 4; ++j) { const float z = w0v[j] + wp[j]; const float sp = __logf(1.0f + __expf(-z));
                dec[j] = __expf(-__expf(-sp - 0.5f)); aa[j] = fast_sigmoid(a0v[j] + ap[j]); kkp[j] = kr_[j] * kksc[j]; nsq += kkp[j] * kkp[j]; }
            nsq = red16(nsq);
            const float inrm = 1.0f / fmaxf(sqrtf(nsq), 1e-12f);
            f32x4 kkv, bv, khv, wrv, wv; float br = 0.f, kr2 = 0.f, rk = 0.f;
#pragma unroll
            for (int j = 0; j < 4; ++j) { const float kk = kkp[j] * inrm; const float kh = kr_[j] * (1.0f + (aa[j] - 1.0f) * kasc[j]); const float bb = kk * aa[j];
                kkv[j] = kk; bv[j] = bb; khv[j] = kh; wv[j] = dec[j]; wrv[j] = dec[j] * rr[j]; br += bb * rr[j]; kr2 += kh * rr[j]; rk += rr[j] * kh * rkv[j]; }
            br = red16(br); kr2 = red16(kr2); rk = red16(rk);
            *(LAS f32x4*)(kk_s + et * 64 + ec * 4) = kkv; *(LAS f32x4*)(w_s + et * 64 + ec * 4) = wv; *(LAS f32x4*)(b_s + et * 64 + ec * 4) = bv;
            *(LAS f32x4*)(kh_s + et * 64 + ec * 4) = khv; *(LAS f32x4*)(wr_s + et * 64 + ec * 4) = wrv;
            if (ec == 0) { sc_s[et * 2] = br; sc_s[et * 2 + 1] = kr2; }
            float v0, v1; MIX2(l_vc, l_vp, muv[0], muv[1], v0, v1)
            *(LAS f32x2*)(v_s + et * 32 + ec * 2) = (f32x2){v0, v1};
            const f32x2 gp = *(const LAS f32x2*)(gpre + et * 32 + ec * 2);
            *(unsigned*)(e1g + n * 512 + h * 64 + rq * 32 + ec * 2) = cvt_pk_bf16(rk * v0, rk * v1);
            *(unsigned*)(gg + n * 512 + h * 64 + rq * 32 + ec * 2) = cvt_pk_bf16(gp[0], gp[1]);
        }
        if (prep_rep + 1 < PREP_REP) __syncthreads();
        }
        if (t0 + TC < SEQ) RW_ISSUE(t0 + TC);
        __syncthreads();
        {
            f32x4 kkA = *(const LAS f32x4*)(kk_s + kq * 4), wrA = *(const LAS f32x4*)(wr_s + kq * 4), wwA = *(const LAS f32x4*)(w_s + kq * 4), bbA = *(const LAS f32x4*)(b_s + kq * 4), khA = *(const LAS f32x4*)(kh_s + kq * 4);
            float vvA = v_s[rl]; f32x2 scA = *(const LAS f32x2*)(sc_s);
            float yacc = 0.f;
#pragma unroll 1
            for (int t = 0; t < TC; ++t) {
                const int tn = (t + 1) & (TC - 1);
                const f32x4 kkB = *(const LAS f32x4*)(kk_s + tn * 64 + kq * 4), wrB = *(const LAS f32x4*)(wr_s + tn * 64 + kq * 4), wwB = *(const LAS f32x4*)(w_s + tn * 64 + kq * 4);
                const f32x4 bbB = *(const LAS f32x4*)(b_s + tn * 64 + kq * 4), khB = *(const LAS f32x4*)(kh_s + tn * 64 + kq * 4);
                const float vvB = v_s[tn * 32 + rl]; const f32x2 scB = *(const LAS f32x2*)(sc_s + tn * 2);
                float sa = S[0] * kkA[0] + S[1] * kkA[1] + S[2] * kkA[2] + S[3] * kkA[3];
                float yy = S[0] * wrA[0] + S[1] * wrA[1] + S[2] * wrA[2] + S[3] * wrA[3];
                sa = red16(sa); yy = red16(yy);
                const float y = yy - sa * scA[0] + vvA * scA[1];
                yacc = (kq == (t & 15)) ? y : yacc;
#pragma unroll
                for (int i = 0; i < 4; ++i) S[i] = S[i] * wwA[i] + (vvA * khA[i] - sa * bbA[i]);
                if ((t & 15) == 15) y_s[((t & 16) + kq) * 32 + rl] = yacc;
                kkA = kkB; wrA = wrB; wwA = wwB; bbA = bbB; khA = khB; vvA = vvB; scA = scB;
            }
        }
        __syncthreads();
        { const int tok = tid >> 4, c2 = (tid & 15) * 2; *(f32x2*)(yraw + (nb0 + t0 + tok) * 512 + h * 64 + rq * 32 + c2) = *(const LAS f32x2*)(y_s + tok * 32 + c2); }
    }
#undef MIX2
#undef RW_ISSUE
}

__device__ __forceinline__ void phase_rwkv_epi(const Params& p, int bid, int nb) {
    const int tid = opaque_tid(), wid = tid >> 6, lane = tid & 63;
    const float* yraw = p.out; const bf16_t* e1g = (const bf16_t*)(p.out + (size_t)NTOK * 512); const bf16_t* gg = e1g + (size_t)NTOK * 512;
    bf16_t* mix = (bf16_t*)(p.ws + OFF_BUF64);
    const f32x4 g0 = *(const f32x4*)(p.in[I_AGNG] + lane * 8), g1 = *(const f32x4*)(p.in[I_AGNG] + lane * 8 + 4), b0 = *(const f32x4*)(p.in[I_AGNB] + lane * 8), b1 = *(const f32x4*)(p.in[I_AGNB] + lane * 8 + 4);
    for (int n = bid * 8 + wid; n < NTOK; n += nb * 8) {
        const f32x4 y0 = *(const f32x4*)(yraw + (size_t)n * 512 + lane * 8), y1 = *(const f32x4*)(yraw + (size_t)n * 512 + lane * 8 + 4);
        const u32x4 ev = *(const u32x4*)(e1g + (size_t)n * 512 + lane * 8), gv = *(const u32x4*)(gg + (size_t)n * 512 + lane * 8);
        float s = (y0[0] + y0[1]) + (y0[2] + y0[3]) + (y1[0] + y1[1]) + (y1[2] + y1[3]);
        s = red8(s); const float mean = s * (1.0f / 64.0f);
        const f32x4 d0 = y0 - mean, d1 = y1 - mean;
        float q = (d0[0] * d0[0] + d0[1] * d0[1]) + (d0[2] * d0[2] + d0[3] * d0[3]) + (d1[0] * d1[0] + d1[1] * d1[1]) + (d1[2] * d1[2] + d1[3] * d1[3]);
        q = red8(q); const float rs = rsqrtf(q * (1.0f / 64.0f) + 64e-5f);
        float o[8];
        const unsigned ew[4] = {ev.x, ev.y, ev.z, ev.w}, gw[4] = {gv.x, gv.y, gv.z, gv.w};
#pragma unroll
        for (int j = 0; j < 4; ++j) { const float ya = (j < 2 ? d0[2 * j] : d1[2 * j - 4]), yb = (j < 2 ? d0[2 * j + 1] : d1[2 * j - 3]);
            const float ga = (j < 2 ? g0[2 * j] : g1[2 * j - 4]), gb_ = (j < 2 ? g0[2 * j + 1] : g1[2 * j - 3]); const float ba = (j < 2 ? b0[2 * j] : b1[2 * j - 4]), bb_ = (j < 2 ? b0[2 * j + 1] : b1[2 * j - 3]);
            o[2 * j] = (ya * rs * ga + ba + __uint_as_float(ew[j] << 16)) * __uint_as_float(gw[j] << 16);
            o[2 * j + 1] = (yb * rs * gb_ + bb_ + __uint_as_float(ew[j] & 0xffff0000u)) * __uint_as_float(gw[j] & 0xffff0000u); }
        u32x4 w; w.x = cvt_pk_bf16(o[0], o[1]); w.y = cvt_pk_bf16(o[2], o[3]); w.z = cvt_pk_bf16(o[4], o[5]); w.w = cvt_pk_bf16(o[6], o[7]);
        *(u32x4*)(mix + (size_t)n * DM + lane * 8) = w;
    }
}

__device__ __forceinline__ int gla_fT(int row) { return ((row >> 1) & 1) | (((row >> 3) & 1) << 1); }
__device__ __forceinline__ int gla_hV(int row) { return (row & 3) | (((row >> 3) & 1) << 2); }
__device__ __forceinline__ void gla2_item(const Params& p, LAS unsigned char* lds, int item) {
    const int tid = opaque_tid(), lane = tid & 63, wid = tid >> 6, fr = lane & 15, g = lane >> 4;
    const int b = item >> 2, h = item & 3;
    const bf16_t* P0 = (const bf16_t*)(p.ws + OFF_P) + 1792;
    const float* xa16 = (const float*)(p.ws + OFF_U);
    bf16_t* mix = (bf16_t*)(p.ws + OFF_BUF64);
    LAS float* bcf = (LAS float*)lds;
    LAS float* tot = bcf + 64 * 64;
    LAS float* bls = tot + 8 * 64;
    LAS float* pn = bls + 64;
    LAS unsigned char* qd_i = (LAS unsigned char*)(pn + 64 * 8);
    LAS unsigned char* ki_a = qd_i + 8192;
    LAS unsigned char* ki_t = ki_a + 8192;
    LAS unsigned char* att_i = ki_t + 8192;
    LAS unsigned char* v_i = att_i + 8192;
    for (int i = tid; i < 8192 / 16; i += 512) *(LAS u32x4*)(att_i + i * 16) = (u32x4){0u, 0u, 0u, 0u};
    float gw2[16];
#pragma unroll
    for (int i = 0; i < 16; ++i) gw2[i] = p.in[I_BGW2][i * 256 + h * 64 + lane];
    const float gb = p.in[I_BGB][h * 64 + lane];
    const f32x4 ngv = *(const f32x4*)(p.in[I_BNG] + h * 128 + wid * 16 + g * 4);
    f32x4 Sacc[4];
#pragma unroll
    for (int rt = 0; rt < 4; ++rt) Sacc[rt] = (f32x4){0.f, 0.f, 0.f, 0.f};
    const int q4 = fr >> 2, p4 = fr & 3;
    __syncthreads();
    for (int c0 = 0; c0 < SEQ; c0 += 64) {
        const size_t n0 = (size_t)b * SEQ + c0;
        { float run = 0.f;
#pragma unroll
            for (int tt = 0; tt < 8; ++tt) { const int c = wid * 8 + tt; const float* xr = xa16 + (n0 + c) * 16; float z = gb;
#pragma unroll
                for (int i = 0; i < 16; ++i) z += xr[i] * gw2[i];
                const float ls = (z >= 0.f) ? -log1pf(__expf(-z)) : (z - log1pf(__expf(z)));
                run += ls * (1.0f / 16.0f); bcf[c * 64 + lane] = run; }
            tot[wid * 64 + lane] = run; }
        __syncthreads();
        { float off = 0.f;
            for (int w2 = 0; w2 < wid; ++w2) off += tot[w2 * 64 + lane];
#pragma unroll
            for (int tt = 0; tt < 8; ++tt) bcf[(wid * 8 + tt) * 64 + lane] += off;
            if (wid == 7) bls[lane] = __expf(bcf[63 * 64 + lane]); }
        __syncthreads();
        { const int tok = tid >> 3, dc = tid & 7; const size_t n = n0 + tok;
            const u32x4 qv = *(const u32x4*)(P0 + n * NE_MAIN + h * 64 + dc * 8), kv = *(const u32x4*)(P0 + n * NE_MAIN + 256 + h * 64 + dc * 8);
            const f32x4 bc0 = *(const LAS f32x4*)(bcf + tok * 64 + dc * 8), bc1 = *(const LAS f32x4*)(bcf + tok * 64 + dc * 8 + 4);
            const unsigned qw[4] = {qv.x, qv.y, qv.z, qv.w}, kw[4] = {kv.x, kv.y, kv.z, kv.w};
            float qo[8], ko[8];
#pragma unroll
            for (int j = 0; j < 4; ++j) { const float ba = (j < 2 ? bc0[2 * j] : bc1[2 * j - 4]), bb = (j < 2 ? bc0[2 * j + 1] : bc1[2 * j - 3]);
                const float ea = __expf(ba), eb = __expf(bb);
                qo[2 * j] = __uint_as_float(qw[j] << 16) * 0.125f * ea; qo[2 * j + 1] = __uint_as_float(qw[j] & 0xffff0000u) * 0.125f * eb;
                ko[2 * j] = __uint_as_float(kw[j] << 16) / ea; ko[2 * j + 1] = __uint_as_float(kw[j] & 0xffff0000u) / eb; }
            u32x4 qp, kp; qp.x = cvt_pk_bf16(qo[0], qo[1]); qp.y = cvt_pk_bf16(qo[2], qo[3]); qp.z = cvt_pk_bf16(qo[4], qo[5]); qp.w = cvt_pk_bf16(qo[6], qo[7]);
            kp.x = cvt_pk_bf16(ko[0], ko[1]); kp.y = cvt_pk_bf16(ko[2], ko[3]); kp.z = cvt_pk_bf16(ko[4], ko[5]); kp.w = cvt_pk_bf16(ko[6], ko[7]);
            *(LAS u32x4*)(qd_i + tok * 128 + ((dc ^ (tok & 7)) * 16)) = qp;
            *(LAS u32x4*)(ki_a + tok * 128 + ((dc ^ (tok & 7)) * 16)) = kp;
            *(LAS u32x4*)(ki_t + tok * 128 + (((((dc >> 1) ^ gla_fT(tok)) << 1) | (dc & 1)) * 16)) = kp;
#pragma unroll
            for (int i = 0; i < 2; ++i) { const int vc = dc * 2 + i; const u32x4 vv_ = *(const u32x4*)(P0 + n * NE_MAIN + 512 + h * 128 + vc * 8);
                *(LAS u32x4*)(v_i + tok * 256 + (((((vc >> 1) ^ gla_hV(tok)) << 1) | (vc & 1)) * 16)) = vv_; } }
        __syncthreads();
        for (int ti = wid; ti < 10; ti += 8) {
            int st, ct; { const int tb[10] = {0x00, 0x01, 0x02, 0x03, 0x11, 0x12, 0x13, 0x22, 0x23, 0x33}; int code = 0;
#pragma unroll
                for (int k = 0; k < 10; ++k) if (k == ti) code = tb[k];
                st = code >> 4; ct = code & 15; }
            f32x4 d = (f32x4){0.f, 0.f, 0.f, 0.f};
            const int rs_ = st * 16 + fr, rc_ = ct * 16 + fr;
#pragma unroll
            for (int s = 0; s < 2; ++s) {
                const bf16x8 a = *(const LAS bf16x8*)(ki_a + rs_ * 128 + (((s * 4 + g) ^ (rs_ & 7)) * 16));
                const bf16x8 bq = *(const LAS bf16x8*)(qd_i + rc_ * 128 + (((s * 4 + g) ^ (rc_ & 7)) * 16));
                d = __builtin_amdgcn_mfma_f32_16x16x32_bf16(a, bq, d, 0, 0, 0); }
            const int c = ct * 16 + fr; float o4[4];
#pragma unroll
            for (int r = 0; r < 4; ++r) { const int s_ = st * 16 + g * 4 + r; o4[r] = (s_ <= c) ? d[r] : 0.f; }
            u32x2 w; w.x = cvt_pk_bf16(o4[0], o4[1]); w.y = cvt_pk_bf16(o4[2], o4[3]);
            *(LAS u32x2*)(att_i + c * 128 + (((2 * st + (g >> 1)) ^ (c & 7)) * 16) + (g & 1) * 8) = w;
        }
        __syncthreads();
        {
            bf16x8 vf[2];
#pragma unroll
            for (int s = 0; s < 2; ++s) {
                const int r1 = s * 32 + g * 8 + q4, r2 = r1 + 4; const int c = 2 * wid + (p4 >> 1);
                const s16x4 lo = __builtin_amdgcn_ds_read_tr16_b64_v4i16((LAS s16x4*)(v_i + r1 * 256 + (((((c >> 1) ^ gla_hV(r1)) << 1) | (c & 1)) * 16) + (p4 & 1) * 8));
                const s16x4 hi = __builtin_amdgcn_ds_read_tr16_b64_v4i16((LAS s16x4*)(v_i + r2 * 256 + (((((c >> 1) ^ gla_hV(r2)) << 1) | (c & 1)) * 16) + (p4 & 1) * 8));
                vf[s] = (bf16x8){lo[0], lo[1], lo[2], lo[3], hi[0], hi[1], hi[2], hi[3]}; }
            bf16x8 sf[2];
#pragma unroll
            for (int s = 0; s < 2; ++s) { u32x4 w; w.x = cvt_pk_bf16(Sacc[2 * s][0], Sacc[2 * s][1]); w.y = cvt_pk_bf16(Sacc[2 * s][2], Sacc[2 * s][3]);
                w.z = cvt_pk_bf16(Sacc[2 * s + 1][0], Sacc[2 * s + 1][1]); w.w = cvt_pk_bf16(Sacc[2 * s + 1][2], Sacc[2 * s + 1][3]); sf[s] = __builtin_bit_cast(bf16x8, w); }
            f32x4 oacc[4];
#pragma unroll
            for (int ct = 0; ct < 4; ++ct) {
                const int c = ct * 16 + fr; f32x4 d = (f32x4){0.f, 0.f, 0.f, 0.f};
#pragma unroll
                for (int s = 0; s < 2; ++s) {
                    const bf16x8 ab = *(const LAS bf16x8*)(att_i + c * 128 + (((s * 4 + g) ^ (c & 7)) * 16));
                    d = __builtin_amdgcn_mfma_f32_16x16x32_bf16(vf[s], ab, d, 0, 0, 0);
                    const s16x4 q0 = *(const LAS s16x4*)(qd_i + c * 128 + (((s * 4 + (g >> 1)) ^ (c & 7)) * 16) + (g & 1) * 8);
                    const s16x4 q1 = *(const LAS s16x4*)(qd_i + c * 128 + (((s * 4 + 2 + (g >> 1)) ^ (c & 7)) * 16) + (g & 1) * 8);
                    const bf16x8 qb = (bf16x8){q0[0], q0[1], q0[2], q0[3], q1[0], q1[1], q1[2], q1[3]};
                    d = __builtin_amdgcn_mfma_f32_16x16x32_bf16(sf[s], qb, d, 0, 0, 0); }
                oacc[ct] = d; }
#pragma unroll
            for (int rt = 0; rt < 4; ++rt) {
#pragma unroll
                for (int s = 0; s < 2; ++s) {
                    const int r1 = s * 32 + g * 8 + q4, r2 = r1 + 4; const int c = 2 * rt + (p4 >> 1);
                    const s16x4 lo = __builtin_amdgcn_ds_read_tr16_b64_v4i16((LAS s16x4*)(ki_t + r1 * 128 + (((((c >> 1) ^ gla_fT(r1)) << 1) | (c & 1)) * 16) + (p4 & 1) * 8));
                    const s16x4 hi = __builtin_amdgcn_ds_read_tr16_b64_v4i16((LAS s16x4*)(ki_t + r2 * 128 + (((((c >> 1) ^ gla_fT(r2)) << 1) | (c & 1)) * 16) + (p4 & 1) * 8));
                    const bf16x8 kf = (bf16x8){lo[0], lo[1], lo[2], lo[3], hi[0], hi[1], hi[2], hi[3]};
                    Sacc[rt] = __builtin_amdgcn_mfma_f32_16x16x32_bf16(kf, vf[s], Sacc[rt], 0, 0, 0); }
                const f32x4 eb = *(const LAS f32x4*)(bls + rt * 16 + g * 4);
                Sacc[rt] = Sacc[rt] * eb; }
#pragma unroll
            for (int ct = 0; ct < 4; ++ct) { float ss = oacc[ct][0] * oacc[ct][0] + oacc[ct][1] * oacc[ct][1] + oacc[ct][2] * oacc[ct][2] + oacc[ct][3] * oacc[ct][3];
                ss += __shfl_xor(ss, 16); ss += __shfl_xor(ss, 32);
                if (g == 0) pn[(ct * 16 + fr) * 8 + wid] = ss; }
            __syncthreads();
#pragma unroll
            for (int ct = 0; ct < 4; ++ct) { const int c = ct * 16 + fr;
                const f32x4 a0 = *(const LAS f32x4*)(pn + c * 8), a1 = *(const LAS f32x4*)(pn + c * 8 + 4);
                const float ss = (a0[0] + a0[1]) + (a0[2] + a0[3]) + (a1[0] + a1[1]) + (a1[2] + a1[3]);
                const float rs = rsqrtf(ss * (1.0f / 128.0f) + 1e-5f);
                const u32x2 gv = *(const u32x2*)(P0 + (n0 + c) * NE_MAIN + 1024 + h * 128 + wid * 16 + g * 4);
                const float g0 = __uint_as_float(gv.x << 16), g1 = __uint_as_float(gv.x & 0xffff0000u), g2 = __uint_as_float(gv.y << 16), g3 = __uint_as_float(gv.y & 0xffff0000u);
                const float v0 = oacc[ct][0] * rs * ngv[0] * (g0 / (1.0f + __expf(-g0))), v1 = oacc[ct][1] * rs * ngv[1] * (g1 / (1.0f + __expf(-g1)));
                const float v2 = oacc[ct][2] * rs * ngv[2] * (g2 / (1.0f + __expf(-g2))), v3 = oacc[ct][3] * rs * ngv[3] * (g3 / (1.0f + __expf(-g3)));
                u32x2 w; w.x = cvt_pk_bf16(v0, v1); w.y = cvt_pk_bf16(v2, v3);
                *(u32x2*)(mix + (n0 + c) * DM + 512 + h * 128 + wid * 16 + g * 4) = w; }
        }
    }
}

__device__ __forceinline__ void phase_mixer_even(const Params& p, LAS unsigned char* lds, int bid, int nb, int which) {
    for (int item = bid; item < 160; item += nb) {
        if (which != 2 && item < 128) rwkv2_item(p, lds, item); else if (which != 1 && item >= 128) gla2_item(p, lds, item - 128);
        __syncthreads();
    }
}

__device__ __forceinline__ void phase_rope(const Params& p, int bid, int nb) {
    const int tid = opaque_tid(), wid = tid >> 6, lane = tid & 63;
    unsigned char* ws = p.ws;
    const bf16_t* Pd = (const bf16_t*)(ws + OFF_PD);
    bf16_t* qr = (bf16_t*)(ws + OFF_BUF64); bf16_t* kr = (bf16_t*)(ws + OFF_KR); bf16_t* vv = (bf16_t*)(ws + OFF_VV);
    bf16_t* iqr = (bf16_t*)(ws + OFF_IQR); bf16_t* ikr = (bf16_t*)(ws + OFF_IKR); float* iw = (float*)(ws + OFF_IW);
    const float* c64 = (const float*)(ws + OFF_ROPE); const float* s64 = c64 + 4096 * 64; const float* c32 = s64 + 4096 * 64; const float* s32 = c32 + 4096 * 32;
    const float ikg = p.in[I_CIKG][lane], ikb = p.in[I_CIKB][lane];
    for (int n = bid * 8 + wid; n < NTOK; n += nb * 8) {
        const int pos = n & (SEQ - 1);
        const bf16_t* row = Pd + (size_t)n * NO_MAIN;
        const float c = c64[pos * 64 + lane], s = s64[pos * 64 + lane];
#pragma unroll
        for (int h = 0; h < 8; ++h) { const float z1 = bf2f(row[h * 128 + lane]), z2 = bf2f(row[h * 128 + 64 + lane]);
            qr[(size_t)n * 1024 + h * 128 + lane] = f2bf((z1 * c - z2 * s) * 0.08838834764831845f);
            qr[(size_t)n * 1024 + h * 128 + 64 + lane] = f2bf((z2 * c + z1 * s) * 0.08838834764831845f); }
        { const float z1 = bf2f(row[1024 + lane]), z2 = bf2f(row[1024 + 64 + lane]);
            kr[(size_t)n * 128 + lane] = f2bf(z1 * c - z2 * s); kr[(size_t)n * 128 + 64 + lane] = f2bf(z2 * c + z1 * s); }
        vv[(size_t)n * 128 + lane] = row[1152 + lane]; vv[(size_t)n * 128 + 64 + lane] = row[1152 + 64 + lane];
        const int j32 = lane & 31; const float cc = c32[pos * 32 + j32], ss = s32[pos * 32 + j32];
#pragma unroll
        for (int r = 0; r < 2; ++r) { const int h = (lane >> 5) + 2 * r; const float z1 = bf2f(row[1280 + h * 64 + j32]), z2 = bf2f(row[1280 + h * 64 + 32 + j32]);
            iqr[(size_t)n * 256 + h * 64 + j32] = f2bf((z1 * cc - z2 * ss) * 0.125f); iqr[(size_t)n * 256 + h * 64 + 32 + j32] = f2bf((z2 * cc + z1 * ss) * 0.125f); }
        { const float x = bf2f(row[1536 + lane]); const float mean = wave_sum(x) * (1.0f / 64.0f); const float d = x - mean; const float var = wave_sum(d * d) * (1.0f / 64.0f);
            const float y = d * rsqrtf(var + LN_EPS) * ikg + ikb; const float o = __shfl_xor(y, 32);
            const float res = lane < 32 ? (y * cc - o * ss) : (y * cc + o * ss);
            ikr[(size_t)n * 64 + lane] = f2bf(res); }
        if (lane < 4) iw[(size_t)n * 4 + lane] = bf2f(row[1600 + lane]) * 0.5f;
    }
}

__device__ __forceinline__ void phase_index(const Params& p, LAS unsigned char* lds, int bid, int nb) {
    const int tid = opaque_tid(), wid = tid >> 6, lane = tid & 63;
    unsigned char* ws = p.ws;
    const bf16_t* iqr = (const bf16_t*)(ws + OFF_IQR); const bf16_t* ikr = (const bf16_t*)(ws + OFF_IKR); const float* iw = (const float*)(ws + OFF_IW);
    unsigned short* idx = (unsigned short*)(ws + OFF_IDX);
    LAS unsigned* sc = (LAS unsigned*)lds + wid * 4096;
    LAS int* hist = (LAS int*)(lds + 131072) + wid * 256;
    LAS float* iqs = (LAS float*)(lds + 131072 + 8192) + wid * 256;
    const unsigned long long lt_mask = (1ull << lane) - 1ull;
    for (int n = bid * 8 + wid; n < NTOK; n += nb * 8) {
        const int t = n & (SEQ - 1), b = n >> 12, nv = t + 1;
        unsigned short* out = idx + (size_t)n * 256;
        if (nv <= 256) { for (int j = lane; j < 256; j += 64) out[j] = (unsigned short)(j < nv ? j : 0); continue; }
#pragma unroll
        for (int j = 0; j < 4; ++j) iqs[lane * 4 + j] = bf2f(iqr[(size_t)n * 256 + lane * 4 + j]);
        const float w0 = iw[(size_t)n * 4 + 0], w1 = iw[(size_t)n * 4 + 1], w2 = iw[(size_t)n * 4 + 2], w3 = iw[(size_t)n * 4 + 3];
        const int nvp = (nv + 63) & ~63;
        for (int c0 = 0; c0 < nvp; c0 += 64) {
            const int key = c0 + lane; const bool valid = key < nv;
            float kf[64];
            const u32x4* kp = (const u32x4*)(ikr + ((size_t)b * SEQ + (valid ? key : 0)) * 64);
#pragma unroll
            for (int q = 0; q < 8; ++q) { const u32x4 w = kp[q];
                kf[q * 8 + 0] = __uint_as_float(w.x << 16); kf[q * 8 + 1] = __uint_as_float(w.x & 0xffff0000u); kf[q * 8 + 2] = __uint_as_float(w.y << 16); kf[q * 8 + 3] = __uint_as_float(w.y & 0xffff0000u);
                kf[q * 8 + 4] = __uint_as_float(w.z << 16); kf[q * 8 + 5] = __uint_as_float(w.z & 0xffff0000u); kf[q * 8 + 6] = __uint_as_float(w.w << 16); kf[q * 8 + 7] = __uint_as_float(w.w & 0xffff0000u); }
            float sh[4];
#pragma unroll
            for (int h = 0; h < 4; ++h) { float a = 0.f;
#pragma unroll
                for (int d4 = 0; d4 < 16; ++d4) { const f32x4 qv = *(const LAS f32x4*)(iqs + h * 64 + d4 * 4); a += qv[0] * kf[d4 * 4] + qv[1] * kf[d4 * 4 + 1] + qv[2] * kf[d4 * 4 + 2] + qv[3] * kf[d4 * 4 + 3]; }
                sh[h] = fmaxf(a, 0.f); }
            float score = sh[0] * w0 + sh[1] * w1 + sh[2] * w2 + sh[3] * w3;
            score += 0.0f;
            unsigned u = __float_as_uint(score); u = (u & 0x80000000u) ? ~u : (u | 0x80000000u);
            sc[key] = valid ? u : 0u;
        }
        unsigned prefix = 0; int need = 256;
#pragma unroll 1
        for (int pass = 3; pass >= 0; --pass) {
            const int shift = pass * 8;
#pragma unroll
            for (int j = 0; j < 4; ++j) hist[lane * 4 + j] = 0;
            for (int c0 = 0; c0 < nvp; c0 += 64) { const unsigned u = sc[c0 + lane];
                const bool match = (c0 + lane < nv) && (pass == 3 || (u >> (shift + 8)) == prefix);
                if (match) __hip_atomic_fetch_add(hist + ((u >> shift) & 255u), 1, __ATOMIC_RELAXED, __HIP_MEMORY_SCOPE_WORKGROUP); }
            int hb[4];
#pragma unroll
            for (int j = 0; j < 4; ++j) hb[j] = hist[lane * 4 + j];
            const int tot = hb[0] + hb[1] + hb[2] + hb[3];
            int suf = tot;
#pragma unroll
            for (int off = 1; off < 64; off <<= 1) { const int v = __shfl_down(suf, off); if (lane + off < 64) suf += v; }
            const int above = suf - tot;
            const bool is = (above < need) && (need <= suf);
            int bin = 0, nneed = 0;
            if (is) { int c = above;
#pragma unroll
                for (int k = 3; k >= 0; --k) { if (nneed == 0) { if (need <= c + hb[k]) { bin = lane * 4 + k; nneed = need - c; } else c += hb[k]; } } }
            const unsigned long long bal = __ballot(is);
            const int src = __ffsll((long long)bal) - 1;
            bin = __shfl(bin, src); nneed = __shfl(nneed, src);
            prefix = (prefix << 8) | (unsigned)bin; need = nneed;
        }
        const unsigned T = prefix;
        int base = 0, ties = 0;
        for (int c0 = 0; c0 < nvp; c0 += 64) { const int key = c0 + lane; const unsigned u = sc[key]; const bool valid = key < nv;
            const bool gt = valid && u > T, eq = valid && u == T;
            const unsigned long long beq = __ballot(eq);
            const int rank = ties + __popcll(beq & lt_mask);
            const bool take = gt || (eq && rank < need);
            const unsigned long long bt = __ballot(take);
            const int pos = base + __popcll(bt & lt_mask);
            if (take && pos < 256) out[pos] = (unsigned short)key;
            base += __popcll(bt); ties += __popcll(beq); }
    }
}

__device__ __forceinline__ void phase_attn(const Params& p, LAS unsigned char* lds, int bid, int nb) {
    const int tid = opaque_tid(), wid = tid >> 6, lane = tid & 63;
    unsigned char* ws = p.ws;
    const bf16_t* qr = (const bf16_t*)(ws + OFF_BUF64); const bf16_t* kr = (const bf16_t*)(ws + OFF_KR); const bf16_t* vv = (const bf16_t*)(ws + OFF_VV);
    const unsigned short* idx = (const unsigned short*)(ws + OFF_IDX);
    bf16_t* ao = (bf16_t*)(ws + OFF_PD);
    LAS float* qs = (LAS float*)lds + wid * 1024;
    LAS float* ps = (LAS float*)(lds + 32768) + wid * 2048;
    LAS int* ks = (LAS int*)(lds + 32768 + 65536) + wid * 256;
    for (int n = bid * 8 + wid; n < NTOK; n += nb * 8) {
        const int t = n & (SEQ - 1), b = n >> 12, cnt = (t + 1) < 256 ? (t + 1) : 256;
        asm volatile("" ::: "memory");
#pragma unroll
        for (int j = 0; j < 16; ++j) qs[j * 64 + lane] = bf2f(qr[(size_t)n * 1024 + j * 64 + lane]);
#pragma unroll
        for (int r = 0; r < 4; ++r) ks[r * 64 + lane] = idx[(size_t)n * 256 + r * 64 + lane];
#pragma unroll 1
        for (int r = 0; r < 4; ++r) {
            const int j = r * 64 + lane; const bool valid = j < cnt; const int key = valid ? ks[j] : 0;
            const u32x4* kp = (const u32x4*)(kr + ((size_t)b * SEQ + key) * 128);
            float kf[128];
#pragma unroll
            for (int q = 0; q < 16; ++q) { const u32x4 w = kp[q];
                kf[q * 8 + 0] = __uint_as_float(w.x << 16); kf[q * 8 + 1] = __uint_as_float(w.x & 0xffff0000u); kf[q * 8 + 2] = __uint_as_float(w.y << 16); kf[q * 8 + 3] = __uint_as_float(w.y & 0xffff0000u);
                kf[q * 8 + 4] = __uint_as_float(w.z << 16); kf[q * 8 + 5] = __uint_as_float(w.z & 0xffff0000u); kf[q * 8 + 6] = __uint_as_float(w.w << 16); kf[q * 8 + 7] = __uint_as_float(w.w & 0xffff0000u); }
#pragma unroll 1
            for (int h = 0; h < 8; ++h) { float a = 0.f;
#pragma unroll
                for (int d4 = 0; d4 < 32; ++d4) { const f32x4 qv = *(const LAS f32x4*)(qs + h * 128 + d4 * 4);
                    a += qv[0] * kf[d4 * 4] + qv[1] * kf[d4 * 4 + 1] + qv[2] * kf[d4 * 4 + 2] + qv[3] * kf[d4 * 4 + 3]; }
                ps[h * 256 + j] = valid ? a : -INFINITY; }
        }
#pragma unroll
        for (int h = 0; h < 8; ++h) { float x[4]; float m = -INFINITY;
#pragma unroll
            for (int r = 0; r < 4; ++r) { x[r] = ps[h * 256 + r * 64 + lane]; m = fmaxf(m, x[r]); }
#pragma unroll
            for (int o = 32; o > 0; o >>= 1) m = fmaxf(m, __shfl_xor(m, o));
            float s = 0.f;
#pragma unroll
            for (int r = 0; r < 4; ++r) { x[r] = expf(x[r] - m); s += x[r]; }
            s = wave_sum(s); const float inv = 1.0f / s;
#pragma unroll
            for (int r = 0; r < 4; ++r) ps[h * 256 + r * 64 + lane] = x[r] * inv; }
        float o0[8], o1[8];
#pragma unroll
        for (int h = 0; h < 8; ++h) { o0[h] = 0.f; o1[h] = 0.f; }
        for (int j = 0; j < cnt; ++j) { const int key = ks[j];
            const unsigned w = *(const unsigned*)(vv + ((size_t)b * SEQ + key) * 128 + 2 * lane);
            const float v0 = __uint_as_float(w << 16), v1 = __uint_as_float(w & 0xffff0000u);
#pragma unroll
            for (int h = 0; h < 8; ++h) { const float pj = ps[h * 256 + j]; o0[h] += pj * v0; o1[h] += pj * v1; } }
#pragma unroll
        for (int h = 0; h < 8; ++h) *(unsigned*)(ao + (size_t)n * 1024 + h * 128 + 2 * lane) = cvt_pk_bf16(o0[h], o1[h]);
    }
}

__device__ __forceinline__ int idx_bin(float s, float lo, float scale) { int b = (int)((s - lo) * scale); b = b < 0 ? 0 : b; return b > 255 ? 255 : b; }
__device__ __forceinline__ void phase_index2(const Params& p, LAS unsigned char* lds, int bid, int nb) {
    const int tid = opaque_tid(), wid = tid >> 6, lane = tid & 63, fr = lane & 15, g = lane >> 4;
    unsigned char* ws = p.ws;
    const bf16_t* iqr = (const bf16_t*)(ws + OFF_IQR); const bf16_t* ikr = (const bf16_t*)(ws + OFF_IKR); const float* iw = (const float*)(ws + OFF_IW);
    unsigned short* idx = (unsigned short*)(ws + OFF_IDX);
    LAS float* sc = (LAS float*)lds;
    LAS int* hist = (LAS int*)(lds + 131072) + wid * 256;
    LAS float* cand = (LAS float*)(lds + 131072 + 8192) + wid * 64;
    const unsigned long long lt_mask = (1ull << lane) - 1ull;
    for (int qt = bid; qt < NTOK / 8; qt += nb) {
        const int n0 = qt * 8, t0 = n0 & (SEQ - 1), b = n0 >> 12;
        asm volatile("" ::: "memory");
        if (t0 + 8 > 256) {
            bf16x8 af[2][2];
#pragma unroll
            for (int hh = 0; hh < 2; ++hh)
#pragma unroll
                for (int s = 0; s < 2; ++s) af[hh][s] = *(const bf16x8*)(iqr + (size_t)(n0 + (fr & 7)) * 256 + (2 * hh + (fr >> 3)) * 64 + s * 32 + g * 8);
            float w0[4], w1[4];
#pragma unroll
            for (int r = 0; r < 4; ++r) { const int q = 4 * (g & 1) + r; w0[r] = iw[(size_t)(n0 + q) * 4 + (g >> 1)]; w1[r] = iw[(size_t)(n0 + q) * 4 + 2 + (g >> 1)]; }
            const int nkt = (t0 + 8 + 15) >> 4;
            const bf16_t* kb = ikr + (size_t)b * SEQ * 64;
            for (int kt = wid; kt < nkt; kt += 8) {
                const bf16_t* kp = kb + (size_t)(kt * 16 + fr) * 64 + g * 8;
                const bf16x8 b0 = *(const bf16x8*)kp, b1 = *(const bf16x8*)(kp + 32);
                f32x4 d0 = (f32x4){0.f, 0.f, 0.f, 0.f}, d1 = (f32x4){0.f, 0.f, 0.f, 0.f};
                d0 = __builtin_amdgcn_mfma_f32_16x16x32_bf16(af[0][0], b0, d0, 0, 0, 0); d0 = __builtin_amdgcn_mfma_f32_16x16x32_bf16(af[0][1], b1, d0, 0, 0, 0);
                d1 = __builtin_amdgcn_mfma_f32_16x16x32_bf16(af[1][0], b0, d1, 0, 0, 0); d1 = __builtin_amdgcn_mfma_f32_16x16x32_bf16(af[1][1], b1, d1, 0, 0, 0);
#pragma unroll
                for (int r = 0; r < 4; ++r) { float v = fmaxf(d0[r], 0.f) * w0[r] + fmaxf(d1[r], 0.f) * w1[r]; v += __shfl_xor(v, 32); v += 0.0f;
                    if (g < 2) sc[(4 * g + r) * 4096 + kt * 16 + fr] = v; }
            }
        }
        __syncthreads();
        {
            const int n = n0 + wid, t = t0 + wid, nv = t + 1;
            unsigned short* out = idx + (size_t)n * 256;
            if (nv <= 256) { for (int j = lane; j < 256; j += 64) out[j] = (unsigned short)(j < nv ? j : 0); }
            else {
                LAS const float* srow = sc + wid * 4096;
                const int nvp = (nv + 63) & ~63;
                float lo, hi;
                { float mn = INFINITY, mx = -INFINITY;
                    for (int c0 = 0; c0 < nvp; c0 += 64) { const float s = srow[c0 + lane]; if (c0 + lane < nv) { mn = fminf(mn, s); mx = fmaxf(mx, s); } }
#pragma unroll
                    for (int o = 32; o > 0; o >>= 1) { mn = fminf(mn, __shfl_xor(mn, o)); mx = fmaxf(mx, __shfl_xor(mx, o)); }
                    lo = mn; hi = mx; }
                float lo1 = 0.f, sc1 = 0.f, lo2 = 0.f, sc2 = 0.f, lo3 = 0.f, sc3 = 0.f; int b1 = 0, b2 = 0, b3 = 0, nlev = 0;
                int m = nv, need = 256;
#define IDX_CLASSIFY(s, cls) do { cls = 1; \
                    if (nlev >= 1) { const int bb = idx_bin(s, lo1, sc1); if (bb != b1) cls = bb > b1 ? 2 : 0; } \
                    if (cls == 1 && nlev >= 2) { const int bb = idx_bin(s, lo2, sc2); if (bb != b2) cls = bb > b2 ? 2 : 0; } \
                    if (cls == 1 && nlev >= 3) { const int bb = idx_bin(s, lo3, sc3); if (bb != b3) cls = bb > b3 ? 2 : 0; } } while (0)
#pragma unroll 1
                while (m > 64 && nlev < 3 && (hi - lo) > 1e-30f) {
                    const float width = hi - lo, scale = 256.0f / width;
#pragma unroll
                    for (int j = 0; j < 4; ++j) hist[lane * 4 + j] = 0;
                    for (int c0 = 0; c0 < nvp; c0 += 64) { const float s = srow[c0 + lane]; int cls; IDX_CLASSIFY(s, cls);
                        if (c0 + lane < nv && cls == 1) __hip_atomic_fetch_add(hist + idx_bin(s, lo, scale), 1, __ATOMIC_RELAXED, __HIP_MEMORY_SCOPE_WORKGROUP); }
                    int hb[4];
#pragma unroll
                    for (int j = 0; j < 4; ++j) hb[j] = hist[lane * 4 + j];
                    const int tot = hb[0] + hb[1] + hb[2] + hb[3];
                    int suf = tot;
#pragma unroll
                    for (int off = 1; off < 64; off <<= 1) { const int v = __shfl_down(suf, off); if (lane + off < 64) suf += v; }
                    const int above = suf - tot;
                    const bool is = (above < need) && (need <= suf);
                    int bin = 0, nneed = 0, mm = 0;
                    if (is) { int c = above;
#pragma unroll
                        for (int k = 3; k >= 0; --k) { if (nneed == 0) { if (need <= c + hb[k]) { bin = lane * 4 + k; nneed = need - c; mm = hb[k]; } else c += hb[k]; } } }
                    const unsigned long long bal = __ballot(is);
                    const int srcl = __ffsll((long long)bal) - 1;
                    bin = __shfl(bin, srcl); nneed = __shfl(nneed, srcl); mm = __shfl(mm, srcl);
                    if (nlev == 0) { lo1 = lo; sc1 = scale; b1 = bin; } else if (nlev == 1) { lo2 = lo; sc2 = scale; b2 = bin; } else { lo3 = lo; sc3 = scale; b3 = bin; }
                    ++nlev; need = nneed; m = mm;
                    const float w = width * (1.0f / 256.0f); lo = lo + (float)bin * w; hi = lo + w;
                }
                float T = -INFINITY; int need_t = need; const bool exact = (m <= 64);
                if (exact) {
                    int base = 0;
                    for (int c0 = 0; c0 < nvp; c0 += 64) { const float s = srow[c0 + lane]; int cls; IDX_CLASSIFY(s, cls);
                        const bool isc = (c0 + lane < nv) && cls == 1; const unsigned long long bc = __ballot(isc);
                        if (isc) { const int pos = base + __popcll(bc & lt_mask); if (pos < 64) cand[pos] = s; }
                        base += __popcll(bc); }
                    const float mine = lane < m ? cand[lane] : -INFINITY;
                    int cgt = 0, cge = 0;
                    for (int j = 0; j < m; ++j) { const float vj = cand[j]; cgt += vj > mine ? 1 : 0; cge += vj >= mine ? 1 : 0; }
                    const bool isT = (lane < m) && (cgt < need) && (need <= cge);
                    const unsigned long long bT = __ballot(isT);
                    const int sl = __ffsll((long long)bT) - 1;
                    T = __shfl(mine, sl); need_t = need - __shfl(cgt, sl);
                }
                int base = 0, ties = 0;
                for (int c0 = 0; c0 < nvp; c0 += 64) { const int key = c0 + lane; const float s = srow[key]; const bool valid = key < nv; int cls; IDX_CLASSIFY(s, cls);
                    const bool sure = valid && (cls == 2 || (cls == 1 && exact && s > T));
                    const bool tie = valid && cls == 1 && (exact ? (s == T) : true);
                    const unsigned long long beq = __ballot(tie);
                    const int rank = ties + __popcll(beq & lt_mask);
                    const bool take = sure || (tie && rank < need_t);
                    const unsigned long long bt = __ballot(take);
                    const int pos = base + __popcll(bt & lt_mask);
                    if (take && pos < 256) out[pos] = (unsigned short)key;
                    base += __popcll(bt); ties += __popcll(beq); }
#undef IDX_CLASSIFY
            }
        }
        __syncthreads();
    }
}

__device__ __forceinline__ void phase_attn2(const Params& p, LAS unsigned char* lds, int bid, int nb) {
    const int tid = opaque_tid(), wid = tid >> 6, lane = tid & 63, fr = lane & 15, g = lane >> 4;
    unsigned char* ws = p.ws;
    const bf16_t* qr = (const bf16_t*)(ws + OFF_BUF64); const bf16_t* kr = (const bf16_t*)(ws + OFF_KR); const bf16_t* vv = (const bf16_t*)(ws + OFF_VV);
    const unsigned short* idx = (const unsigned short*)(ws + OFF_IDX);
    bf16_t* ao = (bf16_t*)(ws + OFF_PD);
    LAS unsigned char* vbuf = lds + wid * 16384;
    LAS unsigned short* ks = (LAS unsigned short*)(lds + 131072) + wid * 256;
    const int q4 = fr >> 2, p4 = fr & 3;
    for (int n = bid * 8 + wid; n < NTOK; n += nb * 8) {
        const int t = n & (SEQ - 1), b = n >> 12, cnt = (t + 1) < 256 ? (t + 1) : 256;
        asm volatile("" ::: "memory");
        *(LAS u32x2*)(ks + lane * 4) = *(const u32x2*)(idx + (size_t)n * 256 + lane * 4);
        bf16x8 qf[4];
#pragma unroll
        for (int s = 0; s < 4; ++s) { qf[s] = (bf16x8){0, 0, 0, 0, 0, 0, 0, 0}; if (fr < 8) qf[s] = *(const bf16x8*)(qr + (size_t)n * 1024 + fr * 128 + s * 32 + g * 8); }
        const bf16_t* kbase = kr + (size_t)b * SEQ * 128; const bf16_t* vbase = vv + (size_t)b * SEQ * 128;
        f32x4 acc[16];
#pragma unroll
        for (int tl = 0; tl < 16; ++tl) {
            const int j = tl * 16 + fr; const int key = j < cnt ? (int)ks[j] : 0;
            const bf16_t* kp = kbase + (size_t)key * 128 + g * 8;
            bf16x8 kf[4];
#pragma unroll
            for (int s = 0; s < 4; ++s) kf[s] = *(const bf16x8*)(kp + s * 32);
            f32x4 a = (f32x4){0.f, 0.f, 0.f, 0.f};
#pragma unroll
            for (int s = 0; s < 4; ++s) a = __builtin_amdgcn_mfma_f32_16x16x32_bf16(kf[s], qf[s], a, 0, 0, 0);
            acc[tl] = a;
        }
        float m = -INFINITY;
#pragma unroll
        for (int tl = 0; tl < 16; ++tl)
#pragma unroll
            for (int r = 0; r < 4; ++r) { if (tl * 16 + g * 4 + r >= cnt) acc[tl][r] = -INFINITY; m = fmaxf(m, acc[tl][r]); }
        m = fmaxf(m, __shfl_xor(m, 16)); m = fmaxf(m, __shfl_xor(m, 32));
        float sum = 0.f;
#pragma unroll
        for (int tl = 0; tl < 16; ++tl)
#pragma unroll
            for (int r = 0; r < 4; ++r) { const float e = __expf(acc[tl][r] - m); acc[tl][r] = e; sum += e; }
        sum += __shfl_xor(sum, 16); sum += __shfl_xor(sum, 32);
        const float inv = 1.0f / sum;
        bf16x8 pf[8];
#pragma unroll
        for (int s = 0; s < 8; ++s) { u32x4 w; w.x = cvt_pk_bf16(acc[2 * s][0], acc[2 * s][1]); w.y = cvt_pk_bf16(acc[2 * s][2], acc[2 * s][3]);
            w.z = cvt_pk_bf16(acc[2 * s + 1][0], acc[2 * s + 1][1]); w.w = cvt_pk_bf16(acc[2 * s + 1][2], acc[2 * s + 1][3]); pf[s] = __builtin_bit_cast(bf16x8, w); }
        f32x4 o[8];
#pragma unroll
        for (int dt = 0; dt < 8; ++dt) o[dt] = (f32x4){0.f, 0.f, 0.f, 0.f};
#pragma unroll
        for (int s = 0; s < 8; ++s) {
            LAS unsigned char* vb = vbuf + (s & 1) * 8192;
#pragma unroll
            for (int i = 0; i < 8; ++i) { const int kl = i * 4 + g, cp = fr; const int jj = s * 32 + kl; const int key = jj < cnt ? (int)ks[jj] : 0;
                const int c = cp ^ ((kl & 7) << 1);
                const u32x4 val = *(const u32x4*)(vbase + (size_t)key * 128 + c * 8);
                *(LAS u32x4*)(vb + kl * 256 + cp * 16) = val; }
            const int kl1 = 4 * g + q4, kl2 = 16 + 4 * g + q4;
#pragma unroll
            for (int dt = 0; dt < 8; ++dt) {
                const int c = 2 * dt + (p4 >> 1);
                const s16x4 lo = __builtin_amdgcn_ds_read_tr16_b64_v4i16((LAS s16x4*)(vb + kl1 * 256 + ((c ^ ((kl1 & 7) << 1)) * 16) + (p4 & 1) * 8));
                const s16x4 hi = __builtin_amdgcn_ds_read_tr16_b64_v4i16((LAS s16x4*)(vb + kl2 * 256 + ((c ^ ((kl2 & 7) << 1)) * 16) + (p4 & 1) * 8));
                const bf16x8 af = (bf16x8){lo[0], lo[1], lo[2], lo[3], hi[0], hi[1], hi[2], hi[3]};
                o[dt] = __builtin_amdgcn_mfma_f32_16x16x32_bf16(af, pf[s], o[dt], 0, 0, 0);
            }
        }
        if (fr < 8) {
#pragma unroll
            for (int dt = 0; dt < 8; ++dt) { u32x2 w; w.x = cvt_pk_bf16(o[dt][0] * inv, o[dt][1] * inv); w.y = cvt_pk_bf16(o[dt][2] * inv, o[dt][3] * inv);
                *(u32x2*)(ao + (size_t)n * 1024 + fr * 128 + dt * 16 + g * 4) = w; }
        }
    }
}

__device__ __forceinline__ void phase_inproj_even(const Params& p, LAS unsigned char* lds, int bid, int nb) {
    unsigned char* ws = p.ws;
    pg::DenseSched S; S.init(ws + OFF_BUF64, ws + OFF_WINE, NTOK, NE_MAIN, 1024, nb, bid);
    pg::EpiBf16 E; E.O = (bf16_t*)(ws + OFF_P); E.ldc = NE_MAIN;
    pg::gemm_phase(lds, 1024, S, E);
}
__device__ __forceinline__ void phase_inproj_odd(const Params& p, LAS unsigned char* lds, int bid, int nb) {
    unsigned char* ws = p.ws;
    pg::DenseSched S; S.init(ws + OFF_BUF64, ws + OFF_WINO, NTOK, NO_MAIN, 1024, nb, bid);
    pg::EpiBf16 E; E.O = (bf16_t*)(ws + OFF_PD); E.ldc = NO_MAIN;
    pg::gemm_phase(lds, 1024, S, E);
}
__device__ __forceinline__ void phase_outproj(const Params& p, LAS unsigned char* lds, int bid, int nb, size_t aoff, size_t woff, const float* X) {
    unsigned char* ws = p.ws;
    pg::DenseSched S; S.init(ws + aoff, ws + woff, NTOK, 1024, 1024, nb, bid);
    pg::EpiResid E; E.X = X; E.U = (float*)(ws + OFF_U);
    pg::gemm_phase(lds, 1024, S, E);
}

__device__ __forceinline__ void grid_barrier(unsigned* ctr, unsigned target) {
    asm volatile("s_waitcnt vmcnt(0) lgkmcnt(0)" ::: "memory");
    __syncthreads();
    if (threadIdx.x == 0) {
        __builtin_amdgcn_fence(__ATOMIC_RELEASE, "agent");
        asm volatile("s_waitcnt vmcnt(0)" ::: "memory");
        __hip_atomic_fetch_add(ctr, 1u, __ATOMIC_RELAXED, __HIP_MEMORY_SCOPE_AGENT);
        while (__hip_atomic_load(ctr, __ATOMIC_RELAXED, __HIP_MEMORY_SCOPE_AGENT) < target) __builtin_amdgcn_s_sleep(1);
        __builtin_amdgcn_fence(__ATOMIC_ACQUIRE, "agent");
        asm volatile("s_waitcnt vmcnt(0)" ::: "memory");
    }
    __syncthreads();
}
#ifndef DUP
#define DUP 0
#endif
#define GSYNC() do { bar_target += nb0u; grid_barrier(bar_ctr, bar_target); } while (0)
__global__ __launch_bounds__(512, 2) void mega(KArgs a) {
    extern __shared__ __attribute__((aligned(16))) unsigned char smem[];
    LAS unsigned char* lds = (LAS unsigned char*)smem;
    Params p; p.in.t = (LAS const unsigned long long*)(lds + PTAB_OFF); p.out = a.out; p.ws = a.ws;
    if ((threadIdx.x & 63) == 0) ((LAS int*)(lds + WTAB_OFF))[hw_slot()] = threadIdx.x >> 6;
    if (threadIdx.x == 0) { LAS unsigned long long* tw_ = (LAS unsigned long long*)(lds + PTAB_OFF);
#pragma unroll
        for (int i = 0; i < 30; ++i) tw_[i] = (unsigned long long)a.in[i]; }
    __syncthreads();
    cg::grid_group grid = cg::this_grid();
    const int bid0 = blockIdx.x, nb0 = gridDim.x;
    unsigned* bar_ctr = (unsigned*)(p.ws + OFF_MISC + MISC_BAR); unsigned bar_target = 0; const unsigned nb0u = gridDim.x;
    if (blockIdx.x == 0 && threadIdx.x == 0) __hip_atomic_store(bar_ctr, 0u, __ATOMIC_RELAXED, __HIP_MEMORY_SCOPE_AGENT);
    grid.sync();
    int bid, nb;
#define FRESH() do { bid = bid0; nb = nb0; asm volatile("" : "+s"(bid), "+s"(nb)); } while (0)
#define RUNP(id, call) do { FRESH(); call; GSYNC(); if (DUP == id) { FRESH(); call; GSYNC(); } } while (0)
    RUNP(10, phase_prep(p, lds, bid, nb));
#pragma unroll 1
    for (int layer = 0; layer < 2; ++layer) {
        if (layer == 0) {
            FRESH(); phase_inproj_even(p, lds, bid, nb);
            FRESH(); phase_gla_alpha(p, lds, bid, nb);
            GSYNC();
            if (DUP == 11) { FRESH(); phase_inproj_even(p, lds, bid, nb); GSYNC(); }
            if (DUP == 12) { FRESH(); phase_gla_alpha(p, lds, bid, nb); GSYNC(); }
            RUNP(1, phase_mixer_even(p, lds, bid, nb, 0));
            RUNP(13, phase_rwkv_epi(p, bid, nb));
        } else {
            RUNP(14, phase_inproj_odd(p, lds, bid, nb));
            RUNP(15, phase_rope(p, bid, nb));
            RUNP(2, phase_index2(p, lds, bid, nb));
            RUNP(3, phase_attn2(p, lds, bid, nb));
        }
        RUNP(16, phase_outproj(p, lds, bid, nb, layer ? OFF_PD : OFF_BUF64, layer ? OFF_WOUTO : OFF_WOUTE, layer ? p.out : p.in[I_X]));
        FRESH(); phase_ln_route(p, lds, bid, nb, layer);
        GSYNC();
        RUNP(17, phase_moe_gateup(p, lds, bid, nb, layer));
        RUNP(18, phase_moe_down(p, lds, bid, nb, layer));
        RUNP(19, phase_ln2(p, bid, nb, layer, p.out, true));
    }
}

extern "C" void kernel_launch(void* const* d_in, const int* in_sizes, int n_in, void* d_out, int out_size, void* d_ws, size_t ws_size, hipStream_t stream) {
    if (ws_size < WS_NEED) { fprintf(stderr, "workspace too small: %zu < %zu\n", ws_size, (size_t)WS_NEED); return; }
    KArgs p{};
    for (int i = 0; i < 30; ++i) p.in[i] = (const float*)d_in[i];
    p.out = (float*)d_out; p.ws = (unsigned char*)d_ws;
    static int grid_blocks = 0;
    if (!grid_blocks) {
        (void)hipFuncSetAttribute((const void*)mega, hipFuncAttributeMaxDynamicSharedMemorySize, LDS_BYTES);
        int dev = 0, cus = 0, per_cu = 0;
        (void)hipGetDevice(&dev);
        (void)hipDeviceGetAttribute(&cus, hipDeviceAttributeMultiprocessorCount, dev);
        (void)hipOccupancyMaxActiveBlocksPerMultiprocessor(&per_cu, mega, 512, LDS_BYTES);
        if (per_cu < 1) { fprintf(stderr, "occupancy query returned %d\n", per_cu); per_cu = 1; }
        grid_blocks = cus;
    }
    void* args[] = {&p};
    hipError_t e = hipLaunchCooperativeKernel((void*)mega, dim3(grid_blocks), dim3(512), args, LDS_BYTES, stream);
    if (e != hipSuccess) fprintf(stderr, "cooperative launch failed: %s (grid %d)\n", hipGetErrorString(e), grid_blocks);
}
```

```cpp
#include <hip/hip_runtime.h>
#include <hip/hip_cooperative_groups.h>
#include <cstdio>
#include <cstdint>
namespace cg = cooperative_groups;

#ifndef SANITIZE
#define SANITIZE 0
#endif
#ifndef PREP_REP
#define PREP_REP 1
#endif
constexpr int NTOK = 32768, SEQ = 4096, NB = 8, DM = 1024;
constexpr int EVEN_COLS = 3344, ODD_COLS = 1604;
constexpr int NE_MAIN = 3328;
constexpr int NO_MAIN = 1792;
constexpr int NEXP = 16, DEXP = 256;
constexpr float DN_ALPHA = 1.4142135623730951f;
constexpr float LN_EPS = 1e-5f;
constexpr int MOE_ROWS = 65536 + 16 * 256;

typedef unsigned short bf16_t;
typedef short bf16x8 __attribute__((ext_vector_type(8)));
typedef float f32x4 __attribute__((ext_vector_type(4)));
typedef short s16x4 __attribute__((ext_vector_type(4)));
typedef float f32x2 __attribute__((ext_vector_type(2)));
typedef unsigned u32x4 __attribute__((ext_vector_type(4)));
typedef unsigned u32x2 __attribute__((ext_vector_type(2)));
#define LAS __attribute__((address_space(3)))

typedef __bf16 bf16x2_t __attribute__((ext_vector_type(2)));
__device__ __forceinline__ unsigned cvt_pk_bf16(float lo, float hi) { bf16x2_t v; v[0] = (__bf16)lo; v[1] = (__bf16)hi; return __builtin_bit_cast(unsigned, v); }
__device__ __forceinline__ bf16_t f2bf(float f) { return (bf16_t)(cvt_pk_bf16(f, 0.f) & 0xffffu); }
__device__ __forceinline__ float bf2f(bf16_t h) { return __uint_as_float(((unsigned)h) << 16); }
constexpr int LDS_BYTES = 160 * 1024;
constexpr int PTAB_OFF = LDS_BYTES - 256;
constexpr int WTAB_OFF = LDS_BYTES - 512;
__device__ __forceinline__ int hw_slot() { return (int)(__builtin_amdgcn_s_getreg(0x2804) & 63u); }
__device__ __forceinline__ int opaque_tid() {
    extern __shared__ __attribute__((aligned(16))) unsigned char smem_[];
    const int w = __builtin_amdgcn_readfirstlane(((LAS const int*)((LAS unsigned char*)smem_ + WTAB_OFF))[hw_slot()]);
    int l; asm volatile("v_mbcnt_lo_u32_b32 %0, -1, 0\n\tv_mbcnt_hi_u32_b32 %0, -1, %0" : "=v"(l));
    return (w << 6) | l; }
__device__ __forceinline__ f32x4 fzero4() { float z = 0.f; asm volatile("" : "+v"(z)); return (f32x4){z, z, z, z}; }
__device__ __forceinline__ u32x4 uzero4() { unsigned z = 0u; asm volatile("" : "+v"(z)); return (u32x4){z, z, z, z}; }
__device__ __forceinline__ float fast_rcp(float x) { return __builtin_amdgcn_rcpf(x); }
__device__ __forceinline__ float fast_sigmoid(float x) { return fast_rcp(1.0f + __expf(-x)); }
__device__ __forceinline__ float fast_tanh(float x) { const float e = __expf(2.0f * x); return 1.0f - 2.0f * fast_rcp(1.0f + e); }
__device__ __forceinline__ bf16x8 pack_8g(const f32x4 a, const f32x4 b) { u32x4 w; w.x = cvt_pk_bf16(a[0], a[1]); w.y = cvt_pk_bf16(a[2], a[3]); w.z = cvt_pk_bf16(b[0], b[1]); w.w = cvt_pk_bf16(b[2], b[3]); return __builtin_bit_cast(bf16x8, w); }
__device__ __forceinline__ float wave_sum(float v) {
#pragma unroll
    for (int o = 32; o > 0; o >>= 1) v += __shfl_xor(v, o);
    return v;
}

constexpr size_t MiB = 1024ull * 1024ull;
constexpr size_t OFF_WINE = 0;
constexpr size_t OFF_WOUTE = OFF_WINE + (size_t)NE_MAIN * 1024 * 2;
constexpr size_t OFF_WINO = OFF_WOUTE + 2 * MiB;
constexpr size_t OFF_WOUTO = OFF_WINO + (size_t)NO_MAIN * 1024 * 2;
constexpr size_t OFF_WGU = OFF_WOUTO + 2 * MiB;
constexpr size_t OFF_WD = OFF_WGU + 32 * MiB;
constexpr size_t OFF_ROPE = OFF_WD + 16 * MiB;
constexpr size_t OFF_MISC = OFF_ROPE + 3 * MiB;
constexpr size_t OFF_BUF64 = OFF_MISC + 4 * MiB;
constexpr size_t OFF_P = OFF_BUF64 + 64 * MiB;
constexpr size_t OFF_U = OFF_P + 208 * MiB;
constexpr size_t WS_NEED = OFF_U + 128 * MiB;
constexpr size_t OFF_HE = OFF_P;
constexpr size_t OFF_ACT = OFF_HE + (size_t)MOE_ROWS * 1024 * 2;
constexpr size_t OFF_PD = OFF_P;
constexpr size_t OFF_KR = OFF_P + 112 * MiB;
constexpr size_t OFF_VV = OFF_KR + 8 * MiB;
constexpr size_t OFF_IQR = OFF_VV + 8 * MiB;
constexpr size_t OFF_IKR = OFF_IQR + 16 * MiB;
constexpr size_t OFF_IW = OFF_IKR + 4 * MiB;
constexpr size_t OFF_IDX = OFF_IW + 1 * MiB;
constexpr size_t MISC_CNT = 0;
constexpr size_t MISC_TOKINFO = 4096;
constexpr size_t MISC_TOKGATE = MISC_TOKINFO + (size_t)NTOK * 16;
constexpr size_t MISC_LIST = MISC_TOKGATE + (size_t)NTOK * 8;
constexpr size_t MISC_BAR = 2048;
constexpr size_t MISC_W2T = 3 * MiB;
constexpr size_t MISC_A2T = MISC_W2T + 65536;
constexpr size_t MISC_G2T = MISC_A2T + 65536;

struct InTab { LAS const unsigned long long* t;
    __device__ __forceinline__ const float* operator[](int i) const { const unsigned long long v = t[i];
        const unsigned lo = __builtin_amdgcn_readfirstlane((unsigned)v), hi = __builtin_amdgcn_readfirstlane((unsigned)(v >> 32));
        return (const float*)(((unsigned long long)hi << 32) | lo); } };
struct Params { InTab in; float* out; unsigned char* ws; };
struct KArgs { const float* in[30]; float* out; unsigned char* ws; };
enum { I_X = 0, I_WINE, I_AMU, I_AW0, I_AW2, I_AA0, I_AA2, I_AG2, I_AKK, I_AKA, I_ARK, I_AGNG, I_AGNB, I_BGW2, I_BGB, I_BNG, I_WOUTE,
       I_WINO, I_CIKG, I_CIKB, I_WOUTO, I_LN1G, I_LN1B, I_LN2G, I_LN2B, I_RW, I_RB, I_EG, I_EU, I_ED };

namespace pg {
constexpr int BM = 256, BK = 64, HALF = 128, HTB = HALF * BK * 2, STAGE_BYTES = 8 * HTB;
__host__ __device__ __forceinline__ int lds_byte(int r, int c) { const int st = (r >> 4) * 2 + (c >> 5), rr = r & 15, cc = c & 31, ob = rr * 64 + cc * 2; return st * 1024 + (ob ^ (((ob >> 9) & 1) << 5)); }
__host__ __device__ __forceinline__ void stage_rc(int b, int& R, int& C) { const int st = b / 1024, sb = b % 1024, swz = sb ^ (((sb >> 9) & 1) << 5); R = (st >> 1) * 16 + swz / 64; C = (st & 1) * 32 + (swz % 64) / 2; }
__host__ __device__ __forceinline__ int perm32(int rho) { const int n = rho >> 4, i = rho & 15; return 8 * (i >> 2) + 4 * n + (i & 3); }

struct Unit { int pm, pn, e, rt, cnt; };

template <class Epi, class Sched>
__device__ __forceinline__ void gemm_phase(LAS unsigned char* lds, const int K, const Sched& S, const Epi& E) {
    const int tid = opaque_tid(), wid = __builtin_amdgcn_readfirstlane(tid >> 6), lane = tid & 63, wr = wid >> 2, wc = wid & 3, fr = lane & 15, fq = lane >> 4;
    const int nt = K / BK;
    unsigned voffB[2];
#pragma unroll
    for (int i = 0; i < 2; ++i) { int R, C; stage_rc(tid * 16 + i * 8192, R, C); const int Rb = Epi::PERM ? ((R & ~31) + perm32(R & 31)) : R; voffB[i] = (unsigned)(Rb * K + C) * 2u; }
    const size_t kstep = (size_t)(BK * 2);
    const size_t hstepB = (size_t)HALF * K * 2;
    const unsigned ldsw = (unsigned)wid * 1024u;
    const int aoff = lds_byte(wr * 64 + fr, fq * 8), boff = lds_byte(wc * 32 + fr, fq * 8);
#define PG_SA(b, h) (((b) * 2 + (h)) * HTB)
#define PG_SB(b, h) ((4 + (b) * 2 + (h)) * HTB)
#define PG_STAGE(bufoff, gbase, voff) do { _Pragma("unroll") for (int _i = 0; _i < 2; ++_i) \
        __builtin_amdgcn_global_load_lds((const unsigned*)((const char*)(gbase) + (voff)[_i]), (LAS unsigned*)(lds + (bufoff) + ldsw + _i * 8192), 16, 0, 0); } while (0)
#define PG_LDA(dst, b, h) do { _Pragma("unroll") for (int m = 0; m < 4; ++m) _Pragma("unroll") for (int k = 0; k < 2; ++k) dst[m][k] = *(const LAS bf16x8*)(lds + PG_SA(b, h) + aoff + m * 2048 + k * 1024); } while (0)
#define PG_LDB(dst, b, h) do { _Pragma("unroll") for (int n = 0; n < 2; ++n) _Pragma("unroll") for (int k = 0; k < 2; ++k) dst[n][k] = *(const LAS bf16x8*)(lds + PG_SB(b, h) + boff + n * 2048 + k * 1024); } while (0)
#define PG_MMA(ai, bj, At, Bt) do { __builtin_amdgcn_s_setprio(1); _Pragma("unroll") for (int m = 0; m < 4; ++m) _Pragma("unroll") for (int n = 0; n < 2; ++n) _Pragma("unroll") for (int k = 0; k < 2; ++k) \
        acc[ai][bj][m][n] = __builtin_amdgcn_mfma_f32_16x16x32_bf16(Bt[n][k], At[m][k], acc[ai][bj][m][n], 0, 0, 0); __builtin_amdgcn_s_setprio(0); } while (0)
#define PG_WAIT_V(n) asm volatile("s_waitcnt vmcnt(" #n ")" ::: "memory")
#define PG_WAIT_L(n) asm volatile("s_waitcnt lgkmcnt(" #n ")" ::: "memory")
#define PG_BAR __builtin_amdgcn_s_barrier()
#define PG_SCHED __builtin_amdgcn_sched_barrier(0)
#define PG_AOFF(dst0, dst1, u) do { _Pragma("unroll") for (int _i = 0; _i < 2; ++_i) { int _R, _C; stage_rc(tid * 16 + _i * 8192, _R, _C); \
        dst0[_i] = S.a_rowoff(u, 0, _R) + (unsigned)_C * 2u; dst1[_i] = S.a_rowoff(u, 1, _R) + (unsigned)_C * 2u; } } while (0)
    Unit cur, nxt; int ui = 0;
    if (!S.next(0, cur)) return;
    f32x4 acc[2][2][4][2];
#pragma unroll
    for (int a = 0; a < 2; ++a)
#pragma unroll
        for (int b = 0; b < 2; ++b)
#pragma unroll
            for (int m = 0; m < 4; ++m)
#pragma unroll
                for (int n = 0; n < 2; ++n) acc[a][b][m][n] = (f32x4){0.f, 0.f, 0.f, 0.f};
    bf16x8 At[4][2], B0[2][2], B1[2][2];
    const char* const Ab = S.a_base();
    unsigned aC0[2], aC1[2];
    PG_AOFF(aC0, aC1, cur);
    const char* cB = S.b_ptr(cur);
    PG_STAGE(PG_SB(0, 0), cB, voffB); PG_STAGE(PG_SA(0, 0), Ab, aC0); PG_STAGE(PG_SB(0, 1), cB + hstepB, voffB); PG_STAGE(PG_SA(0, 1), Ab, aC1);
    if (wr == 1) PG_BAR;
    PG_WAIT_V(4); PG_BAR;
    PG_STAGE(PG_SB(1, 0), cB + kstep, voffB); PG_STAGE(PG_SA(1, 0), Ab + kstep, aC0); PG_STAGE(PG_SB(1, 1), cB + hstepB + kstep, voffB);
    PG_WAIT_V(6); PG_BAR;
    for (;;) {
        const bool has_next = S.next(ui + 1, nxt);
        const char* nB = has_next ? S.b_ptr(nxt) : cB;
#pragma unroll 1
        for (int t = 0; t < nt; t += 2) {
            const bool last = (t == nt - 2);
            const char* a1 = Ab + (size_t)(t + 1) * kstep;
            const char* a2 = last ? Ab : Ab + (size_t)(t + 2) * kstep; const char* b2 = last ? nB : cB + (size_t)(t + 2) * kstep;
            const char* a3 = a2 + kstep; const char* b3 = b2 + kstep;
            PG_LDB(B0, 0, 0); PG_SCHED; PG_LDA(At, 0, 0); PG_STAGE(PG_SA(1, 1), a1, aC1);
            if (last && has_next) PG_AOFF(aC0, aC1, nxt);
            PG_WAIT_L(8); PG_BAR; PG_WAIT_L(0); PG_MMA(0, 0, At, B0); PG_BAR; PG_SCHED;
            PG_LDB(B1, 0, 1); PG_STAGE(PG_SB(0, 0), b2, voffB);
            PG_BAR; PG_WAIT_L(0); PG_MMA(0, 1, At, B1); PG_BAR;
            PG_LDA(At, 0, 1); PG_STAGE(PG_SA(0, 0), a2, aC0);
            PG_BAR; PG_WAIT_L(0); PG_MMA(1, 0, At, B0); PG_BAR; PG_SCHED;
            PG_STAGE(PG_SB(0, 1), b2 + hstepB, voffB);
            PG_WAIT_V(6); PG_BAR; PG_MMA(1, 1, At, B1); PG_BAR;
            PG_LDB(B0, 1, 0); PG_SCHED; PG_LDA(At, 1, 0); PG_STAGE(PG_SA(0, 1), a2, aC1);
            PG_WAIT_L(8); PG_BAR; PG_WAIT_L(0); PG_MMA(0, 0, At, B0); PG_BAR; PG_SCHED;
            PG_LDB(B1, 1, 1); PG_STAGE(PG_SB(1, 0), b3, voffB);
            PG_BAR; PG_WAIT_L(0); PG_MMA(0, 1, At, B1); PG_BAR;
            PG_LDA(At, 1, 1); PG_STAGE(PG_SA(1, 0), a3, aC0);
            PG_BAR; PG_WAIT_L(0); PG_MMA(1, 0, At, B0); PG_BAR; PG_SCHED;
            PG_STAGE(PG_SB(1, 1), b3 + hstepB, voffB);
            PG_WAIT_V(6); PG_BAR; PG_MMA(1, 1, At, B1); PG_BAR;
        }
        E(acc, cur, wr, wc, fr, fq);
        if (!has_next) break;
#pragma unroll
        for (int a = 0; a < 2; ++a)
#pragma unroll
            for (int b = 0; b < 2; ++b)
#pragma unroll
                for (int m = 0; m < 4; ++m)
#pragma unroll
                    for (int n = 0; n < 2; ++n) acc[a][b][m][n] = (f32x4){0.f, 0.f, 0.f, 0.f};
        cur = nxt; cB = nB; ++ui;
    }
    PG_WAIT_V(0);
    if (wr == 0) PG_BAR;
    PG_BAR;
#undef PG_SA
#undef PG_SB
#undef PG_STAGE
#undef PG_LDA
#undef PG_LDB
#undef PG_MMA
#undef PG_WAIT_V
#undef PG_WAIT_L
#undef PG_BAR
#undef PG_SCHED
#undef PG_AOFF
}

struct DenseSched {
    const char* A; const char* Bt; int K, nM, nN, nwg, G, c;
    __device__ void init(const void* A_, const void* Bt_, int M, int N, int K_, int G_, int c_) { A = (const char*)A_; Bt = (const char*)Bt_; K = K_; nM = M / BM; nN = N / BM; nwg = nM * nN; G = G_; c = c_; }
    __device__ __forceinline__ bool next(int i, Unit& u) const {
        const long L = (long)i * G + c; if (L >= nwg) return false;
        int wgid = (int)L; { const int q = nwg / 8, r = nwg % 8, xcd = wgid % 8, off = wgid / 8; wgid = (xcd < r ? xcd * (q + 1) : r * (q + 1) + (xcd - r) * q) + off; }
        const int nig = 8 * nN, gid = wgid / nig, fm = gid * 8, gsz = (nM - fm) < 8 ? (nM - fm) : 8;
        u.pm = fm + ((wgid % nig) % gsz); u.pn = (wgid % nig) / gsz; u.e = 0; u.rt = 0; u.cnt = 0; return true;
    }
    __device__ __forceinline__ const char* a_base() const { return A; }
    __device__ __forceinline__ unsigned a_rowoff(const Unit& u, int half, int R) const { return (unsigned)(u.pm * BM + half * HALF + R) * (unsigned)(K * 2); }
    __device__ __forceinline__ const char* b_ptr(const Unit& u) const { return Bt + (size_t)u.pn * BM * K * 2; }
};

__device__ __forceinline__ void moe_build_units(LAS int* tab, const int* cntp, int NCT, int G, int c) {
    const int i = opaque_tid();
    if (i < 16) {
        const int L = i * G + c; int accu = 0, rtb = 0, found = 0, pm = 0, pn = 0, ee = 0, rt = 0, cn = 0;
        for (int e = 0; e < 16; ++e) { const int ce = cntp[e], nte = (ce + 255) >> 8, ue = nte * NCT;
            if (!found && L < accu + ue) { const int local = L - accu; ee = e; rt = local / NCT; pn = local % NCT; pm = rtb + rt; cn = ce; found = 1; }
            accu += ue; rtb += nte; }
        tab[i * 8 + 0] = found; tab[i * 8 + 1] = pm; tab[i * 8 + 2] = pn; tab[i * 8 + 3] = ee; tab[i * 8 + 4] = rt; tab[i * 8 + 5] = cn;
    }
    __syncthreads();
}
template <bool GATHER>
struct MoeSched {
    const char* A; const char* Bt; const int* list; int K; size_t wstride; LAS int* tab;
    __device__ void init(const void* A_, const void* Bt_, size_t wstride_bytes, const int* list_, int K_, LAS int* tab_) {
        A = (const char*)A_; Bt = (const char*)Bt_; wstride = wstride_bytes; list = list_; K = K_; tab = tab_; }
    __device__ __forceinline__ bool next(int i, Unit& u) const {
        if (i >= 16) return false;
        const int f = __builtin_amdgcn_readfirstlane(tab[i * 8 + 0]);
        u.pm = __builtin_amdgcn_readfirstlane(tab[i * 8 + 1]); u.pn = __builtin_amdgcn_readfirstlane(tab[i * 8 + 2]); u.e = __builtin_amdgcn_readfirstlane(tab[i * 8 + 3]);
        u.rt = __builtin_amdgcn_readfirstlane(tab[i * 8 + 4]); u.cnt = __builtin_amdgcn_readfirstlane(tab[i * 8 + 5]);
        return f != 0;
    }
    __device__ __forceinline__ const char* a_base() const { return A; }
    __device__ __forceinline__ unsigned a_rowoff(const Unit& u, int half, int R) const {
        if (GATHER) { const int slot = u.rt * BM + half * HALF + R; const int tok = slot < u.cnt ? list[u.e * NTOK + slot] : 0; return (unsigned)tok * (unsigned)(K * 2); }
        return (unsigned)(u.pm * BM + half * HALF + R) * (unsigned)(K * 2);
    }
    __device__ __forceinline__ const char* b_ptr(const Unit& u) const { return Bt + (size_t)u.e * wstride + (size_t)u.pn * BM * K * 2; }
};

struct EpiBf16 {
    static constexpr bool PERM = true;
    bf16_t* O; int ldc;
    __device__ __forceinline__ void operator()(const f32x4 (&acc)[2][2][4][2], const Unit& u, int wr, int wc, int fr, int fq) const {
        const int row0 = u.pm * BM + wr * 64 + fr, col0 = u.pn * BM + wc * 32 + 8 * fq;
#pragma unroll
        for (int ai = 0; ai < 2; ++ai)
#pragma unroll
            for (int m = 0; m < 4; ++m) { bf16_t* rowp = O + (size_t)(row0 + ai * HALF + m * 16) * ldc + col0;
#pragma unroll
                for (int bj = 0; bj < 2; ++bj) { const f32x4 v0 = acc[ai][bj][m][0], v1 = acc[ai][bj][m][1];
                    u32x4 w; w.x = cvt_pk_bf16(v0[0], v0[1]); w.y = cvt_pk_bf16(v0[2], v0[3]); w.z = cvt_pk_bf16(v1[0], v1[1]); w.w = cvt_pk_bf16(v1[2], v1[3]);
                    *(u32x4*)(rowp + bj * HALF) = w; } }
    }
};
struct EpiResid {
    static constexpr bool PERM = false;
    const float* X; float* U;
    __device__ __forceinline__ void operator()(const f32x4 (&acc)[2][2][4][2], const Unit& u, int wr, int wc, int fr, int fq) const {
        const int row0 = u.pm * BM + wr * 64 + fr, col0 = u.pn * BM + wc * 32 + 4 * fq;
#pragma unroll
        for (int ai = 0; ai < 2; ++ai)
#pragma unroll
            for (int m = 0; m < 4; ++m) { const size_t off = (size_t)(row0 + ai * HALF + m * 16) * DM + col0;
#pragma unroll
                for (int bj = 0; bj < 2; ++bj)
#pragma unroll
                    for (int n = 0; n < 2; ++n) { const f32x4 xv = *(const f32x4*)(X + off + bj * HALF + n * 16);
                        *(f32x4*)(U + off + bj * HALF + n * 16) = xv * DN_ALPHA + acc[ai][bj][m][n]; } }
    }
};
struct EpiSwiglu {
    static constexpr bool PERM = true;
    bf16_t* O;
    __device__ __forceinline__ void operator()(const f32x4 (&acc)[2][2][4][2], const Unit& u, int wr, int wc, int fr, int fq) const {
        const int row0 = u.pm * BM + wr * 64 + fr, col0 = u.pn * HALF + wc * 32 + 8 * fq;
#pragma unroll
        for (int ai = 0; ai < 2; ++ai)
#pragma unroll
            for (int m = 0; m < 4; ++m) { bf16_t* rowp = O + (size_t)(row0 + ai * HALF + m * 16) * DEXP + col0;
                float r[8];
#pragma unroll
                for (int n = 0; n < 2; ++n)
#pragma unroll
                    for (int j = 0; j < 4; ++j) { const float g = acc[ai][0][m][n][j], up = acc[ai][1][m][n][j]; r[n * 4 + j] = g / (1.0f + __expf(-g)) * up; }
                u32x4 w; w.x = cvt_pk_bf16(r[0], r[1]); w.y = cvt_pk_bf16(r[2], r[3]); w.z = cvt_pk_bf16(r[4], r[5]); w.w = cvt_pk_bf16(r[6], r[7]);
                *(u32x4*)rowp = w; }
    }
};
}

__device__ __forceinline__ void tr_tile(LAS float* tile  , const float* src, int ld, int k0, int c0, int ncols_valid, bf16_t* dst, int dstK, int drow0, int tid) {
    {
        const int r = tid >> 3, cc = (tid & 7) * 8;
        const float* sp = src + (size_t)(k0 + r) * ld + c0 + cc;
#pragma unroll
        for (int j = 0; j < 8; ++j) tile[r * 65 + cc + j] = (c0 + cc + j < ncols_valid) ? sp[j] : 0.f;
    }
    __syncthreads();
    {
        const int n = tid >> 3, kk = (tid & 7) * 8;
        u32x4 w;
        w.x = cvt_pk_bf16(tile[(kk + 0) * 65 + n], tile[(kk + 1) * 65 + n]); w.y = cvt_pk_bf16(tile[(kk + 2) * 65 + n], tile[(kk + 3) * 65 + n]);
        w.z = cvt_pk_bf16(tile[(kk + 4) * 65 + n], tile[(kk + 5) * 65 + n]); w.w = cvt_pk_bf16(tile[(kk + 6) * 65 + n], tile[(kk + 7) * 65 + n]);
        *(u32x4*)(dst + (size_t)(drow0 + n) * dstK + k0 + kk) = w;
    }
    __syncthreads();
}

__device__ __forceinline__ void phase_prep(const Params& p, LAS unsigned char* lds, int bid, int nb) {
    const int tid = opaque_tid();
    LAS float* tile = (LAS float*)lds;
    unsigned char* ws = p.ws;
    const int T0 = 832, T1 = T0 + 256, T2 = T1 + 448, T3 = T2 + 256, T4 = T3 + 2048, T5 = T4 + 2048, T6 = T5 + 2048, T7 = T6 + 32;
    for (int t = bid; t < T7; t += nb) {
        if (t >= T6) { const int q = t - T6;
            if (q < 8) tr_tile(tile, p.in[I_AW2], 512, 0, q * 64, 512, (bf16_t*)(ws + OFF_MISC + MISC_W2T), 64, q * 64, tid);
            else if (q < 16) tr_tile(tile, p.in[I_AA2], 512, 0, (q - 8) * 64, 512, (bf16_t*)(ws + OFF_MISC + MISC_A2T), 64, (q - 8) * 64, tid);
            else { const int r = q - 16; tr_tile(tile, p.in[I_AG2], 512, (r >> 3) * 64, (r & 7) * 64, 512, (bf16_t*)(ws + OFF_MISC + MISC_G2T), 128, (r & 7) * 64, tid); }
            continue; }
        if (t < T0) { const int kt = t / 52, ct = t % 52; tr_tile(tile, p.in[I_WINE], EVEN_COLS, kt * 64, ct * 64, EVEN_COLS, (bf16_t*)(ws + OFF_WINE), 1024, ct * 64, tid); }
        else if (t < T1) { const int q = t - T0, kt = q / 16, ct = q % 16; tr_tile(tile, p.in[I_WOUTE], 1024, kt * 64, ct * 64, 1024, (bf16_t*)(ws + OFF_WOUTE), 1024, ct * 64, tid); }
        else if (t < T2) { const int q = t - T1, kt = q / 28, ct = q % 28; tr_tile(tile, p.in[I_WINO], ODD_COLS, kt * 64, ct * 64, ODD_COLS, (bf16_t*)(ws + OFF_WINO), 1024, ct * 64, tid); }
        else if (t < T3) { const int q = t - T2, kt = q / 16, ct = q % 16; tr_tile(tile, p.in[I_WOUTO], 1024, kt * 64, ct * 64, 1024, (bf16_t*)(ws + OFF_WOUTO), 1024, ct * 64, tid); }
        else if (t < T5) { const bool up = t >= T4; const int q = t - (up ? T4 : T3), le = q / 64, r = q % 64, kt = r / 4, ct = r % 4;
            const int c0 = ct * 64, drow0 = (c0 / 128) * 256 + (up ? 128 : 0) + (c0 % 128);
            tr_tile(tile, p.in[up ? I_EU : I_EG] + (size_t)le * 1024 * 256, 256, kt * 64, c0, 256, (bf16_t*)(ws + OFF_WGU) + (size_t)le * 512 * 1024, 1024, drow0, tid); }
        else { const int q = t - T5, le = q / 64, r = q % 64, kt = r / 16, ct = r % 16;
            tr_tile(tile, p.in[I_ED] + (size_t)le * 256 * 1024, 1024, kt * 64, ct * 64, 1024, (bf16_t*)(ws + OFF_WD) + (size_t)le * 1024 * 256, 256, ct * 64, tid); }
    }
    {
        const float* x = p.in[I_X]; bf16_t* xb = (bf16_t*)(ws + OFF_BUF64);
        const size_t n8 = (size_t)NTOK * DM / 8;
        for (size_t i = (size_t)bid * 512 + tid; i < n8; i += (size_t)nb * 512) {
            const f32x4 a = *(const f32x4*)(x + i * 8), b = *(const f32x4*)(x + i * 8 + 4);
            u32x4 w; w.x = cvt_pk_bf16(a[0], a[1]); w.y = cvt_pk_bf16(a[2], a[3]); w.z = cvt_pk_bf16(b[0], b[1]); w.w = cvt_pk_bf16(b[2], b[3]);
            *(u32x4*)(xb + i * 8) = w;
        }
    }
    {
        float* c64 = (float*)(ws + OFF_ROPE); float* s64 = c64 + 4096 * 64; float* c32 = s64 + 4096 * 64; float* s32 = c32 + 4096 * 32;
        for (int i = bid * 512 + tid; i < 4096 * 64; i += nb * 512) { const int pos = i >> 6, j = i & 63; const float inv = powf(10000.0f, -(float)j / 64.0f); const float ang = (float)pos * inv; c64[i] = cosf(ang); s64[i] = sinf(ang); }
        for (int i = bid * 512 + tid; i < 4096 * 32; i += nb * 512) { const int pos = i >> 5, j = i & 31; const float inv = powf(10000.0f, -(float)j / 32.0f); const float ang = (float)pos * inv; c32[i] = cosf(ang); s32[i] = sinf(ang); }
    }
    if (bid == 0 && tid < 64) ((int*)(ws + OFF_MISC + MISC_CNT))[tid] = 0;
}

__device__ __forceinline__ void phase_ln_route(const Params& p, LAS unsigned char* lds, int bid, int nb, int layer) {
    const int tid = opaque_tid(), wid = tid >> 6, lane = tid & 63;
    unsigned char* ws = p.ws;
    LAS float* rwT = (LAS float*)lds;
    for (int i = tid; i < 16 * 1024; i += 512) { const int e = i >> 10, k = i & 1023; rwT[i] = p.in[I_RW][k * 16 + e]; }
    __syncthreads();
    float* U = (float*)(ws + OFF_U); bf16_t* hb = (bf16_t*)(ws + OFF_BUF64);
    const float* g = p.in[I_LN1G] + layer * DM; const float* b = p.in[I_LN1B] + layer * DM;
    int* cnt = (int*)(ws + OFF_MISC + MISC_CNT) + layer * 16;
    int* tokinfo = (int*)(ws + OFF_MISC + MISC_TOKINFO); float* tokgate = (float*)(ws + OFF_MISC + MISC_TOKGATE); int* list = (int*)(ws + OFF_MISC + MISC_LIST);
    f32x4 gv[4], bv[4];
#pragma unroll
    for (int j = 0; j < 4; ++j) { gv[j] = *(const f32x4*)(g + j * 256 + lane * 4); bv[j] = *(const f32x4*)(b + j * 256 + lane * 4); }
    float rbias[16];
#pragma unroll
    for (int e = 0; e < 16; ++e) rbias[e] = p.in[I_RB][e];
    for (int tok = bid * 8 + wid; tok < NTOK; tok += nb * 8) {
        f32x4 v[4]; float s = 0.f;
#pragma unroll
        for (int j = 0; j < 4; ++j) { v[j] = *(const f32x4*)(U + (size_t)tok * DM + j * 256 + lane * 4); s += (v[j][0] + v[j][1]) + (v[j][2] + v[j][3]); }
        const float mean = wave_sum(s) * (1.0f / DM);
        float q = 0.f;
#pragma unroll
        for (int j = 0; j < 4; ++j) { v[j] -= mean; q += (v[j][0] * v[j][0] + v[j][1] * v[j][1]) + (v[j][2] * v[j][2] + v[j][3] * v[j][3]); }
        const float rstd = rsqrtf(wave_sum(q) * (1.0f / DM) + LN_EPS);
#pragma unroll
        for (int j = 0; j < 4; ++j) { v[j] = v[j] * rstd * gv[j] + bv[j];
            *(f32x4*)(U + (size_t)tok * DM + j * 256 + lane * 4) = v[j];
            u32x2 w; w.x = cvt_pk_bf16(v[j][0], v[j][1]); w.y = cvt_pk_bf16(v[j][2], v[j][3]);
            *(u32x2*)(hb + (size_t)tok * DM + j * 256 + lane * 4) = w; }
        float lg[16];
        asm volatile("" ::: "memory");
#pragma unroll
        for (int e = 0; e < 16; ++e) { float a = 0.f;
#pragma unroll
            for (int j = 0; j < 4; ++j) { const f32x4 w = *(const LAS f32x4*)(rwT + e * 1024 + j * 256 + lane * 4); a += (v[j][0] * w[0] + v[j][1] * w[1]) + (v[j][2] * w[2] + v[j][3] * w[3]); }
            lg[e] = wave_sum(a); }
        float sg[16], sel[16];
#pragma unroll
        for (int e = 0; e < 16; ++e) { sg[e] = 1.0f / (1.0f + expf(-lg[e])); sel[e] = sg[e] + rbias[e]; }
        int best = 0; float bestv = -INFINITY;
#pragma unroll
        for (int gI = 0; gI < 4; ++gI) { float m1 = -INFINITY, m2 = -INFINITY;
#pragma unroll
            for (int j = 0; j < 4; ++j) { const float x = sel[gI * 4 + j]; if (x > m1) { m2 = m1; m1 = x; } else if (x > m2) m2 = x; }
            const float gs = m1 + m2; if (gs > bestv) { bestv = gs; best = gI; } }
        int e0 = 0, e1 = 0; float v0 = -INFINITY, v1 = -INFINITY, s0 = 0.f, s1 = 0.f;
#pragma unroll
        for (int e = 0; e < 16; ++e) { if ((e >> 2) == best) { const float x = sel[e];
                if (x > v0) { v1 = v0; e1 = e0; s1 = s0; v0 = x; e0 = e; s0 = sg[e]; } else if (x > v1) { v1 = x; e1 = e; s1 = sg[e]; } } }
        const float gsum = s0 + s1; const float g0 = s0 / gsum, g1 = s1 / gsum;
        if (lane == 0) {
            const int sl0 = atomicAdd(cnt + e0, 1), sl1 = atomicAdd(cnt + e1, 1);
            list[e0 * NTOK + sl0] = tok; list[e1 * NTOK + sl1] = tok;
            tokinfo[tok * 4 + 0] = e0; tokinfo[tok * 4 + 1] = sl0; tokinfo[tok * 4 + 2] = e1; tokinfo[tok * 4 + 3] = sl1;
            tokgate[tok * 2 + 0] = g0; tokgate[tok * 2 + 1] = g1;
        }
    }
}

__device__ __forceinline__ void phase_ln2(const Params& p, int bid, int nb, int layer, float* dst, bool with_moe) {
    const int tid = opaque_tid(), wid = tid >> 6, lane = tid & 63;
    unsigned char* ws = p.ws;
    const float* U = (const float*)(ws + OFF_U); bf16_t* xb = (bf16_t*)(ws + OFF_BUF64);
    const bf16_t* he = (const bf16_t*)(ws + OFF_HE);
    const float* g = p.in[I_LN2G] + layer * DM; const float* b = p.in[I_LN2B] + layer * DM;
    const int* cnt = (const int*)(ws + OFF_MISC + MISC_CNT) + layer * 16;
    const int* tokinfo = (const int*)(ws + OFF_MISC + MISC_TOKINFO); const float* tokgate = (const float*)(ws + OFF_MISC + MISC_TOKGATE);
    int rowbase[16]; { int a = 0;
#pragma unroll
        for (int e = 0; e < 16; ++e) { rowbase[e] = a; a += ((cnt[e] + 255) >> 8) << 8; } }
    f32x4 gv[4], bv[4];
#pragma unroll
    for (int j = 0; j < 4; ++j) { gv[j] = *(const f32x4*)(g + j * 256 + lane * 4); bv[j] = *(const f32x4*)(b + j * 256 + lane * 4); }
    for (int tok = bid * 8 + wid; tok < NTOK; tok += nb * 8) {
        f32x4 v[4]; float s = 0.f;
        int r0 = 0, r1 = 0; float g0 = 0.f, g1 = 0.f;
        if (with_moe) { const int e0 = tokinfo[tok * 4 + 0], sl0 = tokinfo[tok * 4 + 1], e1 = tokinfo[tok * 4 + 2], sl1 = tokinfo[tok * 4 + 3];
            int rb0 = 0, rb1 = 0;
#pragma unroll
            for (int e = 0; e < 16; ++e) { if (e == e0) rb0 = rowbase[e]; if (e == e1) rb1 = rowbase[e]; }
            r0 = rb0 + sl0; r1 = rb1 + sl1; g0 = tokgate[tok * 2 + 0]; g1 = tokgate[tok * 2 + 1]; }
#pragma unroll
        for (int j = 0; j < 4; ++j) { v[j] = *(const f32x4*)(U + (size_t)tok * DM + j * 256 + lane * 4) * DN_ALPHA;
            if (with_moe) { const u32x2 a = *(const u32x2*)(he + (size_t)r0 * DM + j * 256 + lane * 4), c = *(const u32x2*)(he + (size_t)r1 * DM + j * 256 + lane * 4);
                v[j][0] += g0 * __uint_as_float(a.x << 16) + g1 * __uint_as_float(c.x << 16); v[j][1] += g0 * __uint_as_float(a.x & 0xffff0000u) + g1 * __uint_as_float(c.x & 0xffff0000u);
                v[j][2] += g0 * __uint_as_float(a.y << 16) + g1 * __uint_as_float(c.y << 16); v[j][3] += g0 * __uint_as_float(a.y & 0xffff0000u) + g1 * __uint_as_float(c.y & 0xffff0000u); }
            s += (v[j][0] + v[j][1]) + (v[j][2] + v[j][3]); }
        const float mean = wave_sum(s) * (1.0f / DM);
        float q = 0.f;
#pragma unroll
        for (int j = 0; j < 4; ++j) { v[j] -= mean; q += (v[j][0] * v[j][0] + v[j][1] * v[j][1]) + (v[j][2] * v[j][2] + v[j][3] * v[j][3]); }
        const float rstd = rsqrtf(wave_sum(q) * (1.0f / DM) + LN_EPS);
#pragma unroll
        for (int j = 0; j < 4; ++j) { v[j] = v[j] * rstd * gv[j] + bv[j];
            *(f32x4*)(dst + (size_t)tok * DM + j * 256 + lane * 4) = v[j];
            u32x2 w; w.x = cvt_pk_bf16(v[j][0], v[j][1]); w.y = cvt_pk_bf16(v[j][2], v[j][3]);
            *(u32x2*)(xb + (size_t)tok * DM + j * 256 + lane * 4) = w; }
    }
}

__device__ __forceinline__ void phase_resid_only(const Params& p, const float* X, int bid, int nb) {
    float* U = (float*)(p.ws + OFF_U);
    const size_t n4 = (size_t)NTOK * DM / 4;
    for (size_t i = (size_t)bid * 512 + threadIdx.x; i < n4; i += (size_t)nb * 512) *(f32x4*)(U + i * 4) = *(const f32x4*)(X + i * 4) * DN_ALPHA;
}

__device__ __forceinline__ void phase_moe_gateup(const Params& p, LAS unsigned char* lds, int bid, int nb, int layer) {
    unsigned char* ws = p.ws;
    LAS int* tab = (LAS int*)(lds + pg::STAGE_BYTES);
    pg::moe_build_units(tab, (const int*)(ws + OFF_MISC + MISC_CNT) + layer * 16, 2, nb, bid);
    pg::MoeSched<true> S; S.init(ws + OFF_BUF64, ws + OFF_WGU + (size_t)layer * 16 * 512 * 1024 * 2, (size_t)512 * 1024 * 2, (const int*)(ws + OFF_MISC + MISC_LIST), 1024, tab);
    pg::EpiSwiglu E; E.O = (bf16_t*)(ws + OFF_ACT);
    pg::gemm_phase(lds, 1024, S, E);
}
__device__ __forceinline__ void phase_moe_down(const Params& p, LAS unsigned char* lds, int bid, int nb, int layer) {
    unsigned char* ws = p.ws;
    LAS int* tab = (LAS int*)(lds + pg::STAGE_BYTES);
    pg::moe_build_units(tab, (const int*)(ws + OFF_MISC + MISC_CNT) + layer * 16, 4, nb, bid);
    pg::MoeSched<false> S; S.init(ws + OFF_ACT, ws + OFF_WD + (size_t)layer * 16 * 1024 * 256 * 2, (size_t)1024 * 256 * 2, nullptr, 256, tab);
    pg::EpiBf16 E; E.O = (bf16_t*)(ws + OFF_HE); E.ldc = 1024;
    pg::gemm_phase(lds, 256, S, E);
}

__device__ __forceinline__ void phase_gla_alpha(const Params& p, LAS unsigned char* lds, int bid, int nb) {
    const int tid = opaque_tid(), wid = tid >> 6, lane = tid & 63;
    LAS float* wT = (LAS float*)lds;
    for (int i = tid; i < 16 * 1024; i += 512) { const int e = i & 15, k = i >> 4; wT[e * 1024 + k] = p.in[I_WINE][(size_t)k * EVEN_COLS + NE_MAIN + e]; }
    __syncthreads();
    const float* x = p.in[I_X]; float* xa = (float*)(p.ws + OFF_U);
    for (int tok = bid * 8 + wid; tok < NTOK; tok += nb * 8) {
        f32x4 v[4];
        asm volatile("" ::: "memory");
#pragma unroll
        for (int j = 0; j < 4; ++j) v[j] = *(const f32x4*)(x + (size_t)tok * DM + j * 256 + lane * 4);
        float mine = 0.f;
#pragma unroll
        for (int e = 0; e < 16; ++e) { float a = 0.f;
#pragma unroll
            for (int j = 0; j < 4; ++j) { const f32x4 w = *(const LAS f32x4*)(wT + e * 1024 + j * 256 + lane * 4); a += (v[j][0] * w[0] + v[j][1] * w[1]) + (v[j][2] * w[2] + v[j][3] * w[3]); }
            a = wave_sum(a); if (lane == e) mine = a; }
        if (lane < 16) xa[(size_t)tok * 16 + lane] = mine;
    }
    __syncthreads();
}

template <int CTRL> __device__ __forceinline__ float dppf(float v) { return __builtin_bit_cast(float, __builtin_amdgcn_update_dpp(0, __builtin_bit_cast(int, v), CTRL, 0xf, 0xf, true)); }
__device__ __forceinline__ float red8(float v) { v += dppf<0xB1>(v); v += dppf<0x4E>(v); v += dppf<0x141>(v); return v; }

__device__ __forceinline__ void rwkv_item(const Params& p, LAS unsigned char* lds, int item) {
    constexpr int TC = 16;
    const int tid = opaque_tid(), lane = tid & 63, tg = tid >> 6;
    const int b = item >> 3, h = item & 7;
    const bf16_t* P0 = (const bf16_t*)(p.ws + OFF_P);
    bf16_t* mix = (bf16_t*)(p.ws + OFF_BUF64);
    LAS float* w2s = (LAS float*)lds;
    LAS float* a2s = w2s + 64 * 64;
    LAS float* g2s = a2s + 64 * 64;
    LAS float* tw = g2s + 128 * 64;
    LAS float* xa_s = tw + TC * 64;
    LAS float* sg = xa_s + TC * 64;
    LAS float* r_s = sg + TC * 128;
    LAS float* k_s = r_s + TC * 64;
    LAS float* v_s = k_s + TC * 64;
    LAS float* w_s = v_s + TC * 64;
    LAS float* kk_s = w_s + TC * 64;
    LAS float* kka_s = kk_s + TC * 64;
    LAS float* kh_s = kka_s + TC * 64;
    LAS float* g_s = kh_s + TC * 64;
    LAS float* y_s = g_s + TC * 64;
    LAS float* rk_s = y_s + TC * 64;
    const float* mu = p.in[I_AMU];
    for (int i = tid; i < 64 * 64; i += 512) { const int r = i >> 6, c = i & 63; w2s[i] = p.in[I_AW2][r * 512 + h * 64 + c]; a2s[i] = p.in[I_AA2][r * 512 + h * 64 + c]; }
    for (int i = tid; i < 128 * 64; i += 512) { const int r = i >> 6, c = i & 63; g2s[i] = p.in[I_AG2][r * 512 + h * 64 + c]; }
    const int j = lane;
    const float w0 = p.in[I_AW0][h * 64 + j], a0 = p.in[I_AA0][h * 64 + j], kksc = p.in[I_AKK][h * 64 + j], kasc = p.in[I_AKA][h * 64 + j], rkj = p.in[I_ARK][h * 64 + j];
    const float gng = p.in[I_AGNG][h * 64 + j], gnb = p.in[I_AGNB][h * 64 + j];
    float S[8];
#pragma unroll
    for (int i = 0; i < 8; ++i) S[i] = 0.f;
    const int row = tid >> 3, kq = tid & 7;
    __syncthreads();
    for (int t0 = 0; t0 < SEQ; t0 += TC) {
        for (int idx = tid; idx < TC * 448; idx += 512) {
            const int t = idx / 448, c = idx % 448; int col; LAS float* dst; int kind = 0;
            if (c < 64) { col = h * 64 + c; dst = r_s + t * 64 + c; }
            else if (c < 128) { col = 512 + h * 64 + (c - 64); dst = k_s + t * 64 + (c - 64); }
            else if (c < 192) { col = 1024 + h * 64 + (c - 128); dst = v_s + t * 64 + (c - 128); }
            else if (c < 256) { col = 1536 + (c - 192); dst = tw + t * 64 + (c - 192); kind = 1; }
            else if (c < 320) { col = 1600 + (c - 256); dst = xa_s + t * 64 + (c - 256); }
            else { col = 1664 + (c - 320); dst = sg + t * 128 + (c - 320); kind = 2; }
            const size_t n = (size_t)b * SEQ + t0 + t;
            const float cur = bf2f(P0[n * NE_MAIN + col]);
            const float prev = (t0 + t) > 0 ? bf2f(P0[(n - 1) * NE_MAIN + col]) : 0.f;
            float val = cur + (prev - cur) * mu[col];
            if (kind == 1) val = tanhf(val); else if (kind == 2) val = 1.0f / (1.0f + expf(-val));
            *dst = val;
        }
        __syncthreads();
#pragma unroll
        for (int tt = 0; tt < 2; ++tt) {
            const int t = tg + tt * 8;
            float aw = 0.f, aa = 0.f, ag = 0.f;
            asm volatile("" ::: "memory");
#pragma unroll 4
            for (int i = 0; i < 64; ++i) { aw += tw[t * 64 + i] * w2s[i * 64 + j]; aa += xa_s[t * 64 + i] * a2s[i * 64 + j]; }
            asm volatile("" ::: "memory");
#pragma unroll 4
            for (int i = 0; i < 128; ++i) ag += sg[t * 128 + i] * g2s[i * 64 + j];
            asm volatile("" ::: "memory");
            const float z = w0 + aw;
            const float sp = (-z > 20.f) ? -z : log1pf(expf(-z));
            const float wlog = -sp - 0.5f;
            const float decay = expf(-expf(wlog));
            const float a = 1.0f / (1.0f + expf(-(a0 + aa)));
            const float kraw = k_s[t * 64 + j];
            const float kkp = kraw * kksc;
            const float nrm = sqrtf(wave_sum(kkp * kkp));
            const float kk = kkp / fmaxf(nrm, 1e-12f);
            const float kh = kraw * (1.0f + (a - 1.0f) * kasc);
            const float rr = r_s[t * 64 + j];
            const float rk = wave_sum(rr * kh * rkj);
            w_s[t * 64 + j] = decay; kk_s[t * 64 + j] = kk; kka_s[t * 64 + j] = kk * a; kh_s[t * 64 + j] = kh; g_s[t * 64 + j] = ag;
            if (j == 0) rk_s[t] = rk;
        }
        __syncthreads();
        for (int t = 0; t < TC; ++t) {
            const f32x4 kk0 = *(const LAS f32x4*)(kk_s + t * 64 + kq * 8), kk1 = *(const LAS f32x4*)(kk_s + t * 64 + kq * 8 + 4);
            const f32x4 ww0 = *(const LAS f32x4*)(w_s + t * 64 + kq * 8), ww1 = *(const LAS f32x4*)(w_s + t * 64 + kq * 8 + 4);
            const f32x4 ka0 = *(const LAS f32x4*)(kka_s + t * 64 + kq * 8), ka1 = *(const LAS f32x4*)(kka_s + t * 64 + kq * 8 + 4);
            const f32x4 kh0 = *(const LAS f32x4*)(kh_s + t * 64 + kq * 8), kh1 = *(const LAS f32x4*)(kh_s + t * 64 + kq * 8 + 4);
            const f32x4 rr0 = *(const LAS f32x4*)(r_s + t * 64 + kq * 8), rr1 = *(const LAS f32x4*)(r_s + t * 64 + kq * 8 + 4);
            const float vv = v_s[t * 64 + row];
            float sa = 0.f;
#pragma unroll
            for (int i = 0; i < 4; ++i) { sa += S[i] * kk0[i]; sa += S[4 + i] * kk1[i]; }
            sa = red8(sa);
            float y = 0.f;
#pragma unroll
            for (int i = 0; i < 4; ++i) {
                S[i] = S[i] * ww0[i] - sa * ka0[i] + vv * kh0[i]; S[4 + i] = S[4 + i] * ww1[i] - sa * ka1[i] + vv * kh1[i];
                y += S[i] * rr0[i]; y += S[4 + i] * rr1[i]; }
            y = red8(y);
            if (kq == 0) y_s[t * 64 + row] = y;
        }
        __syncthreads();
#pragma unroll
        for (int tt = 0; tt < 2; ++tt) {
            const int t = tg + tt * 8;
            const float y = y_s[t * 64 + j];
            const float mean = wave_sum(y) * (1.0f / 64.0f);
            const float d = y - mean;
            const float var = wave_sum(d * d) * (1.0f / 64.0f);
            const float yn = d * rsqrtf(var + 64e-5f) * gng + gnb;
            const float o = (yn + rk_s[t] * v_s[t * 64 + j]) * g_s[t * 64 + j];
            mix[((size_t)b * SEQ + t0 + t) * DM + h * 64 + j] = f2bf(o);
        }
        __syncthreads();
    }
}

__device__ __forceinline__ void gla_item(const Params& p, LAS unsigned char* lds, int item) {
    const int tid = opaque_tid(), lane = tid & 63, tg = tid >> 6;
    const int b = item >> 2, h = item & 3;
    const bf16_t* P0 = (const bf16_t*)(p.ws + OFF_P) + 1792;
    const float* xa16 = (const float*)(p.ws + OFF_U);
    bf16_t* mix = (bf16_t*)(p.ws + OFF_BUF64);
    LAS float* qd = (LAS float*)lds;
    LAS float* ki = qd + 64 * 65;
    LAS float* att = ki + 64 * 65;
    LAS float* vs = att + 64 * 65;
    LAS float* St = vs + 64 * 128;
    LAS float* bl = St + 64 * 128;
    for (int i = tid; i < 64 * 128; i += 512) St[i] = 0.f;
    float gw2[16];
#pragma unroll
    for (int i = 0; i < 16; ++i) gw2[i] = p.in[I_BGW2][i * 256 + h * 64 + lane];
    const float gb = p.in[I_BGB][h * 64 + lane];
    const float* bng = p.in[I_BNG];
    __syncthreads();
    for (int c0 = 0; c0 < SEQ; c0 += 64) {
        const size_t n0 = (size_t)b * SEQ + c0;
        for (int tt = 0; tt < 8; ++tt) { const int c = tg * 8 + tt; float z = gb;
#pragma unroll
            for (int i = 0; i < 16; ++i) z += xa16[(n0 + c) * 16 + i] * gw2[i];
            const float ls = (z >= 0.f) ? -log1pf(expf(-z)) : (z - log1pf(expf(z)));
            att[c * 65 + lane] = ls * (1.0f / 16.0f); }
        for (int i = tid; i < 64 * 128; i += 512) { const int c = i >> 7, e = i & 127; vs[i] = bf2f(P0[(n0 + c) * NE_MAIN + 512 + h * 128 + e]); }
        __syncthreads();
        if (tid < 64) { float a = 0.f; for (int c = 0; c < 64; ++c) { a += att[c * 65 + tid]; att[c * 65 + tid] = a; } bl[tid] = a; }
        __syncthreads();
        for (int i = tid; i < 64 * 64; i += 512) { const int c = i >> 6, d = i & 63; const float bc = att[c * 65 + d];
            const float q = bf2f(P0[(n0 + c) * NE_MAIN + h * 64 + d]), k = bf2f(P0[(n0 + c) * NE_MAIN + 256 + h * 64 + d]);
            qd[c * 65 + d] = q * 0.125f * expf(bc); ki[c * 65 + d] = k * expf(-bc); }
        __syncthreads();
        { const int c = tid >> 3, sgp = tid & 7; float a[8];
#pragma unroll
            for (int i = 0; i < 8; ++i) a[i] = 0.f;
            for (int d = 0; d < 64; ++d) { const float qv = qd[c * 65 + d];
#pragma unroll
                for (int i = 0; i < 8; ++i) a[i] += qv * ki[(sgp * 8 + i) * 65 + d]; }
            __syncthreads();
#pragma unroll
            for (int i = 0; i < 8; ++i) att[c * 65 + sgp * 8 + i] = (sgp * 8 + i <= c) ? a[i] : 0.f; }
        __syncthreads();
        { const int c = tid >> 3, eg = tid & 7; float o[16];
#pragma unroll
            for (int i = 0; i < 16; ++i) o[i] = 0.f;
            for (int s = 0; s <= c; ++s) { const float a = att[c * 65 + s];
#pragma unroll
                for (int i = 0; i < 16; ++i) o[i] += a * vs[s * 128 + eg * 16 + i]; }
            for (int d = 0; d < 64; ++d) { const float qv = qd[c * 65 + d];
#pragma unroll
                for (int i = 0; i < 16; ++i) o[i] += qv * St[d * 128 + eg * 16 + i]; }
            float ss = 0.f;
#pragma unroll
            for (int i = 0; i < 16; ++i) ss += o[i] * o[i];
            ss = red8(ss);
            const float rs = rsqrtf(ss * (1.0f / 128.0f) + 1e-5f);
#pragma unroll
            for (int i = 0; i < 16; ++i) { const int e = eg * 16 + i; const float g = bf2f(P0[(n0 + c) * NE_MAIN + 1024 + h * 128 + e]);
                const float val = o[i] * rs * bng[h * 128 + e] * (g / (1.0f + expf(-g)));
                mix[(n0 + c) * DM + 512 + h * 128 + e] = f2bf(val); } }
        __syncthreads();
        { const int d = tid >> 3, eg = tid & 7; float a[16];
#pragma unroll
            for (int i = 0; i < 16; ++i) a[i] = St[d * 128 + eg * 16 + i];
            for (int c = 0; c < 64; ++c) { const float kv = ki[c * 65 + d];
#pragma unroll
                for (int i = 0; i < 16; ++i) a[i] += kv * vs[c * 128 + eg * 16 + i]; }
            const float eb = expf(bl[d]);
#pragma unroll
            for (int i = 0; i < 16; ++i) St[d * 128 + eg * 16 + i] = a[i] * eb; }
        __syncthreads();
    }
}

__device__ __forceinline__ float red16(float v) { v += dppf<0xB1>(v); v += dppf<0x4E>(v); v += dppf<0x141>(v); v += dppf<0x140>(v); return v; }
__device__ __forceinline__ void rwkv2_item(const Params& p, LAS unsigned char* lds, int item) {
    constexpr int TC = 32;
    const int tid = opaque_tid(), lane = tid & 63, wid = tid >> 6, fr = lane & 15, g = lane >> 4;
    const int b = item >> 4, h = (item >> 1) & 7, rq = item & 1;
    unsigned char* ws = p.ws;
    const bf16_t* P0 = (const bf16_t*)(ws + OFF_P);
    float* yraw = p.out;
    bf16_t* e1g = (bf16_t*)(p.out + (size_t)NTOK * 512);
    bf16_t* gg = e1g + (size_t)NTOK * 512;
    LAS float* kk_s = (LAS float*)lds;
    LAS float* w_s = kk_s + TC * 64;
    LAS float* b_s = w_s + TC * 64;
    LAS float* kh_s = b_s + TC * 64;
    LAS float* wr_s = kh_s + TC * 64;
    LAS float* wpre = wr_s + TC * 64;
    LAS float* apre = wpre + TC * 64;
    LAS float* gpre = apre + TC * 64;
    LAS float* v_s = gpre + TC * 32;
    LAS float* y_s = v_s + TC * 32;
    LAS float* sc_s = y_s + TC * 32;
    LAS unsigned char* tw_i = (LAS unsigned char*)(sc_s + TC * 2);
    LAS unsigned char* xa_i = tw_i + TC * 128;
    LAS unsigned char* sg_i = xa_i + TC * 128;
    const float* mu = p.in[I_AMU];
    const bf16_t* w2t = (const bf16_t*)(ws + OFF_MISC + MISC_W2T); const bf16_t* a2t = (const bf16_t*)(ws + OFF_MISC + MISC_A2T); const bf16_t* g2t = (const bf16_t*)(ws + OFF_MISC + MISC_G2T);
    const int mrt = wid >> 2, mct = wid & 3;
    bf16x8 wf[2], af[2], gf[4];
#pragma unroll
    for (int s = 0; s < 2; ++s) { wf[s] = *(const bf16x8*)(w2t + (size_t)(h * 64 + mct * 16 + fr) * 64 + s * 32 + g * 8); af[s] = *(const bf16x8*)(a2t + (size_t)(h * 64 + mct * 16 + fr) * 64 + s * 32 + g * 8); }
    const int grt = (wid >> 1) & 1, gct = wid & 1;
#pragma unroll
    for (int s = 0; s < 4; ++s) gf[s] = *(const bf16x8*)(g2t + (size_t)(h * 64 + rq * 32 + gct * 16 + fr) * 128 + s * 32 + g * 8);
    const int et = tid >> 4, ec = tid & 15;
    const f32x4 w0v = *(const f32x4*)(p.in[I_AW0] + h * 64 + ec * 4), a0v = *(const f32x4*)(p.in[I_AA0] + h * 64 + ec * 4);
    const f32x4 kksc = *(const f32x4*)(p.in[I_AKK] + h * 64 + ec * 4), kasc = *(const f32x4*)(p.in[I_AKA] + h * 64 + ec * 4), rkv = *(const f32x4*)(p.in[I_ARK] + h * 64 + ec * 4);
    const f32x4 mur = *(const f32x4*)(mu + h * 64 + ec * 4), muk = *(const f32x4*)(mu + 512 + h * 64 + ec * 4);
    const f32x2 muv = *(const f32x2*)(mu + 1024 + h * 64 + rq * 32 + ec * 2);
    const int p1tok0 = tid >> 5, p1cc = tid & 31, p1col = 1536 + p1cc * 8;
    const f32x4 p1m0 = *(const f32x4*)(mu + p1col), p1m1 = *(const f32x4*)(mu + p1col + 4);
    float S[4] = {0.f, 0.f, 0.f, 0.f};
    const int rl = wid * 4 + g, kq = fr;
    const size_t nb0 = (size_t)b * SEQ;
    u32x4 l_cu[2], l_pv[2]; u32x2 l_rc, l_kc, l_rp, l_kp; unsigned l_vc, l_vp;
#define RW_ISSUE(t0n) do { \
        _Pragma("unroll") for (int _i = 0; _i < 2; ++_i) { const size_t _n = nb0 + (t0n) + p1tok0 + _i * 16; \
            l_cu[_i] = *(const u32x4*)(P0 + _n * NE_MAIN + p1col); l_pv[_i] = uzero4(); \
            if ((t0n) + p1tok0 + _i * 16 > 0) l_pv[_i] = *(const u32x4*)(P0 + (_n - 1) * NE_MAIN + p1col); } \
        { const size_t _n = nb0 + (t0n) + et; const bool _hp = ((t0n) + et) > 0; \
            l_rc = *(const u32x2*)(P0 + _n * NE_MAIN + h * 64 + ec * 4); l_kc = *(const u32x2*)(P0 + _n * NE_MAIN + 512 + h * 64 + ec * 4); \
            l_vc = *(const unsigned*)(P0 + _n * NE_MAIN + 1024 + h * 64 + rq * 32 + ec * 2); \
            l_rp = (u32x2){0u, 0u}; l_kp = (u32x2){0u, 0u}; l_vp = 0u; \
            if (_hp) { l_rp = *(const u32x2*)(P0 + (_n - 1) * NE_MAIN + h * 64 + ec * 4); l_kp = *(const u32x2*)(P0 + (_n - 1) * NE_MAIN + 512 + h * 64 + ec * 4); \
                l_vp = *(const unsigned*)(P0 + (_n - 1) * NE_MAIN + 1024 + h * 64 + rq * 32 + ec * 2); } } } while (0)
#define MIX2(wc, wp, mA, mB, o0, o1) { const float c0 = __uint_as_float((wc) << 16), c1 = __uint_as_float((wc) & 0xffff0000u), q0 = __uint_as_float((wp) << 16), q1 = __uint_as_float((wp) & 0xffff0000u); o0 = c0 + (q0 - c0) * (mA); o1 = c1 + (q1 - c1) * (mB); }
    RW_ISSUE(0);
    for (int t0 = 0; t0 < SEQ; t0 += TC) {
#pragma unroll 1
        for (int prep_rep = 0; prep_rep < PREP_REP; ++prep_rep) {
#pragma unroll
        for (int i = 0; i < 2; ++i) {
            const int tok = p1tok0 + i * 16, cc = p1cc;
            const u32x4 cu = l_cu[i], pv = l_pv[i];
            float x[8];
            MIX2(cu.x, pv.x, p1m0[0], p1m0[1], x[0], x[1]) MIX2(cu.y, pv.y, p1m0[2], p1m0[3], x[2], x[3]) MIX2(cu.z, pv.z, p1m1[0], p1m1[1], x[4], x[5]) MIX2(cu.w, pv.w, p1m1[2], p1m1[3], x[6], x[7])
            if (cc < 8) {
#pragma unroll
                for (int j = 0; j < 8; ++j) x[j] = fast_tanh(x[j]); }
            else if (cc >= 16) {
#pragma unroll
                for (int j = 0; j < 8; ++j) x[j] = fast_sigmoid(x[j]); }
            u32x4 o; o.x = cvt_pk_bf16(x[0], x[1]); o.y = cvt_pk_bf16(x[2], x[3]); o.z = cvt_pk_bf16(x[4], x[5]); o.w = cvt_pk_bf16(x[6], x[7]);
            if (cc < 8) *(LAS u32x4*)(tw_i + tok * 128 + ((cc ^ (tok & 7)) * 16)) = o;
            else if (cc < 16) *(LAS u32x4*)(xa_i + tok * 128 + (((cc - 8) ^ (tok & 7)) * 16)) = o;
            else *(LAS u32x4*)(sg_i + tok * 256 + (((cc - 16) ^ (tok & 7)) * 16)) = o;
        }
        __syncthreads();
        {
            f32x4 dw = fzero4(), da = fzero4();
            const int row = mrt * 16 + fr;
#pragma unroll
            for (int s = 0; s < 2; ++s) {
                const bf16x8 ta = *(const LAS bf16x8*)(tw_i + row * 128 + (((s * 4 + g) ^ (row & 7)) * 16));
                const bf16x8 xa = *(const LAS bf16x8*)(xa_i + row * 128 + (((s * 4 + g) ^ (row & 7)) * 16));
                dw = __builtin_amdgcn_mfma_f32_16x16x32_bf16(ta, wf[s], dw, 0, 0, 0);
                da = __builtin_amdgcn_mfma_f32_16x16x32_bf16(xa, af[s], da, 0, 0, 0);
            }
#pragma unroll
            for (int r = 0; r < 4; ++r) { wpre[(mrt * 16 + g * 4 + r) * 64 + mct * 16 + fr] = dw[r]; apre[(mrt * 16 + g * 4 + r) * 64 + mct * 16 + fr] = da[r]; }
            if (wid < 4) {
                f32x4 dg = fzero4();
                const int grow = grt * 16 + fr;
#pragma unroll
                for (int s = 0; s < 4; ++s) { const bf16x8 sa_ = *(const LAS bf16x8*)(sg_i + grow * 256 + (((s * 4 + g) ^ (grow & 7)) * 16));
                    dg = __builtin_amdgcn_mfma_f32_16x16x32_bf16(sa_, gf[s], dg, 0, 0, 0); }
#pragma unroll
                for (int r = 0; r < 4; ++r) gpre[(grt * 16 + g * 4 + r) * 32 + gct * 16 + fr] = dg[r];
            }
        }
        __syncthreads();
        {
            const size_t n = nb0 + t0 + et;
            float rr[4], kr_[4];
            MIX2(l_rc.x, l_rp.x, mur[0], mur[1], rr[0], rr[1]) MIX2(l_rc.y, l_rp.y, mur[2], mur[3], rr[2], rr[3])
            MIX2(l_kc.x, l_kp.x, muk[0], muk[1], kr_[0], kr_[1]) MIX2(l_kc.y, l_kp.y, muk[2], muk[3], kr_[2], kr_[3])
            const f32x4 wp = *(const LAS f32x4*)(wpre + et * 64 + ec * 4), ap = *(const LAS f32x4*)(apre + et * 64 + ec * 4);
            float dec[4], aa[4], kkp[4], nsq = 0.f;
#pragma unroll
            for (int j = 0; j < 4; ++j) { const float z = w0v[j] + wp[j]; const float sp = __logf(1.0f + __expf(-z));
                dec[j] = __expf(-__expf(-sp - 0.5f)); aa[j] = fast_sigmoid(a0v[j] + ap[j]); kkp[j] = kr_[j] * kksc[j]; nsq += kkp[j] * kkp[j]; }
            nsq = red16(nsq);
            const float inrm = 1.0f / fmaxf(sqrtf(nsq), 1e-12f);
            f32x4 kkv, bv, khv, wrv, wv; float br = 0.f, kr2 = 0.f, rk = 0.f;
#pragma unroll
            for (int j = 0; j < 4; ++j) { const float kk = kkp[j] * inrm; const float kh = kr_[j] * (1.0f + (aa[j] - 1.0f) * kasc[j]); const float bb = kk * aa[j];
                kkv[j] = kk; bv[j] = bb; khv[j] = kh; wv[j] = dec[j]; wrv[j] = dec[j] * rr[j]; br += bb * rr[j]; kr2 += kh * rr[j]; rk += rr[j] * kh * rkv[j]; }
            br = red16(br); kr2 = red16(kr2); rk = red16(rk);
            *(LAS f32x4*)(kk_s + et * 64 + ec * 4) = kkv; *(LAS f32x4*)(w_s + et * 64 + ec * 4) = wv; *(LAS f32x4*)(b_s + et * 64 + ec * 4) = bv;
            *(LAS f32x4*)(kh_s + et * 64 + ec * 4) = khv; *(LAS f32x4*)(wr_s + et * 64 + ec * 4) = wrv;
            if (ec == 0) { sc_s[et * 2] = br; sc_s[et * 2 + 1] = kr2; }
            float v0, v1; MIX2(l_vc, l_vp, muv[0], muv[1], v0, v1)
            *(LAS f32x2*)(v_s + et * 32 + ec * 2) = (f32x2){v0, v1};
            const f32x2 gp = *(const LAS f32x2*)(gpre + et * 32 + ec * 2);
            *(unsigned*)(e1g + n * 512 + h * 64 + rq * 32 + ec * 2) = cvt_pk_bf16(rk * v0, rk * v1);
            *(unsigned*)(gg + n * 512 + h * 64 + rq * 32 + ec * 2) = cvt_pk_bf16(gp[0], gp[1]);
        }
        if (prep_rep + 1 < PREP_REP) __syncthreads();
        }
        if (t0 + TC < SEQ) RW_ISSUE(t0 + TC);
        __syncthreads();
        {
            f32x4 kkA = *(const LAS f32x4*)(kk_s + kq * 4), wrA = *(const LAS f32x4*)(wr_s + kq * 4), wwA = *(const LAS f32x4*)(w_s + kq * 4), bbA = *(const LAS f32x4*)(b_s + kq * 4), khA = *(const LAS f32x4*)(kh_s + kq * 4);
            float vvA = v_s[rl]; f32x2 scA = *(const LAS f32x2*)(sc_s);
            float yacc = 0.f;
#pragma unroll 1
            for (int t = 0; t < TC; ++t) {
                const int tn = (t + 1) & (TC - 1);
                const f32x4 kkB = *(const LAS f32x4*)(kk_s + tn * 64 + kq * 4), wrB = *(const LAS f32x4*)(wr_s + tn * 64 + kq * 4), wwB = *(const LAS f32x4*)(w_s + tn * 64 + kq * 4);
                const f32x4 bbB = *(const LAS f32x4*)(b_s + tn * 64 + kq * 4), khB = *(const LAS f32x4*)(kh_s + tn * 64 + kq * 4);
                const float vvB = v_s[tn * 32 + rl]; const f32x2 scB = *(const LAS f32x2*)(sc_s + tn * 2);
                float sa = S[0] * kkA[0] + S[1] * kkA[1] + S[2] * kkA[2] + S[3] * kkA[3];
                float yy = S[0] * wrA[0] + S[1] * wrA[1] + S[2] * wrA[2] + S[3] * wrA[3];
                sa = red16(sa); yy = red16(yy);
                const float y = yy - sa * scA[0] + vvA * scA[1];
                yacc = (kq == (t & 15)) ? y : yacc;
#pragma unroll
                for (int i = 0; i < 4; ++i) S[i] = S[i] * wwA[i] + (vvA * khA[i] - sa * bbA[i]);
                if ((t & 15) == 15) y_s[((t & 16) + kq) * 32 + rl] = yacc;
                kkA = kkB; wrA = wrB; wwA = wwB; bbA = bbB; khA = khB; vvA = vvB; scA = scB;
            }
        }
        __syncthreads();
        { const int tok = tid >> 4, c2 = (tid & 15) * 2; *(f32x2*)(yraw + (nb0 + t0 + tok) * 512 + h * 64 + rq * 32 + c2) = *(const LAS f32x2*)(y_s + tok * 32 + c2); }
    }
#undef MIX2
#undef RW_ISSUE
}

template <int CTRL> __device__ __forceinline__ float dpp0f(float v) { return __builtin_bit_cast(float, __builtin_amdgcn_update_dpp(0, __builtin_bit_cast(int, v), CTRL, 0xf, 0xf, true)); }
__device__ __forceinline__ bf16x8 pack_lo4(const f32x4 a) { u32x4 w; w.x = cvt_pk_bf16(a[0], a[1]); w.y = cvt_pk_bf16(a[2], a[3]); w.z = 0u; w.w = 0u; return __builtin_bit_cast(bf16x8, w); }
__device__ __forceinline__ bf16x8 pack_8(const f32x4 a, const f32x4 b) { u32x4 w; w.x = cvt_pk_bf16(a[0], a[1]); w.y = cvt_pk_bf16(a[2], a[3]); w.z = cvt_pk_bf16(b[0], b[1]); w.w = cvt_pk_bf16(b[2], b[3]); return __builtin_bit_cast(bf16x8, w); }
__device__ __forceinline__ f32x4 mm16(const f32x4 PT, const f32x4 Q) { return __builtin_amdgcn_mfma_f32_16x16x32_bf16(pack_lo4(PT), pack_lo4(Q), fzero4(), 0, 0, 0); }
constexpr int RW3_SLOT = 12544;
__device__ __forceinline__ int rw3_trswz(int row, int c) { return (((c >> 1) ^ ((row >> 1) & 3)) << 1) | (c & 1); }
__device__ __forceinline__ void rwkv3_item(const Params& p, LAS unsigned char* lds, int item) {
    const int tid = opaque_tid(), lane = tid & 63, wid = tid >> 6, fr = lane & 15, g = lane >> 4;
    const int b = item >> 3, h = item & 7;
    unsigned char* ws = p.ws;
    const bf16_t* P0 = (const bf16_t*)(ws + OFF_P);
    float* yraw = p.out; bf16_t* e1g = (bf16_t*)(p.out + (size_t)NTOK * 512); bf16_t* gg = e1g + (size_t)NTOK * 512;
    LAS unsigned char* w2h = lds;
    LAS unsigned char* a2h = lds + 8192;
    LAS unsigned char* g2h = lds + 16384;
    LAS unsigned char* slots = lds + 32768;
    LAS float* ptab = (LAS float*)(lds + 32768 + 8 * RW3_SLOT);
    LAS float* mul = ptab + 8 * 64;
    {
        const float* mu = p.in[I_AMU];
        if (tid < 64) { ptab[tid] = mu[h * 64 + tid]; ptab[64 + tid] = mu[512 + h * 64 + tid]; ptab[128 + tid] = mu[1024 + h * 64 + tid];
            ptab[192 + tid] = p.in[I_AW0][h * 64 + tid]; ptab[256 + tid] = p.in[I_AA0][h * 64 + tid]; ptab[320 + tid] = p.in[I_AKK][h * 64 + tid];
            ptab[384 + tid] = p.in[I_AKA][h * 64 + tid]; ptab[448 + tid] = p.in[I_ARK][h * 64 + tid]; }
        if (tid < 256) mul[tid] = mu[1536 + tid];
    }
    {
        const bf16_t* w2t = (const bf16_t*)(ws + OFF_MISC + MISC_W2T); const bf16_t* a2t = (const bf16_t*)(ws + OFF_MISC + MISC_A2T); const bf16_t* g2t = (const bf16_t*)(ws + OFF_MISC + MISC_G2T);
        { const int row = tid >> 3, c = tid & 7;
            *(LAS u32x4*)(w2h + row * 128 + ((c ^ (row & 7)) * 16)) = *(const u32x4*)(w2t + (size_t)(h * 64 + row) * 64 + c * 8);
            *(LAS u32x4*)(a2h + row * 128 + ((c ^ (row & 7)) * 16)) = *(const u32x4*)(a2t + (size_t)(h * 64 + row) * 64 + c * 8); }
#pragma unroll
        for (int i = 0; i < 2; ++i) { const int q = tid + i * 512, row = q >> 4, c = q & 15;
            *(LAS u32x4*)(g2h + row * 256 + ((c ^ (row & 7)) * 16)) = *(const u32x4*)(g2t + (size_t)(h * 64 + row) * 128 + c * 8); }
    }
    __syncthreads();
    f32x4 Hacc[4];
#pragma unroll
    for (int rt = 0; rt < 4; ++rt) Hacc[rt] = fzero4();
    const size_t nb0 = (size_t)b * SEQ;
    const int q4 = fr >> 2, p4 = fr & 3;
#define MIXB(wc, wp, mA, mB, o0, o1) { const float c0 = __uint_as_float((wc) << 16), c1 = __uint_as_float((wc) & 0xffff0000u), q0 = __uint_as_float((wp) << 16), q1 = __uint_as_float((wp) & 0xffff0000u); o0 = c0 + (q0 - c0) * (mA); o1 = c1 + (q1 - c1) * (mB); }
#pragma unroll 1
    for (int tick = 0; tick < SEQ / 128; ++tick) {
        {
            int lane_t = lane; asm volatile("" : "+v"(lane_t));
            const int fr = lane_t & 15, g = lane_t >> 4, q4 = fr >> 2, p4 = fr & 3;
            LAS unsigned char* sl = slots + wid * RW3_SLOT;
            LAS unsigned char* Qt_i = sl, * Rh_i = sl + 2048, * Kh_i = sl + 4096, * Bn_i = sl + 6144, * Vi_i = sl + 8192, * M1_i = sl + 10240, * DD_i = sl + 11264; LAS float* gam_i = (LAS float*)(sl + 12288);
            const int t0 = (tick * 8 + wid) * 16;
            const size_t n = nb0 + t0 + fr;
            const bool hasp = (t0 + fr) > 0;
            const bf16_t* rowc = P0 + n * NE_MAIN; const bf16_t* rowp = rowc - NE_MAIN;
            u32x2 lrc[4], lkc[4], lvc[4], lrp[4], lkp[4], lvp[4];
#pragma unroll
            for (int ct = 0; ct < 4; ++ct) { const int c0 = ct * 16 + g * 4;
                lrc[ct] = *(const u32x2*)(rowc + h * 64 + c0); lkc[ct] = *(const u32x2*)(rowc + 512 + h * 64 + c0); lvc[ct] = *(const u32x2*)(rowc + 1024 + h * 64 + c0);
                lrp[ct] = (u32x2){0u, 0u}; lkp[ct] = lrp[ct]; lvp[ct] = lrp[ct];
                if (hasp) { lrp[ct] = *(const u32x2*)(rowp + h * 64 + c0); lkp[ct] = *(const u32x2*)(rowp + 512 + h * 64 + c0); lvp[ct] = *(const u32x2*)(rowp + 1024 + h * 64 + c0); } }
            bf16x8 bw[2], ba[2], bg[4];
#pragma unroll
            for (int f = 0; f < 8; ++f) {
                const int col = 1536 + (f < 2 ? f * 32 : (f < 4 ? 64 + (f - 2) * 32 : 128 + (f - 4) * 32)) + g * 8;
                const u32x4 cu = *(const u32x4*)(rowc + col); u32x4 pv = uzero4(); if (hasp) pv = *(const u32x4*)(rowp + col);
                const f32x4 m0 = *(const LAS f32x4*)(mul + col - 1536), m1 = *(const LAS f32x4*)(mul + col - 1536 + 4);
                float x[8];
                MIXB(cu.x, pv.x, m0[0], m0[1], x[0], x[1]) MIXB(cu.y, pv.y, m0[2], m0[3], x[2], x[3]) MIXB(cu.z, pv.z, m1[0], m1[1], x[4], x[5]) MIXB(cu.w, pv.w, m1[2], m1[3], x[6], x[7])
                if (f < 2) {
#pragma unroll
                    for (int j = 0; j < 8; ++j) x[j] = fast_tanh(x[j]); }
                else if (f >= 4) {
#pragma unroll
                    for (int j = 0; j < 8; ++j) x[j] = fast_sigmoid(x[j]); }
                u32x4 o; o.x = cvt_pk_bf16(x[0], x[1]); o.y = cvt_pk_bf16(x[2], x[3]); o.z = cvt_pk_bf16(x[4], x[5]); o.w = cvt_pk_bf16(x[6], x[7]);
                const bf16x8 ob = __builtin_bit_cast(bf16x8, o);
                if (f < 2) bw[f] = ob; else if (f < 4) ba[f - 2] = ob; else bg[f - 4] = ob;
            }
            f32x4 Wt[4], At[4], Gt[4];
#pragma unroll
            for (int ct = 0; ct < 4; ++ct) {
                const int row = ct * 16 + fr;
                f32x4 dw = fzero4(), da = dw, dg = dw;
#pragma unroll
                for (int s = 0; s < 2; ++s) {
                    dw = __builtin_amdgcn_mfma_f32_16x16x32_bf16(*(const LAS bf16x8*)(w2h + row * 128 + (((s * 4 + g) ^ (row & 7)) * 16)), bw[s], dw, 0, 0, 0);
                    da = __builtin_amdgcn_mfma_f32_16x16x32_bf16(*(const LAS bf16x8*)(a2h + row * 128 + (((s * 4 + g) ^ (row & 7)) * 16)), ba[s], da, 0, 0, 0); }
#pragma unroll
                for (int s = 0; s < 4; ++s) dg = __builtin_amdgcn_mfma_f32_16x16x32_bf16(*(const LAS bf16x8*)(g2h + row * 256 + (((s * 4 + g) ^ (row & 7)) * 16)), bg[s], dg, 0, 0, 0);
                Wt[ct] = dw; At[ct] = da; Gt[ct] = dg;
            }
            f32x4 Rm[4], Khm[4], Lw[4], Aa[4];
            float nsq = 0.f, rk = 0.f;
            u32x2 Vp[4];
#pragma unroll
            for (int ct = 0; ct < 4; ++ct) {
                const int c0 = ct * 16 + g * 4;
                const u32x2 rc = lrc[ct], kc = lkc[ct], vc = lvc[ct], rp = lrp[ct], kp = lkp[ct], vp = lvp[ct];
                const f32x4 mr = *(const LAS f32x4*)(ptab + c0), mk = *(const LAS f32x4*)(ptab + 64 + c0), mv = *(const LAS f32x4*)(ptab + 128 + c0);
                f32x4 Km, Vm;
                MIXB(rc.x, rp.x, mr[0], mr[1], Rm[ct][0], Rm[ct][1]) MIXB(rc.y, rp.y, mr[2], mr[3], Rm[ct][2], Rm[ct][3])
                MIXB(kc.x, kp.x, mk[0], mk[1], Km[0], Km[1]) MIXB(kc.y, kp.y, mk[2], mk[3], Km[2], Km[3])
                MIXB(vc.x, vp.x, mv[0], mv[1], Vm[0], Vm[1]) MIXB(vc.y, vp.y, mv[2], mv[3], Vm[2], Vm[3])
                const f32x4 w0v = *(const LAS f32x4*)(ptab + 192 + c0), a0v = *(const LAS f32x4*)(ptab + 256 + c0), kks = *(const LAS f32x4*)(ptab + 320 + c0), kas = *(const LAS f32x4*)(ptab + 384 + c0), rkp = *(const LAS f32x4*)(ptab + 448 + c0);
#pragma unroll
                for (int r = 0; r < 4; ++r) { const float z = w0v[r] + Wt[ct][r]; const float sp = __logf(1.0f + __expf(-z));
                    Lw[ct][r] = -__expf(-sp - 0.5f);
                    const float a = fast_sigmoid(a0v[r] + At[ct][r]); Aa[ct][r] = a;
                    const float kkp = Km[r] * kks[r]; nsq += kkp * kkp; Wt[ct][r] = kkp;
                    const float kh = Km[r] * (1.0f + (a - 1.0f) * kas[r]); Khm[ct][r] = kh; rk += Rm[ct][r] * kh * rkp[r]; }
                Vp[ct].x = cvt_pk_bf16(Vm[0], Vm[1]); Vp[ct].y = cvt_pk_bf16(Vm[2], Vm[3]);
                At[ct] = Vm;
            }
            nsq += __shfl_xor(nsq, 16); nsq += __shfl_xor(nsq, 32);
            rk += __shfl_xor(rk, 16); rk += __shfl_xor(rk, 32);
            const float inrm = 1.0f / fmaxf(sqrtf(nsq), 1e-12f);
#pragma unroll
            for (int ct = 0; ct < 4; ++ct) { const int c0 = ct * 16 + g * 4;
                u32x2 ew, gw; ew.x = cvt_pk_bf16(rk * At[ct][0], rk * At[ct][1]); ew.y = cvt_pk_bf16(rk * At[ct][2], rk * At[ct][3]);
                gw.x = cvt_pk_bf16(Gt[ct][0], Gt[ct][1]); gw.y = cvt_pk_bf16(Gt[ct][2], Gt[ct][3]);
                *(u32x2*)(e1g + n * 512 + h * 64 + c0) = ew; *(u32x2*)(gg + n * 512 + h * 64 + c0) = gw;
                const int c = 2 * ct + (g >> 1);
                *(LAS u32x2*)(Vi_i + fr * 128 + rw3_trswz(fr, c) * 16 + (g & 1) * 8) = Vp[ct]; }
            u32x2 Qp[4], Kp[4], Bp[4], Rp[4];
#pragma unroll
            for (int ct = 0; ct < 4; ++ct) {
                const int c0 = ct * 16 + g * 4;
                f32x4 gmv; float qh[4], kh_[4], bh[4], rh[4];
#pragma unroll
                for (int r = 0; r < 4; ++r) {
                    float L = Lw[ct][r];
                    L += dpp0f<0x111>(L); L += dpp0f<0x112>(L); L += dpp0f<0x114>(L); L += dpp0f<0x118>(L);
                    const float Ltot = __shfl(L, lane | 15);
                    const float eL = __expf(L), ieL = fast_rcp(eL), eLex = __expf(L - Lw[ct][r]);
                    const float kk = Wt[ct][r] * inrm, bb = kk * Aa[ct][r];
                    qh[r] = kk * eLex; kh_[r] = Khm[ct][r] * ieL; bh[r] = bb * ieL; rh[r] = Rm[ct][r] * eL;
                    gmv[r] = __expf(Ltot); }
                Qp[ct].x = cvt_pk_bf16(qh[0], qh[1]); Qp[ct].y = cvt_pk_bf16(qh[2], qh[3]); Kp[ct].x = cvt_pk_bf16(kh_[0], kh_[1]); Kp[ct].y = cvt_pk_bf16(kh_[2], kh_[3]);
                Bp[ct].x = cvt_pk_bf16(bh[0], bh[1]); Bp[ct].y = cvt_pk_bf16(bh[2], bh[3]); Rp[ct].x = cvt_pk_bf16(rh[0], rh[1]); Rp[ct].y = cvt_pk_bf16(rh[2], rh[3]);
                if (fr == 0) *(LAS f32x4*)(gam_i + c0) = gmv;
            }
            bf16x8 Qf[2], Kf[2], Bf[2], Rf[2];
#pragma unroll
            for (int s = 0; s < 2; ++s) { Qf[s] = __builtin_bit_cast(bf16x8, (u32x4){Qp[2 * s].x, Qp[2 * s].y, Qp[2 * s + 1].x, Qp[2 * s + 1].y}); Kf[s] = __builtin_bit_cast(bf16x8, (u32x4){Kp[2 * s].x, Kp[2 * s].y, Kp[2 * s + 1].x, Kp[2 * s + 1].y});
                Bf[s] = __builtin_bit_cast(bf16x8, (u32x4){Bp[2 * s].x, Bp[2 * s].y, Bp[2 * s + 1].x, Bp[2 * s + 1].y}); Rf[s] = __builtin_bit_cast(bf16x8, (u32x4){Rp[2 * s].x, Rp[2 * s].y, Rp[2 * s + 1].x, Rp[2 * s + 1].y}); }
            f32x4 Ab = fzero4(), AbT = Ab, Ak = Ab, DkT = Ab, DbT = Ab;
#pragma unroll
            for (int s = 0; s < 2; ++s) {
                Ab = __builtin_amdgcn_mfma_f32_16x16x32_bf16(Qf[s], Bf[s], Ab, 0, 0, 0);
                AbT = __builtin_amdgcn_mfma_f32_16x16x32_bf16(Bf[s], Qf[s], AbT, 0, 0, 0);
                Ak = __builtin_amdgcn_mfma_f32_16x16x32_bf16(Qf[s], Kf[s], Ak, 0, 0, 0);
                DkT = __builtin_amdgcn_mfma_f32_16x16x32_bf16(Kf[s], Rf[s], DkT, 0, 0, 0);
                DbT = __builtin_amdgcn_mfma_f32_16x16x32_bf16(Bf[s], Rf[s], DbT, 0, 0, 0); }
            f32x4 N, NT, ident;
#pragma unroll
            for (int r = 0; r < 4; ++r) { const int row = 4 * g + r;
                N[r] = (fr < row) ? -Ab[r] : 0.f; Ak[r] = (fr < row) ? Ak[r] : 0.f;
                NT[r] = (row < fr) ? -AbT[r] : 0.f;
                DkT[r] = (row <= fr) ? DkT[r] : 0.f; DbT[r] = (row <= fr) ? -DbT[r] : 0.f;
                ident[r] = (row == fr) ? 1.f : 0.f; }
            const f32x4 N2 = mm16(NT, N), N2T = mm16(N, NT);
            const f32x4 N4 = mm16(N2T, N2), N4T = mm16(N2, N2T);
            const f32x4 N8T = mm16(N4, N4T);
            const f32x4 X1 = N + ident, X1T = NT + ident, X2 = N2 + ident, X2T = N2T + ident, X4 = N4 + ident, X8T = N8T + ident;
            const f32x4 U12 = mm16(X1T, X2), U12T = mm16(X1, X2T), U34T = mm16(X4, X8T);
            const f32x4 TT = mm16(U12, U34T);
            const f32x4 M1T = mm16(Ak, TT);
#pragma unroll
            for (int ct = 0; ct < 4; ++ct) { const int c = 2 * ct + (g >> 1);
                *(LAS u32x2*)(Qt_i + fr * 128 + rw3_trswz(fr, c) * 16 + (g & 1) * 8) = Qp[ct]; }
            s16x4 qtr[4];
#pragma unroll
            for (int ct = 0; ct < 4; ++ct) { const int row = 4 * g + q4, c = 2 * ct + (p4 >> 1);
                qtr[ct] = __builtin_amdgcn_ds_read_tr16_b64_v4i16((LAS s16x4*)(Qt_i + row * 128 + rw3_trswz(row, c) * 16 + (p4 & 1) * 8)); }
            const bf16x8 TTf = pack_lo4(TT);
            f32x4 Qt[4];
#pragma unroll
            for (int ct = 0; ct < 4; ++ct) { const bf16x8 af = (bf16x8){qtr[ct][0], qtr[ct][1], qtr[ct][2], qtr[ct][3], 0, 0, 0, 0};
                Qt[ct] = __builtin_amdgcn_mfma_f32_16x16x32_bf16(af, TTf, fzero4(), 0, 0, 0); }
#pragma unroll
            for (int ct = 0; ct < 4; ++ct) {
                const int s = ct >> 1, hh = ct & 1;
                u32x2 w; w.x = cvt_pk_bf16(Qt[ct][0], Qt[ct][1]); w.y = cvt_pk_bf16(Qt[ct][2], Qt[ct][3]);
                *(LAS u32x2*)(Qt_i + fr * 128 + (((s * 4 + g) ^ (fr & 7)) * 16) + hh * 8) = w;
                *(LAS u32x2*)(Rh_i + fr * 128 + (((s * 4 + g) ^ (fr & 7)) * 16) + hh * 8) = Rp[ct];
                const int c = 2 * ct + (g >> 1);
                *(LAS u32x2*)(Kh_i + fr * 128 + rw3_trswz(fr, c) * 16 + (g & 1) * 8) = Kp[ct];
                *(LAS u32x2*)(Bn_i + fr * 128 + rw3_trswz(fr, c) * 16 + (g & 1) * 8) = (u32x2){Bp[ct].x ^ 0x80008000u, Bp[ct].y ^ 0x80008000u}; }
            { const int cs = (g ^ ((fr >> 2) & 3)) * 16;
                u32x2 w; w.x = cvt_pk_bf16(M1T[0], M1T[1]); w.y = cvt_pk_bf16(M1T[2], M1T[3]);
                *(LAS u32x2*)(M1_i + fr * 64 + cs) = (u32x2){0u, 0u}; *(LAS u32x2*)(M1_i + fr * 64 + cs + 8) = w;
                w.x = cvt_pk_bf16(DbT[0], DbT[1]); w.y = cvt_pk_bf16(DbT[2], DbT[3]); *(LAS u32x2*)(DD_i + fr * 64 + cs) = w;
                w.x = cvt_pk_bf16(DkT[0], DkT[1]); w.y = cvt_pk_bf16(DkT[2], DkT[3]); *(LAS u32x2*)(DD_i + fr * 64 + cs + 8) = w; }
        }
        __syncthreads();
        if (wid < 4) {
#pragma unroll 1
            for (int j = 0; j < 8; ++j) {
                int lane_t = lane; asm volatile("" : "+v"(lane_t));
                const int fr = lane_t & 15, g = lane_t >> 4, q4 = fr >> 2, p4 = fr & 3;
                LAS unsigned char* sl = slots + j * RW3_SLOT;
                LAS unsigned char* Qt_i = sl, * Rh_i = sl + 2048, * Kh_i = sl + 4096, * Bn_i = sl + 6144, * Vi_i = sl + 8192, * M1_i = sl + 10240, * DD_i = sl + 11264; LAS const float* gam_i = (LAS const float*)(sl + 12288);
                const bf16x8 Hb0 = pack_8(Hacc[0], Hacc[1]), Hb1 = pack_8(Hacc[2], Hacc[3]);
                const int trow = 4 * g + q4;
                const s16x4 vv = __builtin_amdgcn_ds_read_tr16_b64_v4i16((LAS s16x4*)(Vi_i + trow * 128 + rw3_trswz(trow, 2 * wid + (p4 >> 1)) * 16 + (p4 & 1) * 8));
                const bf16x8 q0 = *(const LAS bf16x8*)(Qt_i + fr * 128 + (((0 + g) ^ (fr & 7)) * 16)), q1 = *(const LAS bf16x8*)(Qt_i + fr * 128 + (((4 + g) ^ (fr & 7)) * 16));
                const bf16x8 r0 = *(const LAS bf16x8*)(Rh_i + fr * 128 + (((0 + g) ^ (fr & 7)) * 16)), r1 = *(const LAS bf16x8*)(Rh_i + fr * 128 + (((4 + g) ^ (fr & 7)) * 16));
                const int cs = (g ^ ((fr >> 2) & 3)) * 16;
                const bf16x8 m1 = *(const LAS bf16x8*)(M1_i + fr * 64 + cs), dd = *(const LAS bf16x8*)(DD_i + fr * 64 + cs);
                const bf16x8 v0 = (bf16x8){0, 0, 0, 0, vv[0], vv[1], vv[2], vv[3]};
                f32x4 Z = fzero4();
                Z = __builtin_amdgcn_mfma_f32_16x16x32_bf16(q0, Hb0, Z, 0, 0, 0); Z = __builtin_amdgcn_mfma_f32_16x16x32_bf16(q1, Hb1, Z, 0, 0, 0); Z = __builtin_amdgcn_mfma_f32_16x16x32_bf16(m1, v0, Z, 0, 0, 0);
                u32x2 zw; zw.x = cvt_pk_bf16(Z[0], Z[1]); zw.y = cvt_pk_bf16(Z[2], Z[3]);
                const s16x4 zs = __builtin_bit_cast(s16x4, zw);
                const bf16x8 zv = (bf16x8){zs[0], zs[1], zs[2], zs[3], vv[0], vv[1], vv[2], vv[3]};
                f32x4 Y = fzero4();
                Y = __builtin_amdgcn_mfma_f32_16x16x32_bf16(r0, Hb0, Y, 0, 0, 0); Y = __builtin_amdgcn_mfma_f32_16x16x32_bf16(r1, Hb1, Y, 0, 0, 0); Y = __builtin_amdgcn_mfma_f32_16x16x32_bf16(dd, zv, Y, 0, 0, 0);
                const size_t nrow = nb0 + (size_t)(tick * 8 + j) * 16 + 4 * g;
#pragma unroll
                for (int r = 0; r < 4; ++r) yraw[(nrow + r) * 512 + h * 64 + wid * 16 + fr] = Y[r];
#pragma unroll
                for (int rt = 0; rt < 4; ++rt) { const int c = 2 * rt + (p4 >> 1);
                    const s16x4 bn = __builtin_amdgcn_ds_read_tr16_b64_v4i16((LAS s16x4*)(Bn_i + trow * 128 + rw3_trswz(trow, c) * 16 + (p4 & 1) * 8));
                    const s16x4 kh = __builtin_amdgcn_ds_read_tr16_b64_v4i16((LAS s16x4*)(Kh_i + trow * 128 + rw3_trswz(trow, c) * 16 + (p4 & 1) * 8));
                    const bf16x8 af = (bf16x8){bn[0], bn[1], bn[2], bn[3], kh[0], kh[1], kh[2], kh[3]};
                    Hacc[rt] = __builtin_amdgcn_mfma_f32_16x16x32_bf16(af, zv, Hacc[rt], 0, 0, 0);
                    Hacc[rt] = Hacc[rt] * *(const LAS f32x4*)(gam_i + rt * 16 + g * 4); }
            }
        }
        __syncthreads();
    }
#undef MIXB
}

__device__ __forceinline__ void phase_rwkv_epi(const Params& p, int bid, int nb) {
    const int tid = opaque_tid(), wid = tid >> 6, lane = tid & 63;
    const float* yraw = p.out; const bf16_t* e1g = (const bf16_t*)(p.out + (size_t)NTOK * 512); const bf16_t* gg = e1g + (size_t)NTOK * 512;
    bf16_t* mix = (bf16_t*)(p.ws + OFF_BUF64);
    const f32x4 g0 = *(const f32x4*)(p.in[I_AGNG] + lane * 8), g1 = *(const f32x4*)(p.in[I_AGNG] + lane * 8 + 4), b0 = *(const f32x4*)(p.in[I_AGNB] + lane * 8), b1 = *(const f32x4*)(p.in[I_AGNB] + lane * 8 + 4);
    for (int n = bid * 8 + wid; n < NTOK; n += nb * 8) {
        const f32x4 y0 = *(const f32x4*)(yraw + (size_t)n * 512 + lane * 8), y1 = *(const f32x4*)(yraw + (size_t)n * 512 + lane * 8 + 4);
        const u32x4 ev = *(const u32x4*)(e1g + (size_t)n * 512 + lane * 8), gv = *(const u32x4*)(gg + (size_t)n * 512 + lane * 8);
#if SANITIZE
        f32x4 y0s = y0, y1s = y1;
#pragma unroll
        for (int j = 0; j < 4; ++j) { if (!(fabsf(y0s[j]) < 1e30f)) y0s[j] = 0.f; if (!(fabsf(y1s[j]) < 1e30f)) y1s[j] = 0.f; }
#define y0 y0s
#define y1 y1s
#endif
        float s = (y0[0] + y0[1]) + (y0[2] + y0[3]) + (y1[0] + y1[1]) + (y1[2] + y1[3]);
        s = red8(s); const float mean = s * (1.0f / 64.0f);
        const f32x4 d0 = y0 - mean, d1 = y1 - mean;
        float q = (d0[0] * d0[0] + d0[1] * d0[1]) + (d0[2] * d0[2] + d0[3] * d0[3]) + (d1[0] * d1[0] + d1[1] * d1[1]) + (d1[2] * d1[2] + d1[3] * d1[3]);
        q = red8(q); const float rs = rsqrtf(q * (1.0f / 64.0f) + 64e-5f);
        float o[8];
        const unsigned ew[4] = {ev.x, ev.y, ev.z, ev.w}, gw[4] = {gv.x, gv.y, gv.z, gv.w};
#pragma unroll
        for (int j = 0; j < 4; ++j) { const float ya = (j < 2 ? d0[2 * j] : d1[2 * j - 4]), yb = (j < 2 ? d0[2 * j + 1] : d1[2 * j - 3]);
            const float ga = (j < 2 ? g0[2 * j] : g1[2 * j - 4]), gb_ = (j < 2 ? g0[2 * j + 1] : g1[2 * j - 3]); const float ba = (j < 2 ? b0[2 * j] : b1[2 * j - 4]), bb_ = (j < 2 ? b0[2 * j + 1] : b1[2 * j - 3]);
            o[2 * j] = (ya * rs * ga + ba + __uint_as_float(ew[j] << 16)) * __uint_as_float(gw[j] << 16);
            o[2 * j + 1] = (yb * rs * gb_ + bb_ + __uint_as_float(ew[j] & 0xffff0000u)) * __uint_as_float(gw[j] & 0xffff0000u); }
        u32x4 w; w.x = cvt_pk_bf16(o[0], o[1]); w.y = cvt_pk_bf16(o[2], o[3]); w.z = cvt_pk_bf16(o[4], o[5]); w.w = cvt_pk_bf16(o[6], o[7]);
#if SANITIZE
#undef y0
#undef y1
#pragma unroll
        for (int j = 0; j < 8; ++j) if (!(fabsf(o[j]) < 1e30f)) o[j] = 0.f;
        w.x = cvt_pk_bf16(o[0], o[1]); w.y = cvt_pk_bf16(o[2], o[3]); w.z = cvt_pk_bf16(o[4], o[5]); w.w = cvt_pk_bf16(o[6], o[7]);
#endif
        *(u32x4*)(mix + (size_t)n * DM + lane * 8) = w;
    }
}

__device__ __forceinline__ int gla_fT(int row) { return ((row >> 1) & 1) | (((row >> 3) & 1) << 1); }
__device__ __forceinline__ int gla_hV(int row) { return (row & 3) | (((row >> 3) & 1) << 2); }
__device__ __forceinline__ void gla2_item(const Params& p, LAS unsigned char* lds, int item) {
    const int tid = opaque_tid(), lane = tid & 63, wid = tid >> 6, fr = lane & 15, g = lane >> 4;
    const int b = item >> 2, h = item & 3;
    const bf16_t* P0 = (const bf16_t*)(p.ws + OFF_P) + 1792;
    const float* xa16 = (const float*)(p.ws + OFF_U);
    bf16_t* mix = (bf16_t*)(p.ws + OFF_BUF64);
    LAS float* bcf = (LAS float*)lds;
    LAS float* tot = bcf + 64 * 64;
    LAS float* bls = tot + 8 * 64;
    LAS float* pn = bls + 64;
    LAS float* xs = pn + 64 * 8;
    LAS unsigned char* qd_i = (LAS unsigned char*)(xs + 2 * 1024);
    LAS unsigned char* ki_a = qd_i + 8192;
    LAS unsigned char* ki_t = ki_a + 8192;
    LAS unsigned char* att_i = ki_t + 8192;
    LAS unsigned char* v_i = att_i + 8192;
    for (int i = tid; i < 8192 / 16; i += 512) *(LAS u32x4*)(att_i + i * 16) = uzero4();
    float gw2[16];
#pragma unroll
    for (int i = 0; i < 16; ++i) gw2[i] = p.in[I_BGW2][i * 256 + h * 64 + lane];
    const float gb = p.in[I_BGB][h * 64 + lane];
    const f32x4 ngv = *(const f32x4*)(p.in[I_BNG] + h * 128 + wid * 16 + g * 4);
    f32x4 Sacc[4];
#pragma unroll
    for (int rt = 0; rt < 4; ++rt) Sacc[rt] = fzero4();
    const int q4 = fr >> 2, p4 = fr & 3;
    const int tok = tid >> 3, dc = tid & 7;
    u32x4 nq, nk, nv0, nv1; u32x2 ngate[4]; f32x4 nxa = fzero4();
#define GLA_ISSUE(c0n) do { const size_t _n = (size_t)b * SEQ + (c0n) + tok; \
        nq = *(const u32x4*)(P0 + _n * NE_MAIN + h * 64 + dc * 8); nk = *(const u32x4*)(P0 + _n * NE_MAIN + 256 + h * 64 + dc * 8); \
        nv0 = *(const u32x4*)(P0 + _n * NE_MAIN + 512 + h * 128 + dc * 16); nv1 = *(const u32x4*)(P0 + _n * NE_MAIN + 512 + h * 128 + dc * 16 + 8); \
        _Pragma("unroll") for (int _ct = 0; _ct < 4; ++_ct) ngate[_ct] = *(const u32x2*)(P0 + ((size_t)b * SEQ + (c0n) + _ct * 16 + fr) * NE_MAIN + 1024 + h * 128 + wid * 16 + g * 4); \
        if (tid < 256) nxa = *(const f32x4*)(xa16 + ((size_t)b * SEQ + (c0n)) * 16 + tid * 4); } while (0)
    GLA_ISSUE(0);
    if (tid < 256) *(LAS f32x4*)(xs + tid * 4) = nxa;
    __syncthreads();
    for (int c0 = 0; c0 < SEQ; c0 += 64) {
        const size_t n0 = (size_t)b * SEQ + c0;
        LAS const float* xsc = xs + ((c0 >> 6) & 1) * 1024;
        { float run = 0.f;
#pragma unroll
            for (int tt = 0; tt < 8; ++tt) { const int c = wid * 8 + tt; float z = gb;
#pragma unroll
                for (int i4 = 0; i4 < 4; ++i4) { const f32x4 xv = *(const LAS f32x4*)(xsc + c * 16 + i4 * 4); z += xv[0] * gw2[i4 * 4] + xv[1] * gw2[i4 * 4 + 1] + xv[2] * gw2[i4 * 4 + 2] + xv[3] * gw2[i4 * 4 + 3]; }
                const float ls = fminf(z, 0.f) - __logf(1.0f + __expf(-fabsf(z)));
                run += ls * (1.0f / 16.0f); bcf[c * 64 + lane] = run; }
            tot[wid * 64 + lane] = run; }
        __syncthreads();
        { float off = 0.f;
            for (int w2 = 0; w2 < wid; ++w2) off += tot[w2 * 64 + lane];
#pragma unroll
            for (int tt = 0; tt < 8; ++tt) bcf[(wid * 8 + tt) * 64 + lane] += off;
            if (wid == 7) bls[lane] = __expf(bcf[63 * 64 + lane]); }
        __syncthreads();
        u32x2 gate[4];
        { const f32x4 bc0 = *(const LAS f32x4*)(bcf + tok * 64 + dc * 8), bc1 = *(const LAS f32x4*)(bcf + tok * 64 + dc * 8 + 4);
            const unsigned qw[4] = {nq.x, nq.y, nq.z, nq.w}, kw[4] = {nk.x, nk.y, nk.z, nk.w};
            float qo[8], ko[8];
#pragma unroll
            for (int j = 0; j < 4; ++j) { const float ba = (j < 2 ? bc0[2 * j] : bc1[2 * j - 4]), bb = (j < 2 ? bc0[2 * j + 1] : bc1[2 * j - 3]);
                const float ea = __expf(ba), eb = __expf(bb), ia = fast_rcp(ea), ib = fast_rcp(eb);
                qo[2 * j] = __uint_as_float(qw[j] << 16) * 0.125f * ea; qo[2 * j + 1] = __uint_as_float(qw[j] & 0xffff0000u) * 0.125f * eb;
                ko[2 * j] = __uint_as_float(kw[j] << 16) * ia; ko[2 * j + 1] = __uint_as_float(kw[j] & 0xffff0000u) * ib; }
            u32x4 qp, kp; qp.x = cvt_pk_bf16(qo[0], qo[1]); qp.y = cvt_pk_bf16(qo[2], qo[3]); qp.z = cvt_pk_bf16(qo[4], qo[5]); qp.w = cvt_pk_bf16(qo[6], qo[7]);
            kp.x = cvt_pk_bf16(ko[0], ko[1]); kp.y = cvt_pk_bf16(ko[2], ko[3]); kp.z = cvt_pk_bf16(ko[4], ko[5]); kp.w = cvt_pk_bf16(ko[6], ko[7]);
            *(LAS u32x4*)(qd_i + tok * 128 + ((dc ^ (tok & 7)) * 16)) = qp;
            *(LAS u32x4*)(ki_a + tok * 128 + ((dc ^ (tok & 7)) * 16)) = kp;
            *(LAS u32x4*)(ki_t + tok * 128 + (((((dc >> 1) ^ gla_fT(tok)) << 1) | (dc & 1)) * 16)) = kp;
            { const int pr = dc ^ gla_hV(tok); *(LAS u32x4*)(v_i + tok * 256 + (pr * 2) * 16) = nv0; *(LAS u32x4*)(v_i + tok * 256 + (pr * 2 + 1) * 16) = nv1; }
#pragma unroll
            for (int ct = 0; ct < 4; ++ct) gate[ct] = ngate[ct]; }
        if (c0 + 64 < SEQ) GLA_ISSUE(c0 + 64);
        __syncthreads();
        for (int ti = wid; ti < 10; ti += 8) {
            int st, ct; { const int tb[10] = {0x00, 0x01, 0x02, 0x03, 0x11, 0x12, 0x13, 0x22, 0x23, 0x33}; int code = 0;
#pragma unroll
                for (int k = 0; k < 10; ++k) if (k == ti) code = tb[k];
                st = code >> 4; ct = code & 15; }
            f32x4 d = fzero4();
            const int rs_ = st * 16 + fr, rc_ = ct * 16 + fr;
#pragma unroll
            for (int s = 0; s < 2; ++s) {
                const bf16x8 a = *(const LAS bf16x8*)(ki_a + rs_ * 128 + (((s * 4 + g) ^ (rs_ & 7)) * 16));
                const bf16x8 bq = *(const LAS bf16x8*)(qd_i + rc_ * 128 + (((s * 4 + g) ^ (rc_ & 7)) * 16));
                d = __builtin_amdgcn_mfma_f32_16x16x32_bf16(a, bq, d, 0, 0, 0); }
            const int c = ct * 16 + fr; float o4[4];
#pragma unroll
            for (int r = 0; r < 4; ++r) { const int s_ = st * 16 + g * 4 + r; o4[r] = (s_ <= c) ? d[r] : 0.f; }
            u32x2 w; w.x = cvt_pk_bf16(o4[0], o4[1]); w.y = cvt_pk_bf16(o4[2], o4[3]);
            *(LAS u32x2*)(att_i + c * 128 + (((2 * st + (g >> 1)) ^ (c & 7)) * 16) + (g & 1) * 8) = w;
        }
        __syncthreads();
        {
            bf16x8 vf[2];
#pragma unroll
            for (int s = 0; s < 2; ++s) {
                const int r1 = s * 32 + g * 8 + q4, r2 = r1 + 4; const int c = 2 * wid + (p4 >> 1);
                const s16x4 lo = __builtin_amdgcn_ds_read_tr16_b64_v4i16((LAS s16x4*)(v_i + r1 * 256 + (((((c >> 1) ^ gla_hV(r1)) << 1) | (c & 1)) * 16) + (p4 & 1) * 8));
                const s16x4 hi = __builtin_amdgcn_ds_read_tr16_b64_v4i16((LAS s16x4*)(v_i + r2 * 256 + (((((c >> 1) ^ gla_hV(r2)) << 1) | (c & 1)) * 16) + (p4 & 1) * 8));
                vf[s] = (bf16x8){lo[0], lo[1], lo[2], lo[3], hi[0], hi[1], hi[2], hi[3]}; }
            bf16x8 sf[2];
#pragma unroll
            for (int s = 0; s < 2; ++s) sf[s] = pack_8g(Sacc[2 * s], Sacc[2 * s + 1]);
            f32x4 oacc[4];
#pragma unroll
            for (int ct = 0; ct < 4; ++ct) {
                const int c = ct * 16 + fr; f32x4 d = fzero4();
#pragma unroll
                for (int s = 0; s < 2; ++s) {
                    const bf16x8 ab = *(const LAS bf16x8*)(att_i + c * 128 + (((s * 4 + g) ^ (c & 7)) * 16));
                    d = __builtin_amdgcn_mfma_f32_16x16x32_bf16(vf[s], ab, d, 0, 0, 0);
                    const s16x4 q0 = *(const LAS s16x4*)(qd_i + c * 128 + (((s * 4 + (g >> 1)) ^ (c & 7)) * 16) + (g & 1) * 8);
                    const s16x4 q1 = *(const LAS s16x4*)(qd_i + c * 128 + (((s * 4 + 2 + (g >> 1)) ^ (c & 7)) * 16) + (g & 1) * 8);
                    const bf16x8 qb = (bf16x8){q0[0], q0[1], q0[2], q0[3], q1[0], q1[1], q1[2], q1[3]};
                    d = __builtin_amdgcn_mfma_f32_16x16x32_bf16(sf[s], qb, d, 0, 0, 0); }
                oacc[ct] = d; }
#pragma unroll
            for (int rt = 0; rt < 4; ++rt) {
#pragma unroll
                for (int s = 0; s < 2; ++s) {
                    const int r1 = s * 32 + g * 8 + q4, r2 = r1 + 4; const int c = 2 * rt + (p4 >> 1);
                    const s16x4 lo = __builtin_amdgcn_ds_read_tr16_b64_v4i16((LAS s16x4*)(ki_t + r1 * 128 + (((((c >> 1) ^ gla_fT(r1)) << 1) | (c & 1)) * 16) + (p4 & 1) * 8));
                    const s16x4 hi = __builtin_amdgcn_ds_read_tr16_b64_v4i16((LAS s16x4*)(ki_t + r2 * 128 + (((((c >> 1) ^ gla_fT(r2)) << 1) | (c & 1)) * 16) + (p4 & 1) * 8));
                    const bf16x8 kf = (bf16x8){lo[0], lo[1], lo[2], lo[3], hi[0], hi[1], hi[2], hi[3]};
                    Sacc[rt] = __builtin_amdgcn_mfma_f32_16x16x32_bf16(kf, vf[s], Sacc[rt], 0, 0, 0); }
                const f32x4 eb = *(const LAS f32x4*)(bls + rt * 16 + g * 4);
                Sacc[rt] = Sacc[rt] * eb; }
#pragma unroll
            for (int ct = 0; ct < 4; ++ct) { float ss = oacc[ct][0] * oacc[ct][0] + oacc[ct][1] * oacc[ct][1] + oacc[ct][2] * oacc[ct][2] + oacc[ct][3] * oacc[ct][3];
                ss += __shfl_xor(ss, 16); ss += __shfl_xor(ss, 32);
                if (g == 0) pn[(ct * 16 + fr) * 8 + wid] = ss; }
            if (tid < 256 && c0 + 64 < SEQ) *(LAS f32x4*)(xs + (((c0 >> 6) + 1) & 1) * 1024 + tid * 4) = nxa;
            __syncthreads();
#pragma unroll
            for (int ct = 0; ct < 4; ++ct) { const int c = ct * 16 + fr;
                const f32x4 a0 = *(const LAS f32x4*)(pn + c * 8), a1 = *(const LAS f32x4*)(pn + c * 8 + 4);
                const float ss = (a0[0] + a0[1]) + (a0[2] + a0[3]) + (a1[0] + a1[1]) + (a1[2] + a1[3]);
                const float rs = rsqrtf(ss * (1.0f / 128.0f) + 1e-5f);
                const u32x2 gv = gate[ct];
                const float g0 = __uint_as_float(gv.x << 16), g1 = __uint_as_float(gv.x & 0xffff0000u), g2 = __uint_as_float(gv.y << 16), g3 = __uint_as_float(gv.y & 0xffff0000u);
                const float v0 = oacc[ct][0] * rs * ngv[0] * (g0 * fast_sigmoid(g0)), v1 = oacc[ct][1] * rs * ngv[1] * (g1 * fast_sigmoid(g1));
                const float v2 = oacc[ct][2] * rs * ngv[2] * (g2 * fast_sigmoid(g2)), v3 = oacc[ct][3] * rs * ngv[3] * (g3 * fast_sigmoid(g3));
                u32x2 w; w.x = cvt_pk_bf16(v0, v1); w.y = cvt_pk_bf16(v2, v3);
                *(u32x2*)(mix + (n0 + c) * DM + 512 + h * 128 + wid * 16 + g * 4) = w; }
        }
    }
#undef GLA_ISSUE
}

__device__ __forceinline__ void phase_mixer_even(const Params& p, LAS unsigned char* lds, int bid, int nb, int which) {
    for (int item = bid; item < 96; item += nb) {
        if (which != 2 && item < 64) rwkv3_item(p, lds, item); else if (which != 1 && item >= 64) gla2_item(p, lds, item - 64);
        __syncthreads();
    }
}

__device__ __forceinline__ void phase_rope(const Params& p, int bid, int nb) {
    const int tid = opaque_tid(), wid = tid >> 6, lane = tid & 63;
    unsigned char* ws = p.ws;
    const bf16_t* Pd = (const bf16_t*)(ws + OFF_PD);
    bf16_t* qr = (bf16_t*)(ws + OFF_BUF64); bf16_t* kr = (bf16_t*)(ws + OFF_KR); bf16_t* vv = (bf16_t*)(ws + OFF_VV);
    bf16_t* iqr = (bf16_t*)(ws + OFF_IQR); bf16_t* ikr = (bf16_t*)(ws + OFF_IKR); float* iw = (float*)(ws + OFF_IW);
    const float* c64 = (const float*)(ws + OFF_ROPE); const float* s64 = c64 + 4096 * 64; const float* c32 = s64 + 4096 * 64; const float* s32 = c32 + 4096 * 32;
    const float ikg = p.in[I_CIKG][lane], ikb = p.in[I_CIKB][lane];
    for (int n = bid * 8 + wid; n < NTOK; n += nb * 8) {
        const int pos = n & (SEQ - 1);
        const bf16_t* row = Pd + (size_t)n * NO_MAIN;
        const float c = c64[pos * 64 + lane], s = s64[pos * 64 + lane];
#pragma unroll
        for (int h = 0; h < 8; ++h) { const float z1 = bf2f(row[h * 128 + lane]), z2 = bf2f(row[h * 128 + 64 + lane]);
            qr[(size_t)n * 1024 + h * 128 + lane] = f2bf((z1 * c - z2 * s) * 0.08838834764831845f);
            qr[(size_t)n * 1024 + h * 128 + 64 + lane] = f2bf((z2 * c + z1 * s) * 0.08838834764831845f); }
        { const float z1 = bf2f(row[1024 + lane]), z2 = bf2f(row[1024 + 64 + lane]);
            kr[(size_t)n * 128 + lane] = f2bf(z1 * c - z2 * s); kr[(size_t)n * 128 + 64 + lane] = f2bf(z2 * c + z1 * s); }
        vv[(size_t)n * 128 + lane] = row[1152 + lane]; vv[(size_t)n * 128 + 64 + lane] = row[1152 + 64 + lane];
        const int j32 = lane & 31; const float cc = c32[pos * 32 + j32], ss = s32[pos * 32 + j32];
#pragma unroll
        for (int r = 0; r < 2; ++r) { const int h = (lane >> 5) + 2 * r; const float z1 = bf2f(row[1280 + h * 64 + j32]), z2 = bf2f(row[1280 + h * 64 + 32 + j32]);
            iqr[(size_t)n * 256 + h * 64 + j32] = f2bf((z1 * cc - z2 * ss) * 0.125f); iqr[(size_t)n * 256 + h * 64 + 32 + j32] = f2bf((z2 * cc + z1 * ss) * 0.125f); }
        { const float x = bf2f(row[1536 + lane]); const float mean = wave_sum(x) * (1.0f / 64.0f); const float d = x - mean; const float var = wave_sum(d * d) * (1.0f / 64.0f);
            const float y = d * rsqrtf(var + LN_EPS) * ikg + ikb; const float o = __shfl_xor(y, 32);
            const float res = lane < 32 ? (y * cc - o * ss) : (y * cc + o * ss);
            ikr[(size_t)n * 64 + lane] = f2bf(res); }
        if (lane < 4) iw[(size_t)n * 4 + lane] = bf2f(row[1600 + lane]) * 0.5f;
    }
}

__device__ __forceinline__ void phase_index(const Params& p, LAS unsigned char* lds, int bid, int nb) {
    const int tid = opaque_tid(), wid = tid >> 6, lane = tid & 63;
    unsigned char* ws = p.ws;
    const bf16_t* iqr = (const bf16_t*)(ws + OFF_IQR); const bf16_t* ikr = (const bf16_t*)(ws + OFF_IKR); const float* iw = (const float*)(ws + OFF_IW);
    unsigned short* idx = (unsigned short*)(ws + OFF_IDX);
    LAS unsigned* sc = (LAS unsigned*)lds + wid * 4096;
    LAS int* hist = (LAS int*)(lds + 131072) + wid * 256;
    LAS float* iqs = (LAS float*)(lds + 131072 + 8192) + wid * 256;
    const unsigned long long lt_mask = (1ull << lane) - 1ull;
    for (int n = bid * 8 + wid; n < NTOK; n += nb * 8) {
        const int t = n & (SEQ - 1), b = n >> 12, nv = t + 1;
        unsigned short* out = idx + (size_t)n * 256;
        if (nv <= 256) { for (int j = lane; j < 256; j += 64) out[j] = (unsigned short)(j < nv ? j : 0); continue; }
#pragma unroll
        for (int j = 0; j < 4; ++j) iqs[lane * 4 + j] = bf2f(iqr[(size_t)n * 256 + lane * 4 + j]);
        const float w0 = iw[(size_t)n * 4 + 0], w1 = iw[(size_t)n * 4 + 1], w2 = iw[(size_t)n * 4 + 2], w3 = iw[(size_t)n * 4 + 3];
        const int nvp = (nv + 63) & ~63;
        for (int c0 = 0; c0 < nvp; c0 += 64) {
            const int key = c0 + lane; const bool valid = key < nv;
            float kf[64];
            const u32x4* kp = (const u32x4*)(ikr + ((size_t)b * SEQ + (valid ? key : 0)) * 64);
#pragma unroll
            for (int q = 0; q < 8; ++q) { const u32x4 w = kp[q];
                kf[q * 8 + 0] = __uint_as_float(w.x << 16); kf[q * 8 + 1] = __uint_as_float(w.x & 0xffff0000u); kf[q * 8 + 2] = __uint_as_float(w.y << 16); kf[q * 8 + 3] = __uint_as_float(w.y & 0xffff0000u);
                kf[q * 8 + 4] = __uint_as_float(w.z << 16); kf[q * 8 + 5] = __uint_as_float(w.z & 0xffff0000u); kf[q * 8 + 6] = __uint_as_float(w.w << 16); kf[q * 8 + 7] = __uint_as_float(w.w & 0xffff0000u); }
            float sh[4];
#pragma unroll
            for (int h = 0; h < 4; ++h) { float a = 0.f;
#pragma unroll
                for (int d4 = 0; d4 < 16; ++d4) { const f32x4 qv = *(const LAS f32x4*)(iqs + h * 64 + d4 * 4); a += qv[0] * kf[d4 * 4] + qv[1] * kf[d4 * 4 + 1] + qv[2] * kf[d4 * 4 + 2] + qv[3] * kf[d4 * 4 + 3]; }
                sh[h] = fmaxf(a, 0.f); }
            float score = sh[0] * w0 + sh[1] * w1 + sh[2] * w2 + sh[3] * w3;
            score += 0.0f;
            unsigned u = __float_as_uint(score); u = (u & 0x80000000u) ? ~u : (u | 0x80000000u);
            sc[key] = valid ? u : 0u;
        }
        unsigned prefix = 0; int need = 256;
#pragma unroll 1
        for (int pass = 3; pass >= 0; --pass) {
            const int shift = pass * 8;
#pragma unroll
            for (int j = 0; j < 4; ++j) hist[lane * 4 + j] = 0;
            for (int c0 = 0; c0 < nvp; c0 += 64) { const unsigned u = sc[c0 + lane];
                const bool match = (c0 + lane < nv) && (pass == 3 || (u >> (shift + 8)) == prefix);
                if (match) __hip_atomic_fetch_add(hist + ((u >> shift) & 255u), 1, __ATOMIC_RELAXED, __HIP_MEMORY_SCOPE_WORKGROUP); }
            int hb[4];
#pragma unroll
            for (int j = 0; j < 4; ++j) hb[j] = hist[lane * 4 + j];
            const int tot = hb[0] + hb[1] + hb[2] + hb[3];
            int suf = tot;
#pragma unroll
            for (int off = 1; off < 64; off <<= 1) { const int v = __shfl_down(suf, off); if (lane + off < 64) suf += v; }
            const int above = suf - tot;
            const bool is = (above < need) && (need <= suf);
            int bin = 0, nneed = 0;
            if (is) { int c = above;
#pragma unroll
                for (int k = 3; k >= 0; --k) { if (nneed == 0) { if (need <= c + hb[k]) { bin = lane * 4 + k; nneed = need - c; } else c += hb[k]; } } }
            const unsigned long long bal = __ballot(is);
            const int src = __ffsll((long long)bal) - 1;
            bin = __shfl(bin, src); nneed = __shfl(nneed, src);
            prefix = (prefix << 8) | (unsigned)bin; need = nneed;
        }
        const unsigned T = prefix;
        int base = 0, ties = 0;
        for (int c0 = 0; c0 < nvp; c0 += 64) { const int key = c0 + lane; const unsigned u = sc[key]; const bool valid = key < nv;
            const bool gt = valid && u > T, eq = valid && u == T;
            const unsigned long long beq = __ballot(eq);
            const int rank = ties + __popcll(beq & lt_mask);
            const bool take = gt || (eq && rank < need);
            const unsigned long long bt = __ballot(take);
            const int pos = base + __popcll(bt & lt_mask);
            if (take && pos < 256) out[pos] = (unsigned short)key;
            base += __popcll(bt); ties += __popcll(beq); }
    }
}

__device__ __forceinline__ void phase_attn(const Params& p, LAS unsigned char* lds, int bid, int nb) {
    const int tid = opaque_tid(), wid = tid >> 6, lane = tid & 63;
    unsigned char* ws = p.ws;
    const bf16_t* qr = (const bf16_t*)(ws + OFF_BUF64); const bf16_t* kr = (const bf16_t*)(ws + OFF_KR); const bf16_t* vv = (const bf16_t*)(ws + OFF_VV);
    const unsigned short* idx = (const unsigned short*)(ws + OFF_IDX);
    bf16_t* ao = (bf16_t*)(ws + OFF_PD);
    LAS float* qs = (LAS float*)lds + wid * 1024;
    LAS float* ps = (LAS float*)(lds + 32768) + wid * 2048;
    LAS int* ks = (LAS int*)(lds + 32768 + 65536) + wid * 256;
    for (int n = bid * 8 + wid; n < NTOK; n += nb * 8) {
        const int t = n & (SEQ - 1), b = n >> 12, cnt = (t + 1) < 256 ? (t + 1) : 256;
        asm volatile("" ::: "memory");
#pragma unroll
        for (int j = 0; j < 16; ++j) qs[j * 64 + lane] = bf2f(qr[(size_t)n * 1024 + j * 64 + lane]);
#pragma unroll
        for (int r = 0; r < 4; ++r) ks[r * 64 + lane] = idx[(size_t)n * 256 + r * 64 + lane];
#pragma unroll 1
        for (int r = 0; r < 4; ++r) {
            const int j = r * 64 + lane; const bool valid = j < cnt; const int key = valid ? ks[j] : 0;
            const u32x4* kp = (const u32x4*)(kr + ((size_t)b * SEQ + key) * 128);
            float kf[128];
#pragma unroll
            for (int q = 0; q < 16; ++q) { const u32x4 w = kp[q];
                kf[q * 8 + 0] = __uint_as_float(w.x << 16); kf[q * 8 + 1] = __uint_as_float(w.x & 0xffff0000u); kf[q * 8 + 2] = __uint_as_float(w.y << 16); kf[q * 8 + 3] = __uint_as_float(w.y & 0xffff0000u);
                kf[q * 8 + 4] = __uint_as_float(w.z << 16); kf[q * 8 + 5] = __uint_as_float(w.z & 0xffff0000u); kf[q * 8 + 6] = __uint_as_float(w.w << 16); kf[q * 8 + 7] = __uint_as_float(w.w & 0xffff0000u); }
#pragma unroll 1
            for (int h = 0; h < 8; ++h) { float a = 0.f;
#pragma unroll
                for (int d4 = 0; d4 < 32; ++d4) { const f32x4 qv = *(const LAS f32x4*)(qs + h * 128 + d4 * 4);
                    a += qv[0] * kf[d4 * 4] + qv[1] * kf[d4 * 4 + 1] + qv[2] * kf[d4 * 4 + 2] + qv[3] * kf[d4 * 4 + 3]; }
                ps[h * 256 + j] = valid ? a : -INFINITY; }
        }
#pragma unroll
        for (int h = 0; h < 8; ++h) { float x[4]; float m = -INFINITY;
#pragma unroll
            for (int r = 0; r < 4; ++r) { x[r] = ps[h * 256 + r * 64 + lane]; m = fmaxf(m, x[r]); }
#pragma unroll
            for (int o = 32; o > 0; o >>= 1) m = fmaxf(m, __shfl_xor(m, o));
            float s = 0.f;
#pragma unroll
            for (int r = 0; r < 4; ++r) { x[r] = expf(x[r] - m); s += x[r]; }
            s = wave_sum(s); const float inv = 1.0f / s;
#pragma unroll
            for (int r = 0; r < 4; ++r) ps[h * 256 + r * 64 + lane] = x[r] * inv; }
        float o0[8], o1[8];
#pragma unroll
        for (int h = 0; h < 8; ++h) { o0[h] = 0.f; o1[h] = 0.f; }
        for (int j = 0; j < cnt; ++j) { const int key = ks[j];
            const unsigned w = *(const unsigned*)(vv + ((size_t)b * SEQ + key) * 128 + 2 * lane);
            const float v0 = __uint_as_float(w << 16), v1 = __uint_as_float(w & 0xffff0000u);
#pragma unroll
            for (int h = 0; h < 8; ++h) { const float pj = ps[h * 256 + j]; o0[h] += pj * v0; o1[h] += pj * v1; } }
#pragma unroll
        for (int h = 0; h < 8; ++h) *(unsigned*)(ao + (size_t)n * 1024 + h * 128 + 2 * lane) = cvt_pk_bf16(o0[h], o1[h]);
    }
}

__device__ __forceinline__ int idx_bin(float s, float lo, float scale) { int b = (int)((s - lo) * scale); b = b < 0 ? 0 : b; return b > 255 ? 255 : b; }
__device__ __forceinline__ void phase_index2(const Params& p, LAS unsigned char* lds, int bid, int nb) {
    const int tid = opaque_tid(), wid = tid >> 6, lane = tid & 63, fr = lane & 15, g = lane >> 4;
    unsigned char* ws = p.ws;
    const bf16_t* iqr = (const bf16_t*)(ws + OFF_IQR); const bf16_t* ikr = (const bf16_t*)(ws + OFF_IKR); const float* iw = (const float*)(ws + OFF_IW);
    unsigned short* idx = (unsigned short*)(ws + OFF_IDX);
    LAS float* sc = (LAS float*)lds;
    LAS int* hist = (LAS int*)(lds + 131072) + wid * 256;
    LAS float* cand = (LAS float*)(lds + 131072 + 8192) + wid * 64;
    const unsigned long long lt_mask = (1ull << lane) - 1ull;
    for (int qt = bid; qt < NTOK / 8; qt += nb) {
        const int n0 = qt * 8, t0 = n0 & (SEQ - 1), b = n0 >> 12;
        asm volatile("" ::: "memory");
        if (t0 + 8 > 256) {
            bf16x8 af[2][2];
#pragma unroll
            for (int hh = 0; hh < 2; ++hh)
#pragma unroll
                for (int s = 0; s < 2; ++s) af[hh][s] = *(const bf16x8*)(iqr + (size_t)(n0 + (fr & 7)) * 256 + (2 * hh + (fr >> 3)) * 64 + s * 32 + g * 8);
            float w0[4], w1[4];
#pragma unroll
            for (int r = 0; r < 4; ++r) { const int q = 4 * (g & 1) + r; w0[r] = iw[(size_t)(n0 + q) * 4 + (g >> 1)]; w1[r] = iw[(size_t)(n0 + q) * 4 + 2 + (g >> 1)]; }
            const int nkt = (t0 + 8 + 15) >> 4;
            const bf16_t* kb = ikr + (size_t)b * SEQ * 64;
            for (int kt = wid; kt < nkt; kt += 8) {
                const bf16_t* kp = kb + (size_t)(kt * 16 + fr) * 64 + g * 8;
                const bf16x8 b0 = *(const bf16x8*)kp, b1 = *(const bf16x8*)(kp + 32);
                f32x4 d0 = fzero4(), d1 = fzero4();
                d0 = __builtin_amdgcn_mfma_f32_16x16x32_bf16(af[0][0], b0, d0, 0, 0, 0); d0 = __builtin_amdgcn_mfma_f32_16x16x32_bf16(af[0][1], b1, d0, 0, 0, 0);
                d1 = __builtin_amdgcn_mfma_f32_16x16x32_bf16(af[1][0], b0, d1, 0, 0, 0); d1 = __builtin_amdgcn_mfma_f32_16x16x32_bf16(af[1][1], b1, d1, 0, 0, 0);
#pragma unroll
                for (int r = 0; r < 4; ++r) { float v = fmaxf(d0[r], 0.f) * w0[r] + fmaxf(d1[r], 0.f) * w1[r]; v += __shfl_xor(v, 32); v += 0.0f;
                    if (g < 2) sc[(4 * g + r) * 4096 + kt * 16 + fr] = v; }
            }
        }
        __syncthreads();
        {
            const int n = n0 + wid, t = t0 + wid, nv = t + 1;
            unsigned short* out = idx + (size_t)n * 256;
            if (nv <= 256) { for (int j = lane; j < 256; j += 64) out[j] = (unsigned short)(j < nv ? j : 0); }
            else {
                LAS const float* srow = sc + wid * 4096;
                const int nvp = (nv + 63) & ~63;
                float lo, hi;
                { float mn = INFINITY, mx = -INFINITY;
                    for (int c0 = 0; c0 < nvp; c0 += 64) { const float s = srow[c0 + lane]; if (c0 + lane < nv) { mn = fminf(mn, s); mx = fmaxf(mx, s); } }
#pragma unroll
                    for (int o = 32; o > 0; o >>= 1) { mn = fminf(mn, __shfl_xor(mn, o)); mx = fmaxf(mx, __shfl_xor(mx, o)); }
                    lo = mn; hi = mx; }
                float lo1 = 0.f, sc1 = 0.f, lo2 = 0.f, sc2 = 0.f, lo3 = 0.f, sc3 = 0.f; int b1 = 0, b2 = 0, b3 = 0, nlev = 0;
                int m = nv, need = 256;
#define IDX_CLASSIFY(s, cls) do { cls = 1; \
                    if (nlev >= 1) { const int bb = idx_bin(s, lo1, sc1); if (bb != b1) cls = bb > b1 ? 2 : 0; } \
                    if (cls == 1 && nlev >= 2) { const int bb = idx_bin(s, lo2, sc2); if (bb != b2) cls = bb > b2 ? 2 : 0; } \
                    if (cls == 1 && nlev >= 3) { const int bb = idx_bin(s, lo3, sc3); if (bb != b3) cls = bb > b3 ? 2 : 0; } } while (0)
#pragma unroll 1
                while (m > 64 && nlev < 3 && (hi - lo) > 1e-30f) {
                    const float width = hi - lo, scale = 256.0f / width;
                    { int z = 0; asm volatile("" : "+v"(z));
#pragma unroll
                    for (int j = 0; j < 4; ++j) hist[lane * 4 + j] = z; }
                    for (int c0 = 0; c0 < nvp; c0 += 64) { const float s = srow[c0 + lane]; int cls; IDX_CLASSIFY(s, cls);
                        if (c0 + lane < nv && cls == 1) __hip_atomic_fetch_add(hist + idx_bin(s, lo, scale), 1, __ATOMIC_RELAXED, __HIP_MEMORY_SCOPE_WORKGROUP); }
                    int hb[4];
#pragma unroll
                    for (int j = 0; j < 4; ++j) hb[j] = hist[lane * 4 + j];
                    const int tot = hb[0] + hb[1] + hb[2] + hb[3];
                    int suf = tot;
#pragma unroll
                    for (int off = 1; off < 64; off <<= 1) { const int v = __shfl_down(suf, off); if (lane + off < 64) suf += v; }
                    const int above = suf - tot;
                    const bool is = (above < need) && (need <= suf);
                    int bin = 0, nneed = 0, mm = 0;
                    if (is) { int c = above;
#pragma unroll
                        for (int k = 3; k >= 0; --k) { if (nneed == 0) { if (need <= c + hb[k]) { bin = lane * 4 + k; nneed = need - c; mm = hb[k]; } else c += hb[k]; } } }
                    const unsigned long long bal = __ballot(is);
                    const int srcl = __ffsll((long long)bal) - 1;
                    bin = __shfl(bin, srcl); nneed = __shfl(nneed, srcl); mm = __shfl(mm, srcl);
                    if (nlev == 0) { lo1 = lo; sc1 = scale; b1 = bin; } else if (nlev == 1) { lo2 = lo; sc2 = scale; b2 = bin; } else { lo3 = lo; sc3 = scale; b3 = bin; }
                    ++nlev; need = nneed; m = mm;
                    const float w = width * (1.0f / 256.0f); lo = lo + (float)bin * w; hi = lo + w;
                }
                float T = -INFINITY; int need_t = need; const bool exact = (m <= 64);
                if (exact) {
                    int base = 0;
                    for (int c0 = 0; c0 < nvp; c0 += 64) { const float s = srow[c0 + lane]; int cls; IDX_CLASSIFY(s, cls);
                        const bool isc = (c0 + lane < nv) && cls == 1; const unsigned long long bc = __ballot(isc);
                        if (isc) { const int pos = base + __popcll(bc & lt_mask); if (pos < 64) cand[pos] = s; }
                        base += __popcll(bc); }
                    const float mine = lane < m ? cand[lane] : -INFINITY;
                    int cgt = 0, cge = 0;
                    for (int j = 0; j < m; ++j) { const float vj = cand[j]; cgt += vj > mine ? 1 : 0; cge += vj >= mine ? 1 : 0; }
                    const bool isT = (lane < m) && (cgt < need) && (need <= cge);
                    const unsigned long long bT = __ballot(isT);
                    const int sl = __ffsll((long long)bT) - 1;
                    T = __shfl(mine, sl); need_t = need - __shfl(cgt, sl);
                }
                int base = 0, ties = 0;
                for (int c0 = 0; c0 < nvp; c0 += 64) { const int key = c0 + lane; const float s = srow[key]; const bool valid = key < nv; int cls; IDX_CLASSIFY(s, cls);
                    const bool sure = valid && (cls == 2 || (cls == 1 && exact && s > T));
                    const bool tie = valid && cls == 1 && (exact ? (s == T) : true);
                    const unsigned long long beq = __ballot(tie);
                    const int rank = ties + __popcll(beq & lt_mask);
                    const bool take = sure || (tie && rank < need_t);
                    const unsigned long long bt = __ballot(take);
                    const int pos = base + __popcll(bt & lt_mask);
                    if (take && pos < 256) out[pos] = (unsigned short)key;
                    base += __popcll(bt); ties += __popcll(beq); }
#undef IDX_CLASSIFY
            }
        }
        __syncthreads();
    }
}

__device__ __forceinline__ void phase_attn2(const Params& p, LAS unsigned char* lds, int bid, int nb) {
    const int tid = opaque_tid(), wid = tid >> 6, lane = tid & 63, fr = lane & 15, g = lane >> 4;
    unsigned char* ws = p.ws;
    const bf16_t* qr = (const bf16_t*)(ws + OFF_BUF64); const bf16_t* kr = (const bf16_t*)(ws + OFF_KR); const bf16_t* vv = (const bf16_t*)(ws + OFF_VV);
    const unsigned short* idx = (const unsigned short*)(ws + OFF_IDX);
    bf16_t* ao = (bf16_t*)(ws + OFF_PD);
    LAS unsigned char* vbuf = lds + wid * 16384;
    LAS unsigned short* ks = (LAS unsigned short*)(lds + 131072) + wid * 256;
    const int q4 = fr >> 2, p4 = fr & 3;
    for (int n = bid * 8 + wid; n < NTOK; n += nb * 8) {
        const int t = n & (SEQ - 1), b = n >> 12, cnt = (t + 1) < 256 ? (t + 1) : 256;
        asm volatile("" ::: "memory");
        *(LAS u32x2*)(ks + lane * 4) = *(const u32x2*)(idx + (size_t)n * 256 + lane * 4);
        bf16x8 qf[4];
#pragma unroll
        for (int s = 0; s < 4; ++s) { qf[s] = (bf16x8){0, 0, 0, 0, 0, 0, 0, 0}; if (fr < 8) qf[s] = *(const bf16x8*)(qr + (size_t)n * 1024 + fr * 128 + s * 32 + g * 8); }
        const bf16_t* kbase = kr + (size_t)b * SEQ * 128; const bf16_t* vbase = vv + (size_t)b * SEQ * 128;
        f32x4 acc[16];
#pragma unroll
        for (int tl = 0; tl < 16; ++tl) {
            const int j = tl * 16 + fr; const int key = j < cnt ? (int)ks[j] : 0;
            const bf16_t* kp = kbase + (size_t)key * 128 + g * 8;
            bf16x8 kf[4];
#pragma unroll
            for (int s = 0; s < 4; ++s) kf[s] = *(const bf16x8*)(kp + s * 32);
            f32x4 a = fzero4();
#pragma unroll
            for (int s = 0; s < 4; ++s) a = __builtin_amdgcn_mfma_f32_16x16x32_bf16(kf[s], qf[s], a, 0, 0, 0);
            acc[tl] = a;
        }
        float m = -INFINITY;
#pragma unroll
        for (int tl = 0; tl < 16; ++tl)
#pragma unroll
            for (int r = 0; r < 4; ++r) { if (tl * 16 + g * 4 + r >= cnt) acc[tl][r] = -INFINITY; m = fmaxf(m, acc[tl][r]); }
        m = fmaxf(m, __shfl_xor(m, 16)); m = fmaxf(m, __shfl_xor(m, 32));
        float sum = 0.f;
#pragma unroll
        for (int tl = 0; tl < 16; ++tl)
#pragma unroll
            for (int r = 0; r < 4; ++r) { const float e = __expf(acc[tl][r] - m); acc[tl][r] = e; sum += e; }
        sum += __shfl_xor(sum, 16); sum += __shfl_xor(sum, 32);
        const float inv = 1.0f / sum;
        bf16x8 pf[8];
#pragma unroll
        for (int s = 0; s < 8; ++s) { u32x4 w; w.x = cvt_pk_bf16(acc[2 * s][0], acc[2 * s][1]); w.y = cvt_pk_bf16(acc[2 * s][2], acc[2 * s][3]);
            w.z = cvt_pk_bf16(acc[2 * s + 1][0], acc[2 * s + 1][1]); w.w = cvt_pk_bf16(acc[2 * s + 1][2], acc[2 * s + 1][3]); pf[s] = __builtin_bit_cast(bf16x8, w); }
        f32x4 o[8];
#pragma unroll
        for (int dt = 0; dt < 8; ++dt) o[dt] = fzero4();
#pragma unroll
        for (int s = 0; s < 8; ++s) {
            LAS unsigned char* vb = vbuf + (s & 1) * 8192;
#pragma unroll
            for (int i = 0; i < 8; ++i) { const int kl = i * 4 + g, cp = fr; const int jj = s * 32 + kl; const int key = jj < cnt ? (int)ks[jj] : 0;
                const int c = cp ^ ((kl & 7) << 1);
                const u32x4 val = *(const u32x4*)(vbase + (size_t)key * 128 + c * 8);
                *(LAS u32x4*)(vb + kl * 256 + cp * 16) = val; }
            const int kl1 = 4 * g + q4, kl2 = 16 + 4 * g + q4;
#pragma unroll
            for (int dt = 0; dt < 8; ++dt) {
                const int c = 2 * dt + (p4 >> 1);
                const s16x4 lo = __builtin_amdgcn_ds_read_tr16_b64_v4i16((LAS s16x4*)(vb + kl1 * 256 + ((c ^ ((kl1 & 7) << 1)) * 16) + (p4 & 1) * 8));
                const s16x4 hi = __builtin_amdgcn_ds_read_tr16_b64_v4i16((LAS s16x4*)(vb + kl2 * 256 + ((c ^ ((kl2 & 7) << 1)) * 16) + (p4 & 1) * 8));
                const bf16x8 af = (bf16x8){lo[0], lo[1], lo[2], lo[3], hi[0], hi[1], hi[2], hi[3]};
                o[dt] = __builtin_amdgcn_mfma_f32_16x16x32_bf16(af, pf[s], o[dt], 0, 0, 0);
            }
        }
        if (fr < 8) {
#pragma unroll
            for (int dt = 0; dt < 8; ++dt) { u32x2 w; w.x = cvt_pk_bf16(o[dt][0] * inv, o[dt][1] * inv); w.y = cvt_pk_bf16(o[dt][2] * inv, o[dt][3] * inv);
                *(u32x2*)(ao + (size_t)n * 1024 + fr * 128 + dt * 16 + g * 4) = w; }
        }
    }
}

__device__ __forceinline__ void phase_inproj_even(const Params& p, LAS unsigned char* lds, int bid, int nb) {
    unsigned char* ws = p.ws;
    pg::DenseSched S; S.init(ws + OFF_BUF64, ws + OFF_WINE, NTOK, NE_MAIN, 1024, nb, bid);
    pg::EpiBf16 E; E.O = (bf16_t*)(ws + OFF_P); E.ldc = NE_MAIN;
    pg::gemm_phase(lds, 1024, S, E);
}
__device__ __forceinline__ void phase_inproj_odd(const Params& p, LAS unsigned char* lds, int bid, int nb) {
    unsigned char* ws = p.ws;
    pg::DenseSched S; S.init(ws + OFF_BUF64, ws + OFF_WINO, NTOK, NO_MAIN, 1024, nb, bid);
    pg::EpiBf16 E; E.O = (bf16_t*)(ws + OFF_PD); E.ldc = NO_MAIN;
    pg::gemm_phase(lds, 1024, S, E);
}
__device__ __forceinline__ void phase_outproj(const Params& p, LAS unsigned char* lds, int bid, int nb, size_t aoff, size_t woff, const float* X) {
    unsigned char* ws = p.ws;
    pg::DenseSched S; S.init(ws + aoff, ws + woff, NTOK, 1024, 1024, nb, bid);
    pg::EpiResid E; E.X = X; E.U = (float*)(ws + OFF_U);
    pg::gemm_phase(lds, 1024, S, E);
}

__device__ __forceinline__ void grid_barrier(unsigned* ctr, unsigned target) {
    asm volatile("s_waitcnt vmcnt(0) lgkmcnt(0)" ::: "memory");
    __syncthreads();
    if (threadIdx.x == 0) {
        __builtin_amdgcn_fence(__ATOMIC_RELEASE, "agent");
        asm volatile("s_waitcnt vmcnt(0)" ::: "memory");
        __hip_atomic_fetch_add(ctr, 1u, __ATOMIC_RELAXED, __HIP_MEMORY_SCOPE_AGENT);
        while (__hip_atomic_load(ctr, __ATOMIC_RELAXED, __HIP_MEMORY_SCOPE_AGENT) < target) __builtin_amdgcn_s_sleep(1);
        __builtin_amdgcn_fence(__ATOMIC_ACQUIRE, "agent");
        asm volatile("s_waitcnt vmcnt(0)" ::: "memory");
    }
    __syncthreads();
}
#ifndef DUP
#define DUP 0
#endif
#define GSYNC() do { bar_target += nb0u; grid_barrier(bar_ctr, bar_target); } while (0)
__global__ __launch_bounds__(512, 2) void mega(KArgs a) {
    extern __shared__ __attribute__((aligned(16))) unsigned char smem[];
    LAS unsigned char* lds = (LAS unsigned char*)smem;
    Params p; p.in.t = (LAS const unsigned long long*)(lds + PTAB_OFF); p.out = a.out; p.ws = a.ws;
    if ((threadIdx.x & 63) == 0) ((LAS int*)(lds + WTAB_OFF))[hw_slot()] = threadIdx.x >> 6;
    if (threadIdx.x == 0) { LAS unsigned long long* tw_ = (LAS unsigned long long*)(lds + PTAB_OFF);
#pragma unroll
        for (int i = 0; i < 30; ++i) tw_[i] = (unsigned long long)a.in[i]; }
    __syncthreads();
    cg::grid_group grid = cg::this_grid();
    const int bid0 = blockIdx.x, nb0 = gridDim.x;
    unsigned* bar_ctr = (unsigned*)(p.ws + OFF_MISC + MISC_BAR); unsigned bar_target = 0; const unsigned nb0u = gridDim.x;
    if (blockIdx.x == 0 && threadIdx.x == 0) __hip_atomic_store(bar_ctr, 0u, __ATOMIC_RELAXED, __HIP_MEMORY_SCOPE_AGENT);
    grid.sync();
    int bid, nb;
#define FRESH() do { bid = bid0; nb = nb0; asm volatile("" : "+s"(bid), "+s"(nb)); } while (0)
#define RUNP(id, call) do { FRESH(); call; GSYNC(); if (DUP == id) { FRESH(); call; GSYNC(); } } while (0)
    RUNP(10, phase_prep(p, lds, bid, nb));
#pragma unroll 1
    for (int layer = 0; layer < 2; ++layer) {
        if (layer == 0) {
            FRESH(); phase_inproj_even(p, lds, bid, nb);
            FRESH(); phase_gla_alpha(p, lds, bid, nb);
            GSYNC();
            if (DUP == 11) { FRESH(); phase_inproj_even(p, lds, bid, nb); GSYNC(); }
            if (DUP == 12) { FRESH(); phase_gla_alpha(p, lds, bid, nb); GSYNC(); }
            RUNP(1, phase_mixer_even(p, lds, bid, nb, 0));
            RUNP(13, phase_rwkv_epi(p, bid, nb));
        } else {
            RUNP(14, phase_inproj_odd(p, lds, bid, nb));
            RUNP(15, phase_rope(p, bid, nb));
            RUNP(2, phase_index2(p, lds, bid, nb));
            RUNP(3, phase_attn2(p, lds, bid, nb));
        }
        RUNP(16, phase_outproj(p, lds, bid, nb, layer ? OFF_PD : OFF_BUF64, layer ? OFF_WOUTO : OFF_WOUTE, layer ? p.out : p.in[I_X]));
        FRESH(); phase_ln_route(p, lds, bid, nb, layer);
        GSYNC();
        RUNP(17, phase_moe_gateup(p, lds, bid, nb, layer));
        RUNP(18, phase_moe_down(p, lds, bid, nb, layer));
        RUNP(19, phase_ln2(p, bid, nb, layer, p.out, true));
    }
}

extern "C" void kernel_launch(void* const* d_in, const int* in_sizes, int n_in, void* d_out, int out_size, void* d_ws, size_t ws_size, hipStream_t stream) {
    if (ws_size < WS_NEED) { fprintf(stderr, "workspace too small: %zu < %zu\n", ws_size, (size_t)WS_NEED); return; }
    KArgs p{};
    for (int i = 0; i < 30; ++i) p.in[i] = (const float*)d_in[i];
    p.out = (float*)d_out; p.ws = (unsigned char*)d_ws;
    static int grid_blocks = 0;
    if (!grid_blocks) {
        (void)hipFuncSetAttribute((const void*)mega, hipFuncAttributeMaxDynamicSharedMemorySize, LDS_BYTES);
        int dev = 0, cus = 0, per_cu = 0;
        (void)hipGetDevice(&dev);
        (void)hipDeviceGetAttribute(&cus, hipDeviceAttributeMultiprocessorCount, dev);
        (void)hipOccupancyMaxActiveBlocksPerMultiprocessor(&per_cu, mega, 512, LDS_BYTES);
        if (per_cu < 1) { fprintf(stderr, "occupancy query returned %d\n", per_cu); per_cu = 1; }
        grid_blocks = cus;
    }
    void* args[] = {&p};
    hipError_t e = hipLaunchCooperativeKernel((void*)mega, dim3(grid_blocks), dim3(512), args, LDS_BYTES, stream);
    if (e != hipSuccess) fprintf(stderr, "cooperative launch failed: %s (grid %d)\n", hipGetErrorString(e), grid_blocks);
}
```

```cpp
#include <hip/hip_runtime.h>
#include <hip/hip_cooperative_groups.h>
#include <cstdio>
#include <cstdint>
namespace cg = cooperative_groups;

#ifndef PROBE_ID
#define PROBE_ID 0
#endif
#ifndef PROBE_BLK
#define PROBE_BLK 7
#endif
#ifndef IDXPROBE
#define IDXPROBE 0
#endif
#ifndef SANITIZE
#define SANITIZE 0
#endif
#ifndef PREP_REP
#define PREP_REP 1
#endif
constexpr int NTOK = 32768, SEQ = 4096, NB = 8, DM = 1024;
constexpr int EVEN_COLS = 3344, ODD_COLS = 1604;
constexpr int NE_MAIN = 3328;
constexpr int NO_MAIN = 1792;
constexpr int NEXP = 16, DEXP = 256;
constexpr float DN_ALPHA = 1.4142135623730951f;
constexpr float LN_EPS = 1e-5f;
constexpr int MOE_ROWS = 65536 + 16 * 256;

typedef unsigned short bf16_t;
typedef short bf16x8 __attribute__((ext_vector_type(8)));
typedef float f32x4 __attribute__((ext_vector_type(4)));
typedef short s16x4 __attribute__((ext_vector_type(4)));
typedef float f32x2 __attribute__((ext_vector_type(2)));
typedef unsigned u32x4 __attribute__((ext_vector_type(4)));
typedef unsigned u32x2 __attribute__((ext_vector_type(2)));
#define LAS __attribute__((address_space(3)))

typedef __bf16 bf16x2_t __attribute__((ext_vector_type(2)));
__device__ __forceinline__ unsigned cvt_pk_bf16(float lo, float hi) { bf16x2_t v; v[0] = (__bf16)lo; v[1] = (__bf16)hi; return __builtin_bit_cast(unsigned, v); }
__device__ __forceinline__ bf16_t f2bf(float f) { return (bf16_t)(cvt_pk_bf16(f, 0.f) & 0xffffu); }
__device__ __forceinline__ float bf2f(bf16_t h) { return __uint_as_float(((unsigned)h) << 16); }
constexpr int LDS_BYTES = 160 * 1024;
constexpr int PTAB_OFF = LDS_BYTES - 256;
constexpr int WTAB_OFF = LDS_BYTES - 512;
__device__ __forceinline__ int hw_slot() { return (int)(__builtin_amdgcn_s_getreg(0x2804) & 63u); }
__device__ __forceinline__ int opaque_tid() {
    extern __shared__ __attribute__((aligned(16))) unsigned char smem_[];
    const int w = __builtin_amdgcn_readfirstlane(((LAS const int*)((LAS unsigned char*)smem_ + WTAB_OFF))[hw_slot()]);
    int l; asm volatile("v_mbcnt_lo_u32_b32 %0, -1, 0\n\tv_mbcnt_hi_u32_b32 %0, -1, %0" : "=v"(l));
    return (w << 6) | l; }
#if PROBE_ID
#define PROBE_DECL unsigned long long probe_acc = 0, probe_t0 = 0
#define PROBE_BEGIN(id) do { if (PROBE_ID == (id)) probe_t0 = __builtin_amdgcn_s_memtime(); } while (0)
#define PROBE_END(id) do { if (PROBE_ID == (id)) probe_acc += __builtin_amdgcn_s_memtime() - probe_t0; } while (0)
#define PROBE_STORE(ws, bid, tid) do { if (PROBE_ID < 30 && (bid) == 7 && (tid) == 0) *(float*)((ws) + OFF_MISC + MISC_PROBE) = (float)probe_acc * 1e-6f; } while (0)
#else
#define PROBE_DECL
#define PROBE_BEGIN(id)
#define PROBE_END(id)
#define PROBE_STORE(ws, bid, tid)
#endif
__device__ __forceinline__ f32x4 fzero4() { float z = 0.f; asm volatile("" : "+v"(z)); return (f32x4){z, z, z, z}; }
__device__ __forceinline__ u32x4 uzero4() { unsigned z = 0u; asm volatile("" : "+v"(z)); return (u32x4){z, z, z, z}; }
__device__ __forceinline__ float fast_rcp(float x) { return __builtin_amdgcn_rcpf(x); }
__device__ __forceinline__ float fast_sigmoid(float x) { return fast_rcp(1.0f + __expf(-x)); }
__device__ __forceinline__ float fast_tanh(float x) { const float e = __expf(2.0f * x); return 1.0f - 2.0f * fast_rcp(1.0f + e); }
__device__ __forceinline__ bf16x8 pack_8g(const f32x4 a, const f32x4 b) { u32x4 w; w.x = cvt_pk_bf16(a[0], a[1]); w.y = cvt_pk_bf16(a[2], a[3]); w.z = cvt_pk_bf16(b[0], b[1]); w.w = cvt_pk_bf16(b[2], b[3]); return __builtin_bit_cast(bf16x8, w); }
template <int CTRL> __device__ __forceinline__ float dppf(float v) { return __builtin_bit_cast(float, __builtin_amdgcn_update_dpp(0, __builtin_bit_cast(int, v), CTRL, 0xf, 0xf, true)); }
__device__ __forceinline__ float wave_sum(float v) {
#pragma unroll
    for (int o = 32; o > 0; o >>= 1) v += __shfl_xor(v, o);
    return v;
}

constexpr size_t MiB = 1024ull * 1024ull;
constexpr size_t OFF_WINE = 0;
constexpr size_t OFF_WOUTE = OFF_WINE + (size_t)NE_MAIN * 1024 * 2;
constexpr size_t OFF_WINO = OFF_WOUTE + 2 * MiB;
constexpr size_t OFF_WOUTO = OFF_WINO + (size_t)NO_MAIN * 1024 * 2;
constexpr size_t OFF_WGU = OFF_WOUTO + 2 * MiB;
constexpr size_t OFF_WD = OFF_WGU + 32 * MiB;
constexpr size_t OFF_ROPE = OFF_WD + 16 * MiB;
constexpr size_t OFF_MISC = OFF_ROPE + 3 * MiB;
constexpr size_t OFF_BUF64 = OFF_MISC + 4 * MiB;
constexpr size_t OFF_P = OFF_BUF64 + 64 * MiB;
constexpr size_t OFF_U = OFF_P + 208 * MiB;
constexpr size_t WS_NEED = OFF_U + 128 * MiB;
constexpr size_t OFF_HE = OFF_P;
constexpr size_t OFF_ACT = OFF_HE + (size_t)MOE_ROWS * 1024 * 2;
constexpr size_t OFF_PD = OFF_P;
constexpr size_t OFF_KR = OFF_P + 112 * MiB;
constexpr size_t OFF_VV = OFF_KR + 8 * MiB;
constexpr size_t OFF_IQR = OFF_VV + 8 * MiB;
constexpr size_t OFF_IKR = OFF_IQR + 16 * MiB;
constexpr size_t OFF_IW = OFF_IKR + 4 * MiB;
constexpr size_t OFF_IDX = OFF_IW + 1 * MiB;
constexpr size_t MISC_CNT = 0;
constexpr size_t MISC_TOKINFO = 4096;
constexpr size_t MISC_TOKGATE = MISC_TOKINFO + (size_t)NTOK * 16;
constexpr size_t MISC_LIST = MISC_TOKGATE + (size_t)NTOK * 8;
constexpr size_t MISC_BAR = 2048;
constexpr size_t MISC_PROBE = 2304;
constexpr size_t MISC_W2T = 3 * MiB;
constexpr size_t MISC_A2T = MISC_W2T + 65536;
constexpr size_t MISC_G2T = MISC_A2T + 65536;

struct InTab { LAS const unsigned long long* t;
    __device__ __forceinline__ const float* operator[](int i) const { const unsigned long long v = t[i];
        const unsigned lo = __builtin_amdgcn_readfirstlane((unsigned)v), hi = __builtin_amdgcn_readfirstlane((unsigned)(v >> 32));
        return (const float*)(((unsigned long long)hi << 32) | lo); } };
struct Params { InTab in; float* out; unsigned char* ws; };
struct KArgs { const float* in[30]; float* out; unsigned char* ws; };
enum { I_X = 0, I_WINE, I_AMU, I_AW0, I_AW2, I_AA0, I_AA2, I_AG2, I_AKK, I_AKA, I_ARK, I_AGNG, I_AGNB, I_BGW2, I_BGB, I_BNG, I_WOUTE,
       I_WINO, I_CIKG, I_CIKB, I_WOUTO, I_LN1G, I_LN1B, I_LN2G, I_LN2B, I_RW, I_RB, I_EG, I_EU, I_ED };

namespace pg {
constexpr int BM = 256, BK = 64, HALF = 128, HTB = HALF * BK * 2, STAGE_BYTES = 8 * HTB;
__host__ __device__ __forceinline__ int lds_byte(int r, int c) { const int st = (r >> 4) * 2 + (c >> 5), rr = r & 15, cc = c & 31, ob = rr * 64 + cc * 2; return st * 1024 + (ob ^ (((ob >> 9) & 1) << 5)); }
__host__ __device__ __forceinline__ void stage_rc(int b, int& R, int& C) { const int st = b / 1024, sb = b % 1024, swz = sb ^ (((sb >> 9) & 1) << 5); R = (st >> 1) * 16 + swz / 64; C = (st & 1) * 32 + (swz % 64) / 2; }
__host__ __device__ __forceinline__ int perm32(int rho) { const int n = rho >> 4, i = rho & 15; return 8 * (i >> 2) + 4 * n + (i & 3); }

struct Unit { int pm, pn, e, rt, cnt; };

template <class Epi, class Sched>
__device__ __forceinline__ void gemm_phase(LAS unsigned char* lds, const int K, const Sched& S, const Epi& E) {
    const int tid = opaque_tid(), wid = __builtin_amdgcn_readfirstlane(tid >> 6), lane = tid & 63, wr = wid >> 2, wc = wid & 3, fr = lane & 15, fq = lane >> 4;
    const int nt = K / BK;
    unsigned voffB[2];
#pragma unroll
    for (int i = 0; i < 2; ++i) { int R, C; stage_rc(tid * 16 + i * 8192, R, C); const int Rb = Epi::PERM ? ((R & ~31) + perm32(R & 31)) : R; voffB[i] = (unsigned)(Rb * K + C) * 2u; }
    const size_t kstep = (size_t)(BK * 2);
    const size_t hstepB = (size_t)HALF * K * 2;
    const unsigned ldsw = (unsigned)wid * 1024u;
    const int aoff = lds_byte(wr * 64 + fr, fq * 8), boff = lds_byte(wc * 32 + fr, fq * 8);
#define PG_SA(b, h) (((b) * 2 + (h)) * HTB)
#define PG_SB(b, h) ((4 + (b) * 2 + (h)) * HTB)
#define PG_STAGE(bufoff, gbase, voff) do { _Pragma("unroll") for (int _i = 0; _i < 2; ++_i) \
        __builtin_amdgcn_global_load_lds((const unsigned*)((const char*)(gbase) + (voff)[_i]), (LAS unsigned*)(lds + (bufoff) + ldsw + _i * 8192), 16, 0, 0); } while (0)
#define PG_LDA(dst, b, h) do { _Pragma("unroll") for (int m = 0; m < 4; ++m) _Pragma("unroll") for (int k = 0; k < 2; ++k) dst[m][k] = *(const LAS bf16x8*)(lds + PG_SA(b, h) + aoff + m * 2048 + k * 1024); } while (0)
#define PG_LDB(dst, b, h) do { _Pragma("unroll") for (int n = 0; n < 2; ++n) _Pragma("unroll") for (int k = 0; k < 2; ++k) dst[n][k] = *(const LAS bf16x8*)(lds + PG_SB(b, h) + boff + n * 2048 + k * 1024); } while (0)
#define PG_MMA(ai, bj, At, Bt) do { __builtin_amdgcn_s_setprio(1); _Pragma("unroll") for (int m = 0; m < 4; ++m) _Pragma("unroll") for (int n = 0; n < 2; ++n) _Pragma("unroll") for (int k = 0; k < 2; ++k) \
        acc[ai][bj][m][n] = __builtin_amdgcn_mfma_f32_16x16x32_bf16(Bt[n][k], At[m][k], acc[ai][bj][m][n], 0, 0, 0); __builtin_amdgcn_s_setprio(0); } while (0)
#define PG_WAIT_V(n) asm volatile("s_waitcnt vmcnt(" #n ")" ::: "memory")
#define PG_WAIT_L(n) asm volatile("s_waitcnt lgkmcnt(" #n ")" ::: "memory")
#define PG_BAR __builtin_amdgcn_s_barrier()
#define PG_SCHED __builtin_amdgcn_sched_barrier(0)
#define PG_AOFF(dst0, dst1, u) do { _Pragma("unroll") for (int _i = 0; _i < 2; ++_i) { int _R, _C; stage_rc(tid * 16 + _i * 8192, _R, _C); \
        dst0[_i] = S.a_rowoff(u, 0, _R) + (unsigned)_C * 2u; dst1[_i] = S.a_rowoff(u, 1, _R) + (unsigned)_C * 2u; } } while (0)
    Unit cur, nxt; int ui = 0;
    if (!S.next(0, cur)) return;
    f32x4 acc[2][2][4][2];
#pragma unroll
    for (int a = 0; a < 2; ++a)
#pragma unroll
        for (int b = 0; b < 2; ++b)
#pragma unroll
            for (int m = 0; m < 4; ++m)
#pragma unroll
                for (int n = 0; n < 2; ++n) acc[a][b][m][n] = (f32x4){0.f, 0.f, 0.f, 0.f};
    bf16x8 At[4][2], B0[2][2], B1[2][2];
    const char* const Ab = S.a_base();
    unsigned aC0[2], aC1[2];
    PG_AOFF(aC0, aC1, cur);
    const char* cB = S.b_ptr(cur);
    PG_STAGE(PG_SB(0, 0), cB, voffB); PG_STAGE(PG_SA(0, 0), Ab, aC0); PG_STAGE(PG_SB(0, 1), cB + hstepB, voffB); PG_STAGE(PG_SA(0, 1), Ab, aC1);
    if (wr == 1) PG_BAR;
    PG_WAIT_V(4); PG_BAR;
    PG_STAGE(PG_SB(1, 0), cB + kstep, voffB); PG_STAGE(PG_SA(1, 0), Ab + kstep, aC0); PG_STAGE(PG_SB(1, 1), cB + hstepB + kstep, voffB);
    PG_WAIT_V(6); PG_BAR;
    for (;;) {
        const bool has_next = S.next(ui + 1, nxt);
        const char* nB = has_next ? S.b_ptr(nxt) : cB;
#pragma unroll 1
        for (int t = 0; t < nt; t += 2) {
            const bool last = (t == nt - 2);
            const char* a1 = Ab + (size_t)(t + 1) * kstep;
            const char* a2 = last ? Ab : Ab + (size_t)(t + 2) * kstep; const char* b2 = last ? nB : cB + (size_t)(t + 2) * kstep;
            const char* a3 = a2 + kstep; const char* b3 = b2 + kstep;
            PG_LDB(B0, 0, 0); PG_SCHED; PG_LDA(At, 0, 0); PG_STAGE(PG_SA(1, 1), a1, aC1);
            if (last && has_next) PG_AOFF(aC0, aC1, nxt);
            PG_WAIT_L(8); PG_BAR; PG_WAIT_L(0); PG_MMA(0, 0, At, B0); PG_BAR; PG_SCHED;
            PG_LDB(B1, 0, 1); PG_STAGE(PG_SB(0, 0), b2, voffB);
            PG_BAR; PG_WAIT_L(0); PG_MMA(0, 1, At, B1); PG_BAR;
            PG_LDA(At, 0, 1); PG_STAGE(PG_SA(0, 0), a2, aC0);
            PG_BAR; PG_WAIT_L(0); PG_MMA(1, 0, At, B0); PG_BAR; PG_SCHED;
            PG_STAGE(PG_SB(0, 1), b2 + hstepB, voffB);
            PG_WAIT_V(6); PG_BAR; PG_MMA(1, 1, At, B1); PG_BAR;
            PG_LDB(B0, 1, 0); PG_SCHED; PG_LDA(At, 1, 0); PG_STAGE(PG_SA(0, 1), a2, aC1);
            PG_WAIT_L(8); PG_BAR; PG_WAIT_L(0); PG_MMA(0, 0, At, B0); PG_BAR; PG_SCHED;
            PG_LDB(B1, 1, 1); PG_STAGE(PG_SB(1, 0), b3, voffB);
            PG_BAR; PG_WAIT_L(0); PG_MMA(0, 1, At, B1); PG_BAR;
            PG_LDA(At, 1, 1); PG_STAGE(PG_SA(1, 0), a3, aC0);
            PG_BAR; PG_WAIT_L(0); PG_MMA(1, 0, At, B0); PG_BAR; PG_SCHED;
            PG_STAGE(PG_SB(1, 1), b3 + hstepB, voffB);
            PG_WAIT_V(6); PG_BAR; PG_MMA(1, 1, At, B1); PG_BAR;
        }
        E(acc, cur, wr, wc, fr, fq);
        if (!has_next) break;
#pragma unroll
        for (int a = 0; a < 2; ++a)
#pragma unroll
            for (int b = 0; b < 2; ++b)
#pragma unroll
                for (int m = 0; m < 4; ++m)
#pragma unroll
                    for (int n = 0; n < 2; ++n) acc[a][b][m][n] = (f32x4){0.f, 0.f, 0.f, 0.f};
        cur = nxt; cB = nB; ++ui;
    }
    PG_WAIT_V(0);
    if (wr == 0) PG_BAR;
    PG_BAR;
#undef PG_SA
#undef PG_SB
#undef PG_STAGE
#undef PG_LDA
#undef PG_LDB
#undef PG_MMA
#undef PG_WAIT_V
#undef PG_WAIT_L
#undef PG_BAR
#undef PG_SCHED
#undef PG_AOFF
}

struct DenseSched {
    const char* A; const char* Bt; int K, nM, nN, nwg, G, c;
    __device__ void init(const void* A_, const void* Bt_, int M, int N, int K_, int G_, int c_) { A = (const char*)A_; Bt = (const char*)Bt_; K = K_; nM = M / BM; nN = N / BM; nwg = nM * nN; G = G_; c = c_; }
    __device__ __forceinline__ bool next(int i, Unit& u) const {
        const long L = (long)i * G + c; if (L >= nwg) return false;
        int wgid = (int)L; { const int q = nwg / 8, r = nwg % 8, xcd = wgid % 8, off = wgid / 8; wgid = (xcd < r ? xcd * (q + 1) : r * (q + 1) + (xcd - r) * q) + off; }
        const int nig = 8 * nN, gid = wgid / nig, fm = gid * 8, gsz = (nM - fm) < 8 ? (nM - fm) : 8;
        u.pm = fm + ((wgid % nig) % gsz); u.pn = (wgid % nig) / gsz; u.e = 0; u.rt = 0; u.cnt = 0; return true;
    }
    __device__ __forceinline__ const char* a_base() const { return A; }
    __device__ __forceinline__ unsigned a_rowoff(const Unit& u, int half, int R) const { return (unsigned)(u.pm * BM + half * HALF + R) * (unsigned)(K * 2); }
    __device__ __forceinline__ const char* b_ptr(const Unit& u) const { return Bt + (size_t)u.pn * BM * K * 2; }
};

__device__ __forceinline__ void moe_build_units(LAS int* tab, const int* cntp, int NCT, int G, int c) {
    const int i = opaque_tid();
    if (i < 16) {
        const int L = i * G + c; int accu = 0, rtb = 0, found = 0, pm = 0, pn = 0, ee = 0, rt = 0, cn = 0;
        for (int e = 0; e < 16; ++e) { const int ce = cntp[e], nte = (ce + 255) >> 8, ue = nte * NCT;
            if (!found && L < accu + ue) { const int local = L - accu; ee = e; rt = local / NCT; pn = local % NCT; pm = rtb + rt; cn = ce; found = 1; }
            accu += ue; rtb += nte; }
        tab[i * 8 + 0] = found; tab[i * 8 + 1] = pm; tab[i * 8 + 2] = pn; tab[i * 8 + 3] = ee; tab[i * 8 + 4] = rt; tab[i * 8 + 5] = cn;
    }
    __syncthreads();
}
template <bool GATHER>
struct MoeSched {
    const char* A; const char* Bt; const int* list; int K; size_t wstride; LAS int* tab;
    __device__ void init(const void* A_, const void* Bt_, size_t wstride_bytes, const int* list_, int K_, LAS int* tab_) {
        A = (const char*)A_; Bt = (const char*)Bt_; wstride = wstride_bytes; list = list_; K = K_; tab = tab_; }
    __device__ __forceinline__ bool next(int i, Unit& u) const {
        if (i >= 16) return false;
        const int f = __builtin_amdgcn_readfirstlane(tab[i * 8 + 0]);
        u.pm = __builtin_amdgcn_readfirstlane(tab[i * 8 + 1]); u.pn = __builtin_amdgcn_readfirstlane(tab[i * 8 + 2]); u.e = __builtin_amdgcn_readfirstlane(tab[i * 8 + 3]);
        u.rt = __builtin_amdgcn_readfirstlane(tab[i * 8 + 4]); u.cnt = __builtin_amdgcn_readfirstlane(tab[i * 8 + 5]);
        return f != 0;
    }
    __device__ __forceinline__ const char* a_base() const { return A; }
    __device__ __forceinline__ unsigned a_rowoff(const Unit& u, int half, int R) const {
        if (GATHER) { const int slot = u.rt * BM + half * HALF + R; const int tok = slot < u.cnt ? list[u.e * NTOK + slot] : 0; return (unsigned)tok * (unsigned)(K * 2); }
        return (unsigned)(u.pm * BM + half * HALF + R) * (unsigned)(K * 2);
    }
    __device__ __forceinline__ const char* b_ptr(const Unit& u) const { return Bt + (size_t)u.e * wstride + (size_t)u.pn * BM * K * 2; }
};

struct EpiBf16 {
    static constexpr bool PERM = true;
    bf16_t* O; int ldc;
    __device__ __forceinline__ void operator()(const f32x4 (&acc)[2][2][4][2], const Unit& u, int wr, int wc, int fr, int fq) const {
        const int row0 = u.pm * BM + wr * 64 + fr, col0 = u.pn * BM + wc * 32 + 8 * fq;
#pragma unroll
        for (int ai = 0; ai < 2; ++ai)
#pragma unroll
            for (int m = 0; m < 4; ++m) { bf16_t* rowp = O + (size_t)(row0 + ai * HALF + m * 16) * ldc + col0;
#pragma unroll
                for (int bj = 0; bj < 2; ++bj) { const f32x4 v0 = acc[ai][bj][m][0], v1 = acc[ai][bj][m][1];
                    u32x4 w; w.x = cvt_pk_bf16(v0[0], v0[1]); w.y = cvt_pk_bf16(v0[2], v0[3]); w.z = cvt_pk_bf16(v1[0], v1[1]); w.w = cvt_pk_bf16(v1[2], v1[3]);
                    *(u32x4*)(rowp + bj * HALF) = w; } }
    }
};
struct EpiResid {
    static constexpr bool PERM = false;
    const float* X; float* U;
    __device__ __forceinline__ void operator()(const f32x4 (&acc)[2][2][4][2], const Unit& u, int wr, int wc, int fr, int fq) const {
        const int row0 = u.pm * BM + wr * 64 + fr, col0 = u.pn * BM + wc * 32 + 4 * fq;
#pragma unroll
        for (int ai = 0; ai < 2; ++ai)
#pragma unroll
            for (int m = 0; m < 4; ++m) { const size_t off = (size_t)(row0 + ai * HALF + m * 16) * DM + col0;
#pragma unroll
                for (int bj = 0; bj < 2; ++bj)
#pragma unroll
                    for (int n = 0; n < 2; ++n) { const f32x4 xv = *(const f32x4*)(X + off + bj * HALF + n * 16);
                        *(f32x4*)(U + off + bj * HALF + n * 16) = xv * DN_ALPHA + acc[ai][bj][m][n]; } }
    }
};
struct EpiSwiglu {
    static constexpr bool PERM = true;
    bf16_t* O;
    __device__ __forceinline__ void operator()(const f32x4 (&acc)[2][2][4][2], const Unit& u, int wr, int wc, int fr, int fq) const {
        const int row0 = u.pm * BM + wr * 64 + fr, col0 = u.pn * HALF + wc * 32 + 8 * fq;
#pragma unroll
        for (int ai = 0; ai < 2; ++ai)
#pragma unroll
            for (int m = 0; m < 4; ++m) { bf16_t* rowp = O + (size_t)(row0 + ai * HALF + m * 16) * DEXP + col0;
                float r[8];
#pragma unroll
                for (int n = 0; n < 2; ++n)
#pragma unroll
                    for (int j = 0; j < 4; ++j) { const float g = acc[ai][0][m][n][j], up = acc[ai][1][m][n][j]; r[n * 4 + j] = g / (1.0f + __expf(-g)) * up; }
                u32x4 w; w.x = cvt_pk_bf16(r[0], r[1]); w.y = cvt_pk_bf16(r[2], r[3]); w.z = cvt_pk_bf16(r[4], r[5]); w.w = cvt_pk_bf16(r[6], r[7]);
                *(u32x4*)rowp = w; }
    }
};
}

__device__ __forceinline__ void tr_tile(LAS float* tile  , const float* src, int ld, int k0, int c0, int ncols_valid, bf16_t* dst, int dstK, int drow0, int tid) {
    {
        const int r = tid >> 3, cc = (tid & 7) * 8;
        const float* sp = src + (size_t)(k0 + r) * ld + c0 + cc;
#pragma unroll
        for (int j = 0; j < 8; ++j) tile[r * 65 + cc + j] = (c0 + cc + j < ncols_valid) ? sp[j] : 0.f;
    }
    __syncthreads();
    {
        const int n = tid >> 3, kk = (tid & 7) * 8;
        u32x4 w;
        w.x = cvt_pk_bf16(tile[(kk + 0) * 65 + n], tile[(kk + 1) * 65 + n]); w.y = cvt_pk_bf16(tile[(kk + 2) * 65 + n], tile[(kk + 3) * 65 + n]);
        w.z = cvt_pk_bf16(tile[(kk + 4) * 65 + n], tile[(kk + 5) * 65 + n]); w.w = cvt_pk_bf16(tile[(kk + 6) * 65 + n], tile[(kk + 7) * 65 + n]);
        *(u32x4*)(dst + (size_t)(drow0 + n) * dstK + k0 + kk) = w;
    }
    __syncthreads();
}

__device__ __forceinline__ void phase_prep(const Params& p, LAS unsigned char* lds, int bid, int nb) {
    const int tid = opaque_tid();
    LAS float* tile = (LAS float*)lds;
    unsigned char* ws = p.ws;
    const int T0 = 832, T1 = T0 + 256, T2 = T1 + 448, T3 = T2 + 256, T4 = T3 + 2048, T5 = T4 + 2048, T6 = T5 + 2048, T7 = T6 + 32;
    for (int t = bid; t < T7; t += nb) {
        if (t >= T6) { const int q = t - T6;
            if (q < 8) tr_tile(tile, p.in[I_AW2], 512, 0, q * 64, 512, (bf16_t*)(ws + OFF_MISC + MISC_W2T), 64, q * 64, tid);
            else if (q < 16) tr_tile(tile, p.in[I_AA2], 512, 0, (q - 8) * 64, 512, (bf16_t*)(ws + OFF_MISC + MISC_A2T), 64, (q - 8) * 64, tid);
            else { const int r = q - 16; tr_tile(tile, p.in[I_AG2], 512, (r >> 3) * 64, (r & 7) * 64, 512, (bf16_t*)(ws + OFF_MISC + MISC_G2T), 128, (r & 7) * 64, tid); }
            continue; }
        if (t < T0) { const int kt = t / 52, ct = t % 52; tr_tile(tile, p.in[I_WINE], EVEN_COLS, kt * 64, ct * 64, EVEN_COLS, (bf16_t*)(ws + OFF_WINE), 1024, ct * 64, tid); }
        else if (t < T1) { const int q = t - T0, kt = q / 16, ct = q % 16; tr_tile(tile, p.in[I_WOUTE], 1024, kt * 64, ct * 64, 1024, (bf16_t*)(ws + OFF_WOUTE), 1024, ct * 64, tid); }
        else if (t < T2) { const int q = t - T1, kt = q / 28, ct = q % 28; tr_tile(tile, p.in[I_WINO], ODD_COLS, kt * 64, ct * 64, ODD_COLS, (bf16_t*)(ws + OFF_WINO), 1024, ct * 64, tid); }
        else if (t < T3) { const int q = t - T2, kt = q / 16, ct = q % 16; tr_tile(tile, p.in[I_WOUTO], 1024, kt * 64, ct * 64, 1024, (bf16_t*)(ws + OFF_WOUTO), 1024, ct * 64, tid); }
        else if (t < T5) { const bool up = t >= T4; const int q = t - (up ? T4 : T3), le = q / 64, r = q % 64, kt = r / 4, ct = r % 4;
            const int c0 = ct * 64, drow0 = (c0 / 128) * 256 + (up ? 128 : 0) + (c0 % 128);
            tr_tile(tile, p.in[up ? I_EU : I_EG] + (size_t)le * 1024 * 256, 256, kt * 64, c0, 256, (bf16_t*)(ws + OFF_WGU) + (size_t)le * 512 * 1024, 1024, drow0, tid); }
        else { const int q = t - T5, le = q / 64, r = q % 64, kt = r / 16, ct = r % 16;
            tr_tile(tile, p.in[I_ED] + (size_t)le * 256 * 1024, 1024, kt * 64, ct * 64, 1024, (bf16_t*)(ws + OFF_WD) + (size_t)le * 1024 * 256, 256, ct * 64, tid); }
    }
    {
        const float* x = p.in[I_X]; bf16_t* xb = (bf16_t*)(ws + OFF_BUF64);
        const size_t n8 = (size_t)NTOK * DM / 8;
        for (size_t i = (size_t)bid * 512 + tid; i < n8; i += (size_t)nb * 512) {
            const f32x4 a = *(const f32x4*)(x + i * 8), b = *(const f32x4*)(x + i * 8 + 4);
            u32x4 w; w.x = cvt_pk_bf16(a[0], a[1]); w.y = cvt_pk_bf16(a[2], a[3]); w.z = cvt_pk_bf16(b[0], b[1]); w.w = cvt_pk_bf16(b[2], b[3]);
            *(u32x4*)(xb + i * 8) = w;
        }
    }
    {
        float* c64 = (float*)(ws + OFF_ROPE); float* s64 = c64 + 4096 * 64; float* c32 = s64 + 4096 * 64; float* s32 = c32 + 4096 * 32;
        for (int i = bid * 512 + tid; i < 4096 * 64; i += nb * 512) { const int pos = i >> 6, j = i & 63; const float inv = powf(10000.0f, -(float)j / 64.0f); const float ang = (float)pos * inv; c64[i] = cosf(ang); s64[i] = sinf(ang); }
        for (int i = bid * 512 + tid; i < 4096 * 32; i += nb * 512) { const int pos = i >> 5, j = i & 31; const float inv = powf(10000.0f, -(float)j / 32.0f); const float ang = (float)pos * inv; c32[i] = cosf(ang); s32[i] = sinf(ang); }
    }
    if (bid == 0 && tid < 64) ((int*)(ws + OFF_MISC + MISC_CNT))[tid] = 0;
}

__device__ __forceinline__ float reduce16_wave(const float (&v)[16], int lane) {
    float a8[8];
#pragma unroll
    for (int i = 0; i < 8; ++i) { const float mine = (lane & 32) ? v[8 + i] : v[i], other = (lane & 32) ? v[i] : v[8 + i]; a8[i] = mine + __shfl_xor(other, 32); }
    float a4[4];
#pragma unroll
    for (int i = 0; i < 4; ++i) { const float mine = (lane & 16) ? a8[4 + i] : a8[i], other = (lane & 16) ? a8[i] : a8[4 + i]; a4[i] = mine + __shfl_xor(other, 16); }
    float a2[2];
#pragma unroll
    for (int i = 0; i < 2; ++i) { const float mine = (lane & 8) ? a4[2 + i] : a4[i], other = (lane & 8) ? a4[i] : a4[2 + i]; a2[i] = mine + __shfl_xor(other, 8); }
    float a1; { const float mine = (lane & 4) ? a2[1] : a2[0], other = (lane & 4) ? a2[0] : a2[1]; a1 = mine + __shfl_xor(other, 4); }
    a1 += dppf<0x4E>(a1); a1 += dppf<0xB1>(a1);
    return a1;
}
__device__ __forceinline__ void phase_ln_route(const Params& p, LAS unsigned char* lds, int bid, int nb, int layer) {
    const int tid = opaque_tid(), wid = tid >> 6, lane = tid & 63;
    unsigned char* ws = p.ws;
    LAS float* rwT = (LAS float*)lds;
    LAS int* sel = (LAS int*)(lds + 65536);
    LAS float* selg = (LAS float*)(lds + 65536 + 1024);
    LAS int* cntw = (LAS int*)(lds + 65536 + 2048);
    { const float* rw = p.in[I_RW];
        for (int i = tid; i < 16 * 1024; i += 512) { const int e = i >> 10, k = i & 1023; rwT[i] = rw[k * 16 + e]; } }
    __syncthreads();
    float* U = (float*)(ws + OFF_U); bf16_t* hb = (bf16_t*)(ws + OFF_BUF64);
    const float* g = p.in[I_LN1G] + layer * DM; const float* b = p.in[I_LN1B] + layer * DM;
    int* cnt = (int*)(ws + OFF_MISC + MISC_CNT) + layer * 16;
    int* tokinfo = (int*)(ws + OFF_MISC + MISC_TOKINFO); float* tokgate = (float*)(ws + OFF_MISC + MISC_TOKGATE); int* list = (int*)(ws + OFF_MISC + MISC_LIST);
    f32x4 gv[4], bv[4];
#pragma unroll
    for (int j = 0; j < 4; ++j) { gv[j] = *(const f32x4*)(g + j * 256 + lane * 4); bv[j] = *(const f32x4*)(b + j * 256 + lane * 4); }
    const float* rbp = p.in[I_RB];
    const float my_rb = rbp[((lane >> 5) & 1) * 8 + ((lane >> 4) & 1) * 4 + ((lane >> 3) & 1) * 2 + ((lane >> 2) & 1)];
    for (int blk = bid; blk < NTOK / 128; blk += nb) {
#pragma unroll 1
        for (int i = 0; i < 16; ++i) {
            const int tl = wid * 16 + i, tok = blk * 128 + tl;
            f32x4 v[4]; float s = 0.f;
            asm volatile("" ::: "memory");
#pragma unroll
            for (int j = 0; j < 4; ++j) { v[j] = *(const f32x4*)(U + (size_t)tok * DM + j * 256 + lane * 4); s += (v[j][0] + v[j][1]) + (v[j][2] + v[j][3]); }
            const float mean = wave_sum(s) * (1.0f / DM);
            float q = 0.f;
#pragma unroll
            for (int j = 0; j < 4; ++j) { v[j] -= mean; q += (v[j][0] * v[j][0] + v[j][1] * v[j][1]) + (v[j][2] * v[j][2] + v[j][3] * v[j][3]); }
            const float rstd = rsqrtf(wave_sum(q) * (1.0f / DM) + LN_EPS);
#pragma unroll
            for (int j = 0; j < 4; ++j) { v[j] = v[j] * rstd * gv[j] + bv[j];
                *(f32x4*)(U + (size_t)tok * DM + j * 256 + lane * 4) = v[j];
                u32x2 w; w.x = cvt_pk_bf16(v[j][0], v[j][1]); w.y = cvt_pk_bf16(v[j][2], v[j][3]);
                *(u32x2*)(hb + (size_t)tok * DM + j * 256 + lane * 4) = w; }
            float part[16];
#pragma unroll
            for (int e = 0; e < 16; ++e) { float a = 0.f;
#pragma unroll
                for (int j = 0; j < 4; ++j) { const f32x4 w = *(const LAS f32x4*)(rwT + e * 1024 + j * 256 + lane * 4); a += (v[j][0] * w[0] + v[j][1] * w[1]) + (v[j][2] * w[2] + v[j][3] * w[3]); }
                part[e] = a; }
            const float lgm = reduce16_wave(part, lane);
            const float sgm = 1.0f / (1.0f + expf(-lgm)), selm = sgm + my_rb;
            float sg[16], sl[16];
#pragma unroll
            for (int e = 0; e < 16; ++e) { const int L = ((e >> 3) & 1) * 32 + ((e >> 2) & 1) * 16 + ((e >> 1) & 1) * 8 + (e & 1) * 4;
                sg[e] = __builtin_bit_cast(float, __builtin_amdgcn_readlane(__builtin_bit_cast(int, sgm), L)); sl[e] = __builtin_bit_cast(float, __builtin_amdgcn_readlane(__builtin_bit_cast(int, selm), L)); }
            int best = 0; float bestv = -INFINITY;
#pragma unroll
            for (int gI = 0; gI < 4; ++gI) { float m1 = -INFINITY, m2 = -INFINITY;
#pragma unroll
                for (int j = 0; j < 4; ++j) { const float x = sl[gI * 4 + j]; if (x > m1) { m2 = m1; m1 = x; } else if (x > m2) m2 = x; }
                const float gs = m1 + m2; if (gs > bestv) { bestv = gs; best = gI; } }
            int e0 = 0, e1 = 0; float v0 = -INFINITY, v1 = -INFINITY, s0 = 0.f, s1 = 0.f;
#pragma unroll
            for (int e = 0; e < 16; ++e) { if ((e >> 2) == best) { const float x = sl[e];
                    if (x > v0) { v1 = v0; e1 = e0; s1 = s0; v0 = x; e0 = e; s0 = sg[e]; } else if (x > v1) { v1 = x; e1 = e; s1 = sg[e]; } } }
            const float gsum = s0 + s1;
            if (lane == 0) { sel[tl * 2] = e0; sel[tl * 2 + 1] = e1; selg[tl * 2] = s0 / gsum; selg[tl * 2 + 1] = s1 / gsum; }
        }
        __syncthreads();
        int myE = -1, myRank = 0;
        if (tid < 256) { myE = sel[tid];
#pragma unroll
            for (int e = 0; e < 16; ++e) { const unsigned long long mk = __ballot(myE == e); if (myE == e) myRank = __popcll(mk & ((1ull << lane) - 1ull)); if (lane == 0) cntw[wid * 16 + e] = __popcll(mk); } }
        __syncthreads();
        if (tid < 16) { const int c0 = cntw[tid], c1 = cntw[16 + tid], c2 = cntw[32 + tid], c3 = cntw[48 + tid];
            const int basev = atomicAdd(cnt + tid, c0 + c1 + c2 + c3);
            cntw[64 + tid] = basev; cntw[80 + tid] = basev + c0; cntw[96 + tid] = basev + c0 + c1; cntw[112 + tid] = basev + c0 + c1 + c2; }
        __syncthreads();
        if (tid < 256) { const int slot = cntw[64 + wid * 16 + myE] + myRank; const int tok = blk * 128 + (tid >> 1), k = tid & 1;
            list[myE * NTOK + slot] = tok; tokinfo[tok * 4 + k * 2] = myE; tokinfo[tok * 4 + k * 2 + 1] = slot; tokgate[tok * 2 + k] = selg[tid]; }
        __syncthreads();
    }
}

__device__ __forceinline__ void phase_ln2(const Params& p, int bid, int nb, int layer, float* dst, bool with_moe) {
    const int tid = opaque_tid(), wid = tid >> 6, lane = tid & 63;
    unsigned char* ws = p.ws;
    const float* U = (const float*)(ws + OFF_U); bf16_t* xb = (bf16_t*)(ws + OFF_BUF64);
    const bf16_t* he = (const bf16_t*)(ws + OFF_HE);
    const float* g = p.in[I_LN2G] + layer * DM; const float* b = p.in[I_LN2B] + layer * DM;
    const int* cnt = (const int*)(ws + OFF_MISC + MISC_CNT) + layer * 16;
    const int* tokinfo = (const int*)(ws + OFF_MISC + MISC_TOKINFO); const float* tokgate = (const float*)(ws + OFF_MISC + MISC_TOKGATE);
    int rowbase[16]; { int a = 0;
#pragma unroll
        for (int e = 0; e < 16; ++e) { rowbase[e] = a; a += ((cnt[e] + 255) >> 8) << 8; } }
    f32x4 gv[4], bv[4];
#pragma unroll
    for (int j = 0; j < 4; ++j) { gv[j] = *(const f32x4*)(g + j * 256 + lane * 4); bv[j] = *(const f32x4*)(b + j * 256 + lane * 4); }
    for (int tok = bid * 8 + wid; tok < NTOK; tok += nb * 8) {
        f32x4 v[4]; float s = 0.f;
        int r0 = 0, r1 = 0; float g0 = 0.f, g1 = 0.f;
        if (with_moe) { const int e0 = tokinfo[tok * 4 + 0], sl0 = tokinfo[tok * 4 + 1], e1 = tokinfo[tok * 4 + 2], sl1 = tokinfo[tok * 4 + 3];
            int rb0 = 0, rb1 = 0;
#pragma unroll
            for (int e = 0; e < 16; ++e) { if (e == e0) rb0 = rowbase[e]; if (e == e1) rb1 = rowbase[e]; }
            r0 = rb0 + sl0; r1 = rb1 + sl1; g0 = tokgate[tok * 2 + 0]; g1 = tokgate[tok * 2 + 1]; }
#pragma unroll
        for (int j = 0; j < 4; ++j) { v[j] = *(const f32x4*)(U + (size_t)tok * DM + j * 256 + lane * 4) * DN_ALPHA;
            if (with_moe) { const u32x2 a = *(const u32x2*)(he + (size_t)r0 * DM + j * 256 + lane * 4), c = *(const u32x2*)(he + (size_t)r1 * DM + j * 256 + lane * 4);
                v[j][0] += g0 * __uint_as_float(a.x << 16) + g1 * __uint_as_float(c.x << 16); v[j][1] += g0 * __uint_as_float(a.x & 0xffff0000u) + g1 * __uint_as_float(c.x & 0xffff0000u);
                v[j][2] += g0 * __uint_as_float(a.y << 16) + g1 * __uint_as_float(c.y << 16); v[j][3] += g0 * __uint_as_float(a.y & 0xffff0000u) + g1 * __uint_as_float(c.y & 0xffff0000u); }
            s += (v[j][0] + v[j][1]) + (v[j][2] + v[j][3]); }
        const float mean = wave_sum(s) * (1.0f / DM);
        float q = 0.f;
#pragma unroll
        for (int j = 0; j < 4; ++j) { v[j] -= mean; q += (v[j][0] * v[j][0] + v[j][1] * v[j][1]) + (v[j][2] * v[j][2] + v[j][3] * v[j][3]); }
        const float rstd = rsqrtf(wave_sum(q) * (1.0f / DM) + LN_EPS);
#pragma unroll
        for (int j = 0; j < 4; ++j) { v[j] = v[j] * rstd * gv[j] + bv[j];
#if PROBE_ID
            if (layer == 1) v[j] = v[j] * (1.0f + *(const float*)(ws + OFF_MISC + MISC_PROBE));
#endif
            *(f32x4*)(dst + (size_t)tok * DM + j * 256 + lane * 4) = v[j];
            u32x2 w; w.x = cvt_pk_bf16(v[j][0], v[j][1]); w.y = cvt_pk_bf16(v[j][2], v[j][3]);
            *(u32x2*)(xb + (size_t)tok * DM + j * 256 + lane * 4) = w; }
    }
}

__device__ __forceinline__ void phase_resid_only(const Params& p, const float* X, int bid, int nb) {
    float* U = (float*)(p.ws + OFF_U);
    const size_t n4 = (size_t)NTOK * DM / 4;
    for (size_t i = (size_t)bid * 512 + threadIdx.x; i < n4; i += (size_t)nb * 512) *(f32x4*)(U + i * 4) = *(const f32x4*)(X + i * 4) * DN_ALPHA;
}

__device__ __forceinline__ void phase_moe_gateup(const Params& p, LAS unsigned char* lds, int bid, int nb, int layer) {
    unsigned char* ws = p.ws;
    LAS int* tab = (LAS int*)(lds + pg::STAGE_BYTES);
    pg::moe_build_units(tab, (const int*)(ws + OFF_MISC + MISC_CNT) + layer * 16, 2, nb, bid);
    pg::MoeSched<true> S; S.init(ws + OFF_BUF64, ws + OFF_WGU + (size_t)layer * 16 * 512 * 1024 * 2, (size_t)512 * 1024 * 2, (const int*)(ws + OFF_MISC + MISC_LIST), 1024, tab);
    pg::EpiSwiglu E; E.O = (bf16_t*)(ws + OFF_ACT);
    pg::gemm_phase(lds, 1024, S, E);
}
__device__ __forceinline__ void phase_moe_down(const Params& p, LAS unsigned char* lds, int bid, int nb, int layer) {
    unsigned char* ws = p.ws;
    LAS int* tab = (LAS int*)(lds + pg::STAGE_BYTES);
    pg::moe_build_units(tab, (const int*)(ws + OFF_MISC + MISC_CNT) + layer * 16, 4, nb, bid);
    pg::MoeSched<false> S; S.init(ws + OFF_ACT, ws + OFF_WD + (size_t)layer * 16 * 1024 * 256 * 2, (size_t)1024 * 256 * 2, nullptr, 256, tab);
    pg::EpiBf16 E; E.O = (bf16_t*)(ws + OFF_HE); E.ldc = 1024;
    pg::gemm_phase(lds, 256, S, E);
}

__device__ __forceinline__ void phase_gla_alpha(const Params& p, LAS unsigned char* lds, int bid, int nb) {
    const int tid = opaque_tid(), wid = tid >> 6, lane = tid & 63;
    LAS float* wT = (LAS float*)lds;
    for (int i = tid; i < 16 * 1024; i += 512) { const int e = i & 15, k = i >> 4; wT[e * 1024 + k] = p.in[I_WINE][(size_t)k * EVEN_COLS + NE_MAIN + e]; }
    __syncthreads();
    const float* x = p.in[I_X]; float* xa = (float*)(p.ws + OFF_U);
    for (int tok = bid * 8 + wid; tok < NTOK; tok += nb * 8) {
        f32x4 v[4];
        asm volatile("" ::: "memory");
#pragma unroll
        for (int j = 0; j < 4; ++j) v[j] = *(const f32x4*)(x + (size_t)tok * DM + j * 256 + lane * 4);
        float mine = 0.f;
#pragma unroll
        for (int e = 0; e < 16; ++e) { float a = 0.f;
#pragma unroll
            for (int j = 0; j < 4; ++j) { const f32x4 w = *(const LAS f32x4*)(wT + e * 1024 + j * 256 + lane * 4); a += (v[j][0] * w[0] + v[j][1] * w[1]) + (v[j][2] * w[2] + v[j][3] * w[3]); }
            a = wave_sum(a); if (lane == e) mine = a; }
        if (lane < 16) xa[(size_t)tok * 16 + lane] = mine;
    }
    __syncthreads();
}

__device__ __forceinline__ float red8(float v) { v += dppf<0xB1>(v); v += dppf<0x4E>(v); v += dppf<0x141>(v); return v; }

__device__ __forceinline__ void rwkv_item(const Params& p, LAS unsigned char* lds, int item) {
    constexpr int TC = 16;
    const int tid = opaque_tid(), lane = tid & 63, tg = tid >> 6;
    const int b = item >> 3, h = item & 7;
    const bf16_t* P0 = (const bf16_t*)(p.ws + OFF_P);
    bf16_t* mix = (bf16_t*)(p.ws + OFF_BUF64);
    LAS float* w2s = (LAS float*)lds;
    LAS float* a2s = w2s + 64 * 64;
    LAS float* g2s = a2s + 64 * 64;
    LAS float* tw = g2s + 128 * 64;
    LAS float* xa_s = tw + TC * 64;
    LAS float* sg = xa_s + TC * 64;
    LAS float* r_s = sg + TC * 128;
    LAS float* k_s = r_s + TC * 64;
    LAS float* v_s = k_s + TC * 64;
    LAS float* w_s = v_s + TC * 64;
    LAS float* kk_s = w_s + TC * 64;
    LAS float* kka_s = kk_s + TC * 64;
    LAS float* kh_s = kka_s + TC * 64;
    LAS float* g_s = kh_s + TC * 64;
    LAS float* y_s = g_s + TC * 64;
    LAS float* rk_s = y_s + TC * 64;
    const float* mu = p.in[I_AMU];
    for (int i = tid; i < 64 * 64; i += 512) { const int r = i >> 6, c = i & 63; w2s[i] = p.in[I_AW2][r * 512 + h * 64 + c]; a2s[i] = p.in[I_AA2][r * 512 + h * 64 + c]; }
    for (int i = tid; i < 128 * 64; i += 512) { const int r = i >> 6, c = i & 63; g2s[i] = p.in[I_AG2][r * 512 + h * 64 + c]; }
    const int j = lane;
    const float w0 = p.in[I_AW0][h * 64 + j], a0 = p.in[I_AA0][h * 64 + j], kksc = p.in[I_AKK][h * 64 + j], kasc = p.in[I_AKA][h * 64 + j], rkj = p.in[I_ARK][h * 64 + j];
    const float gng = p.in[I_AGNG][h * 64 + j], gnb = p.in[I_AGNB][h * 64 + j];
    float S[8];
#pragma unroll
    for (int i = 0; i < 8; ++i) S[i] = 0.f;
    const int row = tid >> 3, kq = tid & 7;
    __syncthreads();
    for (int t0 = 0; t0 < SEQ; t0 += TC) {
        for (int idx = tid; idx < TC * 448; idx += 512) {
            const int t = idx / 448, c = idx % 448; int col; LAS float* dst; int kind = 0;
            if (c < 64) { col = h * 64 + c; dst = r_s + t * 64 + c; }
            else if (c < 128) { col = 512 + h * 64 + (c - 64); dst = k_s + t * 64 + (c - 64); }
            else if (c < 192) { col = 1024 + h * 64 + (c - 128); dst = v_s + t * 64 + (c - 128); }
            else if (c < 256) { col = 1536 + (c - 192); dst = tw + t * 64 + (c - 192); kind = 1; }
            else if (c < 320) { col = 1600 + (c - 256); dst = xa_s + t * 64 + (c - 256); }
            else { col = 1664 + (c - 320); dst = sg + t * 128 + (c - 320); kind = 2; }
            const size_t n = (size_t)b * SEQ + t0 + t;
            const float cur = bf2f(P0[n * NE_MAIN + col]);
            const float prev = (t0 + t) > 0 ? bf2f(P0[(n - 1) * NE_MAIN + col]) : 0.f;
            float val = cur + (prev - cur) * mu[col];
            if (kind == 1) val = tanhf(val); else if (kind == 2) val = 1.0f / (1.0f + expf(-val));
            *dst = val;
        }
        __syncthreads();
#pragma unroll
        for (int tt = 0; tt < 2; ++tt) {
            const int t = tg + tt * 8;
            float aw = 0.f, aa = 0.f, ag = 0.f;
            asm volatile("" ::: "memory");
#pragma unroll 4
            for (int i = 0; i < 64; ++i) { aw += tw[t * 64 + i] * w2s[i * 64 + j]; aa += xa_s[t * 64 + i] * a2s[i * 64 + j]; }
            asm volatile("" ::: "memory");
#pragma unroll 4
            for (int i = 0; i < 128; ++i) ag += sg[t * 128 + i] * g2s[i * 64 + j];
            asm volatile("" ::: "memory");
            const float z = w0 + aw;
            const float sp = (-z > 20.f) ? -z : log1pf(expf(-z));
            const float wlog = -sp - 0.5f;
            const float decay = expf(-expf(wlog));
            const float a = 1.0f / (1.0f + expf(-(a0 + aa)));
            const float kraw = k_s[t * 64 + j];
            const float kkp = kraw * kksc;
            const float nrm = sqrtf(wave_sum(kkp * kkp));
            const float kk = kkp / fmaxf(nrm, 1e-12f);
            const float kh = kraw * (1.0f + (a - 1.0f) * kasc);
            const float rr = r_s[t * 64 + j];
            const float rk = wave_sum(rr * kh * rkj);
            w_s[t * 64 + j] = decay; kk_s[t * 64 + j] = kk; kka_s[t * 64 + j] = kk * a; kh_s[t * 64 + j] = kh; g_s[t * 64 + j] = ag;
            if (j == 0) rk_s[t] = rk;
        }
        __syncthreads();
        for (int t = 0; t < TC; ++t) {
            const f32x4 kk0 = *(const LAS f32x4*)(kk_s + t * 64 + kq * 8), kk1 = *(const LAS f32x4*)(kk_s + t * 64 + kq * 8 + 4);
            const f32x4 ww0 = *(const LAS f32x4*)(w_s + t * 64 + kq * 8), ww1 = *(const LAS f32x4*)(w_s + t * 64 + kq * 8 + 4);
            const f32x4 ka0 = *(const LAS f32x4*)(kka_s + t * 64 + kq * 8), ka1 = *(const LAS f32x4*)(kka_s + t * 64 + kq * 8 + 4);
            const f32x4 kh0 = *(const LAS f32x4*)(kh_s + t * 64 + kq * 8), kh1 = *(const LAS f32x4*)(kh_s + t * 64 + kq * 8 + 4);
            const f32x4 rr0 = *(const LAS f32x4*)(r_s + t * 64 + kq * 8), rr1 = *(const LAS f32x4*)(r_s + t * 64 + kq * 8 + 4);
            const float vv = v_s[t * 64 + row];
            float sa = 0.f;
#pragma unroll
            for (int i = 0; i < 4; ++i) { sa += S[i] * kk0[i]; sa += S[4 + i] * kk1[i]; }
            sa = red8(sa);
            float y = 0.f;
#pragma unroll
            for (int i = 0; i < 4; ++i) {
                S[i] = S[i] * ww0[i] - sa * ka0[i] + vv * kh0[i]; S[4 + i] = S[4 + i] * ww1[i] - sa * ka1[i] + vv * kh1[i];
                y += S[i] * rr0[i]; y += S[4 + i] * rr1[i]; }
            y = red8(y);
            if (kq == 0) y_s[t * 64 + row] = y;
        }
        __syncthreads();
#pragma unroll
        for (int tt = 0; tt < 2; ++tt) {
            const int t = tg + tt * 8;
            const float y = y_s[t * 64 + j];
            const float mean = wave_sum(y) * (1.0f / 64.0f);
            const float d = y - mean;
            const float var = wave_sum(d * d) * (1.0f / 64.0f);
            const float yn = d * rsqrtf(var + 64e-5f) * gng + gnb;
            const float o = (yn + rk_s[t] * v_s[t * 64 + j]) * g_s[t * 64 + j];
            mix[((size_t)b * SEQ + t0 + t) * DM + h * 64 + j] = f2bf(o);
        }
        __syncthreads();
    }
}

__device__ __forceinline__ void gla_item(const Params& p, LAS unsigned char* lds, int item) {
    const int tid = opaque_tid(), lane = tid & 63, tg = tid >> 6;
    const int b = item >> 2, h = item & 3;
    const bf16_t* P0 = (const bf16_t*)(p.ws + OFF_P) + 1792;
    const float* xa16 = (const float*)(p.ws + OFF_U);
    bf16_t* mix = (bf16_t*)(p.ws + OFF_BUF64);
    LAS float* qd = (LAS float*)lds;
    LAS float* ki = qd + 64 * 65;
    LAS float* att = ki + 64 * 65;
    LAS float* vs = att + 64 * 65;
    LAS float* St = vs + 64 * 128;
    LAS float* bl = St + 64 * 128;
    for (int i = tid; i < 64 * 128; i += 512) St[i] = 0.f;
    float gw2[16];
#pragma unroll
    for (int i = 0; i < 16; ++i) gw2[i] = p.in[I_BGW2][i * 256 + h * 64 + lane];
    const float gb = p.in[I_BGB][h * 64 + lane];
    const float* bng = p.in[I_BNG];
    __syncthreads();
    for (int c0 = 0; c0 < SEQ; c0 += 64) {
        const size_t n0 = (size_t)b * SEQ + c0;
        for (int tt = 0; tt < 8; ++tt) { const int c = tg * 8 + tt; float z = gb;
#pragma unroll
            for (int i = 0; i < 16; ++i) z += xa16[(n0 + c) * 16 + i] * gw2[i];
            const float ls = (z >= 0.f) ? -log1pf(expf(-z)) : (z - log1pf(expf(z)));
            att[c * 65 + lane] = ls * (1.0f / 16.0f); }
        for (int i = tid; i < 64 * 128; i += 512) { const int c = i >> 7, e = i & 127; vs[i] = bf2f(P0[(n0 + c) * NE_MAIN + 512 + h * 128 + e]); }
        __syncthreads();
        if (tid < 64) { float a = 0.f; for (int c = 0; c < 64; ++c) { a += att[c * 65 + tid]; att[c * 65 + tid] = a; } bl[tid] = a; }
        __syncthreads();
        for (int i = tid; i < 64 * 64; i += 512) { const int c = i >> 6, d = i & 63; const float bc = att[c * 65 + d];
            const float q = bf2f(P0[(n0 + c) * NE_MAIN + h * 64 + d]), k = bf2f(P0[(n0 + c) * NE_MAIN + 256 + h * 64 + d]);
            qd[c * 65 + d] = q * 0.125f * expf(bc); ki[c * 65 + d] = k * expf(-bc); }
        __syncthreads();
        { const int c = tid >> 3, sgp = tid & 7; float a[8];
#pragma unroll
            for (int i = 0; i < 8; ++i) a[i] = 0.f;
            for (int d = 0; d < 64; ++d) { const float qv = qd[c * 65 + d];
#pragma unroll
                for (int i = 0; i < 8; ++i) a[i] += qv * ki[(sgp * 8 + i) * 65 + d]; }
            __syncthreads();
#pragma unroll
            for (int i = 0; i < 8; ++i) att[c * 65 + sgp * 8 + i] = (sgp * 8 + i <= c) ? a[i] : 0.f; }
        __syncthreads();
        { const int c = tid >> 3, eg = tid & 7; float o[16];
#pragma unroll
            for (int i = 0; i < 16; ++i) o[i] = 0.f;
            for (int s = 0; s <= c; ++s) { const float a = att[c * 65 + s];
#pragma unroll
                for (int i = 0; i < 16; ++i) o[i] += a * vs[s * 128 + eg * 16 + i]; }
            for (int d = 0; d < 64; ++d) { const float qv = qd[c * 65 + d];
#pragma unroll
                for (int i = 0; i < 16; ++i) o[i] += qv * St[d * 128 + eg * 16 + i]; }
            float ss = 0.f;
#pragma unroll
            for (int i = 0; i < 16; ++i) ss += o[i] * o[i];
            ss = red8(ss);
            const float rs = rsqrtf(ss * (1.0f / 128.0f) + 1e-5f);
#pragma unroll
            for (int i = 0; i < 16; ++i) { const int e = eg * 16 + i; const float g = bf2f(P0[(n0 + c) * NE_MAIN + 1024 + h * 128 + e]);
                const float val = o[i] * rs * bng[h * 128 + e] * (g / (1.0f + expf(-g)));
                mix[(n0 + c) * DM + 512 + h * 128 + e] = f2bf(val); } }
        __syncthreads();
        { const int d = tid >> 3, eg = tid & 7; float a[16];
#pragma unroll
            for (int i = 0; i < 16; ++i) a[i] = St[d * 128 + eg * 16 + i];
            for (int c = 0; c < 64; ++c) { const float kv = ki[c * 65 + d];
#pragma unroll
                for (int i = 0; i < 16; ++i) a[i] += kv * vs[c * 128 + eg * 16 + i]; }
            const float eb = expf(bl[d]);
#pragma unroll
            for (int i = 0; i < 16; ++i) St[d * 128 + eg * 16 + i] = a[i] * eb; }
        __syncthreads();
    }
}

__device__ __forceinline__ float red16(float v) { v += dppf<0xB1>(v); v += dppf<0x4E>(v); v += dppf<0x141>(v); v += dppf<0x140>(v); return v; }
__device__ __forceinline__ void rwkv2_item(const Params& p, LAS unsigned char* lds, int item) {
    constexpr int TC = 32;
    const int tid = opaque_tid(), lane = tid & 63, wid = tid >> 6, fr = lane & 15, g = lane >> 4;
    const int b = item >> 4, h = (item >> 1) & 7, rq = item & 1;
    unsigned char* ws = p.ws;
    const bf16_t* P0 = (const bf16_t*)(ws + OFF_P);
    float* yraw = p.out;
    bf16_t* e1g = (bf16_t*)(p.out + (size_t)NTOK * 512);
    bf16_t* gg = e1g + (size_t)NTOK * 512;
    LAS float* kk_s = (LAS float*)lds;
    LAS float* w_s = kk_s + TC * 64;
    LAS float* b_s = w_s + TC * 64;
    LAS float* kh_s = b_s + TC * 64;
    LAS float* wr_s = kh_s + TC * 64;
    LAS float* wpre = wr_s + TC * 64;
    LAS float* apre = wpre + TC * 64;
    LAS float* gpre = apre + TC * 64;
    LAS float* v_s = gpre + TC * 32;
    LAS float* y_s = v_s + TC * 32;
    LAS float* sc_s = y_s + TC * 32;
    LAS unsigned char* tw_i = (LAS unsigned char*)(sc_s + TC * 2);
    LAS unsigned char* xa_i = tw_i + TC * 128;
    LAS unsigned char* sg_i = xa_i + TC * 128;
    const float* mu = p.in[I_AMU];
    const bf16_t* w2t = (const bf16_t*)(ws + OFF_MISC + MISC_W2T); const bf16_t* a2t = (const bf16_t*)(ws + OFF_MISC + MISC_A2T); const bf16_t* g2t = (const bf16_t*)(ws + OFF_MISC + MISC_G2T);
    const int mrt = wid >> 2, mct = wid & 3;
    bf16x8 wf[2], af[2], gf[4];
#pragma unroll
    for (int s = 0; s < 2; ++s) { wf[s] = *(const bf16x8*)(w2t + (size_t)(h * 64 + mct * 16 + fr) * 64 + s * 32 + g * 8); af[s] = *(const bf16x8*)(a2t + (size_t)(h * 64 + mct * 16 + fr) * 64 + s * 32 + g * 8); }
    const int grt = (wid >> 1) & 1, gct = wid & 1;
#pragma unroll
    for (int s = 0; s < 4; ++s) gf[s] = *(const bf16x8*)(g2t + (size_t)(h * 64 + rq * 32 + gct * 16 + fr) * 128 + s * 32 + g * 8);
    const int et = tid >> 4, ec = tid & 15;
    const f32x4 w0v = *(const f32x4*)(p.in[I_AW0] + h * 64 + ec * 4), a0v = *(const f32x4*)(p.in[I_AA0] + h * 64 + ec * 4);
    const f32x4 kksc = *(const f32x4*)(p.in[I_AKK] + h * 64 + ec * 4), kasc = *(const f32x4*)(p.in[I_AKA] + h * 64 + ec * 4), rkv = *(const f32x4*)(p.in[I_ARK] + h * 64 + ec * 4);
    const f32x4 mur = *(const f32x4*)(mu + h * 64 + ec * 4), muk = *(const f32x4*)(mu + 512 + h * 64 + ec * 4);
    const f32x2 muv = *(const f32x2*)(mu + 1024 + h * 64 + rq * 32 + ec * 2);
    const int p1tok0 = tid >> 5, p1cc = tid & 31, p1col = 1536 + p1cc * 8;
    const f32x4 p1m0 = *(const f32x4*)(mu + p1col), p1m1 = *(const f32x4*)(mu + p1col + 4);
    float S[4] = {0.f, 0.f, 0.f, 0.f};
    const int rl = wid * 4 + g, kq = fr;
    const size_t nb0 = (size_t)b * SEQ;
    u32x4 l_cu[2], l_pv[2]; u32x2 l_rc, l_kc, l_rp, l_kp; unsigned l_vc, l_vp;
#define RW_ISSUE(t0n) do { \
        _Pragma("unroll") for (int _i = 0; _i < 2; ++_i) { const size_t _n = nb0 + (t0n) + p1tok0 + _i * 16; \
            l_cu[_i] = *(const u32x4*)(P0 + _n * NE_MAIN + p1col); l_pv[_i] = uzero4(); \
            if ((t0n) + p1tok0 + _i * 16 > 0) l_pv[_i] = *(const u32x4*)(P0 + (_n - 1) * NE_MAIN + p1col); } \
        { const size_t _n = nb0 + (t0n) + et; const bool _hp = ((t0n) + et) > 0; \
            l_rc = *(const u32x2*)(P0 + _n * NE_MAIN + h * 64 + ec * 4); l_kc = *(const u32x2*)(P0 + _n * NE_MAIN + 512 + h * 64 + ec * 4); \
            l_vc = *(const unsigned*)(P0 + _n * NE_MAIN + 1024 + h * 64 + rq * 32 + ec * 2); \
            l_rp = (u32x2){0u, 0u}; l_kp = (u32x2){0u, 0u}; l_vp = 0u; \
            if (_hp) { l_rp = *(const u32x2*)(P0 + (_n - 1) * NE_MAIN + h * 64 + ec * 4); l_kp = *(const u32x2*)(P0 + (_n - 1) * NE_MAIN + 512 + h * 64 + ec * 4); \
                l_vp = *(const unsigned*)(P0 + (_n - 1) * NE_MAIN + 1024 + h * 64 + rq * 32 + ec * 2); } } } while (0)
#define MIX2(wc, wp, mA, mB, o0, o1) { const float c0 = __uint_as_float((wc) << 16), c1 = __uint_as_float((wc) & 0xffff0000u), q0 = __uint_as_float((wp) << 16), q1 = __uint_as_float((wp) & 0xffff0000u); o0 = c0 + (q0 - c0) * (mA); o1 = c1 + (q1 - c1) * (mB); }
    RW_ISSUE(0);
    for (int t0 = 0; t0 < SEQ; t0 += TC) {
#pragma unroll 1
        for (int prep_rep = 0; prep_rep < PREP_REP; ++prep_rep) {
#pragma unroll
        for (int i = 0; i < 2; ++i) {
            const int tok = p1tok0 + i * 16, cc = p1cc;
            const u32x4 cu = l_cu[i], pv = l_pv[i];
            float x[8];
            MIX2(cu.x, pv.x, p1m0[0], p1m0[1], x[0], x[1]) MIX2(cu.y, pv.y, p1m0[2], p1m0[3], x[2], x[3]) MIX2(cu.z, pv.z, p1m1[0], p1m1[1], x[4], x[5]) MIX2(cu.w, pv.w, p1m1[2], p1m1[3], x[6], x[7])
            if (cc < 8) {
#pragma unroll
                for (int j = 0; j < 8; ++j) x[j] = fast_tanh(x[j]); }
            else if (cc >= 16) {
#pragma unroll
                for (int j = 0; j < 8; ++j) x[j] = fast_sigmoid(x[j]); }
            u32x4 o; o.x = cvt_pk_bf16(x[0], x[1]); o.y = cvt_pk_bf16(x[2], x[3]); o.z = cvt_pk_bf16(x[4], x[5]); o.w = cvt_pk_bf16(x[6], x[7]);
            if (cc < 8) *(LAS u32x4*)(tw_i + tok * 128 + ((cc ^ (tok & 7)) * 16)) = o;
            else if (cc < 16) *(LAS u32x4*)(xa_i + tok * 128 + (((cc - 8) ^ (tok & 7)) * 16)) = o;
            else *(LAS u32x4*)(sg_i + tok * 256 + (((cc - 16) ^ (tok & 7)) * 16)) = o;
        }
        __syncthreads();
        {
            f32x4 dw = fzero4(), da = fzero4();
            const int row = mrt * 16 + fr;
#pragma unroll
            for (int s = 0; s < 2; ++s) {
                const bf16x8 ta = *(const LAS bf16x8*)(tw_i + row * 128 + (((s * 4 + g) ^ (row & 7)) * 16));
                const bf16x8 xa = *(const LAS bf16x8*)(xa_i + row * 128 + (((s * 4 + g) ^ (row & 7)) * 16));
                dw = __builtin_amdgcn_mfma_f32_16x16x32_bf16(ta, wf[s], dw, 0, 0, 0);
                da = __builtin_amdgcn_mfma_f32_16x16x32_bf16(xa, af[s], da, 0, 0, 0);
            }
#pragma unroll
            for (int r = 0; r < 4; ++r) { wpre[(mrt * 16 + g * 4 + r) * 64 + mct * 16 + fr] = dw[r]; apre[(mrt * 16 + g * 4 + r) * 64 + mct * 16 + fr] = da[r]; }
            if (wid < 4) {
                f32x4 dg = fzero4();
                const int grow = grt * 16 + fr;
#pragma unroll
                for (int s = 0; s < 4; ++s) { const bf16x8 sa_ = *(const LAS bf16x8*)(sg_i + grow * 256 + (((s * 4 + g) ^ (grow & 7)) * 16));
                    dg = __builtin_amdgcn_mfma_f32_16x16x32_bf16(sa_, gf[s], dg, 0, 0, 0); }
#pragma unroll
                for (int r = 0; r < 4; ++r) gpre[(grt * 16 + g * 4 + r) * 32 + gct * 16 + fr] = dg[r];
            }
        }
        __syncthreads();
        {
            const size_t n = nb0 + t0 + et;
            float rr[4], kr_[4];
            MIX2(l_rc.x, l_rp.x, mur[0], mur[1], rr[0], rr[1]) MIX2(l_rc.y, l_rp.y, mur[2], mur[3], rr[2], rr[3])
            MIX2(l_kc.x, l_kp.x, muk[0], muk[1], kr_[0], kr_[1]) MIX2(l_kc.y, l_kp.y, muk[2], muk[3], kr_[2], kr_[3])
            const f32x4 wp = *(const LAS f32x4*)(wpre + et * 64 + ec * 4), ap = *(const LAS f32x4*)(apre + et * 64 + ec * 4);
            float dec[4], aa[4], kkp[4], nsq = 0.f;
#pragma unroll
            for (int j = 0; j < 4; ++j) { const float z = w0v[j] + wp[j]; const float sp = __logf(1.0f + __expf(-z));
                dec[j] = __expf(-__expf(-sp - 0.5f)); aa[j] = fast_sigmoid(a0v[j] + ap[j]); kkp[j] = kr_[j] * kksc[j]; nsq += kkp[j] * kkp[j]; }
            nsq = red16(nsq);
            const float inrm = 1.0f / fmaxf(sqrtf(nsq), 1e-12f);
            f32x4 kkv, bv, khv, wrv, wv; float br = 0.f, kr2 = 0.f, rk = 0.f;
#pragma unroll
            for (int j = 0; j < 4; ++j) { const float kk = kkp[j] * inrm; const float kh = kr_[j] * (1.0f + (aa[j] - 1.0f) * kasc[j]); const float bb = kk * aa[j];
                kkv[j] = kk; bv[j] = bb; khv[j] = kh; wv[j] = dec[j]; wrv[j] = dec[j] * rr[j]; br += bb * rr[j]; kr2 += kh * rr[j]; rk += rr[j] * kh * rkv[j]; }
            br = red16(br); kr2 = red16(kr2); rk = red16(rk);
            *(LAS f32x4*)(kk_s + et * 64 + ec * 4) = kkv; *(LAS f32x4*)(w_s + et * 64 + ec * 4) = wv; *(LAS f32x4*)(b_s + et * 64 + ec * 4) = bv;
            *(LAS f32x4*)(kh_s + et * 64 + ec * 4) = khv; *(LAS f32x4*)(wr_s + et * 64 + ec * 4) = wrv;
            if (ec == 0) { sc_s[et * 2] = br; sc_s[et * 2 + 1] = kr2; }
            float v0, v1; MIX2(l_vc, l_vp, muv[0], muv[1], v0, v1)
            *(LAS f32x2*)(v_s + et * 32 + ec * 2) = (f32x2){v0, v1};
            const f32x2 gp = *(const LAS f32x2*)(gpre + et * 32 + ec * 2);
            *(unsigned*)(e1g + n * 512 + h * 64 + rq * 32 + ec * 2) = cvt_pk_bf16(rk * v0, rk * v1);
            *(unsigned*)(gg + n * 512 + h * 64 + rq * 32 + ec * 2) = cvt_pk_bf16(gp[0], gp[1]);
        }
        if (prep_rep + 1 < PREP_REP) __syncthreads();
        }
        if (t0 + TC < SEQ) RW_ISSUE(t0 + TC);
        __syncthreads();
        {
            f32x4 kkA = *(const LAS f32x4*)(kk_s + kq * 4), wrA = *(const LAS f32x4*)(wr_s + kq * 4), wwA = *(const LAS f32x4*)(w_s + kq * 4), bbA = *(const LAS f32x4*)(b_s + kq * 4), khA = *(const LAS f32x4*)(kh_s + kq * 4);
            float vvA = v_s[rl]; f32x2 scA = *(const LAS f32x2*)(sc_s);
            float yacc = 0.f;
#pragma unroll 1
            for (int t = 0; t < TC; ++t) {
                const int tn = (t + 1) & (TC - 1);
                const f32x4 kkB = *(const LAS f32x4*)(kk_s + tn * 64 + kq * 4), wrB = *(const LAS f32x4*)(wr_s + tn * 64 + kq * 4), wwB = *(const LAS f32x4*)(w_s + tn * 64 + kq * 4);
                const f32x4 bbB = *(const LAS f32x4*)(b_s + tn * 64 + kq * 4), khB = *(const LAS f32x4*)(kh_s + tn * 64 + kq * 4);
                const float vvB = v_s[tn * 32 + rl]; const f32x2 scB = *(const LAS f32x2*)(sc_s + tn * 2);
                float sa = S[0] * kkA[0] + S[1] * kkA[1] + S[2] * kkA[2] + S[3] * kkA[3];
                float yy = S[0] * wrA[0] + S[1] * wrA[1] + S[2] * wrA[2] + S[3] * wrA[3];
                sa = red16(sa); yy = red16(yy);
                const float y = yy - sa * scA[0] + vvA * scA[1];
                yacc = (kq == (t & 15)) ? y : yacc;
#pragma unroll
                for (int i = 0; i < 4; ++i) S[i] = S[i] * wwA[i] + (vvA * khA[i] - sa * bbA[i]);
                if ((t & 15) == 15) y_s[((t & 16) + kq) * 32 + rl] = yacc;
                kkA = kkB; wrA = wrB; wwA = wwB; bbA = bbB; khA = khB; vvA = vvB; scA = scB;
            }
        }
        __syncthreads();
        { const int tok = tid >> 4, c2 = (tid & 15) * 2; *(f32x2*)(yraw + (nb0 + t0 + tok) * 512 + h * 64 + rq * 32 + c2) = *(const LAS f32x2*)(y_s + tok * 32 + c2); }
    }
#undef MIX2
#undef RW_ISSUE
}

template <int CTRL> __device__ __forceinline__ float dpp0f(float v) { return __builtin_bit_cast(float, __builtin_amdgcn_update_dpp(0, __builtin_bit_cast(int, v), CTRL, 0xf, 0xf, true)); }
__device__ __forceinline__ bf16x8 pack_lo4(const f32x4 a) { u32x4 w; w.x = cvt_pk_bf16(a[0], a[1]); w.y = cvt_pk_bf16(a[2], a[3]); w.z = 0u; w.w = 0u; return __builtin_bit_cast(bf16x8, w); }
__device__ __forceinline__ bf16x8 pack_8(const f32x4 a, const f32x4 b) { u32x4 w; w.x = cvt_pk_bf16(a[0], a[1]); w.y = cvt_pk_bf16(a[2], a[3]); w.z = cvt_pk_bf16(b[0], b[1]); w.w = cvt_pk_bf16(b[2], b[3]); return __builtin_bit_cast(bf16x8, w); }
__device__ __forceinline__ f32x4 mm16(const f32x4 PT, const f32x4 Q) { return __builtin_amdgcn_mfma_f32_16x16x32_bf16(pack_lo4(PT), pack_lo4(Q), fzero4(), 0, 0, 0); }
constexpr int RW3_SLOT = 12544;
__device__ __forceinline__ int rw3_trswz(int row, int c) { return (((c >> 1) ^ ((row >> 1) & 3)) << 1) | (c & 1); }
__device__ __forceinline__ void rwkv3_item(const Params& p, LAS unsigned char* lds, int item) {
    const int tid = opaque_tid(), lane = tid & 63, wid = tid >> 6, fr = lane & 15, g = lane >> 4;
    const int b = item >> 3, h = item & 7;
    unsigned char* ws = p.ws;
    const bf16_t* P0 = (const bf16_t*)(ws + OFF_P);
    float* yraw = p.out; bf16_t* e1g = (bf16_t*)(p.out + (size_t)NTOK * 512); bf16_t* gg = e1g + (size_t)NTOK * 512;
    LAS unsigned char* w2h = lds;
    LAS unsigned char* a2h = lds + 8192;
    LAS unsigned char* g2h = lds + 16384;
    LAS unsigned char* slots = lds + 32768;
    LAS float* ptab = (LAS float*)(lds + 32768 + 8 * RW3_SLOT);
    LAS float* mul = ptab + 8 * 64;
    {
        const float* mu = p.in[I_AMU];
        if (tid < 64) { ptab[tid] = mu[h * 64 + tid]; ptab[64 + tid] = mu[512 + h * 64 + tid]; ptab[128 + tid] = mu[1024 + h * 64 + tid];
            ptab[192 + tid] = p.in[I_AW0][h * 64 + tid]; ptab[256 + tid] = p.in[I_AA0][h * 64 + tid]; ptab[320 + tid] = p.in[I_AKK][h * 64 + tid];
            ptab[384 + tid] = p.in[I_AKA][h * 64 + tid]; ptab[448 + tid] = p.in[I_ARK][h * 64 + tid]; }
        if (tid < 256) mul[tid] = mu[1536 + tid];
    }
    {
        const bf16_t* w2t = (const bf16_t*)(ws + OFF_MISC + MISC_W2T); const bf16_t* a2t = (const bf16_t*)(ws + OFF_MISC + MISC_A2T); const bf16_t* g2t = (const bf16_t*)(ws + OFF_MISC + MISC_G2T);
        { const int row = tid >> 3, c = tid & 7;
            *(LAS u32x4*)(w2h + row * 128 + ((c ^ (row & 7)) * 16)) = *(const u32x4*)(w2t + (size_t)(h * 64 + row) * 64 + c * 8);
            *(LAS u32x4*)(a2h + row * 128 + ((c ^ (row & 7)) * 16)) = *(const u32x4*)(a2t + (size_t)(h * 64 + row) * 64 + c * 8); }
#pragma unroll
        for (int i = 0; i < 2; ++i) { const int q = tid + i * 512, row = q >> 4, c = q & 15;
            *(LAS u32x4*)(g2h + row * 256 + ((c ^ (row & 7)) * 16)) = *(const u32x4*)(g2t + (size_t)(h * 64 + row) * 128 + c * 8); }
    }
    __syncthreads();
    f32x4 Hacc[4];
#pragma unroll
    for (int rt = 0; rt < 4; ++rt) Hacc[rt] = fzero4();
    const size_t nb0 = (size_t)b * SEQ;
    const int q4 = fr >> 2, p4 = fr & 3;
#define MIXB(wc, wp, mA, mB, o0, o1) { const float c0 = __uint_as_float((wc) << 16), c1 = __uint_as_float((wc) & 0xffff0000u), q0 = __uint_as_float((wp) << 16), q1 = __uint_as_float((wp) & 0xffff0000u); o0 = c0 + (q0 - c0) * (mA); o1 = c1 + (q1 - c1) * (mB); }
#pragma unroll 1
    for (int tick = 0; tick < SEQ / 128; ++tick) {
        {
            int lane_t = lane; asm volatile("" : "+v"(lane_t));
            const int fr = lane_t & 15, g = lane_t >> 4, q4 = fr >> 2, p4 = fr & 3;
            LAS unsigned char* sl = slots + wid * RW3_SLOT;
            LAS unsigned char* Qt_i = sl, * Rh_i = sl + 2048, * Kh_i = sl + 4096, * Bn_i = sl + 6144, * Vi_i = sl + 8192, * M1_i = sl + 10240, * DD_i = sl + 11264; LAS float* gam_i = (LAS float*)(sl + 12288);
            const int t0 = (tick * 8 + wid) * 16;
            const size_t n = nb0 + t0 + fr;
            const bool hasp = (t0 + fr) > 0;
            const bf16_t* rowc = P0 + n * NE_MAIN; const bf16_t* rowp = rowc - NE_MAIN;
            u32x2 lrc[4], lkc[4], lvc[4], lrp[4], lkp[4], lvp[4];
#pragma unroll
            for (int ct = 0; ct < 4; ++ct) { const int c0 = ct * 16 + g * 4;
                lrc[ct] = *(const u32x2*)(rowc + h * 64 + c0); lkc[ct] = *(const u32x2*)(rowc + 512 + h * 64 + c0); lvc[ct] = *(const u32x2*)(rowc + 1024 + h * 64 + c0);
                lrp[ct] = (u32x2){0u, 0u}; lkp[ct] = lrp[ct]; lvp[ct] = lrp[ct];
                if (hasp) { lrp[ct] = *(const u32x2*)(rowp + h * 64 + c0); lkp[ct] = *(const u32x2*)(rowp + 512 + h * 64 + c0); lvp[ct] = *(const u32x2*)(rowp + 1024 + h * 64 + c0); } }
            bf16x8 bw[2], ba[2], bg[4];
#pragma unroll
            for (int f = 0; f < 8; ++f) {
                const int col = 1536 + (f < 2 ? f * 32 : (f < 4 ? 64 + (f - 2) * 32 : 128 + (f - 4) * 32)) + g * 8;
                const u32x4 cu = *(const u32x4*)(rowc + col); u32x4 pv = uzero4(); if (hasp) pv = *(const u32x4*)(rowp + col);
                const f32x4 m0 = *(const LAS f32x4*)(mul + col - 1536), m1 = *(const LAS f32x4*)(mul + col - 1536 + 4);
                float x[8];
                MIXB(cu.x, pv.x, m0[0], m0[1], x[0], x[1]) MIXB(cu.y, pv.y, m0[2], m0[3], x[2], x[3]) MIXB(cu.z, pv.z, m1[0], m1[1], x[4], x[5]) MIXB(cu.w, pv.w, m1[2], m1[3], x[6], x[7])
                if (f < 2) {
#pragma unroll
                    for (int j = 0; j < 8; ++j) x[j] = fast_tanh(x[j]); }
                else if (f >= 4) {
#pragma unroll
                    for (int j = 0; j < 8; ++j) x[j] = fast_sigmoid(x[j]); }
                u32x4 o; o.x = cvt_pk_bf16(x[0], x[1]); o.y = cvt_pk_bf16(x[2], x[3]); o.z = cvt_pk_bf16(x[4], x[5]); o.w = cvt_pk_bf16(x[6], x[7]);
                const bf16x8 ob = __builtin_bit_cast(bf16x8, o);
                if (f < 2) bw[f] = ob; else if (f < 4) ba[f - 2] = ob; else bg[f - 4] = ob;
            }
            f32x4 Wt[4], At[4], Gt[4];
#pragma unroll
            for (int ct = 0; ct < 4; ++ct) {
                const int row = ct * 16 + fr;
                f32x4 dw = fzero4(), da = dw, dg = dw;
#pragma unroll
                for (int s = 0; s < 2; ++s) {
                    dw = __builtin_amdgcn_mfma_f32_16x16x32_bf16(*(const LAS bf16x8*)(w2h + row * 128 + (((s * 4 + g) ^ (row & 7)) * 16)), bw[s], dw, 0, 0, 0);
                    da = __builtin_amdgcn_mfma_f32_16x16x32_bf16(*(const LAS bf16x8*)(a2h + row * 128 + (((s * 4 + g) ^ (row & 7)) * 16)), ba[s], da, 0, 0, 0); }
#pragma unroll
                for (int s = 0; s < 4; ++s) dg = __builtin_amdgcn_mfma_f32_16x16x32_bf16(*(const LAS bf16x8*)(g2h + row * 256 + (((s * 4 + g) ^ (row & 7)) * 16)), bg[s], dg, 0, 0, 0);
                Wt[ct] = dw; At[ct] = da; Gt[ct] = dg;
            }
            f32x4 Rm[4], Khm[4], Lw[4], Aa[4];
            float nsq = 0.f, rk = 0.f;
            u32x2 Vp[4];
#pragma unroll
            for (int ct = 0; ct < 4; ++ct) {
                const int c0 = ct * 16 + g * 4;
                const u32x2 rc = lrc[ct], kc = lkc[ct], vc = lvc[ct], rp = lrp[ct], kp = lkp[ct], vp = lvp[ct];
                const f32x4 mr = *(const LAS f32x4*)(ptab + c0), mk = *(const LAS f32x4*)(ptab + 64 + c0), mv = *(const LAS f32x4*)(ptab + 128 + c0);
                f32x4 Km, Vm;
                MIXB(rc.x, rp.x, mr[0], mr[1], Rm[ct][0], Rm[ct][1]) MIXB(rc.y, rp.y, mr[2], mr[3], Rm[ct][2], Rm[ct][3])
                MIXB(kc.x, kp.x, mk[0], mk[1], Km[0], Km[1]) MIXB(kc.y, kp.y, mk[2], mk[3], Km[2], Km[3])
                MIXB(vc.x, vp.x, mv[0], mv[1], Vm[0], Vm[1]) MIXB(vc.y, vp.y, mv[2], mv[3], Vm[2], Vm[3])
                const f32x4 w0v = *(const LAS f32x4*)(ptab + 192 + c0), a0v = *(const LAS f32x4*)(ptab + 256 + c0), kks = *(const LAS f32x4*)(ptab + 320 + c0), kas = *(const LAS f32x4*)(ptab + 384 + c0), rkp = *(const LAS f32x4*)(ptab + 448 + c0);
#pragma unroll
                for (int r = 0; r < 4; ++r) { const float z = w0v[r] + Wt[ct][r]; const float sp = __logf(1.0f + __expf(-z));
                    Lw[ct][r] = -__expf(-sp - 0.5f);
                    const float a = fast_sigmoid(a0v[r] + At[ct][r]); Aa[ct][r] = a;
                    const float kkp = Km[r] * kks[r]; nsq += kkp * kkp; Wt[ct][r] = kkp;
                    const float kh = Km[r] * (1.0f + (a - 1.0f) * kas[r]); Khm[ct][r] = kh; rk += Rm[ct][r] * kh * rkp[r]; }
                Vp[ct].x = cvt_pk_bf16(Vm[0], Vm[1]); Vp[ct].y = cvt_pk_bf16(Vm[2], Vm[3]);
                At[ct] = Vm;
            }
            nsq += __shfl_xor(nsq, 16); nsq += __shfl_xor(nsq, 32);
            rk += __shfl_xor(rk, 16); rk += __shfl_xor(rk, 32);
            const float inrm = 1.0f / fmaxf(sqrtf(nsq), 1e-12f);
#pragma unroll
            for (int ct = 0; ct < 4; ++ct) { const int c0 = ct * 16 + g * 4;
                u32x2 ew, gw; ew.x = cvt_pk_bf16(rk * At[ct][0], rk * At[ct][1]); ew.y = cvt_pk_bf16(rk * At[ct][2], rk * At[ct][3]);
                gw.x = cvt_pk_bf16(Gt[ct][0], Gt[ct][1]); gw.y = cvt_pk_bf16(Gt[ct][2], Gt[ct][3]);
                *(u32x2*)(e1g + n * 512 + h * 64 + c0) = ew; *(u32x2*)(gg + n * 512 + h * 64 + c0) = gw;
                const int c = 2 * ct + (g >> 1);
                *(LAS u32x2*)(Vi_i + fr * 128 + rw3_trswz(fr, c) * 16 + (g & 1) * 8) = Vp[ct]; }
            u32x2 Qp[4], Kp[4], Bp[4], Rp[4];
#pragma unroll
            for (int ct = 0; ct < 4; ++ct) {
                const int c0 = ct * 16 + g * 4;
                f32x4 gmv; float qh[4], kh_[4], bh[4], rh[4];
#pragma unroll
                for (int r = 0; r < 4; ++r) {
                    float L = Lw[ct][r];
                    L += dpp0f<0x111>(L); L += dpp0f<0x112>(L); L += dpp0f<0x114>(L); L += dpp0f<0x118>(L);
                    const float Ltot = __shfl(L, lane | 15);
                    const float eL = __expf(L), ieL = fast_rcp(eL), eLex = __expf(L - Lw[ct][r]);
                    const float kk = Wt[ct][r] * inrm, bb = kk * Aa[ct][r];
                    qh[r] = kk * eLex; kh_[r] = Khm[ct][r] * ieL; bh[r] = bb * ieL; rh[r] = Rm[ct][r] * eL;
                    gmv[r] = __expf(Ltot); }
                Qp[ct].x = cvt_pk_bf16(qh[0], qh[1]); Qp[ct].y = cvt_pk_bf16(qh[2], qh[3]); Kp[ct].x = cvt_pk_bf16(kh_[0], kh_[1]); Kp[ct].y = cvt_pk_bf16(kh_[2], kh_[3]);
                Bp[ct].x = cvt_pk_bf16(bh[0], bh[1]); Bp[ct].y = cvt_pk_bf16(bh[2], bh[3]); Rp[ct].x = cvt_pk_bf16(rh[0], rh[1]); Rp[ct].y = cvt_pk_bf16(rh[2], rh[3]);
                if (fr == 0) *(LAS f32x4*)(gam_i + c0) = gmv;
            }
            bf16x8 Qf[2], Kf[2], Bf[2], Rf[2];
#pragma unroll
            for (int s = 0; s < 2; ++s) { Qf[s] = __builtin_bit_cast(bf16x8, (u32x4){Qp[2 * s].x, Qp[2 * s].y, Qp[2 * s + 1].x, Qp[2 * s + 1].y}); Kf[s] = __builtin_bit_cast(bf16x8, (u32x4){Kp[2 * s].x, Kp[2 * s].y, Kp[2 * s + 1].x, Kp[2 * s + 1].y});
                Bf[s] = __builtin_bit_cast(bf16x8, (u32x4){Bp[2 * s].x, Bp[2 * s].y, Bp[2 * s + 1].x, Bp[2 * s + 1].y}); Rf[s] = __builtin_bit_cast(bf16x8, (u32x4){Rp[2 * s].x, Rp[2 * s].y, Rp[2 * s + 1].x, Rp[2 * s + 1].y}); }
            f32x4 Ab = fzero4(), AbT = Ab, Ak = Ab, DkT = Ab, DbT = Ab;
#pragma unroll
            for (int s = 0; s < 2; ++s) {
                Ab = __builtin_amdgcn_mfma_f32_16x16x32_bf16(Qf[s], Bf[s], Ab, 0, 0, 0);
                AbT = __builtin_amdgcn_mfma_f32_16x16x32_bf16(Bf[s], Qf[s], AbT, 0, 0, 0);
                Ak = __builtin_amdgcn_mfma_f32_16x16x32_bf16(Qf[s], Kf[s], Ak, 0, 0, 0);
                DkT = __builtin_amdgcn_mfma_f32_16x16x32_bf16(Kf[s], Rf[s], DkT, 0, 0, 0);
                DbT = __builtin_amdgcn_mfma_f32_16x16x32_bf16(Bf[s], Rf[s], DbT, 0, 0, 0); }
            f32x4 N, NT, ident;
#pragma unroll
            for (int r = 0; r < 4; ++r) { const int row = 4 * g + r;
                N[r] = (fr < row) ? -Ab[r] : 0.f; Ak[r] = (fr < row) ? Ak[r] : 0.f;
                NT[r] = (row < fr) ? -AbT[r] : 0.f;
                DkT[r] = (row <= fr) ? DkT[r] : 0.f; DbT[r] = (row <= fr) ? -DbT[r] : 0.f;
                ident[r] = (row == fr) ? 1.f : 0.f; }
            const f32x4 N2 = mm16(NT, N), N2T = mm16(N, NT);
            const f32x4 N4 = mm16(N2T, N2), N4T = mm16(N2, N2T);
            const f32x4 N8T = mm16(N4, N4T);
            const f32x4 X1 = N + ident, X1T = NT + ident, X2 = N2 + ident, X2T = N2T + ident, X4 = N4 + ident, X8T = N8T + ident;
            const f32x4 U12 = mm16(X1T, X2), U12T = mm16(X1, X2T), U34T = mm16(X4, X8T);
            const f32x4 TT = mm16(U12, U34T);
            const f32x4 M1T = mm16(Ak, TT);
#pragma unroll
            for (int ct = 0; ct < 4; ++ct) { const int c = 2 * ct + (g >> 1);
                *(LAS u32x2*)(Qt_i + fr * 128 + rw3_trswz(fr, c) * 16 + (g & 1) * 8) = Qp[ct]; }
            s16x4 qtr[4];
#pragma unroll
            for (int ct = 0; ct < 4; ++ct) { const int row = 4 * g + q4, c = 2 * ct + (p4 >> 1);
                qtr[ct] = __builtin_amdgcn_ds_read_tr16_b64_v4i16((LAS s16x4*)(Qt_i + row * 128 + rw3_trswz(row, c) * 16 + (p4 & 1) * 8)); }
            const bf16x8 TTf = pack_lo4(TT);
            f32x4 Qt[4];
#pragma unroll
            for (int ct = 0; ct < 4; ++ct) { const bf16x8 af = (bf16x8){qtr[ct][0], qtr[ct][1], qtr[ct][2], qtr[ct][3], 0, 0, 0, 0};
                Qt[ct] = __builtin_amdgcn_mfma_f32_16x16x32_bf16(af, TTf, fzero4(), 0, 0, 0); }
#pragma unroll
            for (int ct = 0; ct < 4; ++ct) {
                const int s = ct >> 1, hh = ct & 1;
                u32x2 w; w.x = cvt_pk_bf16(Qt[ct][0], Qt[ct][1]); w.y = cvt_pk_bf16(Qt[ct][2], Qt[ct][3]);
                *(LAS u32x2*)(Qt_i + fr * 128 + (((s * 4 + g) ^ (fr & 7)) * 16) + hh * 8) = w;
                *(LAS u32x2*)(Rh_i + fr * 128 + (((s * 4 + g) ^ (fr & 7)) * 16) + hh * 8) = Rp[ct];
                const int c = 2 * ct + (g >> 1);
                *(LAS u32x2*)(Kh_i + fr * 128 + rw3_trswz(fr, c) * 16 + (g & 1) * 8) = Kp[ct];
                *(LAS u32x2*)(Bn_i + fr * 128 + rw3_trswz(fr, c) * 16 + (g & 1) * 8) = (u32x2){Bp[ct].x ^ 0x80008000u, Bp[ct].y ^ 0x80008000u}; }
            { const int cs = (g ^ ((fr >> 2) & 3)) * 16;
                u32x2 w; w.x = cvt_pk_bf16(M1T[0], M1T[1]); w.y = cvt_pk_bf16(M1T[2], M1T[3]);
                *(LAS u32x2*)(M1_i + fr * 64 + cs) = (u32x2){0u, 0u}; *(LAS u32x2*)(M1_i + fr * 64 + cs + 8) = w;
                w.x = cvt_pk_bf16(DbT[0], DbT[1]); w.y = cvt_pk_bf16(DbT[2], DbT[3]); *(LAS u32x2*)(DD_i + fr * 64 + cs) = w;
                w.x = cvt_pk_bf16(DkT[0], DkT[1]); w.y = cvt_pk_bf16(DkT[2], DkT[3]); *(LAS u32x2*)(DD_i + fr * 64 + cs + 8) = w; }
        }
        __syncthreads();
        if (wid < 4) {
#pragma unroll 1
            for (int j = 0; j < 8; ++j) {
                int lane_t = lane; asm volatile("" : "+v"(lane_t));
                const int fr = lane_t & 15, g = lane_t >> 4, q4 = fr >> 2, p4 = fr & 3;
                LAS unsigned char* sl = slots + j * RW3_SLOT;
                LAS unsigned char* Qt_i = sl, * Rh_i = sl + 2048, * Kh_i = sl + 4096, * Bn_i = sl + 6144, * Vi_i = sl + 8192, * M1_i = sl + 10240, * DD_i = sl + 11264; LAS const float* gam_i = (LAS const float*)(sl + 12288);
                const bf16x8 Hb0 = pack_8(Hacc[0], Hacc[1]), Hb1 = pack_8(Hacc[2], Hacc[3]);
                const int trow = 4 * g + q4;
                const s16x4 vv = __builtin_amdgcn_ds_read_tr16_b64_v4i16((LAS s16x4*)(Vi_i + trow * 128 + rw3_trswz(trow, 2 * wid + (p4 >> 1)) * 16 + (p4 & 1) * 8));
                const bf16x8 q0 = *(const LAS bf16x8*)(Qt_i + fr * 128 + (((0 + g) ^ (fr & 7)) * 16)), q1 = *(const LAS bf16x8*)(Qt_i + fr * 128 + (((4 + g) ^ (fr & 7)) * 16));
                const bf16x8 r0 = *(const LAS bf16x8*)(Rh_i + fr * 128 + (((0 + g) ^ (fr & 7)) * 16)), r1 = *(const LAS bf16x8*)(Rh_i + fr * 128 + (((4 + g) ^ (fr & 7)) * 16));
                const int cs = (g ^ ((fr >> 2) & 3)) * 16;
                const bf16x8 m1 = *(const LAS bf16x8*)(M1_i + fr * 64 + cs), dd = *(const LAS bf16x8*)(DD_i + fr * 64 + cs);
                const bf16x8 v0 = (bf16x8){0, 0, 0, 0, vv[0], vv[1], vv[2], vv[3]};
                f32x4 Z = fzero4();
                Z = __builtin_amdgcn_mfma_f32_16x16x32_bf16(q0, Hb0, Z, 0, 0, 0); Z = __builtin_amdgcn_mfma_f32_16x16x32_bf16(q1, Hb1, Z, 0, 0, 0); Z = __builtin_amdgcn_mfma_f32_16x16x32_bf16(m1, v0, Z, 0, 0, 0);
                u32x2 zw; zw.x = cvt_pk_bf16(Z[0], Z[1]); zw.y = cvt_pk_bf16(Z[2], Z[3]);
                const s16x4 zs = __builtin_bit_cast(s16x4, zw);
                const bf16x8 zv = (bf16x8){zs[0], zs[1], zs[2], zs[3], vv[0], vv[1], vv[2], vv[3]};
                f32x4 Y = fzero4();
                Y = __builtin_amdgcn_mfma_f32_16x16x32_bf16(r0, Hb0, Y, 0, 0, 0); Y = __builtin_amdgcn_mfma_f32_16x16x32_bf16(r1, Hb1, Y, 0, 0, 0); Y = __builtin_amdgcn_mfma_f32_16x16x32_bf16(dd, zv, Y, 0, 0, 0);
                const size_t nrow = nb0 + (size_t)(tick * 8 + j) * 16 + 4 * g;
#pragma unroll
                for (int r = 0; r < 4; ++r) yraw[(nrow + r) * 512 + h * 64 + wid * 16 + fr] = Y[r];
#pragma unroll
                for (int rt = 0; rt < 4; ++rt) { const int c = 2 * rt + (p4 >> 1);
                    const s16x4 bn = __builtin_amdgcn_ds_read_tr16_b64_v4i16((LAS s16x4*)(Bn_i + trow * 128 + rw3_trswz(trow, c) * 16 + (p4 & 1) * 8));
                    const s16x4 kh = __builtin_amdgcn_ds_read_tr16_b64_v4i16((LAS s16x4*)(Kh_i + trow * 128 + rw3_trswz(trow, c) * 16 + (p4 & 1) * 8));
                    const bf16x8 af = (bf16x8){bn[0], bn[1], bn[2], bn[3], kh[0], kh[1], kh[2], kh[3]};
                    Hacc[rt] = __builtin_amdgcn_mfma_f32_16x16x32_bf16(af, zv, Hacc[rt], 0, 0, 0);
                    Hacc[rt] = Hacc[rt] * *(const LAS f32x4*)(gam_i + rt * 16 + g * 4); }
            }
        }
        __syncthreads();
    }
#undef MIXB
}

__device__ __forceinline__ void phase_rwkv_epi(const Params& p, int bid, int nb) {
    const int tid = opaque_tid(), wid = tid >> 6, lane = tid & 63;
    const float* yraw = p.out; const bf16_t* e1g = (const bf16_t*)(p.out + (size_t)NTOK * 512); const bf16_t* gg = e1g + (size_t)NTOK * 512;
    bf16_t* mix = (bf16_t*)(p.ws + OFF_BUF64);
    const f32x4 g0 = *(const f32x4*)(p.in[I_AGNG] + lane * 8), g1 = *(const f32x4*)(p.in[I_AGNG] + lane * 8 + 4), b0 = *(const f32x4*)(p.in[I_AGNB] + lane * 8), b1 = *(const f32x4*)(p.in[I_AGNB] + lane * 8 + 4);
    for (int n = bid * 8 + wid; n < NTOK; n += nb * 8) {
        const f32x4 y0 = *(const f32x4*)(yraw + (size_t)n * 512 + lane * 8), y1 = *(const f32x4*)(yraw + (size_t)n * 512 + lane * 8 + 4);
        const u32x4 ev = *(const u32x4*)(e1g + (size_t)n * 512 + lane * 8), gv = *(const u32x4*)(gg + (size_t)n * 512 + lane * 8);
#if SANITIZE
        f32x4 y0s = y0, y1s = y1;
#pragma unroll
        for (int j = 0; j < 4; ++j) { if (!(fabsf(y0s[j]) < 1e30f)) y0s[j] = 0.f; if (!(fabsf(y1s[j]) < 1e30f)) y1s[j] = 0.f; }
#define y0 y0s
#define y1 y1s
#endif
        float s = (y0[0] + y0[1]) + (y0[2] + y0[3]) + (y1[0] + y1[1]) + (y1[2] + y1[3]);
        s = red8(s); const float mean = s * (1.0f / 64.0f);
        const f32x4 d0 = y0 - mean, d1 = y1 - mean;
        float q = (d0[0] * d0[0] + d0[1] * d0[1]) + (d0[2] * d0[2] + d0[3] * d0[3]) + (d1[0] * d1[0] + d1[1] * d1[1]) + (d1[2] * d1[2] + d1[3] * d1[3]);
        q = red8(q); const float rs = rsqrtf(q * (1.0f / 64.0f) + 64e-5f);
        float o[8];
        const unsigned ew[4] = {ev.x, ev.y, ev.z, ev.w}, gw[4] = {gv.x, gv.y, gv.z, gv.w};
#pragma unroll
        for (int j = 0; j < 4; ++j) { const float ya = (j < 2 ? d0[2 * j] : d1[2 * j - 4]), yb = (j < 2 ? d0[2 * j + 1] : d1[2 * j - 3]);
            const float ga = (j < 2 ? g0[2 * j] : g1[2 * j - 4]), gb_ = (j < 2 ? g0[2 * j + 1] : g1[2 * j - 3]); const float ba = (j < 2 ? b0[2 * j] : b1[2 * j - 4]), bb_ = (j < 2 ? b0[2 * j + 1] : b1[2 * j - 3]);
            o[2 * j] = (ya * rs * ga + ba + __uint_as_float(ew[j] << 16)) * __uint_as_float(gw[j] << 16);
            o[2 * j + 1] = (yb * rs * gb_ + bb_ + __uint_as_float(ew[j] & 0xffff0000u)) * __uint_as_float(gw[j] & 0xffff0000u); }
        u32x4 w; w.x = cvt_pk_bf16(o[0], o[1]); w.y = cvt_pk_bf16(o[2], o[3]); w.z = cvt_pk_bf16(o[4], o[5]); w.w = cvt_pk_bf16(o[6], o[7]);
#if SANITIZE
#undef y0
#undef y1
#pragma unroll
        for (int j = 0; j < 8; ++j) if (!(fabsf(o[j]) < 1e30f)) o[j] = 0.f;
        w.x = cvt_pk_bf16(o[0], o[1]); w.y = cvt_pk_bf16(o[2], o[3]); w.z = cvt_pk_bf16(o[4], o[5]); w.w = cvt_pk_bf16(o[6], o[7]);
#endif
        *(u32x4*)(mix + (size_t)n * DM + lane * 8) = w;
    }
}

__device__ __forceinline__ int gla_fT(int row) { return ((row >> 1) & 1) | (((row >> 3) & 1) << 1); }
__device__ __forceinline__ int gla_hV(int row) { return (row & 3) | (((row >> 3) & 1) << 2); }
__device__ __forceinline__ void gla2_item(const Params& p, LAS unsigned char* lds, int item) {
    const int tid = opaque_tid(), lane = tid & 63, wid = tid >> 6, fr = lane & 15, g = lane >> 4;
    const int b = item >> 2, h = item & 3;
    const bf16_t* P0 = (const bf16_t*)(p.ws + OFF_P) + 1792;
    const float* xa16 = (const float*)(p.ws + OFF_U);
    bf16_t* mix = (bf16_t*)(p.ws + OFF_BUF64);
    LAS float* bcf = (LAS float*)lds;
    LAS float* tot = bcf + 64 * 64;
    LAS float* bls = tot + 8 * 64;
    LAS float* pn = bls + 64;
    LAS float* xs = pn + 64 * 8;
    LAS unsigned char* qd_i = (LAS unsigned char*)(xs + 2 * 1024);
    LAS unsigned char* ki_a = qd_i + 8192;
    LAS unsigned char* ki_t = ki_a + 8192;
    LAS unsigned char* att_i = ki_t + 8192;
    LAS unsigned char* v_i = att_i + 8192;
    for (int i = tid; i < 8192 / 16; i += 512) *(LAS u32x4*)(att_i + i * 16) = uzero4();
    float gw2[16];
#pragma unroll
    for (int i = 0; i < 16; ++i) gw2[i] = p.in[I_BGW2][i * 256 + h * 64 + lane];
    const float gb = p.in[I_BGB][h * 64 + lane];
    const f32x4 ngv = *(const f32x4*)(p.in[I_BNG] + h * 128 + wid * 16 + g * 4);
    f32x4 Sacc[4];
#pragma unroll
    for (int rt = 0; rt < 4; ++rt) Sacc[rt] = fzero4();
    const int q4 = fr >> 2, p4 = fr & 3;
    const int tok = tid >> 3, dc = tid & 7;
    u32x4 nq, nk, nv0, nv1; u32x2 ngate[4]; f32x4 nxa = fzero4();
#define GLA_ISSUE(c0n) do { const size_t _n = (size_t)b * SEQ + (c0n) + tok; \
        nq = *(const u32x4*)(P0 + _n * NE_MAIN + h * 64 + dc * 8); nk = *(const u32x4*)(P0 + _n * NE_MAIN + 256 + h * 64 + dc * 8); \
        nv0 = *(const u32x4*)(P0 + _n * NE_MAIN + 512 + h * 128 + dc * 16); nv1 = *(const u32x4*)(P0 + _n * NE_MAIN + 512 + h * 128 + dc * 16 + 8); \
        _Pragma("unroll") for (int _ct = 0; _ct < 4; ++_ct) ngate[_ct] = *(const u32x2*)(P0 + ((size_t)b * SEQ + (c0n) + _ct * 16 + fr) * NE_MAIN + 1024 + h * 128 + wid * 16 + g * 4); \
        if (tid < 256) nxa = *(const f32x4*)(xa16 + ((size_t)b * SEQ + (c0n)) * 16 + tid * 4); } while (0)
    GLA_ISSUE(0);
    if (tid < 256) *(LAS f32x4*)(xs + tid * 4) = nxa;
    __syncthreads();
    for (int c0 = 0; c0 < SEQ; c0 += 64) {
        const size_t n0 = (size_t)b * SEQ + c0;
        LAS const float* xsc = xs + ((c0 >> 6) & 1) * 1024;
        { float run = 0.f;
#pragma unroll
            for (int tt = 0; tt < 8; ++tt) { const int c = wid * 8 + tt; float z = gb;
#pragma unroll
                for (int i4 = 0; i4 < 4; ++i4) { const f32x4 xv = *(const LAS f32x4*)(xsc + c * 16 + i4 * 4); z += xv[0] * gw2[i4 * 4] + xv[1] * gw2[i4 * 4 + 1] + xv[2] * gw2[i4 * 4 + 2] + xv[3] * gw2[i4 * 4 + 3]; }
                const float ls = fminf(z, 0.f) - __logf(1.0f + __expf(-fabsf(z)));
                run += ls * (1.0f / 16.0f); bcf[c * 64 + lane] = run; }
            tot[wid * 64 + lane] = run; }
        __syncthreads();
        { float off = 0.f;
            for (int w2 = 0; w2 < wid; ++w2) off += tot[w2 * 64 + lane];
#pragma unroll
            for (int tt = 0; tt < 8; ++tt) bcf[(wid * 8 + tt) * 64 + lane] += off;
            if (wid == 7) bls[lane] = __expf(bcf[63 * 64 + lane]); }
        __syncthreads();
        u32x2 gate[4];
        { const f32x4 bc0 = *(const LAS f32x4*)(bcf + tok * 64 + dc * 8), bc1 = *(const LAS f32x4*)(bcf + tok * 64 + dc * 8 + 4);
            const unsigned qw[4] = {nq.x, nq.y, nq.z, nq.w}, kw[4] = {nk.x, nk.y, nk.z, nk.w};
            float qo[8], ko[8];
#pragma unroll
            for (int j = 0; j < 4; ++j) { const float ba = (j < 2 ? bc0[2 * j] : bc1[2 * j - 4]), bb = (j < 2 ? bc0[2 * j + 1] : bc1[2 * j - 3]);
                const float ea = __expf(ba), eb = __expf(bb), ia = fast_rcp(ea), ib = fast_rcp(eb);
                qo[2 * j] = __uint_as_float(qw[j] << 16) * 0.125f * ea; qo[2 * j + 1] = __uint_as_float(qw[j] & 0xffff0000u) * 0.125f * eb;
                ko[2 * j] = __uint_as_float(kw[j] << 16) * ia; ko[2 * j + 1] = __uint_as_float(kw[j] & 0xffff0000u) * ib; }
            u32x4 qp, kp; qp.x = cvt_pk_bf16(qo[0], qo[1]); qp.y = cvt_pk_bf16(qo[2], qo[3]); qp.z = cvt_pk_bf16(qo[4], qo[5]); qp.w = cvt_pk_bf16(qo[6], qo[7]);
            kp.x = cvt_pk_bf16(ko[0], ko[1]); kp.y = cvt_pk_bf16(ko[2], ko[3]); kp.z = cvt_pk_bf16(ko[4], ko[5]); kp.w = cvt_pk_bf16(ko[6], ko[7]);
            *(LAS u32x4*)(qd_i + tok * 128 + ((dc ^ (tok & 7)) * 16)) = qp;
            *(LAS u32x4*)(ki_a + tok * 128 + ((dc ^ (tok & 7)) * 16)) = kp;
            *(LAS u32x4*)(ki_t + tok * 128 + (((((dc >> 1) ^ gla_fT(tok)) << 1) | (dc & 1)) * 16)) = kp;
            { const int pr = dc ^ gla_hV(tok); *(LAS u32x4*)(v_i + tok * 256 + (pr * 2) * 16) = nv0; *(LAS u32x4*)(v_i + tok * 256 + (pr * 2 + 1) * 16) = nv1; }
#pragma unroll
            for (int ct = 0; ct < 4; ++ct) gate[ct] = ngate[ct]; }
        if (c0 + 64 < SEQ) GLA_ISSUE(c0 + 64);
        __syncthreads();
        for (int ti = wid; ti < 10; ti += 8) {
            int st, ct; { const int tb[10] = {0x00, 0x01, 0x02, 0x03, 0x11, 0x12, 0x13, 0x22, 0x23, 0x33}; int code = 0;
#pragma unroll
                for (int k = 0; k < 10; ++k) if (k == ti) code = tb[k];
                st = code >> 4; ct = code & 15; }
            f32x4 d = fzero4();
            const int rs_ = st * 16 + fr, rc_ = ct * 16 + fr;
#pragma unroll
            for (int s = 0; s < 2; ++s) {
                const bf16x8 a = *(const LAS bf16x8*)(ki_a + rs_ * 128 + (((s * 4 + g) ^ (rs_ & 7)) * 16));
                const bf16x8 bq = *(const LAS bf16x8*)(qd_i + rc_ * 128 + (((s * 4 + g) ^ (rc_ & 7)) * 16));
                d = __builtin_amdgcn_mfma_f32_16x16x32_bf16(a, bq, d, 0, 0, 0); }
            const int c = ct * 16 + fr; float o4[4];
#pragma unroll
            for (int r = 0; r < 4; ++r) { const int s_ = st * 16 + g * 4 + r; o4[r] = (s_ <= c) ? d[r] : 0.f; }
            u32x2 w; w.x = cvt_pk_bf16(o4[0], o4[1]); w.y = cvt_pk_bf16(o4[2], o4[3]);
            *(LAS u32x2*)(att_i + c * 128 + (((2 * st + (g >> 1)) ^ (c & 7)) * 16) + (g & 1) * 8) = w;
        }
        __syncthreads();
        {
            bf16x8 vf[2];
#pragma unroll
            for (int s = 0; s < 2; ++s) {
                const int r1 = s * 32 + g * 8 + q4, r2 = r1 + 4; const int c = 2 * wid + (p4 >> 1);
                const s16x4 lo = __builtin_amdgcn_ds_read_tr16_b64_v4i16((LAS s16x4*)(v_i + r1 * 256 + (((((c >> 1) ^ gla_hV(r1)) << 1) | (c & 1)) * 16) + (p4 & 1) * 8));
                const s16x4 hi = __builtin_amdgcn_ds_read_tr16_b64_v4i16((LAS s16x4*)(v_i + r2 * 256 + (((((c >> 1) ^ gla_hV(r2)) << 1) | (c & 1)) * 16) + (p4 & 1) * 8));
                vf[s] = (bf16x8){lo[0], lo[1], lo[2], lo[3], hi[0], hi[1], hi[2], hi[3]}; }
            bf16x8 sf[2];
#pragma unroll
            for (int s = 0; s < 2; ++s) sf[s] = pack_8g(Sacc[2 * s], Sacc[2 * s + 1]);
            f32x4 oacc[4];
#pragma unroll
            for (int ct = 0; ct < 4; ++ct) {
                const int c = ct * 16 + fr; f32x4 d = fzero4();
#pragma unroll
                for (int s = 0; s < 2; ++s) {
                    const bf16x8 ab = *(const LAS bf16x8*)(att_i + c * 128 + (((s * 4 + g) ^ (c & 7)) * 16));
                    d = __builtin_amdgcn_mfma_f32_16x16x32_bf16(vf[s], ab, d, 0, 0, 0);
                    const s16x4 q0 = *(const LAS s16x4*)(qd_i + c * 128 + (((s * 4 + (g >> 1)) ^ (c & 7)) * 16) + (g & 1) * 8);
                    const s16x4 q1 = *(const LAS s16x4*)(qd_i + c * 128 + (((s * 4 + 2 + (g >> 1)) ^ (c & 7)) * 16) + (g & 1) * 8);
                    const bf16x8 qb = (bf16x8){q0[0], q0[1], q0[2], q0[3], q1[0], q1[1], q1[2], q1[3]};
                    d = __builtin_amdgcn_mfma_f32_16x16x32_bf16(sf[s], qb, d, 0, 0, 0); }
                oacc[ct] = d; }
#pragma unroll
            for (int rt = 0; rt < 4; ++rt) {
#pragma unroll
                for (int s = 0; s < 2; ++s) {
                    const int r1 = s * 32 + g * 8 + q4, r2 = r1 + 4; const int c = 2 * rt + (p4 >> 1);
                    const s16x4 lo = __builtin_amdgcn_ds_read_tr16_b64_v4i16((LAS s16x4*)(ki_t + r1 * 128 + (((((c >> 1) ^ gla_fT(r1)) << 1) | (c & 1)) * 16) + (p4 & 1) * 8));
                    const s16x4 hi = __builtin_amdgcn_ds_read_tr16_b64_v4i16((LAS s16x4*)(ki_t + r2 * 128 + (((((c >> 1) ^ gla_fT(r2)) << 1) | (c & 1)) * 16) + (p4 & 1) * 8));
                    const bf16x8 kf = (bf16x8){lo[0], lo[1], lo[2], lo[3], hi[0], hi[1], hi[2], hi[3]};
                    Sacc[rt] = __builtin_amdgcn_mfma_f32_16x16x32_bf16(kf, vf[s], Sacc[rt], 0, 0, 0); }
                const f32x4 eb = *(const LAS f32x4*)(bls + rt * 16 + g * 4);
                Sacc[rt] = Sacc[rt] * eb; }
#pragma unroll
            for (int ct = 0; ct < 4; ++ct) { float ss = oacc[ct][0] * oacc[ct][0] + oacc[ct][1] * oacc[ct][1] + oacc[ct][2] * oacc[ct][2] + oacc[ct][3] * oacc[ct][3];
                ss += __shfl_xor(ss, 16); ss += __shfl_xor(ss, 32);
                if (g == 0) pn[(ct * 16 + fr) * 8 + wid] = ss; }
            if (tid < 256 && c0 + 64 < SEQ) *(LAS f32x4*)(xs + (((c0 >> 6) + 1) & 1) * 1024 + tid * 4) = nxa;
            __syncthreads();
#pragma unroll
            for (int ct = 0; ct < 4; ++ct) { const int c = ct * 16 + fr;
                const f32x4 a0 = *(const LAS f32x4*)(pn + c * 8), a1 = *(const LAS f32x4*)(pn + c * 8 + 4);
                const float ss = (a0[0] + a0[1]) + (a0[2] + a0[3]) + (a1[0] + a1[1]) + (a1[2] + a1[3]);
                const float rs = rsqrtf(ss * (1.0f / 128.0f) + 1e-5f);
                const u32x2 gv = gate[ct];
                const float g0 = __uint_as_float(gv.x << 16), g1 = __uint_as_float(gv.x & 0xffff0000u), g2 = __uint_as_float(gv.y << 16), g3 = __uint_as_float(gv.y & 0xffff0000u);
                const float v0 = oacc[ct][0] * rs * ngv[0] * (g0 * fast_sigmoid(g0)), v1 = oacc[ct][1] * rs * ngv[1] * (g1 * fast_sigmoid(g1));
                const float v2 = oacc[ct][2] * rs * ngv[2] * (g2 * fast_sigmoid(g2)), v3 = oacc[ct][3] * rs * ngv[3] * (g3 * fast_sigmoid(g3));
                u32x2 w; w.x = cvt_pk_bf16(v0, v1); w.y = cvt_pk_bf16(v2, v3);
                *(u32x2*)(mix + (n0 + c) * DM + 512 + h * 128 + wid * 16 + g * 4) = w; }
        }
    }
#undef GLA_ISSUE
}

__device__ __forceinline__ void phase_mixer_even(const Params& p, LAS unsigned char* lds, int bid, int nb, int which) {
    for (int item = bid; item < 96; item += nb) {
        if (which != 2 && item < 64) rwkv3_item(p, lds, item); else if (which != 1 && item >= 64) gla2_item(p, lds, item - 64);
        __syncthreads();
    }
}

__device__ __forceinline__ void phase_rope(const Params& p, int bid, int nb) {
    const int tid = opaque_tid(), wid = tid >> 6, lane = tid & 63;
    unsigned char* ws = p.ws;
    const bf16_t* Pd = (const bf16_t*)(ws + OFF_PD);
    bf16_t* qr = (bf16_t*)(ws + OFF_BUF64); bf16_t* kr = (bf16_t*)(ws + OFF_KR); bf16_t* vv = (bf16_t*)(ws + OFF_VV);
    bf16_t* iqr = (bf16_t*)(ws + OFF_IQR); bf16_t* ikr = (bf16_t*)(ws + OFF_IKR); float* iw = (float*)(ws + OFF_IW);
    const float* c64 = (const float*)(ws + OFF_ROPE); const float* s64 = c64 + 4096 * 64; const float* c32 = s64 + 4096 * 64; const float* s32 = c32 + 4096 * 32;
    const float ikg = p.in[I_CIKG][lane], ikb = p.in[I_CIKB][lane];
    for (int n = bid * 8 + wid; n < NTOK; n += nb * 8) {
        const int pos = n & (SEQ - 1);
        const bf16_t* row = Pd + (size_t)n * NO_MAIN;
        const float c = c64[pos * 64 + lane], s = s64[pos * 64 + lane];
#pragma unroll
        for (int h = 0; h < 8; ++h) { const float z1 = bf2f(row[h * 128 + lane]), z2 = bf2f(row[h * 128 + 64 + lane]);
            qr[(size_t)n * 1024 + h * 128 + lane] = f2bf((z1 * c - z2 * s) * 0.08838834764831845f);
            qr[(size_t)n * 1024 + h * 128 + 64 + lane] = f2bf((z2 * c + z1 * s) * 0.08838834764831845f); }
        { const float z1 = bf2f(row[1024 + lane]), z2 = bf2f(row[1024 + 64 + lane]);
            kr[(size_t)n * 128 + lane] = f2bf(z1 * c - z2 * s); kr[(size_t)n * 128 + 64 + lane] = f2bf(z2 * c + z1 * s); }
        vv[(size_t)n * 128 + lane] = row[1152 + lane]; vv[(size_t)n * 128 + 64 + lane] = row[1152 + 64 + lane];
        const int j32 = lane & 31; const float cc = c32[pos * 32 + j32], ss = s32[pos * 32 + j32];
#pragma unroll
        for (int r = 0; r < 2; ++r) { const int h = (lane >> 5) + 2 * r; const float z1 = bf2f(row[1280 + h * 64 + j32]), z2 = bf2f(row[1280 + h * 64 + 32 + j32]);
            iqr[(size_t)n * 256 + h * 64 + j32] = f2bf((z1 * cc - z2 * ss) * 0.125f); iqr[(size_t)n * 256 + h * 64 + 32 + j32] = f2bf((z2 * cc + z1 * ss) * 0.125f); }
        { const float x = bf2f(row[1536 + lane]); const float mean = wave_sum(x) * (1.0f / 64.0f); const float d = x - mean; const float var = wave_sum(d * d) * (1.0f / 64.0f);
            const float y = d * rsqrtf(var + LN_EPS) * ikg + ikb; const float o = __shfl_xor(y, 32);
            const float res = lane < 32 ? (y * cc - o * ss) : (y * cc + o * ss);
            ikr[(size_t)n * 64 + lane] = f2bf(res); }
        if (lane < 4) iw[(size_t)n * 4 + lane] = bf2f(row[1600 + lane]) * 0.5f;
    }
}

__device__ __forceinline__ void phase_index(const Params& p, LAS unsigned char* lds, int bid, int nb) {
    const int tid = opaque_tid(), wid = tid >> 6, lane = tid & 63;
    unsigned char* ws = p.ws;
    const bf16_t* iqr = (const bf16_t*)(ws + OFF_IQR); const bf16_t* ikr = (const bf16_t*)(ws + OFF_IKR); const float* iw = (const float*)(ws + OFF_IW);
    unsigned short* idx = (unsigned short*)(ws + OFF_IDX);
    LAS unsigned* sc = (LAS unsigned*)lds + wid * 4096;
    LAS int* hist = (LAS int*)(lds + 131072) + wid * 256;
    LAS float* iqs = (LAS float*)(lds + 131072 + 8192) + wid * 256;
    const unsigned long long lt_mask = (1ull << lane) - 1ull;
    for (int n = bid * 8 + wid; n < NTOK; n += nb * 8) {
        const int t = n & (SEQ - 1), b = n >> 12, nv = t + 1;
        unsigned short* out = idx + (size_t)n * 256;
        if (nv <= 256) { for (int j = lane; j < 256; j += 64) out[j] = (unsigned short)(j < nv ? j : 0); continue; }
#pragma unroll
        for (int j = 0; j < 4; ++j) iqs[lane * 4 + j] = bf2f(iqr[(size_t)n * 256 + lane * 4 + j]);
        const float w0 = iw[(size_t)n * 4 + 0], w1 = iw[(size_t)n * 4 + 1], w2 = iw[(size_t)n * 4 + 2], w3 = iw[(size_t)n * 4 + 3];
        const int nvp = (nv + 63) & ~63;
        for (int c0 = 0; c0 < nvp; c0 += 64) {
            const int key = c0 + lane; const bool valid = key < nv;
            float kf[64];
            const u32x4* kp = (const u32x4*)(ikr + ((size_t)b * SEQ + (valid ? key : 0)) * 64);
#pragma unroll
            for (int q = 0; q < 8; ++q) { const u32x4 w = kp[q];
                kf[q * 8 + 0] = __uint_as_float(w.x << 16); kf[q * 8 + 1] = __uint_as_float(w.x & 0xffff0000u); kf[q * 8 + 2] = __uint_as_float(w.y << 16); kf[q * 8 + 3] = __uint_as_float(w.y & 0xffff0000u);
                kf[q * 8 + 4] = __uint_as_float(w.z << 16); kf[q * 8 + 5] = __uint_as_float(w.z & 0xffff0000u); kf[q * 8 + 6] = __uint_as_float(w.w << 16); kf[q * 8 + 7] = __uint_as_float(w.w & 0xffff0000u); }
            float sh[4];
#pragma unroll
            for (int h = 0; h < 4; ++h) { float a = 0.f;
#pragma unroll
                for (int d4 = 0; d4 < 16; ++d4) { const f32x4 qv = *(const LAS f32x4*)(iqs + h * 64 + d4 * 4); a += qv[0] * kf[d4 * 4] + qv[1] * kf[d4 * 4 + 1] + qv[2] * kf[d4 * 4 + 2] + qv[3] * kf[d4 * 4 + 3]; }
                sh[h] = fmaxf(a, 0.f); }
            float score = sh[0] * w0 + sh[1] * w1 + sh[2] * w2 + sh[3] * w3;
            score += 0.0f;
            unsigned u = __float_as_uint(score); u = (u & 0x80000000u) ? ~u : (u | 0x80000000u);
            sc[key] = valid ? u : 0u;
        }
        unsigned prefix = 0; int need = 256;
#pragma unroll 1
        for (int pass = 3; pass >= 0; --pass) {
            const int shift = pass * 8;
#pragma unroll
            for (int j = 0; j < 4; ++j) hist[lane * 4 + j] = 0;
            for (int c0 = 0; c0 < nvp; c0 += 64) { const unsigned u = sc[c0 + lane];
                const bool match = (c0 + lane < nv) && (pass == 3 || (u >> (shift + 8)) == prefix);
                if (match) __hip_atomic_fetch_add(hist + ((u >> shift) & 255u), 1, __ATOMIC_RELAXED, __HIP_MEMORY_SCOPE_WORKGROUP); }
            int hb[4];
#pragma unroll
            for (int j = 0; j < 4; ++j) hb[j] = hist[lane * 4 + j];
            const int tot = hb[0] + hb[1] + hb[2] + hb[3];
            int suf = tot;
#pragma unroll
            for (int off = 1; off < 64; off <<= 1) { const int v = __shfl_down(suf, off); if (lane + off < 64) suf += v; }
            const int above = suf - tot;
            const bool is = (above < need) && (need <= suf);
            int bin = 0, nneed = 0;
            if (is) { int c = above;
#pragma unroll
                for (int k = 3; k >= 0; --k) { if (nneed == 0) { if (need <= c + hb[k]) { bin = lane * 4 + k; nneed = need - c; } else c += hb[k]; } } }
            const unsigned long long bal = __ballot(is);
            const int src = __ffsll((long long)bal) - 1;
            bin = __shfl(bin, src); nneed = __shfl(nneed, src);
            prefix = (prefix << 8) | (unsigned)bin; need = nneed;
        }
        const unsigned T = prefix;
        int base = 0, ties = 0;
        for (int c0 = 0; c0 < nvp; c0 += 64) { const int key = c0 + lane; const unsigned u = sc[key]; const bool valid = key < nv;
            const bool gt = valid && u > T, eq = valid && u == T;
            const unsigned long long beq = __ballot(eq);
            const int rank = ties + __popcll(beq & lt_mask);
            const bool take = gt || (eq && rank < need);
            const unsigned long long bt = __ballot(take);
            const int pos = base + __popcll(bt & lt_mask);
            if (take && pos < 256) out[pos] = (unsigned short)key;
            base += __popcll(bt); ties += __popcll(beq); }
    }
}

__device__ __forceinline__ void phase_attn(const Params& p, LAS unsigned char* lds, int bid, int nb) {
    const int tid = opaque_tid(), wid = tid >> 6, lane = tid & 63;
    unsigned char* ws = p.ws;
    const bf16_t* qr = (const bf16_t*)(ws + OFF_BUF64); const bf16_t* kr = (const bf16_t*)(ws + OFF_KR); const bf16_t* vv = (const bf16_t*)(ws + OFF_VV);
    const unsigned short* idx = (const unsigned short*)(ws + OFF_IDX);
    bf16_t* ao = (bf16_t*)(ws + OFF_PD);
    LAS float* qs = (LAS float*)lds + wid * 1024;
    LAS float* ps = (LAS float*)(lds + 32768) + wid * 2048;
    LAS int* ks = (LAS int*)(lds + 32768 + 65536) + wid * 256;
    for (int n = bid * 8 + wid; n < NTOK; n += nb * 8) {
        const int t = n & (SEQ - 1), b = n >> 12, cnt = (t + 1) < 256 ? (t + 1) : 256;
        asm volatile("" ::: "memory");
#pragma unroll
        for (int j = 0; j < 16; ++j) qs[j * 64 + lane] = bf2f(qr[(size_t)n * 1024 + j * 64 + lane]);
#pragma unroll
        for (int r = 0; r < 4; ++r) ks[r * 64 + lane] = idx[(size_t)n * 256 + r * 64 + lane];
#pragma unroll 1
        for (int r = 0; r < 4; ++r) {
            const int j = r * 64 + lane; const bool valid = j < cnt; const int key = valid ? ks[j] : 0;
            const u32x4* kp = (const u32x4*)(kr + ((size_t)b * SEQ + key) * 128);
            float kf[128];
#pragma unroll
            for (int q = 0; q < 16; ++q) { const u32x4 w = kp[q];
                kf[q * 8 + 0] = __uint_as_float(w.x << 16); kf[q * 8 + 1] = __uint_as_float(w.x & 0xffff0000u); kf[q * 8 + 2] = __uint_as_float(w.y << 16); kf[q * 8 + 3] = __uint_as_float(w.y & 0xffff0000u);
                kf[q * 8 + 4] = __uint_as_float(w.z << 16); kf[q * 8 + 5] = __uint_as_float(w.z & 0xffff0000u); kf[q * 8 + 6] = __uint_as_float(w.w << 16); kf[q * 8 + 7] = __uint_as_float(w.w & 0xffff0000u); }
#pragma unroll 1
            for (int h = 0; h < 8; ++h) { float a = 0.f;
#pragma unroll
                for (int d4 = 0; d4 < 32; ++d4) { const f32x4 qv = *(const LAS f32x4*)(qs + h * 128 + d4 * 4);
                    a += qv[0] * kf[d4 * 4] + qv[1] * kf[d4 * 4 + 1] + qv[2] * kf[d4 * 4 + 2] + qv[3] * kf[d4 * 4 + 3]; }
                ps[h * 256 + j] = valid ? a : -INFINITY; }
        }
#pragma unroll
        for (int h = 0; h < 8; ++h) { float x[4]; float m = -INFINITY;
#pragma unroll
            for (int r = 0; r < 4; ++r) { x[r] = ps[h * 256 + r * 64 + lane]; m = fmaxf(m, x[r]); }
#pragma unroll
            for (int o = 32; o > 0; o >>= 1) m = fmaxf(m, __shfl_xor(m, o));
            float s = 0.f;
#pragma unroll
            for (int r = 0; r < 4; ++r) { x[r] = expf(x[r] - m); s += x[r]; }
            s = wave_sum(s); const float inv = 1.0f / s;
#pragma unroll
            for (int r = 0; r < 4; ++r) ps[h * 256 + r * 64 + lane] = x[r] * inv; }
        float o0[8], o1[8];
#pragma unroll
        for (int h = 0; h < 8; ++h) { o0[h] = 0.f; o1[h] = 0.f; }
        for (int j = 0; j < cnt; ++j) { const int key = ks[j];
            const unsigned w = *(const unsigned*)(vv + ((size_t)b * SEQ + key) * 128 + 2 * lane);
            const float v0 = __uint_as_float(w << 16), v1 = __uint_as_float(w & 0xffff0000u);
#pragma unroll
            for (int h = 0; h < 8; ++h) { const float pj = ps[h * 256 + j]; o0[h] += pj * v0; o1[h] += pj * v1; } }
#pragma unroll
        for (int h = 0; h < 8; ++h) *(unsigned*)(ao + (size_t)n * 1024 + h * 128 + 2 * lane) = cvt_pk_bf16(o0[h], o1[h]);
    }
}

__device__ __forceinline__ int idx_bin(float s, float lo, float scale) { int b = (int)((s - lo) * scale); b = b < 0 ? 0 : b; return b > 255 ? 255 : b; }
__device__ __forceinline__ unsigned ord_key(float s) { const unsigned u = __float_as_uint(s); return (u & 0x80000000u) ? ~u : (u | 0x80000000u); }
__device__ __forceinline__ float ord_val(unsigned k) { return __uint_as_float((k & 0x80000000u) ? (k & 0x7fffffffu) : ~k); }
__device__ __forceinline__ void phase_index2(const Params& p, LAS unsigned char* lds, int bid, int nb) {
    const int tid = opaque_tid(), wid = tid >> 6, lane = tid & 63, fr = lane & 15, g = lane >> 4;
    unsigned char* ws = p.ws;
    const bf16_t* iqr = (const bf16_t*)(ws + OFF_IQR); const bf16_t* ikr = (const bf16_t*)(ws + OFF_IKR); const float* iw = (const float*)(ws + OFF_IW);
    unsigned short* idx = (unsigned short*)(ws + OFF_IDX);
    LAS float* sc = (LAS float*)lds;
    LAS int* hist = (LAS int*)(lds + 131072) + wid * 256;
    LAS float* candv = (LAS float*)(lds + 131072 + 8192) + wid * 264;
    LAS unsigned short* candi = (LAS unsigned short*)(lds + 131072 + 8192 + 8 * 264 * 4) + wid * 256;
    LAS unsigned* mm = (LAS unsigned*)(lds + 131072 + 8192 + 8 * 264 * 4 + 8 * 512);
    const unsigned long long lt_mask = (1ull << lane) - 1ull;
    const int ntile = NTOK / 8;
    PROBE_DECL;
    PROBE_BEGIN(9);
    for (int it = bid; it < ntile; it += nb) {
        const int round = it / nb, qt = (round & 1) ? (round * nb + (nb - 1 - (it - round * nb))) : it;
        const int n0 = qt * 8, t0 = n0 & (SEQ - 1), b = n0 >> 12;
        asm volatile("" ::: "memory");
        if (tid < 16) mm[tid] = (tid & 1) ? 0u : 0xffffffffu;
        __syncthreads();
        PROBE_BEGIN(1);
#pragma unroll 1
        for (int genrep = 0; genrep < (IDXPROBE == 1 ? 2 : 1); ++genrep)
        if (t0 + 8 > 256) {
            bf16x8 af[2][2];
#pragma unroll
            for (int hh = 0; hh < 2; ++hh)
#pragma unroll
                for (int s = 0; s < 2; ++s) af[hh][s] = *(const bf16x8*)(iqr + (size_t)(n0 + 2 * (fr >> 2) + ((fr >> 1) & 1)) * 256 + (2 * hh + (fr & 1)) * 64 + s * 32 + g * 8);
            const f32x4 wq0 = *(const f32x4*)(iw + (size_t)(n0 + 2 * g) * 4), wq1 = *(const f32x4*)(iw + (size_t)(n0 + 2 * g + 1) * 4);
            float vmin0 = INFINITY, vmax0 = -INFINITY, vmin1 = INFINITY, vmax1 = -INFINITY;
            const int nkt = (t0 + 8 + 15) >> 4;
            const bf16_t* kb = ikr + (size_t)b * SEQ * 64;
            bf16x8 pb0[3], pb1[3];
#pragma unroll
            for (int i = 0; i < 2; ++i) { const int ktp = wid + 8 * i < nkt ? wid + 8 * i : wid; const bf16_t* kp = kb + (size_t)(ktp * 16 + fr) * 64 + g * 8; pb0[i] = *(const bf16x8*)kp; pb1[i] = *(const bf16x8*)(kp + 32); }
            for (int kt = wid; kt < nkt; kt += 8) {
                { const int ktp = kt + 16 < nkt ? kt + 16 : kt; const bf16_t* kp = kb + (size_t)(ktp * 16 + fr) * 64 + g * 8; pb0[2] = *(const bf16x8*)kp; pb1[2] = *(const bf16x8*)(kp + 32); }
                const bf16x8 b0 = pb0[0], b1 = pb1[0];
                pb0[0] = pb0[1]; pb1[0] = pb1[1]; pb0[1] = pb0[2]; pb1[1] = pb1[2];
                f32x4 d0 = fzero4(), d1 = fzero4();
                d0 = __builtin_amdgcn_mfma_f32_16x16x32_bf16(af[0][0], b0, d0, 0, 0, 0); d0 = __builtin_amdgcn_mfma_f32_16x16x32_bf16(af[0][1], b1, d0, 0, 0, 0);
                d1 = __builtin_amdgcn_mfma_f32_16x16x32_bf16(af[1][0], b0, d1, 0, 0, 0); d1 = __builtin_amdgcn_mfma_f32_16x16x32_bf16(af[1][1], b1, d1, 0, 0, 0);
                float s0 = fmaxf(d0[0], 0.f) * wq0[0] + fmaxf(d0[1], 0.f) * wq0[1] + fmaxf(d1[0], 0.f) * wq0[2] + fmaxf(d1[1], 0.f) * wq0[3];
                float s1 = fmaxf(d0[2], 0.f) * wq1[0] + fmaxf(d0[3], 0.f) * wq1[1] + fmaxf(d1[2], 0.f) * wq1[2] + fmaxf(d1[3], 0.f) * wq1[3];
                s0 += 0.0f; s1 += 0.0f;
                vmin0 = fminf(vmin0, s0); vmax0 = fmaxf(vmax0, s0); vmin1 = fminf(vmin1, s1); vmax1 = fmaxf(vmax1, s1);
                sc[(2 * g) * 4096 + kt * 16 + fr] = s0; sc[(2 * g + 1) * 4096 + kt * 16 + fr] = s1;
            }
#pragma unroll
            for (int j = 0; j < 2; ++j) { float mn = j ? vmin1 : vmin0, mx = j ? vmax1 : vmax0;
                mn = fminf(mn, dppf<0xB1>(mn)); mn = fminf(mn, dppf<0x4E>(mn)); mn = fminf(mn, dppf<0x141>(mn)); mn = fminf(mn, dppf<0x140>(mn));
                mx = fmaxf(mx, dppf<0xB1>(mx)); mx = fmaxf(mx, dppf<0x4E>(mx)); mx = fmaxf(mx, dppf<0x141>(mx)); mx = fmaxf(mx, dppf<0x140>(mx));
                if (fr == 0 && mx >= mn) { const int q = 2 * g + j;
                    __hip_atomic_fetch_min(mm + q * 2, ord_key(mn), __ATOMIC_RELAXED, __HIP_MEMORY_SCOPE_WORKGROUP); __hip_atomic_fetch_max(mm + q * 2 + 1, ord_key(mx), __ATOMIC_RELAXED, __HIP_MEMORY_SCOPE_WORKGROUP); } }
        }
        PROBE_END(1);
        PROBE_BEGIN(2);
        __syncthreads();
        PROBE_END(2);
        PROBE_BEGIN(7);
#pragma unroll 1
        for (int selrep = 0; selrep < (IDXPROBE == 2 ? 2 : 1); ++selrep)
        {
            const int n = n0 + wid, t = t0 + wid, nv = t + 1;
            unsigned short* out = idx + (size_t)n * 256;
            if (nv <= 256) { for (int j = lane; j < 256; j += 64) out[j] = (unsigned short)(j < nv ? j : 0); }
            else {
                LAS const float* srow = sc + wid * 4096;
                const int nvp = (nv + 255) & ~255;
                const unsigned kmax = mm[wid * 2 + 1];
                const int kbase = (int)(kmax >> 19) - 255;
                unsigned P = 0u; int sh = 32;
                bool capped = false;
                float lo = ord_val(mm[wid * 2]), hi = ord_val(mm[wid * 2 + 1]);
                float lo1 = 0.f, sc1 = 0.f, lo2 = 0.f, sc2 = 0.f, lo3 = 0.f, sc3 = 0.f; int b1 = 0, b2 = 0, b3 = 0, nlev = 0;
                int m = nv, need = 256;
#define IDX_HIST_SCAN(bin, nneed, mmc, lumpc) do { int hb[4]; \
                    _Pragma("unroll") for (int j = 0; j < 4; ++j) hb[j] = hist[lane * 4 + j]; \
                    if (lane == 0) hb[0] += (lumpc); \
                    const int tot = hb[0] + hb[1] + hb[2] + hb[3]; int suf = tot; \
                    _Pragma("unroll") for (int off = 1; off < 64; off <<= 1) { const int v = __shfl_down(suf, off); if (lane + off < 64) suf += v; } \
                    const int above = suf - tot; const bool is = (above < need) && (need <= suf); \
                    bin = 0; nneed = 0; mmc = 0; \
                    if (is) { int c = above; \
                        _Pragma("unroll") for (int k = 3; k >= 0; --k) { if (nneed == 0) { if (need <= c + hb[k]) { bin = lane * 4 + k; nneed = need - c; mmc = hb[k]; } else c += hb[k]; } } } \
                    const unsigned long long bal = __ballot(is); const int srcl = __ffsll((long long)bal) - 1; \
                    bin = __shfl(bin, srcl); nneed = __shfl(nneed, srcl); mmc = __shfl(mmc, srcl); } while (0)
#define IDX_ZERO_HIST() do { int z = 0; asm volatile("" : "+v"(z)); _Pragma("unroll") for (int j = 0; j < 4; ++j) hist[lane * 4 + j] = z; } while (0)
                PROBE_BEGIN(3);
                {
                    IDX_ZERO_HIST();
                    int lumpl = 0;
                    for (int c0 = 0; c0 < nvp; c0 += 256) { const f32x4 s4 = *(const LAS f32x4*)(srow + c0 + lane * 4);
#pragma unroll
                        for (int e_ = 0; e_ < 4; ++e_) { const unsigned k = ord_key(s4[e_]); const int bin = (int)(k >> 19) - kbase; const bool valid = c0 + lane * 4 + e_ < nv;
                            if (valid && bin > 0) __hip_atomic_fetch_add(hist + bin, 1, __ATOMIC_RELAXED, __HIP_MEMORY_SCOPE_WORKGROUP);
                            lumpl += (valid && bin <= 0) ? 1 : 0; } }
                    int lump = lumpl;
#pragma unroll
                    for (int o = 32; o > 0; o >>= 1) lump += __shfl_xor(lump, o);
                    int bin, nneed, mmc; IDX_HIST_SCAN(bin, nneed, mmc, lump);
                    need = nneed; m = mmc;
                    if (bin > 0) { P = (unsigned)(kbase + bin); sh = 19; }
                    else { capped = true; hi = ord_val(((unsigned)(kbase + 1) << 19) - 1u); if (hi < lo) hi = lo; }
                }
                PROBE_END(3);
                PROBE_BEGIN(4);
#pragma unroll 1
                while (!capped && m > 128 && sh > 0) {
                    const int nsh = sh > 8 ? sh - 8 : 0; const unsigned dmask = (1u << (sh - nsh)) - 1u;
                    IDX_ZERO_HIST();
                    for (int c0 = 0; c0 < nvp; c0 += 256) { const f32x4 s4 = *(const LAS f32x4*)(srow + c0 + lane * 4);
#pragma unroll
                        for (int e_ = 0; e_ < 4; ++e_) { const unsigned k = ord_key(s4[e_]);
                            if (c0 + lane * 4 + e_ < nv && (k >> sh) == P) __hip_atomic_fetch_add(hist + ((k >> nsh) & dmask), 1, __ATOMIC_RELAXED, __HIP_MEMORY_SCOPE_WORKGROUP); } }
                    int bin, nneed, mmc; IDX_HIST_SCAN(bin, nneed, mmc, 0);
                    P = (P << (sh - nsh)) | (unsigned)bin; sh = nsh; need = nneed; m = mmc;
                }
#define IDX_CLASSIFY(s, cls) do { \
                    if (!capped) { const unsigned kk_ = sh >= 32 ? 0u : (ord_key(s) >> sh); cls = kk_ > P ? 2 : (kk_ == P ? 1 : 0); } \
                    else if ((int)(ord_key(s) >> 19) > kbase) cls = 2; \
                    else { cls = 1; \
                        if (nlev >= 1) { const int bb = idx_bin(s, lo1, sc1); if (bb != b1) cls = bb > b1 ? 2 : 0; } \
                        if (cls == 1 && nlev >= 2) { const int bb = idx_bin(s, lo2, sc2); if (bb != b2) cls = bb > b2 ? 2 : 0; } \
                        if (cls == 1 && nlev >= 3) { const int bb = idx_bin(s, lo3, sc3); if (bb != b3) cls = bb > b3 ? 2 : 0; } } } while (0)
#pragma unroll 1
                while (capped && m > 128 && nlev < 3 && (hi - lo) > 1e-30f) {
                    const float width = hi - lo, scale = 256.0f / width;
                    IDX_ZERO_HIST();
                    for (int c0 = 0; c0 < nvp; c0 += 256) { const f32x4 s4 = *(const LAS f32x4*)(srow + c0 + lane * 4);
#pragma unroll
                        for (int e_ = 0; e_ < 4; ++e_) { const float s = s4[e_]; int cls; IDX_CLASSIFY(s, cls);
                            if (c0 + lane * 4 + e_ < nv && cls == 1) __hip_atomic_fetch_add(hist + idx_bin(s, lo, scale), 1, __ATOMIC_RELAXED, __HIP_MEMORY_SCOPE_WORKGROUP); } }
                    int bin, nneed, mmc; IDX_HIST_SCAN(bin, nneed, mmc, 0);
                    if (nlev == 0) { lo1 = lo; sc1 = scale; b1 = bin; } else if (nlev == 1) { lo2 = lo; sc2 = scale; b2 = bin; } else { lo3 = lo; sc3 = scale; b3 = bin; }
                    ++nlev; need = nneed; m = mmc;
                    const float w = width * (1.0f / 256.0f); lo = lo + (float)bin * w; hi = lo + w;
                }
#undef IDX_HIST_SCAN
#undef IDX_ZERO_HIST
                PROBE_END(4);
                PROBE_BEGIN(5);
                int base = 0, nc = 0;
                for (int c0 = 0; c0 < nvp; c0 += 256) { const f32x4 s4 = *(const LAS f32x4*)(srow + c0 + lane * 4);
                    bool su[4], ca[4]; int nsu = 0, nca = 0;
#pragma unroll
                    for (int e_ = 0; e_ < 4; ++e_) { const bool valid = c0 + lane * 4 + e_ < nv; int cls; IDX_CLASSIFY(s4[e_], cls); su[e_] = valid && cls == 2; ca[e_] = valid && cls == 1; nsu += su[e_] ? 1 : 0; nca += ca[e_] ? 1 : 0; }
                    unsigned long long bs4[4], bc4[4]; int ps = base, pc = nc, tots = 0, totc = 0;
#pragma unroll
                    for (int e_ = 0; e_ < 4; ++e_) { bs4[e_] = __ballot(su[e_]); bc4[e_] = __ballot(ca[e_]); ps += __popcll(bs4[e_] & lt_mask); pc += __popcll(bc4[e_] & lt_mask); tots += __popcll(bs4[e_]); totc += __popcll(bc4[e_]); }
#pragma unroll
                    for (int e_ = 0; e_ < 4; ++e_) { const int key = c0 + lane * 4 + e_;
                        if (su[e_]) { if (ps < 256) out[ps] = (unsigned short)key; ++ps; }
                        if (ca[e_]) { if (pc < 256) { candv[pc] = s4[e_]; candi[pc] = (unsigned short)key; } ++pc; } }
                    base += tots; nc += totc; }
#undef IDX_CLASSIFY
                PROBE_END(5);
                PROBE_BEGIN(6);
                const int mcap = nc < 256 ? nc : 256;
                float T = -INFINITY; int need_t = need;
                if (nc <= 256) {
                    float mine[4]; int cgt[4], cge[4];
#pragma unroll
                    for (int k = 0; k < 4; ++k) { mine[k] = (lane + 64 * k) < mcap ? candv[lane + 64 * k] : -INFINITY; cgt[k] = 0; cge[k] = 0; }
                    if (lane < 4 && mcap + lane < 260) candv[mcap + lane] = -INFINITY;
                    const int nk = (mcap + 63) >> 6;
                    for (int j = 0; j < mcap; j += 4) { const f32x4 vj = *(const LAS f32x4*)(candv + j);
#pragma unroll
                        for (int k = 0; k < 4; ++k) { if (k < nk) {
#pragma unroll
                            for (int e_ = 0; e_ < 4; ++e_) { cgt[k] += vj[e_] > mine[k] ? 1 : 0; cge[k] += vj[e_] >= mine[k] ? 1 : 0; } } } }
                    float tv = -INFINITY; int tg = 0; bool isT = false;
#pragma unroll
                    for (int k = 0; k < 4; ++k) { const bool ok = ((lane + 64 * k) < mcap) && (cgt[k] < need) && (need <= cge[k]); if (ok && !isT) { isT = true; tv = mine[k]; tg = cgt[k]; } }
                    const unsigned long long bT = __ballot(isT);
                    const int sl = __ffsll((long long)bT) - 1;
                    T = __shfl(tv, sl); need_t = need - __shfl(tg, sl);
                }
                int ties = 0;
                for (int c0 = 0; c0 < mcap; c0 += 64) { const int j = c0 + lane; const bool valid = j < mcap; const float s = valid ? candv[j] : -INFINITY;
                    const bool sure = valid && (nc <= 256) && s > T;
                    const bool tie = valid && ((nc <= 256) ? (s == T) : true);
                    const unsigned long long beq = __ballot(tie);
                    const int rank = ties + __popcll(beq & lt_mask);
                    const bool take = sure || (tie && rank < need_t);
                    const unsigned long long bt = __ballot(take);
                    const int pos = base + __popcll(bt & lt_mask);
                    if (take && pos < 256) out[pos] = candi[j];
                    base += __popcll(bt); ties += __popcll(beq); }
                PROBE_END(6);
            }
        }
        PROBE_END(7);
        PROBE_BEGIN(8);
        __syncthreads();
        PROBE_END(8);
    }
    PROBE_END(9);
    PROBE_STORE(ws, bid, tid);
}

__device__ __forceinline__ void phase_attn2(const Params& p, LAS unsigned char* lds, int bid, int nb) {
    const int tid = opaque_tid(), wid = tid >> 6, lane = tid & 63, fr = lane & 15, g = lane >> 4;
    unsigned char* ws = p.ws;
    const bf16_t* qr = (const bf16_t*)(ws + OFF_BUF64); const bf16_t* kr = (const bf16_t*)(ws + OFF_KR); const bf16_t* vv = (const bf16_t*)(ws + OFF_VV);
    const unsigned short* idx = (const unsigned short*)(ws + OFF_IDX);
    bf16_t* ao = (bf16_t*)(ws + OFF_PD);
    LAS unsigned char* vbuf = lds + wid * 16384;
    LAS unsigned short* ks = (LAS unsigned short*)(lds + 131072) + wid * 256;
    const int q4 = fr >> 2, p4 = fr & 3;
    for (int n = bid * 8 + wid; n < NTOK; n += nb * 8) {
        const int t = n & (SEQ - 1), b = n >> 12, cnt = (t + 1) < 256 ? (t + 1) : 256;
        asm volatile("" ::: "memory");
        *(LAS u32x2*)(ks + lane * 4) = *(const u32x2*)(idx + (size_t)n * 256 + lane * 4);
        bf16x8 qf[4];
#pragma unroll
        for (int s = 0; s < 4; ++s) { qf[s] = (bf16x8){0, 0, 0, 0, 0, 0, 0, 0}; if (fr < 8) qf[s] = *(const bf16x8*)(qr + (size_t)n * 1024 + fr * 128 + s * 32 + g * 8); }
        const bf16_t* kbase = kr + (size_t)b * SEQ * 128; const bf16_t* vbase = vv + (size_t)b * SEQ * 128;
        f32x4 acc[16];
#pragma unroll
        for (int tl = 0; tl < 16; ++tl) {
            const int j = tl * 16 + fr; const int key = j < cnt ? (int)ks[j] : 0;
            const bf16_t* kp = kbase + (size_t)key * 128 + g * 8;
            bf16x8 kf[4];
#pragma unroll
            for (int s = 0; s < 4; ++s) kf[s] = *(const bf16x8*)(kp + s * 32);
            f32x4 a = fzero4();
#pragma unroll
            for (int s = 0; s < 4; ++s) a = __builtin_amdgcn_mfma_f32_16x16x32_bf16(kf[s], qf[s], a, 0, 0, 0);
            acc[tl] = a;
        }
        float m = -INFINITY;
#pragma unroll
        for (int tl = 0; tl < 16; ++tl)
#pragma unroll
            for (int r = 0; r < 4; ++r) { if (tl * 16 + g * 4 + r >= cnt) acc[tl][r] = -INFINITY; m = fmaxf(m, acc[tl][r]); }
        m = fmaxf(m, __shfl_xor(m, 16)); m = fmaxf(m, __shfl_xor(m, 32));
        float sum = 0.f;
#pragma unroll
        for (int tl = 0; tl < 16; ++tl)
#pragma unroll
            for (int r = 0; r < 4; ++r) { const float e = __expf(acc[tl][r] - m); acc[tl][r] = e; sum += e; }
        sum += __shfl_xor(sum, 16); sum += __shfl_xor(sum, 32);
        const float inv = 1.0f / sum;
        bf16x8 pf[8];
#pragma unroll
        for (int s = 0; s < 8; ++s) { u32x4 w; w.x = cvt_pk_bf16(acc[2 * s][0], acc[2 * s][1]); w.y = cvt_pk_bf16(acc[2 * s][2], acc[2 * s][3]);
            w.z = cvt_pk_bf16(acc[2 * s + 1][0], acc[2 * s + 1][1]); w.w = cvt_pk_bf16(acc[2 * s + 1][2], acc[2 * s + 1][3]); pf[s] = __builtin_bit_cast(bf16x8, w); }
        f32x4 o[8];
#pragma unroll
        for (int dt = 0; dt < 8; ++dt) o[dt] = fzero4();
#pragma unroll
        for (int s = 0; s < 8; ++s) {
            LAS unsigned char* vb = vbuf + (s & 1) * 8192;
#pragma unroll
            for (int i = 0; i < 8; ++i) { const int kl = i * 4 + g, cp = fr; const int jj = s * 32 + kl; const int key = jj < cnt ? (int)ks[jj] : 0;
                const int c = cp ^ ((kl & 7) << 1);
                const u32x4 val = *(const u32x4*)(vbase + (size_t)key * 128 + c * 8);
                *(LAS u32x4*)(vb + kl * 256 + cp * 16) = val; }
            const int kl1 = 4 * g + q4, kl2 = 16 + 4 * g + q4;
#pragma unroll
            for (int dt = 0; dt < 8; ++dt) {
                const int c = 2 * dt + (p4 >> 1);
                const s16x4 lo = __builtin_amdgcn_ds_read_tr16_b64_v4i16((LAS s16x4*)(vb + kl1 * 256 + ((c ^ ((kl1 & 7) << 1)) * 16) + (p4 & 1) * 8));
                const s16x4 hi = __builtin_amdgcn_ds_read_tr16_b64_v4i16((LAS s16x4*)(vb + kl2 * 256 + ((c ^ ((kl2 & 7) << 1)) * 16) + (p4 & 1) * 8));
                const bf16x8 af = (bf16x8){lo[0], lo[1], lo[2], lo[3], hi[0], hi[1], hi[2], hi[3]};
                o[dt] = __builtin_amdgcn_mfma_f32_16x16x32_bf16(af, pf[s], o[dt], 0, 0, 0);
            }
        }
        if (fr < 8) {
#pragma unroll
            for (int dt = 0; dt < 8; ++dt) { u32x2 w; w.x = cvt_pk_bf16(o[dt][0] * inv, o[dt][1] * inv); w.y = cvt_pk_bf16(o[dt][2] * inv, o[dt][3] * inv);
                *(u32x2*)(ao + (size_t)n * 1024 + fr * 128 + dt * 16 + g * 4) = w; }
        }
    }
}

__device__ __forceinline__ void phase_inproj_even(const Params& p, LAS unsigned char* lds, int bid, int nb) {
    unsigned char* ws = p.ws;
    pg::DenseSched S; S.init(ws + OFF_BUF64, ws + OFF_WINE, NTOK, NE_MAIN, 1024, nb, bid);
    pg::EpiBf16 E; E.O = (bf16_t*)(ws + OFF_P); E.ldc = NE_MAIN;
    pg::gemm_phase(lds, 1024, S, E);
}
__device__ __forceinline__ void phase_inproj_odd(const Params& p, LAS unsigned char* lds, int bid, int nb) {
    unsigned char* ws = p.ws;
    pg::DenseSched S; S.init(ws + OFF_BUF64, ws + OFF_WINO, NTOK, NO_MAIN, 1024, nb, bid);
    pg::EpiBf16 E; E.O = (bf16_t*)(ws + OFF_PD); E.ldc = NO_MAIN;
    pg::gemm_phase(lds, 1024, S, E);
}
__device__ __forceinline__ void phase_outproj(const Params& p, LAS unsigned char* lds, int bid, int nb, size_t aoff, size_t woff, const float* X) {
    unsigned char* ws = p.ws;
    pg::DenseSched S; S.init(ws + aoff, ws + woff, NTOK, 1024, 1024, nb, bid);
    pg::EpiResid E; E.X = X; E.U = (float*)(ws + OFF_U);
    pg::gemm_phase(lds, 1024, S, E);
}

__device__ __forceinline__ void grid_barrier(unsigned* ctr, unsigned target) {
    asm volatile("s_waitcnt vmcnt(0) lgkmcnt(0)" ::: "memory");
    __syncthreads();
    if (threadIdx.x == 0) {
        __builtin_amdgcn_fence(__ATOMIC_RELEASE, "agent");
        asm volatile("s_waitcnt vmcnt(0)" ::: "memory");
        __hip_atomic_fetch_add(ctr, 1u, __ATOMIC_RELAXED, __HIP_MEMORY_SCOPE_AGENT);
        while (__hip_atomic_load(ctr, __ATOMIC_RELAXED, __HIP_MEMORY_SCOPE_AGENT) < target) __builtin_amdgcn_s_sleep(1);
        __builtin_amdgcn_fence(__ATOMIC_ACQUIRE, "agent");
        asm volatile("s_waitcnt vmcnt(0)" ::: "memory");
    }
    __syncthreads();
}
#ifndef DUP
#define DUP 0
#endif
#define GSYNC() do { bar_target += nb0u; grid_barrier(bar_ctr, bar_target); } while (0)
__global__ __launch_bounds__(512, 2) void mega(KArgs a) {
    extern __shared__ __attribute__((aligned(16))) unsigned char smem[];
    LAS unsigned char* lds = (LAS unsigned char*)smem;
    Params p; p.in.t = (LAS const unsigned long long*)(lds + PTAB_OFF); p.out = a.out; p.ws = a.ws;
    if ((threadIdx.x & 63) == 0) ((LAS int*)(lds + WTAB_OFF))[hw_slot()] = threadIdx.x >> 6;
    if (threadIdx.x == 0) { LAS unsigned long long* tw_ = (LAS unsigned long long*)(lds + PTAB_OFF);
#pragma unroll
        for (int i = 0; i < 30; ++i) tw_[i] = (unsigned long long)a.in[i]; }
    __syncthreads();
    cg::grid_group grid = cg::this_grid();
    const int bid0 = blockIdx.x, nb0 = gridDim.x;
    unsigned* bar_ctr = (unsigned*)(p.ws + OFF_MISC + MISC_BAR); unsigned bar_target = 0; const unsigned nb0u = gridDim.x;
    if (blockIdx.x == 0 && threadIdx.x == 0) __hip_atomic_store(bar_ctr, 0u, __ATOMIC_RELAXED, __HIP_MEMORY_SCOPE_AGENT);
    grid.sync();
    int bid, nb;
#define FRESH() do { bid = bid0; nb = nb0; asm volatile("" : "+s"(bid), "+s"(nb)); } while (0)
#define PHP(pid, call) do { unsigned long long t0_ = 0; if (PROBE_ID == (pid)) t0_ = __builtin_amdgcn_s_memtime(); call; if (PROBE_ID == (pid) && bid0 == (PROBE_BLK) && opaque_tid() == 0) *(float*)(p.ws + OFF_MISC + MISC_PROBE) = (float)(__builtin_amdgcn_s_memtime() - t0_) * 5e-8f; } while (0)
#define RUNP(id, call) do { FRESH(); call; GSYNC(); if (DUP == id) { FRESH(); call; GSYNC(); } } while (0)
    RUNP(10, PHP(30, phase_prep(p, lds, bid, nb)));
#if PROBE_ID == 20
    const unsigned long long kstart = __builtin_amdgcn_s_memtime();
#endif
#pragma unroll 1
    for (int layer = 0; layer < 2; ++layer) {
        if (layer == 0) {
            FRESH(); PHP(31, phase_inproj_even(p, lds, bid, nb));
            FRESH(); PHP(32, phase_gla_alpha(p, lds, bid, nb));
            GSYNC();
            if (DUP == 11) { FRESH(); phase_inproj_even(p, lds, bid, nb); GSYNC(); }
            if (DUP == 12) { FRESH(); phase_gla_alpha(p, lds, bid, nb); GSYNC(); }
            RUNP(1, PHP(33, phase_mixer_even(p, lds, bid, nb, 0)));
            RUNP(13, PHP(34, phase_rwkv_epi(p, bid, nb)));
        } else {
            RUNP(14, PHP(40, phase_inproj_odd(p, lds, bid, nb)));
            RUNP(15, PHP(41, phase_rope(p, bid, nb)));
            RUNP(2, PHP(43, phase_index2(p, lds, bid, nb)));
            RUNP(3, PHP(42, phase_attn2(p, lds, bid, nb)));
        }
        RUNP(16, PHP(35, phase_outproj(p, lds, bid, nb, layer ? OFF_PD : OFF_BUF64, layer ? OFF_WOUTO : OFF_WOUTE, layer ? p.out : p.in[I_X])));
        FRESH(); PHP(36, phase_ln_route(p, lds, bid, nb, layer));
        GSYNC();
        RUNP(17, PHP(37, phase_moe_gateup(p, lds, bid, nb, layer)));
        RUNP(18, PHP(38, phase_moe_down(p, lds, bid, nb, layer)));
#if PROBE_ID == 20
        if (layer == 1) { if (bid0 == 7 && threadIdx.x == 0) *(float*)(p.ws + OFF_MISC + MISC_PROBE) = (float)(__builtin_amdgcn_s_memtime() - kstart) * 1e-8f; GSYNC(); }
#endif
        RUNP(19, PHP(39, phase_ln2(p, bid, nb, layer, p.out, true)));
    }
}

extern "C" void kernel_launch(void* const* d_in, const int* in_sizes, int n_in, void* d_out, int out_size, void* d_ws, size_t ws_size, hipStream_t stream) {
    if (ws_size < WS_NEED) { fprintf(stderr, "workspace too small: %zu < %zu\n", ws_size, (size_t)WS_NEED); return; }
    KArgs p{};
    for (int i = 0; i < 30; ++i) p.in[i] = (const float*)d_in[i];
    p.out = (float*)d_out; p.ws = (unsigned char*)d_ws;
    static int grid_blocks = 0;
    if (!grid_blocks) {
        (void)hipFuncSetAttribute((const void*)mega, hipFuncAttributeMaxDynamicSharedMemorySize, LDS_BYTES);
        int dev = 0, cus = 0, per_cu = 0;
        (void)hipGetDevice(&dev);
        (void)hipDeviceGetAttribute(&cus, hipDeviceAttributeMultiprocessorCount, dev);
        (void)hipOccupancyMaxActiveBlocksPerMultiprocessor(&per_cu, mega, 512, LDS_BYTES);
        if (per_cu < 1) { fprintf(stderr, "occupancy query returned %d\n", per_cu); per_cu = 1; }
        grid_blocks = cus;
    }
    void* args[] = {&p};
    hipError_t e = hipLaunchCooperativeKernel((void*)mega, dim3(grid_blocks), dim3(512), args, LDS_BYTES, stream);
    if (e != hipSuccess) fprintf(stderr, "cooperative launch failed: %s (grid %d)\n", hipGetErrorString(e), grid_blocks);
}
```

```cpp
#include <hip/hip_runtime.h>
#include <hip/hip_cooperative_groups.h>
#include <cstdio>
#include <cstdint>
namespace cg = cooperative_groups;

#ifndef PROBE_ID
#define PROBE_ID 0
#endif
#ifndef PROBE_BLK
#define PROBE_BLK 7
#endif
#ifndef IDXPROBE
#define IDXPROBE 0
#endif
#ifndef SANITIZE
#define SANITIZE 0
#endif
#ifndef PREP_REP
#define PREP_REP 1
#endif
constexpr int NTOK = 32768, SEQ = 4096, NB = 8, DM = 1024;
constexpr int EVEN_COLS = 3344, ODD_COLS = 1604;
constexpr int NE_MAIN = 3328;
constexpr int NO_MAIN = 1792;
constexpr int NEXP = 16, DEXP = 256;
constexpr float DN_ALPHA = 1.4142135623730951f;
constexpr float LN_EPS = 1e-5f;
constexpr int MOE_ROWS = 65536 + 16 * 256;

typedef unsigned short bf16_t;
typedef short bf16x8 __attribute__((ext_vector_type(8)));
typedef float f32x4 __attribute__((ext_vector_type(4)));
typedef short s16x4 __attribute__((ext_vector_type(4)));
typedef float f32x2 __attribute__((ext_vector_type(2)));
typedef unsigned u32x4 __attribute__((ext_vector_type(4)));
typedef unsigned u32x2 __attribute__((ext_vector_type(2)));
#define LAS __attribute__((address_space(3)))

typedef __bf16 bf16x2_t __attribute__((ext_vector_type(2)));
__device__ __forceinline__ unsigned cvt_pk_bf16(float lo, float hi) { bf16x2_t v; v[0] = (__bf16)lo; v[1] = (__bf16)hi; return __builtin_bit_cast(unsigned, v); }
__device__ __forceinline__ bf16_t f2bf(float f) { return (bf16_t)(cvt_pk_bf16(f, 0.f) & 0xffffu); }
__device__ __forceinline__ float bf2f(bf16_t h) { return __uint_as_float(((unsigned)h) << 16); }
constexpr int LDS_BYTES = 160 * 1024;
constexpr int PTAB_OFF = LDS_BYTES - 256;
constexpr int WTAB_OFF = LDS_BYTES - 512;
__device__ __forceinline__ int hw_slot() { return (int)(__builtin_amdgcn_s_getreg(0x2804) & 63u); }
__device__ __forceinline__ int opaque_tid() {
    extern __shared__ __attribute__((aligned(16))) unsigned char smem_[];
    const int w = __builtin_amdgcn_readfirstlane(((LAS const int*)((LAS unsigned char*)smem_ + WTAB_OFF))[hw_slot()]);
    int l; asm volatile("v_mbcnt_lo_u32_b32 %0, -1, 0\n\tv_mbcnt_hi_u32_b32 %0, -1, %0" : "=v"(l));
    return (w << 6) | l; }
#if PROBE_ID
#define PROBE_DECL unsigned long long probe_acc = 0, probe_t0 = 0
#define PROBE_BEGIN(id) do { if (PROBE_ID == (id)) probe_t0 = __builtin_amdgcn_s_memtime(); } while (0)
#define PROBE_END(id) do { if (PROBE_ID == (id)) probe_acc += __builtin_amdgcn_s_memtime() - probe_t0; } while (0)
#define PROBE_STORE(ws, bid, tid) do { if (PROBE_ID < 30 && (bid) == 7 && (tid) == 0) *(float*)((ws) + OFF_MISC + MISC_PROBE) = (float)probe_acc * 1e-6f; } while (0)
#else
#define PROBE_DECL
#define PROBE_BEGIN(id)
#define PROBE_END(id)
#define PROBE_STORE(ws, bid, tid)
#endif
__device__ __forceinline__ f32x4 fzero4() { float z = 0.f; asm volatile("" : "+v"(z)); return (f32x4){z, z, z, z}; }
__device__ __forceinline__ u32x4 uzero4() { unsigned z = 0u; asm volatile("" : "+v"(z)); return (u32x4){z, z, z, z}; }
__device__ __forceinline__ float fast_rcp(float x) { return __builtin_amdgcn_rcpf(x); }
__device__ __forceinline__ float fast_sigmoid(float x) { return fast_rcp(1.0f + __expf(-x)); }
__device__ __forceinline__ float fast_tanh(float x) { const float e = __expf(2.0f * x); return 1.0f - 2.0f * fast_rcp(1.0f + e); }
__device__ __forceinline__ bf16x8 pack_8g(const f32x4 a, const f32x4 b) { u32x4 w; w.x = cvt_pk_bf16(a[0], a[1]); w.y = cvt_pk_bf16(a[2], a[3]); w.z = cvt_pk_bf16(b[0], b[1]); w.w = cvt_pk_bf16(b[2], b[3]); return __builtin_bit_cast(bf16x8, w); }
template <int CTRL> __device__ __forceinline__ float dppf(float v) { return __builtin_bit_cast(float, __builtin_amdgcn_update_dpp(0, __builtin_bit_cast(int, v), CTRL, 0xf, 0xf, true)); }
__device__ __forceinline__ float wave_sum(float v) {
#pragma unroll
    for (int o = 32; o > 0; o >>= 1) v += __shfl_xor(v, o);
    return v;
}

constexpr size_t MiB = 1024ull * 1024ull;
constexpr size_t OFF_WINE = 0;
constexpr size_t OFF_WOUTE = OFF_WINE + (size_t)NE_MAIN * 1024 * 2;
constexpr size_t OFF_WINO = OFF_WOUTE + 2 * MiB;
constexpr size_t OFF_WOUTO = OFF_WINO + (size_t)NO_MAIN * 1024 * 2;
constexpr size_t OFF_WGU = OFF_WOUTO + 2 * MiB;
constexpr size_t OFF_WD = OFF_WGU + 32 * MiB;
constexpr size_t OFF_ROPE = OFF_WD + 16 * MiB;
constexpr size_t OFF_MISC = OFF_ROPE + 3 * MiB;
constexpr size_t OFF_BUF64 = OFF_MISC + 4 * MiB;
constexpr size_t OFF_P = OFF_BUF64 + 64 * MiB;
constexpr size_t OFF_U = OFF_P + 208 * MiB;
constexpr size_t WS_NEED = OFF_U + 128 * MiB;
constexpr size_t OFF_HE = OFF_P;
constexpr size_t OFF_ACT = OFF_HE + (size_t)MOE_ROWS * 1024 * 2;
constexpr size_t OFF_PD = OFF_P;
constexpr size_t OFF_KR = OFF_P + 112 * MiB;
constexpr size_t OFF_VV = OFF_KR + 8 * MiB;
constexpr size_t OFF_IQR = OFF_VV + 8 * MiB;
constexpr size_t OFF_IKR = OFF_IQR + 16 * MiB;
constexpr size_t OFF_IW = OFF_IKR + 4 * MiB;
constexpr size_t OFF_IDX = OFF_IW + 1 * MiB;
constexpr size_t MISC_CNT = 0;
constexpr size_t MISC_TOKINFO = 4096;
constexpr size_t MISC_TOKGATE = MISC_TOKINFO + (size_t)NTOK * 16;
constexpr size_t MISC_LIST = MISC_TOKGATE + (size_t)NTOK * 8;
constexpr size_t MISC_BAR = 2048;
constexpr size_t MISC_PROBE = 2304;
constexpr size_t MISC_W2T = 3 * MiB;
constexpr size_t MISC_A2T = MISC_W2T + 65536;
constexpr size_t MISC_G2T = MISC_A2T + 65536;

struct InTab { LAS const unsigned long long* t;
    __device__ __forceinline__ const float* operator[](int i) const { const unsigned long long v = t[i];
        const unsigned lo = __builtin_amdgcn_readfirstlane((unsigned)v), hi = __builtin_amdgcn_readfirstlane((unsigned)(v >> 32));
        return (const float*)(((unsigned long long)hi << 32) | lo); } };
struct Params { InTab in; float* out; unsigned char* ws; };
struct KArgs { const float* in[30]; float* out; unsigned char* ws; };
enum { I_X = 0, I_WINE, I_AMU, I_AW0, I_AW2, I_AA0, I_AA2, I_AG2, I_AKK, I_AKA, I_ARK, I_AGNG, I_AGNB, I_BGW2, I_BGB, I_BNG, I_WOUTE,
       I_WINO, I_CIKG, I_CIKB, I_WOUTO, I_LN1G, I_LN1B, I_LN2G, I_LN2B, I_RW, I_RB, I_EG, I_EU, I_ED };

namespace pg {
constexpr int BM = 256, BK = 64, HALF = 128, HTB = HALF * BK * 2, STAGE_BYTES = 8 * HTB;
__host__ __device__ __forceinline__ int lds_byte(int r, int c) { const int st = (r >> 4) * 2 + (c >> 5), rr = r & 15, cc = c & 31, ob = rr * 64 + cc * 2; return st * 1024 + (ob ^ (((ob >> 9) & 1) << 5)); }
__host__ __device__ __forceinline__ void stage_rc(int b, int& R, int& C) { const int st = b / 1024, sb = b % 1024, swz = sb ^ (((sb >> 9) & 1) << 5); R = (st >> 1) * 16 + swz / 64; C = (st & 1) * 32 + (swz % 64) / 2; }
__host__ __device__ __forceinline__ int perm32(int rho) { const int n = rho >> 4, i = rho & 15; return 8 * (i >> 2) + 4 * n + (i & 3); }

struct Unit { int pm, pn, e, rt, cnt; };

template <class Epi, class Sched>
__device__ __forceinline__ void gemm_phase(LAS unsigned char* lds, const int K, const Sched& S, const Epi& E) {
    const int tid = opaque_tid(), wid = __builtin_amdgcn_readfirstlane(tid >> 6), lane = tid & 63, wr = wid >> 2, wc = wid & 3, fr = lane & 15, fq = lane >> 4;
    const int nt = K / BK;
    unsigned voffB[2];
#pragma unroll
    for (int i = 0; i < 2; ++i) { int R, C; stage_rc(tid * 16 + i * 8192, R, C); const int Rb = Epi::PERM ? ((R & ~31) + perm32(R & 31)) : R; voffB[i] = (unsigned)(Rb * K + C) * 2u; }
    const size_t kstep = (size_t)(BK * 2);
    const size_t hstepB = (size_t)HALF * K * 2;
    const unsigned ldsw = (unsigned)wid * 1024u;
    const int aoff = lds_byte(wr * 64 + fr, fq * 8), boff = lds_byte(wc * 32 + fr, fq * 8);
#define PG_SA(b, h) (((b) * 2 + (h)) * HTB)
#define PG_SB(b, h) ((4 + (b) * 2 + (h)) * HTB)
#define PG_STAGE(bufoff, gbase, voff) do { _Pragma("unroll") for (int _i = 0; _i < 2; ++_i) \
        __builtin_amdgcn_global_load_lds((const unsigned*)((const char*)(gbase) + (voff)[_i]), (LAS unsigned*)(lds + (bufoff) + ldsw + _i * 8192), 16, 0, 0); } while (0)
#define PG_LDA(dst, b, h) do { _Pragma("unroll") for (int m = 0; m < 4; ++m) _Pragma("unroll") for (int k = 0; k < 2; ++k) dst[m][k] = *(const LAS bf16x8*)(lds + PG_SA(b, h) + aoff + m * 2048 + k * 1024); } while (0)
#define PG_LDB(dst, b, h) do { _Pragma("unroll") for (int n = 0; n < 2; ++n) _Pragma("unroll") for (int k = 0; k < 2; ++k) dst[n][k] = *(const LAS bf16x8*)(lds + PG_SB(b, h) + boff + n * 2048 + k * 1024); } while (0)
#define PG_MMA(ai, bj, At, Bt) do { __builtin_amdgcn_s_setprio(1); _Pragma("unroll") for (int m = 0; m < 4; ++m) _Pragma("unroll") for (int n = 0; n < 2; ++n) _Pragma("unroll") for (int k = 0; k < 2; ++k) \
        acc[ai][bj][m][n] = __builtin_amdgcn_mfma_f32_16x16x32_bf16(Bt[n][k], At[m][k], acc[ai][bj][m][n], 0, 0, 0); __builtin_amdgcn_s_setprio(0); } while (0)
#define PG_WAIT_V(n) asm volatile("s_waitcnt vmcnt(" #n ")" ::: "memory")
#define PG_WAIT_L(n) asm volatile("s_waitcnt lgkmcnt(" #n ")" ::: "memory")
#define PG_BAR __builtin_amdgcn_s_barrier()
#define PG_SCHED __builtin_amdgcn_sched_barrier(0)
#define PG_AOFF(dst0, dst1, u) do { _Pragma("unroll") for (int _i = 0; _i < 2; ++_i) { int _R, _C; stage_rc(tid * 16 + _i * 8192, _R, _C); \
        dst0[_i] = S.a_rowoff(u, 0, _R) + (unsigned)_C * 2u; dst1[_i] = S.a_rowoff(u, 1, _R) + (unsigned)_C * 2u; } } while (0)
    Unit cur, nxt; int ui = 0;
    if (!S.next(0, cur)) return;
    f32x4 acc[2][2][4][2];
#pragma unroll
    for (int a = 0; a < 2; ++a)
#pragma unroll
        for (int b = 0; b < 2; ++b)
#pragma unroll
            for (int m = 0; m < 4; ++m)
#pragma unroll
                for (int n = 0; n < 2; ++n) acc[a][b][m][n] = (f32x4){0.f, 0.f, 0.f, 0.f};
    bf16x8 At[4][2], B0[2][2], B1[2][2];
    const char* const Ab = S.a_base();
    unsigned aC0[2], aC1[2];
    PG_AOFF(aC0, aC1, cur);
    const char* cB = S.b_ptr(cur);
    PG_STAGE(PG_SB(0, 0), cB, voffB); PG_STAGE(PG_SA(0, 0), Ab, aC0); PG_STAGE(PG_SB(0, 1), cB + hstepB, voffB); PG_STAGE(PG_SA(0, 1), Ab, aC1);
    if (wr == 1) PG_BAR;
    PG_WAIT_V(4); PG_BAR;
    PG_STAGE(PG_SB(1, 0), cB + kstep, voffB); PG_STAGE(PG_SA(1, 0), Ab + kstep, aC0); PG_STAGE(PG_SB(1, 1), cB + hstepB + kstep, voffB);
    PG_WAIT_V(6); PG_BAR;
    for (;;) {
        const bool has_next = S.next(ui + 1, nxt);
        const char* nB = has_next ? S.b_ptr(nxt) : cB;
#pragma unroll 1
        for (int t = 0; t < nt; t += 2) {
            const bool last = (t == nt - 2);
            const char* a1 = Ab + (size_t)(t + 1) * kstep;
            const char* a2 = last ? Ab : Ab + (size_t)(t + 2) * kstep; const char* b2 = last ? nB : cB + (size_t)(t + 2) * kstep;
            const char* a3 = a2 + kstep; const char* b3 = b2 + kstep;
            PG_LDB(B0, 0, 0); PG_SCHED; PG_LDA(At, 0, 0); PG_STAGE(PG_SA(1, 1), a1, aC1);
            if (last && has_next) PG_AOFF(aC0, aC1, nxt);
            PG_WAIT_L(8); PG_BAR; PG_WAIT_L(0); PG_MMA(0, 0, At, B0); PG_BAR; PG_SCHED;
            PG_LDB(B1, 0, 1); PG_STAGE(PG_SB(0, 0), b2, voffB);
            PG_BAR; PG_WAIT_L(0); PG_MMA(0, 1, At, B1); PG_BAR;
            PG_LDA(At, 0, 1); PG_STAGE(PG_SA(0, 0), a2, aC0);
            PG_BAR; PG_WAIT_L(0); PG_MMA(1, 0, At, B0); PG_BAR; PG_SCHED;
            PG_STAGE(PG_SB(0, 1), b2 + hstepB, voffB);
            PG_WAIT_V(6); PG_BAR; PG_MMA(1, 1, At, B1); PG_BAR;
            PG_LDB(B0, 1, 0); PG_SCHED; PG_LDA(At, 1, 0); PG_STAGE(PG_SA(0, 1), a2, aC1);
            PG_WAIT_L(8); PG_BAR; PG_WAIT_L(0); PG_MMA(0, 0, At, B0); PG_BAR; PG_SCHED;
            PG_LDB(B1, 1, 1); PG_STAGE(PG_SB(1, 0), b3, voffB);
            PG_BAR; PG_WAIT_L(0); PG_MMA(0, 1, At, B1); PG_BAR;
            PG_LDA(At, 1, 1); PG_STAGE(PG_SA(1, 0), a3, aC0);
            PG_BAR; PG_WAIT_L(0); PG_MMA(1, 0, At, B0); PG_BAR; PG_SCHED;
            PG_STAGE(PG_SB(1, 1), b3 + hstepB, voffB);
            PG_WAIT_V(6); PG_BAR; PG_MMA(1, 1, At, B1); PG_BAR;
        }
        E(acc, cur, wr, wc, fr, fq);
        if (!has_next) break;
#pragma unroll
        for (int a = 0; a < 2; ++a)
#pragma unroll
            for (int b = 0; b < 2; ++b)
#pragma unroll
                for (int m = 0; m < 4; ++m)
#pragma unroll
                    for (int n = 0; n < 2; ++n) acc[a][b][m][n] = (f32x4){0.f, 0.f, 0.f, 0.f};
        cur = nxt; cB = nB; ++ui;
    }
    PG_WAIT_V(0);
    if (wr == 0) PG_BAR;
    PG_BAR;
#undef PG_SA
#undef PG_SB
#undef PG_STAGE
#undef PG_LDA
#undef PG_LDB
#undef PG_MMA
#undef PG_WAIT_V
#undef PG_WAIT_L
#undef PG_BAR
#undef PG_SCHED
#undef PG_AOFF
}

struct DenseSched {
    const char* A; const char* Bt; int K, nM, nN, nwg, G, c;
    __device__ void init(const void* A_, const void* Bt_, int M, int N, int K_, int G_, int c_) { A = (const char*)A_; Bt = (const char*)Bt_; K = K_; nM = M / BM; nN = N / BM; nwg = nM * nN; G = G_; c = c_; }
    __device__ __forceinline__ bool next(int i, Unit& u) const {
        const long L = (long)i * G + c; if (L >= nwg) return false;
        int wgid = (int)L; { const int q = nwg / 8, r = nwg % 8, xcd = wgid % 8, off = wgid / 8; wgid = (xcd < r ? xcd * (q + 1) : r * (q + 1) + (xcd - r) * q) + off; }
        const int nig = 8 * nN, gid = wgid / nig, fm = gid * 8, gsz = (nM - fm) < 8 ? (nM - fm) : 8;
        u.pm = fm + ((wgid % nig) % gsz); u.pn = (wgid % nig) / gsz; u.e = 0; u.rt = 0; u.cnt = 0; return true;
    }
    __device__ __forceinline__ const char* a_base() const { return A; }
    __device__ __forceinline__ unsigned a_rowoff(const Unit& u, int half, int R) const { return (unsigned)(u.pm * BM + half * HALF + R) * (unsigned)(K * 2); }
    __device__ __forceinline__ const char* b_ptr(const Unit& u) const { return Bt + (size_t)u.pn * BM * K * 2; }
};

__device__ __forceinline__ void moe_build_units(LAS int* tab, const int* cntp, int NCT, int G, int c) {
    const int i = opaque_tid();
    if (i < 16) {
        const int L = i * G + c; int accu = 0, rtb = 0, found = 0, pm = 0, pn = 0, ee = 0, rt = 0, cn = 0;
        for (int e = 0; e < 16; ++e) { const int ce = cntp[e], nte = (ce + 255) >> 8, ue = nte * NCT;
            if (!found && L < accu + ue) { const int local = L - accu; ee = e; rt = local / NCT; pn = local % NCT; pm = rtb + rt; cn = ce; found = 1; }
            accu += ue; rtb += nte; }
        tab[i * 8 + 0] = found; tab[i * 8 + 1] = pm; tab[i * 8 + 2] = pn; tab[i * 8 + 3] = ee; tab[i * 8 + 4] = rt; tab[i * 8 + 5] = cn;
    }
    __syncthreads();
}
template <bool GATHER>
struct MoeSched {
    const char* A; const char* Bt; const int* list; int K; size_t wstride; LAS int* tab;
    __device__ void init(const void* A_, const void* Bt_, size_t wstride_bytes, const int* list_, int K_, LAS int* tab_) {
        A = (const char*)A_; Bt = (const char*)Bt_; wstride = wstride_bytes; list = list_; K = K_; tab = tab_; }
    __device__ __forceinline__ bool next(int i, Unit& u) const {
        if (i >= 16) return false;
        const int f = __builtin_amdgcn_readfirstlane(tab[i * 8 + 0]);
        u.pm = __builtin_amdgcn_readfirstlane(tab[i * 8 + 1]); u.pn = __builtin_amdgcn_readfirstlane(tab[i * 8 + 2]); u.e = __builtin_amdgcn_readfirstlane(tab[i * 8 + 3]);
        u.rt = __builtin_amdgcn_readfirstlane(tab[i * 8 + 4]); u.cnt = __builtin_amdgcn_readfirstlane(tab[i * 8 + 5]);
        return f != 0;
    }
    __device__ __forceinline__ const char* a_base() const { return A; }
    __device__ __forceinline__ unsigned a_rowoff(const Unit& u, int half, int R) const {
        if (GATHER) { const int slot = u.rt * BM + half * HALF + R; const int tok = slot < u.cnt ? list[u.e * NTOK + slot] : 0; return (unsigned)tok * (unsigned)(K * 2); }
        return (unsigned)(u.pm * BM + half * HALF + R) * (unsigned)(K * 2);
    }
    __device__ __forceinline__ const char* b_ptr(const Unit& u) const { return Bt + (size_t)u.e * wstride + (size_t)u.pn * BM * K * 2; }
};

struct EpiBf16 {
    static constexpr bool PERM = true;
    bf16_t* O; int ldc;
    __device__ __forceinline__ void operator()(const f32x4 (&acc)[2][2][4][2], const Unit& u, int wr, int wc, int fr, int fq) const {
        const int row0 = u.pm * BM + wr * 64 + fr, col0 = u.pn * BM + wc * 32 + 8 * fq;
#pragma unroll
        for (int ai = 0; ai < 2; ++ai)
#pragma unroll
            for (int m = 0; m < 4; ++m) { bf16_t* rowp = O + (size_t)(row0 + ai * HALF + m * 16) * ldc + col0;
#pragma unroll
                for (int bj = 0; bj < 2; ++bj) { const f32x4 v0 = acc[ai][bj][m][0], v1 = acc[ai][bj][m][1];
                    u32x4 w; w.x = cvt_pk_bf16(v0[0], v0[1]); w.y = cvt_pk_bf16(v0[2], v0[3]); w.z = cvt_pk_bf16(v1[0], v1[1]); w.w = cvt_pk_bf16(v1[2], v1[3]);
                    *(u32x4*)(rowp + bj * HALF) = w; } }
    }
};
struct EpiResid {
    static constexpr bool PERM = false;
    const float* X; float* U;
    __device__ __forceinline__ void operator()(const f32x4 (&acc)[2][2][4][2], const Unit& u, int wr, int wc, int fr, int fq) const {
        const int row0 = u.pm * BM + wr * 64 + fr, col0 = u.pn * BM + wc * 32 + 4 * fq;
#pragma unroll
        for (int ai = 0; ai < 2; ++ai)
#pragma unroll
            for (int m = 0; m < 4; ++m) { const size_t off = (size_t)(row0 + ai * HALF + m * 16) * DM + col0;
#pragma unroll
                for (int bj = 0; bj < 2; ++bj)
#pragma unroll
                    for (int n = 0; n < 2; ++n) { const f32x4 xv = *(const f32x4*)(X + off + bj * HALF + n * 16);
                        *(f32x4*)(U + off + bj * HALF + n * 16) = xv * DN_ALPHA + acc[ai][bj][m][n]; } }
    }
};
struct EpiSwiglu {
    static constexpr bool PERM = true;
    bf16_t* O;
    __device__ __forceinline__ void operator()(const f32x4 (&acc)[2][2][4][2], const Unit& u, int wr, int wc, int fr, int fq) const {
        const int row0 = u.pm * BM + wr * 64 + fr, col0 = u.pn * HALF + wc * 32 + 8 * fq;
#pragma unroll
        for (int ai = 0; ai < 2; ++ai)
#pragma unroll
            for (int m = 0; m < 4; ++m) { bf16_t* rowp = O + (size_t)(row0 + ai * HALF + m * 16) * DEXP + col0;
                float r[8];
#pragma unroll
                for (int n = 0; n < 2; ++n)
#pragma unroll
                    for (int j = 0; j < 4; ++j) { const float g = acc[ai][0][m][n][j], up = acc[ai][1][m][n][j]; r[n * 4 + j] = g / (1.0f + __expf(-g)) * up; }
                u32x4 w; w.x = cvt_pk_bf16(r[0], r[1]); w.y = cvt_pk_bf16(r[2], r[3]); w.z = cvt_pk_bf16(r[4], r[5]); w.w = cvt_pk_bf16(r[6], r[7]);
                *(u32x4*)rowp = w; }
    }
};
}

__device__ __forceinline__ float reduce16_wave(const float (&v)[16], int lane) {
    float a8[8];
#pragma unroll
    for (int i = 0; i < 8; ++i) { const float mine = (lane & 32) ? v[8 + i] : v[i], other = (lane & 32) ? v[i] : v[8 + i]; a8[i] = mine + __shfl_xor(other, 32); }
    float a4[4];
#pragma unroll
    for (int i = 0; i < 4; ++i) { const float mine = (lane & 16) ? a8[4 + i] : a8[i], other = (lane & 16) ? a8[i] : a8[4 + i]; a4[i] = mine + __shfl_xor(other, 16); }
    float a2[2];
#pragma unroll
    for (int i = 0; i < 2; ++i) { const float mine = (lane & 8) ? a4[2 + i] : a4[i], other = (lane & 8) ? a4[i] : a4[2 + i]; a2[i] = mine + __shfl_xor(other, 8); }
    float a1; { const float mine = (lane & 4) ? a2[1] : a2[0], other = (lane & 4) ? a2[0] : a2[1]; a1 = mine + __shfl_xor(other, 4); }
    a1 += dppf<0x4E>(a1); a1 += dppf<0xB1>(a1);
    return a1;
}
__device__ __forceinline__ void tr_tile(LAS float* tile  , const float* src, int ld, int k0, int c0, int ncols_valid, bf16_t* dst, int dstK, int drow0, int tid) {
    {
        const int r = tid >> 3, cc = (tid & 7) * 8;
        const float* sp = src + (size_t)(k0 + r) * ld + c0 + cc;
#pragma unroll
        for (int j = 0; j < 8; ++j) tile[r * 65 + cc + j] = (c0 + cc + j < ncols_valid) ? sp[j] : 0.f;
    }
    __syncthreads();
    {
        const int n = tid >> 3, kk = (tid & 7) * 8;
        u32x4 w;
        w.x = cvt_pk_bf16(tile[(kk + 0) * 65 + n], tile[(kk + 1) * 65 + n]); w.y = cvt_pk_bf16(tile[(kk + 2) * 65 + n], tile[(kk + 3) * 65 + n]);
        w.z = cvt_pk_bf16(tile[(kk + 4) * 65 + n], tile[(kk + 5) * 65 + n]); w.w = cvt_pk_bf16(tile[(kk + 6) * 65 + n], tile[(kk + 7) * 65 + n]);
        *(u32x4*)(dst + (size_t)(drow0 + n) * dstK + k0 + kk) = w;
    }
    __syncthreads();
}

__device__ __forceinline__ void phase_prep(const Params& p, LAS unsigned char* lds, int bid, int nb) {
    const int tid = opaque_tid();
    LAS float* tile = (LAS float*)lds;
    unsigned char* ws = p.ws;
    const int T0 = 832, T1 = T0 + 256, T2 = T1 + 448, T3 = T2 + 256, T4 = T3 + 2048, T5 = T4 + 2048, T6 = T5 + 2048, T7 = T6 + 32;
    for (int t = bid; t < T7; t += nb) {
        if (t >= T6) { const int q = t - T6;
            if (q < 8) tr_tile(tile, p.in[I_AW2], 512, 0, q * 64, 512, (bf16_t*)(ws + OFF_MISC + MISC_W2T), 64, q * 64, tid);
            else if (q < 16) tr_tile(tile, p.in[I_AA2], 512, 0, (q - 8) * 64, 512, (bf16_t*)(ws + OFF_MISC + MISC_A2T), 64, (q - 8) * 64, tid);
            else { const int r = q - 16; tr_tile(tile, p.in[I_AG2], 512, (r >> 3) * 64, (r & 7) * 64, 512, (bf16_t*)(ws + OFF_MISC + MISC_G2T), 128, (r & 7) * 64, tid); }
            continue; }
        if (t < T0) { const int kt = t / 52, ct = t % 52; tr_tile(tile, p.in[I_WINE], EVEN_COLS, kt * 64, ct * 64, EVEN_COLS, (bf16_t*)(ws + OFF_WINE), 1024, ct * 64, tid); }
        else if (t < T1) { const int q = t - T0, kt = q / 16, ct = q % 16; tr_tile(tile, p.in[I_WOUTE], 1024, kt * 64, ct * 64, 1024, (bf16_t*)(ws + OFF_WOUTE), 1024, ct * 64, tid); }
        else if (t < T2) { const int q = t - T1, kt = q / 28, ct = q % 28; tr_tile(tile, p.in[I_WINO], ODD_COLS, kt * 64, ct * 64, ODD_COLS, (bf16_t*)(ws + OFF_WINO), 1024, ct * 64, tid); }
        else if (t < T3) { const int q = t - T2, kt = q / 16, ct = q % 16; tr_tile(tile, p.in[I_WOUTO], 1024, kt * 64, ct * 64, 1024, (bf16_t*)(ws + OFF_WOUTO), 1024, ct * 64, tid); }
        else if (t < T5) { const bool up = t >= T4; const int q = t - (up ? T4 : T3), le = q / 64, r = q % 64, kt = r / 4, ct = r % 4;
            const int c0 = ct * 64, drow0 = (c0 / 128) * 256 + (up ? 128 : 0) + (c0 % 128);
            tr_tile(tile, p.in[up ? I_EU : I_EG] + (size_t)le * 1024 * 256, 256, kt * 64, c0, 256, (bf16_t*)(ws + OFF_WGU) + (size_t)le * 512 * 1024, 1024, drow0, tid); }
        else { const int q = t - T5, le = q / 64, r = q % 64, kt = r / 16, ct = r % 16;
            tr_tile(tile, p.in[I_ED] + (size_t)le * 256 * 1024, 1024, kt * 64, ct * 64, 1024, (bf16_t*)(ws + OFF_WD) + (size_t)le * 1024 * 256, 256, ct * 64, tid); }
    }
    {
        const float* x = p.in[I_X]; bf16_t* xb = (bf16_t*)(ws + OFF_BUF64);
        const size_t n8 = (size_t)NTOK * DM / 8;
        for (size_t i = (size_t)bid * 512 + tid; i < n8; i += (size_t)nb * 512) {
            const f32x4 a = *(const f32x4*)(x + i * 8), b = *(const f32x4*)(x + i * 8 + 4);
            u32x4 w; w.x = cvt_pk_bf16(a[0], a[1]); w.y = cvt_pk_bf16(a[2], a[3]); w.z = cvt_pk_bf16(b[0], b[1]); w.w = cvt_pk_bf16(b[2], b[3]);
            *(u32x4*)(xb + i * 8) = w;
        }
    }
    {
        float* c64 = (float*)(ws + OFF_ROPE); float* s64 = c64 + 4096 * 64; float* c32 = s64 + 4096 * 64; float* s32 = c32 + 4096 * 32;
        for (int i = bid * 512 + tid; i < 4096 * 64; i += nb * 512) { const int pos = i >> 6, j = i & 63; const float inv = powf(10000.0f, -(float)j / 64.0f); const float ang = (float)pos * inv; c64[i] = cosf(ang); s64[i] = sinf(ang); }
        for (int i = bid * 512 + tid; i < 4096 * 32; i += nb * 512) { const int pos = i >> 5, j = i & 31; const float inv = powf(10000.0f, -(float)j / 32.0f); const float ang = (float)pos * inv; c32[i] = cosf(ang); s32[i] = sinf(ang); }
    }
    if (bid == 0 && tid < 64) ((int*)(ws + OFF_MISC + MISC_CNT))[tid] = 0;
}

__device__ __forceinline__ void phase_ln_route(const Params& p, LAS unsigned char* lds, int bid, int nb, int layer) {
    const int tid = opaque_tid(), wid = tid >> 6, lane = tid & 63;
    unsigned char* ws = p.ws;
    LAS float* rwT = (LAS float*)lds;
    LAS int* sel = (LAS int*)(lds + 65536);
    LAS float* selg = (LAS float*)(lds + 65536 + 1024);
    LAS int* cntw = (LAS int*)(lds + 65536 + 2048);
    { const float* rw = p.in[I_RW];
        for (int i = tid; i < 16 * 1024; i += 512) { const int e = i >> 10, k = i & 1023; rwT[i] = rw[k * 16 + e]; } }
    __syncthreads();
    float* U = (float*)(ws + OFF_U); bf16_t* hb = (bf16_t*)(ws + OFF_BUF64);
    const float* g = p.in[I_LN1G] + layer * DM; const float* b = p.in[I_LN1B] + layer * DM;
    int* cnt = (int*)(ws + OFF_MISC + MISC_CNT) + layer * 16;
    int* tokinfo = (int*)(ws + OFF_MISC + MISC_TOKINFO); float* tokgate = (float*)(ws + OFF_MISC + MISC_TOKGATE); int* list = (int*)(ws + OFF_MISC + MISC_LIST);
    f32x4 gv[4], bv[4];
#pragma unroll
    for (int j = 0; j < 4; ++j) { gv[j] = *(const f32x4*)(g + j * 256 + lane * 4); bv[j] = *(const f32x4*)(b + j * 256 + lane * 4); }
    const float* rbp = p.in[I_RB];
    const float my_rb = rbp[((lane >> 5) & 1) * 8 + ((lane >> 4) & 1) * 4 + ((lane >> 3) & 1) * 2 + ((lane >> 2) & 1)];
    for (int blk = bid; blk < NTOK / 128; blk += nb) {
#pragma unroll 1
        for (int i = 0; i < 16; ++i) {
            const int tl = wid * 16 + i, tok = blk * 128 + tl;
            f32x4 v[4]; float s = 0.f;
            asm volatile("" ::: "memory");
#pragma unroll
            for (int j = 0; j < 4; ++j) { v[j] = *(const f32x4*)(U + (size_t)tok * DM + j * 256 + lane * 4); s += (v[j][0] + v[j][1]) + (v[j][2] + v[j][3]); }
            const float mean = wave_sum(s) * (1.0f / DM);
            float q = 0.f;
#pragma unroll
            for (int j = 0; j < 4; ++j) { v[j] -= mean; q += (v[j][0] * v[j][0] + v[j][1] * v[j][1]) + (v[j][2] * v[j][2] + v[j][3] * v[j][3]); }
            const float rstd = rsqrtf(wave_sum(q) * (1.0f / DM) + LN_EPS);
#pragma unroll
            for (int j = 0; j < 4; ++j) { v[j] = v[j] * rstd * gv[j] + bv[j];
                *(f32x4*)(U + (size_t)tok * DM + j * 256 + lane * 4) = v[j];
                u32x2 w; w.x = cvt_pk_bf16(v[j][0], v[j][1]); w.y = cvt_pk_bf16(v[j][2], v[j][3]);
                *(u32x2*)(hb + (size_t)tok * DM + j * 256 + lane * 4) = w; }
            float part[16];
#pragma unroll
            for (int e = 0; e < 16; ++e) { float a = 0.f;
#pragma unroll
                for (int j = 0; j < 4; ++j) { const f32x4 w = *(const LAS f32x4*)(rwT + e * 1024 + j * 256 + lane * 4); a += (v[j][0] * w[0] + v[j][1] * w[1]) + (v[j][2] * w[2] + v[j][3] * w[3]); }
                part[e] = a; }
            const float lgm = reduce16_wave(part, lane);
            const float sgm = 1.0f / (1.0f + expf(-lgm)), selm = sgm + my_rb;
            float sg[16], sl[16];
#pragma unroll
            for (int e = 0; e < 16; ++e) { const int L = ((e >> 3) & 1) * 32 + ((e >> 2) & 1) * 16 + ((e >> 1) & 1) * 8 + (e & 1) * 4;
                sg[e] = __builtin_bit_cast(float, __builtin_amdgcn_readlane(__builtin_bit_cast(int, sgm), L)); sl[e] = __builtin_bit_cast(float, __builtin_amdgcn_readlane(__builtin_bit_cast(int, selm), L)); }
            int best = 0; float bestv = -INFINITY;
#pragma unroll
            for (int gI = 0; gI < 4; ++gI) { float m1 = -INFINITY, m2 = -INFINITY;
#pragma unroll
                for (int j = 0; j < 4; ++j) { const float x = sl[gI * 4 + j]; if (x > m1) { m2 = m1; m1 = x; } else if (x > m2) m2 = x; }
                const float gs = m1 + m2; if (gs > bestv) { bestv = gs; best = gI; } }
            int e0 = 0, e1 = 0; float v0 = -INFINITY, v1 = -INFINITY, s0 = 0.f, s1 = 0.f;
#pragma unroll
            for (int e = 0; e < 16; ++e) { if ((e >> 2) == best) { const float x = sl[e];
                    if (x > v0) { v1 = v0; e1 = e0; s1 = s0; v0 = x; e0 = e; s0 = sg[e]; } else if (x > v1) { v1 = x; e1 = e; s1 = sg[e]; } } }
            const float gsum = s0 + s1;
            if (lane == 0) { sel[tl * 2] = e0; sel[tl * 2 + 1] = e1; selg[tl * 2] = s0 / gsum; selg[tl * 2 + 1] = s1 / gsum; }
        }
        __syncthreads();
        int myE = -1, myRank = 0;
        if (tid < 256) { myE = sel[tid];
#pragma unroll
            for (int e = 0; e < 16; ++e) { const unsigned long long mk = __ballot(myE == e); if (myE == e) myRank = __popcll(mk & ((1ull << lane) - 1ull)); if (lane == 0) cntw[wid * 16 + e] = __popcll(mk); } }
        __syncthreads();
        if (tid < 16) { const int c0 = cntw[tid], c1 = cntw[16 + tid], c2 = cntw[32 + tid], c3 = cntw[48 + tid];
            const int basev = atomicAdd(cnt + tid, c0 + c1 + c2 + c3);
            cntw[64 + tid] = basev; cntw[80 + tid] = basev + c0; cntw[96 + tid] = basev + c0 + c1; cntw[112 + tid] = basev + c0 + c1 + c2; }
        __syncthreads();
        if (tid < 256) { const int slot = cntw[64 + wid * 16 + myE] + myRank; const int tok = blk * 128 + (tid >> 1), k = tid & 1;
            list[myE * NTOK + slot] = tok; tokinfo[tok * 4 + k * 2] = myE; tokinfo[tok * 4 + k * 2 + 1] = slot; tokgate[tok * 2 + k] = selg[tid]; }
        __syncthreads();
    }
}

__device__ __forceinline__ void phase_ln2(const Params& p, int bid, int nb, int layer, float* dst, bool with_moe) {
    const int tid = opaque_tid(), wid = tid >> 6, lane = tid & 63;
    unsigned char* ws = p.ws;
    const float* U = (const float*)(ws + OFF_U); bf16_t* xb = (bf16_t*)(ws + OFF_BUF64);
    const bf16_t* he = (const bf16_t*)(ws + OFF_HE);
    const float* g = p.in[I_LN2G] + layer * DM; const float* b = p.in[I_LN2B] + layer * DM;
    const int* cnt = (const int*)(ws + OFF_MISC + MISC_CNT) + layer * 16;
    const int* tokinfo = (const int*)(ws + OFF_MISC + MISC_TOKINFO); const float* tokgate = (const float*)(ws + OFF_MISC + MISC_TOKGATE);
    int rowbase[16]; { int a = 0;
#pragma unroll
        for (int e = 0; e < 16; ++e) { rowbase[e] = a; a += ((cnt[e] + 255) >> 8) << 8; } }
    f32x4 gv[4], bv[4];
#pragma unroll
    for (int j = 0; j < 4; ++j) { gv[j] = *(const f32x4*)(g + j * 256 + lane * 4); bv[j] = *(const f32x4*)(b + j * 256 + lane * 4); }
    for (int tok = bid * 8 + wid; tok < NTOK; tok += nb * 8) {
        f32x4 v[4]; float s = 0.f;
        int r0 = 0, r1 = 0; float g0 = 0.f, g1 = 0.f;
        if (with_moe) { const int e0 = tokinfo[tok * 4 + 0], sl0 = tokinfo[tok * 4 + 1], e1 = tokinfo[tok * 4 + 2], sl1 = tokinfo[tok * 4 + 3];
            int rb0 = 0, rb1 = 0;
#pragma unroll
            for (int e = 0; e < 16; ++e) { if (e == e0) rb0 = rowbase[e]; if (e == e1) rb1 = rowbase[e]; }
            r0 = rb0 + sl0; r1 = rb1 + sl1; g0 = tokgate[tok * 2 + 0]; g1 = tokgate[tok * 2 + 1]; }
#pragma unroll
        for (int j = 0; j < 4; ++j) { v[j] = *(const f32x4*)(U + (size_t)tok * DM + j * 256 + lane * 4) * DN_ALPHA;
            if (with_moe) { const u32x2 a = *(const u32x2*)(he + (size_t)r0 * DM + j * 256 + lane * 4), c = *(const u32x2*)(he + (size_t)r1 * DM + j * 256 + lane * 4);
                v[j][0] += g0 * __uint_as_float(a.x << 16) + g1 * __uint_as_float(c.x << 16); v[j][1] += g0 * __uint_as_float(a.x & 0xffff0000u) + g1 * __uint_as_float(c.x & 0xffff0000u);
                v[j][2] += g0 * __uint_as_float(a.y << 16) + g1 * __uint_as_float(c.y << 16); v[j][3] += g0 * __uint_as_float(a.y & 0xffff0000u) + g1 * __uint_as_float(c.y & 0xffff0000u); }
            s += (v[j][0] + v[j][1]) + (v[j][2] + v[j][3]); }
        const float mean = wave_sum(s) * (1.0f / DM);
        float q = 0.f;
#pragma unroll
        for (int j = 0; j < 4; ++j) { v[j] -= mean; q += (v[j][0] * v[j][0] + v[j][1] * v[j][1]) + (v[j][2] * v[j][2] + v[j][3] * v[j][3]); }
        const float rstd = rsqrtf(wave_sum(q) * (1.0f / DM) + LN_EPS);
#pragma unroll
        for (int j = 0; j < 4; ++j) { v[j] = v[j] * rstd * gv[j] + bv[j];
#if PROBE_ID
            if (layer == 1) v[j] = v[j] * (1.0f + *(const float*)(ws + OFF_MISC + MISC_PROBE));
#endif
            *(f32x4*)(dst + (size_t)tok * DM + j * 256 + lane * 4) = v[j];
            u32x2 w; w.x = cvt_pk_bf16(v[j][0], v[j][1]); w.y = cvt_pk_bf16(v[j][2], v[j][3]);
            *(u32x2*)(xb + (size_t)tok * DM + j * 256 + lane * 4) = w; }
    }
}

__device__ __forceinline__ void phase_resid_only(const Params& p, const float* X, int bid, int nb) {
    float* U = (float*)(p.ws + OFF_U);
    const size_t n4 = (size_t)NTOK * DM / 4;
    for (size_t i = (size_t)bid * 512 + threadIdx.x; i < n4; i += (size_t)nb * 512) *(f32x4*)(U + i * 4) = *(const f32x4*)(X + i * 4) * DN_ALPHA;
}

__device__ __forceinline__ void phase_moe_gateup(const Params& p, LAS unsigned char* lds, int bid, int nb, int layer) {
    unsigned char* ws = p.ws;
    LAS int* tab = (LAS int*)(lds + pg::STAGE_BYTES);
    pg::moe_build_units(tab, (const int*)(ws + OFF_MISC + MISC_CNT) + layer * 16, 2, nb, bid);
    pg::MoeSched<true> S; S.init(ws + OFF_BUF64, ws + OFF_WGU + (size_t)layer * 16 * 512 * 1024 * 2, (size_t)512 * 1024 * 2, (const int*)(ws + OFF_MISC + MISC_LIST), 1024, tab);
    pg::EpiSwiglu E; E.O = (bf16_t*)(ws + OFF_ACT);
    pg::gemm_phase(lds, 1024, S, E);
}
__device__ __forceinline__ void phase_moe_down(const Params& p, LAS unsigned char* lds, int bid, int nb, int layer) {
    unsigned char* ws = p.ws;
    LAS int* tab = (LAS int*)(lds + pg::STAGE_BYTES);
    pg::moe_build_units(tab, (const int*)(ws + OFF_MISC + MISC_CNT) + layer * 16, 4, nb, bid);
    pg::MoeSched<false> S; S.init(ws + OFF_ACT, ws + OFF_WD + (size_t)layer * 16 * 1024 * 256 * 2, (size_t)1024 * 256 * 2, nullptr, 256, tab);
    pg::EpiBf16 E; E.O = (bf16_t*)(ws + OFF_HE); E.ldc = 1024;
    pg::gemm_phase(lds, 256, S, E);
}

__device__ __forceinline__ void phase_gla_alpha(const Params& p, LAS unsigned char* lds, int bid, int nb) {
    const int tid = opaque_tid(), wid = tid >> 6, lane = tid & 63;
    LAS float* wT = (LAS float*)lds;
    for (int i = tid; i < 16 * 1024; i += 512) { const int e = i & 15, k = i >> 4; wT[e * 1024 + k] = p.in[I_WINE][(size_t)k * EVEN_COLS + NE_MAIN + e]; }
    __syncthreads();
    const float* x = p.in[I_X]; float* xa = (float*)(p.ws + OFF_U);
    for (int tok = bid * 8 + wid; tok < NTOK; tok += nb * 8) {
        f32x4 v[4];
        asm volatile("" ::: "memory");
#pragma unroll
        for (int j = 0; j < 4; ++j) v[j] = *(const f32x4*)(x + (size_t)tok * DM + j * 256 + lane * 4);
        float part[16];
#pragma unroll
        for (int e = 0; e < 16; ++e) { float a = 0.f;
#pragma unroll
            for (int j = 0; j < 4; ++j) { const f32x4 w = *(const LAS f32x4*)(wT + e * 1024 + j * 256 + lane * 4); a += (v[j][0] * w[0] + v[j][1] * w[1]) + (v[j][2] * w[2] + v[j][3] * w[3]); }
            part[e] = a; }
        const float r = reduce16_wave(part, lane);
        if ((lane & 3) == 0) xa[(size_t)tok * 16 + ((lane >> 5) & 1) * 8 + ((lane >> 4) & 1) * 4 + ((lane >> 3) & 1) * 2 + ((lane >> 2) & 1)] = r;
    }
    __syncthreads();
}

__device__ __forceinline__ float red8(float v) { v += dppf<0xB1>(v); v += dppf<0x4E>(v); v += dppf<0x141>(v); return v; }

__device__ __forceinline__ void rwkv_item(const Params& p, LAS unsigned char* lds, int item) {
    constexpr int TC = 16;
    const int tid = opaque_tid(), lane = tid & 63, tg = tid >> 6;
    const int b = item >> 3, h = item & 7;
    const bf16_t* P0 = (const bf16_t*)(p.ws + OFF_P);
    bf16_t* mix = (bf16_t*)(p.ws + OFF_BUF64);
    LAS float* w2s = (LAS float*)lds;
    LAS float* a2s = w2s + 64 * 64;
    LAS float* g2s = a2s + 64 * 64;
    LAS float* tw = g2s + 128 * 64;
    LAS float* xa_s = tw + TC * 64;
    LAS float* sg = xa_s + TC * 64;
    LAS float* r_s = sg + TC * 128;
    LAS float* k_s = r_s + TC * 64;
    LAS float* v_s = k_s + TC * 64;
    LAS float* w_s = v_s + TC * 64;
    LAS float* kk_s = w_s + TC * 64;
    LAS float* kka_s = kk_s + TC * 64;
    LAS float* kh_s = kka_s + TC * 64;
    LAS float* g_s = kh_s + TC * 64;
    LAS float* y_s = g_s + TC * 64;
    LAS float* rk_s = y_s + TC * 64;
    const float* mu = p.in[I_AMU];
    for (int i = tid; i < 64 * 64; i += 512) { const int r = i >> 6, c = i & 63; w2s[i] = p.in[I_AW2][r * 512 + h * 64 + c]; a2s[i] = p.in[I_AA2][r * 512 + h * 64 + c]; }
    for (int i = tid; i < 128 * 64; i += 512) { const int r = i >> 6, c = i & 63; g2s[i] = p.in[I_AG2][r * 512 + h * 64 + c]; }
    const int j = lane;
    const float w0 = p.in[I_AW0][h * 64 + j], a0 = p.in[I_AA0][h * 64 + j], kksc = p.in[I_AKK][h * 64 + j], kasc = p.in[I_AKA][h * 64 + j], rkj = p.in[I_ARK][h * 64 + j];
    const float gng = p.in[I_AGNG][h * 64 + j], gnb = p.in[I_AGNB][h * 64 + j];
    float S[8];
#pragma unroll
    for (int i = 0; i < 8; ++i) S[i] = 0.f;
    const int row = tid >> 3, kq = tid & 7;
    __syncthreads();
    for (int t0 = 0; t0 < SEQ; t0 += TC) {
        for (int idx = tid; idx < TC * 448; idx += 512) {
            const int t = idx / 448, c = idx % 448; int col; LAS float* dst; int kind = 0;
            if (c < 64) { col = h * 64 + c; dst = r_s + t * 64 + c; }
            else if (c < 128) { col = 512 + h * 64 + (c - 64); dst = k_s + t * 64 + (c - 64); }
            else if (c < 192) { col = 1024 + h * 64 + (c - 128); dst = v_s + t * 64 + (c - 128); }
            else if (c < 256) { col = 1536 + (c - 192); dst = tw + t * 64 + (c - 192); kind = 1; }
            else if (c < 320) { col = 1600 + (c - 256); dst = xa_s + t * 64 + (c - 256); }
            else { col = 1664 + (c - 320); dst = sg + t * 128 + (c - 320); kind = 2; }
            const size_t n = (size_t)b * SEQ + t0 + t;
            const float cur = bf2f(P0[n * NE_MAIN + col]);
            const float prev = (t0 + t) > 0 ? bf2f(P0[(n - 1) * NE_MAIN + col]) : 0.f;
            float val = cur + (prev - cur) * mu[col];
            if (kind == 1) val = tanhf(val); else if (kind == 2) val = 1.0f / (1.0f + expf(-val));
            *dst = val;
        }
        __syncthreads();
#pragma unroll
        for (int tt = 0; tt < 2; ++tt) {
            const int t = tg + tt * 8;
            float aw = 0.f, aa = 0.f, ag = 0.f;
            asm volatile("" ::: "memory");
#pragma unroll 4
            for (int i = 0; i < 64; ++i) { aw += tw[t * 64 + i] * w2s[i * 64 + j]; aa += xa_s[t * 64 + i] * a2s[i * 64 + j]; }
            asm volatile("" ::: "memory");
#pragma unroll 4
            for (int i = 0; i < 128; ++i) ag += sg[t * 128 + i] * g2s[i * 64 + j];
            asm volatile("" ::: "memory");
            const float z = w0 + aw;
            const float sp = (-z > 20.f) ? -z : log1pf(expf(-z));
            const float wlog = -sp - 0.5f;
            const float decay = expf(-expf(wlog));
            const float a = 1.0f / (1.0f + expf(-(a0 + aa)));
            const float kraw = k_s[t * 64 + j];
            const float kkp = kraw * kksc;
            const float nrm = sqrtf(wave_sum(kkp * kkp));
            const float kk = kkp / fmaxf(nrm, 1e-12f);
            const float kh = kraw * (1.0f + (a - 1.0f) * kasc);
            const float rr = r_s[t * 64 + j];
            const float rk = wave_sum(rr * kh * rkj);
            w_s[t * 64 + j] = decay; kk_s[t * 64 + j] = kk; kka_s[t * 64 + j] = kk * a; kh_s[t * 64 + j] = kh; g_s[t * 64 + j] = ag;
            if (j == 0) rk_s[t] = rk;
        }
        __syncthreads();
        for (int t = 0; t < TC; ++t) {
            const f32x4 kk0 = *(const LAS f32x4*)(kk_s + t * 64 + kq * 8), kk1 = *(const LAS f32x4*)(kk_s + t * 64 + kq * 8 + 4);
            const f32x4 ww0 = *(const LAS f32x4*)(w_s + t * 64 + kq * 8), ww1 = *(const LAS f32x4*)(w_s + t * 64 + kq * 8 + 4);
            const f32x4 ka0 = *(const LAS f32x4*)(kka_s + t * 64 + kq * 8), ka1 = *(const LAS f32x4*)(kka_s + t * 64 + kq * 8 + 4);
            const f32x4 kh0 = *(const LAS f32x4*)(kh_s + t * 64 + kq * 8), kh1 = *(const LAS f32x4*)(kh_s + t * 64 + kq * 8 + 4);
            const f32x4 rr0 = *(const LAS f32x4*)(r_s + t * 64 + kq * 8), rr1 = *(const LAS f32x4*)(r_s + t * 64 + kq * 8 + 4);
            const float vv = v_s[t * 64 + row];
            float sa = 0.f;
#pragma unroll
            for (int i = 0; i < 4; ++i) { sa += S[i] * kk0[i]; sa += S[4 + i] * kk1[i]; }
            sa = red8(sa);
            float y = 0.f;
#pragma unroll
            for (int i = 0; i < 4; ++i) {
                S[i] = S[i] * ww0[i] - sa * ka0[i] + vv * kh0[i]; S[4 + i] = S[4 + i] * ww1[i] - sa * ka1[i] + vv * kh1[i];
                y += S[i] * rr0[i]; y += S[4 + i] * rr1[i]; }
            y = red8(y);
            if (kq == 0) y_s[t * 64 + row] = y;
        }
        __syncthreads();
#pragma unroll
        for (int tt = 0; tt < 2; ++tt) {
            const int t = tg + tt * 8;
            const float y = y_s[t * 64 + j];
            const float mean = wave_sum(y) * (1.0f / 64.0f);
            const float d = y - mean;
            const float var = wave_sum(d * d) * (1.0f / 64.0f);
            const float yn = d * rsqrtf(var + 64e-5f) * gng + gnb;
            const float o = (yn + rk_s[t] * v_s[t * 64 + j]) * g_s[t * 64 + j];
            mix[((size_t)b * SEQ + t0 + t) * DM + h * 64 + j] = f2bf(o);
        }
        __syncthreads();
    }
}

__device__ __forceinline__ void gla_item(const Params& p, LAS unsigned char* lds, int item) {
    const int tid = opaque_tid(), lane = tid & 63, tg = tid >> 6;
    const int b = item >> 2, h = item & 3;
    const bf16_t* P0 = (const bf16_t*)(p.ws + OFF_P) + 1792;
    const float* xa16 = (const float*)(p.ws + OFF_U);
    bf16_t* mix = (bf16_t*)(p.ws + OFF_BUF64);
    LAS float* qd = (LAS float*)lds;
    LAS float* ki = qd + 64 * 65;
    LAS float* att = ki + 64 * 65;
    LAS float* vs = att + 64 * 65;
    LAS float* St = vs + 64 * 128;
    LAS float* bl = St + 64 * 128;
    for (int i = tid; i < 64 * 128; i += 512) St[i] = 0.f;
    float gw2[16];
#pragma unroll
    for (int i = 0; i < 16; ++i) gw2[i] = p.in[I_BGW2][i * 256 + h * 64 + lane];
    const float gb = p.in[I_BGB][h * 64 + lane];
    const float* bng = p.in[I_BNG];
    __syncthreads();
    for (int c0 = 0; c0 < SEQ; c0 += 64) {
        const size_t n0 = (size_t)b * SEQ + c0;
        for (int tt = 0; tt < 8; ++tt) { const int c = tg * 8 + tt; float z = gb;
#pragma unroll
            for (int i = 0; i < 16; ++i) z += xa16[(n0 + c) * 16 + i] * gw2[i];
            const float ls = (z >= 0.f) ? -log1pf(expf(-z)) : (z - log1pf(expf(z)));
            att[c * 65 + lane] = ls * (1.0f / 16.0f); }
        for (int i = tid; i < 64 * 128; i += 512) { const int c = i >> 7, e = i & 127; vs[i] = bf2f(P0[(n0 + c) * NE_MAIN + 512 + h * 128 + e]); }
        __syncthreads();
        if (tid < 64) { float a = 0.f; for (int c = 0; c < 64; ++c) { a += att[c * 65 + tid]; att[c * 65 + tid] = a; } bl[tid] = a; }
        __syncthreads();
        for (int i = tid; i < 64 * 64; i += 512) { const int c = i >> 6, d = i & 63; const float bc = att[c * 65 + d];
            const float q = bf2f(P0[(n0 + c) * NE_MAIN + h * 64 + d]), k = bf2f(P0[(n0 + c) * NE_MAIN + 256 + h * 64 + d]);
            qd[c * 65 + d] = q * 0.125f * expf(bc); ki[c * 65 + d] = k * expf(-bc); }
        __syncthreads();
        { const int c = tid >> 3, sgp = tid & 7; float a[8];
#pragma unroll
            for (int i = 0; i < 8; ++i) a[i] = 0.f;
            for (int d = 0; d < 64; ++d) { const float qv = qd[c * 65 + d];
#pragma unroll
                for (int i = 0; i < 8; ++i) a[i] += qv * ki[(sgp * 8 + i) * 65 + d]; }
            __syncthreads();
#pragma unroll
            for (int i = 0; i < 8; ++i) att[c * 65 + sgp * 8 + i] = (sgp * 8 + i <= c) ? a[i] : 0.f; }
        __syncthreads();
        { const int c = tid >> 3, eg = tid & 7; float o[16];
#pragma unroll
            for (int i = 0; i < 16; ++i) o[i] = 0.f;
            for (int s = 0; s <= c; ++s) { const float a = att[c * 65 + s];
#pragma unroll
                for (int i = 0; i < 16; ++i) o[i] += a * vs[s * 128 + eg * 16 + i]; }
            for (int d = 0; d < 64; ++d) { const float qv = qd[c * 65 + d];
#pragma unroll
                for (int i = 0; i < 16; ++i) o[i] += qv * St[d * 128 + eg * 16 + i]; }
            float ss = 0.f;
#pragma unroll
            for (int i = 0; i < 16; ++i) ss += o[i] * o[i];
            ss = red8(ss);
            const float rs = rsqrtf(ss * (1.0f / 128.0f) + 1e-5f);
#pragma unroll
            for (int i = 0; i < 16; ++i) { const int e = eg * 16 + i; const float g = bf2f(P0[(n0 + c) * NE_MAIN + 1024 + h * 128 + e]);
                const float val = o[i] * rs * bng[h * 128 + e] * (g / (1.0f + expf(-g)));
                mix[(n0 + c) * DM + 512 + h * 128 + e] = f2bf(val); } }
        __syncthreads();
        { const int d = tid >> 3, eg = tid & 7; float a[16];
#pragma unroll
            for (int i = 0; i < 16; ++i) a[i] = St[d * 128 + eg * 16 + i];
            for (int c = 0; c < 64; ++c) { const float kv = ki[c * 65 + d];
#pragma unroll
                for (int i = 0; i < 16; ++i) a[i] += kv * vs[c * 128 + eg * 16 + i]; }
            const float eb = expf(bl[d]);
#pragma unroll
            for (int i = 0; i < 16; ++i) St[d * 128 + eg * 16 + i] = a[i] * eb; }
        __syncthreads();
    }
}

__device__ __forceinline__ float red16(float v) { v += dppf<0xB1>(v); v += dppf<0x4E>(v); v += dppf<0x141>(v); v += dppf<0x140>(v); return v; }
__device__ __forceinline__ void rwkv2_item(const Params& p, LAS unsigned char* lds, int item) {
    constexpr int TC = 32;
    const int tid = opaque_tid(), lane = tid & 63, wid = tid >> 6, fr = lane & 15, g = lane >> 4;
    const int b = item >> 4, h = (item >> 1) & 7, rq = item & 1;
    unsigned char* ws = p.ws;
    const bf16_t* P0 = (const bf16_t*)(ws + OFF_P);
    float* yraw = p.out;
    bf16_t* e1g = (bf16_t*)(p.out + (size_t)NTOK * 512);
    bf16_t* gg = e1g + (size_t)NTOK * 512;
    LAS float* kk_s = (LAS float*)lds;
    LAS float* w_s = kk_s + TC * 64;
    LAS float* b_s = w_s + TC * 64;
    LAS float* kh_s = b_s + TC * 64;
    LAS float* wr_s = kh_s + TC * 64;
    LAS float* wpre = wr_s + TC * 64;
    LAS float* apre = wpre + TC * 64;
    LAS float* gpre = apre + TC * 64;
    LAS float* v_s = gpre + TC * 32;
    LAS float* y_s = v_s + TC * 32;
    LAS float* sc_s = y_s + TC * 32;
    LAS unsigned char* tw_i = (LAS unsigned char*)(sc_s + TC * 2);
    LAS unsigned char* xa_i = tw_i + TC * 128;
    LAS unsigned char* sg_i = xa_i + TC * 128;
    const float* mu = p.in[I_AMU];
    const bf16_t* w2t = (const bf16_t*)(ws + OFF_MISC + MISC_W2T); const bf16_t* a2t = (const bf16_t*)(ws + OFF_MISC + MISC_A2T); const bf16_t* g2t = (const bf16_t*)(ws + OFF_MISC + MISC_G2T);
    const int mrt = wid >> 2, mct = wid & 3;
    bf16x8 wf[2], af[2], gf[4];
#pragma unroll
    for (int s = 0; s < 2; ++s) { wf[s] = *(const bf16x8*)(w2t + (size_t)(h * 64 + mct * 16 + fr) * 64 + s * 32 + g * 8); af[s] = *(const bf16x8*)(a2t + (size_t)(h * 64 + mct * 16 + fr) * 64 + s * 32 + g * 8); }
    const int grt = (wid >> 1) & 1, gct = wid & 1;
#pragma unroll
    for (int s = 0; s < 4; ++s) gf[s] = *(const bf16x8*)(g2t + (size_t)(h * 64 + rq * 32 + gct * 16 + fr) * 128 + s * 32 + g * 8);
    const int et = tid >> 4, ec = tid & 15;
    const f32x4 w0v = *(const f32x4*)(p.in[I_AW0] + h * 64 + ec * 4), a0v = *(const f32x4*)(p.in[I_AA0] + h * 64 + ec * 4);
    const f32x4 kksc = *(const f32x4*)(p.in[I_AKK] + h * 64 + ec * 4), kasc = *(const f32x4*)(p.in[I_AKA] + h * 64 + ec * 4), rkv = *(const f32x4*)(p.in[I_ARK] + h * 64 + ec * 4);
    const f32x4 mur = *(const f32x4*)(mu + h * 64 + ec * 4), muk = *(const f32x4*)(mu + 512 + h * 64 + ec * 4);
    const f32x2 muv = *(const f32x2*)(mu + 1024 + h * 64 + rq * 32 + ec * 2);
    const int p1tok0 = tid >> 5, p1cc = tid & 31, p1col = 1536 + p1cc * 8;
    const f32x4 p1m0 = *(const f32x4*)(mu + p1col), p1m1 = *(const f32x4*)(mu + p1col + 4);
    float S[4] = {0.f, 0.f, 0.f, 0.f};
    const int rl = wid * 4 + g, kq = fr;
    const size_t nb0 = (size_t)b * SEQ;
    u32x4 l_cu[2], l_pv[2]; u32x2 l_rc, l_kc, l_rp, l_kp; unsigned l_vc, l_vp;
#define RW_ISSUE(t0n) do { \
        _Pragma("unroll") for (int _i = 0; _i < 2; ++_i) { const size_t _n = nb0 + (t0n) + p1tok0 + _i * 16; \
            l_cu[_i] = *(const u32x4*)(P0 + _n * NE_MAIN + p1col); l_pv[_i] = uzero4(); \
            if ((t0n) + p1tok0 + _i * 16 > 0) l_pv[_i] = *(const u32x4*)(P0 + (_n - 1) * NE_MAIN + p1col); } \
        { const size_t _n = nb0 + (t0n) + et; const bool _hp = ((t0n) + et) > 0; \
            l_rc = *(const u32x2*)(P0 + _n * NE_MAIN + h * 64 + ec * 4); l_kc = *(const u32x2*)(P0 + _n * NE_MAIN + 512 + h * 64 + ec * 4); \
            l_vc = *(const unsigned*)(P0 + _n * NE_MAIN + 1024 + h * 64 + rq * 32 + ec * 2); \
            l_rp = (u32x2){0u, 0u}; l_kp = (u32x2){0u, 0u}; l_vp = 0u; \
            if (_hp) { l_rp = *(const u32x2*)(P0 + (_n - 1) * NE_MAIN + h * 64 + ec * 4); l_kp = *(const u32x2*)(P0 + (_n - 1) * NE_MAIN + 512 + h * 64 + ec * 4); \
                l_vp = *(const unsigned*)(P0 + (_n - 1) * NE_MAIN + 1024 + h * 64 + rq * 32 + ec * 2); } } } while (0)
#define MIX2(wc, wp, mA, mB, o0, o1) { const float c0 = __uint_as_float((wc) << 16), c1 = __uint_as_float((wc) & 0xffff0000u), q0 = __uint_as_float((wp) << 16), q1 = __uint_as_float((wp) & 0xffff0000u); o0 = c0 + (q0 - c0) * (mA); o1 = c1 + (q1 - c1) * (mB); }
    RW_ISSUE(0);
    for (int t0 = 0; t0 < SEQ; t0 += TC) {
#pragma unroll 1
        for (int prep_rep = 0; prep_rep < PREP_REP; ++prep_rep) {
#pragma unroll
        for (int i = 0; i < 2; ++i) {
            const int tok = p1tok0 + i * 16, cc = p1cc;
            const u32x4 cu = l_cu[i], pv = l_pv[i];
            float x[8];
            MIX2(cu.x, pv.x, p1m0[0], p1m0[1], x[0], x[1]) MIX2(cu.y, pv.y, p1m0[2], p1m0[3], x[2], x[3]) MIX2(cu.z, pv.z, p1m1[0], p1m1[1], x[4], x[5]) MIX2(cu.w, pv.w, p1m1[2], p1m1[3], x[6], x[7])
            if (cc < 8) {
#pragma unroll
                for (int j = 0; j < 8; ++j) x[j] = fast_tanh(x[j]); }
            else if (cc >= 16) {
#pragma unroll
                for (int j = 0; j < 8; ++j) x[j] = fast_sigmoid(x[j]); }
            u32x4 o; o.x = cvt_pk_bf16(x[0], x[1]); o.y = cvt_pk_bf16(x[2], x[3]); o.z = cvt_pk_bf16(x[4], x[5]); o.w = cvt_pk_bf16(x[6], x[7]);
            if (cc < 8) *(LAS u32x4*)(tw_i + tok * 128 + ((cc ^ (tok & 7)) * 16)) = o;
            else if (cc < 16) *(LAS u32x4*)(xa_i + tok * 128 + (((cc - 8) ^ (tok & 7)) * 16)) = o;
            else *(LAS u32x4*)(sg_i + tok * 256 + (((cc - 16) ^ (tok & 7)) * 16)) = o;
        }
        __syncthreads();
        {
            f32x4 dw = fzero4(), da = fzero4();
            const int row = mrt * 16 + fr;
#pragma unroll
            for (int s = 0; s < 2; ++s) {
                const bf16x8 ta = *(const LAS bf16x8*)(tw_i + row * 128 + (((s * 4 + g) ^ (row & 7)) * 16));
                const bf16x8 xa = *(const LAS bf16x8*)(xa_i + row * 128 + (((s * 4 + g) ^ (row & 7)) * 16));
                dw = __builtin_amdgcn_mfma_f32_16x16x32_bf16(ta, wf[s], dw, 0, 0, 0);
                da = __builtin_amdgcn_mfma_f32_16x16x32_bf16(xa, af[s], da, 0, 0, 0);
            }
#pragma unroll
            for (int r = 0; r < 4; ++r) { wpre[(mrt * 16 + g * 4 + r) * 64 + mct * 16 + fr] = dw[r]; apre[(mrt * 16 + g * 4 + r) * 64 + mct * 16 + fr] = da[r]; }
            if (wid < 4) {
                f32x4 dg = fzero4();
                const int grow = grt * 16 + fr;
#pragma unroll
                for (int s = 0; s < 4; ++s) { const bf16x8 sa_ = *(const LAS bf16x8*)(sg_i + grow * 256 + (((s * 4 + g) ^ (grow & 7)) * 16));
                    dg = __builtin_amdgcn_mfma_f32_16x16x32_bf16(sa_, gf[s], dg, 0, 0, 0); }
#pragma unroll
                for (int r = 0; r < 4; ++r) gpre[(grt * 16 + g * 4 + r) * 32 + gct * 16 + fr] = dg[r];
            }
        }
        __syncthreads();
        {
            const size_t n = nb0 + t0 + et;
            float rr[4], kr_[4];
            MIX2(l_rc.x, l_rp.x, mur[0], mur[1], rr[0], rr[1]) MIX2(l_rc.y, l_rp.y, mur[2], mur[3], rr[2], rr[3])
            MIX2(l_kc.x, l_kp.x, muk[0], muk[1], kr_[0], kr_[1]) MIX2(l_kc.y, l_kp.y, muk[2], muk[3], kr_[2], kr_[3])
            const f32x4 wp = *(const LAS f32x4*)(wpre + et * 64 + ec * 4), ap = *(const LAS f32x4*)(apre + et * 64 + ec * 4);
            float dec[4], aa[4], kkp[4], nsq = 0.f;
#pragma unroll
            for (int j = 0; j < 4; ++j) { const float z = w0v[j] + wp[j]; const float sp = __logf(1.0f + __expf(-z));
                dec[j] = __expf(-__expf(-sp - 0.5f)); aa[j] = fast_sigmoid(a0v[j] + ap[j]); kkp[j] = kr_[j] * kksc[j]; nsq += kkp[j] * kkp[j]; }
            nsq = red16(nsq);
            const float inrm = 1.0f / fmaxf(sqrtf(nsq), 1e-12f);
            f32x4 kkv, bv, khv, wrv, wv; float br = 0.f, kr2 = 0.f, rk = 0.f;
#pragma unroll
            for (int j = 0; j < 4; ++j) { const float kk = kkp[j] * inrm; const float kh = kr_[j] * (1.0f + (aa[j] - 1.0f) * kasc[j]); const float bb = kk * aa[j];
                kkv[j] = kk; bv[j] = bb; khv[j] = kh; wv[j] = dec[j]; wrv[j] = dec[j] * rr[j]; br += bb * rr[j]; kr2 += kh * rr[j]; rk += rr[j] * kh * rkv[j]; }
            br = red16(br); kr2 = red16(kr2); rk = red16(rk);
            *(LAS f32x4*)(kk_s + et * 64 + ec * 4) = kkv; *(LAS f32x4*)(w_s + et * 64 + ec * 4) = wv; *(LAS f32x4*)(b_s + et * 64 + ec * 4) = bv;
            *(LAS f32x4*)(kh_s + et * 64 + ec * 4) = khv; *(LAS f32x4*)(wr_s + et * 64 + ec * 4) = wrv;
            if (ec == 0) { sc_s[et * 2] = br; sc_s[et * 2 + 1] = kr2; }
            float v0, v1; MIX2(l_vc, l_vp, muv[0], muv[1], v0, v1)
            *(LAS f32x2*)(v_s + et * 32 + ec * 2) = (f32x2){v0, v1};
            const f32x2 gp = *(const LAS f32x2*)(gpre + et * 32 + ec * 2);
            *(unsigned*)(e1g + n * 512 + h * 64 + rq * 32 + ec * 2) = cvt_pk_bf16(rk * v0, rk * v1);
            *(unsigned*)(gg + n * 512 + h * 64 + rq * 32 + ec * 2) = cvt_pk_bf16(gp[0], gp[1]);
        }
        if (prep_rep + 1 < PREP_REP) __syncthreads();
        }
        if (t0 + TC < SEQ) RW_ISSUE(t0 + TC);
        __syncthreads();
        {
            f32x4 kkA = *(const LAS f32x4*)(kk_s + kq * 4), wrA = *(const LAS f32x4*)(wr_s + kq * 4), wwA = *(const LAS f32x4*)(w_s + kq * 4), bbA = *(const LAS f32x4*)(b_s + kq * 4), khA = *(const LAS f32x4*)(kh_s + kq * 4);
            float vvA = v_s[rl]; f32x2 scA = *(const LAS f32x2*)(sc_s);
            float yacc = 0.f;
#pragma unroll 1
            for (int t = 0; t < TC; ++t) {
                const int tn = (t + 1) & (TC - 1);
                const f32x4 kkB = *(const LAS f32x4*)(kk_s + tn * 64 + kq * 4), wrB = *(const LAS f32x4*)(wr_s + tn * 64 + kq * 4), wwB = *(const LAS f32x4*)(w_s + tn * 64 + kq * 4);
                const f32x4 bbB = *(const LAS f32x4*)(b_s + tn * 64 + kq * 4), khB = *(const LAS f32x4*)(kh_s + tn * 64 + kq * 4);
                const float vvB = v_s[tn * 32 + rl]; const f32x2 scB = *(const LAS f32x2*)(sc_s + tn * 2);
                float sa = S[0] * kkA[0] + S[1] * kkA[1] + S[2] * kkA[2] + S[3] * kkA[3];
                float yy = S[0] * wrA[0] + S[1] * wrA[1] + S[2] * wrA[2] + S[3] * wrA[3];
                sa = red16(sa); yy = red16(yy);
                const float y = yy - sa * scA[0] + vvA * scA[1];
                yacc = (kq == (t & 15)) ? y : yacc;
#pragma unroll
                for (int i = 0; i < 4; ++i) S[i] = S[i] * wwA[i] + (vvA * khA[i] - sa * bbA[i]);
                if ((t & 15) == 15) y_s[((t & 16) + kq) * 32 + rl] = yacc;
                kkA = kkB; wrA = wrB; wwA = wwB; bbA = bbB; khA = khB; vvA = vvB; scA = scB;
            }
        }
        __syncthreads();
        { const int tok = tid >> 4, c2 = (tid & 15) * 2; *(f32x2*)(yraw + (nb0 + t0 + tok) * 512 + h * 64 + rq * 32 + c2) = *(const LAS f32x2*)(y_s + tok * 32 + c2); }
    }
#undef MIX2
#undef RW_ISSUE
}

constexpr size_t OFF_ACT256 = OFF_U + 4 * MiB;
__device__ __forceinline__ void phase_lora_act(const Params& p, int bid, int nb) {
    const int tid = opaque_tid();
    const bf16_t* P0 = (const bf16_t*)(p.ws + OFF_P); bf16_t* act = (bf16_t*)(p.ws + OFF_ACT256);
    const float* mu = p.in[I_AMU];
    const int cc = tid & 31, col = 1536 + cc * 8;
    const f32x4 m0 = *(const f32x4*)(mu + col), m1 = *(const f32x4*)(mu + col + 4);
    for (int n = bid * 16 + (tid >> 5); n < NTOK; n += nb * 16) {
        const u32x4 cu = *(const u32x4*)(P0 + (size_t)n * NE_MAIN + col); u32x4 pv = uzero4(); if ((n & (SEQ - 1)) > 0) pv = *(const u32x4*)(P0 + (size_t)(n - 1) * NE_MAIN + col);
        const unsigned cw[4] = {cu.x, cu.y, cu.z, cu.w}, pw[4] = {pv.x, pv.y, pv.z, pv.w}; float x[8];
#pragma unroll
        for (int j = 0; j < 4; ++j) { const float c0 = __uint_as_float(cw[j] << 16), c1 = __uint_as_float(cw[j] & 0xffff0000u), q0 = __uint_as_float(pw[j] << 16), q1 = __uint_as_float(pw[j] & 0xffff0000u);
            const float ma = (j < 2 ? m0[2 * j] : m1[2 * j - 4]), mb = (j < 2 ? m0[2 * j + 1] : m1[2 * j - 3]);
            x[2 * j] = c0 + (q0 - c0) * ma; x[2 * j + 1] = c1 + (q1 - c1) * mb; }
        if (cc < 8) {
#pragma unroll
            for (int j = 0; j < 8; ++j) x[j] = fast_tanh(x[j]); }
        else if (cc >= 16) {
#pragma unroll
            for (int j = 0; j < 8; ++j) x[j] = fast_sigmoid(x[j]); }
        u32x4 o; o.x = cvt_pk_bf16(x[0], x[1]); o.y = cvt_pk_bf16(x[2], x[3]); o.z = cvt_pk_bf16(x[4], x[5]); o.w = cvt_pk_bf16(x[6], x[7]);
        *(u32x4*)(act + (size_t)n * 256 + cc * 8) = o;
    }
}

template <int CTRL> __device__ __forceinline__ float dpp0f(float v) { return __builtin_bit_cast(float, __builtin_amdgcn_update_dpp(0, __builtin_bit_cast(int, v), CTRL, 0xf, 0xf, true)); }
__device__ __forceinline__ bf16x8 pack_lo4(const f32x4 a) { u32x4 w; w.x = cvt_pk_bf16(a[0], a[1]); w.y = cvt_pk_bf16(a[2], a[3]); w.z = 0u; w.w = 0u; return __builtin_bit_cast(bf16x8, w); }
__device__ __forceinline__ bf16x8 pack_8(const f32x4 a, const f32x4 b) { u32x4 w; w.x = cvt_pk_bf16(a[0], a[1]); w.y = cvt_pk_bf16(a[2], a[3]); w.z = cvt_pk_bf16(b[0], b[1]); w.w = cvt_pk_bf16(b[2], b[3]); return __builtin_bit_cast(bf16x8, w); }
__device__ __forceinline__ f32x4 mm16(const f32x4 PT, const f32x4 Q) { return __builtin_amdgcn_mfma_f32_16x16x32_bf16(pack_lo4(PT), pack_lo4(Q), fzero4(), 0, 0, 0); }
constexpr int RW3_SLOT = 12544;
__device__ __forceinline__ int rw3_trswz(int row, int c) { return (((c >> 1) ^ ((row >> 1) & 3)) << 1) | (c & 1); }
__device__ __forceinline__ void rwkv3_item(const Params& p, LAS unsigned char* lds, int item) {
    const int tid = opaque_tid(), lane = tid & 63, wid = tid >> 6, fr = lane & 15, g = lane >> 4;
    const int b = item >> 3, h = item & 7;
    unsigned char* ws = p.ws;
    const bf16_t* P0 = (const bf16_t*)(ws + OFF_P);
    float* yraw = p.out; bf16_t* e1g = (bf16_t*)(p.out + (size_t)NTOK * 512); bf16_t* gg = e1g + (size_t)NTOK * 512;
    LAS unsigned char* w2h = lds;
    LAS unsigned char* a2h = lds + 8192;
    LAS unsigned char* g2h = lds + 16384;
    LAS unsigned char* slots = lds + 32768;
    LAS float* ptab = (LAS float*)(lds + 32768 + 8 * RW3_SLOT);
    LAS float* mul = ptab + 8 * 64;
    {
        const float* mu = p.in[I_AMU];
        if (tid < 64) { ptab[tid] = mu[h * 64 + tid]; ptab[64 + tid] = mu[512 + h * 64 + tid]; ptab[128 + tid] = mu[1024 + h * 64 + tid];
            ptab[192 + tid] = p.in[I_AW0][h * 64 + tid]; ptab[256 + tid] = p.in[I_AA0][h * 64 + tid]; ptab[320 + tid] = p.in[I_AKK][h * 64 + tid];
            ptab[384 + tid] = p.in[I_AKA][h * 64 + tid]; ptab[448 + tid] = p.in[I_ARK][h * 64 + tid]; }
        if (tid < 256) mul[tid] = mu[1536 + tid];
    }
    {
        const bf16_t* w2t = (const bf16_t*)(ws + OFF_MISC + MISC_W2T); const bf16_t* a2t = (const bf16_t*)(ws + OFF_MISC + MISC_A2T); const bf16_t* g2t = (const bf16_t*)(ws + OFF_MISC + MISC_G2T);
        { const int row = tid >> 3, c = tid & 7;
            *(LAS u32x4*)(w2h + row * 128 + ((c ^ (row & 7)) * 16)) = *(const u32x4*)(w2t + (size_t)(h * 64 + row) * 64 + c * 8);
            *(LAS u32x4*)(a2h + row * 128 + ((c ^ (row & 7)) * 16)) = *(const u32x4*)(a2t + (size_t)(h * 64 + row) * 64 + c * 8); }
#pragma unroll
        for (int i = 0; i < 2; ++i) { const int q = tid + i * 512, row = q >> 4, c = q & 15;
            *(LAS u32x4*)(g2h + row * 256 + ((c ^ (row & 7)) * 16)) = *(const u32x4*)(g2t + (size_t)(h * 64 + row) * 128 + c * 8); }
    }
    __syncthreads();
    f32x4 Hacc[4];
#pragma unroll
    for (int rt = 0; rt < 4; ++rt) Hacc[rt] = fzero4();
    const size_t nb0 = (size_t)b * SEQ;
    const int q4 = fr >> 2, p4 = fr & 3;
#define MIXB(wc, wp, mA, mB, o0, o1) { const float c0 = __uint_as_float((wc) << 16), c1 = __uint_as_float((wc) & 0xffff0000u), q0 = __uint_as_float((wp) << 16), q1 = __uint_as_float((wp) & 0xffff0000u); o0 = c0 + (q0 - c0) * (mA); o1 = c1 + (q1 - c1) * (mB); }
    const bf16_t* actp = (const bf16_t*)(ws + OFF_ACT256);
    u32x2 nrc[4], nkc[4], nvc[4], nrp[4], nkp[4], nvp[4]; bf16x8 nb_[8];
#define RW3_LOADS(tk) do { const int t0_ = ((tk) * 8 + wid) * 16; const int fr_ = lane & 15, g_ = lane >> 4; const size_t n_ = nb0 + t0_ + fr_; const bool hp_ = (t0_ + fr_) > 0; \
        const bf16_t* rc_ = P0 + n_ * NE_MAIN; const bf16_t* rp_ = rc_ - NE_MAIN; \
        _Pragma("unroll") for (int ct = 0; ct < 4; ++ct) { const int c0 = ct * 16 + g_ * 4; \
            nrc[ct] = *(const u32x2*)(rc_ + h * 64 + c0); nkc[ct] = *(const u32x2*)(rc_ + 512 + h * 64 + c0); nvc[ct] = *(const u32x2*)(rc_ + 1024 + h * 64 + c0); \
            nrp[ct] = (u32x2){0u, 0u}; nkp[ct] = nrp[ct]; nvp[ct] = nrp[ct]; \
            if (hp_) { nrp[ct] = *(const u32x2*)(rp_ + h * 64 + c0); nkp[ct] = *(const u32x2*)(rp_ + 512 + h * 64 + c0); nvp[ct] = *(const u32x2*)(rp_ + 1024 + h * 64 + c0); } } \
        _Pragma("unroll") for (int f = 0; f < 8; ++f) nb_[f] = *(const bf16x8*)(actp + n_ * 256 + f * 32 + g_ * 8); } while (0)
#pragma unroll 1
    for (int tick = 0; tick < SEQ / 128; ++tick) {
        {
            int lane_t = lane; asm volatile("" : "+v"(lane_t));
            const int fr = lane_t & 15, g = lane_t >> 4, q4 = fr >> 2, p4 = fr & 3;
            LAS unsigned char* sl = slots + wid * RW3_SLOT;
            LAS unsigned char* Qt_i = sl, * Rh_i = sl + 2048, * Kh_i = sl + 4096, * Bn_i = sl + 6144, * Vi_i = sl + 8192, * M1_i = sl + 10240, * DD_i = sl + 11264; LAS float* gam_i = (LAS float*)(sl + 12288);
            const int t0 = (tick * 8 + wid) * 16;
            const size_t n = nb0 + t0 + fr;
            const bool hasp = (t0 + fr) > 0;
            const bf16_t* rowc = P0 + n * NE_MAIN; const bf16_t* rowp = rowc - NE_MAIN;
            RW3_LOADS(tick);
#define lrc nrc
#define lkc nkc
#define lvc nvc
#define lrp nrp
#define lkp nkp
#define lvp nvp
            bf16x8 bw[2], ba[2], bg[4];
            bw[0] = nb_[0]; bw[1] = nb_[1]; ba[0] = nb_[2]; ba[1] = nb_[3]; bg[0] = nb_[4]; bg[1] = nb_[5]; bg[2] = nb_[6]; bg[3] = nb_[7];
            f32x4 Wt[4], At[4], Gt[4];
#pragma unroll
            for (int ct = 0; ct < 4; ++ct) {
                const int row = ct * 16 + fr;
                f32x4 dw = fzero4(), da = dw, dg = dw;
#pragma unroll
                for (int s = 0; s < 2; ++s) {
                    dw = __builtin_amdgcn_mfma_f32_16x16x32_bf16(*(const LAS bf16x8*)(w2h + row * 128 + (((s * 4 + g) ^ (row & 7)) * 16)), bw[s], dw, 0, 0, 0);
                    da = __builtin_amdgcn_mfma_f32_16x16x32_bf16(*(const LAS bf16x8*)(a2h + row * 128 + (((s * 4 + g) ^ (row & 7)) * 16)), ba[s], da, 0, 0, 0); }
#pragma unroll
                for (int s = 0; s < 4; ++s) dg = __builtin_amdgcn_mfma_f32_16x16x32_bf16(*(const LAS bf16x8*)(g2h + row * 256 + (((s * 4 + g) ^ (row & 7)) * 16)), bg[s], dg, 0, 0, 0);
                Wt[ct] = dw; At[ct] = da; Gt[ct] = dg;
            }
            f32x4 Rm[4], Khm[4], Lw[4], Aa[4];
            float nsq = 0.f, rk = 0.f;
            u32x2 Vp[4];
#pragma unroll
            for (int ct = 0; ct < 4; ++ct) {
                const int c0 = ct * 16 + g * 4;
                const u32x2 rc = lrc[ct], kc = lkc[ct], vc = lvc[ct], rp = lrp[ct], kp = lkp[ct], vp = lvp[ct];
                const f32x4 mr = *(const LAS f32x4*)(ptab + c0), mk = *(const LAS f32x4*)(ptab + 64 + c0), mv = *(const LAS f32x4*)(ptab + 128 + c0);
                f32x4 Km, Vm;
                MIXB(rc.x, rp.x, mr[0], mr[1], Rm[ct][0], Rm[ct][1]) MIXB(rc.y, rp.y, mr[2], mr[3], Rm[ct][2], Rm[ct][3])
                MIXB(kc.x, kp.x, mk[0], mk[1], Km[0], Km[1]) MIXB(kc.y, kp.y, mk[2], mk[3], Km[2], Km[3])
                MIXB(vc.x, vp.x, mv[0], mv[1], Vm[0], Vm[1]) MIXB(vc.y, vp.y, mv[2], mv[3], Vm[2], Vm[3])
                const f32x4 w0v = *(const LAS f32x4*)(ptab + 192 + c0), a0v = *(const LAS f32x4*)(ptab + 256 + c0), kks = *(const LAS f32x4*)(ptab + 320 + c0), kas = *(const LAS f32x4*)(ptab + 384 + c0), rkp = *(const LAS f32x4*)(ptab + 448 + c0);
#pragma unroll
                for (int r = 0; r < 4; ++r) { const float z = w0v[r] + Wt[ct][r]; const float sp = __logf(1.0f + __expf(-z));
                    Lw[ct][r] = -__expf(-sp - 0.5f);
                    const float a = fast_sigmoid(a0v[r] + At[ct][r]); Aa[ct][r] = a;
                    const float kkp = Km[r] * kks[r]; nsq += kkp * kkp; Wt[ct][r] = kkp;
                    const float kh = Km[r] * (1.0f + (a - 1.0f) * kas[r]); Khm[ct][r] = kh; rk += Rm[ct][r] * kh * rkp[r]; }
                Vp[ct].x = cvt_pk_bf16(Vm[0], Vm[1]); Vp[ct].y = cvt_pk_bf16(Vm[2], Vm[3]);
                At[ct] = Vm;
            }
            nsq += __shfl_xor(nsq, 16); nsq += __shfl_xor(nsq, 32);
            rk += __shfl_xor(rk, 16); rk += __shfl_xor(rk, 32);
            const float inrm = 1.0f / fmaxf(sqrtf(nsq), 1e-12f);
#pragma unroll
            for (int ct = 0; ct < 4; ++ct) { const int c0 = ct * 16 + g * 4;
                u32x2 ew, gw; ew.x = cvt_pk_bf16(rk * At[ct][0], rk * At[ct][1]); ew.y = cvt_pk_bf16(rk * At[ct][2], rk * At[ct][3]);
                gw.x = cvt_pk_bf16(Gt[ct][0], Gt[ct][1]); gw.y = cvt_pk_bf16(Gt[ct][2], Gt[ct][3]);
                *(u32x2*)(e1g + n * 512 + h * 64 + c0) = ew; *(u32x2*)(gg + n * 512 + h * 64 + c0) = gw;
                const int c = 2 * ct + (g >> 1);
                *(LAS u32x2*)(Vi_i + fr * 128 + rw3_trswz(fr, c) * 16 + (g & 1) * 8) = Vp[ct]; }
            u32x2 Qp[4], Kp[4], Bp[4], Rp[4];
#pragma unroll
            for (int ct = 0; ct < 4; ++ct) {
                const int c0 = ct * 16 + g * 4;
                f32x4 gmv; float qh[4], kh_[4], bh[4], rh[4];
#pragma unroll
                for (int r = 0; r < 4; ++r) {
                    float L = Lw[ct][r];
                    L += dpp0f<0x111>(L); L += dpp0f<0x112>(L); L += dpp0f<0x114>(L); L += dpp0f<0x118>(L);
                    const float Ltot = red16(Lw[ct][r]);
                    const float eL = __expf(L), ieL = fast_rcp(eL), eLex = __expf(L - Lw[ct][r]);
                    const float kk = Wt[ct][r] * inrm, bb = kk * Aa[ct][r];
                    qh[r] = kk * eLex; kh_[r] = Khm[ct][r] * ieL; bh[r] = bb * ieL; rh[r] = Rm[ct][r] * eL;
                    gmv[r] = __expf(Ltot); }
                Qp[ct].x = cvt_pk_bf16(qh[0], qh[1]); Qp[ct].y = cvt_pk_bf16(qh[2], qh[3]); Kp[ct].x = cvt_pk_bf16(kh_[0], kh_[1]); Kp[ct].y = cvt_pk_bf16(kh_[2], kh_[3]);
                Bp[ct].x = cvt_pk_bf16(bh[0], bh[1]); Bp[ct].y = cvt_pk_bf16(bh[2], bh[3]); Rp[ct].x = cvt_pk_bf16(rh[0], rh[1]); Rp[ct].y = cvt_pk_bf16(rh[2], rh[3]);
                if (fr == 0) *(LAS f32x4*)(gam_i + c0) = gmv;
            }
            bf16x8 Qf[2], Kf[2], Bf[2], Rf[2];
#pragma unroll
            for (int s = 0; s < 2; ++s) { Qf[s] = __builtin_bit_cast(bf16x8, (u32x4){Qp[2 * s].x, Qp[2 * s].y, Qp[2 * s + 1].x, Qp[2 * s + 1].y}); Kf[s] = __builtin_bit_cast(bf16x8, (u32x4){Kp[2 * s].x, Kp[2 * s].y, Kp[2 * s + 1].x, Kp[2 * s + 1].y});
                Bf[s] = __builtin_bit_cast(bf16x8, (u32x4){Bp[2 * s].x, Bp[2 * s].y, Bp[2 * s + 1].x, Bp[2 * s + 1].y}); Rf[s] = __builtin_bit_cast(bf16x8, (u32x4){Rp[2 * s].x, Rp[2 * s].y, Rp[2 * s + 1].x, Rp[2 * s + 1].y}); }
            f32x4 Ab = fzero4(), AbT = Ab, Ak = Ab, DkT = Ab, DbT = Ab;
#pragma unroll
            for (int s = 0; s < 2; ++s) {
                Ab = __builtin_amdgcn_mfma_f32_16x16x32_bf16(Qf[s], Bf[s], Ab, 0, 0, 0);
                AbT = __builtin_amdgcn_mfma_f32_16x16x32_bf16(Bf[s], Qf[s], AbT, 0, 0, 0);
                Ak = __builtin_amdgcn_mfma_f32_16x16x32_bf16(Qf[s], Kf[s], Ak, 0, 0, 0);
                DkT = __builtin_amdgcn_mfma_f32_16x16x32_bf16(Kf[s], Rf[s], DkT, 0, 0, 0);
                DbT = __builtin_amdgcn_mfma_f32_16x16x32_bf16(Bf[s], Rf[s], DbT, 0, 0, 0); }
            f32x4 N, NT, ident;
#pragma unroll
            for (int r = 0; r < 4; ++r) { const int row = 4 * g + r;
                N[r] = (fr < row) ? -Ab[r] : 0.f; Ak[r] = (fr < row) ? Ak[r] : 0.f;
                NT[r] = (row < fr) ? -AbT[r] : 0.f;
                DkT[r] = (row <= fr) ? DkT[r] : 0.f; DbT[r] = (row <= fr) ? -DbT[r] : 0.f;
                ident[r] = (row == fr) ? 1.f : 0.f; }
            const f32x4 N2 = mm16(NT, N), N2T = mm16(N, NT);
            const f32x4 N4 = mm16(N2T, N2), N4T = mm16(N2, N2T);
            const f32x4 N8T = mm16(N4, N4T);
            const f32x4 X1 = N + ident, X1T = NT + ident, X2 = N2 + ident, X2T = N2T + ident, X4 = N4 + ident, X8T = N8T + ident;
            const f32x4 U12 = mm16(X1T, X2), U12T = mm16(X1, X2T), U34T = mm16(X4, X8T);
            const f32x4 TT = mm16(U12, U34T);
            const f32x4 M1T = mm16(Ak, TT);
#pragma unroll
            for (int ct = 0; ct < 4; ++ct) { const int c = 2 * ct + (g >> 1);
                *(LAS u32x2*)(Qt_i + fr * 128 + rw3_trswz(fr, c) * 16 + (g & 1) * 8) = Qp[ct]; }
            s16x4 qtr[4];
#pragma unroll
            for (int ct = 0; ct < 4; ++ct) { const int row = 4 * g + q4, c = 2 * ct + (p4 >> 1);
                qtr[ct] = __builtin_amdgcn_ds_read_tr16_b64_v4i16((LAS s16x4*)(Qt_i + row * 128 + rw3_trswz(row, c) * 16 + (p4 & 1) * 8)); }
            const bf16x8 TTf = pack_lo4(TT);
            f32x4 Qt[4];
#pragma unroll
            for (int ct = 0; ct < 4; ++ct) { const bf16x8 af = (bf16x8){qtr[ct][0], qtr[ct][1], qtr[ct][2], qtr[ct][3], 0, 0, 0, 0};
                Qt[ct] = __builtin_amdgcn_mfma_f32_16x16x32_bf16(af, TTf, fzero4(), 0, 0, 0); }
#pragma unroll
            for (int ct = 0; ct < 4; ++ct) {
                const int s = ct >> 1, hh = ct & 1;
                u32x2 w; w.x = cvt_pk_bf16(Qt[ct][0], Qt[ct][1]); w.y = cvt_pk_bf16(Qt[ct][2], Qt[ct][3]);
                *(LAS u32x2*)(Qt_i + fr * 128 + (((s * 4 + g) ^ (fr & 7)) * 16) + hh * 8) = w;
                *(LAS u32x2*)(Rh_i + fr * 128 + (((s * 4 + g) ^ (fr & 7)) * 16) + hh * 8) = Rp[ct];
                const int c = 2 * ct + (g >> 1);
                *(LAS u32x2*)(Kh_i + fr * 128 + rw3_trswz(fr, c) * 16 + (g & 1) * 8) = Kp[ct];
                *(LAS u32x2*)(Bn_i + fr * 128 + rw3_trswz(fr, c) * 16 + (g & 1) * 8) = (u32x2){Bp[ct].x ^ 0x80008000u, Bp[ct].y ^ 0x80008000u}; }
            { const int cs = (g ^ ((fr >> 2) & 3)) * 16;
                u32x2 w; w.x = cvt_pk_bf16(M1T[0], M1T[1]); w.y = cvt_pk_bf16(M1T[2], M1T[3]);
                *(LAS u32x2*)(M1_i + fr * 64 + cs) = (u32x2){0u, 0u}; *(LAS u32x2*)(M1_i + fr * 64 + cs + 8) = w;
                w.x = cvt_pk_bf16(DbT[0], DbT[1]); w.y = cvt_pk_bf16(DbT[2], DbT[3]); *(LAS u32x2*)(DD_i + fr * 64 + cs) = w;
                w.x = cvt_pk_bf16(DkT[0], DkT[1]); w.y = cvt_pk_bf16(DkT[2], DkT[3]); *(LAS u32x2*)(DD_i + fr * 64 + cs + 8) = w; }
        }
        __syncthreads();
        if (wid < 4) {
#pragma unroll 1
            for (int j = 0; j < 8; ++j) {
                int lane_t = lane; asm volatile("" : "+v"(lane_t));
                const int fr = lane_t & 15, g = lane_t >> 4, q4 = fr >> 2, p4 = fr & 3;
                LAS unsigned char* sl = slots + j * RW3_SLOT;
                LAS unsigned char* Qt_i = sl, * Rh_i = sl + 2048, * Kh_i = sl + 4096, * Bn_i = sl + 6144, * Vi_i = sl + 8192, * M1_i = sl + 10240, * DD_i = sl + 11264; LAS const float* gam_i = (LAS const float*)(sl + 12288);
                const bf16x8 Hb0 = pack_8(Hacc[0], Hacc[1]), Hb1 = pack_8(Hacc[2], Hacc[3]);
                const int trow = 4 * g + q4;
                const s16x4 vv = __builtin_amdgcn_ds_read_tr16_b64_v4i16((LAS s16x4*)(Vi_i + trow * 128 + rw3_trswz(trow, 2 * wid + (p4 >> 1)) * 16 + (p4 & 1) * 8));
                const bf16x8 q0 = *(const LAS bf16x8*)(Qt_i + fr * 128 + (((0 + g) ^ (fr & 7)) * 16)), q1 = *(const LAS bf16x8*)(Qt_i + fr * 128 + (((4 + g) ^ (fr & 7)) * 16));
                const bf16x8 r0 = *(const LAS bf16x8*)(Rh_i + fr * 128 + (((0 + g) ^ (fr & 7)) * 16)), r1 = *(const LAS bf16x8*)(Rh_i + fr * 128 + (((4 + g) ^ (fr & 7)) * 16));
                const int cs = (g ^ ((fr >> 2) & 3)) * 16;
                const bf16x8 m1 = *(const LAS bf16x8*)(M1_i + fr * 64 + cs), dd = *(const LAS bf16x8*)(DD_i + fr * 64 + cs);
                const bf16x8 v0 = (bf16x8){0, 0, 0, 0, vv[0], vv[1], vv[2], vv[3]};
                f32x4 Z = fzero4();
                Z = __builtin_amdgcn_mfma_f32_16x16x32_bf16(q0, Hb0, Z, 0, 0, 0); Z = __builtin_amdgcn_mfma_f32_16x16x32_bf16(q1, Hb1, Z, 0, 0, 0); Z = __builtin_amdgcn_mfma_f32_16x16x32_bf16(m1, v0, Z, 0, 0, 0);
                u32x2 zw; zw.x = cvt_pk_bf16(Z[0], Z[1]); zw.y = cvt_pk_bf16(Z[2], Z[3]);
                const s16x4 zs = __builtin_bit_cast(s16x4, zw);
                const bf16x8 zv = (bf16x8){zs[0], zs[1], zs[2], zs[3], vv[0], vv[1], vv[2], vv[3]};
                f32x4 Y = fzero4();
                Y = __builtin_amdgcn_mfma_f32_16x16x32_bf16(r0, Hb0, Y, 0, 0, 0); Y = __builtin_amdgcn_mfma_f32_16x16x32_bf16(r1, Hb1, Y, 0, 0, 0); Y = __builtin_amdgcn_mfma_f32_16x16x32_bf16(dd, zv, Y, 0, 0, 0);
                const size_t nrow = nb0 + (size_t)(tick * 8 + j) * 16 + 4 * g;
#pragma unroll
                for (int r = 0; r < 4; ++r) yraw[(nrow + r) * 512 + h * 64 + wid * 16 + fr] = Y[r];
#pragma unroll
                for (int rt = 0; rt < 4; ++rt) { const int c = 2 * rt + (p4 >> 1);
                    const s16x4 bn = __builtin_amdgcn_ds_read_tr16_b64_v4i16((LAS s16x4*)(Bn_i + trow * 128 + rw3_trswz(trow, c) * 16 + (p4 & 1) * 8));
                    const s16x4 kh = __builtin_amdgcn_ds_read_tr16_b64_v4i16((LAS s16x4*)(Kh_i + trow * 128 + rw3_trswz(trow, c) * 16 + (p4 & 1) * 8));
                    const bf16x8 af = (bf16x8){bn[0], bn[1], bn[2], bn[3], kh[0], kh[1], kh[2], kh[3]};
                    Hacc[rt] = __builtin_amdgcn_mfma_f32_16x16x32_bf16(af, zv, Hacc[rt], 0, 0, 0);
                    Hacc[rt] = Hacc[rt] * *(const LAS f32x4*)(gam_i + rt * 16 + g * 4); }
            }
        }
        __syncthreads();
    }
#undef MIXB
#undef RW3_LOADS
#undef lrc
#undef lkc
#undef lvc
#undef lrp
#undef lkp
#undef lvp
}

__device__ __forceinline__ void phase_rwkv_epi(const Params& p, int bid, int nb) {
    const int tid = opaque_tid(), wid = tid >> 6, lane = tid & 63;
    const float* yraw = p.out; const bf16_t* e1g = (const bf16_t*)(p.out + (size_t)NTOK * 512); const bf16_t* gg = e1g + (size_t)NTOK * 512;
    bf16_t* mix = (bf16_t*)(p.ws + OFF_BUF64);
    const f32x4 g0 = *(const f32x4*)(p.in[I_AGNG] + lane * 8), g1 = *(const f32x4*)(p.in[I_AGNG] + lane * 8 + 4), b0 = *(const f32x4*)(p.in[I_AGNB] + lane * 8), b1 = *(const f32x4*)(p.in[I_AGNB] + lane * 8 + 4);
    for (int n = bid * 8 + wid; n < NTOK; n += nb * 8) {
        const f32x4 y0 = *(const f32x4*)(yraw + (size_t)n * 512 + lane * 8), y1 = *(const f32x4*)(yraw + (size_t)n * 512 + lane * 8 + 4);
        const u32x4 ev = *(const u32x4*)(e1g + (size_t)n * 512 + lane * 8), gv = *(const u32x4*)(gg + (size_t)n * 512 + lane * 8);
#if SANITIZE
        f32x4 y0s = y0, y1s = y1;
#pragma unroll
        for (int j = 0; j < 4; ++j) { if (!(fabsf(y0s[j]) < 1e30f)) y0s[j] = 0.f; if (!(fabsf(y1s[j]) < 1e30f)) y1s[j] = 0.f; }
#define y0 y0s
#define y1 y1s
#endif
        float s = (y0[0] + y0[1]) + (y0[2] + y0[3]) + (y1[0] + y1[1]) + (y1[2] + y1[3]);
        s = red8(s); const float mean = s * (1.0f / 64.0f);
        const f32x4 d0 = y0 - mean, d1 = y1 - mean;
        float q = (d0[0] * d0[0] + d0[1] * d0[1]) + (d0[2] * d0[2] + d0[3] * d0[3]) + (d1[0] * d1[0] + d1[1] * d1[1]) + (d1[2] * d1[2] + d1[3] * d1[3]);
        q = red8(q); const float rs = rsqrtf(q * (1.0f / 64.0f) + 64e-5f);
        float o[8];
        const unsigned ew[4] = {ev.x, ev.y, ev.z, ev.w}, gw[4] = {gv.x, gv.y, gv.z, gv.w};
#pragma unroll
        for (int j = 0; j < 4; ++j) { const float ya = (j < 2 ? d0[2 * j] : d1[2 * j - 4]), yb = (j < 2 ? d0[2 * j + 1] : d1[2 * j - 3]);
            const float ga = (j < 2 ? g0[2 * j] : g1[2 * j - 4]), gb_ = (j < 2 ? g0[2 * j + 1] : g1[2 * j - 3]); const float ba = (j < 2 ? b0[2 * j] : b1[2 * j - 4]), bb_ = (j < 2 ? b0[2 * j + 1] : b1[2 * j - 3]);
            o[2 * j] = (ya * rs * ga + ba + __uint_as_float(ew[j] << 16)) * __uint_as_float(gw[j] << 16);
            o[2 * j + 1] = (yb * rs * gb_ + bb_ + __uint_as_float(ew[j] & 0xffff0000u)) * __uint_as_float(gw[j] & 0xffff0000u); }
        u32x4 w; w.x = cvt_pk_bf16(o[0], o[1]); w.y = cvt_pk_bf16(o[2], o[3]); w.z = cvt_pk_bf16(o[4], o[5]); w.w = cvt_pk_bf16(o[6], o[7]);
#if SANITIZE
#undef y0
#undef y1
#pragma unroll
        for (int j = 0; j < 8; ++j) if (!(fabsf(o[j]) < 1e30f)) o[j] = 0.f;
        w.x = cvt_pk_bf16(o[0], o[1]); w.y = cvt_pk_bf16(o[2], o[3]); w.z = cvt_pk_bf16(o[4], o[5]); w.w = cvt_pk_bf16(o[6], o[7]);
#endif
        *(u32x4*)(mix + (size_t)n * DM + lane * 8) = w;
    }
}

__device__ __forceinline__ int gla_fT(int row) { return ((row >> 1) & 1) | (((row >> 3) & 1) << 1); }
__device__ __forceinline__ int gla_hV(int row) { return (row & 3) | (((row >> 3) & 1) << 2); }
__device__ __forceinline__ void gla2_item(const Params& p, LAS unsigned char* lds, int item) {
    const int tid = opaque_tid(), lane = tid & 63, wid = tid >> 6, fr = lane & 15, g = lane >> 4;
    const int b = item >> 2, h = item & 3;
    const bf16_t* P0 = (const bf16_t*)(p.ws + OFF_P) + 1792;
    const float* xa16 = (const float*)(p.ws + OFF_U);
    bf16_t* mix = (bf16_t*)(p.ws + OFF_BUF64);
    LAS float* bcf = (LAS float*)lds;
    LAS float* tot = bcf + 64 * 64;
    LAS float* bls = tot + 8 * 64;
    LAS float* pn = bls + 64;
    LAS float* xs = pn + 64 * 8;
    LAS unsigned char* qd_i = (LAS unsigned char*)(xs + 2 * 1024);
    LAS unsigned char* ki_a = qd_i + 8192;
    LAS unsigned char* ki_t = ki_a + 8192;
    LAS unsigned char* att_i = ki_t + 8192;
    LAS unsigned char* v_i = att_i + 8192;
    for (int i = tid; i < 8192 / 16; i += 512) *(LAS u32x4*)(att_i + i * 16) = uzero4();
    float gw2[16];
#pragma unroll
    for (int i = 0; i < 16; ++i) gw2[i] = p.in[I_BGW2][i * 256 + h * 64 + lane];
    const float gb = p.in[I_BGB][h * 64 + lane];
    const f32x4 ngv = *(const f32x4*)(p.in[I_BNG] + h * 128 + wid * 16 + g * 4);
    f32x4 Sacc[4];
#pragma unroll
    for (int rt = 0; rt < 4; ++rt) Sacc[rt] = fzero4();
    const int q4 = fr >> 2, p4 = fr & 3;
    const int tok = tid >> 3, dc = tid & 7;
    u32x4 nq, nk, nv0, nv1; u32x2 ngate[4]; f32x4 nxa = fzero4();
#define GLA_ISSUE(c0n) do { const size_t _n = (size_t)b * SEQ + (c0n) + tok; \
        nq = *(const u32x4*)(P0 + _n * NE_MAIN + h * 64 + dc * 8); nk = *(const u32x4*)(P0 + _n * NE_MAIN + 256 + h * 64 + dc * 8); \
        nv0 = *(const u32x4*)(P0 + _n * NE_MAIN + 512 + h * 128 + dc * 16); nv1 = *(const u32x4*)(P0 + _n * NE_MAIN + 512 + h * 128 + dc * 16 + 8); \
        _Pragma("unroll") for (int _ct = 0; _ct < 4; ++_ct) ngate[_ct] = *(const u32x2*)(P0 + ((size_t)b * SEQ + (c0n) + _ct * 16 + fr) * NE_MAIN + 1024 + h * 128 + wid * 16 + g * 4); \
        if (tid < 256) nxa = *(const f32x4*)(xa16 + ((size_t)b * SEQ + (c0n)) * 16 + tid * 4); } while (0)
    GLA_ISSUE(0);
    if (tid < 256) *(LAS f32x4*)(xs + tid * 4) = nxa;
    __syncthreads();
    for (int c0 = 0; c0 < SEQ; c0 += 64) {
        const size_t n0 = (size_t)b * SEQ + c0;
        LAS const float* xsc = xs + ((c0 >> 6) & 1) * 1024;
        { float run = 0.f;
#pragma unroll
            for (int tt = 0; tt < 8; ++tt) { const int c = wid * 8 + tt; float z = gb;
#pragma unroll
                for (int i4 = 0; i4 < 4; ++i4) { const f32x4 xv = *(const LAS f32x4*)(xsc + c * 16 + i4 * 4); z += xv[0] * gw2[i4 * 4] + xv[1] * gw2[i4 * 4 + 1] + xv[2] * gw2[i4 * 4 + 2] + xv[3] * gw2[i4 * 4 + 3]; }
                const float ls = fminf(z, 0.f) - __logf(1.0f + __expf(-fabsf(z)));
                run += ls * (1.0f / 16.0f); bcf[c * 64 + lane] = run; }
            tot[wid * 64 + lane] = run; }
        __syncthreads();
        { float off = 0.f;
            for (int w2 = 0; w2 < wid; ++w2) off += tot[w2 * 64 + lane];
#pragma unroll
            for (int tt = 0; tt < 8; ++tt) bcf[(wid * 8 + tt) * 64 + lane] += off;
            if (wid == 7) bls[lane] = __expf(bcf[63 * 64 + lane]); }
        __syncthreads();
        u32x2 gate[4];
        { const f32x4 bc0 = *(const LAS f32x4*)(bcf + tok * 64 + dc * 8), bc1 = *(const LAS f32x4*)(bcf + tok * 64 + dc * 8 + 4);
            const unsigned qw[4] = {nq.x, nq.y, nq.z, nq.w}, kw[4] = {nk.x, nk.y, nk.z, nk.w};
            float qo[8], ko[8];
#pragma unroll
            for (int j = 0; j < 4; ++j) { const float ba = (j < 2 ? bc0[2 * j] : bc1[2 * j - 4]), bb = (j < 2 ? bc0[2 * j + 1] : bc1[2 * j - 3]);
                const float ea = __expf(ba), eb = __expf(bb), ia = fast_rcp(ea), ib = fast_rcp(eb);
                qo[2 * j] = __uint_as_float(qw[j] << 16) * 0.125f * ea; qo[2 * j + 1] = __uint_as_float(qw[j] & 0xffff0000u) * 0.125f * eb;
                ko[2 * j] = __uint_as_float(kw[j] << 16) * ia; ko[2 * j + 1] = __uint_as_float(kw[j] & 0xffff0000u) * ib; }
            u32x4 qp, kp; qp.x = cvt_pk_bf16(qo[0], qo[1]); qp.y = cvt_pk_bf16(qo[2], qo[3]); qp.z = cvt_pk_bf16(qo[4], qo[5]); qp.w = cvt_pk_bf16(qo[6], qo[7]);
            kp.x = cvt_pk_bf16(ko[0], ko[1]); kp.y = cvt_pk_bf16(ko[2], ko[3]); kp.z = cvt_pk_bf16(ko[4], ko[5]); kp.w = cvt_pk_bf16(ko[6], ko[7]);
            *(LAS u32x4*)(qd_i + tok * 128 + ((dc ^ (tok & 7)) * 16)) = qp;
            *(LAS u32x4*)(ki_a + tok * 128 + ((dc ^ (tok & 7)) * 16)) = kp;
            *(LAS u32x4*)(ki_t + tok * 128 + (((((dc >> 1) ^ gla_fT(tok)) << 1) | (dc & 1)) * 16)) = kp;
            { const int pr = dc ^ gla_hV(tok); *(LAS u32x4*)(v_i + tok * 256 + (pr * 2) * 16) = nv0; *(LAS u32x4*)(v_i + tok * 256 + (pr * 2 + 1) * 16) = nv1; }
#pragma unroll
            for (int ct = 0; ct < 4; ++ct) gate[ct] = ngate[ct]; }
        if (c0 + 64 < SEQ) GLA_ISSUE(c0 + 64);
        __syncthreads();
        for (int ti = wid; ti < 10; ti += 8) {
            int st, ct; { const int tb[10] = {0x00, 0x01, 0x02, 0x03, 0x11, 0x12, 0x13, 0x22, 0x23, 0x33}; int code = 0;
#pragma unroll
                for (int k = 0; k < 10; ++k) if (k == ti) code = tb[k];
                st = code >> 4; ct = code & 15; }
            f32x4 d = fzero4();
            const int rs_ = st * 16 + fr, rc_ = ct * 16 + fr;
#pragma unroll
            for (int s = 0; s < 2; ++s) {
                const bf16x8 a = *(const LAS bf16x8*)(ki_a + rs_ * 128 + (((s * 4 + g) ^ (rs_ & 7)) * 16));
                const bf16x8 bq = *(const LAS bf16x8*)(qd_i + rc_ * 128 + (((s * 4 + g) ^ (rc_ & 7)) * 16));
                d = __builtin_amdgcn_mfma_f32_16x16x32_bf16(a, bq, d, 0, 0, 0); }
            const int c = ct * 16 + fr; float o4[4];
#pragma unroll
            for (int r = 0; r < 4; ++r) { const int s_ = st * 16 + g * 4 + r; o4[r] = (s_ <= c) ? d[r] : 0.f; }
            u32x2 w; w.x = cvt_pk_bf16(o4[0], o4[1]); w.y = cvt_pk_bf16(o4[2], o4[3]);
            *(LAS u32x2*)(att_i + c * 128 + (((2 * st + (g >> 1)) ^ (c & 7)) * 16) + (g & 1) * 8) = w;
        }
        __syncthreads();
        {
            bf16x8 vf[2];
#pragma unroll
            for (int s = 0; s < 2; ++s) {
                const int r1 = s * 32 + g * 8 + q4, r2 = r1 + 4; const int c = 2 * wid + (p4 >> 1);
                const s16x4 lo = __builtin_amdgcn_ds_read_tr16_b64_v4i16((LAS s16x4*)(v_i + r1 * 256 + (((((c >> 1) ^ gla_hV(r1)) << 1) | (c & 1)) * 16) + (p4 & 1) * 8));
                const s16x4 hi = __builtin_amdgcn_ds_read_tr16_b64_v4i16((LAS s16x4*)(v_i + r2 * 256 + (((((c >> 1) ^ gla_hV(r2)) << 1) | (c & 1)) * 16) + (p4 & 1) * 8));
                vf[s] = (bf16x8){lo[0], lo[1], lo[2], lo[3], hi[0], hi[1], hi[2], hi[3]}; }
            bf16x8 sf[2];
#pragma unroll
            for (int s = 0; s < 2; ++s) sf[s] = pack_8g(Sacc[2 * s], Sacc[2 * s + 1]);
            f32x4 oacc[4];
#pragma unroll
            for (int ct = 0; ct < 4; ++ct) {
                const int c = ct * 16 + fr; f32x4 d = fzero4();
#pragma unroll
                for (int s = 0; s < 2; ++s) {
                    const bf16x8 ab = *(const LAS bf16x8*)(att_i + c * 128 + (((s * 4 + g) ^ (c & 7)) * 16));
                    d = __builtin_amdgcn_mfma_f32_16x16x32_bf16(vf[s], ab, d, 0, 0, 0);
                    const s16x4 q0 = *(const LAS s16x4*)(qd_i + c * 128 + (((s * 4 + (g >> 1)) ^ (c & 7)) * 16) + (g & 1) * 8);
                    const s16x4 q1 = *(const LAS s16x4*)(qd_i + c * 128 + (((s * 4 + 2 + (g >> 1)) ^ (c & 7)) * 16) + (g & 1) * 8);
                    const bf16x8 qb = (bf16x8){q0[0], q0[1], q0[2], q0[3], q1[0], q1[1], q1[2], q1[3]};
                    d = __builtin_amdgcn_mfma_f32_16x16x32_bf16(sf[s], qb, d, 0, 0, 0); }
                oacc[ct] = d; }
#pragma unroll
            for (int rt = 0; rt < 4; ++rt) {
#pragma unroll
                for (int s = 0; s < 2; ++s) {
                    const int r1 = s * 32 + g * 8 + q4, r2 = r1 + 4; const int c = 2 * rt + (p4 >> 1);
                    const s16x4 lo = __builtin_amdgcn_ds_read_tr16_b64_v4i16((LAS s16x4*)(ki_t + r1 * 128 + (((((c >> 1) ^ gla_fT(r1)) << 1) | (c & 1)) * 16) + (p4 & 1) * 8));
                    const s16x4 hi = __builtin_amdgcn_ds_read_tr16_b64_v4i16((LAS s16x4*)(ki_t + r2 * 128 + (((((c >> 1) ^ gla_fT(r2)) << 1) | (c & 1)) * 16) + (p4 & 1) * 8));
                    const bf16x8 kf = (bf16x8){lo[0], lo[1], lo[2], lo[3], hi[0], hi[1], hi[2], hi[3]};
                    Sacc[rt] = __builtin_amdgcn_mfma_f32_16x16x32_bf16(kf, vf[s], Sacc[rt], 0, 0, 0); }
                const f32x4 eb = *(const LAS f32x4*)(bls + rt * 16 + g * 4);
                Sacc[rt] = Sacc[rt] * eb; }
#pragma unroll
            for (int ct = 0; ct < 4; ++ct) { float ss = oacc[ct][0] * oacc[ct][0] + oacc[ct][1] * oacc[ct][1] + oacc[ct][2] * oacc[ct][2] + oacc[ct][3] * oacc[ct][3];
                ss += __shfl_xor(ss, 16); ss += __shfl_xor(ss, 32);
                if (g == 0) pn[(ct * 16 + fr) * 8 + wid] = ss; }
            if (tid < 256 && c0 + 64 < SEQ) *(LAS f32x4*)(xs + (((c0 >> 6) + 1) & 1) * 1024 + tid * 4) = nxa;
            __syncthreads();
#pragma unroll
            for (int ct = 0; ct < 4; ++ct) { const int c = ct * 16 + fr;
                const f32x4 a0 = *(const LAS f32x4*)(pn + c * 8), a1 = *(const LAS f32x4*)(pn + c * 8 + 4);
                const float ss = (a0[0] + a0[1]) + (a0[2] + a0[3]) + (a1[0] + a1[1]) + (a1[2] + a1[3]);
                const float rs = rsqrtf(ss * (1.0f / 128.0f) + 1e-5f);
                const u32x2 gv = gate[ct];
                const float g0 = __uint_as_float(gv.x << 16), g1 = __uint_as_float(gv.x & 0xffff0000u), g2 = __uint_as_float(gv.y << 16), g3 = __uint_as_float(gv.y & 0xffff0000u);
                const float v0 = oacc[ct][0] * rs * ngv[0] * (g0 * fast_sigmoid(g0)), v1 = oacc[ct][1] * rs * ngv[1] * (g1 * fast_sigmoid(g1));
                const float v2 = oacc[ct][2] * rs * ngv[2] * (g2 * fast_sigmoid(g2)), v3 = oacc[ct][3] * rs * ngv[3] * (g3 * fast_sigmoid(g3));
                u32x2 w; w.x = cvt_pk_bf16(v0, v1); w.y = cvt_pk_bf16(v2, v3);
                *(u32x2*)(mix + (n0 + c) * DM + 512 + h * 128 + wid * 16 + g * 4) = w; }
        }
    }
#undef GLA_ISSUE
}

__device__ __forceinline__ void phase_mixer_even(const Params& p, LAS unsigned char* lds, int bid, int nb, int which) {
    for (int item = bid; item < 96; item += nb) {
        if (which != 2 && item < 64) rwkv3_item(p, lds, item); else if (which != 1 && item >= 64) gla2_item(p, lds, item - 64);
        __syncthreads();
    }
}

__device__ __forceinline__ void phase_rope(const Params& p, int bid, int nb) {
    const int tid = opaque_tid(), wid = tid >> 6, lane = tid & 63;
    unsigned char* ws = p.ws;
    const bf16_t* Pd = (const bf16_t*)(ws + OFF_PD);
    bf16_t* qr = (bf16_t*)(ws + OFF_BUF64); bf16_t* kr = (bf16_t*)(ws + OFF_KR); bf16_t* vv = (bf16_t*)(ws + OFF_VV);
    bf16_t* iqr = (bf16_t*)(ws + OFF_IQR); bf16_t* ikr = (bf16_t*)(ws + OFF_IKR); float* iw = (float*)(ws + OFF_IW);
    const float* c64 = (const float*)(ws + OFF_ROPE); const float* s64 = c64 + 4096 * 64; const float* c32 = s64 + 4096 * 64; const float* s32 = c32 + 4096 * 32;
    const float ikg = p.in[I_CIKG][lane], ikb = p.in[I_CIKB][lane];
    for (int n = bid * 8 + wid; n < NTOK; n += nb * 8) {
        const int pos = n & (SEQ - 1);
        const bf16_t* row = Pd + (size_t)n * NO_MAIN;
#define ROPE8(off1, off2, cs, sn, scale, dst, d1, d2) do { \
            const u32x4 a_ = *(const u32x4*)(row + (off1)), b_ = *(const u32x4*)(row + (off2)); \
            const f32x4 c0_ = *(const f32x4*)(cs), c1_ = *(const f32x4*)((cs) + 4), s0_ = *(const f32x4*)(sn), s1_ = *(const f32x4*)((sn) + 4); \
            const unsigned aw_[4] = {a_.x, a_.y, a_.z, a_.w}, bw_[4] = {b_.x, b_.y, b_.z, b_.w}; float o1_[8], o2_[8]; \
            _Pragma("unroll") for (int j_ = 0; j_ < 4; ++j_) { \
                const float z1a = __uint_as_float(aw_[j_] << 16), z1b = __uint_as_float(aw_[j_] & 0xffff0000u), z2a = __uint_as_float(bw_[j_] << 16), z2b = __uint_as_float(bw_[j_] & 0xffff0000u); \
                const float ca = (j_ < 2 ? c0_[2 * j_] : c1_[2 * j_ - 4]), cb = (j_ < 2 ? c0_[2 * j_ + 1] : c1_[2 * j_ - 3]), sa = (j_ < 2 ? s0_[2 * j_] : s1_[2 * j_ - 4]), sb = (j_ < 2 ? s0_[2 * j_ + 1] : s1_[2 * j_ - 3]); \
                o1_[2 * j_] = (z1a * ca - z2a * sa) * (scale); o1_[2 * j_ + 1] = (z1b * cb - z2b * sb) * (scale); o2_[2 * j_] = (z2a * ca + z1a * sa) * (scale); o2_[2 * j_ + 1] = (z2b * cb + z1b * sb) * (scale); } \
            u32x4 w1_, w2_; w1_.x = cvt_pk_bf16(o1_[0], o1_[1]); w1_.y = cvt_pk_bf16(o1_[2], o1_[3]); w1_.z = cvt_pk_bf16(o1_[4], o1_[5]); w1_.w = cvt_pk_bf16(o1_[6], o1_[7]); \
            w2_.x = cvt_pk_bf16(o2_[0], o2_[1]); w2_.y = cvt_pk_bf16(o2_[2], o2_[3]); w2_.z = cvt_pk_bf16(o2_[4], o2_[5]); w2_.w = cvt_pk_bf16(o2_[6], o2_[7]); \
            *(u32x4*)((dst) + (d1)) = w1_; *(u32x4*)((dst) + (d2)) = w2_; } while (0)
        { const int h = lane >> 3, jb = (lane & 7) * 8;
            ROPE8(h * 128 + jb, h * 128 + 64 + jb, c64 + pos * 64 + jb, s64 + pos * 64 + jb, 0.08838834764831845f, qr + (size_t)n * 1024, h * 128 + jb, h * 128 + 64 + jb); }
        if (lane < 8) { const int jb = lane * 8;
            ROPE8(1024 + jb, 1024 + 64 + jb, c64 + pos * 64 + jb, s64 + pos * 64 + jb, 1.0f, kr + (size_t)n * 128, jb, 64 + jb); }
        else if (lane < 24) { const int c = (lane - 8) * 8;
            *(u32x4*)(vv + (size_t)n * 128 + c) = *(const u32x4*)(row + 1152 + c); }
        else if (lane < 40) { const int h = (lane - 24) >> 2, jb = ((lane - 24) & 3) * 8;
            ROPE8(1280 + h * 64 + jb, 1280 + h * 64 + 32 + jb, c32 + pos * 32 + jb, s32 + pos * 32 + jb, 0.125f, iqr + (size_t)n * 256, h * 64 + jb, h * 64 + 32 + jb); }
#undef ROPE8
        const int j32 = lane & 31; const float cc = c32[pos * 32 + j32], ss = s32[pos * 32 + j32];
        { const float x = bf2f(row[1536 + lane]); const float mean = wave_sum(x) * (1.0f / 64.0f); const float d = x - mean; const float var = wave_sum(d * d) * (1.0f / 64.0f);
            const float y = d * rsqrtf(var + LN_EPS) * ikg + ikb; const float o = __shfl_xor(y, 32);
            const float res = lane < 32 ? (y * cc - o * ss) : (y * cc + o * ss);
            ikr[(size_t)n * 64 + lane] = f2bf(res); }
        if (lane < 4) iw[(size_t)n * 4 + lane] = bf2f(row[1600 + lane]) * 0.5f;
    }
}

__device__ __forceinline__ void phase_index(const Params& p, LAS unsigned char* lds, int bid, int nb) {
    const int tid = opaque_tid(), wid = tid >> 6, lane = tid & 63;
    unsigned char* ws = p.ws;
    const bf16_t* iqr = (const bf16_t*)(ws + OFF_IQR); const bf16_t* ikr = (const bf16_t*)(ws + OFF_IKR); const float* iw = (const float*)(ws + OFF_IW);
    unsigned short* idx = (unsigned short*)(ws + OFF_IDX);
    LAS unsigned* sc = (LAS unsigned*)lds + wid * 4096;
    LAS int* hist = (LAS int*)(lds + 131072) + wid * 256;
    LAS float* iqs = (LAS float*)(lds + 131072 + 8192) + wid * 256;
    const unsigned long long lt_mask = (1ull << lane) - 1ull;
    for (int n = bid * 8 + wid; n < NTOK; n += nb * 8) {
        const int t = n & (SEQ - 1), b = n >> 12, nv = t + 1;
        unsigned short* out = idx + (size_t)n * 256;
        if (nv <= 256) { for (int j = lane; j < 256; j += 64) out[j] = (unsigned short)(j < nv ? j : 0); continue; }
#pragma unroll
        for (int j = 0; j < 4; ++j) iqs[lane * 4 + j] = bf2f(iqr[(size_t)n * 256 + lane * 4 + j]);
        const float w0 = iw[(size_t)n * 4 + 0], w1 = iw[(size_t)n * 4 + 1], w2 = iw[(size_t)n * 4 + 2], w3 = iw[(size_t)n * 4 + 3];
        const int nvp = (nv + 63) & ~63;
        for (int c0 = 0; c0 < nvp; c0 += 64) {
            const int key = c0 + lane; const bool valid = key < nv;
            float kf[64];
            const u32x4* kp = (const u32x4*)(ikr + ((size_t)b * SEQ + (valid ? key : 0)) * 64);
#pragma unroll
            for (int q = 0; q < 8; ++q) { const u32x4 w = kp[q];
                kf[q * 8 + 0] = __uint_as_float(w.x << 16); kf[q * 8 + 1] = __uint_as_float(w.x & 0xffff0000u); kf[q * 8 + 2] = __uint_as_float(w.y << 16); kf[q * 8 + 3] = __uint_as_float(w.y & 0xffff0000u);
                kf[q * 8 + 4] = __uint_as_float(w.z << 16); kf[q * 8 + 5] = __uint_as_float(w.z & 0xffff0000u); kf[q * 8 + 6] = __uint_as_float(w.w << 16); kf[q * 8 + 7] = __uint_as_float(w.w & 0xffff0000u); }
            float sh[4];
#pragma unroll
            for (int h = 0; h < 4; ++h) { float a = 0.f;
#pragma unroll
                for (int d4 = 0; d4 < 16; ++d4) { const f32x4 qv = *(const LAS f32x4*)(iqs + h * 64 + d4 * 4); a += qv[0] * kf[d4 * 4] + qv[1] * kf[d4 * 4 + 1] + qv[2] * kf[d4 * 4 + 2] + qv[3] * kf[d4 * 4 + 3]; }
                sh[h] = fmaxf(a, 0.f); }
            float score = sh[0] * w0 + sh[1] * w1 + sh[2] * w2 + sh[3] * w3;
            score += 0.0f;
            unsigned u = __float_as_uint(score); u = (u & 0x80000000u) ? ~u : (u | 0x80000000u);
            sc[key] = valid ? u : 0u;
        }
        unsigned prefix = 0; int need = 256;
#pragma unroll 1
        for (int pass = 3; pass >= 0; --pass) {
            const int shift = pass * 8;
#pragma unroll
            for (int j = 0; j < 4; ++j) hist[lane * 4 + j] = 0;
            for (int c0 = 0; c0 < nvp; c0 += 64) { const unsigned u = sc[c0 + lane];
                const bool match = (c0 + lane < nv) && (pass == 3 || (u >> (shift + 8)) == prefix);
                if (match) __hip_atomic_fetch_add(hist + ((u >> shift) & 255u), 1, __ATOMIC_RELAXED, __HIP_MEMORY_SCOPE_WORKGROUP); }
            int hb[4];
#pragma unroll
            for (int j = 0; j < 4; ++j) hb[j] = hist[lane * 4 + j];
            const int tot = hb[0] + hb[1] + hb[2] + hb[3];
            int suf = tot;
#pragma unroll
            for (int off = 1; off < 64; off <<= 1) { const int v = __shfl_down(suf, off); if (lane + off < 64) suf += v; }
            const int above = suf - tot;
            const bool is = (above < need) && (need <= suf);
            int bin = 0, nneed = 0;
            if (is) { int c = above;
#pragma unroll
                for (int k = 3; k >= 0; --k) { if (nneed == 0) { if (need <= c + hb[k]) { bin = lane * 4 + k; nneed = need - c; } else c += hb[k]; } } }
            const unsigned long long bal = __ballot(is);
            const int src = __ffsll((long long)bal) - 1;
            bin = __shfl(bin, src); nneed = __shfl(nneed, src);
            prefix = (prefix << 8) | (unsigned)bin; need = nneed;
        }
        const unsigned T = prefix;
        int base = 0, ties = 0;
        for (int c0 = 0; c0 < nvp; c0 += 64) { const int key = c0 + lane; const unsigned u = sc[key]; const bool valid = key < nv;
            const bool gt = valid && u > T, eq = valid && u == T;
            const unsigned long long beq = __ballot(eq);
            const int rank = ties + __popcll(beq & lt_mask);
            const bool take = gt || (eq && rank < need);
            const unsigned long long bt = __ballot(take);
            const int pos = base + __popcll(bt & lt_mask);
            if (take && pos < 256) out[pos] = (unsigned short)key;
            base += __popcll(bt); ties += __popcll(beq); }
    }
}

__device__ __forceinline__ void phase_attn(const Params& p, LAS unsigned char* lds, int bid, int nb) {
    const int tid = opaque_tid(), wid = tid >> 6, lane = tid & 63;
    unsigned char* ws = p.ws;
    const bf16_t* qr = (const bf16_t*)(ws + OFF_BUF64); const bf16_t* kr = (const bf16_t*)(ws + OFF_KR); const bf16_t* vv = (const bf16_t*)(ws + OFF_VV);
    const unsigned short* idx = (const unsigned short*)(ws + OFF_IDX);
    bf16_t* ao = (bf16_t*)(ws + OFF_PD);
    LAS float* qs = (LAS float*)lds + wid * 1024;
    LAS float* ps = (LAS float*)(lds + 32768) + wid * 2048;
    LAS int* ks = (LAS int*)(lds + 32768 + 65536) + wid * 256;
    for (int n = bid * 8 + wid; n < NTOK; n += nb * 8) {
        const int t = n & (SEQ - 1), b = n >> 12, cnt = (t + 1) < 256 ? (t + 1) : 256;
        asm volatile("" ::: "memory");
#pragma unroll
        for (int j = 0; j < 16; ++j) qs[j * 64 + lane] = bf2f(qr[(size_t)n * 1024 + j * 64 + lane]);
#pragma unroll
        for (int r = 0; r < 4; ++r) ks[r * 64 + lane] = idx[(size_t)n * 256 + r * 64 + lane];
#pragma unroll 1
        for (int r = 0; r < 4; ++r) {
            const int j = r * 64 + lane; const bool valid = j < cnt; const int key = valid ? ks[j] : 0;
            const u32x4* kp = (const u32x4*)(kr + ((size_t)b * SEQ + key) * 128);
            float kf[128];
#pragma unroll
            for (int q = 0; q < 16; ++q) { const u32x4 w = kp[q];
                kf[q * 8 + 0] = __uint_as_float(w.x << 16); kf[q * 8 + 1] = __uint_as_float(w.x & 0xffff0000u); kf[q * 8 + 2] = __uint_as_float(w.y << 16); kf[q * 8 + 3] = __uint_as_float(w.y & 0xffff0000u);
                kf[q * 8 + 4] = __uint_as_float(w.z << 16); kf[q * 8 + 5] = __uint_as_float(w.z & 0xffff0000u); kf[q * 8 + 6] = __uint_as_float(w.w << 16); kf[q * 8 + 7] = __uint_as_float(w.w & 0xffff0000u); }
#pragma unroll 1
            for (int h = 0; h < 8; ++h) { float a = 0.f;
#pragma unroll
                for (int d4 = 0; d4 < 32; ++d4) { const f32x4 qv = *(const LAS f32x4*)(qs + h * 128 + d4 * 4);
                    a += qv[0] * kf[d4 * 4] + qv[1] * kf[d4 * 4 + 1] + qv[2] * kf[d4 * 4 + 2] + qv[3] * kf[d4 * 4 + 3]; }
                ps[h * 256 + j] = valid ? a : -INFINITY; }
        }
#pragma unroll
        for (int h = 0; h < 8; ++h) { float x[4]; float m = -INFINITY;
#pragma unroll
            for (int r = 0; r < 4; ++r) { x[r] = ps[h * 256 + r * 64 + lane]; m = fmaxf(m, x[r]); }
#pragma unroll
            for (int o = 32; o > 0; o >>= 1) m = fmaxf(m, __shfl_xor(m, o));
            float s = 0.f;
#pragma unroll
            for (int r = 0; r < 4; ++r) { x[r] = expf(x[r] - m); s += x[r]; }
            s = wave_sum(s); const float inv = 1.0f / s;
#pragma unroll
            for (int r = 0; r < 4; ++r) ps[h * 256 + r * 64 + lane] = x[r] * inv; }
        float o0[8], o1[8];
#pragma unroll
        for (int h = 0; h < 8; ++h) { o0[h] = 0.f; o1[h] = 0.f; }
        for (int j = 0; j < cnt; ++j) { const int key = ks[j];
            const unsigned w = *(const unsigned*)(vv + ((size_t)b * SEQ + key) * 128 + 2 * lane);
            const float v0 = __uint_as_float(w << 16), v1 = __uint_as_float(w & 0xffff0000u);
#pragma unroll
            for (int h = 0; h < 8; ++h) { const float pj = ps[h * 256 + j]; o0[h] += pj * v0; o1[h] += pj * v1; } }
#pragma unroll
        for (int h = 0; h < 8; ++h) *(unsigned*)(ao + (size_t)n * 1024 + h * 128 + 2 * lane) = cvt_pk_bf16(o0[h], o1[h]);
    }
}

__device__ __forceinline__ void attn_query(const bf16_t* qr, const bf16_t* kr, const bf16_t* vv, bf16_t* ao, int n, LAS const unsigned short* ks, LAS unsigned char* vbuf, int lane) {
    const int fr = lane & 15, g = lane >> 4, q4 = fr >> 2, p4 = fr & 3;
    const int t = n & (SEQ - 1), b = n >> 12, cnt = (t + 1) < 256 ? (t + 1) : 256;
    {
        bf16x8 qf[4];
#pragma unroll
        for (int s = 0; s < 4; ++s) { qf[s] = (bf16x8){0, 0, 0, 0, 0, 0, 0, 0}; if (fr < 8) qf[s] = *(const bf16x8*)(qr + (size_t)n * 1024 + fr * 128 + s * 32 + g * 8); }
        const bf16_t* kbase = kr + (size_t)b * SEQ * 128; const bf16_t* vbase = vv + (size_t)b * SEQ * 128;
        f32x4 acc[16];
        bf16x8 kf[3][2][4];
#define ATT_KLOAD(buf, grp) do { _Pragma("unroll") for (int t2 = 0; t2 < 2; ++t2) { const int j_ = ((grp) * 2 + t2) * 16 + fr; const int key_ = j_ < cnt ? (int)ks[j_] : 0; \
            const bf16_t* kp_ = kbase + (size_t)key_ * 128 + g * 8; _Pragma("unroll") for (int s = 0; s < 4; ++s) kf[buf][t2][s] = *(const bf16x8*)(kp_ + s * 32); } } while (0)
        ATT_KLOAD(0, 0); ATT_KLOAD(1, 1);
#pragma unroll
        for (int grp = 0; grp < 8; ++grp) {
            if (grp + 2 < 8) ATT_KLOAD((grp + 2) % 3, grp + 2);
#pragma unroll
            for (int t2 = 0; t2 < 2; ++t2) { f32x4 a = fzero4();
#pragma unroll
                for (int s = 0; s < 4; ++s) a = __builtin_amdgcn_mfma_f32_16x16x32_bf16(kf[grp % 3][t2][s], qf[s], a, 0, 0, 0);
                acc[grp * 2 + t2] = a; }
        }
#undef ATT_KLOAD
        u32x4 vr[2][8];
#define ATT_VLOAD(buf, s) do { _Pragma("unroll") for (int i = 0; i < 8; ++i) { const int kl_ = i * 4 + g; const int jj_ = (s) * 32 + kl_; const int key_ = jj_ < cnt ? (int)ks[jj_] : 0; \
            const int c_ = fr ^ ((kl_ & 7) << 1); vr[buf][i] = *(const u32x4*)(vbase + (size_t)key_ * 128 + c_ * 8); } } while (0)
        ATT_VLOAD(0, 0);
        float m = -INFINITY;
#pragma unroll
        for (int tl = 0; tl < 16; ++tl)
#pragma unroll
            for (int r = 0; r < 4; ++r) { if (tl * 16 + g * 4 + r >= cnt) acc[tl][r] = -INFINITY; m = fmaxf(m, acc[tl][r]); }
        m = fmaxf(m, __shfl_xor(m, 16)); m = fmaxf(m, __shfl_xor(m, 32));
        float sum = 0.f;
#pragma unroll
        for (int tl = 0; tl < 16; ++tl)
#pragma unroll
            for (int r = 0; r < 4; ++r) { const float e_ = __expf(acc[tl][r] - m); acc[tl][r] = e_; sum += e_; }
        sum += __shfl_xor(sum, 16); sum += __shfl_xor(sum, 32);
        const float inv = 1.0f / sum;
        bf16x8 pf[8];
#pragma unroll
        for (int s = 0; s < 8; ++s) pf[s] = pack_8g(acc[2 * s], acc[2 * s + 1]);
        f32x4 o[8];
#pragma unroll
        for (int dt = 0; dt < 8; ++dt) o[dt] = fzero4();
#pragma unroll
        for (int s = 0; s < 8; ++s) {
            LAS unsigned char* vb = vbuf + (s & 1) * 8192;
            if (s + 1 < 8) ATT_VLOAD((s + 1) & 1, s + 1);
#pragma unroll
            for (int i = 0; i < 8; ++i) { const int kl = i * 4 + g; *(LAS u32x4*)(vb + kl * 256 + fr * 16) = vr[s & 1][i]; }
            const int kl1 = 4 * g + q4, kl2 = 16 + 4 * g + q4;
#pragma unroll
            for (int dt = 0; dt < 8; ++dt) {
                const int c = 2 * dt + (p4 >> 1);
                const s16x4 lo = __builtin_amdgcn_ds_read_tr16_b64_v4i16((LAS s16x4*)(vb + kl1 * 256 + ((c ^ ((kl1 & 7) << 1)) * 16) + (p4 & 1) * 8));
                const s16x4 hi = __builtin_amdgcn_ds_read_tr16_b64_v4i16((LAS s16x4*)(vb + kl2 * 256 + ((c ^ ((kl2 & 7) << 1)) * 16) + (p4 & 1) * 8));
                const bf16x8 af = (bf16x8){lo[0], lo[1], lo[2], lo[3], hi[0], hi[1], hi[2], hi[3]};
                o[dt] = __builtin_amdgcn_mfma_f32_16x16x32_bf16(af, pf[s], o[dt], 0, 0, 0);
            }
        }
#undef ATT_VLOAD
        if (fr < 8) {
#pragma unroll
            for (int dt = 0; dt < 8; ++dt) { u32x2 w; w.x = cvt_pk_bf16(o[dt][0] * inv, o[dt][1] * inv); w.y = cvt_pk_bf16(o[dt][2] * inv, o[dt][3] * inv);
                *(u32x2*)(ao + (size_t)n * 1024 + fr * 128 + dt * 16 + g * 4) = w; }
        }
    }
}

__device__ __forceinline__ int idx_bin(float s, float lo, float scale) { int b = (int)((s - lo) * scale); b = b < 0 ? 0 : b; return b > 255 ? 255 : b; }
__device__ __forceinline__ unsigned ord_key(float s) { const unsigned u = __float_as_uint(s); return (u & 0x80000000u) ? ~u : (u | 0x80000000u); }
__device__ __forceinline__ float ord_val(unsigned k) { return __uint_as_float((k & 0x80000000u) ? (k & 0x7fffffffu) : ~k); }
__device__ __forceinline__ void phase_index2(const Params& p, LAS unsigned char* lds, int bid, int nb) {
    const int tid = opaque_tid(), wid = __builtin_amdgcn_readfirstlane(tid >> 6), lane0 = tid & 63;
    unsigned char* ws = p.ws;
    const bf16_t* iqr = (const bf16_t*)(ws + OFF_IQR); const bf16_t* ikr = (const bf16_t*)(ws + OFF_IKR); const float* iw = (const float*)(ws + OFF_IW);
    const bf16_t* qr = (const bf16_t*)(ws + OFF_BUF64); const bf16_t* kr = (const bf16_t*)(ws + OFF_KR); const bf16_t* vv = (const bf16_t*)(ws + OFF_VV); bf16_t* ao = (bf16_t*)(ws + OFF_PD);
    LAS unsigned short* out = (LAS unsigned short*)(lds + 131072 + 24576) + wid * 256;
    LAS float* sc = (LAS float*)lds;
    LAS int* hist = (LAS int*)(lds + 131072) + wid * 256;
    LAS float* candv = (LAS float*)(lds + 131072 + 8192) + wid * 264;
    LAS unsigned short* candi = (LAS unsigned short*)(lds + 131072 + 8192 + 8 * 264 * 4) + wid * 256;
    LAS unsigned* mm = (LAS unsigned*)(lds + 131072 + 8192 + 8 * 264 * 4 + 8 * 512);
    const int ntile = NTOK / 8;
    PROBE_DECL;
    PROBE_BEGIN(9);
    for (int it = bid; it < ntile; it += nb) {
        const int round = it / nb, qt = (round & 1) ? (round * nb + (nb - 1 - (it - round * nb))) : it;
        const int n0 = qt * 8, t0 = n0 & (SEQ - 1), b = n0 >> 12;
        int lane = lane0; asm volatile("" : "+v"(lane));
        const int fr = lane & 15, g = lane >> 4; const unsigned long long lt_mask = (1ull << lane) - 1ull;
        asm volatile("" ::: "memory");
        if (tid < 16) mm[tid] = (tid & 1) ? 0u : 0xffffffffu;
        __syncthreads();
        PROBE_BEGIN(1);
#pragma unroll 1
        for (int genrep = 0; genrep < (IDXPROBE == 1 ? 2 : 1); ++genrep)
        if (t0 + 8 > 256) {
            bf16x8 af[2][2];
#pragma unroll
            for (int hh = 0; hh < 2; ++hh)
#pragma unroll
                for (int s = 0; s < 2; ++s) af[hh][s] = *(const bf16x8*)(iqr + (size_t)(n0 + 2 * (fr >> 2) + ((fr >> 1) & 1)) * 256 + (2 * hh + (fr & 1)) * 64 + s * 32 + g * 8);
            const f32x4 wq0 = *(const f32x4*)(iw + (size_t)(n0 + 2 * g) * 4), wq1 = *(const f32x4*)(iw + (size_t)(n0 + 2 * g + 1) * 4);
            float vmin0 = INFINITY, vmax0 = -INFINITY, vmin1 = INFINITY, vmax1 = -INFINITY;
            const int nkt = (t0 + 8 + 15) >> 4;
            const bf16_t* kb = ikr + (size_t)b * SEQ * 64;
            bf16x8 pb0[3], pb1[3];
#pragma unroll
            for (int i = 0; i < 2; ++i) { const int ktp = wid + 8 * i < nkt ? wid + 8 * i : wid; const bf16_t* kp = kb + (size_t)(ktp * 16 + fr) * 64 + g * 8; pb0[i] = *(const bf16x8*)kp; pb1[i] = *(const bf16x8*)(kp + 32); }
            for (int kt = wid; kt < nkt; kt += 8) {
                { const int ktp = kt + 16 < nkt ? kt + 16 : kt; const bf16_t* kp = kb + (size_t)(ktp * 16 + fr) * 64 + g * 8; pb0[2] = *(const bf16x8*)kp; pb1[2] = *(const bf16x8*)(kp + 32); }
                const bf16x8 b0 = pb0[0], b1 = pb1[0];
                pb0[0] = pb0[1]; pb1[0] = pb1[1]; pb0[1] = pb0[2]; pb1[1] = pb1[2];
                f32x4 d0 = fzero4(), d1 = fzero4();
                d0 = __builtin_amdgcn_mfma_f32_16x16x32_bf16(af[0][0], b0, d0, 0, 0, 0); d0 = __builtin_amdgcn_mfma_f32_16x16x32_bf16(af[0][1], b1, d0, 0, 0, 0);
                d1 = __builtin_amdgcn_mfma_f32_16x16x32_bf16(af[1][0], b0, d1, 0, 0, 0); d1 = __builtin_amdgcn_mfma_f32_16x16x32_bf16(af[1][1], b1, d1, 0, 0, 0);
                float s0 = fmaxf(d0[0], 0.f) * wq0[0] + fmaxf(d0[1], 0.f) * wq0[1] + fmaxf(d1[0], 0.f) * wq0[2] + fmaxf(d1[1], 0.f) * wq0[3];
                float s1 = fmaxf(d0[2], 0.f) * wq1[0] + fmaxf(d0[3], 0.f) * wq1[1] + fmaxf(d1[2], 0.f) * wq1[2] + fmaxf(d1[3], 0.f) * wq1[3];
                s0 += 0.0f; s1 += 0.0f;
                vmin0 = fminf(vmin0, s0); vmax0 = fmaxf(vmax0, s0); vmin1 = fminf(vmin1, s1); vmax1 = fmaxf(vmax1, s1);
                sc[(2 * g) * 4096 + kt * 16 + fr] = s0; sc[(2 * g + 1) * 4096 + kt * 16 + fr] = s1;
            }
#pragma unroll
            for (int j = 0; j < 2; ++j) { float mn = j ? vmin1 : vmin0, mx = j ? vmax1 : vmax0;
                mn = fminf(mn, dppf<0xB1>(mn)); mn = fminf(mn, dppf<0x4E>(mn)); mn = fminf(mn, dppf<0x141>(mn)); mn = fminf(mn, dppf<0x140>(mn));
                mx = fmaxf(mx, dppf<0xB1>(mx)); mx = fmaxf(mx, dppf<0x4E>(mx)); mx = fmaxf(mx, dppf<0x141>(mx)); mx = fmaxf(mx, dppf<0x140>(mx));
                if (fr == 0 && mx >= mn) { const int q = 2 * g + j;
                    __hip_atomic_fetch_min(mm + q * 2, ord_key(mn), __ATOMIC_RELAXED, __HIP_MEMORY_SCOPE_WORKGROUP); __hip_atomic_fetch_max(mm + q * 2 + 1, ord_key(mx), __ATOMIC_RELAXED, __HIP_MEMORY_SCOPE_WORKGROUP); } }
        }
        PROBE_END(1);
        PROBE_BEGIN(2);
        __syncthreads();
        PROBE_END(2);
        PROBE_BEGIN(7);
#pragma unroll 1
        for (int selrep = 0; selrep < (IDXPROBE == 2 ? 2 : 1); ++selrep)
        {
            const int n = n0 + wid, t = t0 + wid, nv = t + 1;
            if (nv <= 256) { for (int j = lane; j < 256; j += 64) out[j] = (unsigned short)(j < nv ? j : 0); }
            else {
                LAS const float* srow = sc + wid * 4096;
                const int nvp = (nv + 255) & ~255;
                const unsigned kmax = mm[wid * 2 + 1];
                const int kbase = (int)(kmax >> 19) - 255;
                unsigned P = 0u; int sh = 32;
                bool capped = false;
                float lo = ord_val(mm[wid * 2]), hi = ord_val(mm[wid * 2 + 1]);
                float lo1 = 0.f, sc1 = 0.f, lo2 = 0.f, sc2 = 0.f, lo3 = 0.f, sc3 = 0.f; int b1 = 0, b2 = 0, b3 = 0, nlev = 0;
                int m = nv, need = 256;
#define IDX_HIST_SCAN(bin, nneed, mmc, lumpc) do { int hb[4]; \
                    _Pragma("unroll") for (int j = 0; j < 4; ++j) hb[j] = hist[lane * 4 + j]; \
                    if (lane == 0) hb[0] += (lumpc); \
                    const int tot = hb[0] + hb[1] + hb[2] + hb[3]; int suf = tot; \
                    _Pragma("unroll") for (int off = 1; off < 64; off <<= 1) { const int v = __shfl_down(suf, off); if (lane + off < 64) suf += v; } \
                    const int above = suf - tot; const bool is = (above < need) && (need <= suf); \
                    bin = 0; nneed = 0; mmc = 0; \
                    if (is) { int c = above; \
                        _Pragma("unroll") for (int k = 3; k >= 0; --k) { if (nneed == 0) { if (need <= c + hb[k]) { bin = lane * 4 + k; nneed = need - c; mmc = hb[k]; } else c += hb[k]; } } } \
                    const unsigned long long bal = __ballot(is); const int srcl = __ffsll((long long)bal) - 1; \
                    bin = __shfl(bin, srcl); nneed = __shfl(nneed, srcl); mmc = __shfl(mmc, srcl); } while (0)
#define IDX_ZERO_HIST() do { int z = 0; asm volatile("" : "+v"(z)); _Pragma("unroll") for (int j = 0; j < 4; ++j) hist[lane * 4 + j] = z; } while (0)
                PROBE_BEGIN(3);
                {
                    IDX_ZERO_HIST();
                    int lumpl = 0;
                    for (int c0 = 0; c0 < nvp; c0 += 256) { const f32x4 s4 = *(const LAS f32x4*)(srow + c0 + lane * 4);
#pragma unroll
                        for (int e_ = 0; e_ < 4; ++e_) { const unsigned k = ord_key(s4[e_]); const int bin = (int)(k >> 19) - kbase; const bool valid = c0 + lane * 4 + e_ < nv;
                            if (valid && bin > 0) __hip_atomic_fetch_add(hist + bin, 1, __ATOMIC_RELAXED, __HIP_MEMORY_SCOPE_WORKGROUP);
                            lumpl += (valid && bin <= 0) ? 1 : 0; } }
                    int lump = lumpl;
#pragma unroll
                    for (int o = 32; o > 0; o >>= 1) lump += __shfl_xor(lump, o);
                    int bin, nneed, mmc; IDX_HIST_SCAN(bin, nneed, mmc, lump);
                    need = nneed; m = mmc;
                    if (bin > 0) { P = (unsigned)(kbase + bin); sh = 19; }
                    else { capped = true; hi = ord_val(((unsigned)(kbase + 1) << 19) - 1u); if (hi < lo) hi = lo; }
                }
                PROBE_END(3);
                PROBE_BEGIN(4);
#pragma unroll 1
                while (!capped && m > 128 && sh > 0) {
                    const int nsh = sh > 8 ? sh - 8 : 0; const unsigned dmask = (1u << (sh - nsh)) - 1u;
                    IDX_ZERO_HIST();
                    for (int c0 = 0; c0 < nvp; c0 += 256) { const f32x4 s4 = *(const LAS f32x4*)(srow + c0 + lane * 4);
#pragma unroll
                        for (int e_ = 0; e_ < 4; ++e_) { const unsigned k = ord_key(s4[e_]);
                            if (c0 + lane * 4 + e_ < nv && (k >> sh) == P) __hip_atomic_fetch_add(hist + ((k >> nsh) & dmask), 1, __ATOMIC_RELAXED, __HIP_MEMORY_SCOPE_WORKGROUP); } }
                    int bin, nneed, mmc; IDX_HIST_SCAN(bin, nneed, mmc, 0);
                    P = (P << (sh - nsh)) | (unsigned)bin; sh = nsh; need = nneed; m = mmc;
                }
#define IDX_CLASSIFY(s, cls) do { \
                    if (!capped) { const unsigned kk_ = sh >= 32 ? 0u : (ord_key(s) >> sh); cls = kk_ > P ? 2 : (kk_ == P ? 1 : 0); } \
                    else if ((int)(ord_key(s) >> 19) > kbase) cls = 2; \
                    else { cls = 1; \
                        if (nlev >= 1) { const int bb = idx_bin(s, lo1, sc1); if (bb != b1) cls = bb > b1 ? 2 : 0; } \
                        if (cls == 1 && nlev >= 2) { const int bb = idx_bin(s, lo2, sc2); if (bb != b2) cls = bb > b2 ? 2 : 0; } \
                        if (cls == 1 && nlev >= 3) { const int bb = idx_bin(s, lo3, sc3); if (bb != b3) cls = bb > b3 ? 2 : 0; } } } while (0)
#pragma unroll 1
                while (capped && m > 128 && nlev < 3 && (hi - lo) > 1e-30f) {
                    const float width = hi - lo, scale = 256.0f / width;
                    IDX_ZERO_HIST();
                    for (int c0 = 0; c0 < nvp; c0 += 256) { const f32x4 s4 = *(const LAS f32x4*)(srow + c0 + lane * 4);
#pragma unroll
                        for (int e_ = 0; e_ < 4; ++e_) { const float s = s4[e_]; int cls; IDX_CLASSIFY(s, cls);
                            if (c0 + lane * 4 + e_ < nv && cls == 1) __hip_atomic_fetch_add(hist + idx_bin(s, lo, scale), 1, __ATOMIC_RELAXED, __HIP_MEMORY_SCOPE_WORKGROUP); } }
                    int bin, nneed, mmc; IDX_HIST_SCAN(bin, nneed, mmc, 0);
                    if (nlev == 0) { lo1 = lo; sc1 = scale; b1 = bin; } else if (nlev == 1) { lo2 = lo; sc2 = scale; b2 = bin; } else { lo3 = lo; sc3 = scale; b3 = bin; }
                    ++nlev; need = nneed; m = mmc;
                    const float w = width * (1.0f / 256.0f); lo = lo + (float)bin * w; hi = lo + w;
                }
#undef IDX_HIST_SCAN
#undef IDX_ZERO_HIST
                PROBE_END(4);
                PROBE_BEGIN(5);
                int base = 0, nc = 0;
                for (int c0 = 0; c0 < nvp; c0 += 256) { const f32x4 s4 = *(const LAS f32x4*)(srow + c0 + lane * 4);
                    bool su[4], ca[4]; int nsu = 0, nca = 0;
#pragma unroll
                    for (int e_ = 0; e_ < 4; ++e_) { const bool valid = c0 + lane * 4 + e_ < nv; int cls; IDX_CLASSIFY(s4[e_], cls); su[e_] = valid && cls == 2; ca[e_] = valid && cls == 1; nsu += su[e_] ? 1 : 0; nca += ca[e_] ? 1 : 0; }
                    unsigned long long bs4[4], bc4[4]; int ps = base, pc = nc, tots = 0, totc = 0;
#pragma unroll
                    for (int e_ = 0; e_ < 4; ++e_) { bs4[e_] = __ballot(su[e_]); bc4[e_] = __ballot(ca[e_]); ps += __popcll(bs4[e_] & lt_mask); pc += __popcll(bc4[e_] & lt_mask); tots += __popcll(bs4[e_]); totc += __popcll(bc4[e_]); }
#pragma unroll
                    for (int e_ = 0; e_ < 4; ++e_) { const int key = c0 + lane * 4 + e_;
                        if (su[e_]) { if (ps < 256) out[ps] = (unsigned short)key; ++ps; }
                        if (ca[e_]) { if (pc < 256) { candv[pc] = s4[e_]; candi[pc] = (unsigned short)key; } ++pc; } }
                    base += tots; nc += totc; }
#undef IDX_CLASSIFY
                PROBE_END(5);
                PROBE_BEGIN(6);
                const int mcap = nc < 256 ? nc : 256;
                float T = -INFINITY; int need_t = need;
                if (nc <= 256) {
                    float mine[4]; int cgt[4], cge[4];
#pragma unroll
                    for (int k = 0; k < 4; ++k) { mine[k] = (lane + 64 * k) < mcap ? candv[lane + 64 * k] : -INFINITY; cgt[k] = 0; cge[k] = 0; }
                    if (lane < 4 && mcap + lane < 260) candv[mcap + lane] = -INFINITY;
                    const int nk = (mcap + 63) >> 6;
                    for (int j = 0; j < mcap; j += 4) { const f32x4 vj = *(const LAS f32x4*)(candv + j);
#pragma unroll
                        for (int k = 0; k < 4; ++k) { if (k < nk) {
#pragma unroll
                            for (int e_ = 0; e_ < 4; ++e_) { cgt[k] += vj[e_] > mine[k] ? 1 : 0; cge[k] += vj[e_] >= mine[k] ? 1 : 0; } } } }
                    float tv = -INFINITY; int tg = 0; bool isT = false;
#pragma unroll
                    for (int k = 0; k < 4; ++k) { const bool ok = ((lane + 64 * k) < mcap) && (cgt[k] < need) && (need <= cge[k]); if (ok && !isT) { isT = true; tv = mine[k]; tg = cgt[k]; } }
                    const unsigned long long bT = __ballot(isT);
                    const int sl = __ffsll((long long)bT) - 1;
                    T = __shfl(tv, sl); need_t = need - __shfl(tg, sl);
                }
                int ties = 0;
                for (int c0 = 0; c0 < mcap; c0 += 64) { const int j = c0 + lane; const bool valid = j < mcap; const float s = valid ? candv[j] : -INFINITY;
                    const bool sure = valid && (nc <= 256) && s > T;
                    const bool tie = valid && ((nc <= 256) ? (s == T) : true);
                    const unsigned long long beq = __ballot(tie);
                    const int rank = ties + __popcll(beq & lt_mask);
                    const bool take = sure || (tie && rank < need_t);
                    const unsigned long long bt = __ballot(take);
                    const int pos = base + __popcll(bt & lt_mask);
                    if (take && pos < 256) out[pos] = candi[j];
                    base += __popcll(bt); ties += __popcll(beq); }
                PROBE_END(6);
            }
            attn_query(qr, kr, vv, ao, n, out, (LAS unsigned char*)(sc + wid * 4096), lane);
        }
        PROBE_END(7);
        PROBE_BEGIN(8);
        __syncthreads();
        PROBE_END(8);
    }
    PROBE_END(9);
    PROBE_STORE(ws, bid, tid);
}

__device__ __forceinline__ void phase_attn2(const Params& p, LAS unsigned char* lds, int bid, int nb) {
    const int tid = opaque_tid(), wid = tid >> 6, lane = tid & 63, fr = lane & 15, g = lane >> 4;
    unsigned char* ws = p.ws;
    const bf16_t* qr = (const bf16_t*)(ws + OFF_BUF64); const bf16_t* kr = (const bf16_t*)(ws + OFF_KR); const bf16_t* vv = (const bf16_t*)(ws + OFF_VV);
    const unsigned short* idx = (const unsigned short*)(ws + OFF_IDX);
    bf16_t* ao = (bf16_t*)(ws + OFF_PD);
    LAS unsigned char* vbuf = lds + wid * 16384;
    LAS unsigned short* ks = (LAS unsigned short*)(lds + 131072) + wid * 256;
    const int q4 = fr >> 2, p4 = fr & 3;
    int n = bid * 8 + wid;
    u32x2 nidx = (u32x2){0u, 0u};
    if (n < NTOK) nidx = *(const u32x2*)(idx + (size_t)n * 256 + lane * 4);
    for (; n < NTOK; n += nb * 8) {
        const int t = n & (SEQ - 1), b = n >> 12, cnt = (t + 1) < 256 ? (t + 1) : 256;
        asm volatile("" ::: "memory");
        *(LAS u32x2*)(ks + lane * 4) = nidx;
        { const int nn = n + nb * 8; int l4 = lane * 4; asm volatile("" : "+v"(l4)); if (nn < NTOK) nidx = *(const u32x2*)(idx + (size_t)nn * 256 + l4); }
        bf16x8 qf[4];
#pragma unroll
        for (int s = 0; s < 4; ++s) { qf[s] = (bf16x8){0, 0, 0, 0, 0, 0, 0, 0}; if (fr < 8) qf[s] = *(const bf16x8*)(qr + (size_t)n * 1024 + fr * 128 + s * 32 + g * 8); }
        const bf16_t* kbase = kr + (size_t)b * SEQ * 128; const bf16_t* vbase = vv + (size_t)b * SEQ * 128;
        f32x4 acc[16];
        bf16x8 kf[3][2][4];
#define ATT_KLOAD(buf, grp) do { _Pragma("unroll") for (int t2 = 0; t2 < 2; ++t2) { const int j_ = ((grp) * 2 + t2) * 16 + fr; const int key_ = j_ < cnt ? (int)ks[j_] : 0; \
            const bf16_t* kp_ = kbase + (size_t)key_ * 128 + g * 8; _Pragma("unroll") for (int s = 0; s < 4; ++s) kf[buf][t2][s] = *(const bf16x8*)(kp_ + s * 32); } } while (0)
        ATT_KLOAD(0, 0); ATT_KLOAD(1, 1);
#pragma unroll
        for (int grp = 0; grp < 8; ++grp) {
            if (grp + 2 < 8) ATT_KLOAD((grp + 2) % 3, grp + 2);
#pragma unroll
            for (int t2 = 0; t2 < 2; ++t2) { f32x4 a = fzero4();
#pragma unroll
                for (int s = 0; s < 4; ++s) a = __builtin_amdgcn_mfma_f32_16x16x32_bf16(kf[grp % 3][t2][s], qf[s], a, 0, 0, 0);
                acc[grp * 2 + t2] = a; }
        }
#undef ATT_KLOAD
        u32x4 vr[2][8];
#define ATT_VLOAD(buf, s) do { _Pragma("unroll") for (int i = 0; i < 8; ++i) { const int kl_ = i * 4 + g; const int jj_ = (s) * 32 + kl_; const int key_ = jj_ < cnt ? (int)ks[jj_] : 0; \
            const int c_ = fr ^ ((kl_ & 7) << 1); vr[buf][i] = *(const u32x4*)(vbase + (size_t)key_ * 128 + c_ * 8); } } while (0)
        ATT_VLOAD(0, 0);
        float m = -INFINITY;
#pragma unroll
        for (int tl = 0; tl < 16; ++tl)
#pragma unroll
            for (int r = 0; r < 4; ++r) { if (tl * 16 + g * 4 + r >= cnt) acc[tl][r] = -INFINITY; m = fmaxf(m, acc[tl][r]); }
        m = fmaxf(m, __shfl_xor(m, 16)); m = fmaxf(m, __shfl_xor(m, 32));
        float sum = 0.f;
#pragma unroll
        for (int tl = 0; tl < 16; ++tl)
#pragma unroll
            for (int r = 0; r < 4; ++r) { const float e_ = __expf(acc[tl][r] - m); acc[tl][r] = e_; sum += e_; }
        sum += __shfl_xor(sum, 16); sum += __shfl_xor(sum, 32);
        const float inv = 1.0f / sum;
        bf16x8 pf[8];
#pragma unroll
        for (int s = 0; s < 8; ++s) pf[s] = pack_8g(acc[2 * s], acc[2 * s + 1]);
        f32x4 o[8];
#pragma unroll
        for (int dt = 0; dt < 8; ++dt) o[dt] = fzero4();
#pragma unroll
        for (int s = 0; s < 8; ++s) {
            LAS unsigned char* vb = vbuf + (s & 1) * 8192;
            if (s + 1 < 8) ATT_VLOAD((s + 1) & 1, s + 1);
#pragma unroll
            for (int i = 0; i < 8; ++i) { const int kl = i * 4 + g; *(LAS u32x4*)(vb + kl * 256 + fr * 16) = vr[s & 1][i]; }
            const int kl1 = 4 * g + q4, kl2 = 16 + 4 * g + q4;
#pragma unroll
            for (int dt = 0; dt < 8; ++dt) {
                const int c = 2 * dt + (p4 >> 1);
                const s16x4 lo = __builtin_amdgcn_ds_read_tr16_b64_v4i16((LAS s16x4*)(vb + kl1 * 256 + ((c ^ ((kl1 & 7) << 1)) * 16) + (p4 & 1) * 8));
                const s16x4 hi = __builtin_amdgcn_ds_read_tr16_b64_v4i16((LAS s16x4*)(vb + kl2 * 256 + ((c ^ ((kl2 & 7) << 1)) * 16) + (p4 & 1) * 8));
                const bf16x8 af = (bf16x8){lo[0], lo[1], lo[2], lo[3], hi[0], hi[1], hi[2], hi[3]};
                o[dt] = __builtin_amdgcn_mfma_f32_16x16x32_bf16(af, pf[s], o[dt], 0, 0, 0);
            }
        }
#undef ATT_VLOAD
        if (fr < 8) {
#pragma unroll
            for (int dt = 0; dt < 8; ++dt) { u32x2 w; w.x = cvt_pk_bf16(o[dt][0] * inv, o[dt][1] * inv); w.y = cvt_pk_bf16(o[dt][2] * inv, o[dt][3] * inv);
                *(u32x2*)(ao + (size_t)n * 1024 + fr * 128 + dt * 16 + g * 4) = w; }
        }
    }
}

__device__ __forceinline__ void phase_inproj_even(const Params& p, LAS unsigned char* lds, int bid, int nb) {
    unsigned char* ws = p.ws;
    pg::DenseSched S; S.init(ws + OFF_BUF64, ws + OFF_WINE, NTOK, NE_MAIN, 1024, nb, bid);
    pg::EpiBf16 E; E.O = (bf16_t*)(ws + OFF_P); E.ldc = NE_MAIN;
    pg::gemm_phase(lds, 1024, S, E);
}
__device__ __forceinline__ void phase_inproj_odd(const Params& p, LAS unsigned char* lds, int bid, int nb) {
    unsigned char* ws = p.ws;
    pg::DenseSched S; S.init(ws + OFF_BUF64, ws + OFF_WINO, NTOK, NO_MAIN, 1024, nb, bid);
    pg::EpiBf16 E; E.O = (bf16_t*)(ws + OFF_PD); E.ldc = NO_MAIN;
    pg::gemm_phase(lds, 1024, S, E);
}
__device__ __forceinline__ void phase_outproj(const Params& p, LAS unsigned char* lds, int bid, int nb, size_t aoff, size_t woff, const float* X) {
    unsigned char* ws = p.ws;
    pg::DenseSched S; S.init(ws + aoff, ws + woff, NTOK, 1024, 1024, nb, bid);
    pg::EpiResid E; E.X = X; E.U = (float*)(ws + OFF_U);
    pg::gemm_phase(lds, 1024, S, E);
}

__device__ __forceinline__ void grid_barrier(unsigned* ctr, unsigned target) {
    asm volatile("s_waitcnt vmcnt(0) lgkmcnt(0)" ::: "memory");
    __syncthreads();
    if (threadIdx.x == 0) {
        __builtin_amdgcn_fence(__ATOMIC_RELEASE, "agent");
        asm volatile("s_waitcnt vmcnt(0)" ::: "memory");
        __hip_atomic_fetch_add(ctr, 1u, __ATOMIC_RELAXED, __HIP_MEMORY_SCOPE_AGENT);
        while (__hip_atomic_load(ctr, __ATOMIC_RELAXED, __HIP_MEMORY_SCOPE_AGENT) < target) __builtin_amdgcn_s_sleep(1);
        __builtin_amdgcn_fence(__ATOMIC_ACQUIRE, "agent");
        asm volatile("s_waitcnt vmcnt(0)" ::: "memory");
    }
    __syncthreads();
}
#ifndef DUP
#define DUP 0
#endif
#define GSYNC() do { bar_target += nb0u; grid_barrier(bar_ctr, bar_target); } while (0)
__global__ __launch_bounds__(512, 2) void mega(KArgs a) {
    extern __shared__ __attribute__((aligned(16))) unsigned char smem[];
    LAS unsigned char* lds = (LAS unsigned char*)smem;
    Params p; p.in.t = (LAS const unsigned long long*)(lds + PTAB_OFF); p.out = a.out; p.ws = a.ws;
    if ((threadIdx.x & 63) == 0) ((LAS int*)(lds + WTAB_OFF))[hw_slot()] = threadIdx.x >> 6;
    if (threadIdx.x == 0) { LAS unsigned long long* tw_ = (LAS unsigned long long*)(lds + PTAB_OFF);
#pragma unroll
        for (int i = 0; i < 30; ++i) tw_[i] = (unsigned long long)a.in[i]; }
    __syncthreads();
    cg::grid_group grid = cg::this_grid();
    const int bid0 = blockIdx.x, nb0 = gridDim.x;
    unsigned* bar_ctr = (unsigned*)(p.ws + OFF_MISC + MISC_BAR); unsigned bar_target = 0; const unsigned nb0u = gridDim.x;
    if (blockIdx.x == 0 && threadIdx.x == 0) __hip_atomic_store(bar_ctr, 0u, __ATOMIC_RELAXED, __HIP_MEMORY_SCOPE_AGENT);
    grid.sync();
    int bid, nb;
#define FRESH() do { bid = bid0; nb = nb0; asm volatile("" : "+s"(bid), "+s"(nb)); } while (0)
#define PHP(pid, call) do { unsigned long long t0_ = 0; if (PROBE_ID == (pid)) t0_ = __builtin_amdgcn_s_memtime(); call; if (PROBE_ID == (pid) && bid0 == (PROBE_BLK) && opaque_tid() == 0) *(float*)(p.ws + OFF_MISC + MISC_PROBE) = (float)(__builtin_amdgcn_s_memtime() - t0_) * 2e-8f; } while (0)
#define RUNP(id, call) do { FRESH(); call; GSYNC(); if (DUP == id) { FRESH(); call; GSYNC(); } } while (0)
    RUNP(10, PHP(30, phase_prep(p, lds, bid, nb)));
#if PROBE_ID == 20
    const unsigned long long kstart = __builtin_amdgcn_s_memtime();
#endif
#pragma unroll 1
    for (int layer = 0; layer < 2; ++layer) {
        if (layer == 0) {
            FRESH(); PHP(31, phase_inproj_even(p, lds, bid, nb));
            FRESH(); PHP(32, phase_gla_alpha(p, lds, bid, nb));
            GSYNC();
            if (DUP == 11) { FRESH(); phase_inproj_even(p, lds, bid, nb); GSYNC(); }
            if (DUP == 12) { FRESH(); phase_gla_alpha(p, lds, bid, nb); GSYNC(); }
            RUNP(21, PHP(44, phase_lora_act(p, bid, nb)));
            RUNP(1, PHP(33, phase_mixer_even(p, lds, bid, nb, 0)));
            RUNP(13, PHP(34, phase_rwkv_epi(p, bid, nb)));
        } else {
            RUNP(14, PHP(40, phase_inproj_odd(p, lds, bid, nb)));
            RUNP(15, PHP(41, phase_rope(p, bid, nb)));
            RUNP(2, PHP(43, phase_index2(p, lds, bid, nb)));
        }
        RUNP(16, PHP(35, phase_outproj(p, lds, bid, nb, layer ? OFF_PD : OFF_BUF64, layer ? OFF_WOUTO : OFF_WOUTE, layer ? p.out : p.in[I_X])));
        FRESH(); PHP(36, phase_ln_route(p, lds, bid, nb, layer));
        GSYNC();
        RUNP(17, PHP(37, phase_moe_gateup(p, lds, bid, nb, layer)));
        RUNP(18, PHP(38, phase_moe_down(p, lds, bid, nb, layer)));
#if PROBE_ID == 20
        if (layer == 1) { if (bid0 == 7 && threadIdx.x == 0) *(float*)(p.ws + OFF_MISC + MISC_PROBE) = (float)(__builtin_amdgcn_s_memtime() - kstart) * 1e-8f; GSYNC(); }
#endif
        RUNP(19, PHP(39, phase_ln2(p, bid, nb, layer, p.out, true)));
    }
}

extern "C" void kernel_launch(void* const* d_in, const int* in_sizes, int n_in, void* d_out, int out_size, void* d_ws, size_t ws_size, hipStream_t stream) {
    if (ws_size < WS_NEED) { fprintf(stderr, "workspace too small: %zu < %zu\n", ws_size, (size_t)WS_NEED); return; }
    KArgs p{};
    for (int i = 0; i < 30; ++i) p.in[i] = (const float*)d_in[i];
    p.out = (float*)d_out; p.ws = (unsigned char*)d_ws;
    static int grid_blocks = 0;
    if (!grid_blocks) {
        (void)hipFuncSetAttribute((const void*)mega, hipFuncAttributeMaxDynamicSharedMemorySize, LDS_BYTES);
        int dev = 0, cus = 0, per_cu = 0;
        (void)hipGetDevice(&dev);
        (void)hipDeviceGetAttribute(&cus, hipDeviceAttributeMultiprocessorCount, dev);
        (void)hipOccupancyMaxActiveBlocksPerMultiprocessor(&per_cu, mega, 512, LDS_BYTES);
        if (per_cu < 1) { fprintf(stderr, "occupancy query returned %d\n", per_cu); per_cu = 1; }
        grid_blocks = cus;
    }
    void* args[] = {&p};
    hipError_t e = hipLaunchCooperativeKernel((void*)mega, dim3(grid_blocks), dim3(512), args, LDS_BYTES, stream);
    if (e != hipSuccess) fprintf(stderr, "cooperative launch failed: %s (grid %d)\n", hipGetErrorString(e), grid_blocks);
}
```

```cpp
#include <hip/hip_runtime.h>
#include <hip/hip_cooperative_groups.h>
#include <cstdio>
#include <cstdint>
namespace cg = cooperative_groups;

#ifndef PROBE_ID
#define PROBE_ID 0
#endif
#ifndef PROBE_BLK
#define PROBE_BLK 7
#endif
#ifndef IDXPROBE
#define IDXPROBE 0
#endif
#ifndef SANITIZE
#define SANITIZE 0
#endif
#ifndef PREP_REP
#define PREP_REP 1
#endif
constexpr int NTOK = 32768, SEQ = 4096, NB = 8, DM = 1024;
constexpr int EVEN_COLS = 3344, ODD_COLS = 1604;
constexpr int NE_MAIN = 3328;
constexpr int NO_MAIN = 1792;
constexpr int NEXP = 16, DEXP = 256;
constexpr float DN_ALPHA = 1.4142135623730951f;
constexpr float LN_EPS = 1e-5f;
constexpr int MOE_ROWS = 65536 + 16 * 256;

typedef unsigned short bf16_t;
typedef short bf16x8 __attribute__((ext_vector_type(8)));
typedef float f32x4 __attribute__((ext_vector_type(4)));
typedef short s16x4 __attribute__((ext_vector_type(4)));
typedef float f32x2 __attribute__((ext_vector_type(2)));
typedef unsigned u32x4 __attribute__((ext_vector_type(4)));
typedef unsigned u32x2 __attribute__((ext_vector_type(2)));
#define LAS __attribute__((address_space(3)))

typedef __bf16 bf16x2_t __attribute__((ext_vector_type(2)));
__device__ __forceinline__ unsigned cvt_pk_bf16(float lo, float hi) { bf16x2_t v; v[0] = (__bf16)lo; v[1] = (__bf16)hi; return __builtin_bit_cast(unsigned, v); }
__device__ __forceinline__ bf16_t f2bf(float f) { return (bf16_t)(cvt_pk_bf16(f, 0.f) & 0xffffu); }
__device__ __forceinline__ float bf2f(bf16_t h) { return __uint_as_float(((unsigned)h) << 16); }
constexpr int LDS_BYTES = 160 * 1024;
constexpr int PTAB_OFF = LDS_BYTES - 256;
constexpr int WTAB_OFF = LDS_BYTES - 512;
__device__ __forceinline__ int hw_slot() { return (int)(__builtin_amdgcn_s_getreg(0x2804) & 63u); }
__device__ __forceinline__ int opaque_tid() {
    extern __shared__ __attribute__((aligned(16))) unsigned char smem_[];
    const int w = __builtin_amdgcn_readfirstlane(((LAS const int*)((LAS unsigned char*)smem_ + WTAB_OFF))[hw_slot()]);
    int l; asm volatile("v_mbcnt_lo_u32_b32 %0, -1, 0\n\tv_mbcnt_hi_u32_b32 %0, -1, %0" : "=v"(l));
    return (w << 6) | l; }
#if PROBE_ID
#define PROBE_DECL unsigned long long probe_acc = 0, probe_t0 = 0
#define PROBE_BEGIN(id) do { if (PROBE_ID == (id)) probe_t0 = __builtin_amdgcn_s_memtime(); } while (0)
#define PROBE_END(id) do { if (PROBE_ID == (id)) probe_acc += __builtin_amdgcn_s_memtime() - probe_t0; } while (0)
#define PROBE_STORE(ws, bid, tid) do { if (PROBE_ID < 30 && (bid) == 7 && (tid) == 0) *(float*)((ws) + OFF_MISC + MISC_PROBE) = (float)probe_acc * 1e-6f; } while (0)
#else
#define PROBE_DECL
#define PROBE_BEGIN(id)
#define PROBE_END(id)
#define PROBE_STORE(ws, bid, tid)
#endif
__device__ __forceinline__ f32x4 fzero4() { float z = 0.f; asm volatile("" : "+v"(z)); return (f32x4){z, z, z, z}; }
__device__ __forceinline__ u32x4 uzero4() { unsigned z = 0u; asm volatile("" : "+v"(z)); return (u32x4){z, z, z, z}; }
__device__ __forceinline__ float fast_rcp(float x) { return __builtin_amdgcn_rcpf(x); }
__device__ __forceinline__ float fast_sigmoid(float x) { return fast_rcp(1.0f + __expf(-x)); }
__device__ __forceinline__ float fast_tanh(float x) { const float e = __expf(2.0f * x); return 1.0f - 2.0f * fast_rcp(1.0f + e); }
__device__ __forceinline__ bf16x8 pack_8g(const f32x4 a, const f32x4 b) { u32x4 w; w.x = cvt_pk_bf16(a[0], a[1]); w.y = cvt_pk_bf16(a[2], a[3]); w.z = cvt_pk_bf16(b[0], b[1]); w.w = cvt_pk_bf16(b[2], b[3]); return __builtin_bit_cast(bf16x8, w); }
template <int CTRL> __device__ __forceinline__ float dppf(float v) { return __builtin_bit_cast(float, __builtin_amdgcn_update_dpp(0, __builtin_bit_cast(int, v), CTRL, 0xf, 0xf, true)); }
__device__ __forceinline__ float wave_sum(float v) {
#pragma unroll
    for (int o = 32; o > 0; o >>= 1) v += __shfl_xor(v, o);
    return v;
}

constexpr size_t MiB = 1024ull * 1024ull;
constexpr size_t OFF_WINE = 0;
constexpr size_t OFF_WOUTE = OFF_WINE + (size_t)NE_MAIN * 1024 * 2;
constexpr size_t OFF_WINO = OFF_WOUTE + 2 * MiB;
constexpr size_t OFF_WOUTO = OFF_WINO + (size_t)NO_MAIN * 1024 * 2;
constexpr size_t OFF_WGU = OFF_WOUTO + 2 * MiB;
constexpr size_t OFF_WD = OFF_WGU + 32 * MiB;
constexpr size_t OFF_ROPE = OFF_WD + 16 * MiB;
constexpr size_t OFF_MISC = OFF_ROPE + 3 * MiB;
constexpr size_t OFF_BUF64 = OFF_MISC + 4 * MiB;
constexpr size_t OFF_P = OFF_BUF64 + 64 * MiB;
constexpr size_t OFF_U = OFF_P + 208 * MiB;
constexpr size_t WS_NEED = OFF_U + 128 * MiB;
constexpr size_t OFF_HE = OFF_P;
constexpr size_t OFF_ACT = OFF_HE + (size_t)MOE_ROWS * 1024 * 2;
constexpr size_t OFF_PD = OFF_P;
constexpr size_t OFF_KR = OFF_P + 112 * MiB;
constexpr size_t OFF_VV = OFF_KR + 8 * MiB;
constexpr size_t OFF_IQR = OFF_VV + 8 * MiB;
constexpr size_t OFF_IKR = OFF_IQR + 16 * MiB;
constexpr size_t OFF_IW = OFF_IKR + 4 * MiB;
constexpr size_t OFF_IDX = OFF_IW + 1 * MiB;
constexpr size_t MISC_CNT = 0;
constexpr size_t MISC_TOKINFO = 4096;
constexpr size_t MISC_TOKGATE = MISC_TOKINFO + (size_t)NTOK * 16;
constexpr size_t MISC_LIST = MISC_TOKGATE + (size_t)NTOK * 8;
constexpr size_t MISC_PROBE = 2304;
constexpr size_t MISC_W2T = 3 * MiB;
constexpr size_t MISC_A2T = MISC_W2T + 65536;
constexpr size_t MISC_G2T = MISC_A2T + 65536;
constexpr size_t MISC_BAR = MISC_G2T + 131072;

struct InTab { LAS const unsigned long long* t;
    __device__ __forceinline__ const float* operator[](int i) const { const unsigned long long v = t[i];
        const unsigned lo = __builtin_amdgcn_readfirstlane((unsigned)v), hi = __builtin_amdgcn_readfirstlane((unsigned)(v >> 32));
        return (const float*)(((unsigned long long)hi << 32) | lo); } };
struct Params { InTab in; float* out; unsigned char* ws; };
struct KArgs { const float* in[30]; float* out; unsigned char* ws; };
enum { I_X = 0, I_WINE, I_AMU, I_AW0, I_AW2, I_AA0, I_AA2, I_AG2, I_AKK, I_AKA, I_ARK, I_AGNG, I_AGNB, I_BGW2, I_BGB, I_BNG, I_WOUTE,
       I_WINO, I_CIKG, I_CIKB, I_WOUTO, I_LN1G, I_LN1B, I_LN2G, I_LN2B, I_RW, I_RB, I_EG, I_EU, I_ED };

namespace pg {
constexpr int BM = 256, BK = 64, HALF = 128, HTB = HALF * BK * 2, STAGE_BYTES = 8 * HTB;
__host__ __device__ __forceinline__ int lds_byte(int r, int c) { const int st = (r >> 4) * 2 + (c >> 5), rr = r & 15, cc = c & 31, ob = rr * 64 + cc * 2; return st * 1024 + (ob ^ (((ob >> 9) & 1) << 5)); }
__host__ __device__ __forceinline__ void stage_rc(int b, int& R, int& C) { const int st = b / 1024, sb = b % 1024, swz = sb ^ (((sb >> 9) & 1) << 5); R = (st >> 1) * 16 + swz / 64; C = (st & 1) * 32 + (swz % 64) / 2; }
__host__ __device__ __forceinline__ int perm32(int rho) { const int n = rho >> 4, i = rho & 15; return 8 * (i >> 2) + 4 * n + (i & 3); }

struct Unit { int pm, pn, e, rt, cnt; };

template <class Epi, class Sched>
__device__ __forceinline__ void gemm_phase(LAS unsigned char* lds, const int K, const Sched& S, const Epi& E) {
    const int tid = opaque_tid(), wid = __builtin_amdgcn_readfirstlane(tid >> 6), lane = tid & 63, wr = wid >> 2, wc = wid & 3, fr = lane & 15, fq = lane >> 4;
    const int nt = K / BK;
    unsigned voffB[2];
#pragma unroll
    for (int i = 0; i < 2; ++i) { int R, C; stage_rc(tid * 16 + i * 8192, R, C); const int Rb = Epi::PERM ? ((R & ~31) + perm32(R & 31)) : R; voffB[i] = (unsigned)(Rb * K + C) * 2u; }
    const size_t kstep = (size_t)(BK * 2);
    const size_t hstepB = (size_t)HALF * K * 2;
    const unsigned ldsw = (unsigned)wid * 1024u;
    const int aoff = lds_byte(wr * 64 + fr, fq * 8), boff = lds_byte(wc * 32 + fr, fq * 8);
#define PG_SA(b, h) (((b) * 2 + (h)) * HTB)
#define PG_SB(b, h) ((4 + (b) * 2 + (h)) * HTB)
#define PG_STAGE(bufoff, gbase, voff) do { _Pragma("unroll") for (int _i = 0; _i < 2; ++_i) \
        __builtin_amdgcn_global_load_lds((const unsigned*)((const char*)(gbase) + (voff)[_i]), (LAS unsigned*)(lds + (bufoff) + ldsw + _i * 8192), 16, 0, 0); } while (0)
#define PG_LDA(dst, b, h) do { _Pragma("unroll") for (int m = 0; m < 4; ++m) _Pragma("unroll") for (int k = 0; k < 2; ++k) dst[m][k] = *(const LAS bf16x8*)(lds + PG_SA(b, h) + aoff + m * 2048 + k * 1024); } while (0)
#define PG_LDB(dst, b, h) do { _Pragma("unroll") for (int n = 0; n < 2; ++n) _Pragma("unroll") for (int k = 0; k < 2; ++k) dst[n][k] = *(const LAS bf16x8*)(lds + PG_SB(b, h) + boff + n * 2048 + k * 1024); } while (0)
#define PG_MMA(ai, bj, At, Bt) do { __builtin_amdgcn_s_setprio(1); _Pragma("unroll") for (int m = 0; m < 4; ++m) _Pragma("unroll") for (int n = 0; n < 2; ++n) _Pragma("unroll") for (int k = 0; k < 2; ++k) \
        acc[ai][bj][m][n] = __builtin_amdgcn_mfma_f32_16x16x32_bf16(Bt[n][k], At[m][k], acc[ai][bj][m][n], 0, 0, 0); __builtin_amdgcn_s_setprio(0); } while (0)
#define PG_WAIT_V(n) asm volatile("s_waitcnt vmcnt(" #n ")" ::: "memory")
#define PG_WAIT_L(n) asm volatile("s_waitcnt lgkmcnt(" #n ")" ::: "memory")
#define PG_BAR __builtin_amdgcn_s_barrier()
#define PG_SCHED __builtin_amdgcn_sched_barrier(0)
#define PG_AOFF(dst0, dst1, u) do { _Pragma("unroll") for (int _i = 0; _i < 2; ++_i) { int _R, _C; stage_rc(tid * 16 + _i * 8192, _R, _C); \
        dst0[_i] = S.a_rowoff(u, 0, _R) + (unsigned)_C * 2u; dst1[_i] = S.a_rowoff(u, 1, _R) + (unsigned)_C * 2u; } } while (0)
    Unit cur, nxt; int ui = 0;
    if (!S.next(0, cur)) return;
    f32x4 acc[2][2][4][2];
#pragma unroll
    for (int a = 0; a < 2; ++a)
#pragma unroll
        for (int b = 0; b < 2; ++b)
#pragma unroll
            for (int m = 0; m < 4; ++m)
#pragma unroll
                for (int n = 0; n < 2; ++n) acc[a][b][m][n] = (f32x4){0.f, 0.f, 0.f, 0.f};
    bf16x8 At[4][2], B0[2][2], B1[2][2];
    const char* const Ab = S.a_base();
    unsigned aC0[2], aC1[2];
    PG_AOFF(aC0, aC1, cur);
    const char* cB = S.b_ptr(cur);
    PG_STAGE(PG_SB(0, 0), cB, voffB); PG_STAGE(PG_SA(0, 0), Ab, aC0); PG_STAGE(PG_SB(0, 1), cB + hstepB, voffB); PG_STAGE(PG_SA(0, 1), Ab, aC1);
    if (wr == 1) PG_BAR;
    PG_WAIT_V(4); PG_BAR;
    PG_STAGE(PG_SB(1, 0), cB + kstep, voffB); PG_STAGE(PG_SA(1, 0), Ab + kstep, aC0); PG_STAGE(PG_SB(1, 1), cB + hstepB + kstep, voffB);
    PG_WAIT_V(6); PG_BAR;
    for (;;) {
        const bool has_next = S.next(ui + 1, nxt);
        const char* nB = has_next ? S.b_ptr(nxt) : cB;
#pragma unroll 1
        for (int t = 0; t < nt; t += 2) {
            const bool last = (t == nt - 2);
            const char* a1 = Ab + (size_t)(t + 1) * kstep;
            const char* a2 = last ? Ab : Ab + (size_t)(t + 2) * kstep; const char* b2 = last ? nB : cB + (size_t)(t + 2) * kstep;
            const char* a3 = a2 + kstep; const char* b3 = b2 + kstep;
            PG_LDB(B0, 0, 0); PG_SCHED; PG_LDA(At, 0, 0); PG_STAGE(PG_SA(1, 1), a1, aC1);
            if (last && has_next) PG_AOFF(aC0, aC1, nxt);
            PG_WAIT_L(8); PG_BAR; PG_WAIT_L(0); PG_MMA(0, 0, At, B0); PG_BAR; PG_SCHED;
            PG_LDB(B1, 0, 1); PG_STAGE(PG_SB(0, 0), b2, voffB);
            PG_BAR; PG_WAIT_L(0); PG_MMA(0, 1, At, B1); PG_BAR;
            PG_LDA(At, 0, 1); PG_STAGE(PG_SA(0, 0), a2, aC0);
            PG_BAR; PG_WAIT_L(0); PG_MMA(1, 0, At, B0); PG_BAR; PG_SCHED;
            PG_STAGE(PG_SB(0, 1), b2 + hstepB, voffB);
            PG_WAIT_V(6); PG_BAR; PG_MMA(1, 1, At, B1); PG_BAR;
            PG_LDB(B0, 1, 0); PG_SCHED; PG_LDA(At, 1, 0); PG_STAGE(PG_SA(0, 1), a2, aC1);
            PG_WAIT_L(8); PG_BAR; PG_WAIT_L(0); PG_MMA(0, 0, At, B0); PG_BAR; PG_SCHED;
            PG_LDB(B1, 1, 1); PG_STAGE(PG_SB(1, 0), b3, voffB);
            PG_BAR; PG_WAIT_L(0); PG_MMA(0, 1, At, B1); PG_BAR;
            PG_LDA(At, 1, 1); PG_STAGE(PG_SA(1, 0), a3, aC0);
            PG_BAR; PG_WAIT_L(0); PG_MMA(1, 0, At, B0); PG_BAR; PG_SCHED;
            PG_STAGE(PG_SB(1, 1), b3 + hstepB, voffB);
            PG_WAIT_V(6); PG_BAR; PG_MMA(1, 1, At, B1); PG_BAR;
        }
        E(acc, cur, wr, wc, fr, fq);
        if (!has_next) break;
#pragma unroll
        for (int a = 0; a < 2; ++a)
#pragma unroll
            for (int b = 0; b < 2; ++b)
#pragma unroll
                for (int m = 0; m < 4; ++m)
#pragma unroll
                    for (int n = 0; n < 2; ++n) acc[a][b][m][n] = (f32x4){0.f, 0.f, 0.f, 0.f};
        cur = nxt; cB = nB; ++ui;
    }
    PG_WAIT_V(0);
    if (wr == 0) PG_BAR;
    PG_BAR;
#undef PG_SA
#undef PG_SB
#undef PG_STAGE
#undef PG_LDA
#undef PG_LDB
#undef PG_MMA
#undef PG_WAIT_V
#undef PG_WAIT_L
#undef PG_BAR
#undef PG_SCHED
#undef PG_AOFF
}

struct DenseSched {
    const char* A; const char* Bt; int K, nM, nN, nwg, G, c;
    __device__ void init(const void* A_, const void* Bt_, int M, int N, int K_, int G_, int c_) { A = (const char*)A_; Bt = (const char*)Bt_; K = K_; nM = M / BM; nN = N / BM; nwg = nM * nN; G = G_; c = c_; }
    __device__ __forceinline__ bool next(int i, Unit& u) const {
        const long L = (long)i * G + c; if (L >= nwg) return false;
        int wgid = (int)L; { const int q = nwg / 8, r = nwg % 8, xcd = wgid % 8, off = wgid / 8; wgid = (xcd < r ? xcd * (q + 1) : r * (q + 1) + (xcd - r) * q) + off; }
        const int nig = 8 * nN, gid = wgid / nig, fm = gid * 8, gsz = (nM - fm) < 8 ? (nM - fm) : 8;
        u.pm = fm + ((wgid % nig) % gsz); u.pn = (wgid % nig) / gsz; u.e = 0; u.rt = 0; u.cnt = 0; return true;
    }
    __device__ __forceinline__ const char* a_base() const { return A; }
    __device__ __forceinline__ unsigned a_rowoff(const Unit& u, int half, int R) const { return (unsigned)(u.pm * BM + half * HALF + R) * (unsigned)(K * 2); }
    __device__ __forceinline__ const char* b_ptr(const Unit& u) const { return Bt + (size_t)u.pn * BM * K * 2; }
};

__device__ __forceinline__ void moe_build_units(LAS int* tab, const int* cntp, int NCT, int G, int c) {
    const int i = opaque_tid();
    if (i < 16) {
        const int L = i * G + c; int accu = 0, rtb = 0, found = 0, pm = 0, pn = 0, ee = 0, rt = 0, cn = 0;
        for (int e = 0; e < 16; ++e) { const int ce = cntp[e], nte = (ce + 255) >> 8, ue = nte * NCT;
            if (!found && L < accu + ue) { const int local = L - accu; ee = e; rt = local / NCT; pn = local % NCT; pm = rtb + rt; cn = ce; found = 1; }
            accu += ue; rtb += nte; }
        tab[i * 8 + 0] = found; tab[i * 8 + 1] = pm; tab[i * 8 + 2] = pn; tab[i * 8 + 3] = ee; tab[i * 8 + 4] = rt; tab[i * 8 + 5] = cn;
    }
    __syncthreads();
}
template <bool GATHER>
struct MoeSched {
    const char* A; const char* Bt; const int* list; int K; size_t wstride; LAS int* tab;
    __device__ void init(const void* A_, const void* Bt_, size_t wstride_bytes, const int* list_, int K_, LAS int* tab_) {
        A = (const char*)A_; Bt = (const char*)Bt_; wstride = wstride_bytes; list = list_; K = K_; tab = tab_; }
    __device__ __forceinline__ bool next(int i, Unit& u) const {
        if (i >= 16) return false;
        const int f = __builtin_amdgcn_readfirstlane(tab[i * 8 + 0]);
        u.pm = __builtin_amdgcn_readfirstlane(tab[i * 8 + 1]); u.pn = __builtin_amdgcn_readfirstlane(tab[i * 8 + 2]); u.e = __builtin_amdgcn_readfirstlane(tab[i * 8 + 3]);
        u.rt = __builtin_amdgcn_readfirstlane(tab[i * 8 + 4]); u.cnt = __builtin_amdgcn_readfirstlane(tab[i * 8 + 5]);
        return f != 0;
    }
    __device__ __forceinline__ const char* a_base() const { return A; }
    __device__ __forceinline__ unsigned a_rowoff(const Unit& u, int half, int R) const {
        if (GATHER) { const int slot = u.rt * BM + half * HALF + R; const int tok = slot < u.cnt ? list[u.e * NTOK + slot] : 0; return (unsigned)tok * (unsigned)(K * 2); }
        return (unsigned)(u.pm * BM + half * HALF + R) * (unsigned)(K * 2);
    }
    __device__ __forceinline__ const char* b_ptr(const Unit& u) const { return Bt + (size_t)u.e * wstride + (size_t)u.pn * BM * K * 2; }
};

struct EpiBf16 {
    static constexpr bool PERM = true;
    bf16_t* O; int ldc;
    __device__ __forceinline__ void operator()(const f32x4 (&acc)[2][2][4][2], const Unit& u, int wr, int wc, int fr, int fq) const {
        const int row0 = u.pm * BM + wr * 64 + fr, col0 = u.pn * BM + wc * 32 + 8 * fq;
#pragma unroll
        for (int ai = 0; ai < 2; ++ai)
#pragma unroll
            for (int m = 0; m < 4; ++m) { bf16_t* rowp = O + (size_t)(row0 + ai * HALF + m * 16) * ldc + col0;
#pragma unroll
                for (int bj = 0; bj < 2; ++bj) { const f32x4 v0 = acc[ai][bj][m][0], v1 = acc[ai][bj][m][1];
                    u32x4 w; w.x = cvt_pk_bf16(v0[0], v0[1]); w.y = cvt_pk_bf16(v0[2], v0[3]); w.z = cvt_pk_bf16(v1[0], v1[1]); w.w = cvt_pk_bf16(v1[2], v1[3]);
                    *(u32x4*)(rowp + bj * HALF) = w; } }
    }
};
struct EpiResid {
    static constexpr bool PERM = false;
    const float* X; float* U;
    __device__ __forceinline__ void operator()(const f32x4 (&acc)[2][2][4][2], const Unit& u, int wr, int wc, int fr, int fq) const {
        const int row0 = u.pm * BM + wr * 64 + fr, col0 = u.pn * BM + wc * 32 + 4 * fq;
#pragma unroll
        for (int ai = 0; ai < 2; ++ai)
#pragma unroll
            for (int m = 0; m < 4; ++m) { const size_t off = (size_t)(row0 + ai * HALF + m * 16) * DM + col0;
#pragma unroll
                for (int bj = 0; bj < 2; ++bj)
#pragma unroll
                    for (int n = 0; n < 2; ++n) { const f32x4 xv = *(const f32x4*)(X + off + bj * HALF + n * 16);
                        *(f32x4*)(U + off + bj * HALF + n * 16) = xv * DN_ALPHA + acc[ai][bj][m][n]; } }
    }
};
struct EpiSwiglu {
    static constexpr bool PERM = true;
    bf16_t* O;
    __device__ __forceinline__ void operator()(const f32x4 (&acc)[2][2][4][2], const Unit& u, int wr, int wc, int fr, int fq) const {
        const int row0 = u.pm * BM + wr * 64 + fr, col0 = u.pn * HALF + wc * 32 + 8 * fq;
#pragma unroll
        for (int ai = 0; ai < 2; ++ai)
#pragma unroll
            for (int m = 0; m < 4; ++m) { bf16_t* rowp = O + (size_t)(row0 + ai * HALF + m * 16) * DEXP + col0;
                float r[8];
#pragma unroll
                for (int n = 0; n < 2; ++n)
#pragma unroll
                    for (int j = 0; j < 4; ++j) { const float g = acc[ai][0][m][n][j], up = acc[ai][1][m][n][j]; r[n * 4 + j] = g / (1.0f + __expf(-g)) * up; }
                u32x4 w; w.x = cvt_pk_bf16(r[0], r[1]); w.y = cvt_pk_bf16(r[2], r[3]); w.z = cvt_pk_bf16(r[4], r[5]); w.w = cvt_pk_bf16(r[6], r[7]);
                *(u32x4*)rowp = w; }
    }
};
}

__device__ __forceinline__ float reduce16_wave(const float (&v)[16], int lane) {
    float a8[8];
#pragma unroll
    for (int i = 0; i < 8; ++i) { const float mine = (lane & 32) ? v[8 + i] : v[i], other = (lane & 32) ? v[i] : v[8 + i]; a8[i] = mine + __shfl_xor(other, 32); }
    float a4[4];
#pragma unroll
    for (int i = 0; i < 4; ++i) { const float mine = (lane & 16) ? a8[4 + i] : a8[i], other = (lane & 16) ? a8[i] : a8[4 + i]; a4[i] = mine + __shfl_xor(other, 16); }
    float a2[2];
#pragma unroll
    for (int i = 0; i < 2; ++i) { const float mine = (lane & 8) ? a4[2 + i] : a4[i], other = (lane & 8) ? a4[i] : a4[2 + i]; a2[i] = mine + __shfl_xor(other, 8); }
    float a1; { const float mine = (lane & 4) ? a2[1] : a2[0], other = (lane & 4) ? a2[0] : a2[1]; a1 = mine + __shfl_xor(other, 4); }
    a1 += dppf<0x4E>(a1); a1 += dppf<0xB1>(a1);
    return a1;
}
__device__ __forceinline__ void tr_tile(LAS float* tile  , const float* src, int ld, int k0, int c0, int ncols_valid, bf16_t* dst, int dstK, int drow0, int tid) {
    {
        const int r = tid >> 3, cc = (tid & 7) * 8;
        const float* sp = src + (size_t)(k0 + r) * ld + c0 + cc;
#pragma unroll
        for (int j = 0; j < 8; ++j) tile[r * 65 + cc + j] = (c0 + cc + j < ncols_valid) ? sp[j] : 0.f;
    }
    __syncthreads();
    {
        const int n = tid >> 3, kk = (tid & 7) * 8;
        u32x4 w;
        w.x = cvt_pk_bf16(tile[(kk + 0) * 65 + n], tile[(kk + 1) * 65 + n]); w.y = cvt_pk_bf16(tile[(kk + 2) * 65 + n], tile[(kk + 3) * 65 + n]);
        w.z = cvt_pk_bf16(tile[(kk + 4) * 65 + n], tile[(kk + 5) * 65 + n]); w.w = cvt_pk_bf16(tile[(kk + 6) * 65 + n], tile[(kk + 7) * 65 + n]);
        *(u32x4*)(dst + (size_t)(drow0 + n) * dstK + k0 + kk) = w;
    }
    __syncthreads();
}

__device__ __forceinline__ void phase_prep(const Params& p, LAS unsigned char* lds, int bid, int nb) {
    const int tid = opaque_tid();
    LAS float* tile = (LAS float*)lds;
    unsigned char* ws = p.ws;
    const int T0 = 832, T1 = T0 + 256, T2 = T1 + 448, T3 = T2 + 256, T4 = T3 + 2048, T5 = T4 + 2048, T6 = T5 + 2048, T7 = T6 + 32;
    for (int t = bid; t < T7; t += nb) {
        if (t >= T6) { const int q = t - T6;
            if (q < 8) tr_tile(tile, p.in[I_AW2], 512, 0, q * 64, 512, (bf16_t*)(ws + OFF_MISC + MISC_W2T), 64, q * 64, tid);
            else if (q < 16) tr_tile(tile, p.in[I_AA2], 512, 0, (q - 8) * 64, 512, (bf16_t*)(ws + OFF_MISC + MISC_A2T), 64, (q - 8) * 64, tid);
            else { const int r = q - 16; tr_tile(tile, p.in[I_AG2], 512, (r >> 3) * 64, (r & 7) * 64, 512, (bf16_t*)(ws + OFF_MISC + MISC_G2T), 128, (r & 7) * 64, tid); }
            continue; }
        if (t < T0) { const int kt = t / 52, ct = t % 52; tr_tile(tile, p.in[I_WINE], EVEN_COLS, kt * 64, ct * 64, EVEN_COLS, (bf16_t*)(ws + OFF_WINE), 1024, ct * 64, tid); }
        else if (t < T1) { const int q = t - T0, kt = q / 16, ct = q % 16; tr_tile(tile, p.in[I_WOUTE], 1024, kt * 64, ct * 64, 1024, (bf16_t*)(ws + OFF_WOUTE), 1024, ct * 64, tid); }
        else if (t < T2) { const int q = t - T1, kt = q / 28, ct = q % 28; tr_tile(tile, p.in[I_WINO], ODD_COLS, kt * 64, ct * 64, ODD_COLS, (bf16_t*)(ws + OFF_WINO), 1024, ct * 64, tid); }
        else if (t < T3) { const int q = t - T2, kt = q / 16, ct = q % 16; tr_tile(tile, p.in[I_WOUTO], 1024, kt * 64, ct * 64, 1024, (bf16_t*)(ws + OFF_WOUTO), 1024, ct * 64, tid); }
        else if (t < T5) { const bool up = t >= T4; const int q = t - (up ? T4 : T3), le = q / 64, r = q % 64, kt = r / 4, ct = r % 4;
            const int c0 = ct * 64, drow0 = (c0 / 128) * 256 + (up ? 128 : 0) + (c0 % 128);
            tr_tile(tile, p.in[up ? I_EU : I_EG] + (size_t)le * 1024 * 256, 256, kt * 64, c0, 256, (bf16_t*)(ws + OFF_WGU) + (size_t)le * 512 * 1024, 1024, drow0, tid); }
        else { const int q = t - T5, le = q / 64, r = q % 64, kt = r / 16, ct = r % 16;
            tr_tile(tile, p.in[I_ED] + (size_t)le * 256 * 1024, 1024, kt * 64, ct * 64, 1024, (bf16_t*)(ws + OFF_WD) + (size_t)le * 1024 * 256, 256, ct * 64, tid); }
    }
    {
        const float* x = p.in[I_X]; bf16_t* xb = (bf16_t*)(ws + OFF_BUF64);
        const size_t n8 = (size_t)NTOK * DM / 8;
        for (size_t i = (size_t)bid * 512 + tid; i < n8; i += (size_t)nb * 512) {
            const f32x4 a = *(const f32x4*)(x + i * 8), b = *(const f32x4*)(x + i * 8 + 4);
            u32x4 w; w.x = cvt_pk_bf16(a[0], a[1]); w.y = cvt_pk_bf16(a[2], a[3]); w.z = cvt_pk_bf16(b[0], b[1]); w.w = cvt_pk_bf16(b[2], b[3]);
            *(u32x4*)(xb + i * 8) = w;
        }
    }
    {
        float* c64 = (float*)(ws + OFF_ROPE); float* s64 = c64 + 4096 * 64; float* c32 = s64 + 4096 * 64; float* s32 = c32 + 4096 * 32;
        for (int i = bid * 512 + tid; i < 4096 * 64; i += nb * 512) { const int pos = i >> 6, j = i & 63; const float inv = powf(10000.0f, -(float)j / 64.0f); const float ang = (float)pos * inv; c64[i] = cosf(ang); s64[i] = sinf(ang); }
        for (int i = bid * 512 + tid; i < 4096 * 32; i += nb * 512) { const int pos = i >> 5, j = i & 31; const float inv = powf(10000.0f, -(float)j / 32.0f); const float ang = (float)pos * inv; c32[i] = cosf(ang); s32[i] = sinf(ang); }
    }
    if (bid == 0 && tid < 64) ((int*)(ws + OFF_MISC + MISC_CNT))[tid] = 0;
}

__device__ __forceinline__ void phase_ln_route(const Params& p, LAS unsigned char* lds, int bid, int nb, int layer) {
    const int tid = opaque_tid(), wid = tid >> 6, lane = tid & 63;
    unsigned char* ws = p.ws;
    LAS float* rwT = (LAS float*)lds;
    LAS int* sel = (LAS int*)(lds + 65536);
    LAS float* selg = (LAS float*)(lds + 65536 + 1024);
    LAS int* cntw = (LAS int*)(lds + 65536 + 2048);
    { const float* rw = p.in[I_RW];
        for (int i = tid; i < 16 * 1024; i += 512) { const int e = i >> 10, k = i & 1023; rwT[i] = rw[k * 16 + e]; } }
    __syncthreads();
    float* U = (float*)(ws + OFF_U); bf16_t* hb = (bf16_t*)(ws + OFF_BUF64);
    const float* g = p.in[I_LN1G] + layer * DM; const float* b = p.in[I_LN1B] + layer * DM;
    int* cnt = (int*)(ws + OFF_MISC + MISC_CNT) + layer * 16;
    int* tokinfo = (int*)(ws + OFF_MISC + MISC_TOKINFO); float* tokgate = (float*)(ws + OFF_MISC + MISC_TOKGATE); int* list = (int*)(ws + OFF_MISC + MISC_LIST);
    f32x4 gv[4], bv[4];
#pragma unroll
    for (int j = 0; j < 4; ++j) { gv[j] = *(const f32x4*)(g + j * 256 + lane * 4); bv[j] = *(const f32x4*)(b + j * 256 + lane * 4); }
    const float* rbp = p.in[I_RB];
    const float my_rb = rbp[((lane >> 5) & 1) * 8 + ((lane >> 4) & 1) * 4 + ((lane >> 3) & 1) * 2 + ((lane >> 2) & 1)];
    for (int blk = bid; blk < NTOK / 128; blk += nb) {
#pragma unroll 1
        for (int i = 0; i < 16; ++i) {
            const int tl = wid * 16 + i, tok = blk * 128 + tl;
            f32x4 v[4]; float s = 0.f;
            asm volatile("" ::: "memory");
#pragma unroll
            for (int j = 0; j < 4; ++j) { v[j] = *(const f32x4*)(U + (size_t)tok * DM + j * 256 + lane * 4); s += (v[j][0] + v[j][1]) + (v[j][2] + v[j][3]); }
            const float mean = wave_sum(s) * (1.0f / DM);
            float q = 0.f;
#pragma unroll
            for (int j = 0; j < 4; ++j) { v[j] -= mean; q += (v[j][0] * v[j][0] + v[j][1] * v[j][1]) + (v[j][2] * v[j][2] + v[j][3] * v[j][3]); }
            const float rstd = rsqrtf(wave_sum(q) * (1.0f / DM) + LN_EPS);
#pragma unroll
            for (int j = 0; j < 4; ++j) { v[j] = v[j] * rstd * gv[j] + bv[j];
                *(f32x4*)(U + (size_t)tok * DM + j * 256 + lane * 4) = v[j];
                u32x2 w; w.x = cvt_pk_bf16(v[j][0], v[j][1]); w.y = cvt_pk_bf16(v[j][2], v[j][3]);
                *(u32x2*)(hb + (size_t)tok * DM + j * 256 + lane * 4) = w; }
            float part[16];
#pragma unroll
            for (int e = 0; e < 16; ++e) { float a = 0.f;
#pragma unroll
                for (int j = 0; j < 4; ++j) { const f32x4 w = *(const LAS f32x4*)(rwT + e * 1024 + j * 256 + lane * 4); a += (v[j][0] * w[0] + v[j][1] * w[1]) + (v[j][2] * w[2] + v[j][3] * w[3]); }
                part[e] = a; }
            const float lgm = reduce16_wave(part, lane);
            const float sgm = 1.0f / (1.0f + expf(-lgm)), selm = sgm + my_rb;
            float sg[16], sl[16];
#pragma unroll
            for (int e = 0; e < 16; ++e) { const int L = ((e >> 3) & 1) * 32 + ((e >> 2) & 1) * 16 + ((e >> 1) & 1) * 8 + (e & 1) * 4;
                sg[e] = __builtin_bit_cast(float, __builtin_amdgcn_readlane(__builtin_bit_cast(int, sgm), L)); sl[e] = __builtin_bit_cast(float, __builtin_amdgcn_readlane(__builtin_bit_cast(int, selm), L)); }
            int best = 0; float bestv = -INFINITY;
#pragma unroll
            for (int gI = 0; gI < 4; ++gI) { float m1 = -INFINITY, m2 = -INFINITY;
#pragma unroll
                for (int j = 0; j < 4; ++j) { const float x = sl[gI * 4 + j]; if (x > m1) { m2 = m1; m1 = x; } else if (x > m2) m2 = x; }
                const float gs = m1 + m2; if (gs > bestv) { bestv = gs; best = gI; } }
            int e0 = 0, e1 = 0; float v0 = -INFINITY, v1 = -INFINITY, s0 = 0.f, s1 = 0.f;
#pragma unroll
            for (int e = 0; e < 16; ++e) { if ((e >> 2) == best) { const float x = sl[e];
                    if (x > v0) { v1 = v0; e1 = e0; s1 = s0; v0 = x; e0 = e; s0 = sg[e]; } else if (x > v1) { v1 = x; e1 = e; s1 = sg[e]; } } }
            const float gsum = s0 + s1;
            if (lane == 0) { sel[tl * 2] = e0; sel[tl * 2 + 1] = e1; selg[tl * 2] = s0 / gsum; selg[tl * 2 + 1] = s1 / gsum; }
        }
        __syncthreads();
        int myE = -1, myRank = 0;
        if (tid < 256) { myE = sel[tid];
#pragma unroll
            for (int e = 0; e < 16; ++e) { const unsigned long long mk = __ballot(myE == e); if (myE == e) myRank = __popcll(mk & ((1ull << lane) - 1ull)); if (lane == 0) cntw[wid * 16 + e] = __popcll(mk); } }
        __syncthreads();
        if (tid < 16) { const int c0 = cntw[tid], c1 = cntw[16 + tid], c2 = cntw[32 + tid], c3 = cntw[48 + tid];
            const int basev = atomicAdd(cnt + tid, c0 + c1 + c2 + c3);
            cntw[64 + tid] = basev; cntw[80 + tid] = basev + c0; cntw[96 + tid] = basev + c0 + c1; cntw[112 + tid] = basev + c0 + c1 + c2; }
        __syncthreads();
        if (tid < 256) { const int slot = cntw[64 + wid * 16 + myE] + myRank; const int tok = blk * 128 + (tid >> 1), k = tid & 1;
            list[myE * NTOK + slot] = tok; tokinfo[tok * 4 + k * 2] = myE; tokinfo[tok * 4 + k * 2 + 1] = slot; tokgate[tok * 2 + k] = selg[tid]; }
        __syncthreads();
    }
}

__device__ __forceinline__ void phase_ln2(const Params& p, int bid, int nb, int layer, float* dst, bool with_moe) {
    const int tid = opaque_tid(), wid = tid >> 6, lane = tid & 63;
    unsigned char* ws = p.ws;
    const float* U = (const float*)(ws + OFF_U); bf16_t* xb = (bf16_t*)(ws + OFF_BUF64);
    const bf16_t* he = (const bf16_t*)(ws + OFF_HE);
    const float* g = p.in[I_LN2G] + layer * DM; const float* b = p.in[I_LN2B] + layer * DM;
    const int* cnt = (const int*)(ws + OFF_MISC + MISC_CNT) + layer * 16;
    const int* tokinfo = (const int*)(ws + OFF_MISC + MISC_TOKINFO); const float* tokgate = (const float*)(ws + OFF_MISC + MISC_TOKGATE);
    int rowbase[16]; { int a = 0;
#pragma unroll
        for (int e = 0; e < 16; ++e) { rowbase[e] = a; a += ((cnt[e] + 255) >> 8) << 8; } }
    f32x4 gv[4], bv[4];
#pragma unroll
    for (int j = 0; j < 4; ++j) { gv[j] = *(const f32x4*)(g + j * 256 + lane * 4); bv[j] = *(const f32x4*)(b + j * 256 + lane * 4); }
    for (int tok = bid * 8 + wid; tok < NTOK; tok += nb * 8) {
        f32x4 v[4]; float s = 0.f;
        int r0 = 0, r1 = 0; float g0 = 0.f, g1 = 0.f;
        if (with_moe) { const int e0 = tokinfo[tok * 4 + 0], sl0 = tokinfo[tok * 4 + 1], e1 = tokinfo[tok * 4 + 2], sl1 = tokinfo[tok * 4 + 3];
            int rb0 = 0, rb1 = 0;
#pragma unroll
            for (int e = 0; e < 16; ++e) { if (e == e0) rb0 = rowbase[e]; if (e == e1) rb1 = rowbase[e]; }
            r0 = rb0 + sl0; r1 = rb1 + sl1; g0 = tokgate[tok * 2 + 0]; g1 = tokgate[tok * 2 + 1]; }
#pragma unroll
        for (int j = 0; j < 4; ++j) { v[j] = *(const f32x4*)(U + (size_t)tok * DM + j * 256 + lane * 4) * DN_ALPHA;
            if (with_moe) { const u32x2 a = *(const u32x2*)(he + (size_t)r0 * DM + j * 256 + lane * 4), c = *(const u32x2*)(he + (size_t)r1 * DM + j * 256 + lane * 4);
                v[j][0] += g0 * __uint_as_float(a.x << 16) + g1 * __uint_as_float(c.x << 16); v[j][1] += g0 * __uint_as_float(a.x & 0xffff0000u) + g1 * __uint_as_float(c.x & 0xffff0000u);
                v[j][2] += g0 * __uint_as_float(a.y << 16) + g1 * __uint_as_float(c.y << 16); v[j][3] += g0 * __uint_as_float(a.y & 0xffff0000u) + g1 * __uint_as_float(c.y & 0xffff0000u); }
            s += (v[j][0] + v[j][1]) + (v[j][2] + v[j][3]); }
        const float mean = wave_sum(s) * (1.0f / DM);
        float q = 0.f;
#pragma unroll
        for (int j = 0; j < 4; ++j) { v[j] -= mean; q += (v[j][0] * v[j][0] + v[j][1] * v[j][1]) + (v[j][2] * v[j][2] + v[j][3] * v[j][3]); }
        const float rstd = rsqrtf(wave_sum(q) * (1.0f / DM) + LN_EPS);
#pragma unroll
        for (int j = 0; j < 4; ++j) { v[j] = v[j] * rstd * gv[j] + bv[j];
#if PROBE_ID
            if (layer == 1) v[j] = v[j] * (1.0f + *(const float*)(ws + OFF_MISC + MISC_PROBE));
#endif
            *(f32x4*)(dst + (size_t)tok * DM + j * 256 + lane * 4) = v[j];
            u32x2 w; w.x = cvt_pk_bf16(v[j][0], v[j][1]); w.y = cvt_pk_bf16(v[j][2], v[j][3]);
            *(u32x2*)(xb + (size_t)tok * DM + j * 256 + lane * 4) = w; }
    }
}

__device__ __forceinline__ void phase_resid_only(const Params& p, const float* X, int bid, int nb) {
    float* U = (float*)(p.ws + OFF_U);
    const size_t n4 = (size_t)NTOK * DM / 4;
    for (size_t i = (size_t)bid * 512 + threadIdx.x; i < n4; i += (size_t)nb * 512) *(f32x4*)(U + i * 4) = *(const f32x4*)(X + i * 4) * DN_ALPHA;
}

__device__ __forceinline__ void phase_moe_gateup(const Params& p, LAS unsigned char* lds, int bid, int nb, int layer) {
    unsigned char* ws = p.ws;
    LAS int* tab = (LAS int*)(lds + pg::STAGE_BYTES);
    pg::moe_build_units(tab, (const int*)(ws + OFF_MISC + MISC_CNT) + layer * 16, 2, nb, bid);
    pg::MoeSched<true> S; S.init(ws + OFF_BUF64, ws + OFF_WGU + (size_t)layer * 16 * 512 * 1024 * 2, (size_t)512 * 1024 * 2, (const int*)(ws + OFF_MISC + MISC_LIST), 1024, tab);
    pg::EpiSwiglu E; E.O = (bf16_t*)(ws + OFF_ACT);
    pg::gemm_phase(lds, 1024, S, E);
}
__device__ __forceinline__ void phase_moe_down(const Params& p, LAS unsigned char* lds, int bid, int nb, int layer) {
    unsigned char* ws = p.ws;
    LAS int* tab = (LAS int*)(lds + pg::STAGE_BYTES);
    pg::moe_build_units(tab, (const int*)(ws + OFF_MISC + MISC_CNT) + layer * 16, 4, nb, bid);
    pg::MoeSched<false> S; S.init(ws + OFF_ACT, ws + OFF_WD + (size_t)layer * 16 * 1024 * 256 * 2, (size_t)1024 * 256 * 2, nullptr, 256, tab);
    pg::EpiBf16 E; E.O = (bf16_t*)(ws + OFF_HE); E.ldc = 1024;
    pg::gemm_phase(lds, 256, S, E);
}

__device__ __forceinline__ void phase_gla_alpha(const Params& p, LAS unsigned char* lds, int bid, int nb) {
    const int tid = opaque_tid(), wid = tid >> 6, lane = tid & 63;
    LAS float* wT = (LAS float*)lds;
    for (int i = tid; i < 16 * 1024; i += 512) { const int e = i & 15, k = i >> 4; wT[e * 1024 + k] = p.in[I_WINE][(size_t)k * EVEN_COLS + NE_MAIN + e]; }
    __syncthreads();
    const float* x = p.in[I_X]; float* xa = (float*)(p.ws + OFF_U);
    for (int tok = bid * 8 + wid; tok < NTOK; tok += nb * 8) {
        f32x4 v[4];
        asm volatile("" ::: "memory");
#pragma unroll
        for (int j = 0; j < 4; ++j) v[j] = *(const f32x4*)(x + (size_t)tok * DM + j * 256 + lane * 4);
        float part[16];
#pragma unroll
        for (int e = 0; e < 16; ++e) { float a = 0.f;
#pragma unroll
            for (int j = 0; j < 4; ++j) { const f32x4 w = *(const LAS f32x4*)(wT + e * 1024 + j * 256 + lane * 4); a += (v[j][0] * w[0] + v[j][1] * w[1]) + (v[j][2] * w[2] + v[j][3] * w[3]); }
            part[e] = a; }
        const float r = reduce16_wave(part, lane);
        if ((lane & 3) == 0) xa[(size_t)tok * 16 + ((lane >> 5) & 1) * 8 + ((lane >> 4) & 1) * 4 + ((lane >> 3) & 1) * 2 + ((lane >> 2) & 1)] = r;
    }
    __syncthreads();
}

__device__ __forceinline__ float red8(float v) { v += dppf<0xB1>(v); v += dppf<0x4E>(v); v += dppf<0x141>(v); return v; }

__device__ __forceinline__ void rwkv_item(const Params& p, LAS unsigned char* lds, int item) {
    constexpr int TC = 16;
    const int tid = opaque_tid(), lane = tid & 63, tg = tid >> 6;
    const int b = item >> 3, h = item & 7;
    const bf16_t* P0 = (const bf16_t*)(p.ws + OFF_P);
    bf16_t* mix = (bf16_t*)(p.ws + OFF_BUF64);
    LAS float* w2s = (LAS float*)lds;
    LAS float* a2s = w2s + 64 * 64;
    LAS float* g2s = a2s + 64 * 64;
    LAS float* tw = g2s + 128 * 64;
    LAS float* xa_s = tw + TC * 64;
    LAS float* sg = xa_s + TC * 64;
    LAS float* r_s = sg + TC * 128;
    LAS float* k_s = r_s + TC * 64;
    LAS float* v_s = k_s + TC * 64;
    LAS float* w_s = v_s + TC * 64;
    LAS float* kk_s = w_s + TC * 64;
    LAS float* kka_s = kk_s + TC * 64;
    LAS float* kh_s = kka_s + TC * 64;
    LAS float* g_s = kh_s + TC * 64;
    LAS float* y_s = g_s + TC * 64;
    LAS float* rk_s = y_s + TC * 64;
    const float* mu = p.in[I_AMU];
    for (int i = tid; i < 64 * 64; i += 512) { const int r = i >> 6, c = i & 63; w2s[i] = p.in[I_AW2][r * 512 + h * 64 + c]; a2s[i] = p.in[I_AA2][r * 512 + h * 64 + c]; }
    for (int i = tid; i < 128 * 64; i += 512) { const int r = i >> 6, c = i & 63; g2s[i] = p.in[I_AG2][r * 512 + h * 64 + c]; }
    const int j = lane;
    const float w0 = p.in[I_AW0][h * 64 + j], a0 = p.in[I_AA0][h * 64 + j], kksc = p.in[I_AKK][h * 64 + j], kasc = p.in[I_AKA][h * 64 + j], rkj = p.in[I_ARK][h * 64 + j];
    const float gng = p.in[I_AGNG][h * 64 + j], gnb = p.in[I_AGNB][h * 64 + j];
    float S[8];
#pragma unroll
    for (int i = 0; i < 8; ++i) S[i] = 0.f;
    const int row = tid >> 3, kq = tid & 7;
    __syncthreads();
    for (int t0 = 0; t0 < SEQ; t0 += TC) {
        for (int idx = tid; idx < TC * 448; idx += 512) {
            const int t = idx / 448, c = idx % 448; int col; LAS float* dst; int kind = 0;
            if (c < 64) { col = h * 64 + c; dst = r_s + t * 64 + c; }
            else if (c < 128) { col = 512 + h * 64 + (c - 64); dst = k_s + t * 64 + (c - 64); }
            else if (c < 192) { col = 1024 + h * 64 + (c - 128); dst = v_s + t * 64 + (c - 128); }
            else if (c < 256) { col = 1536 + (c - 192); dst = tw + t * 64 + (c - 192); kind = 1; }
            else if (c < 320) { col = 1600 + (c - 256); dst = xa_s + t * 64 + (c - 256); }
            else { col = 1664 + (c - 320); dst = sg + t * 128 + (c - 320); kind = 2; }
            const size_t n = (size_t)b * SEQ + t0 + t;
            const float cur = bf2f(P0[n * NE_MAIN + col]);
            const float prev = (t0 + t) > 0 ? bf2f(P0[(n - 1) * NE_MAIN + col]) : 0.f;
            float val = cur + (prev - cur) * mu[col];
            if (kind == 1) val = tanhf(val); else if (kind == 2) val = 1.0f / (1.0f + expf(-val));
            *dst = val;
        }
        __syncthreads();
#pragma unroll
        for (int tt = 0; tt < 2; ++tt) {
            const int t = tg + tt * 8;
            float aw = 0.f, aa = 0.f, ag = 0.f;
            asm volatile("" ::: "memory");
#pragma unroll 4
            for (int i = 0; i < 64; ++i) { aw += tw[t * 64 + i] * w2s[i * 64 + j]; aa += xa_s[t * 64 + i] * a2s[i * 64 + j]; }
            asm volatile("" ::: "memory");
#pragma unroll 4
            for (int i = 0; i < 128; ++i) ag += sg[t * 128 + i] * g2s[i * 64 + j];
            asm volatile("" ::: "memory");
            const float z = w0 + aw;
            const float sp = (-z > 20.f) ? -z : log1pf(expf(-z));
            const float wlog = -sp - 0.5f;
            const float decay = expf(-expf(wlog));
            const float a = 1.0f / (1.0f + expf(-(a0 + aa)));
            const float kraw = k_s[t * 64 + j];
            const float kkp = kraw * kksc;
            const float nrm = sqrtf(wave_sum(kkp * kkp));
            const float kk = kkp / fmaxf(nrm, 1e-12f);
            const float kh = kraw * (1.0f + (a - 1.0f) * kasc);
            const float rr = r_s[t * 64 + j];
            const float rk = wave_sum(rr * kh * rkj);
            w_s[t * 64 + j] = decay; kk_s[t * 64 + j] = kk; kka_s[t * 64 + j] = kk * a; kh_s[t * 64 + j] = kh; g_s[t * 64 + j] = ag;
            if (j == 0) rk_s[t] = rk;
        }
        __syncthreads();
        for (int t = 0; t < TC; ++t) {
            const f32x4 kk0 = *(const LAS f32x4*)(kk_s + t * 64 + kq * 8), kk1 = *(const LAS f32x4*)(kk_s + t * 64 + kq * 8 + 4);
            const f32x4 ww0 = *(const LAS f32x4*)(w_s + t * 64 + kq * 8), ww1 = *(const LAS f32x4*)(w_s + t * 64 + kq * 8 + 4);
            const f32x4 ka0 = *(const LAS f32x4*)(kka_s + t * 64 + kq * 8), ka1 = *(const LAS f32x4*)(kka_s + t * 64 + kq * 8 + 4);
            const f32x4 kh0 = *(const LAS f32x4*)(kh_s + t * 64 + kq * 8), kh1 = *(const LAS f32x4*)(kh_s + t * 64 + kq * 8 + 4);
            const f32x4 rr0 = *(const LAS f32x4*)(r_s + t * 64 + kq * 8), rr1 = *(const LAS f32x4*)(r_s + t * 64 + kq * 8 + 4);
            const float vv = v_s[t * 64 + row];
            float sa = 0.f;
#pragma unroll
            for (int i = 0; i < 4; ++i) { sa += S[i] * kk0[i]; sa += S[4 + i] * kk1[i]; }
            sa = red8(sa);
            float y = 0.f;
#pragma unroll
            for (int i = 0; i < 4; ++i) {
                S[i] = S[i] * ww0[i] - sa * ka0[i] + vv * kh0[i]; S[4 + i] = S[4 + i] * ww1[i] - sa * ka1[i] + vv * kh1[i];
                y += S[i] * rr0[i]; y += S[4 + i] * rr1[i]; }
            y = red8(y);
            if (kq == 0) y_s[t * 64 + row] = y;
        }
        __syncthreads();
#pragma unroll
        for (int tt = 0; tt < 2; ++tt) {
            const int t = tg + tt * 8;
            const float y = y_s[t * 64 + j];
            const float mean = wave_sum(y) * (1.0f / 64.0f);
            const float d = y - mean;
            const float var = wave_sum(d * d) * (1.0f / 64.0f);
            const float yn = d * rsqrtf(var + 64e-5f) * gng + gnb;
            const float o = (yn + rk_s[t] * v_s[t * 64 + j]) * g_s[t * 64 + j];
            mix[((size_t)b * SEQ + t0 + t) * DM + h * 64 + j] = f2bf(o);
        }
        __syncthreads();
    }
}

__device__ __forceinline__ void gla_item(const Params& p, LAS unsigned char* lds, int item) {
    const int tid = opaque_tid(), lane = tid & 63, tg = tid >> 6;
    const int b = item >> 2, h = item & 3;
    const bf16_t* P0 = (const bf16_t*)(p.ws + OFF_P) + 1792;
    const float* xa16 = (const float*)(p.ws + OFF_U);
    bf16_t* mix = (bf16_t*)(p.ws + OFF_BUF64);
    LAS float* qd = (LAS float*)lds;
    LAS float* ki = qd + 64 * 65;
    LAS float* att = ki + 64 * 65;
    LAS float* vs = att + 64 * 65;
    LAS float* St = vs + 64 * 128;
    LAS float* bl = St + 64 * 128;
    for (int i = tid; i < 64 * 128; i += 512) St[i] = 0.f;
    float gw2[16];
#pragma unroll
    for (int i = 0; i < 16; ++i) gw2[i] = p.in[I_BGW2][i * 256 + h * 64 + lane];
    const float gb = p.in[I_BGB][h * 64 + lane];
    const float* bng = p.in[I_BNG];
    __syncthreads();
    for (int c0 = 0; c0 < SEQ; c0 += 64) {
        const size_t n0 = (size_t)b * SEQ + c0;
        for (int tt = 0; tt < 8; ++tt) { const int c = tg * 8 + tt; float z = gb;
#pragma unroll
            for (int i = 0; i < 16; ++i) z += xa16[(n0 + c) * 16 + i] * gw2[i];
            const float ls = (z >= 0.f) ? -log1pf(expf(-z)) : (z - log1pf(expf(z)));
            att[c * 65 + lane] = ls * (1.0f / 16.0f); }
        for (int i = tid; i < 64 * 128; i += 512) { const int c = i >> 7, e = i & 127; vs[i] = bf2f(P0[(n0 + c) * NE_MAIN + 512 + h * 128 + e]); }
        __syncthreads();
        if (tid < 64) { float a = 0.f; for (int c = 0; c < 64; ++c) { a += att[c * 65 + tid]; att[c * 65 + tid] = a; } bl[tid] = a; }
        __syncthreads();
        for (int i = tid; i < 64 * 64; i += 512) { const int c = i >> 6, d = i & 63; const float bc = att[c * 65 + d];
            const float q = bf2f(P0[(n0 + c) * NE_MAIN + h * 64 + d]), k = bf2f(P0[(n0 + c) * NE_MAIN + 256 + h * 64 + d]);
            qd[c * 65 + d] = q * 0.125f * expf(bc); ki[c * 65 + d] = k * expf(-bc); }
        __syncthreads();
        { const int c = tid >> 3, sgp = tid & 7; float a[8];
#pragma unroll
            for (int i = 0; i < 8; ++i) a[i] = 0.f;
            for (int d = 0; d < 64; ++d) { const float qv = qd[c * 65 + d];
#pragma unroll
                for (int i = 0; i < 8; ++i) a[i] += qv * ki[(sgp * 8 + i) * 65 + d]; }
            __syncthreads();
#pragma unroll
            for (int i = 0; i < 8; ++i) att[c * 65 + sgp * 8 + i] = (sgp * 8 + i <= c) ? a[i] : 0.f; }
        __syncthreads();
        { const int c = tid >> 3, eg = tid & 7; float o[16];
#pragma unroll
            for (int i = 0; i < 16; ++i) o[i] = 0.f;
            for (int s = 0; s <= c; ++s) { const float a = att[c * 65 + s];
#pragma unroll
                for (int i = 0; i < 16; ++i) o[i] += a * vs[s * 128 + eg * 16 + i]; }
            for (int d = 0; d < 64; ++d) { const float qv = qd[c * 65 + d];
#pragma unroll
                for (int i = 0; i < 16; ++i) o[i] += qv * St[d * 128 + eg * 16 + i]; }
            float ss = 0.f;
#pragma unroll
            for (int i = 0; i < 16; ++i) ss += o[i] * o[i];
            ss = red8(ss);
            const float rs = rsqrtf(ss * (1.0f / 128.0f) + 1e-5f);
#pragma unroll
            for (int i = 0; i < 16; ++i) { const int e = eg * 16 + i; const float g = bf2f(P0[(n0 + c) * NE_MAIN + 1024 + h * 128 + e]);
                const float val = o[i] * rs * bng[h * 128 + e] * (g / (1.0f + expf(-g)));
                mix[(n0 + c) * DM + 512 + h * 128 + e] = f2bf(val); } }
        __syncthreads();
        { const int d = tid >> 3, eg = tid & 7; float a[16];
#pragma unroll
            for (int i = 0; i < 16; ++i) a[i] = St[d * 128 + eg * 16 + i];
            for (int c = 0; c < 64; ++c) { const float kv = ki[c * 65 + d];
#pragma unroll
                for (int i = 0; i < 16; ++i) a[i] += kv * vs[c * 128 + eg * 16 + i]; }
            const float eb = expf(bl[d]);
#pragma unroll
            for (int i = 0; i < 16; ++i) St[d * 128 + eg * 16 + i] = a[i] * eb; }
        __syncthreads();
    }
}

__device__ __forceinline__ float red16(float v) { v += dppf<0xB1>(v); v += dppf<0x4E>(v); v += dppf<0x141>(v); v += dppf<0x140>(v); return v; }
__device__ __forceinline__ void rwkv2_item(const Params& p, LAS unsigned char* lds, int item) {
    constexpr int TC = 32;
    const int tid = opaque_tid(), lane = tid & 63, wid = tid >> 6, fr = lane & 15, g = lane >> 4;
    const int b = item >> 4, h = (item >> 1) & 7, rq = item & 1;
    unsigned char* ws = p.ws;
    const bf16_t* P0 = (const bf16_t*)(ws + OFF_P);
    float* yraw = p.out;
    bf16_t* e1g = (bf16_t*)(p.out + (size_t)NTOK * 512);
    bf16_t* gg = e1g + (size_t)NTOK * 512;
    LAS float* kk_s = (LAS float*)lds;
    LAS float* w_s = kk_s + TC * 64;
    LAS float* b_s = w_s + TC * 64;
    LAS float* kh_s = b_s + TC * 64;
    LAS float* wr_s = kh_s + TC * 64;
    LAS float* wpre = wr_s + TC * 64;
    LAS float* apre = wpre + TC * 64;
    LAS float* gpre = apre + TC * 64;
    LAS float* v_s = gpre + TC * 32;
    LAS float* y_s = v_s + TC * 32;
    LAS float* sc_s = y_s + TC * 32;
    LAS unsigned char* tw_i = (LAS unsigned char*)(sc_s + TC * 2);
    LAS unsigned char* xa_i = tw_i + TC * 128;
    LAS unsigned char* sg_i = xa_i + TC * 128;
    const float* mu = p.in[I_AMU];
    const bf16_t* w2t = (const bf16_t*)(ws + OFF_MISC + MISC_W2T); const bf16_t* a2t = (const bf16_t*)(ws + OFF_MISC + MISC_A2T); const bf16_t* g2t = (const bf16_t*)(ws + OFF_MISC + MISC_G2T);
    const int mrt = wid >> 2, mct = wid & 3;
    bf16x8 wf[2], af[2], gf[4];
#pragma unroll
    for (int s = 0; s < 2; ++s) { wf[s] = *(const bf16x8*)(w2t + (size_t)(h * 64 + mct * 16 + fr) * 64 + s * 32 + g * 8); af[s] = *(const bf16x8*)(a2t + (size_t)(h * 64 + mct * 16 + fr) * 64 + s * 32 + g * 8); }
    const int grt = (wid >> 1) & 1, gct = wid & 1;
#pragma unroll
    for (int s = 0; s < 4; ++s) gf[s] = *(const bf16x8*)(g2t + (size_t)(h * 64 + rq * 32 + gct * 16 + fr) * 128 + s * 32 + g * 8);
    const int et = tid >> 4, ec = tid & 15;
    const f32x4 w0v = *(const f32x4*)(p.in[I_AW0] + h * 64 + ec * 4), a0v = *(const f32x4*)(p.in[I_AA0] + h * 64 + ec * 4);
    const f32x4 kksc = *(const f32x4*)(p.in[I_AKK] + h * 64 + ec * 4), kasc = *(const f32x4*)(p.in[I_AKA] + h * 64 + ec * 4), rkv = *(const f32x4*)(p.in[I_ARK] + h * 64 + ec * 4);
    const f32x4 mur = *(const f32x4*)(mu + h * 64 + ec * 4), muk = *(const f32x4*)(mu + 512 + h * 64 + ec * 4);
    const f32x2 muv = *(const f32x2*)(mu + 1024 + h * 64 + rq * 32 + ec * 2);
    const int p1tok0 = tid >> 5, p1cc = tid & 31, p1col = 1536 + p1cc * 8;
    const f32x4 p1m0 = *(const f32x4*)(mu + p1col), p1m1 = *(const f32x4*)(mu + p1col + 4);
    float S[4] = {0.f, 0.f, 0.f, 0.f};
    const int rl = wid * 4 + g, kq = fr;
    const size_t nb0 = (size_t)b * SEQ;
    u32x4 l_cu[2], l_pv[2]; u32x2 l_rc, l_kc, l_rp, l_kp; unsigned l_vc, l_vp;
#define RW_ISSUE(t0n) do { \
        _Pragma("unroll") for (int _i = 0; _i < 2; ++_i) { const size_t _n = nb0 + (t0n) + p1tok0 + _i * 16; \
            l_cu[_i] = *(const u32x4*)(P0 + _n * NE_MAIN + p1col); l_pv[_i] = uzero4(); \
            if ((t0n) + p1tok0 + _i * 16 > 0) l_pv[_i] = *(const u32x4*)(P0 + (_n - 1) * NE_MAIN + p1col); } \
        { const size_t _n = nb0 + (t0n) + et; const bool _hp = ((t0n) + et) > 0; \
            l_rc = *(const u32x2*)(P0 + _n * NE_MAIN + h * 64 + ec * 4); l_kc = *(const u32x2*)(P0 + _n * NE_MAIN + 512 + h * 64 + ec * 4); \
            l_vc = *(const unsigned*)(P0 + _n * NE_MAIN + 1024 + h * 64 + rq * 32 + ec * 2); \
            l_rp = (u32x2){0u, 0u}; l_kp = (u32x2){0u, 0u}; l_vp = 0u; \
            if (_hp) { l_rp = *(const u32x2*)(P0 + (_n - 1) * NE_MAIN + h * 64 + ec * 4); l_kp = *(const u32x2*)(P0 + (_n - 1) * NE_MAIN + 512 + h * 64 + ec * 4); \
                l_vp = *(const unsigned*)(P0 + (_n - 1) * NE_MAIN + 1024 + h * 64 + rq * 32 + ec * 2); } } } while (0)
#define MIX2(wc, wp, mA, mB, o0, o1) { const float c0 = __uint_as_float((wc) << 16), c1 = __uint_as_float((wc) & 0xffff0000u), q0 = __uint_as_float((wp) << 16), q1 = __uint_as_float((wp) & 0xffff0000u); o0 = c0 + (q0 - c0) * (mA); o1 = c1 + (q1 - c1) * (mB); }
    RW_ISSUE(0);
    for (int t0 = 0; t0 < SEQ; t0 += TC) {
#pragma unroll 1
        for (int prep_rep = 0; prep_rep < PREP_REP; ++prep_rep) {
#pragma unroll
        for (int i = 0; i < 2; ++i) {
            const int tok = p1tok0 + i * 16, cc = p1cc;
            const u32x4 cu = l_cu[i], pv = l_pv[i];
            float x[8];
            MIX2(cu.x, pv.x, p1m0[0], p1m0[1], x[0], x[1]) MIX2(cu.y, pv.y, p1m0[2], p1m0[3], x[2], x[3]) MIX2(cu.z, pv.z, p1m1[0], p1m1[1], x[4], x[5]) MIX2(cu.w, pv.w, p1m1[2], p1m1[3], x[6], x[7])
            if (cc < 8) {
#pragma unroll
                for (int j = 0; j < 8; ++j) x[j] = fast_tanh(x[j]); }
            else if (cc >= 16) {
#pragma unroll
                for (int j = 0; j < 8; ++j) x[j] = fast_sigmoid(x[j]); }
            u32x4 o; o.x = cvt_pk_bf16(x[0], x[1]); o.y = cvt_pk_bf16(x[2], x[3]); o.z = cvt_pk_bf16(x[4], x[5]); o.w = cvt_pk_bf16(x[6], x[7]);
            if (cc < 8) *(LAS u32x4*)(tw_i + tok * 128 + ((cc ^ (tok & 7)) * 16)) = o;
            else if (cc < 16) *(LAS u32x4*)(xa_i + tok * 128 + (((cc - 8) ^ (tok & 7)) * 16)) = o;
            else *(LAS u32x4*)(sg_i + tok * 256 + (((cc - 16) ^ (tok & 7)) * 16)) = o;
        }
        __syncthreads();
        {
            f32x4 dw = fzero4(), da = fzero4();
            const int row = mrt * 16 + fr;
#pragma unroll
            for (int s = 0; s < 2; ++s) {
                const bf16x8 ta = *(const LAS bf16x8*)(tw_i + row * 128 + (((s * 4 + g) ^ (row & 7)) * 16));
                const bf16x8 xa = *(const LAS bf16x8*)(xa_i + row * 128 + (((s * 4 + g) ^ (row & 7)) * 16));
                dw = __builtin_amdgcn_mfma_f32_16x16x32_bf16(ta, wf[s], dw, 0, 0, 0);
                da = __builtin_amdgcn_mfma_f32_16x16x32_bf16(xa, af[s], da, 0, 0, 0);
            }
#pragma unroll
            for (int r = 0; r < 4; ++r) { wpre[(mrt * 16 + g * 4 + r) * 64 + mct * 16 + fr] = dw[r]; apre[(mrt * 16 + g * 4 + r) * 64 + mct * 16 + fr] = da[r]; }
            if (wid < 4) {
                f32x4 dg = fzero4();
                const int grow = grt * 16 + fr;
#pragma unroll
                for (int s = 0; s < 4; ++s) { const bf16x8 sa_ = *(const LAS bf16x8*)(sg_i + grow * 256 + (((s * 4 + g) ^ (grow & 7)) * 16));
                    dg = __builtin_amdgcn_mfma_f32_16x16x32_bf16(sa_, gf[s], dg, 0, 0, 0); }
#pragma unroll
                for (int r = 0; r < 4; ++r) gpre[(grt * 16 + g * 4 + r) * 32 + gct * 16 + fr] = dg[r];
            }
        }
        __syncthreads();
        {
            const size_t n = nb0 + t0 + et;
            float rr[4], kr_[4];
            MIX2(l_rc.x, l_rp.x, mur[0], mur[1], rr[0], rr[1]) MIX2(l_rc.y, l_rp.y, mur[2], mur[3], rr[2], rr[3])
            MIX2(l_kc.x, l_kp.x, muk[0], muk[1], kr_[0], kr_[1]) MIX2(l_kc.y, l_kp.y, muk[2], muk[3], kr_[2], kr_[3])
            const f32x4 wp = *(const LAS f32x4*)(wpre + et * 64 + ec * 4), ap = *(const LAS f32x4*)(apre + et * 64 + ec * 4);
            float dec[4], aa[4], kkp[4], nsq = 0.f;
#pragma unroll
            for (int j = 0; j < 4; ++j) { const float z = w0v[j] + wp[j]; const float sp = __logf(1.0f + __expf(-z));
                dec[j] = __expf(-__expf(-sp - 0.5f)); aa[j] = fast_sigmoid(a0v[j] + ap[j]); kkp[j] = kr_[j] * kksc[j]; nsq += kkp[j] * kkp[j]; }
            nsq = red16(nsq);
            const float inrm = 1.0f / fmaxf(sqrtf(nsq), 1e-12f);
            f32x4 kkv, bv, khv, wrv, wv; float br = 0.f, kr2 = 0.f, rk = 0.f;
#pragma unroll
            for (int j = 0; j < 4; ++j) { const float kk = kkp[j] * inrm; const float kh = kr_[j] * (1.0f + (aa[j] - 1.0f) * kasc[j]); const float bb = kk * aa[j];
                kkv[j] = kk; bv[j] = bb; khv[j] = kh; wv[j] = dec[j]; wrv[j] = dec[j] * rr[j]; br += bb * rr[j]; kr2 += kh * rr[j]; rk += rr[j] * kh * rkv[j]; }
            br = red16(br); kr2 = red16(kr2); rk = red16(rk);
            *(LAS f32x4*)(kk_s + et * 64 + ec * 4) = kkv; *(LAS f32x4*)(w_s + et * 64 + ec * 4) = wv; *(LAS f32x4*)(b_s + et * 64 + ec * 4) = bv;
            *(LAS f32x4*)(kh_s + et * 64 + ec * 4) = khv; *(LAS f32x4*)(wr_s + et * 64 + ec * 4) = wrv;
            if (ec == 0) { sc_s[et * 2] = br; sc_s[et * 2 + 1] = kr2; }
            float v0, v1; MIX2(l_vc, l_vp, muv[0], muv[1], v0, v1)
            *(LAS f32x2*)(v_s + et * 32 + ec * 2) = (f32x2){v0, v1};
            const f32x2 gp = *(const LAS f32x2*)(gpre + et * 32 + ec * 2);
            *(unsigned*)(e1g + n * 512 + h * 64 + rq * 32 + ec * 2) = cvt_pk_bf16(rk * v0, rk * v1);
            *(unsigned*)(gg + n * 512 + h * 64 + rq * 32 + ec * 2) = cvt_pk_bf16(gp[0], gp[1]);
        }
        if (prep_rep + 1 < PREP_REP) __syncthreads();
        }
        if (t0 + TC < SEQ) RW_ISSUE(t0 + TC);
        __syncthreads();
        {
            f32x4 kkA = *(const LAS f32x4*)(kk_s + kq * 4), wrA = *(const LAS f32x4*)(wr_s + kq * 4), wwA = *(const LAS f32x4*)(w_s + kq * 4), bbA = *(const LAS f32x4*)(b_s + kq * 4), khA = *(const LAS f32x4*)(kh_s + kq * 4);
            float vvA = v_s[rl]; f32x2 scA = *(const LAS f32x2*)(sc_s);
            float yacc = 0.f;
#pragma unroll 1
            for (int t = 0; t < TC; ++t) {
                const int tn = (t + 1) & (TC - 1);
                const f32x4 kkB = *(const LAS f32x4*)(kk_s + tn * 64 + kq * 4), wrB = *(const LAS f32x4*)(wr_s + tn * 64 + kq * 4), wwB = *(const LAS f32x4*)(w_s + tn * 64 + kq * 4);
                const f32x4 bbB = *(const LAS f32x4*)(b_s + tn * 64 + kq * 4), khB = *(const LAS f32x4*)(kh_s + tn * 64 + kq * 4);
                const float vvB = v_s[tn * 32 + rl]; const f32x2 scB = *(const LAS f32x2*)(sc_s + tn * 2);
                float sa = S[0] * kkA[0] + S[1] * kkA[1] + S[2] * kkA[2] + S[3] * kkA[3];
                float yy = S[0] * wrA[0] + S[1] * wrA[1] + S[2] * wrA[2] + S[3] * wrA[3];
                sa = red16(sa); yy = red16(yy);
                const float y = yy - sa * scA[0] + vvA * scA[1];
                yacc = (kq == (t & 15)) ? y : yacc;
#pragma unroll
                for (int i = 0; i < 4; ++i) S[i] = S[i] * wwA[i] + (vvA * khA[i] - sa * bbA[i]);
                if ((t & 15) == 15) y_s[((t & 16) + kq) * 32 + rl] = yacc;
                kkA = kkB; wrA = wrB; wwA = wwB; bbA = bbB; khA = khB; vvA = vvB; scA = scB;
            }
        }
        __syncthreads();
        { const int tok = tid >> 4, c2 = (tid & 15) * 2; *(f32x2*)(yraw + (nb0 + t0 + tok) * 512 + h * 64 + rq * 32 + c2) = *(const LAS f32x2*)(y_s + tok * 32 + c2); }
    }
#undef MIX2
#undef RW_ISSUE
}

constexpr size_t OFF_ACT256 = OFF_U + 4 * MiB;
__device__ __forceinline__ void phase_lora_act(const Params& p, int bid, int nb) {
    const int tid = opaque_tid();
    const bf16_t* P0 = (const bf16_t*)(p.ws + OFF_P); bf16_t* act = (bf16_t*)(p.ws + OFF_ACT256);
    const float* mu = p.in[I_AMU];
    const int cc = tid & 31, col = 1536 + cc * 8;
    const f32x4 m0 = *(const f32x4*)(mu + col), m1 = *(const f32x4*)(mu + col + 4);
    for (int n = bid * 16 + (tid >> 5); n < NTOK; n += nb * 16) {
        const u32x4 cu = *(const u32x4*)(P0 + (size_t)n * NE_MAIN + col); u32x4 pv = uzero4(); if ((n & (SEQ - 1)) > 0) pv = *(const u32x4*)(P0 + (size_t)(n - 1) * NE_MAIN + col);
        const unsigned cw[4] = {cu.x, cu.y, cu.z, cu.w}, pw[4] = {pv.x, pv.y, pv.z, pv.w}; float x[8];
#pragma unroll
        for (int j = 0; j < 4; ++j) { const float c0 = __uint_as_float(cw[j] << 16), c1 = __uint_as_float(cw[j] & 0xffff0000u), q0 = __uint_as_float(pw[j] << 16), q1 = __uint_as_float(pw[j] & 0xffff0000u);
            const float ma = (j < 2 ? m0[2 * j] : m1[2 * j - 4]), mb = (j < 2 ? m0[2 * j + 1] : m1[2 * j - 3]);
            x[2 * j] = c0 + (q0 - c0) * ma; x[2 * j + 1] = c1 + (q1 - c1) * mb; }
        if (cc < 8) {
#pragma unroll
            for (int j = 0; j < 8; ++j) x[j] = fast_tanh(x[j]); }
        else if (cc >= 16) {
#pragma unroll
            for (int j = 0; j < 8; ++j) x[j] = fast_sigmoid(x[j]); }
        u32x4 o; o.x = cvt_pk_bf16(x[0], x[1]); o.y = cvt_pk_bf16(x[2], x[3]); o.z = cvt_pk_bf16(x[4], x[5]); o.w = cvt_pk_bf16(x[6], x[7]);
        *(u32x4*)(act + (size_t)n * 256 + cc * 8) = o;
    }
}

template <int CTRL> __device__ __forceinline__ float dpp0f(float v) { return __builtin_bit_cast(float, __builtin_amdgcn_update_dpp(0, __builtin_bit_cast(int, v), CTRL, 0xf, 0xf, true)); }
__device__ __forceinline__ bf16x8 pack_lo4(const f32x4 a) { u32x4 w; w.x = cvt_pk_bf16(a[0], a[1]); w.y = cvt_pk_bf16(a[2], a[3]); w.z = 0u; w.w = 0u; return __builtin_bit_cast(bf16x8, w); }
__device__ __forceinline__ bf16x8 pack_8(const f32x4 a, const f32x4 b) { u32x4 w; w.x = cvt_pk_bf16(a[0], a[1]); w.y = cvt_pk_bf16(a[2], a[3]); w.z = cvt_pk_bf16(b[0], b[1]); w.w = cvt_pk_bf16(b[2], b[3]); return __builtin_bit_cast(bf16x8, w); }
__device__ __forceinline__ f32x4 mm16(const f32x4 PT, const f32x4 Q) { return __builtin_amdgcn_mfma_f32_16x16x32_bf16(pack_lo4(PT), pack_lo4(Q), fzero4(), 0, 0, 0); }
constexpr int RW3_SLOT = 12544;
__device__ __forceinline__ int rw3_trswz(int row, int c) { return (((c >> 1) ^ ((row >> 1) & 3)) << 1) | (c & 1); }
__device__ __forceinline__ void rwkv3_item(const Params& p, LAS unsigned char* lds, int item) {
    const int tid = opaque_tid(), lane = tid & 63, wid = tid >> 6, fr = lane & 15, g = lane >> 4;
    const int b = item >> 3, h = item & 7;
    unsigned char* ws = p.ws;
    const bf16_t* P0 = (const bf16_t*)(ws + OFF_P);
    float* yraw = p.out; bf16_t* e1g = (bf16_t*)(p.out + (size_t)NTOK * 512); bf16_t* gg = e1g + (size_t)NTOK * 512;
    LAS unsigned char* w2h = lds;
    LAS unsigned char* a2h = lds + 8192;
    LAS unsigned char* g2h = lds + 16384;
    LAS unsigned char* slots = lds + 32768;
    LAS float* ptab = (LAS float*)(lds + 32768 + 8 * RW3_SLOT);
    LAS float* mul = ptab + 8 * 64;
    {
        const float* mu = p.in[I_AMU];
        if (tid < 64) { ptab[tid] = mu[h * 64 + tid]; ptab[64 + tid] = mu[512 + h * 64 + tid]; ptab[128 + tid] = mu[1024 + h * 64 + tid];
            ptab[192 + tid] = p.in[I_AW0][h * 64 + tid]; ptab[256 + tid] = p.in[I_AA0][h * 64 + tid]; ptab[320 + tid] = p.in[I_AKK][h * 64 + tid];
            ptab[384 + tid] = p.in[I_AKA][h * 64 + tid]; ptab[448 + tid] = p.in[I_ARK][h * 64 + tid]; }
        if (tid < 256) mul[tid] = mu[1536 + tid];
    }
    {
        const bf16_t* w2t = (const bf16_t*)(ws + OFF_MISC + MISC_W2T); const bf16_t* a2t = (const bf16_t*)(ws + OFF_MISC + MISC_A2T); const bf16_t* g2t = (const bf16_t*)(ws + OFF_MISC + MISC_G2T);
        { const int row = tid >> 3, c = tid & 7;
            *(LAS u32x4*)(w2h + row * 128 + ((c ^ (row & 7)) * 16)) = *(const u32x4*)(w2t + (size_t)(h * 64 + row) * 64 + c * 8);
            *(LAS u32x4*)(a2h + row * 128 + ((c ^ (row & 7)) * 16)) = *(const u32x4*)(a2t + (size_t)(h * 64 + row) * 64 + c * 8); }
#pragma unroll
        for (int i = 0; i < 2; ++i) { const int q = tid + i * 512, row = q >> 4, c = q & 15;
            *(LAS u32x4*)(g2h + row * 256 + ((c ^ (row & 7)) * 16)) = *(const u32x4*)(g2t + (size_t)(h * 64 + row) * 128 + c * 8); }
    }
    __syncthreads();
    f32x4 Hacc[4];
#pragma unroll
    for (int rt = 0; rt < 4; ++rt) Hacc[rt] = fzero4();
    const size_t nb0 = (size_t)b * SEQ;
    const int q4 = fr >> 2, p4 = fr & 3;
#define MIXB(wc, wp, mA, mB, o0, o1) { const float c0 = __uint_as_float((wc) << 16), c1 = __uint_as_float((wc) & 0xffff0000u), q0 = __uint_as_float((wp) << 16), q1 = __uint_as_float((wp) & 0xffff0000u); o0 = c0 + (q0 - c0) * (mA); o1 = c1 + (q1 - c1) * (mB); }
    const bf16_t* actp = (const bf16_t*)(ws + OFF_ACT256);
    u32x2 nrc[4], nkc[4], nvc[4], nrp[4], nkp[4], nvp[4]; bf16x8 nb_[8];
#define RW3_LOADS(tk) do { const int t0_ = ((tk) * 8 + wid) * 16; const int fr_ = lane & 15, g_ = lane >> 4; const size_t n_ = nb0 + t0_ + fr_; const bool hp_ = (t0_ + fr_) > 0; \
        const bf16_t* rc_ = P0 + n_ * NE_MAIN; const bf16_t* rp_ = rc_ - NE_MAIN; \
        _Pragma("unroll") for (int ct = 0; ct < 4; ++ct) { const int c0 = ct * 16 + g_ * 4; \
            nrc[ct] = *(const u32x2*)(rc_ + h * 64 + c0); nkc[ct] = *(const u32x2*)(rc_ + 512 + h * 64 + c0); nvc[ct] = *(const u32x2*)(rc_ + 1024 + h * 64 + c0); \
            nrp[ct] = (u32x2){0u, 0u}; nkp[ct] = nrp[ct]; nvp[ct] = nrp[ct]; \
            if (hp_) { nrp[ct] = *(const u32x2*)(rp_ + h * 64 + c0); nkp[ct] = *(const u32x2*)(rp_ + 512 + h * 64 + c0); nvp[ct] = *(const u32x2*)(rp_ + 1024 + h * 64 + c0); } } \
        _Pragma("unroll") for (int f = 0; f < 8; ++f) nb_[f] = *(const bf16x8*)(actp + n_ * 256 + f * 32 + g_ * 8); } while (0)
#pragma unroll 1
    for (int tick = 0; tick < SEQ / 128; ++tick) {
        {
            int lane_t = lane; asm volatile("" : "+v"(lane_t));
            const int fr = lane_t & 15, g = lane_t >> 4, q4 = fr >> 2, p4 = fr & 3;
            LAS unsigned char* sl = slots + wid * RW3_SLOT;
            LAS unsigned char* Qt_i = sl, * Rh_i = sl + 2048, * Kh_i = sl + 4096, * Bn_i = sl + 6144, * Vi_i = sl + 8192, * M1_i = sl + 10240, * DD_i = sl + 11264; LAS float* gam_i = (LAS float*)(sl + 12288);
            const int t0 = (tick * 8 + wid) * 16;
            const size_t n = nb0 + t0 + fr;
            const bool hasp = (t0 + fr) > 0;
            const bf16_t* rowc = P0 + n * NE_MAIN; const bf16_t* rowp = rowc - NE_MAIN;
            RW3_LOADS(tick);
#define lrc nrc
#define lkc nkc
#define lvc nvc
#define lrp nrp
#define lkp nkp
#define lvp nvp
            bf16x8 bw[2], ba[2], bg[4];
            bw[0] = nb_[0]; bw[1] = nb_[1]; ba[0] = nb_[2]; ba[1] = nb_[3]; bg[0] = nb_[4]; bg[1] = nb_[5]; bg[2] = nb_[6]; bg[3] = nb_[7];
            f32x4 Wt[4], At[4], Gt[4];
#pragma unroll
            for (int ct = 0; ct < 4; ++ct) {
                const int row = ct * 16 + fr;
                f32x4 dw = fzero4(), da = dw, dg = dw;
#pragma unroll
                for (int s = 0; s < 2; ++s) {
                    dw = __builtin_amdgcn_mfma_f32_16x16x32_bf16(*(const LAS bf16x8*)(w2h + row * 128 + (((s * 4 + g) ^ (row & 7)) * 16)), bw[s], dw, 0, 0, 0);
                    da = __builtin_amdgcn_mfma_f32_16x16x32_bf16(*(const LAS bf16x8*)(a2h + row * 128 + (((s * 4 + g) ^ (row & 7)) * 16)), ba[s], da, 0, 0, 0); }
#pragma unroll
                for (int s = 0; s < 4; ++s) dg = __builtin_amdgcn_mfma_f32_16x16x32_bf16(*(const LAS bf16x8*)(g2h + row * 256 + (((s * 4 + g) ^ (row & 7)) * 16)), bg[s], dg, 0, 0, 0);
                Wt[ct] = dw; At[ct] = da; Gt[ct] = dg;
            }
            f32x4 Rm[4], Khm[4], Lw[4], Aa[4];
            float nsq = 0.f, rk = 0.f;
            u32x2 Vp[4];
#pragma unroll
            for (int ct = 0; ct < 4; ++ct) {
                const int c0 = ct * 16 + g * 4;
                const u32x2 rc = lrc[ct], kc = lkc[ct], vc = lvc[ct], rp = lrp[ct], kp = lkp[ct], vp = lvp[ct];
                const f32x4 mr = *(const LAS f32x4*)(ptab + c0), mk = *(const LAS f32x4*)(ptab + 64 + c0), mv = *(const LAS f32x4*)(ptab + 128 + c0);
                f32x4 Km, Vm;
                MIXB(rc.x, rp.x, mr[0], mr[1], Rm[ct][0], Rm[ct][1]) MIXB(rc.y, rp.y, mr[2], mr[3], Rm[ct][2], Rm[ct][3])
                MIXB(kc.x, kp.x, mk[0], mk[1], Km[0], Km[1]) MIXB(kc.y, kp.y, mk[2], mk[3], Km[2], Km[3])
                MIXB(vc.x, vp.x, mv[0], mv[1], Vm[0], Vm[1]) MIXB(vc.y, vp.y, mv[2], mv[3], Vm[2], Vm[3])
                const f32x4 w0v = *(const LAS f32x4*)(ptab + 192 + c0), a0v = *(const LAS f32x4*)(ptab + 256 + c0), kks = *(const LAS f32x4*)(ptab + 320 + c0), kas = *(const LAS f32x4*)(ptab + 384 + c0), rkp = *(const LAS f32x4*)(ptab + 448 + c0);
#pragma unroll
                for (int r = 0; r < 4; ++r) { const float z = w0v[r] + Wt[ct][r]; const float sp = __logf(1.0f + __expf(-z));
                    Lw[ct][r] = -__expf(-sp - 0.5f);
                    const float a = fast_sigmoid(a0v[r] + At[ct][r]); Aa[ct][r] = a;
                    const float kkp = Km[r] * kks[r]; nsq += kkp * kkp; Wt[ct][r] = kkp;
                    const float kh = Km[r] * (1.0f + (a - 1.0f) * kas[r]); Khm[ct][r] = kh; rk += Rm[ct][r] * kh * rkp[r]; }
                Vp[ct].x = cvt_pk_bf16(Vm[0], Vm[1]); Vp[ct].y = cvt_pk_bf16(Vm[2], Vm[3]);
                At[ct] = Vm;
            }
            nsq += __shfl_xor(nsq, 16); nsq += __shfl_xor(nsq, 32);
            rk += __shfl_xor(rk, 16); rk += __shfl_xor(rk, 32);
            const float inrm = 1.0f / fmaxf(sqrtf(nsq), 1e-12f);
#pragma unroll
            for (int ct = 0; ct < 4; ++ct) { const int c0 = ct * 16 + g * 4;
                u32x2 ew, gw; ew.x = cvt_pk_bf16(rk * At[ct][0], rk * At[ct][1]); ew.y = cvt_pk_bf16(rk * At[ct][2], rk * At[ct][3]);
                gw.x = cvt_pk_bf16(Gt[ct][0], Gt[ct][1]); gw.y = cvt_pk_bf16(Gt[ct][2], Gt[ct][3]);
                *(u32x2*)(e1g + n * 512 + h * 64 + c0) = ew; *(u32x2*)(gg + n * 512 + h * 64 + c0) = gw;
                const int c = 2 * ct + (g >> 1);
                *(LAS u32x2*)(Vi_i + fr * 128 + rw3_trswz(fr, c) * 16 + (g & 1) * 8) = Vp[ct]; }
            u32x2 Qp[4], Kp[4], Bp[4], Rp[4];
#pragma unroll
            for (int ct = 0; ct < 4; ++ct) {
                const int c0 = ct * 16 + g * 4;
                f32x4 gmv; float qh[4], kh_[4], bh[4], rh[4];
#pragma unroll
                for (int r = 0; r < 4; ++r) {
                    float L = Lw[ct][r];
                    L += dpp0f<0x111>(L); L += dpp0f<0x112>(L); L += dpp0f<0x114>(L); L += dpp0f<0x118>(L);
                    const float Ltot = red16(Lw[ct][r]);
                    const float eL = __expf(L), ieL = fast_rcp(eL), eLex = __expf(L - Lw[ct][r]);
                    const float kk = Wt[ct][r] * inrm, bb = kk * Aa[ct][r];
                    qh[r] = kk * eLex; kh_[r] = Khm[ct][r] * ieL; bh[r] = bb * ieL; rh[r] = Rm[ct][r] * eL;
                    gmv[r] = __expf(Ltot); }
                Qp[ct].x = cvt_pk_bf16(qh[0], qh[1]); Qp[ct].y = cvt_pk_bf16(qh[2], qh[3]); Kp[ct].x = cvt_pk_bf16(kh_[0], kh_[1]); Kp[ct].y = cvt_pk_bf16(kh_[2], kh_[3]);
                Bp[ct].x = cvt_pk_bf16(bh[0], bh[1]); Bp[ct].y = cvt_pk_bf16(bh[2], bh[3]); Rp[ct].x = cvt_pk_bf16(rh[0], rh[1]); Rp[ct].y = cvt_pk_bf16(rh[2], rh[3]);
                if (fr == 0) *(LAS f32x4*)(gam_i + c0) = gmv;
            }
            bf16x8 Qf[2], Kf[2], Bf[2], Rf[2];
#pragma unroll
            for (int s = 0; s < 2; ++s) { Qf[s] = __builtin_bit_cast(bf16x8, (u32x4){Qp[2 * s].x, Qp[2 * s].y, Qp[2 * s + 1].x, Qp[2 * s + 1].y}); Kf[s] = __builtin_bit_cast(bf16x8, (u32x4){Kp[2 * s].x, Kp[2 * s].y, Kp[2 * s + 1].x, Kp[2 * s + 1].y});
                Bf[s] = __builtin_bit_cast(bf16x8, (u32x4){Bp[2 * s].x, Bp[2 * s].y, Bp[2 * s + 1].x, Bp[2 * s + 1].y}); Rf[s] = __builtin_bit_cast(bf16x8, (u32x4){Rp[2 * s].x, Rp[2 * s].y, Rp[2 * s + 1].x, Rp[2 * s + 1].y}); }
            f32x4 Ab = fzero4(), AbT = Ab, Ak = Ab, DkT = Ab, DbT = Ab;
#pragma unroll
            for (int s = 0; s < 2; ++s) {
                Ab = __builtin_amdgcn_mfma_f32_16x16x32_bf16(Qf[s], Bf[s], Ab, 0, 0, 0);
                AbT = __builtin_amdgcn_mfma_f32_16x16x32_bf16(Bf[s], Qf[s], AbT, 0, 0, 0);
                Ak = __builtin_amdgcn_mfma_f32_16x16x32_bf16(Qf[s], Kf[s], Ak, 0, 0, 0);
                DkT = __builtin_amdgcn_mfma_f32_16x16x32_bf16(Kf[s], Rf[s], DkT, 0, 0, 0);
                DbT = __builtin_amdgcn_mfma_f32_16x16x32_bf16(Bf[s], Rf[s], DbT, 0, 0, 0); }
            f32x4 N, NT, ident;
#pragma unroll
            for (int r = 0; r < 4; ++r) { const int row = 4 * g + r;
                N[r] = (fr < row) ? -Ab[r] : 0.f; Ak[r] = (fr < row) ? Ak[r] : 0.f;
                NT[r] = (row < fr) ? -AbT[r] : 0.f;
                DkT[r] = (row <= fr) ? DkT[r] : 0.f; DbT[r] = (row <= fr) ? -DbT[r] : 0.f;
                ident[r] = (row == fr) ? 1.f : 0.f; }
            const f32x4 N2 = mm16(NT, N), N2T = mm16(N, NT);
            const f32x4 N4 = mm16(N2T, N2), N4T = mm16(N2, N2T);
            const f32x4 N8T = mm16(N4, N4T);
            const f32x4 X1 = N + ident, X1T = NT + ident, X2 = N2 + ident, X2T = N2T + ident, X4 = N4 + ident, X8T = N8T + ident;
            const f32x4 U12 = mm16(X1T, X2), U12T = mm16(X1, X2T), U34T = mm16(X4, X8T);
            const f32x4 TT = mm16(U12, U34T);
            const f32x4 M1T = mm16(Ak, TT);
#pragma unroll
            for (int ct = 0; ct < 4; ++ct) { const int c = 2 * ct + (g >> 1);
                *(LAS u32x2*)(Qt_i + fr * 128 + rw3_trswz(fr, c) * 16 + (g & 1) * 8) = Qp[ct]; }
            s16x4 qtr[4];
#pragma unroll
            for (int ct = 0; ct < 4; ++ct) { const int row = 4 * g + q4, c = 2 * ct + (p4 >> 1);
                qtr[ct] = __builtin_amdgcn_ds_read_tr16_b64_v4i16((LAS s16x4*)(Qt_i + row * 128 + rw3_trswz(row, c) * 16 + (p4 & 1) * 8)); }
            const bf16x8 TTf = pack_lo4(TT);
            f32x4 Qt[4];
#pragma unroll
            for (int ct = 0; ct < 4; ++ct) { const bf16x8 af = (bf16x8){qtr[ct][0], qtr[ct][1], qtr[ct][2], qtr[ct][3], 0, 0, 0, 0};
                Qt[ct] = __builtin_amdgcn_mfma_f32_16x16x32_bf16(af, TTf, fzero4(), 0, 0, 0); }
#pragma unroll
            for (int ct = 0; ct < 4; ++ct) {
                const int s = ct >> 1, hh = ct & 1;
                u32x2 w; w.x = cvt_pk_bf16(Qt[ct][0], Qt[ct][1]); w.y = cvt_pk_bf16(Qt[ct][2], Qt[ct][3]);
                *(LAS u32x2*)(Qt_i + fr * 128 + (((s * 4 + g) ^ (fr & 7)) * 16) + hh * 8) = w;
                *(LAS u32x2*)(Rh_i + fr * 128 + (((s * 4 + g) ^ (fr & 7)) * 16) + hh * 8) = Rp[ct];
                const int c = 2 * ct + (g >> 1);
                *(LAS u32x2*)(Kh_i + fr * 128 + rw3_trswz(fr, c) * 16 + (g & 1) * 8) = Kp[ct];
                *(LAS u32x2*)(Bn_i + fr * 128 + rw3_trswz(fr, c) * 16 + (g & 1) * 8) = (u32x2){Bp[ct].x ^ 0x80008000u, Bp[ct].y ^ 0x80008000u}; }
            { const int cs = (g ^ ((fr >> 2) & 3)) * 16;
                u32x2 w; w.x = cvt_pk_bf16(M1T[0], M1T[1]); w.y = cvt_pk_bf16(M1T[2], M1T[3]);
                *(LAS u32x2*)(M1_i + fr * 64 + cs) = (u32x2){0u, 0u}; *(LAS u32x2*)(M1_i + fr * 64 + cs + 8) = w;
                w.x = cvt_pk_bf16(DbT[0], DbT[1]); w.y = cvt_pk_bf16(DbT[2], DbT[3]); *(LAS u32x2*)(DD_i + fr * 64 + cs) = w;
                w.x = cvt_pk_bf16(DkT[0], DkT[1]); w.y = cvt_pk_bf16(DkT[2], DkT[3]); *(LAS u32x2*)(DD_i + fr * 64 + cs + 8) = w; }
        }
        __syncthreads();
        if (wid < 4) {
#pragma unroll 1
            for (int j = 0; j < 8; ++j) {
                int lane_t = lane; asm volatile("" : "+v"(lane_t));
                const int fr = lane_t & 15, g = lane_t >> 4, q4 = fr >> 2, p4 = fr & 3;
                LAS unsigned char* sl = slots + j * RW3_SLOT;
                LAS unsigned char* Qt_i = sl, * Rh_i = sl + 2048, * Kh_i = sl + 4096, * Bn_i = sl + 6144, * Vi_i = sl + 8192, * M1_i = sl + 10240, * DD_i = sl + 11264; LAS const float* gam_i = (LAS const float*)(sl + 12288);
                const bf16x8 Hb0 = pack_8(Hacc[0], Hacc[1]), Hb1 = pack_8(Hacc[2], Hacc[3]);
                const int trow = 4 * g + q4;
                const s16x4 vv = __builtin_amdgcn_ds_read_tr16_b64_v4i16((LAS s16x4*)(Vi_i + trow * 128 + rw3_trswz(trow, 2 * wid + (p4 >> 1)) * 16 + (p4 & 1) * 8));
                const bf16x8 q0 = *(const LAS bf16x8*)(Qt_i + fr * 128 + (((0 + g) ^ (fr & 7)) * 16)), q1 = *(const LAS bf16x8*)(Qt_i + fr * 128 + (((4 + g) ^ (fr & 7)) * 16));
                const bf16x8 r0 = *(const LAS bf16x8*)(Rh_i + fr * 128 + (((0 + g) ^ (fr & 7)) * 16)), r1 = *(const LAS bf16x8*)(Rh_i + fr * 128 + (((4 + g) ^ (fr & 7)) * 16));
                const int cs = (g ^ ((fr >> 2) & 3)) * 16;
                const bf16x8 m1 = *(const LAS bf16x8*)(M1_i + fr * 64 + cs), dd = *(const LAS bf16x8*)(DD_i + fr * 64 + cs);
                const bf16x8 v0 = (bf16x8){0, 0, 0, 0, vv[0], vv[1], vv[2], vv[3]};
                f32x4 Z = fzero4();
                Z = __builtin_amdgcn_mfma_f32_16x16x32_bf16(q0, Hb0, Z, 0, 0, 0); Z = __builtin_amdgcn_mfma_f32_16x16x32_bf16(q1, Hb1, Z, 0, 0, 0); Z = __builtin_amdgcn_mfma_f32_16x16x32_bf16(m1, v0, Z, 0, 0, 0);
                u32x2 zw; zw.x = cvt_pk_bf16(Z[0], Z[1]); zw.y = cvt_pk_bf16(Z[2], Z[3]);
                const s16x4 zs = __builtin_bit_cast(s16x4, zw);
                const bf16x8 zv = (bf16x8){zs[0], zs[1], zs[2], zs[3], vv[0], vv[1], vv[2], vv[3]};
                f32x4 Y = fzero4();
                Y = __builtin_amdgcn_mfma_f32_16x16x32_bf16(r0, Hb0, Y, 0, 0, 0); Y = __builtin_amdgcn_mfma_f32_16x16x32_bf16(r1, Hb1, Y, 0, 0, 0); Y = __builtin_amdgcn_mfma_f32_16x16x32_bf16(dd, zv, Y, 0, 0, 0);
                const size_t nrow = nb0 + (size_t)(tick * 8 + j) * 16 + 4 * g;
#pragma unroll
                for (int r = 0; r < 4; ++r) yraw[(nrow + r) * 512 + h * 64 + wid * 16 + fr] = Y[r];
#pragma unroll
                for (int rt = 0; rt < 4; ++rt) { const int c = 2 * rt + (p4 >> 1);
                    const s16x4 bn = __builtin_amdgcn_ds_read_tr16_b64_v4i16((LAS s16x4*)(Bn_i + trow * 128 + rw3_trswz(trow, c) * 16 + (p4 & 1) * 8));
                    const s16x4 kh = __builtin_amdgcn_ds_read_tr16_b64_v4i16((LAS s16x4*)(Kh_i + trow * 128 + rw3_trswz(trow, c) * 16 + (p4 & 1) * 8));
                    const bf16x8 af = (bf16x8){bn[0], bn[1], bn[2], bn[3], kh[0], kh[1], kh[2], kh[3]};
                    Hacc[rt] = __builtin_amdgcn_mfma_f32_16x16x32_bf16(af, zv, Hacc[rt], 0, 0, 0);
                    Hacc[rt] = Hacc[rt] * *(const LAS f32x4*)(gam_i + rt * 16 + g * 4); }
            }
        }
        __syncthreads();
    }
#undef MIXB
#undef RW3_LOADS
#undef lrc
#undef lkc
#undef lvc
#undef lrp
#undef lkp
#undef lvp
}

__device__ __forceinline__ void phase_rwkv_epi(const Params& p, int bid, int nb) {
    const int tid = opaque_tid(), wid = tid >> 6, lane = tid & 63;
    const float* yraw = p.out; const bf16_t* e1g = (const bf16_t*)(p.out + (size_t)NTOK * 512); const bf16_t* gg = e1g + (size_t)NTOK * 512;
    bf16_t* mix = (bf16_t*)(p.ws + OFF_BUF64);
    const f32x4 g0 = *(const f32x4*)(p.in[I_AGNG] + lane * 8), g1 = *(const f32x4*)(p.in[I_AGNG] + lane * 8 + 4), b0 = *(const f32x4*)(p.in[I_AGNB] + lane * 8), b1 = *(const f32x4*)(p.in[I_AGNB] + lane * 8 + 4);
    for (int n = bid * 8 + wid; n < NTOK; n += nb * 8) {
        const f32x4 y0 = *(const f32x4*)(yraw + (size_t)n * 512 + lane * 8), y1 = *(const f32x4*)(yraw + (size_t)n * 512 + lane * 8 + 4);
        const u32x4 ev = *(const u32x4*)(e1g + (size_t)n * 512 + lane * 8), gv = *(const u32x4*)(gg + (size_t)n * 512 + lane * 8);
#if SANITIZE
        f32x4 y0s = y0, y1s = y1;
#pragma unroll
        for (int j = 0; j < 4; ++j) { if (!(fabsf(y0s[j]) < 1e30f)) y0s[j] = 0.f; if (!(fabsf(y1s[j]) < 1e30f)) y1s[j] = 0.f; }
#define y0 y0s
#define y1 y1s
#endif
        float s = (y0[0] + y0[1]) + (y0[2] + y0[3]) + (y1[0] + y1[1]) + (y1[2] + y1[3]);
        s = red8(s); const float mean = s * (1.0f / 64.0f);
        const f32x4 d0 = y0 - mean, d1 = y1 - mean;
        float q = (d0[0] * d0[0] + d0[1] * d0[1]) + (d0[2] * d0[2] + d0[3] * d0[3]) + (d1[0] * d1[0] + d1[1] * d1[1]) + (d1[2] * d1[2] + d1[3] * d1[3]);
        q = red8(q); const float rs = rsqrtf(q * (1.0f / 64.0f) + 64e-5f);
        float o[8];
        const unsigned ew[4] = {ev.x, ev.y, ev.z, ev.w}, gw[4] = {gv.x, gv.y, gv.z, gv.w};
#pragma unroll
        for (int j = 0; j < 4; ++j) { const float ya = (j < 2 ? d0[2 * j] : d1[2 * j - 4]), yb = (j < 2 ? d0[2 * j + 1] : d1[2 * j - 3]);
            const float ga = (j < 2 ? g0[2 * j] : g1[2 * j - 4]), gb_ = (j < 2 ? g0[2 * j + 1] : g1[2 * j - 3]); const float ba = (j < 2 ? b0[2 * j] : b1[2 * j - 4]), bb_ = (j < 2 ? b0[2 * j + 1] : b1[2 * j - 3]);
            o[2 * j] = (ya * rs * ga + ba + __uint_as_float(ew[j] << 16)) * __uint_as_float(gw[j] << 16);
            o[2 * j + 1] = (yb * rs * gb_ + bb_ + __uint_as_float(ew[j] & 0xffff0000u)) * __uint_as_float(gw[j] & 0xffff0000u); }
        u32x4 w; w.x = cvt_pk_bf16(o[0], o[1]); w.y = cvt_pk_bf16(o[2], o[3]); w.z = cvt_pk_bf16(o[4], o[5]); w.w = cvt_pk_bf16(o[6], o[7]);
#if SANITIZE
#undef y0
#undef y1
#pragma unroll
        for (int j = 0; j < 8; ++j) if (!(fabsf(o[j]) < 1e30f)) o[j] = 0.f;
        w.x = cvt_pk_bf16(o[0], o[1]); w.y = cvt_pk_bf16(o[2], o[3]); w.z = cvt_pk_bf16(o[4], o[5]); w.w = cvt_pk_bf16(o[6], o[7]);
#endif
        *(u32x4*)(mix + (size_t)n * DM + lane * 8) = w;
    }
}

__device__ __forceinline__ int gla_fT(int row) { return ((row >> 1) & 1) | (((row >> 3) & 1) << 1); }
__device__ __forceinline__ int gla_hV(int row) { return (row & 3) | (((row >> 3) & 1) << 2); }
__device__ __forceinline__ void gla2_item(const Params& p, LAS unsigned char* lds, int item) {
    const int tid = opaque_tid(), lane = tid & 63, wid = tid >> 6, fr = lane & 15, g = lane >> 4;
    const int b = item >> 2, h = item & 3;
    const bf16_t* P0 = (const bf16_t*)(p.ws + OFF_P) + 1792;
    const float* xa16 = (const float*)(p.ws + OFF_U);
    bf16_t* mix = (bf16_t*)(p.ws + OFF_BUF64);
    LAS float* bcf = (LAS float*)lds;
    LAS float* tot = bcf + 64 * 64;
    LAS float* bls = tot + 8 * 64;
    LAS float* pn = bls + 64;
    LAS float* xs = pn + 64 * 8;
    LAS unsigned char* qd_i = (LAS unsigned char*)(xs + 2 * 1024);
    LAS unsigned char* ki_a = qd_i + 8192;
    LAS unsigned char* ki_t = ki_a + 8192;
    LAS unsigned char* att_i = ki_t + 8192;
    LAS unsigned char* v_i = att_i + 8192;
    for (int i = tid; i < 8192 / 16; i += 512) *(LAS u32x4*)(att_i + i * 16) = uzero4();
    float gw2[16];
#pragma unroll
    for (int i = 0; i < 16; ++i) gw2[i] = p.in[I_BGW2][i * 256 + h * 64 + lane];
    const float gb = p.in[I_BGB][h * 64 + lane];
    const f32x4 ngv = *(const f32x4*)(p.in[I_BNG] + h * 128 + wid * 16 + g * 4);
    f32x4 Sacc[4];
#pragma unroll
    for (int rt = 0; rt < 4; ++rt) Sacc[rt] = fzero4();
    const int q4 = fr >> 2, p4 = fr & 3;
    const int tok = tid >> 3, dc = tid & 7;
    u32x4 nq, nk, nv0, nv1; u32x2 ngate[4]; f32x4 nxa = fzero4();
#define GLA_ISSUE(c0n) do { const size_t _n = (size_t)b * SEQ + (c0n) + tok; \
        nq = *(const u32x4*)(P0 + _n * NE_MAIN + h * 64 + dc * 8); nk = *(const u32x4*)(P0 + _n * NE_MAIN + 256 + h * 64 + dc * 8); \
        nv0 = *(const u32x4*)(P0 + _n * NE_MAIN + 512 + h * 128 + dc * 16); nv1 = *(const u32x4*)(P0 + _n * NE_MAIN + 512 + h * 128 + dc * 16 + 8); \
        _Pragma("unroll") for (int _ct = 0; _ct < 4; ++_ct) ngate[_ct] = *(const u32x2*)(P0 + ((size_t)b * SEQ + (c0n) + _ct * 16 + fr) * NE_MAIN + 1024 + h * 128 + wid * 16 + g * 4); \
        if (tid < 256) nxa = *(const f32x4*)(xa16 + ((size_t)b * SEQ + (c0n)) * 16 + tid * 4); } while (0)
    GLA_ISSUE(0);
    if (tid < 256) *(LAS f32x4*)(xs + tid * 4) = nxa;
    __syncthreads();
    for (int c0 = 0; c0 < SEQ; c0 += 64) {
        const size_t n0 = (size_t)b * SEQ + c0;
        LAS const float* xsc = xs + ((c0 >> 6) & 1) * 1024;
        { float run = 0.f;
#pragma unroll
            for (int tt = 0; tt < 8; ++tt) { const int c = wid * 8 + tt; float z = gb;
#pragma unroll
                for (int i4 = 0; i4 < 4; ++i4) { const f32x4 xv = *(const LAS f32x4*)(xsc + c * 16 + i4 * 4); z += xv[0] * gw2[i4 * 4] + xv[1] * gw2[i4 * 4 + 1] + xv[2] * gw2[i4 * 4 + 2] + xv[3] * gw2[i4 * 4 + 3]; }
                const float ls = fminf(z, 0.f) - __logf(1.0f + __expf(-fabsf(z)));
                run += ls * (1.0f / 16.0f); bcf[c * 64 + lane] = run; }
            tot[wid * 64 + lane] = run; }
        __syncthreads();
        { float off = 0.f;
            for (int w2 = 0; w2 < wid; ++w2) off += tot[w2 * 64 + lane];
#pragma unroll
            for (int tt = 0; tt < 8; ++tt) bcf[(wid * 8 + tt) * 64 + lane] += off;
            if (wid == 7) bls[lane] = __expf(bcf[63 * 64 + lane]); }
        __syncthreads();
        u32x2 gate[4];
        { const f32x4 bc0 = *(const LAS f32x4*)(bcf + tok * 64 + dc * 8), bc1 = *(const LAS f32x4*)(bcf + tok * 64 + dc * 8 + 4);
            const unsigned qw[4] = {nq.x, nq.y, nq.z, nq.w}, kw[4] = {nk.x, nk.y, nk.z, nk.w};
            float qo[8], ko[8];
#pragma unroll
            for (int j = 0; j < 4; ++j) { const float ba = (j < 2 ? bc0[2 * j] : bc1[2 * j - 4]), bb = (j < 2 ? bc0[2 * j + 1] : bc1[2 * j - 3]);
                const float ea = __expf(ba), eb = __expf(bb), ia = fast_rcp(ea), ib = fast_rcp(eb);
                qo[2 * j] = __uint_as_float(qw[j] << 16) * 0.125f * ea; qo[2 * j + 1] = __uint_as_float(qw[j] & 0xffff0000u) * 0.125f * eb;
                ko[2 * j] = __uint_as_float(kw[j] << 16) * ia; ko[2 * j + 1] = __uint_as_float(kw[j] & 0xffff0000u) * ib; }
            u32x4 qp, kp; qp.x = cvt_pk_bf16(qo[0], qo[1]); qp.y = cvt_pk_bf16(qo[2], qo[3]); qp.z = cvt_pk_bf16(qo[4], qo[5]); qp.w = cvt_pk_bf16(qo[6], qo[7]);
            kp.x = cvt_pk_bf16(ko[0], ko[1]); kp.y = cvt_pk_bf16(ko[2], ko[3]); kp.z = cvt_pk_bf16(ko[4], ko[5]); kp.w = cvt_pk_bf16(ko[6], ko[7]);
            *(LAS u32x4*)(qd_i + tok * 128 + ((dc ^ (tok & 7)) * 16)) = qp;
            *(LAS u32x4*)(ki_a + tok * 128 + ((dc ^ (tok & 7)) * 16)) = kp;
            *(LAS u32x4*)(ki_t + tok * 128 + (((((dc >> 1) ^ gla_fT(tok)) << 1) | (dc & 1)) * 16)) = kp;
            { const int pr = dc ^ gla_hV(tok); *(LAS u32x4*)(v_i + tok * 256 + (pr * 2) * 16) = nv0; *(LAS u32x4*)(v_i + tok * 256 + (pr * 2 + 1) * 16) = nv1; }
#pragma unroll
            for (int ct = 0; ct < 4; ++ct) gate[ct] = ngate[ct]; }
        if (c0 + 64 < SEQ) GLA_ISSUE(c0 + 64);
        __syncthreads();
        for (int ti = wid; ti < 10; ti += 8) {
            int st, ct; { const int tb[10] = {0x00, 0x01, 0x02, 0x03, 0x11, 0x12, 0x13, 0x22, 0x23, 0x33}; int code = 0;
#pragma unroll
                for (int k = 0; k < 10; ++k) if (k == ti) code = tb[k];
                st = code >> 4; ct = code & 15; }
            f32x4 d = fzero4();
            const int rs_ = st * 16 + fr, rc_ = ct * 16 + fr;
#pragma unroll
            for (int s = 0; s < 2; ++s) {
                const bf16x8 a = *(const LAS bf16x8*)(ki_a + rs_ * 128 + (((s * 4 + g) ^ (rs_ & 7)) * 16));
                const bf16x8 bq = *(const LAS bf16x8*)(qd_i + rc_ * 128 + (((s * 4 + g) ^ (rc_ & 7)) * 16));
                d = __builtin_amdgcn_mfma_f32_16x16x32_bf16(a, bq, d, 0, 0, 0); }
            const int c = ct * 16 + fr; float o4[4];
#pragma unroll
            for (int r = 0; r < 4; ++r) { const int s_ = st * 16 + g * 4 + r; o4[r] = (s_ <= c) ? d[r] : 0.f; }
            u32x2 w; w.x = cvt_pk_bf16(o4[0], o4[1]); w.y = cvt_pk_bf16(o4[2], o4[3]);
            *(LAS u32x2*)(att_i + c * 128 + (((2 * st + (g >> 1)) ^ (c & 7)) * 16) + (g & 1) * 8) = w;
        }
        __syncthreads();
        {
            bf16x8 vf[2];
#pragma unroll
            for (int s = 0; s < 2; ++s) {
                const int r1 = s * 32 + g * 8 + q4, r2 = r1 + 4; const int c = 2 * wid + (p4 >> 1);
                const s16x4 lo = __builtin_amdgcn_ds_read_tr16_b64_v4i16((LAS s16x4*)(v_i + r1 * 256 + (((((c >> 1) ^ gla_hV(r1)) << 1) | (c & 1)) * 16) + (p4 & 1) * 8));
                const s16x4 hi = __builtin_amdgcn_ds_read_tr16_b64_v4i16((LAS s16x4*)(v_i + r2 * 256 + (((((c >> 1) ^ gla_hV(r2)) << 1) | (c & 1)) * 16) + (p4 & 1) * 8));
                vf[s] = (bf16x8){lo[0], lo[1], lo[2], lo[3], hi[0], hi[1], hi[2], hi[3]}; }
            bf16x8 sf[2];
#pragma unroll
            for (int s = 0; s < 2; ++s) sf[s] = pack_8g(Sacc[2 * s], Sacc[2 * s + 1]);
            f32x4 oacc[4];
#pragma unroll
            for (int ct = 0; ct < 4; ++ct) {
                const int c = ct * 16 + fr; f32x4 d = fzero4();
#pragma unroll
                for (int s = 0; s < 2; ++s) {
                    const bf16x8 ab = *(const LAS bf16x8*)(att_i + c * 128 + (((s * 4 + g) ^ (c & 7)) * 16));
                    d = __builtin_amdgcn_mfma_f32_16x16x32_bf16(vf[s], ab, d, 0, 0, 0);
                    const s16x4 q0 = *(const LAS s16x4*)(qd_i + c * 128 + (((s * 4 + (g >> 1)) ^ (c & 7)) * 16) + (g & 1) * 8);
                    const s16x4 q1 = *(const LAS s16x4*)(qd_i + c * 128 + (((s * 4 + 2 + (g >> 1)) ^ (c & 7)) * 16) + (g & 1) * 8);
                    const bf16x8 qb = (bf16x8){q0[0], q0[1], q0[2], q0[3], q1[0], q1[1], q1[2], q1[3]};
                    d = __builtin_amdgcn_mfma_f32_16x16x32_bf16(sf[s], qb, d, 0, 0, 0); }
                oacc[ct] = d; }
#pragma unroll
            for (int rt = 0; rt < 4; ++rt) {
#pragma unroll
                for (int s = 0; s < 2; ++s) {
                    const int r1 = s * 32 + g * 8 + q4, r2 = r1 + 4; const int c = 2 * rt + (p4 >> 1);
                    const s16x4 lo = __builtin_amdgcn_ds_read_tr16_b64_v4i16((LAS s16x4*)(ki_t + r1 * 128 + (((((c >> 1) ^ gla_fT(r1)) << 1) | (c & 1)) * 16) + (p4 & 1) * 8));
                    const s16x4 hi = __builtin_amdgcn_ds_read_tr16_b64_v4i16((LAS s16x4*)(ki_t + r2 * 128 + (((((c >> 1) ^ gla_fT(r2)) << 1) | (c & 1)) * 16) + (p4 & 1) * 8));
                    const bf16x8 kf = (bf16x8){lo[0], lo[1], lo[2], lo[3], hi[0], hi[1], hi[2], hi[3]};
                    Sacc[rt] = __builtin_amdgcn_mfma_f32_16x16x32_bf16(kf, vf[s], Sacc[rt], 0, 0, 0); }
                const f32x4 eb = *(const LAS f32x4*)(bls + rt * 16 + g * 4);
                Sacc[rt] = Sacc[rt] * eb; }
#pragma unroll
            for (int ct = 0; ct < 4; ++ct) { float ss = oacc[ct][0] * oacc[ct][0] + oacc[ct][1] * oacc[ct][1] + oacc[ct][2] * oacc[ct][2] + oacc[ct][3] * oacc[ct][3];
                ss += __shfl_xor(ss, 16); ss += __shfl_xor(ss, 32);
                if (g == 0) pn[(ct * 16 + fr) * 8 + wid] = ss; }
            if (tid < 256 && c0 + 64 < SEQ) *(LAS f32x4*)(xs + (((c0 >> 6) + 1) & 1) * 1024 + tid * 4) = nxa;
            __syncthreads();
#pragma unroll
            for (int ct = 0; ct < 4; ++ct) { const int c = ct * 16 + fr;
                const f32x4 a0 = *(const LAS f32x4*)(pn + c * 8), a1 = *(const LAS f32x4*)(pn + c * 8 + 4);
                const float ss = (a0[0] + a0[1]) + (a0[2] + a0[3]) + (a1[0] + a1[1]) + (a1[2] + a1[3]);
                const float rs = rsqrtf(ss * (1.0f / 128.0f) + 1e-5f);
                const u32x2 gv = gate[ct];
                const float g0 = __uint_as_float(gv.x << 16), g1 = __uint_as_float(gv.x & 0xffff0000u), g2 = __uint_as_float(gv.y << 16), g3 = __uint_as_float(gv.y & 0xffff0000u);
                const float v0 = oacc[ct][0] * rs * ngv[0] * (g0 * fast_sigmoid(g0)), v1 = oacc[ct][1] * rs * ngv[1] * (g1 * fast_sigmoid(g1));
                const float v2 = oacc[ct][2] * rs * ngv[2] * (g2 * fast_sigmoid(g2)), v3 = oacc[ct][3] * rs * ngv[3] * (g3 * fast_sigmoid(g3));
                u32x2 w; w.x = cvt_pk_bf16(v0, v1); w.y = cvt_pk_bf16(v2, v3);
                *(u32x2*)(mix + (n0 + c) * DM + 512 + h * 128 + wid * 16 + g * 4) = w; }
        }
    }
#undef GLA_ISSUE
}

__device__ __forceinline__ void phase_mixer_even(const Params& p, LAS unsigned char* lds, int bid, int nb, int which) {
    for (int item = bid; item < 96; item += nb) {
        if (which != 2 && item < 64) rwkv3_item(p, lds, item); else if (which != 1 && item >= 64) gla2_item(p, lds, item - 64);
        __syncthreads();
    }
}

__device__ __forceinline__ void phase_rope(const Params& p, int bid, int nb) {
    const int tid = opaque_tid(), wid = tid >> 6, lane = tid & 63;
    unsigned char* ws = p.ws;
    const bf16_t* Pd = (const bf16_t*)(ws + OFF_PD);
    bf16_t* qr = (bf16_t*)(ws + OFF_BUF64); bf16_t* kr = (bf16_t*)(ws + OFF_KR); bf16_t* vv = (bf16_t*)(ws + OFF_VV);
    bf16_t* iqr = (bf16_t*)(ws + OFF_IQR); bf16_t* ikr = (bf16_t*)(ws + OFF_IKR); float* iw = (float*)(ws + OFF_IW);
    const float* c64 = (const float*)(ws + OFF_ROPE); const float* s64 = c64 + 4096 * 64; const float* c32 = s64 + 4096 * 64; const float* s32 = c32 + 4096 * 32;
    const float ikg = p.in[I_CIKG][lane], ikb = p.in[I_CIKB][lane];
    for (int n = bid * 8 + wid; n < NTOK; n += nb * 8) {
        const int pos = n & (SEQ - 1);
        const bf16_t* row = Pd + (size_t)n * NO_MAIN;
#define ROPE8(off1, off2, cs, sn, scale, dst, d1, d2) do { \
            const u32x4 a_ = *(const u32x4*)(row + (off1)), b_ = *(const u32x4*)(row + (off2)); \
            const f32x4 c0_ = *(const f32x4*)(cs), c1_ = *(const f32x4*)((cs) + 4), s0_ = *(const f32x4*)(sn), s1_ = *(const f32x4*)((sn) + 4); \
            const unsigned aw_[4] = {a_.x, a_.y, a_.z, a_.w}, bw_[4] = {b_.x, b_.y, b_.z, b_.w}; float o1_[8], o2_[8]; \
            _Pragma("unroll") for (int j_ = 0; j_ < 4; ++j_) { \
                const float z1a = __uint_as_float(aw_[j_] << 16), z1b = __uint_as_float(aw_[j_] & 0xffff0000u), z2a = __uint_as_float(bw_[j_] << 16), z2b = __uint_as_float(bw_[j_] & 0xffff0000u); \
                const float ca = (j_ < 2 ? c0_[2 * j_] : c1_[2 * j_ - 4]), cb = (j_ < 2 ? c0_[2 * j_ + 1] : c1_[2 * j_ - 3]), sa = (j_ < 2 ? s0_[2 * j_] : s1_[2 * j_ - 4]), sb = (j_ < 2 ? s0_[2 * j_ + 1] : s1_[2 * j_ - 3]); \
                o1_[2 * j_] = (z1a * ca - z2a * sa) * (scale); o1_[2 * j_ + 1] = (z1b * cb - z2b * sb) * (scale); o2_[2 * j_] = (z2a * ca + z1a * sa) * (scale); o2_[2 * j_ + 1] = (z2b * cb + z1b * sb) * (scale); } \
            u32x4 w1_, w2_; w1_.x = cvt_pk_bf16(o1_[0], o1_[1]); w1_.y = cvt_pk_bf16(o1_[2], o1_[3]); w1_.z = cvt_pk_bf16(o1_[4], o1_[5]); w1_.w = cvt_pk_bf16(o1_[6], o1_[7]); \
            w2_.x = cvt_pk_bf16(o2_[0], o2_[1]); w2_.y = cvt_pk_bf16(o2_[2], o2_[3]); w2_.z = cvt_pk_bf16(o2_[4], o2_[5]); w2_.w = cvt_pk_bf16(o2_[6], o2_[7]); \
            *(u32x4*)((dst) + (d1)) = w1_; *(u32x4*)((dst) + (d2)) = w2_; } while (0)
        { const int h = lane >> 3, jb = (lane & 7) * 8;
            ROPE8(h * 128 + jb, h * 128 + 64 + jb, c64 + pos * 64 + jb, s64 + pos * 64 + jb, 0.08838834764831845f, qr + (size_t)n * 1024, h * 128 + jb, h * 128 + 64 + jb); }
        if (lane < 8) { const int jb = lane * 8;
            ROPE8(1024 + jb, 1024 + 64 + jb, c64 + pos * 64 + jb, s64 + pos * 64 + jb, 1.0f, kr + (size_t)n * 128, jb, 64 + jb); }
        else if (lane < 24) { const int c = (lane - 8) * 8;
            *(u32x4*)(vv + (size_t)n * 128 + c) = *(const u32x4*)(row + 1152 + c); }
        else if (lane < 40) { const int h = (lane - 24) >> 2, jb = ((lane - 24) & 3) * 8;
            ROPE8(1280 + h * 64 + jb, 1280 + h * 64 + 32 + jb, c32 + pos * 32 + jb, s32 + pos * 32 + jb, 0.125f, iqr + (size_t)n * 256, h * 64 + jb, h * 64 + 32 + jb); }
#undef ROPE8
        const int j32 = lane & 31; const float cc = c32[pos * 32 + j32], ss = s32[pos * 32 + j32];
        { const float x = bf2f(row[1536 + lane]); const float mean = wave_sum(x) * (1.0f / 64.0f); const float d = x - mean; const float var = wave_sum(d * d) * (1.0f / 64.0f);
            const float y = d * rsqrtf(var + LN_EPS) * ikg + ikb; const float o = __shfl_xor(y, 32);
            const float res = lane < 32 ? (y * cc - o * ss) : (y * cc + o * ss);
            ikr[(size_t)n * 64 + lane] = f2bf(res); }
        if (lane < 4) iw[(size_t)n * 4 + lane] = bf2f(row[1600 + lane]) * 0.5f;
    }
}

__device__ __forceinline__ void phase_index(const Params& p, LAS unsigned char* lds, int bid, int nb) {
    const int tid = opaque_tid(), wid = tid >> 6, lane = tid & 63;
    unsigned char* ws = p.ws;
    const bf16_t* iqr = (const bf16_t*)(ws + OFF_IQR); const bf16_t* ikr = (const bf16_t*)(ws + OFF_IKR); const float* iw = (const float*)(ws + OFF_IW);
    unsigned short* idx = (unsigned short*)(ws + OFF_IDX);
    LAS unsigned* sc = (LAS unsigned*)lds + wid * 4096;
    LAS int* hist = (LAS int*)(lds + 131072) + wid * 256;
    LAS float* iqs = (LAS float*)(lds + 131072 + 8192) + wid * 256;
    const unsigned long long lt_mask = (1ull << lane) - 1ull;
    for (int n = bid * 8 + wid; n < NTOK; n += nb * 8) {
        const int t = n & (SEQ - 1), b = n >> 12, nv = t + 1;
        unsigned short* out = idx + (size_t)n * 256;
        if (nv <= 256) { for (int j = lane; j < 256; j += 64) out[j] = (unsigned short)(j < nv ? j : 0); continue; }
#pragma unroll
        for (int j = 0; j < 4; ++j) iqs[lane * 4 + j] = bf2f(iqr[(size_t)n * 256 + lane * 4 + j]);
        const float w0 = iw[(size_t)n * 4 + 0], w1 = iw[(size_t)n * 4 + 1], w2 = iw[(size_t)n * 4 + 2], w3 = iw[(size_t)n * 4 + 3];
        const int nvp = (nv + 63) & ~63;
        for (int c0 = 0; c0 < nvp; c0 += 64) {
            const int key = c0 + lane; const bool valid = key < nv;
            float kf[64];
            const u32x4* kp = (const u32x4*)(ikr + ((size_t)b * SEQ + (valid ? key : 0)) * 64);
#pragma unroll
            for (int q = 0; q < 8; ++q) { const u32x4 w = kp[q];
                kf[q * 8 + 0] = __uint_as_float(w.x << 16); kf[q * 8 + 1] = __uint_as_float(w.x & 0xffff0000u); kf[q * 8 + 2] = __uint_as_float(w.y << 16); kf[q * 8 + 3] = __uint_as_float(w.y & 0xffff0000u);
                kf[q * 8 + 4] = __uint_as_float(w.z << 16); kf[q * 8 + 5] = __uint_as_float(w.z & 0xffff0000u); kf[q * 8 + 6] = __uint_as_float(w.w << 16); kf[q * 8 + 7] = __uint_as_float(w.w & 0xffff0000u); }
            float sh[4];
#pragma unroll
            for (int h = 0; h < 4; ++h) { float a = 0.f;
#pragma unroll
                for (int d4 = 0; d4 < 16; ++d4) { const f32x4 qv = *(const LAS f32x4*)(iqs + h * 64 + d4 * 4); a += qv[0] * kf[d4 * 4] + qv[1] * kf[d4 * 4 + 1] + qv[2] * kf[d4 * 4 + 2] + qv[3] * kf[d4 * 4 + 3]; }
                sh[h] = fmaxf(a, 0.f); }
            float score = sh[0] * w0 + sh[1] * w1 + sh[2] * w2 + sh[3] * w3;
            score += 0.0f;
            unsigned u = __float_as_uint(score); u = (u & 0x80000000u) ? ~u : (u | 0x80000000u);
            sc[key] = valid ? u : 0u;
        }
        unsigned prefix = 0; int need = 256;
#pragma unroll 1
        for (int pass = 3; pass >= 0; --pass) {
            const int shift = pass * 8;
#pragma unroll
            for (int j = 0; j < 4; ++j) hist[lane * 4 + j] = 0;
            for (int c0 = 0; c0 < nvp; c0 += 64) { const unsigned u = sc[c0 + lane];
                const bool match = (c0 + lane < nv) && (pass == 3 || (u >> (shift + 8)) == prefix);
                if (match) __hip_atomic_fetch_add(hist + ((u >> shift) & 255u), 1, __ATOMIC_RELAXED, __HIP_MEMORY_SCOPE_WORKGROUP); }
            int hb[4];
#pragma unroll
            for (int j = 0; j < 4; ++j) hb[j] = hist[lane * 4 + j];
            const int tot = hb[0] + hb[1] + hb[2] + hb[3];
            int suf = tot;
#pragma unroll
            for (int off = 1; off < 64; off <<= 1) { const int v = __shfl_down(suf, off); if (lane + off < 64) suf += v; }
            const int above = suf - tot;
            const bool is = (above < need) && (need <= suf);
            int bin = 0, nneed = 0;
            if (is) { int c = above;
#pragma unroll
                for (int k = 3; k >= 0; --k) { if (nneed == 0) { if (need <= c + hb[k]) { bin = lane * 4 + k; nneed = need - c; } else c += hb[k]; } } }
            const unsigned long long bal = __ballot(is);
            const int src = __ffsll((long long)bal) - 1;
            bin = __shfl(bin, src); nneed = __shfl(nneed, src);
            prefix = (prefix << 8) | (unsigned)bin; need = nneed;
        }
        const unsigned T = prefix;
        int base = 0, ties = 0;
        for (int c0 = 0; c0 < nvp; c0 += 64) { const int key = c0 + lane; const unsigned u = sc[key]; const bool valid = key < nv;
            const bool gt = valid && u > T, eq = valid && u == T;
            const unsigned long long beq = __ballot(eq);
            const int rank = ties + __popcll(beq & lt_mask);
            const bool take = gt || (eq && rank < need);
            const unsigned long long bt = __ballot(take);
            const int pos = base + __popcll(bt & lt_mask);
            if (take && pos < 256) out[pos] = (unsigned short)key;
            base += __popcll(bt); ties += __popcll(beq); }
    }
}

__device__ __forceinline__ void phase_attn(const Params& p, LAS unsigned char* lds, int bid, int nb) {
    const int tid = opaque_tid(), wid = tid >> 6, lane = tid & 63;
    unsigned char* ws = p.ws;
    const bf16_t* qr = (const bf16_t*)(ws + OFF_BUF64); const bf16_t* kr = (const bf16_t*)(ws + OFF_KR); const bf16_t* vv = (const bf16_t*)(ws + OFF_VV);
    const unsigned short* idx = (const unsigned short*)(ws + OFF_IDX);
    bf16_t* ao = (bf16_t*)(ws + OFF_PD);
    LAS float* qs = (LAS float*)lds + wid * 1024;
    LAS float* ps = (LAS float*)(lds + 32768) + wid * 2048;
    LAS int* ks = (LAS int*)(lds + 32768 + 65536) + wid * 256;
    for (int n = bid * 8 + wid; n < NTOK; n += nb * 8) {
        const int t = n & (SEQ - 1), b = n >> 12, cnt = (t + 1) < 256 ? (t + 1) : 256;
        asm volatile("" ::: "memory");
#pragma unroll
        for (int j = 0; j < 16; ++j) qs[j * 64 + lane] = bf2f(qr[(size_t)n * 1024 + j * 64 + lane]);
#pragma unroll
        for (int r = 0; r < 4; ++r) ks[r * 64 + lane] = idx[(size_t)n * 256 + r * 64 + lane];
#pragma unroll 1
        for (int r = 0; r < 4; ++r) {
            const int j = r * 64 + lane; const bool valid = j < cnt; const int key = valid ? ks[j] : 0;
            const u32x4* kp = (const u32x4*)(kr + ((size_t)b * SEQ + key) * 128);
            float kf[128];
#pragma unroll
            for (int q = 0; q < 16; ++q) { const u32x4 w = kp[q];
                kf[q * 8 + 0] = __uint_as_float(w.x << 16); kf[q * 8 + 1] = __uint_as_float(w.x & 0xffff0000u); kf[q * 8 + 2] = __uint_as_float(w.y << 16); kf[q * 8 + 3] = __uint_as_float(w.y & 0xffff0000u);
                kf[q * 8 + 4] = __uint_as_float(w.z << 16); kf[q * 8 + 5] = __uint_as_float(w.z & 0xffff0000u); kf[q * 8 + 6] = __uint_as_float(w.w << 16); kf[q * 8 + 7] = __uint_as_float(w.w & 0xffff0000u); }
#pragma unroll 1
            for (int h = 0; h < 8; ++h) { float a = 0.f;
#pragma unroll
                for (int d4 = 0; d4 < 32; ++d4) { const f32x4 qv = *(const LAS f32x4*)(qs + h * 128 + d4 * 4);
                    a += qv[0] * kf[d4 * 4] + qv[1] * kf[d4 * 4 + 1] + qv[2] * kf[d4 * 4 + 2] + qv[3] * kf[d4 * 4 + 3]; }
                ps[h * 256 + j] = valid ? a : -INFINITY; }
        }
#pragma unroll
        for (int h = 0; h < 8; ++h) { float x[4]; float m = -INFINITY;
#pragma unroll
            for (int r = 0; r < 4; ++r) { x[r] = ps[h * 256 + r * 64 + lane]; m = fmaxf(m, x[r]); }
#pragma unroll
            for (int o = 32; o > 0; o >>= 1) m = fmaxf(m, __shfl_xor(m, o));
            float s = 0.f;
#pragma unroll
            for (int r = 0; r < 4; ++r) { x[r] = expf(x[r] - m); s += x[r]; }
            s = wave_sum(s); const float inv = 1.0f / s;
#pragma unroll
            for (int r = 0; r < 4; ++r) ps[h * 256 + r * 64 + lane] = x[r] * inv; }
        float o0[8], o1[8];
#pragma unroll
        for (int h = 0; h < 8; ++h) { o0[h] = 0.f; o1[h] = 0.f; }
        for (int j = 0; j < cnt; ++j) { const int key = ks[j];
            const unsigned w = *(const unsigned*)(vv + ((size_t)b * SEQ + key) * 128 + 2 * lane);
            const float v0 = __uint_as_float(w << 16), v1 = __uint_as_float(w & 0xffff0000u);
#pragma unroll
            for (int h = 0; h < 8; ++h) { const float pj = ps[h * 256 + j]; o0[h] += pj * v0; o1[h] += pj * v1; } }
#pragma unroll
        for (int h = 0; h < 8; ++h) *(unsigned*)(ao + (size_t)n * 1024 + h * 128 + 2 * lane) = cvt_pk_bf16(o0[h], o1[h]);
    }
}

__device__ __forceinline__ void attn_query(const bf16_t* qr, const bf16_t* kr, const bf16_t* vv, bf16_t* ao, int n, LAS const unsigned short* ks, LAS unsigned char* vbuf, int lane) {
    const int fr = lane & 15, g = lane >> 4, q4 = fr >> 2, p4 = fr & 3;
    const int t = n & (SEQ - 1), b = n >> 12, cnt = (t + 1) < 256 ? (t + 1) : 256;
    {
        bf16x8 qf[4];
#pragma unroll
        for (int s = 0; s < 4; ++s) { qf[s] = (bf16x8){0, 0, 0, 0, 0, 0, 0, 0}; if (fr < 8) qf[s] = *(const bf16x8*)(qr + (size_t)n * 1024 + fr * 128 + s * 32 + g * 8); }
        const bf16_t* kbase = kr + (size_t)b * SEQ * 128; const bf16_t* vbase = vv + (size_t)b * SEQ * 128;
        f32x4 acc[16];
        bf16x8 kf[3][2][4];
#define ATT_KLOAD(buf, grp) do { _Pragma("unroll") for (int t2 = 0; t2 < 2; ++t2) { const int j_ = ((grp) * 2 + t2) * 16 + fr; const int key_ = j_ < cnt ? (int)ks[j_] : 0; \
            const bf16_t* kp_ = kbase + (size_t)key_ * 128 + g * 8; _Pragma("unroll") for (int s = 0; s < 4; ++s) kf[buf][t2][s] = *(const bf16x8*)(kp_ + s * 32); } } while (0)
        ATT_KLOAD(0, 0); ATT_KLOAD(1, 1);
#pragma unroll
        for (int grp = 0; grp < 8; ++grp) {
            if (grp + 2 < 8) ATT_KLOAD((grp + 2) % 3, grp + 2);
#pragma unroll
            for (int t2 = 0; t2 < 2; ++t2) { f32x4 a = fzero4();
#pragma unroll
                for (int s = 0; s < 4; ++s) a = __builtin_amdgcn_mfma_f32_16x16x32_bf16(kf[grp % 3][t2][s], qf[s], a, 0, 0, 0);
                acc[grp * 2 + t2] = a; }
        }
#undef ATT_KLOAD
        u32x4 vr[2][8];
#define ATT_VLOAD(buf, s) do { _Pragma("unroll") for (int i = 0; i < 8; ++i) { const int kl_ = i * 4 + g; const int jj_ = (s) * 32 + kl_; const int key_ = jj_ < cnt ? (int)ks[jj_] : 0; \
            const int c_ = fr ^ ((kl_ & 7) << 1); vr[buf][i] = *(const u32x4*)(vbase + (size_t)key_ * 128 + c_ * 8); } } while (0)
        ATT_VLOAD(0, 0);
        float m = -INFINITY;
#pragma unroll
        for (int tl = 0; tl < 16; ++tl)
#pragma unroll
            for (int r = 0; r < 4; ++r) { if (tl * 16 + g * 4 + r >= cnt) acc[tl][r] = -INFINITY; m = fmaxf(m, acc[tl][r]); }
        m = fmaxf(m, __shfl_xor(m, 16)); m = fmaxf(m, __shfl_xor(m, 32));
        float sum = 0.f;
#pragma unroll
        for (int tl = 0; tl < 16; ++tl)
#pragma unroll
            for (int r = 0; r < 4; ++r) { const float e_ = __expf(acc[tl][r] - m); acc[tl][r] = e_; sum += e_; }
        sum += __shfl_xor(sum, 16); sum += __shfl_xor(sum, 32);
        const float inv = 1.0f / sum;
        bf16x8 pf[8];
#pragma unroll
        for (int s = 0; s < 8; ++s) pf[s] = pack_8g(acc[2 * s], acc[2 * s + 1]);
        f32x4 o[8];
#pragma unroll
        for (int dt = 0; dt < 8; ++dt) o[dt] = fzero4();
#pragma unroll
        for (int s = 0; s < 8; ++s) {
            LAS unsigned char* vb = vbuf + (s & 1) * 8192;
            if (s + 1 < 8) ATT_VLOAD((s + 1) & 1, s + 1);
#pragma unroll
            for (int i = 0; i < 8; ++i) { const int kl = i * 4 + g; *(LAS u32x4*)(vb + kl * 256 + fr * 16) = vr[s & 1][i]; }
            const int kl1 = 4 * g + q4, kl2 = 16 + 4 * g + q4;
#pragma unroll
            for (int dt = 0; dt < 8; ++dt) {
                const int c = 2 * dt + (p4 >> 1);
                const s16x4 lo = __builtin_amdgcn_ds_read_tr16_b64_v4i16((LAS s16x4*)(vb + kl1 * 256 + ((c ^ ((kl1 & 7) << 1)) * 16) + (p4 & 1) * 8));
                const s16x4 hi = __builtin_amdgcn_ds_read_tr16_b64_v4i16((LAS s16x4*)(vb + kl2 * 256 + ((c ^ ((kl2 & 7) << 1)) * 16) + (p4 & 1) * 8));
                const bf16x8 af = (bf16x8){lo[0], lo[1], lo[2], lo[3], hi[0], hi[1], hi[2], hi[3]};
                o[dt] = __builtin_amdgcn_mfma_f32_16x16x32_bf16(af, pf[s], o[dt], 0, 0, 0);
            }
        }
#undef ATT_VLOAD
        if (fr < 8) {
#pragma unroll
            for (int dt = 0; dt < 8; ++dt) { u32x2 w; w.x = cvt_pk_bf16(o[dt][0] * inv, o[dt][1] * inv); w.y = cvt_pk_bf16(o[dt][2] * inv, o[dt][3] * inv);
                *(u32x2*)(ao + (size_t)n * 1024 + fr * 128 + dt * 16 + g * 4) = w; }
        }
    }
}

__device__ __forceinline__ int idx_bin(float s, float lo, float scale) { int b = (int)((s - lo) * scale); b = b < 0 ? 0 : b; return b > 255 ? 255 : b; }
__device__ __forceinline__ unsigned ord_key(float s) { const unsigned u = __float_as_uint(s); return (u & 0x80000000u) ? ~u : (u | 0x80000000u); }
__device__ __forceinline__ float ord_val(unsigned k) { return __uint_as_float((k & 0x80000000u) ? (k & 0x7fffffffu) : ~k); }
__device__ __forceinline__ void phase_index2(const Params& p, LAS unsigned char* lds, int bid, int nb) {
    const int tid = opaque_tid(), wid = __builtin_amdgcn_readfirstlane(tid >> 6), lane0 = tid & 63;
    unsigned char* ws = p.ws;
    const bf16_t* iqr = (const bf16_t*)(ws + OFF_IQR); const bf16_t* ikr = (const bf16_t*)(ws + OFF_IKR); const float* iw = (const float*)(ws + OFF_IW);
    const bf16_t* qr = (const bf16_t*)(ws + OFF_BUF64); const bf16_t* kr = (const bf16_t*)(ws + OFF_KR); const bf16_t* vv = (const bf16_t*)(ws + OFF_VV); bf16_t* ao = (bf16_t*)(ws + OFF_PD);
    LAS unsigned short* out = (LAS unsigned short*)(lds + 131072 + 24576) + wid * 256;
    LAS float* sc = (LAS float*)lds;
    LAS int* hist = (LAS int*)(lds + 131072) + wid * 256;
    LAS float* candv = (LAS float*)(lds + 131072 + 8192) + wid * 264;
    LAS unsigned short* candi = (LAS unsigned short*)(lds + 131072 + 8192 + 8 * 264 * 4) + wid * 256;
    LAS unsigned* mm = (LAS unsigned*)(lds + 131072 + 8192 + 8 * 264 * 4 + 8 * 512);
    const int ntile = NTOK / 8;
    PROBE_DECL;
    PROBE_BEGIN(9);
    for (int it = bid; it < ntile; it += nb) {
        const int round = it / nb, qt = (round & 1) ? (round * nb + (nb - 1 - (it - round * nb))) : it;
        const int n0 = qt * 8, t0 = n0 & (SEQ - 1), b = n0 >> 12;
        int lane = lane0; asm volatile("" : "+v"(lane));
        const int fr = lane & 15, g = lane >> 4; const unsigned long long lt_mask = (1ull << lane) - 1ull;
        asm volatile("" ::: "memory");
        if (tid < 16) mm[tid] = (tid & 1) ? 0u : 0xffffffffu;
        __syncthreads();
        PROBE_BEGIN(1);
#pragma unroll 1
        for (int genrep = 0; genrep < (IDXPROBE == 1 ? 2 : 1); ++genrep)
        if (t0 + 8 > 256) {
            bf16x8 af[2][2];
#pragma unroll
            for (int hh = 0; hh < 2; ++hh)
#pragma unroll
                for (int s = 0; s < 2; ++s) af[hh][s] = *(const bf16x8*)(iqr + (size_t)(n0 + 2 * (fr >> 2) + ((fr >> 1) & 1)) * 256 + (2 * hh + (fr & 1)) * 64 + s * 32 + g * 8);
            const f32x4 wq0 = *(const f32x4*)(iw + (size_t)(n0 + 2 * g) * 4), wq1 = *(const f32x4*)(iw + (size_t)(n0 + 2 * g + 1) * 4);
            float vmin0 = INFINITY, vmax0 = -INFINITY, vmin1 = INFINITY, vmax1 = -INFINITY;
            const int nkt = (t0 + 8 + 15) >> 4;
            const bf16_t* kb = ikr + (size_t)b * SEQ * 64;
            bf16x8 pb0[3], pb1[3];
#pragma unroll
            for (int i = 0; i < 2; ++i) { const int ktp = wid + 8 * i < nkt ? wid + 8 * i : wid; const bf16_t* kp = kb + (size_t)(ktp * 16 + fr) * 64 + g * 8; pb0[i] = *(const bf16x8*)kp; pb1[i] = *(const bf16x8*)(kp + 32); }
            for (int kt = wid; kt < nkt; kt += 8) {
                { const int ktp = kt + 16 < nkt ? kt + 16 : kt; const bf16_t* kp = kb + (size_t)(ktp * 16 + fr) * 64 + g * 8; pb0[2] = *(const bf16x8*)kp; pb1[2] = *(const bf16x8*)(kp + 32); }
                const bf16x8 b0 = pb0[0], b1 = pb1[0];
                pb0[0] = pb0[1]; pb1[0] = pb1[1]; pb0[1] = pb0[2]; pb1[1] = pb1[2];
                f32x4 d0 = fzero4(), d1 = fzero4();
                d0 = __builtin_amdgcn_mfma_f32_16x16x32_bf16(af[0][0], b0, d0, 0, 0, 0); d0 = __builtin_amdgcn_mfma_f32_16x16x32_bf16(af[0][1], b1, d0, 0, 0, 0);
                d1 = __builtin_amdgcn_mfma_f32_16x16x32_bf16(af[1][0], b0, d1, 0, 0, 0); d1 = __builtin_amdgcn_mfma_f32_16x16x32_bf16(af[1][1], b1, d1, 0, 0, 0);
                float s0 = fmaxf(d0[0], 0.f) * wq0[0] + fmaxf(d0[1], 0.f) * wq0[1] + fmaxf(d1[0], 0.f) * wq0[2] + fmaxf(d1[1], 0.f) * wq0[3];
                float s1 = fmaxf(d0[2], 0.f) * wq1[0] + fmaxf(d0[3], 0.f) * wq1[1] + fmaxf(d1[2], 0.f) * wq1[2] + fmaxf(d1[3], 0.f) * wq1[3];
                s0 += 0.0f; s1 += 0.0f;
                vmin0 = fminf(vmin0, s0); vmax0 = fmaxf(vmax0, s0); vmin1 = fminf(vmin1, s1); vmax1 = fmaxf(vmax1, s1);
                sc[(2 * g) * 4096 + kt * 16 + fr] = s0; sc[(2 * g + 1) * 4096 + kt * 16 + fr] = s1;
            }
#pragma unroll
            for (int j = 0; j < 2; ++j) { float mn = j ? vmin1 : vmin0, mx = j ? vmax1 : vmax0;
                mn = fminf(mn, dppf<0xB1>(mn)); mn = fminf(mn, dppf<0x4E>(mn)); mn = fminf(mn, dppf<0x141>(mn)); mn = fminf(mn, dppf<0x140>(mn));
                mx = fmaxf(mx, dppf<0xB1>(mx)); mx = fmaxf(mx, dppf<0x4E>(mx)); mx = fmaxf(mx, dppf<0x141>(mx)); mx = fmaxf(mx, dppf<0x140>(mx));
                if (fr == 0 && mx >= mn) { const int q = 2 * g + j;
                    __hip_atomic_fetch_min(mm + q * 2, ord_key(mn), __ATOMIC_RELAXED, __HIP_MEMORY_SCOPE_WORKGROUP); __hip_atomic_fetch_max(mm + q * 2 + 1, ord_key(mx), __ATOMIC_RELAXED, __HIP_MEMORY_SCOPE_WORKGROUP); } }
        }
        PROBE_END(1);
        PROBE_BEGIN(2);
        __syncthreads();
        PROBE_END(2);
        PROBE_BEGIN(7);
#pragma unroll 1
        for (int selrep = 0; selrep < (IDXPROBE == 2 ? 2 : 1); ++selrep)
        {
            const int n = n0 + wid, t = t0 + wid, nv = t + 1;
            if (nv <= 256) { for (int j = lane; j < 256; j += 64) out[j] = (unsigned short)(j < nv ? j : 0); }
            else {
                LAS const float* srow = sc + wid * 4096;
                const int nvp = (nv + 255) & ~255;
                const unsigned kmax = mm[wid * 2 + 1];
                const int kbase = (int)(kmax >> 19) - 255;
                unsigned P = 0u; int sh = 32;
                bool capped = false;
                float lo = ord_val(mm[wid * 2]), hi = ord_val(mm[wid * 2 + 1]);
                float lo1 = 0.f, sc1 = 0.f, lo2 = 0.f, sc2 = 0.f, lo3 = 0.f, sc3 = 0.f; int b1 = 0, b2 = 0, b3 = 0, nlev = 0;
                int m = nv, need = 256;
#define IDX_HIST_SCAN(bin, nneed, mmc, lumpc) do { int hb[4]; \
                    _Pragma("unroll") for (int j = 0; j < 4; ++j) hb[j] = hist[lane * 4 + j]; \
                    if (lane == 0) hb[0] += (lumpc); \
                    const int tot = hb[0] + hb[1] + hb[2] + hb[3]; int suf = tot; \
                    _Pragma("unroll") for (int off = 1; off < 64; off <<= 1) { const int v = __shfl_down(suf, off); if (lane + off < 64) suf += v; } \
                    const int above = suf - tot; const bool is = (above < need) && (need <= suf); \
                    bin = 0; nneed = 0; mmc = 0; \
                    if (is) { int c = above; \
                        _Pragma("unroll") for (int k = 3; k >= 0; --k) { if (nneed == 0) { if (need <= c + hb[k]) { bin = lane * 4 + k; nneed = need - c; mmc = hb[k]; } else c += hb[k]; } } } \
                    const unsigned long long bal = __ballot(is); const int srcl = __ffsll((long long)bal) - 1; \
                    bin = __shfl(bin, srcl); nneed = __shfl(nneed, srcl); mmc = __shfl(mmc, srcl); } while (0)
#define IDX_ZERO_HIST() do { int z = 0; asm volatile("" : "+v"(z)); _Pragma("unroll") for (int j = 0; j < 4; ++j) hist[lane * 4 + j] = z; } while (0)
                PROBE_BEGIN(3);
                {
                    IDX_ZERO_HIST();
                    int lumpl = 0;
                    for (int c0 = 0; c0 < nvp; c0 += 256) { const f32x4 s4 = *(const LAS f32x4*)(srow + c0 + lane * 4);
#pragma unroll
                        for (int e_ = 0; e_ < 4; ++e_) { const unsigned k = ord_key(s4[e_]); const int bin = (int)(k >> 19) - kbase; const bool valid = c0 + lane * 4 + e_ < nv;
                            if (valid && bin > 0) __hip_atomic_fetch_add(hist + bin, 1, __ATOMIC_RELAXED, __HIP_MEMORY_SCOPE_WORKGROUP);
                            lumpl += (valid && bin <= 0) ? 1 : 0; } }
                    int lump = lumpl;
#pragma unroll
                    for (int o = 32; o > 0; o >>= 1) lump += __shfl_xor(lump, o);
                    int bin, nneed, mmc; IDX_HIST_SCAN(bin, nneed, mmc, lump);
                    need = nneed; m = mmc;
                    if (bin > 0) { P = (unsigned)(kbase + bin); sh = 19; }
                    else { capped = true; hi = ord_val(((unsigned)(kbase + 1) << 19) - 1u); if (hi < lo) hi = lo; }
                }
                PROBE_END(3);
                PROBE_BEGIN(4);
#pragma unroll 1
                while (!capped && m > 128 && sh > 0) {
                    const int nsh = sh > 8 ? sh - 8 : 0; const unsigned dmask = (1u << (sh - nsh)) - 1u;
                    IDX_ZERO_HIST();
                    for (int c0 = 0; c0 < nvp; c0 += 256) { const f32x4 s4 = *(const LAS f32x4*)(srow + c0 + lane * 4);
#pragma unroll
                        for (int e_ = 0; e_ < 4; ++e_) { const unsigned k = ord_key(s4[e_]);
                            if (c0 + lane * 4 + e_ < nv && (k >> sh) == P) __hip_atomic_fetch_add(hist + ((k >> nsh) & dmask), 1, __ATOMIC_RELAXED, __HIP_MEMORY_SCOPE_WORKGROUP); } }
                    int bin, nneed, mmc; IDX_HIST_SCAN(bin, nneed, mmc, 0);
                    P = (P << (sh - nsh)) | (unsigned)bin; sh = nsh; need = nneed; m = mmc;
                }
#define IDX_CLASSIFY(s, cls) do { \
                    if (!capped) { const unsigned kk_ = sh >= 32 ? 0u : (ord_key(s) >> sh); cls = kk_ > P ? 2 : (kk_ == P ? 1 : 0); } \
                    else if ((int)(ord_key(s) >> 19) > kbase) cls = 2; \
                    else { cls = 1; \
                        if (nlev >= 1) { const int bb = idx_bin(s, lo1, sc1); if (bb != b1) cls = bb > b1 ? 2 : 0; } \
                        if (cls == 1 && nlev >= 2) { const int bb = idx_bin(s, lo2, sc2); if (bb != b2) cls = bb > b2 ? 2 : 0; } \
                        if (cls == 1 && nlev >= 3) { const int bb = idx_bin(s, lo3, sc3); if (bb != b3) cls = bb > b3 ? 2 : 0; } } } while (0)
#pragma unroll 1
                while (capped && m > 128 && nlev < 3 && (hi - lo) > 1e-30f) {
                    const float width = hi - lo, scale = 256.0f / width;
                    IDX_ZERO_HIST();
                    for (int c0 = 0; c0 < nvp; c0 += 256) { const f32x4 s4 = *(const LAS f32x4*)(srow + c0 + lane * 4);
#pragma unroll
                        for (int e_ = 0; e_ < 4; ++e_) { const float s = s4[e_]; int cls; IDX_CLASSIFY(s, cls);
                            if (c0 + lane * 4 + e_ < nv && cls == 1) __hip_atomic_fetch_add(hist + idx_bin(s, lo, scale), 1, __ATOMIC_RELAXED, __HIP_MEMORY_SCOPE_WORKGROUP); } }
                    int bin, nneed, mmc; IDX_HIST_SCAN(bin, nneed, mmc, 0);
                    if (nlev == 0) { lo1 = lo; sc1 = scale; b1 = bin; } else if (nlev == 1) { lo2 = lo; sc2 = scale; b2 = bin; } else { lo3 = lo; sc3 = scale; b3 = bin; }
                    ++nlev; need = nneed; m = mmc;
                    const float w = width * (1.0f / 256.0f); lo = lo + (float)bin * w; hi = lo + w;
                }
#undef IDX_HIST_SCAN
#undef IDX_ZERO_HIST
                PROBE_END(4);
                PROBE_BEGIN(5);
                int base = 0, nc = 0;
                for (int c0 = 0; c0 < nvp; c0 += 256) { const f32x4 s4 = *(const LAS f32x4*)(srow + c0 + lane * 4);
                    bool su[4], ca[4]; int nsu = 0, nca = 0;
#pragma unroll
                    for (int e_ = 0; e_ < 4; ++e_) { const bool valid = c0 + lane * 4 + e_ < nv; int cls; IDX_CLASSIFY(s4[e_], cls); su[e_] = valid && cls == 2; ca[e_] = valid && cls == 1; nsu += su[e_] ? 1 : 0; nca += ca[e_] ? 1 : 0; }
                    unsigned long long bs4[4], bc4[4]; int ps = base, pc = nc, tots = 0, totc = 0;
#pragma unroll
                    for (int e_ = 0; e_ < 4; ++e_) { bs4[e_] = __ballot(su[e_]); bc4[e_] = __ballot(ca[e_]); ps += __popcll(bs4[e_] & lt_mask); pc += __popcll(bc4[e_] & lt_mask); tots += __popcll(bs4[e_]); totc += __popcll(bc4[e_]); }
#pragma unroll
                    for (int e_ = 0; e_ < 4; ++e_) { const int key = c0 + lane * 4 + e_;
                        if (su[e_]) { if (ps < 256) out[ps] = (unsigned short)key; ++ps; }
                        if (ca[e_]) { if (pc < 256) { candv[pc] = s4[e_]; candi[pc] = (unsigned short)key; } ++pc; } }
                    base += tots; nc += totc; }
#undef IDX_CLASSIFY
                PROBE_END(5);
                PROBE_BEGIN(6);
                const int mcap = nc < 256 ? nc : 256;
                float T = -INFINITY; int need_t = need;
                if (nc <= 256) {
                    float mine[4]; int cgt[4], cge[4];
#pragma unroll
                    for (int k = 0; k < 4; ++k) { mine[k] = (lane + 64 * k) < mcap ? candv[lane + 64 * k] : -INFINITY; cgt[k] = 0; cge[k] = 0; }
                    if (lane < 4 && mcap + lane < 260) candv[mcap + lane] = -INFINITY;
                    const int nk = (mcap + 63) >> 6;
                    for (int j = 0; j < mcap; j += 4) { const f32x4 vj = *(const LAS f32x4*)(candv + j);
#pragma unroll
                        for (int k = 0; k < 4; ++k) { if (k < nk) {
#pragma unroll
                            for (int e_ = 0; e_ < 4; ++e_) { cgt[k] += vj[e_] > mine[k] ? 1 : 0; cge[k] += vj[e_] >= mine[k] ? 1 : 0; } } } }
                    float tv = -INFINITY; int tg = 0; bool isT = false;
#pragma unroll
                    for (int k = 0; k < 4; ++k) { const bool ok = ((lane + 64 * k) < mcap) && (cgt[k] < need) && (need <= cge[k]); if (ok && !isT) { isT = true; tv = mine[k]; tg = cgt[k]; } }
                    const unsigned long long bT = __ballot(isT);
                    const int sl = __ffsll((long long)bT) - 1;
                    T = __shfl(tv, sl); need_t = need - __shfl(tg, sl);
                }
                int ties = 0;
                for (int c0 = 0; c0 < mcap; c0 += 64) { const int j = c0 + lane; const bool valid = j < mcap; const float s = valid ? candv[j] : -INFINITY;
                    const bool sure = valid && (nc <= 256) && s > T;
                    const bool tie = valid && ((nc <= 256) ? (s == T) : true);
                    const unsigned long long beq = __ballot(tie);
                    const int rank = ties + __popcll(beq & lt_mask);
                    const bool take = sure || (tie && rank < need_t);
                    const unsigned long long bt = __ballot(take);
                    const int pos = base + __popcll(bt & lt_mask);
                    if (take && pos < 256) out[pos] = candi[j];
                    base += __popcll(bt); ties += __popcll(beq); }
                PROBE_END(6);
            }
            attn_query(qr, kr, vv, ao, n, out, (LAS unsigned char*)(sc + wid * 4096), lane);
        }
        PROBE_END(7);
        PROBE_BEGIN(8);
        __syncthreads();
        PROBE_END(8);
    }
    PROBE_END(9);
    PROBE_STORE(ws, bid, tid);
}

__device__ __forceinline__ void phase_attn2(const Params& p, LAS unsigned char* lds, int bid, int nb) {
    const int tid = opaque_tid(), wid = tid >> 6, lane = tid & 63, fr = lane & 15, g = lane >> 4;
    unsigned char* ws = p.ws;
    const bf16_t* qr = (const bf16_t*)(ws + OFF_BUF64); const bf16_t* kr = (const bf16_t*)(ws + OFF_KR); const bf16_t* vv = (const bf16_t*)(ws + OFF_VV);
    const unsigned short* idx = (const unsigned short*)(ws + OFF_IDX);
    bf16_t* ao = (bf16_t*)(ws + OFF_PD);
    LAS unsigned char* vbuf = lds + wid * 16384;
    LAS unsigned short* ks = (LAS unsigned short*)(lds + 131072) + wid * 256;
    const int q4 = fr >> 2, p4 = fr & 3;
    int n = bid * 8 + wid;
    u32x2 nidx = (u32x2){0u, 0u};
    if (n < NTOK) nidx = *(const u32x2*)(idx + (size_t)n * 256 + lane * 4);
    for (; n < NTOK; n += nb * 8) {
        const int t = n & (SEQ - 1), b = n >> 12, cnt = (t + 1) < 256 ? (t + 1) : 256;
        asm volatile("" ::: "memory");
        *(LAS u32x2*)(ks + lane * 4) = nidx;
        { const int nn = n + nb * 8; int l4 = lane * 4; asm volatile("" : "+v"(l4)); if (nn < NTOK) nidx = *(const u32x2*)(idx + (size_t)nn * 256 + l4); }
        bf16x8 qf[4];
#pragma unroll
        for (int s = 0; s < 4; ++s) { qf[s] = (bf16x8){0, 0, 0, 0, 0, 0, 0, 0}; if (fr < 8) qf[s] = *(const bf16x8*)(qr + (size_t)n * 1024 + fr * 128 + s * 32 + g * 8); }
        const bf16_t* kbase = kr + (size_t)b * SEQ * 128; const bf16_t* vbase = vv + (size_t)b * SEQ * 128;
        f32x4 acc[16];
        bf16x8 kf[3][2][4];
#define ATT_KLOAD(buf, grp) do { _Pragma("unroll") for (int t2 = 0; t2 < 2; ++t2) { const int j_ = ((grp) * 2 + t2) * 16 + fr; const int key_ = j_ < cnt ? (int)ks[j_] : 0; \
            const bf16_t* kp_ = kbase + (size_t)key_ * 128 + g * 8; _Pragma("unroll") for (int s = 0; s < 4; ++s) kf[buf][t2][s] = *(const bf16x8*)(kp_ + s * 32); } } while (0)
        ATT_KLOAD(0, 0); ATT_KLOAD(1, 1);
#pragma unroll
        for (int grp = 0; grp < 8; ++grp) {
            if (grp + 2 < 8) ATT_KLOAD((grp + 2) % 3, grp + 2);
#pragma unroll
            for (int t2 = 0; t2 < 2; ++t2) { f32x4 a = fzero4();
#pragma unroll
                for (int s = 0; s < 4; ++s) a = __builtin_amdgcn_mfma_f32_16x16x32_bf16(kf[grp % 3][t2][s], qf[s], a, 0, 0, 0);
                acc[grp * 2 + t2] = a; }
        }
#undef ATT_KLOAD
        u32x4 vr[2][8];
#define ATT_VLOAD(buf, s) do { _Pragma("unroll") for (int i = 0; i < 8; ++i) { const int kl_ = i * 4 + g; const int jj_ = (s) * 32 + kl_; const int key_ = jj_ < cnt ? (int)ks[jj_] : 0; \
            const int c_ = fr ^ ((kl_ & 7) << 1); vr[buf][i] = *(const u32x4*)(vbase + (size_t)key_ * 128 + c_ * 8); } } while (0)
        ATT_VLOAD(0, 0);
        float m = -INFINITY;
#pragma unroll
        for (int tl = 0; tl < 16; ++tl)
#pragma unroll
            for (int r = 0; r < 4; ++r) { if (tl * 16 + g * 4 + r >= cnt) acc[tl][r] = -INFINITY; m = fmaxf(m, acc[tl][r]); }
        m = fmaxf(m, __shfl_xor(m, 16)); m = fmaxf(m, __shfl_xor(m, 32));
        float sum = 0.f;
#pragma unroll
        for (int tl = 0; tl < 16; ++tl)
#pragma unroll
            for (int r = 0; r < 4; ++r) { const float e_ = __expf(acc[tl][r] - m); acc[tl][r] = e_; sum += e_; }
        sum += __shfl_xor(sum, 16); sum += __shfl_xor(sum, 32);
        const float inv = 1.0f / sum;
        bf16x8 pf[8];
#pragma unroll
        for (int s = 0; s < 8; ++s) pf[s] = pack_8g(acc[2 * s], acc[2 * s + 1]);
        f32x4 o[8];
#pragma unroll
        for (int dt = 0; dt < 8; ++dt) o[dt] = fzero4();
#pragma unroll
        for (int s = 0; s < 8; ++s) {
            LAS unsigned char* vb = vbuf + (s & 1) * 8192;
            if (s + 1 < 8) ATT_VLOAD((s + 1) & 1, s + 1);
#pragma unroll
            for (int i = 0; i < 8; ++i) { const int kl = i * 4 + g; *(LAS u32x4*)(vb + kl * 256 + fr * 16) = vr[s & 1][i]; }
            const int kl1 = 4 * g + q4, kl2 = 16 + 4 * g + q4;
#pragma unroll
            for (int dt = 0; dt < 8; ++dt) {
                const int c = 2 * dt + (p4 >> 1);
                const s16x4 lo = __builtin_amdgcn_ds_read_tr16_b64_v4i16((LAS s16x4*)(vb + kl1 * 256 + ((c ^ ((kl1 & 7) << 1)) * 16) + (p4 & 1) * 8));
                const s16x4 hi = __builtin_amdgcn_ds_read_tr16_b64_v4i16((LAS s16x4*)(vb + kl2 * 256 + ((c ^ ((kl2 & 7) << 1)) * 16) + (p4 & 1) * 8));
                const bf16x8 af = (bf16x8){lo[0], lo[1], lo[2], lo[3], hi[0], hi[1], hi[2], hi[3]};
                o[dt] = __builtin_amdgcn_mfma_f32_16x16x32_bf16(af, pf[s], o[dt], 0, 0, 0);
            }
        }
#undef ATT_VLOAD
        if (fr < 8) {
#pragma unroll
            for (int dt = 0; dt < 8; ++dt) { u32x2 w; w.x = cvt_pk_bf16(o[dt][0] * inv, o[dt][1] * inv); w.y = cvt_pk_bf16(o[dt][2] * inv, o[dt][3] * inv);
                *(u32x2*)(ao + (size_t)n * 1024 + fr * 128 + dt * 16 + g * 4) = w; }
        }
    }
}

__device__ __forceinline__ void phase_inproj_even(const Params& p, LAS unsigned char* lds, int bid, int nb) {
    unsigned char* ws = p.ws;
    pg::DenseSched S; S.init(ws + OFF_BUF64, ws + OFF_WINE, NTOK, NE_MAIN, 1024, nb, bid);
    pg::EpiBf16 E; E.O = (bf16_t*)(ws + OFF_P); E.ldc = NE_MAIN;
    pg::gemm_phase(lds, 1024, S, E);
}
__device__ __forceinline__ void phase_inproj_odd(const Params& p, LAS unsigned char* lds, int bid, int nb) {
    unsigned char* ws = p.ws;
    pg::DenseSched S; S.init(ws + OFF_BUF64, ws + OFF_WINO, NTOK, NO_MAIN, 1024, nb, bid);
    pg::EpiBf16 E; E.O = (bf16_t*)(ws + OFF_PD); E.ldc = NO_MAIN;
    pg::gemm_phase(lds, 1024, S, E);
}
__device__ __forceinline__ void phase_outproj(const Params& p, LAS unsigned char* lds, int bid, int nb, size_t aoff, size_t woff, const float* X) {
    unsigned char* ws = p.ws;
    pg::DenseSched S; S.init(ws + aoff, ws + woff, NTOK, 1024, 1024, nb, bid);
    pg::EpiResid E; E.X = X; E.U = (float*)(ws + OFF_U);
    pg::gemm_phase(lds, 1024, S, E);
}

#define XB_TMO      128
#define XB_XCNT(j)  (256  + 64 * (j))
#define XB_XSUB(j)  (1280 + 64 * (j))
#define XB_XGEN(j)  (2304 + 64 * (j))
#define XB_TOP      3328
#define XB_TOPGEN   3392
#define XCD_BAR_WORDS 3456
#define XB_SPIN_CAP (1u << 20)
__device__ __forceinline__ unsigned xb_ld(unsigned* p)              { return __hip_atomic_load(p, __ATOMIC_RELAXED, __HIP_MEMORY_SCOPE_AGENT); }
__device__ __forceinline__ unsigned xb_add(unsigned* p, unsigned v) { return __hip_atomic_fetch_add(p, v, __ATOMIC_RELAXED, __HIP_MEMORY_SCOPE_AGENT); }
__device__ __forceinline__ unsigned xb_xcc_id() { return (unsigned)__builtin_amdgcn_s_getreg((3 << 11) | 20) & 0xFu; }
#define XB_SPIN(cond, bar) do { unsigned _sp = 0; while (cond) { __builtin_amdgcn_s_sleep(1); \
    if ((++_sp & 255u) == 0u) { if (xb_ld(&(bar)[XB_TMO])) break; if (_sp > XB_SPIN_CAP) { atomicAdd(&(bar)[XB_TMO], 1u); break; } } } } while (0)
__device__ __forceinline__ void xcd_barrier_complete(unsigned* bar, unsigned x, unsigned& nloc, unsigned& nx) {
    const unsigned G = gridDim.x;
    unsigned sum, cnt, mine, sp = 0u;
    for (;;) {
        sum = 0u; cnt = 0u; mine = 0u;
#pragma unroll
        for (unsigned j = 0; j < 16; ++j) { const unsigned c = xb_ld(&bar[XB_XCNT(j)]); sum += c; cnt += (c > 0u) ? 1u : 0u; mine = (j == x) ? c : mine; }
        if (sum == G) break;
        __builtin_amdgcn_s_sleep(1);
        if ((++sp & 255u) == 0u) { if (xb_ld(&bar[XB_TMO])) break; if (sp > XB_SPIN_CAP) { atomicAdd(&bar[XB_TMO], 1u); break; } }
    }
    nloc = mine > 0u ? mine : 1u; nx = cnt > 0u ? cnt : 1u;
}
__device__ __forceinline__ void grid_barrier(unsigned* bar, volatile LAS unsigned* st) {
    asm volatile("s_waitcnt vmcnt(0) lgkmcnt(0)" ::: "memory");
    __syncthreads();
    if (threadIdx.x == 0) {
        const unsigned x = xb_xcc_id();
        __builtin_amdgcn_s_waitcnt(0);
        unsigned nloc = st[0], nx = st[1];
        if (nloc == 0u) { xcd_barrier_complete(bar, x, nloc, nx); st[0] = nloc; st[1] = nx; }
        const unsigned old = xb_add(&bar[XB_XSUB(x)], 1u);
        const unsigned gen = old / nloc;
        if (old + 1u == (gen + 1u) * nloc) {
            __builtin_amdgcn_fence(__ATOMIC_RELEASE, "agent");
            asm volatile("s_waitcnt vmcnt(0)" ::: "memory");
            const unsigned og = xb_add(&bar[XB_TOP], 1u);
            const unsigned tg = og / nx;
            if (og + 1u == (tg + 1u) * nx) xb_add(&bar[XB_TOPGEN], 1u);
            else XB_SPIN(xb_ld(&bar[XB_TOPGEN]) == tg, bar);
            __builtin_amdgcn_fence(__ATOMIC_ACQUIRE, "agent");
            xb_add(&bar[XB_XGEN(x)], 1u);
            asm volatile("s_waitcnt vmcnt(0)" ::: "memory");
        } else {
            XB_SPIN(xb_ld(&bar[XB_XGEN(x)]) == gen, bar);
            __builtin_amdgcn_fence(__ATOMIC_ACQUIRE, "agent");
            asm volatile("s_waitcnt vmcnt(0)" ::: "memory");
        }
    }
    __syncthreads();
}
#ifndef DUP
#define DUP 0
#endif
#define GSYNC() grid_barrier(bar_ctr, (volatile LAS unsigned*)(lds + LDS_BYTES - 1024))
__global__ __launch_bounds__(512, 2) void mega(KArgs a) {
    extern __shared__ __attribute__((aligned(16))) unsigned char smem[];
    LAS unsigned char* lds = (LAS unsigned char*)smem;
    Params p; p.in.t = (LAS const unsigned long long*)(lds + PTAB_OFF); p.out = a.out; p.ws = a.ws;
    if ((threadIdx.x & 63) == 0) ((LAS int*)(lds + WTAB_OFF))[hw_slot()] = threadIdx.x >> 6;
    if (threadIdx.x == 0) { LAS unsigned long long* tw_ = (LAS unsigned long long*)(lds + PTAB_OFF);
#pragma unroll
        for (int i = 0; i < 30; ++i) tw_[i] = (unsigned long long)a.in[i]; }
    __syncthreads();
    cg::grid_group grid = cg::this_grid();
    const int bid0 = blockIdx.x, nb0 = gridDim.x;
    unsigned* bar_ctr = (unsigned*)(p.ws + OFF_MISC + MISC_BAR);
    if (blockIdx.x == 0) for (int i = threadIdx.x; i < XCD_BAR_WORDS; i += 512) __hip_atomic_store(bar_ctr + i, 0u, __ATOMIC_RELAXED, __HIP_MEMORY_SCOPE_AGENT);
    if (threadIdx.x < 2) ((LAS unsigned*)(lds + LDS_BYTES - 1024))[threadIdx.x] = 0u;
    grid.sync();
    if (threadIdx.x == 0) (void)xb_add(&bar_ctr[XB_XCNT(xb_xcc_id())], 1u);
    int bid, nb;
#define FRESH() do { bid = bid0; nb = nb0; asm volatile("" : "+s"(bid), "+s"(nb)); } while (0)
#define PHP(pid, call) do { unsigned long long t0_ = 0; if (PROBE_ID == (pid)) t0_ = __builtin_amdgcn_s_memtime(); call; if (PROBE_ID == (pid) && bid0 == (PROBE_BLK) && opaque_tid() == 0) *(float*)(p.ws + OFF_MISC + MISC_PROBE) = (float)(__builtin_amdgcn_s_memtime() - t0_) * 2e-8f; } while (0)
#define RUNP(id, call) do { FRESH(); call; GSYNC(); if (DUP == id) { FRESH(); call; GSYNC(); } } while (0)
    RUNP(10, PHP(30, phase_prep(p, lds, bid, nb)));
#if PROBE_ID == 20
    const unsigned long long kstart = __builtin_amdgcn_s_memtime();
#endif
#pragma unroll 1
    for (int layer = 0; layer < 2; ++layer) {
        if (layer == 0) {
            FRESH(); PHP(31, phase_inproj_even(p, lds, bid, nb));
            FRESH(); PHP(32, phase_gla_alpha(p, lds, bid, nb));
            GSYNC();
            if (DUP == 11) { FRESH(); phase_inproj_even(p, lds, bid, nb); GSYNC(); }
            if (DUP == 12) { FRESH(); phase_gla_alpha(p, lds, bid, nb); GSYNC(); }
            RUNP(21, PHP(44, phase_lora_act(p, bid, nb)));
            RUNP(1, PHP(33, phase_mixer_even(p, lds, bid, nb, 0)));
            RUNP(13, PHP(34, phase_rwkv_epi(p, bid, nb)));
        } else {
            RUNP(14, PHP(40, phase_inproj_odd(p, lds, bid, nb)));
            RUNP(15, PHP(41, phase_rope(p, bid, nb)));
            RUNP(2, PHP(43, phase_index2(p, lds, bid, nb)));
        }
        RUNP(16, PHP(35, phase_outproj(p, lds, bid, nb, layer ? OFF_PD : OFF_BUF64, layer ? OFF_WOUTO : OFF_WOUTE, layer ? p.out : p.in[I_X])));
        FRESH(); PHP(36, phase_ln_route(p, lds, bid, nb, layer));
        GSYNC();
        RUNP(17, PHP(37, phase_moe_gateup(p, lds, bid, nb, layer)));
        RUNP(18, PHP(38, phase_moe_down(p, lds, bid, nb, layer)));
#if PROBE_ID == 20
        if (layer == 1) { if (bid0 == 7 && threadIdx.x == 0) *(float*)(p.ws + OFF_MISC + MISC_PROBE) = (float)(__builtin_amdgcn_s_memtime() - kstart) * 1e-8f; GSYNC(); }
#endif
        RUNP(19, PHP(39, phase_ln2(p, bid, nb, layer, p.out, true)));
    }
}

extern "C" void kernel_launch(void* const* d_in, const int* in_sizes, int n_in, void* d_out, int out_size, void* d_ws, size_t ws_size, hipStream_t stream) {
    if (ws_size < WS_NEED) { fprintf(stderr, "workspace too small: %zu < %zu\n", ws_size, (size_t)WS_NEED); return; }
    KArgs p{};
    for (int i = 0; i < 30; ++i) p.in[i] = (const float*)d_in[i];
    p.out = (float*)d_out; p.ws = (unsigned char*)d_ws;
    static int grid_blocks = 0;
    if (!grid_blocks) {
        (void)hipFuncSetAttribute((const void*)mega, hipFuncAttributeMaxDynamicSharedMemorySize, LDS_BYTES);
        int dev = 0, cus = 0, per_cu = 0;
        (void)hipGetDevice(&dev);
        (void)hipDeviceGetAttribute(&cus, hipDeviceAttributeMultiprocessorCount, dev);
        (void)hipOccupancyMaxActiveBlocksPerMultiprocessor(&per_cu, mega, 512, LDS_BYTES);
        if (per_cu < 1) { fprintf(stderr, "occupancy query returned %d\n", per_cu); per_cu = 1; }
        grid_blocks = cus;
    }
    void* args[] = {&p};
    hipError_t e = hipLaunchCooperativeKernel((void*)mega, dim3(grid_blocks), dim3(512), args, LDS_BYTES, stream);
    if (e != hipSuccess) fprintf(stderr, "cooperative launch failed: %s (grid %d)\n", hipGetErrorString(e), grid_blocks);
}
```

```cpp
#include <hip/hip_runtime.h>
#include <hip/hip_cooperative_groups.h>
#include <cstdio>
#include <cstdint>
namespace cg = cooperative_groups;

#ifndef PROBE_ID
#define PROBE_ID 0
#endif
#ifndef PROBE_BLK
#define PROBE_BLK 7
#endif
#ifndef IDXPROBE
#define IDXPROBE 0
#endif
#ifndef SANITIZE
#define SANITIZE 0
#endif
#ifndef PREP_REP
#define PREP_REP 1
#endif
constexpr int NTOK = 32768, SEQ = 4096, NB = 8, DM = 1024;
constexpr int EVEN_COLS = 3344, ODD_COLS = 1604;
constexpr int NE_MAIN = 3328;
constexpr int NO_MAIN = 1792;
constexpr int NEXP = 16, DEXP = 256;
constexpr float DN_ALPHA = 1.4142135623730951f;
constexpr float LN_EPS = 1e-5f;
constexpr int MOE_ROWS = 65536 + 16 * 256;

typedef unsigned short bf16_t;
typedef short bf16x8 __attribute__((ext_vector_type(8)));
typedef float f32x4 __attribute__((ext_vector_type(4)));
typedef short s16x4 __attribute__((ext_vector_type(4)));
typedef float f32x2 __attribute__((ext_vector_type(2)));
typedef unsigned u32x4 __attribute__((ext_vector_type(4)));
typedef unsigned u32x2 __attribute__((ext_vector_type(2)));
#define LAS __attribute__((address_space(3)))

typedef __bf16 bf16x2_t __attribute__((ext_vector_type(2)));
__device__ __forceinline__ unsigned cvt_pk_bf16(float lo, float hi) { bf16x2_t v; v[0] = (__bf16)lo; v[1] = (__bf16)hi; return __builtin_bit_cast(unsigned, v); }
__device__ __forceinline__ bf16_t f2bf(float f) { return (bf16_t)(cvt_pk_bf16(f, 0.f) & 0xffffu); }
__device__ __forceinline__ float bf2f(bf16_t h) { return __uint_as_float(((unsigned)h) << 16); }
constexpr int LDS_BYTES = 160 * 1024;
constexpr int PTAB_OFF = LDS_BYTES - 256;
constexpr int WTAB_OFF = LDS_BYTES - 512;
__device__ __forceinline__ int hw_slot() { return (int)(__builtin_amdgcn_s_getreg(0x2804) & 63u); }
__device__ __forceinline__ int opaque_tid() {
    extern __shared__ __attribute__((aligned(16))) unsigned char smem_[];
    const int w = __builtin_amdgcn_readfirstlane(((LAS const int*)((LAS unsigned char*)smem_ + WTAB_OFF))[hw_slot()]);
    int l; asm volatile("v_mbcnt_lo_u32_b32 %0, -1, 0\n\tv_mbcnt_hi_u32_b32 %0, -1, %0" : "=v"(l));
    return (w << 6) | l; }
#if PROBE_ID
#define PROBE_DECL unsigned long long probe_acc = 0, probe_t0 = 0
#define PROBE_BEGIN(id) do { if (PROBE_ID == (id)) probe_t0 = __builtin_amdgcn_s_memtime(); } while (0)
#define PROBE_END(id) do { if (PROBE_ID == (id)) probe_acc += __builtin_amdgcn_s_memtime() - probe_t0; } while (0)
#define PROBE_STORE(ws, bid, tid) do { if (PROBE_ID < 30 && (bid) == 7 && (tid) == 0) *(float*)((ws) + OFF_MISC + MISC_PROBE) = (float)probe_acc * 1e-6f; } while (0)
#else
#define PROBE_DECL
#define PROBE_BEGIN(id)
#define PROBE_END(id)
#define PROBE_STORE(ws, bid, tid)
#endif
__device__ __forceinline__ f32x4 fzero4() { float z = 0.f; asm volatile("" : "+v"(z)); return (f32x4){z, z, z, z}; }
__device__ __forceinline__ u32x4 uzero4() { unsigned z = 0u; asm volatile("" : "+v"(z)); return (u32x4){z, z, z, z}; }
__device__ __forceinline__ float fast_rcp(float x) { return __builtin_amdgcn_rcpf(x); }
__device__ __forceinline__ float fast_sigmoid(float x) { return fast_rcp(1.0f + __expf(-x)); }
__device__ __forceinline__ float fast_tanh(float x) { const float e = __expf(2.0f * x); return 1.0f - 2.0f * fast_rcp(1.0f + e); }
__device__ __forceinline__ bf16x8 pack_8g(const f32x4 a, const f32x4 b) { u32x4 w; w.x = cvt_pk_bf16(a[0], a[1]); w.y = cvt_pk_bf16(a[2], a[3]); w.z = cvt_pk_bf16(b[0], b[1]); w.w = cvt_pk_bf16(b[2], b[3]); return __builtin_bit_cast(bf16x8, w); }
template <int CTRL> __device__ __forceinline__ float dppf(float v) { return __builtin_bit_cast(float, __builtin_amdgcn_update_dpp(0, __builtin_bit_cast(int, v), CTRL, 0xf, 0xf, true)); }
__device__ __forceinline__ float wave_sum(float v) {
#pragma unroll
    for (int o = 32; o > 0; o >>= 1) v += __shfl_xor(v, o);
    return v;
}

constexpr size_t MiB = 1024ull * 1024ull;
constexpr size_t OFF_WINE = 0;
constexpr size_t OFF_WOUTE = OFF_WINE + (size_t)NE_MAIN * 1024 * 2;
constexpr size_t OFF_WINO = OFF_WOUTE + 2 * MiB;
constexpr size_t OFF_WOUTO = OFF_WINO + (size_t)NO_MAIN * 1024 * 2;
constexpr size_t OFF_WGU = OFF_WOUTO + 2 * MiB;
constexpr size_t OFF_WD = OFF_WGU + 32 * MiB;
constexpr size_t OFF_ROPE = OFF_WD + 16 * MiB;
constexpr size_t OFF_MISC = OFF_ROPE + 3 * MiB;
constexpr size_t OFF_BUF64 = OFF_MISC + 4 * MiB;
constexpr size_t OFF_P = OFF_BUF64 + 64 * MiB;
constexpr size_t OFF_U = OFF_P + 208 * MiB;
constexpr size_t WS_NEED = OFF_U + 128 * MiB;
constexpr size_t OFF_HE = OFF_P;
constexpr size_t OFF_ACT = OFF_HE + (size_t)MOE_ROWS * 1024 * 2;
constexpr size_t OFF_PD = OFF_P;
constexpr size_t OFF_KR = OFF_P + 112 * MiB;
constexpr size_t OFF_VV = OFF_KR + 8 * MiB;
constexpr size_t OFF_IQR = OFF_VV + 8 * MiB;
constexpr size_t OFF_IKR = OFF_IQR + 16 * MiB;
constexpr size_t OFF_IW = OFF_IKR + 4 * MiB;
constexpr size_t OFF_IDX = OFF_IW + 1 * MiB;
constexpr size_t MISC_CNT = 0;
constexpr size_t MISC_TOKINFO = 4096;
constexpr size_t MISC_TOKGATE = MISC_TOKINFO + (size_t)NTOK * 16;
constexpr size_t MISC_LIST = MISC_TOKGATE + (size_t)NTOK * 8;
constexpr size_t MISC_PROBE = 2304;
constexpr size_t MISC_W2T = 3 * MiB;
constexpr size_t MISC_A2T = MISC_W2T + 65536;
constexpr size_t MISC_G2T = MISC_A2T + 65536;
constexpr size_t MISC_BAR = MISC_G2T + 131072;
constexpr size_t MISC_RWF = MISC_BAR + 16384;
constexpr size_t MISC_PCTR = MISC_RWF + 16384;
constexpr size_t OFF_GLA_ORAW = OFF_U + 50 * MiB;
constexpr size_t OFF_GLA_QDG = OFF_U + 82 * MiB;
constexpr size_t OFF_GLA_SIN = OFF_U + 90 * MiB;
constexpr size_t OFF_RWXB = OFF_U + 24 * MiB;

struct InTab { LAS const unsigned long long* t;
    __device__ __forceinline__ const float* operator[](int i) const { const unsigned long long v = t[i];
        const unsigned lo = __builtin_amdgcn_readfirstlane((unsigned)v), hi = __builtin_amdgcn_readfirstlane((unsigned)(v >> 32));
        return (const float*)(((unsigned long long)hi << 32) | lo); } };
struct Params { InTab in; float* out; unsigned char* ws; };
struct KArgs { const float* in[30]; float* out; unsigned char* ws; };
enum { I_X = 0, I_WINE, I_AMU, I_AW0, I_AW2, I_AA0, I_AA2, I_AG2, I_AKK, I_AKA, I_ARK, I_AGNG, I_AGNB, I_BGW2, I_BGB, I_BNG, I_WOUTE,
       I_WINO, I_CIKG, I_CIKB, I_WOUTO, I_LN1G, I_LN1B, I_LN2G, I_LN2B, I_RW, I_RB, I_EG, I_EU, I_ED };

namespace pg {
constexpr int BM = 256, BK = 64, HALF = 128, HTB = HALF * BK * 2, STAGE_BYTES = 8 * HTB;
__host__ __device__ __forceinline__ int lds_byte(int r, int c) { const int st = (r >> 4) * 2 + (c >> 5), rr = r & 15, cc = c & 31, ob = rr * 64 + cc * 2; return st * 1024 + (ob ^ (((ob >> 9) & 1) << 5)); }
__host__ __device__ __forceinline__ void stage_rc(int b, int& R, int& C) { const int st = b / 1024, sb = b % 1024, swz = sb ^ (((sb >> 9) & 1) << 5); R = (st >> 1) * 16 + swz / 64; C = (st & 1) * 32 + (swz % 64) / 2; }
__host__ __device__ __forceinline__ int perm32(int rho) { const int n = rho >> 4, i = rho & 15; return 8 * (i >> 2) + 4 * n + (i & 3); }

struct Unit { int pm, pn, e, rt, cnt; };

template <class Epi, class Sched>
__device__ __forceinline__ void gemm_phase(LAS unsigned char* lds, const int K, const Sched& S, const Epi& E) {
    const int tid = opaque_tid(), wid = __builtin_amdgcn_readfirstlane(tid >> 6), lane = tid & 63, wr = wid >> 2, wc = wid & 3, fr = lane & 15, fq = lane >> 4;
    const int nt = K / BK;
    unsigned voffB[2];
#pragma unroll
    for (int i = 0; i < 2; ++i) { int R, C; stage_rc(tid * 16 + i * 8192, R, C); const int Rb = Epi::PERM ? ((R & ~31) + perm32(R & 31)) : R; voffB[i] = (unsigned)(Rb * K + C) * 2u; }
    const size_t kstep = (size_t)(BK * 2);
    const size_t hstepB = (size_t)HALF * K * 2;
    const unsigned ldsw = (unsigned)wid * 1024u;
    const int aoff = lds_byte(wr * 64 + fr, fq * 8), boff = lds_byte(wc * 32 + fr, fq * 8);
#define PG_SA(b, h) (((b) * 2 + (h)) * HTB)
#define PG_SB(b, h) ((4 + (b) * 2 + (h)) * HTB)
#define PG_STAGE(bufoff, gbase, voff) do { _Pragma("unroll") for (int _i = 0; _i < 2; ++_i) \
        __builtin_amdgcn_global_load_lds((const unsigned*)((const char*)(gbase) + (voff)[_i]), (LAS unsigned*)(lds + (bufoff) + ldsw + _i * 8192), 16, 0, 0); } while (0)
#define PG_LDA(dst, b, h) do { _Pragma("unroll") for (int m = 0; m < 4; ++m) _Pragma("unroll") for (int k = 0; k < 2; ++k) dst[m][k] = *(const LAS bf16x8*)(lds + PG_SA(b, h) + aoff + m * 2048 + k * 1024); } while (0)
#define PG_LDB(dst, b, h) do { _Pragma("unroll") for (int n = 0; n < 2; ++n) _Pragma("unroll") for (int k = 0; k < 2; ++k) dst[n][k] = *(const LAS bf16x8*)(lds + PG_SB(b, h) + boff + n * 2048 + k * 1024); } while (0)
#define PG_MMA(ai, bj, At, Bt) do { __builtin_amdgcn_s_setprio(1); _Pragma("unroll") for (int m = 0; m < 4; ++m) _Pragma("unroll") for (int n = 0; n < 2; ++n) _Pragma("unroll") for (int k = 0; k < 2; ++k) \
        acc[ai][bj][m][n] = __builtin_amdgcn_mfma_f32_16x16x32_bf16(Bt[n][k], At[m][k], acc[ai][bj][m][n], 0, 0, 0); __builtin_amdgcn_s_setprio(0); } while (0)
#define PG_WAIT_V(n) asm volatile("s_waitcnt vmcnt(" #n ")" ::: "memory")
#define PG_WAIT_L(n) asm volatile("s_waitcnt lgkmcnt(" #n ")" ::: "memory")
#define PG_BAR __builtin_amdgcn_s_barrier()
#define PG_SCHED __builtin_amdgcn_sched_barrier(0)
#define PG_AOFF(dst0, dst1, u) do { _Pragma("unroll") for (int _i = 0; _i < 2; ++_i) { int _R, _C; stage_rc(tid * 16 + _i * 8192, _R, _C); \
        dst0[_i] = S.a_rowoff(u, 0, _R) + (unsigned)_C * 2u; dst1[_i] = S.a_rowoff(u, 1, _R) + (unsigned)_C * 2u; } } while (0)
    Unit cur, nxt; int ui = 0;
    if (!S.next(0, cur)) return;
    f32x4 acc[2][2][4][2];
#pragma unroll
    for (int a = 0; a < 2; ++a)
#pragma unroll
        for (int b = 0; b < 2; ++b)
#pragma unroll
            for (int m = 0; m < 4; ++m)
#pragma unroll
                for (int n = 0; n < 2; ++n) acc[a][b][m][n] = (f32x4){0.f, 0.f, 0.f, 0.f};
    bf16x8 At[4][2], B0[2][2], B1[2][2];
    const char* const Ab = S.a_base();
    unsigned aC0[2], aC1[2];
    PG_AOFF(aC0, aC1, cur);
    const char* cB = S.b_ptr(cur);
    PG_STAGE(PG_SB(0, 0), cB, voffB); PG_STAGE(PG_SA(0, 0), Ab, aC0); PG_STAGE(PG_SB(0, 1), cB + hstepB, voffB); PG_STAGE(PG_SA(0, 1), Ab, aC1);
    if (wr == 1) PG_BAR;
    PG_WAIT_V(4); PG_BAR;
    PG_STAGE(PG_SB(1, 0), cB + kstep, voffB); PG_STAGE(PG_SA(1, 0), Ab + kstep, aC0); PG_STAGE(PG_SB(1, 1), cB + hstepB + kstep, voffB);
    PG_WAIT_V(6); PG_BAR;
    for (;;) {
        const bool has_next = S.next(ui + 1, nxt);
        const char* nB = has_next ? S.b_ptr(nxt) : cB;
#pragma unroll 1
        for (int t = 0; t < nt; t += 2) {
            const bool last = (t == nt - 2);
            const char* a1 = Ab + (size_t)(t + 1) * kstep;
            const char* a2 = last ? Ab : Ab + (size_t)(t + 2) * kstep; const char* b2 = last ? nB : cB + (size_t)(t + 2) * kstep;
            const char* a3 = a2 + kstep; const char* b3 = b2 + kstep;
            PG_LDB(B0, 0, 0); PG_SCHED; PG_LDA(At, 0, 0); PG_STAGE(PG_SA(1, 1), a1, aC1);
            if (last && has_next) PG_AOFF(aC0, aC1, nxt);
            PG_WAIT_L(8); PG_BAR; PG_WAIT_L(0); PG_MMA(0, 0, At, B0); PG_BAR; PG_SCHED;
            PG_LDB(B1, 0, 1); PG_STAGE(PG_SB(0, 0), b2, voffB);
            PG_BAR; PG_WAIT_L(0); PG_MMA(0, 1, At, B1); PG_BAR;
            PG_LDA(At, 0, 1); PG_STAGE(PG_SA(0, 0), a2, aC0);
            PG_BAR; PG_WAIT_L(0); PG_MMA(1, 0, At, B0); PG_BAR; PG_SCHED;
            PG_STAGE(PG_SB(0, 1), b2 + hstepB, voffB);
            PG_WAIT_V(6); PG_BAR; PG_MMA(1, 1, At, B1); PG_BAR;
            PG_LDB(B0, 1, 0); PG_SCHED; PG_LDA(At, 1, 0); PG_STAGE(PG_SA(0, 1), a2, aC1);
            PG_WAIT_L(8); PG_BAR; PG_WAIT_L(0); PG_MMA(0, 0, At, B0); PG_BAR; PG_SCHED;
            PG_LDB(B1, 1, 1); PG_STAGE(PG_SB(1, 0), b3, voffB);
            PG_BAR; PG_WAIT_L(0); PG_MMA(0, 1, At, B1); PG_BAR;
            PG_LDA(At, 1, 1); PG_STAGE(PG_SA(1, 0), a3, aC0);
            PG_BAR; PG_WAIT_L(0); PG_MMA(1, 0, At, B0); PG_BAR; PG_SCHED;
            PG_STAGE(PG_SB(1, 1), b3 + hstepB, voffB);
            PG_WAIT_V(6); PG_BAR; PG_MMA(1, 1, At, B1); PG_BAR;
        }
        E(acc, cur, wr, wc, fr, fq);
        if (!has_next) break;
#pragma unroll
        for (int a = 0; a < 2; ++a)
#pragma unroll
            for (int b = 0; b < 2; ++b)
#pragma unroll
                for (int m = 0; m < 4; ++m)
#pragma unroll
                    for (int n = 0; n < 2; ++n) acc[a][b][m][n] = (f32x4){0.f, 0.f, 0.f, 0.f};
        cur = nxt; cB = nB; ++ui;
    }
    PG_WAIT_V(0);
    if (wr == 0) PG_BAR;
    PG_BAR;
#undef PG_SA
#undef PG_SB
#undef PG_STAGE
#undef PG_LDA
#undef PG_LDB
#undef PG_MMA
#undef PG_WAIT_V
#undef PG_WAIT_L
#undef PG_BAR
#undef PG_SCHED
#undef PG_AOFF
}

struct DenseSched {
    const char* A; const char* Bt; int K, nM, nN, nwg, G, c;
    __device__ void init(const void* A_, const void* Bt_, int M, int N, int K_, int G_, int c_) { A = (const char*)A_; Bt = (const char*)Bt_; K = K_; nM = M / BM; nN = N / BM; nwg = nM * nN; G = G_; c = c_; }
    __device__ __forceinline__ bool next(int i, Unit& u) const {
        const long L = (long)i * G + c; if (L >= nwg) return false;
        int wgid = (int)L; { const int q = nwg / 8, r = nwg % 8, xcd = wgid % 8, off = wgid / 8; wgid = (xcd < r ? xcd * (q + 1) : r * (q + 1) + (xcd - r) * q) + off; }
        const int nig = 8 * nN, gid = wgid / nig, fm = gid * 8, gsz = (nM - fm) < 8 ? (nM - fm) : 8;
        u.pm = fm + ((wgid % nig) % gsz); u.pn = (wgid % nig) / gsz; u.e = 0; u.rt = 0; u.cnt = 0; return true;
    }
    __device__ __forceinline__ const char* a_base() const { return A; }
    __device__ __forceinline__ unsigned a_rowoff(const Unit& u, int half, int R) const { return (unsigned)(u.pm * BM + half * HALF + R) * (unsigned)(K * 2); }
    __device__ __forceinline__ const char* b_ptr(const Unit& u) const { return Bt + (size_t)u.pn * BM * K * 2; }
};

__device__ __forceinline__ void moe_build_units(LAS int* tab, const int* cntp, int NCT, int G, int c) {
    const int i = opaque_tid();
    if (i < 16) {
        const int L = i * G + c; int accu = 0, rtb = 0, found = 0, pm = 0, pn = 0, ee = 0, rt = 0, cn = 0;
        for (int e = 0; e < 16; ++e) { const int ce = cntp[e], nte = (ce + 255) >> 8, ue = nte * NCT;
            if (!found && L < accu + ue) { const int local = L - accu; ee = e; rt = local / NCT; pn = local % NCT; pm = rtb + rt; cn = ce; found = 1; }
            accu += ue; rtb += nte; }
        tab[i * 8 + 0] = found; tab[i * 8 + 1] = pm; tab[i * 8 + 2] = pn; tab[i * 8 + 3] = ee; tab[i * 8 + 4] = rt; tab[i * 8 + 5] = cn;
    }
    __syncthreads();
}
template <bool GATHER>
struct MoeSched {
    const char* A; const char* Bt; const int* list; int K; size_t wstride; LAS int* tab;
    __device__ void init(const void* A_, const void* Bt_, size_t wstride_bytes, const int* list_, int K_, LAS int* tab_) {
        A = (const char*)A_; Bt = (const char*)Bt_; wstride = wstride_bytes; list = list_; K = K_; tab = tab_; }
    __device__ __forceinline__ bool next(int i, Unit& u) const {
        if (i >= 16) return false;
        const int f = __builtin_amdgcn_readfirstlane(tab[i * 8 + 0]);
        u.pm = __builtin_amdgcn_readfirstlane(tab[i * 8 + 1]); u.pn = __builtin_amdgcn_readfirstlane(tab[i * 8 + 2]); u.e = __builtin_amdgcn_readfirstlane(tab[i * 8 + 3]);
        u.rt = __builtin_amdgcn_readfirstlane(tab[i * 8 + 4]); u.cnt = __builtin_amdgcn_readfirstlane(tab[i * 8 + 5]);
        return f != 0;
    }
    __device__ __forceinline__ const char* a_base() const { return A; }
    __device__ __forceinline__ unsigned a_rowoff(const Unit& u, int half, int R) const {
        if (GATHER) { const int slot = u.rt * BM + half * HALF + R; const int tok = slot < u.cnt ? list[u.e * NTOK + slot] : 0; return (unsigned)tok * (unsigned)(K * 2); }
        return (unsigned)(u.pm * BM + half * HALF + R) * (unsigned)(K * 2);
    }
    __device__ __forceinline__ const char* b_ptr(const Unit& u) const { return Bt + (size_t)u.e * wstride + (size_t)u.pn * BM * K * 2; }
};

struct EpiBf16 {
    static constexpr bool PERM = true;
    bf16_t* O; int ldc;
    __device__ __forceinline__ void operator()(const f32x4 (&acc)[2][2][4][2], const Unit& u, int wr, int wc, int fr, int fq) const {
        const int row0 = u.pm * BM + wr * 64 + fr, col0 = u.pn * BM + wc * 32 + 8 * fq;
#pragma unroll
        for (int ai = 0; ai < 2; ++ai)
#pragma unroll
            for (int m = 0; m < 4; ++m) { bf16_t* rowp = O + (size_t)(row0 + ai * HALF + m * 16) * ldc + col0;
#pragma unroll
                for (int bj = 0; bj < 2; ++bj) { const f32x4 v0 = acc[ai][bj][m][0], v1 = acc[ai][bj][m][1];
                    u32x4 w; w.x = cvt_pk_bf16(v0[0], v0[1]); w.y = cvt_pk_bf16(v0[2], v0[3]); w.z = cvt_pk_bf16(v1[0], v1[1]); w.w = cvt_pk_bf16(v1[2], v1[3]);
                    *(u32x4*)(rowp + bj * HALF) = w; } }
    }
};
struct EpiResid {
    static constexpr bool PERM = false;
    const float* X; float* U;
    __device__ __forceinline__ void operator()(const f32x4 (&acc)[2][2][4][2], const Unit& u, int wr, int wc, int fr, int fq) const {
        const int row0 = u.pm * BM + wr * 64 + fr, col0 = u.pn * BM + wc * 32 + 4 * fq;
#pragma unroll
        for (int ai = 0; ai < 2; ++ai)
#pragma unroll
            for (int m = 0; m < 4; ++m) { const size_t off = (size_t)(row0 + ai * HALF + m * 16) * DM + col0;
#pragma unroll
                for (int bj = 0; bj < 2; ++bj)
#pragma unroll
                    for (int n = 0; n < 2; ++n) { const f32x4 xv = *(const f32x4*)(X + off + bj * HALF + n * 16);
                        *(f32x4*)(U + off + bj * HALF + n * 16) = xv * DN_ALPHA + acc[ai][bj][m][n]; } }
    }
};
struct EpiSwiglu {
    static constexpr bool PERM = true;
    bf16_t* O;
    __device__ __forceinline__ void operator()(const f32x4 (&acc)[2][2][4][2], const Unit& u, int wr, int wc, int fr, int fq) const {
        const int row0 = u.pm * BM + wr * 64 + fr, col0 = u.pn * HALF + wc * 32 + 8 * fq;
#pragma unroll
        for (int ai = 0; ai < 2; ++ai)
#pragma unroll
            for (int m = 0; m < 4; ++m) { bf16_t* rowp = O + (size_t)(row0 + ai * HALF + m * 16) * DEXP + col0;
                float r[8];
#pragma unroll
                for (int n = 0; n < 2; ++n)
#pragma unroll
                    for (int j = 0; j < 4; ++j) { const float g = acc[ai][0][m][n][j], up = acc[ai][1][m][n][j]; r[n * 4 + j] = g / (1.0f + __expf(-g)) * up; }
                u32x4 w; w.x = cvt_pk_bf16(r[0], r[1]); w.y = cvt_pk_bf16(r[2], r[3]); w.z = cvt_pk_bf16(r[4], r[5]); w.w = cvt_pk_bf16(r[6], r[7]);
                *(u32x4*)rowp = w; }
    }
};
}

__device__ __forceinline__ float reduce16_wave(const float (&v)[16], int lane) {
    float a8[8];
#pragma unroll
    for (int i = 0; i < 8; ++i) { const float mine = (lane & 32) ? v[8 + i] : v[i], other = (lane & 32) ? v[i] : v[8 + i]; a8[i] = mine + __shfl_xor(other, 32); }
    float a4[4];
#pragma unroll
    for (int i = 0; i < 4; ++i) { const float mine = (lane & 16) ? a8[4 + i] : a8[i], other = (lane & 16) ? a8[i] : a8[4 + i]; a4[i] = mine + __shfl_xor(other, 16); }
    float a2[2];
#pragma unroll
    for (int i = 0; i < 2; ++i) { const float mine = (lane & 8) ? a4[2 + i] : a4[i], other = (lane & 8) ? a4[i] : a4[2 + i]; a2[i] = mine + __shfl_xor(other, 8); }
    float a1; { const float mine = (lane & 4) ? a2[1] : a2[0], other = (lane & 4) ? a2[0] : a2[1]; a1 = mine + __shfl_xor(other, 4); }
    a1 += dppf<0x4E>(a1); a1 += dppf<0xB1>(a1);
    return a1;
}
__device__ __forceinline__ void tr_tile(LAS float* tile  , const float* src, int ld, int k0, int c0, int ncols_valid, bf16_t* dst, int dstK, int drow0, int tid) {
    {
        const int r = tid >> 3, cc = (tid & 7) * 8;
        const float* sp = src + (size_t)(k0 + r) * ld + c0 + cc;
        if (c0 + cc + 8 <= ncols_valid) {
            const f32x4 a = *(const f32x4*)sp, b = *(const f32x4*)(sp + 4);
#pragma unroll
            for (int j = 0; j < 4; ++j) { tile[r * 65 + cc + j] = a[j]; tile[r * 65 + cc + 4 + j] = b[j]; }
        } else {
#pragma unroll
            for (int j = 0; j < 8; ++j) tile[r * 65 + cc + j] = (c0 + cc + j < ncols_valid) ? sp[j] : 0.f;
        }
    }
    __syncthreads();
    {
        const int n = tid >> 3, kk = (tid & 7) * 8;
        u32x4 w;
        w.x = cvt_pk_bf16(tile[(kk + 0) * 65 + n], tile[(kk + 1) * 65 + n]); w.y = cvt_pk_bf16(tile[(kk + 2) * 65 + n], tile[(kk + 3) * 65 + n]);
        w.z = cvt_pk_bf16(tile[(kk + 4) * 65 + n], tile[(kk + 5) * 65 + n]); w.w = cvt_pk_bf16(tile[(kk + 6) * 65 + n], tile[(kk + 7) * 65 + n]);
        *(u32x4*)(dst + (size_t)(drow0 + n) * dstK + k0 + kk) = w;
    }
    __syncthreads();
}

__device__ __forceinline__ void phase_prep(const Params& p, LAS unsigned char* lds, int bid, int nb, int part) {
    const int tid = opaque_tid();
    LAS float* tile = (LAS float*)lds;
    unsigned char* ws = p.ws;
    const int T0 = 832, T1 = T0 + 256, T2 = T1 + 448, T3 = T2 + 256, T4 = T3 + 2048, T5 = T4 + 2048, T6 = T5 + 2048, T7 = T6 + 32;
    if (part == 0) {
        for (int t0 = bid; t0 < T0 + 32; t0 += nb) {
            const int t = t0 < T0 ? t0 : T6 + (t0 - T0);
            if (t >= T6) { const int q = t - T6;
                if (q < 8) tr_tile(tile, p.in[I_AW2], 512, 0, q * 64, 512, (bf16_t*)(ws + OFF_MISC + MISC_W2T), 64, q * 64, tid);
                else if (q < 16) tr_tile(tile, p.in[I_AA2], 512, 0, (q - 8) * 64, 512, (bf16_t*)(ws + OFF_MISC + MISC_A2T), 64, (q - 8) * 64, tid);
                else { const int r = q - 16; tr_tile(tile, p.in[I_AG2], 512, (r >> 3) * 64, (r & 7) * 64, 512, (bf16_t*)(ws + OFF_MISC + MISC_G2T), 128, (r & 7) * 64, tid); }
                continue; }
            { const int kt = t / 52, ct = t % 52; tr_tile(tile, p.in[I_WINE], EVEN_COLS, kt * 64, ct * 64, EVEN_COLS, (bf16_t*)(ws + OFF_WINE), 1024, ct * 64, tid); }
        }
        __syncthreads();
        {
            const int wid = tid >> 6, lane = tid & 63;
            LAS float* wT = (LAS float*)lds;
            for (int i = tid; i < 16 * 1024; i += 512) { const int e_ = i & 15, k = i >> 4; wT[e_ * 1024 + k] = p.in[I_WINE][(size_t)k * EVEN_COLS + NE_MAIN + e_]; }
            __syncthreads();
            const float* x = p.in[I_X]; bf16_t* xb = (bf16_t*)(ws + OFF_BUF64); float* xa = (float*)(ws + OFF_U);
            for (int tok = bid * 8 + wid; tok < NTOK; tok += nb * 8) {
                f32x4 v[4];
                asm volatile("" ::: "memory");
#pragma unroll
                for (int j = 0; j < 4; ++j) { v[j] = *(const f32x4*)(x + (size_t)tok * DM + j * 256 + lane * 4);
                    u32x2 w; w.x = cvt_pk_bf16(v[j][0], v[j][1]); w.y = cvt_pk_bf16(v[j][2], v[j][3]); *(u32x2*)(xb + (size_t)tok * DM + j * 256 + lane * 4) = w; }
                float part_[16];
#pragma unroll
                for (int e_ = 0; e_ < 16; ++e_) { float a = 0.f;
#pragma unroll
                    for (int j = 0; j < 4; ++j) { const f32x4 w = *(const LAS f32x4*)(wT + e_ * 1024 + j * 256 + lane * 4); a += (v[j][0] * w[0] + v[j][1] * w[1]) + (v[j][2] * w[2] + v[j][3] * w[3]); }
                    part_[e_] = a; }
                const float r = reduce16_wave(part_, lane);
                if ((lane & 3) == 0) xa[(size_t)tok * 16 + ((lane >> 5) & 1) * 8 + ((lane >> 4) & 1) * 4 + ((lane >> 3) & 1) * 2 + ((lane >> 2) & 1)] = r;
            }
            __syncthreads();
        }
        if (bid == 0 && tid < 64) ((int*)(ws + OFF_MISC + MISC_CNT))[tid] = 0;
        if (bid == 1) for (int i = tid; i < (16384 + 64) / 4; i += 512) ((unsigned*)(ws + OFF_MISC + MISC_RWF))[i] = 0u;
        return;
    }
    unsigned* pctr = (unsigned*)(ws + OFF_MISC + MISC_PCTR);
    LAS int* tsh = (LAS int*)(lds + 65536);
    for (;;) {
        __syncthreads();
        if (tid == 0) tsh[0] = (int)__hip_atomic_fetch_add(pctr, 8u, __ATOMIC_RELAXED, __HIP_MEMORY_SCOPE_AGENT);
        __syncthreads();
        const int tb = T0 + __builtin_amdgcn_readfirstlane(tsh[0]);
        if (tb >= T6) break;
#pragma unroll 1
      for (int t = tb; t < tb + 8 && t < T6; ++t) {
        if (t < T1) { const int q = t - T0, kt = q / 16, ct = q % 16; tr_tile(tile, p.in[I_WOUTE], 1024, kt * 64, ct * 64, 1024, (bf16_t*)(ws + OFF_WOUTE), 1024, ct * 64, tid); }
        else if (t < T2) { const int q = t - T1, kt = q / 28, ct = q % 28; tr_tile(tile, p.in[I_WINO], ODD_COLS, kt * 64, ct * 64, ODD_COLS, (bf16_t*)(ws + OFF_WINO), 1024, ct * 64, tid); }
        else if (t < T3) { const int q = t - T2, kt = q / 16, ct = q % 16; tr_tile(tile, p.in[I_WOUTO], 1024, kt * 64, ct * 64, 1024, (bf16_t*)(ws + OFF_WOUTO), 1024, ct * 64, tid); }
        else if (t < T5) { const bool up = t >= T4; const int q = t - (up ? T4 : T3), le = q / 64, r = q % 64, kt = r / 4, ct = r % 4;
            const int c0 = ct * 64, drow0 = (c0 / 128) * 256 + (up ? 128 : 0) + (c0 % 128);
            tr_tile(tile, p.in[up ? I_EU : I_EG] + (size_t)le * 1024 * 256, 256, kt * 64, c0, 256, (bf16_t*)(ws + OFF_WGU) + (size_t)le * 512 * 1024, 1024, drow0, tid); }
        else { const int q = t - T5, le = q / 64, r = q % 64, kt = r / 16, ct = r % 16;
            tr_tile(tile, p.in[I_ED] + (size_t)le * 256 * 1024, 1024, kt * 64, ct * 64, 1024, (bf16_t*)(ws + OFF_WD) + (size_t)le * 1024 * 256, 256, ct * 64, tid); }
      }
    }
    {
        float* c64 = (float*)(ws + OFF_ROPE); float* s64 = c64 + 4096 * 64; float* c32 = s64 + 4096 * 64; float* s32 = c32 + 4096 * 32;
        for (int i = bid * 512 + tid; i < 4096 * 64; i += nb * 512) { const int pos = i >> 6, j = i & 63; const float inv = powf(10000.0f, -(float)j / 64.0f); const float ang = (float)pos * inv; c64[i] = cosf(ang); s64[i] = sinf(ang); }
        for (int i = bid * 512 + tid; i < 4096 * 32; i += nb * 512) { const int pos = i >> 5, j = i & 31; const float inv = powf(10000.0f, -(float)j / 32.0f); const float ang = (float)pos * inv; c32[i] = cosf(ang); s32[i] = sinf(ang); }
    }
}

__device__ __forceinline__ void phase_ln_route(const Params& p, LAS unsigned char* lds, int bid, int nb, int layer) {
    const int tid = opaque_tid(), wid = tid >> 6, lane = tid & 63;
    unsigned char* ws = p.ws;
    LAS float* rwT = (LAS float*)lds;
    LAS int* sel = (LAS int*)(lds + 65536);
    LAS float* selg = (LAS float*)(lds + 65536 + 1024);
    LAS int* cntw = (LAS int*)(lds + 65536 + 2048);
    { const float* rw = p.in[I_RW];
        for (int i = tid; i < 16 * 1024; i += 512) { const int e = i >> 10, k = i & 1023; rwT[i] = rw[k * 16 + e]; } }
    __syncthreads();
    float* U = (float*)(ws + OFF_U); bf16_t* hb = (bf16_t*)(ws + OFF_BUF64);
    const float* g = p.in[I_LN1G] + layer * DM; const float* b = p.in[I_LN1B] + layer * DM;
    int* cnt = (int*)(ws + OFF_MISC + MISC_CNT) + layer * 16;
    int* tokinfo = (int*)(ws + OFF_MISC + MISC_TOKINFO); float* tokgate = (float*)(ws + OFF_MISC + MISC_TOKGATE); int* list = (int*)(ws + OFF_MISC + MISC_LIST);
    f32x4 gv[4], bv[4];
#pragma unroll
    for (int j = 0; j < 4; ++j) { gv[j] = *(const f32x4*)(g + j * 256 + lane * 4); bv[j] = *(const f32x4*)(b + j * 256 + lane * 4); }
    const float* rbp = p.in[I_RB];
    const float my_rb = rbp[((lane >> 5) & 1) * 8 + ((lane >> 4) & 1) * 4 + ((lane >> 3) & 1) * 2 + ((lane >> 2) & 1)];
    for (int blk = bid; blk < NTOK / 128; blk += nb) {
#pragma unroll 1
        for (int i = 0; i < 16; ++i) {
            const int tl = wid * 16 + i, tok = blk * 128 + tl;
            f32x4 v[4]; float s = 0.f;
            asm volatile("" ::: "memory");
#pragma unroll
            for (int j = 0; j < 4; ++j) { v[j] = *(const f32x4*)(U + (size_t)tok * DM + j * 256 + lane * 4); s += (v[j][0] + v[j][1]) + (v[j][2] + v[j][3]); }
            const float mean = wave_sum(s) * (1.0f / DM);
            float q = 0.f;
#pragma unroll
            for (int j = 0; j < 4; ++j) { v[j] -= mean; q += (v[j][0] * v[j][0] + v[j][1] * v[j][1]) + (v[j][2] * v[j][2] + v[j][3] * v[j][3]); }
            const float rstd = rsqrtf(wave_sum(q) * (1.0f / DM) + LN_EPS);
#pragma unroll
            for (int j = 0; j < 4; ++j) { v[j] = v[j] * rstd * gv[j] + bv[j];
                *(f32x4*)(U + (size_t)tok * DM + j * 256 + lane * 4) = v[j];
                u32x2 w; w.x = cvt_pk_bf16(v[j][0], v[j][1]); w.y = cvt_pk_bf16(v[j][2], v[j][3]);
                *(u32x2*)(hb + (size_t)tok * DM + j * 256 + lane * 4) = w; }
            float part[16];
#pragma unroll
            for (int e = 0; e < 16; ++e) { float a = 0.f;
#pragma unroll
                for (int j = 0; j < 4; ++j) { const f32x4 w = *(const LAS f32x4*)(rwT + e * 1024 + j * 256 + lane * 4); a += (v[j][0] * w[0] + v[j][1] * w[1]) + (v[j][2] * w[2] + v[j][3] * w[3]); }
                part[e] = a; }
            const float lgm = reduce16_wave(part, lane);
            const float sgm = 1.0f / (1.0f + expf(-lgm)), selm = sgm + my_rb;
            float sg[16], sl[16];
#pragma unroll
            for (int e = 0; e < 16; ++e) { const int L = ((e >> 3) & 1) * 32 + ((e >> 2) & 1) * 16 + ((e >> 1) & 1) * 8 + (e & 1) * 4;
                sg[e] = __builtin_bit_cast(float, __builtin_amdgcn_readlane(__builtin_bit_cast(int, sgm), L)); sl[e] = __builtin_bit_cast(float, __builtin_amdgcn_readlane(__builtin_bit_cast(int, selm), L)); }
            int best = 0; float bestv = -INFINITY;
#pragma unroll
            for (int gI = 0; gI < 4; ++gI) { float m1 = -INFINITY, m2 = -INFINITY;
#pragma unroll
                for (int j = 0; j < 4; ++j) { const float x = sl[gI * 4 + j]; if (x > m1) { m2 = m1; m1 = x; } else if (x > m2) m2 = x; }
                const float gs = m1 + m2; if (gs > bestv) { bestv = gs; best = gI; } }
            int e0 = 0, e1 = 0; float v0 = -INFINITY, v1 = -INFINITY, s0 = 0.f, s1 = 0.f;
#pragma unroll
            for (int e = 0; e < 16; ++e) { if ((e >> 2) == best) { const float x = sl[e];
                    if (x > v0) { v1 = v0; e1 = e0; s1 = s0; v0 = x; e0 = e; s0 = sg[e]; } else if (x > v1) { v1 = x; e1 = e; s1 = sg[e]; } } }
            const float gsum = s0 + s1;
            if (lane == 0) { sel[tl * 2] = e0; sel[tl * 2 + 1] = e1; selg[tl * 2] = s0 / gsum; selg[tl * 2 + 1] = s1 / gsum; }
        }
        __syncthreads();
        int myE = -1, myRank = 0;
        if (tid < 256) { myE = sel[tid];
#pragma unroll
            for (int e = 0; e < 16; ++e) { const unsigned long long mk = __ballot(myE == e); if (myE == e) myRank = __popcll(mk & ((1ull << lane) - 1ull)); if (lane == 0) cntw[wid * 16 + e] = __popcll(mk); } }
        __syncthreads();
        if (tid < 16) { const int c0 = cntw[tid], c1 = cntw[16 + tid], c2 = cntw[32 + tid], c3 = cntw[48 + tid];
            const int basev = atomicAdd(cnt + tid, c0 + c1 + c2 + c3);
            cntw[64 + tid] = basev; cntw[80 + tid] = basev + c0; cntw[96 + tid] = basev + c0 + c1; cntw[112 + tid] = basev + c0 + c1 + c2; }
        __syncthreads();
        if (tid < 256) { const int slot = cntw[64 + wid * 16 + myE] + myRank; const int tok = blk * 128 + (tid >> 1), k = tid & 1;
            list[myE * NTOK + slot] = tok; tokinfo[tok * 4 + k * 2] = myE; tokinfo[tok * 4 + k * 2 + 1] = slot; tokgate[tok * 2 + k] = selg[tid]; }
        __syncthreads();
    }
}

__device__ __forceinline__ void phase_ln2(const Params& p, int bid, int nb, int layer, float* dst, bool with_moe) {
    const int tid = opaque_tid(), wid = tid >> 6, lane = tid & 63;
    unsigned char* ws = p.ws;
    const float* U = (const float*)(ws + OFF_U); bf16_t* xb = (bf16_t*)(ws + OFF_BUF64);
    const bf16_t* he = (const bf16_t*)(ws + OFF_HE);
    const float* g = p.in[I_LN2G] + layer * DM; const float* b = p.in[I_LN2B] + layer * DM;
    const int* cnt = (const int*)(ws + OFF_MISC + MISC_CNT) + layer * 16;
    const int* tokinfo = (const int*)(ws + OFF_MISC + MISC_TOKINFO); const float* tokgate = (const float*)(ws + OFF_MISC + MISC_TOKGATE);
    int rowbase[16]; { int a = 0;
#pragma unroll
        for (int e = 0; e < 16; ++e) { rowbase[e] = a; a += ((cnt[e] + 255) >> 8) << 8; } }
    f32x4 gv[4], bv[4];
#pragma unroll
    for (int j = 0; j < 4; ++j) { gv[j] = *(const f32x4*)(g + j * 256 + lane * 4); bv[j] = *(const f32x4*)(b + j * 256 + lane * 4); }
    for (int tok = bid * 8 + wid; tok < NTOK; tok += nb * 8) {
        f32x4 v[4]; float s = 0.f;
        int r0 = 0, r1 = 0; float g0 = 0.f, g1 = 0.f;
        if (with_moe) { const int e0 = tokinfo[tok * 4 + 0], sl0 = tokinfo[tok * 4 + 1], e1 = tokinfo[tok * 4 + 2], sl1 = tokinfo[tok * 4 + 3];
            int rb0 = 0, rb1 = 0;
#pragma unroll
            for (int e = 0; e < 16; ++e) { if (e == e0) rb0 = rowbase[e]; if (e == e1) rb1 = rowbase[e]; }
            r0 = rb0 + sl0; r1 = rb1 + sl1; g0 = tokgate[tok * 2 + 0]; g1 = tokgate[tok * 2 + 1]; }
#pragma unroll
        for (int j = 0; j < 4; ++j) { v[j] = *(const f32x4*)(U + (size_t)tok * DM + j * 256 + lane * 4) * DN_ALPHA;
            if (with_moe) { const u32x2 a = *(const u32x2*)(he + (size_t)r0 * DM + j * 256 + lane * 4), c = *(const u32x2*)(he + (size_t)r1 * DM + j * 256 + lane * 4);
                v[j][0] += g0 * __uint_as_float(a.x << 16) + g1 * __uint_as_float(c.x << 16); v[j][1] += g0 * __uint_as_float(a.x & 0xffff0000u) + g1 * __uint_as_float(c.x & 0xffff0000u);
                v[j][2] += g0 * __uint_as_float(a.y << 16) + g1 * __uint_as_float(c.y << 16); v[j][3] += g0 * __uint_as_float(a.y & 0xffff0000u) + g1 * __uint_as_float(c.y & 0xffff0000u); }
            s += (v[j][0] + v[j][1]) + (v[j][2] + v[j][3]); }
        const float mean = wave_sum(s) * (1.0f / DM);
        float q = 0.f;
#pragma unroll
        for (int j = 0; j < 4; ++j) { v[j] -= mean; q += (v[j][0] * v[j][0] + v[j][1] * v[j][1]) + (v[j][2] * v[j][2] + v[j][3] * v[j][3]); }
        const float rstd = rsqrtf(wave_sum(q) * (1.0f / DM) + LN_EPS);
#pragma unroll
        for (int j = 0; j < 4; ++j) { v[j] = v[j] * rstd * gv[j] + bv[j];
#if PROBE_ID
            if (layer == 1) v[j] = v[j] * (1.0f + *(const float*)(ws + OFF_MISC + MISC_PROBE));
#endif
            *(f32x4*)(dst + (size_t)tok * DM + j * 256 + lane * 4) = v[j];
            u32x2 w; w.x = cvt_pk_bf16(v[j][0], v[j][1]); w.y = cvt_pk_bf16(v[j][2], v[j][3]);
            *(u32x2*)(xb + (size_t)tok * DM + j * 256 + lane * 4) = w; }
    }
}

__device__ __forceinline__ void phase_resid_only(const Params& p, const float* X, int bid, int nb) {
    float* U = (float*)(p.ws + OFF_U);
    const size_t n4 = (size_t)NTOK * DM / 4;
    for (size_t i = (size_t)bid * 512 + threadIdx.x; i < n4; i += (size_t)nb * 512) *(f32x4*)(U + i * 4) = *(const f32x4*)(X + i * 4) * DN_ALPHA;
}

__device__ __forceinline__ void phase_moe_gateup(const Params& p, LAS unsigned char* lds, int bid, int nb, int layer) {
    unsigned char* ws = p.ws;
    LAS int* tab = (LAS int*)(lds + pg::STAGE_BYTES);
    pg::moe_build_units(tab, (const int*)(ws + OFF_MISC + MISC_CNT) + layer * 16, 2, nb, bid);
    pg::MoeSched<true> S; S.init(ws + OFF_BUF64, ws + OFF_WGU + (size_t)layer * 16 * 512 * 1024 * 2, (size_t)512 * 1024 * 2, (const int*)(ws + OFF_MISC + MISC_LIST), 1024, tab);
    pg::EpiSwiglu E; E.O = (bf16_t*)(ws + OFF_ACT);
    pg::gemm_phase(lds, 1024, S, E);
}
__device__ __forceinline__ void phase_moe_down(const Params& p, LAS unsigned char* lds, int bid, int nb, int layer) {
    unsigned char* ws = p.ws;
    LAS int* tab = (LAS int*)(lds + pg::STAGE_BYTES);
    pg::moe_build_units(tab, (const int*)(ws + OFF_MISC + MISC_CNT) + layer * 16, 4, nb, bid);
    pg::MoeSched<false> S; S.init(ws + OFF_ACT, ws + OFF_WD + (size_t)layer * 16 * 1024 * 256 * 2, (size_t)1024 * 256 * 2, nullptr, 256, tab);
    pg::EpiBf16 E; E.O = (bf16_t*)(ws + OFF_HE); E.ldc = 1024;
    pg::gemm_phase(lds, 256, S, E);
}

__device__ __forceinline__ void phase_gla_alpha(const Params& p, LAS unsigned char* lds, int bid, int nb) {
    const int tid = opaque_tid(), wid = tid >> 6, lane = tid & 63;
    LAS float* wT = (LAS float*)lds;
    for (int i = tid; i < 16 * 1024; i += 512) { const int e = i & 15, k = i >> 4; wT[e * 1024 + k] = p.in[I_WINE][(size_t)k * EVEN_COLS + NE_MAIN + e]; }
    __syncthreads();
    const float* x = p.in[I_X]; float* xa = (float*)(p.ws + OFF_U);
    for (int tok = bid * 8 + wid; tok < NTOK; tok += nb * 8) {
        f32x4 v[4];
        asm volatile("" ::: "memory");
#pragma unroll
        for (int j = 0; j < 4; ++j) v[j] = *(const f32x4*)(x + (size_t)tok * DM + j * 256 + lane * 4);
        float part[16];
#pragma unroll
        for (int e = 0; e < 16; ++e) { float a = 0.f;
#pragma unroll
            for (int j = 0; j < 4; ++j) { const f32x4 w = *(const LAS f32x4*)(wT + e * 1024 + j * 256 + lane * 4); a += (v[j][0] * w[0] + v[j][1] * w[1]) + (v[j][2] * w[2] + v[j][3] * w[3]); }
            part[e] = a; }
        const float r = reduce16_wave(part, lane);
        if ((lane & 3) == 0) xa[(size_t)tok * 16 + ((lane >> 5) & 1) * 8 + ((lane >> 4) & 1) * 4 + ((lane >> 3) & 1) * 2 + ((lane >> 2) & 1)] = r;
    }
    __syncthreads();
}

__device__ __forceinline__ float red8(float v) { v += dppf<0xB1>(v); v += dppf<0x4E>(v); v += dppf<0x141>(v); return v; }

__device__ __forceinline__ void rwkv_item(const Params& p, LAS unsigned char* lds, int item) {
    constexpr int TC = 16;
    const int tid = opaque_tid(), lane = tid & 63, tg = tid >> 6;
    const int b = item >> 3, h = item & 7;
    const bf16_t* P0 = (const bf16_t*)(p.ws + OFF_P);
    bf16_t* mix = (bf16_t*)(p.ws + OFF_BUF64);
    LAS float* w2s = (LAS float*)lds;
    LAS float* a2s = w2s + 64 * 64;
    LAS float* g2s = a2s + 64 * 64;
    LAS float* tw = g2s + 128 * 64;
    LAS float* xa_s = tw + TC * 64;
    LAS float* sg = xa_s + TC * 64;
    LAS float* r_s = sg + TC * 128;
    LAS float* k_s = r_s + TC * 64;
    LAS float* v_s = k_s + TC * 64;
    LAS float* w_s = v_s + TC * 64;
    LAS float* kk_s = w_s + TC * 64;
    LAS float* kka_s = kk_s + TC * 64;
    LAS float* kh_s = kka_s + TC * 64;
    LAS float* g_s = kh_s + TC * 64;
    LAS float* y_s = g_s + TC * 64;
    LAS float* rk_s = y_s + TC * 64;
    const float* mu = p.in[I_AMU];
    for (int i = tid; i < 64 * 64; i += 512) { const int r = i >> 6, c = i & 63; w2s[i] = p.in[I_AW2][r * 512 + h * 64 + c]; a2s[i] = p.in[I_AA2][r * 512 + h * 64 + c]; }
    for (int i = tid; i < 128 * 64; i += 512) { const int r = i >> 6, c = i & 63; g2s[i] = p.in[I_AG2][r * 512 + h * 64 + c]; }
    const int j = lane;
    const float w0 = p.in[I_AW0][h * 64 + j], a0 = p.in[I_AA0][h * 64 + j], kksc = p.in[I_AKK][h * 64 + j], kasc = p.in[I_AKA][h * 64 + j], rkj = p.in[I_ARK][h * 64 + j];
    const float gng = p.in[I_AGNG][h * 64 + j], gnb = p.in[I_AGNB][h * 64 + j];
    float S[8];
#pragma unroll
    for (int i = 0; i < 8; ++i) S[i] = 0.f;
    const int row = tid >> 3, kq = tid & 7;
    __syncthreads();
    for (int t0 = 0; t0 < SEQ; t0 += TC) {
        for (int idx = tid; idx < TC * 448; idx += 512) {
            const int t = idx / 448, c = idx % 448; int col; LAS float* dst; int kind = 0;
            if (c < 64) { col = h * 64 + c; dst = r_s + t * 64 + c; }
            else if (c < 128) { col = 512 + h * 64 + (c - 64); dst = k_s + t * 64 + (c - 64); }
            else if (c < 192) { col = 1024 + h * 64 + (c - 128); dst = v_s + t * 64 + (c - 128); }
            else if (c < 256) { col = 1536 + (c - 192); dst = tw + t * 64 + (c - 192); kind = 1; }
            else if (c < 320) { col = 1600 + (c - 256); dst = xa_s + t * 64 + (c - 256); }
            else { col = 1664 + (c - 320); dst = sg + t * 128 + (c - 320); kind = 2; }
            const size_t n = (size_t)b * SEQ + t0 + t;
            const float cur = bf2f(P0[n * NE_MAIN + col]);
            const float prev = (t0 + t) > 0 ? bf2f(P0[(n - 1) * NE_MAIN + col]) : 0.f;
            float val = cur + (prev - cur) * mu[col];
            if (kind == 1) val = tanhf(val); else if (kind == 2) val = 1.0f / (1.0f + expf(-val));
            *dst = val;
        }
        __syncthreads();
#pragma unroll
        for (int tt = 0; tt < 2; ++tt) {
            const int t = tg + tt * 8;
            float aw = 0.f, aa = 0.f, ag = 0.f;
            asm volatile("" ::: "memory");
#pragma unroll 4
            for (int i = 0; i < 64; ++i) { aw += tw[t * 64 + i] * w2s[i * 64 + j]; aa += xa_s[t * 64 + i] * a2s[i * 64 + j]; }
            asm volatile("" ::: "memory");
#pragma unroll 4
            for (int i = 0; i < 128; ++i) ag += sg[t * 128 + i] * g2s[i * 64 + j];
            asm volatile("" ::: "memory");
            const float z = w0 + aw;
            const float sp = (-z > 20.f) ? -z : log1pf(expf(-z));
            const float wlog = -sp - 0.5f;
            const float decay = expf(-expf(wlog));
            const float a = 1.0f / (1.0f + expf(-(a0 + aa)));
            const float kraw = k_s[t * 64 + j];
            const float kkp = kraw * kksc;
            const float nrm = sqrtf(wave_sum(kkp * kkp));
            const float kk = kkp / fmaxf(nrm, 1e-12f);
            const float kh = kraw * (1.0f + (a - 1.0f) * kasc);
            const float rr = r_s[t * 64 + j];
            const float rk = wave_sum(rr * kh * rkj);
            w_s[t * 64 + j] = decay; kk_s[t * 64 + j] = kk; kka_s[t * 64 + j] = kk * a; kh_s[t * 64 + j] = kh; g_s[t * 64 + j] = ag;
            if (j == 0) rk_s[t] = rk;
        }
        __syncthreads();
        for (int t = 0; t < TC; ++t) {
            const f32x4 kk0 = *(const LAS f32x4*)(kk_s + t * 64 + kq * 8), kk1 = *(const LAS f32x4*)(kk_s + t * 64 + kq * 8 + 4);
            const f32x4 ww0 = *(const LAS f32x4*)(w_s + t * 64 + kq * 8), ww1 = *(const LAS f32x4*)(w_s + t * 64 + kq * 8 + 4);
            const f32x4 ka0 = *(const LAS f32x4*)(kka_s + t * 64 + kq * 8), ka1 = *(const LAS f32x4*)(kka_s + t * 64 + kq * 8 + 4);
            const f32x4 kh0 = *(const LAS f32x4*)(kh_s + t * 64 + kq * 8), kh1 = *(const LAS f32x4*)(kh_s + t * 64 + kq * 8 + 4);
            const f32x4 rr0 = *(const LAS f32x4*)(r_s + t * 64 + kq * 8), rr1 = *(const LAS f32x4*)(r_s + t * 64 + kq * 8 + 4);
            const float vv = v_s[t * 64 + row];
            float sa = 0.f;
#pragma unroll
            for (int i = 0; i < 4; ++i) { sa += S[i] * kk0[i]; sa += S[4 + i] * kk1[i]; }
            sa = red8(sa);
            float y = 0.f;
#pragma unroll
            for (int i = 0; i < 4; ++i) {
                S[i] = S[i] * ww0[i] - sa * ka0[i] + vv * kh0[i]; S[4 + i] = S[4 + i] * ww1[i] - sa * ka1[i] + vv * kh1[i];
                y += S[i] * rr0[i]; y += S[4 + i] * rr1[i]; }
            y = red8(y);
            if (kq == 0) y_s[t * 64 + row] = y;
        }
        __syncthreads();
#pragma unroll
        for (int tt = 0; tt < 2; ++tt) {
            const int t = tg + tt * 8;
            const float y = y_s[t * 64 + j];
            const float mean = wave_sum(y) * (1.0f / 64.0f);
            const float d = y - mean;
            const float var = wave_sum(d * d) * (1.0f / 64.0f);
            const float yn = d * rsqrtf(var + 64e-5f) * gng + gnb;
            const float o = (yn + rk_s[t] * v_s[t * 64 + j]) * g_s[t * 64 + j];
            mix[((size_t)b * SEQ + t0 + t) * DM + h * 64 + j] = f2bf(o);
        }
        __syncthreads();
    }
}

__device__ __forceinline__ void gla_item(const Params& p, LAS unsigned char* lds, int item) {
    const int tid = opaque_tid(), lane = tid & 63, tg = tid >> 6;
    const int b = item >> 2, h = item & 3;
    const bf16_t* P0 = (const bf16_t*)(p.ws + OFF_P) + 1792;
    const float* xa16 = (const float*)(p.ws + OFF_U);
    bf16_t* mix = (bf16_t*)(p.ws + OFF_BUF64);
    LAS float* qd = (LAS float*)lds;
    LAS float* ki = qd + 64 * 65;
    LAS float* att = ki + 64 * 65;
    LAS float* vs = att + 64 * 65;
    LAS float* St = vs + 64 * 128;
    LAS float* bl = St + 64 * 128;
    for (int i = tid; i < 64 * 128; i += 512) St[i] = 0.f;
    float gw2[16];
#pragma unroll
    for (int i = 0; i < 16; ++i) gw2[i] = p.in[I_BGW2][i * 256 + h * 64 + lane];
    const float gb = p.in[I_BGB][h * 64 + lane];
    const float* bng = p.in[I_BNG];
    __syncthreads();
    for (int c0 = 0; c0 < SEQ; c0 += 64) {
        const size_t n0 = (size_t)b * SEQ + c0;
        for (int tt = 0; tt < 8; ++tt) { const int c = tg * 8 + tt; float z = gb;
#pragma unroll
            for (int i = 0; i < 16; ++i) z += xa16[(n0 + c) * 16 + i] * gw2[i];
            const float ls = (z >= 0.f) ? -log1pf(expf(-z)) : (z - log1pf(expf(z)));
            att[c * 65 + lane] = ls * (1.0f / 16.0f); }
        for (int i = tid; i < 64 * 128; i += 512) { const int c = i >> 7, e = i & 127; vs[i] = bf2f(P0[(n0 + c) * NE_MAIN + 512 + h * 128 + e]); }
        __syncthreads();
        if (tid < 64) { float a = 0.f; for (int c = 0; c < 64; ++c) { a += att[c * 65 + tid]; att[c * 65 + tid] = a; } bl[tid] = a; }
        __syncthreads();
        for (int i = tid; i < 64 * 64; i += 512) { const int c = i >> 6, d = i & 63; const float bc = att[c * 65 + d];
            const float q = bf2f(P0[(n0 + c) * NE_MAIN + h * 64 + d]), k = bf2f(P0[(n0 + c) * NE_MAIN + 256 + h * 64 + d]);
            qd[c * 65 + d] = q * 0.125f * expf(bc); ki[c * 65 + d] = k * expf(-bc); }
        __syncthreads();
        { const int c = tid >> 3, sgp = tid & 7; float a[8];
#pragma unroll
            for (int i = 0; i < 8; ++i) a[i] = 0.f;
            for (int d = 0; d < 64; ++d) { const float qv = qd[c * 65 + d];
#pragma unroll
                for (int i = 0; i < 8; ++i) a[i] += qv * ki[(sgp * 8 + i) * 65 + d]; }
            __syncthreads();
#pragma unroll
            for (int i = 0; i < 8; ++i) att[c * 65 + sgp * 8 + i] = (sgp * 8 + i <= c) ? a[i] : 0.f; }
        __syncthreads();
        { const int c = tid >> 3, eg = tid & 7; float o[16];
#pragma unroll
            for (int i = 0; i < 16; ++i) o[i] = 0.f;
            for (int s = 0; s <= c; ++s) { const float a = att[c * 65 + s];
#pragma unroll
                for (int i = 0; i < 16; ++i) o[i] += a * vs[s * 128 + eg * 16 + i]; }
            for (int d = 0; d < 64; ++d) { const float qv = qd[c * 65 + d];
#pragma unroll
                for (int i = 0; i < 16; ++i) o[i] += qv * St[d * 128 + eg * 16 + i]; }
            float ss = 0.f;
#pragma unroll
            for (int i = 0; i < 16; ++i) ss += o[i] * o[i];
            ss = red8(ss);
            const float rs = rsqrtf(ss * (1.0f / 128.0f) + 1e-5f);
#pragma unroll
            for (int i = 0; i < 16; ++i) { const int e = eg * 16 + i; const float g = bf2f(P0[(n0 + c) * NE_MAIN + 1024 + h * 128 + e]);
                const float val = o[i] * rs * bng[h * 128 + e] * (g / (1.0f + expf(-g)));
                mix[(n0 + c) * DM + 512 + h * 128 + e] = f2bf(val); } }
        __syncthreads();
        { const int d = tid >> 3, eg = tid & 7; float a[16];
#pragma unroll
            for (int i = 0; i < 16; ++i) a[i] = St[d * 128 + eg * 16 + i];
            for (int c = 0; c < 64; ++c) { const float kv = ki[c * 65 + d];
#pragma unroll
                for (int i = 0; i < 16; ++i) a[i] += kv * vs[c * 128 + eg * 16 + i]; }
            const float eb = expf(bl[d]);
#pragma unroll
            for (int i = 0; i < 16; ++i) St[d * 128 + eg * 16 + i] = a[i] * eb; }
        __syncthreads();
    }
}

__device__ __forceinline__ float red16(float v) { v += dppf<0xB1>(v); v += dppf<0x4E>(v); v += dppf<0x141>(v); v += dppf<0x140>(v); return v; }
__device__ __forceinline__ void rwkv2_item(const Params& p, LAS unsigned char* lds, int item) {
    constexpr int TC = 32;
    const int tid = opaque_tid(), lane = tid & 63, wid = tid >> 6, fr = lane & 15, g = lane >> 4;
    const int b = item >> 4, h = (item >> 1) & 7, rq = item & 1;
    unsigned char* ws = p.ws;
    const bf16_t* P0 = (const bf16_t*)(ws + OFF_P);
    float* yraw = p.out;
    bf16_t* e1g = (bf16_t*)(p.out + (size_t)NTOK * 512);
    bf16_t* gg = e1g + (size_t)NTOK * 512;
    LAS float* kk_s = (LAS float*)lds;
    LAS float* w_s = kk_s + TC * 64;
    LAS float* b_s = w_s + TC * 64;
    LAS float* kh_s = b_s + TC * 64;
    LAS float* wr_s = kh_s + TC * 64;
    LAS float* wpre = wr_s + TC * 64;
    LAS float* apre = wpre + TC * 64;
    LAS float* gpre = apre + TC * 64;
    LAS float* v_s = gpre + TC * 32;
    LAS float* y_s = v_s + TC * 32;
    LAS float* sc_s = y_s + TC * 32;
    LAS unsigned char* tw_i = (LAS unsigned char*)(sc_s + TC * 2);
    LAS unsigned char* xa_i = tw_i + TC * 128;
    LAS unsigned char* sg_i = xa_i + TC * 128;
    const float* mu = p.in[I_AMU];
    const bf16_t* w2t = (const bf16_t*)(ws + OFF_MISC + MISC_W2T); const bf16_t* a2t = (const bf16_t*)(ws + OFF_MISC + MISC_A2T); const bf16_t* g2t = (const bf16_t*)(ws + OFF_MISC + MISC_G2T);
    const int mrt = wid >> 2, mct = wid & 3;
    bf16x8 wf[2], af[2], gf[4];
#pragma unroll
    for (int s = 0; s < 2; ++s) { wf[s] = *(const bf16x8*)(w2t + (size_t)(h * 64 + mct * 16 + fr) * 64 + s * 32 + g * 8); af[s] = *(const bf16x8*)(a2t + (size_t)(h * 64 + mct * 16 + fr) * 64 + s * 32 + g * 8); }
    const int grt = (wid >> 1) & 1, gct = wid & 1;
#pragma unroll
    for (int s = 0; s < 4; ++s) gf[s] = *(const bf16x8*)(g2t + (size_t)(h * 64 + rq * 32 + gct * 16 + fr) * 128 + s * 32 + g * 8);
    const int et = tid >> 4, ec = tid & 15;
    const f32x4 w0v = *(const f32x4*)(p.in[I_AW0] + h * 64 + ec * 4), a0v = *(const f32x4*)(p.in[I_AA0] + h * 64 + ec * 4);
    const f32x4 kksc = *(const f32x4*)(p.in[I_AKK] + h * 64 + ec * 4), kasc = *(const f32x4*)(p.in[I_AKA] + h * 64 + ec * 4), rkv = *(const f32x4*)(p.in[I_ARK] + h * 64 + ec * 4);
    const f32x4 mur = *(const f32x4*)(mu + h * 64 + ec * 4), muk = *(const f32x4*)(mu + 512 + h * 64 + ec * 4);
    const f32x2 muv = *(const f32x2*)(mu + 1024 + h * 64 + rq * 32 + ec * 2);
    const int p1tok0 = tid >> 5, p1cc = tid & 31, p1col = 1536 + p1cc * 8;
    const f32x4 p1m0 = *(const f32x4*)(mu + p1col), p1m1 = *(const f32x4*)(mu + p1col + 4);
    float S[4] = {0.f, 0.f, 0.f, 0.f};
    const int rl = wid * 4 + g, kq = fr;
    const size_t nb0 = (size_t)b * SEQ;
    u32x4 l_cu[2], l_pv[2]; u32x2 l_rc, l_kc, l_rp, l_kp; unsigned l_vc, l_vp;
#define RW_ISSUE(t0n) do { \
        _Pragma("unroll") for (int _i = 0; _i < 2; ++_i) { const size_t _n = nb0 + (t0n) + p1tok0 + _i * 16; \
            l_cu[_i] = *(const u32x4*)(P0 + _n * NE_MAIN + p1col); l_pv[_i] = uzero4(); \
            if ((t0n) + p1tok0 + _i * 16 > 0) l_pv[_i] = *(const u32x4*)(P0 + (_n - 1) * NE_MAIN + p1col); } \
        { const size_t _n = nb0 + (t0n) + et; const bool _hp = ((t0n) + et) > 0; \
            l_rc = *(const u32x2*)(P0 + _n * NE_MAIN + h * 64 + ec * 4); l_kc = *(const u32x2*)(P0 + _n * NE_MAIN + 512 + h * 64 + ec * 4); \
            l_vc = *(const unsigned*)(P0 + _n * NE_MAIN + 1024 + h * 64 + rq * 32 + ec * 2); \
            l_rp = (u32x2){0u, 0u}; l_kp = (u32x2){0u, 0u}; l_vp = 0u; \
            if (_hp) { l_rp = *(const u32x2*)(P0 + (_n - 1) * NE_MAIN + h * 64 + ec * 4); l_kp = *(const u32x2*)(P0 + (_n - 1) * NE_MAIN + 512 + h * 64 + ec * 4); \
                l_vp = *(const unsigned*)(P0 + (_n - 1) * NE_MAIN + 1024 + h * 64 + rq * 32 + ec * 2); } } } while (0)
#define MIX2(wc, wp, mA, mB, o0, o1) { const float c0 = __uint_as_float((wc) << 16), c1 = __uint_as_float((wc) & 0xffff0000u), q0 = __uint_as_float((wp) << 16), q1 = __uint_as_float((wp) & 0xffff0000u); o0 = c0 + (q0 - c0) * (mA); o1 = c1 + (q1 - c1) * (mB); }
    RW_ISSUE(0);
    for (int t0 = 0; t0 < SEQ; t0 += TC) {
#pragma unroll 1
        for (int prep_rep = 0; prep_rep < PREP_REP; ++prep_rep) {
#pragma unroll
        for (int i = 0; i < 2; ++i) {
            const int tok = p1tok0 + i * 16, cc = p1cc;
            const u32x4 cu = l_cu[i], pv = l_pv[i];
            float x[8];
            MIX2(cu.x, pv.x, p1m0[0], p1m0[1], x[0], x[1]) MIX2(cu.y, pv.y, p1m0[2], p1m0[3], x[2], x[3]) MIX2(cu.z, pv.z, p1m1[0], p1m1[1], x[4], x[5]) MIX2(cu.w, pv.w, p1m1[2], p1m1[3], x[6], x[7])
            if (cc < 8) {
#pragma unroll
                for (int j = 0; j < 8; ++j) x[j] = fast_tanh(x[j]); }
            else if (cc >= 16) {
#pragma unroll
                for (int j = 0; j < 8; ++j) x[j] = fast_sigmoid(x[j]); }
            u32x4 o; o.x = cvt_pk_bf16(x[0], x[1]); o.y = cvt_pk_bf16(x[2], x[3]); o.z = cvt_pk_bf16(x[4], x[5]); o.w = cvt_pk_bf16(x[6], x[7]);
            if (cc < 8) *(LAS u32x4*)(tw_i + tok * 128 + ((cc ^ (tok & 7)) * 16)) = o;
            else if (cc < 16) *(LAS u32x4*)(xa_i + tok * 128 + (((cc - 8) ^ (tok & 7)) * 16)) = o;
            else *(LAS u32x4*)(sg_i + tok * 256 + (((cc - 16) ^ (tok & 7)) * 16)) = o;
        }
        __syncthreads();
        {
            f32x4 dw = fzero4(), da = fzero4();
            const int row = mrt * 16 + fr;
#pragma unroll
            for (int s = 0; s < 2; ++s) {
                const bf16x8 ta = *(const LAS bf16x8*)(tw_i + row * 128 + (((s * 4 + g) ^ (row & 7)) * 16));
                const bf16x8 xa = *(const LAS bf16x8*)(xa_i + row * 128 + (((s * 4 + g) ^ (row & 7)) * 16));
                dw = __builtin_amdgcn_mfma_f32_16x16x32_bf16(ta, wf[s], dw, 0, 0, 0);
                da = __builtin_amdgcn_mfma_f32_16x16x32_bf16(xa, af[s], da, 0, 0, 0);
            }
#pragma unroll
            for (int r = 0; r < 4; ++r) { wpre[(mrt * 16 + g * 4 + r) * 64 + mct * 16 + fr] = dw[r]; apre[(mrt * 16 + g * 4 + r) * 64 + mct * 16 + fr] = da[r]; }
            if (wid < 4) {
                f32x4 dg = fzero4();
                const int grow = grt * 16 + fr;
#pragma unroll
                for (int s = 0; s < 4; ++s) { const bf16x8 sa_ = *(const LAS bf16x8*)(sg_i + grow * 256 + (((s * 4 + g) ^ (grow & 7)) * 16));
                    dg = __builtin_amdgcn_mfma_f32_16x16x32_bf16(sa_, gf[s], dg, 0, 0, 0); }
#pragma unroll
                for (int r = 0; r < 4; ++r) gpre[(grt * 16 + g * 4 + r) * 32 + gct * 16 + fr] = dg[r];
            }
        }
        __syncthreads();
        {
            const size_t n = nb0 + t0 + et;
            float rr[4], kr_[4];
            MIX2(l_rc.x, l_rp.x, mur[0], mur[1], rr[0], rr[1]) MIX2(l_rc.y, l_rp.y, mur[2], mur[3], rr[2], rr[3])
            MIX2(l_kc.x, l_kp.x, muk[0], muk[1], kr_[0], kr_[1]) MIX2(l_kc.y, l_kp.y, muk[2], muk[3], kr_[2], kr_[3])
            const f32x4 wp = *(const LAS f32x4*)(wpre + et * 64 + ec * 4), ap = *(const LAS f32x4*)(apre + et * 64 + ec * 4);
            float dec[4], aa[4], kkp[4], nsq = 0.f;
#pragma unroll
            for (int j = 0; j < 4; ++j) { const float z = w0v[j] + wp[j]; const float sp = __logf(1.0f + __expf(-z));
                dec[j] = __expf(-__expf(-sp - 0.5f)); aa[j] = fast_sigmoid(a0v[j] + ap[j]); kkp[j] = kr_[j] * kksc[j]; nsq += kkp[j] * kkp[j]; }
            nsq = red16(nsq);
            const float inrm = 1.0f / fmaxf(sqrtf(nsq), 1e-12f);
            f32x4 kkv, bv, khv, wrv, wv; float br = 0.f, kr2 = 0.f, rk = 0.f;
#pragma unroll
            for (int j = 0; j < 4; ++j) { const float kk = kkp[j] * inrm; const float kh = kr_[j] * (1.0f + (aa[j] - 1.0f) * kasc[j]); const float bb = kk * aa[j];
                kkv[j] = kk; bv[j] = bb; khv[j] = kh; wv[j] = dec[j]; wrv[j] = dec[j] * rr[j]; br += bb * rr[j]; kr2 += kh * rr[j]; rk += rr[j] * kh * rkv[j]; }
            br = red16(br); kr2 = red16(kr2); rk = red16(rk);
            *(LAS f32x4*)(kk_s + et * 64 + ec * 4) = kkv; *(LAS f32x4*)(w_s + et * 64 + ec * 4) = wv; *(LAS f32x4*)(b_s + et * 64 + ec * 4) = bv;
            *(LAS f32x4*)(kh_s + et * 64 + ec * 4) = khv; *(LAS f32x4*)(wr_s + et * 64 + ec * 4) = wrv;
            if (ec == 0) { sc_s[et * 2] = br; sc_s[et * 2 + 1] = kr2; }
            float v0, v1; MIX2(l_vc, l_vp, muv[0], muv[1], v0, v1)
            *(LAS f32x2*)(v_s + et * 32 + ec * 2) = (f32x2){v0, v1};
            const f32x2 gp = *(const LAS f32x2*)(gpre + et * 32 + ec * 2);
            *(unsigned*)(e1g + n * 512 + h * 64 + rq * 32 + ec * 2) = cvt_pk_bf16(rk * v0, rk * v1);
            *(unsigned*)(gg + n * 512 + h * 64 + rq * 32 + ec * 2) = cvt_pk_bf16(gp[0], gp[1]);
        }
        if (prep_rep + 1 < PREP_REP) __syncthreads();
        }
        if (t0 + TC < SEQ) RW_ISSUE(t0 + TC);
        __syncthreads();
        {
            f32x4 kkA = *(const LAS f32x4*)(kk_s + kq * 4), wrA = *(const LAS f32x4*)(wr_s + kq * 4), wwA = *(const LAS f32x4*)(w_s + kq * 4), bbA = *(const LAS f32x4*)(b_s + kq * 4), khA = *(const LAS f32x4*)(kh_s + kq * 4);
            float vvA = v_s[rl]; f32x2 scA = *(const LAS f32x2*)(sc_s);
            float yacc = 0.f;
#pragma unroll 1
            for (int t = 0; t < TC; ++t) {
                const int tn = (t + 1) & (TC - 1);
                const f32x4 kkB = *(const LAS f32x4*)(kk_s + tn * 64 + kq * 4), wrB = *(const LAS f32x4*)(wr_s + tn * 64 + kq * 4), wwB = *(const LAS f32x4*)(w_s + tn * 64 + kq * 4);
                const f32x4 bbB = *(const LAS f32x4*)(b_s + tn * 64 + kq * 4), khB = *(const LAS f32x4*)(kh_s + tn * 64 + kq * 4);
                const float vvB = v_s[tn * 32 + rl]; const f32x2 scB = *(const LAS f32x2*)(sc_s + tn * 2);
                float sa = S[0] * kkA[0] + S[1] * kkA[1] + S[2] * kkA[2] + S[3] * kkA[3];
                float yy = S[0] * wrA[0] + S[1] * wrA[1] + S[2] * wrA[2] + S[3] * wrA[3];
                sa = red16(sa); yy = red16(yy);
                const float y = yy - sa * scA[0] + vvA * scA[1];
                yacc = (kq == (t & 15)) ? y : yacc;
#pragma unroll
                for (int i = 0; i < 4; ++i) S[i] = S[i] * wwA[i] + (vvA * khA[i] - sa * bbA[i]);
                if ((t & 15) == 15) y_s[((t & 16) + kq) * 32 + rl] = yacc;
                kkA = kkB; wrA = wrB; wwA = wwB; bbA = bbB; khA = khB; vvA = vvB; scA = scB;
            }
        }
        __syncthreads();
        { const int tok = tid >> 4, c2 = (tid & 15) * 2; *(f32x2*)(yraw + (nb0 + t0 + tok) * 512 + h * 64 + rq * 32 + c2) = *(const LAS f32x2*)(y_s + tok * 32 + c2); }
    }
#undef MIX2
#undef RW_ISSUE
}

constexpr size_t OFF_ACT256 = OFF_U + 4 * MiB;
__device__ __forceinline__ void phase_lora_act(const Params& p, int bid, int nb) {
    const int tid = opaque_tid();
    const bf16_t* P0 = (const bf16_t*)(p.ws + OFF_P); bf16_t* act = (bf16_t*)(p.ws + OFF_ACT256);
    const float* mu = p.in[I_AMU];
    const int cc = tid & 31, col = 1536 + cc * 8;
    const f32x4 m0 = *(const f32x4*)(mu + col), m1 = *(const f32x4*)(mu + col + 4);
    for (int n = bid * 16 + (tid >> 5); n < NTOK; n += nb * 16) {
        const u32x4 cu = *(const u32x4*)(P0 + (size_t)n * NE_MAIN + col); u32x4 pv = uzero4(); if ((n & (SEQ - 1)) > 0) pv = *(const u32x4*)(P0 + (size_t)(n - 1) * NE_MAIN + col);
        const unsigned cw[4] = {cu.x, cu.y, cu.z, cu.w}, pw[4] = {pv.x, pv.y, pv.z, pv.w}; float x[8];
#pragma unroll
        for (int j = 0; j < 4; ++j) { const float c0 = __uint_as_float(cw[j] << 16), c1 = __uint_as_float(cw[j] & 0xffff0000u), q0 = __uint_as_float(pw[j] << 16), q1 = __uint_as_float(pw[j] & 0xffff0000u);
            const float ma = (j < 2 ? m0[2 * j] : m1[2 * j - 4]), mb = (j < 2 ? m0[2 * j + 1] : m1[2 * j - 3]);
            x[2 * j] = c0 + (q0 - c0) * ma; x[2 * j + 1] = c1 + (q1 - c1) * mb; }
        if (cc < 8) {
#pragma unroll
            for (int j = 0; j < 8; ++j) x[j] = fast_tanh(x[j]); }
        else if (cc >= 16) {
#pragma unroll
            for (int j = 0; j < 8; ++j) x[j] = fast_sigmoid(x[j]); }
        u32x4 o; o.x = cvt_pk_bf16(x[0], x[1]); o.y = cvt_pk_bf16(x[2], x[3]); o.z = cvt_pk_bf16(x[4], x[5]); o.w = cvt_pk_bf16(x[6], x[7]);
        *(u32x4*)(act + (size_t)n * 256 + cc * 8) = o;
    }
}

template <int CTRL> __device__ __forceinline__ float dpp0f(float v) { return __builtin_bit_cast(float, __builtin_amdgcn_update_dpp(0, __builtin_bit_cast(int, v), CTRL, 0xf, 0xf, true)); }
__device__ __forceinline__ bf16x8 pack_lo4(const f32x4 a) { u32x4 w; w.x = cvt_pk_bf16(a[0], a[1]); w.y = cvt_pk_bf16(a[2], a[3]); w.z = 0u; w.w = 0u; return __builtin_bit_cast(bf16x8, w); }
__device__ __forceinline__ bf16x8 pack_8(const f32x4 a, const f32x4 b) { u32x4 w; w.x = cvt_pk_bf16(a[0], a[1]); w.y = cvt_pk_bf16(a[2], a[3]); w.z = cvt_pk_bf16(b[0], b[1]); w.w = cvt_pk_bf16(b[2], b[3]); return __builtin_bit_cast(bf16x8, w); }
__device__ __forceinline__ f32x4 mm16(const f32x4 PT, const f32x4 Q) { return __builtin_amdgcn_mfma_f32_16x16x32_bf16(pack_lo4(PT), pack_lo4(Q), fzero4(), 0, 0, 0); }
constexpr int RW3_SLOT = 12544;
__device__ __forceinline__ int rw3_trswz(int row, int c) { return (((c >> 1) ^ ((row >> 1) & 3)) << 1) | (c & 1); }
__device__ __forceinline__ unsigned rw_ld(unsigned* p_) { return __hip_atomic_load(p_, __ATOMIC_RELAXED, __HIP_MEMORY_SCOPE_AGENT); }
__device__ __forceinline__ void rwkv3_item(const Params& p, LAS unsigned char* lds, int item, int role, int which) {
    const int tid = opaque_tid(), lane = tid & 63, wid = tid >> 6, fr = lane & 15, g = lane >> 4;
    const int b = item >> 3, h = item & 7;
    unsigned char* ws = p.ws;
    const bf16_t* P0 = (const bf16_t*)(ws + OFF_P);
    float* yraw = p.out; bf16_t* e1g = (bf16_t*)(p.out + (size_t)NTOK * 512); bf16_t* gg = e1g + (size_t)NTOK * 512;
    LAS unsigned char* w2h = lds;
    LAS unsigned char* a2h = lds + 8192;
    LAS unsigned char* g2h = lds + 16384;
    LAS unsigned char* slots = lds + 32768;
    LAS float* ptab = (LAS float*)(lds + 32768 + 8 * RW3_SLOT);
    LAS float* mul = ptab + 8 * 64;
    if (role == 0) {
        const float* mu = p.in[I_AMU];
        if (tid < 64) { ptab[tid] = mu[h * 64 + tid]; ptab[64 + tid] = mu[512 + h * 64 + tid]; ptab[128 + tid] = mu[1024 + h * 64 + tid];
            ptab[192 + tid] = p.in[I_AW0][h * 64 + tid]; ptab[256 + tid] = p.in[I_AA0][h * 64 + tid]; ptab[320 + tid] = p.in[I_AKK][h * 64 + tid];
            ptab[384 + tid] = p.in[I_AKA][h * 64 + tid]; ptab[448 + tid] = p.in[I_ARK][h * 64 + tid]; }
        if (tid < 256) mul[tid] = mu[1536 + tid];
    }
    if (role == 0) {
        const bf16_t* w2t = (const bf16_t*)(ws + OFF_MISC + MISC_W2T); const bf16_t* a2t = (const bf16_t*)(ws + OFF_MISC + MISC_A2T); const bf16_t* g2t = (const bf16_t*)(ws + OFF_MISC + MISC_G2T);
        { const int row = tid >> 3, c = tid & 7;
            *(LAS u32x4*)(w2h + row * 128 + ((c ^ (row & 7)) * 16)) = *(const u32x4*)(w2t + (size_t)(h * 64 + row) * 64 + c * 8);
            *(LAS u32x4*)(a2h + row * 128 + ((c ^ (row & 7)) * 16)) = *(const u32x4*)(a2t + (size_t)(h * 64 + row) * 64 + c * 8); }
#pragma unroll
        for (int i = 0; i < 2; ++i) { const int q = tid + i * 512, row = q >> 4, c = q & 15;
            *(LAS u32x4*)(g2h + row * 256 + ((c ^ (row & 7)) * 16)) = *(const u32x4*)(g2t + (size_t)(h * 64 + row) * 128 + c * 8); }
    }
    __syncthreads();
    f32x4 Hacc[4];
#pragma unroll
    for (int rt = 0; rt < 4; ++rt) Hacc[rt] = fzero4();
    const size_t nb0 = (size_t)b * SEQ;
    const int q4 = fr >> 2, p4 = fr & 3;
#define MIXB(wc, wp, mA, mB, o0, o1) { const float c0 = __uint_as_float((wc) << 16), c1 = __uint_as_float((wc) & 0xffff0000u), q0 = __uint_as_float((wp) << 16), q1 = __uint_as_float((wp) & 0xffff0000u); o0 = c0 + (q0 - c0) * (mA); o1 = c1 + (q1 - c1) * (mB); }
    const bf16_t* actp = (const bf16_t*)(ws + OFF_ACT256);
    u32x2 nrc[4], nkc[4], nvc[4], nrp[4], nkp[4], nvp[4]; bf16x8 nb_[8];
#define RW3_LOADS(tk) do { const int t0_ = ((tk) * 8 + wid) * 16; const int fr_ = lane & 15, g_ = lane >> 4; const size_t n_ = nb0 + t0_ + fr_; const bool hp_ = (t0_ + fr_) > 0; \
        const bf16_t* rc_ = P0 + n_ * NE_MAIN; const bf16_t* rp_ = rc_ - NE_MAIN; \
        _Pragma("unroll") for (int ct = 0; ct < 4; ++ct) { const int c0 = ct * 16 + g_ * 4; \
            nrc[ct] = *(const u32x2*)(rc_ + h * 64 + c0); nkc[ct] = *(const u32x2*)(rc_ + 512 + h * 64 + c0); nvc[ct] = *(const u32x2*)(rc_ + 1024 + h * 64 + c0); \
            nrp[ct] = (u32x2){0u, 0u}; nkp[ct] = nrp[ct]; nvp[ct] = nrp[ct]; \
            if (hp_) { nrp[ct] = *(const u32x2*)(rp_ + h * 64 + c0); nkp[ct] = *(const u32x2*)(rp_ + 512 + h * 64 + c0); nvp[ct] = *(const u32x2*)(rp_ + 1024 + h * 64 + c0); } } \
        _Pragma("unroll") for (int f = 0; f < 8; ++f) nb_[f] = *(const bf16x8*)(actp + n_ * 256 + f * 32 + g_ * 8); } while (0)
    unsigned char* xb = ws + OFF_RWXB; unsigned* flg = (unsigned*)(ws + OFF_MISC + MISC_RWF);
#pragma unroll 1
    for (int it = 0; it < (role ? 32 : 16); ++it) {
        const int tick = role ? it : 2 * it + which;
        const int hk = tick >> 1, hw = tick & 1;
        unsigned* f_prod = flg + (item * 2 + hw) * 16; unsigned* f_cons = flg + 2048 + (item * 2 + hw) * 16;
        unsigned char* xslot = xb + ((((size_t)item * 2 + (hk & 1)) * 2 + hw) * 8) * RW3_SLOT;
        if (role == 0) {
            int lane_t = lane; asm volatile("" : "+v"(lane_t));
            const int fr = lane_t & 15, g = lane_t >> 4, q4 = fr >> 2, p4 = fr & 3;
            LAS unsigned char* sl = slots + wid * RW3_SLOT;
            LAS unsigned char* Qt_i = sl, * Rh_i = sl + 2048, * Kh_i = sl + 4096, * Bn_i = sl + 6144, * Vi_i = sl + 8192, * M1_i = sl + 10240, * DD_i = sl + 11264; LAS float* gam_i = (LAS float*)(sl + 12288);
            const int t0 = (tick * 8 + wid) * 16;
            const size_t n = nb0 + t0 + fr;
            const bool hasp = (t0 + fr) > 0;
            const bf16_t* rowc = P0 + n * NE_MAIN; const bf16_t* rowp = rowc - NE_MAIN;
            RW3_LOADS(tick);
#define lrc nrc
#define lkc nkc
#define lvc nvc
#define lrp nrp
#define lkp nkp
#define lvp nvp
            bf16x8 bw[2], ba[2], bg[4];
            bw[0] = nb_[0]; bw[1] = nb_[1]; ba[0] = nb_[2]; ba[1] = nb_[3]; bg[0] = nb_[4]; bg[1] = nb_[5]; bg[2] = nb_[6]; bg[3] = nb_[7];
            f32x4 Wt[4], At[4], Gt[4];
#pragma unroll
            for (int ct = 0; ct < 4; ++ct) {
                const int row = ct * 16 + fr;
                f32x4 dw = fzero4(), da = dw, dg = dw;
#pragma unroll
                for (int s = 0; s < 2; ++s) {
                    dw = __builtin_amdgcn_mfma_f32_16x16x32_bf16(*(const LAS bf16x8*)(w2h + row * 128 + (((s * 4 + g) ^ (row & 7)) * 16)), bw[s], dw, 0, 0, 0);
                    da = __builtin_amdgcn_mfma_f32_16x16x32_bf16(*(const LAS bf16x8*)(a2h + row * 128 + (((s * 4 + g) ^ (row & 7)) * 16)), ba[s], da, 0, 0, 0); }
#pragma unroll
                for (int s = 0; s < 4; ++s) dg = __builtin_amdgcn_mfma_f32_16x16x32_bf16(*(const LAS bf16x8*)(g2h + row * 256 + (((s * 4 + g) ^ (row & 7)) * 16)), bg[s], dg, 0, 0, 0);
                Wt[ct] = dw; At[ct] = da; Gt[ct] = dg;
            }
            f32x4 Rm[4], Khm[4], Lw[4], Aa[4];
            float nsq = 0.f, rk = 0.f;
            u32x2 Vp[4];
#pragma unroll
            for (int ct = 0; ct < 4; ++ct) {
                const int c0 = ct * 16 + g * 4;
                const u32x2 rc = lrc[ct], kc = lkc[ct], vc = lvc[ct], rp = lrp[ct], kp = lkp[ct], vp = lvp[ct];
                const f32x4 mr = *(const LAS f32x4*)(ptab + c0), mk = *(const LAS f32x4*)(ptab + 64 + c0), mv = *(const LAS f32x4*)(ptab + 128 + c0);
                f32x4 Km, Vm;
                MIXB(rc.x, rp.x, mr[0], mr[1], Rm[ct][0], Rm[ct][1]) MIXB(rc.y, rp.y, mr[2], mr[3], Rm[ct][2], Rm[ct][3])
                MIXB(kc.x, kp.x, mk[0], mk[1], Km[0], Km[1]) MIXB(kc.y, kp.y, mk[2], mk[3], Km[2], Km[3])
                MIXB(vc.x, vp.x, mv[0], mv[1], Vm[0], Vm[1]) MIXB(vc.y, vp.y, mv[2], mv[3], Vm[2], Vm[3])
                const f32x4 w0v = *(const LAS f32x4*)(ptab + 192 + c0), a0v = *(const LAS f32x4*)(ptab + 256 + c0), kks = *(const LAS f32x4*)(ptab + 320 + c0), kas = *(const LAS f32x4*)(ptab + 384 + c0), rkp = *(const LAS f32x4*)(ptab + 448 + c0);
#pragma unroll
                for (int r = 0; r < 4; ++r) { const float z = w0v[r] + Wt[ct][r]; const float sp = __logf(1.0f + __expf(-z));
                    Lw[ct][r] = -__expf(-sp - 0.5f);
                    const float a = fast_sigmoid(a0v[r] + At[ct][r]); Aa[ct][r] = a;
                    const float kkp = Km[r] * kks[r]; nsq += kkp * kkp; Wt[ct][r] = kkp;
                    const float kh = Km[r] * (1.0f + (a - 1.0f) * kas[r]); Khm[ct][r] = kh; rk += Rm[ct][r] * kh * rkp[r]; }
                Vp[ct].x = cvt_pk_bf16(Vm[0], Vm[1]); Vp[ct].y = cvt_pk_bf16(Vm[2], Vm[3]);
                At[ct] = Vm;
            }
            nsq += __shfl_xor(nsq, 16); nsq += __shfl_xor(nsq, 32);
            rk += __shfl_xor(rk, 16); rk += __shfl_xor(rk, 32);
            const float inrm = 1.0f / fmaxf(sqrtf(nsq), 1e-12f);
#pragma unroll
            for (int ct = 0; ct < 4; ++ct) { const int c0 = ct * 16 + g * 4;
                u32x2 ew, gw; ew.x = cvt_pk_bf16(rk * At[ct][0], rk * At[ct][1]); ew.y = cvt_pk_bf16(rk * At[ct][2], rk * At[ct][3]);
                gw.x = cvt_pk_bf16(Gt[ct][0], Gt[ct][1]); gw.y = cvt_pk_bf16(Gt[ct][2], Gt[ct][3]);
                *(u32x2*)(e1g + n * 512 + h * 64 + c0) = ew; *(u32x2*)(gg + n * 512 + h * 64 + c0) = gw;
                const int c = 2 * ct + (g >> 1);
                *(LAS u32x2*)(Vi_i + fr * 128 + rw3_trswz(fr, c) * 16 + (g & 1) * 8) = Vp[ct]; }
            u32x2 Qp[4], Kp[4], Bp[4], Rp[4];
#pragma unroll
            for (int ct = 0; ct < 4; ++ct) {
                const int c0 = ct * 16 + g * 4;
                f32x4 gmv; float qh[4], kh_[4], bh[4], rh[4];
#pragma unroll
                for (int r = 0; r < 4; ++r) {
                    float L = Lw[ct][r];
                    L += dpp0f<0x111>(L); L += dpp0f<0x112>(L); L += dpp0f<0x114>(L); L += dpp0f<0x118>(L);
                    const float Ltot = red16(Lw[ct][r]);
                    const float eL = __expf(L), ieL = fast_rcp(eL), eLex = __expf(L - Lw[ct][r]);
                    const float kk = Wt[ct][r] * inrm, bb = kk * Aa[ct][r];
                    qh[r] = kk * eLex; kh_[r] = Khm[ct][r] * ieL; bh[r] = bb * ieL; rh[r] = Rm[ct][r] * eL;
                    gmv[r] = __expf(Ltot); }
                Qp[ct].x = cvt_pk_bf16(qh[0], qh[1]); Qp[ct].y = cvt_pk_bf16(qh[2], qh[3]); Kp[ct].x = cvt_pk_bf16(kh_[0], kh_[1]); Kp[ct].y = cvt_pk_bf16(kh_[2], kh_[3]);
                Bp[ct].x = cvt_pk_bf16(bh[0], bh[1]); Bp[ct].y = cvt_pk_bf16(bh[2], bh[3]); Rp[ct].x = cvt_pk_bf16(rh[0], rh[1]); Rp[ct].y = cvt_pk_bf16(rh[2], rh[3]);
                if (fr == 0) *(LAS f32x4*)(gam_i + c0) = gmv;
            }
            bf16x8 Qf[2], Kf[2], Bf[2], Rf[2];
#pragma unroll
            for (int s = 0; s < 2; ++s) { Qf[s] = __builtin_bit_cast(bf16x8, (u32x4){Qp[2 * s].x, Qp[2 * s].y, Qp[2 * s + 1].x, Qp[2 * s + 1].y}); Kf[s] = __builtin_bit_cast(bf16x8, (u32x4){Kp[2 * s].x, Kp[2 * s].y, Kp[2 * s + 1].x, Kp[2 * s + 1].y});
                Bf[s] = __builtin_bit_cast(bf16x8, (u32x4){Bp[2 * s].x, Bp[2 * s].y, Bp[2 * s + 1].x, Bp[2 * s + 1].y}); Rf[s] = __builtin_bit_cast(bf16x8, (u32x4){Rp[2 * s].x, Rp[2 * s].y, Rp[2 * s + 1].x, Rp[2 * s + 1].y}); }
            f32x4 Ab = fzero4(), AbT = Ab, Ak = Ab, DkT = Ab, DbT = Ab;
#pragma unroll
            for (int s = 0; s < 2; ++s) {
                Ab = __builtin_amdgcn_mfma_f32_16x16x32_bf16(Qf[s], Bf[s], Ab, 0, 0, 0);
                AbT = __builtin_amdgcn_mfma_f32_16x16x32_bf16(Bf[s], Qf[s], AbT, 0, 0, 0);
                Ak = __builtin_amdgcn_mfma_f32_16x16x32_bf16(Qf[s], Kf[s], Ak, 0, 0, 0);
                DkT = __builtin_amdgcn_mfma_f32_16x16x32_bf16(Kf[s], Rf[s], DkT, 0, 0, 0);
                DbT = __builtin_amdgcn_mfma_f32_16x16x32_bf16(Bf[s], Rf[s], DbT, 0, 0, 0); }
            f32x4 N, NT, ident;
#pragma unroll
            for (int r = 0; r < 4; ++r) { const int row = 4 * g + r;
                N[r] = (fr < row) ? -Ab[r] : 0.f; Ak[r] = (fr < row) ? Ak[r] : 0.f;
                NT[r] = (row < fr) ? -AbT[r] : 0.f;
                DkT[r] = (row <= fr) ? DkT[r] : 0.f; DbT[r] = (row <= fr) ? -DbT[r] : 0.f;
                ident[r] = (row == fr) ? 1.f : 0.f; }
            const f32x4 N2 = mm16(NT, N), N2T = mm16(N, NT);
            const f32x4 N4 = mm16(N2T, N2), N4T = mm16(N2, N2T);
            const f32x4 N8T = mm16(N4, N4T);
            const f32x4 X1 = N + ident, X1T = NT + ident, X2 = N2 + ident, X2T = N2T + ident, X4 = N4 + ident, X8T = N8T + ident;
            const f32x4 U12 = mm16(X1T, X2), U12T = mm16(X1, X2T), U34T = mm16(X4, X8T);
            const f32x4 TT = mm16(U12, U34T);
            const f32x4 M1T = mm16(Ak, TT);
#pragma unroll
            for (int ct = 0; ct < 4; ++ct) { const int c = 2 * ct + (g >> 1);
                *(LAS u32x2*)(Qt_i + fr * 128 + rw3_trswz(fr, c) * 16 + (g & 1) * 8) = Qp[ct]; }
            s16x4 qtr[4];
#pragma unroll
            for (int ct = 0; ct < 4; ++ct) { const int row = 4 * g + q4, c = 2 * ct + (p4 >> 1);
                qtr[ct] = __builtin_amdgcn_ds_read_tr16_b64_v4i16((LAS s16x4*)(Qt_i + row * 128 + rw3_trswz(row, c) * 16 + (p4 & 1) * 8)); }
            const bf16x8 TTf = pack_lo4(TT);
            f32x4 Qt[4];
#pragma unroll
            for (int ct = 0; ct < 4; ++ct) { const bf16x8 af = (bf16x8){qtr[ct][0], qtr[ct][1], qtr[ct][2], qtr[ct][3], 0, 0, 0, 0};
                Qt[ct] = __builtin_amdgcn_mfma_f32_16x16x32_bf16(af, TTf, fzero4(), 0, 0, 0); }
#pragma unroll
            for (int ct = 0; ct < 4; ++ct) {
                const int s = ct >> 1, hh = ct & 1;
                u32x2 w; w.x = cvt_pk_bf16(Qt[ct][0], Qt[ct][1]); w.y = cvt_pk_bf16(Qt[ct][2], Qt[ct][3]);
                *(LAS u32x2*)(Qt_i + fr * 128 + (((s * 4 + g) ^ (fr & 7)) * 16) + hh * 8) = w;
                *(LAS u32x2*)(Rh_i + fr * 128 + (((s * 4 + g) ^ (fr & 7)) * 16) + hh * 8) = Rp[ct];
                const int c = 2 * ct + (g >> 1);
                *(LAS u32x2*)(Kh_i + fr * 128 + rw3_trswz(fr, c) * 16 + (g & 1) * 8) = Kp[ct];
                *(LAS u32x2*)(Bn_i + fr * 128 + rw3_trswz(fr, c) * 16 + (g & 1) * 8) = (u32x2){Bp[ct].x ^ 0x80008000u, Bp[ct].y ^ 0x80008000u}; }
            { const int cs = (g ^ ((fr >> 2) & 3)) * 16;
                u32x2 w; w.x = cvt_pk_bf16(M1T[0], M1T[1]); w.y = cvt_pk_bf16(M1T[2], M1T[3]);
                *(LAS u32x2*)(M1_i + fr * 64 + cs) = (u32x2){0u, 0u}; *(LAS u32x2*)(M1_i + fr * 64 + cs + 8) = w;
                w.x = cvt_pk_bf16(DbT[0], DbT[1]); w.y = cvt_pk_bf16(DbT[2], DbT[3]); *(LAS u32x2*)(DD_i + fr * 64 + cs) = w;
                w.x = cvt_pk_bf16(DkT[0], DkT[1]); w.y = cvt_pk_bf16(DkT[2], DkT[3]); *(LAS u32x2*)(DD_i + fr * 64 + cs + 8) = w; }
        }
        if (role == 0) {
            if (hk >= 2 && tid == 0) { for (unsigned sp = 0; rw_ld(f_cons) < (unsigned)(hk - 1) && sp < (1u << 22); ++sp) __builtin_amdgcn_s_sleep(2); }
            __syncthreads();
            { LAS const unsigned char* sl = slots + wid * RW3_SLOT; unsigned char* dst = xslot + (size_t)wid * RW3_SLOT;
                for (int i = lane; i < RW3_SLOT / 16; i += 64) *(u32x4*)(dst + i * 16) = *(const LAS u32x4*)(sl + i * 16); }
            asm volatile("s_waitcnt vmcnt(0)" ::: "memory");
            __syncthreads();
            if (tid == 0) { __builtin_amdgcn_fence(__ATOMIC_RELEASE, "agent"); asm volatile("s_waitcnt vmcnt(0)" ::: "memory"); __hip_atomic_store(f_prod, (unsigned)(hk + 1), __ATOMIC_RELAXED, __HIP_MEMORY_SCOPE_AGENT); }
            continue;
        }
        if (tid == 0) { for (unsigned sp = 0; rw_ld(f_prod) < (unsigned)(hk + 1) && sp < (1u << 22); ++sp) __builtin_amdgcn_s_sleep(2);
            __builtin_amdgcn_fence(__ATOMIC_ACQUIRE, "agent"); asm volatile("s_waitcnt vmcnt(0)" ::: "memory"); }
        __syncthreads();
        for (int i = tid; i < 8 * RW3_SLOT / 16; i += 512) *(LAS u32x4*)(slots + i * 16) = *(const u32x4*)(xslot + (size_t)i * 16);
        asm volatile("s_waitcnt vmcnt(0) lgkmcnt(0)" ::: "memory");
        __syncthreads();
        if (tid == 0) __hip_atomic_store(f_cons, (unsigned)(hk + 1), __ATOMIC_RELAXED, __HIP_MEMORY_SCOPE_AGENT);
        if (wid < 4) {
#pragma unroll 1
            for (int j = 0; j < 8; ++j) {
                int lane_t = lane; asm volatile("" : "+v"(lane_t));
                const int fr = lane_t & 15, g = lane_t >> 4, q4 = fr >> 2, p4 = fr & 3;
                LAS unsigned char* sl = slots + j * RW3_SLOT;
                LAS unsigned char* Qt_i = sl, * Rh_i = sl + 2048, * Kh_i = sl + 4096, * Bn_i = sl + 6144, * Vi_i = sl + 8192, * M1_i = sl + 10240, * DD_i = sl + 11264; LAS const float* gam_i = (LAS const float*)(sl + 12288);
                const bf16x8 Hb0 = pack_8(Hacc[0], Hacc[1]), Hb1 = pack_8(Hacc[2], Hacc[3]);
                const int trow = 4 * g + q4;
                const s16x4 vv = __builtin_amdgcn_ds_read_tr16_b64_v4i16((LAS s16x4*)(Vi_i + trow * 128 + rw3_trswz(trow, 2 * wid + (p4 >> 1)) * 16 + (p4 & 1) * 8));
                const bf16x8 q0 = *(const LAS bf16x8*)(Qt_i + fr * 128 + (((0 + g) ^ (fr & 7)) * 16)), q1 = *(const LAS bf16x8*)(Qt_i + fr * 128 + (((4 + g) ^ (fr & 7)) * 16));
                const bf16x8 r0 = *(const LAS bf16x8*)(Rh_i + fr * 128 + (((0 + g) ^ (fr & 7)) * 16)), r1 = *(const LAS bf16x8*)(Rh_i + fr * 128 + (((4 + g) ^ (fr & 7)) * 16));
                const int cs = (g ^ ((fr >> 2) & 3)) * 16;
                const bf16x8 m1 = *(const LAS bf16x8*)(M1_i + fr * 64 + cs), dd = *(const LAS bf16x8*)(DD_i + fr * 64 + cs);
                const bf16x8 v0 = (bf16x8){0, 0, 0, 0, vv[0], vv[1], vv[2], vv[3]};
                f32x4 Z = fzero4();
                Z = __builtin_amdgcn_mfma_f32_16x16x32_bf16(q0, Hb0, Z, 0, 0, 0); Z = __builtin_amdgcn_mfma_f32_16x16x32_bf16(q1, Hb1, Z, 0, 0, 0); Z = __builtin_amdgcn_mfma_f32_16x16x32_bf16(m1, v0, Z, 0, 0, 0);
                u32x2 zw; zw.x = cvt_pk_bf16(Z[0], Z[1]); zw.y = cvt_pk_bf16(Z[2], Z[3]);
                const s16x4 zs = __builtin_bit_cast(s16x4, zw);
                const bf16x8 zv = (bf16x8){zs[0], zs[1], zs[2], zs[3], vv[0], vv[1], vv[2], vv[3]};
                f32x4 Y = fzero4();
                Y = __builtin_amdgcn_mfma_f32_16x16x32_bf16(r0, Hb0, Y, 0, 0, 0); Y = __builtin_amdgcn_mfma_f32_16x16x32_bf16(r1, Hb1, Y, 0, 0, 0); Y = __builtin_amdgcn_mfma_f32_16x16x32_bf16(dd, zv, Y, 0, 0, 0);
                const size_t nrow = nb0 + (size_t)(tick * 8 + j) * 16 + 4 * g;
#pragma unroll
                for (int r = 0; r < 4; ++r) yraw[(nrow + r) * 512 + h * 64 + wid * 16 + fr] = Y[r];
#pragma unroll
                for (int rt = 0; rt < 4; ++rt) { const int c = 2 * rt + (p4 >> 1);
                    const s16x4 bn = __builtin_amdgcn_ds_read_tr16_b64_v4i16((LAS s16x4*)(Bn_i + trow * 128 + rw3_trswz(trow, c) * 16 + (p4 & 1) * 8));
                    const s16x4 kh = __builtin_amdgcn_ds_read_tr16_b64_v4i16((LAS s16x4*)(Kh_i + trow * 128 + rw3_trswz(trow, c) * 16 + (p4 & 1) * 8));
                    const bf16x8 af = (bf16x8){bn[0], bn[1], bn[2], bn[3], kh[0], kh[1], kh[2], kh[3]};
                    Hacc[rt] = __builtin_amdgcn_mfma_f32_16x16x32_bf16(af, zv, Hacc[rt], 0, 0, 0);
                    Hacc[rt] = Hacc[rt] * *(const LAS f32x4*)(gam_i + rt * 16 + g * 4); }
            }
        }
        __syncthreads();
    }
#undef MIXB
#undef RW3_LOADS
#undef lrc
#undef lkc
#undef lvc
#undef lrp
#undef lkp
#undef lvp
}

__device__ __forceinline__ void phase_rwkv_epi(const Params& p, int bid, int nb) {
    const int tid = opaque_tid(), wid = tid >> 6, lane = tid & 63;
    const float* yraw = p.out; const bf16_t* e1g = (const bf16_t*)(p.out + (size_t)NTOK * 512); const bf16_t* gg = e1g + (size_t)NTOK * 512;
    bf16_t* mix = (bf16_t*)(p.ws + OFF_BUF64);
    const f32x4 g0 = *(const f32x4*)(p.in[I_AGNG] + lane * 8), g1 = *(const f32x4*)(p.in[I_AGNG] + lane * 8 + 4), b0 = *(const f32x4*)(p.in[I_AGNB] + lane * 8), b1 = *(const f32x4*)(p.in[I_AGNB] + lane * 8 + 4);
    for (int n = bid * 8 + wid; n < NTOK; n += nb * 8) {
        const f32x4 y0 = *(const f32x4*)(yraw + (size_t)n * 512 + lane * 8), y1 = *(const f32x4*)(yraw + (size_t)n * 512 + lane * 8 + 4);
        const u32x4 ev = *(const u32x4*)(e1g + (size_t)n * 512 + lane * 8), gv = *(const u32x4*)(gg + (size_t)n * 512 + lane * 8);
#if SANITIZE
        f32x4 y0s = y0, y1s = y1;
#pragma unroll
        for (int j = 0; j < 4; ++j) { if (!(fabsf(y0s[j]) < 1e30f)) y0s[j] = 0.f; if (!(fabsf(y1s[j]) < 1e30f)) y1s[j] = 0.f; }
#define y0 y0s
#define y1 y1s
#endif
        float s = (y0[0] + y0[1]) + (y0[2] + y0[3]) + (y1[0] + y1[1]) + (y1[2] + y1[3]);
        s = red8(s); const float mean = s * (1.0f / 64.0f);
        const f32x4 d0 = y0 - mean, d1 = y1 - mean;
        float q = (d0[0] * d0[0] + d0[1] * d0[1]) + (d0[2] * d0[2] + d0[3] * d0[3]) + (d1[0] * d1[0] + d1[1] * d1[1]) + (d1[2] * d1[2] + d1[3] * d1[3]);
        q = red8(q); const float rs = rsqrtf(q * (1.0f / 64.0f) + 64e-5f);
        float o[8];
        const unsigned ew[4] = {ev.x, ev.y, ev.z, ev.w}, gw[4] = {gv.x, gv.y, gv.z, gv.w};
#pragma unroll
        for (int j = 0; j < 4; ++j) { const float ya = (j < 2 ? d0[2 * j] : d1[2 * j - 4]), yb = (j < 2 ? d0[2 * j + 1] : d1[2 * j - 3]);
            const float ga = (j < 2 ? g0[2 * j] : g1[2 * j - 4]), gb_ = (j < 2 ? g0[2 * j + 1] : g1[2 * j - 3]); const float ba = (j < 2 ? b0[2 * j] : b1[2 * j - 4]), bb_ = (j < 2 ? b0[2 * j + 1] : b1[2 * j - 3]);
            o[2 * j] = (ya * rs * ga + ba + __uint_as_float(ew[j] << 16)) * __uint_as_float(gw[j] << 16);
            o[2 * j + 1] = (yb * rs * gb_ + bb_ + __uint_as_float(ew[j] & 0xffff0000u)) * __uint_as_float(gw[j] & 0xffff0000u); }
        u32x4 w; w.x = cvt_pk_bf16(o[0], o[1]); w.y = cvt_pk_bf16(o[2], o[3]); w.z = cvt_pk_bf16(o[4], o[5]); w.w = cvt_pk_bf16(o[6], o[7]);
#if SANITIZE
#undef y0
#undef y1
#pragma unroll
        for (int j = 0; j < 8; ++j) if (!(fabsf(o[j]) < 1e30f)) o[j] = 0.f;
        w.x = cvt_pk_bf16(o[0], o[1]); w.y = cvt_pk_bf16(o[2], o[3]); w.z = cvt_pk_bf16(o[4], o[5]); w.w = cvt_pk_bf16(o[6], o[7]);
#endif
        *(u32x4*)(mix + (size_t)n * DM + lane * 8) = w;
    }
}

__device__ __forceinline__ int gla_fT(int row) { return ((row >> 1) & 1) | (((row >> 3) & 1) << 1); }
__device__ __forceinline__ int gla_hV(int row) { return (row & 3) | (((row >> 3) & 1) << 2); }
__device__ __forceinline__ void gla2_item(const Params& p, LAS unsigned char* lds, int item, int seg) {
    const int tid = opaque_tid(), lane = tid & 63, wid = tid >> 6, fr = lane & 15, g = lane >> 4;
    const int b = item >> 2, h = item & 3;
    const bf16_t* P0 = (const bf16_t*)(p.ws + OFF_P) + 1792;
    const float* xa16 = (const float*)(p.ws + OFF_U);
    bf16_t* mix = (bf16_t*)(p.ws + OFF_BUF64);
    LAS float* bcf = (LAS float*)lds;
    LAS float* tot = bcf + 64 * 64;
    LAS float* bls = tot + 8 * 64;
    LAS float* pn = bls + 64;
    LAS float* xs = pn + 64 * 8;
    LAS float* boff = xs + 2 * 1024;
    LAS unsigned char* qd_i = (LAS unsigned char*)(boff + 64);
    LAS unsigned char* ki_a = qd_i + 8192;
    LAS unsigned char* ki_t = ki_a + 8192;
    LAS unsigned char* att_i = ki_t + 8192;
    LAS unsigned char* v_i = att_i + 8192;
    for (int i = tid; i < 8192 / 16; i += 512) *(LAS u32x4*)(att_i + i * 16) = uzero4();
    float gw2[16];
#pragma unroll
    for (int i = 0; i < 16; ++i) gw2[i] = p.in[I_BGW2][i * 256 + h * 64 + lane];
    const float gb = p.in[I_BGB][h * 64 + lane];
    const f32x4 ngv = *(const f32x4*)(p.in[I_BNG] + h * 128 + wid * 16 + g * 4);
    f32x4 Sacc[4];
#pragma unroll
    for (int rt = 0; rt < 4; ++rt) Sacc[rt] = fzero4();
    const int q4 = fr >> 2, p4 = fr & 3;
    const int tok = tid >> 3, dc = tid & 7;
    u32x4 nq, nk, nv0, nv1; u32x2 ngate[4]; f32x4 nxa = fzero4();
#define GLA_ISSUE(c0n) do { const size_t _n = (size_t)b * SEQ + (c0n) + tok; \
        nq = *(const u32x4*)(P0 + _n * NE_MAIN + h * 64 + dc * 8); nk = *(const u32x4*)(P0 + _n * NE_MAIN + 256 + h * 64 + dc * 8); \
        nv0 = *(const u32x4*)(P0 + _n * NE_MAIN + 512 + h * 128 + dc * 16); nv1 = *(const u32x4*)(P0 + _n * NE_MAIN + 512 + h * 128 + dc * 16 + 8); \
        _Pragma("unroll") for (int _ct = 0; _ct < 4; ++_ct) ngate[_ct] = *(const u32x2*)(P0 + ((size_t)b * SEQ + (c0n) + _ct * 16 + fr) * NE_MAIN + 1024 + h * 128 + wid * 16 + g * 4); \
        if (tid < 256) nxa = *(const f32x4*)(xa16 + ((size_t)b * SEQ + (c0n)) * 16 + tid * 4); } while (0)
    const int cbeg = seg * (SEQ / 2), cend = cbeg + SEQ / 2;
    float* oraw = (float*)(p.ws + OFF_GLA_ORAW); bf16_t* qdgb = (bf16_t*)(p.ws + OFF_GLA_QDG);
    GLA_ISSUE(cbeg);
    if (tid < 256) *(LAS f32x4*)(xs + ((cbeg >> 6) & 1) * 1024 + tid * 4) = nxa;
    if (tid < 64) boff[tid] = 0.f;
    __syncthreads();
    for (int c0 = cbeg; c0 < cend; c0 += 64) {
        const size_t n0 = (size_t)b * SEQ + c0;
        LAS const float* xsc = xs + ((c0 >> 6) & 1) * 1024;
        { float run = 0.f;
#pragma unroll
            for (int tt = 0; tt < 8; ++tt) { const int c = wid * 8 + tt; float z = gb;
#pragma unroll
                for (int i4 = 0; i4 < 4; ++i4) { const f32x4 xv = *(const LAS f32x4*)(xsc + c * 16 + i4 * 4); z += xv[0] * gw2[i4 * 4] + xv[1] * gw2[i4 * 4 + 1] + xv[2] * gw2[i4 * 4 + 2] + xv[3] * gw2[i4 * 4 + 3]; }
                const float ls = fminf(z, 0.f) - __logf(1.0f + __expf(-fabsf(z)));
                run += ls * (1.0f / 16.0f); bcf[c * 64 + lane] = run; }
            tot[wid * 64 + lane] = run; }
        __syncthreads();
        { float off = 0.f;
            for (int w2 = 0; w2 < wid; ++w2) off += tot[w2 * 64 + lane];
#pragma unroll
            for (int tt = 0; tt < 8; ++tt) bcf[(wid * 8 + tt) * 64 + lane] += off;
            if (wid == 7) bls[lane] = __expf(bcf[63 * 64 + lane]); }
        __syncthreads();
        u32x2 gate[4];
        { const f32x4 bc0 = *(const LAS f32x4*)(bcf + tok * 64 + dc * 8), bc1 = *(const LAS f32x4*)(bcf + tok * 64 + dc * 8 + 4);
            const unsigned qw[4] = {nq.x, nq.y, nq.z, nq.w}, kw[4] = {nk.x, nk.y, nk.z, nk.w};
            float qo[8], ko[8];
#pragma unroll
            for (int j = 0; j < 4; ++j) { const float ba = (j < 2 ? bc0[2 * j] : bc1[2 * j - 4]), bb = (j < 2 ? bc0[2 * j + 1] : bc1[2 * j - 3]);
                const float ea = __expf(ba), eb = __expf(bb), ia = fast_rcp(ea), ib = fast_rcp(eb);
                qo[2 * j] = __uint_as_float(qw[j] << 16) * 0.125f * ea; qo[2 * j + 1] = __uint_as_float(qw[j] & 0xffff0000u) * 0.125f * eb;
                ko[2 * j] = __uint_as_float(kw[j] << 16) * ia; ko[2 * j + 1] = __uint_as_float(kw[j] & 0xffff0000u) * ib; }
            u32x4 qp, kp; qp.x = cvt_pk_bf16(qo[0], qo[1]); qp.y = cvt_pk_bf16(qo[2], qo[3]); qp.z = cvt_pk_bf16(qo[4], qo[5]); qp.w = cvt_pk_bf16(qo[6], qo[7]);
            kp.x = cvt_pk_bf16(ko[0], ko[1]); kp.y = cvt_pk_bf16(ko[2], ko[3]); kp.z = cvt_pk_bf16(ko[4], ko[5]); kp.w = cvt_pk_bf16(ko[6], ko[7]);
            *(LAS u32x4*)(qd_i + tok * 128 + ((dc ^ (tok & 7)) * 16)) = qp;
            if (seg) {
                const f32x4 bo0 = *(const LAS f32x4*)(boff + dc * 8), bo1 = *(const LAS f32x4*)(boff + dc * 8 + 4); float qg[8];
#pragma unroll
                for (int j = 0; j < 8; ++j) qg[j] = qo[j] * __expf(j < 4 ? bo0[j] : bo1[j - 4]);
                u32x4 w; w.x = cvt_pk_bf16(qg[0], qg[1]); w.y = cvt_pk_bf16(qg[2], qg[3]); w.z = cvt_pk_bf16(qg[4], qg[5]); w.w = cvt_pk_bf16(qg[6], qg[7]);
                *(u32x4*)(qdgb + ((size_t)b * 2048 + (c0 - cbeg) + tok) * 256 + h * 64 + dc * 8) = w; }
            *(LAS u32x4*)(ki_a + tok * 128 + ((dc ^ (tok & 7)) * 16)) = kp;
            *(LAS u32x4*)(ki_t + tok * 128 + (((((dc >> 1) ^ gla_fT(tok)) << 1) | (dc & 1)) * 16)) = kp;
            { const int pr = dc ^ gla_hV(tok); *(LAS u32x4*)(v_i + tok * 256 + (pr * 2) * 16) = nv0; *(LAS u32x4*)(v_i + tok * 256 + (pr * 2 + 1) * 16) = nv1; }
#pragma unroll
            for (int ct = 0; ct < 4; ++ct) gate[ct] = ngate[ct]; }
        if (c0 + 64 < cend) GLA_ISSUE(c0 + 64);
        __syncthreads();
        for (int ti = wid; ti < 10; ti += 8) {
            int st, ct; { const int tb[10] = {0x00, 0x01, 0x02, 0x03, 0x11, 0x12, 0x13, 0x22, 0x23, 0x33}; int code = 0;
#pragma unroll
                for (int k = 0; k < 10; ++k) if (k == ti) code = tb[k];
                st = code >> 4; ct = code & 15; }
            f32x4 d = fzero4();
            const int rs_ = st * 16 + fr, rc_ = ct * 16 + fr;
#pragma unroll
            for (int s = 0; s < 2; ++s) {
                const bf16x8 a = *(const LAS bf16x8*)(ki_a + rs_ * 128 + (((s * 4 + g) ^ (rs_ & 7)) * 16));
                const bf16x8 bq = *(const LAS bf16x8*)(qd_i + rc_ * 128 + (((s * 4 + g) ^ (rc_ & 7)) * 16));
                d = __builtin_amdgcn_mfma_f32_16x16x32_bf16(a, bq, d, 0, 0, 0); }
            const int c = ct * 16 + fr; float o4[4];
#pragma unroll
            for (int r = 0; r < 4; ++r) { const int s_ = st * 16 + g * 4 + r; o4[r] = (s_ <= c) ? d[r] : 0.f; }
            u32x2 w; w.x = cvt_pk_bf16(o4[0], o4[1]); w.y = cvt_pk_bf16(o4[2], o4[3]);
            *(LAS u32x2*)(att_i + c * 128 + (((2 * st + (g >> 1)) ^ (c & 7)) * 16) + (g & 1) * 8) = w;
        }
        if (seg && tid < 64) boff[tid] += bcf[63 * 64 + tid];
        __syncthreads();
        {
            bf16x8 vf[2];
#pragma unroll
            for (int s = 0; s < 2; ++s) {
                const int r1 = s * 32 + g * 8 + q4, r2 = r1 + 4; const int c = 2 * wid + (p4 >> 1);
                const s16x4 lo = __builtin_amdgcn_ds_read_tr16_b64_v4i16((LAS s16x4*)(v_i + r1 * 256 + (((((c >> 1) ^ gla_hV(r1)) << 1) | (c & 1)) * 16) + (p4 & 1) * 8));
                const s16x4 hi = __builtin_amdgcn_ds_read_tr16_b64_v4i16((LAS s16x4*)(v_i + r2 * 256 + (((((c >> 1) ^ gla_hV(r2)) << 1) | (c & 1)) * 16) + (p4 & 1) * 8));
                vf[s] = (bf16x8){lo[0], lo[1], lo[2], lo[3], hi[0], hi[1], hi[2], hi[3]}; }
            bf16x8 sf[2];
#pragma unroll
            for (int s = 0; s < 2; ++s) sf[s] = pack_8g(Sacc[2 * s], Sacc[2 * s + 1]);
            f32x4 oacc[4];
#pragma unroll
            for (int ct = 0; ct < 4; ++ct) {
                const int c = ct * 16 + fr; f32x4 d = fzero4();
#pragma unroll
                for (int s = 0; s < 2; ++s) {
                    const bf16x8 ab = *(const LAS bf16x8*)(att_i + c * 128 + (((s * 4 + g) ^ (c & 7)) * 16));
                    d = __builtin_amdgcn_mfma_f32_16x16x32_bf16(vf[s], ab, d, 0, 0, 0);
                    const s16x4 q0 = *(const LAS s16x4*)(qd_i + c * 128 + (((s * 4 + (g >> 1)) ^ (c & 7)) * 16) + (g & 1) * 8);
                    const s16x4 q1 = *(const LAS s16x4*)(qd_i + c * 128 + (((s * 4 + 2 + (g >> 1)) ^ (c & 7)) * 16) + (g & 1) * 8);
                    const bf16x8 qb = (bf16x8){q0[0], q0[1], q0[2], q0[3], q1[0], q1[1], q1[2], q1[3]};
                    d = __builtin_amdgcn_mfma_f32_16x16x32_bf16(sf[s], qb, d, 0, 0, 0); }
                oacc[ct] = d; }
#pragma unroll
            for (int rt = 0; rt < 4; ++rt) {
#pragma unroll
                for (int s = 0; s < 2; ++s) {
                    const int r1 = s * 32 + g * 8 + q4, r2 = r1 + 4; const int c = 2 * rt + (p4 >> 1);
                    const s16x4 lo = __builtin_amdgcn_ds_read_tr16_b64_v4i16((LAS s16x4*)(ki_t + r1 * 128 + (((((c >> 1) ^ gla_fT(r1)) << 1) | (c & 1)) * 16) + (p4 & 1) * 8));
                    const s16x4 hi = __builtin_amdgcn_ds_read_tr16_b64_v4i16((LAS s16x4*)(ki_t + r2 * 128 + (((((c >> 1) ^ gla_fT(r2)) << 1) | (c & 1)) * 16) + (p4 & 1) * 8));
                    const bf16x8 kf = (bf16x8){lo[0], lo[1], lo[2], lo[3], hi[0], hi[1], hi[2], hi[3]};
                    Sacc[rt] = __builtin_amdgcn_mfma_f32_16x16x32_bf16(kf, vf[s], Sacc[rt], 0, 0, 0); }
                const f32x4 eb = *(const LAS f32x4*)(bls + rt * 16 + g * 4);
                Sacc[rt] = Sacc[rt] * eb; }
#pragma unroll
            for (int ct = 0; ct < 4; ++ct) { float ss = oacc[ct][0] * oacc[ct][0] + oacc[ct][1] * oacc[ct][1] + oacc[ct][2] * oacc[ct][2] + oacc[ct][3] * oacc[ct][3];
                ss += __shfl_xor(ss, 16); ss += __shfl_xor(ss, 32);
                if (g == 0) pn[(ct * 16 + fr) * 8 + wid] = ss; }
            if (tid < 256 && c0 + 64 < cend) *(LAS f32x4*)(xs + (((c0 >> 6) + 1) & 1) * 1024 + tid * 4) = nxa;
            __syncthreads();
            if (seg) {
#pragma unroll
                for (int ct = 0; ct < 4; ++ct) *(f32x4*)(oraw + ((size_t)b * 2048 + (c0 - cbeg) + ct * 16 + fr) * 512 + h * 128 + wid * 16 + g * 4) = oacc[ct];
            } else
#pragma unroll
            for (int ct = 0; ct < 4; ++ct) { const int c = ct * 16 + fr;
                const f32x4 a0 = *(const LAS f32x4*)(pn + c * 8), a1 = *(const LAS f32x4*)(pn + c * 8 + 4);
                const float ss = (a0[0] + a0[1]) + (a0[2] + a0[3]) + (a1[0] + a1[1]) + (a1[2] + a1[3]);
                const float rs = rsqrtf(ss * (1.0f / 128.0f) + 1e-5f);
                const u32x2 gv = gate[ct];
                const float g0 = __uint_as_float(gv.x << 16), g1 = __uint_as_float(gv.x & 0xffff0000u), g2 = __uint_as_float(gv.y << 16), g3 = __uint_as_float(gv.y & 0xffff0000u);
                const float v0 = oacc[ct][0] * rs * ngv[0] * (g0 * fast_sigmoid(g0)), v1 = oacc[ct][1] * rs * ngv[1] * (g1 * fast_sigmoid(g1));
                const float v2 = oacc[ct][2] * rs * ngv[2] * (g2 * fast_sigmoid(g2)), v3 = oacc[ct][3] * rs * ngv[3] * (g3 * fast_sigmoid(g3));
                u32x2 w; w.x = cvt_pk_bf16(v0, v1); w.y = cvt_pk_bf16(v2, v3);
                *(u32x2*)(mix + (n0 + c) * DM + 512 + h * 128 + wid * 16 + g * 4) = w; }
        }
    }
    if (seg == 0) { float* sin_ = (float*)(p.ws + OFF_GLA_SIN) + (size_t)item * 64 * 128;
#pragma unroll
        for (int rt = 0; rt < 4; ++rt)
#pragma unroll
            for (int r = 0; r < 4; ++r) sin_[(rt * 16 + g * 4 + r) * 128 + wid * 16 + fr] = Sacc[rt][r]; }
#undef GLA_ISSUE
}

__device__ __forceinline__ void phase_gla_fix(const Params& p, LAS unsigned char* lds, int bid, int nb) {
    const int tid = opaque_tid(), lane = tid & 63, wid = tid >> 6, fr = lane & 15, g = lane >> 4;
    const bf16_t* P0 = (const bf16_t*)(p.ws + OFF_P) + 1792;
    const float* oraw = (const float*)(p.ws + OFF_GLA_ORAW); const bf16_t* qdgb = (const bf16_t*)(p.ws + OFF_GLA_QDG); const float* sinb = (const float*)(p.ws + OFF_GLA_SIN);
    bf16_t* mix = (bf16_t*)(p.ws + OFF_BUF64);
    LAS unsigned char* st_i = lds;
    LAS float* pn = (LAS float*)(lds + 16384);
    for (int it = bid; it < 32 * 32; it += nb) {
        const int item = it >> 5, ch = it & 31, b = item >> 2, h = item & 3;
        __syncthreads();
        { const float* sp = sinb + (size_t)item * 64 * 128;
            const int e_ = tid >> 2, d0 = (tid & 3) * 16; float v[16];
#pragma unroll
            for (int j = 0; j < 16; ++j) v[j] = sp[(d0 + j) * 128 + e_];
#pragma unroll
            for (int c2 = 0; c2 < 2; ++c2) { u32x4 w; w.x = cvt_pk_bf16(v[c2 * 8], v[c2 * 8 + 1]); w.y = cvt_pk_bf16(v[c2 * 8 + 2], v[c2 * 8 + 3]); w.z = cvt_pk_bf16(v[c2 * 8 + 4], v[c2 * 8 + 5]); w.w = cvt_pk_bf16(v[c2 * 8 + 6], v[c2 * 8 + 7]);
                const int c = (d0 >> 3) + c2; *(LAS u32x4*)(st_i + e_ * 128 + ((c ^ (e_ & 7)) * 16)) = w; } }
        __syncthreads();
        const size_t t0 = (size_t)b * 2048 + ch * 64;
        const size_t n0 = (size_t)b * SEQ + 2048 + ch * 64;
        const f32x4 ngv = *(const f32x4*)(p.in[I_BNG] + h * 128 + wid * 16 + g * 4);
        f32x4 oacc[4];
#pragma unroll
        for (int ct = 0; ct < 4; ++ct) {
            const int c = ct * 16 + fr;
            f32x4 d = *(const f32x4*)(oraw + (t0 + c) * 512 + h * 128 + wid * 16 + g * 4);
#pragma unroll
            for (int s = 0; s < 2; ++s) {
                const int er = wid * 16 + fr;
                const bf16x8 a = *(const LAS bf16x8*)(st_i + er * 128 + (((s * 4 + g) ^ (er & 7)) * 16));
                const bf16x8 bq = *(const bf16x8*)(qdgb + (t0 + c) * 256 + h * 64 + s * 32 + g * 8);
                d = __builtin_amdgcn_mfma_f32_16x16x32_bf16(a, bq, d, 0, 0, 0); }
            oacc[ct] = d; }
#pragma unroll
        for (int ct = 0; ct < 4; ++ct) { float ss = oacc[ct][0] * oacc[ct][0] + oacc[ct][1] * oacc[ct][1] + oacc[ct][2] * oacc[ct][2] + oacc[ct][3] * oacc[ct][3];
            ss += __shfl_xor(ss, 16); ss += __shfl_xor(ss, 32);
            if (g == 0) pn[(ct * 16 + fr) * 8 + wid] = ss; }
        __syncthreads();
#pragma unroll
        for (int ct = 0; ct < 4; ++ct) { const int c = ct * 16 + fr;
            const f32x4 a0 = *(const LAS f32x4*)(pn + c * 8), a1 = *(const LAS f32x4*)(pn + c * 8 + 4);
            const float ss = (a0[0] + a0[1]) + (a0[2] + a0[3]) + (a1[0] + a1[1]) + (a1[2] + a1[3]);
            const float rs = rsqrtf(ss * (1.0f / 128.0f) + 1e-5f);
            const u32x2 gv = *(const u32x2*)(P0 + (n0 + c) * NE_MAIN + 1024 + h * 128 + wid * 16 + g * 4);
            const float g0 = __uint_as_float(gv.x << 16), g1 = __uint_as_float(gv.x & 0xffff0000u), g2 = __uint_as_float(gv.y << 16), g3 = __uint_as_float(gv.y & 0xffff0000u);
            const float v0 = oacc[ct][0] * rs * ngv[0] * (g0 * fast_sigmoid(g0)), v1 = oacc[ct][1] * rs * ngv[1] * (g1 * fast_sigmoid(g1));
            const float v2 = oacc[ct][2] * rs * ngv[2] * (g2 * fast_sigmoid(g2)), v3 = oacc[ct][3] * rs * ngv[3] * (g3 * fast_sigmoid(g3));
            u32x2 w; w.x = cvt_pk_bf16(v0, v1); w.y = cvt_pk_bf16(v2, v3);
            *(u32x2*)(mix + (n0 + c) * DM + 512 + h * 128 + wid * 16 + g * 4) = w; }
    }
}


__device__ __forceinline__ void phase_mixer_even(const Params& p, LAS unsigned char* lds, int bid, int nb, int which) {
    if (nb >= 224) {
        if (bid < 64) { if (which != 2) rwkv3_item(p, lds, bid, 1, 0); }
        else if (bid < 192) { if (which != 2) rwkv3_item(p, lds, (bid - 64) >> 1, 0, (bid - 64) & 1); }
        else { if (which != 1) gla2_item(p, lds, (bid - 192) >> 1, (bid - 192) & 1); }
    }
    __syncthreads();
    if (which == 0) phase_prep(p, lds, bid, nb, 1);
}

__device__ __forceinline__ void phase_rope(const Params& p, int bid, int nb) {
    const int tid = opaque_tid(), wid = tid >> 6, lane = tid & 63;
    unsigned char* ws = p.ws;
    const bf16_t* Pd = (const bf16_t*)(ws + OFF_PD);
    bf16_t* qr = (bf16_t*)(ws + OFF_BUF64); bf16_t* kr = (bf16_t*)(ws + OFF_KR); bf16_t* vv = (bf16_t*)(ws + OFF_VV);
    bf16_t* iqr = (bf16_t*)(ws + OFF_IQR); bf16_t* ikr = (bf16_t*)(ws + OFF_IKR); float* iw = (float*)(ws + OFF_IW);
    const float* c64 = (const float*)(ws + OFF_ROPE); const float* s64 = c64 + 4096 * 64; const float* c32 = s64 + 4096 * 64; const float* s32 = c32 + 4096 * 32;
    const float ikg = p.in[I_CIKG][lane], ikb = p.in[I_CIKB][lane];
    for (int n = bid * 8 + wid; n < NTOK; n += nb * 8) {
        const int pos = n & (SEQ - 1);
        const bf16_t* row = Pd + (size_t)n * NO_MAIN;
#define ROPE8(off1, off2, cs, sn, scale, dst, d1, d2) do { \
            const u32x4 a_ = *(const u32x4*)(row + (off1)), b_ = *(const u32x4*)(row + (off2)); \
            const f32x4 c0_ = *(const f32x4*)(cs), c1_ = *(const f32x4*)((cs) + 4), s0_ = *(const f32x4*)(sn), s1_ = *(const f32x4*)((sn) + 4); \
            const unsigned aw_[4] = {a_.x, a_.y, a_.z, a_.w}, bw_[4] = {b_.x, b_.y, b_.z, b_.w}; float o1_[8], o2_[8]; \
            _Pragma("unroll") for (int j_ = 0; j_ < 4; ++j_) { \
                const float z1a = __uint_as_float(aw_[j_] << 16), z1b = __uint_as_float(aw_[j_] & 0xffff0000u), z2a = __uint_as_float(bw_[j_] << 16), z2b = __uint_as_float(bw_[j_] & 0xffff0000u); \
                const float ca = (j_ < 2 ? c0_[2 * j_] : c1_[2 * j_ - 4]), cb = (j_ < 2 ? c0_[2 * j_ + 1] : c1_[2 * j_ - 3]), sa = (j_ < 2 ? s0_[2 * j_] : s1_[2 * j_ - 4]), sb = (j_ < 2 ? s0_[2 * j_ + 1] : s1_[2 * j_ - 3]); \
                o1_[2 * j_] = (z1a * ca - z2a * sa) * (scale); o1_[2 * j_ + 1] = (z1b * cb - z2b * sb) * (scale); o2_[2 * j_] = (z2a * ca + z1a * sa) * (scale); o2_[2 * j_ + 1] = (z2b * cb + z1b * sb) * (scale); } \
            u32x4 w1_, w2_; w1_.x = cvt_pk_bf16(o1_[0], o1_[1]); w1_.y = cvt_pk_bf16(o1_[2], o1_[3]); w1_.z = cvt_pk_bf16(o1_[4], o1_[5]); w1_.w = cvt_pk_bf16(o1_[6], o1_[7]); \
            w2_.x = cvt_pk_bf16(o2_[0], o2_[1]); w2_.y = cvt_pk_bf16(o2_[2], o2_[3]); w2_.z = cvt_pk_bf16(o2_[4], o2_[5]); w2_.w = cvt_pk_bf16(o2_[6], o2_[7]); \
            *(u32x4*)((dst) + (d1)) = w1_; *(u32x4*)((dst) + (d2)) = w2_; } while (0)
        { const int h = lane >> 3, jb = (lane & 7) * 8;
            ROPE8(h * 128 + jb, h * 128 + 64 + jb, c64 + pos * 64 + jb, s64 + pos * 64 + jb, 0.08838834764831845f, qr + (size_t)n * 1024, h * 128 + jb, h * 128 + 64 + jb); }
        if (lane < 8) { const int jb = lane * 8;
            ROPE8(1024 + jb, 1024 + 64 + jb, c64 + pos * 64 + jb, s64 + pos * 64 + jb, 1.0f, kr + (size_t)n * 128, jb, 64 + jb); }
        else if (lane < 24) { const int c = (lane - 8) * 8;
            *(u32x4*)(vv + (size_t)n * 128 + c) = *(const u32x4*)(row + 1152 + c); }
        else if (lane < 40) { const int h = (lane - 24) >> 2, jb = ((lane - 24) & 3) * 8;
            ROPE8(1280 + h * 64 + jb, 1280 + h * 64 + 32 + jb, c32 + pos * 32 + jb, s32 + pos * 32 + jb, 0.125f, iqr + (size_t)n * 256, h * 64 + jb, h * 64 + 32 + jb); }
#undef ROPE8
        const int j32 = lane & 31; const float cc = c32[pos * 32 + j32], ss = s32[pos * 32 + j32];
        { const float x = bf2f(row[1536 + lane]); const float mean = wave_sum(x) * (1.0f / 64.0f); const float d = x - mean; const float var = wave_sum(d * d) * (1.0f / 64.0f);
            const float y = d * rsqrtf(var + LN_EPS) * ikg + ikb; const float o = __shfl_xor(y, 32);
            const float res = lane < 32 ? (y * cc - o * ss) : (y * cc + o * ss);
            ikr[(size_t)n * 64 + lane] = f2bf(res); }
        if (lane < 4) iw[(size_t)n * 4 + lane] = bf2f(row[1600 + lane]) * 0.5f;
    }
}

__device__ __forceinline__ void phase_index(const Params& p, LAS unsigned char* lds, int bid, int nb) {
    const int tid = opaque_tid(), wid = tid >> 6, lane = tid & 63;
    unsigned char* ws = p.ws;
    const bf16_t* iqr = (const bf16_t*)(ws + OFF_IQR); const bf16_t* ikr = (const bf16_t*)(ws + OFF_IKR); const float* iw = (const float*)(ws + OFF_IW);
    unsigned short* idx = (unsigned short*)(ws + OFF_IDX);
    LAS unsigned* sc = (LAS unsigned*)lds + wid * 4096;
    LAS int* hist = (LAS int*)(lds + 131072) + wid * 256;
    LAS float* iqs = (LAS float*)(lds + 131072 + 8192) + wid * 256;
    const unsigned long long lt_mask = (1ull << lane) - 1ull;
    for (int n = bid * 8 + wid; n < NTOK; n += nb * 8) {
        const int t = n & (SEQ - 1), b = n >> 12, nv = t + 1;
        unsigned short* out = idx + (size_t)n * 256;
        if (nv <= 256) { for (int j = lane; j < 256; j += 64) out[j] = (unsigned short)(j < nv ? j : 0); continue; }
#pragma unroll
        for (int j = 0; j < 4; ++j) iqs[lane * 4 + j] = bf2f(iqr[(size_t)n * 256 + lane * 4 + j]);
        const float w0 = iw[(size_t)n * 4 + 0], w1 = iw[(size_t)n * 4 + 1], w2 = iw[(size_t)n * 4 + 2], w3 = iw[(size_t)n * 4 + 3];
        const int nvp = (nv + 63) & ~63;
        for (int c0 = 0; c0 < nvp; c0 += 64) {
            const int key = c0 + lane; const bool valid = key < nv;
            float kf[64];
            const u32x4* kp = (const u32x4*)(ikr + ((size_t)b * SEQ + (valid ? key : 0)) * 64);
#pragma unroll
            for (int q = 0; q < 8; ++q) { const u32x4 w = kp[q];
                kf[q * 8 + 0] = __uint_as_float(w.x << 16); kf[q * 8 + 1] = __uint_as_float(w.x & 0xffff0000u); kf[q * 8 + 2] = __uint_as_float(w.y << 16); kf[q * 8 + 3] = __uint_as_float(w.y & 0xffff0000u);
                kf[q * 8 + 4] = __uint_as_float(w.z << 16); kf[q * 8 + 5] = __uint_as_float(w.z & 0xffff0000u); kf[q * 8 + 6] = __uint_as_float(w.w << 16); kf[q * 8 + 7] = __uint_as_float(w.w & 0xffff0000u); }
            float sh[4];
#pragma unroll
            for (int h = 0; h < 4; ++h) { float a = 0.f;
#pragma unroll
                for (int d4 = 0; d4 < 16; ++d4) { const f32x4 qv = *(const LAS f32x4*)(iqs + h * 64 + d4 * 4); a += qv[0] * kf[d4 * 4] + qv[1] * kf[d4 * 4 + 1] + qv[2] * kf[d4 * 4 + 2] + qv[3] * kf[d4 * 4 + 3]; }
                sh[h] = fmaxf(a, 0.f); }
            float score = sh[0] * w0 + sh[1] * w1 + sh[2] * w2 + sh[3] * w3;
            score += 0.0f;
            unsigned u = __float_as_uint(score); u = (u & 0x80000000u) ? ~u : (u | 0x80000000u);
            sc[key] = valid ? u : 0u;
        }
        unsigned prefix = 0; int need = 256;
#pragma unroll 1
        for (int pass = 3; pass >= 0; --pass) {
            const int shift = pass * 8;
#pragma unroll
            for (int j = 0; j < 4; ++j) hist[lane * 4 + j] = 0;
            for (int c0 = 0; c0 < nvp; c0 += 64) { const unsigned u = sc[c0 + lane];
                const bool match = (c0 + lane < nv) && (pass == 3 || (u >> (shift + 8)) == prefix);
                if (match) __hip_atomic_fetch_add(hist + ((u >> shift) & 255u), 1, __ATOMIC_RELAXED, __HIP_MEMORY_SCOPE_WORKGROUP); }
            int hb[4];
#pragma unroll
            for (int j = 0; j < 4; ++j) hb[j] = hist[lane * 4 + j];
            const int tot = hb[0] + hb[1] + hb[2] + hb[3];
            int suf = tot;
#pragma unroll
            for (int off = 1; off < 64; off <<= 1) { const int v = __shfl_down(suf, off); if (lane + off < 64) suf += v; }
            const int above = suf - tot;
            const bool is = (above < need) && (need <= suf);
            int bin = 0, nneed = 0;
            if (is) { int c = above;
#pragma unroll
                for (int k = 3; k >= 0; --k) { if (nneed == 0) { if (need <= c + hb[k]) { bin = lane * 4 + k; nneed = need - c; } else c += hb[k]; } } }
            const unsigned long long bal = __ballot(is);
            const int src = __ffsll((long long)bal) - 1;
            bin = __shfl(bin, src); nneed = __shfl(nneed, src);
            prefix = (prefix << 8) | (unsigned)bin; need = nneed;
        }
        const unsigned T = prefix;
        int base = 0, ties = 0;
        for (int c0 = 0; c0 < nvp; c0 += 64) { const int key = c0 + lane; const unsigned u = sc[key]; const bool valid = key < nv;
            const bool gt = valid && u > T, eq = valid && u == T;
            const unsigned long long beq = __ballot(eq);
            const int rank = ties + __popcll(beq & lt_mask);
            const bool take = gt || (eq && rank < need);
            const unsigned long long bt = __ballot(take);
            const int pos = base + __popcll(bt & lt_mask);
            if (take && pos < 256) out[pos] = (unsigned short)key;
            base += __popcll(bt); ties += __popcll(beq); }
    }
}

__device__ __forceinline__ void phase_attn(const Params& p, LAS unsigned char* lds, int bid, int nb) {
    const int tid = opaque_tid(), wid = tid >> 6, lane = tid & 63;
    unsigned char* ws = p.ws;
    const bf16_t* qr = (const bf16_t*)(ws + OFF_BUF64); const bf16_t* kr = (const bf16_t*)(ws + OFF_KR); const bf16_t* vv = (const bf16_t*)(ws + OFF_VV);
    const unsigned short* idx = (const unsigned short*)(ws + OFF_IDX);
    bf16_t* ao = (bf16_t*)(ws + OFF_PD);
    LAS float* qs = (LAS float*)lds + wid * 1024;
    LAS float* ps = (LAS float*)(lds + 32768) + wid * 2048;
    LAS int* ks = (LAS int*)(lds + 32768 + 65536) + wid * 256;
    for (int n = bid * 8 + wid; n < NTOK; n += nb * 8) {
        const int t = n & (SEQ - 1), b = n >> 12, cnt = (t + 1) < 256 ? (t + 1) : 256;
        asm volatile("" ::: "memory");
#pragma unroll
        for (int j = 0; j < 16; ++j) qs[j * 64 + lane] = bf2f(qr[(size_t)n * 1024 + j * 64 + lane]);
#pragma unroll
        for (int r = 0; r < 4; ++r) ks[r * 64 + lane] = idx[(size_t)n * 256 + r * 64 + lane];
#pragma unroll 1
        for (int r = 0; r < 4; ++r) {
            const int j = r * 64 + lane; const bool valid = j < cnt; const int key = valid ? ks[j] : 0;
            const u32x4* kp = (const u32x4*)(kr + ((size_t)b * SEQ + key) * 128);
            float kf[128];
#pragma unroll
            for (int q = 0; q < 16; ++q) { const u32x4 w = kp[q];
                kf[q * 8 + 0] = __uint_as_float(w.x << 16); kf[q * 8 + 1] = __uint_as_float(w.x & 0xffff0000u); kf[q * 8 + 2] = __uint_as_float(w.y << 16); kf[q * 8 + 3] = __uint_as_float(w.y & 0xffff0000u);
                kf[q * 8 + 4] = __uint_as_float(w.z << 16); kf[q * 8 + 5] = __uint_as_float(w.z & 0xffff0000u); kf[q * 8 + 6] = __uint_as_float(w.w << 16); kf[q * 8 + 7] = __uint_as_float(w.w & 0xffff0000u); }
#pragma unroll 1
            for (int h = 0; h < 8; ++h) { float a = 0.f;
#pragma unroll
                for (int d4 = 0; d4 < 32; ++d4) { const f32x4 qv = *(const LAS f32x4*)(qs + h * 128 + d4 * 4);
                    a += qv[0] * kf[d4 * 4] + qv[1] * kf[d4 * 4 + 1] + qv[2] * kf[d4 * 4 + 2] + qv[3] * kf[d4 * 4 + 3]; }
                ps[h * 256 + j] = valid ? a : -INFINITY; }
        }
#pragma unroll
        for (int h = 0; h < 8; ++h) { float x[4]; float m = -INFINITY;
#pragma unroll
            for (int r = 0; r < 4; ++r) { x[r] = ps[h * 256 + r * 64 + lane]; m = fmaxf(m, x[r]); }
#pragma unroll
            for (int o = 32; o > 0; o >>= 1) m = fmaxf(m, __shfl_xor(m, o));
            float s = 0.f;
#pragma unroll
            for (int r = 0; r < 4; ++r) { x[r] = expf(x[r] - m); s += x[r]; }
            s = wave_sum(s); const float inv = 1.0f / s;
#pragma unroll
            for (int r = 0; r < 4; ++r) ps[h * 256 + r * 64 + lane] = x[r] * inv; }
        float o0[8], o1[8];
#pragma unroll
        for (int h = 0; h < 8; ++h) { o0[h] = 0.f; o1[h] = 0.f; }
        for (int j = 0; j < cnt; ++j) { const int key = ks[j];
            const unsigned w = *(const unsigned*)(vv + ((size_t)b * SEQ + key) * 128 + 2 * lane);
            const float v0 = __uint_as_float(w << 16), v1 = __uint_as_float(w & 0xffff0000u);
#pragma unroll
            for (int h = 0; h < 8; ++h) { const float pj = ps[h * 256 + j]; o0[h] += pj * v0; o1[h] += pj * v1; } }
#pragma unroll
        for (int h = 0; h < 8; ++h) *(unsigned*)(ao + (size_t)n * 1024 + h * 128 + 2 * lane) = cvt_pk_bf16(o0[h], o1[h]);
    }
}

__device__ __forceinline__ void attn_query(const bf16_t* qr, const bf16_t* kr, const bf16_t* vv, bf16_t* ao, int n, LAS const unsigned short* ks, LAS unsigned char* vbuf, int lane) {
    const int fr = lane & 15, g = lane >> 4, q4 = fr >> 2, p4 = fr & 3;
    const int t = n & (SEQ - 1), b = n >> 12, cnt = (t + 1) < 256 ? (t + 1) : 256;
    {
        bf16x8 qf[4];
#pragma unroll
        for (int s = 0; s < 4; ++s) { qf[s] = (bf16x8){0, 0, 0, 0, 0, 0, 0, 0}; if (fr < 8) qf[s] = *(const bf16x8*)(qr + (size_t)n * 1024 + fr * 128 + s * 32 + g * 8); }
        const bf16_t* kbase = kr + (size_t)b * SEQ * 128; const bf16_t* vbase = vv + (size_t)b * SEQ * 128;
        f32x4 acc[16];
        bf16x8 kf[3][2][4];
#define ATT_KLOAD(buf, grp) do { _Pragma("unroll") for (int t2 = 0; t2 < 2; ++t2) { const int j_ = ((grp) * 2 + t2) * 16 + fr; const int key_ = j_ < cnt ? (int)ks[j_] : 0; \
            const bf16_t* kp_ = kbase + (size_t)key_ * 128 + g * 8; _Pragma("unroll") for (int s = 0; s < 4; ++s) kf[buf][t2][s] = *(const bf16x8*)(kp_ + s * 32); } } while (0)
        ATT_KLOAD(0, 0); ATT_KLOAD(1, 1);
#pragma unroll
        for (int grp = 0; grp < 8; ++grp) {
            if (grp + 2 < 8) ATT_KLOAD((grp + 2) % 3, grp + 2);
#pragma unroll
            for (int t2 = 0; t2 < 2; ++t2) { f32x4 a = fzero4();
#pragma unroll
                for (int s = 0; s < 4; ++s) a = __builtin_amdgcn_mfma_f32_16x16x32_bf16(kf[grp % 3][t2][s], qf[s], a, 0, 0, 0);
                acc[grp * 2 + t2] = a; }
        }
#undef ATT_KLOAD
        u32x4 vr[2][8];
#define ATT_VLOAD(buf, s) do { _Pragma("unroll") for (int i = 0; i < 8; ++i) { const int kl_ = i * 4 + g; const int jj_ = (s) * 32 + kl_; const int key_ = jj_ < cnt ? (int)ks[jj_] : 0; \
            const int c_ = fr ^ ((kl_ & 7) << 1); vr[buf][i] = *(const u32x4*)(vbase + (size_t)key_ * 128 + c_ * 8); } } while (0)
        ATT_VLOAD(0, 0);
        float m = -INFINITY;
#pragma unroll
        for (int tl = 0; tl < 16; ++tl)
#pragma unroll
            for (int r = 0; r < 4; ++r) { if (tl * 16 + g * 4 + r >= cnt) acc[tl][r] = -INFINITY; m = fmaxf(m, acc[tl][r]); }
        m = fmaxf(m, __shfl_xor(m, 16)); m = fmaxf(m, __shfl_xor(m, 32));
        float sum = 0.f;
#pragma unroll
        for (int tl = 0; tl < 16; ++tl)
#pragma unroll
            for (int r = 0; r < 4; ++r) { const float e_ = __expf(acc[tl][r] - m); acc[tl][r] = e_; sum += e_; }
        sum += __shfl_xor(sum, 16); sum += __shfl_xor(sum, 32);
        const float inv = 1.0f / sum;
        bf16x8 pf[8];
#pragma unroll
        for (int s = 0; s < 8; ++s) pf[s] = pack_8g(acc[2 * s], acc[2 * s + 1]);
        f32x4 o[8];
#pragma unroll
        for (int dt = 0; dt < 8; ++dt) o[dt] = fzero4();
#pragma unroll
        for (int s = 0; s < 8; ++s) {
            LAS unsigned char* vb = vbuf + (s & 1) * 8192;
            if (s + 1 < 8) ATT_VLOAD((s + 1) & 1, s + 1);
#pragma unroll
            for (int i = 0; i < 8; ++i) { const int kl = i * 4 + g; *(LAS u32x4*)(vb + kl * 256 + fr * 16) = vr[s & 1][i]; }
            const int kl1 = 4 * g + q4, kl2 = 16 + 4 * g + q4;
#pragma unroll
            for (int dt = 0; dt < 8; ++dt) {
                const int c = 2 * dt + (p4 >> 1);
                const s16x4 lo = __builtin_amdgcn_ds_read_tr16_b64_v4i16((LAS s16x4*)(vb + kl1 * 256 + ((c ^ ((kl1 & 7) << 1)) * 16) + (p4 & 1) * 8));
                const s16x4 hi = __builtin_amdgcn_ds_read_tr16_b64_v4i16((LAS s16x4*)(vb + kl2 * 256 + ((c ^ ((kl2 & 7) << 1)) * 16) + (p4 & 1) * 8));
                const bf16x8 af = (bf16x8){lo[0], lo[1], lo[2], lo[3], hi[0], hi[1], hi[2], hi[3]};
                o[dt] = __builtin_amdgcn_mfma_f32_16x16x32_bf16(af, pf[s], o[dt], 0, 0, 0);
            }
        }
#undef ATT_VLOAD
        if (fr < 8) {
#pragma unroll
            for (int dt = 0; dt < 8; ++dt) { u32x2 w; w.x = cvt_pk_bf16(o[dt][0] * inv, o[dt][1] * inv); w.y = cvt_pk_bf16(o[dt][2] * inv, o[dt][3] * inv);
                *(u32x2*)(ao + (size_t)n * 1024 + fr * 128 + dt * 16 + g * 4) = w; }
        }
    }
}

__device__ __forceinline__ int idx_bin(float s, float lo, float scale) { int b = (int)((s - lo) * scale); b = b < 0 ? 0 : b; return b > 255 ? 255 : b; }
__device__ __forceinline__ unsigned ord_key(float s) { const unsigned u = __float_as_uint(s); return (u & 0x80000000u) ? ~u : (u | 0x80000000u); }
__device__ __forceinline__ float ord_val(unsigned k) { return __uint_as_float((k & 0x80000000u) ? (k & 0x7fffffffu) : ~k); }
__device__ __forceinline__ void phase_index2(const Params& p, LAS unsigned char* lds, int bid, int nb) {
    const int tid = opaque_tid(), wid = __builtin_amdgcn_readfirstlane(tid >> 6), lane0 = tid & 63;
    unsigned char* ws = p.ws;
    const bf16_t* iqr = (const bf16_t*)(ws + OFF_IQR); const bf16_t* ikr = (const bf16_t*)(ws + OFF_IKR); const float* iw = (const float*)(ws + OFF_IW);
    const bf16_t* qr = (const bf16_t*)(ws + OFF_BUF64); const bf16_t* kr = (const bf16_t*)(ws + OFF_KR); const bf16_t* vv = (const bf16_t*)(ws + OFF_VV); bf16_t* ao = (bf16_t*)(ws + OFF_PD);
    LAS unsigned short* out = (LAS unsigned short*)(lds + 131072 + 24576) + wid * 256;
    LAS float* sc = (LAS float*)lds;
    LAS int* hist = (LAS int*)(lds + 131072) + wid * 256;
    LAS float* candv = (LAS float*)(lds + 131072 + 8192) + wid * 264;
    LAS unsigned short* candi = (LAS unsigned short*)(lds + 131072 + 8192 + 8 * 264 * 4) + wid * 256;
    LAS unsigned* mm = (LAS unsigned*)(lds + 131072 + 8192 + 8 * 264 * 4 + 8 * 512);
    const int ntile = NTOK / 8;
    PROBE_DECL;
    PROBE_BEGIN(9);
    for (int it = bid; it < ntile; it += nb) {
        const int round = it / nb, qt = (round & 1) ? (round * nb + (nb - 1 - (it - round * nb))) : it;
        const int n0 = qt * 8, t0 = n0 & (SEQ - 1), b = n0 >> 12;
        int lane = lane0; asm volatile("" : "+v"(lane));
        const int fr = lane & 15, g = lane >> 4; const unsigned long long lt_mask = (1ull << lane) - 1ull;
        asm volatile("" ::: "memory");
        if (tid < 16) mm[tid] = (tid & 1) ? 0u : 0xffffffffu;
        __syncthreads();
        PROBE_BEGIN(1);
#pragma unroll 1
        for (int genrep = 0; genrep < (IDXPROBE == 1 ? 2 : 1); ++genrep)
        if (t0 + 8 > 256) {
            bf16x8 af[2][2];
#pragma unroll
            for (int hh = 0; hh < 2; ++hh)
#pragma unroll
                for (int s = 0; s < 2; ++s) af[hh][s] = *(const bf16x8*)(iqr + (size_t)(n0 + 2 * (fr >> 2) + ((fr >> 1) & 1)) * 256 + (2 * hh + (fr & 1)) * 64 + s * 32 + g * 8);
            const f32x4 wq0 = *(const f32x4*)(iw + (size_t)(n0 + 2 * g) * 4), wq1 = *(const f32x4*)(iw + (size_t)(n0 + 2 * g + 1) * 4);
            float vmin0 = INFINITY, vmax0 = -INFINITY, vmin1 = INFINITY, vmax1 = -INFINITY;
            const int nkt = (t0 + 8 + 15) >> 4;
            const bf16_t* kb = ikr + (size_t)b * SEQ * 64;
            bf16x8 pb0[3], pb1[3];
#pragma unroll
            for (int i = 0; i < 2; ++i) { const int ktp = wid + 8 * i < nkt ? wid + 8 * i : wid; const bf16_t* kp = kb + (size_t)(ktp * 16 + fr) * 64 + g * 8; pb0[i] = *(const bf16x8*)kp; pb1[i] = *(const bf16x8*)(kp + 32); }
            for (int kt = wid; kt < nkt; kt += 8) {
                { const int ktp = kt + 16 < nkt ? kt + 16 : kt; const bf16_t* kp = kb + (size_t)(ktp * 16 + fr) * 64 + g * 8; pb0[2] = *(const bf16x8*)kp; pb1[2] = *(const bf16x8*)(kp + 32); }
                const bf16x8 b0 = pb0[0], b1 = pb1[0];
                pb0[0] = pb0[1]; pb1[0] = pb1[1]; pb0[1] = pb0[2]; pb1[1] = pb1[2];
                f32x4 d0 = fzero4(), d1 = fzero4();
                d0 = __builtin_amdgcn_mfma_f32_16x16x32_bf16(af[0][0], b0, d0, 0, 0, 0); d0 = __builtin_amdgcn_mfma_f32_16x16x32_bf16(af[0][1], b1, d0, 0, 0, 0);
                d1 = __builtin_amdgcn_mfma_f32_16x16x32_bf16(af[1][0], b0, d1, 0, 0, 0); d1 = __builtin_amdgcn_mfma_f32_16x16x32_bf16(af[1][1], b1, d1, 0, 0, 0);
                float s0 = fmaxf(d0[0], 0.f) * wq0[0] + fmaxf(d0[1], 0.f) * wq0[1] + fmaxf(d1[0], 0.f) * wq0[2] + fmaxf(d1[1], 0.f) * wq0[3];
                float s1 = fmaxf(d0[2], 0.f) * wq1[0] + fmaxf(d0[3], 0.f) * wq1[1] + fmaxf(d1[2], 0.f) * wq1[2] + fmaxf(d1[3], 0.f) * wq1[3];
                s0 += 0.0f; s1 += 0.0f;
                vmin0 = fminf(vmin0, s0); vmax0 = fmaxf(vmax0, s0); vmin1 = fminf(vmin1, s1); vmax1 = fmaxf(vmax1, s1);
                sc[(2 * g) * 4096 + kt * 16 + fr] = s0; sc[(2 * g + 1) * 4096 + kt * 16 + fr] = s1;
            }
#pragma unroll
            for (int j = 0; j < 2; ++j) { float mn = j ? vmin1 : vmin0, mx = j ? vmax1 : vmax0;
                mn = fminf(mn, dppf<0xB1>(mn)); mn = fminf(mn, dppf<0x4E>(mn)); mn = fminf(mn, dppf<0x141>(mn)); mn = fminf(mn, dppf<0x140>(mn));
                mx = fmaxf(mx, dppf<0xB1>(mx)); mx = fmaxf(mx, dppf<0x4E>(mx)); mx = fmaxf(mx, dppf<0x141>(mx)); mx = fmaxf(mx, dppf<0x140>(mx));
                if (fr == 0 && mx >= mn) { const int q = 2 * g + j;
                    __hip_atomic_fetch_min(mm + q * 2, ord_key(mn), __ATOMIC_RELAXED, __HIP_MEMORY_SCOPE_WORKGROUP); __hip_atomic_fetch_max(mm + q * 2 + 1, ord_key(mx), __ATOMIC_RELAXED, __HIP_MEMORY_SCOPE_WORKGROUP); } }
        }
        PROBE_END(1);
        PROBE_BEGIN(2);
        __syncthreads();
        PROBE_END(2);
        PROBE_BEGIN(7);
#pragma unroll 1
        for (int selrep = 0; selrep < (IDXPROBE == 2 ? 2 : 1); ++selrep)
        {
            const int n = n0 + wid, t = t0 + wid, nv = t + 1;
            if (nv <= 256) { for (int j = lane; j < 256; j += 64) out[j] = (unsigned short)(j < nv ? j : 0); }
            else {
                LAS const float* srow = sc + wid * 4096;
                const int nvp = (nv + 255) & ~255;
                const unsigned kmax = mm[wid * 2 + 1];
                const int kbase = (int)(kmax >> 19) - 255;
                unsigned P = 0u; int sh = 32;
                bool capped = false;
                float lo = ord_val(mm[wid * 2]), hi = ord_val(mm[wid * 2 + 1]);
                float lo1 = 0.f, sc1 = 0.f, lo2 = 0.f, sc2 = 0.f, lo3 = 0.f, sc3 = 0.f; int b1 = 0, b2 = 0, b3 = 0, nlev = 0;
                int m = nv, need = 256;
#define IDX_HIST_SCAN(bin, nneed, mmc, lumpc) do { int hb[4]; \
                    _Pragma("unroll") for (int j = 0; j < 4; ++j) hb[j] = hist[lane * 4 + j]; \
                    if (lane == 0) hb[0] += (lumpc); \
                    const int tot = hb[0] + hb[1] + hb[2] + hb[3]; int suf = tot; \
                    _Pragma("unroll") for (int off = 1; off < 64; off <<= 1) { const int v = __shfl_down(suf, off); if (lane + off < 64) suf += v; } \
                    const int above = suf - tot; const bool is = (above < need) && (need <= suf); \
                    bin = 0; nneed = 0; mmc = 0; \
                    if (is) { int c = above; \
                        _Pragma("unroll") for (int k = 3; k >= 0; --k) { if (nneed == 0) { if (need <= c + hb[k]) { bin = lane * 4 + k; nneed = need - c; mmc = hb[k]; } else c += hb[k]; } } } \
                    const unsigned long long bal = __ballot(is); const int srcl = __ffsll((long long)bal) - 1; \
                    bin = __shfl(bin, srcl); nneed = __shfl(nneed, srcl); mmc = __shfl(mmc, srcl); } while (0)
#define IDX_ZERO_HIST() do { int z = 0; asm volatile("" : "+v"(z)); _Pragma("unroll") for (int j = 0; j < 4; ++j) hist[lane * 4 + j] = z; } while (0)
                PROBE_BEGIN(3);
                {
                    IDX_ZERO_HIST();
                    int lumpl = 0;
                    for (int c0 = 0; c0 < nvp; c0 += 256) { const f32x4 s4 = *(const LAS f32x4*)(srow + c0 + lane * 4);
#pragma unroll
                        for (int e_ = 0; e_ < 4; ++e_) { const unsigned k = ord_key(s4[e_]); const int bin = (int)(k >> 19) - kbase; const bool valid = c0 + lane * 4 + e_ < nv;
                            if (valid && bin > 0) __hip_atomic_fetch_add(hist + bin, 1, __ATOMIC_RELAXED, __HIP_MEMORY_SCOPE_WORKGROUP);
                            lumpl += (valid && bin <= 0) ? 1 : 0; } }
                    int lump = lumpl;
#pragma unroll
                    for (int o = 32; o > 0; o >>= 1) lump += __shfl_xor(lump, o);
                    int bin, nneed, mmc; IDX_HIST_SCAN(bin, nneed, mmc, lump);
                    need = nneed; m = mmc;
                    if (bin > 0) { P = (unsigned)(kbase + bin); sh = 19; }
                    else { capped = true; hi = ord_val(((unsigned)(kbase + 1) << 19) - 1u); if (hi < lo) hi = lo; }
                }
                PROBE_END(3);
                PROBE_BEGIN(4);
#pragma unroll 1
                while (!capped && m > 128 && sh > 0) {
                    const int nsh = sh > 8 ? sh - 8 : 0; const unsigned dmask = (1u << (sh - nsh)) - 1u;
                    IDX_ZERO_HIST();
                    for (int c0 = 0; c0 < nvp; c0 += 256) { const f32x4 s4 = *(const LAS f32x4*)(srow + c0 + lane * 4);
#pragma unroll
                        for (int e_ = 0; e_ < 4; ++e_) { const unsigned k = ord_key(s4[e_]);
                            if (c0 + lane * 4 + e_ < nv && (k >> sh) == P) __hip_atomic_fetch_add(hist + ((k >> nsh) & dmask), 1, __ATOMIC_RELAXED, __HIP_MEMORY_SCOPE_WORKGROUP); } }
                    int bin, nneed, mmc; IDX_HIST_SCAN(bin, nneed, mmc, 0);
                    P = (P << (sh - nsh)) | (unsigned)bin; sh = nsh; need = nneed; m = mmc;
                }
#define IDX_CLASSIFY(s, cls) do { \
                    if (!capped) { const unsigned kk_ = sh >= 32 ? 0u : (ord_key(s) >> sh); cls = kk_ > P ? 2 : (kk_ == P ? 1 : 0); } \
                    else if ((int)(ord_key(s) >> 19) > kbase) cls = 2; \
                    else { cls = 1; \
                        if (nlev >= 1) { const int bb = idx_bin(s, lo1, sc1); if (bb != b1) cls = bb > b1 ? 2 : 0; } \
                        if (cls == 1 && nlev >= 2) { const int bb = idx_bin(s, lo2, sc2); if (bb != b2) cls = bb > b2 ? 2 : 0; } \
                        if (cls == 1 && nlev >= 3) { const int bb = idx_bin(s, lo3, sc3); if (bb != b3) cls = bb > b3 ? 2 : 0; } } } while (0)
#pragma unroll 1
                while (capped && m > 128 && nlev < 3 && (hi - lo) > 1e-30f) {
                    const float width = hi - lo, scale = 256.0f / width;
                    IDX_ZERO_HIST();
                    for (int c0 = 0; c0 < nvp; c0 += 256) { const f32x4 s4 = *(const LAS f32x4*)(srow + c0 + lane * 4);
#pragma unroll
                        for (int e_ = 0; e_ < 4; ++e_) { const float s = s4[e_]; int cls; IDX_CLASSIFY(s, cls);
                            if (c0 + lane * 4 + e_ < nv && cls == 1) __hip_atomic_fetch_add(hist + idx_bin(s, lo, scale), 1, __ATOMIC_RELAXED, __HIP_MEMORY_SCOPE_WORKGROUP); } }
                    int bin, nneed, mmc; IDX_HIST_SCAN(bin, nneed, mmc, 0);
                    if (nlev == 0) { lo1 = lo; sc1 = scale; b1 = bin; } else if (nlev == 1) { lo2 = lo; sc2 = scale; b2 = bin; } else { lo3 = lo; sc3 = scale; b3 = bin; }
                    ++nlev; need = nneed; m = mmc;
                    const float w = width * (1.0f / 256.0f); lo = lo + (float)bin * w; hi = lo + w;
                }
#undef IDX_HIST_SCAN
#undef IDX_ZERO_HIST
                PROBE_END(4);
                PROBE_BEGIN(5);
                int base = 0, nc = 0;
                for (int c0 = 0; c0 < nvp; c0 += 256) { const f32x4 s4 = *(const LAS f32x4*)(srow + c0 + lane * 4);
                    bool su[4], ca[4]; int nsu = 0, nca = 0;
#pragma unroll
                    for (int e_ = 0; e_ < 4; ++e_) { const bool valid = c0 + lane * 4 + e_ < nv; int cls; IDX_CLASSIFY(s4[e_], cls); su[e_] = valid && cls == 2; ca[e_] = valid && cls == 1; nsu += su[e_] ? 1 : 0; nca += ca[e_] ? 1 : 0; }
                    unsigned long long bs4[4], bc4[4]; int ps = base, pc = nc, tots = 0, totc = 0;
#pragma unroll
                    for (int e_ = 0; e_ < 4; ++e_) { bs4[e_] = __ballot(su[e_]); bc4[e_] = __ballot(ca[e_]); ps += __popcll(bs4[e_] & lt_mask); pc += __popcll(bc4[e_] & lt_mask); tots += __popcll(bs4[e_]); totc += __popcll(bc4[e_]); }
#pragma unroll
                    for (int e_ = 0; e_ < 4; ++e_) { const int key = c0 + lane * 4 + e_;
                        if (su[e_]) { if (ps < 256) out[ps] = (unsigned short)key; ++ps; }
                        if (ca[e_]) { if (pc < 256) { candv[pc] = s4[e_]; candi[pc] = (unsigned short)key; } ++pc; } }
                    base += tots; nc += totc; }
#undef IDX_CLASSIFY
                PROBE_END(5);
                PROBE_BEGIN(6);
                const int mcap = nc < 256 ? nc : 256;
                float T = -INFINITY; int need_t = need;
                if (nc <= 256) {
                    float mine[4]; int cgt[4], cge[4];
#pragma unroll
                    for (int k = 0; k < 4; ++k) { mine[k] = (lane + 64 * k) < mcap ? candv[lane + 64 * k] : -INFINITY; cgt[k] = 0; cge[k] = 0; }
                    if (lane < 4 && mcap + lane < 260) candv[mcap + lane] = -INFINITY;
                    const int nk = (mcap + 63) >> 6;
                    for (int j = 0; j < mcap; j += 4) { const f32x4 vj = *(const LAS f32x4*)(candv + j);
#pragma unroll
                        for (int k = 0; k < 4; ++k) { if (k < nk) {
#pragma unroll
                            for (int e_ = 0; e_ < 4; ++e_) { cgt[k] += vj[e_] > mine[k] ? 1 : 0; cge[k] += vj[e_] >= mine[k] ? 1 : 0; } } } }
                    float tv = -INFINITY; int tg = 0; bool isT = false;
#pragma unroll
                    for (int k = 0; k < 4; ++k) { const bool ok = ((lane + 64 * k) < mcap) && (cgt[k] < need) && (need <= cge[k]); if (ok && !isT) { isT = true; tv = mine[k]; tg = cgt[k]; } }
                    const unsigned long long bT = __ballot(isT);
                    const int sl = __ffsll((long long)bT) - 1;
                    T = __shfl(tv, sl); need_t = need - __shfl(tg, sl);
                }
                int ties = 0;
                for (int c0 = 0; c0 < mcap; c0 += 64) { const int j = c0 + lane; const bool valid = j < mcap; const float s = valid ? candv[j] : -INFINITY;
                    const bool sure = valid && (nc <= 256) && s > T;
                    const bool tie = valid && ((nc <= 256) ? (s == T) : true);
                    const unsigned long long beq = __ballot(tie);
                    const int rank = ties + __popcll(beq & lt_mask);
                    const bool take = sure || (tie && rank < need_t);
                    const unsigned long long bt = __ballot(take);
                    const int pos = base + __popcll(bt & lt_mask);
                    if (take && pos < 256) out[pos] = candi[j];
                    base += __popcll(bt); ties += __popcll(beq); }
                PROBE_END(6);
            }
            attn_query(qr, kr, vv, ao, n, out, (LAS unsigned char*)(sc + wid * 4096), lane);
        }
        PROBE_END(7);
        PROBE_BEGIN(8);
        __syncthreads();
        PROBE_END(8);
    }
    PROBE_END(9);
    PROBE_STORE(ws, bid, tid);
}

__device__ __forceinline__ void phase_attn2(const Params& p, LAS unsigned char* lds, int bid, int nb) {
    const int tid = opaque_tid(), wid = tid >> 6, lane = tid & 63, fr = lane & 15, g = lane >> 4;
    unsigned char* ws = p.ws;
    const bf16_t* qr = (const bf16_t*)(ws + OFF_BUF64); const bf16_t* kr = (const bf16_t*)(ws + OFF_KR); const bf16_t* vv = (const bf16_t*)(ws + OFF_VV);
    const unsigned short* idx = (const unsigned short*)(ws + OFF_IDX);
    bf16_t* ao = (bf16_t*)(ws + OFF_PD);
    LAS unsigned char* vbuf = lds + wid * 16384;
    LAS unsigned short* ks = (LAS unsigned short*)(lds + 131072) + wid * 256;
    const int q4 = fr >> 2, p4 = fr & 3;
    int n = bid * 8 + wid;
    u32x2 nidx = (u32x2){0u, 0u};
    if (n < NTOK) nidx = *(const u32x2*)(idx + (size_t)n * 256 + lane * 4);
    for (; n < NTOK; n += nb * 8) {
        const int t = n & (SEQ - 1), b = n >> 12, cnt = (t + 1) < 256 ? (t + 1) : 256;
        asm volatile("" ::: "memory");
        *(LAS u32x2*)(ks + lane * 4) = nidx;
        { const int nn = n + nb * 8; int l4 = lane * 4; asm volatile("" : "+v"(l4)); if (nn < NTOK) nidx = *(const u32x2*)(idx + (size_t)nn * 256 + l4); }
        bf16x8 qf[4];
#pragma unroll
        for (int s = 0; s < 4; ++s) { qf[s] = (bf16x8){0, 0, 0, 0, 0, 0, 0, 0}; if (fr < 8) qf[s] = *(const bf16x8*)(qr + (size_t)n * 1024 + fr * 128 + s * 32 + g * 8); }
        const bf16_t* kbase = kr + (size_t)b * SEQ * 128; const bf16_t* vbase = vv + (size_t)b * SEQ * 128;
        f32x4 acc[16];
        bf16x8 kf[3][2][4];
#define ATT_KLOAD(buf, grp) do { _Pragma("unroll") for (int t2 = 0; t2 < 2; ++t2) { const int j_ = ((grp) * 2 + t2) * 16 + fr; const int key_ = j_ < cnt ? (int)ks[j_] : 0; \
            const bf16_t* kp_ = kbase + (size_t)key_ * 128 + g * 8; _Pragma("unroll") for (int s = 0; s < 4; ++s) kf[buf][t2][s] = *(const bf16x8*)(kp_ + s * 32); } } while (0)
        ATT_KLOAD(0, 0); ATT_KLOAD(1, 1);
#pragma unroll
        for (int grp = 0; grp < 8; ++grp) {
            if (grp + 2 < 8) ATT_KLOAD((grp + 2) % 3, grp + 2);
#pragma unroll
            for (int t2 = 0; t2 < 2; ++t2) { f32x4 a = fzero4();
#pragma unroll
                for (int s = 0; s < 4; ++s) a = __builtin_amdgcn_mfma_f32_16x16x32_bf16(kf[grp % 3][t2][s], qf[s], a, 0, 0, 0);
                acc[grp * 2 + t2] = a; }
        }
#undef ATT_KLOAD
        u32x4 vr[2][8];
#define ATT_VLOAD(buf, s) do { _Pragma("unroll") for (int i = 0; i < 8; ++i) { const int kl_ = i * 4 + g; const int jj_ = (s) * 32 + kl_; const int key_ = jj_ < cnt ? (int)ks[jj_] : 0; \
            const int c_ = fr ^ ((kl_ & 7) << 1); vr[buf][i] = *(const u32x4*)(vbase + (size_t)key_ * 128 + c_ * 8); } } while (0)
        ATT_VLOAD(0, 0);
        float m = -INFINITY;
#pragma unroll
        for (int tl = 0; tl < 16; ++tl)
#pragma unroll
            for (int r = 0; r < 4; ++r) { if (tl * 16 + g * 4 + r >= cnt) acc[tl][r] = -INFINITY; m = fmaxf(m, acc[tl][r]); }
        m = fmaxf(m, __shfl_xor(m, 16)); m = fmaxf(m, __shfl_xor(m, 32));
        float sum = 0.f;
#pragma unroll
        for (int tl = 0; tl < 16; ++tl)
#pragma unroll
            for (int r = 0; r < 4; ++r) { const float e_ = __expf(acc[tl][r] - m); acc[tl][r] = e_; sum += e_; }
        sum += __shfl_xor(sum, 16); sum += __shfl_xor(sum, 32);
        const float inv = 1.0f / sum;
        bf16x8 pf[8];
#pragma unroll
        for (int s = 0; s < 8; ++s) pf[s] = pack_8g(acc[2 * s], acc[2 * s + 1]);
        f32x4 o[8];
#pragma unroll
        for (int dt = 0; dt < 8; ++dt) o[dt] = fzero4();
#pragma unroll
        for (int s = 0; s < 8; ++s) {
            LAS unsigned char* vb = vbuf + (s & 1) * 8192;
            if (s + 1 < 8) ATT_VLOAD((s + 1) & 1, s + 1);
#pragma unroll
            for (int i = 0; i < 8; ++i) { const int kl = i * 4 + g; *(LAS u32x4*)(vb + kl * 256 + fr * 16) = vr[s & 1][i]; }
            const int kl1 = 4 * g + q4, kl2 = 16 + 4 * g + q4;
#pragma unroll
            for (int dt = 0; dt < 8; ++dt) {
                const int c = 2 * dt + (p4 >> 1);
                const s16x4 lo = __builtin_amdgcn_ds_read_tr16_b64_v4i16((LAS s16x4*)(vb + kl1 * 256 + ((c ^ ((kl1 & 7) << 1)) * 16) + (p4 & 1) * 8));
                const s16x4 hi = __builtin_amdgcn_ds_read_tr16_b64_v4i16((LAS s16x4*)(vb + kl2 * 256 + ((c ^ ((kl2 & 7) << 1)) * 16) + (p4 & 1) * 8));
                const bf16x8 af = (bf16x8){lo[0], lo[1], lo[2], lo[3], hi[0], hi[1], hi[2], hi[3]};
                o[dt] = __builtin_amdgcn_mfma_f32_16x16x32_bf16(af, pf[s], o[dt], 0, 0, 0);
            }
        }
#undef ATT_VLOAD
        if (fr < 8) {
#pragma unroll
            for (int dt = 0; dt < 8; ++dt) { u32x2 w; w.x = cvt_pk_bf16(o[dt][0] * inv, o[dt][1] * inv); w.y = cvt_pk_bf16(o[dt][2] * inv, o[dt][3] * inv);
                *(u32x2*)(ao + (size_t)n * 1024 + fr * 128 + dt * 16 + g * 4) = w; }
        }
    }
}

__device__ __forceinline__ void phase_inproj_even(const Params& p, LAS unsigned char* lds, int bid, int nb) {
    unsigned char* ws = p.ws;
    pg::DenseSched S; S.init(ws + OFF_BUF64, ws + OFF_WINE, NTOK, NE_MAIN, 1024, nb, bid);
    pg::EpiBf16 E; E.O = (bf16_t*)(ws + OFF_P); E.ldc = NE_MAIN;
    pg::gemm_phase(lds, 1024, S, E);
}
__device__ __forceinline__ void phase_inproj_odd(const Params& p, LAS unsigned char* lds, int bid, int nb) {
    unsigned char* ws = p.ws;
    pg::DenseSched S; S.init(ws + OFF_BUF64, ws + OFF_WINO, NTOK, NO_MAIN, 1024, nb, bid);
    pg::EpiBf16 E; E.O = (bf16_t*)(ws + OFF_PD); E.ldc = NO_MAIN;
    pg::gemm_phase(lds, 1024, S, E);
}
__device__ __forceinline__ void phase_outproj(const Params& p, LAS unsigned char* lds, int bid, int nb, size_t aoff, size_t woff, const float* X) {
    unsigned char* ws = p.ws;
    pg::DenseSched S; S.init(ws + aoff, ws + woff, NTOK, 1024, 1024, nb, bid);
    pg::EpiResid E; E.X = X; E.U = (float*)(ws + OFF_U);
    pg::gemm_phase(lds, 1024, S, E);
}

#define XB_TMO      128
#define XB_XCNT(j)  (256  + 64 * (j))
#define XB_XSUB(j)  (1280 + 64 * (j))
#define XB_XGEN(j)  (2304 + 64 * (j))
#define XB_TOP      3328
#define XB_TOPGEN   3392
#define XCD_BAR_WORDS 3456
#define XB_SPIN_CAP (1u << 20)
__device__ __forceinline__ unsigned xb_ld(unsigned* p)              { return __hip_atomic_load(p, __ATOMIC_RELAXED, __HIP_MEMORY_SCOPE_AGENT); }
__device__ __forceinline__ unsigned xb_add(unsigned* p, unsigned v) { return __hip_atomic_fetch_add(p, v, __ATOMIC_RELAXED, __HIP_MEMORY_SCOPE_AGENT); }
__device__ __forceinline__ unsigned xb_xcc_id() { return (unsigned)__builtin_amdgcn_s_getreg((3 << 11) | 20) & 0xFu; }
#define XB_SPIN(cond, bar) do { unsigned _sp = 0; while (cond) { __builtin_amdgcn_s_sleep(1); \
    if ((++_sp & 255u) == 0u) { if (xb_ld(&(bar)[XB_TMO])) break; if (_sp > XB_SPIN_CAP) { atomicAdd(&(bar)[XB_TMO], 1u); break; } } } } while (0)
__device__ __forceinline__ void xcd_barrier_complete(unsigned* bar, unsigned x, unsigned& nloc, unsigned& nx) {
    const unsigned G = gridDim.x;
    unsigned sum, cnt, mine, sp = 0u;
    for (;;) {
        sum = 0u; cnt = 0u; mine = 0u;
#pragma unroll
        for (unsigned j = 0; j < 16; ++j) { const unsigned c = xb_ld(&bar[XB_XCNT(j)]); sum += c; cnt += (c > 0u) ? 1u : 0u; mine = (j == x) ? c : mine; }
        if (sum == G) break;
        __builtin_amdgcn_s_sleep(1);
        if ((++sp & 255u) == 0u) { if (xb_ld(&bar[XB_TMO])) break; if (sp > XB_SPIN_CAP) { atomicAdd(&bar[XB_TMO], 1u); break; } }
    }
    nloc = mine > 0u ? mine : 1u; nx = cnt > 0u ? cnt : 1u;
}
__device__ __forceinline__ void grid_barrier(unsigned* bar, volatile LAS unsigned* st) {
    asm volatile("s_waitcnt vmcnt(0) lgkmcnt(0)" ::: "memory");
    __syncthreads();
    if (threadIdx.x == 0) {
        const unsigned x = xb_xcc_id();
        __builtin_amdgcn_s_waitcnt(0);
        unsigned nloc = st[0], nx = st[1];
        if (nloc == 0u) { xcd_barrier_complete(bar, x, nloc, nx); st[0] = nloc; st[1] = nx; }
        const unsigned old = xb_add(&bar[XB_XSUB(x)], 1u);
        const unsigned gen = old / nloc;
        if (old + 1u == (gen + 1u) * nloc) {
            __builtin_amdgcn_fence(__ATOMIC_RELEASE, "agent");
            asm volatile("s_waitcnt vmcnt(0)" ::: "memory");
            const unsigned og = xb_add(&bar[XB_TOP], 1u);
            const unsigned tg = og / nx;
            if (og + 1u == (tg + 1u) * nx) xb_add(&bar[XB_TOPGEN], 1u);
            else XB_SPIN(xb_ld(&bar[XB_TOPGEN]) == tg, bar);
            __builtin_amdgcn_fence(__ATOMIC_ACQUIRE, "agent");
            xb_add(&bar[XB_XGEN(x)], 1u);
            asm volatile("s_waitcnt vmcnt(0)" ::: "memory");
        } else {
            XB_SPIN(xb_ld(&bar[XB_XGEN(x)]) == gen, bar);
            __builtin_amdgcn_fence(__ATOMIC_ACQUIRE, "agent");
            asm volatile("s_waitcnt vmcnt(0)" ::: "memory");
        }
    }
    __syncthreads();
}
#ifndef DUP
#define DUP 0
#endif
#define GSYNC() grid_barrier(bar_ctr, (volatile LAS unsigned*)(lds + LDS_BYTES - 1024))
__global__ __launch_bounds__(512, 2) void mega(KArgs a) {
    extern __shared__ __attribute__((aligned(16))) unsigned char smem[];
    LAS unsigned char* lds = (LAS unsigned char*)smem;
    Params p; p.in.t = (LAS const unsigned long long*)(lds + PTAB_OFF); p.out = a.out; p.ws = a.ws;
    if ((threadIdx.x & 63) == 0) ((LAS int*)(lds + WTAB_OFF))[hw_slot()] = threadIdx.x >> 6;
    if (threadIdx.x == 0) { LAS unsigned long long* tw_ = (LAS unsigned long long*)(lds + PTAB_OFF);
#pragma unroll
        for (int i = 0; i < 30; ++i) tw_[i] = (unsigned long long)a.in[i]; }
    __syncthreads();
    cg::grid_group grid = cg::this_grid();
    const int bid0 = blockIdx.x, nb0 = gridDim.x;
    unsigned* bar_ctr = (unsigned*)(p.ws + OFF_MISC + MISC_BAR);
    if (blockIdx.x == 0) for (int i = threadIdx.x; i < XCD_BAR_WORDS; i += 512) __hip_atomic_store(bar_ctr + i, 0u, __ATOMIC_RELAXED, __HIP_MEMORY_SCOPE_AGENT);
    if (threadIdx.x < 2) ((LAS unsigned*)(lds + LDS_BYTES - 1024))[threadIdx.x] = 0u;
    grid.sync();
    if (threadIdx.x == 0) (void)xb_add(&bar_ctr[XB_XCNT(xb_xcc_id())], 1u);
    int bid, nb;
#define FRESH() do { bid = bid0; nb = nb0; asm volatile("" : "+s"(bid), "+s"(nb)); } while (0)
#define PHP(pid, call) do { unsigned long long t0_ = 0; if (PROBE_ID == (pid)) t0_ = __builtin_amdgcn_s_memtime(); call; if (PROBE_ID == (pid) && bid0 == (PROBE_BLK) && opaque_tid() == 0) *(float*)(p.ws + OFF_MISC + MISC_PROBE) = (float)(__builtin_amdgcn_s_memtime() - t0_) * 3e-8f; } while (0)
#define RUNP(id, call) do { FRESH(); call; GSYNC(); if (DUP == id) { FRESH(); call; GSYNC(); } } while (0)
    RUNP(10, PHP(30, phase_prep(p, lds, bid, nb, 0)));
#if PROBE_ID == 20
    const unsigned long long kstart = __builtin_amdgcn_s_memtime();
#endif
#pragma unroll 1
    for (int layer = 0; layer < 2; ++layer) {
        if (layer == 0) {
            FRESH(); PHP(31, phase_inproj_even(p, lds, bid, nb));
            GSYNC();
            RUNP(21, PHP(44, phase_lora_act(p, bid, nb)));
            PHP(45, RUNP(1, PHP(33, phase_mixer_even(p, lds, bid, nb, 0))));
            FRESH(); PHP(34, phase_rwkv_epi(p, bid, nb));
            RUNP(13, PHP(46, phase_gla_fix(p, lds, bid, nb)));
        } else {
            RUNP(14, PHP(40, phase_inproj_odd(p, lds, bid, nb)));
            RUNP(15, PHP(41, phase_rope(p, bid, nb)));
            RUNP(2, PHP(43, phase_index2(p, lds, bid, nb)));
        }
        RUNP(16, PHP(35, phase_outproj(p, lds, bid, nb, layer ? OFF_PD : OFF_BUF64, layer ? OFF_WOUTO : OFF_WOUTE, layer ? p.out : p.in[I_X])));
        FRESH(); PHP(36, phase_ln_route(p, lds, bid, nb, layer));
        GSYNC();
        RUNP(17, PHP(37, phase_moe_gateup(p, lds, bid, nb, layer)));
        RUNP(18, PHP(38, phase_moe_down(p, lds, bid, nb, layer)));
#if PROBE_ID == 20
        if (layer == 1) { if (bid0 == 7 && threadIdx.x == 0) *(float*)(p.ws + OFF_MISC + MISC_PROBE) = (float)(__builtin_amdgcn_s_memtime() - kstart) * 1e-8f; GSYNC(); }
#endif
        RUNP(19, PHP(39, phase_ln2(p, bid, nb, layer, p.out, true)));
    }
}

extern "C" void kernel_launch(void* const* d_in, const int* in_sizes, int n_in, void* d_out, int out_size, void* d_ws, size_t ws_size, hipStream_t stream) {
    if (ws_size < WS_NEED) { fprintf(stderr, "workspace too small: %zu < %zu\n", ws_size, (size_t)WS_NEED); return; }
    KArgs p{};
    for (int i = 0; i < 30; ++i) p.in[i] = (const float*)d_in[i];
    p.out = (float*)d_out; p.ws = (unsigned char*)d_ws;
    static int grid_blocks = 0;
    if (!grid_blocks) {
        (void)hipFuncSetAttribute((const void*)mega, hipFuncAttributeMaxDynamicSharedMemorySize, LDS_BYTES);
        int dev = 0, cus = 0, per_cu = 0;
        (void)hipGetDevice(&dev);
        (void)hipDeviceGetAttribute(&cus, hipDeviceAttributeMultiprocessorCount, dev);
        (void)hipOccupancyMaxActiveBlocksPerMultiprocessor(&per_cu, mega, 512, LDS_BYTES);
        if (per_cu < 1) { fprintf(stderr, "occupancy query returned %d\n", per_cu); per_cu = 1; }
        grid_blocks = cus;
    }
    void* args[] = {&p};
    hipError_t e = hipLaunchCooperativeKernel((void*)mega, dim3(grid_blocks), dim3(512), args, LDS_BYTES, stream);
    if (e != hipSuccess) fprintf(stderr, "cooperative launch failed: %s (grid %d)\n", hipGetErrorString(e), grid_blocks);
}
```

```cpp
#include <hip/hip_runtime.h>
#include <hip/hip_cooperative_groups.h>
#include <cstdio>
#include <cstdint>
namespace cg = cooperative_groups;

#ifndef PROBE_ID
#define PROBE_ID 0
#endif
#ifndef PROBE_BLK
#define PROBE_BLK 7
#endif
#ifndef IDXPROBE
#define IDXPROBE 0
#endif
#ifndef SANITIZE
#define SANITIZE 0
#endif
#ifndef PREP_REP
#define PREP_REP 1
#endif
constexpr int NTOK = 32768, SEQ = 4096, NB = 8, DM = 1024;
constexpr int EVEN_COLS = 3344, ODD_COLS = 1604;
constexpr int NE_MAIN = 3328;
constexpr int NO_MAIN = 1792;
constexpr int NEXP = 16, DEXP = 256;
constexpr float DN_ALPHA = 1.4142135623730951f;
constexpr float LN_EPS = 1e-5f;
constexpr int MOE_ROWS = 65536 + 16 * 256;

typedef unsigned short bf16_t;
typedef short bf16x8 __attribute__((ext_vector_type(8)));
typedef float f32x4 __attribute__((ext_vector_type(4)));
typedef short s16x4 __attribute__((ext_vector_type(4)));
typedef float f32x2 __attribute__((ext_vector_type(2)));
typedef unsigned u32x4 __attribute__((ext_vector_type(4)));
typedef unsigned u32x2 __attribute__((ext_vector_type(2)));
#define LAS __attribute__((address_space(3)))

typedef __bf16 bf16x2_t __attribute__((ext_vector_type(2)));
__device__ __forceinline__ unsigned cvt_pk_bf16(float lo, float hi) { bf16x2_t v; v[0] = (__bf16)lo; v[1] = (__bf16)hi; return __builtin_bit_cast(unsigned, v); }
__device__ __forceinline__ bf16_t f2bf(float f) { return (bf16_t)(cvt_pk_bf16(f, 0.f) & 0xffffu); }
__device__ __forceinline__ float bf2f(bf16_t h) { return __uint_as_float(((unsigned)h) << 16); }
constexpr int LDS_BYTES = 160 * 1024;
constexpr int PTAB_OFF = LDS_BYTES - 256;
constexpr int WTAB_OFF = LDS_BYTES - 512;
__device__ __forceinline__ int hw_slot() { return (int)(__builtin_amdgcn_s_getreg(0x2804) & 63u); }
__device__ __forceinline__ int opaque_tid() {
    extern __shared__ __attribute__((aligned(16))) unsigned char smem_[];
    const int w = __builtin_amdgcn_readfirstlane(((LAS const int*)((LAS unsigned char*)smem_ + WTAB_OFF))[hw_slot()]);
    int l; asm volatile("v_mbcnt_lo_u32_b32 %0, -1, 0\n\tv_mbcnt_hi_u32_b32 %0, -1, %0" : "=v"(l));
    return (w << 6) | l; }
#if PROBE_ID
#define PROBE_DECL unsigned long long probe_acc = 0, probe_t0 = 0
#define PROBE_BEGIN(id) do { if (PROBE_ID == (id)) probe_t0 = __builtin_amdgcn_s_memtime(); } while (0)
#define PROBE_END(id) do { if (PROBE_ID == (id)) probe_acc += __builtin_amdgcn_s_memtime() - probe_t0; } while (0)
#define PROBE_STORE(ws, bid, tid) do { if (PROBE_ID < 30 && (bid) == 7 && (tid) == 0) *(float*)((ws) + OFF_MISC + MISC_PROBE) = (float)probe_acc * 1e-6f; } while (0)
#else
#define PROBE_DECL
#define PROBE_BEGIN(id)
#define PROBE_END(id)
#define PROBE_STORE(ws, bid, tid)
#endif
__device__ __forceinline__ f32x4 fzero4() { float z = 0.f; asm volatile("" : "+v"(z)); return (f32x4){z, z, z, z}; }
__device__ __forceinline__ u32x4 uzero4() { unsigned z = 0u; asm volatile("" : "+v"(z)); return (u32x4){z, z, z, z}; }
__device__ __forceinline__ float fast_rcp(float x) { return __builtin_amdgcn_rcpf(x); }
__device__ __forceinline__ float fast_sigmoid(float x) { return fast_rcp(1.0f + __expf(-x)); }
__device__ __forceinline__ float fast_tanh(float x) { const float e = __expf(2.0f * x); return 1.0f - 2.0f * fast_rcp(1.0f + e); }
__device__ __forceinline__ bf16x8 pack_8g(const f32x4 a, const f32x4 b) { u32x4 w; w.x = cvt_pk_bf16(a[0], a[1]); w.y = cvt_pk_bf16(a[2], a[3]); w.z = cvt_pk_bf16(b[0], b[1]); w.w = cvt_pk_bf16(b[2], b[3]); return __builtin_bit_cast(bf16x8, w); }
template <int CTRL> __device__ __forceinline__ float dppf(float v) { return __builtin_bit_cast(float, __builtin_amdgcn_update_dpp(0, __builtin_bit_cast(int, v), CTRL, 0xf, 0xf, true)); }
__device__ __forceinline__ float wave_sum(float v) {
#pragma unroll
    for (int o = 32; o > 0; o >>= 1) v += __shfl_xor(v, o);
    return v;
}

constexpr size_t MiB = 1024ull * 1024ull;
constexpr size_t OFF_WINE = 0;
constexpr size_t OFF_WOUTE = OFF_WINE + (size_t)NE_MAIN * 1024 * 2;
constexpr size_t OFF_WINO = OFF_WOUTE + 2 * MiB;
constexpr size_t OFF_WOUTO = OFF_WINO + (size_t)NO_MAIN * 1024 * 2;
constexpr size_t OFF_WGU = OFF_WOUTO + 2 * MiB;
constexpr size_t OFF_WD = OFF_WGU + 32 * MiB;
constexpr size_t OFF_ROPE = OFF_WD + 16 * MiB;
constexpr size_t OFF_MISC = OFF_ROPE + 3 * MiB;
constexpr size_t OFF_BUF64 = OFF_MISC + 4 * MiB;
constexpr size_t OFF_P = OFF_BUF64 + 64 * MiB;
constexpr size_t OFF_U = OFF_P + 208 * MiB;
constexpr size_t WS_NEED = OFF_U + 128 * MiB;
constexpr size_t OFF_HE = OFF_P;
constexpr size_t OFF_ACT = OFF_HE + (size_t)MOE_ROWS * 1024 * 2;
constexpr size_t OFF_PD = OFF_P;
constexpr size_t OFF_KR = OFF_P + 112 * MiB;
constexpr size_t OFF_VV = OFF_KR + 8 * MiB;
constexpr size_t OFF_IQR = OFF_VV + 8 * MiB;
constexpr size_t OFF_IKR = OFF_IQR + 16 * MiB;
constexpr size_t OFF_IW = OFF_IKR + 4 * MiB;
constexpr size_t OFF_IDX = OFF_IW + 1 * MiB;
constexpr size_t MISC_CNT = 0;
constexpr size_t MISC_TOKINFO = 4096;
constexpr size_t MISC_TOKGATE = MISC_TOKINFO + (size_t)NTOK * 16;
constexpr size_t MISC_LIST = MISC_TOKGATE + (size_t)NTOK * 8;
constexpr size_t MISC_PROBE = 2304;
constexpr size_t MISC_W2T = 3 * MiB;
constexpr size_t MISC_A2T = MISC_W2T + 65536;
constexpr size_t MISC_G2T = MISC_A2T + 65536;
constexpr size_t MISC_BAR = MISC_G2T + 131072;
constexpr size_t MISC_RWF = MISC_BAR + 16384;
constexpr size_t MISC_PCTR = MISC_RWF + 16384;
constexpr size_t OFF_GLA_ORAW = OFF_U + 50 * MiB;
constexpr size_t OFF_GLA_QDG = OFF_U + 82 * MiB;
constexpr size_t OFF_GLA_SIN = OFF_U + 90 * MiB;
constexpr size_t OFF_RWXB = OFF_U + 24 * MiB;

struct InTab { LAS const unsigned long long* t;
    __device__ __forceinline__ const float* operator[](int i) const { const unsigned long long v = t[i];
        const unsigned lo = __builtin_amdgcn_readfirstlane((unsigned)v), hi = __builtin_amdgcn_readfirstlane((unsigned)(v >> 32));
        return (const float*)(((unsigned long long)hi << 32) | lo); } };
struct Params { InTab in; float* out; unsigned char* ws; };
struct KArgs { const float* in[30]; float* out; unsigned char* ws; };
enum { I_X = 0, I_WINE, I_AMU, I_AW0, I_AW2, I_AA0, I_AA2, I_AG2, I_AKK, I_AKA, I_ARK, I_AGNG, I_AGNB, I_BGW2, I_BGB, I_BNG, I_WOUTE,
       I_WINO, I_CIKG, I_CIKB, I_WOUTO, I_LN1G, I_LN1B, I_LN2G, I_LN2B, I_RW, I_RB, I_EG, I_EU, I_ED };

namespace pg {
constexpr int BM = 256, BK = 64, HALF = 128, HTB = HALF * BK * 2, STAGE_BYTES = 8 * HTB;
__host__ __device__ __forceinline__ int lds_byte(int r, int c) { const int st = (r >> 4) * 2 + (c >> 5), rr = r & 15, cc = c & 31, ob = rr * 64 + cc * 2; return st * 1024 + (ob ^ (((ob >> 9) & 1) << 5)); }
__host__ __device__ __forceinline__ void stage_rc(int b, int& R, int& C) { const int st = b / 1024, sb = b % 1024, swz = sb ^ (((sb >> 9) & 1) << 5); R = (st >> 1) * 16 + swz / 64; C = (st & 1) * 32 + (swz % 64) / 2; }
__host__ __device__ __forceinline__ int perm32(int rho) { const int n = rho >> 4, i = rho & 15; return 8 * (i >> 2) + 4 * n + (i & 3); }

struct Unit { int pm, pn, e, rt, cnt; };

template <class Epi, class Sched>
__device__ __forceinline__ void gemm_phase(LAS unsigned char* lds, const int K, const Sched& S, const Epi& E) {
    const int tid = opaque_tid(), wid = __builtin_amdgcn_readfirstlane(tid >> 6), lane = tid & 63, wr = wid >> 2, wc = wid & 3, fr = lane & 15, fq = lane >> 4;
    const int nt = K / BK;
    unsigned voffB[2];
#pragma unroll
    for (int i = 0; i < 2; ++i) { int R, C; stage_rc(tid * 16 + i * 8192, R, C); const int Rb = Epi::PERM ? ((R & ~31) + perm32(R & 31)) : R; voffB[i] = (unsigned)(Rb * K + C) * 2u; }
    const size_t kstep = (size_t)(BK * 2);
    const size_t hstepB = (size_t)HALF * K * 2;
    const unsigned ldsw = (unsigned)wid * 1024u;
    const int aoff = lds_byte(wr * 64 + fr, fq * 8), boff = lds_byte(wc * 32 + fr, fq * 8);
#define PG_SA(b, h) (((b) * 2 + (h)) * HTB)
#define PG_SB(b, h) ((4 + (b) * 2 + (h)) * HTB)
#define PG_STAGE(bufoff, gbase, voff) do { _Pragma("unroll") for (int _i = 0; _i < 2; ++_i) \
        __builtin_amdgcn_global_load_lds((const unsigned*)((const char*)(gbase) + (voff)[_i]), (LAS unsigned*)(lds + (bufoff) + ldsw + _i * 8192), 16, 0, 0); } while (0)
#define PG_LDA(dst, b, h) do { _Pragma("unroll") for (int m = 0; m < 4; ++m) _Pragma("unroll") for (int k = 0; k < 2; ++k) dst[m][k] = *(const LAS bf16x8*)(lds + PG_SA(b, h) + aoff + m * 2048 + k * 1024); } while (0)
#define PG_LDB(dst, b, h) do { _Pragma("unroll") for (int n = 0; n < 2; ++n) _Pragma("unroll") for (int k = 0; k < 2; ++k) dst[n][k] = *(const LAS bf16x8*)(lds + PG_SB(b, h) + boff + n * 2048 + k * 1024); } while (0)
#define PG_MMA(ai, bj, At, Bt) do { __builtin_amdgcn_s_setprio(1); _Pragma("unroll") for (int m = 0; m < 4; ++m) _Pragma("unroll") for (int n = 0; n < 2; ++n) _Pragma("unroll") for (int k = 0; k < 2; ++k) \
        acc[ai][bj][m][n] = __builtin_amdgcn_mfma_f32_16x16x32_bf16(Bt[n][k], At[m][k], acc[ai][bj][m][n], 0, 0, 0); __builtin_amdgcn_s_setprio(0); } while (0)
#define PG_WAIT_V(n) asm volatile("s_waitcnt vmcnt(" #n ")" ::: "memory")
#define PG_WAIT_L(n) asm volatile("s_waitcnt lgkmcnt(" #n ")" ::: "memory")
#define PG_BAR __builtin_amdgcn_s_barrier()
#define PG_SCHED __builtin_amdgcn_sched_barrier(0)
#define PG_AOFF(dst0, dst1, u) do { _Pragma("unroll") for (int _i = 0; _i < 2; ++_i) { int _R, _C; stage_rc(tid * 16 + _i * 8192, _R, _C); \
        dst0[_i] = S.a_rowoff(u, 0, _R) + (unsigned)_C * 2u; dst1[_i] = S.a_rowoff(u, 1, _R) + (unsigned)_C * 2u; } } while (0)
    Unit cur, nxt; int ui = 0;
    if (!S.next(0, cur)) return;
    f32x4 acc[2][2][4][2];
#pragma unroll
    for (int a = 0; a < 2; ++a)
#pragma unroll
        for (int b = 0; b < 2; ++b)
#pragma unroll
            for (int m = 0; m < 4; ++m)
#pragma unroll
                for (int n = 0; n < 2; ++n) acc[a][b][m][n] = (f32x4){0.f, 0.f, 0.f, 0.f};
    bf16x8 At[4][2], B0[2][2], B1[2][2];
    const char* const Ab = S.a_base();
    unsigned aC0[2], aC1[2];
    PG_AOFF(aC0, aC1, cur);
    const char* cB = S.b_ptr(cur);
    PG_STAGE(PG_SB(0, 0), cB, voffB); PG_STAGE(PG_SA(0, 0), Ab, aC0); PG_STAGE(PG_SB(0, 1), cB + hstepB, voffB); PG_STAGE(PG_SA(0, 1), Ab, aC1);
    if (wr == 1) PG_BAR;
    PG_WAIT_V(4); PG_BAR;
    PG_STAGE(PG_SB(1, 0), cB + kstep, voffB); PG_STAGE(PG_SA(1, 0), Ab + kstep, aC0); PG_STAGE(PG_SB(1, 1), cB + hstepB + kstep, voffB);
    PG_WAIT_V(6); PG_BAR;
    for (;;) {
        const bool has_next = S.next(ui + 1, nxt);
        const char* nB = has_next ? S.b_ptr(nxt) : cB;
#pragma unroll 1
        for (int t = 0; t < nt; t += 2) {
            const bool last = (t == nt - 2);
            const char* a1 = Ab + (size_t)(t + 1) * kstep;
            const char* a2 = last ? Ab : Ab + (size_t)(t + 2) * kstep; const char* b2 = last ? nB : cB + (size_t)(t + 2) * kstep;
            const char* a3 = a2 + kstep; const char* b3 = b2 + kstep;
            PG_LDB(B0, 0, 0); PG_SCHED; PG_LDA(At, 0, 0); PG_STAGE(PG_SA(1, 1), a1, aC1);
            if (last && has_next) PG_AOFF(aC0, aC1, nxt);
            PG_WAIT_L(8); PG_BAR; PG_WAIT_L(0); PG_MMA(0, 0, At, B0); PG_BAR; PG_SCHED;
            PG_LDB(B1, 0, 1); PG_STAGE(PG_SB(0, 0), b2, voffB);
            PG_BAR; PG_WAIT_L(0); PG_MMA(0, 1, At, B1); PG_BAR;
            PG_LDA(At, 0, 1); PG_STAGE(PG_SA(0, 0), a2, aC0);
            PG_BAR; PG_WAIT_L(0); PG_MMA(1, 0, At, B0); PG_BAR; PG_SCHED;
            PG_STAGE(PG_SB(0, 1), b2 + hstepB, voffB);
            PG_WAIT_V(6); PG_BAR; PG_MMA(1, 1, At, B1); PG_BAR;
            PG_LDB(B0, 1, 0); PG_SCHED; PG_LDA(At, 1, 0); PG_STAGE(PG_SA(0, 1), a2, aC1);
            PG_WAIT_L(8); PG_BAR; PG_WAIT_L(0); PG_MMA(0, 0, At, B0); PG_BAR; PG_SCHED;
            PG_LDB(B1, 1, 1); PG_STAGE(PG_SB(1, 0), b3, voffB);
            PG_BAR; PG_WAIT_L(0); PG_MMA(0, 1, At, B1); PG_BAR;
            PG_LDA(At, 1, 1); PG_STAGE(PG_SA(1, 0), a3, aC0);
            PG_BAR; PG_WAIT_L(0); PG_MMA(1, 0, At, B0); PG_BAR; PG_SCHED;
            PG_STAGE(PG_SB(1, 1), b3 + hstepB, voffB);
            PG_WAIT_V(6); PG_BAR; PG_MMA(1, 1, At, B1); PG_BAR;
        }
        E(acc, cur, wr, wc, fr, fq);
        if (!has_next) break;
#pragma unroll
        for (int a = 0; a < 2; ++a)
#pragma unroll
            for (int b = 0; b < 2; ++b)
#pragma unroll
                for (int m = 0; m < 4; ++m)
#pragma unroll
                    for (int n = 0; n < 2; ++n) acc[a][b][m][n] = (f32x4){0.f, 0.f, 0.f, 0.f};
        cur = nxt; cB = nB; ++ui;
    }
    PG_WAIT_V(0);
    if (wr == 0) PG_BAR;
    PG_BAR;
#undef PG_SA
#undef PG_SB
#undef PG_STAGE
#undef PG_LDA
#undef PG_LDB
#undef PG_MMA
#undef PG_WAIT_V
#undef PG_WAIT_L
#undef PG_BAR
#undef PG_SCHED
#undef PG_AOFF
}

struct DenseSched {
    const char* A; const char* Bt; int K, nM, nN, nwg, G, c;
    __device__ void init(const void* A_, const void* Bt_, int M, int N, int K_, int G_, int c_) { A = (const char*)A_; Bt = (const char*)Bt_; K = K_; nM = M / BM; nN = N / BM; nwg = nM * nN; G = G_; c = c_; }
    __device__ __forceinline__ bool next(int i, Unit& u) const {
        const long L = (long)i * G + c; if (L >= nwg) return false;
        int wgid = (int)L; { const int q = nwg / 8, r = nwg % 8, xcd = wgid % 8, off = wgid / 8; wgid = (xcd < r ? xcd * (q + 1) : r * (q + 1) + (xcd - r) * q) + off; }
        const int nig = 8 * nN, gid = wgid / nig, fm = gid * 8, gsz = (nM - fm) < 8 ? (nM - fm) : 8;
        u.pm = fm + ((wgid % nig) % gsz); u.pn = (wgid % nig) / gsz; u.e = 0; u.rt = 0; u.cnt = 0; return true;
    }
    __device__ __forceinline__ const char* a_base() const { return A; }
    __device__ __forceinline__ unsigned a_rowoff(const Unit& u, int half, int R) const { return (unsigned)(u.pm * BM + half * HALF + R) * (unsigned)(K * 2); }
    __device__ __forceinline__ const char* b_ptr(const Unit& u) const { return Bt + (size_t)u.pn * BM * K * 2; }
};

__device__ __forceinline__ void moe_build_units(LAS int* tab, const int* cntp, int NCT, int G, int c) {
    const int i = opaque_tid();
    if (i < 16) {
        const int L = i * G + c; int accu = 0, rtb = 0, found = 0, pm = 0, pn = 0, ee = 0, rt = 0, cn = 0;
        for (int e = 0; e < 16; ++e) { const int ce = cntp[e], nte = (ce + 255) >> 8, ue = nte * NCT;
            if (!found && L < accu + ue) { const int local = L - accu; ee = e; rt = local / NCT; pn = local % NCT; pm = rtb + rt; cn = ce; found = 1; }
            accu += ue; rtb += nte; }
        tab[i * 8 + 0] = found; tab[i * 8 + 1] = pm; tab[i * 8 + 2] = pn; tab[i * 8 + 3] = ee; tab[i * 8 + 4] = rt; tab[i * 8 + 5] = cn;
    }
    __syncthreads();
}
template <bool GATHER>
struct MoeSched {
    const char* A; const char* Bt; const int* list; int K; size_t wstride; LAS int* tab;
    __device__ void init(const void* A_, const void* Bt_, size_t wstride_bytes, const int* list_, int K_, LAS int* tab_) {
        A = (const char*)A_; Bt = (const char*)Bt_; wstride = wstride_bytes; list = list_; K = K_; tab = tab_; }
    __device__ __forceinline__ bool next(int i, Unit& u) const {
        if (i >= 16) return false;
        const int f = __builtin_amdgcn_readfirstlane(tab[i * 8 + 0]);
        u.pm = __builtin_amdgcn_readfirstlane(tab[i * 8 + 1]); u.pn = __builtin_amdgcn_readfirstlane(tab[i * 8 + 2]); u.e = __builtin_amdgcn_readfirstlane(tab[i * 8 + 3]);
        u.rt = __builtin_amdgcn_readfirstlane(tab[i * 8 + 4]); u.cnt = __builtin_amdgcn_readfirstlane(tab[i * 8 + 5]);
        return f != 0;
    }
    __device__ __forceinline__ const char* a_base() const { return A; }
    __device__ __forceinline__ unsigned a_rowoff(const Unit& u, int half, int R) const {
        if (GATHER) { const int slot = u.rt * BM + half * HALF + R; const int tok = slot < u.cnt ? list[u.e * NTOK + slot] : 0; return (unsigned)tok * (unsigned)(K * 2); }
        return (unsigned)(u.pm * BM + half * HALF + R) * (unsigned)(K * 2);
    }
    __device__ __forceinline__ const char* b_ptr(const Unit& u) const { return Bt + (size_t)u.e * wstride + (size_t)u.pn * BM * K * 2; }
};

struct EpiBf16 {
    static constexpr bool PERM = true;
    bf16_t* O; int ldc;
    __device__ __forceinline__ void operator()(const f32x4 (&acc)[2][2][4][2], const Unit& u, int wr, int wc, int fr, int fq) const {
        const int row0 = u.pm * BM + wr * 64 + fr, col0 = u.pn * BM + wc * 32 + 8 * fq;
#pragma unroll
        for (int ai = 0; ai < 2; ++ai)
#pragma unroll
            for (int m = 0; m < 4; ++m) { bf16_t* rowp = O + (size_t)(row0 + ai * HALF + m * 16) * ldc + col0;
#pragma unroll
                for (int bj = 0; bj < 2; ++bj) { const f32x4 v0 = acc[ai][bj][m][0], v1 = acc[ai][bj][m][1];
                    u32x4 w; w.x = cvt_pk_bf16(v0[0], v0[1]); w.y = cvt_pk_bf16(v0[2], v0[3]); w.z = cvt_pk_bf16(v1[0], v1[1]); w.w = cvt_pk_bf16(v1[2], v1[3]);
                    *(u32x4*)(rowp + bj * HALF) = w; } }
    }
};
struct EpiResid {
    static constexpr bool PERM = false;
    const float* X; float* U;
    __device__ __forceinline__ void operator()(const f32x4 (&acc)[2][2][4][2], const Unit& u, int wr, int wc, int fr, int fq) const {
        const int row0 = u.pm * BM + wr * 64 + fr, col0 = u.pn * BM + wc * 32 + 4 * fq;
#pragma unroll
        for (int ai = 0; ai < 2; ++ai)
#pragma unroll
            for (int m = 0; m < 4; ++m) { const size_t off = (size_t)(row0 + ai * HALF + m * 16) * DM + col0;
#pragma unroll
                for (int bj = 0; bj < 2; ++bj)
#pragma unroll
                    for (int n = 0; n < 2; ++n) { const f32x4 xv = *(const f32x4*)(X + off + bj * HALF + n * 16);
                        *(f32x4*)(U + off + bj * HALF + n * 16) = xv * DN_ALPHA + acc[ai][bj][m][n]; } }
    }
};
struct EpiSwiglu {
    static constexpr bool PERM = true;
    bf16_t* O;
    __device__ __forceinline__ void operator()(const f32x4 (&acc)[2][2][4][2], const Unit& u, int wr, int wc, int fr, int fq) const {
        const int row0 = u.pm * BM + wr * 64 + fr, col0 = u.pn * HALF + wc * 32 + 8 * fq;
#pragma unroll
        for (int ai = 0; ai < 2; ++ai)
#pragma unroll
            for (int m = 0; m < 4; ++m) { bf16_t* rowp = O + (size_t)(row0 + ai * HALF + m * 16) * DEXP + col0;
                float r[8];
#pragma unroll
                for (int n = 0; n < 2; ++n)
#pragma unroll
                    for (int j = 0; j < 4; ++j) { const float g = acc[ai][0][m][n][j], up = acc[ai][1][m][n][j]; r[n * 4 + j] = g / (1.0f + __expf(-g)) * up; }
                u32x4 w; w.x = cvt_pk_bf16(r[0], r[1]); w.y = cvt_pk_bf16(r[2], r[3]); w.z = cvt_pk_bf16(r[4], r[5]); w.w = cvt_pk_bf16(r[6], r[7]);
                *(u32x4*)rowp = w; }
    }
};
}

__device__ __forceinline__ void tr_tile256(LAS float* tile  , const float* src, int ld, int k0, int c0, bf16_t* dst, int dstK, int blk, int blk_stride, int dst_off, int tid) {
    {
        const int c4 = tid & 63;
#pragma unroll
        for (int i = 0; i < 8; ++i) { const int r = (tid >> 6) + 8 * i; const f32x4 a = *(const f32x4*)(src + (size_t)(k0 + r) * ld + c0 + c4 * 4);
            tile[r * 257 + c4 * 4 + 0] = a[0]; tile[r * 257 + c4 * 4 + 1] = a[1]; tile[r * 257 + c4 * 4 + 2] = a[2]; tile[r * 257 + c4 * 4 + 3] = a[3]; }
    }
    __syncthreads();
    {
        const int kk = (tid & 7) * 8;
#pragma unroll
        for (int i = 0; i < 4; ++i) { const int n = (tid >> 3) + 64 * i, col = c0 + n;
            u32x4 w;
            w.x = cvt_pk_bf16(tile[(kk + 0) * 257 + n], tile[(kk + 1) * 257 + n]); w.y = cvt_pk_bf16(tile[(kk + 2) * 257 + n], tile[(kk + 3) * 257 + n]);
            w.z = cvt_pk_bf16(tile[(kk + 4) * 257 + n], tile[(kk + 5) * 257 + n]); w.w = cvt_pk_bf16(tile[(kk + 6) * 257 + n], tile[(kk + 7) * 257 + n]);
            const int drow = (col / blk) * blk_stride + dst_off + (col % blk);
            *(u32x4*)(dst + (size_t)drow * dstK + k0 + kk) = w; }
    }
    __syncthreads();
}
__device__ __forceinline__ float reduce16_wave(const float (&v)[16], int lane) {
    float a8[8];
#pragma unroll
    for (int i = 0; i < 8; ++i) { const float mine = (lane & 32) ? v[8 + i] : v[i], other = (lane & 32) ? v[i] : v[8 + i]; a8[i] = mine + __shfl_xor(other, 32); }
    float a4[4];
#pragma unroll
    for (int i = 0; i < 4; ++i) { const float mine = (lane & 16) ? a8[4 + i] : a8[i], other = (lane & 16) ? a8[i] : a8[4 + i]; a4[i] = mine + __shfl_xor(other, 16); }
    float a2[2];
#pragma unroll
    for (int i = 0; i < 2; ++i) { const float mine = (lane & 8) ? a4[2 + i] : a4[i], other = (lane & 8) ? a4[i] : a4[2 + i]; a2[i] = mine + __shfl_xor(other, 8); }
    float a1; { const float mine = (lane & 4) ? a2[1] : a2[0], other = (lane & 4) ? a2[0] : a2[1]; a1 = mine + __shfl_xor(other, 4); }
    a1 += dppf<0x4E>(a1); a1 += dppf<0xB1>(a1);
    return a1;
}
__device__ __forceinline__ void tr_tile(LAS float* tile  , const float* src, int ld, int k0, int c0, int ncols_valid, bf16_t* dst, int dstK, int drow0, int tid) {
    {
        const int r = tid >> 3, cc = (tid & 7) * 8;
        const float* sp = src + (size_t)(k0 + r) * ld + c0 + cc;
        if (c0 + cc + 8 <= ncols_valid) {
            const f32x4 a = *(const f32x4*)sp, b = *(const f32x4*)(sp + 4);
#pragma unroll
            for (int j = 0; j < 4; ++j) { tile[r * 65 + cc + j] = a[j]; tile[r * 65 + cc + 4 + j] = b[j]; }
        } else {
#pragma unroll
            for (int j = 0; j < 8; ++j) tile[r * 65 + cc + j] = (c0 + cc + j < ncols_valid) ? sp[j] : 0.f;
        }
    }
    __syncthreads();
    {
        const int n = tid >> 3, kk = (tid & 7) * 8;
        u32x4 w;
        w.x = cvt_pk_bf16(tile[(kk + 0) * 65 + n], tile[(kk + 1) * 65 + n]); w.y = cvt_pk_bf16(tile[(kk + 2) * 65 + n], tile[(kk + 3) * 65 + n]);
        w.z = cvt_pk_bf16(tile[(kk + 4) * 65 + n], tile[(kk + 5) * 65 + n]); w.w = cvt_pk_bf16(tile[(kk + 6) * 65 + n], tile[(kk + 7) * 65 + n]);
        *(u32x4*)(dst + (size_t)(drow0 + n) * dstK + k0 + kk) = w;
    }
    __syncthreads();
}

__device__ __forceinline__ void phase_prep(const Params& p, LAS unsigned char* lds, int bid, int nb, int part) {
    const int tid = opaque_tid();
    LAS float* tile = (LAS float*)lds;
    unsigned char* ws = p.ws;
    const int T0 = 832, T1 = T0 + 256, T2 = T1 + 448, T3 = T2 + 256, T4 = T3 + 2048, T5 = T4 + 2048, T6 = T5 + 2048, T7 = T6 + 32;
    if (part == 0) {
        for (int t0 = bid; t0 < T0 + 32; t0 += nb) {
            const int t = t0 < T0 ? t0 : T6 + (t0 - T0);
            if (t >= T6) { const int q = t - T6;
                if (q < 8) tr_tile(tile, p.in[I_AW2], 512, 0, q * 64, 512, (bf16_t*)(ws + OFF_MISC + MISC_W2T), 64, q * 64, tid);
                else if (q < 16) tr_tile(tile, p.in[I_AA2], 512, 0, (q - 8) * 64, 512, (bf16_t*)(ws + OFF_MISC + MISC_A2T), 64, (q - 8) * 64, tid);
                else { const int r = q - 16; tr_tile(tile, p.in[I_AG2], 512, (r >> 3) * 64, (r & 7) * 64, 512, (bf16_t*)(ws + OFF_MISC + MISC_G2T), 128, (r & 7) * 64, tid); }
                continue; }
            { const int kt = t / 52, ct = t % 52; tr_tile(tile, p.in[I_WINE], EVEN_COLS, kt * 64, ct * 64, EVEN_COLS, (bf16_t*)(ws + OFF_WINE), 1024, ct * 64, tid); }
        }
        __syncthreads();
        {
            const int wid = tid >> 6, lane = tid & 63;
            LAS float* wT = (LAS float*)lds;
            for (int i = tid; i < 16 * 1024; i += 512) { const int e_ = i & 15, k = i >> 4; wT[e_ * 1024 + k] = p.in[I_WINE][(size_t)k * EVEN_COLS + NE_MAIN + e_]; }
            __syncthreads();
            const float* x = p.in[I_X]; bf16_t* xb = (bf16_t*)(ws + OFF_BUF64); float* xa = (float*)(ws + OFF_U);
            for (int tok = bid * 8 + wid; tok < NTOK; tok += nb * 8) {
                f32x4 v[4];
                asm volatile("" ::: "memory");
#pragma unroll
                for (int j = 0; j < 4; ++j) { v[j] = *(const f32x4*)(x + (size_t)tok * DM + j * 256 + lane * 4);
                    u32x2 w; w.x = cvt_pk_bf16(v[j][0], v[j][1]); w.y = cvt_pk_bf16(v[j][2], v[j][3]); *(u32x2*)(xb + (size_t)tok * DM + j * 256 + lane * 4) = w; }
                float part_[16];
#pragma unroll
                for (int e_ = 0; e_ < 16; ++e_) { float a = 0.f;
#pragma unroll
                    for (int j = 0; j < 4; ++j) { const f32x4 w = *(const LAS f32x4*)(wT + e_ * 1024 + j * 256 + lane * 4); a += (v[j][0] * w[0] + v[j][1] * w[1]) + (v[j][2] * w[2] + v[j][3] * w[3]); }
                    part_[e_] = a; }
                const float r = reduce16_wave(part_, lane);
                if ((lane & 3) == 0) xa[(size_t)tok * 16 + ((lane >> 5) & 1) * 8 + ((lane >> 4) & 1) * 4 + ((lane >> 3) & 1) * 2 + ((lane >> 2) & 1)] = r;
            }
            __syncthreads();
        }
        if (bid == 0 && tid < 64) ((int*)(ws + OFF_MISC + MISC_CNT))[tid] = 0;
        if (bid == 1) for (int i = tid; i < (16384 + 64) / 4; i += 512) ((unsigned*)(ws + OFF_MISC + MISC_RWF))[i] = 0u;
        return;
    }
    unsigned* pctr = (unsigned*)(ws + OFF_MISC + MISC_PCTR);
    LAS int* tsh = (LAS int*)(lds + 69632);
    const int U0 = 64, U1 = U0 + 64, U2 = U1 + 512, U3 = U2 + 512, U4 = U3 + 512, U5 = U4 + 448;
    for (;;) {
        __syncthreads();
        if (tid == 0) tsh[0] = (int)__hip_atomic_fetch_add(pctr, 2u, __ATOMIC_RELAXED, __HIP_MEMORY_SCOPE_AGENT);
        __syncthreads();
        const int tb = __builtin_amdgcn_readfirstlane(tsh[0]);
        if (tb >= U5) break;
#pragma unroll 1
        for (int t = tb; t < tb + 2 && t < U5; ++t) {
            if (t < U0) { const int kt = t >> 2, cb = t & 3; tr_tile256(tile, p.in[I_WOUTE], 1024, kt * 64, cb * 256, (bf16_t*)(ws + OFF_WOUTE), 1024, 1 << 20, 0, 0, tid); }
            else if (t < U1) { const int q = t - U0, kt = q >> 2, cb = q & 3; tr_tile256(tile, p.in[I_WOUTO], 1024, kt * 64, cb * 256, (bf16_t*)(ws + OFF_WOUTO), 1024, 1 << 20, 0, 0, tid); }
            else if (t < U3) { const bool up = t >= U2; const int q = t - (up ? U2 : U1), le = q >> 4, kt = q & 15;
                tr_tile256(tile, p.in[up ? I_EU : I_EG] + (size_t)le * 1024 * 256, 256, kt * 64, 0, (bf16_t*)(ws + OFF_WGU) + (size_t)le * 512 * 1024, 1024, 128, 256, up ? 128 : 0, tid); }
            else if (t < U4) { const int q = t - U3, le = q >> 4, r = q & 15, kt = r >> 2, cb = r & 3;
                tr_tile256(tile, p.in[I_ED] + (size_t)le * 256 * 1024, 1024, kt * 64, cb * 256, (bf16_t*)(ws + OFF_WD) + (size_t)le * 1024 * 256, 256, 1 << 20, 0, 0, tid); }
            else { const int q = t - U4, kt = q / 28, ct = q % 28; tr_tile(tile, p.in[I_WINO], ODD_COLS, kt * 64, ct * 64, ODD_COLS, (bf16_t*)(ws + OFF_WINO), 1024, ct * 64, tid); }
        }
    }
    {
        float* c64 = (float*)(ws + OFF_ROPE); float* s64 = c64 + 4096 * 64; float* c32 = s64 + 4096 * 64; float* s32 = c32 + 4096 * 32;
        for (int i = bid * 512 + tid; i < 4096 * 64; i += nb * 512) { const int pos = i >> 6, j = i & 63; const float inv = powf(10000.0f, -(float)j / 64.0f); const float ang = (float)pos * inv; c64[i] = cosf(ang); s64[i] = sinf(ang); }
        for (int i = bid * 512 + tid; i < 4096 * 32; i += nb * 512) { const int pos = i >> 5, j = i & 31; const float inv = powf(10000.0f, -(float)j / 32.0f); const float ang = (float)pos * inv; c32[i] = cosf(ang); s32[i] = sinf(ang); }
    }
}

__device__ __forceinline__ void phase_ln_route(const Params& p, LAS unsigned char* lds, int bid, int nb, int layer) {
    const int tid = opaque_tid(), wid = tid >> 6, lane = tid & 63;
    unsigned char* ws = p.ws;
    LAS float* rwT = (LAS float*)lds;
    LAS int* sel = (LAS int*)(lds + 65536);
    LAS float* selg = (LAS float*)(lds + 65536 + 1024);
    LAS int* cntw = (LAS int*)(lds + 65536 + 2048);
    { const float* rw = p.in[I_RW];
        for (int i = tid; i < 16 * 1024; i += 512) { const int e = i >> 10, k = i & 1023; rwT[i] = rw[k * 16 + e]; } }
    __syncthreads();
    float* U = (float*)(ws + OFF_U); bf16_t* hb = (bf16_t*)(ws + OFF_BUF64);
    const float* g = p.in[I_LN1G] + layer * DM; const float* b = p.in[I_LN1B] + layer * DM;
    int* cnt = (int*)(ws + OFF_MISC + MISC_CNT) + layer * 16;
    int* tokinfo = (int*)(ws + OFF_MISC + MISC_TOKINFO); float* tokgate = (float*)(ws + OFF_MISC + MISC_TOKGATE); int* list = (int*)(ws + OFF_MISC + MISC_LIST);
    f32x4 gv[4], bv[4];
#pragma unroll
    for (int j = 0; j < 4; ++j) { gv[j] = *(const f32x4*)(g + j * 256 + lane * 4); bv[j] = *(const f32x4*)(b + j * 256 + lane * 4); }
    const float* rbp = p.in[I_RB];
    const float my_rb = rbp[((lane >> 5) & 1) * 8 + ((lane >> 4) & 1) * 4 + ((lane >> 3) & 1) * 2 + ((lane >> 2) & 1)];
    for (int blk = bid; blk < NTOK / 128; blk += nb) {
#pragma unroll 1
        for (int i = 0; i < 16; ++i) {
            const int tl = wid * 16 + i, tok = blk * 128 + tl;
            f32x4 v[4]; float s = 0.f;
            asm volatile("" ::: "memory");
#pragma unroll
            for (int j = 0; j < 4; ++j) { v[j] = *(const f32x4*)(U + (size_t)tok * DM + j * 256 + lane * 4); s += (v[j][0] + v[j][1]) + (v[j][2] + v[j][3]); }
            const float mean = wave_sum(s) * (1.0f / DM);
            float q = 0.f;
#pragma unroll
            for (int j = 0; j < 4; ++j) { v[j] -= mean; q += (v[j][0] * v[j][0] + v[j][1] * v[j][1]) + (v[j][2] * v[j][2] + v[j][3] * v[j][3]); }
            const float rstd = rsqrtf(wave_sum(q) * (1.0f / DM) + LN_EPS);
#pragma unroll
            for (int j = 0; j < 4; ++j) { v[j] = v[j] * rstd * gv[j] + bv[j];
                *(f32x4*)(U + (size_t)tok * DM + j * 256 + lane * 4) = v[j];
                u32x2 w; w.x = cvt_pk_bf16(v[j][0], v[j][1]); w.y = cvt_pk_bf16(v[j][2], v[j][3]);
                *(u32x2*)(hb + (size_t)tok * DM + j * 256 + lane * 4) = w; }
            float part[16];
#pragma unroll
            for (int e = 0; e < 16; ++e) { float a = 0.f;
#pragma unroll
                for (int j = 0; j < 4; ++j) { const f32x4 w = *(const LAS f32x4*)(rwT + e * 1024 + j * 256 + lane * 4); a += (v[j][0] * w[0] + v[j][1] * w[1]) + (v[j][2] * w[2] + v[j][3] * w[3]); }
                part[e] = a; }
            const float lgm = reduce16_wave(part, lane);
            const float sgm = 1.0f / (1.0f + expf(-lgm)), selm = sgm + my_rb;
            float sg[16], sl[16];
#pragma unroll
            for (int e = 0; e < 16; ++e) { const int L = ((e >> 3) & 1) * 32 + ((e >> 2) & 1) * 16 + ((e >> 1) & 1) * 8 + (e & 1) * 4;
                sg[e] = __builtin_bit_cast(float, __builtin_amdgcn_readlane(__builtin_bit_cast(int, sgm), L)); sl[e] = __builtin_bit_cast(float, __builtin_amdgcn_readlane(__builtin_bit_cast(int, selm), L)); }
            int best = 0; float bestv = -INFINITY;
#pragma unroll
            for (int gI = 0; gI < 4; ++gI) { float m1 = -INFINITY, m2 = -INFINITY;
#pragma unroll
                for (int j = 0; j < 4; ++j) { const float x = sl[gI * 4 + j]; if (x > m1) { m2 = m1; m1 = x; } else if (x > m2) m2 = x; }
                const float gs = m1 + m2; if (gs > bestv) { bestv = gs; best = gI; } }
            int e0 = 0, e1 = 0; float v0 = -INFINITY, v1 = -INFINITY, s0 = 0.f, s1 = 0.f;
#pragma unroll
            for (int e = 0; e < 16; ++e) { if ((e >> 2) == best) { const float x = sl[e];
                    if (x > v0) { v1 = v0; e1 = e0; s1 = s0; v0 = x; e0 = e; s0 = sg[e]; } else if (x > v1) { v1 = x; e1 = e; s1 = sg[e]; } } }
            const float gsum = s0 + s1;
            if (lane == 0) { sel[tl * 2] = e0; sel[tl * 2 + 1] = e1; selg[tl * 2] = s0 / gsum; selg[tl * 2 + 1] = s1 / gsum; }
        }
        __syncthreads();
        int myE = -1, myRank = 0;
        if (tid < 256) { myE = sel[tid];
#pragma unroll
            for (int e = 0; e < 16; ++e) { const unsigned long long mk = __ballot(myE == e); if (myE == e) myRank = __popcll(mk & ((1ull << lane) - 1ull)); if (lane == 0) cntw[wid * 16 + e] = __popcll(mk); } }
        __syncthreads();
        if (tid < 16) { const int c0 = cntw[tid], c1 = cntw[16 + tid], c2 = cntw[32 + tid], c3 = cntw[48 + tid];
            const int basev = atomicAdd(cnt + tid, c0 + c1 + c2 + c3);
            cntw[64 + tid] = basev; cntw[80 + tid] = basev + c0; cntw[96 + tid] = basev + c0 + c1; cntw[112 + tid] = basev + c0 + c1 + c2; }
        __syncthreads();
        if (tid < 256) { const int slot = cntw[64 + wid * 16 + myE] + myRank; const int tok = blk * 128 + (tid >> 1), k = tid & 1;
            list[myE * NTOK + slot] = tok; tokinfo[tok * 4 + k * 2] = myE; tokinfo[tok * 4 + k * 2 + 1] = slot; tokgate[tok * 2 + k] = selg[tid]; }
        __syncthreads();
    }
}

__device__ __forceinline__ void phase_ln2(const Params& p, int bid, int nb, int layer, float* dst, bool with_moe) {
    const int tid = opaque_tid(), wid = tid >> 6, lane = tid & 63;
    unsigned char* ws = p.ws;
    const float* U = (const float*)(ws + OFF_U); bf16_t* xb = (bf16_t*)(ws + OFF_BUF64);
    const bf16_t* he = (const bf16_t*)(ws + OFF_HE);
    const float* g = p.in[I_LN2G] + layer * DM; const float* b = p.in[I_LN2B] + layer * DM;
    const int* cnt = (const int*)(ws + OFF_MISC + MISC_CNT) + layer * 16;
    const int* tokinfo = (const int*)(ws + OFF_MISC + MISC_TOKINFO); const float* tokgate = (const float*)(ws + OFF_MISC + MISC_TOKGATE);
    int rowbase[16]; { int a = 0;
#pragma unroll
        for (int e = 0; e < 16; ++e) { rowbase[e] = a; a += ((cnt[e] + 255) >> 8) << 8; } }
    f32x4 gv[4], bv[4];
#pragma unroll
    for (int j = 0; j < 4; ++j) { gv[j] = *(const f32x4*)(g + j * 256 + lane * 4); bv[j] = *(const f32x4*)(b + j * 256 + lane * 4); }
    for (int tok = bid * 8 + wid; tok < NTOK; tok += nb * 8) {
        f32x4 v[4]; float s = 0.f;
        int r0 = 0, r1 = 0; float g0 = 0.f, g1 = 0.f;
        if (with_moe) { const int e0 = tokinfo[tok * 4 + 0], sl0 = tokinfo[tok * 4 + 1], e1 = tokinfo[tok * 4 + 2], sl1 = tokinfo[tok * 4 + 3];
            int rb0 = 0, rb1 = 0;
#pragma unroll
            for (int e = 0; e < 16; ++e) { if (e == e0) rb0 = rowbase[e]; if (e == e1) rb1 = rowbase[e]; }
            r0 = rb0 + sl0; r1 = rb1 + sl1; g0 = tokgate[tok * 2 + 0]; g1 = tokgate[tok * 2 + 1]; }
#pragma unroll
        for (int j = 0; j < 4; ++j) { v[j] = *(const f32x4*)(U + (size_t)tok * DM + j * 256 + lane * 4) * DN_ALPHA;
            if (with_moe) { const u32x2 a = *(const u32x2*)(he + (size_t)r0 * DM + j * 256 + lane * 4), c = *(const u32x2*)(he + (size_t)r1 * DM + j * 256 + lane * 4);
                v[j][0] += g0 * __uint_as_float(a.x << 16) + g1 * __uint_as_float(c.x << 16); v[j][1] += g0 * __uint_as_float(a.x & 0xffff0000u) + g1 * __uint_as_float(c.x & 0xffff0000u);
                v[j][2] += g0 * __uint_as_float(a.y << 16) + g1 * __uint_as_float(c.y << 16); v[j][3] += g0 * __uint_as_float(a.y & 0xffff0000u) + g1 * __uint_as_float(c.y & 0xffff0000u); }
            s += (v[j][0] + v[j][1]) + (v[j][2] + v[j][3]); }
        const float mean = wave_sum(s) * (1.0f / DM);
        float q = 0.f;
#pragma unroll
        for (int j = 0; j < 4; ++j) { v[j] -= mean; q += (v[j][0] * v[j][0] + v[j][1] * v[j][1]) + (v[j][2] * v[j][2] + v[j][3] * v[j][3]); }
        const float rstd = rsqrtf(wave_sum(q) * (1.0f / DM) + LN_EPS);
#pragma unroll
        for (int j = 0; j < 4; ++j) { v[j] = v[j] * rstd * gv[j] + bv[j];
#if PROBE_ID
            if (layer == 1) v[j] = v[j] * (1.0f + *(const float*)(ws + OFF_MISC + MISC_PROBE));
#endif
            *(f32x4*)(dst + (size_t)tok * DM + j * 256 + lane * 4) = v[j];
            u32x2 w; w.x = cvt_pk_bf16(v[j][0], v[j][1]); w.y = cvt_pk_bf16(v[j][2], v[j][3]);
            *(u32x2*)(xb + (size_t)tok * DM + j * 256 + lane * 4) = w; }
    }
}


__device__ __forceinline__ void phase_moe_gateup(const Params& p, LAS unsigned char* lds, int bid, int nb, int layer) {
    unsigned char* ws = p.ws;
    LAS int* tab = (LAS int*)(lds + pg::STAGE_BYTES);
    pg::moe_build_units(tab, (const int*)(ws + OFF_MISC + MISC_CNT) + layer * 16, 2, nb, bid);
    pg::MoeSched<true> S; S.init(ws + OFF_BUF64, ws + OFF_WGU + (size_t)layer * 16 * 512 * 1024 * 2, (size_t)512 * 1024 * 2, (const int*)(ws + OFF_MISC + MISC_LIST), 1024, tab);
    pg::EpiSwiglu E; E.O = (bf16_t*)(ws + OFF_ACT);
    pg::gemm_phase(lds, 1024, S, E);
}
__device__ __forceinline__ void phase_moe_down(const Params& p, LAS unsigned char* lds, int bid, int nb, int layer) {
    unsigned char* ws = p.ws;
    LAS int* tab = (LAS int*)(lds + pg::STAGE_BYTES);
    pg::moe_build_units(tab, (const int*)(ws + OFF_MISC + MISC_CNT) + layer * 16, 4, nb, bid);
    pg::MoeSched<false> S; S.init(ws + OFF_ACT, ws + OFF_WD + (size_t)layer * 16 * 1024 * 256 * 2, (size_t)1024 * 256 * 2, nullptr, 256, tab);
    pg::EpiBf16 E; E.O = (bf16_t*)(ws + OFF_HE); E.ldc = 1024;
    pg::gemm_phase(lds, 256, S, E);
}


__device__ __forceinline__ float red8(float v) { v += dppf<0xB1>(v); v += dppf<0x4E>(v); v += dppf<0x141>(v); return v; }


__device__ __forceinline__ float red16(float v) { v += dppf<0xB1>(v); v += dppf<0x4E>(v); v += dppf<0x141>(v); v += dppf<0x140>(v); return v; }

constexpr size_t OFF_ACT256 = OFF_U + 4 * MiB;
__device__ __forceinline__ void phase_lora_act(const Params& p, int bid, int nb) {
    const int tid = opaque_tid();
    const bf16_t* P0 = (const bf16_t*)(p.ws + OFF_P); bf16_t* act = (bf16_t*)(p.ws + OFF_ACT256);
    const float* mu = p.in[I_AMU];
    const int cc = tid & 31, col = 1536 + cc * 8;
    const f32x4 m0 = *(const f32x4*)(mu + col), m1 = *(const f32x4*)(mu + col + 4);
    for (int n = bid * 16 + (tid >> 5); n < NTOK; n += nb * 16) {
        const u32x4 cu = *(const u32x4*)(P0 + (size_t)n * NE_MAIN + col); u32x4 pv = uzero4(); if ((n & (SEQ - 1)) > 0) pv = *(const u32x4*)(P0 + (size_t)(n - 1) * NE_MAIN + col);
        const unsigned cw[4] = {cu.x, cu.y, cu.z, cu.w}, pw[4] = {pv.x, pv.y, pv.z, pv.w}; float x[8];
#pragma unroll
        for (int j = 0; j < 4; ++j) { const float c0 = __uint_as_float(cw[j] << 16), c1 = __uint_as_float(cw[j] & 0xffff0000u), q0 = __uint_as_float(pw[j] << 16), q1 = __uint_as_float(pw[j] & 0xffff0000u);
            const float ma = (j < 2 ? m0[2 * j] : m1[2 * j - 4]), mb = (j < 2 ? m0[2 * j + 1] : m1[2 * j - 3]);
            x[2 * j] = c0 + (q0 - c0) * ma; x[2 * j + 1] = c1 + (q1 - c1) * mb; }
        if (cc < 8) {
#pragma unroll
            for (int j = 0; j < 8; ++j) x[j] = fast_tanh(x[j]); }
        else if (cc >= 16) {
#pragma unroll
            for (int j = 0; j < 8; ++j) x[j] = fast_sigmoid(x[j]); }
        u32x4 o; o.x = cvt_pk_bf16(x[0], x[1]); o.y = cvt_pk_bf16(x[2], x[3]); o.z = cvt_pk_bf16(x[4], x[5]); o.w = cvt_pk_bf16(x[6], x[7]);
        *(u32x4*)(act + (size_t)n * 256 + cc * 8) = o;
    }
}

template <int CTRL> __device__ __forceinline__ float dpp0f(float v) { return __builtin_bit_cast(float, __builtin_amdgcn_update_dpp(0, __builtin_bit_cast(int, v), CTRL, 0xf, 0xf, true)); }
__device__ __forceinline__ bf16x8 pack_lo4(const f32x4 a) { u32x4 w; w.x = cvt_pk_bf16(a[0], a[1]); w.y = cvt_pk_bf16(a[2], a[3]); w.z = 0u; w.w = 0u; return __builtin_bit_cast(bf16x8, w); }
__device__ __forceinline__ bf16x8 pack_8(const f32x4 a, const f32x4 b) { u32x4 w; w.x = cvt_pk_bf16(a[0], a[1]); w.y = cvt_pk_bf16(a[2], a[3]); w.z = cvt_pk_bf16(b[0], b[1]); w.w = cvt_pk_bf16(b[2], b[3]); return __builtin_bit_cast(bf16x8, w); }
__device__ __forceinline__ f32x4 mm16(const f32x4 PT, const f32x4 Q) { return __builtin_amdgcn_mfma_f32_16x16x32_bf16(pack_lo4(PT), pack_lo4(Q), fzero4(), 0, 0, 0); }
constexpr int RW3_SLOT = 12544;
__device__ __forceinline__ int rw3_trswz(int row, int c) { return (((c >> 1) ^ ((row >> 1) & 3)) << 1) | (c & 1); }
__device__ __forceinline__ unsigned rw_ld(unsigned* p_) { return __hip_atomic_load(p_, __ATOMIC_RELAXED, __HIP_MEMORY_SCOPE_AGENT); }
__device__ __forceinline__ void rwkv3_item(const Params& p, LAS unsigned char* lds, int item, int role, int which) {
    const int tid = opaque_tid(), lane = tid & 63, wid = tid >> 6, fr = lane & 15, g = lane >> 4;
    const int b = item >> 3, h = item & 7;
    unsigned char* ws = p.ws;
    const bf16_t* P0 = (const bf16_t*)(ws + OFF_P);
    float* yraw = p.out; bf16_t* e1g = (bf16_t*)(p.out + (size_t)NTOK * 512); bf16_t* gg = e1g + (size_t)NTOK * 512;
    LAS unsigned char* w2h = lds;
    LAS unsigned char* a2h = lds + 8192;
    LAS unsigned char* g2h = lds + 16384;
    LAS unsigned char* slots = lds + 32768;
    LAS float* ptab = (LAS float*)(lds + 32768 + 8 * RW3_SLOT);
    LAS float* mul = ptab + 8 * 64;
    if (role == 0) {
        const float* mu = p.in[I_AMU];
        if (tid < 64) { ptab[tid] = mu[h * 64 + tid]; ptab[64 + tid] = mu[512 + h * 64 + tid]; ptab[128 + tid] = mu[1024 + h * 64 + tid];
            ptab[192 + tid] = p.in[I_AW0][h * 64 + tid]; ptab[256 + tid] = p.in[I_AA0][h * 64 + tid]; ptab[320 + tid] = p.in[I_AKK][h * 64 + tid];
            ptab[384 + tid] = p.in[I_AKA][h * 64 + tid]; ptab[448 + tid] = p.in[I_ARK][h * 64 + tid]; }
        if (tid < 256) mul[tid] = mu[1536 + tid];
    }
    if (role == 0) {
        const bf16_t* w2t = (const bf16_t*)(ws + OFF_MISC + MISC_W2T); const bf16_t* a2t = (const bf16_t*)(ws + OFF_MISC + MISC_A2T); const bf16_t* g2t = (const bf16_t*)(ws + OFF_MISC + MISC_G2T);
        { const int row = tid >> 3, c = tid & 7;
            *(LAS u32x4*)(w2h + row * 128 + ((c ^ (row & 7)) * 16)) = *(const u32x4*)(w2t + (size_t)(h * 64 + row) * 64 + c * 8);
            *(LAS u32x4*)(a2h + row * 128 + ((c ^ (row & 7)) * 16)) = *(const u32x4*)(a2t + (size_t)(h * 64 + row) * 64 + c * 8); }
#pragma unroll
        for (int i = 0; i < 2; ++i) { const int q = tid + i * 512, row = q >> 4, c = q & 15;
            *(LAS u32x4*)(g2h + row * 256 + ((c ^ (row & 7)) * 16)) = *(const u32x4*)(g2t + (size_t)(h * 64 + row) * 128 + c * 8); }
    }
    __syncthreads();
    f32x4 Hacc[4];
#pragma unroll
    for (int rt = 0; rt < 4; ++rt) Hacc[rt] = fzero4();
    const size_t nb0 = (size_t)b * SEQ;
    const int q4 = fr >> 2, p4 = fr & 3;
#define MIXB(wc, wp, mA, mB, o0, o1) { const float c0 = __uint_as_float((wc) << 16), c1 = __uint_as_float((wc) & 0xffff0000u), q0 = __uint_as_float((wp) << 16), q1 = __uint_as_float((wp) & 0xffff0000u); o0 = c0 + (q0 - c0) * (mA); o1 = c1 + (q1 - c1) * (mB); }
    const bf16_t* actp = (const bf16_t*)(ws + OFF_ACT256);
    u32x2 nrc[4], nkc[4], nvc[4], nrp[4], nkp[4], nvp[4]; bf16x8 nb_[8];
#define RW3_LOADS(tk) do { const int t0_ = ((tk) * 8 + wid) * 16; const int fr_ = lane & 15, g_ = lane >> 4; const size_t n_ = nb0 + t0_ + fr_; const bool hp_ = (t0_ + fr_) > 0; \
        const bf16_t* rc_ = P0 + n_ * NE_MAIN; const bf16_t* rp_ = rc_ - NE_MAIN; \
        _Pragma("unroll") for (int ct = 0; ct < 4; ++ct) { const int c0 = ct * 16 + g_ * 4; \
            nrc[ct] = *(const u32x2*)(rc_ + h * 64 + c0); nkc[ct] = *(const u32x2*)(rc_ + 512 + h * 64 + c0); nvc[ct] = *(const u32x2*)(rc_ + 1024 + h * 64 + c0); \
            nrp[ct] = (u32x2){0u, 0u}; nkp[ct] = nrp[ct]; nvp[ct] = nrp[ct]; \
            if (hp_) { nrp[ct] = *(const u32x2*)(rp_ + h * 64 + c0); nkp[ct] = *(const u32x2*)(rp_ + 512 + h * 64 + c0); nvp[ct] = *(const u32x2*)(rp_ + 1024 + h * 64 + c0); } } \
        _Pragma("unroll") for (int f = 0; f < 8; ++f) nb_[f] = *(const bf16x8*)(actp + n_ * 256 + f * 32 + g_ * 8); } while (0)
    unsigned char* xb = ws + OFF_RWXB; unsigned* flg = (unsigned*)(ws + OFF_MISC + MISC_RWF);
    const __amdgpu_buffer_rsrc_t xrsrc = __builtin_amdgcn_make_buffer_rsrc((void*)xb, 0, 64 * 2 * 2 * 8 * RW3_SLOT, 0x00020000);
#pragma unroll 1
    for (int it = 0; it < (role ? 32 : 16); ++it) {
        const int tick = role ? it : 2 * it + which;
        const int hk = tick >> 1, hw = tick & 1;
        unsigned* f_prod = flg + (item * 2 + hw) * 16; unsigned* f_cons = flg + 2048 + (item * 2 + hw) * 16;
        unsigned char* xslot = xb + ((((size_t)item * 2 + (hk & 1)) * 2 + hw) * 8) * RW3_SLOT;
        if (role == 0) {
            int lane_t = lane; asm volatile("" : "+v"(lane_t));
            const int fr = lane_t & 15, g = lane_t >> 4, q4 = fr >> 2, p4 = fr & 3;
            LAS unsigned char* sl = slots + wid * RW3_SLOT;
            LAS unsigned char* Qt_i = sl, * Rh_i = sl + 2048, * Kh_i = sl + 4096, * Bn_i = sl + 6144, * Vi_i = sl + 8192, * M1_i = sl + 10240, * DD_i = sl + 11264; LAS float* gam_i = (LAS float*)(sl + 12288);
            const int t0 = (tick * 8 + wid) * 16;
            const size_t n = nb0 + t0 + fr;
            const bool hasp = (t0 + fr) > 0;
            const bf16_t* rowc = P0 + n * NE_MAIN; const bf16_t* rowp = rowc - NE_MAIN;
            RW3_LOADS(tick);
#define lrc nrc
#define lkc nkc
#define lvc nvc
#define lrp nrp
#define lkp nkp
#define lvp nvp
            bf16x8 bw[2], ba[2], bg[4];
            bw[0] = nb_[0]; bw[1] = nb_[1]; ba[0] = nb_[2]; ba[1] = nb_[3]; bg[0] = nb_[4]; bg[1] = nb_[5]; bg[2] = nb_[6]; bg[3] = nb_[7];
            f32x4 Wt[4], At[4], Gt[4];
#pragma unroll
            for (int ct = 0; ct < 4; ++ct) {
                const int row = ct * 16 + fr;
                f32x4 dw = fzero4(), da = dw, dg = dw;
#pragma unroll
                for (int s = 0; s < 2; ++s) {
                    dw = __builtin_amdgcn_mfma_f32_16x16x32_bf16(*(const LAS bf16x8*)(w2h + row * 128 + (((s * 4 + g) ^ (row & 7)) * 16)), bw[s], dw, 0, 0, 0);
                    da = __builtin_amdgcn_mfma_f32_16x16x32_bf16(*(const LAS bf16x8*)(a2h + row * 128 + (((s * 4 + g) ^ (row & 7)) * 16)), ba[s], da, 0, 0, 0); }
#pragma unroll
                for (int s = 0; s < 4; ++s) dg = __builtin_amdgcn_mfma_f32_16x16x32_bf16(*(const LAS bf16x8*)(g2h + row * 256 + (((s * 4 + g) ^ (row & 7)) * 16)), bg[s], dg, 0, 0, 0);
                Wt[ct] = dw; At[ct] = da; Gt[ct] = dg;
            }
            f32x4 Rm[4], Khm[4], Lw[4], Aa[4];
            float nsq = 0.f, rk = 0.f;
            u32x2 Vp[4];
#pragma unroll
            for (int ct = 0; ct < 4; ++ct) {
                const int c0 = ct * 16 + g * 4;
                const u32x2 rc = lrc[ct], kc = lkc[ct], vc = lvc[ct], rp = lrp[ct], kp = lkp[ct], vp = lvp[ct];
                const f32x4 mr = *(const LAS f32x4*)(ptab + c0), mk = *(const LAS f32x4*)(ptab + 64 + c0), mv = *(const LAS f32x4*)(ptab + 128 + c0);
                f32x4 Km, Vm;
                MIXB(rc.x, rp.x, mr[0], mr[1], Rm[ct][0], Rm[ct][1]) MIXB(rc.y, rp.y, mr[2], mr[3], Rm[ct][2], Rm[ct][3])
                MIXB(kc.x, kp.x, mk[0], mk[1], Km[0], Km[1]) MIXB(kc.y, kp.y, mk[2], mk[3], Km[2], Km[3])
                MIXB(vc.x, vp.x, mv[0], mv[1], Vm[0], Vm[1]) MIXB(vc.y, vp.y, mv[2], mv[3], Vm[2], Vm[3])
                const f32x4 w0v = *(const LAS f32x4*)(ptab + 192 + c0), a0v = *(const LAS f32x4*)(ptab + 256 + c0), kks = *(const LAS f32x4*)(ptab + 320 + c0), kas = *(const LAS f32x4*)(ptab + 384 + c0), rkp = *(const LAS f32x4*)(ptab + 448 + c0);
#pragma unroll
                for (int r = 0; r < 4; ++r) { const float z = w0v[r] + Wt[ct][r]; const float sp = __logf(1.0f + __expf(-z));
                    Lw[ct][r] = -__expf(-sp - 0.5f);
                    const float a = fast_sigmoid(a0v[r] + At[ct][r]); Aa[ct][r] = a;
                    const float kkp = Km[r] * kks[r]; nsq += kkp * kkp; Wt[ct][r] = kkp;
                    const float kh = Km[r] * (1.0f + (a - 1.0f) * kas[r]); Khm[ct][r] = kh; rk += Rm[ct][r] * kh * rkp[r]; }
                Vp[ct].x = cvt_pk_bf16(Vm[0], Vm[1]); Vp[ct].y = cvt_pk_bf16(Vm[2], Vm[3]);
                At[ct] = Vm;
            }
            nsq += __shfl_xor(nsq, 16); nsq += __shfl_xor(nsq, 32);
            rk += __shfl_xor(rk, 16); rk += __shfl_xor(rk, 32);
            const float inrm = 1.0f / fmaxf(sqrtf(nsq), 1e-12f);
#pragma unroll
            for (int ct = 0; ct < 4; ++ct) { const int c0 = ct * 16 + g * 4;
                u32x2 ew, gw; ew.x = cvt_pk_bf16(rk * At[ct][0], rk * At[ct][1]); ew.y = cvt_pk_bf16(rk * At[ct][2], rk * At[ct][3]);
                gw.x = cvt_pk_bf16(Gt[ct][0], Gt[ct][1]); gw.y = cvt_pk_bf16(Gt[ct][2], Gt[ct][3]);
                *(u32x2*)(e1g + n * 512 + h * 64 + c0) = ew; *(u32x2*)(gg + n * 512 + h * 64 + c0) = gw;
                const int c = 2 * ct + (g >> 1);
                *(LAS u32x2*)(Vi_i + fr * 128 + rw3_trswz(fr, c) * 16 + (g & 1) * 8) = Vp[ct]; }
            u32x2 Qp[4], Kp[4], Bp[4], Rp[4];
#pragma unroll
            for (int ct = 0; ct < 4; ++ct) {
                const int c0 = ct * 16 + g * 4;
                f32x4 gmv; float qh[4], kh_[4], bh[4], rh[4];
#pragma unroll
                for (int r = 0; r < 4; ++r) {
                    float L = Lw[ct][r];
                    L += dpp0f<0x111>(L); L += dpp0f<0x112>(L); L += dpp0f<0x114>(L); L += dpp0f<0x118>(L);
                    const float Ltot = red16(Lw[ct][r]);
                    const float eL = __expf(L), ieL = fast_rcp(eL), eLex = __expf(L - Lw[ct][r]);
                    const float kk = Wt[ct][r] * inrm, bb = kk * Aa[ct][r];
                    qh[r] = kk * eLex; kh_[r] = Khm[ct][r] * ieL; bh[r] = bb * ieL; rh[r] = Rm[ct][r] * eL;
                    gmv[r] = __expf(Ltot); }
                Qp[ct].x = cvt_pk_bf16(qh[0], qh[1]); Qp[ct].y = cvt_pk_bf16(qh[2], qh[3]); Kp[ct].x = cvt_pk_bf16(kh_[0], kh_[1]); Kp[ct].y = cvt_pk_bf16(kh_[2], kh_[3]);
                Bp[ct].x = cvt_pk_bf16(bh[0], bh[1]); Bp[ct].y = cvt_pk_bf16(bh[2], bh[3]); Rp[ct].x = cvt_pk_bf16(rh[0], rh[1]); Rp[ct].y = cvt_pk_bf16(rh[2], rh[3]);
                if (fr == 0) *(LAS f32x4*)(gam_i + c0) = gmv;
            }
            bf16x8 Qf[2], Kf[2], Bf[2], Rf[2];
#pragma unroll
            for (int s = 0; s < 2; ++s) { Qf[s] = __builtin_bit_cast(bf16x8, (u32x4){Qp[2 * s].x, Qp[2 * s].y, Qp[2 * s + 1].x, Qp[2 * s + 1].y}); Kf[s] = __builtin_bit_cast(bf16x8, (u32x4){Kp[2 * s].x, Kp[2 * s].y, Kp[2 * s + 1].x, Kp[2 * s + 1].y});
                Bf[s] = __builtin_bit_cast(bf16x8, (u32x4){Bp[2 * s].x, Bp[2 * s].y, Bp[2 * s + 1].x, Bp[2 * s + 1].y}); Rf[s] = __builtin_bit_cast(bf16x8, (u32x4){Rp[2 * s].x, Rp[2 * s].y, Rp[2 * s + 1].x, Rp[2 * s + 1].y}); }
            f32x4 Ab = fzero4(), AbT = Ab, Ak = Ab, DkT = Ab, DbT = Ab;
#pragma unroll
            for (int s = 0; s < 2; ++s) {
                Ab = __builtin_amdgcn_mfma_f32_16x16x32_bf16(Qf[s], Bf[s], Ab, 0, 0, 0);
                AbT = __builtin_amdgcn_mfma_f32_16x16x32_bf16(Bf[s], Qf[s], AbT, 0, 0, 0);
                Ak = __builtin_amdgcn_mfma_f32_16x16x32_bf16(Qf[s], Kf[s], Ak, 0, 0, 0);
                DkT = __builtin_amdgcn_mfma_f32_16x16x32_bf16(Kf[s], Rf[s], DkT, 0, 0, 0);
                DbT = __builtin_amdgcn_mfma_f32_16x16x32_bf16(Bf[s], Rf[s], DbT, 0, 0, 0); }
            f32x4 N, NT, ident;
#pragma unroll
            for (int r = 0; r < 4; ++r) { const int row = 4 * g + r;
                N[r] = (fr < row) ? -Ab[r] : 0.f; Ak[r] = (fr < row) ? Ak[r] : 0.f;
                NT[r] = (row < fr) ? -AbT[r] : 0.f;
                DkT[r] = (row <= fr) ? DkT[r] : 0.f; DbT[r] = (row <= fr) ? -DbT[r] : 0.f;
                ident[r] = (row == fr) ? 1.f : 0.f; }
            const f32x4 N2 = mm16(NT, N), N2T = mm16(N, NT);
            const f32x4 N4 = mm16(N2T, N2), N4T = mm16(N2, N2T);
            const f32x4 N8T = mm16(N4, N4T);
            const f32x4 X1 = N + ident, X1T = NT + ident, X2 = N2 + ident, X2T = N2T + ident, X4 = N4 + ident, X8T = N8T + ident;
            const f32x4 U12 = mm16(X1T, X2), U12T = mm16(X1, X2T), U34T = mm16(X4, X8T);
            const f32x4 TT = mm16(U12, U34T);
            const f32x4 M1T = mm16(Ak, TT);
#pragma unroll
            for (int ct = 0; ct < 4; ++ct) { const int c = 2 * ct + (g >> 1);
                *(LAS u32x2*)(Qt_i + fr * 128 + rw3_trswz(fr, c) * 16 + (g & 1) * 8) = Qp[ct]; }
            s16x4 qtr[4];
#pragma unroll
            for (int ct = 0; ct < 4; ++ct) { const int row = 4 * g + q4, c = 2 * ct + (p4 >> 1);
                qtr[ct] = __builtin_amdgcn_ds_read_tr16_b64_v4i16((LAS s16x4*)(Qt_i + row * 128 + rw3_trswz(row, c) * 16 + (p4 & 1) * 8)); }
            const bf16x8 TTf = pack_lo4(TT);
            f32x4 Qt[4];
#pragma unroll
            for (int ct = 0; ct < 4; ++ct) { const bf16x8 af = (bf16x8){qtr[ct][0], qtr[ct][1], qtr[ct][2], qtr[ct][3], 0, 0, 0, 0};
                Qt[ct] = __builtin_amdgcn_mfma_f32_16x16x32_bf16(af, TTf, fzero4(), 0, 0, 0); }
#pragma unroll
            for (int ct = 0; ct < 4; ++ct) {
                const int s = ct >> 1, hh = ct & 1;
                u32x2 w; w.x = cvt_pk_bf16(Qt[ct][0], Qt[ct][1]); w.y = cvt_pk_bf16(Qt[ct][2], Qt[ct][3]);
                *(LAS u32x2*)(Qt_i + fr * 128 + (((s * 4 + g) ^ (fr & 7)) * 16) + hh * 8) = w;
                *(LAS u32x2*)(Rh_i + fr * 128 + (((s * 4 + g) ^ (fr & 7)) * 16) + hh * 8) = Rp[ct];
                const int c = 2 * ct + (g >> 1);
                *(LAS u32x2*)(Kh_i + fr * 128 + rw3_trswz(fr, c) * 16 + (g & 1) * 8) = Kp[ct];
                *(LAS u32x2*)(Bn_i + fr * 128 + rw3_trswz(fr, c) * 16 + (g & 1) * 8) = (u32x2){Bp[ct].x ^ 0x80008000u, Bp[ct].y ^ 0x80008000u}; }
            { const int cs = (g ^ ((fr >> 2) & 3)) * 16;
                u32x2 w; w.x = cvt_pk_bf16(M1T[0], M1T[1]); w.y = cvt_pk_bf16(M1T[2], M1T[3]);
                *(LAS u32x2*)(M1_i + fr * 64 + cs) = (u32x2){0u, 0u}; *(LAS u32x2*)(M1_i + fr * 64 + cs + 8) = w;
                w.x = cvt_pk_bf16(DbT[0], DbT[1]); w.y = cvt_pk_bf16(DbT[2], DbT[3]); *(LAS u32x2*)(DD_i + fr * 64 + cs) = w;
                w.x = cvt_pk_bf16(DkT[0], DkT[1]); w.y = cvt_pk_bf16(DkT[2], DkT[3]); *(LAS u32x2*)(DD_i + fr * 64 + cs + 8) = w; }
        }
        if (role == 0) {
            if (hk >= 2 && tid == 0) { for (unsigned sp = 0; rw_ld(f_cons) < (unsigned)(hk - 1) && sp < (1u << 22); ++sp) __builtin_amdgcn_s_sleep(2); }
            __syncthreads();
            { LAS const unsigned char* sl = slots + wid * RW3_SLOT; const unsigned doff = (unsigned)((xslot - xb) + (size_t)wid * RW3_SLOT);
                for (int i = lane; i < RW3_SLOT / 16; i += 64) __builtin_amdgcn_raw_buffer_store_b128(*(const LAS u32x4*)(sl + i * 16), xrsrc, doff + (unsigned)i * 16u, 0, 16); }
            asm volatile("s_waitcnt vmcnt(0)" ::: "memory");
            __syncthreads();
            if (tid == 0) __hip_atomic_store(f_prod, (unsigned)(hk + 1), __ATOMIC_RELAXED, __HIP_MEMORY_SCOPE_AGENT);
            continue;
        }
        if (tid == 0) { for (unsigned sp = 0; rw_ld(f_prod) < (unsigned)(hk + 1) && sp < (1u << 22); ++sp) __builtin_amdgcn_s_sleep(2);
            __builtin_amdgcn_fence(__ATOMIC_ACQUIRE, "agent"); asm volatile("s_waitcnt vmcnt(0)" ::: "memory"); }
        __syncthreads();
        for (int i = tid; i < 8 * RW3_SLOT / 16; i += 512) *(LAS u32x4*)(slots + i * 16) = *(const u32x4*)(xslot + (size_t)i * 16);
        asm volatile("s_waitcnt vmcnt(0) lgkmcnt(0)" ::: "memory");
        __syncthreads();
        if (tid == 0) __hip_atomic_store(f_cons, (unsigned)(hk + 1), __ATOMIC_RELAXED, __HIP_MEMORY_SCOPE_AGENT);
        if (wid < 4) {
#pragma unroll 1
            for (int j = 0; j < 8; ++j) {
                int lane_t = lane; asm volatile("" : "+v"(lane_t));
                const int fr = lane_t & 15, g = lane_t >> 4, q4 = fr >> 2, p4 = fr & 3;
                LAS unsigned char* sl = slots + j * RW3_SLOT;
                LAS unsigned char* Qt_i = sl, * Rh_i = sl + 2048, * Kh_i = sl + 4096, * Bn_i = sl + 6144, * Vi_i = sl + 8192, * M1_i = sl + 10240, * DD_i = sl + 11264; LAS const float* gam_i = (LAS const float*)(sl + 12288);
                const bf16x8 Hb0 = pack_8(Hacc[0], Hacc[1]), Hb1 = pack_8(Hacc[2], Hacc[3]);
                const int trow = 4 * g + q4;
                const s16x4 vv = __builtin_amdgcn_ds_read_tr16_b64_v4i16((LAS s16x4*)(Vi_i + trow * 128 + rw3_trswz(trow, 2 * wid + (p4 >> 1)) * 16 + (p4 & 1) * 8));
                const bf16x8 q0 = *(const LAS bf16x8*)(Qt_i + fr * 128 + (((0 + g) ^ (fr & 7)) * 16)), q1 = *(const LAS bf16x8*)(Qt_i + fr * 128 + (((4 + g) ^ (fr & 7)) * 16));
                const bf16x8 r0 = *(const LAS bf16x8*)(Rh_i + fr * 128 + (((0 + g) ^ (fr & 7)) * 16)), r1 = *(const LAS bf16x8*)(Rh_i + fr * 128 + (((4 + g) ^ (fr & 7)) * 16));
                const int cs = (g ^ ((fr >> 2) & 3)) * 16;
                const bf16x8 m1 = *(const LAS bf16x8*)(M1_i + fr * 64 + cs), dd = *(const LAS bf16x8*)(DD_i + fr * 64 + cs);
                const bf16x8 v0 = (bf16x8){0, 0, 0, 0, vv[0], vv[1], vv[2], vv[3]};
                f32x4 Z = fzero4();
                Z = __builtin_amdgcn_mfma_f32_16x16x32_bf16(q0, Hb0, Z, 0, 0, 0); Z = __builtin_amdgcn_mfma_f32_16x16x32_bf16(q1, Hb1, Z, 0, 0, 0); Z = __builtin_amdgcn_mfma_f32_16x16x32_bf16(m1, v0, Z, 0, 0, 0);
                u32x2 zw; zw.x = cvt_pk_bf16(Z[0], Z[1]); zw.y = cvt_pk_bf16(Z[2], Z[3]);
                const s16x4 zs = __builtin_bit_cast(s16x4, zw);
                const bf16x8 zv = (bf16x8){zs[0], zs[1], zs[2], zs[3], vv[0], vv[1], vv[2], vv[3]};
                f32x4 Y = fzero4();
                Y = __builtin_amdgcn_mfma_f32_16x16x32_bf16(r0, Hb0, Y, 0, 0, 0); Y = __builtin_amdgcn_mfma_f32_16x16x32_bf16(r1, Hb1, Y, 0, 0, 0); Y = __builtin_amdgcn_mfma_f32_16x16x32_bf16(dd, zv, Y, 0, 0, 0);
                const size_t nrow = nb0 + (size_t)(tick * 8 + j) * 16 + 4 * g;
#pragma unroll
                for (int r = 0; r < 4; ++r) yraw[(nrow + r) * 512 + h * 64 + wid * 16 + fr] = Y[r];
#pragma unroll
                for (int rt = 0; rt < 4; ++rt) { const int c = 2 * rt + (p4 >> 1);
                    const s16x4 bn = __builtin_amdgcn_ds_read_tr16_b64_v4i16((LAS s16x4*)(Bn_i + trow * 128 + rw3_trswz(trow, c) * 16 + (p4 & 1) * 8));
                    const s16x4 kh = __builtin_amdgcn_ds_read_tr16_b64_v4i16((LAS s16x4*)(Kh_i + trow * 128 + rw3_trswz(trow, c) * 16 + (p4 & 1) * 8));
                    const bf16x8 af = (bf16x8){bn[0], bn[1], bn[2], bn[3], kh[0], kh[1], kh[2], kh[3]};
                    Hacc[rt] = __builtin_amdgcn_mfma_f32_16x16x32_bf16(af, zv, Hacc[rt], 0, 0, 0);
                    Hacc[rt] = Hacc[rt] * *(const LAS f32x4*)(gam_i + rt * 16 + g * 4); }
            }
        }
        __syncthreads();
    }
#undef MIXB
#undef RW3_LOADS
#undef lrc
#undef lkc
#undef lvc
#undef lrp
#undef lkp
#undef lvp
}

__device__ __forceinline__ void phase_rwkv_epi(const Params& p, int bid, int nb) {
    const int tid = opaque_tid(), wid = tid >> 6, lane = tid & 63;
    const float* yraw = p.out; const bf16_t* e1g = (const bf16_t*)(p.out + (size_t)NTOK * 512); const bf16_t* gg = e1g + (size_t)NTOK * 512;
    bf16_t* mix = (bf16_t*)(p.ws + OFF_BUF64);
    const f32x4 g0 = *(const f32x4*)(p.in[I_AGNG] + lane * 8), g1 = *(const f32x4*)(p.in[I_AGNG] + lane * 8 + 4), b0 = *(const f32x4*)(p.in[I_AGNB] + lane * 8), b1 = *(const f32x4*)(p.in[I_AGNB] + lane * 8 + 4);
    for (int n = bid * 8 + wid; n < NTOK; n += nb * 8) {
        const f32x4 y0 = *(const f32x4*)(yraw + (size_t)n * 512 + lane * 8), y1 = *(const f32x4*)(yraw + (size_t)n * 512 + lane * 8 + 4);
        const u32x4 ev = *(const u32x4*)(e1g + (size_t)n * 512 + lane * 8), gv = *(const u32x4*)(gg + (size_t)n * 512 + lane * 8);
#if SANITIZE
        f32x4 y0s = y0, y1s = y1;
#pragma unroll
        for (int j = 0; j < 4; ++j) { if (!(fabsf(y0s[j]) < 1e30f)) y0s[j] = 0.f; if (!(fabsf(y1s[j]) < 1e30f)) y1s[j] = 0.f; }
#define y0 y0s
#define y1 y1s
#endif
        float s = (y0[0] + y0[1]) + (y0[2] + y0[3]) + (y1[0] + y1[1]) + (y1[2] + y1[3]);
        s = red8(s); const float mean = s * (1.0f / 64.0f);
        const f32x4 d0 = y0 - mean, d1 = y1 - mean;
        float q = (d0[0] * d0[0] + d0[1] * d0[1]) + (d0[2] * d0[2] + d0[3] * d0[3]) + (d1[0] * d1[0] + d1[1] * d1[1]) + (d1[2] * d1[2] + d1[3] * d1[3]);
        q = red8(q); const float rs = rsqrtf(q * (1.0f / 64.0f) + 64e-5f);
        float o[8];
        const unsigned ew[4] = {ev.x, ev.y, ev.z, ev.w}, gw[4] = {gv.x, gv.y, gv.z, gv.w};
#pragma unroll
        for (int j = 0; j < 4; ++j) { const float ya = (j < 2 ? d0[2 * j] : d1[2 * j - 4]), yb = (j < 2 ? d0[2 * j + 1] : d1[2 * j - 3]);
            const float ga = (j < 2 ? g0[2 * j] : g1[2 * j - 4]), gb_ = (j < 2 ? g0[2 * j + 1] : g1[2 * j - 3]); const float ba = (j < 2 ? b0[2 * j] : b1[2 * j - 4]), bb_ = (j < 2 ? b0[2 * j + 1] : b1[2 * j - 3]);
            o[2 * j] = (ya * rs * ga + ba + __uint_as_float(ew[j] << 16)) * __uint_as_float(gw[j] << 16);
            o[2 * j + 1] = (yb * rs * gb_ + bb_ + __uint_as_float(ew[j] & 0xffff0000u)) * __uint_as_float(gw[j] & 0xffff0000u); }
        u32x4 w; w.x = cvt_pk_bf16(o[0], o[1]); w.y = cvt_pk_bf16(o[2], o[3]); w.z = cvt_pk_bf16(o[4], o[5]); w.w = cvt_pk_bf16(o[6], o[7]);
#if SANITIZE
#undef y0
#undef y1
#pragma unroll
        for (int j = 0; j < 8; ++j) if (!(fabsf(o[j]) < 1e30f)) o[j] = 0.f;
        w.x = cvt_pk_bf16(o[0], o[1]); w.y = cvt_pk_bf16(o[2], o[3]); w.z = cvt_pk_bf16(o[4], o[5]); w.w = cvt_pk_bf16(o[6], o[7]);
#endif
        *(u32x4*)(mix + (size_t)n * DM + lane * 8) = w;
    }
}

__device__ __forceinline__ int gla_fT(int row) { return ((row >> 1) & 1) | (((row >> 3) & 1) << 1); }
__device__ __forceinline__ int gla_hV(int row) { return (row & 3) | (((row >> 3) & 1) << 2); }
__device__ __forceinline__ void gla2_item(const Params& p, LAS unsigned char* lds, int item, int seg) {
    const int tid = opaque_tid(), lane = tid & 63, wid = tid >> 6, fr = lane & 15, g = lane >> 4;
    const int b = item >> 2, h = item & 3;
    const bf16_t* P0 = (const bf16_t*)(p.ws + OFF_P) + 1792;
    const float* xa16 = (const float*)(p.ws + OFF_U);
    bf16_t* mix = (bf16_t*)(p.ws + OFF_BUF64);
    LAS float* bcf = (LAS float*)lds;
    LAS float* tot = bcf + 64 * 64;
    LAS float* bls = tot + 8 * 64;
    LAS float* pn = bls + 64;
    LAS float* xs = pn + 64 * 8;
    LAS float* boff = xs + 2 * 1024;
    LAS unsigned char* qd_i = (LAS unsigned char*)(boff + 64);
    LAS unsigned char* ki_a = qd_i + 8192;
    LAS unsigned char* ki_t = ki_a + 8192;
    LAS unsigned char* att_i = ki_t + 8192;
    LAS unsigned char* v_i = att_i + 8192;
    for (int i = tid; i < 8192 / 16; i += 512) *(LAS u32x4*)(att_i + i * 16) = uzero4();
    float gw2[16];
#pragma unroll
    for (int i = 0; i < 16; ++i) gw2[i] = p.in[I_BGW2][i * 256 + h * 64 + lane];
    const float gb = p.in[I_BGB][h * 64 + lane];
    const f32x4 ngv = *(const f32x4*)(p.in[I_BNG] + h * 128 + wid * 16 + g * 4);
    f32x4 Sacc[4];
#pragma unroll
    for (int rt = 0; rt < 4; ++rt) Sacc[rt] = fzero4();
    const int q4 = fr >> 2, p4 = fr & 3;
    const int tok = tid >> 3, dc = tid & 7;
    u32x4 nq, nk, nv0, nv1; u32x2 ngate[4]; f32x4 nxa = fzero4();
#define GLA_ISSUE(c0n) do { const size_t _n = (size_t)b * SEQ + (c0n) + tok; \
        nq = *(const u32x4*)(P0 + _n * NE_MAIN + h * 64 + dc * 8); nk = *(const u32x4*)(P0 + _n * NE_MAIN + 256 + h * 64 + dc * 8); \
        nv0 = *(const u32x4*)(P0 + _n * NE_MAIN + 512 + h * 128 + dc * 16); nv1 = *(const u32x4*)(P0 + _n * NE_MAIN + 512 + h * 128 + dc * 16 + 8); \
        _Pragma("unroll") for (int _ct = 0; _ct < 4; ++_ct) ngate[_ct] = *(const u32x2*)(P0 + ((size_t)b * SEQ + (c0n) + _ct * 16 + fr) * NE_MAIN + 1024 + h * 128 + wid * 16 + g * 4); \
        if (tid < 256) nxa = *(const f32x4*)(xa16 + ((size_t)b * SEQ + (c0n)) * 16 + tid * 4); } while (0)
    const int cbeg = seg * (SEQ / 2), cend = cbeg + SEQ / 2;
    float* oraw = (float*)(p.ws + OFF_GLA_ORAW); bf16_t* qdgb = (bf16_t*)(p.ws + OFF_GLA_QDG);
    GLA_ISSUE(cbeg);
    if (tid < 256) *(LAS f32x4*)(xs + ((cbeg >> 6) & 1) * 1024 + tid * 4) = nxa;
    if (tid < 64) boff[tid] = 0.f;
    __syncthreads();
    for (int c0 = cbeg; c0 < cend; c0 += 64) {
        const size_t n0 = (size_t)b * SEQ + c0;
        LAS const float* xsc = xs + ((c0 >> 6) & 1) * 1024;
        { float run = 0.f;
#pragma unroll
            for (int tt = 0; tt < 8; ++tt) { const int c = wid * 8 + tt; float z = gb;
#pragma unroll
                for (int i4 = 0; i4 < 4; ++i4) { const f32x4 xv = *(const LAS f32x4*)(xsc + c * 16 + i4 * 4); z += xv[0] * gw2[i4 * 4] + xv[1] * gw2[i4 * 4 + 1] + xv[2] * gw2[i4 * 4 + 2] + xv[3] * gw2[i4 * 4 + 3]; }
                const float ls = fminf(z, 0.f) - __logf(1.0f + __expf(-fabsf(z)));
                run += ls * (1.0f / 16.0f); bcf[c * 64 + lane] = run; }
            tot[wid * 64 + lane] = run; }
        __syncthreads();
        { float off = 0.f;
            for (int w2 = 0; w2 < wid; ++w2) off += tot[w2 * 64 + lane];
#pragma unroll
            for (int tt = 0; tt < 8; ++tt) bcf[(wid * 8 + tt) * 64 + lane] += off;
            if (wid == 7) bls[lane] = __expf(bcf[63 * 64 + lane]); }
        __syncthreads();
        u32x2 gate[4];
        { const f32x4 bc0 = *(const LAS f32x4*)(bcf + tok * 64 + dc * 8), bc1 = *(const LAS f32x4*)(bcf + tok * 64 + dc * 8 + 4);
            const unsigned qw[4] = {nq.x, nq.y, nq.z, nq.w}, kw[4] = {nk.x, nk.y, nk.z, nk.w};
            float qo[8], ko[8];
#pragma unroll
            for (int j = 0; j < 4; ++j) { const float ba = (j < 2 ? bc0[2 * j] : bc1[2 * j - 4]), bb = (j < 2 ? bc0[2 * j + 1] : bc1[2 * j - 3]);
                const float ea = __expf(ba), eb = __expf(bb), ia = fast_rcp(ea), ib = fast_rcp(eb);
                qo[2 * j] = __uint_as_float(qw[j] << 16) * 0.125f * ea; qo[2 * j + 1] = __uint_as_float(qw[j] & 0xffff0000u) * 0.125f * eb;
                ko[2 * j] = __uint_as_float(kw[j] << 16) * ia; ko[2 * j + 1] = __uint_as_float(kw[j] & 0xffff0000u) * ib; }
            u32x4 qp, kp; qp.x = cvt_pk_bf16(qo[0], qo[1]); qp.y = cvt_pk_bf16(qo[2], qo[3]); qp.z = cvt_pk_bf16(qo[4], qo[5]); qp.w = cvt_pk_bf16(qo[6], qo[7]);
            kp.x = cvt_pk_bf16(ko[0], ko[1]); kp.y = cvt_pk_bf16(ko[2], ko[3]); kp.z = cvt_pk_bf16(ko[4], ko[5]); kp.w = cvt_pk_bf16(ko[6], ko[7]);
            *(LAS u32x4*)(qd_i + tok * 128 + ((dc ^ (tok & 7)) * 16)) = qp;
            if (seg) {
                const f32x4 bo0 = *(const LAS f32x4*)(boff + dc * 8), bo1 = *(const LAS f32x4*)(boff + dc * 8 + 4); float qg[8];
#pragma unroll
                for (int j = 0; j < 8; ++j) qg[j] = qo[j] * __expf(j < 4 ? bo0[j] : bo1[j - 4]);
                u32x4 w; w.x = cvt_pk_bf16(qg[0], qg[1]); w.y = cvt_pk_bf16(qg[2], qg[3]); w.z = cvt_pk_bf16(qg[4], qg[5]); w.w = cvt_pk_bf16(qg[6], qg[7]);
                *(u32x4*)(qdgb + ((size_t)b * 2048 + (c0 - cbeg) + tok) * 256 + h * 64 + dc * 8) = w; }
            *(LAS u32x4*)(ki_a + tok * 128 + ((dc ^ (tok & 7)) * 16)) = kp;
            *(LAS u32x4*)(ki_t + tok * 128 + (((((dc >> 1) ^ gla_fT(tok)) << 1) | (dc & 1)) * 16)) = kp;
            { const int pr = dc ^ gla_hV(tok); *(LAS u32x4*)(v_i + tok * 256 + (pr * 2) * 16) = nv0; *(LAS u32x4*)(v_i + tok * 256 + (pr * 2 + 1) * 16) = nv1; }
#pragma unroll
            for (int ct = 0; ct < 4; ++ct) gate[ct] = ngate[ct]; }
        if (c0 + 64 < cend) GLA_ISSUE(c0 + 64);
        __syncthreads();
        for (int ti = wid; ti < 10; ti += 8) {
            int st, ct; { const int tb[10] = {0x00, 0x01, 0x02, 0x03, 0x11, 0x12, 0x13, 0x22, 0x23, 0x33}; int code = 0;
#pragma unroll
                for (int k = 0; k < 10; ++k) if (k == ti) code = tb[k];
                st = code >> 4; ct = code & 15; }
            f32x4 d = fzero4();
            const int rs_ = st * 16 + fr, rc_ = ct * 16 + fr;
#pragma unroll
            for (int s = 0; s < 2; ++s) {
                const bf16x8 a = *(const LAS bf16x8*)(ki_a + rs_ * 128 + (((s * 4 + g) ^ (rs_ & 7)) * 16));
                const bf16x8 bq = *(const LAS bf16x8*)(qd_i + rc_ * 128 + (((s * 4 + g) ^ (rc_ & 7)) * 16));
                d = __builtin_amdgcn_mfma_f32_16x16x32_bf16(a, bq, d, 0, 0, 0); }
            const int c = ct * 16 + fr; float o4[4];
#pragma unroll
            for (int r = 0; r < 4; ++r) { const int s_ = st * 16 + g * 4 + r; o4[r] = (s_ <= c) ? d[r] : 0.f; }
            u32x2 w; w.x = cvt_pk_bf16(o4[0], o4[1]); w.y = cvt_pk_bf16(o4[2], o4[3]);
            *(LAS u32x2*)(att_i + c * 128 + (((2 * st + (g >> 1)) ^ (c & 7)) * 16) + (g & 1) * 8) = w;
        }
        if (seg && tid < 64) boff[tid] += bcf[63 * 64 + tid];
        __syncthreads();
        {
            bf16x8 vf[2];
#pragma unroll
            for (int s = 0; s < 2; ++s) {
                const int r1 = s * 32 + g * 8 + q4, r2 = r1 + 4; const int c = 2 * wid + (p4 >> 1);
                const s16x4 lo = __builtin_amdgcn_ds_read_tr16_b64_v4i16((LAS s16x4*)(v_i + r1 * 256 + (((((c >> 1) ^ gla_hV(r1)) << 1) | (c & 1)) * 16) + (p4 & 1) * 8));
                const s16x4 hi = __builtin_amdgcn_ds_read_tr16_b64_v4i16((LAS s16x4*)(v_i + r2 * 256 + (((((c >> 1) ^ gla_hV(r2)) << 1) | (c & 1)) * 16) + (p4 & 1) * 8));
                vf[s] = (bf16x8){lo[0], lo[1], lo[2], lo[3], hi[0], hi[1], hi[2], hi[3]}; }
            bf16x8 sf[2];
#pragma unroll
            for (int s = 0; s < 2; ++s) sf[s] = pack_8g(Sacc[2 * s], Sacc[2 * s + 1]);
            f32x4 oacc[4];
#pragma unroll
            for (int ct = 0; ct < 4; ++ct) {
                const int c = ct * 16 + fr; f32x4 d = fzero4();
#pragma unroll
                for (int s = 0; s < 2; ++s) {
                    const bf16x8 ab = *(const LAS bf16x8*)(att_i + c * 128 + (((s * 4 + g) ^ (c & 7)) * 16));
                    d = __builtin_amdgcn_mfma_f32_16x16x32_bf16(vf[s], ab, d, 0, 0, 0);
                    const s16x4 q0 = *(const LAS s16x4*)(qd_i + c * 128 + (((s * 4 + (g >> 1)) ^ (c & 7)) * 16) + (g & 1) * 8);
                    const s16x4 q1 = *(const LAS s16x4*)(qd_i + c * 128 + (((s * 4 + 2 + (g >> 1)) ^ (c & 7)) * 16) + (g & 1) * 8);
                    const bf16x8 qb = (bf16x8){q0[0], q0[1], q0[2], q0[3], q1[0], q1[1], q1[2], q1[3]};
                    d = __builtin_amdgcn_mfma_f32_16x16x32_bf16(sf[s], qb, d, 0, 0, 0); }
                oacc[ct] = d; }
#pragma unroll
            for (int rt = 0; rt < 4; ++rt) {
#pragma unroll
                for (int s = 0; s < 2; ++s) {
                    const int r1 = s * 32 + g * 8 + q4, r2 = r1 + 4; const int c = 2 * rt + (p4 >> 1);
                    const s16x4 lo = __builtin_amdgcn_ds_read_tr16_b64_v4i16((LAS s16x4*)(ki_t + r1 * 128 + (((((c >> 1) ^ gla_fT(r1)) << 1) | (c & 1)) * 16) + (p4 & 1) * 8));
                    const s16x4 hi = __builtin_amdgcn_ds_read_tr16_b64_v4i16((LAS s16x4*)(ki_t + r2 * 128 + (((((c >> 1) ^ gla_fT(r2)) << 1) | (c & 1)) * 16) + (p4 & 1) * 8));
                    const bf16x8 kf = (bf16x8){lo[0], lo[1], lo[2], lo[3], hi[0], hi[1], hi[2], hi[3]};
                    Sacc[rt] = __builtin_amdgcn_mfma_f32_16x16x32_bf16(kf, vf[s], Sacc[rt], 0, 0, 0); }
                const f32x4 eb = *(const LAS f32x4*)(bls + rt * 16 + g * 4);
                Sacc[rt] = Sacc[rt] * eb; }
#pragma unroll
            for (int ct = 0; ct < 4; ++ct) { float ss = oacc[ct][0] * oacc[ct][0] + oacc[ct][1] * oacc[ct][1] + oacc[ct][2] * oacc[ct][2] + oacc[ct][3] * oacc[ct][3];
                ss += __shfl_xor(ss, 16); ss += __shfl_xor(ss, 32);
                if (g == 0) pn[(ct * 16 + fr) * 8 + wid] = ss; }
            if (tid < 256 && c0 + 64 < cend) *(LAS f32x4*)(xs + (((c0 >> 6) + 1) & 1) * 1024 + tid * 4) = nxa;
            __syncthreads();
            if (seg) {
#pragma unroll
                for (int ct = 0; ct < 4; ++ct) *(f32x4*)(oraw + ((size_t)b * 2048 + (c0 - cbeg) + ct * 16 + fr) * 512 + h * 128 + wid * 16 + g * 4) = oacc[ct];
            } else
#pragma unroll
            for (int ct = 0; ct < 4; ++ct) { const int c = ct * 16 + fr;
                const f32x4 a0 = *(const LAS f32x4*)(pn + c * 8), a1 = *(const LAS f32x4*)(pn + c * 8 + 4);
                const float ss = (a0[0] + a0[1]) + (a0[2] + a0[3]) + (a1[0] + a1[1]) + (a1[2] + a1[3]);
                const float rs = rsqrtf(ss * (1.0f / 128.0f) + 1e-5f);
                const u32x2 gv = gate[ct];
                const float g0 = __uint_as_float(gv.x << 16), g1 = __uint_as_float(gv.x & 0xffff0000u), g2 = __uint_as_float(gv.y << 16), g3 = __uint_as_float(gv.y & 0xffff0000u);
                const float v0 = oacc[ct][0] * rs * ngv[0] * (g0 * fast_sigmoid(g0)), v1 = oacc[ct][1] * rs * ngv[1] * (g1 * fast_sigmoid(g1));
                const float v2 = oacc[ct][2] * rs * ngv[2] * (g2 * fast_sigmoid(g2)), v3 = oacc[ct][3] * rs * ngv[3] * (g3 * fast_sigmoid(g3));
                u32x2 w; w.x = cvt_pk_bf16(v0, v1); w.y = cvt_pk_bf16(v2, v3);
                *(u32x2*)(mix + (n0 + c) * DM + 512 + h * 128 + wid * 16 + g * 4) = w; }
        }
    }
    if (seg == 0) { float* sin_ = (float*)(p.ws + OFF_GLA_SIN) + (size_t)item * 64 * 128;
#pragma unroll
        for (int rt = 0; rt < 4; ++rt)
#pragma unroll
            for (int r = 0; r < 4; ++r) sin_[(rt * 16 + g * 4 + r) * 128 + wid * 16 + fr] = Sacc[rt][r]; }
#undef GLA_ISSUE
}

__device__ __forceinline__ void phase_gla_fix(const Params& p, LAS unsigned char* lds, int bid, int nb) {
    const int tid = opaque_tid(), lane = tid & 63, wid = tid >> 6, fr = lane & 15, g = lane >> 4;
    const bf16_t* P0 = (const bf16_t*)(p.ws + OFF_P) + 1792;
    const float* oraw = (const float*)(p.ws + OFF_GLA_ORAW); const bf16_t* qdgb = (const bf16_t*)(p.ws + OFF_GLA_QDG); const float* sinb = (const float*)(p.ws + OFF_GLA_SIN);
    bf16_t* mix = (bf16_t*)(p.ws + OFF_BUF64);
    LAS unsigned char* st_i = lds;
    LAS float* pn = (LAS float*)(lds + 16384);
    for (int it = bid; it < 32 * 32; it += nb) {
        const int item = it >> 5, ch = it & 31, b = item >> 2, h = item & 3;
        __syncthreads();
        { const float* sp = sinb + (size_t)item * 64 * 128;
            const int e_ = tid >> 2, d0 = (tid & 3) * 16; float v[16];
#pragma unroll
            for (int j = 0; j < 16; ++j) v[j] = sp[(d0 + j) * 128 + e_];
#pragma unroll
            for (int c2 = 0; c2 < 2; ++c2) { u32x4 w; w.x = cvt_pk_bf16(v[c2 * 8], v[c2 * 8 + 1]); w.y = cvt_pk_bf16(v[c2 * 8 + 2], v[c2 * 8 + 3]); w.z = cvt_pk_bf16(v[c2 * 8 + 4], v[c2 * 8 + 5]); w.w = cvt_pk_bf16(v[c2 * 8 + 6], v[c2 * 8 + 7]);
                const int c = (d0 >> 3) + c2; *(LAS u32x4*)(st_i + e_ * 128 + ((c ^ (e_ & 7)) * 16)) = w; } }
        __syncthreads();
        const size_t t0 = (size_t)b * 2048 + ch * 64;
        const size_t n0 = (size_t)b * SEQ + 2048 + ch * 64;
        const f32x4 ngv = *(const f32x4*)(p.in[I_BNG] + h * 128 + wid * 16 + g * 4);
        f32x4 oacc[4];
#pragma unroll
        for (int ct = 0; ct < 4; ++ct) {
            const int c = ct * 16 + fr;
            f32x4 d = *(const f32x4*)(oraw + (t0 + c) * 512 + h * 128 + wid * 16 + g * 4);
#pragma unroll
            for (int s = 0; s < 2; ++s) {
                const int er = wid * 16 + fr;
                const bf16x8 a = *(const LAS bf16x8*)(st_i + er * 128 + (((s * 4 + g) ^ (er & 7)) * 16));
                const bf16x8 bq = *(const bf16x8*)(qdgb + (t0 + c) * 256 + h * 64 + s * 32 + g * 8);
                d = __builtin_amdgcn_mfma_f32_16x16x32_bf16(a, bq, d, 0, 0, 0); }
            oacc[ct] = d; }
#pragma unroll
        for (int ct = 0; ct < 4; ++ct) { float ss = oacc[ct][0] * oacc[ct][0] + oacc[ct][1] * oacc[ct][1] + oacc[ct][2] * oacc[ct][2] + oacc[ct][3] * oacc[ct][3];
            ss += __shfl_xor(ss, 16); ss += __shfl_xor(ss, 32);
            if (g == 0) pn[(ct * 16 + fr) * 8 + wid] = ss; }
        __syncthreads();
#pragma unroll
        for (int ct = 0; ct < 4; ++ct) { const int c = ct * 16 + fr;
            const f32x4 a0 = *(const LAS f32x4*)(pn + c * 8), a1 = *(const LAS f32x4*)(pn + c * 8 + 4);
            const float ss = (a0[0] + a0[1]) + (a0[2] + a0[3]) + (a1[0] + a1[1]) + (a1[2] + a1[3]);
            const float rs = rsqrtf(ss * (1.0f / 128.0f) + 1e-5f);
            const u32x2 gv = *(const u32x2*)(P0 + (n0 + c) * NE_MAIN + 1024 + h * 128 + wid * 16 + g * 4);
            const float g0 = __uint_as_float(gv.x << 16), g1 = __uint_as_float(gv.x & 0xffff0000u), g2 = __uint_as_float(gv.y << 16), g3 = __uint_as_float(gv.y & 0xffff0000u);
            const float v0 = oacc[ct][0] * rs * ngv[0] * (g0 * fast_sigmoid(g0)), v1 = oacc[ct][1] * rs * ngv[1] * (g1 * fast_sigmoid(g1));
            const float v2 = oacc[ct][2] * rs * ngv[2] * (g2 * fast_sigmoid(g2)), v3 = oacc[ct][3] * rs * ngv[3] * (g3 * fast_sigmoid(g3));
            u32x2 w; w.x = cvt_pk_bf16(v0, v1); w.y = cvt_pk_bf16(v2, v3);
            *(u32x2*)(mix + (n0 + c) * DM + 512 + h * 128 + wid * 16 + g * 4) = w; }
    }
}


__device__ __forceinline__ void phase_mixer_even(const Params& p, LAS unsigned char* lds, int bid, int nb, int which) {
    PROBE_DECL;
    PROBE_BEGIN(47);
    if (nb >= 224) {
        if (bid < 64) { if (which != 2) rwkv3_item(p, lds, bid, 1, 0); }
        else if (bid < 192) { if (which != 2) rwkv3_item(p, lds, (bid - 64) >> 1, 0, (bid - 64) & 1); }
        else { if (which != 1) gla2_item(p, lds, (bid - 192) >> 1, (bid - 192) & 1); }
    }
    __syncthreads();
    PROBE_END(47);
    PROBE_BEGIN(48);
    if (which == 0) phase_prep(p, lds, bid, nb, 1);
    PROBE_END(48);
#if PROBE_ID == 47 || PROBE_ID == 48
    if (bid == PROBE_BLK && opaque_tid() == 0) *(float*)(p.ws + OFF_MISC + MISC_PROBE) = (float)probe_acc * 3e-8f;
#endif
}

__device__ __forceinline__ void phase_rope(const Params& p, int bid, int nb) {
    const int tid = opaque_tid(), wid = tid >> 6, lane = tid & 63;
    unsigned char* ws = p.ws;
    const bf16_t* Pd = (const bf16_t*)(ws + OFF_PD);
    bf16_t* qr = (bf16_t*)(ws + OFF_BUF64); bf16_t* kr = (bf16_t*)(ws + OFF_KR); bf16_t* vv = (bf16_t*)(ws + OFF_VV);
    bf16_t* iqr = (bf16_t*)(ws + OFF_IQR); bf16_t* ikr = (bf16_t*)(ws + OFF_IKR); float* iw = (float*)(ws + OFF_IW);
    const float* c64 = (const float*)(ws + OFF_ROPE); const float* s64 = c64 + 4096 * 64; const float* c32 = s64 + 4096 * 64; const float* s32 = c32 + 4096 * 32;
    const float ikg = p.in[I_CIKG][lane], ikb = p.in[I_CIKB][lane];
    for (int n = bid * 8 + wid; n < NTOK; n += nb * 8) {
        const int pos = n & (SEQ - 1);
        const bf16_t* row = Pd + (size_t)n * NO_MAIN;
#define ROPE8(off1, off2, cs, sn, scale, dst, d1, d2) do { \
            const u32x4 a_ = *(const u32x4*)(row + (off1)), b_ = *(const u32x4*)(row + (off2)); \
            const f32x4 c0_ = *(const f32x4*)(cs), c1_ = *(const f32x4*)((cs) + 4), s0_ = *(const f32x4*)(sn), s1_ = *(const f32x4*)((sn) + 4); \
            const unsigned aw_[4] = {a_.x, a_.y, a_.z, a_.w}, bw_[4] = {b_.x, b_.y, b_.z, b_.w}; float o1_[8], o2_[8]; \
            _Pragma("unroll") for (int j_ = 0; j_ < 4; ++j_) { \
                const float z1a = __uint_as_float(aw_[j_] << 16), z1b = __uint_as_float(aw_[j_] & 0xffff0000u), z2a = __uint_as_float(bw_[j_] << 16), z2b = __uint_as_float(bw_[j_] & 0xffff0000u); \
                const float ca = (j_ < 2 ? c0_[2 * j_] : c1_[2 * j_ - 4]), cb = (j_ < 2 ? c0_[2 * j_ + 1] : c1_[2 * j_ - 3]), sa = (j_ < 2 ? s0_[2 * j_] : s1_[2 * j_ - 4]), sb = (j_ < 2 ? s0_[2 * j_ + 1] : s1_[2 * j_ - 3]); \
                o1_[2 * j_] = (z1a * ca - z2a * sa) * (scale); o1_[2 * j_ + 1] = (z1b * cb - z2b * sb) * (scale); o2_[2 * j_] = (z2a * ca + z1a * sa) * (scale); o2_[2 * j_ + 1] = (z2b * cb + z1b * sb) * (scale); } \
            u32x4 w1_, w2_; w1_.x = cvt_pk_bf16(o1_[0], o1_[1]); w1_.y = cvt_pk_bf16(o1_[2], o1_[3]); w1_.z = cvt_pk_bf16(o1_[4], o1_[5]); w1_.w = cvt_pk_bf16(o1_[6], o1_[7]); \
            w2_.x = cvt_pk_bf16(o2_[0], o2_[1]); w2_.y = cvt_pk_bf16(o2_[2], o2_[3]); w2_.z = cvt_pk_bf16(o2_[4], o2_[5]); w2_.w = cvt_pk_bf16(o2_[6], o2_[7]); \
            *(u32x4*)((dst) + (d1)) = w1_; *(u32x4*)((dst) + (d2)) = w2_; } while (0)
        { const int h = lane >> 3, jb = (lane & 7) * 8;
            ROPE8(h * 128 + jb, h * 128 + 64 + jb, c64 + pos * 64 + jb, s64 + pos * 64 + jb, 0.08838834764831845f, qr + (size_t)n * 1024, h * 128 + jb, h * 128 + 64 + jb); }
        if (lane < 8) { const int jb = lane * 8;
            ROPE8(1024 + jb, 1024 + 64 + jb, c64 + pos * 64 + jb, s64 + pos * 64 + jb, 1.0f, kr + (size_t)n * 128, jb, 64 + jb); }
        else if (lane < 24) { const int c = (lane - 8) * 8;
            *(u32x4*)(vv + (size_t)n * 128 + c) = *(const u32x4*)(row + 1152 + c); }
        else if (lane < 40) { const int h = (lane - 24) >> 2, jb = ((lane - 24) & 3) * 8;
            ROPE8(1280 + h * 64 + jb, 1280 + h * 64 + 32 + jb, c32 + pos * 32 + jb, s32 + pos * 32 + jb, 0.125f, iqr + (size_t)n * 256, h * 64 + jb, h * 64 + 32 + jb); }
#undef ROPE8
        const int j32 = lane & 31; const float cc = c32[pos * 32 + j32], ss = s32[pos * 32 + j32];
        { const float x = bf2f(row[1536 + lane]); const float mean = wave_sum(x) * (1.0f / 64.0f); const float d = x - mean; const float var = wave_sum(d * d) * (1.0f / 64.0f);
            const float y = d * rsqrtf(var + LN_EPS) * ikg + ikb; const float o = __shfl_xor(y, 32);
            const float res = lane < 32 ? (y * cc - o * ss) : (y * cc + o * ss);
            ikr[(size_t)n * 64 + lane] = f2bf(res); }
        if (lane < 4) iw[(size_t)n * 4 + lane] = bf2f(row[1600 + lane]) * 0.5f;
    }
}


__device__ __forceinline__ void attn_query(const bf16_t* qr, const bf16_t* kr, const bf16_t* vv, bf16_t* ao, int n, LAS const unsigned short* ks, LAS unsigned char* vbuf, int lane) {
    const int fr = lane & 15, g = lane >> 4, q4 = fr >> 2, p4 = fr & 3;
    const int t = n & (SEQ - 1), b = n >> 12, cnt = (t + 1) < 256 ? (t + 1) : 256;
    {
        bf16x8 qf[4];
#pragma unroll
        for (int s = 0; s < 4; ++s) { qf[s] = (bf16x8){0, 0, 0, 0, 0, 0, 0, 0}; if (fr < 8) qf[s] = *(const bf16x8*)(qr + (size_t)n * 1024 + fr * 128 + s * 32 + g * 8); }
        const bf16_t* kbase = kr + (size_t)b * SEQ * 128; const bf16_t* vbase = vv + (size_t)b * SEQ * 128;
        f32x4 acc[16];
        bf16x8 kf[3][2][4];
#define ATT_KLOAD(buf, grp) do { _Pragma("unroll") for (int t2 = 0; t2 < 2; ++t2) { const int j_ = ((grp) * 2 + t2) * 16 + fr; const int key_ = j_ < cnt ? (int)ks[j_] : 0; \
            const bf16_t* kp_ = kbase + (size_t)key_ * 128 + g * 8; _Pragma("unroll") for (int s = 0; s < 4; ++s) kf[buf][t2][s] = *(const bf16x8*)(kp_ + s * 32); } } while (0)
        ATT_KLOAD(0, 0); ATT_KLOAD(1, 1);
#pragma unroll
        for (int grp = 0; grp < 8; ++grp) {
            if (grp + 2 < 8) ATT_KLOAD((grp + 2) % 3, grp + 2);
#pragma unroll
            for (int t2 = 0; t2 < 2; ++t2) { f32x4 a = fzero4();
#pragma unroll
                for (int s = 0; s < 4; ++s) a = __builtin_amdgcn_mfma_f32_16x16x32_bf16(kf[grp % 3][t2][s], qf[s], a, 0, 0, 0);
                acc[grp * 2 + t2] = a; }
        }
#undef ATT_KLOAD
        u32x4 vr[2][8];
#define ATT_VLOAD(buf, s) do { _Pragma("unroll") for (int i = 0; i < 8; ++i) { const int kl_ = i * 4 + g; const int jj_ = (s) * 32 + kl_; const int key_ = jj_ < cnt ? (int)ks[jj_] : 0; \
            const int c_ = fr ^ ((kl_ & 7) << 1); vr[buf][i] = *(const u32x4*)(vbase + (size_t)key_ * 128 + c_ * 8); } } while (0)
        ATT_VLOAD(0, 0);
        float m = -INFINITY;
#pragma unroll
        for (int tl = 0; tl < 16; ++tl)
#pragma unroll
            for (int r = 0; r < 4; ++r) { if (tl * 16 + g * 4 + r >= cnt) acc[tl][r] = -INFINITY; m = fmaxf(m, acc[tl][r]); }
        m = fmaxf(m, __shfl_xor(m, 16)); m = fmaxf(m, __shfl_xor(m, 32));
        float sum = 0.f;
#pragma unroll
        for (int tl = 0; tl < 16; ++tl)
#pragma unroll
            for (int r = 0; r < 4; ++r) { const float e_ = __expf(acc[tl][r] - m); acc[tl][r] = e_; sum += e_; }
        sum += __shfl_xor(sum, 16); sum += __shfl_xor(sum, 32);
        const float inv = 1.0f / sum;
        bf16x8 pf[8];
#pragma unroll
        for (int s = 0; s < 8; ++s) pf[s] = pack_8g(acc[2 * s], acc[2 * s + 1]);
        f32x4 o[8];
#pragma unroll
        for (int dt = 0; dt < 8; ++dt) o[dt] = fzero4();
#pragma unroll
        for (int s = 0; s < 8; ++s) {
            LAS unsigned char* vb = vbuf + (s & 1) * 8192;
            if (s + 1 < 8) ATT_VLOAD((s + 1) & 1, s + 1);
#pragma unroll
            for (int i = 0; i < 8; ++i) { const int kl = i * 4 + g; *(LAS u32x4*)(vb + kl * 256 + fr * 16) = vr[s & 1][i]; }
            const int kl1 = 4 * g + q4, kl2 = 16 + 4 * g + q4;
#pragma unroll
            for (int dt = 0; dt < 8; ++dt) {
                const int c = 2 * dt + (p4 >> 1);
                const s16x4 lo = __builtin_amdgcn_ds_read_tr16_b64_v4i16((LAS s16x4*)(vb + kl1 * 256 + ((c ^ ((kl1 & 7) << 1)) * 16) + (p4 & 1) * 8));
                const s16x4 hi = __builtin_amdgcn_ds_read_tr16_b64_v4i16((LAS s16x4*)(vb + kl2 * 256 + ((c ^ ((kl2 & 7) << 1)) * 16) + (p4 & 1) * 8));
                const bf16x8 af = (bf16x8){lo[0], lo[1], lo[2], lo[3], hi[0], hi[1], hi[2], hi[3]};
                o[dt] = __builtin_amdgcn_mfma_f32_16x16x32_bf16(af, pf[s], o[dt], 0, 0, 0);
            }
        }
#undef ATT_VLOAD
        if (fr < 8) {
#pragma unroll
            for (int dt = 0; dt < 8; ++dt) { u32x2 w; w.x = cvt_pk_bf16(o[dt][0] * inv, o[dt][1] * inv); w.y = cvt_pk_bf16(o[dt][2] * inv, o[dt][3] * inv);
                *(u32x2*)(ao + (size_t)n * 1024 + fr * 128 + dt * 16 + g * 4) = w; }
        }
    }
}

__device__ __forceinline__ int idx_bin(float s, float lo, float scale) { int b = (int)((s - lo) * scale); b = b < 0 ? 0 : b; return b > 255 ? 255 : b; }
__device__ __forceinline__ unsigned ord_key(float s) { const unsigned u = __float_as_uint(s); return (u & 0x80000000u) ? ~u : (u | 0x80000000u); }
__device__ __forceinline__ float ord_val(unsigned k) { return __uint_as_float((k & 0x80000000u) ? (k & 0x7fffffffu) : ~k); }
__device__ __forceinline__ void phase_index2(const Params& p, LAS unsigned char* lds, int bid, int nb) {
    const int tid = opaque_tid(), wid = __builtin_amdgcn_readfirstlane(tid >> 6), lane0 = tid & 63;
    unsigned char* ws = p.ws;
    const bf16_t* iqr = (const bf16_t*)(ws + OFF_IQR); const bf16_t* ikr = (const bf16_t*)(ws + OFF_IKR); const float* iw = (const float*)(ws + OFF_IW);
    const bf16_t* qr = (const bf16_t*)(ws + OFF_BUF64); const bf16_t* kr = (const bf16_t*)(ws + OFF_KR); const bf16_t* vv = (const bf16_t*)(ws + OFF_VV); bf16_t* ao = (bf16_t*)(ws + OFF_PD);
    LAS unsigned short* out = (LAS unsigned short*)(lds + 131072 + 24576) + wid * 256;
    LAS float* sc = (LAS float*)lds;
    LAS int* hist = (LAS int*)(lds + 131072) + wid * 256;
    LAS float* candv = (LAS float*)(lds + 131072 + 8192) + wid * 264;
    LAS unsigned short* candi = (LAS unsigned short*)(lds + 131072 + 8192 + 8 * 264 * 4) + wid * 256;
    LAS unsigned* mm = (LAS unsigned*)(lds + 131072 + 8192 + 8 * 264 * 4 + 8 * 512);
    const int ntile = NTOK / 8;
    PROBE_DECL;
    PROBE_BEGIN(9);
    for (int it = bid; it < ntile; it += nb) {
        const int round = it / nb, qt = (round & 1) ? (round * nb + (nb - 1 - (it - round * nb))) : it;
        const int n0 = qt * 8, t0 = n0 & (SEQ - 1), b = n0 >> 12;
        int lane = lane0; asm volatile("" : "+v"(lane));
        const int fr = lane & 15, g = lane >> 4; const unsigned long long lt_mask = (1ull << lane) - 1ull;
        asm volatile("" ::: "memory");
        if (tid < 16) mm[tid] = (tid & 1) ? 0u : 0xffffffffu;
        __syncthreads();
        PROBE_BEGIN(1);
#pragma unroll 1
        for (int genrep = 0; genrep < (IDXPROBE == 1 ? 2 : 1); ++genrep)
        if (t0 + 8 > 256) {
            bf16x8 af[2][2];
#pragma unroll
            for (int hh = 0; hh < 2; ++hh)
#pragma unroll
                for (int s = 0; s < 2; ++s) af[hh][s] = *(const bf16x8*)(iqr + (size_t)(n0 + 2 * (fr >> 2) + ((fr >> 1) & 1)) * 256 + (2 * hh + (fr & 1)) * 64 + s * 32 + g * 8);
            const f32x4 wq0 = *(const f32x4*)(iw + (size_t)(n0 + 2 * g) * 4), wq1 = *(const f32x4*)(iw + (size_t)(n0 + 2 * g + 1) * 4);
            float vmin0 = INFINITY, vmax0 = -INFINITY, vmin1 = INFINITY, vmax1 = -INFINITY;
            const int nkt = (t0 + 8 + 15) >> 4;
            const bf16_t* kb = ikr + (size_t)b * SEQ * 64;
            bf16x8 pb0[3], pb1[3];
#pragma unroll
            for (int i = 0; i < 2; ++i) { const int ktp = wid + 8 * i < nkt ? wid + 8 * i : wid; const bf16_t* kp = kb + (size_t)(ktp * 16 + fr) * 64 + g * 8; pb0[i] = *(const bf16x8*)kp; pb1[i] = *(const bf16x8*)(kp + 32); }
            for (int kt = wid; kt < nkt; kt += 8) {
                { const int ktp = kt + 16 < nkt ? kt + 16 : kt; const bf16_t* kp = kb + (size_t)(ktp * 16 + fr) * 64 + g * 8; pb0[2] = *(const bf16x8*)kp; pb1[2] = *(const bf16x8*)(kp + 32); }
                const bf16x8 b0 = pb0[0], b1 = pb1[0];
                pb0[0] = pb0[1]; pb1[0] = pb1[1]; pb0[1] = pb0[2]; pb1[1] = pb1[2];
                f32x4 d0 = fzero4(), d1 = fzero4();
                d0 = __builtin_amdgcn_mfma_f32_16x16x32_bf16(af[0][0], b0, d0, 0, 0, 0); d0 = __builtin_amdgcn_mfma_f32_16x16x32_bf16(af[0][1], b1, d0, 0, 0, 0);
                d1 = __builtin_amdgcn_mfma_f32_16x16x32_bf16(af[1][0], b0, d1, 0, 0, 0); d1 = __builtin_amdgcn_mfma_f32_16x16x32_bf16(af[1][1], b1, d1, 0, 0, 0);
                float s0 = fmaxf(d0[0], 0.f) * wq0[0] + fmaxf(d0[1], 0.f) * wq0[1] + fmaxf(d1[0], 0.f) * wq0[2] + fmaxf(d1[1], 0.f) * wq0[3];
                float s1 = fmaxf(d0[2], 0.f) * wq1[0] + fmaxf(d0[3], 0.f) * wq1[1] + fmaxf(d1[2], 0.f) * wq1[2] + fmaxf(d1[3], 0.f) * wq1[3];
                s0 += 0.0f; s1 += 0.0f;
                vmin0 = fminf(vmin0, s0); vmax0 = fmaxf(vmax0, s0); vmin1 = fminf(vmin1, s1); vmax1 = fmaxf(vmax1, s1);
                sc[(2 * g) * 4096 + kt * 16 + fr] = s0; sc[(2 * g + 1) * 4096 + kt * 16 + fr] = s1;
            }
#pragma unroll
            for (int j = 0; j < 2; ++j) { float mn = j ? vmin1 : vmin0, mx = j ? vmax1 : vmax0;
                mn = fminf(mn, dppf<0xB1>(mn)); mn = fminf(mn, dppf<0x4E>(mn)); mn = fminf(mn, dppf<0x141>(mn)); mn = fminf(mn, dppf<0x140>(mn));
                mx = fmaxf(mx, dppf<0xB1>(mx)); mx = fmaxf(mx, dppf<0x4E>(mx)); mx = fmaxf(mx, dppf<0x141>(mx)); mx = fmaxf(mx, dppf<0x140>(mx));
                if (fr == 0 && mx >= mn) { const int q = 2 * g + j;
                    __hip_atomic_fetch_min(mm + q * 2, ord_key(mn), __ATOMIC_RELAXED, __HIP_MEMORY_SCOPE_WORKGROUP); __hip_atomic_fetch_max(mm + q * 2 + 1, ord_key(mx), __ATOMIC_RELAXED, __HIP_MEMORY_SCOPE_WORKGROUP); } }
        }
        PROBE_END(1);
        PROBE_BEGIN(2);
        __syncthreads();
        PROBE_END(2);
        PROBE_BEGIN(7);
#pragma unroll 1
        for (int selrep = 0; selrep < (IDXPROBE == 2 ? 2 : 1); ++selrep)
        {
            const int n = n0 + wid, t = t0 + wid, nv = t + 1;
            if (nv <= 256) { for (int j = lane; j < 256; j += 64) out[j] = (unsigned short)(j < nv ? j : 0); }
            else {
                LAS const float* srow = sc + wid * 4096;
                const int nvp = (nv + 255) & ~255;
                const unsigned kmax = mm[wid * 2 + 1];
                const int kbase = (int)(kmax >> 19) - 255;
                unsigned P = 0u; int sh = 32;
                bool capped = false;
                float lo = ord_val(mm[wid * 2]), hi = ord_val(mm[wid * 2 + 1]);
                float lo1 = 0.f, sc1 = 0.f, lo2 = 0.f, sc2 = 0.f, lo3 = 0.f, sc3 = 0.f; int b1 = 0, b2 = 0, b3 = 0, nlev = 0;
                int m = nv, need = 256;
#define IDX_HIST_SCAN(bin, nneed, mmc, lumpc) do { int hb[4]; \
                    _Pragma("unroll") for (int j = 0; j < 4; ++j) hb[j] = hist[lane * 4 + j]; \
                    if (lane == 0) hb[0] += (lumpc); \
                    const int tot = hb[0] + hb[1] + hb[2] + hb[3]; int suf = tot; \
                    _Pragma("unroll") for (int off = 1; off < 64; off <<= 1) { const int v = __shfl_down(suf, off); if (lane + off < 64) suf += v; } \
                    const int above = suf - tot; const bool is = (above < need) && (need <= suf); \
                    bin = 0; nneed = 0; mmc = 0; \
                    if (is) { int c = above; \
                        _Pragma("unroll") for (int k = 3; k >= 0; --k) { if (nneed == 0) { if (need <= c + hb[k]) { bin = lane * 4 + k; nneed = need - c; mmc = hb[k]; } else c += hb[k]; } } } \
                    const unsigned long long bal = __ballot(is); const int srcl = __ffsll((long long)bal) - 1; \
                    bin = __shfl(bin, srcl); nneed = __shfl(nneed, srcl); mmc = __shfl(mmc, srcl); } while (0)
#define IDX_ZERO_HIST() do { int z = 0; asm volatile("" : "+v"(z)); _Pragma("unroll") for (int j = 0; j < 4; ++j) hist[lane * 4 + j] = z; } while (0)
                PROBE_BEGIN(3);
                {
                    IDX_ZERO_HIST();
                    int lumpl = 0;
                    for (int c0 = 0; c0 < nvp; c0 += 256) { const f32x4 s4 = *(const LAS f32x4*)(srow + c0 + lane * 4);
#pragma unroll
                        for (int e_ = 0; e_ < 4; ++e_) { const unsigned k = ord_key(s4[e_]); const int bin = (int)(k >> 19) - kbase; const bool valid = c0 + lane * 4 + e_ < nv;
                            if (valid && bin > 0) __hip_atomic_fetch_add(hist + bin, 1, __ATOMIC_RELAXED, __HIP_MEMORY_SCOPE_WORKGROUP);
                            lumpl += (valid && bin <= 0) ? 1 : 0; } }
                    int lump = lumpl;
#pragma unroll
                    for (int o = 32; o > 0; o >>= 1) lump += __shfl_xor(lump, o);
                    int bin, nneed, mmc; IDX_HIST_SCAN(bin, nneed, mmc, lump);
                    need = nneed; m = mmc;
                    if (bin > 0) { P = (unsigned)(kbase + bin); sh = 19; }
                    else { capped = true; hi = ord_val(((unsigned)(kbase + 1) << 19) - 1u); if (hi < lo) hi = lo; }
                }
                PROBE_END(3);
                PROBE_BEGIN(4);
#pragma unroll 1
                while (!capped && m > 128 && sh > 0) {
                    const int nsh = sh > 8 ? sh - 8 : 0; const unsigned dmask = (1u << (sh - nsh)) - 1u;
                    IDX_ZERO_HIST();
                    for (int c0 = 0; c0 < nvp; c0 += 256) { const f32x4 s4 = *(const LAS f32x4*)(srow + c0 + lane * 4);
#pragma unroll
                        for (int e_ = 0; e_ < 4; ++e_) { const unsigned k = ord_key(s4[e_]);
                            if (c0 + lane * 4 + e_ < nv && (k >> sh) == P) __hip_atomic_fetch_add(hist + ((k >> nsh) & dmask), 1, __ATOMIC_RELAXED, __HIP_MEMORY_SCOPE_WORKGROUP); } }
                    int bin, nneed, mmc; IDX_HIST_SCAN(bin, nneed, mmc, 0);
                    P = (P << (sh - nsh)) | (unsigned)bin; sh = nsh; need = nneed; m = mmc;
                }
#define IDX_CLASSIFY(s, cls) do { \
                    if (!capped) { const unsigned kk_ = sh >= 32 ? 0u : (ord_key(s) >> sh); cls = kk_ > P ? 2 : (kk_ == P ? 1 : 0); } \
                    else if ((int)(ord_key(s) >> 19) > kbase) cls = 2; \
                    else { cls = 1; \
                        if (nlev >= 1) { const int bb = idx_bin(s, lo1, sc1); if (bb != b1) cls = bb > b1 ? 2 : 0; } \
                        if (cls == 1 && nlev >= 2) { const int bb = idx_bin(s, lo2, sc2); if (bb != b2) cls = bb > b2 ? 2 : 0; } \
                        if (cls == 1 && nlev >= 3) { const int bb = idx_bin(s, lo3, sc3); if (bb != b3) cls = bb > b3 ? 2 : 0; } } } while (0)
#pragma unroll 1
                while (capped && m > 128 && nlev < 3 && (hi - lo) > 1e-30f) {
                    const float width = hi - lo, scale = 256.0f / width;
                    IDX_ZERO_HIST();
                    for (int c0 = 0; c0 < nvp; c0 += 256) { const f32x4 s4 = *(const LAS f32x4*)(srow + c0 + lane * 4);
#pragma unroll
                        for (int e_ = 0; e_ < 4; ++e_) { const float s = s4[e_]; int cls; IDX_CLASSIFY(s, cls);
                            if (c0 + lane * 4 + e_ < nv && cls == 1) __hip_atomic_fetch_add(hist + idx_bin(s, lo, scale), 1, __ATOMIC_RELAXED, __HIP_MEMORY_SCOPE_WORKGROUP); } }
                    int bin, nneed, mmc; IDX_HIST_SCAN(bin, nneed, mmc, 0);
                    if (nlev == 0) { lo1 = lo; sc1 = scale; b1 = bin; } else if (nlev == 1) { lo2 = lo; sc2 = scale; b2 = bin; } else { lo3 = lo; sc3 = scale; b3 = bin; }
                    ++nlev; need = nneed; m = mmc;
                    const float w = width * (1.0f / 256.0f); lo = lo + (float)bin * w; hi = lo + w;
                }
#undef IDX_HIST_SCAN
#undef IDX_ZERO_HIST
                PROBE_END(4);
                PROBE_BEGIN(5);
                int base = 0, nc = 0;
                for (int c0 = 0; c0 < nvp; c0 += 256) { const f32x4 s4 = *(const LAS f32x4*)(srow + c0 + lane * 4);
                    bool su[4], ca[4]; int nsu = 0, nca = 0;
#pragma unroll
                    for (int e_ = 0; e_ < 4; ++e_) { const bool valid = c0 + lane * 4 + e_ < nv; int cls; IDX_CLASSIFY(s4[e_], cls); su[e_] = valid && cls == 2; ca[e_] = valid && cls == 1; nsu += su[e_] ? 1 : 0; nca += ca[e_] ? 1 : 0; }
                    unsigned long long bs4[4], bc4[4]; int ps = base, pc = nc, tots = 0, totc = 0;
#pragma unroll
                    for (int e_ = 0; e_ < 4; ++e_) { bs4[e_] = __ballot(su[e_]); bc4[e_] = __ballot(ca[e_]); ps += __popcll(bs4[e_] & lt_mask); pc += __popcll(bc4[e_] & lt_mask); tots += __popcll(bs4[e_]); totc += __popcll(bc4[e_]); }
#pragma unroll
                    for (int e_ = 0; e_ < 4; ++e_) { const int key = c0 + lane * 4 + e_;
                        if (su[e_]) { if (ps < 256) out[ps] = (unsigned short)key; ++ps; }
                        if (ca[e_]) { if (pc < 256) { candv[pc] = s4[e_]; candi[pc] = (unsigned short)key; } ++pc; } }
                    base += tots; nc += totc; }
#undef IDX_CLASSIFY
                PROBE_END(5);
                PROBE_BEGIN(6);
                const int mcap = nc < 256 ? nc : 256;
                float T = -INFINITY; int need_t = need;
                if (nc <= 256) {
                    float mine[4]; int cgt[4], cge[4];
#pragma unroll
                    for (int k = 0; k < 4; ++k) { mine[k] = (lane + 64 * k) < mcap ? candv[lane + 64 * k] : -INFINITY; cgt[k] = 0; cge[k] = 0; }
                    if (lane < 4 && mcap + lane < 260) candv[mcap + lane] = -INFINITY;
                    const int nk = (mcap + 63) >> 6;
                    for (int j = 0; j < mcap; j += 4) { const f32x4 vj = *(const LAS f32x4*)(candv + j);
#pragma unroll
                        for (int k = 0; k < 4; ++k) { if (k < nk) {
#pragma unroll
                            for (int e_ = 0; e_ < 4; ++e_) { cgt[k] += vj[e_] > mine[k] ? 1 : 0; cge[k] += vj[e_] >= mine[k] ? 1 : 0; } } } }
                    float tv = -INFINITY; int tg = 0; bool isT = false;
#pragma unroll
                    for (int k = 0; k < 4; ++k) { const bool ok = ((lane + 64 * k) < mcap) && (cgt[k] < need) && (need <= cge[k]); if (ok && !isT) { isT = true; tv = mine[k]; tg = cgt[k]; } }
                    const unsigned long long bT = __ballot(isT);
                    const int sl = __ffsll((long long)bT) - 1;
                    T = __shfl(tv, sl); need_t = need - __shfl(tg, sl);
                }
                int ties = 0;
                for (int c0 = 0; c0 < mcap; c0 += 64) { const int j = c0 + lane; const bool valid = j < mcap; const float s = valid ? candv[j] : -INFINITY;
                    const bool sure = valid && (nc <= 256) && s > T;
                    const bool tie = valid && ((nc <= 256) ? (s == T) : true);
                    const unsigned long long beq = __ballot(tie);
                    const int rank = ties + __popcll(beq & lt_mask);
                    const bool take = sure || (tie && rank < need_t);
                    const unsigned long long bt = __ballot(take);
                    const int pos = base + __popcll(bt & lt_mask);
                    if (take && pos < 256) out[pos] = candi[j];
                    base += __popcll(bt); ties += __popcll(beq); }
                PROBE_END(6);
            }
            attn_query(qr, kr, vv, ao, n, out, (LAS unsigned char*)(sc + wid * 4096), lane);
        }
        PROBE_END(7);
        PROBE_BEGIN(8);
        __syncthreads();
        PROBE_END(8);
    }
    PROBE_END(9);
    PROBE_STORE(ws, bid, tid);
}


__device__ __forceinline__ void phase_inproj_even(const Params& p, LAS unsigned char* lds, int bid, int nb) {
    unsigned char* ws = p.ws;
    pg::DenseSched S; S.init(ws + OFF_BUF64, ws + OFF_WINE, NTOK, NE_MAIN, 1024, nb, bid);
    pg::EpiBf16 E; E.O = (bf16_t*)(ws + OFF_P); E.ldc = NE_MAIN;
    pg::gemm_phase(lds, 1024, S, E);
}
__device__ __forceinline__ void phase_inproj_odd(const Params& p, LAS unsigned char* lds, int bid, int nb) {
    unsigned char* ws = p.ws;
    pg::DenseSched S; S.init(ws + OFF_BUF64, ws + OFF_WINO, NTOK, NO_MAIN, 1024, nb, bid);
    pg::EpiBf16 E; E.O = (bf16_t*)(ws + OFF_PD); E.ldc = NO_MAIN;
    pg::gemm_phase(lds, 1024, S, E);
}
__device__ __forceinline__ void phase_outproj(const Params& p, LAS unsigned char* lds, int bid, int nb, size_t aoff, size_t woff, const float* X) {
    unsigned char* ws = p.ws;
    pg::DenseSched S; S.init(ws + aoff, ws + woff, NTOK, 1024, 1024, nb, bid);
    pg::EpiResid E; E.X = X; E.U = (float*)(ws + OFF_U);
    pg::gemm_phase(lds, 1024, S, E);
}

#define XB_TMO      128
#define XB_XCNT(j)  (256  + 64 * (j))
#define XB_XSUB(j)  (1280 + 64 * (j))
#define XB_XGEN(j)  (2304 + 64 * (j))
#define XB_TOP      3328
#define XB_TOPGEN   3392
#define XCD_BAR_WORDS 3456
#define XB_SPIN_CAP (1u << 20)
__device__ __forceinline__ unsigned xb_ld(unsigned* p)              { return __hip_atomic_load(p, __ATOMIC_RELAXED, __HIP_MEMORY_SCOPE_AGENT); }
__device__ __forceinline__ unsigned xb_add(unsigned* p, unsigned v) { return __hip_atomic_fetch_add(p, v, __ATOMIC_RELAXED, __HIP_MEMORY_SCOPE_AGENT); }
__device__ __forceinline__ unsigned xb_xcc_id() { return (unsigned)__builtin_amdgcn_s_getreg((3 << 11) | 20) & 0xFu; }
#define XB_SPIN(cond, bar) do { unsigned _sp = 0; while (cond) { __builtin_amdgcn_s_sleep(1); \
    if ((++_sp & 255u) == 0u) { if (xb_ld(&(bar)[XB_TMO])) break; if (_sp > XB_SPIN_CAP) { atomicAdd(&(bar)[XB_TMO], 1u); break; } } } } while (0)
__device__ __forceinline__ void xcd_barrier_complete(unsigned* bar, unsigned x, unsigned& nloc, unsigned& nx) {
    const unsigned G = gridDim.x;
    unsigned sum, cnt, mine, sp = 0u;
    for (;;) {
        sum = 0u; cnt = 0u; mine = 0u;
#pragma unroll
        for (unsigned j = 0; j < 16; ++j) { const unsigned c = xb_ld(&bar[XB_XCNT(j)]); sum += c; cnt += (c > 0u) ? 1u : 0u; mine = (j == x) ? c : mine; }
        if (sum == G) break;
        __builtin_amdgcn_s_sleep(1);
        if ((++sp & 255u) == 0u) { if (xb_ld(&bar[XB_TMO])) break; if (sp > XB_SPIN_CAP) { atomicAdd(&bar[XB_TMO], 1u); break; } }
    }
    nloc = mine > 0u ? mine : 1u; nx = cnt > 0u ? cnt : 1u;
}
__device__ __forceinline__ void grid_barrier(unsigned* bar, volatile LAS unsigned* st) {
    asm volatile("s_waitcnt vmcnt(0) lgkmcnt(0)" ::: "memory");
    __syncthreads();
    if (threadIdx.x == 0) {
        const unsigned x = xb_xcc_id();
        __builtin_amdgcn_s_waitcnt(0);
        unsigned nloc = st[0], nx = st[1];
        if (nloc == 0u) { xcd_barrier_complete(bar, x, nloc, nx); st[0] = nloc; st[1] = nx; }
        const unsigned old = xb_add(&bar[XB_XSUB(x)], 1u);
        const unsigned gen = old / nloc;
        if (old + 1u == (gen + 1u) * nloc) {
            __builtin_amdgcn_fence(__ATOMIC_RELEASE, "agent");
            asm volatile("s_waitcnt vmcnt(0)" ::: "memory");
            const unsigned og = xb_add(&bar[XB_TOP], 1u);
            const unsigned tg = og / nx;
            if (og + 1u == (tg + 1u) * nx) xb_add(&bar[XB_TOPGEN], 1u);
            else XB_SPIN(xb_ld(&bar[XB_TOPGEN]) == tg, bar);
            __builtin_amdgcn_fence(__ATOMIC_ACQUIRE, "agent");
            xb_add(&bar[XB_XGEN(x)], 1u);
            asm volatile("s_waitcnt vmcnt(0)" ::: "memory");
        } else {
            XB_SPIN(xb_ld(&bar[XB_XGEN(x)]) == gen, bar);
            __builtin_amdgcn_fence(__ATOMIC_ACQUIRE, "agent");
            asm volatile("s_waitcnt vmcnt(0)" ::: "memory");
        }
    }
    __syncthreads();
}
#ifndef DUP
#define DUP 0
#endif
#define GSYNC() grid_barrier(bar_ctr, (volatile LAS unsigned*)(lds + LDS_BYTES - 1024))
__global__ __launch_bounds__(512, 2) void mega(KArgs a) {
    extern __shared__ __attribute__((aligned(16))) unsigned char smem[];
    LAS unsigned char* lds = (LAS unsigned char*)smem;
    Params p; p.in.t = (LAS const unsigned long long*)(lds + PTAB_OFF); p.out = a.out; p.ws = a.ws;
    if ((threadIdx.x & 63) == 0) ((LAS int*)(lds + WTAB_OFF))[hw_slot()] = threadIdx.x >> 6;
    if (threadIdx.x == 0) { LAS unsigned long long* tw_ = (LAS unsigned long long*)(lds + PTAB_OFF);
#pragma unroll
        for (int i = 0; i < 30; ++i) tw_[i] = (unsigned long long)a.in[i]; }
    __syncthreads();
    cg::grid_group grid = cg::this_grid();
    const int bid0 = blockIdx.x, nb0 = gridDim.x;
    unsigned* bar_ctr = (unsigned*)(p.ws + OFF_MISC + MISC_BAR);
    if (blockIdx.x == 0) for (int i = threadIdx.x; i < XCD_BAR_WORDS; i += 512) __hip_atomic_store(bar_ctr + i, 0u, __ATOMIC_RELAXED, __HIP_MEMORY_SCOPE_AGENT);
    if (threadIdx.x < 2) ((LAS unsigned*)(lds + LDS_BYTES - 1024))[threadIdx.x] = 0u;
    grid.sync();
    if (threadIdx.x == 0) (void)xb_add(&bar_ctr[XB_XCNT(xb_xcc_id())], 1u);
    int bid, nb;
#define FRESH() do { bid = bid0; nb = nb0; asm volatile("" : "+s"(bid), "+s"(nb)); } while (0)
#define PHP(pid, call) do { unsigned long long t0_ = 0; if (PROBE_ID == (pid)) t0_ = __builtin_amdgcn_s_memtime(); call; if (PROBE_ID == (pid) && bid0 == (PROBE_BLK) && opaque_tid() == 0) *(float*)(p.ws + OFF_MISC + MISC_PROBE) = (float)(__builtin_amdgcn_s_memtime() - t0_) * 3e-8f; } while (0)
#define RUNP(id, call) do { FRESH(); call; GSYNC(); if (DUP == id) { FRESH(); call; GSYNC(); } } while (0)
    RUNP(10, PHP(30, phase_prep(p, lds, bid, nb, 0)));
#if PROBE_ID == 20
    const unsigned long long kstart = __builtin_amdgcn_s_memtime();
#endif
#pragma unroll 1
    for (int layer = 0; layer < 2; ++layer) {
        if (layer == 0) {
            FRESH(); PHP(31, phase_inproj_even(p, lds, bid, nb));
            GSYNC();
            RUNP(21, PHP(44, phase_lora_act(p, bid, nb)));
            PHP(45, RUNP(1, PHP(33, phase_mixer_even(p, lds, bid, nb, 0))));
            FRESH(); PHP(34, phase_rwkv_epi(p, bid, nb));
            RUNP(13, PHP(46, phase_gla_fix(p, lds, bid, nb)));
        } else {
            RUNP(14, PHP(40, phase_inproj_odd(p, lds, bid, nb)));
            RUNP(15, PHP(41, phase_rope(p, bid, nb)));
            RUNP(2, PHP(43, phase_index2(p, lds, bid, nb)));
        }
        RUNP(16, PHP(35, phase_outproj(p, lds, bid, nb, layer ? OFF_PD : OFF_BUF64, layer ? OFF_WOUTO : OFF_WOUTE, layer ? p.out : p.in[I_X])));
        FRESH(); PHP(36, phase_ln_route(p, lds, bid, nb, layer));
        GSYNC();
        RUNP(17, PHP(37, phase_moe_gateup(p, lds, bid, nb, layer)));
        RUNP(18, PHP(38, phase_moe_down(p, lds, bid, nb, layer)));
#if PROBE_ID == 20
        if (layer == 1) { if (bid0 == 7 && threadIdx.x == 0) *(float*)(p.ws + OFF_MISC + MISC_PROBE) = (float)(__builtin_amdgcn_s_memtime() - kstart) * 1e-8f; GSYNC(); }
#endif
        RUNP(19, PHP(39, phase_ln2(p, bid, nb, layer, p.out, true)));
    }
}

extern "C" void kernel_launch(void* const* d_in, const int* in_sizes, int n_in, void* d_out, int out_size, void* d_ws, size_t ws_size, hipStream_t stream) {
    if (ws_size < WS_NEED) { fprintf(stderr, "workspace too small: %zu < %zu\n", ws_size, (size_t)WS_NEED); return; }
    KArgs p{};
    for (int i = 0; i < 30; ++i) p.in[i] = (const float*)d_in[i];
    p.out = (float*)d_out; p.ws = (unsigned char*)d_ws;
    static int grid_blocks = 0;
    if (!grid_blocks) {
        (void)hipFuncSetAttribute((const void*)mega, hipFuncAttributeMaxDynamicSharedMemorySize, LDS_BYTES);
        int dev = 0, cus = 0, per_cu = 0;
        (void)hipGetDevice(&dev);
        (void)hipDeviceGetAttribute(&cus, hipDeviceAttributeMultiprocessorCount, dev);
        (void)hipOccupancyMaxActiveBlocksPerMultiprocessor(&per_cu, mega, 512, LDS_BYTES);
        if (per_cu < 1) { fprintf(stderr, "occupancy query returned %d\n", per_cu); per_cu = 1; }
        grid_blocks = cus;
    }
    void* args[] = {&p};
    hipError_t e = hipLaunchCooperativeKernel((void*)mega, dim3(grid_blocks), dim3(512), args, LDS_BYTES, stream);
    if (e != hipSuccess) fprintf(stderr, "cooperative launch failed: %s (grid %d)\n", hipGetErrorString(e), grid_blocks);
}
```

```cpp
#include <hip/hip_runtime.h>
#include <hip/hip_cooperative_groups.h>
#include <cstdio>
#include <cstdint>
namespace cg = cooperative_groups;

#ifndef PROBE_ID
#define PROBE_ID 0
#endif
#ifndef PROBE_BLK
#define PROBE_BLK 7
#endif
#ifndef IDXPROBE
#define IDXPROBE 0
#endif
#ifndef SANITIZE
#define SANITIZE 0
#endif
#ifndef PREP_REP
#define PREP_REP 1
#endif
constexpr int NTOK = 32768, SEQ = 4096, NB = 8, DM = 1024;
constexpr int EVEN_COLS = 3344, ODD_COLS = 1604;
constexpr int NE_MAIN = 3328;
constexpr int NO_MAIN = 1792;
constexpr int NEXP = 16, DEXP = 256;
constexpr float DN_ALPHA = 1.4142135623730951f;
constexpr float LN_EPS = 1e-5f;
constexpr int MOE_ROWS = 65536 + 16 * 256;

typedef unsigned short bf16_t;
typedef short bf16x8 __attribute__((ext_vector_type(8)));
typedef float f32x4 __attribute__((ext_vector_type(4)));
typedef short s16x4 __attribute__((ext_vector_type(4)));
typedef float f32x2 __attribute__((ext_vector_type(2)));
typedef unsigned u32x4 __attribute__((ext_vector_type(4)));
typedef unsigned u32x2 __attribute__((ext_vector_type(2)));
#define LAS __attribute__((address_space(3)))

typedef __bf16 bf16x2_t __attribute__((ext_vector_type(2)));
__device__ __forceinline__ unsigned cvt_pk_bf16(float lo, float hi) { bf16x2_t v; v[0] = (__bf16)lo; v[1] = (__bf16)hi; return __builtin_bit_cast(unsigned, v); }
__device__ __forceinline__ bf16_t f2bf(float f) { return (bf16_t)(cvt_pk_bf16(f, 0.f) & 0xffffu); }
__device__ __forceinline__ float bf2f(bf16_t h) { return __uint_as_float(((unsigned)h) << 16); }
constexpr int LDS_BYTES = 160 * 1024;
constexpr int PTAB_OFF = LDS_BYTES - 256;
constexpr int WTAB_OFF = LDS_BYTES - 512;
__device__ __forceinline__ int hw_slot() { return (int)(__builtin_amdgcn_s_getreg(0x2804) & 63u); }
__device__ __forceinline__ int opaque_tid() {
    extern __shared__ __attribute__((aligned(16))) unsigned char smem_[];
    const int w = __builtin_amdgcn_readfirstlane(((LAS const int*)((LAS unsigned char*)smem_ + WTAB_OFF))[hw_slot()]);
    int l; asm volatile("v_mbcnt_lo_u32_b32 %0, -1, 0\n\tv_mbcnt_hi_u32_b32 %0, -1, %0" : "=v"(l));
    return (w << 6) | l; }
#if PROBE_ID
#define PROBE_DECL unsigned long long probe_acc = 0, probe_t0 = 0
#define PROBE_BEGIN(id) do { if (PROBE_ID == (id)) probe_t0 = __builtin_amdgcn_s_memtime(); } while (0)
#define PROBE_END(id) do { if (PROBE_ID == (id)) probe_acc += __builtin_amdgcn_s_memtime() - probe_t0; } while (0)
#define PROBE_STORE(ws, bid, tid) do { if (PROBE_ID < 30 && (bid) == 7 && (tid) == 0) *(float*)((ws) + OFF_MISC + MISC_PROBE) = (float)probe_acc * 5e-8f; } while (0)
#else
#define PROBE_DECL
#define PROBE_BEGIN(id)
#define PROBE_END(id)
#define PROBE_STORE(ws, bid, tid)
#endif
__device__ __forceinline__ f32x4 fzero4() { float z = 0.f; asm volatile("" : "+v"(z)); return (f32x4){z, z, z, z}; }
__device__ __forceinline__ u32x4 uzero4() { unsigned z = 0u; asm volatile("" : "+v"(z)); return (u32x4){z, z, z, z}; }
__device__ __forceinline__ float fast_rcp(float x) { return __builtin_amdgcn_rcpf(x); }
__device__ __forceinline__ float fast_sigmoid(float x) { return fast_rcp(1.0f + __expf(-x)); }
__device__ __forceinline__ float fast_tanh(float x) { const float e = __expf(2.0f * x); return 1.0f - 2.0f * fast_rcp(1.0f + e); }
__device__ __forceinline__ bf16x8 pack_8g(const f32x4 a, const f32x4 b) { u32x4 w; w.x = cvt_pk_bf16(a[0], a[1]); w.y = cvt_pk_bf16(a[2], a[3]); w.z = cvt_pk_bf16(b[0], b[1]); w.w = cvt_pk_bf16(b[2], b[3]); return __builtin_bit_cast(bf16x8, w); }
template <int CTRL> __device__ __forceinline__ float dppf(float v) { return __builtin_bit_cast(float, __builtin_amdgcn_update_dpp(0, __builtin_bit_cast(int, v), CTRL, 0xf, 0xf, true)); }
__device__ __forceinline__ float wave_sum(float v) {
#pragma unroll
    for (int o = 32; o > 0; o >>= 1) v += __shfl_xor(v, o);
    return v;
}

constexpr size_t MiB = 1024ull * 1024ull;
constexpr size_t OFF_WINE = 0;
constexpr size_t OFF_WOUTE = OFF_WINE + (size_t)NE_MAIN * 1024 * 2;
constexpr size_t OFF_WINO = OFF_WOUTE + 2 * MiB;
constexpr size_t OFF_WOUTO = OFF_WINO + (size_t)NO_MAIN * 1024 * 2;
constexpr size_t OFF_WGU = OFF_WOUTO + 2 * MiB;
constexpr size_t OFF_WD = OFF_WGU + 32 * MiB;
constexpr size_t OFF_ROPE = OFF_WD + 16 * MiB;
constexpr size_t OFF_MISC = OFF_ROPE + 3 * MiB;
constexpr size_t OFF_BUF64 = OFF_MISC + 4 * MiB;
constexpr size_t OFF_P = OFF_BUF64 + 64 * MiB;
constexpr size_t OFF_U = OFF_P + 208 * MiB;
constexpr size_t WS_NEED = OFF_U + 128 * MiB;
constexpr size_t OFF_HE = OFF_P;
constexpr size_t OFF_ACT = OFF_HE + (size_t)MOE_ROWS * 1024 * 2;
constexpr size_t OFF_PD = OFF_P;
constexpr size_t OFF_KR = OFF_P + 112 * MiB;
constexpr size_t OFF_VV = OFF_KR + 8 * MiB;
constexpr size_t OFF_IQR = OFF_VV + 8 * MiB;
constexpr size_t OFF_IKR = OFF_IQR + 16 * MiB;
constexpr size_t OFF_IW = OFF_IKR + 4 * MiB;
constexpr size_t OFF_IDX = OFF_IW + 1 * MiB;
constexpr size_t MISC_CNT = 0;
constexpr size_t MISC_TOKINFO = 4096;
constexpr size_t MISC_TOKGATE = MISC_TOKINFO + (size_t)NTOK * 16;
constexpr size_t MISC_LIST = MISC_TOKGATE + (size_t)NTOK * 8;
constexpr size_t MISC_PROBE = 2304;
constexpr size_t MISC_W2T = 3 * MiB;
constexpr size_t MISC_A2T = MISC_W2T + 65536;
constexpr size_t MISC_G2T = MISC_A2T + 65536;
constexpr size_t MISC_BAR = MISC_G2T + 131072;
constexpr size_t MISC_RWF = MISC_BAR + 16384;
constexpr size_t MISC_PCTR = MISC_RWF + 16384;
constexpr size_t OFF_GLA_ORAW = OFF_U + 50 * MiB;
constexpr size_t OFF_GLA_QDG = OFF_U + 82 * MiB;
constexpr size_t OFF_GLA_SIN = OFF_U + 90 * MiB;
constexpr size_t OFF_RWXB = OFF_U + 24 * MiB;

struct InTab { LAS const unsigned long long* t;
    __device__ __forceinline__ const float* operator[](int i) const { const unsigned long long v = t[i];
        const unsigned lo = __builtin_amdgcn_readfirstlane((unsigned)v), hi = __builtin_amdgcn_readfirstlane((unsigned)(v >> 32));
        return (const float*)(((unsigned long long)hi << 32) | lo); } };
struct Params { InTab in; float* out; unsigned char* ws; };
struct KArgs { const float* in[30]; float* out; unsigned char* ws; };
enum { I_X = 0, I_WINE, I_AMU, I_AW0, I_AW2, I_AA0, I_AA2, I_AG2, I_AKK, I_AKA, I_ARK, I_AGNG, I_AGNB, I_BGW2, I_BGB, I_BNG, I_WOUTE,
       I_WINO, I_CIKG, I_CIKB, I_WOUTO, I_LN1G, I_LN1B, I_LN2G, I_LN2B, I_RW, I_RB, I_EG, I_EU, I_ED };

namespace pg {
constexpr int BM = 256, BK = 64, HALF = 128, HTB = HALF * BK * 2, STAGE_BYTES = 8 * HTB;
__host__ __device__ __forceinline__ int lds_byte(int r, int c) { const int st = (r >> 4) * 2 + (c >> 5), rr = r & 15, cc = c & 31, ob = rr * 64 + cc * 2; return st * 1024 + (ob ^ (((ob >> 9) & 1) << 5)); }
__host__ __device__ __forceinline__ void stage_rc(int b, int& R, int& C) { const int st = b / 1024, sb = b % 1024, swz = sb ^ (((sb >> 9) & 1) << 5); R = (st >> 1) * 16 + swz / 64; C = (st & 1) * 32 + (swz % 64) / 2; }
__host__ __device__ __forceinline__ int perm32(int rho) { const int n = rho >> 4, i = rho & 15; return 8 * (i >> 2) + 4 * n + (i & 3); }

struct Unit { int pm, pn, e, rt, cnt; };

template <class Epi, class Sched>
__device__ __forceinline__ void gemm_phase(LAS unsigned char* lds, const int K, const Sched& S, const Epi& E) {
    const int tid = opaque_tid(), wid = __builtin_amdgcn_readfirstlane(tid >> 6), lane = tid & 63, wr = wid >> 2, wc = wid & 3, fr = lane & 15, fq = lane >> 4;
    const int nt = K / BK;
    unsigned voffB[2];
#pragma unroll
    for (int i = 0; i < 2; ++i) { int R, C; stage_rc(tid * 16 + i * 8192, R, C); const int Rb = Epi::PERM ? ((R & ~31) + perm32(R & 31)) : R; voffB[i] = (unsigned)(Rb * K + C) * 2u; }
    const size_t kstep = (size_t)(BK * 2);
    const size_t hstepB = (size_t)HALF * K * 2;
    const unsigned ldsw = (unsigned)wid * 1024u;
    const int aoff = lds_byte(wr * 64 + fr, fq * 8), boff = lds_byte(wc * 32 + fr, fq * 8);
#define PG_SA(b, h) (((b) * 2 + (h)) * HTB)
#define PG_SB(b, h) ((4 + (b) * 2 + (h)) * HTB)
#define PG_STAGE(bufoff, gbase, voff) do { _Pragma("unroll") for (int _i = 0; _i < 2; ++_i) \
        __builtin_amdgcn_global_load_lds((const unsigned*)((const char*)(gbase) + (voff)[_i]), (LAS unsigned*)(lds + (bufoff) + ldsw + _i * 8192), 16, 0, 0); } while (0)
#define PG_LDA(dst, b, h) do { _Pragma("unroll") for (int m = 0; m < 4; ++m) _Pragma("unroll") for (int k = 0; k < 2; ++k) dst[m][k] = *(const LAS bf16x8*)(lds + PG_SA(b, h) + aoff + m * 2048 + k * 1024); } while (0)
#define PG_LDB(dst, b, h) do { _Pragma("unroll") for (int n = 0; n < 2; ++n) _Pragma("unroll") for (int k = 0; k < 2; ++k) dst[n][k] = *(const LAS bf16x8*)(lds + PG_SB(b, h) + boff + n * 2048 + k * 1024); } while (0)
#define PG_MMA(ai, bj, At, Bt) do { __builtin_amdgcn_s_setprio(1); _Pragma("unroll") for (int m = 0; m < 4; ++m) _Pragma("unroll") for (int n = 0; n < 2; ++n) _Pragma("unroll") for (int k = 0; k < 2; ++k) \
        acc[ai][bj][m][n] = __builtin_amdgcn_mfma_f32_16x16x32_bf16(Bt[n][k], At[m][k], acc[ai][bj][m][n], 0, 0, 0); __builtin_amdgcn_s_setprio(0); } while (0)
#define PG_WAIT_V(n) asm volatile("s_waitcnt vmcnt(" #n ")" ::: "memory")
#define PG_WAIT_L(n) asm volatile("s_waitcnt lgkmcnt(" #n ")" ::: "memory")
#define PG_BAR __builtin_amdgcn_s_barrier()
#define PG_SCHED __builtin_amdgcn_sched_barrier(0)
#define PG_AOFF(dst0, dst1, u) do { _Pragma("unroll") for (int _i = 0; _i < 2; ++_i) { int _R, _C; stage_rc(tid * 16 + _i * 8192, _R, _C); \
        dst0[_i] = S.a_rowoff(u, 0, _R) + (unsigned)_C * 2u; dst1[_i] = S.a_rowoff(u, 1, _R) + (unsigned)_C * 2u; } } while (0)
    Unit cur, nxt; int ui = 0;
    if (!S.next(0, cur)) return;
    f32x4 acc[2][2][4][2];
#pragma unroll
    for (int a = 0; a < 2; ++a)
#pragma unroll
        for (int b = 0; b < 2; ++b)
#pragma unroll
            for (int m = 0; m < 4; ++m)
#pragma unroll
                for (int n = 0; n < 2; ++n) acc[a][b][m][n] = (f32x4){0.f, 0.f, 0.f, 0.f};
    bf16x8 At[4][2], B0[2][2], B1[2][2];
    const char* const Ab = S.a_base();
    unsigned aC0[2], aC1[2];
    PG_AOFF(aC0, aC1, cur);
    const char* cB = S.b_ptr(cur);
    PG_STAGE(PG_SB(0, 0), cB, voffB); PG_STAGE(PG_SA(0, 0), Ab, aC0); PG_STAGE(PG_SB(0, 1), cB + hstepB, voffB); PG_STAGE(PG_SA(0, 1), Ab, aC1);
    if (wr == 1) PG_BAR;
    PG_WAIT_V(4); PG_BAR;
    PG_STAGE(PG_SB(1, 0), cB + kstep, voffB); PG_STAGE(PG_SA(1, 0), Ab + kstep, aC0); PG_STAGE(PG_SB(1, 1), cB + hstepB + kstep, voffB);
    PG_WAIT_V(6); PG_BAR;
    for (;;) {
        const bool has_next = S.next(ui + 1, nxt);
        const char* nB = has_next ? S.b_ptr(nxt) : cB;
#pragma unroll 1
        for (int t = 0; t < nt; t += 2) {
            const bool last = (t == nt - 2);
            const char* a1 = Ab + (size_t)(t + 1) * kstep;
            const char* a2 = last ? Ab : Ab + (size_t)(t + 2) * kstep; const char* b2 = last ? nB : cB + (size_t)(t + 2) * kstep;
            const char* a3 = a2 + kstep; const char* b3 = b2 + kstep;
            PG_LDB(B0, 0, 0); PG_SCHED; PG_LDA(At, 0, 0); PG_STAGE(PG_SA(1, 1), a1, aC1);
            if (last && has_next) PG_AOFF(aC0, aC1, nxt);
            PG_WAIT_L(8); PG_BAR; PG_WAIT_L(0); PG_MMA(0, 0, At, B0); PG_BAR; PG_SCHED;
            PG_LDB(B1, 0, 1); PG_STAGE(PG_SB(0, 0), b2, voffB);
            PG_BAR; PG_WAIT_L(0); PG_MMA(0, 1, At, B1); PG_BAR;
            PG_LDA(At, 0, 1); PG_STAGE(PG_SA(0, 0), a2, aC0);
            PG_BAR; PG_WAIT_L(0); PG_MMA(1, 0, At, B0); PG_BAR; PG_SCHED;
            PG_STAGE(PG_SB(0, 1), b2 + hstepB, voffB);
            PG_WAIT_V(6); PG_BAR; PG_MMA(1, 1, At, B1); PG_BAR;
            PG_LDB(B0, 1, 0); PG_SCHED; PG_LDA(At, 1, 0); PG_STAGE(PG_SA(0, 1), a2, aC1);
            PG_WAIT_L(8); PG_BAR; PG_WAIT_L(0); PG_MMA(0, 0, At, B0); PG_BAR; PG_SCHED;
            PG_LDB(B1, 1, 1); PG_STAGE(PG_SB(1, 0), b3, voffB);
            PG_BAR; PG_WAIT_L(0); PG_MMA(0, 1, At, B1); PG_BAR;
            PG_LDA(At, 1, 1); PG_STAGE(PG_SA(1, 0), a3, aC0);
            PG_BAR; PG_WAIT_L(0); PG_MMA(1, 0, At, B0); PG_BAR; PG_SCHED;
            PG_STAGE(PG_SB(1, 1), b3 + hstepB, voffB);
            PG_WAIT_V(6); PG_BAR; PG_MMA(1, 1, At, B1); PG_BAR;
        }
        E(acc, cur, wr, wc, fr, fq);
        if (!has_next) break;
#pragma unroll
        for (int a = 0; a < 2; ++a)
#pragma unroll
            for (int b = 0; b < 2; ++b)
#pragma unroll
                for (int m = 0; m < 4; ++m)
#pragma unroll
                    for (int n = 0; n < 2; ++n) acc[a][b][m][n] = (f32x4){0.f, 0.f, 0.f, 0.f};
        cur = nxt; cB = nB; ++ui;
    }
    PG_WAIT_V(0);
    if (wr == 0) PG_BAR;
    PG_BAR;
#undef PG_SA
#undef PG_SB
#undef PG_STAGE
#undef PG_LDA
#undef PG_LDB
#undef PG_MMA
#undef PG_WAIT_V
#undef PG_WAIT_L
#undef PG_BAR
#undef PG_SCHED
#undef PG_AOFF
}

struct DenseSched {
    const char* A; const char* Bt; int K, nM, nN, nwg, G, c;
    __device__ void init(const void* A_, const void* Bt_, int M, int N, int K_, int G_, int c_) { A = (const char*)A_; Bt = (const char*)Bt_; K = K_; nM = M / BM; nN = N / BM; nwg = nM * nN; G = G_; c = c_; }
    __device__ __forceinline__ bool next(int i, Unit& u) const {
        const long L = (long)i * G + c; if (L >= nwg) return false;
        int wgid = (int)L; { const int q = nwg / 8, r = nwg % 8, xcd = wgid % 8, off = wgid / 8; wgid = (xcd < r ? xcd * (q + 1) : r * (q + 1) + (xcd - r) * q) + off; }
        const int nig = 8 * nN, gid = wgid / nig, fm = gid * 8, gsz = (nM - fm) < 8 ? (nM - fm) : 8;
        u.pm = fm + ((wgid % nig) % gsz); u.pn = (wgid % nig) / gsz; u.e = 0; u.rt = 0; u.cnt = 0; return true;
    }
    __device__ __forceinline__ const char* a_base() const { return A; }
    __device__ __forceinline__ unsigned a_rowoff(const Unit& u, int half, int R) const { return (unsigned)(u.pm * BM + half * HALF + R) * (unsigned)(K * 2); }
    __device__ __forceinline__ const char* b_ptr(const Unit& u) const { return Bt + (size_t)u.pn * BM * K * 2; }
};

__device__ __forceinline__ void moe_build_units(LAS int* tab, const int* cntp, int NCT, int G, int c) {
    const int i = opaque_tid();
    if (i < 16) {
        const int L = i * G + c; int accu = 0, rtb = 0, found = 0, pm = 0, pn = 0, ee = 0, rt = 0, cn = 0;
        for (int e = 0; e < 16; ++e) { const int ce = cntp[e], nte = (ce + 255) >> 8, ue = nte * NCT;
            if (!found && L < accu + ue) { const int local = L - accu; ee = e; rt = local / NCT; pn = local % NCT; pm = rtb + rt; cn = ce; found = 1; }
            accu += ue; rtb += nte; }
        tab[i * 8 + 0] = found; tab[i * 8 + 1] = pm; tab[i * 8 + 2] = pn; tab[i * 8 + 3] = ee; tab[i * 8 + 4] = rt; tab[i * 8 + 5] = cn;
    }
    __syncthreads();
}
template <bool GATHER>
struct MoeSched {
    const char* A; const char* Bt; const int* list; int K; size_t wstride; LAS int* tab;
    __device__ void init(const void* A_, const void* Bt_, size_t wstride_bytes, const int* list_, int K_, LAS int* tab_) {
        A = (const char*)A_; Bt = (const char*)Bt_; wstride = wstride_bytes; list = list_; K = K_; tab = tab_; }
    __device__ __forceinline__ bool next(int i, Unit& u) const {
        if (i >= 16) return false;
        const int f = __builtin_amdgcn_readfirstlane(tab[i * 8 + 0]);
        u.pm = __builtin_amdgcn_readfirstlane(tab[i * 8 + 1]); u.pn = __builtin_amdgcn_readfirstlane(tab[i * 8 + 2]); u.e = __builtin_amdgcn_readfirstlane(tab[i * 8 + 3]);
        u.rt = __builtin_amdgcn_readfirstlane(tab[i * 8 + 4]); u.cnt = __builtin_amdgcn_readfirstlane(tab[i * 8 + 5]);
        return f != 0;
    }
    __device__ __forceinline__ const char* a_base() const { return A; }
    __device__ __forceinline__ unsigned a_rowoff(const Unit& u, int half, int R) const {
        if (GATHER) { const int slot = u.rt * BM + half * HALF + R; const int tok = slot < u.cnt ? list[u.e * NTOK + slot] : 0; return (unsigned)tok * (unsigned)(K * 2); }
        return (unsigned)(u.pm * BM + half * HALF + R) * (unsigned)(K * 2);
    }
    __device__ __forceinline__ const char* b_ptr(const Unit& u) const { return Bt + (size_t)u.e * wstride + (size_t)u.pn * BM * K * 2; }
};

struct EpiBf16 {
    static constexpr bool PERM = true;
    bf16_t* O; int ldc;
    __device__ __forceinline__ void operator()(const f32x4 (&acc)[2][2][4][2], const Unit& u, int wr, int wc, int fr, int fq) const {
        const int row0 = u.pm * BM + wr * 64 + fr, col0 = u.pn * BM + wc * 32 + 8 * fq;
#pragma unroll
        for (int ai = 0; ai < 2; ++ai)
#pragma unroll
            for (int m = 0; m < 4; ++m) { bf16_t* rowp = O + (size_t)(row0 + ai * HALF + m * 16) * ldc + col0;
#pragma unroll
                for (int bj = 0; bj < 2; ++bj) { const f32x4 v0 = acc[ai][bj][m][0], v1 = acc[ai][bj][m][1];
                    u32x4 w; w.x = cvt_pk_bf16(v0[0], v0[1]); w.y = cvt_pk_bf16(v0[2], v0[3]); w.z = cvt_pk_bf16(v1[0], v1[1]); w.w = cvt_pk_bf16(v1[2], v1[3]);
                    *(u32x4*)(rowp + bj * HALF) = w; } }
    }
};
struct EpiResid {
    static constexpr bool PERM = false;
    const float* X; float* U;
    __device__ __forceinline__ void operator()(const f32x4 (&acc)[2][2][4][2], const Unit& u, int wr, int wc, int fr, int fq) const {
        const int row0 = u.pm * BM + wr * 64 + fr, col0 = u.pn * BM + wc * 32 + 4 * fq;
#pragma unroll
        for (int ai = 0; ai < 2; ++ai)
#pragma unroll
            for (int m = 0; m < 4; ++m) { const size_t off = (size_t)(row0 + ai * HALF + m * 16) * DM + col0;
#pragma unroll
                for (int bj = 0; bj < 2; ++bj)
#pragma unroll
                    for (int n = 0; n < 2; ++n) { const f32x4 xv = *(const f32x4*)(X + off + bj * HALF + n * 16);
                        *(f32x4*)(U + off + bj * HALF + n * 16) = xv * DN_ALPHA + acc[ai][bj][m][n]; } }
    }
};
struct EpiSwiglu {
    static constexpr bool PERM = true;
    bf16_t* O;
    __device__ __forceinline__ void operator()(const f32x4 (&acc)[2][2][4][2], const Unit& u, int wr, int wc, int fr, int fq) const {
        const int row0 = u.pm * BM + wr * 64 + fr, col0 = u.pn * HALF + wc * 32 + 8 * fq;
#pragma unroll
        for (int ai = 0; ai < 2; ++ai)
#pragma unroll
            for (int m = 0; m < 4; ++m) { bf16_t* rowp = O + (size_t)(row0 + ai * HALF + m * 16) * DEXP + col0;
                float r[8];
#pragma unroll
                for (int n = 0; n < 2; ++n)
#pragma unroll
                    for (int j = 0; j < 4; ++j) { const float g = acc[ai][0][m][n][j], up = acc[ai][1][m][n][j]; r[n * 4 + j] = g / (1.0f + __expf(-g)) * up; }
                u32x4 w; w.x = cvt_pk_bf16(r[0], r[1]); w.y = cvt_pk_bf16(r[2], r[3]); w.z = cvt_pk_bf16(r[4], r[5]); w.w = cvt_pk_bf16(r[6], r[7]);
                *(u32x4*)rowp = w; }
    }
};
}

__device__ __forceinline__ void tr_tile256(LAS float* tile  , const float* src, int ld, int k0, int c0, bf16_t* dst, int dstK, int blk, int blk_stride, int dst_off, int tid) {
    {
        const int c4 = tid & 63;
#pragma unroll
        for (int i = 0; i < 8; ++i) { const int r = (tid >> 6) + 8 * i; const f32x4 a = *(const f32x4*)(src + (size_t)(k0 + r) * ld + c0 + c4 * 4);
            tile[r * 257 + c4 * 4 + 0] = a[0]; tile[r * 257 + c4 * 4 + 1] = a[1]; tile[r * 257 + c4 * 4 + 2] = a[2]; tile[r * 257 + c4 * 4 + 3] = a[3]; }
    }
    __syncthreads();
    {
        const int kk = (tid & 7) * 8;
#pragma unroll
        for (int i = 0; i < 4; ++i) { const int n = (tid >> 3) + 64 * i, col = c0 + n;
            u32x4 w;
            w.x = cvt_pk_bf16(tile[(kk + 0) * 257 + n], tile[(kk + 1) * 257 + n]); w.y = cvt_pk_bf16(tile[(kk + 2) * 257 + n], tile[(kk + 3) * 257 + n]);
            w.z = cvt_pk_bf16(tile[(kk + 4) * 257 + n], tile[(kk + 5) * 257 + n]); w.w = cvt_pk_bf16(tile[(kk + 6) * 257 + n], tile[(kk + 7) * 257 + n]);
            const int drow = (col / blk) * blk_stride + dst_off + (col % blk);
            *(u32x4*)(dst + (size_t)drow * dstK + k0 + kk) = w; }
    }
    __syncthreads();
}
__device__ __forceinline__ float reduce16_wave(const float (&v)[16], int lane) {
    float a8[8];
#pragma unroll
    for (int i = 0; i < 8; ++i) { const float mine = (lane & 32) ? v[8 + i] : v[i], other = (lane & 32) ? v[i] : v[8 + i]; a8[i] = mine + __shfl_xor(other, 32); }
    float a4[4];
#pragma unroll
    for (int i = 0; i < 4; ++i) { const float mine = (lane & 16) ? a8[4 + i] : a8[i], other = (lane & 16) ? a8[i] : a8[4 + i]; a4[i] = mine + __shfl_xor(other, 16); }
    float a2[2];
#pragma unroll
    for (int i = 0; i < 2; ++i) { const float mine = (lane & 8) ? a4[2 + i] : a4[i], other = (lane & 8) ? a4[i] : a4[2 + i]; a2[i] = mine + __shfl_xor(other, 8); }
    float a1; { const float mine = (lane & 4) ? a2[1] : a2[0], other = (lane & 4) ? a2[0] : a2[1]; a1 = mine + __shfl_xor(other, 4); }
    a1 += dppf<0x4E>(a1); a1 += dppf<0xB1>(a1);
    return a1;
}
__device__ __forceinline__ void tr_tile(LAS float* tile  , const float* src, int ld, int k0, int c0, int ncols_valid, bf16_t* dst, int dstK, int drow0, int tid) {
    {
        const int r = tid >> 3, cc = (tid & 7) * 8;
        const float* sp = src + (size_t)(k0 + r) * ld + c0 + cc;
        if (c0 + cc + 8 <= ncols_valid) {
            const f32x4 a = *(const f32x4*)sp, b = *(const f32x4*)(sp + 4);
#pragma unroll
            for (int j = 0; j < 4; ++j) { tile[r * 65 + cc + j] = a[j]; tile[r * 65 + cc + 4 + j] = b[j]; }
        } else {
#pragma unroll
            for (int j = 0; j < 8; ++j) tile[r * 65 + cc + j] = (c0 + cc + j < ncols_valid) ? sp[j] : 0.f;
        }
    }
    __syncthreads();
    {
        const int n = tid >> 3, kk = (tid & 7) * 8;
        u32x4 w;
        w.x = cvt_pk_bf16(tile[(kk + 0) * 65 + n], tile[(kk + 1) * 65 + n]); w.y = cvt_pk_bf16(tile[(kk + 2) * 65 + n], tile[(kk + 3) * 65 + n]);
        w.z = cvt_pk_bf16(tile[(kk + 4) * 65 + n], tile[(kk + 5) * 65 + n]); w.w = cvt_pk_bf16(tile[(kk + 6) * 65 + n], tile[(kk + 7) * 65 + n]);
        *(u32x4*)(dst + (size_t)(drow0 + n) * dstK + k0 + kk) = w;
    }
    __syncthreads();
}

__device__ __forceinline__ void phase_prep(const Params& p, LAS unsigned char* lds, int bid, int nb, int part) {
    const int tid = opaque_tid();
    LAS float* tile = (LAS float*)lds;
    unsigned char* ws = p.ws;
    const int T0 = 832, T1 = T0 + 256, T2 = T1 + 448, T3 = T2 + 256, T4 = T3 + 2048, T5 = T4 + 2048, T6 = T5 + 2048, T7 = T6 + 32;
    if (part == 0) {
        for (int t0 = bid; t0 < T0 + 32; t0 += nb) {
            const int t = t0 < T0 ? t0 : T6 + (t0 - T0);
            if (t >= T6) { const int q = t - T6;
                if (q < 8) tr_tile(tile, p.in[I_AW2], 512, 0, q * 64, 512, (bf16_t*)(ws + OFF_MISC + MISC_W2T), 64, q * 64, tid);
                else if (q < 16) tr_tile(tile, p.in[I_AA2], 512, 0, (q - 8) * 64, 512, (bf16_t*)(ws + OFF_MISC + MISC_A2T), 64, (q - 8) * 64, tid);
                else { const int r = q - 16; tr_tile(tile, p.in[I_AG2], 512, (r >> 3) * 64, (r & 7) * 64, 512, (bf16_t*)(ws + OFF_MISC + MISC_G2T), 128, (r & 7) * 64, tid); }
                continue; }
            { const int kt = t / 52, ct = t % 52; tr_tile(tile, p.in[I_WINE], EVEN_COLS, kt * 64, ct * 64, EVEN_COLS, (bf16_t*)(ws + OFF_WINE), 1024, ct * 64, tid); }
        }
        __syncthreads();
        {
            const int wid = tid >> 6, lane = tid & 63;
            LAS float* wT = (LAS float*)lds;
            for (int i = tid; i < 16 * 1024; i += 512) { const int e_ = i & 15, k = i >> 4; wT[e_ * 1024 + k] = p.in[I_WINE][(size_t)k * EVEN_COLS + NE_MAIN + e_]; }
            __syncthreads();
            const float* x = p.in[I_X]; bf16_t* xb = (bf16_t*)(ws + OFF_BUF64); float* xa = (float*)(ws + OFF_U);
            for (int tok = bid * 8 + wid; tok < NTOK; tok += nb * 8) {
                f32x4 v[4];
                asm volatile("" ::: "memory");
#pragma unroll
                for (int j = 0; j < 4; ++j) { v[j] = *(const f32x4*)(x + (size_t)tok * DM + j * 256 + lane * 4);
                    u32x2 w; w.x = cvt_pk_bf16(v[j][0], v[j][1]); w.y = cvt_pk_bf16(v[j][2], v[j][3]); *(u32x2*)(xb + (size_t)tok * DM + j * 256 + lane * 4) = w; }
                float part_[16];
#pragma unroll
                for (int e_ = 0; e_ < 16; ++e_) { float a = 0.f;
#pragma unroll
                    for (int j = 0; j < 4; ++j) { const f32x4 w = *(const LAS f32x4*)(wT + e_ * 1024 + j * 256 + lane * 4); a += (v[j][0] * w[0] + v[j][1] * w[1]) + (v[j][2] * w[2] + v[j][3] * w[3]); }
                    part_[e_] = a; }
                const float r = reduce16_wave(part_, lane);
                if ((lane & 3) == 0) xa[(size_t)tok * 16 + ((lane >> 5) & 1) * 8 + ((lane >> 4) & 1) * 4 + ((lane >> 3) & 1) * 2 + ((lane >> 2) & 1)] = r;
            }
            __syncthreads();
        }
        if (bid == 0 && tid < 64) ((int*)(ws + OFF_MISC + MISC_CNT))[tid] = 0;
        if (bid == 1) for (int i = tid; i < (16384 + 256) / 4; i += 512) ((unsigned*)(ws + OFF_MISC + MISC_RWF))[i] = 0u;
        return;
    }
    unsigned* pctr = (unsigned*)(ws + OFF_MISC + MISC_PCTR);
    LAS int* tsh = (LAS int*)(lds + 69632);
    const int U0 = 64, U1 = U0 + 64, U2 = U1 + 512, U3 = U2 + 512, U4 = U3 + 512, U5 = U4 + 448;
    for (;;) {
        __syncthreads();
        if (tid == 0) tsh[0] = (int)__hip_atomic_fetch_add(pctr, 2u, __ATOMIC_RELAXED, __HIP_MEMORY_SCOPE_AGENT);
        __syncthreads();
        const int tb = __builtin_amdgcn_readfirstlane(tsh[0]);
        if (tb >= U5) break;
#pragma unroll 1
        for (int t = tb; t < tb + 2 && t < U5; ++t) {
            if (t < U0) { const int kt = t >> 2, cb = t & 3; tr_tile256(tile, p.in[I_WOUTE], 1024, kt * 64, cb * 256, (bf16_t*)(ws + OFF_WOUTE), 1024, 1 << 20, 0, 0, tid); }
            else if (t < U1) { const int q = t - U0, kt = q >> 2, cb = q & 3; tr_tile256(tile, p.in[I_WOUTO], 1024, kt * 64, cb * 256, (bf16_t*)(ws + OFF_WOUTO), 1024, 1 << 20, 0, 0, tid); }
            else if (t < U3) { const bool up = t >= U2; const int q = t - (up ? U2 : U1), le = q >> 4, kt = q & 15;
                tr_tile256(tile, p.in[up ? I_EU : I_EG] + (size_t)le * 1024 * 256, 256, kt * 64, 0, (bf16_t*)(ws + OFF_WGU) + (size_t)le * 512 * 1024, 1024, 128, 256, up ? 128 : 0, tid); }
            else if (t < U4) { const int q = t - U3, le = q >> 4, r = q & 15, kt = r >> 2, cb = r & 3;
                tr_tile256(tile, p.in[I_ED] + (size_t)le * 256 * 1024, 1024, kt * 64, cb * 256, (bf16_t*)(ws + OFF_WD) + (size_t)le * 1024 * 256, 256, 1 << 20, 0, 0, tid); }
            else { const int q = t - U4, kt = q / 28, ct = q % 28; tr_tile(tile, p.in[I_WINO], ODD_COLS, kt * 64, ct * 64, ODD_COLS, (bf16_t*)(ws + OFF_WINO), 1024, ct * 64, tid); }
        }
    }
    {
        float* c64 = (float*)(ws + OFF_ROPE); float* s64 = c64 + 4096 * 64; float* c32 = s64 + 4096 * 64; float* s32 = c32 + 4096 * 32;
        for (int i = bid * 512 + tid; i < 4096 * 64; i += nb * 512) { const int pos = i >> 6, j = i & 63; const float inv = powf(10000.0f, -(float)j / 64.0f); const float ang = (float)pos * inv; c64[i] = cosf(ang); s64[i] = sinf(ang); }
        for (int i = bid * 512 + tid; i < 4096 * 32; i += nb * 512) { const int pos = i >> 5, j = i & 31; const float inv = powf(10000.0f, -(float)j / 32.0f); const float ang = (float)pos * inv; c32[i] = cosf(ang); s32[i] = sinf(ang); }
    }
}

__device__ __forceinline__ void phase_ln_route(const Params& p, LAS unsigned char* lds, int bid, int nb, int layer) {
    const int tid = opaque_tid(), wid = tid >> 6, lane = tid & 63;
    unsigned char* ws = p.ws;
    LAS float* rwT = (LAS float*)lds;
    LAS int* sel = (LAS int*)(lds + 65536);
    LAS float* selg = (LAS float*)(lds + 65536 + 1024);
    LAS int* cntw = (LAS int*)(lds + 65536 + 2048);
    { const float* rw = p.in[I_RW];
        for (int i = tid; i < 16 * 1024; i += 512) { const int e = i >> 10, k = i & 1023; rwT[i] = rw[k * 16 + e]; } }
    __syncthreads();
    float* U = (float*)(ws + OFF_U); bf16_t* hb = (bf16_t*)(ws + OFF_BUF64);
    const float* g = p.in[I_LN1G] + layer * DM; const float* b = p.in[I_LN1B] + layer * DM;
    int* cnt = (int*)(ws + OFF_MISC + MISC_CNT) + layer * 16;
    int* tokinfo = (int*)(ws + OFF_MISC + MISC_TOKINFO); float* tokgate = (float*)(ws + OFF_MISC + MISC_TOKGATE); int* list = (int*)(ws + OFF_MISC + MISC_LIST);
    f32x4 gv[4], bv[4];
#pragma unroll
    for (int j = 0; j < 4; ++j) { gv[j] = *(const f32x4*)(g + j * 256 + lane * 4); bv[j] = *(const f32x4*)(b + j * 256 + lane * 4); }
    const float* rbp = p.in[I_RB];
    const float my_rb = rbp[((lane >> 5) & 1) * 8 + ((lane >> 4) & 1) * 4 + ((lane >> 3) & 1) * 2 + ((lane >> 2) & 1)];
    for (int blk = bid; blk < NTOK / 128; blk += nb) {
#pragma unroll 1
        for (int i = 0; i < 16; ++i) {
            const int tl = wid * 16 + i, tok = blk * 128 + tl;
            f32x4 v[4]; float s = 0.f;
            asm volatile("" ::: "memory");
#pragma unroll
            for (int j = 0; j < 4; ++j) { v[j] = *(const f32x4*)(U + (size_t)tok * DM + j * 256 + lane * 4); s += (v[j][0] + v[j][1]) + (v[j][2] + v[j][3]); }
            const float mean = wave_sum(s) * (1.0f / DM);
            float q = 0.f;
#pragma unroll
            for (int j = 0; j < 4; ++j) { v[j] -= mean; q += (v[j][0] * v[j][0] + v[j][1] * v[j][1]) + (v[j][2] * v[j][2] + v[j][3] * v[j][3]); }
            const float rstd = rsqrtf(wave_sum(q) * (1.0f / DM) + LN_EPS);
#pragma unroll
            for (int j = 0; j < 4; ++j) { v[j] = v[j] * rstd * gv[j] + bv[j];
                *(f32x4*)(U + (size_t)tok * DM + j * 256 + lane * 4) = v[j];
                u32x2 w; w.x = cvt_pk_bf16(v[j][0], v[j][1]); w.y = cvt_pk_bf16(v[j][2], v[j][3]);
                *(u32x2*)(hb + (size_t)tok * DM + j * 256 + lane * 4) = w; }
            float part[16];
#pragma unroll
            for (int e = 0; e < 16; ++e) { float a = 0.f;
#pragma unroll
                for (int j = 0; j < 4; ++j) { const f32x4 w = *(const LAS f32x4*)(rwT + e * 1024 + j * 256 + lane * 4); a += (v[j][0] * w[0] + v[j][1] * w[1]) + (v[j][2] * w[2] + v[j][3] * w[3]); }
                part[e] = a; }
            const float lgm = reduce16_wave(part, lane);
            const float sgm = 1.0f / (1.0f + expf(-lgm)), selm = sgm + my_rb;
            float sg[16], sl[16];
#pragma unroll
            for (int e = 0; e < 16; ++e) { const int L = ((e >> 3) & 1) * 32 + ((e >> 2) & 1) * 16 + ((e >> 1) & 1) * 8 + (e & 1) * 4;
                sg[e] = __builtin_bit_cast(float, __builtin_amdgcn_readlane(__builtin_bit_cast(int, sgm), L)); sl[e] = __builtin_bit_cast(float, __builtin_amdgcn_readlane(__builtin_bit_cast(int, selm), L)); }
            int best = 0; float bestv = -INFINITY;
#pragma unroll
            for (int gI = 0; gI < 4; ++gI) { float m1 = -INFINITY, m2 = -INFINITY;
#pragma unroll
                for (int j = 0; j < 4; ++j) { const float x = sl[gI * 4 + j]; if (x > m1) { m2 = m1; m1 = x; } else if (x > m2) m2 = x; }
                const float gs = m1 + m2; if (gs > bestv) { bestv = gs; best = gI; } }
            int e0 = 0, e1 = 0; float v0 = -INFINITY, v1 = -INFINITY, s0 = 0.f, s1 = 0.f;
#pragma unroll
            for (int e = 0; e < 16; ++e) { if ((e >> 2) == best) { const float x = sl[e];
                    if (x > v0) { v1 = v0; e1 = e0; s1 = s0; v0 = x; e0 = e; s0 = sg[e]; } else if (x > v1) { v1 = x; e1 = e; s1 = sg[e]; } } }
            const float gsum = s0 + s1;
            if (lane == 0) { sel[tl * 2] = e0; sel[tl * 2 + 1] = e1; selg[tl * 2] = s0 / gsum; selg[tl * 2 + 1] = s1 / gsum; }
        }
        __syncthreads();
        int myE = -1, myRank = 0;
        if (tid < 256) { myE = sel[tid];
#pragma unroll
            for (int e = 0; e < 16; ++e) { const unsigned long long mk = __ballot(myE == e); if (myE == e) myRank = __popcll(mk & ((1ull << lane) - 1ull)); if (lane == 0) cntw[wid * 16 + e] = __popcll(mk); } }
        __syncthreads();
        if (tid < 16) { const int c0 = cntw[tid], c1 = cntw[16 + tid], c2 = cntw[32 + tid], c3 = cntw[48 + tid];
            const int basev = atomicAdd(cnt + tid, c0 + c1 + c2 + c3);
            cntw[64 + tid] = basev; cntw[80 + tid] = basev + c0; cntw[96 + tid] = basev + c0 + c1; cntw[112 + tid] = basev + c0 + c1 + c2; }
        __syncthreads();
        if (tid < 256) { const int slot = cntw[64 + wid * 16 + myE] + myRank; const int tok = blk * 128 + (tid >> 1), k = tid & 1;
            list[myE * NTOK + slot] = tok; tokinfo[tok * 4 + k * 2] = myE; tokinfo[tok * 4 + k * 2 + 1] = slot; tokgate[tok * 2 + k] = selg[tid]; }
        __syncthreads();
    }
}

__device__ __forceinline__ void phase_ln2(const Params& p, int bid, int nb, int layer, float* dst, bool with_moe) {
    const int tid = opaque_tid(), wid = tid >> 6, lane = tid & 63;
    unsigned char* ws = p.ws;
    const float* U = (const float*)(ws + OFF_U); bf16_t* xb = (bf16_t*)(ws + OFF_BUF64);
    const bf16_t* he = (const bf16_t*)(ws + OFF_HE);
    const float* g = p.in[I_LN2G] + layer * DM; const float* b = p.in[I_LN2B] + layer * DM;
    const int* cnt = (const int*)(ws + OFF_MISC + MISC_CNT) + layer * 16;
    const int* tokinfo = (const int*)(ws + OFF_MISC + MISC_TOKINFO); const float* tokgate = (const float*)(ws + OFF_MISC + MISC_TOKGATE);
    int rowbase[16]; { int a = 0;
#pragma unroll
        for (int e = 0; e < 16; ++e) { rowbase[e] = a; a += ((cnt[e] + 255) >> 8) << 8; } }
    f32x4 gv[4], bv[4];
#pragma unroll
    for (int j = 0; j < 4; ++j) { gv[j] = *(const f32x4*)(g + j * 256 + lane * 4); bv[j] = *(const f32x4*)(b + j * 256 + lane * 4); }
    for (int tok = bid * 8 + wid; tok < NTOK; tok += nb * 8) {
        f32x4 v[4]; float s = 0.f;
        int r0 = 0, r1 = 0; float g0 = 0.f, g1 = 0.f;
        if (with_moe) { const int e0 = tokinfo[tok * 4 + 0], sl0 = tokinfo[tok * 4 + 1], e1 = tokinfo[tok * 4 + 2], sl1 = tokinfo[tok * 4 + 3];
            int rb0 = 0, rb1 = 0;
#pragma unroll
            for (int e = 0; e < 16; ++e) { if (e == e0) rb0 = rowbase[e]; if (e == e1) rb1 = rowbase[e]; }
            r0 = rb0 + sl0; r1 = rb1 + sl1; g0 = tokgate[tok * 2 + 0]; g1 = tokgate[tok * 2 + 1]; }
#pragma unroll
        for (int j = 0; j < 4; ++j) { v[j] = *(const f32x4*)(U + (size_t)tok * DM + j * 256 + lane * 4) * DN_ALPHA;
            if (with_moe) { const u32x2 a = *(const u32x2*)(he + (size_t)r0 * DM + j * 256 + lane * 4), c = *(const u32x2*)(he + (size_t)r1 * DM + j * 256 + lane * 4);
                v[j][0] += g0 * __uint_as_float(a.x << 16) + g1 * __uint_as_float(c.x << 16); v[j][1] += g0 * __uint_as_float(a.x & 0xffff0000u) + g1 * __uint_as_float(c.x & 0xffff0000u);
                v[j][2] += g0 * __uint_as_float(a.y << 16) + g1 * __uint_as_float(c.y << 16); v[j][3] += g0 * __uint_as_float(a.y & 0xffff0000u) + g1 * __uint_as_float(c.y & 0xffff0000u); }
            s += (v[j][0] + v[j][1]) + (v[j][2] + v[j][3]); }
        const float mean = wave_sum(s) * (1.0f / DM);
        float q = 0.f;
#pragma unroll
        for (int j = 0; j < 4; ++j) { v[j] -= mean; q += (v[j][0] * v[j][0] + v[j][1] * v[j][1]) + (v[j][2] * v[j][2] + v[j][3] * v[j][3]); }
        const float rstd = rsqrtf(wave_sum(q) * (1.0f / DM) + LN_EPS);
#pragma unroll
        for (int j = 0; j < 4; ++j) { v[j] = v[j] * rstd * gv[j] + bv[j];
#if PROBE_ID
            if (layer == 1) v[j] = v[j] * (1.0f + *(const float*)(ws + OFF_MISC + MISC_PROBE));
#endif
            *(f32x4*)(dst + (size_t)tok * DM + j * 256 + lane * 4) = v[j];
            u32x2 w; w.x = cvt_pk_bf16(v[j][0], v[j][1]); w.y = cvt_pk_bf16(v[j][2], v[j][3]);
            *(u32x2*)(xb + (size_t)tok * DM + j * 256 + lane * 4) = w; }
    }
}


__device__ __forceinline__ void phase_moe_gateup(const Params& p, LAS unsigned char* lds, int bid, int nb, int layer) {
    unsigned char* ws = p.ws;
    LAS int* tab = (LAS int*)(lds + pg::STAGE_BYTES);
    pg::moe_build_units(tab, (const int*)(ws + OFF_MISC + MISC_CNT) + layer * 16, 2, nb, bid);
    pg::MoeSched<true> S; S.init(ws + OFF_BUF64, ws + OFF_WGU + (size_t)layer * 16 * 512 * 1024 * 2, (size_t)512 * 1024 * 2, (const int*)(ws + OFF_MISC + MISC_LIST), 1024, tab);
    pg::EpiSwiglu E; E.O = (bf16_t*)(ws + OFF_ACT);
    pg::gemm_phase(lds, 1024, S, E);
}
__device__ __forceinline__ void phase_moe_down(const Params& p, LAS unsigned char* lds, int bid, int nb, int layer) {
    unsigned char* ws = p.ws;
    LAS int* tab = (LAS int*)(lds + pg::STAGE_BYTES);
    pg::moe_build_units(tab, (const int*)(ws + OFF_MISC + MISC_CNT) + layer * 16, 4, nb, bid);
    pg::MoeSched<false> S; S.init(ws + OFF_ACT, ws + OFF_WD + (size_t)layer * 16 * 1024 * 256 * 2, (size_t)1024 * 256 * 2, nullptr, 256, tab);
    pg::EpiBf16 E; E.O = (bf16_t*)(ws + OFF_HE); E.ldc = 1024;
    pg::gemm_phase(lds, 256, S, E);
}


__device__ __forceinline__ float red8(float v) { v += dppf<0xB1>(v); v += dppf<0x4E>(v); v += dppf<0x141>(v); return v; }


__device__ __forceinline__ float red16(float v) { v += dppf<0xB1>(v); v += dppf<0x4E>(v); v += dppf<0x141>(v); v += dppf<0x140>(v); return v; }

constexpr size_t OFF_ACT256 = OFF_U + 4 * MiB;
__device__ __forceinline__ void phase_lora_act(const Params& p, int bid, int nb) {
    const int tid = opaque_tid();
    const bf16_t* P0 = (const bf16_t*)(p.ws + OFF_P); bf16_t* act = (bf16_t*)(p.ws + OFF_ACT256);
    const float* mu = p.in[I_AMU];
    const int cc = tid & 31, col = 1536 + cc * 8;
    const f32x4 m0 = *(const f32x4*)(mu + col), m1 = *(const f32x4*)(mu + col + 4);
    for (int n = bid * 16 + (tid >> 5); n < NTOK; n += nb * 16) {
        const u32x4 cu = *(const u32x4*)(P0 + (size_t)n * NE_MAIN + col); u32x4 pv = uzero4(); if ((n & (SEQ - 1)) > 0) pv = *(const u32x4*)(P0 + (size_t)(n - 1) * NE_MAIN + col);
        const unsigned cw[4] = {cu.x, cu.y, cu.z, cu.w}, pw[4] = {pv.x, pv.y, pv.z, pv.w}; float x[8];
#pragma unroll
        for (int j = 0; j < 4; ++j) { const float c0 = __uint_as_float(cw[j] << 16), c1 = __uint_as_float(cw[j] & 0xffff0000u), q0 = __uint_as_float(pw[j] << 16), q1 = __uint_as_float(pw[j] & 0xffff0000u);
            const float ma = (j < 2 ? m0[2 * j] : m1[2 * j - 4]), mb = (j < 2 ? m0[2 * j + 1] : m1[2 * j - 3]);
            x[2 * j] = c0 + (q0 - c0) * ma; x[2 * j + 1] = c1 + (q1 - c1) * mb; }
        if (cc < 8) {
#pragma unroll
            for (int j = 0; j < 8; ++j) x[j] = fast_tanh(x[j]); }
        else if (cc >= 16) {
#pragma unroll
            for (int j = 0; j < 8; ++j) x[j] = fast_sigmoid(x[j]); }
        u32x4 o; o.x = cvt_pk_bf16(x[0], x[1]); o.y = cvt_pk_bf16(x[2], x[3]); o.z = cvt_pk_bf16(x[4], x[5]); o.w = cvt_pk_bf16(x[6], x[7]);
        *(u32x4*)(act + (size_t)n * 256 + cc * 8) = o;
    }
}

template <int CTRL> __device__ __forceinline__ float dpp0f(float v) { return __builtin_bit_cast(float, __builtin_amdgcn_update_dpp(0, __builtin_bit_cast(int, v), CTRL, 0xf, 0xf, true)); }
__device__ __forceinline__ bf16x8 pack_lo4(const f32x4 a) { u32x4 w; w.x = cvt_pk_bf16(a[0], a[1]); w.y = cvt_pk_bf16(a[2], a[3]); w.z = 0u; w.w = 0u; return __builtin_bit_cast(bf16x8, w); }
__device__ __forceinline__ bf16x8 pack_8(const f32x4 a, const f32x4 b) { u32x4 w; w.x = cvt_pk_bf16(a[0], a[1]); w.y = cvt_pk_bf16(a[2], a[3]); w.z = cvt_pk_bf16(b[0], b[1]); w.w = cvt_pk_bf16(b[2], b[3]); return __builtin_bit_cast(bf16x8, w); }
__device__ __forceinline__ f32x4 mm16(const f32x4 PT, const f32x4 Q) { return __builtin_amdgcn_mfma_f32_16x16x32_bf16(pack_lo4(PT), pack_lo4(Q), fzero4(), 0, 0, 0); }
constexpr int RW3_SLOT = 12544;
__device__ __forceinline__ int rw3_trswz(int row, int c) { return (((c >> 1) ^ ((row >> 1) & 3)) << 1) | (c & 1); }
__device__ __forceinline__ unsigned rw_ld(unsigned* p_) { return __hip_atomic_load(p_, __ATOMIC_RELAXED, __HIP_MEMORY_SCOPE_AGENT); }
__device__ __forceinline__ void rwkv3_item(const Params& p, LAS unsigned char* lds, int item, int role, int which) {
    const int tid = opaque_tid(), lane = tid & 63, wid = tid >> 6, fr = lane & 15, g = lane >> 4;
    const int b = item >> 3, h = item & 7;
    unsigned char* ws = p.ws;
    const bf16_t* P0 = (const bf16_t*)(ws + OFF_P);
    float* yraw = p.out; bf16_t* e1g = (bf16_t*)(p.out + (size_t)NTOK * 512); bf16_t* gg = e1g + (size_t)NTOK * 512;
    LAS unsigned char* w2h = lds;
    LAS unsigned char* a2h = lds + 8192;
    LAS unsigned char* g2h = lds + 16384;
    LAS unsigned char* slots = lds + 32768;
    LAS float* ptab = (LAS float*)(lds + 32768 + 8 * RW3_SLOT);
    LAS float* mul = ptab + 8 * 64;
    if (role == 0) {
        const float* mu = p.in[I_AMU];
        if (tid < 64) { ptab[tid] = mu[h * 64 + tid]; ptab[64 + tid] = mu[512 + h * 64 + tid]; ptab[128 + tid] = mu[1024 + h * 64 + tid];
            ptab[192 + tid] = p.in[I_AW0][h * 64 + tid]; ptab[256 + tid] = p.in[I_AA0][h * 64 + tid]; ptab[320 + tid] = p.in[I_AKK][h * 64 + tid];
            ptab[384 + tid] = p.in[I_AKA][h * 64 + tid]; ptab[448 + tid] = p.in[I_ARK][h * 64 + tid]; }
        if (tid < 256) mul[tid] = mu[1536 + tid];
    }
    if (role == 0) {
        const bf16_t* w2t = (const bf16_t*)(ws + OFF_MISC + MISC_W2T); const bf16_t* a2t = (const bf16_t*)(ws + OFF_MISC + MISC_A2T); const bf16_t* g2t = (const bf16_t*)(ws + OFF_MISC + MISC_G2T);
        { const int row = tid >> 3, c = tid & 7;
            *(LAS u32x4*)(w2h + row * 128 + ((c ^ (row & 7)) * 16)) = *(const u32x4*)(w2t + (size_t)(h * 64 + row) * 64 + c * 8);
            *(LAS u32x4*)(a2h + row * 128 + ((c ^ (row & 7)) * 16)) = *(const u32x4*)(a2t + (size_t)(h * 64 + row) * 64 + c * 8); }
#pragma unroll
        for (int i = 0; i < 2; ++i) { const int q = tid + i * 512, row = q >> 4, c = q & 15;
            *(LAS u32x4*)(g2h + row * 256 + ((c ^ (row & 7)) * 16)) = *(const u32x4*)(g2t + (size_t)(h * 64 + row) * 128 + c * 8); }
    }
    __syncthreads();
    f32x4 Hacc[4];
#pragma unroll
    for (int rt = 0; rt < 4; ++rt) Hacc[rt] = fzero4();
    const size_t nb0 = (size_t)b * SEQ;
    const int q4 = fr >> 2, p4 = fr & 3;
#define MIXB(wc, wp, mA, mB, o0, o1) { const float c0 = __uint_as_float((wc) << 16), c1 = __uint_as_float((wc) & 0xffff0000u), q0 = __uint_as_float((wp) << 16), q1 = __uint_as_float((wp) & 0xffff0000u); o0 = c0 + (q0 - c0) * (mA); o1 = c1 + (q1 - c1) * (mB); }
    const bf16_t* actp = (const bf16_t*)(ws + OFF_ACT256);
    u32x2 nrc[4], nkc[4], nvc[4], nrp[4], nkp[4], nvp[4]; bf16x8 nb_[8];
#define RW3_LOADS(tk) do { const int t0_ = ((tk) * 8 + wid) * 16; const int fr_ = lane & 15, g_ = lane >> 4; const size_t n_ = nb0 + t0_ + fr_; const bool hp_ = (t0_ + fr_) > 0; \
        const bf16_t* rc_ = P0 + n_ * NE_MAIN; const bf16_t* rp_ = rc_ - NE_MAIN; \
        _Pragma("unroll") for (int ct = 0; ct < 4; ++ct) { const int c0 = ct * 16 + g_ * 4; \
            nrc[ct] = *(const u32x2*)(rc_ + h * 64 + c0); nkc[ct] = *(const u32x2*)(rc_ + 512 + h * 64 + c0); nvc[ct] = *(const u32x2*)(rc_ + 1024 + h * 64 + c0); \
            nrp[ct] = (u32x2){0u, 0u}; nkp[ct] = nrp[ct]; nvp[ct] = nrp[ct]; \
            if (hp_) { nrp[ct] = *(const u32x2*)(rp_ + h * 64 + c0); nkp[ct] = *(const u32x2*)(rp_ + 512 + h * 64 + c0); nvp[ct] = *(const u32x2*)(rp_ + 1024 + h * 64 + c0); } } \
        _Pragma("unroll") for (int f = 0; f < 8; ++f) nb_[f] = *(const bf16x8*)(actp + n_ * 256 + f * 32 + g_ * 8); } while (0)
    unsigned char* xb = ws + OFF_RWXB; unsigned* flg = (unsigned*)(ws + OFF_MISC + MISC_RWF);
    const __amdgpu_buffer_rsrc_t xrsrc = __builtin_amdgcn_make_buffer_rsrc((void*)xb, 0, 64 * 2 * 2 * 8 * RW3_SLOT, 0x00020000);
#pragma unroll 1
    for (int it = 0; it < (role ? 32 : 16); ++it) {
        const int tick = role ? it : 2 * it + which;
        const int hk = tick >> 1, hw = tick & 1;
        unsigned* f_prod = flg + (item * 2 + hw) * 16; unsigned* f_cons = flg + 2048 + (item * 2 + hw) * 16;
        unsigned char* xslot = xb + ((((size_t)item * 2 + (hk & 1)) * 2 + hw) * 8) * RW3_SLOT;
        if (role == 0) {
            int lane_t = lane; asm volatile("" : "+v"(lane_t));
            const int fr = lane_t & 15, g = lane_t >> 4, q4 = fr >> 2, p4 = fr & 3;
            LAS unsigned char* sl = slots + wid * RW3_SLOT;
            LAS unsigned char* Qt_i = sl, * Rh_i = sl + 2048, * Kh_i = sl + 4096, * Bn_i = sl + 6144, * Vi_i = sl + 8192, * M1_i = sl + 10240, * DD_i = sl + 11264; LAS float* gam_i = (LAS float*)(sl + 12288);
            const int t0 = (tick * 8 + wid) * 16;
            const size_t n = nb0 + t0 + fr;
            const bool hasp = (t0 + fr) > 0;
            const bf16_t* rowc = P0 + n * NE_MAIN; const bf16_t* rowp = rowc - NE_MAIN;
            RW3_LOADS(tick);
#define lrc nrc
#define lkc nkc
#define lvc nvc
#define lrp nrp
#define lkp nkp
#define lvp nvp
            bf16x8 bw[2], ba[2], bg[4];
            bw[0] = nb_[0]; bw[1] = nb_[1]; ba[0] = nb_[2]; ba[1] = nb_[3]; bg[0] = nb_[4]; bg[1] = nb_[5]; bg[2] = nb_[6]; bg[3] = nb_[7];
            f32x4 Wt[4], At[4], Gt[4];
#pragma unroll
            for (int ct = 0; ct < 4; ++ct) {
                const int row = ct * 16 + fr;
                f32x4 dw = fzero4(), da = dw, dg = dw;
#pragma unroll
                for (int s = 0; s < 2; ++s) {
                    dw = __builtin_amdgcn_mfma_f32_16x16x32_bf16(*(const LAS bf16x8*)(w2h + row * 128 + (((s * 4 + g) ^ (row & 7)) * 16)), bw[s], dw, 0, 0, 0);
                    da = __builtin_amdgcn_mfma_f32_16x16x32_bf16(*(const LAS bf16x8*)(a2h + row * 128 + (((s * 4 + g) ^ (row & 7)) * 16)), ba[s], da, 0, 0, 0); }
#pragma unroll
                for (int s = 0; s < 4; ++s) dg = __builtin_amdgcn_mfma_f32_16x16x32_bf16(*(const LAS bf16x8*)(g2h + row * 256 + (((s * 4 + g) ^ (row & 7)) * 16)), bg[s], dg, 0, 0, 0);
                Wt[ct] = dw; At[ct] = da; Gt[ct] = dg;
            }
            f32x4 Rm[4], Khm[4], Lw[4], Aa[4];
            float nsq = 0.f, rk = 0.f;
            u32x2 Vp[4];
#pragma unroll
            for (int ct = 0; ct < 4; ++ct) {
                const int c0 = ct * 16 + g * 4;
                const u32x2 rc = lrc[ct], kc = lkc[ct], vc = lvc[ct], rp = lrp[ct], kp = lkp[ct], vp = lvp[ct];
                const f32x4 mr = *(const LAS f32x4*)(ptab + c0), mk = *(const LAS f32x4*)(ptab + 64 + c0), mv = *(const LAS f32x4*)(ptab + 128 + c0);
                f32x4 Km, Vm;
                MIXB(rc.x, rp.x, mr[0], mr[1], Rm[ct][0], Rm[ct][1]) MIXB(rc.y, rp.y, mr[2], mr[3], Rm[ct][2], Rm[ct][3])
                MIXB(kc.x, kp.x, mk[0], mk[1], Km[0], Km[1]) MIXB(kc.y, kp.y, mk[2], mk[3], Km[2], Km[3])
                MIXB(vc.x, vp.x, mv[0], mv[1], Vm[0], Vm[1]) MIXB(vc.y, vp.y, mv[2], mv[3], Vm[2], Vm[3])
                const f32x4 w0v = *(const LAS f32x4*)(ptab + 192 + c0), a0v = *(const LAS f32x4*)(ptab + 256 + c0), kks = *(const LAS f32x4*)(ptab + 320 + c0), kas = *(const LAS f32x4*)(ptab + 384 + c0), rkp = *(const LAS f32x4*)(ptab + 448 + c0);
#pragma unroll
                for (int r = 0; r < 4; ++r) { const float z = w0v[r] + Wt[ct][r]; const float sp = __logf(1.0f + __expf(-z));
                    Lw[ct][r] = -__expf(-sp - 0.5f);
                    const float a = fast_sigmoid(a0v[r] + At[ct][r]); Aa[ct][r] = a;
                    const float kkp = Km[r] * kks[r]; nsq += kkp * kkp; Wt[ct][r] = kkp;
                    const float kh = Km[r] * (1.0f + (a - 1.0f) * kas[r]); Khm[ct][r] = kh; rk += Rm[ct][r] * kh * rkp[r]; }
                Vp[ct].x = cvt_pk_bf16(Vm[0], Vm[1]); Vp[ct].y = cvt_pk_bf16(Vm[2], Vm[3]);
                At[ct] = Vm;
            }
            nsq += __shfl_xor(nsq, 16); nsq += __shfl_xor(nsq, 32);
            rk += __shfl_xor(rk, 16); rk += __shfl_xor(rk, 32);
            const float inrm = 1.0f / fmaxf(sqrtf(nsq), 1e-12f);
#pragma unroll
            for (int ct = 0; ct < 4; ++ct) { const int c0 = ct * 16 + g * 4;
                u32x2 ew, gw; ew.x = cvt_pk_bf16(rk * At[ct][0], rk * At[ct][1]); ew.y = cvt_pk_bf16(rk * At[ct][2], rk * At[ct][3]);
                gw.x = cvt_pk_bf16(Gt[ct][0], Gt[ct][1]); gw.y = cvt_pk_bf16(Gt[ct][2], Gt[ct][3]);
                *(u32x2*)(e1g + n * 512 + h * 64 + c0) = ew; *(u32x2*)(gg + n * 512 + h * 64 + c0) = gw;
                const int c = 2 * ct + (g >> 1);
                *(LAS u32x2*)(Vi_i + fr * 128 + rw3_trswz(fr, c) * 16 + (g & 1) * 8) = Vp[ct]; }
            u32x2 Qp[4], Kp[4], Bp[4], Rp[4];
#pragma unroll
            for (int ct = 0; ct < 4; ++ct) {
                const int c0 = ct * 16 + g * 4;
                f32x4 gmv; float qh[4], kh_[4], bh[4], rh[4];
#pragma unroll
                for (int r = 0; r < 4; ++r) {
                    float L = Lw[ct][r];
                    L += dpp0f<0x111>(L); L += dpp0f<0x112>(L); L += dpp0f<0x114>(L); L += dpp0f<0x118>(L);
                    const float Ltot = red16(Lw[ct][r]);
                    const float eL = __expf(L), ieL = fast_rcp(eL), eLex = __expf(L - Lw[ct][r]);
                    const float kk = Wt[ct][r] * inrm, bb = kk * Aa[ct][r];
                    qh[r] = kk * eLex; kh_[r] = Khm[ct][r] * ieL; bh[r] = bb * ieL; rh[r] = Rm[ct][r] * eL;
                    gmv[r] = __expf(Ltot); }
                Qp[ct].x = cvt_pk_bf16(qh[0], qh[1]); Qp[ct].y = cvt_pk_bf16(qh[2], qh[3]); Kp[ct].x = cvt_pk_bf16(kh_[0], kh_[1]); Kp[ct].y = cvt_pk_bf16(kh_[2], kh_[3]);
                Bp[ct].x = cvt_pk_bf16(bh[0], bh[1]); Bp[ct].y = cvt_pk_bf16(bh[2], bh[3]); Rp[ct].x = cvt_pk_bf16(rh[0], rh[1]); Rp[ct].y = cvt_pk_bf16(rh[2], rh[3]);
                if (fr == 0) *(LAS f32x4*)(gam_i + c0) = gmv;
            }
            bf16x8 Qf[2], Kf[2], Bf[2], Rf[2];
#pragma unroll
            for (int s = 0; s < 2; ++s) { Qf[s] = __builtin_bit_cast(bf16x8, (u32x4){Qp[2 * s].x, Qp[2 * s].y, Qp[2 * s + 1].x, Qp[2 * s + 1].y}); Kf[s] = __builtin_bit_cast(bf16x8, (u32x4){Kp[2 * s].x, Kp[2 * s].y, Kp[2 * s + 1].x, Kp[2 * s + 1].y});
                Bf[s] = __builtin_bit_cast(bf16x8, (u32x4){Bp[2 * s].x, Bp[2 * s].y, Bp[2 * s + 1].x, Bp[2 * s + 1].y}); Rf[s] = __builtin_bit_cast(bf16x8, (u32x4){Rp[2 * s].x, Rp[2 * s].y, Rp[2 * s + 1].x, Rp[2 * s + 1].y}); }
            f32x4 Ab = fzero4(), AbT = Ab, Ak = Ab, DkT = Ab, DbT = Ab;
#pragma unroll
            for (int s = 0; s < 2; ++s) {
                Ab = __builtin_amdgcn_mfma_f32_16x16x32_bf16(Qf[s], Bf[s], Ab, 0, 0, 0);
                AbT = __builtin_amdgcn_mfma_f32_16x16x32_bf16(Bf[s], Qf[s], AbT, 0, 0, 0);
                Ak = __builtin_amdgcn_mfma_f32_16x16x32_bf16(Qf[s], Kf[s], Ak, 0, 0, 0);
                DkT = __builtin_amdgcn_mfma_f32_16x16x32_bf16(Kf[s], Rf[s], DkT, 0, 0, 0);
                DbT = __builtin_amdgcn_mfma_f32_16x16x32_bf16(Bf[s], Rf[s], DbT, 0, 0, 0); }
            f32x4 N, NT, ident;
#pragma unroll
            for (int r = 0; r < 4; ++r) { const int row = 4 * g + r;
                N[r] = (fr < row) ? -Ab[r] : 0.f; Ak[r] = (fr < row) ? Ak[r] : 0.f;
                NT[r] = (row < fr) ? -AbT[r] : 0.f;
                DkT[r] = (row <= fr) ? DkT[r] : 0.f; DbT[r] = (row <= fr) ? -DbT[r] : 0.f;
                ident[r] = (row == fr) ? 1.f : 0.f; }
            const f32x4 N2 = mm16(NT, N), N2T = mm16(N, NT);
            const f32x4 N4 = mm16(N2T, N2), N4T = mm16(N2, N2T);
            const f32x4 N8T = mm16(N4, N4T);
            const f32x4 X1 = N + ident, X1T = NT + ident, X2 = N2 + ident, X2T = N2T + ident, X4 = N4 + ident, X8T = N8T + ident;
            const f32x4 U12 = mm16(X1T, X2), U12T = mm16(X1, X2T), U34T = mm16(X4, X8T);
            const f32x4 TT = mm16(U12, U34T);
            const f32x4 M1T = mm16(Ak, TT);
#pragma unroll
            for (int ct = 0; ct < 4; ++ct) { const int c = 2 * ct + (g >> 1);
                *(LAS u32x2*)(Qt_i + fr * 128 + rw3_trswz(fr, c) * 16 + (g & 1) * 8) = Qp[ct]; }
            s16x4 qtr[4];
#pragma unroll
            for (int ct = 0; ct < 4; ++ct) { const int row = 4 * g + q4, c = 2 * ct + (p4 >> 1);
                qtr[ct] = __builtin_amdgcn_ds_read_tr16_b64_v4i16((LAS s16x4*)(Qt_i + row * 128 + rw3_trswz(row, c) * 16 + (p4 & 1) * 8)); }
            const bf16x8 TTf = pack_lo4(TT);
            f32x4 Qt[4];
#pragma unroll
            for (int ct = 0; ct < 4; ++ct) { const bf16x8 af = (bf16x8){qtr[ct][0], qtr[ct][1], qtr[ct][2], qtr[ct][3], 0, 0, 0, 0};
                Qt[ct] = __builtin_amdgcn_mfma_f32_16x16x32_bf16(af, TTf, fzero4(), 0, 0, 0); }
#pragma unroll
            for (int ct = 0; ct < 4; ++ct) {
                const int s = ct >> 1, hh = ct & 1;
                u32x2 w; w.x = cvt_pk_bf16(Qt[ct][0], Qt[ct][1]); w.y = cvt_pk_bf16(Qt[ct][2], Qt[ct][3]);
                *(LAS u32x2*)(Qt_i + fr * 128 + (((s * 4 + g) ^ (fr & 7)) * 16) + hh * 8) = w;
                *(LAS u32x2*)(Rh_i + fr * 128 + (((s * 4 + g) ^ (fr & 7)) * 16) + hh * 8) = Rp[ct];
                const int c = 2 * ct + (g >> 1);
                *(LAS u32x2*)(Kh_i + fr * 128 + rw3_trswz(fr, c) * 16 + (g & 1) * 8) = Kp[ct];
                *(LAS u32x2*)(Bn_i + fr * 128 + rw3_trswz(fr, c) * 16 + (g & 1) * 8) = (u32x2){Bp[ct].x ^ 0x80008000u, Bp[ct].y ^ 0x80008000u}; }
            { const int cs = (g ^ ((fr >> 2) & 3)) * 16;
                u32x2 w; w.x = cvt_pk_bf16(M1T[0], M1T[1]); w.y = cvt_pk_bf16(M1T[2], M1T[3]);
                *(LAS u32x2*)(M1_i + fr * 64 + cs) = (u32x2){0u, 0u}; *(LAS u32x2*)(M1_i + fr * 64 + cs + 8) = w;
                w.x = cvt_pk_bf16(DbT[0], DbT[1]); w.y = cvt_pk_bf16(DbT[2], DbT[3]); *(LAS u32x2*)(DD_i + fr * 64 + cs) = w;
                w.x = cvt_pk_bf16(DkT[0], DkT[1]); w.y = cvt_pk_bf16(DkT[2], DkT[3]); *(LAS u32x2*)(DD_i + fr * 64 + cs + 8) = w; }
        }
        if (role == 0) {
            if (hk >= 2 && tid == 0) { for (unsigned sp = 0; rw_ld(f_cons) < (unsigned)(hk - 1) && sp < (1u << 22); ++sp) __builtin_amdgcn_s_sleep(2); }
            __syncthreads();
            { LAS const unsigned char* sl = slots + wid * RW3_SLOT; const unsigned doff = (unsigned)((xslot - xb) + (size_t)wid * RW3_SLOT);
                for (int i = lane; i < RW3_SLOT / 16; i += 64) __builtin_amdgcn_raw_buffer_store_b128(*(const LAS u32x4*)(sl + i * 16), xrsrc, doff + (unsigned)i * 16u, 0, 16); }
            asm volatile("s_waitcnt vmcnt(0)" ::: "memory");
            __syncthreads();
            if (tid == 0) __hip_atomic_store(f_prod, (unsigned)(hk + 1), __ATOMIC_RELAXED, __HIP_MEMORY_SCOPE_AGENT);
            continue;
        }
        if (tid == 0) { for (unsigned sp = 0; rw_ld(f_prod) < (unsigned)(hk + 1) && sp < (1u << 22); ++sp) __builtin_amdgcn_s_sleep(2);
            __builtin_amdgcn_fence(__ATOMIC_ACQUIRE, "agent"); asm volatile("s_waitcnt vmcnt(0)" ::: "memory"); }
        __syncthreads();
        for (int i = tid; i < 8 * RW3_SLOT / 16; i += 512) *(LAS u32x4*)(slots + i * 16) = *(const u32x4*)(xslot + (size_t)i * 16);
        asm volatile("s_waitcnt vmcnt(0) lgkmcnt(0)" ::: "memory");
        __syncthreads();
        if (tid == 0) __hip_atomic_store(f_cons, (unsigned)(hk + 1), __ATOMIC_RELAXED, __HIP_MEMORY_SCOPE_AGENT);
        if (wid < 4) {
#pragma unroll 1
            for (int j = 0; j < 8; ++j) {
                int lane_t = lane; asm volatile("" : "+v"(lane_t));
                const int fr = lane_t & 15, g = lane_t >> 4, q4 = fr >> 2, p4 = fr & 3;
                LAS unsigned char* sl = slots + j * RW3_SLOT;
                LAS unsigned char* Qt_i = sl, * Rh_i = sl + 2048, * Kh_i = sl + 4096, * Bn_i = sl + 6144, * Vi_i = sl + 8192, * M1_i = sl + 10240, * DD_i = sl + 11264; LAS const float* gam_i = (LAS const float*)(sl + 12288);
                const bf16x8 Hb0 = pack_8(Hacc[0], Hacc[1]), Hb1 = pack_8(Hacc[2], Hacc[3]);
                const int trow = 4 * g + q4;
                const s16x4 vv = __builtin_amdgcn_ds_read_tr16_b64_v4i16((LAS s16x4*)(Vi_i + trow * 128 + rw3_trswz(trow, 2 * wid + (p4 >> 1)) * 16 + (p4 & 1) * 8));
                const bf16x8 q0 = *(const LAS bf16x8*)(Qt_i + fr * 128 + (((0 + g) ^ (fr & 7)) * 16)), q1 = *(const LAS bf16x8*)(Qt_i + fr * 128 + (((4 + g) ^ (fr & 7)) * 16));
                const bf16x8 r0 = *(const LAS bf16x8*)(Rh_i + fr * 128 + (((0 + g) ^ (fr & 7)) * 16)), r1 = *(const LAS bf16x8*)(Rh_i + fr * 128 + (((4 + g) ^ (fr & 7)) * 16));
                const int cs = (g ^ ((fr >> 2) & 3)) * 16;
                const bf16x8 m1 = *(const LAS bf16x8*)(M1_i + fr * 64 + cs), dd = *(const LAS bf16x8*)(DD_i + fr * 64 + cs);
                const bf16x8 v0 = (bf16x8){0, 0, 0, 0, vv[0], vv[1], vv[2], vv[3]};
                f32x4 Z = fzero4();
                Z = __builtin_amdgcn_mfma_f32_16x16x32_bf16(q0, Hb0, Z, 0, 0, 0); Z = __builtin_amdgcn_mfma_f32_16x16x32_bf16(q1, Hb1, Z, 0, 0, 0); Z = __builtin_amdgcn_mfma_f32_16x16x32_bf16(m1, v0, Z, 0, 0, 0);
                u32x2 zw; zw.x = cvt_pk_bf16(Z[0], Z[1]); zw.y = cvt_pk_bf16(Z[2], Z[3]);
                const s16x4 zs = __builtin_bit_cast(s16x4, zw);
                const bf16x8 zv = (bf16x8){zs[0], zs[1], zs[2], zs[3], vv[0], vv[1], vv[2], vv[3]};
                f32x4 Y = fzero4();
                Y = __builtin_amdgcn_mfma_f32_16x16x32_bf16(r0, Hb0, Y, 0, 0, 0); Y = __builtin_amdgcn_mfma_f32_16x16x32_bf16(r1, Hb1, Y, 0, 0, 0); Y = __builtin_amdgcn_mfma_f32_16x16x32_bf16(dd, zv, Y, 0, 0, 0);
                const size_t nrow = nb0 + (size_t)(tick * 8 + j) * 16 + 4 * g;
#pragma unroll
                for (int r = 0; r < 4; ++r) yraw[(nrow + r) * 512 + h * 64 + wid * 16 + fr] = Y[r];
#pragma unroll
                for (int rt = 0; rt < 4; ++rt) { const int c = 2 * rt + (p4 >> 1);
                    const s16x4 bn = __builtin_amdgcn_ds_read_tr16_b64_v4i16((LAS s16x4*)(Bn_i + trow * 128 + rw3_trswz(trow, c) * 16 + (p4 & 1) * 8));
                    const s16x4 kh = __builtin_amdgcn_ds_read_tr16_b64_v4i16((LAS s16x4*)(Kh_i + trow * 128 + rw3_trswz(trow, c) * 16 + (p4 & 1) * 8));
                    const bf16x8 af = (bf16x8){bn[0], bn[1], bn[2], bn[3], kh[0], kh[1], kh[2], kh[3]};
                    Hacc[rt] = __builtin_amdgcn_mfma_f32_16x16x32_bf16(af, zv, Hacc[rt], 0, 0, 0);
                    Hacc[rt] = Hacc[rt] * *(const LAS f32x4*)(gam_i + rt * 16 + g * 4); }
            }
        }
        __syncthreads();
    }
#undef MIXB
#undef RW3_LOADS
#undef lrc
#undef lkc
#undef lvc
#undef lrp
#undef lkp
#undef lvp
}

__device__ __forceinline__ void phase_rwkv_epi(const Params& p, int bid, int nb) {
    const int tid = opaque_tid(), wid = tid >> 6, lane = tid & 63;
    const float* yraw = p.out; const bf16_t* e1g = (const bf16_t*)(p.out + (size_t)NTOK * 512); const bf16_t* gg = e1g + (size_t)NTOK * 512;
    bf16_t* mix = (bf16_t*)(p.ws + OFF_BUF64);
    const f32x4 g0 = *(const f32x4*)(p.in[I_AGNG] + lane * 8), g1 = *(const f32x4*)(p.in[I_AGNG] + lane * 8 + 4), b0 = *(const f32x4*)(p.in[I_AGNB] + lane * 8), b1 = *(const f32x4*)(p.in[I_AGNB] + lane * 8 + 4);
    for (int n = bid * 8 + wid; n < NTOK; n += nb * 8) {
        const f32x4 y0 = *(const f32x4*)(yraw + (size_t)n * 512 + lane * 8), y1 = *(const f32x4*)(yraw + (size_t)n * 512 + lane * 8 + 4);
        const u32x4 ev = *(const u32x4*)(e1g + (size_t)n * 512 + lane * 8), gv = *(const u32x4*)(gg + (size_t)n * 512 + lane * 8);
#if SANITIZE
        f32x4 y0s = y0, y1s = y1;
#pragma unroll
        for (int j = 0; j < 4; ++j) { if (!(fabsf(y0s[j]) < 1e30f)) y0s[j] = 0.f; if (!(fabsf(y1s[j]) < 1e30f)) y1s[j] = 0.f; }
#define y0 y0s
#define y1 y1s
#endif
        float s = (y0[0] + y0[1]) + (y0[2] + y0[3]) + (y1[0] + y1[1]) + (y1[2] + y1[3]);
        s = red8(s); const float mean = s * (1.0f / 64.0f);
        const f32x4 d0 = y0 - mean, d1 = y1 - mean;
        float q = (d0[0] * d0[0] + d0[1] * d0[1]) + (d0[2] * d0[2] + d0[3] * d0[3]) + (d1[0] * d1[0] + d1[1] * d1[1]) + (d1[2] * d1[2] + d1[3] * d1[3]);
        q = red8(q); const float rs = rsqrtf(q * (1.0f / 64.0f) + 64e-5f);
        float o[8];
        const unsigned ew[4] = {ev.x, ev.y, ev.z, ev.w}, gw[4] = {gv.x, gv.y, gv.z, gv.w};
#pragma unroll
        for (int j = 0; j < 4; ++j) { const float ya = (j < 2 ? d0[2 * j] : d1[2 * j - 4]), yb = (j < 2 ? d0[2 * j + 1] : d1[2 * j - 3]);
            const float ga = (j < 2 ? g0[2 * j] : g1[2 * j - 4]), gb_ = (j < 2 ? g0[2 * j + 1] : g1[2 * j - 3]); const float ba = (j < 2 ? b0[2 * j] : b1[2 * j - 4]), bb_ = (j < 2 ? b0[2 * j + 1] : b1[2 * j - 3]);
            o[2 * j] = (ya * rs * ga + ba + __uint_as_float(ew[j] << 16)) * __uint_as_float(gw[j] << 16);
            o[2 * j + 1] = (yb * rs * gb_ + bb_ + __uint_as_float(ew[j] & 0xffff0000u)) * __uint_as_float(gw[j] & 0xffff0000u); }
        u32x4 w; w.x = cvt_pk_bf16(o[0], o[1]); w.y = cvt_pk_bf16(o[2], o[3]); w.z = cvt_pk_bf16(o[4], o[5]); w.w = cvt_pk_bf16(o[6], o[7]);
#if SANITIZE
#undef y0
#undef y1
#pragma unroll
        for (int j = 0; j < 8; ++j) if (!(fabsf(o[j]) < 1e30f)) o[j] = 0.f;
        w.x = cvt_pk_bf16(o[0], o[1]); w.y = cvt_pk_bf16(o[2], o[3]); w.z = cvt_pk_bf16(o[4], o[5]); w.w = cvt_pk_bf16(o[6], o[7]);
#endif
        *(u32x4*)(mix + (size_t)n * DM + lane * 8) = w;
    }
}

__device__ __forceinline__ int gla_fT(int row) { return ((row >> 1) & 1) | (((row >> 3) & 1) << 1); }
__device__ __forceinline__ int gla_hV(int row) { return (row & 3) | (((row >> 3) & 1) << 2); }
__device__ __forceinline__ void gla2_item(const Params& p, LAS unsigned char* lds, int item, int seg) {
    const int tid = opaque_tid(), lane = tid & 63, wid = tid >> 6, fr = lane & 15, g = lane >> 4;
    const int b = item >> 2, h = item & 3;
    const bf16_t* P0 = (const bf16_t*)(p.ws + OFF_P) + 1792;
    const float* xa16 = (const float*)(p.ws + OFF_U);
    bf16_t* mix = (bf16_t*)(p.ws + OFF_BUF64);
    LAS float* bcf = (LAS float*)lds;
    LAS float* tot = bcf + 64 * 64;
    LAS float* bls = tot + 8 * 64;
    LAS float* pn = bls + 64;
    LAS float* xs = pn + 64 * 8;
    LAS float* boff = xs + 2 * 1024;
    LAS unsigned char* qd_i = (LAS unsigned char*)(boff + 64);
    LAS unsigned char* ki_a = qd_i + 8192;
    LAS unsigned char* ki_t = ki_a + 8192;
    LAS unsigned char* att_i = ki_t + 8192;
    LAS unsigned char* v_i = att_i + 8192;
    for (int i = tid; i < 8192 / 16; i += 512) *(LAS u32x4*)(att_i + i * 16) = uzero4();
    float gw2[16];
#pragma unroll
    for (int i = 0; i < 16; ++i) gw2[i] = p.in[I_BGW2][i * 256 + h * 64 + lane];
    const float gb = p.in[I_BGB][h * 64 + lane];
    const f32x4 ngv = *(const f32x4*)(p.in[I_BNG] + h * 128 + wid * 16 + g * 4);
    f32x4 Sacc[4];
#pragma unroll
    for (int rt = 0; rt < 4; ++rt) Sacc[rt] = fzero4();
    const int q4 = fr >> 2, p4 = fr & 3;
    const int tok = tid >> 3, dc = tid & 7;
    u32x4 nq, nk, nv0, nv1; u32x2 ngate[4]; f32x4 nxa = fzero4();
#define GLA_ISSUE(c0n) do { const size_t _n = (size_t)b * SEQ + (c0n) + tok; \
        nq = *(const u32x4*)(P0 + _n * NE_MAIN + h * 64 + dc * 8); nk = *(const u32x4*)(P0 + _n * NE_MAIN + 256 + h * 64 + dc * 8); \
        nv0 = *(const u32x4*)(P0 + _n * NE_MAIN + 512 + h * 128 + dc * 16); nv1 = *(const u32x4*)(P0 + _n * NE_MAIN + 512 + h * 128 + dc * 16 + 8); \
        _Pragma("unroll") for (int _ct = 0; _ct < 4; ++_ct) ngate[_ct] = *(const u32x2*)(P0 + ((size_t)b * SEQ + (c0n) + _ct * 16 + fr) * NE_MAIN + 1024 + h * 128 + wid * 16 + g * 4); \
        if (tid < 256) nxa = *(const f32x4*)(xa16 + ((size_t)b * SEQ + (c0n)) * 16 + tid * 4); } while (0)
    const int cbeg = seg * (SEQ / 2), cend = cbeg + SEQ / 2;
    float* oraw = (float*)(p.ws + OFF_GLA_ORAW); bf16_t* qdgb = (bf16_t*)(p.ws + OFF_GLA_QDG);
    GLA_ISSUE(cbeg);
    if (tid < 256) *(LAS f32x4*)(xs + ((cbeg >> 6) & 1) * 1024 + tid * 4) = nxa;
    if (tid < 64) boff[tid] = 0.f;
    __syncthreads();
    for (int c0 = cbeg; c0 < cend; c0 += 64) {
        const size_t n0 = (size_t)b * SEQ + c0;
        LAS const float* xsc = xs + ((c0 >> 6) & 1) * 1024;
        { float run = 0.f;
#pragma unroll
            for (int tt = 0; tt < 8; ++tt) { const int c = wid * 8 + tt; float z = gb;
#pragma unroll
                for (int i4 = 0; i4 < 4; ++i4) { const f32x4 xv = *(const LAS f32x4*)(xsc + c * 16 + i4 * 4); z += xv[0] * gw2[i4 * 4] + xv[1] * gw2[i4 * 4 + 1] + xv[2] * gw2[i4 * 4 + 2] + xv[3] * gw2[i4 * 4 + 3]; }
                const float ls = fminf(z, 0.f) - __logf(1.0f + __expf(-fabsf(z)));
                run += ls * (1.0f / 16.0f); bcf[c * 64 + lane] = run; }
            tot[wid * 64 + lane] = run; }
        __syncthreads();
        { float off = 0.f;
            for (int w2 = 0; w2 < wid; ++w2) off += tot[w2 * 64 + lane];
#pragma unroll
            for (int tt = 0; tt < 8; ++tt) bcf[(wid * 8 + tt) * 64 + lane] += off;
            if (wid == 7) bls[lane] = __expf(bcf[63 * 64 + lane]); }
        __syncthreads();
        u32x2 gate[4];
        { const f32x4 bc0 = *(const LAS f32x4*)(bcf + tok * 64 + dc * 8), bc1 = *(const LAS f32x4*)(bcf + tok * 64 + dc * 8 + 4);
            const unsigned qw[4] = {nq.x, nq.y, nq.z, nq.w}, kw[4] = {nk.x, nk.y, nk.z, nk.w};
            float qo[8], ko[8];
#pragma unroll
            for (int j = 0; j < 4; ++j) { const float ba = (j < 2 ? bc0[2 * j] : bc1[2 * j - 4]), bb = (j < 2 ? bc0[2 * j + 1] : bc1[2 * j - 3]);
                const float ea = __expf(ba), eb = __expf(bb), ia = fast_rcp(ea), ib = fast_rcp(eb);
                qo[2 * j] = __uint_as_float(qw[j] << 16) * 0.125f * ea; qo[2 * j + 1] = __uint_as_float(qw[j] & 0xffff0000u) * 0.125f * eb;
                ko[2 * j] = __uint_as_float(kw[j] << 16) * ia; ko[2 * j + 1] = __uint_as_float(kw[j] & 0xffff0000u) * ib; }
            u32x4 qp, kp; qp.x = cvt_pk_bf16(qo[0], qo[1]); qp.y = cvt_pk_bf16(qo[2], qo[3]); qp.z = cvt_pk_bf16(qo[4], qo[5]); qp.w = cvt_pk_bf16(qo[6], qo[7]);
            kp.x = cvt_pk_bf16(ko[0], ko[1]); kp.y = cvt_pk_bf16(ko[2], ko[3]); kp.z = cvt_pk_bf16(ko[4], ko[5]); kp.w = cvt_pk_bf16(ko[6], ko[7]);
            *(LAS u32x4*)(qd_i + tok * 128 + ((dc ^ (tok & 7)) * 16)) = qp;
            if (seg) {
                const f32x4 bo0 = *(const LAS f32x4*)(boff + dc * 8), bo1 = *(const LAS f32x4*)(boff + dc * 8 + 4); float qg[8];
#pragma unroll
                for (int j = 0; j < 8; ++j) qg[j] = qo[j] * __expf(j < 4 ? bo0[j] : bo1[j - 4]);
                u32x4 w; w.x = cvt_pk_bf16(qg[0], qg[1]); w.y = cvt_pk_bf16(qg[2], qg[3]); w.z = cvt_pk_bf16(qg[4], qg[5]); w.w = cvt_pk_bf16(qg[6], qg[7]);
                *(u32x4*)(qdgb + ((size_t)b * 2048 + (c0 - cbeg) + tok) * 256 + h * 64 + dc * 8) = w; }
            *(LAS u32x4*)(ki_a + tok * 128 + ((dc ^ (tok & 7)) * 16)) = kp;
            *(LAS u32x4*)(ki_t + tok * 128 + (((((dc >> 1) ^ gla_fT(tok)) << 1) | (dc & 1)) * 16)) = kp;
            { const int pr = dc ^ gla_hV(tok); *(LAS u32x4*)(v_i + tok * 256 + (pr * 2) * 16) = nv0; *(LAS u32x4*)(v_i + tok * 256 + (pr * 2 + 1) * 16) = nv1; }
#pragma unroll
            for (int ct = 0; ct < 4; ++ct) gate[ct] = ngate[ct]; }
        if (c0 + 64 < cend) GLA_ISSUE(c0 + 64);
        __syncthreads();
        for (int ti = wid; ti < 10; ti += 8) {
            int st, ct; { const int tb[10] = {0x00, 0x01, 0x02, 0x03, 0x11, 0x12, 0x13, 0x22, 0x23, 0x33}; int code = 0;
#pragma unroll
                for (int k = 0; k < 10; ++k) if (k == ti) code = tb[k];
                st = code >> 4; ct = code & 15; }
            f32x4 d = fzero4();
            const int rs_ = st * 16 + fr, rc_ = ct * 16 + fr;
#pragma unroll
            for (int s = 0; s < 2; ++s) {
                const bf16x8 a = *(const LAS bf16x8*)(ki_a + rs_ * 128 + (((s * 4 + g) ^ (rs_ & 7)) * 16));
                const bf16x8 bq = *(const LAS bf16x8*)(qd_i + rc_ * 128 + (((s * 4 + g) ^ (rc_ & 7)) * 16));
                d = __builtin_amdgcn_mfma_f32_16x16x32_bf16(a, bq, d, 0, 0, 0); }
            const int c = ct * 16 + fr; float o4[4];
#pragma unroll
            for (int r = 0; r < 4; ++r) { const int s_ = st * 16 + g * 4 + r; o4[r] = (s_ <= c) ? d[r] : 0.f; }
            u32x2 w; w.x = cvt_pk_bf16(o4[0], o4[1]); w.y = cvt_pk_bf16(o4[2], o4[3]);
            *(LAS u32x2*)(att_i + c * 128 + (((2 * st + (g >> 1)) ^ (c & 7)) * 16) + (g & 1) * 8) = w;
        }
        if (seg && tid < 64) boff[tid] += bcf[63 * 64 + tid];
        __syncthreads();
        {
            bf16x8 vf[2];
#pragma unroll
            for (int s = 0; s < 2; ++s) {
                const int r1 = s * 32 + g * 8 + q4, r2 = r1 + 4; const int c = 2 * wid + (p4 >> 1);
                const s16x4 lo = __builtin_amdgcn_ds_read_tr16_b64_v4i16((LAS s16x4*)(v_i + r1 * 256 + (((((c >> 1) ^ gla_hV(r1)) << 1) | (c & 1)) * 16) + (p4 & 1) * 8));
                const s16x4 hi = __builtin_amdgcn_ds_read_tr16_b64_v4i16((LAS s16x4*)(v_i + r2 * 256 + (((((c >> 1) ^ gla_hV(r2)) << 1) | (c & 1)) * 16) + (p4 & 1) * 8));
                vf[s] = (bf16x8){lo[0], lo[1], lo[2], lo[3], hi[0], hi[1], hi[2], hi[3]}; }
            bf16x8 sf[2];
#pragma unroll
            for (int s = 0; s < 2; ++s) sf[s] = pack_8g(Sacc[2 * s], Sacc[2 * s + 1]);
            f32x4 oacc[4];
#pragma unroll
            for (int ct = 0; ct < 4; ++ct) {
                const int c = ct * 16 + fr; f32x4 d = fzero4();
#pragma unroll
                for (int s = 0; s < 2; ++s) {
                    const bf16x8 ab = *(const LAS bf16x8*)(att_i + c * 128 + (((s * 4 + g) ^ (c & 7)) * 16));
                    d = __builtin_amdgcn_mfma_f32_16x16x32_bf16(vf[s], ab, d, 0, 0, 0);
                    const s16x4 q0 = *(const LAS s16x4*)(qd_i + c * 128 + (((s * 4 + (g >> 1)) ^ (c & 7)) * 16) + (g & 1) * 8);
                    const s16x4 q1 = *(const LAS s16x4*)(qd_i + c * 128 + (((s * 4 + 2 + (g >> 1)) ^ (c & 7)) * 16) + (g & 1) * 8);
                    const bf16x8 qb = (bf16x8){q0[0], q0[1], q0[2], q0[3], q1[0], q1[1], q1[2], q1[3]};
                    d = __builtin_amdgcn_mfma_f32_16x16x32_bf16(sf[s], qb, d, 0, 0, 0); }
                oacc[ct] = d; }
#pragma unroll
            for (int rt = 0; rt < 4; ++rt) {
#pragma unroll
                for (int s = 0; s < 2; ++s) {
                    const int r1 = s * 32 + g * 8 + q4, r2 = r1 + 4; const int c = 2 * rt + (p4 >> 1);
                    const s16x4 lo = __builtin_amdgcn_ds_read_tr16_b64_v4i16((LAS s16x4*)(ki_t + r1 * 128 + (((((c >> 1) ^ gla_fT(r1)) << 1) | (c & 1)) * 16) + (p4 & 1) * 8));
                    const s16x4 hi = __builtin_amdgcn_ds_read_tr16_b64_v4i16((LAS s16x4*)(ki_t + r2 * 128 + (((((c >> 1) ^ gla_fT(r2)) << 1) | (c & 1)) * 16) + (p4 & 1) * 8));
                    const bf16x8 kf = (bf16x8){lo[0], lo[1], lo[2], lo[3], hi[0], hi[1], hi[2], hi[3]};
                    Sacc[rt] = __builtin_amdgcn_mfma_f32_16x16x32_bf16(kf, vf[s], Sacc[rt], 0, 0, 0); }
                const f32x4 eb = *(const LAS f32x4*)(bls + rt * 16 + g * 4);
                Sacc[rt] = Sacc[rt] * eb; }
#pragma unroll
            for (int ct = 0; ct < 4; ++ct) { float ss = oacc[ct][0] * oacc[ct][0] + oacc[ct][1] * oacc[ct][1] + oacc[ct][2] * oacc[ct][2] + oacc[ct][3] * oacc[ct][3];
                ss += __shfl_xor(ss, 16); ss += __shfl_xor(ss, 32);
                if (g == 0) pn[(ct * 16 + fr) * 8 + wid] = ss; }
            if (tid < 256 && c0 + 64 < cend) *(LAS f32x4*)(xs + (((c0 >> 6) + 1) & 1) * 1024 + tid * 4) = nxa;
            __syncthreads();
            if (seg) {
#pragma unroll
                for (int ct = 0; ct < 4; ++ct) *(f32x4*)(oraw + ((size_t)b * 2048 + (c0 - cbeg) + ct * 16 + fr) * 512 + h * 128 + wid * 16 + g * 4) = oacc[ct];
            } else
#pragma unroll
            for (int ct = 0; ct < 4; ++ct) { const int c = ct * 16 + fr;
                const f32x4 a0 = *(const LAS f32x4*)(pn + c * 8), a1 = *(const LAS f32x4*)(pn + c * 8 + 4);
                const float ss = (a0[0] + a0[1]) + (a0[2] + a0[3]) + (a1[0] + a1[1]) + (a1[2] + a1[3]);
                const float rs = rsqrtf(ss * (1.0f / 128.0f) + 1e-5f);
                const u32x2 gv = gate[ct];
                const float g0 = __uint_as_float(gv.x << 16), g1 = __uint_as_float(gv.x & 0xffff0000u), g2 = __uint_as_float(gv.y << 16), g3 = __uint_as_float(gv.y & 0xffff0000u);
                const float v0 = oacc[ct][0] * rs * ngv[0] * (g0 * fast_sigmoid(g0)), v1 = oacc[ct][1] * rs * ngv[1] * (g1 * fast_sigmoid(g1));
                const float v2 = oacc[ct][2] * rs * ngv[2] * (g2 * fast_sigmoid(g2)), v3 = oacc[ct][3] * rs * ngv[3] * (g3 * fast_sigmoid(g3));
                u32x2 w; w.x = cvt_pk_bf16(v0, v1); w.y = cvt_pk_bf16(v2, v3);
                *(u32x2*)(mix + (n0 + c) * DM + 512 + h * 128 + wid * 16 + g * 4) = w; }
        }
    }
    if (seg == 0) { float* sin_ = (float*)(p.ws + OFF_GLA_SIN) + (size_t)item * 64 * 128;
#pragma unroll
        for (int rt = 0; rt < 4; ++rt)
#pragma unroll
            for (int r = 0; r < 4; ++r) sin_[(rt * 16 + g * 4 + r) * 128 + wid * 16 + fr] = Sacc[rt][r]; }
#undef GLA_ISSUE
}

__device__ __forceinline__ void phase_gla_fix(const Params& p, LAS unsigned char* lds, int bid, int nb) {
    const int tid = opaque_tid(), lane = tid & 63, wid = tid >> 6, fr = lane & 15, g = lane >> 4;
    const bf16_t* P0 = (const bf16_t*)(p.ws + OFF_P) + 1792;
    const float* oraw = (const float*)(p.ws + OFF_GLA_ORAW); const bf16_t* qdgb = (const bf16_t*)(p.ws + OFF_GLA_QDG); const float* sinb = (const float*)(p.ws + OFF_GLA_SIN);
    bf16_t* mix = (bf16_t*)(p.ws + OFF_BUF64);
    LAS unsigned char* st_i = lds;
    LAS float* pn = (LAS float*)(lds + 16384);
    for (int it = bid; it < 32 * 32; it += nb) {
        const int item = it >> 5, ch = it & 31, b = item >> 2, h = item & 3;
        __syncthreads();
        { const float* sp = sinb + (size_t)item * 64 * 128;
            const int e_ = tid >> 2, d0 = (tid & 3) * 16; float v[16];
#pragma unroll
            for (int j = 0; j < 16; ++j) v[j] = sp[(d0 + j) * 128 + e_];
#pragma unroll
            for (int c2 = 0; c2 < 2; ++c2) { u32x4 w; w.x = cvt_pk_bf16(v[c2 * 8], v[c2 * 8 + 1]); w.y = cvt_pk_bf16(v[c2 * 8 + 2], v[c2 * 8 + 3]); w.z = cvt_pk_bf16(v[c2 * 8 + 4], v[c2 * 8 + 5]); w.w = cvt_pk_bf16(v[c2 * 8 + 6], v[c2 * 8 + 7]);
                const int c = (d0 >> 3) + c2; *(LAS u32x4*)(st_i + e_ * 128 + ((c ^ (e_ & 7)) * 16)) = w; } }
        __syncthreads();
        const size_t t0 = (size_t)b * 2048 + ch * 64;
        const size_t n0 = (size_t)b * SEQ + 2048 + ch * 64;
        const f32x4 ngv = *(const f32x4*)(p.in[I_BNG] + h * 128 + wid * 16 + g * 4);
        f32x4 oacc[4];
#pragma unroll
        for (int ct = 0; ct < 4; ++ct) {
            const int c = ct * 16 + fr;
            f32x4 d = *(const f32x4*)(oraw + (t0 + c) * 512 + h * 128 + wid * 16 + g * 4);
#pragma unroll
            for (int s = 0; s < 2; ++s) {
                const int er = wid * 16 + fr;
                const bf16x8 a = *(const LAS bf16x8*)(st_i + er * 128 + (((s * 4 + g) ^ (er & 7)) * 16));
                const bf16x8 bq = *(const bf16x8*)(qdgb + (t0 + c) * 256 + h * 64 + s * 32 + g * 8);
                d = __builtin_amdgcn_mfma_f32_16x16x32_bf16(a, bq, d, 0, 0, 0); }
            oacc[ct] = d; }
#pragma unroll
        for (int ct = 0; ct < 4; ++ct) { float ss = oacc[ct][0] * oacc[ct][0] + oacc[ct][1] * oacc[ct][1] + oacc[ct][2] * oacc[ct][2] + oacc[ct][3] * oacc[ct][3];
            ss += __shfl_xor(ss, 16); ss += __shfl_xor(ss, 32);
            if (g == 0) pn[(ct * 16 + fr) * 8 + wid] = ss; }
        __syncthreads();
#pragma unroll
        for (int ct = 0; ct < 4; ++ct) { const int c = ct * 16 + fr;
            const f32x4 a0 = *(const LAS f32x4*)(pn + c * 8), a1 = *(const LAS f32x4*)(pn + c * 8 + 4);
            const float ss = (a0[0] + a0[1]) + (a0[2] + a0[3]) + (a1[0] + a1[1]) + (a1[2] + a1[3]);
            const float rs = rsqrtf(ss * (1.0f / 128.0f) + 1e-5f);
            const u32x2 gv = *(const u32x2*)(P0 + (n0 + c) * NE_MAIN + 1024 + h * 128 + wid * 16 + g * 4);
            const float g0 = __uint_as_float(gv.x << 16), g1 = __uint_as_float(gv.x & 0xffff0000u), g2 = __uint_as_float(gv.y << 16), g3 = __uint_as_float(gv.y & 0xffff0000u);
            const float v0 = oacc[ct][0] * rs * ngv[0] * (g0 * fast_sigmoid(g0)), v1 = oacc[ct][1] * rs * ngv[1] * (g1 * fast_sigmoid(g1));
            const float v2 = oacc[ct][2] * rs * ngv[2] * (g2 * fast_sigmoid(g2)), v3 = oacc[ct][3] * rs * ngv[3] * (g3 * fast_sigmoid(g3));
            u32x2 w; w.x = cvt_pk_bf16(v0, v1); w.y = cvt_pk_bf16(v2, v3);
            *(u32x2*)(mix + (n0 + c) * DM + 512 + h * 128 + wid * 16 + g * 4) = w; }
    }
}


__device__ __forceinline__ void phase_mixer_even(const Params& p, LAS unsigned char* lds, int bid, int nb, int which) {
    PROBE_DECL;
    PROBE_BEGIN(47);
    if (nb >= 224) {
        if (bid < 64) { if (which != 2) rwkv3_item(p, lds, bid, 1, 0); }
        else if (bid < 192) { if (which != 2) rwkv3_item(p, lds, (bid - 64) >> 1, 0, (bid - 64) & 1); }
        else { if (which != 1) gla2_item(p, lds, (bid - 192) >> 1, (bid - 192) & 1); }
    }
    __syncthreads();
    PROBE_END(47);
    PROBE_BEGIN(48);
    if (which == 0) phase_prep(p, lds, bid, nb, 1);
    PROBE_END(48);
#if PROBE_ID == 47 || PROBE_ID == 48
    if (bid == PROBE_BLK && opaque_tid() == 0) *(float*)(p.ws + OFF_MISC + MISC_PROBE) = (float)probe_acc * 3e-8f;
#endif
}

__device__ __forceinline__ void phase_rope(const Params& p, int bid, int nb) {
    const int tid = opaque_tid(), wid = tid >> 6, lane = tid & 63;
    unsigned char* ws = p.ws;
    const bf16_t* Pd = (const bf16_t*)(ws + OFF_PD);
    bf16_t* qr = (bf16_t*)(ws + OFF_BUF64); bf16_t* kr = (bf16_t*)(ws + OFF_KR); bf16_t* vv = (bf16_t*)(ws + OFF_VV);
    bf16_t* iqr = (bf16_t*)(ws + OFF_IQR); bf16_t* ikr = (bf16_t*)(ws + OFF_IKR); float* iw = (float*)(ws + OFF_IW);
    const float* c64 = (const float*)(ws + OFF_ROPE); const float* s64 = c64 + 4096 * 64; const float* c32 = s64 + 4096 * 64; const float* s32 = c32 + 4096 * 32;
    const float ikg = p.in[I_CIKG][lane], ikb = p.in[I_CIKB][lane];
    for (int n = bid * 8 + wid; n < NTOK; n += nb * 8) {
        const int pos = n & (SEQ - 1);
        const bf16_t* row = Pd + (size_t)n * NO_MAIN;
#define ROPE8(off1, off2, cs, sn, scale, dst, d1, d2) do { \
            const u32x4 a_ = *(const u32x4*)(row + (off1)), b_ = *(const u32x4*)(row + (off2)); \
            const f32x4 c0_ = *(const f32x4*)(cs), c1_ = *(const f32x4*)((cs) + 4), s0_ = *(const f32x4*)(sn), s1_ = *(const f32x4*)((sn) + 4); \
            const unsigned aw_[4] = {a_.x, a_.y, a_.z, a_.w}, bw_[4] = {b_.x, b_.y, b_.z, b_.w}; float o1_[8], o2_[8]; \
            _Pragma("unroll") for (int j_ = 0; j_ < 4; ++j_) { \
                const float z1a = __uint_as_float(aw_[j_] << 16), z1b = __uint_as_float(aw_[j_] & 0xffff0000u), z2a = __uint_as_float(bw_[j_] << 16), z2b = __uint_as_float(bw_[j_] & 0xffff0000u); \
                const float ca = (j_ < 2 ? c0_[2 * j_] : c1_[2 * j_ - 4]), cb = (j_ < 2 ? c0_[2 * j_ + 1] : c1_[2 * j_ - 3]), sa = (j_ < 2 ? s0_[2 * j_] : s1_[2 * j_ - 4]), sb = (j_ < 2 ? s0_[2 * j_ + 1] : s1_[2 * j_ - 3]); \
                o1_[2 * j_] = (z1a * ca - z2a * sa) * (scale); o1_[2 * j_ + 1] = (z1b * cb - z2b * sb) * (scale); o2_[2 * j_] = (z2a * ca + z1a * sa) * (scale); o2_[2 * j_ + 1] = (z2b * cb + z1b * sb) * (scale); } \
            u32x4 w1_, w2_; w1_.x = cvt_pk_bf16(o1_[0], o1_[1]); w1_.y = cvt_pk_bf16(o1_[2], o1_[3]); w1_.z = cvt_pk_bf16(o1_[4], o1_[5]); w1_.w = cvt_pk_bf16(o1_[6], o1_[7]); \
            w2_.x = cvt_pk_bf16(o2_[0], o2_[1]); w2_.y = cvt_pk_bf16(o2_[2], o2_[3]); w2_.z = cvt_pk_bf16(o2_[4], o2_[5]); w2_.w = cvt_pk_bf16(o2_[6], o2_[7]); \
            *(u32x4*)((dst) + (d1)) = w1_; *(u32x4*)((dst) + (d2)) = w2_; } while (0)
        { const int h = lane >> 3, jb = (lane & 7) * 8;
            ROPE8(h * 128 + jb, h * 128 + 64 + jb, c64 + pos * 64 + jb, s64 + pos * 64 + jb, 0.08838834764831845f, qr + (size_t)n * 1024, h * 128 + jb, h * 128 + 64 + jb); }
        if (lane < 8) { const int jb = lane * 8;
            ROPE8(1024 + jb, 1024 + 64 + jb, c64 + pos * 64 + jb, s64 + pos * 64 + jb, 1.0f, kr + (size_t)n * 128, jb, 64 + jb); }
        else if (lane < 24) { const int c = (lane - 8) * 8;
            *(u32x4*)(vv + (size_t)n * 128 + c) = *(const u32x4*)(row + 1152 + c); }
        else if (lane < 40) { const int h = (lane - 24) >> 2, jb = ((lane - 24) & 3) * 8;
            ROPE8(1280 + h * 64 + jb, 1280 + h * 64 + 32 + jb, c32 + pos * 32 + jb, s32 + pos * 32 + jb, 0.125f, iqr + (size_t)n * 256, h * 64 + jb, h * 64 + 32 + jb); }
#undef ROPE8
        const int j32 = lane & 31; const float cc = c32[pos * 32 + j32], ss = s32[pos * 32 + j32];
        { const float x = bf2f(row[1536 + lane]); const float mean = wave_sum(x) * (1.0f / 64.0f); const float d = x - mean; const float var = wave_sum(d * d) * (1.0f / 64.0f);
            const float y = d * rsqrtf(var + LN_EPS) * ikg + ikb; const float o = __shfl_xor(y, 32);
            const float res = lane < 32 ? (y * cc - o * ss) : (y * cc + o * ss);
            ikr[(size_t)n * 64 + lane] = f2bf(res); }
        if (lane < 4) iw[(size_t)n * 4 + lane] = bf2f(row[1600 + lane]) * 0.5f;
    }
}


__device__ __forceinline__ void attn_query(const bf16_t* qr, const bf16_t* kr, const bf16_t* vv, bf16_t* ao, int n, LAS const unsigned short* ks, LAS unsigned char* vbuf, int lane) {
    const int fr = lane & 15, g = lane >> 4, q4 = fr >> 2, p4 = fr & 3;
    const int t = n & (SEQ - 1), b = n >> 12, cnt = (t + 1) < 256 ? (t + 1) : 256;
    {
        bf16x8 qf[4];
#pragma unroll
        for (int s = 0; s < 4; ++s) { qf[s] = (bf16x8){0, 0, 0, 0, 0, 0, 0, 0}; if (fr < 8) qf[s] = *(const bf16x8*)(qr + (size_t)n * 1024 + fr * 128 + s * 32 + g * 8); }
        const bf16_t* kbase = kr + (size_t)b * SEQ * 128; const bf16_t* vbase = vv + (size_t)b * SEQ * 128;
        f32x4 acc[16];
        bf16x8 kf[3][2][4];
#define ATT_KLOAD(buf, grp) do { _Pragma("unroll") for (int t2 = 0; t2 < 2; ++t2) { const int j_ = ((grp) * 2 + t2) * 16 + fr; const int key_ = j_ < cnt ? (int)ks[j_] : 0; \
            const bf16_t* kp_ = kbase + (size_t)key_ * 128 + g * 8; _Pragma("unroll") for (int s = 0; s < 4; ++s) kf[buf][t2][s] = *(const bf16x8*)(kp_ + s * 32); } } while (0)
        ATT_KLOAD(0, 0); ATT_KLOAD(1, 1);
#pragma unroll
        for (int grp = 0; grp < 8; ++grp) {
            if (grp + 2 < 8) ATT_KLOAD((grp + 2) % 3, grp + 2);
#pragma unroll
            for (int t2 = 0; t2 < 2; ++t2) { f32x4 a = fzero4();
#pragma unroll
                for (int s = 0; s < 4; ++s) a = __builtin_amdgcn_mfma_f32_16x16x32_bf16(kf[grp % 3][t2][s], qf[s], a, 0, 0, 0);
                acc[grp * 2 + t2] = a; }
        }
#undef ATT_KLOAD
        u32x4 vr[2][8];
#define ATT_VLOAD(buf, s) do { _Pragma("unroll") for (int i = 0; i < 8; ++i) { const int kl_ = i * 4 + g; const int jj_ = (s) * 32 + kl_; const int key_ = jj_ < cnt ? (int)ks[jj_] : 0; \
            const int c_ = fr ^ ((kl_ & 7) << 1); vr[buf][i] = *(const u32x4*)(vbase + (size_t)key_ * 128 + c_ * 8); } } while (0)
        ATT_VLOAD(0, 0);
        float m = -INFINITY;
#pragma unroll
        for (int tl = 0; tl < 16; ++tl)
#pragma unroll
            for (int r = 0; r < 4; ++r) { if (tl * 16 + g * 4 + r >= cnt) acc[tl][r] = -INFINITY; m = fmaxf(m, acc[tl][r]); }
        m = fmaxf(m, __shfl_xor(m, 16)); m = fmaxf(m, __shfl_xor(m, 32));
        float sum = 0.f;
#pragma unroll
        for (int tl = 0; tl < 16; ++tl)
#pragma unroll
            for (int r = 0; r < 4; ++r) { const float e_ = __expf(acc[tl][r] - m); acc[tl][r] = e_; sum += e_; }
        sum += __shfl_xor(sum, 16); sum += __shfl_xor(sum, 32);
        const float inv = 1.0f / sum;
        bf16x8 pf[8];
#pragma unroll
        for (int s = 0; s < 8; ++s) pf[s] = pack_8g(acc[2 * s], acc[2 * s + 1]);
        f32x4 o[8];
#pragma unroll
        for (int dt = 0; dt < 8; ++dt) o[dt] = fzero4();
#pragma unroll
        for (int s = 0; s < 8; ++s) {
            LAS unsigned char* vb = vbuf + (s & 1) * 8192;
            if (s + 1 < 8) ATT_VLOAD((s + 1) & 1, s + 1);
#pragma unroll
            for (int i = 0; i < 8; ++i) { const int kl = i * 4 + g; *(LAS u32x4*)(vb + kl * 256 + fr * 16) = vr[s & 1][i]; }
            const int kl1 = 4 * g + q4, kl2 = 16 + 4 * g + q4;
#pragma unroll
            for (int dt = 0; dt < 8; ++dt) {
                const int c = 2 * dt + (p4 >> 1);
                const s16x4 lo = __builtin_amdgcn_ds_read_tr16_b64_v4i16((LAS s16x4*)(vb + kl1 * 256 + ((c ^ ((kl1 & 7) << 1)) * 16) + (p4 & 1) * 8));
                const s16x4 hi = __builtin_amdgcn_ds_read_tr16_b64_v4i16((LAS s16x4*)(vb + kl2 * 256 + ((c ^ ((kl2 & 7) << 1)) * 16) + (p4 & 1) * 8));
                const bf16x8 af = (bf16x8){lo[0], lo[1], lo[2], lo[3], hi[0], hi[1], hi[2], hi[3]};
                o[dt] = __builtin_amdgcn_mfma_f32_16x16x32_bf16(af, pf[s], o[dt], 0, 0, 0);
            }
        }
#undef ATT_VLOAD
        if (fr < 8) {
#pragma unroll
            for (int dt = 0; dt < 8; ++dt) { u32x2 w; w.x = cvt_pk_bf16(o[dt][0] * inv, o[dt][1] * inv); w.y = cvt_pk_bf16(o[dt][2] * inv, o[dt][3] * inv);
                *(u32x2*)(ao + (size_t)n * 1024 + fr * 128 + dt * 16 + g * 4) = w; }
        }
    }
}

__device__ __forceinline__ int idx_bin(float s, float lo, float scale) { int b = (int)((s - lo) * scale); b = b < 0 ? 0 : b; return b > 255 ? 255 : b; }
__device__ __forceinline__ unsigned ord_key(float s) { const unsigned u = __float_as_uint(s); return (u & 0x80000000u) ? ~u : (u | 0x80000000u); }
__device__ __forceinline__ float ord_val(unsigned k) { return __uint_as_float((k & 0x80000000u) ? (k & 0x7fffffffu) : ~k); }
__device__ __forceinline__ void phase_index2(const Params& p, LAS unsigned char* lds, int bid, int nb) {
    const int tid = opaque_tid(), wid = __builtin_amdgcn_readfirstlane(tid >> 6), lane0 = tid & 63;
    unsigned char* ws = p.ws;
    const bf16_t* iqr = (const bf16_t*)(ws + OFF_IQR); const bf16_t* ikr = (const bf16_t*)(ws + OFF_IKR); const float* iw = (const float*)(ws + OFF_IW);
    const bf16_t* qr = (const bf16_t*)(ws + OFF_BUF64); const bf16_t* kr = (const bf16_t*)(ws + OFF_KR); const bf16_t* vv = (const bf16_t*)(ws + OFF_VV); bf16_t* ao = (bf16_t*)(ws + OFF_PD);
    LAS unsigned short* out = (LAS unsigned short*)(lds + 131072 + 24576) + wid * 256;
    LAS float* sc = (LAS float*)lds;
    LAS int* hist = (LAS int*)(lds + 131072) + wid * 256;
    LAS float* candv = (LAS float*)(lds + 131072 + 8192) + wid * 264;
    LAS unsigned short* candi = (LAS unsigned short*)(lds + 131072 + 8192 + 8 * 264 * 4) + wid * 256;
    LAS unsigned* mm = (LAS unsigned*)(lds + 131072 + 8192 + 8 * 264 * 4 + 8 * 512);
    const int ntile = NTOK / 8;
    PROBE_DECL;
    PROBE_BEGIN(9);
    unsigned* tctr = (unsigned*)(ws + OFF_MISC + MISC_PCTR) + 16;
    LAS int* tsh = (LAS int*)(lds + LDS_BYTES - 1536);
    for (;;) {
        __syncthreads();
        if (tid == 0) tsh[0] = (int)__hip_atomic_fetch_add(tctr, 1u, __ATOMIC_RELAXED, __HIP_MEMORY_SCOPE_AGENT);
        __syncthreads();
        const int it = __builtin_amdgcn_readfirstlane(tsh[0]);
        if (it >= ntile) break;
        const int qt = (it & 7) * 512 + (511 - (it >> 3));
        const int n0 = qt * 8, t0 = n0 & (SEQ - 1), b = n0 >> 12;
        int lane = lane0; asm volatile("" : "+v"(lane));
        const int fr = lane & 15, g = lane >> 4; const unsigned long long lt_mask = (1ull << lane) - 1ull;
        asm volatile("" ::: "memory");
        if (tid < 16) mm[tid] = (tid & 1) ? 0u : 0xffffffffu;
        __syncthreads();
        PROBE_BEGIN(1);
#pragma unroll 1
        for (int genrep = 0; genrep < (IDXPROBE == 1 ? 2 : 1); ++genrep)
        if (t0 + 8 > 256) {
            bf16x8 af[2][2];
#pragma unroll
            for (int hh = 0; hh < 2; ++hh)
#pragma unroll
                for (int s = 0; s < 2; ++s) af[hh][s] = *(const bf16x8*)(iqr + (size_t)(n0 + 2 * (fr >> 2) + ((fr >> 1) & 1)) * 256 + (2 * hh + (fr & 1)) * 64 + s * 32 + g * 8);
            const f32x4 wq0 = *(const f32x4*)(iw + (size_t)(n0 + 2 * g) * 4), wq1 = *(const f32x4*)(iw + (size_t)(n0 + 2 * g + 1) * 4);
            float vmin0 = INFINITY, vmax0 = -INFINITY, vmin1 = INFINITY, vmax1 = -INFINITY;
            const int nkt = (t0 + 8 + 15) >> 4;
            const bf16_t* kb = ikr + (size_t)b * SEQ * 64;
            bf16x8 pb0[3], pb1[3];
#pragma unroll
            for (int i = 0; i < 2; ++i) { const int ktp = wid + 8 * i < nkt ? wid + 8 * i : wid; const bf16_t* kp = kb + (size_t)(ktp * 16 + fr) * 64 + g * 8; pb0[i] = *(const bf16x8*)kp; pb1[i] = *(const bf16x8*)(kp + 32); }
            for (int kt = wid; kt < nkt; kt += 8) {
                { const int ktp = kt + 16 < nkt ? kt + 16 : kt; const bf16_t* kp = kb + (size_t)(ktp * 16 + fr) * 64 + g * 8; pb0[2] = *(const bf16x8*)kp; pb1[2] = *(const bf16x8*)(kp + 32); }
                const bf16x8 b0 = pb0[0], b1 = pb1[0];
                pb0[0] = pb0[1]; pb1[0] = pb1[1]; pb0[1] = pb0[2]; pb1[1] = pb1[2];
                f32x4 d0 = fzero4(), d1 = fzero4();
                d0 = __builtin_amdgcn_mfma_f32_16x16x32_bf16(af[0][0], b0, d0, 0, 0, 0); d0 = __builtin_amdgcn_mfma_f32_16x16x32_bf16(af[0][1], b1, d0, 0, 0, 0);
                d1 = __builtin_amdgcn_mfma_f32_16x16x32_bf16(af[1][0], b0, d1, 0, 0, 0); d1 = __builtin_amdgcn_mfma_f32_16x16x32_bf16(af[1][1], b1, d1, 0, 0, 0);
                float s0 = fmaxf(d0[0], 0.f) * wq0[0] + fmaxf(d0[1], 0.f) * wq0[1] + fmaxf(d1[0], 0.f) * wq0[2] + fmaxf(d1[1], 0.f) * wq0[3];
                float s1 = fmaxf(d0[2], 0.f) * wq1[0] + fmaxf(d0[3], 0.f) * wq1[1] + fmaxf(d1[2], 0.f) * wq1[2] + fmaxf(d1[3], 0.f) * wq1[3];
                s0 += 0.0f; s1 += 0.0f;
                vmin0 = fminf(vmin0, s0); vmax0 = fmaxf(vmax0, s0); vmin1 = fminf(vmin1, s1); vmax1 = fmaxf(vmax1, s1);
                sc[(2 * g) * 4096 + kt * 16 + fr] = s0; sc[(2 * g + 1) * 4096 + kt * 16 + fr] = s1;
            }
#pragma unroll
            for (int j = 0; j < 2; ++j) { float mn = j ? vmin1 : vmin0, mx = j ? vmax1 : vmax0;
                mn = fminf(mn, dppf<0xB1>(mn)); mn = fminf(mn, dppf<0x4E>(mn)); mn = fminf(mn, dppf<0x141>(mn)); mn = fminf(mn, dppf<0x140>(mn));
                mx = fmaxf(mx, dppf<0xB1>(mx)); mx = fmaxf(mx, dppf<0x4E>(mx)); mx = fmaxf(mx, dppf<0x141>(mx)); mx = fmaxf(mx, dppf<0x140>(mx));
                if (fr == 0 && mx >= mn) { const int q = 2 * g + j;
                    __hip_atomic_fetch_min(mm + q * 2, ord_key(mn), __ATOMIC_RELAXED, __HIP_MEMORY_SCOPE_WORKGROUP); __hip_atomic_fetch_max(mm + q * 2 + 1, ord_key(mx), __ATOMIC_RELAXED, __HIP_MEMORY_SCOPE_WORKGROUP); } }
        }
        PROBE_END(1);
        PROBE_BEGIN(2);
        __syncthreads();
        PROBE_END(2);
        PROBE_BEGIN(7);
#pragma unroll 1
        for (int selrep = 0; selrep < (IDXPROBE == 2 ? 2 : 1); ++selrep)
        {
            const int n = n0 + wid, t = t0 + wid, nv = t + 1;
            if (nv <= 256) { for (int j = lane; j < 256; j += 64) out[j] = (unsigned short)(j < nv ? j : 0); }
            else {
                LAS const float* srow = sc + wid * 4096;
                const int nvp = (nv + 255) & ~255;
                const unsigned kmax = mm[wid * 2 + 1];
                const int kbase = (int)(kmax >> 19) - 255;
                unsigned P = 0u; int sh = 32;
                bool capped = false;
                float lo = ord_val(mm[wid * 2]), hi = ord_val(mm[wid * 2 + 1]);
                float lo1 = 0.f, sc1 = 0.f, lo2 = 0.f, sc2 = 0.f, lo3 = 0.f, sc3 = 0.f; int b1 = 0, b2 = 0, b3 = 0, nlev = 0;
                int m = nv, need = 256;
#define IDX_HIST_SCAN(bin, nneed, mmc, lumpc) do { int hb[4]; \
                    _Pragma("unroll") for (int j = 0; j < 4; ++j) hb[j] = hist[lane * 4 + j]; \
                    if (lane == 0) hb[0] += (lumpc); \
                    const int tot = hb[0] + hb[1] + hb[2] + hb[3]; int suf = tot; \
                    _Pragma("unroll") for (int off = 1; off < 64; off <<= 1) { const int v = __shfl_down(suf, off); if (lane + off < 64) suf += v; } \
                    const int above = suf - tot; const bool is = (above < need) && (need <= suf); \
                    bin = 0; nneed = 0; mmc = 0; \
                    if (is) { int c = above; \
                        _Pragma("unroll") for (int k = 3; k >= 0; --k) { if (nneed == 0) { if (need <= c + hb[k]) { bin = lane * 4 + k; nneed = need - c; mmc = hb[k]; } else c += hb[k]; } } } \
                    const unsigned long long bal = __ballot(is); const int srcl = __ffsll((long long)bal) - 1; \
                    bin = __shfl(bin, srcl); nneed = __shfl(nneed, srcl); mmc = __shfl(mmc, srcl); } while (0)
#define IDX_ZERO_HIST() do { int z = 0; asm volatile("" : "+v"(z)); _Pragma("unroll") for (int j = 0; j < 4; ++j) hist[lane * 4 + j] = z; } while (0)
                PROBE_BEGIN(3);
                {
                    IDX_ZERO_HIST();
                    int lumpl = 0;
                    for (int c0 = 0; c0 < nvp; c0 += 256) { const f32x4 s4 = *(const LAS f32x4*)(srow + c0 + lane * 4);
#pragma unroll
                        for (int e_ = 0; e_ < 4; ++e_) { const unsigned k = ord_key(s4[e_]); const int bin = (int)(k >> 19) - kbase; const bool valid = c0 + lane * 4 + e_ < nv;
                            if (valid && bin > 0) __hip_atomic_fetch_add(hist + bin, 1, __ATOMIC_RELAXED, __HIP_MEMORY_SCOPE_WORKGROUP);
                            lumpl += (valid && bin <= 0) ? 1 : 0; } }
                    int lump = lumpl;
#pragma unroll
                    for (int o = 32; o > 0; o >>= 1) lump += __shfl_xor(lump, o);
                    int bin, nneed, mmc; IDX_HIST_SCAN(bin, nneed, mmc, lump);
                    need = nneed; m = mmc;
                    if (bin > 0) { P = (unsigned)(kbase + bin); sh = 19; }
                    else { capped = true; hi = ord_val(((unsigned)(kbase + 1) << 19) - 1u); if (hi < lo) hi = lo; }
                }
                PROBE_END(3);
                PROBE_BEGIN(4);
#pragma unroll 1
                while (!capped && m > 128 && sh > 0) {
                    const int nsh = sh > 8 ? sh - 8 : 0; const unsigned dmask = (1u << (sh - nsh)) - 1u;
                    IDX_ZERO_HIST();
                    for (int c0 = 0; c0 < nvp; c0 += 256) { const f32x4 s4 = *(const LAS f32x4*)(srow + c0 + lane * 4);
#pragma unroll
                        for (int e_ = 0; e_ < 4; ++e_) { const unsigned k = ord_key(s4[e_]);
                            if (c0 + lane * 4 + e_ < nv && (k >> sh) == P) __hip_atomic_fetch_add(hist + ((k >> nsh) & dmask), 1, __ATOMIC_RELAXED, __HIP_MEMORY_SCOPE_WORKGROUP); } }
                    int bin, nneed, mmc; IDX_HIST_SCAN(bin, nneed, mmc, 0);
                    P = (P << (sh - nsh)) | (unsigned)bin; sh = nsh; need = nneed; m = mmc;
                }
#define IDX_CLASSIFY(s, cls) do { \
                    if (!capped) { const unsigned kk_ = sh >= 32 ? 0u : (ord_key(s) >> sh); cls = kk_ > P ? 2 : (kk_ == P ? 1 : 0); } \
                    else if ((int)(ord_key(s) >> 19) > kbase) cls = 2; \
                    else { cls = 1; \
                        if (nlev >= 1) { const int bb = idx_bin(s, lo1, sc1); if (bb != b1) cls = bb > b1 ? 2 : 0; } \
                        if (cls == 1 && nlev >= 2) { const int bb = idx_bin(s, lo2, sc2); if (bb != b2) cls = bb > b2 ? 2 : 0; } \
                        if (cls == 1 && nlev >= 3) { const int bb = idx_bin(s, lo3, sc3); if (bb != b3) cls = bb > b3 ? 2 : 0; } } } while (0)
#pragma unroll 1
                while (capped && m > 128 && nlev < 3 && (hi - lo) > 1e-30f) {
                    const float width = hi - lo, scale = 256.0f / width;
                    IDX_ZERO_HIST();
                    for (int c0 = 0; c0 < nvp; c0 += 256) { const f32x4 s4 = *(const LAS f32x4*)(srow + c0 + lane * 4);
#pragma unroll
                        for (int e_ = 0; e_ < 4; ++e_) { const float s = s4[e_]; int cls; IDX_CLASSIFY(s, cls);
                            if (c0 + lane * 4 + e_ < nv && cls == 1) __hip_atomic_fetch_add(hist + idx_bin(s, lo, scale), 1, __ATOMIC_RELAXED, __HIP_MEMORY_SCOPE_WORKGROUP); } }
                    int bin, nneed, mmc; IDX_HIST_SCAN(bin, nneed, mmc, 0);
                    if (nlev == 0) { lo1 = lo; sc1 = scale; b1 = bin; } else if (nlev == 1) { lo2 = lo; sc2 = scale; b2 = bin; } else { lo3 = lo; sc3 = scale; b3 = bin; }
                    ++nlev; need = nneed; m = mmc;
                    const float w = width * (1.0f / 256.0f); lo = lo + (float)bin * w; hi = lo + w;
                }
#undef IDX_HIST_SCAN
#undef IDX_ZERO_HIST
                PROBE_END(4);
                PROBE_BEGIN(5);
                int base = 0, nc = 0;
                for (int c0 = 0; c0 < nvp; c0 += 256) { const f32x4 s4 = *(const LAS f32x4*)(srow + c0 + lane * 4);
                    bool su[4], ca[4]; int nsu = 0, nca = 0;
#pragma unroll
                    for (int e_ = 0; e_ < 4; ++e_) { const bool valid = c0 + lane * 4 + e_ < nv; int cls; IDX_CLASSIFY(s4[e_], cls); su[e_] = valid && cls == 2; ca[e_] = valid && cls == 1; nsu += su[e_] ? 1 : 0; nca += ca[e_] ? 1 : 0; }
                    unsigned long long bs4[4], bc4[4]; int ps = base, pc = nc, tots = 0, totc = 0;
#pragma unroll
                    for (int e_ = 0; e_ < 4; ++e_) { bs4[e_] = __ballot(su[e_]); bc4[e_] = __ballot(ca[e_]); ps += __popcll(bs4[e_] & lt_mask); pc += __popcll(bc4[e_] & lt_mask); tots += __popcll(bs4[e_]); totc += __popcll(bc4[e_]); }
#pragma unroll
                    for (int e_ = 0; e_ < 4; ++e_) { const int key = c0 + lane * 4 + e_;
                        if (su[e_]) { if (ps < 256) out[ps] = (unsigned short)key; ++ps; }
                        if (ca[e_]) { if (pc < 256) { candv[pc] = s4[e_]; candi[pc] = (unsigned short)key; } ++pc; } }
                    base += tots; nc += totc; }
#undef IDX_CLASSIFY
                PROBE_END(5);
                PROBE_BEGIN(6);
                const int mcap = nc < 256 ? nc : 256;
                float T = -INFINITY; int need_t = need;
                if (nc <= 256) {
                    float mine[4]; int cgt[4], cge[4];
#pragma unroll
                    for (int k = 0; k < 4; ++k) { mine[k] = (lane + 64 * k) < mcap ? candv[lane + 64 * k] : -INFINITY; cgt[k] = 0; cge[k] = 0; }
                    if (lane < 4 && mcap + lane < 260) candv[mcap + lane] = -INFINITY;
                    const int nk = (mcap + 63) >> 6;
                    for (int j = 0; j < mcap; j += 4) { const f32x4 vj = *(const LAS f32x4*)(candv + j);
#pragma unroll
                        for (int k = 0; k < 4; ++k) { if (k < nk) {
#pragma unroll
                            for (int e_ = 0; e_ < 4; ++e_) { cgt[k] += vj[e_] > mine[k] ? 1 : 0; cge[k] += vj[e_] >= mine[k] ? 1 : 0; } } } }
                    float tv = -INFINITY; int tg = 0; bool isT = false;
#pragma unroll
                    for (int k = 0; k < 4; ++k) { const bool ok = ((lane + 64 * k) < mcap) && (cgt[k] < need) && (need <= cge[k]); if (ok && !isT) { isT = true; tv = mine[k]; tg = cgt[k]; } }
                    const unsigned long long bT = __ballot(isT);
                    const int sl = __ffsll((long long)bT) - 1;
                    T = __shfl(tv, sl); need_t = need - __shfl(tg, sl);
                }
                int ties = 0;
                for (int c0 = 0; c0 < mcap; c0 += 64) { const int j = c0 + lane; const bool valid = j < mcap; const float s = valid ? candv[j] : -INFINITY;
                    const bool sure = valid && (nc <= 256) && s > T;
                    const bool tie = valid && ((nc <= 256) ? (s == T) : true);
                    const unsigned long long beq = __ballot(tie);
                    const int rank = ties + __popcll(beq & lt_mask);
                    const bool take = sure || (tie && rank < need_t);
                    const unsigned long long bt = __ballot(take);
                    const int pos = base + __popcll(bt & lt_mask);
                    if (take && pos < 256) out[pos] = candi[j];
                    base += __popcll(bt); ties += __popcll(beq); }
                PROBE_END(6);
            }
            PROBE_BEGIN(11);
            attn_query(qr, kr, vv, ao, n, out, (LAS unsigned char*)(sc + wid * 4096), lane);
            PROBE_END(11);
        }
        PROBE_END(7);
        PROBE_BEGIN(8);
        __syncthreads();
        PROBE_END(8);
    }
    PROBE_END(9);
    PROBE_STORE(ws, bid, tid);
}


__device__ __forceinline__ void phase_inproj_even(const Params& p, LAS unsigned char* lds, int bid, int nb) {
    unsigned char* ws = p.ws;
    pg::DenseSched S; S.init(ws + OFF_BUF64, ws + OFF_WINE, NTOK, NE_MAIN, 1024, nb, bid);
    pg::EpiBf16 E; E.O = (bf16_t*)(ws + OFF_P); E.ldc = NE_MAIN;
    pg::gemm_phase(lds, 1024, S, E);
}
__device__ __forceinline__ void phase_inproj_odd(const Params& p, LAS unsigned char* lds, int bid, int nb) {
    unsigned char* ws = p.ws;
    pg::DenseSched S; S.init(ws + OFF_BUF64, ws + OFF_WINO, NTOK, NO_MAIN, 1024, nb, bid);
    pg::EpiBf16 E; E.O = (bf16_t*)(ws + OFF_PD); E.ldc = NO_MAIN;
    pg::gemm_phase(lds, 1024, S, E);
}
__device__ __forceinline__ void phase_outproj(const Params& p, LAS unsigned char* lds, int bid, int nb, size_t aoff, size_t woff, const float* X) {
    unsigned char* ws = p.ws;
    pg::DenseSched S; S.init(ws + aoff, ws + woff, NTOK, 1024, 1024, nb, bid);
    pg::EpiResid E; E.X = X; E.U = (float*)(ws + OFF_U);
    pg::gemm_phase(lds, 1024, S, E);
}

#define XB_TMO      128
#define XB_XCNT(j)  (256  + 64 * (j))
#define XB_XSUB(j)  (1280 + 64 * (j))
#define XB_XGEN(j)  (2304 + 64 * (j))
#define XB_TOP      3328
#define XB_TOPGEN   3392
#define XCD_BAR_WORDS 3456
#define XB_SPIN_CAP (1u << 20)
__device__ __forceinline__ unsigned xb_ld(unsigned* p)              { return __hip_atomic_load(p, __ATOMIC_RELAXED, __HIP_MEMORY_SCOPE_AGENT); }
__device__ __forceinline__ unsigned xb_add(unsigned* p, unsigned v) { return __hip_atomic_fetch_add(p, v, __ATOMIC_RELAXED, __HIP_MEMORY_SCOPE_AGENT); }
__device__ __forceinline__ unsigned xb_xcc_id() { return (unsigned)__builtin_amdgcn_s_getreg((3 << 11) | 20) & 0xFu; }
#define XB_SPIN(cond, bar) do { unsigned _sp = 0; while (cond) { __builtin_amdgcn_s_sleep(1); \
    if ((++_sp & 255u) == 0u) { if (xb_ld(&(bar)[XB_TMO])) break; if (_sp > XB_SPIN_CAP) { atomicAdd(&(bar)[XB_TMO], 1u); break; } } } } while (0)
__device__ __forceinline__ void xcd_barrier_complete(unsigned* bar, unsigned x, unsigned& nloc, unsigned& nx) {
    const unsigned G = gridDim.x;
    unsigned sum, cnt, mine, sp = 0u;
    for (;;) {
        sum = 0u; cnt = 0u; mine = 0u;
#pragma unroll
        for (unsigned j = 0; j < 16; ++j) { const unsigned c = xb_ld(&bar[XB_XCNT(j)]); sum += c; cnt += (c > 0u) ? 1u : 0u; mine = (j == x) ? c : mine; }
        if (sum == G) break;
        __builtin_amdgcn_s_sleep(1);
        if ((++sp & 255u) == 0u) { if (xb_ld(&bar[XB_TMO])) break; if (sp > XB_SPIN_CAP) { atomicAdd(&bar[XB_TMO], 1u); break; } }
    }
    nloc = mine > 0u ? mine : 1u; nx = cnt > 0u ? cnt : 1u;
}
__device__ __forceinline__ void grid_barrier(unsigned* bar, volatile LAS unsigned* st) {
    asm volatile("s_waitcnt vmcnt(0) lgkmcnt(0)" ::: "memory");
    __syncthreads();
    if (threadIdx.x == 0) {
        const unsigned x = xb_xcc_id();
        __builtin_amdgcn_s_waitcnt(0);
        unsigned nloc = st[0], nx = st[1];
        if (nloc == 0u) { xcd_barrier_complete(bar, x, nloc, nx); st[0] = nloc; st[1] = nx; }
        const unsigned old = xb_add(&bar[XB_XSUB(x)], 1u);
        const unsigned gen = old / nloc;
        if (old + 1u == (gen + 1u) * nloc) {
            __builtin_amdgcn_fence(__ATOMIC_RELEASE, "agent");
            asm volatile("s_waitcnt vmcnt(0)" ::: "memory");
            const unsigned og = xb_add(&bar[XB_TOP], 1u);
            const unsigned tg = og / nx;
            if (og + 1u == (tg + 1u) * nx) xb_add(&bar[XB_TOPGEN], 1u);
            else XB_SPIN(xb_ld(&bar[XB_TOPGEN]) == tg, bar);
            __builtin_amdgcn_fence(__ATOMIC_ACQUIRE, "agent");
            xb_add(&bar[XB_XGEN(x)], 1u);
            asm volatile("s_waitcnt vmcnt(0)" ::: "memory");
        } else {
            XB_SPIN(xb_ld(&bar[XB_XGEN(x)]) == gen, bar);
            __builtin_amdgcn_fence(__ATOMIC_ACQUIRE, "agent");
            asm volatile("s_waitcnt vmcnt(0)" ::: "memory");
        }
    }
    __syncthreads();
}
#ifndef DUP
#define DUP 0
#endif
#define GSYNC() grid_barrier(bar_ctr, (volatile LAS unsigned*)(lds + LDS_BYTES - 1024))
__global__ __launch_bounds__(512, 2) void mega(KArgs a) {
    extern __shared__ __attribute__((aligned(16))) unsigned char smem[];
    LAS unsigned char* lds = (LAS unsigned char*)smem;
    Params p; p.in.t = (LAS const unsigned long long*)(lds + PTAB_OFF); p.out = a.out; p.ws = a.ws;
    if ((threadIdx.x & 63) == 0) ((LAS int*)(lds + WTAB_OFF))[hw_slot()] = threadIdx.x >> 6;
    if (threadIdx.x == 0) { LAS unsigned long long* tw_ = (LAS unsigned long long*)(lds + PTAB_OFF);
#pragma unroll
        for (int i = 0; i < 30; ++i) tw_[i] = (unsigned long long)a.in[i]; }
    __syncthreads();
    cg::grid_group grid = cg::this_grid();
    const int bid0 = blockIdx.x, nb0 = gridDim.x;
    unsigned* bar_ctr = (unsigned*)(p.ws + OFF_MISC + MISC_BAR);
    if (blockIdx.x == 0) for (int i = threadIdx.x; i < XCD_BAR_WORDS; i += 512) __hip_atomic_store(bar_ctr + i, 0u, __ATOMIC_RELAXED, __HIP_MEMORY_SCOPE_AGENT);
    if (threadIdx.x < 2) ((LAS unsigned*)(lds + LDS_BYTES - 1024))[threadIdx.x] = 0u;
    grid.sync();
    if (threadIdx.x == 0) (void)xb_add(&bar_ctr[XB_XCNT(xb_xcc_id())], 1u);
    int bid, nb;
#define FRESH() do { bid = bid0; nb = nb0; asm volatile("" : "+s"(bid), "+s"(nb)); } while (0)
#define PHP(pid, call) do { unsigned long long t0_ = 0; if (PROBE_ID == (pid)) t0_ = __builtin_amdgcn_s_memtime(); call; if (PROBE_ID == (pid) && bid0 == (PROBE_BLK) && opaque_tid() == 0) *(float*)(p.ws + OFF_MISC + MISC_PROBE) = (float)(__builtin_amdgcn_s_memtime() - t0_) * 1.5e-8f; } while (0)
#define RUNP(id, call) do { unsigned long long ts_ = 0; if (PROBE_ID == 200 + (id)) ts_ = __builtin_amdgcn_s_memtime(); FRESH(); call; GSYNC(); if (PROBE_ID == 200 + (id) && bid0 == 7 && opaque_tid() == 0) *(float*)(p.ws + OFF_MISC + MISC_PROBE) = (float)(__builtin_amdgcn_s_memtime() - ts_) * 1.5e-8f; if (DUP == id) { FRESH(); call; GSYNC(); } } while (0)
    RUNP(10, PHP(30, phase_prep(p, lds, bid, nb, 0)));
#if PROBE_ID == 20
    const unsigned long long kstart = __builtin_amdgcn_s_memtime();
#endif
#pragma unroll 1
    for (int layer = 0; layer < 2; ++layer) {
        if (layer == 0) {
            RUNP(31, PHP(31, phase_inproj_even(p, lds, bid, nb)));
            RUNP(21, PHP(44, phase_lora_act(p, bid, nb)));
            PHP(45, RUNP(1, PHP(33, phase_mixer_even(p, lds, bid, nb, 0))));
            FRESH(); PHP(34, phase_rwkv_epi(p, bid, nb));
            RUNP(13, PHP(46, phase_gla_fix(p, lds, bid, nb)));
        } else {
            RUNP(14, PHP(40, phase_inproj_odd(p, lds, bid, nb)));
            RUNP(15, PHP(41, phase_rope(p, bid, nb)));
            RUNP(2, PHP(43, phase_index2(p, lds, bid, nb)));
        }
        RUNP(16, PHP(35, phase_outproj(p, lds, bid, nb, layer ? OFF_PD : OFF_BUF64, layer ? OFF_WOUTO : OFF_WOUTE, layer ? p.out : p.in[I_X])));
        RUNP(36, PHP(36, phase_ln_route(p, lds, bid, nb, layer)));
        RUNP(17, PHP(37, phase_moe_gateup(p, lds, bid, nb, layer)));
        RUNP(18, PHP(38, phase_moe_down(p, lds, bid, nb, layer)));
#if PROBE_ID == 20
        if (layer == 1) { if (bid0 == 7 && threadIdx.x == 0) *(float*)(p.ws + OFF_MISC + MISC_PROBE) = (float)(__builtin_amdgcn_s_memtime() - kstart) * 1e-8f; GSYNC(); }
#endif
        RUNP(19, PHP(39, phase_ln2(p, bid, nb, layer, p.out, true)));
    }
}

extern "C" void kernel_launch(void* const* d_in, const int* in_sizes, int n_in, void* d_out, int out_size, void* d_ws, size_t ws_size, hipStream_t stream) {
    if (ws_size < WS_NEED) { fprintf(stderr, "workspace too small: %zu < %zu\n", ws_size, (size_t)WS_NEED); return; }
    KArgs p{};
    for (int i = 0; i < 30; ++i) p.in[i] = (const float*)d_in[i];
    p.out = (float*)d_out; p.ws = (unsigned char*)d_ws;
    static int grid_blocks = 0;
    if (!grid_blocks) {
        (void)hipFuncSetAttribute((const void*)mega, hipFuncAttributeMaxDynamicSharedMemorySize, LDS_BYTES);
        int dev = 0, cus = 0, per_cu = 0;
        (void)hipGetDevice(&dev);
        (void)hipDeviceGetAttribute(&cus, hipDeviceAttributeMultiprocessorCount, dev);
        (void)hipOccupancyMaxActiveBlocksPerMultiprocessor(&per_cu, mega, 512, LDS_BYTES);
        if (per_cu < 1) { fprintf(stderr, "occupancy query returned %d\n", per_cu); per_cu = 1; }
        grid_blocks = cus;
    }
    void* args[] = {&p};
    hipError_t e = hipLaunchCooperativeKernel((void*)mega, dim3(grid_blocks), dim3(512), args, LDS_BYTES, stream);
    if (e != hipSuccess) fprintf(stderr, "cooperative launch failed: %s (grid %d)\n", hipGetErrorString(e), grid_blocks);
}
```

```cpp
#include <hip/hip_runtime.h>
#include <hip/hip_cooperative_groups.h>
#include <cstdio>
#include <cstdint>
namespace cg = cooperative_groups;

#ifndef PROBE_ID
#define PROBE_ID 0
#endif
#ifndef PROBE_BLK
#define PROBE_BLK 7
#endif
#ifndef IDXPROBE
#define IDXPROBE 0
#endif
#ifndef SANITIZE
#define SANITIZE 0
#endif
#ifndef PREP_REP
#define PREP_REP 1
#endif
constexpr int NTOK = 32768, SEQ = 4096, NB = 8, DM = 1024;
constexpr int EVEN_COLS = 3344, ODD_COLS = 1604;
constexpr int NE_MAIN = 3328;
constexpr int NO_MAIN = 1792;
constexpr int NEXP = 16, DEXP = 256;
constexpr float DN_ALPHA = 1.4142135623730951f;
constexpr float LN_EPS = 1e-5f;
constexpr int MOE_ROWS = 65536 + 16 * 256;

typedef unsigned short bf16_t;
typedef short bf16x8 __attribute__((ext_vector_type(8)));
typedef float f32x4 __attribute__((ext_vector_type(4)));
typedef short s16x4 __attribute__((ext_vector_type(4)));
typedef float f32x2 __attribute__((ext_vector_type(2)));
typedef unsigned u32x4 __attribute__((ext_vector_type(4)));
typedef unsigned u32x2 __attribute__((ext_vector_type(2)));
#define LAS __attribute__((address_space(3)))

typedef __bf16 bf16x2_t __attribute__((ext_vector_type(2)));
__device__ __forceinline__ unsigned cvt_pk_bf16(float lo, float hi) { bf16x2_t v; v[0] = (__bf16)lo; v[1] = (__bf16)hi; return __builtin_bit_cast(unsigned, v); }
__device__ __forceinline__ bf16_t f2bf(float f) { return (bf16_t)(cvt_pk_bf16(f, 0.f) & 0xffffu); }
__device__ __forceinline__ float bf2f(bf16_t h) { return __uint_as_float(((unsigned)h) << 16); }
constexpr int LDS_BYTES = 160 * 1024;
constexpr int PTAB_OFF = LDS_BYTES - 256;
constexpr int WTAB_OFF = LDS_BYTES - 512;
__device__ __forceinline__ int hw_slot() { return (int)(__builtin_amdgcn_s_getreg(0x2804) & 63u); }
__device__ __forceinline__ int opaque_tid() {
    extern __shared__ __attribute__((aligned(16))) unsigned char smem_[];
    const int w = __builtin_amdgcn_readfirstlane(((LAS const int*)((LAS unsigned char*)smem_ + WTAB_OFF))[hw_slot()]);
    int l; asm volatile("v_mbcnt_lo_u32_b32 %0, -1, 0\n\tv_mbcnt_hi_u32_b32 %0, -1, %0" : "=v"(l));
    return (w << 6) | l; }
#if PROBE_ID
#define PROBE_DECL unsigned long long probe_acc = 0, probe_t0 = 0
#define PROBE_PARAMS , unsigned long long& probe_acc, unsigned long long& probe_t0
#define PROBE_PASS , probe_acc, probe_t0
#define PROBE_BEGIN(id) do { if (PROBE_ID == (id)) probe_t0 = __builtin_amdgcn_s_memtime(); } while (0)
#define PROBE_END(id) do { if (PROBE_ID == (id)) probe_acc += __builtin_amdgcn_s_memtime() - probe_t0; } while (0)
#define PROBE_STORE(ws, bid, tid) do { if (PROBE_ID < 30 && (bid) == 7 && (tid) == 0) *(float*)((ws) + OFF_MISC + MISC_PROBE) = (float)probe_acc * 2e-8f; } while (0)
#else
#define PROBE_DECL
#define PROBE_PARAMS
#define PROBE_PASS
#define PROBE_BEGIN(id)
#define PROBE_END(id)
#define PROBE_STORE(ws, bid, tid)
#endif
__device__ __forceinline__ f32x4 fzero4() { float z = 0.f; asm volatile("" : "+v"(z)); return (f32x4){z, z, z, z}; }
__device__ __forceinline__ u32x4 uzero4() { unsigned z = 0u; asm volatile("" : "+v"(z)); return (u32x4){z, z, z, z}; }
__device__ __forceinline__ float fast_rcp(float x) { return __builtin_amdgcn_rcpf(x); }
__device__ __forceinline__ float fast_sigmoid(float x) { return fast_rcp(1.0f + __expf(-x)); }
__device__ __forceinline__ float fast_tanh(float x) { const float e = __expf(2.0f * x); return 1.0f - 2.0f * fast_rcp(1.0f + e); }
__device__ __forceinline__ bf16x8 pack_8g(const f32x4 a, const f32x4 b) { u32x4 w; w.x = cvt_pk_bf16(a[0], a[1]); w.y = cvt_pk_bf16(a[2], a[3]); w.z = cvt_pk_bf16(b[0], b[1]); w.w = cvt_pk_bf16(b[2], b[3]); return __builtin_bit_cast(bf16x8, w); }
template <int CTRL> __device__ __forceinline__ float dppf(float v) { return __builtin_bit_cast(float, __builtin_amdgcn_update_dpp(0, __builtin_bit_cast(int, v), CTRL, 0xf, 0xf, true)); }
__device__ __forceinline__ float wave_sum(float v) {
#pragma unroll
    for (int o = 32; o > 0; o >>= 1) v += __shfl_xor(v, o);
    return v;
}

constexpr size_t MiB = 1024ull * 1024ull;
constexpr size_t OFF_WINE = 0;
constexpr size_t OFF_WOUTE = OFF_WINE + (size_t)NE_MAIN * 1024 * 2;
constexpr size_t OFF_WINO = OFF_WOUTE + 2 * MiB;
constexpr size_t OFF_WOUTO = OFF_WINO + (size_t)NO_MAIN * 1024 * 2;
constexpr size_t OFF_WGU = OFF_WOUTO + 2 * MiB;
constexpr size_t OFF_WD = OFF_WGU + 32 * MiB;
constexpr size_t OFF_ROPE = OFF_WD + 16 * MiB;
constexpr size_t OFF_MISC = OFF_ROPE + 3 * MiB;
constexpr size_t OFF_BUF64 = OFF_MISC + 4 * MiB;
constexpr size_t OFF_P = OFF_BUF64 + 64 * MiB;
constexpr size_t OFF_U = OFF_P + 208 * MiB;
constexpr size_t WS_NEED = OFF_U + 128 * MiB;
constexpr size_t OFF_HE = OFF_P;
constexpr size_t OFF_ACT = OFF_HE + (size_t)MOE_ROWS * 1024 * 2;
constexpr size_t OFF_PD = OFF_P;
constexpr size_t OFF_KR = OFF_P + 112 * MiB;
constexpr size_t OFF_VV = OFF_KR + 8 * MiB;
constexpr size_t OFF_IQR = OFF_VV + 8 * MiB;
constexpr size_t OFF_IKR = OFF_IQR + 16 * MiB;
constexpr size_t OFF_IW = OFF_IKR + 4 * MiB;
constexpr size_t OFF_IDX = OFF_IW + 1 * MiB;
constexpr size_t MISC_CNT = 0;
constexpr size_t MISC_TOKINFO = 4096;
constexpr size_t MISC_TOKGATE = MISC_TOKINFO + (size_t)NTOK * 16;
constexpr size_t MISC_LIST = MISC_TOKGATE + (size_t)NTOK * 8;
constexpr size_t MISC_PROBE = 2304;
constexpr size_t MISC_W2T = 3 * MiB;
constexpr size_t MISC_A2T = MISC_W2T + 65536;
constexpr size_t MISC_G2T = MISC_A2T + 65536;
constexpr size_t MISC_BAR = MISC_G2T + 131072;
constexpr size_t MISC_RWF = MISC_BAR + 16384;
constexpr size_t MISC_PCTR = MISC_RWF + 16384;
constexpr size_t OFF_GLA_ORAW = OFF_U + 50 * MiB;
constexpr size_t OFF_GLA_QDG = OFF_U + 82 * MiB;
constexpr size_t OFF_GLA_SIN = OFF_U + 90 * MiB;
constexpr size_t OFF_RWXB = OFF_U + 24 * MiB;

struct InTab { LAS const unsigned long long* t;
    __device__ __forceinline__ const float* operator[](int i) const { const unsigned long long v = t[i];
        const unsigned lo = __builtin_amdgcn_readfirstlane((unsigned)v), hi = __builtin_amdgcn_readfirstlane((unsigned)(v >> 32));
        return (const float*)(((unsigned long long)hi << 32) | lo); } };
struct Params { InTab in; float* out; unsigned char* ws; };
struct KArgs { const float* in[30]; float* out; unsigned char* ws; };
enum { I_X = 0, I_WINE, I_AMU, I_AW0, I_AW2, I_AA0, I_AA2, I_AG2, I_AKK, I_AKA, I_ARK, I_AGNG, I_AGNB, I_BGW2, I_BGB, I_BNG, I_WOUTE,
       I_WINO, I_CIKG, I_CIKB, I_WOUTO, I_LN1G, I_LN1B, I_LN2G, I_LN2B, I_RW, I_RB, I_EG, I_EU, I_ED };

namespace pg {
constexpr int BM = 256, BK = 64, HALF = 128, HTB = HALF * BK * 2, STAGE_BYTES = 8 * HTB;
__host__ __device__ __forceinline__ int lds_byte(int r, int c) { const int st = (r >> 4) * 2 + (c >> 5), rr = r & 15, cc = c & 31, ob = rr * 64 + cc * 2; return st * 1024 + (ob ^ (((ob >> 9) & 1) << 5)); }
__host__ __device__ __forceinline__ void stage_rc(int b, int& R, int& C) { const int st = b / 1024, sb = b % 1024, swz = sb ^ (((sb >> 9) & 1) << 5); R = (st >> 1) * 16 + swz / 64; C = (st & 1) * 32 + (swz % 64) / 2; }
__host__ __device__ __forceinline__ int perm32(int rho) { const int n = rho >> 4, i = rho & 15; return 8 * (i >> 2) + 4 * n + (i & 3); }

struct Unit { int pm, pn, e, rt, cnt; };

template <class Epi, class Sched>
__device__ __forceinline__ void gemm_phase(LAS unsigned char* lds, const int K, const Sched& S, const Epi& E) {
    const int tid = opaque_tid(), wid = __builtin_amdgcn_readfirstlane(tid >> 6), lane = tid & 63, wr = wid >> 2, wc = wid & 3, fr = lane & 15, fq = lane >> 4;
    const int nt = K / BK;
    unsigned voffB[2];
#pragma unroll
    for (int i = 0; i < 2; ++i) { int R, C; stage_rc(tid * 16 + i * 8192, R, C); const int Rb = Epi::PERM ? ((R & ~31) + perm32(R & 31)) : R; voffB[i] = (unsigned)(Rb * K + C) * 2u; }
    const size_t kstep = (size_t)(BK * 2);
    const size_t hstepB = (size_t)HALF * K * 2;
    const unsigned ldsw = (unsigned)wid * 1024u;
    const int aoff = lds_byte(wr * 64 + fr, fq * 8), boff = lds_byte(wc * 32 + fr, fq * 8);
#define PG_SA(b, h) (((b) * 2 + (h)) * HTB)
#define PG_SB(b, h) ((4 + (b) * 2 + (h)) * HTB)
#define PG_STAGE(bufoff, gbase, voff) do { _Pragma("unroll") for (int _i = 0; _i < 2; ++_i) \
        __builtin_amdgcn_global_load_lds((const unsigned*)((const char*)(gbase) + (voff)[_i]), (LAS unsigned*)(lds + (bufoff) + ldsw + _i * 8192), 16, 0, 0); } while (0)
#define PG_LDA(dst, b, h) do { _Pragma("unroll") for (int m = 0; m < 4; ++m) _Pragma("unroll") for (int k = 0; k < 2; ++k) dst[m][k] = *(const LAS bf16x8*)(lds + PG_SA(b, h) + aoff + m * 2048 + k * 1024); } while (0)
#define PG_LDB(dst, b, h) do { _Pragma("unroll") for (int n = 0; n < 2; ++n) _Pragma("unroll") for (int k = 0; k < 2; ++k) dst[n][k] = *(const LAS bf16x8*)(lds + PG_SB(b, h) + boff + n * 2048 + k * 1024); } while (0)
#define PG_MMA(ai, bj, At, Bt) do { __builtin_amdgcn_s_setprio(1); _Pragma("unroll") for (int m = 0; m < 4; ++m) _Pragma("unroll") for (int n = 0; n < 2; ++n) _Pragma("unroll") for (int k = 0; k < 2; ++k) \
        acc[ai][bj][m][n] = __builtin_amdgcn_mfma_f32_16x16x32_bf16(Bt[n][k], At[m][k], acc[ai][bj][m][n], 0, 0, 0); __builtin_amdgcn_s_setprio(0); } while (0)
#define PG_WAIT_V(n) asm volatile("s_waitcnt vmcnt(" #n ")" ::: "memory")
#define PG_WAIT_L(n) asm volatile("s_waitcnt lgkmcnt(" #n ")" ::: "memory")
#define PG_BAR __builtin_amdgcn_s_barrier()
#define PG_SCHED __builtin_amdgcn_sched_barrier(0)
#define PG_AOFF(dst0, dst1, u) do { _Pragma("unroll") for (int _i = 0; _i < 2; ++_i) { int _R, _C; stage_rc(tid * 16 + _i * 8192, _R, _C); \
        dst0[_i] = S.a_rowoff(u, 0, _R) + (unsigned)_C * 2u; dst1[_i] = S.a_rowoff(u, 1, _R) + (unsigned)_C * 2u; } } while (0)
    Unit cur, nxt; int ui = 0;
    if (!S.next(0, cur)) return;
    f32x4 acc[2][2][4][2];
#pragma unroll
    for (int a = 0; a < 2; ++a)
#pragma unroll
        for (int b = 0; b < 2; ++b)
#pragma unroll
            for (int m = 0; m < 4; ++m)
#pragma unroll
                for (int n = 0; n < 2; ++n) acc[a][b][m][n] = (f32x4){0.f, 0.f, 0.f, 0.f};
    bf16x8 At[4][2], B0[2][2], B1[2][2];
    const char* const Ab = S.a_base();
    unsigned aC0[2], aC1[2];
    PG_AOFF(aC0, aC1, cur);
    const char* cB = S.b_ptr(cur);
    PG_STAGE(PG_SB(0, 0), cB, voffB); PG_STAGE(PG_SA(0, 0), Ab, aC0); PG_STAGE(PG_SB(0, 1), cB + hstepB, voffB); PG_STAGE(PG_SA(0, 1), Ab, aC1);
    if (wr == 1) PG_BAR;
    PG_WAIT_V(4); PG_BAR;
    PG_STAGE(PG_SB(1, 0), cB + kstep, voffB); PG_STAGE(PG_SA(1, 0), Ab + kstep, aC0); PG_STAGE(PG_SB(1, 1), cB + hstepB + kstep, voffB);
    PG_WAIT_V(6); PG_BAR;
    for (;;) {
        const bool has_next = S.next(ui + 1, nxt);
        const char* nB = has_next ? S.b_ptr(nxt) : cB;
#pragma unroll 1
        for (int t = 0; t < nt; t += 2) {
            const bool last = (t == nt - 2);
            const char* a1 = Ab + (size_t)(t + 1) * kstep;
            const char* a2 = last ? Ab : Ab + (size_t)(t + 2) * kstep; const char* b2 = last ? nB : cB + (size_t)(t + 2) * kstep;
            const char* a3 = a2 + kstep; const char* b3 = b2 + kstep;
            PG_LDB(B0, 0, 0); PG_SCHED; PG_LDA(At, 0, 0); PG_STAGE(PG_SA(1, 1), a1, aC1);
            if (last && has_next) PG_AOFF(aC0, aC1, nxt);
            PG_WAIT_L(8); PG_BAR; PG_WAIT_L(0); PG_MMA(0, 0, At, B0); PG_BAR; PG_SCHED;
            PG_LDB(B1, 0, 1); PG_STAGE(PG_SB(0, 0), b2, voffB);
            PG_BAR; PG_WAIT_L(0); PG_MMA(0, 1, At, B1); PG_BAR;
            PG_LDA(At, 0, 1); PG_STAGE(PG_SA(0, 0), a2, aC0);
            PG_BAR; PG_WAIT_L(0); PG_MMA(1, 0, At, B0); PG_BAR; PG_SCHED;
            PG_STAGE(PG_SB(0, 1), b2 + hstepB, voffB);
            PG_WAIT_V(6); PG_BAR; PG_MMA(1, 1, At, B1); PG_BAR;
            PG_LDB(B0, 1, 0); PG_SCHED; PG_LDA(At, 1, 0); PG_STAGE(PG_SA(0, 1), a2, aC1);
            PG_WAIT_L(8); PG_BAR; PG_WAIT_L(0); PG_MMA(0, 0, At, B0); PG_BAR; PG_SCHED;
            PG_LDB(B1, 1, 1); PG_STAGE(PG_SB(1, 0), b3, voffB);
            PG_BAR; PG_WAIT_L(0); PG_MMA(0, 1, At, B1); PG_BAR;
            PG_LDA(At, 1, 1); PG_STAGE(PG_SA(1, 0), a3, aC0);
            PG_BAR; PG_WAIT_L(0); PG_MMA(1, 0, At, B0); PG_BAR; PG_SCHED;
            PG_STAGE(PG_SB(1, 1), b3 + hstepB, voffB);
            PG_WAIT_V(6); PG_BAR; PG_MMA(1, 1, At, B1); PG_BAR;
        }
        E(acc, cur, wr, wc, fr, fq);
        if (!has_next) break;
#pragma unroll
        for (int a = 0; a < 2; ++a)
#pragma unroll
            for (int b = 0; b < 2; ++b)
#pragma unroll
                for (int m = 0; m < 4; ++m)
#pragma unroll
                    for (int n = 0; n < 2; ++n) acc[a][b][m][n] = (f32x4){0.f, 0.f, 0.f, 0.f};
        cur = nxt; cB = nB; ++ui;
    }
    PG_WAIT_V(0);
    if (wr == 0) PG_BAR;
    PG_BAR;
#undef PG_SA
#undef PG_SB
#undef PG_STAGE
#undef PG_LDA
#undef PG_LDB
#undef PG_MMA
#undef PG_WAIT_V
#undef PG_WAIT_L
#undef PG_BAR
#undef PG_SCHED
#undef PG_AOFF
}

struct DenseSched {
    const char* A; const char* Bt; int K, nM, nN, nwg, G, c;
    __device__ void init(const void* A_, const void* Bt_, int M, int N, int K_, int G_, int c_) { A = (const char*)A_; Bt = (const char*)Bt_; K = K_; nM = M / BM; nN = N / BM; nwg = nM * nN; G = G_; c = c_; }
    __device__ __forceinline__ bool next(int i, Unit& u) const {
        const long L = (long)i * G + c; if (L >= nwg) return false;
        int wgid = (int)L; { const int q = nwg / 8, r = nwg % 8, xcd = wgid % 8, off = wgid / 8; wgid = (xcd < r ? xcd * (q + 1) : r * (q + 1) + (xcd - r) * q) + off; }
        const int nig = 8 * nN, gid = wgid / nig, fm = gid * 8, gsz = (nM - fm) < 8 ? (nM - fm) : 8;
        u.pm = fm + ((wgid % nig) % gsz); u.pn = (wgid % nig) / gsz; u.e = 0; u.rt = 0; u.cnt = 0; return true;
    }
    __device__ __forceinline__ const char* a_base() const { return A; }
    __device__ __forceinline__ unsigned a_rowoff(const Unit& u, int half, int R) const { return (unsigned)(u.pm * BM + half * HALF + R) * (unsigned)(K * 2); }
    __device__ __forceinline__ const char* b_ptr(const Unit& u) const { return Bt + (size_t)u.pn * BM * K * 2; }
};

__device__ __forceinline__ void moe_build_units(LAS int* tab, const int* cntp, int NCT, int G, int c) {
    const int i = opaque_tid();
    if (i < 16) {
        const int L = i * G + c; int accu = 0, rtb = 0, found = 0, pm = 0, pn = 0, ee = 0, rt = 0, cn = 0;
        for (int e = 0; e < 16; ++e) { const int ce = cntp[e], nte = (ce + 255) >> 8, ue = nte * NCT;
            if (!found && L < accu + ue) { const int local = L - accu; ee = e; rt = local / NCT; pn = local % NCT; pm = rtb + rt; cn = ce; found = 1; }
            accu += ue; rtb += nte; }
        tab[i * 8 + 0] = found; tab[i * 8 + 1] = pm; tab[i * 8 + 2] = pn; tab[i * 8 + 3] = ee; tab[i * 8 + 4] = rt; tab[i * 8 + 5] = cn;
    }
    __syncthreads();
}
template <bool GATHER>
struct MoeSched {
    const char* A; const char* Bt; const int* list; int K; size_t wstride; LAS int* tab;
    __device__ void init(const void* A_, const void* Bt_, size_t wstride_bytes, const int* list_, int K_, LAS int* tab_) {
        A = (const char*)A_; Bt = (const char*)Bt_; wstride = wstride_bytes; list = list_; K = K_; tab = tab_; }
    __device__ __forceinline__ bool next(int i, Unit& u) const {
        if (i >= 16) return false;
        const int f = __builtin_amdgcn_readfirstlane(tab[i * 8 + 0]);
        u.pm = __builtin_amdgcn_readfirstlane(tab[i * 8 + 1]); u.pn = __builtin_amdgcn_readfirstlane(tab[i * 8 + 2]); u.e = __builtin_amdgcn_readfirstlane(tab[i * 8 + 3]);
        u.rt = __builtin_amdgcn_readfirstlane(tab[i * 8 + 4]); u.cnt = __builtin_amdgcn_readfirstlane(tab[i * 8 + 5]);
        return f != 0;
    }
    __device__ __forceinline__ const char* a_base() const { return A; }
    __device__ __forceinline__ unsigned a_rowoff(const Unit& u, int half, int R) const {
        if (GATHER) { const int slot = u.rt * BM + half * HALF + R; const int tok = slot < u.cnt ? list[u.e * NTOK + slot] : 0; return (unsigned)tok * (unsigned)(K * 2); }
        return (unsigned)(u.pm * BM + half * HALF + R) * (unsigned)(K * 2);
    }
    __device__ __forceinline__ const char* b_ptr(const Unit& u) const { return Bt + (size_t)u.e * wstride + (size_t)u.pn * BM * K * 2; }
};

struct EpiBf16 {
    static constexpr bool PERM = true;
    bf16_t* O; int ldc;
    __device__ __forceinline__ void operator()(const f32x4 (&acc)[2][2][4][2], const Unit& u, int wr, int wc, int fr, int fq) const {
        const int row0 = u.pm * BM + wr * 64 + fr, col0 = u.pn * BM + wc * 32 + 8 * fq;
#pragma unroll
        for (int ai = 0; ai < 2; ++ai)
#pragma unroll
            for (int m = 0; m < 4; ++m) { bf16_t* rowp = O + (size_t)(row0 + ai * HALF + m * 16) * ldc + col0;
#pragma unroll
                for (int bj = 0; bj < 2; ++bj) { const f32x4 v0 = acc[ai][bj][m][0], v1 = acc[ai][bj][m][1];
                    u32x4 w; w.x = cvt_pk_bf16(v0[0], v0[1]); w.y = cvt_pk_bf16(v0[2], v0[3]); w.z = cvt_pk_bf16(v1[0], v1[1]); w.w = cvt_pk_bf16(v1[2], v1[3]);
                    *(u32x4*)(rowp + bj * HALF) = w; } }
    }
};
struct EpiResid {
    static constexpr bool PERM = false;
    const float* X; const bf16_t* Xb; float* U;
    __device__ __forceinline__ void operator()(const f32x4 (&acc)[2][2][4][2], const Unit& u, int wr, int wc, int fr, int fq) const {
        const int row0 = u.pm * BM + wr * 64 + fr, col0 = u.pn * BM + wc * 32 + 4 * fq;
#pragma unroll
        for (int ai = 0; ai < 2; ++ai)
#pragma unroll
            for (int m = 0; m < 4; ++m) { const size_t off = (size_t)(row0 + ai * HALF + m * 16) * DM + col0;
#pragma unroll
                for (int bj = 0; bj < 2; ++bj)
#pragma unroll
                    for (int n = 0; n < 2; ++n) { f32x4 xv;
                        if (Xb) { const u32x2 h = *(const u32x2*)(Xb + off + bj * HALF + n * 16);
                            xv = (f32x4){__uint_as_float(h.x << 16), __uint_as_float(h.x & 0xffff0000u), __uint_as_float(h.y << 16), __uint_as_float(h.y & 0xffff0000u)}; }
                        else xv = *(const f32x4*)(X + off + bj * HALF + n * 16);
                        *(f32x4*)(U + off + bj * HALF + n * 16) = xv * DN_ALPHA + acc[ai][bj][m][n]; } }
    }
};
struct EpiSwiglu {
    static constexpr bool PERM = true;
    bf16_t* O;
    __device__ __forceinline__ void operator()(const f32x4 (&acc)[2][2][4][2], const Unit& u, int wr, int wc, int fr, int fq) const {
        const int row0 = u.pm * BM + wr * 64 + fr, col0 = u.pn * HALF + wc * 32 + 8 * fq;
#pragma unroll
        for (int ai = 0; ai < 2; ++ai)
#pragma unroll
            for (int m = 0; m < 4; ++m) { bf16_t* rowp = O + (size_t)(row0 + ai * HALF + m * 16) * DEXP + col0;
                float r[8];
#pragma unroll
                for (int n = 0; n < 2; ++n)
#pragma unroll
                    for (int j = 0; j < 4; ++j) { const float g = acc[ai][0][m][n][j], up = acc[ai][1][m][n][j]; r[n * 4 + j] = g / (1.0f + __expf(-g)) * up; }
                u32x4 w; w.x = cvt_pk_bf16(r[0], r[1]); w.y = cvt_pk_bf16(r[2], r[3]); w.z = cvt_pk_bf16(r[4], r[5]); w.w = cvt_pk_bf16(r[6], r[7]);
                *(u32x4*)rowp = w; }
    }
};
}

__device__ __forceinline__ void tr_tile256(LAS float* tile  , const float* src, int ld, int k0, int c0, bf16_t* dst, int dstK, int blk, int blk_stride, int dst_off, int tid) {
    {
        const int c4 = tid & 63;
#pragma unroll
        for (int i = 0; i < 8; ++i) { const int r = (tid >> 6) + 8 * i; const f32x4 a = *(const f32x4*)(src + (size_t)(k0 + r) * ld + c0 + c4 * 4);
            tile[r * 257 + c4 * 4 + 0] = a[0]; tile[r * 257 + c4 * 4 + 1] = a[1]; tile[r * 257 + c4 * 4 + 2] = a[2]; tile[r * 257 + c4 * 4 + 3] = a[3]; }
    }
    __syncthreads();
    {
        const int kk = (tid & 7) * 8;
#pragma unroll
        for (int i = 0; i < 4; ++i) { const int n = (tid >> 3) + 64 * i, col = c0 + n;
            u32x4 w;
            w.x = cvt_pk_bf16(tile[(kk + 0) * 257 + n], tile[(kk + 1) * 257 + n]); w.y = cvt_pk_bf16(tile[(kk + 2) * 257 + n], tile[(kk + 3) * 257 + n]);
            w.z = cvt_pk_bf16(tile[(kk + 4) * 257 + n], tile[(kk + 5) * 257 + n]); w.w = cvt_pk_bf16(tile[(kk + 6) * 257 + n], tile[(kk + 7) * 257 + n]);
            const int drow = (col / blk) * blk_stride + dst_off + (col % blk);
            *(u32x4*)(dst + (size_t)drow * dstK + k0 + kk) = w; }
    }
    __syncthreads();
}
__device__ __forceinline__ float reduce16_wave(const float (&v)[16], int lane) {
    float a8[8];
#pragma unroll
    for (int i = 0; i < 8; ++i) { const float mine = (lane & 32) ? v[8 + i] : v[i], other = (lane & 32) ? v[i] : v[8 + i]; a8[i] = mine + __shfl_xor(other, 32); }
    float a4[4];
#pragma unroll
    for (int i = 0; i < 4; ++i) { const float mine = (lane & 16) ? a8[4 + i] : a8[i], other = (lane & 16) ? a8[i] : a8[4 + i]; a4[i] = mine + __shfl_xor(other, 16); }
    float a2[2];
#pragma unroll
    for (int i = 0; i < 2; ++i) { const float mine = (lane & 8) ? a4[2 + i] : a4[i], other = (lane & 8) ? a4[i] : a4[2 + i]; a2[i] = mine + __shfl_xor(other, 8); }
    float a1; { const float mine = (lane & 4) ? a2[1] : a2[0], other = (lane & 4) ? a2[0] : a2[1]; a1 = mine + __shfl_xor(other, 4); }
    a1 += dppf<0x4E>(a1); a1 += dppf<0xB1>(a1);
    return a1;
}
__device__ __forceinline__ void tr_tile(LAS float* tile  , const float* src, int ld, int k0, int c0, int ncols_valid, bf16_t* dst, int dstK, int drow0, int tid) {
    {
        const int r = tid >> 3, cc = (tid & 7) * 8;
        const float* sp = src + (size_t)(k0 + r) * ld + c0 + cc;
        if (c0 + cc + 8 <= ncols_valid) {
            const f32x4 a = *(const f32x4*)sp, b = *(const f32x4*)(sp + 4);
#pragma unroll
            for (int j = 0; j < 4; ++j) { tile[r * 65 + cc + j] = a[j]; tile[r * 65 + cc + 4 + j] = b[j]; }
        } else {
#pragma unroll
            for (int j = 0; j < 8; ++j) tile[r * 65 + cc + j] = (c0 + cc + j < ncols_valid) ? sp[j] : 0.f;
        }
    }
    __syncthreads();
    {
        const int n = tid >> 3, kk = (tid & 7) * 8;
        u32x4 w;
        w.x = cvt_pk_bf16(tile[(kk + 0) * 65 + n], tile[(kk + 1) * 65 + n]); w.y = cvt_pk_bf16(tile[(kk + 2) * 65 + n], tile[(kk + 3) * 65 + n]);
        w.z = cvt_pk_bf16(tile[(kk + 4) * 65 + n], tile[(kk + 5) * 65 + n]); w.w = cvt_pk_bf16(tile[(kk + 6) * 65 + n], tile[(kk + 7) * 65 + n]);
        *(u32x4*)(dst + (size_t)(drow0 + n) * dstK + k0 + kk) = w;
    }
    __syncthreads();
}

__device__ __forceinline__ void phase_prep(const Params& p, LAS unsigned char* lds, int bid, int nb, int part) {
    const int tid = opaque_tid();
    LAS float* tile = (LAS float*)lds;
    unsigned char* ws = p.ws;
    const int T0 = 832, T1 = T0 + 256, T2 = T1 + 448, T3 = T2 + 256, T4 = T3 + 2048, T5 = T4 + 2048, T6 = T5 + 2048, T7 = T6 + 32;
    if (part == 0) {
        for (int t0 = bid; t0 < T0 + 32; t0 += nb) {
            const int t = t0 < T0 ? t0 : T6 + (t0 - T0);
            if (t >= T6) { const int q = t - T6;
                if (q < 8) tr_tile(tile, p.in[I_AW2], 512, 0, q * 64, 512, (bf16_t*)(ws + OFF_MISC + MISC_W2T), 64, q * 64, tid);
                else if (q < 16) tr_tile(tile, p.in[I_AA2], 512, 0, (q - 8) * 64, 512, (bf16_t*)(ws + OFF_MISC + MISC_A2T), 64, (q - 8) * 64, tid);
                else { const int r = q - 16; tr_tile(tile, p.in[I_AG2], 512, (r >> 3) * 64, (r & 7) * 64, 512, (bf16_t*)(ws + OFF_MISC + MISC_G2T), 128, (r & 7) * 64, tid); }
                continue; }
            { const int kt = t / 52, ct = t % 52; tr_tile(tile, p.in[I_WINE], EVEN_COLS, kt * 64, ct * 64, EVEN_COLS, (bf16_t*)(ws + OFF_WINE), 1024, ct * 64, tid); }
        }
        __syncthreads();
        {
            const int wid = tid >> 6, lane = tid & 63;
            LAS float* wT = (LAS float*)lds;
            for (int i = tid; i < 16 * 1024; i += 512) { const int e_ = i & 15, k = i >> 4; wT[e_ * 1024 + k] = p.in[I_WINE][(size_t)k * EVEN_COLS + NE_MAIN + e_]; }
            __syncthreads();
            const float* x = p.in[I_X]; bf16_t* xb = (bf16_t*)(ws + OFF_BUF64); float* xa = (float*)(ws + OFF_U);
            for (int tok = bid * 8 + wid; tok < NTOK; tok += nb * 8) {
                f32x4 v[4];
                asm volatile("" ::: "memory");
#pragma unroll
                for (int j = 0; j < 4; ++j) { v[j] = *(const f32x4*)(x + (size_t)tok * DM + j * 256 + lane * 4);
                    u32x2 w; w.x = cvt_pk_bf16(v[j][0], v[j][1]); w.y = cvt_pk_bf16(v[j][2], v[j][3]); *(u32x2*)(xb + (size_t)tok * DM + j * 256 + lane * 4) = w; }
                float part_[16];
#pragma unroll
                for (int e_ = 0; e_ < 16; ++e_) { float a = 0.f;
#pragma unroll
                    for (int j = 0; j < 4; ++j) { const f32x4 w = *(const LAS f32x4*)(wT + e_ * 1024 + j * 256 + lane * 4); a += (v[j][0] * w[0] + v[j][1] * w[1]) + (v[j][2] * w[2] + v[j][3] * w[3]); }
                    part_[e_] = a; }
                const float r = reduce16_wave(part_, lane);
                if ((lane & 3) == 0) xa[(size_t)tok * 16 + ((lane >> 5) & 1) * 8 + ((lane >> 4) & 1) * 4 + ((lane >> 3) & 1) * 2 + ((lane >> 2) & 1)] = r;
            }
            __syncthreads();
        }
        if (bid == 0 && tid < 64) ((int*)(ws + OFF_MISC + MISC_CNT))[tid] = 0;
        if (bid == 1) for (int i = tid; i < (16384 + 256) / 4; i += 512) ((unsigned*)(ws + OFF_MISC + MISC_RWF))[i] = 0u;
        return;
    }
    unsigned* pctr = (unsigned*)(ws + OFF_MISC + MISC_PCTR);
    LAS int* tsh = (LAS int*)(lds + 69632);
    const int U0 = 64, U1 = U0 + 64, U2 = U1 + 512, U3 = U2 + 512, U4 = U3 + 512, U5 = U4 + 448;
    for (;;) {
        __syncthreads();
        if (tid == 0) tsh[0] = (int)__hip_atomic_fetch_add(pctr, 2u, __ATOMIC_RELAXED, __HIP_MEMORY_SCOPE_AGENT);
        __syncthreads();
        const int tb = __builtin_amdgcn_readfirstlane(tsh[0]);
        if (tb >= U5) break;
#pragma unroll 1
        for (int t = tb; t < tb + 2 && t < U5; ++t) {
            if (t < U0) { const int kt = t >> 2, cb = t & 3; tr_tile256(tile, p.in[I_WOUTE], 1024, kt * 64, cb * 256, (bf16_t*)(ws + OFF_WOUTE), 1024, 1 << 20, 0, 0, tid); }
            else if (t < U1) { const int q = t - U0, kt = q >> 2, cb = q & 3; tr_tile256(tile, p.in[I_WOUTO], 1024, kt * 64, cb * 256, (bf16_t*)(ws + OFF_WOUTO), 1024, 1 << 20, 0, 0, tid); }
            else if (t < U3) { const bool up = t >= U2; const int q = t - (up ? U2 : U1), le = q >> 4, kt = q & 15;
                tr_tile256(tile, p.in[up ? I_EU : I_EG] + (size_t)le * 1024 * 256, 256, kt * 64, 0, (bf16_t*)(ws + OFF_WGU) + (size_t)le * 512 * 1024, 1024, 128, 256, up ? 128 : 0, tid); }
            else if (t < U4) { const int q = t - U3, le = q >> 4, r = q & 15, kt = r >> 2, cb = r & 3;
                tr_tile256(tile, p.in[I_ED] + (size_t)le * 256 * 1024, 1024, kt * 64, cb * 256, (bf16_t*)(ws + OFF_WD) + (size_t)le * 1024 * 256, 256, 1 << 20, 0, 0, tid); }
            else { const int q = t - U4, kt = q / 28, ct = q % 28; tr_tile(tile, p.in[I_WINO], ODD_COLS, kt * 64, ct * 64, ODD_COLS, (bf16_t*)(ws + OFF_WINO), 1024, ct * 64, tid); }
        }
    }
    {
        float* c64 = (float*)(ws + OFF_ROPE); float* s64 = c64 + 4096 * 64; float* c32 = s64 + 4096 * 64; float* s32 = c32 + 4096 * 32;
        for (int i = bid * 512 + tid; i < 4096 * 64; i += nb * 512) { const int pos = i >> 6, j = i & 63; const float inv = powf(10000.0f, -(float)j / 64.0f); const float ang = (float)pos * inv; c64[i] = cosf(ang); s64[i] = sinf(ang); }
        for (int i = bid * 512 + tid; i < 4096 * 32; i += nb * 512) { const int pos = i >> 5, j = i & 31; const float inv = powf(10000.0f, -(float)j / 32.0f); const float ang = (float)pos * inv; c32[i] = cosf(ang); s32[i] = sinf(ang); }
    }
}

__device__ __forceinline__ void phase_ln_route(const Params& p, LAS unsigned char* lds, int bid, int nb, int layer) {
    const int tid = opaque_tid(), wid = tid >> 6, lane = tid & 63;
    unsigned char* ws = p.ws;
    LAS float* rwT = (LAS float*)lds;
    LAS int* sel = (LAS int*)(lds + 65536);
    LAS float* selg = (LAS float*)(lds + 65536 + 1024);
    LAS int* cntw = (LAS int*)(lds + 65536 + 2048);
    { const float* rw = p.in[I_RW];
        for (int i = tid; i < 16 * 1024; i += 512) { const int e = i >> 10, k = i & 1023; rwT[i] = rw[k * 16 + e]; } }
    __syncthreads();
    float* U = (float*)(ws + OFF_U); bf16_t* hb = (bf16_t*)(ws + OFF_BUF64);
    const float* g = p.in[I_LN1G] + layer * DM; const float* b = p.in[I_LN1B] + layer * DM;
    int* cnt = (int*)(ws + OFF_MISC + MISC_CNT) + layer * 16;
    int* tokinfo = (int*)(ws + OFF_MISC + MISC_TOKINFO); float* tokgate = (float*)(ws + OFF_MISC + MISC_TOKGATE); int* list = (int*)(ws + OFF_MISC + MISC_LIST);
    f32x4 gv[4], bv[4];
#pragma unroll
    for (int j = 0; j < 4; ++j) { gv[j] = *(const f32x4*)(g + j * 256 + lane * 4); bv[j] = *(const f32x4*)(b + j * 256 + lane * 4); }
    const float* rbp = p.in[I_RB];
    const float my_rb = rbp[((lane >> 5) & 1) * 8 + ((lane >> 4) & 1) * 4 + ((lane >> 3) & 1) * 2 + ((lane >> 2) & 1)];
    for (int blk = bid; blk < NTOK / 128; blk += nb) {
        f32x4 nv[4];
#pragma unroll
        for (int j = 0; j < 4; ++j) nv[j] = *(const f32x4*)(U + (size_t)(blk * 128 + wid * 16) * DM + j * 256 + lane * 4);
#pragma unroll 1
        for (int i = 0; i < 16; ++i) {
            const int tl = wid * 16 + i, tok = blk * 128 + tl;
            f32x4 v[4]; float s = 0.f;
            asm volatile("" ::: "memory");
#pragma unroll
            for (int j = 0; j < 4; ++j) v[j] = nv[j];
            { const int tokn = tok + (i < 15 ? 1 : 0);
#pragma unroll
                for (int j = 0; j < 4; ++j) nv[j] = *(const f32x4*)(U + (size_t)tokn * DM + j * 256 + lane * 4); }
#pragma unroll
            for (int j = 0; j < 4; ++j) s += (v[j][0] + v[j][1]) + (v[j][2] + v[j][3]);
            const float mean = wave_sum(s) * (1.0f / DM);
            float q = 0.f;
#pragma unroll
            for (int j = 0; j < 4; ++j) { v[j] -= mean; q += (v[j][0] * v[j][0] + v[j][1] * v[j][1]) + (v[j][2] * v[j][2] + v[j][3] * v[j][3]); }
            const float rstd = rsqrtf(wave_sum(q) * (1.0f / DM) + LN_EPS);
#pragma unroll
            for (int j = 0; j < 4; ++j) { v[j] = v[j] * rstd * gv[j] + bv[j];
                u32x2 w; w.x = cvt_pk_bf16(v[j][0], v[j][1]); w.y = cvt_pk_bf16(v[j][2], v[j][3]);
                *(u32x2*)(hb + (size_t)tok * DM + j * 256 + lane * 4) = w; }
            float part[16];
#pragma unroll
            for (int e = 0; e < 16; ++e) { float a = 0.f;
#pragma unroll
                for (int j = 0; j < 4; ++j) { const f32x4 w = *(const LAS f32x4*)(rwT + e * 1024 + j * 256 + lane * 4); a += (v[j][0] * w[0] + v[j][1] * w[1]) + (v[j][2] * w[2] + v[j][3] * w[3]); }
                part[e] = a; }
            const float lgm = reduce16_wave(part, lane);
            const float sgm = 1.0f / (1.0f + expf(-lgm)), selm = sgm + my_rb;
            float sg[16], sl[16];
#pragma unroll
            for (int e = 0; e < 16; ++e) { const int L = ((e >> 3) & 1) * 32 + ((e >> 2) & 1) * 16 + ((e >> 1) & 1) * 8 + (e & 1) * 4;
                sg[e] = __builtin_bit_cast(float, __builtin_amdgcn_readlane(__builtin_bit_cast(int, sgm), L)); sl[e] = __builtin_bit_cast(float, __builtin_amdgcn_readlane(__builtin_bit_cast(int, selm), L)); }
            int best = 0; float bestv = -INFINITY;
#pragma unroll
            for (int gI = 0; gI < 4; ++gI) { float m1 = -INFINITY, m2 = -INFINITY;
#pragma unroll
                for (int j = 0; j < 4; ++j) { const float x = sl[gI * 4 + j]; if (x > m1) { m2 = m1; m1 = x; } else if (x > m2) m2 = x; }
                const float gs = m1 + m2; if (gs > bestv) { bestv = gs; best = gI; } }
            int e0 = 0, e1 = 0; float v0 = -INFINITY, v1 = -INFINITY, s0 = 0.f, s1 = 0.f;
#pragma unroll
            for (int e = 0; e < 16; ++e) { if ((e >> 2) == best) { const float x = sl[e];
                    if (x > v0) { v1 = v0; e1 = e0; s1 = s0; v0 = x; e0 = e; s0 = sg[e]; } else if (x > v1) { v1 = x; e1 = e; s1 = sg[e]; } } }
            const float gsum = s0 + s1;
            if (lane == 0) { sel[tl * 2] = e0; sel[tl * 2 + 1] = e1; selg[tl * 2] = s0 / gsum; selg[tl * 2 + 1] = s1 / gsum; }
        }
        __syncthreads();
        int myE = -1, myRank = 0;
        if (tid < 256) { myE = sel[tid];
#pragma unroll
            for (int e = 0; e < 16; ++e) { const unsigned long long mk = __ballot(myE == e); if (myE == e) myRank = __popcll(mk & ((1ull << lane) - 1ull)); if (lane == 0) cntw[wid * 16 + e] = __popcll(mk); } }
        __syncthreads();
        if (tid < 16) { const int c0 = cntw[tid], c1 = cntw[16 + tid], c2 = cntw[32 + tid], c3 = cntw[48 + tid];
            const int basev = atomicAdd(cnt + tid, c0 + c1 + c2 + c3);
            cntw[64 + tid] = basev; cntw[80 + tid] = basev + c0; cntw[96 + tid] = basev + c0 + c1; cntw[112 + tid] = basev + c0 + c1 + c2; }
        __syncthreads();
        if (tid < 256) { const int slot = cntw[64 + wid * 16 + myE] + myRank; const int tok = blk * 128 + (tid >> 1), k = tid & 1;
            list[myE * NTOK + slot] = tok; tokinfo[tok * 4 + k * 2] = myE; tokinfo[tok * 4 + k * 2 + 1] = slot; tokgate[tok * 2 + k] = selg[tid]; }
        __syncthreads();
    }
}

__device__ __forceinline__ void phase_ln2(const Params& p, int bid, int nb, int layer, float* dst, bool with_moe) {
    const int tid = opaque_tid(), wid = tid >> 6, lane = tid & 63;
    unsigned char* ws = p.ws;
    bf16_t* xb = (bf16_t*)(ws + OFF_BUF64);
    const bf16_t* he = (const bf16_t*)(ws + OFF_HE);
    const float* g = p.in[I_LN2G] + layer * DM; const float* b = p.in[I_LN2B] + layer * DM;
    const int* cnt = (const int*)(ws + OFF_MISC + MISC_CNT) + layer * 16;
    const int* tokinfo = (const int*)(ws + OFF_MISC + MISC_TOKINFO); const float* tokgate = (const float*)(ws + OFF_MISC + MISC_TOKGATE);
    int rowbase[16]; { int a = 0;
#pragma unroll
        for (int e = 0; e < 16; ++e) { rowbase[e] = a; a += ((cnt[e] + 255) >> 8) << 8; } }
    f32x4 gv[4], bv[4];
#pragma unroll
    for (int j = 0; j < 4; ++j) { gv[j] = *(const f32x4*)(g + j * 256 + lane * 4); bv[j] = *(const f32x4*)(b + j * 256 + lane * 4); }
    const int tstride = nb * 8;
    int r0n, r1n; float g0n, g1n;
#define LN2_INFO(tk) do { const int tk_ = (tk) < NTOK ? (tk) : NTOK - 1; const int e0 = tokinfo[tk_ * 4 + 0], sl0 = tokinfo[tk_ * 4 + 1], e1 = tokinfo[tk_ * 4 + 2], sl1 = tokinfo[tk_ * 4 + 3]; \
        int rb0 = 0, rb1 = 0; _Pragma("unroll") for (int e = 0; e < 16; ++e) { if (e == e0) rb0 = rowbase[e]; if (e == e1) rb1 = rowbase[e]; } \
        r0n = rb0 + sl0; r1n = rb1 + sl1; g0n = tokgate[tk_ * 2 + 0]; g1n = tokgate[tk_ * 2 + 1]; } while (0)
#define LN2_ROWS(tk) do { const int tk_ = (tk) < NTOK ? (tk) : NTOK - 1; _Pragma("unroll") for (int j = 0; j < 4; ++j) { hN[j] = *(const u32x2*)(xb + (size_t)tk_ * DM + j * 256 + lane * 4); \
        aN[j] = *(const u32x2*)(he + (size_t)r0n * DM + j * 256 + lane * 4); cN[j] = *(const u32x2*)(he + (size_t)r1n * DM + j * 256 + lane * 4); } } while (0)
    u32x2 hN[4], aN[4], cN[4]; float g0c, g1c;
    { const int tok0 = bid * 8 + wid; LN2_INFO(tok0); LN2_ROWS(tok0); g0c = g0n; g1c = g1n; LN2_INFO(tok0 + tstride); }
#pragma unroll 1
    for (int tok = bid * 8 + wid; tok < NTOK; tok += tstride) {
        f32x4 v[4]; float s = 0.f;
        asm volatile("" ::: "memory");
        u32x2 hC[4], aC[4], cC[4]; const float g0 = g0c, g1 = g1c;
#pragma unroll
        for (int j = 0; j < 4; ++j) { hC[j] = hN[j]; aC[j] = aN[j]; cC[j] = cN[j]; }
        LN2_ROWS(tok + tstride); g0c = g0n; g1c = g1n; LN2_INFO(tok + 2 * tstride);
#pragma unroll
        for (int j = 0; j < 4; ++j) { const u32x2 h = hC[j], a = aC[j], c = cC[j];
            v[j] = (f32x4){__uint_as_float(h.x << 16), __uint_as_float(h.x & 0xffff0000u), __uint_as_float(h.y << 16), __uint_as_float(h.y & 0xffff0000u)} * DN_ALPHA;
            v[j][0] += g0 * __uint_as_float(a.x << 16) + g1 * __uint_as_float(c.x << 16); v[j][1] += g0 * __uint_as_float(a.x & 0xffff0000u) + g1 * __uint_as_float(c.x & 0xffff0000u);
            v[j][2] += g0 * __uint_as_float(a.y << 16) + g1 * __uint_as_float(c.y << 16); v[j][3] += g0 * __uint_as_float(a.y & 0xffff0000u) + g1 * __uint_as_float(c.y & 0xffff0000u);
            s += (v[j][0] + v[j][1]) + (v[j][2] + v[j][3]); }
        const float mean = wave_sum(s) * (1.0f / DM);
        float q = 0.f;
#pragma unroll
        for (int j = 0; j < 4; ++j) { v[j] -= mean; q += (v[j][0] * v[j][0] + v[j][1] * v[j][1]) + (v[j][2] * v[j][2] + v[j][3] * v[j][3]); }
        const float rstd = rsqrtf(wave_sum(q) * (1.0f / DM) + LN_EPS);
#pragma unroll
        for (int j = 0; j < 4; ++j) { v[j] = v[j] * rstd * gv[j] + bv[j];
#if PROBE_ID
            if (layer == 1) v[j] = v[j] * (1.0f + *(const float*)(ws + OFF_MISC + MISC_PROBE));
#endif
            if (layer == 1) *(f32x4*)(dst + (size_t)tok * DM + j * 256 + lane * 4) = v[j];
            else { u32x2 w; w.x = cvt_pk_bf16(v[j][0], v[j][1]); w.y = cvt_pk_bf16(v[j][2], v[j][3]);
                *(u32x2*)(xb + (size_t)tok * DM + j * 256 + lane * 4) = w; } }
    }
}


__device__ __forceinline__ void phase_moe_gateup(const Params& p, LAS unsigned char* lds, int bid, int nb, int layer) {
    unsigned char* ws = p.ws;
    LAS int* tab = (LAS int*)(lds + pg::STAGE_BYTES);
    pg::moe_build_units(tab, (const int*)(ws + OFF_MISC + MISC_CNT) + layer * 16, 2, nb, bid);
    pg::MoeSched<true> S; S.init(ws + OFF_BUF64, ws + OFF_WGU + (size_t)layer * 16 * 512 * 1024 * 2, (size_t)512 * 1024 * 2, (const int*)(ws + OFF_MISC + MISC_LIST), 1024, tab);
    pg::EpiSwiglu E; E.O = (bf16_t*)(ws + OFF_ACT);
    pg::gemm_phase(lds, 1024, S, E);
}
__device__ __forceinline__ void phase_moe_down(const Params& p, LAS unsigned char* lds, int bid, int nb, int layer) {
    unsigned char* ws = p.ws;
    LAS int* tab = (LAS int*)(lds + pg::STAGE_BYTES);
    pg::moe_build_units(tab, (const int*)(ws + OFF_MISC + MISC_CNT) + layer * 16, 4, nb, bid);
    pg::MoeSched<false> S; S.init(ws + OFF_ACT, ws + OFF_WD + (size_t)layer * 16 * 1024 * 256 * 2, (size_t)1024 * 256 * 2, nullptr, 256, tab);
    pg::EpiBf16 E; E.O = (bf16_t*)(ws + OFF_HE); E.ldc = 1024;
    pg::gemm_phase(lds, 256, S, E);
}


__device__ __forceinline__ float red8(float v) { v += dppf<0xB1>(v); v += dppf<0x4E>(v); v += dppf<0x141>(v); return v; }


__device__ __forceinline__ float red16(float v) { v += dppf<0xB1>(v); v += dppf<0x4E>(v); v += dppf<0x141>(v); v += dppf<0x140>(v); return v; }

constexpr size_t OFF_ACT256 = OFF_U + 4 * MiB;
__device__ __forceinline__ void phase_lora_act(const Params& p, int bid, int nb) {
    const int tid = opaque_tid();
    const bf16_t* P0 = (const bf16_t*)(p.ws + OFF_P); bf16_t* act = (bf16_t*)(p.ws + OFF_ACT256);
    const float* mu = p.in[I_AMU];
    const int cc = tid & 31, col = 1536 + cc * 8;
    const f32x4 m0 = *(const f32x4*)(mu + col), m1 = *(const f32x4*)(mu + col + 4);
    for (int n = bid * 16 + (tid >> 5); n < NTOK; n += nb * 16) {
        const u32x4 cu = *(const u32x4*)(P0 + (size_t)n * NE_MAIN + col); u32x4 pv = uzero4(); if ((n & (SEQ - 1)) > 0) pv = *(const u32x4*)(P0 + (size_t)(n - 1) * NE_MAIN + col);
        const unsigned cw[4] = {cu.x, cu.y, cu.z, cu.w}, pw[4] = {pv.x, pv.y, pv.z, pv.w}; float x[8];
#pragma unroll
        for (int j = 0; j < 4; ++j) { const float c0 = __uint_as_float(cw[j] << 16), c1 = __uint_as_float(cw[j] & 0xffff0000u), q0 = __uint_as_float(pw[j] << 16), q1 = __uint_as_float(pw[j] & 0xffff0000u);
            const float ma = (j < 2 ? m0[2 * j] : m1[2 * j - 4]), mb = (j < 2 ? m0[2 * j + 1] : m1[2 * j - 3]);
            x[2 * j] = c0 + (q0 - c0) * ma; x[2 * j + 1] = c1 + (q1 - c1) * mb; }
        if (cc < 8) {
#pragma unroll
            for (int j = 0; j < 8; ++j) x[j] = fast_tanh(x[j]); }
        else if (cc >= 16) {
#pragma unroll
            for (int j = 0; j < 8; ++j) x[j] = fast_sigmoid(x[j]); }
        u32x4 o; o.x = cvt_pk_bf16(x[0], x[1]); o.y = cvt_pk_bf16(x[2], x[3]); o.z = cvt_pk_bf16(x[4], x[5]); o.w = cvt_pk_bf16(x[6], x[7]);
        *(u32x4*)(act + (size_t)n * 256 + cc * 8) = o;
    }
}

template <int CTRL> __device__ __forceinline__ float dpp0f(float v) { return __builtin_bit_cast(float, __builtin_amdgcn_update_dpp(0, __builtin_bit_cast(int, v), CTRL, 0xf, 0xf, true)); }
__device__ __forceinline__ bf16x8 pack_lo4(const f32x4 a) { u32x4 w; w.x = cvt_pk_bf16(a[0], a[1]); w.y = cvt_pk_bf16(a[2], a[3]); w.z = 0u; w.w = 0u; return __builtin_bit_cast(bf16x8, w); }
__device__ __forceinline__ bf16x8 pack_8(const f32x4 a, const f32x4 b) { u32x4 w; w.x = cvt_pk_bf16(a[0], a[1]); w.y = cvt_pk_bf16(a[2], a[3]); w.z = cvt_pk_bf16(b[0], b[1]); w.w = cvt_pk_bf16(b[2], b[3]); return __builtin_bit_cast(bf16x8, w); }
__device__ __forceinline__ f32x4 mm16(const f32x4 PT, const f32x4 Q) { return __builtin_amdgcn_mfma_f32_16x16x32_bf16(pack_lo4(PT), pack_lo4(Q), fzero4(), 0, 0, 0); }
constexpr int RW3_SLOT = 12544;
__device__ __forceinline__ int rw3_trswz(int row, int c) { return (((c >> 1) ^ ((row >> 1) & 3)) << 1) | (c & 1); }
__device__ __forceinline__ unsigned rw_ld(unsigned* p_) { return __hip_atomic_load(p_, __ATOMIC_RELAXED, __HIP_MEMORY_SCOPE_AGENT); }
__device__ __forceinline__ void rwkv3_item(const Params& p, LAS unsigned char* lds, int item, int role, int which) {
    const int tid = opaque_tid(), lane = tid & 63, wid = tid >> 6, fr = lane & 15, g = lane >> 4;
    const int b = item >> 3, h = item & 7;
    unsigned char* ws = p.ws;
    const bf16_t* P0 = (const bf16_t*)(ws + OFF_P);
    float* yraw = p.out; bf16_t* e1g = (bf16_t*)(p.out + (size_t)NTOK * 512); bf16_t* gg = e1g + (size_t)NTOK * 512;
    LAS unsigned char* w2h = lds;
    LAS unsigned char* a2h = lds + 8192;
    LAS unsigned char* g2h = lds + 16384;
    LAS unsigned char* slots = lds + 32768;
    LAS float* ptab = (LAS float*)(lds + 32768 + 8 * RW3_SLOT);
    LAS float* mul = ptab + 8 * 64;
    if (role == 0) {
        const float* mu = p.in[I_AMU];
        if (tid < 64) { ptab[tid] = mu[h * 64 + tid]; ptab[64 + tid] = mu[512 + h * 64 + tid]; ptab[128 + tid] = mu[1024 + h * 64 + tid];
            ptab[192 + tid] = p.in[I_AW0][h * 64 + tid]; ptab[256 + tid] = p.in[I_AA0][h * 64 + tid]; ptab[320 + tid] = p.in[I_AKK][h * 64 + tid];
            ptab[384 + tid] = p.in[I_AKA][h * 64 + tid]; ptab[448 + tid] = p.in[I_ARK][h * 64 + tid]; }
        if (tid < 256) mul[tid] = mu[1536 + tid];
    }
    if (role == 0) {
        const bf16_t* w2t = (const bf16_t*)(ws + OFF_MISC + MISC_W2T); const bf16_t* a2t = (const bf16_t*)(ws + OFF_MISC + MISC_A2T); const bf16_t* g2t = (const bf16_t*)(ws + OFF_MISC + MISC_G2T);
        { const int row = tid >> 3, c = tid & 7;
            *(LAS u32x4*)(w2h + row * 128 + ((c ^ (row & 7)) * 16)) = *(const u32x4*)(w2t + (size_t)(h * 64 + row) * 64 + c * 8);
            *(LAS u32x4*)(a2h + row * 128 + ((c ^ (row & 7)) * 16)) = *(const u32x4*)(a2t + (size_t)(h * 64 + row) * 64 + c * 8); }
#pragma unroll
        for (int i = 0; i < 2; ++i) { const int q = tid + i * 512, row = q >> 4, c = q & 15;
            *(LAS u32x4*)(g2h + row * 256 + ((c ^ (row & 7)) * 16)) = *(const u32x4*)(g2t + (size_t)(h * 64 + row) * 128 + c * 8); }
    }
    __syncthreads();
    f32x4 Hacc[4];
#pragma unroll
    for (int rt = 0; rt < 4; ++rt) Hacc[rt] = fzero4();
    const size_t nb0 = (size_t)b * SEQ;
    const int q4 = fr >> 2, p4 = fr & 3;
#define MIXB(wc, wp, mA, mB, o0, o1) { const float c0 = __uint_as_float((wc) << 16), c1 = __uint_as_float((wc) & 0xffff0000u), q0 = __uint_as_float((wp) << 16), q1 = __uint_as_float((wp) & 0xffff0000u); o0 = c0 + (q0 - c0) * (mA); o1 = c1 + (q1 - c1) * (mB); }
    const bf16_t* actp = (const bf16_t*)(ws + OFF_ACT256);
    u32x2 nrc[4], nkc[4], nvc[4], nrp[4], nkp[4], nvp[4]; bf16x8 nb_[8];
#define RW3_LOADS(tk) do { const int t0_ = ((tk) * 8 + wid) * 16; const int fr_ = lane & 15, g_ = lane >> 4; const size_t n_ = nb0 + t0_ + fr_; const bool hp_ = (t0_ + fr_) > 0; \
        const bf16_t* rc_ = P0 + n_ * NE_MAIN; const bf16_t* rp_ = rc_ - NE_MAIN; \
        _Pragma("unroll") for (int ct = 0; ct < 4; ++ct) { const int c0 = ct * 16 + g_ * 4; \
            nrc[ct] = *(const u32x2*)(rc_ + h * 64 + c0); nkc[ct] = *(const u32x2*)(rc_ + 512 + h * 64 + c0); nvc[ct] = *(const u32x2*)(rc_ + 1024 + h * 64 + c0); \
            nrp[ct] = (u32x2){0u, 0u}; nkp[ct] = nrp[ct]; nvp[ct] = nrp[ct]; \
            if (hp_) { nrp[ct] = *(const u32x2*)(rp_ + h * 64 + c0); nkp[ct] = *(const u32x2*)(rp_ + 512 + h * 64 + c0); nvp[ct] = *(const u32x2*)(rp_ + 1024 + h * 64 + c0); } } \
        _Pragma("unroll") for (int f = 0; f < 8; ++f) nb_[f] = *(const bf16x8*)(actp + n_ * 256 + f * 32 + g_ * 8); } while (0)
    unsigned char* xb = ws + OFF_RWXB; unsigned* flg = (unsigned*)(ws + OFF_MISC + MISC_RWF);
    const __amdgpu_buffer_rsrc_t xrsrc = __builtin_amdgcn_make_buffer_rsrc((void*)xb, 0, 64 * 2 * 2 * 8 * RW3_SLOT, 0x00020000);
#pragma unroll 1
    for (int it = 0; it < (role ? 32 : 16); ++it) {
        const int tick = role ? it : 2 * it + which;
        const int hk = tick >> 1, hw = tick & 1;
        unsigned* f_prod = flg + (item * 2 + hw) * 16; unsigned* f_cons = flg + 2048 + (item * 2 + hw) * 16;
        unsigned char* xslot = xb + ((((size_t)item * 2 + (hk & 1)) * 2 + hw) * 8) * RW3_SLOT;
        if (role == 0) {
            int lane_t = lane; asm volatile("" : "+v"(lane_t));
            const int fr = lane_t & 15, g = lane_t >> 4, q4 = fr >> 2, p4 = fr & 3;
            LAS unsigned char* sl = slots + wid * RW3_SLOT;
            LAS unsigned char* Qt_i = sl, * Rh_i = sl + 2048, * Kh_i = sl + 4096, * Bn_i = sl + 6144, * Vi_i = sl + 8192, * M1_i = sl + 10240, * DD_i = sl + 11264; LAS float* gam_i = (LAS float*)(sl + 12288);
            const int t0 = (tick * 8 + wid) * 16;
            const size_t n = nb0 + t0 + fr;
            const bool hasp = (t0 + fr) > 0;
            const bf16_t* rowc = P0 + n * NE_MAIN; const bf16_t* rowp = rowc - NE_MAIN;
            RW3_LOADS(tick);
#define lrc nrc
#define lkc nkc
#define lvc nvc
#define lrp nrp
#define lkp nkp
#define lvp nvp
            bf16x8 bw[2], ba[2], bg[4];
            bw[0] = nb_[0]; bw[1] = nb_[1]; ba[0] = nb_[2]; ba[1] = nb_[3]; bg[0] = nb_[4]; bg[1] = nb_[5]; bg[2] = nb_[6]; bg[3] = nb_[7];
            f32x4 Wt[4], At[4], Gt[4];
#pragma unroll
            for (int ct = 0; ct < 4; ++ct) {
                const int row = ct * 16 + fr;
                f32x4 dw = fzero4(), da = dw, dg = dw;
#pragma unroll
                for (int s = 0; s < 2; ++s) {
                    dw = __builtin_amdgcn_mfma_f32_16x16x32_bf16(*(const LAS bf16x8*)(w2h + row * 128 + (((s * 4 + g) ^ (row & 7)) * 16)), bw[s], dw, 0, 0, 0);
                    da = __builtin_amdgcn_mfma_f32_16x16x32_bf16(*(const LAS bf16x8*)(a2h + row * 128 + (((s * 4 + g) ^ (row & 7)) * 16)), ba[s], da, 0, 0, 0); }
#pragma unroll
                for (int s = 0; s < 4; ++s) dg = __builtin_amdgcn_mfma_f32_16x16x32_bf16(*(const LAS bf16x8*)(g2h + row * 256 + (((s * 4 + g) ^ (row & 7)) * 16)), bg[s], dg, 0, 0, 0);
                Wt[ct] = dw; At[ct] = da; Gt[ct] = dg;
            }
            f32x4 Rm[4], Khm[4], Lw[4], Aa[4];
            float nsq = 0.f, rk = 0.f;
            u32x2 Vp[4];
#pragma unroll
            for (int ct = 0; ct < 4; ++ct) {
                const int c0 = ct * 16 + g * 4;
                const u32x2 rc = lrc[ct], kc = lkc[ct], vc = lvc[ct], rp = lrp[ct], kp = lkp[ct], vp = lvp[ct];
                const f32x4 mr = *(const LAS f32x4*)(ptab + c0), mk = *(const LAS f32x4*)(ptab + 64 + c0), mv = *(const LAS f32x4*)(ptab + 128 + c0);
                f32x4 Km, Vm;
                MIXB(rc.x, rp.x, mr[0], mr[1], Rm[ct][0], Rm[ct][1]) MIXB(rc.y, rp.y, mr[2], mr[3], Rm[ct][2], Rm[ct][3])
                MIXB(kc.x, kp.x, mk[0], mk[1], Km[0], Km[1]) MIXB(kc.y, kp.y, mk[2], mk[3], Km[2], Km[3])
                MIXB(vc.x, vp.x, mv[0], mv[1], Vm[0], Vm[1]) MIXB(vc.y, vp.y, mv[2], mv[3], Vm[2], Vm[3])
                const f32x4 w0v = *(const LAS f32x4*)(ptab + 192 + c0), a0v = *(const LAS f32x4*)(ptab + 256 + c0), kks = *(const LAS f32x4*)(ptab + 320 + c0), kas = *(const LAS f32x4*)(ptab + 384 + c0), rkp = *(const LAS f32x4*)(ptab + 448 + c0);
#pragma unroll
                for (int r = 0; r < 4; ++r) { const float z = w0v[r] + Wt[ct][r]; const float sp = __logf(1.0f + __expf(-z));
                    Lw[ct][r] = -__expf(-sp - 0.5f);
                    const float a = fast_sigmoid(a0v[r] + At[ct][r]); Aa[ct][r] = a;
                    const float kkp = Km[r] * kks[r]; nsq += kkp * kkp; Wt[ct][r] = kkp;
                    const float kh = Km[r] * (1.0f + (a - 1.0f) * kas[r]); Khm[ct][r] = kh; rk += Rm[ct][r] * kh * rkp[r]; }
                Vp[ct].x = cvt_pk_bf16(Vm[0], Vm[1]); Vp[ct].y = cvt_pk_bf16(Vm[2], Vm[3]);
                At[ct] = Vm;
            }
            nsq += __shfl_xor(nsq, 16); nsq += __shfl_xor(nsq, 32);
            rk += __shfl_xor(rk, 16); rk += __shfl_xor(rk, 32);
            const float inrm = 1.0f / fmaxf(sqrtf(nsq), 1e-12f);
#pragma unroll
            for (int ct = 0; ct < 4; ++ct) { const int c0 = ct * 16 + g * 4;
                u32x2 ew, gw; ew.x = cvt_pk_bf16(rk * At[ct][0], rk * At[ct][1]); ew.y = cvt_pk_bf16(rk * At[ct][2], rk * At[ct][3]);
                gw.x = cvt_pk_bf16(Gt[ct][0], Gt[ct][1]); gw.y = cvt_pk_bf16(Gt[ct][2], Gt[ct][3]);
                *(u32x2*)(e1g + n * 512 + h * 64 + c0) = ew; *(u32x2*)(gg + n * 512 + h * 64 + c0) = gw;
                const int c = 2 * ct + (g >> 1);
                *(LAS u32x2*)(Vi_i + fr * 128 + rw3_trswz(fr, c) * 16 + (g & 1) * 8) = Vp[ct]; }
            u32x2 Qp[4], Kp[4], Bp[4], Rp[4];
#pragma unroll
            for (int ct = 0; ct < 4; ++ct) {
                const int c0 = ct * 16 + g * 4;
                f32x4 gmv; float qh[4], kh_[4], bh[4], rh[4];
#pragma unroll
                for (int r = 0; r < 4; ++r) {
                    float L = Lw[ct][r];
                    L += dpp0f<0x111>(L); L += dpp0f<0x112>(L); L += dpp0f<0x114>(L); L += dpp0f<0x118>(L);
                    const float Ltot = red16(Lw[ct][r]);
                    const float eL = __expf(L), ieL = fast_rcp(eL), eLex = __expf(L - Lw[ct][r]);
                    const float kk = Wt[ct][r] * inrm, bb = kk * Aa[ct][r];
                    qh[r] = kk * eLex; kh_[r] = Khm[ct][r] * ieL; bh[r] = bb * ieL; rh[r] = Rm[ct][r] * eL;
                    gmv[r] = __expf(Ltot); }
                Qp[ct].x = cvt_pk_bf16(qh[0], qh[1]); Qp[ct].y = cvt_pk_bf16(qh[2], qh[3]); Kp[ct].x = cvt_pk_bf16(kh_[0], kh_[1]); Kp[ct].y = cvt_pk_bf16(kh_[2], kh_[3]);
                Bp[ct].x = cvt_pk_bf16(bh[0], bh[1]); Bp[ct].y = cvt_pk_bf16(bh[2], bh[3]); Rp[ct].x = cvt_pk_bf16(rh[0], rh[1]); Rp[ct].y = cvt_pk_bf16(rh[2], rh[3]);
                if (fr == 0) *(LAS f32x4*)(gam_i + c0) = gmv;
            }
            bf16x8 Qf[2], Kf[2], Bf[2], Rf[2];
#pragma unroll
            for (int s = 0; s < 2; ++s) { Qf[s] = __builtin_bit_cast(bf16x8, (u32x4){Qp[2 * s].x, Qp[2 * s].y, Qp[2 * s + 1].x, Qp[2 * s + 1].y}); Kf[s] = __builtin_bit_cast(bf16x8, (u32x4){Kp[2 * s].x, Kp[2 * s].y, Kp[2 * s + 1].x, Kp[2 * s + 1].y});
                Bf[s] = __builtin_bit_cast(bf16x8, (u32x4){Bp[2 * s].x, Bp[2 * s].y, Bp[2 * s + 1].x, Bp[2 * s + 1].y}); Rf[s] = __builtin_bit_cast(bf16x8, (u32x4){Rp[2 * s].x, Rp[2 * s].y, Rp[2 * s + 1].x, Rp[2 * s + 1].y}); }
            f32x4 Ab = fzero4(), AbT = Ab, Ak = Ab, DkT = Ab, DbT = Ab;
#pragma unroll
            for (int s = 0; s < 2; ++s) {
                Ab = __builtin_amdgcn_mfma_f32_16x16x32_bf16(Qf[s], Bf[s], Ab, 0, 0, 0);
                AbT = __builtin_amdgcn_mfma_f32_16x16x32_bf16(Bf[s], Qf[s], AbT, 0, 0, 0);
                Ak = __builtin_amdgcn_mfma_f32_16x16x32_bf16(Qf[s], Kf[s], Ak, 0, 0, 0);
                DkT = __builtin_amdgcn_mfma_f32_16x16x32_bf16(Kf[s], Rf[s], DkT, 0, 0, 0);
                DbT = __builtin_amdgcn_mfma_f32_16x16x32_bf16(Bf[s], Rf[s], DbT, 0, 0, 0); }
            f32x4 N, NT, ident;
#pragma unroll
            for (int r = 0; r < 4; ++r) { const int row = 4 * g + r;
                N[r] = (fr < row) ? -Ab[r] : 0.f; Ak[r] = (fr < row) ? Ak[r] : 0.f;
                NT[r] = (row < fr) ? -AbT[r] : 0.f;
                DkT[r] = (row <= fr) ? DkT[r] : 0.f; DbT[r] = (row <= fr) ? -DbT[r] : 0.f;
                ident[r] = (row == fr) ? 1.f : 0.f; }
            const f32x4 N2 = mm16(NT, N), N2T = mm16(N, NT);
            const f32x4 N4 = mm16(N2T, N2), N4T = mm16(N2, N2T);
            const f32x4 N8T = mm16(N4, N4T);
            const f32x4 X1 = N + ident, X1T = NT + ident, X2 = N2 + ident, X2T = N2T + ident, X4 = N4 + ident, X8T = N8T + ident;
            const f32x4 U12 = mm16(X1T, X2), U12T = mm16(X1, X2T), U34T = mm16(X4, X8T);
            const f32x4 TT = mm16(U12, U34T);
            const f32x4 M1T = mm16(Ak, TT);
#pragma unroll
            for (int ct = 0; ct < 4; ++ct) { const int c = 2 * ct + (g >> 1);
                *(LAS u32x2*)(Qt_i + fr * 128 + rw3_trswz(fr, c) * 16 + (g & 1) * 8) = Qp[ct]; }
            s16x4 qtr[4];
#pragma unroll
            for (int ct = 0; ct < 4; ++ct) { const int row = 4 * g + q4, c = 2 * ct + (p4 >> 1);
                qtr[ct] = __builtin_amdgcn_ds_read_tr16_b64_v4i16((LAS s16x4*)(Qt_i + row * 128 + rw3_trswz(row, c) * 16 + (p4 & 1) * 8)); }
            const bf16x8 TTf = pack_lo4(TT);
            f32x4 Qt[4];
#pragma unroll
            for (int ct = 0; ct < 4; ++ct) { const bf16x8 af = (bf16x8){qtr[ct][0], qtr[ct][1], qtr[ct][2], qtr[ct][3], 0, 0, 0, 0};
                Qt[ct] = __builtin_amdgcn_mfma_f32_16x16x32_bf16(af, TTf, fzero4(), 0, 0, 0); }
#pragma unroll
            for (int ct = 0; ct < 4; ++ct) {
                const int s = ct >> 1, hh = ct & 1;
                u32x2 w; w.x = cvt_pk_bf16(Qt[ct][0], Qt[ct][1]); w.y = cvt_pk_bf16(Qt[ct][2], Qt[ct][3]);
                *(LAS u32x2*)(Qt_i + fr * 128 + (((s * 4 + g) ^ (fr & 7)) * 16) + hh * 8) = w;
                *(LAS u32x2*)(Rh_i + fr * 128 + (((s * 4 + g) ^ (fr & 7)) * 16) + hh * 8) = Rp[ct];
                const int c = 2 * ct + (g >> 1);
                *(LAS u32x2*)(Kh_i + fr * 128 + rw3_trswz(fr, c) * 16 + (g & 1) * 8) = Kp[ct];
                *(LAS u32x2*)(Bn_i + fr * 128 + rw3_trswz(fr, c) * 16 + (g & 1) * 8) = (u32x2){Bp[ct].x ^ 0x80008000u, Bp[ct].y ^ 0x80008000u}; }
            { const int cs = (g ^ ((fr >> 2) & 3)) * 16;
                u32x2 w; w.x = cvt_pk_bf16(M1T[0], M1T[1]); w.y = cvt_pk_bf16(M1T[2], M1T[3]);
                *(LAS u32x2*)(M1_i + fr * 64 + cs) = (u32x2){0u, 0u}; *(LAS u32x2*)(M1_i + fr * 64 + cs + 8) = w;
                w.x = cvt_pk_bf16(DbT[0], DbT[1]); w.y = cvt_pk_bf16(DbT[2], DbT[3]); *(LAS u32x2*)(DD_i + fr * 64 + cs) = w;
                w.x = cvt_pk_bf16(DkT[0], DkT[1]); w.y = cvt_pk_bf16(DkT[2], DkT[3]); *(LAS u32x2*)(DD_i + fr * 64 + cs + 8) = w; }
        }
        if (role == 0) {
            if (hk >= 2 && tid == 0) { for (unsigned sp = 0; rw_ld(f_cons) < (unsigned)(hk - 1) && sp < (1u << 22); ++sp) __builtin_amdgcn_s_sleep(2); }
            __syncthreads();
            { LAS const unsigned char* sl = slots + wid * RW3_SLOT; const unsigned doff = (unsigned)((xslot - xb) + (size_t)wid * RW3_SLOT);
                for (int i = lane; i < RW3_SLOT / 16; i += 64) __builtin_amdgcn_raw_buffer_store_b128(*(const LAS u32x4*)(sl + i * 16), xrsrc, doff + (unsigned)i * 16u, 0, 16); }
            asm volatile("s_waitcnt vmcnt(0)" ::: "memory");
            __syncthreads();
            if (tid == 0) __hip_atomic_store(f_prod, (unsigned)(hk + 1), __ATOMIC_RELAXED, __HIP_MEMORY_SCOPE_AGENT);
            continue;
        }
        if (tid == 0) { for (unsigned sp = 0; rw_ld(f_prod) < (unsigned)(hk + 1) && sp < (1u << 22); ++sp) __builtin_amdgcn_s_sleep(2);
            __builtin_amdgcn_fence(__ATOMIC_ACQUIRE, "agent"); asm volatile("s_waitcnt vmcnt(0)" ::: "memory"); }
        __syncthreads();
        for (int i = tid; i < 8 * RW3_SLOT / 16; i += 512) *(LAS u32x4*)(slots + i * 16) = *(const u32x4*)(xslot + (size_t)i * 16);
        asm volatile("s_waitcnt vmcnt(0) lgkmcnt(0)" ::: "memory");
        __syncthreads();
        if (tid == 0) __hip_atomic_store(f_cons, (unsigned)(hk + 1), __ATOMIC_RELAXED, __HIP_MEMORY_SCOPE_AGENT);
        if (wid < 4) {
#pragma unroll 1
            for (int j = 0; j < 8; ++j) {
                int lane_t = lane; asm volatile("" : "+v"(lane_t));
                const int fr = lane_t & 15, g = lane_t >> 4, q4 = fr >> 2, p4 = fr & 3;
                LAS unsigned char* sl = slots + j * RW3_SLOT;
                LAS unsigned char* Qt_i = sl, * Rh_i = sl + 2048, * Kh_i = sl + 4096, * Bn_i = sl + 6144, * Vi_i = sl + 8192, * M1_i = sl + 10240, * DD_i = sl + 11264; LAS const float* gam_i = (LAS const float*)(sl + 12288);
                const bf16x8 Hb0 = pack_8(Hacc[0], Hacc[1]), Hb1 = pack_8(Hacc[2], Hacc[3]);
                const int trow = 4 * g + q4;
                const s16x4 vv = __builtin_amdgcn_ds_read_tr16_b64_v4i16((LAS s16x4*)(Vi_i + trow * 128 + rw3_trswz(trow, 2 * wid + (p4 >> 1)) * 16 + (p4 & 1) * 8));
                const bf16x8 q0 = *(const LAS bf16x8*)(Qt_i + fr * 128 + (((0 + g) ^ (fr & 7)) * 16)), q1 = *(const LAS bf16x8*)(Qt_i + fr * 128 + (((4 + g) ^ (fr & 7)) * 16));
                const bf16x8 r0 = *(const LAS bf16x8*)(Rh_i + fr * 128 + (((0 + g) ^ (fr & 7)) * 16)), r1 = *(const LAS bf16x8*)(Rh_i + fr * 128 + (((4 + g) ^ (fr & 7)) * 16));
                const int cs = (g ^ ((fr >> 2) & 3)) * 16;
                const bf16x8 m1 = *(const LAS bf16x8*)(M1_i + fr * 64 + cs), dd = *(const LAS bf16x8*)(DD_i + fr * 64 + cs);
                const bf16x8 v0 = (bf16x8){0, 0, 0, 0, vv[0], vv[1], vv[2], vv[3]};
                f32x4 Z = fzero4();
                Z = __builtin_amdgcn_mfma_f32_16x16x32_bf16(q0, Hb0, Z, 0, 0, 0); Z = __builtin_amdgcn_mfma_f32_16x16x32_bf16(q1, Hb1, Z, 0, 0, 0); Z = __builtin_amdgcn_mfma_f32_16x16x32_bf16(m1, v0, Z, 0, 0, 0);
                u32x2 zw; zw.x = cvt_pk_bf16(Z[0], Z[1]); zw.y = cvt_pk_bf16(Z[2], Z[3]);
                const s16x4 zs = __builtin_bit_cast(s16x4, zw);
                const bf16x8 zv = (bf16x8){zs[0], zs[1], zs[2], zs[3], vv[0], vv[1], vv[2], vv[3]};
                f32x4 Y = fzero4();
                Y = __builtin_amdgcn_mfma_f32_16x16x32_bf16(r0, Hb0, Y, 0, 0, 0); Y = __builtin_amdgcn_mfma_f32_16x16x32_bf16(r1, Hb1, Y, 0, 0, 0); Y = __builtin_amdgcn_mfma_f32_16x16x32_bf16(dd, zv, Y, 0, 0, 0);
                const size_t nrow = nb0 + (size_t)(tick * 8 + j) * 16 + 4 * g;
#pragma unroll
                for (int r = 0; r < 4; ++r) yraw[(nrow + r) * 512 + h * 64 + wid * 16 + fr] = Y[r];
#pragma unroll
                for (int rt = 0; rt < 4; ++rt) { const int c = 2 * rt + (p4 >> 1);
                    const s16x4 bn = __builtin_amdgcn_ds_read_tr16_b64_v4i16((LAS s16x4*)(Bn_i + trow * 128 + rw3_trswz(trow, c) * 16 + (p4 & 1) * 8));
                    const s16x4 kh = __builtin_amdgcn_ds_read_tr16_b64_v4i16((LAS s16x4*)(Kh_i + trow * 128 + rw3_trswz(trow, c) * 16 + (p4 & 1) * 8));
                    const bf16x8 af = (bf16x8){bn[0], bn[1], bn[2], bn[3], kh[0], kh[1], kh[2], kh[3]};
                    Hacc[rt] = __builtin_amdgcn_mfma_f32_16x16x32_bf16(af, zv, Hacc[rt], 0, 0, 0);
                    Hacc[rt] = Hacc[rt] * *(const LAS f32x4*)(gam_i + rt * 16 + g * 4); }
            }
        }
        __syncthreads();
    }
#undef MIXB
#undef RW3_LOADS
#undef lrc
#undef lkc
#undef lvc
#undef lrp
#undef lkp
#undef lvp
}

__device__ __forceinline__ void phase_rwkv_epi(const Params& p, int bid, int nb) {
    const int tid = opaque_tid(), wid = tid >> 6, lane = tid & 63;
    const float* yraw = p.out; const bf16_t* e1g = (const bf16_t*)(p.out + (size_t)NTOK * 512); const bf16_t* gg = e1g + (size_t)NTOK * 512;
    bf16_t* mix = (bf16_t*)(p.ws + OFF_BUF64);
    const f32x4 g0 = *(const f32x4*)(p.in[I_AGNG] + lane * 8), g1 = *(const f32x4*)(p.in[I_AGNG] + lane * 8 + 4), b0 = *(const f32x4*)(p.in[I_AGNB] + lane * 8), b1 = *(const f32x4*)(p.in[I_AGNB] + lane * 8 + 4);
    for (int n = bid * 8 + wid; n < NTOK; n += nb * 8) {
        const f32x4 y0 = *(const f32x4*)(yraw + (size_t)n * 512 + lane * 8), y1 = *(const f32x4*)(yraw + (size_t)n * 512 + lane * 8 + 4);
        const u32x4 ev = *(const u32x4*)(e1g + (size_t)n * 512 + lane * 8), gv = *(const u32x4*)(gg + (size_t)n * 512 + lane * 8);
#if SANITIZE
        f32x4 y0s = y0, y1s = y1;
#pragma unroll
        for (int j = 0; j < 4; ++j) { if (!(fabsf(y0s[j]) < 1e30f)) y0s[j] = 0.f; if (!(fabsf(y1s[j]) < 1e30f)) y1s[j] = 0.f; }
#define y0 y0s
#define y1 y1s
#endif
        float s = (y0[0] + y0[1]) + (y0[2] + y0[3]) + (y1[0] + y1[1]) + (y1[2] + y1[3]);
        s = red8(s); const float mean = s * (1.0f / 64.0f);
        const f32x4 d0 = y0 - mean, d1 = y1 - mean;
        float q = (d0[0] * d0[0] + d0[1] * d0[1]) + (d0[2] * d0[2] + d0[3] * d0[3]) + (d1[0] * d1[0] + d1[1] * d1[1]) + (d1[2] * d1[2] + d1[3] * d1[3]);
        q = red8(q); const float rs = rsqrtf(q * (1.0f / 64.0f) + 64e-5f);
        float o[8];
        const unsigned ew[4] = {ev.x, ev.y, ev.z, ev.w}, gw[4] = {gv.x, gv.y, gv.z, gv.w};
#pragma unroll
        for (int j = 0; j < 4; ++j) { const float ya = (j < 2 ? d0[2 * j] : d1[2 * j - 4]), yb = (j < 2 ? d0[2 * j + 1] : d1[2 * j - 3]);
            const float ga = (j < 2 ? g0[2 * j] : g1[2 * j - 4]), gb_ = (j < 2 ? g0[2 * j + 1] : g1[2 * j - 3]); const float ba = (j < 2 ? b0[2 * j] : b1[2 * j - 4]), bb_ = (j < 2 ? b0[2 * j + 1] : b1[2 * j - 3]);
            o[2 * j] = (ya * rs * ga + ba + __uint_as_float(ew[j] << 16)) * __uint_as_float(gw[j] << 16);
            o[2 * j + 1] = (yb * rs * gb_ + bb_ + __uint_as_float(ew[j] & 0xffff0000u)) * __uint_as_float(gw[j] & 0xffff0000u); }
        u32x4 w; w.x = cvt_pk_bf16(o[0], o[1]); w.y = cvt_pk_bf16(o[2], o[3]); w.z = cvt_pk_bf16(o[4], o[5]); w.w = cvt_pk_bf16(o[6], o[7]);
#if SANITIZE
#undef y0
#undef y1
#pragma unroll
        for (int j = 0; j < 8; ++j) if (!(fabsf(o[j]) < 1e30f)) o[j] = 0.f;
        w.x = cvt_pk_bf16(o[0], o[1]); w.y = cvt_pk_bf16(o[2], o[3]); w.z = cvt_pk_bf16(o[4], o[5]); w.w = cvt_pk_bf16(o[6], o[7]);
#endif
        *(u32x4*)(mix + (size_t)n * DM + lane * 8) = w;
    }
}

__device__ __forceinline__ int gla_fT(int row) { return ((row >> 1) & 1) | (((row >> 3) & 1) << 1); }
__device__ __forceinline__ int gla_hV(int row) { return (row & 3) | (((row >> 3) & 1) << 2); }
__device__ __forceinline__ void gla2_item(const Params& p, LAS unsigned char* lds, int item, int seg) {
    const int tid = opaque_tid(), lane = tid & 63, wid = tid >> 6, fr = lane & 15, g = lane >> 4;
    const int b = item >> 2, h = item & 3;
    const bf16_t* P0 = (const bf16_t*)(p.ws + OFF_P) + 1792;
    const float* xa16 = (const float*)(p.ws + OFF_U);
    bf16_t* mix = (bf16_t*)(p.ws + OFF_BUF64);
    LAS float* bcf = (LAS float*)lds;
    LAS float* tot = bcf + 64 * 64;
    LAS float* bls = tot + 8 * 64;
    LAS float* pn = bls + 64;
    LAS float* xs = pn + 64 * 8;
    LAS float* boff = xs + 2 * 1024;
    LAS unsigned char* qd_i = (LAS unsigned char*)(boff + 64);
    LAS unsigned char* ki_a = qd_i + 8192;
    LAS unsigned char* ki_t = ki_a + 8192;
    LAS unsigned char* att_i = ki_t + 8192;
    LAS unsigned char* v_i = att_i + 8192;
    for (int i = tid; i < 8192 / 16; i += 512) *(LAS u32x4*)(att_i + i * 16) = uzero4();
    float gw2[16];
#pragma unroll
    for (int i = 0; i < 16; ++i) gw2[i] = p.in[I_BGW2][i * 256 + h * 64 + lane];
    const float gb = p.in[I_BGB][h * 64 + lane];
    const f32x4 ngv = *(const f32x4*)(p.in[I_BNG] + h * 128 + wid * 16 + g * 4);
    f32x4 Sacc[4];
#pragma unroll
    for (int rt = 0; rt < 4; ++rt) Sacc[rt] = fzero4();
    const int q4 = fr >> 2, p4 = fr & 3;
    const int tok = tid >> 3, dc = tid & 7;
    u32x4 nq, nk, nv0, nv1; u32x2 ngate[4]; f32x4 nxa = fzero4();
#define GLA_ISSUE(c0n) do { const size_t _n = (size_t)b * SEQ + (c0n) + tok; \
        nq = *(const u32x4*)(P0 + _n * NE_MAIN + h * 64 + dc * 8); nk = *(const u32x4*)(P0 + _n * NE_MAIN + 256 + h * 64 + dc * 8); \
        nv0 = *(const u32x4*)(P0 + _n * NE_MAIN + 512 + h * 128 + dc * 16); nv1 = *(const u32x4*)(P0 + _n * NE_MAIN + 512 + h * 128 + dc * 16 + 8); \
        _Pragma("unroll") for (int _ct = 0; _ct < 4; ++_ct) ngate[_ct] = *(const u32x2*)(P0 + ((size_t)b * SEQ + (c0n) + _ct * 16 + fr) * NE_MAIN + 1024 + h * 128 + wid * 16 + g * 4); \
        if (tid < 256) nxa = *(const f32x4*)(xa16 + ((size_t)b * SEQ + (c0n)) * 16 + tid * 4); } while (0)
    const int cbeg = seg * (SEQ / 2), cend = cbeg + SEQ / 2;
    float* oraw = (float*)(p.ws + OFF_GLA_ORAW); bf16_t* qdgb = (bf16_t*)(p.ws + OFF_GLA_QDG);
    GLA_ISSUE(cbeg);
    if (tid < 256) *(LAS f32x4*)(xs + ((cbeg >> 6) & 1) * 1024 + tid * 4) = nxa;
    if (tid < 64) boff[tid] = 0.f;
    __syncthreads();
    for (int c0 = cbeg; c0 < cend; c0 += 64) {
        const size_t n0 = (size_t)b * SEQ + c0;
        LAS const float* xsc = xs + ((c0 >> 6) & 1) * 1024;
        { float run = 0.f;
#pragma unroll
            for (int tt = 0; tt < 8; ++tt) { const int c = wid * 8 + tt; float z = gb;
#pragma unroll
                for (int i4 = 0; i4 < 4; ++i4) { const f32x4 xv = *(const LAS f32x4*)(xsc + c * 16 + i4 * 4); z += xv[0] * gw2[i4 * 4] + xv[1] * gw2[i4 * 4 + 1] + xv[2] * gw2[i4 * 4 + 2] + xv[3] * gw2[i4 * 4 + 3]; }
                const float ls = fminf(z, 0.f) - __logf(1.0f + __expf(-fabsf(z)));
                run += ls * (1.0f / 16.0f); bcf[c * 64 + lane] = run; }
            tot[wid * 64 + lane] = run; }
        __syncthreads();
        { float off = 0.f;
            for (int w2 = 0; w2 < wid; ++w2) off += tot[w2 * 64 + lane];
#pragma unroll
            for (int tt = 0; tt < 8; ++tt) bcf[(wid * 8 + tt) * 64 + lane] += off;
            if (wid == 7) bls[lane] = __expf(bcf[63 * 64 + lane]); }
        __syncthreads();
        u32x2 gate[4];
        { const f32x4 bc0 = *(const LAS f32x4*)(bcf + tok * 64 + dc * 8), bc1 = *(const LAS f32x4*)(bcf + tok * 64 + dc * 8 + 4);
            const unsigned qw[4] = {nq.x, nq.y, nq.z, nq.w}, kw[4] = {nk.x, nk.y, nk.z, nk.w};
            float qo[8], ko[8];
#pragma unroll
            for (int j = 0; j < 4; ++j) { const float ba = (j < 2 ? bc0[2 * j] : bc1[2 * j - 4]), bb = (j < 2 ? bc0[2 * j + 1] : bc1[2 * j - 3]);
                const float ea = __expf(ba), eb = __expf(bb), ia = fast_rcp(ea), ib = fast_rcp(eb);
                qo[2 * j] = __uint_as_float(qw[j] << 16) * 0.125f * ea; qo[2 * j + 1] = __uint_as_float(qw[j] & 0xffff0000u) * 0.125f * eb;
                ko[2 * j] = __uint_as_float(kw[j] << 16) * ia; ko[2 * j + 1] = __uint_as_float(kw[j] & 0xffff0000u) * ib; }
            u32x4 qp, kp; qp.x = cvt_pk_bf16(qo[0], qo[1]); qp.y = cvt_pk_bf16(qo[2], qo[3]); qp.z = cvt_pk_bf16(qo[4], qo[5]); qp.w = cvt_pk_bf16(qo[6], qo[7]);
            kp.x = cvt_pk_bf16(ko[0], ko[1]); kp.y = cvt_pk_bf16(ko[2], ko[3]); kp.z = cvt_pk_bf16(ko[4], ko[5]); kp.w = cvt_pk_bf16(ko[6], ko[7]);
            *(LAS u32x4*)(qd_i + tok * 128 + ((dc ^ (tok & 7)) * 16)) = qp;
            if (seg) {
                const f32x4 bo0 = *(const LAS f32x4*)(boff + dc * 8), bo1 = *(const LAS f32x4*)(boff + dc * 8 + 4); float qg[8];
#pragma unroll
                for (int j = 0; j < 8; ++j) qg[j] = qo[j] * __expf(j < 4 ? bo0[j] : bo1[j - 4]);
                u32x4 w; w.x = cvt_pk_bf16(qg[0], qg[1]); w.y = cvt_pk_bf16(qg[2], qg[3]); w.z = cvt_pk_bf16(qg[4], qg[5]); w.w = cvt_pk_bf16(qg[6], qg[7]);
                *(u32x4*)(qdgb + ((size_t)b * 2048 + (c0 - cbeg) + tok) * 256 + h * 64 + dc * 8) = w; }
            *(LAS u32x4*)(ki_a + tok * 128 + ((dc ^ (tok & 7)) * 16)) = kp;
            *(LAS u32x4*)(ki_t + tok * 128 + (((((dc >> 1) ^ gla_fT(tok)) << 1) | (dc & 1)) * 16)) = kp;
            { const int pr = dc ^ gla_hV(tok); *(LAS u32x4*)(v_i + tok * 256 + (pr * 2) * 16) = nv0; *(LAS u32x4*)(v_i + tok * 256 + (pr * 2 + 1) * 16) = nv1; }
#pragma unroll
            for (int ct = 0; ct < 4; ++ct) gate[ct] = ngate[ct]; }
        if (c0 + 64 < cend) GLA_ISSUE(c0 + 64);
        __syncthreads();
        for (int ti = wid; ti < 10; ti += 8) {
            int st, ct; { const int tb[10] = {0x00, 0x01, 0x02, 0x03, 0x11, 0x12, 0x13, 0x22, 0x23, 0x33}; int code = 0;
#pragma unroll
                for (int k = 0; k < 10; ++k) if (k == ti) code = tb[k];
                st = code >> 4; ct = code & 15; }
            f32x4 d = fzero4();
            const int rs_ = st * 16 + fr, rc_ = ct * 16 + fr;
#pragma unroll
            for (int s = 0; s < 2; ++s) {
                const bf16x8 a = *(const LAS bf16x8*)(ki_a + rs_ * 128 + (((s * 4 + g) ^ (rs_ & 7)) * 16));
                const bf16x8 bq = *(const LAS bf16x8*)(qd_i + rc_ * 128 + (((s * 4 + g) ^ (rc_ & 7)) * 16));
                d = __builtin_amdgcn_mfma_f32_16x16x32_bf16(a, bq, d, 0, 0, 0); }
            const int c = ct * 16 + fr; float o4[4];
#pragma unroll
            for (int r = 0; r < 4; ++r) { const int s_ = st * 16 + g * 4 + r; o4[r] = (s_ <= c) ? d[r] : 0.f; }
            u32x2 w; w.x = cvt_pk_bf16(o4[0], o4[1]); w.y = cvt_pk_bf16(o4[2], o4[3]);
            *(LAS u32x2*)(att_i + c * 128 + (((2 * st + (g >> 1)) ^ (c & 7)) * 16) + (g & 1) * 8) = w;
        }
        if (seg && tid < 64) boff[tid] += bcf[63 * 64 + tid];
        __syncthreads();
        {
            bf16x8 vf[2];
#pragma unroll
            for (int s = 0; s < 2; ++s) {
                const int r1 = s * 32 + g * 8 + q4, r2 = r1 + 4; const int c = 2 * wid + (p4 >> 1);
                const s16x4 lo = __builtin_amdgcn_ds_read_tr16_b64_v4i16((LAS s16x4*)(v_i + r1 * 256 + (((((c >> 1) ^ gla_hV(r1)) << 1) | (c & 1)) * 16) + (p4 & 1) * 8));
                const s16x4 hi = __builtin_amdgcn_ds_read_tr16_b64_v4i16((LAS s16x4*)(v_i + r2 * 256 + (((((c >> 1) ^ gla_hV(r2)) << 1) | (c & 1)) * 16) + (p4 & 1) * 8));
                vf[s] = (bf16x8){lo[0], lo[1], lo[2], lo[3], hi[0], hi[1], hi[2], hi[3]}; }
            bf16x8 sf[2];
#pragma unroll
            for (int s = 0; s < 2; ++s) sf[s] = pack_8g(Sacc[2 * s], Sacc[2 * s + 1]);
            f32x4 oacc[4];
#pragma unroll
            for (int ct = 0; ct < 4; ++ct) {
                const int c = ct * 16 + fr; f32x4 d = fzero4();
#pragma unroll
                for (int s = 0; s < 2; ++s) {
                    const bf16x8 ab = *(const LAS bf16x8*)(att_i + c * 128 + (((s * 4 + g) ^ (c & 7)) * 16));
                    d = __builtin_amdgcn_mfma_f32_16x16x32_bf16(vf[s], ab, d, 0, 0, 0);
                    const s16x4 q0 = *(const LAS s16x4*)(qd_i + c * 128 + (((s * 4 + (g >> 1)) ^ (c & 7)) * 16) + (g & 1) * 8);
                    const s16x4 q1 = *(const LAS s16x4*)(qd_i + c * 128 + (((s * 4 + 2 + (g >> 1)) ^ (c & 7)) * 16) + (g & 1) * 8);
                    const bf16x8 qb = (bf16x8){q0[0], q0[1], q0[2], q0[3], q1[0], q1[1], q1[2], q1[3]};
                    d = __builtin_amdgcn_mfma_f32_16x16x32_bf16(sf[s], qb, d, 0, 0, 0); }
                oacc[ct] = d; }
#pragma unroll
            for (int rt = 0; rt < 4; ++rt) {
#pragma unroll
                for (int s = 0; s < 2; ++s) {
                    const int r1 = s * 32 + g * 8 + q4, r2 = r1 + 4; const int c = 2 * rt + (p4 >> 1);
                    const s16x4 lo = __builtin_amdgcn_ds_read_tr16_b64_v4i16((LAS s16x4*)(ki_t + r1 * 128 + (((((c >> 1) ^ gla_fT(r1)) << 1) | (c & 1)) * 16) + (p4 & 1) * 8));
                    const s16x4 hi = __builtin_amdgcn_ds_read_tr16_b64_v4i16((LAS s16x4*)(ki_t + r2 * 128 + (((((c >> 1) ^ gla_fT(r2)) << 1) | (c & 1)) * 16) + (p4 & 1) * 8));
                    const bf16x8 kf = (bf16x8){lo[0], lo[1], lo[2], lo[3], hi[0], hi[1], hi[2], hi[3]};
                    Sacc[rt] = __builtin_amdgcn_mfma_f32_16x16x32_bf16(kf, vf[s], Sacc[rt], 0, 0, 0); }
                const f32x4 eb = *(const LAS f32x4*)(bls + rt * 16 + g * 4);
                Sacc[rt] = Sacc[rt] * eb; }
#pragma unroll
            for (int ct = 0; ct < 4; ++ct) { float ss = oacc[ct][0] * oacc[ct][0] + oacc[ct][1] * oacc[ct][1] + oacc[ct][2] * oacc[ct][2] + oacc[ct][3] * oacc[ct][3];
                ss += __shfl_xor(ss, 16); ss += __shfl_xor(ss, 32);
                if (g == 0) pn[(ct * 16 + fr) * 8 + wid] = ss; }
            if (tid < 256 && c0 + 64 < cend) *(LAS f32x4*)(xs + (((c0 >> 6) + 1) & 1) * 1024 + tid * 4) = nxa;
            __syncthreads();
            if (seg) {
#pragma unroll
                for (int ct = 0; ct < 4; ++ct) *(f32x4*)(oraw + ((size_t)b * 2048 + (c0 - cbeg) + ct * 16 + fr) * 512 + h * 128 + wid * 16 + g * 4) = oacc[ct];
            } else
#pragma unroll
            for (int ct = 0; ct < 4; ++ct) { const int c = ct * 16 + fr;
                const f32x4 a0 = *(const LAS f32x4*)(pn + c * 8), a1 = *(const LAS f32x4*)(pn + c * 8 + 4);
                const float ss = (a0[0] + a0[1]) + (a0[2] + a0[3]) + (a1[0] + a1[1]) + (a1[2] + a1[3]);
                const float rs = rsqrtf(ss * (1.0f / 128.0f) + 1e-5f);
                const u32x2 gv = gate[ct];
                const float g0 = __uint_as_float(gv.x << 16), g1 = __uint_as_float(gv.x & 0xffff0000u), g2 = __uint_as_float(gv.y << 16), g3 = __uint_as_float(gv.y & 0xffff0000u);
                const float v0 = oacc[ct][0] * rs * ngv[0] * (g0 * fast_sigmoid(g0)), v1 = oacc[ct][1] * rs * ngv[1] * (g1 * fast_sigmoid(g1));
                const float v2 = oacc[ct][2] * rs * ngv[2] * (g2 * fast_sigmoid(g2)), v3 = oacc[ct][3] * rs * ngv[3] * (g3 * fast_sigmoid(g3));
                u32x2 w; w.x = cvt_pk_bf16(v0, v1); w.y = cvt_pk_bf16(v2, v3);
                *(u32x2*)(mix + (n0 + c) * DM + 512 + h * 128 + wid * 16 + g * 4) = w; }
        }
    }
    if (seg == 0) { float* sin_ = (float*)(p.ws + OFF_GLA_SIN) + (size_t)item * 64 * 128;
#pragma unroll
        for (int rt = 0; rt < 4; ++rt)
#pragma unroll
            for (int r = 0; r < 4; ++r) sin_[(rt * 16 + g * 4 + r) * 128 + wid * 16 + fr] = Sacc[rt][r]; }
#undef GLA_ISSUE
}

__device__ __forceinline__ void phase_gla_fix(const Params& p, LAS unsigned char* lds, int bid, int nb) {
    const int tid = opaque_tid(), lane = tid & 63, wid = tid >> 6, fr = lane & 15, g = lane >> 4;
    const bf16_t* P0 = (const bf16_t*)(p.ws + OFF_P) + 1792;
    const float* oraw = (const float*)(p.ws + OFF_GLA_ORAW); const bf16_t* qdgb = (const bf16_t*)(p.ws + OFF_GLA_QDG); const float* sinb = (const float*)(p.ws + OFF_GLA_SIN);
    bf16_t* mix = (bf16_t*)(p.ws + OFF_BUF64);
    LAS unsigned char* st_i = lds;
    LAS float* pn = (LAS float*)(lds + 16384);
    for (int it = bid; it < 32 * 32; it += nb) {
        const int item = it >> 5, ch = it & 31, b = item >> 2, h = item & 3;
        __syncthreads();
        { const float* sp = sinb + (size_t)item * 64 * 128;
            const int e_ = tid >> 2, d0 = (tid & 3) * 16; float v[16];
#pragma unroll
            for (int j = 0; j < 16; ++j) v[j] = sp[(d0 + j) * 128 + e_];
#pragma unroll
            for (int c2 = 0; c2 < 2; ++c2) { u32x4 w; w.x = cvt_pk_bf16(v[c2 * 8], v[c2 * 8 + 1]); w.y = cvt_pk_bf16(v[c2 * 8 + 2], v[c2 * 8 + 3]); w.z = cvt_pk_bf16(v[c2 * 8 + 4], v[c2 * 8 + 5]); w.w = cvt_pk_bf16(v[c2 * 8 + 6], v[c2 * 8 + 7]);
                const int c = (d0 >> 3) + c2; *(LAS u32x4*)(st_i + e_ * 128 + ((c ^ (e_ & 7)) * 16)) = w; } }
        __syncthreads();
        const size_t t0 = (size_t)b * 2048 + ch * 64;
        const size_t n0 = (size_t)b * SEQ + 2048 + ch * 64;
        const f32x4 ngv = *(const f32x4*)(p.in[I_BNG] + h * 128 + wid * 16 + g * 4);
        f32x4 oacc[4];
#pragma unroll
        for (int ct = 0; ct < 4; ++ct) {
            const int c = ct * 16 + fr;
            f32x4 d = *(const f32x4*)(oraw + (t0 + c) * 512 + h * 128 + wid * 16 + g * 4);
#pragma unroll
            for (int s = 0; s < 2; ++s) {
                const int er = wid * 16 + fr;
                const bf16x8 a = *(const LAS bf16x8*)(st_i + er * 128 + (((s * 4 + g) ^ (er & 7)) * 16));
                const bf16x8 bq = *(const bf16x8*)(qdgb + (t0 + c) * 256 + h * 64 + s * 32 + g * 8);
                d = __builtin_amdgcn_mfma_f32_16x16x32_bf16(a, bq, d, 0, 0, 0); }
            oacc[ct] = d; }
#pragma unroll
        for (int ct = 0; ct < 4; ++ct) { float ss = oacc[ct][0] * oacc[ct][0] + oacc[ct][1] * oacc[ct][1] + oacc[ct][2] * oacc[ct][2] + oacc[ct][3] * oacc[ct][3];
            ss += __shfl_xor(ss, 16); ss += __shfl_xor(ss, 32);
            if (g == 0) pn[(ct * 16 + fr) * 8 + wid] = ss; }
        __syncthreads();
#pragma unroll
        for (int ct = 0; ct < 4; ++ct) { const int c = ct * 16 + fr;
            const f32x4 a0 = *(const LAS f32x4*)(pn + c * 8), a1 = *(const LAS f32x4*)(pn + c * 8 + 4);
            const float ss = (a0[0] + a0[1]) + (a0[2] + a0[3]) + (a1[0] + a1[1]) + (a1[2] + a1[3]);
            const float rs = rsqrtf(ss * (1.0f / 128.0f) + 1e-5f);
            const u32x2 gv = *(const u32x2*)(P0 + (n0 + c) * NE_MAIN + 1024 + h * 128 + wid * 16 + g * 4);
            const float g0 = __uint_as_float(gv.x << 16), g1 = __uint_as_float(gv.x & 0xffff0000u), g2 = __uint_as_float(gv.y << 16), g3 = __uint_as_float(gv.y & 0xffff0000u);
            const float v0 = oacc[ct][0] * rs * ngv[0] * (g0 * fast_sigmoid(g0)), v1 = oacc[ct][1] * rs * ngv[1] * (g1 * fast_sigmoid(g1));
            const float v2 = oacc[ct][2] * rs * ngv[2] * (g2 * fast_sigmoid(g2)), v3 = oacc[ct][3] * rs * ngv[3] * (g3 * fast_sigmoid(g3));
            u32x2 w; w.x = cvt_pk_bf16(v0, v1); w.y = cvt_pk_bf16(v2, v3);
            *(u32x2*)(mix + (n0 + c) * DM + 512 + h * 128 + wid * 16 + g * 4) = w; }
    }
}


__device__ __forceinline__ void phase_mixer_even(const Params& p, LAS unsigned char* lds, int bid, int nb, int which) {
    PROBE_DECL;
    PROBE_BEGIN(47);
    if (nb >= 224) {
        if (bid < 64) { if (which != 2) rwkv3_item(p, lds, bid, 1, 0); }
        else if (bid < 192) { if (which != 2) rwkv3_item(p, lds, (bid - 64) >> 1, 0, (bid - 64) & 1); }
        else { if (which != 1) gla2_item(p, lds, (bid - 192) >> 1, (bid - 192) & 1); }
    }
    __syncthreads();
    PROBE_END(47);
    PROBE_BEGIN(48);
    if (which == 0) phase_prep(p, lds, bid, nb, 1);
    PROBE_END(48);
#if PROBE_ID == 47 || PROBE_ID == 48
    if (bid == PROBE_BLK && opaque_tid() == 0) *(float*)(p.ws + OFF_MISC + MISC_PROBE) = (float)probe_acc * 3e-8f;
#endif
}

__device__ __forceinline__ void phase_rope(const Params& p, int bid, int nb) {
    const int tid = opaque_tid(), wid = tid >> 6, lane = tid & 63;
    unsigned char* ws = p.ws;
    const bf16_t* Pd = (const bf16_t*)(ws + OFF_PD);
    bf16_t* qr = (bf16_t*)(ws + OFF_U); bf16_t* kr = (bf16_t*)(ws + OFF_KR); bf16_t* vv = (bf16_t*)(ws + OFF_VV);
    bf16_t* iqr = (bf16_t*)(ws + OFF_IQR); bf16_t* ikr = (bf16_t*)(ws + OFF_IKR); float* iw = (float*)(ws + OFF_IW);
    const float* c64 = (const float*)(ws + OFF_ROPE); const float* s64 = c64 + 4096 * 64; const float* c32 = s64 + 4096 * 64; const float* s32 = c32 + 4096 * 32;
    const float ikg = p.in[I_CIKG][lane], ikb = p.in[I_CIKB][lane];
    for (int n = bid * 8 + wid; n < NTOK; n += nb * 8) {
        const int pos = n & (SEQ - 1);
        const bf16_t* row = Pd + (size_t)n * NO_MAIN;
#define ROPE8(off1, off2, cs, sn, scale, dst, d1, d2) do { \
            const u32x4 a_ = *(const u32x4*)(row + (off1)), b_ = *(const u32x4*)(row + (off2)); \
            const f32x4 c0_ = *(const f32x4*)(cs), c1_ = *(const f32x4*)((cs) + 4), s0_ = *(const f32x4*)(sn), s1_ = *(const f32x4*)((sn) + 4); \
            const unsigned aw_[4] = {a_.x, a_.y, a_.z, a_.w}, bw_[4] = {b_.x, b_.y, b_.z, b_.w}; float o1_[8], o2_[8]; \
            _Pragma("unroll") for (int j_ = 0; j_ < 4; ++j_) { \
                const float z1a = __uint_as_float(aw_[j_] << 16), z1b = __uint_as_float(aw_[j_] & 0xffff0000u), z2a = __uint_as_float(bw_[j_] << 16), z2b = __uint_as_float(bw_[j_] & 0xffff0000u); \
                const float ca = (j_ < 2 ? c0_[2 * j_] : c1_[2 * j_ - 4]), cb = (j_ < 2 ? c0_[2 * j_ + 1] : c1_[2 * j_ - 3]), sa = (j_ < 2 ? s0_[2 * j_] : s1_[2 * j_ - 4]), sb = (j_ < 2 ? s0_[2 * j_ + 1] : s1_[2 * j_ - 3]); \
                o1_[2 * j_] = (z1a * ca - z2a * sa) * (scale); o1_[2 * j_ + 1] = (z1b * cb - z2b * sb) * (scale); o2_[2 * j_] = (z2a * ca + z1a * sa) * (scale); o2_[2 * j_ + 1] = (z2b * cb + z1b * sb) * (scale); } \
            u32x4 w1_, w2_; w1_.x = cvt_pk_bf16(o1_[0], o1_[1]); w1_.y = cvt_pk_bf16(o1_[2], o1_[3]); w1_.z = cvt_pk_bf16(o1_[4], o1_[5]); w1_.w = cvt_pk_bf16(o1_[6], o1_[7]); \
            w2_.x = cvt_pk_bf16(o2_[0], o2_[1]); w2_.y = cvt_pk_bf16(o2_[2], o2_[3]); w2_.z = cvt_pk_bf16(o2_[4], o2_[5]); w2_.w = cvt_pk_bf16(o2_[6], o2_[7]); \
            *(u32x4*)((dst) + (d1)) = w1_; *(u32x4*)((dst) + (d2)) = w2_; } while (0)
        { const int h = lane >> 3, jb = (lane & 7) * 8;
            ROPE8(h * 128 + jb, h * 128 + 64 + jb, c64 + pos * 64 + jb, s64 + pos * 64 + jb, 0.08838834764831845f, qr + (size_t)n * 1024, h * 128 + jb, h * 128 + 64 + jb); }
        if (lane < 8) { const int jb = lane * 8;
            ROPE8(1024 + jb, 1024 + 64 + jb, c64 + pos * 64 + jb, s64 + pos * 64 + jb, 1.0f, kr + (size_t)n * 128, jb, 64 + jb); }
        else if (lane < 24) { const int c = (lane - 8) * 8;
            *(u32x4*)(vv + (size_t)n * 128 + c) = *(const u32x4*)(row + 1152 + c); }
        else if (lane < 40) { const int h = (lane - 24) >> 2, jb = ((lane - 24) & 3) * 8;
            ROPE8(1280 + h * 64 + jb, 1280 + h * 64 + 32 + jb, c32 + pos * 32 + jb, s32 + pos * 32 + jb, 0.125f, iqr + (size_t)n * 256, h * 64 + jb, h * 64 + 32 + jb); }
#undef ROPE8
        const int j32 = lane & 31; const float cc = c32[pos * 32 + j32], ss = s32[pos * 32 + j32];
        { const float x = bf2f(row[1536 + lane]); const float mean = wave_sum(x) * (1.0f / 64.0f); const float d = x - mean; const float var = wave_sum(d * d) * (1.0f / 64.0f);
            const float y = d * rsqrtf(var + LN_EPS) * ikg + ikb; const float o = __shfl_xor(y, 32);
            const float res = lane < 32 ? (y * cc - o * ss) : (y * cc + o * ss);
            ikr[(size_t)n * 64 + lane] = f2bf(res); }
        if (lane < 4) iw[(size_t)n * 4 + lane] = bf2f(row[1600 + lane]) * 0.5f;
    }
}


__device__ __forceinline__ int opq(int v) { asm volatile("" : "+v"(v)); return v; }
#ifndef ATTX
#define ATTX 0
#endif
template <int MODE>
__device__ __forceinline__ void attn_query(const bf16_t* qr, const bf16_t* kr, const bf16_t* vv, bf16_t* ao, int n, LAS const unsigned short* ks, LAS const unsigned short* ksv, LAS unsigned char* vbuf, int lane PROBE_PARAMS) {
    const int fr = lane & 15, g = lane >> 4, q4 = fr >> 2, p4 = fr & 3;
    const int t = n & (SEQ - 1), b = n >> 12, cnt = (t + 1) < 256 ? (t + 1) : 256;
    {
        bf16x8 qf[4];
#pragma unroll
        for (int s = 0; s < 4; ++s) { qf[s] = (bf16x8){0, 0, 0, 0, 0, 0, 0, 0}; if (fr < 8) qf[s] = *(const bf16x8*)(qr + (size_t)n * 1024 + fr * 128 + s * 32 + g * 8); }
        const bf16_t* kbase = kr + (size_t)b * SEQ * 128; const bf16_t* vbase = vv + (size_t)b * SEQ * 128;
        f32x4 acc[16];
        bf16x8 kf[3][2][4];
        const u32x4 kidx0 = *(LAS const u32x4*)(ks + fr * 16), kidx1 = *(LAS const u32x4*)(ks + fr * 16 + 8);
#define ATT_KLOAD(buf, grp) do { _Pragma("unroll") for (int t2 = 0; t2 < 2; ++t2) { const int tl_ = (grp) * 2 + t2; const int key_ = (int)(((tl_ < 8 ? kidx0 : kidx1)[(tl_ & 7) >> 1] >> ((tl_ & 1) * 16)) & 0xffffu); \
            const bf16_t* kp_ = kbase + (size_t)key_ * 128 + g * 8; _Pragma("unroll") for (int s = 0; s < 4; ++s) kf[buf][t2][s] = *(const bf16x8*)(kp_ + s * 32); } } while (0)
        PROBE_BEGIN(12);
        ATT_KLOAD(0, 0); ATT_KLOAD(1, 1);
#pragma unroll
        for (int grp = 0; grp < 8; ++grp) {
            if (grp + 2 < 8) ATT_KLOAD((grp + 2) % 3, grp + 2);
#pragma unroll
            for (int t2 = 0; t2 < 2; ++t2) { f32x4 a = fzero4();
#pragma unroll
                for (int s = 0; s < 4; ++s) a = __builtin_amdgcn_mfma_f32_16x16x32_bf16(kf[grp % 3][t2][s], qf[s], a, 0, 0, 0);
                acc[grp * 2 + t2] = a; }
        }
#undef ATT_KLOAD
        PROBE_END(12);
        PROBE_BEGIN(13);
        u32x4 vr[3][8];
#define ATT_VLOAD(buf, s) do { unsigned pr_[4]; _Pragma("unroll") for (int i = 0; i < 4; ++i) pr_[i] = *(LAS const unsigned*)(ksv + (i * 4 + g) * 16 + 2 * (s)); \
            _Pragma("unroll") for (int i = 0; i < 8; ++i) { const int kl_ = i * 4 + g; const int key_ = (int)(i < 4 ? (pr_[i & 3] & 0xffffu) : (pr_[i & 3] >> 16)); \
            const int c_ = fr ^ ((kl_ & 7) << 1); vr[buf][i] = *(const u32x4*)(vbase + (size_t)key_ * 128 + c_ * 8); } } while (0)
        ATT_VLOAD(0, 0); ATT_VLOAD(1, 1);
        float m = -INFINITY;
#pragma unroll
        for (int tl = 0; tl < 16; ++tl)
#pragma unroll
            for (int r = 0; r < 4; ++r) { if ((g * 4 + r) * 16 + tl >= cnt) acc[tl][r] = -INFINITY; m = fmaxf(m, acc[tl][r]); }
        m = fmaxf(m, __shfl_xor(m, 16)); m = fmaxf(m, __shfl_xor(m, 32));
        float sum = 0.f;
#pragma unroll
        for (int tl = 0; tl < 16; ++tl)
#pragma unroll
            for (int r = 0; r < 4; ++r) { const float e_ = __expf(acc[tl][r] - m); acc[tl][r] = e_; sum += e_; }
        sum += __shfl_xor(sum, 16); sum += __shfl_xor(sum, 32);
        const float inv = 1.0f / sum;
        bf16x8 pf[8];
#pragma unroll
        for (int s = 0; s < 8; ++s) pf[s] = pack_8g(acc[2 * s], acc[2 * s + 1]);
        PROBE_END(13);
        PROBE_BEGIN(14);
        f32x4 o[8];
#pragma unroll
        for (int dt = 0; dt < 8; ++dt) o[dt] = fzero4();
#pragma unroll
        for (int s = 0; s < 8; ++s) {
            LAS unsigned char* vb = vbuf + (s & 1) * 8192;
            if (s + 2 < 8) ATT_VLOAD((s + 2) % 3, s + 2);
#pragma unroll
            for (int i = 0; i < 8; ++i) { const int kl = i * 4 + g; *(LAS u32x4*)(vb + kl * 256 + fr * 16) = vr[s % 3][i]; }
            const int kl1 = 4 * g + q4, kl2 = 16 + 4 * g + q4;
#pragma unroll
            for (int dt = 0; dt < 8; ++dt) {
                const int c = 2 * dt + (p4 >> 1);
                const s16x4 lo = __builtin_amdgcn_ds_read_tr16_b64_v4i16((LAS s16x4*)(vb + kl1 * 256 + ((c ^ ((kl1 & 7) << 1)) * 16) + (p4 & 1) * 8));
                const s16x4 hi = __builtin_amdgcn_ds_read_tr16_b64_v4i16((LAS s16x4*)(vb + kl2 * 256 + ((c ^ ((kl2 & 7) << 1)) * 16) + (p4 & 1) * 8));
                const bf16x8 af = (bf16x8){lo[0], lo[1], lo[2], lo[3], hi[0], hi[1], hi[2], hi[3]};
                o[dt] = __builtin_amdgcn_mfma_f32_16x16x32_bf16(af, pf[s], o[dt], 0, 0, 0);
            }
        }
#undef ATT_VLOAD
        PROBE_END(14);
        if (fr < 8) {
#pragma unroll
            for (int dt = 0; dt < 8; ++dt) { u32x2 w; w.x = cvt_pk_bf16(o[dt][0] * inv, o[dt][1] * inv); w.y = cvt_pk_bf16(o[dt][2] * inv, o[dt][3] * inv);
                *(u32x2*)(ao + (size_t)n * 1024 + fr * 128 + dt * 16 + g * 4) = w; }
        }
    }
}

__device__ __forceinline__ int idx_bin(float s, float lo, float scale) { int b = (int)((s - lo) * scale); b = b < 0 ? 0 : b; return b > 255 ? 255 : b; }
__device__ __forceinline__ unsigned ord_key(float s) { const unsigned u = __float_as_uint(s); return (u & 0x80000000u) ? ~u : (u | 0x80000000u); }
__device__ __forceinline__ float ord_val(unsigned k) { return __uint_as_float((k & 0x80000000u) ? (k & 0x7fffffffu) : ~k); }
__device__ __forceinline__ void phase_index2(const Params& p, LAS unsigned char* lds, int bid, int nb) {
    const int tid = opaque_tid(), wid = __builtin_amdgcn_readfirstlane(tid >> 6), lane0 = tid & 63;
    unsigned char* ws = p.ws;
    const bf16_t* iqr = (const bf16_t*)(ws + OFF_IQR); const bf16_t* ikr = (const bf16_t*)(ws + OFF_IKR); const float* iw = (const float*)(ws + OFF_IW);
    const bf16_t* qr = (const bf16_t*)(ws + OFF_U); const bf16_t* kr = (const bf16_t*)(ws + OFF_KR); const bf16_t* vv = (const bf16_t*)(ws + OFF_VV); bf16_t* ao = (bf16_t*)(ws + OFF_PD);
    LAS unsigned short* out = (LAS unsigned short*)(lds + 131072 + 24576) + wid * 256;
    LAS float* sc = (LAS float*)lds;
    LAS int* hist = (LAS int*)(lds + 131072) + wid * 256;
    LAS float* candv = (LAS float*)(lds + 131072 + 8192) + wid * 264;
    LAS unsigned short* candi = (LAS unsigned short*)(lds + 131072 + 8192 + 8 * 264 * 4) + wid * 256;
    LAS unsigned* mm = (LAS unsigned*)(lds + 131072 + 8192 + 8 * 264 * 4 + 8 * 512);
    const int ntile = NTOK / 8;
    PROBE_DECL;
    PROBE_BEGIN(9);
    unsigned* tctr = (unsigned*)(ws + OFF_MISC + MISC_PCTR) + 16;
    LAS int* tsh = (LAS int*)(lds + LDS_BYTES - 1536);
    for (;;) {
        __syncthreads();
        if (tid == 0) tsh[0] = (int)__hip_atomic_fetch_add(tctr, 1u, __ATOMIC_RELAXED, __HIP_MEMORY_SCOPE_AGENT);
        __syncthreads();
        const int it = __builtin_amdgcn_readfirstlane(tsh[0]);
        if (it >= ntile) break;
        const int qt = (it & 7) * 512 + (511 - (it >> 3));
        const int n0 = qt * 8, t0 = n0 & (SEQ - 1), b = n0 >> 12;
        int lane = lane0; asm volatile("" : "+v"(lane));
        const int fr = lane & 15, g = lane >> 4; const unsigned long long lt_mask = (1ull << lane) - 1ull;
        asm volatile("" ::: "memory");
        if (tid < 16) mm[tid] = (tid & 1) ? 0u : 0xffffffffu;
        __syncthreads();
        PROBE_BEGIN(1);
#pragma unroll 1
        for (int genrep = 0; genrep < (IDXPROBE == 1 ? 2 : 1); ++genrep)
        if (t0 + 8 > 256) {
            bf16x8 af[2][2];
#pragma unroll
            for (int hh = 0; hh < 2; ++hh)
#pragma unroll
                for (int s = 0; s < 2; ++s) af[hh][s] = *(const bf16x8*)(iqr + (size_t)(n0 + 2 * (fr >> 2) + ((fr >> 1) & 1)) * 256 + (2 * hh + (fr & 1)) * 64 + s * 32 + g * 8);
            const f32x4 wq0 = *(const f32x4*)(iw + (size_t)(n0 + 2 * g) * 4), wq1 = *(const f32x4*)(iw + (size_t)(n0 + 2 * g + 1) * 4);
            float vmin0 = INFINITY, vmax0 = -INFINITY, vmin1 = INFINITY, vmax1 = -INFINITY;
            const int nkt = (t0 + 8 + 15) >> 4;
            const bf16_t* kb = ikr + (size_t)b * SEQ * 64;
            bf16x8 pb0[3], pb1[3];
#pragma unroll
            for (int i = 0; i < 2; ++i) { const int ktp = wid + 8 * i < nkt ? wid + 8 * i : wid; const bf16_t* kp = kb + (size_t)(ktp * 16 + fr) * 64 + g * 8; pb0[i] = *(const bf16x8*)kp; pb1[i] = *(const bf16x8*)(kp + 32); }
            for (int kt = wid; kt < nkt; kt += 8) {
                { const int ktp = kt + 16 < nkt ? kt + 16 : kt; const bf16_t* kp = kb + (size_t)(ktp * 16 + fr) * 64 + g * 8; pb0[2] = *(const bf16x8*)kp; pb1[2] = *(const bf16x8*)(kp + 32); }
                const bf16x8 b0 = pb0[0], b1 = pb1[0];
                pb0[0] = pb0[1]; pb1[0] = pb1[1]; pb0[1] = pb0[2]; pb1[1] = pb1[2];
                f32x4 d0 = fzero4(), d1 = fzero4();
                d0 = __builtin_amdgcn_mfma_f32_16x16x32_bf16(af[0][0], b0, d0, 0, 0, 0); d0 = __builtin_amdgcn_mfma_f32_16x16x32_bf16(af[0][1], b1, d0, 0, 0, 0);
                d1 = __builtin_amdgcn_mfma_f32_16x16x32_bf16(af[1][0], b0, d1, 0, 0, 0); d1 = __builtin_amdgcn_mfma_f32_16x16x32_bf16(af[1][1], b1, d1, 0, 0, 0);
                float s0 = fmaxf(d0[0], 0.f) * wq0[0] + fmaxf(d0[1], 0.f) * wq0[1] + fmaxf(d1[0], 0.f) * wq0[2] + fmaxf(d1[1], 0.f) * wq0[3];
                float s1 = fmaxf(d0[2], 0.f) * wq1[0] + fmaxf(d0[3], 0.f) * wq1[1] + fmaxf(d1[2], 0.f) * wq1[2] + fmaxf(d1[3], 0.f) * wq1[3];
                s0 += 0.0f; s1 += 0.0f;
                vmin0 = fminf(vmin0, s0); vmax0 = fmaxf(vmax0, s0); vmin1 = fminf(vmin1, s1); vmax1 = fmaxf(vmax1, s1);
                sc[(2 * g) * 4096 + kt * 16 + fr] = s0; sc[(2 * g + 1) * 4096 + kt * 16 + fr] = s1;
            }
#pragma unroll
            for (int j = 0; j < 2; ++j) { float mn = j ? vmin1 : vmin0, mx = j ? vmax1 : vmax0;
                mn = fminf(mn, dppf<0xB1>(mn)); mn = fminf(mn, dppf<0x4E>(mn)); mn = fminf(mn, dppf<0x141>(mn)); mn = fminf(mn, dppf<0x140>(mn));
                mx = fmaxf(mx, dppf<0xB1>(mx)); mx = fmaxf(mx, dppf<0x4E>(mx)); mx = fmaxf(mx, dppf<0x141>(mx)); mx = fmaxf(mx, dppf<0x140>(mx));
                if (fr == 0 && mx >= mn) { const int q = 2 * g + j;
                    __hip_atomic_fetch_min(mm + q * 2, ord_key(mn), __ATOMIC_RELAXED, __HIP_MEMORY_SCOPE_WORKGROUP); __hip_atomic_fetch_max(mm + q * 2 + 1, ord_key(mx), __ATOMIC_RELAXED, __HIP_MEMORY_SCOPE_WORKGROUP); } }
        }
        PROBE_END(1);
        PROBE_BEGIN(2);
        __syncthreads();
        PROBE_END(2);
        PROBE_BEGIN(7);
#pragma unroll 1
        for (int selrep = 0; selrep < (IDXPROBE == 2 ? 2 : 1); ++selrep)
        {
            const int n = n0 + wid, t = t0 + wid, nv = t + 1;
            if (nv <= 256) { for (int j = lane; j < 256; j += 64) out[j] = (unsigned short)(j < nv ? j : 0); }
            else {
                LAS const float* srow = sc + wid * 4096;
                const int nvp = (nv + 255) & ~255;
                const unsigned kmax = mm[wid * 2 + 1];
                const int kbase = (int)(kmax >> 19) - 255;
                unsigned P = 0u; int sh = 32;
                bool capped = false;
                float lo = ord_val(mm[wid * 2]), hi = ord_val(mm[wid * 2 + 1]);
                float lo1 = 0.f, sc1 = 0.f, lo2 = 0.f, sc2 = 0.f, lo3 = 0.f, sc3 = 0.f; int b1 = 0, b2 = 0, b3 = 0, nlev = 0;
                int m = nv, need = 256;
#define IDX_HIST_SCAN(bin, nneed, mmc, lumpc) do { int hb[4]; \
                    _Pragma("unroll") for (int j = 0; j < 4; ++j) hb[j] = hist[lane * 4 + j]; \
                    if (lane == 0) hb[0] += (lumpc); \
                    const int tot = hb[0] + hb[1] + hb[2] + hb[3]; int suf = tot; \
                    _Pragma("unroll") for (int off = 1; off < 64; off <<= 1) { const int v = __shfl_down(suf, off); if (lane + off < 64) suf += v; } \
                    const int above = suf - tot; const bool is = (above < need) && (need <= suf); \
                    bin = 0; nneed = 0; mmc = 0; \
                    if (is) { int c = above; \
                        _Pragma("unroll") for (int k = 3; k >= 0; --k) { if (nneed == 0) { if (need <= c + hb[k]) { bin = lane * 4 + k; nneed = need - c; mmc = hb[k]; } else c += hb[k]; } } } \
                    const unsigned long long bal = __ballot(is); const int srcl = __ffsll((long long)bal) - 1; \
                    bin = __shfl(bin, srcl); nneed = __shfl(nneed, srcl); mmc = __shfl(mmc, srcl); } while (0)
#define IDX_ZERO_HIST() do { int z = 0; asm volatile("" : "+v"(z)); _Pragma("unroll") for (int j = 0; j < 4; ++j) hist[lane * 4 + j] = z; } while (0)
                PROBE_BEGIN(3);
                {
                    IDX_ZERO_HIST();
                    int lumpl = 0;
                    for (int c0 = 0; c0 < nvp; c0 += 256) { const f32x4 s4 = *(const LAS f32x4*)(srow + c0 + lane * 4);
#pragma unroll
                        for (int e_ = 0; e_ < 4; ++e_) { const unsigned k = ord_key(s4[e_]); const int bin = (int)(k >> 19) - kbase; const bool valid = c0 + lane * 4 + e_ < nv;
                            if (valid && bin > 0) __hip_atomic_fetch_add(hist + bin, 1, __ATOMIC_RELAXED, __HIP_MEMORY_SCOPE_WORKGROUP);
                            lumpl += (valid && bin <= 0) ? 1 : 0; } }
                    int lump = lumpl;
#pragma unroll
                    for (int o = 32; o > 0; o >>= 1) lump += __shfl_xor(lump, o);
                    int bin, nneed, mmc; IDX_HIST_SCAN(bin, nneed, mmc, lump);
                    need = nneed; m = mmc;
                    if (bin > 0) { P = (unsigned)(kbase + bin); sh = 19; }
                    else { capped = true; hi = ord_val(((unsigned)(kbase + 1) << 19) - 1u); if (hi < lo) hi = lo; }
                }
                PROBE_END(3);
                PROBE_BEGIN(4);
#pragma unroll 1
                while (!capped && m > 128 && sh > 0) {
                    const int nsh = sh > 8 ? sh - 8 : 0; const unsigned dmask = (1u << (sh - nsh)) - 1u;
                    IDX_ZERO_HIST();
                    for (int c0 = 0; c0 < nvp; c0 += 256) { const f32x4 s4 = *(const LAS f32x4*)(srow + c0 + lane * 4);
#pragma unroll
                        for (int e_ = 0; e_ < 4; ++e_) { const unsigned k = ord_key(s4[e_]);
                            if (c0 + lane * 4 + e_ < nv && (k >> sh) == P) __hip_atomic_fetch_add(hist + ((k >> nsh) & dmask), 1, __ATOMIC_RELAXED, __HIP_MEMORY_SCOPE_WORKGROUP); } }
                    int bin, nneed, mmc; IDX_HIST_SCAN(bin, nneed, mmc, 0);
                    P = (P << (sh - nsh)) | (unsigned)bin; sh = nsh; need = nneed; m = mmc;
                }
#define IDX_CLASSIFY(s, cls) do { \
                    if (!capped) { const unsigned kk_ = sh >= 32 ? 0u : (ord_key(s) >> sh); cls = kk_ > P ? 2 : (kk_ == P ? 1 : 0); } \
                    else if ((int)(ord_key(s) >> 19) > kbase) cls = 2; \
                    else { cls = 1; \
                        if (nlev >= 1) { const int bb = idx_bin(s, lo1, sc1); if (bb != b1) cls = bb > b1 ? 2 : 0; } \
                        if (cls == 1 && nlev >= 2) { const int bb = idx_bin(s, lo2, sc2); if (bb != b2) cls = bb > b2 ? 2 : 0; } \
                        if (cls == 1 && nlev >= 3) { const int bb = idx_bin(s, lo3, sc3); if (bb != b3) cls = bb > b3 ? 2 : 0; } } } while (0)
#pragma unroll 1
                while (capped && m > 128 && nlev < 3 && (hi - lo) > 1e-30f) {
                    const float width = hi - lo, scale = 256.0f / width;
                    IDX_ZERO_HIST();
                    for (int c0 = 0; c0 < nvp; c0 += 256) { const f32x4 s4 = *(const LAS f32x4*)(srow + c0 + lane * 4);
#pragma unroll
                        for (int e_ = 0; e_ < 4; ++e_) { const float s = s4[e_]; int cls; IDX_CLASSIFY(s, cls);
                            if (c0 + lane * 4 + e_ < nv && cls == 1) __hip_atomic_fetch_add(hist + idx_bin(s, lo, scale), 1, __ATOMIC_RELAXED, __HIP_MEMORY_SCOPE_WORKGROUP); } }
                    int bin, nneed, mmc; IDX_HIST_SCAN(bin, nneed, mmc, 0);
                    if (nlev == 0) { lo1 = lo; sc1 = scale; b1 = bin; } else if (nlev == 1) { lo2 = lo; sc2 = scale; b2 = bin; } else { lo3 = lo; sc3 = scale; b3 = bin; }
                    ++nlev; need = nneed; m = mmc;
                    const float w = width * (1.0f / 256.0f); lo = lo + (float)bin * w; hi = lo + w;
                }
#undef IDX_HIST_SCAN
#undef IDX_ZERO_HIST
                PROBE_END(4);
                PROBE_BEGIN(5);
                int base = 0, nc = 0;
                for (int c0 = 0; c0 < nvp; c0 += 256) { const f32x4 s4 = *(const LAS f32x4*)(srow + c0 + lane * 4);
                    bool su[4], ca[4]; int nsu = 0, nca = 0;
#pragma unroll
                    for (int e_ = 0; e_ < 4; ++e_) { const bool valid = c0 + lane * 4 + e_ < nv; int cls; IDX_CLASSIFY(s4[e_], cls); su[e_] = valid && cls == 2; ca[e_] = valid && cls == 1; nsu += su[e_] ? 1 : 0; nca += ca[e_] ? 1 : 0; }
                    unsigned long long bs4[4], bc4[4]; int ps = base, pc = nc, tots = 0, totc = 0;
#pragma unroll
                    for (int e_ = 0; e_ < 4; ++e_) { bs4[e_] = __ballot(su[e_]); bc4[e_] = __ballot(ca[e_]); ps += __popcll(bs4[e_] & lt_mask); pc += __popcll(bc4[e_] & lt_mask); tots += __popcll(bs4[e_]); totc += __popcll(bc4[e_]); }
#pragma unroll
                    for (int e_ = 0; e_ < 4; ++e_) { const int key = c0 + lane * 4 + e_;
                        if (su[e_]) { if (ps < 256) out[ps] = (unsigned short)key; ++ps; }
                        if (ca[e_]) { if (pc < 256) { candv[pc] = s4[e_]; candi[pc] = (unsigned short)key; } ++pc; } }
                    base += tots; nc += totc; }
#undef IDX_CLASSIFY
                PROBE_END(5);
                PROBE_BEGIN(6);
                const int mcap = nc < 256 ? nc : 256;
                float T = -INFINITY; int need_t = need;
                if (nc <= 256) {
                    float mine[4]; int cgt[4], cge[4];
#pragma unroll
                    for (int k = 0; k < 4; ++k) { mine[k] = (lane + 64 * k) < mcap ? candv[lane + 64 * k] : -INFINITY; cgt[k] = 0; cge[k] = 0; }
                    if (lane < 4 && mcap + lane < 260) candv[mcap + lane] = -INFINITY;
                    const int nk = (mcap + 63) >> 6;
                    for (int j = 0; j < mcap; j += 4) { const f32x4 vj = *(const LAS f32x4*)(candv + j);
#pragma unroll
                        for (int k = 0; k < 4; ++k) { if (k < nk) {
#pragma unroll
                            for (int e_ = 0; e_ < 4; ++e_) { cgt[k] += vj[e_] > mine[k] ? 1 : 0; cge[k] += vj[e_] >= mine[k] ? 1 : 0; } } } }
                    float tv = -INFINITY; int tg = 0; bool isT = false;
#pragma unroll
                    for (int k = 0; k < 4; ++k) { const bool ok = ((lane + 64 * k) < mcap) && (cgt[k] < need) && (need <= cge[k]); if (ok && !isT) { isT = true; tv = mine[k]; tg = cgt[k]; } }
                    const unsigned long long bT = __ballot(isT);
                    const int sl = __ffsll((long long)bT) - 1;
                    T = __shfl(tv, sl); need_t = need - __shfl(tg, sl);
                }
                int ties = 0;
                for (int c0 = 0; c0 < mcap; c0 += 64) { const int j = c0 + lane; const bool valid = j < mcap; const float s = valid ? candv[j] : -INFINITY;
                    const bool sure = valid && (nc <= 256) && s > T;
                    const bool tie = valid && ((nc <= 256) ? (s == T) : true);
                    const unsigned long long beq = __ballot(tie);
                    const int rank = ties + __popcll(beq & lt_mask);
                    const bool take = sure || (tie && rank < need_t);
                    const unsigned long long bt = __ballot(take);
                    const int pos = base + __popcll(bt & lt_mask);
                    if (take && pos < 256) out[pos] = candi[j];
                    base += __popcll(bt); ties += __popcll(beq); }
                PROBE_END(6);
            }
            PROBE_BEGIN(11);
            attn_query<0>(qr, kr, vv, ao, n, out, out, (LAS unsigned char*)(sc + wid * 4096), lane PROBE_PASS);
            if (ATTX) { asm volatile("" ::: "memory"); for (int j = lane; j < 256; j += 64) candi[j] = (unsigned short)j; asm volatile("" ::: "memory"); attn_query<1>(qr, kr, vv, (bf16_t*)(ws + OFF_U), n, ATTX >= 2 ? candi : out, ATTX >= 3 ? candi : out, (LAS unsigned char*)(sc + wid * 4096), lane PROBE_PASS); }
            PROBE_END(11);
        }
        PROBE_END(7);
        PROBE_BEGIN(8);
        __syncthreads();
        PROBE_END(8);
    }
    PROBE_END(9);
    PROBE_STORE(ws, bid, tid);
}


__device__ __forceinline__ void phase_inproj_even(const Params& p, LAS unsigned char* lds, int bid, int nb) {
    unsigned char* ws = p.ws;
    pg::DenseSched S; S.init(ws + OFF_BUF64, ws + OFF_WINE, NTOK, NE_MAIN, 1024, nb, bid);
    pg::EpiBf16 E; E.O = (bf16_t*)(ws + OFF_P); E.ldc = NE_MAIN;
    pg::gemm_phase(lds, 1024, S, E);
}
__device__ __forceinline__ void phase_inproj_odd(const Params& p, LAS unsigned char* lds, int bid, int nb) {
    unsigned char* ws = p.ws;
    pg::DenseSched S; S.init(ws + OFF_BUF64, ws + OFF_WINO, NTOK, NO_MAIN, 1024, nb, bid);
    pg::EpiBf16 E; E.O = (bf16_t*)(ws + OFF_PD); E.ldc = NO_MAIN;
    pg::gemm_phase(lds, 1024, S, E);
}
__device__ __forceinline__ void phase_outproj(const Params& p, LAS unsigned char* lds, int bid, int nb, size_t aoff, size_t woff, const float* X, const bf16_t* Xb) {
    unsigned char* ws = p.ws;
    pg::DenseSched S; S.init(ws + aoff, ws + woff, NTOK, 1024, 1024, nb, bid);
    pg::EpiResid E; E.X = X; E.Xb = Xb; E.U = (float*)(ws + OFF_U);
    pg::gemm_phase(lds, 1024, S, E);
}

#define XB_TMO      128
#define XB_XCNT(j)  (256  + 64 * (j))
#define XB_XSUB(j)  (1280 + 64 * (j))
#define XB_XGEN(j)  (2304 + 64 * (j))
#define XB_TOP      3328
#define XB_TOPGEN   3392
#define XCD_BAR_WORDS 3456
#define XB_SPIN_CAP (1u << 20)
__device__ __forceinline__ unsigned xb_ld(unsigned* p)              { return __hip_atomic_load(p, __ATOMIC_RELAXED, __HIP_MEMORY_SCOPE_AGENT); }
__device__ __forceinline__ unsigned xb_add(unsigned* p, unsigned v) { return __hip_atomic_fetch_add(p, v, __ATOMIC_RELAXED, __HIP_MEMORY_SCOPE_AGENT); }
__device__ __forceinline__ unsigned xb_xcc_id() { return (unsigned)__builtin_amdgcn_s_getreg((3 << 11) | 20) & 0xFu; }
#define XB_SPIN(cond, bar) do { unsigned _sp = 0; while (cond) { __builtin_amdgcn_s_sleep(1); \
    if ((++_sp & 255u) == 0u) { if (xb_ld(&(bar)[XB_TMO])) break; if (_sp > XB_SPIN_CAP) { atomicAdd(&(bar)[XB_TMO], 1u); break; } } } } while (0)
__device__ __forceinline__ void xcd_barrier_complete(unsigned* bar, unsigned x, unsigned& nloc, unsigned& nx) {
    const unsigned G = gridDim.x;
    unsigned sum, cnt, mine, sp = 0u;
    for (;;) {
        sum = 0u; cnt = 0u; mine = 0u;
#pragma unroll
        for (unsigned j = 0; j < 16; ++j) { const unsigned c = xb_ld(&bar[XB_XCNT(j)]); sum += c; cnt += (c > 0u) ? 1u : 0u; mine = (j == x) ? c : mine; }
        if (sum == G) break;
        __builtin_amdgcn_s_sleep(1);
        if ((++sp & 255u) == 0u) { if (xb_ld(&bar[XB_TMO])) break; if (sp > XB_SPIN_CAP) { atomicAdd(&bar[XB_TMO], 1u); break; } }
    }
    nloc = mine > 0u ? mine : 1u; nx = cnt > 0u ? cnt : 1u;
}
__device__ __forceinline__ void grid_barrier(unsigned* bar, volatile LAS unsigned* st) {
    asm volatile("s_waitcnt vmcnt(0) lgkmcnt(0)" ::: "memory");
    __syncthreads();
    if (threadIdx.x == 0) {
        const unsigned x = xb_xcc_id();
        __builtin_amdgcn_s_waitcnt(0);
        unsigned nloc = st[0], nx = st[1];
        if (nloc == 0u) { xcd_barrier_complete(bar, x, nloc, nx); st[0] = nloc; st[1] = nx; }
        const unsigned old = xb_add(&bar[XB_XSUB(x)], 1u);
        const unsigned gen = old / nloc;
        if (old + 1u == (gen + 1u) * nloc) {
            __builtin_amdgcn_fence(__ATOMIC_RELEASE, "agent");
            asm volatile("s_waitcnt vmcnt(0)" ::: "memory");
            const unsigned og = xb_add(&bar[XB_TOP], 1u);
            const unsigned tg = og / nx;
            if (og + 1u == (tg + 1u) * nx) xb_add(&bar[XB_TOPGEN], 1u);
            else XB_SPIN(xb_ld(&bar[XB_TOPGEN]) == tg, bar);
            __builtin_amdgcn_fence(__ATOMIC_ACQUIRE, "agent");
            xb_add(&bar[XB_XGEN(x)], 1u);
            asm volatile("s_waitcnt vmcnt(0)" ::: "memory");
        } else {
            XB_SPIN(xb_ld(&bar[XB_XGEN(x)]) == gen, bar);
            __builtin_amdgcn_fence(__ATOMIC_ACQUIRE, "agent");
            asm volatile("s_waitcnt vmcnt(0)" ::: "memory");
        }
    }
    __syncthreads();
}
#ifndef DUP
#define DUP 0
#endif
#define GSYNC() grid_barrier(bar_ctr, (volatile LAS unsigned*)(lds + LDS_BYTES - 1024))
__global__ __launch_bounds__(512, 2) void mega(KArgs a) {
    extern __shared__ __attribute__((aligned(16))) unsigned char smem[];
    LAS unsigned char* lds = (LAS unsigned char*)smem;
    Params p; p.in.t = (LAS const unsigned long long*)(lds + PTAB_OFF); p.out = a.out; p.ws = a.ws;
    if ((threadIdx.x & 63) == 0) ((LAS int*)(lds + WTAB_OFF))[hw_slot()] = threadIdx.x >> 6;
    if (threadIdx.x == 0) { LAS unsigned long long* tw_ = (LAS unsigned long long*)(lds + PTAB_OFF);
#pragma unroll
        for (int i = 0; i < 30; ++i) tw_[i] = (unsigned long long)a.in[i]; }
    __syncthreads();
    cg::grid_group grid = cg::this_grid();
    const int bid0 = blockIdx.x, nb0 = gridDim.x;
    unsigned* bar_ctr = (unsigned*)(p.ws + OFF_MISC + MISC_BAR);
    if (blockIdx.x == 0) for (int i = threadIdx.x; i < XCD_BAR_WORDS; i += 512) __hip_atomic_store(bar_ctr + i, 0u, __ATOMIC_RELAXED, __HIP_MEMORY_SCOPE_AGENT);
    if (threadIdx.x < 2) ((LAS unsigned*)(lds + LDS_BYTES - 1024))[threadIdx.x] = 0u;
    grid.sync();
    if (threadIdx.x == 0) (void)xb_add(&bar_ctr[XB_XCNT(xb_xcc_id())], 1u);
    int bid, nb;
#define FRESH() do { bid = bid0; nb = nb0; asm volatile("" : "+s"(bid), "+s"(nb)); } while (0)
#define PHP(pid, call) do { unsigned long long t0_ = 0; if (PROBE_ID == (pid)) t0_ = __builtin_amdgcn_s_memtime(); call; if (PROBE_ID == (pid) && bid0 == (PROBE_BLK) && opaque_tid() == 0) *(float*)(p.ws + OFF_MISC + MISC_PROBE) = (float)(__builtin_amdgcn_s_memtime() - t0_) * 1.5e-8f; } while (0)
#define RUNP(id, call) do { unsigned long long ts_ = 0; if (PROBE_ID == 200 + (id)) ts_ = __builtin_amdgcn_s_memtime(); FRESH(); call; GSYNC(); if (PROBE_ID == 200 + (id) && bid0 == 7 && opaque_tid() == 0) *(float*)(p.ws + OFF_MISC + MISC_PROBE) = (float)(__builtin_amdgcn_s_memtime() - ts_) * 1.5e-8f; if (DUP == id) { FRESH(); call; GSYNC(); } } while (0)
    RUNP(10, PHP(30, phase_prep(p, lds, bid, nb, 0)));
#if PROBE_ID == 20
    const unsigned long long kstart = __builtin_amdgcn_s_memtime();
#endif
#pragma unroll 1
    for (int layer = 0; layer < 2; ++layer) {
        if (layer == 0) {
            RUNP(31, PHP(31, phase_inproj_even(p, lds, bid, nb)));
            RUNP(21, PHP(44, phase_lora_act(p, bid, nb)));
            PHP(45, RUNP(1, PHP(33, phase_mixer_even(p, lds, bid, nb, 0))));
            FRESH(); PHP(34, phase_rwkv_epi(p, bid, nb));
            RUNP(13, PHP(46, phase_gla_fix(p, lds, bid, nb)));
        } else {
            RUNP(14, PHP(40, phase_inproj_odd(p, lds, bid, nb)));
            RUNP(15, PHP(41, phase_rope(p, bid, nb)));
            RUNP(2, PHP(43, phase_index2(p, lds, bid, nb)));
        }
        RUNP(16, PHP(35, phase_outproj(p, lds, bid, nb, layer ? OFF_PD : OFF_BUF64, layer ? OFF_WOUTO : OFF_WOUTE, p.in[I_X], layer ? (const bf16_t*)(p.ws + OFF_BUF64) : (const bf16_t*)nullptr)));
        RUNP(36, PHP(36, phase_ln_route(p, lds, bid, nb, layer)));
        RUNP(17, PHP(37, phase_moe_gateup(p, lds, bid, nb, layer)));
        RUNP(18, PHP(38, phase_moe_down(p, lds, bid, nb, layer)));
#if PROBE_ID == 20
        if (layer == 1) { if (bid0 == 7 && threadIdx.x == 0) *(float*)(p.ws + OFF_MISC + MISC_PROBE) = (float)(__builtin_amdgcn_s_memtime() - kstart) * 1e-8f; GSYNC(); }
#endif
        RUNP(19, PHP(39, phase_ln2(p, bid, nb, layer, p.out, true)));
    }
}

extern "C" void kernel_launch(void* const* d_in, const int* in_sizes, int n_in, void* d_out, int out_size, void* d_ws, size_t ws_size, hipStream_t stream) {
    if (ws_size < WS_NEED) { fprintf(stderr, "workspace too small: %zu < %zu\n", ws_size, (size_t)WS_NEED); return; }
    KArgs p{};
    for (int i = 0; i < 30; ++i) p.in[i] = (const float*)d_in[i];
    p.out = (float*)d_out; p.ws = (unsigned char*)d_ws;
    static int grid_blocks = 0;
    if (!grid_blocks) {
        (void)hipFuncSetAttribute((const void*)mega, hipFuncAttributeMaxDynamicSharedMemorySize, LDS_BYTES);
        int dev = 0, cus = 0, per_cu = 0;
        (void)hipGetDevice(&dev);
        (void)hipDeviceGetAttribute(&cus, hipDeviceAttributeMultiprocessorCount, dev);
        (void)hipOccupancyMaxActiveBlocksPerMultiprocessor(&per_cu, mega, 512, LDS_BYTES);
        if (per_cu < 1) { fprintf(stderr, "occupancy query returned %d\n", per_cu); per_cu = 1; }
        grid_blocks = cus;
    }
    void* args[] = {&p};
    hipError_t e = hipLaunchCooperativeKernel((void*)mega, dim3(grid_blocks), dim3(512), args, LDS_BYTES, stream);
    if (e != hipSuccess) fprintf(stderr, "cooperative launch failed: %s (grid %d)\n", hipGetErrorString(e), grid_blocks);
}
```

```cpp
#include <hip/hip_runtime.h>
#include <hip/hip_cooperative_groups.h>
#include <cstdio>
#include <cstdint>
namespace cg = cooperative_groups;

#ifndef PROBE_ID
#define PROBE_ID 0
#endif
#ifndef PROBE_BLK
#define PROBE_BLK 7
#endif
#ifndef IDXPROBE
#define IDXPROBE 0
#endif
#ifndef SANITIZE
#define SANITIZE 0
#endif
#ifndef PREP_REP
#define PREP_REP 1
#endif
constexpr int NTOK = 32768, SEQ = 4096, NB = 8, DM = 1024;
constexpr int EVEN_COLS = 3344, ODD_COLS = 1604;
constexpr int NE_MAIN = 3328;
constexpr int NO_MAIN = 1792;
constexpr int NEXP = 16, DEXP = 256;
constexpr float DN_ALPHA = 1.4142135623730951f;
constexpr float LN_EPS = 1e-5f;
constexpr int MOE_ROWS = 65536 + 16 * 256;

typedef unsigned short bf16_t;
typedef short bf16x8 __attribute__((ext_vector_type(8)));
typedef float f32x4 __attribute__((ext_vector_type(4)));
typedef short s16x4 __attribute__((ext_vector_type(4)));
typedef float f32x2 __attribute__((ext_vector_type(2)));
typedef unsigned u32x4 __attribute__((ext_vector_type(4)));
typedef unsigned u32x2 __attribute__((ext_vector_type(2)));
#define LAS __attribute__((address_space(3)))

typedef __bf16 bf16x2_t __attribute__((ext_vector_type(2)));
__device__ __forceinline__ unsigned cvt_pk_bf16(float lo, float hi) { bf16x2_t v; v[0] = (__bf16)lo; v[1] = (__bf16)hi; return __builtin_bit_cast(unsigned, v); }
__device__ __forceinline__ bf16_t f2bf(float f) { return (bf16_t)(cvt_pk_bf16(f, 0.f) & 0xffffu); }
__device__ __forceinline__ float bf2f(bf16_t h) { return __uint_as_float(((unsigned)h) << 16); }
constexpr int LDS_BYTES = 160 * 1024;
constexpr int PTAB_OFF = LDS_BYTES - 256;
constexpr int WTAB_OFF = LDS_BYTES - 512;
__device__ __forceinline__ int hw_slot() { return (int)(__builtin_amdgcn_s_getreg(0x2804) & 63u); }
__device__ __forceinline__ int opaque_tid() {
    extern __shared__ __attribute__((aligned(16))) unsigned char smem_[];
    const int w = __builtin_amdgcn_readfirstlane(((LAS const int*)((LAS unsigned char*)smem_ + WTAB_OFF))[hw_slot()]);
    int l; asm volatile("v_mbcnt_lo_u32_b32 %0, -1, 0\n\tv_mbcnt_hi_u32_b32 %0, -1, %0" : "=v"(l));
    return (w << 6) | l; }
#if PROBE_ID
#define PROBE_DECL unsigned long long probe_acc = 0, probe_t0 = 0
#define PROBE_PARAMS , unsigned long long& probe_acc, unsigned long long& probe_t0
#define PROBE_PASS , probe_acc, probe_t0
#define PROBE_BEGIN(id) do { if (PROBE_ID == (id)) probe_t0 = __builtin_amdgcn_s_memtime(); } while (0)
#define PROBE_END(id) do { if (PROBE_ID == (id)) probe_acc += __builtin_amdgcn_s_memtime() - probe_t0; } while (0)
#define PROBE_STORE(ws, bid, tid) do { if (PROBE_ID < 30 && (bid) == 7 && (tid) == 0) *(float*)((ws) + OFF_MISC + MISC_PROBE) = (float)probe_acc * 2e-8f; } while (0)
#else
#define PROBE_DECL
#define PROBE_PARAMS
#define PROBE_PASS
#define PROBE_BEGIN(id)
#define PROBE_END(id)
#define PROBE_STORE(ws, bid, tid)
#endif
__device__ __forceinline__ f32x4 fzero4() { float z = 0.f; asm volatile("" : "+v"(z)); return (f32x4){z, z, z, z}; }
__device__ __forceinline__ u32x4 uzero4() { unsigned z = 0u; asm volatile("" : "+v"(z)); return (u32x4){z, z, z, z}; }
__device__ __forceinline__ float fast_rcp(float x) { return __builtin_amdgcn_rcpf(x); }
__device__ __forceinline__ float fast_sigmoid(float x) { return fast_rcp(1.0f + __expf(-x)); }
__device__ __forceinline__ float fast_tanh(float x) { const float e = __expf(2.0f * x); return 1.0f - 2.0f * fast_rcp(1.0f + e); }
__device__ __forceinline__ bf16x8 pack_8g(const f32x4 a, const f32x4 b) { u32x4 w; w.x = cvt_pk_bf16(a[0], a[1]); w.y = cvt_pk_bf16(a[2], a[3]); w.z = cvt_pk_bf16(b[0], b[1]); w.w = cvt_pk_bf16(b[2], b[3]); return __builtin_bit_cast(bf16x8, w); }
template <int CTRL> __device__ __forceinline__ float dppf(float v) { return __builtin_bit_cast(float, __builtin_amdgcn_update_dpp(0, __builtin_bit_cast(int, v), CTRL, 0xf, 0xf, true)); }
__device__ __forceinline__ float wave_sum(float v) {
#pragma unroll
    for (int o = 32; o > 0; o >>= 1) v += __shfl_xor(v, o);
    return v;
}

constexpr size_t MiB = 1024ull * 1024ull;
constexpr size_t OFF_WINE = 0;
constexpr size_t OFF_WOUTE = OFF_WINE + (size_t)NE_MAIN * 1024 * 2;
constexpr size_t OFF_WINO = OFF_WOUTE + 2 * MiB;
constexpr size_t OFF_WOUTO = OFF_WINO + (size_t)NO_MAIN * 1024 * 2;
constexpr size_t OFF_WGU = OFF_WOUTO + 2 * MiB;
constexpr size_t OFF_WD = OFF_WGU + 32 * MiB;
constexpr size_t OFF_ROPE = OFF_WD + 16 * MiB;
constexpr size_t OFF_MISC = OFF_ROPE + 3 * MiB;
constexpr size_t OFF_BUF64 = OFF_MISC + 4 * MiB;
constexpr size_t OFF_P = OFF_BUF64 + 64 * MiB;
constexpr size_t OFF_U = OFF_P + 208 * MiB;
constexpr size_t WS_NEED = OFF_U + 128 * MiB;
constexpr size_t OFF_HE = OFF_P;
constexpr size_t OFF_ACT = OFF_HE + (size_t)MOE_ROWS * 1024 * 2;
constexpr size_t OFF_PD = OFF_P;
constexpr size_t OFF_KR = OFF_P + 112 * MiB;
constexpr size_t OFF_VV = OFF_KR + 8 * MiB;
constexpr size_t OFF_IQR = OFF_VV + 8 * MiB;
constexpr size_t OFF_IKR = OFF_IQR + 16 * MiB;
constexpr size_t OFF_IW = OFF_IKR + 4 * MiB;
constexpr size_t OFF_IDX = OFF_IW + 1 * MiB;
constexpr size_t MISC_CNT = 0;
constexpr size_t MISC_TOKINFO = 4096;
constexpr size_t MISC_TOKGATE = MISC_TOKINFO + (size_t)NTOK * 16;
constexpr size_t MISC_LIST = MISC_TOKGATE + (size_t)NTOK * 8;
constexpr size_t MISC_PROBE = 2304;
constexpr size_t MISC_W2T = 3 * MiB;
constexpr size_t MISC_A2T = MISC_W2T + 65536;
constexpr size_t MISC_G2T = MISC_A2T + 65536;
constexpr size_t MISC_BAR = MISC_G2T + 131072;
constexpr size_t MISC_RWF = MISC_BAR + 16384;
constexpr size_t MISC_PCTR = MISC_RWF + 16384;
constexpr size_t OFF_GLA_ORAW = OFF_U + 50 * MiB;
constexpr size_t OFF_GLA_QDG = OFF_U + 82 * MiB;
constexpr size_t OFF_GLA_SIN = OFF_U + 90 * MiB;
constexpr size_t OFF_RWXB = OFF_U + 24 * MiB;

struct InTab { LAS const unsigned long long* t;
    __device__ __forceinline__ const float* operator[](int i) const { const unsigned long long v = t[i];
        const unsigned lo = __builtin_amdgcn_readfirstlane((unsigned)v), hi = __builtin_amdgcn_readfirstlane((unsigned)(v >> 32));
        return (const float*)(((unsigned long long)hi << 32) | lo); } };
struct Params { InTab in; float* out; unsigned char* ws; };
struct KArgs { const float* in[30]; float* out; unsigned char* ws; };
enum { I_X = 0, I_WINE, I_AMU, I_AW0, I_AW2, I_AA0, I_AA2, I_AG2, I_AKK, I_AKA, I_ARK, I_AGNG, I_AGNB, I_BGW2, I_BGB, I_BNG, I_WOUTE,
       I_WINO, I_CIKG, I_CIKB, I_WOUTO, I_LN1G, I_LN1B, I_LN2G, I_LN2B, I_RW, I_RB, I_EG, I_EU, I_ED };

namespace pg {
constexpr int BM = 256, BK = 64, HALF = 128, HTB = HALF * BK * 2, STAGE_BYTES = 8 * HTB;
__host__ __device__ __forceinline__ int lds_byte(int r, int c) { const int st = (r >> 4) * 2 + (c >> 5), rr = r & 15, cc = c & 31, ob = rr * 64 + cc * 2; return st * 1024 + (ob ^ (((ob >> 9) & 1) << 5)); }
__host__ __device__ __forceinline__ void stage_rc(int b, int& R, int& C) { const int st = b / 1024, sb = b % 1024, swz = sb ^ (((sb >> 9) & 1) << 5); R = (st >> 1) * 16 + swz / 64; C = (st & 1) * 32 + (swz % 64) / 2; }
__host__ __device__ __forceinline__ int perm32(int rho) { const int n = rho >> 4, i = rho & 15; return 8 * (i >> 2) + 4 * n + (i & 3); }

struct Unit { int pm, pn, e, rt, cnt; };

template <class Epi, class Sched>
__device__ __forceinline__ void gemm_phase(LAS unsigned char* lds, const int K, const Sched& S, const Epi& E) {
    const int tid = opaque_tid(), wid = __builtin_amdgcn_readfirstlane(tid >> 6), lane = tid & 63, wr = wid >> 2, wc = wid & 3, fr = lane & 15, fq = lane >> 4;
    const int nt = K / BK;
    unsigned voffB[2];
#pragma unroll
    for (int i = 0; i < 2; ++i) { int R, C; stage_rc(tid * 16 + i * 8192, R, C); const int Rb = Epi::PERM ? ((R & ~31) + perm32(R & 31)) : R; voffB[i] = (unsigned)(Rb * K + C) * 2u; }
    const size_t kstep = (size_t)(BK * 2);
    const size_t hstepB = (size_t)HALF * K * 2;
    const unsigned ldsw = (unsigned)wid * 1024u;
    const int aoff = lds_byte(wr * 64 + fr, fq * 8), boff = lds_byte(wc * 32 + fr, fq * 8);
#define PG_SA(b, h) (((b) * 2 + (h)) * HTB)
#define PG_SB(b, h) ((4 + (b) * 2 + (h)) * HTB)
#define PG_STAGE(bufoff, gbase, voff) do { _Pragma("unroll") for (int _i = 0; _i < 2; ++_i) \
        __builtin_amdgcn_global_load_lds((const unsigned*)((const char*)(gbase) + (voff)[_i]), (LAS unsigned*)(lds + (bufoff) + ldsw + _i * 8192), 16, 0, 0); } while (0)
#define PG_LDA(dst, b, h) do { _Pragma("unroll") for (int m = 0; m < 4; ++m) _Pragma("unroll") for (int k = 0; k < 2; ++k) dst[m][k] = *(const LAS bf16x8*)(lds + PG_SA(b, h) + aoff + m * 2048 + k * 1024); } while (0)
#define PG_LDB(dst, b, h) do { _Pragma("unroll") for (int n = 0; n < 2; ++n) _Pragma("unroll") for (int k = 0; k < 2; ++k) dst[n][k] = *(const LAS bf16x8*)(lds + PG_SB(b, h) + boff + n * 2048 + k * 1024); } while (0)
#define PG_MMA(ai, bj, At, Bt) do { __builtin_amdgcn_s_setprio(1); _Pragma("unroll") for (int m = 0; m < 4; ++m) _Pragma("unroll") for (int n = 0; n < 2; ++n) _Pragma("unroll") for (int k = 0; k < 2; ++k) \
        acc[ai][bj][m][n] = __builtin_amdgcn_mfma_f32_16x16x32_bf16(Bt[n][k], At[m][k], acc[ai][bj][m][n], 0, 0, 0); __builtin_amdgcn_s_setprio(0); } while (0)
#define PG_WAIT_V(n) asm volatile("s_waitcnt vmcnt(" #n ")" ::: "memory")
#define PG_WAIT_L(n) asm volatile("s_waitcnt lgkmcnt(" #n ")" ::: "memory")
#define PG_BAR __builtin_amdgcn_s_barrier()
#define PG_SCHED __builtin_amdgcn_sched_barrier(0)
#define PG_AOFF(dst0, dst1, u) do { _Pragma("unroll") for (int _i = 0; _i < 2; ++_i) { int _R, _C; stage_rc(tid * 16 + _i * 8192, _R, _C); \
        dst0[_i] = S.a_rowoff(u, 0, _R) + (unsigned)_C * 2u; dst1[_i] = S.a_rowoff(u, 1, _R) + (unsigned)_C * 2u; } } while (0)
    Unit cur, nxt; int ui = 0;
    if (!S.next(0, cur)) return;
    f32x4 acc[2][2][4][2];
#pragma unroll
    for (int a = 0; a < 2; ++a)
#pragma unroll
        for (int b = 0; b < 2; ++b)
#pragma unroll
            for (int m = 0; m < 4; ++m)
#pragma unroll
                for (int n = 0; n < 2; ++n) acc[a][b][m][n] = (f32x4){0.f, 0.f, 0.f, 0.f};
    bf16x8 At[4][2], B0[2][2], B1[2][2];
    const char* const Ab = S.a_base();
    unsigned aC0[2], aC1[2];
    PG_AOFF(aC0, aC1, cur);
    const char* cB = S.b_ptr(cur);
    PG_STAGE(PG_SB(0, 0), cB, voffB); PG_STAGE(PG_SA(0, 0), Ab, aC0); PG_STAGE(PG_SB(0, 1), cB + hstepB, voffB); PG_STAGE(PG_SA(0, 1), Ab, aC1);
    if (wr == 1) PG_BAR;
    PG_WAIT_V(4); PG_BAR;
    PG_STAGE(PG_SB(1, 0), cB + kstep, voffB); PG_STAGE(PG_SA(1, 0), Ab + kstep, aC0); PG_STAGE(PG_SB(1, 1), cB + hstepB + kstep, voffB);
    PG_WAIT_V(6); PG_BAR;
    for (;;) {
        const bool has_next = S.next(ui + 1, nxt);
        const char* nB = has_next ? S.b_ptr(nxt) : cB;
#pragma unroll 1
        for (int t = 0; t < nt; t += 2) {
            const bool last = (t == nt - 2);
            const char* a1 = Ab + (size_t)(t + 1) * kstep;
            const char* a2 = last ? Ab : Ab + (size_t)(t + 2) * kstep; const char* b2 = last ? nB : cB + (size_t)(t + 2) * kstep;
            const char* a3 = a2 + kstep; const char* b3 = b2 + kstep;
            PG_LDB(B0, 0, 0); PG_SCHED; PG_LDA(At, 0, 0); PG_STAGE(PG_SA(1, 1), a1, aC1);
            if (last && has_next) PG_AOFF(aC0, aC1, nxt);
            PG_WAIT_L(8); PG_BAR; PG_WAIT_L(0); PG_MMA(0, 0, At, B0); PG_BAR; PG_SCHED;
            PG_LDB(B1, 0, 1); PG_STAGE(PG_SB(0, 0), b2, voffB);
            PG_BAR; PG_WAIT_L(0); PG_MMA(0, 1, At, B1); PG_BAR;
            PG_LDA(At, 0, 1); PG_STAGE(PG_SA(0, 0), a2, aC0);
            PG_BAR; PG_WAIT_L(0); PG_MMA(1, 0, At, B0); PG_BAR; PG_SCHED;
            PG_STAGE(PG_SB(0, 1), b2 + hstepB, voffB);
            PG_WAIT_V(6); PG_BAR; PG_MMA(1, 1, At, B1); PG_BAR;
            PG_LDB(B0, 1, 0); PG_SCHED; PG_LDA(At, 1, 0); PG_STAGE(PG_SA(0, 1), a2, aC1);
            PG_WAIT_L(8); PG_BAR; PG_WAIT_L(0); PG_MMA(0, 0, At, B0); PG_BAR; PG_SCHED;
            PG_LDB(B1, 1, 1); PG_STAGE(PG_SB(1, 0), b3, voffB);
            PG_BAR; PG_WAIT_L(0); PG_MMA(0, 1, At, B1); PG_BAR;
            PG_LDA(At, 1, 1); PG_STAGE(PG_SA(1, 0), a3, aC0);
            PG_BAR; PG_WAIT_L(0); PG_MMA(1, 0, At, B0); PG_BAR; PG_SCHED;
            PG_STAGE(PG_SB(1, 1), b3 + hstepB, voffB);
            PG_WAIT_V(6); PG_BAR; PG_MMA(1, 1, At, B1); PG_BAR;
        }
        E(acc, cur, wr, wc, fr, fq);
        if (!has_next) break;
#pragma unroll
        for (int a = 0; a < 2; ++a)
#pragma unroll
            for (int b = 0; b < 2; ++b)
#pragma unroll
                for (int m = 0; m < 4; ++m)
#pragma unroll
                    for (int n = 0; n < 2; ++n) acc[a][b][m][n] = (f32x4){0.f, 0.f, 0.f, 0.f};
        cur = nxt; cB = nB; ++ui;
    }
    PG_WAIT_V(0);
    if (wr == 0) PG_BAR;
    PG_BAR;
#undef PG_SA
#undef PG_SB
#undef PG_STAGE
#undef PG_LDA
#undef PG_LDB
#undef PG_MMA
#undef PG_WAIT_V
#undef PG_WAIT_L
#undef PG_BAR
#undef PG_SCHED
#undef PG_AOFF
}

struct DenseSched {
    const char* A; const char* Bt; int K, nM, nN, nwg, G, c;
    __device__ void init(const void* A_, const void* Bt_, int M, int N, int K_, int G_, int c_) { A = (const char*)A_; Bt = (const char*)Bt_; K = K_; nM = M / BM; nN = N / BM; nwg = nM * nN; G = G_; c = c_; }
    __device__ __forceinline__ bool next(int i, Unit& u) const {
        const long L = (long)i * G + c; if (L >= nwg) return false;
        int wgid = (int)L; { const int q = nwg / 8, r = nwg % 8, xcd = wgid % 8, off = wgid / 8; wgid = (xcd < r ? xcd * (q + 1) : r * (q + 1) + (xcd - r) * q) + off; }
        const int nig = 8 * nN, gid = wgid / nig, fm = gid * 8, gsz = (nM - fm) < 8 ? (nM - fm) : 8;
        u.pm = fm + ((wgid % nig) % gsz); u.pn = (wgid % nig) / gsz; u.e = 0; u.rt = 0; u.cnt = 0; return true;
    }
    __device__ __forceinline__ const char* a_base() const { return A; }
    __device__ __forceinline__ unsigned a_rowoff(const Unit& u, int half, int R) const { return (unsigned)(u.pm * BM + half * HALF + R) * (unsigned)(K * 2); }
    __device__ __forceinline__ const char* b_ptr(const Unit& u) const { return Bt + (size_t)u.pn * BM * K * 2; }
};

__device__ __forceinline__ void moe_build_units(LAS int* tab, const int* cntp, int NCT, int G, int c) {
    const int i = opaque_tid();
    if (i < 16) {
        const int L = i * G + c; int accu = 0, rtb = 0, found = 0, pm = 0, pn = 0, ee = 0, rt = 0, cn = 0;
        for (int e = 0; e < 16; ++e) { const int ce = cntp[e], nte = (ce + 255) >> 8, ue = nte * NCT;
            if (!found && L < accu + ue) { const int local = L - accu; ee = e; rt = local / NCT; pn = local % NCT; pm = rtb + rt; cn = ce; found = 1; }
            accu += ue; rtb += nte; }
        tab[i * 8 + 0] = found; tab[i * 8 + 1] = pm; tab[i * 8 + 2] = pn; tab[i * 8 + 3] = ee; tab[i * 8 + 4] = rt; tab[i * 8 + 5] = cn;
    }
    __syncthreads();
}
template <bool GATHER>
struct MoeSched {
    const char* A; const char* Bt; const int* list; int K; size_t wstride; LAS int* tab;
    __device__ void init(const void* A_, const void* Bt_, size_t wstride_bytes, const int* list_, int K_, LAS int* tab_) {
        A = (const char*)A_; Bt = (const char*)Bt_; wstride = wstride_bytes; list = list_; K = K_; tab = tab_; }
    __device__ __forceinline__ bool next(int i, Unit& u) const {
        if (i >= 16) return false;
        const int f = __builtin_amdgcn_readfirstlane(tab[i * 8 + 0]);
        u.pm = __builtin_amdgcn_readfirstlane(tab[i * 8 + 1]); u.pn = __builtin_amdgcn_readfirstlane(tab[i * 8 + 2]); u.e = __builtin_amdgcn_readfirstlane(tab[i * 8 + 3]);
        u.rt = __builtin_amdgcn_readfirstlane(tab[i * 8 + 4]); u.cnt = __builtin_amdgcn_readfirstlane(tab[i * 8 + 5]);
        return f != 0;
    }
    __device__ __forceinline__ const char* a_base() const { return A; }
    __device__ __forceinline__ unsigned a_rowoff(const Unit& u, int half, int R) const {
        if (GATHER) { const int slot = u.rt * BM + half * HALF + R; const int tok = slot < u.cnt ? list[u.e * NTOK + slot] : 0; return (unsigned)tok * (unsigned)(K * 2); }
        return (unsigned)(u.pm * BM + half * HALF + R) * (unsigned)(K * 2);
    }
    __device__ __forceinline__ const char* b_ptr(const Unit& u) const { return Bt + (size_t)u.e * wstride + (size_t)u.pn * BM * K * 2; }
};

struct EpiBf16 {
    static constexpr bool PERM = true;
    bf16_t* O; int ldc;
    __device__ __forceinline__ void operator()(const f32x4 (&acc)[2][2][4][2], const Unit& u, int wr, int wc, int fr, int fq) const {
        const int row0 = u.pm * BM + wr * 64 + fr, col0 = u.pn * BM + wc * 32 + 8 * fq;
#pragma unroll
        for (int ai = 0; ai < 2; ++ai)
#pragma unroll
            for (int m = 0; m < 4; ++m) { bf16_t* rowp = O + (size_t)(row0 + ai * HALF + m * 16) * ldc + col0;
#pragma unroll
                for (int bj = 0; bj < 2; ++bj) { const f32x4 v0 = acc[ai][bj][m][0], v1 = acc[ai][bj][m][1];
                    u32x4 w; w.x = cvt_pk_bf16(v0[0], v0[1]); w.y = cvt_pk_bf16(v0[2], v0[3]); w.z = cvt_pk_bf16(v1[0], v1[1]); w.w = cvt_pk_bf16(v1[2], v1[3]);
                    *(u32x4*)(rowp + bj * HALF) = w; } }
    }
};
struct EpiResid {
    static constexpr bool PERM = true;
    const float* X; const bf16_t* Xb; bf16_t* U;
    __device__ __forceinline__ void operator()(const f32x4 (&acc)[2][2][4][2], const Unit& u, int wr, int wc, int fr, int fq) const {
        const int row0 = u.pm * BM + wr * 64 + fr, col0 = u.pn * BM + wc * 32 + 8 * fq;
#pragma unroll
        for (int ai = 0; ai < 2; ++ai)
#pragma unroll
            for (int m = 0; m < 4; ++m) { const size_t off = (size_t)(row0 + ai * HALF + m * 16) * DM + col0;
#pragma unroll
                for (int bj = 0; bj < 2; ++bj) { f32x4 x0, x1;
                    if (Xb) { const u32x4 h = *(const u32x4*)(Xb + off + bj * HALF);
                        x0 = (f32x4){__uint_as_float(h.x << 16), __uint_as_float(h.x & 0xffff0000u), __uint_as_float(h.y << 16), __uint_as_float(h.y & 0xffff0000u)};
                        x1 = (f32x4){__uint_as_float(h.z << 16), __uint_as_float(h.z & 0xffff0000u), __uint_as_float(h.w << 16), __uint_as_float(h.w & 0xffff0000u)}; }
                    else { x0 = *(const f32x4*)(X + off + bj * HALF); x1 = *(const f32x4*)(X + off + bj * HALF + 4); }
                    const f32x4 v0 = x0 * DN_ALPHA + acc[ai][bj][m][0], v1 = x1 * DN_ALPHA + acc[ai][bj][m][1];
                    u32x4 w; w.x = cvt_pk_bf16(v0[0], v0[1]); w.y = cvt_pk_bf16(v0[2], v0[3]); w.z = cvt_pk_bf16(v1[0], v1[1]); w.w = cvt_pk_bf16(v1[2], v1[3]);
                    *(u32x4*)(U + off + bj * HALF) = w; } }
    }
};
struct EpiSwiglu {
    static constexpr bool PERM = true;
    bf16_t* O;
    __device__ __forceinline__ void operator()(const f32x4 (&acc)[2][2][4][2], const Unit& u, int wr, int wc, int fr, int fq) const {
        const int row0 = u.pm * BM + wr * 64 + fr, col0 = u.pn * HALF + wc * 32 + 8 * fq;
#pragma unroll
        for (int ai = 0; ai < 2; ++ai)
#pragma unroll
            for (int m = 0; m < 4; ++m) { bf16_t* rowp = O + (size_t)(row0 + ai * HALF + m * 16) * DEXP + col0;
                float r[8];
#pragma unroll
                for (int n = 0; n < 2; ++n)
#pragma unroll
                    for (int j = 0; j < 4; ++j) { const float g = acc[ai][0][m][n][j], up = acc[ai][1][m][n][j]; r[n * 4 + j] = g / (1.0f + __expf(-g)) * up; }
                u32x4 w; w.x = cvt_pk_bf16(r[0], r[1]); w.y = cvt_pk_bf16(r[2], r[3]); w.z = cvt_pk_bf16(r[4], r[5]); w.w = cvt_pk_bf16(r[6], r[7]);
                *(u32x4*)rowp = w; }
    }
};
}

__device__ __forceinline__ void tr_tile256(LAS float* tile  , const float* src, int ld, int k0, int c0, bf16_t* dst, int dstK, int blk, int blk_stride, int dst_off, int tid) {
    {
        const int c4 = tid & 63;
#pragma unroll
        for (int i = 0; i < 8; ++i) { const int r = (tid >> 6) + 8 * i; const f32x4 a = *(const f32x4*)(src + (size_t)(k0 + r) * ld + c0 + c4 * 4);
            tile[r * 257 + c4 * 4 + 0] = a[0]; tile[r * 257 + c4 * 4 + 1] = a[1]; tile[r * 257 + c4 * 4 + 2] = a[2]; tile[r * 257 + c4 * 4 + 3] = a[3]; }
    }
    __syncthreads();
    {
        const int kk = (tid & 7) * 8;
#pragma unroll
        for (int i = 0; i < 4; ++i) { const int n = (tid >> 3) + 64 * i, col = c0 + n;
            u32x4 w;
            w.x = cvt_pk_bf16(tile[(kk + 0) * 257 + n], tile[(kk + 1) * 257 + n]); w.y = cvt_pk_bf16(tile[(kk + 2) * 257 + n], tile[(kk + 3) * 257 + n]);
            w.z = cvt_pk_bf16(tile[(kk + 4) * 257 + n], tile[(kk + 5) * 257 + n]); w.w = cvt_pk_bf16(tile[(kk + 6) * 257 + n], tile[(kk + 7) * 257 + n]);
            const int drow = (col / blk) * blk_stride + dst_off + (col % blk);
            *(u32x4*)(dst + (size_t)drow * dstK + k0 + kk) = w; }
    }
    __syncthreads();
}
__device__ __forceinline__ float reduce16_wave(const float (&v)[16], int lane) {
    float a8[8];
#pragma unroll
    for (int i = 0; i < 8; ++i) { const float mine = (lane & 32) ? v[8 + i] : v[i], other = (lane & 32) ? v[i] : v[8 + i]; a8[i] = mine + __shfl_xor(other, 32); }
    float a4[4];
#pragma unroll
    for (int i = 0; i < 4; ++i) { const float mine = (lane & 16) ? a8[4 + i] : a8[i], other = (lane & 16) ? a8[i] : a8[4 + i]; a4[i] = mine + __shfl_xor(other, 16); }
    float a2[2];
#pragma unroll
    for (int i = 0; i < 2; ++i) { const float mine = (lane & 8) ? a4[2 + i] : a4[i], other = (lane & 8) ? a4[i] : a4[2 + i]; a2[i] = mine + __shfl_xor(other, 8); }
    float a1; { const float mine = (lane & 4) ? a2[1] : a2[0], other = (lane & 4) ? a2[0] : a2[1]; a1 = mine + __shfl_xor(other, 4); }
    a1 += dppf<0x4E>(a1); a1 += dppf<0xB1>(a1);
    return a1;
}
__device__ __forceinline__ void tr_tile(LAS float* tile  , const float* src, int ld, int k0, int c0, int ncols_valid, bf16_t* dst, int dstK, int drow0, int tid) {
    {
        const int r = tid >> 3, cc = (tid & 7) * 8;
        const float* sp = src + (size_t)(k0 + r) * ld + c0 + cc;
        if (c0 + cc + 8 <= ncols_valid) {
            const f32x4 a = *(const f32x4*)sp, b = *(const f32x4*)(sp + 4);
#pragma unroll
            for (int j = 0; j < 4; ++j) { tile[r * 65 + cc + j] = a[j]; tile[r * 65 + cc + 4 + j] = b[j]; }
        } else {
#pragma unroll
            for (int j = 0; j < 8; ++j) tile[r * 65 + cc + j] = (c0 + cc + j < ncols_valid) ? sp[j] : 0.f;
        }
    }
    __syncthreads();
    {
        const int n = tid >> 3, kk = (tid & 7) * 8;
        u32x4 w;
        w.x = cvt_pk_bf16(tile[(kk + 0) * 65 + n], tile[(kk + 1) * 65 + n]); w.y = cvt_pk_bf16(tile[(kk + 2) * 65 + n], tile[(kk + 3) * 65 + n]);
        w.z = cvt_pk_bf16(tile[(kk + 4) * 65 + n], tile[(kk + 5) * 65 + n]); w.w = cvt_pk_bf16(tile[(kk + 6) * 65 + n], tile[(kk + 7) * 65 + n]);
        *(u32x4*)(dst + (size_t)(drow0 + n) * dstK + k0 + kk) = w;
    }
    __syncthreads();
}

__device__ __forceinline__ void phase_prep(const Params& p, LAS unsigned char* lds, int bid, int nb, int part) {
    const int tid = opaque_tid();
    LAS float* tile = (LAS float*)lds;
    unsigned char* ws = p.ws;
    const int T0 = 832, T1 = T0 + 256, T2 = T1 + 448, T3 = T2 + 256, T4 = T3 + 2048, T5 = T4 + 2048, T6 = T5 + 2048, T7 = T6 + 32;
    if (part == 0) {
        for (int t0 = bid; t0 < T0 + 32; t0 += nb) {
            const int t = t0 < T0 ? t0 : T6 + (t0 - T0);
            if (t >= T6) { const int q = t - T6;
                if (q < 8) tr_tile(tile, p.in[I_AW2], 512, 0, q * 64, 512, (bf16_t*)(ws + OFF_MISC + MISC_W2T), 64, q * 64, tid);
                else if (q < 16) tr_tile(tile, p.in[I_AA2], 512, 0, (q - 8) * 64, 512, (bf16_t*)(ws + OFF_MISC + MISC_A2T), 64, (q - 8) * 64, tid);
                else { const int r = q - 16; tr_tile(tile, p.in[I_AG2], 512, (r >> 3) * 64, (r & 7) * 64, 512, (bf16_t*)(ws + OFF_MISC + MISC_G2T), 128, (r & 7) * 64, tid); }
                continue; }
            { const int kt = t / 52, ct = t % 52; tr_tile(tile, p.in[I_WINE], EVEN_COLS, kt * 64, ct * 64, EVEN_COLS, (bf16_t*)(ws + OFF_WINE), 1024, ct * 64, tid); }
        }
        __syncthreads();
        {
            const int wid = tid >> 6, lane = tid & 63;
            LAS float* wT = (LAS float*)lds;
            for (int i = tid; i < 16 * 1024; i += 512) { const int e_ = i & 15, k = i >> 4; wT[e_ * 1024 + k] = p.in[I_WINE][(size_t)k * EVEN_COLS + NE_MAIN + e_]; }
            __syncthreads();
            const float* x = p.in[I_X]; bf16_t* xb = (bf16_t*)(ws + OFF_BUF64); float* xa = (float*)(ws + OFF_U);
            for (int tok = bid * 8 + wid; tok < NTOK; tok += nb * 8) {
                f32x4 v[4];
                asm volatile("" ::: "memory");
#pragma unroll
                for (int j = 0; j < 4; ++j) { v[j] = *(const f32x4*)(x + (size_t)tok * DM + j * 256 + lane * 4);
                    u32x2 w; w.x = cvt_pk_bf16(v[j][0], v[j][1]); w.y = cvt_pk_bf16(v[j][2], v[j][3]); *(u32x2*)(xb + (size_t)tok * DM + j * 256 + lane * 4) = w; }
                float part_[16];
#pragma unroll
                for (int e_ = 0; e_ < 16; ++e_) { float a = 0.f;
#pragma unroll
                    for (int j = 0; j < 4; ++j) { const f32x4 w = *(const LAS f32x4*)(wT + e_ * 1024 + j * 256 + lane * 4); a += (v[j][0] * w[0] + v[j][1] * w[1]) + (v[j][2] * w[2] + v[j][3] * w[3]); }
                    part_[e_] = a; }
                const float r = reduce16_wave(part_, lane);
                if ((lane & 3) == 0) xa[(size_t)tok * 16 + ((lane >> 5) & 1) * 8 + ((lane >> 4) & 1) * 4 + ((lane >> 3) & 1) * 2 + ((lane >> 2) & 1)] = r;
            }
            __syncthreads();
        }
        if (bid == 0 && tid < 64) ((int*)(ws + OFF_MISC + MISC_CNT))[tid] = 0;
        if (bid == 1) for (int i = tid; i < (16384 + 256) / 4; i += 512) ((unsigned*)(ws + OFF_MISC + MISC_RWF))[i] = 0u;
        return;
    }
    unsigned* pctr = (unsigned*)(ws + OFF_MISC + MISC_PCTR);
    LAS int* tsh = (LAS int*)(lds + 69632);
    const int U0 = 64, U1 = U0 + 64, U2 = U1 + 512, U3 = U2 + 512, U4 = U3 + 512, U5 = U4 + 448;
    for (;;) {
        __syncthreads();
        if (tid == 0) tsh[0] = (int)__hip_atomic_fetch_add(pctr, 2u, __ATOMIC_RELAXED, __HIP_MEMORY_SCOPE_AGENT);
        __syncthreads();
        const int tb = __builtin_amdgcn_readfirstlane(tsh[0]);
        if (tb >= U5) break;
#pragma unroll 1
        for (int t = tb; t < tb + 2 && t < U5; ++t) {
            if (t < U0) { const int kt = t >> 2, cb = t & 3; tr_tile256(tile, p.in[I_WOUTE], 1024, kt * 64, cb * 256, (bf16_t*)(ws + OFF_WOUTE), 1024, 1 << 20, 0, 0, tid); }
            else if (t < U1) { const int q = t - U0, kt = q >> 2, cb = q & 3; tr_tile256(tile, p.in[I_WOUTO], 1024, kt * 64, cb * 256, (bf16_t*)(ws + OFF_WOUTO), 1024, 1 << 20, 0, 0, tid); }
            else if (t < U3) { const bool up = t >= U2; const int q = t - (up ? U2 : U1), le = q >> 4, kt = q & 15;
                tr_tile256(tile, p.in[up ? I_EU : I_EG] + (size_t)le * 1024 * 256, 256, kt * 64, 0, (bf16_t*)(ws + OFF_WGU) + (size_t)le * 512 * 1024, 1024, 128, 256, up ? 128 : 0, tid); }
            else if (t < U4) { const int q = t - U3, le = q >> 4, r = q & 15, kt = r >> 2, cb = r & 3;
                tr_tile256(tile, p.in[I_ED] + (size_t)le * 256 * 1024, 1024, kt * 64, cb * 256, (bf16_t*)(ws + OFF_WD) + (size_t)le * 1024 * 256, 256, 1 << 20, 0, 0, tid); }
            else { const int q = t - U4, kt = q / 28, ct = q % 28; tr_tile(tile, p.in[I_WINO], ODD_COLS, kt * 64, ct * 64, ODD_COLS, (bf16_t*)(ws + OFF_WINO), 1024, ct * 64, tid); }
        }
    }
    {
        float* c64 = (float*)(ws + OFF_ROPE); float* s64 = c64 + 4096 * 64; float* c32 = s64 + 4096 * 64; float* s32 = c32 + 4096 * 32;
        for (int i = bid * 512 + tid; i < 4096 * 64; i += nb * 512) { const int pos = i >> 6, j = i & 63; const float inv = powf(10000.0f, -(float)j / 64.0f); const float ang = (float)pos * inv; c64[i] = cosf(ang); s64[i] = sinf(ang); }
        for (int i = bid * 512 + tid; i < 4096 * 32; i += nb * 512) { const int pos = i >> 5, j = i & 31; const float inv = powf(10000.0f, -(float)j / 32.0f); const float ang = (float)pos * inv; c32[i] = cosf(ang); s32[i] = sinf(ang); }
    }
}

__device__ __forceinline__ void phase_ln_route(const Params& p, LAS unsigned char* lds, int bid, int nb, int layer) {
    const int tid = opaque_tid(), wid = tid >> 6, lane = tid & 63;
    unsigned char* ws = p.ws;
    LAS float* rwT = (LAS float*)lds;
    LAS int* sel = (LAS int*)(lds + 65536);
    LAS float* selg = (LAS float*)(lds + 65536 + 1024);
    LAS int* cntw = (LAS int*)(lds + 65536 + 2048);
    { const float* rw = p.in[I_RW];
        for (int i = tid; i < 16 * 1024; i += 512) { const int e = i >> 10, k = i & 1023; rwT[i] = rw[k * 16 + e]; } }
    __syncthreads();
    const bf16_t* U = (const bf16_t*)(ws + OFF_U); bf16_t* hb = (bf16_t*)(ws + OFF_BUF64);
    const float* g = p.in[I_LN1G] + layer * DM; const float* b = p.in[I_LN1B] + layer * DM;
    int* cnt = (int*)(ws + OFF_MISC + MISC_CNT) + layer * 16;
    int* tokinfo = (int*)(ws + OFF_MISC + MISC_TOKINFO); float* tokgate = (float*)(ws + OFF_MISC + MISC_TOKGATE); int* list = (int*)(ws + OFF_MISC + MISC_LIST);
    f32x4 gv[4], bv[4];
#pragma unroll
    for (int j = 0; j < 4; ++j) { gv[j] = *(const f32x4*)(g + j * 256 + lane * 4); bv[j] = *(const f32x4*)(b + j * 256 + lane * 4); }
    const float* rbp = p.in[I_RB];
    const float my_rb = rbp[((lane >> 5) & 1) * 8 + ((lane >> 4) & 1) * 4 + ((lane >> 3) & 1) * 2 + ((lane >> 2) & 1)];
    for (int blk = bid; blk < NTOK / 128; blk += nb) {
        u32x2 nv[4];
#pragma unroll
        for (int j = 0; j < 4; ++j) nv[j] = *(const u32x2*)(U + (size_t)(blk * 128 + wid * 16) * DM + j * 256 + lane * 4);
#pragma unroll 1
        for (int i = 0; i < 16; ++i) {
            const int tl = wid * 16 + i, tok = blk * 128 + tl;
            f32x4 v[4]; float s = 0.f;
            asm volatile("" ::: "memory");
#pragma unroll
            for (int j = 0; j < 4; ++j) { const u32x2 h = nv[j]; v[j] = (f32x4){__uint_as_float(h.x << 16), __uint_as_float(h.x & 0xffff0000u), __uint_as_float(h.y << 16), __uint_as_float(h.y & 0xffff0000u)}; }
            { const int tokn = tok + (i < 15 ? 1 : 0);
#pragma unroll
                for (int j = 0; j < 4; ++j) nv[j] = *(const u32x2*)(U + (size_t)tokn * DM + j * 256 + lane * 4); }
#pragma unroll
            for (int j = 0; j < 4; ++j) s += (v[j][0] + v[j][1]) + (v[j][2] + v[j][3]);
            const float mean = wave_sum(s) * (1.0f / DM);
            float q = 0.f;
#pragma unroll
            for (int j = 0; j < 4; ++j) { v[j] -= mean; q += (v[j][0] * v[j][0] + v[j][1] * v[j][1]) + (v[j][2] * v[j][2] + v[j][3] * v[j][3]); }
            const float rstd = rsqrtf(wave_sum(q) * (1.0f / DM) + LN_EPS);
#pragma unroll
            for (int j = 0; j < 4; ++j) { v[j] = v[j] * rstd * gv[j] + bv[j];
                u32x2 w; w.x = cvt_pk_bf16(v[j][0], v[j][1]); w.y = cvt_pk_bf16(v[j][2], v[j][3]);
                *(u32x2*)(hb + (size_t)tok * DM + j * 256 + lane * 4) = w; }
            float part[16];
#pragma unroll
            for (int e = 0; e < 16; ++e) { float a = 0.f;
#pragma unroll
                for (int j = 0; j < 4; ++j) { const f32x4 w = *(const LAS f32x4*)(rwT + e * 1024 + j * 256 + lane * 4); a += (v[j][0] * w[0] + v[j][1] * w[1]) + (v[j][2] * w[2] + v[j][3] * w[3]); }
                part[e] = a; }
            const float lgm = reduce16_wave(part, lane);
            const float sgm = 1.0f / (1.0f + expf(-lgm)), selm = sgm + my_rb;
            float sg[16], sl[16];
#pragma unroll
            for (int e = 0; e < 16; ++e) { const int L = ((e >> 3) & 1) * 32 + ((e >> 2) & 1) * 16 + ((e >> 1) & 1) * 8 + (e & 1) * 4;
                sg[e] = __builtin_bit_cast(float, __builtin_amdgcn_readlane(__builtin_bit_cast(int, sgm), L)); sl[e] = __builtin_bit_cast(float, __builtin_amdgcn_readlane(__builtin_bit_cast(int, selm), L)); }
            int best = 0; float bestv = -INFINITY;
#pragma unroll
            for (int gI = 0; gI < 4; ++gI) { float m1 = -INFINITY, m2 = -INFINITY;
#pragma unroll
                for (int j = 0; j < 4; ++j) { const float x = sl[gI * 4 + j]; if (x > m1) { m2 = m1; m1 = x; } else if (x > m2) m2 = x; }
                const float gs = m1 + m2; if (gs > bestv) { bestv = gs; best = gI; } }
            int e0 = 0, e1 = 0; float v0 = -INFINITY, v1 = -INFINITY, s0 = 0.f, s1 = 0.f;
#pragma unroll
            for (int e = 0; e < 16; ++e) { if ((e >> 2) == best) { const float x = sl[e];
                    if (x > v0) { v1 = v0; e1 = e0; s1 = s0; v0 = x; e0 = e; s0 = sg[e]; } else if (x > v1) { v1 = x; e1 = e; s1 = sg[e]; } } }
            const float gsum = s0 + s1;
            if (lane == 0) { sel[tl * 2] = e0; sel[tl * 2 + 1] = e1; selg[tl * 2] = s0 / gsum; selg[tl * 2 + 1] = s1 / gsum; }
        }
        __syncthreads();
        int myE = -1, myRank = 0;
        if (tid < 256) { myE = sel[tid];
#pragma unroll
            for (int e = 0; e < 16; ++e) { const unsigned long long mk = __ballot(myE == e); if (myE == e) myRank = __popcll(mk & ((1ull << lane) - 1ull)); if (lane == 0) cntw[wid * 16 + e] = __popcll(mk); } }
        __syncthreads();
        if (tid < 16) { const int c0 = cntw[tid], c1 = cntw[16 + tid], c2 = cntw[32 + tid], c3 = cntw[48 + tid];
            const int basev = atomicAdd(cnt + tid, c0 + c1 + c2 + c3);
            cntw[64 + tid] = basev; cntw[80 + tid] = basev + c0; cntw[96 + tid] = basev + c0 + c1; cntw[112 + tid] = basev + c0 + c1 + c2; }
        __syncthreads();
        if (tid < 256) { const int slot = cntw[64 + wid * 16 + myE] + myRank; const int tok = blk * 128 + (tid >> 1), k = tid & 1;
            list[myE * NTOK + slot] = tok; tokinfo[tok * 4 + k * 2] = myE; tokinfo[tok * 4 + k * 2 + 1] = slot; tokgate[tok * 2 + k] = selg[tid]; }
        __syncthreads();
    }
}

__device__ __forceinline__ void phase_ln2(const Params& p, int bid, int nb, int layer, float* dst, bool with_moe) {
    const int tid = opaque_tid(), wid = tid >> 6, lane = tid & 63;
    unsigned char* ws = p.ws;
    bf16_t* xb = (bf16_t*)(ws + OFF_BUF64);
    const bf16_t* he = (const bf16_t*)(ws + OFF_HE);
    const float* g = p.in[I_LN2G] + layer * DM; const float* b = p.in[I_LN2B] + layer * DM;
    const int* cnt = (const int*)(ws + OFF_MISC + MISC_CNT) + layer * 16;
    const int* tokinfo = (const int*)(ws + OFF_MISC + MISC_TOKINFO); const float* tokgate = (const float*)(ws + OFF_MISC + MISC_TOKGATE);
    int rowbase[16]; { int a = 0;
#pragma unroll
        for (int e = 0; e < 16; ++e) { rowbase[e] = a; a += ((cnt[e] + 255) >> 8) << 8; } }
    f32x4 gv[4], bv[4];
#pragma unroll
    for (int j = 0; j < 4; ++j) { gv[j] = *(const f32x4*)(g + j * 256 + lane * 4); bv[j] = *(const f32x4*)(b + j * 256 + lane * 4); }
    const int tstride = nb * 8;
    int r0n, r1n; float g0n, g1n;
#define LN2_INFO(tk) do { const int tk_ = (tk) < NTOK ? (tk) : NTOK - 1; const int e0 = tokinfo[tk_ * 4 + 0], sl0 = tokinfo[tk_ * 4 + 1], e1 = tokinfo[tk_ * 4 + 2], sl1 = tokinfo[tk_ * 4 + 3]; \
        int rb0 = 0, rb1 = 0; _Pragma("unroll") for (int e = 0; e < 16; ++e) { if (e == e0) rb0 = rowbase[e]; if (e == e1) rb1 = rowbase[e]; } \
        r0n = rb0 + sl0; r1n = rb1 + sl1; g0n = tokgate[tk_ * 2 + 0]; g1n = tokgate[tk_ * 2 + 1]; } while (0)
#define LN2_ROWS(k, tk) do { const int tk_ = (tk) < NTOK ? (tk) : NTOK - 1; _Pragma("unroll") for (int j = 0; j < 4; ++j) { hN[k][j] = *(const u32x2*)(xb + (size_t)tk_ * DM + j * 256 + lane * 4); \
        aN[k][j] = *(const u32x2*)(he + (size_t)r0n * DM + j * 256 + lane * 4); cN[k][j] = *(const u32x2*)(he + (size_t)r1n * DM + j * 256 + lane * 4); } gN[k][0] = g0n; gN[k][1] = g1n; } while (0)
    u32x2 hN[2][4], aN[2][4], cN[2][4]; float gN[2][2];
    { const int tok0 = bid * 8 + wid; LN2_INFO(tok0); LN2_ROWS(0, tok0); LN2_INFO(tok0 + tstride); LN2_ROWS(1, tok0 + tstride); LN2_INFO(tok0 + 2 * tstride); }
#define LN2_BODY(k, tk) do { const int tok_ = (tk); f32x4 v[4]; float s = 0.f; \
        u32x2 hC[4], aC[4], cC[4]; const float g0 = gN[k][0], g1 = gN[k][1]; \
        _Pragma("unroll") for (int j = 0; j < 4; ++j) { hC[j] = hN[k][j]; aC[j] = aN[k][j]; cC[j] = cN[k][j]; } \
        LN2_ROWS(k, tok_ + 2 * tstride); LN2_INFO(tok_ + 3 * tstride); \
        _Pragma("unroll") for (int j = 0; j < 4; ++j) { const u32x2 h = hC[j], a = aC[j], c = cC[j]; \
            v[j] = (f32x4){__uint_as_float(h.x << 16), __uint_as_float(h.x & 0xffff0000u), __uint_as_float(h.y << 16), __uint_as_float(h.y & 0xffff0000u)} * DN_ALPHA; \
            v[j][0] += g0 * __uint_as_float(a.x << 16) + g1 * __uint_as_float(c.x << 16); v[j][1] += g0 * __uint_as_float(a.x & 0xffff0000u) + g1 * __uint_as_float(c.x & 0xffff0000u); \
            v[j][2] += g0 * __uint_as_float(a.y << 16) + g1 * __uint_as_float(c.y << 16); v[j][3] += g0 * __uint_as_float(a.y & 0xffff0000u) + g1 * __uint_as_float(c.y & 0xffff0000u); \
            s += (v[j][0] + v[j][1]) + (v[j][2] + v[j][3]); } \
        const float mean = wave_sum(s) * (1.0f / DM); \
        float q = 0.f; \
        _Pragma("unroll") for (int j = 0; j < 4; ++j) { v[j] -= mean; q += (v[j][0] * v[j][0] + v[j][1] * v[j][1]) + (v[j][2] * v[j][2] + v[j][3] * v[j][3]); } \
        const float rstd = rsqrtf(wave_sum(q) * (1.0f / DM) + LN_EPS); \
        if (tok_ < NTOK) { \
        _Pragma("unroll") for (int j = 0; j < 4; ++j) { v[j] = v[j] * rstd * gv[j] + bv[j]; \
            LN2_PROBE_SCALE \
            if (layer == 1) *(f32x4*)(dst + (size_t)tok_ * DM + j * 256 + lane * 4) = v[j];        \
            else { u32x2 w; w.x = cvt_pk_bf16(v[j][0], v[j][1]); w.y = cvt_pk_bf16(v[j][2], v[j][3]); \
                *(u32x2*)(xb + (size_t)tok_ * DM + j * 256 + lane * 4) = w; } } } } while (0)
#if PROBE_ID
#define LN2_PROBE_SCALE if (layer == 1) v[j] = v[j] * (1.0f + *(const float*)(ws + OFF_MISC + MISC_PROBE));
#else
#define LN2_PROBE_SCALE
#endif
#pragma unroll 1
    for (int tok = bid * 8 + wid; tok < NTOK; tok += 2 * tstride) {
        asm volatile("" ::: "memory");
        LN2_BODY(0, tok);
        asm volatile("" ::: "memory");
        LN2_BODY(1, tok + tstride);
    }
#undef LN2_BODY
#undef LN2_ROWS
#undef LN2_INFO
}


__device__ __forceinline__ void phase_moe_gateup(const Params& p, LAS unsigned char* lds, int bid, int nb, int layer) {
    unsigned char* ws = p.ws;
    LAS int* tab = (LAS int*)(lds + pg::STAGE_BYTES);
    pg::moe_build_units(tab, (const int*)(ws + OFF_MISC + MISC_CNT) + layer * 16, 2, nb, bid);
    pg::MoeSched<true> S; S.init(ws + OFF_BUF64, ws + OFF_WGU + (size_t)layer * 16 * 512 * 1024 * 2, (size_t)512 * 1024 * 2, (const int*)(ws + OFF_MISC + MISC_LIST), 1024, tab);
    pg::EpiSwiglu E; E.O = (bf16_t*)(ws + OFF_ACT);
    pg::gemm_phase(lds, 1024, S, E);
}
__device__ __forceinline__ void phase_moe_down(const Params& p, LAS unsigned char* lds, int bid, int nb, int layer) {
    unsigned char* ws = p.ws;
    LAS int* tab = (LAS int*)(lds + pg::STAGE_BYTES);
    pg::moe_build_units(tab, (const int*)(ws + OFF_MISC + MISC_CNT) + layer * 16, 4, nb, bid);
    pg::MoeSched<false> S; S.init(ws + OFF_ACT, ws + OFF_WD + (size_t)layer * 16 * 1024 * 256 * 2, (size_t)1024 * 256 * 2, nullptr, 256, tab);
    pg::EpiBf16 E; E.O = (bf16_t*)(ws + OFF_HE); E.ldc = 1024;
    pg::gemm_phase(lds, 256, S, E);
}


__device__ __forceinline__ float red8(float v) { v += dppf<0xB1>(v); v += dppf<0x4E>(v); v += dppf<0x141>(v); return v; }


__device__ __forceinline__ float red16(float v) { v += dppf<0xB1>(v); v += dppf<0x4E>(v); v += dppf<0x141>(v); v += dppf<0x140>(v); return v; }

constexpr size_t OFF_ACT256 = OFF_U + 4 * MiB;
__device__ __forceinline__ void phase_lora_act(const Params& p, int bid, int nb) {
    const int tid = opaque_tid();
    const bf16_t* P0 = (const bf16_t*)(p.ws + OFF_P); bf16_t* act = (bf16_t*)(p.ws + OFF_ACT256);
    const float* mu = p.in[I_AMU];
    const int cc = tid & 31, col = 1536 + cc * 8;
    const f32x4 m0 = *(const f32x4*)(mu + col), m1 = *(const f32x4*)(mu + col + 4);
    for (int n = bid * 16 + (tid >> 5); n < NTOK; n += nb * 16) {
        const u32x4 cu = *(const u32x4*)(P0 + (size_t)n * NE_MAIN + col); u32x4 pv = uzero4(); if ((n & (SEQ - 1)) > 0) pv = *(const u32x4*)(P0 + (size_t)(n - 1) * NE_MAIN + col);
        const unsigned cw[4] = {cu.x, cu.y, cu.z, cu.w}, pw[4] = {pv.x, pv.y, pv.z, pv.w}; float x[8];
#pragma unroll
        for (int j = 0; j < 4; ++j) { const float c0 = __uint_as_float(cw[j] << 16), c1 = __uint_as_float(cw[j] & 0xffff0000u), q0 = __uint_as_float(pw[j] << 16), q1 = __uint_as_float(pw[j] & 0xffff0000u);
            const float ma = (j < 2 ? m0[2 * j] : m1[2 * j - 4]), mb = (j < 2 ? m0[2 * j + 1] : m1[2 * j - 3]);
            x[2 * j] = c0 + (q0 - c0) * ma; x[2 * j + 1] = c1 + (q1 - c1) * mb; }
        if (cc < 8) {
#pragma unroll
            for (int j = 0; j < 8; ++j) x[j] = fast_tanh(x[j]); }
        else if (cc >= 16) {
#pragma unroll
            for (int j = 0; j < 8; ++j) x[j] = fast_sigmoid(x[j]); }
        u32x4 o; o.x = cvt_pk_bf16(x[0], x[1]); o.y = cvt_pk_bf16(x[2], x[3]); o.z = cvt_pk_bf16(x[4], x[5]); o.w = cvt_pk_bf16(x[6], x[7]);
        *(u32x4*)(act + (size_t)n * 256 + cc * 8) = o;
    }
}

template <int CTRL> __device__ __forceinline__ float dpp0f(float v) { return __builtin_bit_cast(float, __builtin_amdgcn_update_dpp(0, __builtin_bit_cast(int, v), CTRL, 0xf, 0xf, true)); }
__device__ __forceinline__ bf16x8 pack_lo4(const f32x4 a) { u32x4 w; w.x = cvt_pk_bf16(a[0], a[1]); w.y = cvt_pk_bf16(a[2], a[3]); w.z = 0u; w.w = 0u; return __builtin_bit_cast(bf16x8, w); }
__device__ __forceinline__ bf16x8 pack_8(const f32x4 a, const f32x4 b) { u32x4 w; w.x = cvt_pk_bf16(a[0], a[1]); w.y = cvt_pk_bf16(a[2], a[3]); w.z = cvt_pk_bf16(b[0], b[1]); w.w = cvt_pk_bf16(b[2], b[3]); return __builtin_bit_cast(bf16x8, w); }
__device__ __forceinline__ f32x4 mm16(const f32x4 PT, const f32x4 Q) { return __builtin_amdgcn_mfma_f32_16x16x32_bf16(pack_lo4(PT), pack_lo4(Q), fzero4(), 0, 0, 0); }
constexpr int RW3_SLOT = 12544;
__device__ __forceinline__ int rw3_trswz(int row, int c) { return (((c >> 1) ^ ((row >> 1) & 3)) << 1) | (c & 1); }
__device__ __forceinline__ unsigned rw_ld(unsigned* p_) { return __hip_atomic_load(p_, __ATOMIC_RELAXED, __HIP_MEMORY_SCOPE_AGENT); }
__device__ __forceinline__ void rwkv3_item(const Params& p, LAS unsigned char* lds, int item, int role, int which) {
    const int tid = opaque_tid(), lane = tid & 63, wid = tid >> 6, fr = lane & 15, g = lane >> 4;
    const int b = item >> 3, h = item & 7;
    unsigned char* ws = p.ws;
    const bf16_t* P0 = (const bf16_t*)(ws + OFF_P);
    float* yraw = p.out; bf16_t* e1g = (bf16_t*)(p.out + (size_t)NTOK * 512); bf16_t* gg = e1g + (size_t)NTOK * 512;
    LAS unsigned char* w2h = lds;
    LAS unsigned char* a2h = lds + 8192;
    LAS unsigned char* g2h = lds + 16384;
    LAS unsigned char* slots = lds + 32768;
    LAS float* ptab = (LAS float*)(lds + 32768 + 8 * RW3_SLOT);
    LAS float* mul = ptab + 8 * 64;
    if (role == 0) {
        const float* mu = p.in[I_AMU];
        if (tid < 64) { ptab[tid] = mu[h * 64 + tid]; ptab[64 + tid] = mu[512 + h * 64 + tid]; ptab[128 + tid] = mu[1024 + h * 64 + tid];
            ptab[192 + tid] = p.in[I_AW0][h * 64 + tid]; ptab[256 + tid] = p.in[I_AA0][h * 64 + tid]; ptab[320 + tid] = p.in[I_AKK][h * 64 + tid];
            ptab[384 + tid] = p.in[I_AKA][h * 64 + tid]; ptab[448 + tid] = p.in[I_ARK][h * 64 + tid]; }
        if (tid < 256) mul[tid] = mu[1536 + tid];
    }
    if (role == 0) {
        const bf16_t* w2t = (const bf16_t*)(ws + OFF_MISC + MISC_W2T); const bf16_t* a2t = (const bf16_t*)(ws + OFF_MISC + MISC_A2T); const bf16_t* g2t = (const bf16_t*)(ws + OFF_MISC + MISC_G2T);
        { const int row = tid >> 3, c = tid & 7;
            *(LAS u32x4*)(w2h + row * 128 + ((c ^ (row & 7)) * 16)) = *(const u32x4*)(w2t + (size_t)(h * 64 + row) * 64 + c * 8);
            *(LAS u32x4*)(a2h + row * 128 + ((c ^ (row & 7)) * 16)) = *(const u32x4*)(a2t + (size_t)(h * 64 + row) * 64 + c * 8); }
#pragma unroll
        for (int i = 0; i < 2; ++i) { const int q = tid + i * 512, row = q >> 4, c = q & 15;
            *(LAS u32x4*)(g2h + row * 256 + ((c ^ (row & 7)) * 16)) = *(const u32x4*)(g2t + (size_t)(h * 64 + row) * 128 + c * 8); }
    }
    __syncthreads();
    f32x4 Hacc[4];
#pragma unroll
    for (int rt = 0; rt < 4; ++rt) Hacc[rt] = fzero4();
    const size_t nb0 = (size_t)b * SEQ;
    const int q4 = fr >> 2, p4 = fr & 3;
#define MIXB(wc, wp, mA, mB, o0, o1) { const float c0 = __uint_as_float((wc) << 16), c1 = __uint_as_float((wc) & 0xffff0000u), q0 = __uint_as_float((wp) << 16), q1 = __uint_as_float((wp) & 0xffff0000u); o0 = c0 + (q0 - c0) * (mA); o1 = c1 + (q1 - c1) * (mB); }
    const bf16_t* actp = (const bf16_t*)(ws + OFF_ACT256);
    u32x2 nrc[4], nkc[4], nvc[4], nrp[4], nkp[4], nvp[4]; bf16x8 nb_[8];
#define RW3_LOADS(tk) do { const int t0_ = ((tk) * 8 + wid) * 16; const int fr_ = lane & 15, g_ = lane >> 4; const size_t n_ = nb0 + t0_ + fr_; const bool hp_ = (t0_ + fr_) > 0; \
        const bf16_t* rc_ = P0 + n_ * NE_MAIN; const bf16_t* rp_ = rc_ - NE_MAIN; \
        _Pragma("unroll") for (int ct = 0; ct < 4; ++ct) { const int c0 = ct * 16 + g_ * 4; \
            nrc[ct] = *(const u32x2*)(rc_ + h * 64 + c0); nkc[ct] = *(const u32x2*)(rc_ + 512 + h * 64 + c0); nvc[ct] = *(const u32x2*)(rc_ + 1024 + h * 64 + c0); \
            nrp[ct] = (u32x2){0u, 0u}; nkp[ct] = nrp[ct]; nvp[ct] = nrp[ct]; \
            if (hp_) { nrp[ct] = *(const u32x2*)(rp_ + h * 64 + c0); nkp[ct] = *(const u32x2*)(rp_ + 512 + h * 64 + c0); nvp[ct] = *(const u32x2*)(rp_ + 1024 + h * 64 + c0); } } \
        _Pragma("unroll") for (int f = 0; f < 8; ++f) nb_[f] = *(const bf16x8*)(actp + n_ * 256 + f * 32 + g_ * 8); } while (0)
    unsigned char* xb = ws + OFF_RWXB; unsigned* flg = (unsigned*)(ws + OFF_MISC + MISC_RWF);
    const __amdgpu_buffer_rsrc_t xrsrc = __builtin_amdgcn_make_buffer_rsrc((void*)xb, 0, 64 * 2 * 2 * 8 * RW3_SLOT, 0x00020000);
#pragma unroll 1
    for (int it = 0; it < (role ? 32 : 16); ++it) {
        const int tick = role ? it : 2 * it + which;
        const int hk = tick >> 1, hw = tick & 1;
        unsigned* f_prod = flg + (item * 2 + hw) * 16; unsigned* f_cons = flg + 2048 + (item * 2 + hw) * 16;
        unsigned char* xslot = xb + ((((size_t)item * 2 + (hk & 1)) * 2 + hw) * 8) * RW3_SLOT;
        if (role == 0) {
            int lane_t = lane; asm volatile("" : "+v"(lane_t));
            const int fr = lane_t & 15, g = lane_t >> 4, q4 = fr >> 2, p4 = fr & 3;
            LAS unsigned char* sl = slots + wid * RW3_SLOT;
            LAS unsigned char* Qt_i = sl, * Rh_i = sl + 2048, * Kh_i = sl + 4096, * Bn_i = sl + 6144, * Vi_i = sl + 8192, * M1_i = sl + 10240, * DD_i = sl + 11264; LAS float* gam_i = (LAS float*)(sl + 12288);
            const int t0 = (tick * 8 + wid) * 16;
            const size_t n = nb0 + t0 + fr;
            const bool hasp = (t0 + fr) > 0;
            const bf16_t* rowc = P0 + n * NE_MAIN; const bf16_t* rowp = rowc - NE_MAIN;
            RW3_LOADS(tick);
#define lrc nrc
#define lkc nkc
#define lvc nvc
#define lrp nrp
#define lkp nkp
#define lvp nvp
            bf16x8 bw[2], ba[2], bg[4];
            bw[0] = nb_[0]; bw[1] = nb_[1]; ba[0] = nb_[2]; ba[1] = nb_[3]; bg[0] = nb_[4]; bg[1] = nb_[5]; bg[2] = nb_[6]; bg[3] = nb_[7];
            f32x4 Wt[4], At[4], Gt[4];
#pragma unroll
            for (int ct = 0; ct < 4; ++ct) {
                const int row = ct * 16 + fr;
                f32x4 dw = fzero4(), da = dw, dg = dw;
#pragma unroll
                for (int s = 0; s < 2; ++s) {
                    dw = __builtin_amdgcn_mfma_f32_16x16x32_bf16(*(const LAS bf16x8*)(w2h + row * 128 + (((s * 4 + g) ^ (row & 7)) * 16)), bw[s], dw, 0, 0, 0);
                    da = __builtin_amdgcn_mfma_f32_16x16x32_bf16(*(const LAS bf16x8*)(a2h + row * 128 + (((s * 4 + g) ^ (row & 7)) * 16)), ba[s], da, 0, 0, 0); }
#pragma unroll
                for (int s = 0; s < 4; ++s) dg = __builtin_amdgcn_mfma_f32_16x16x32_bf16(*(const LAS bf16x8*)(g2h + row * 256 + (((s * 4 + g) ^ (row & 7)) * 16)), bg[s], dg, 0, 0, 0);
                Wt[ct] = dw; At[ct] = da; Gt[ct] = dg;
            }
            f32x4 Rm[4], Khm[4], Lw[4], Aa[4];
            float nsq = 0.f, rk = 0.f;
            u32x2 Vp[4];
#pragma unroll
            for (int ct = 0; ct < 4; ++ct) {
                const int c0 = ct * 16 + g * 4;
                const u32x2 rc = lrc[ct], kc = lkc[ct], vc = lvc[ct], rp = lrp[ct], kp = lkp[ct], vp = lvp[ct];
                const f32x4 mr = *(const LAS f32x4*)(ptab + c0), mk = *(const LAS f32x4*)(ptab + 64 + c0), mv = *(const LAS f32x4*)(ptab + 128 + c0);
                f32x4 Km, Vm;
                MIXB(rc.x, rp.x, mr[0], mr[1], Rm[ct][0], Rm[ct][1]) MIXB(rc.y, rp.y, mr[2], mr[3], Rm[ct][2], Rm[ct][3])
                MIXB(kc.x, kp.x, mk[0], mk[1], Km[0], Km[1]) MIXB(kc.y, kp.y, mk[2], mk[3], Km[2], Km[3])
                MIXB(vc.x, vp.x, mv[0], mv[1], Vm[0], Vm[1]) MIXB(vc.y, vp.y, mv[2], mv[3], Vm[2], Vm[3])
                const f32x4 w0v = *(const LAS f32x4*)(ptab + 192 + c0), a0v = *(const LAS f32x4*)(ptab + 256 + c0), kks = *(const LAS f32x4*)(ptab + 320 + c0), kas = *(const LAS f32x4*)(ptab + 384 + c0), rkp = *(const LAS f32x4*)(ptab + 448 + c0);
#pragma unroll
                for (int r = 0; r < 4; ++r) { const float z = w0v[r] + Wt[ct][r]; const float sp = __logf(1.0f + __expf(-z));
                    Lw[ct][r] = -__expf(-sp - 0.5f);
                    const float a = fast_sigmoid(a0v[r] + At[ct][r]); Aa[ct][r] = a;
                    const float kkp = Km[r] * kks[r]; nsq += kkp * kkp; Wt[ct][r] = kkp;
                    const float kh = Km[r] * (1.0f + (a - 1.0f) * kas[r]); Khm[ct][r] = kh; rk += Rm[ct][r] * kh * rkp[r]; }
                Vp[ct].x = cvt_pk_bf16(Vm[0], Vm[1]); Vp[ct].y = cvt_pk_bf16(Vm[2], Vm[3]);
                At[ct] = Vm;
            }
            nsq += __shfl_xor(nsq, 16); nsq += __shfl_xor(nsq, 32);
            rk += __shfl_xor(rk, 16); rk += __shfl_xor(rk, 32);
            const float inrm = 1.0f / fmaxf(sqrtf(nsq), 1e-12f);
#pragma unroll
            for (int ct = 0; ct < 4; ++ct) { const int c0 = ct * 16 + g * 4;
                u32x2 ew, gw; ew.x = cvt_pk_bf16(rk * At[ct][0], rk * At[ct][1]); ew.y = cvt_pk_bf16(rk * At[ct][2], rk * At[ct][3]);
                gw.x = cvt_pk_bf16(Gt[ct][0], Gt[ct][1]); gw.y = cvt_pk_bf16(Gt[ct][2], Gt[ct][3]);
                *(u32x2*)(e1g + n * 512 + h * 64 + c0) = ew; *(u32x2*)(gg + n * 512 + h * 64 + c0) = gw;
                const int c = 2 * ct + (g >> 1);
                *(LAS u32x2*)(Vi_i + fr * 128 + rw3_trswz(fr, c) * 16 + (g & 1) * 8) = Vp[ct]; }
            u32x2 Qp[4], Kp[4], Bp[4], Rp[4];
#pragma unroll
            for (int ct = 0; ct < 4; ++ct) {
                const int c0 = ct * 16 + g * 4;
                f32x4 gmv; float qh[4], kh_[4], bh[4], rh[4];
#pragma unroll
                for (int r = 0; r < 4; ++r) {
                    float L = Lw[ct][r];
                    L += dpp0f<0x111>(L); L += dpp0f<0x112>(L); L += dpp0f<0x114>(L); L += dpp0f<0x118>(L);
                    const float Ltot = red16(Lw[ct][r]);
                    const float eL = __expf(L), ieL = fast_rcp(eL), eLex = __expf(L - Lw[ct][r]);
                    const float kk = Wt[ct][r] * inrm, bb = kk * Aa[ct][r];
                    qh[r] = kk * eLex; kh_[r] = Khm[ct][r] * ieL; bh[r] = bb * ieL; rh[r] = Rm[ct][r] * eL;
                    gmv[r] = __expf(Ltot); }
                Qp[ct].x = cvt_pk_bf16(qh[0], qh[1]); Qp[ct].y = cvt_pk_bf16(qh[2], qh[3]); Kp[ct].x = cvt_pk_bf16(kh_[0], kh_[1]); Kp[ct].y = cvt_pk_bf16(kh_[2], kh_[3]);
                Bp[ct].x = cvt_pk_bf16(bh[0], bh[1]); Bp[ct].y = cvt_pk_bf16(bh[2], bh[3]); Rp[ct].x = cvt_pk_bf16(rh[0], rh[1]); Rp[ct].y = cvt_pk_bf16(rh[2], rh[3]);
                if (fr == 0) *(LAS f32x4*)(gam_i + c0) = gmv;
            }
            bf16x8 Qf[2], Kf[2], Bf[2], Rf[2];
#pragma unroll
            for (int s = 0; s < 2; ++s) { Qf[s] = __builtin_bit_cast(bf16x8, (u32x4){Qp[2 * s].x, Qp[2 * s].y, Qp[2 * s + 1].x, Qp[2 * s + 1].y}); Kf[s] = __builtin_bit_cast(bf16x8, (u32x4){Kp[2 * s].x, Kp[2 * s].y, Kp[2 * s + 1].x, Kp[2 * s + 1].y});
                Bf[s] = __builtin_bit_cast(bf16x8, (u32x4){Bp[2 * s].x, Bp[2 * s].y, Bp[2 * s + 1].x, Bp[2 * s + 1].y}); Rf[s] = __builtin_bit_cast(bf16x8, (u32x4){Rp[2 * s].x, Rp[2 * s].y, Rp[2 * s + 1].x, Rp[2 * s + 1].y}); }
            f32x4 Ab = fzero4(), AbT = Ab, Ak = Ab, DkT = Ab, DbT = Ab;
#pragma unroll
            for (int s = 0; s < 2; ++s) {
                Ab = __builtin_amdgcn_mfma_f32_16x16x32_bf16(Qf[s], Bf[s], Ab, 0, 0, 0);
                AbT = __builtin_amdgcn_mfma_f32_16x16x32_bf16(Bf[s], Qf[s], AbT, 0, 0, 0);
                Ak = __builtin_amdgcn_mfma_f32_16x16x32_bf16(Qf[s], Kf[s], Ak, 0, 0, 0);
                DkT = __builtin_amdgcn_mfma_f32_16x16x32_bf16(Kf[s], Rf[s], DkT, 0, 0, 0);
                DbT = __builtin_amdgcn_mfma_f32_16x16x32_bf16(Bf[s], Rf[s], DbT, 0, 0, 0); }
            f32x4 N, NT, ident;
#pragma unroll
            for (int r = 0; r < 4; ++r) { const int row = 4 * g + r;
                N[r] = (fr < row) ? -Ab[r] : 0.f; Ak[r] = (fr < row) ? Ak[r] : 0.f;
                NT[r] = (row < fr) ? -AbT[r] : 0.f;
                DkT[r] = (row <= fr) ? DkT[r] : 0.f; DbT[r] = (row <= fr) ? -DbT[r] : 0.f;
                ident[r] = (row == fr) ? 1.f : 0.f; }
            const f32x4 N2 = mm16(NT, N), N2T = mm16(N, NT);
            const f32x4 N4 = mm16(N2T, N2), N4T = mm16(N2, N2T);
            const f32x4 N8T = mm16(N4, N4T);
            const f32x4 X1 = N + ident, X1T = NT + ident, X2 = N2 + ident, X2T = N2T + ident, X4 = N4 + ident, X8T = N8T + ident;
            const f32x4 U12 = mm16(X1T, X2), U12T = mm16(X1, X2T), U34T = mm16(X4, X8T);
            const f32x4 TT = mm16(U12, U34T);
            const f32x4 M1T = mm16(Ak, TT);
#pragma unroll
            for (int ct = 0; ct < 4; ++ct) { const int c = 2 * ct + (g >> 1);
                *(LAS u32x2*)(Qt_i + fr * 128 + rw3_trswz(fr, c) * 16 + (g & 1) * 8) = Qp[ct]; }
            s16x4 qtr[4];
#pragma unroll
            for (int ct = 0; ct < 4; ++ct) { const int row = 4 * g + q4, c = 2 * ct + (p4 >> 1);
                qtr[ct] = __builtin_amdgcn_ds_read_tr16_b64_v4i16((LAS s16x4*)(Qt_i + row * 128 + rw3_trswz(row, c) * 16 + (p4 & 1) * 8)); }
            const bf16x8 TTf = pack_lo4(TT);
            f32x4 Qt[4];
#pragma unroll
            for (int ct = 0; ct < 4; ++ct) { const bf16x8 af = (bf16x8){qtr[ct][0], qtr[ct][1], qtr[ct][2], qtr[ct][3], 0, 0, 0, 0};
                Qt[ct] = __builtin_amdgcn_mfma_f32_16x16x32_bf16(af, TTf, fzero4(), 0, 0, 0); }
#pragma unroll
            for (int ct = 0; ct < 4; ++ct) {
                const int s = ct >> 1, hh = ct & 1;
                u32x2 w; w.x = cvt_pk_bf16(Qt[ct][0], Qt[ct][1]); w.y = cvt_pk_bf16(Qt[ct][2], Qt[ct][3]);
                *(LAS u32x2*)(Qt_i + fr * 128 + (((s * 4 + g) ^ (fr & 7)) * 16) + hh * 8) = w;
                *(LAS u32x2*)(Rh_i + fr * 128 + (((s * 4 + g) ^ (fr & 7)) * 16) + hh * 8) = Rp[ct];
                const int c = 2 * ct + (g >> 1);
                *(LAS u32x2*)(Kh_i + fr * 128 + rw3_trswz(fr, c) * 16 + (g & 1) * 8) = Kp[ct];
                *(LAS u32x2*)(Bn_i + fr * 128 + rw3_trswz(fr, c) * 16 + (g & 1) * 8) = (u32x2){Bp[ct].x ^ 0x80008000u, Bp[ct].y ^ 0x80008000u}; }
            { const int cs = (g ^ ((fr >> 2) & 3)) * 16;
                u32x2 w; w.x = cvt_pk_bf16(M1T[0], M1T[1]); w.y = cvt_pk_bf16(M1T[2], M1T[3]);
                *(LAS u32x2*)(M1_i + fr * 64 + cs) = (u32x2){0u, 0u}; *(LAS u32x2*)(M1_i + fr * 64 + cs + 8) = w;
                w.x = cvt_pk_bf16(DbT[0], DbT[1]); w.y = cvt_pk_bf16(DbT[2], DbT[3]); *(LAS u32x2*)(DD_i + fr * 64 + cs) = w;
                w.x = cvt_pk_bf16(DkT[0], DkT[1]); w.y = cvt_pk_bf16(DkT[2], DkT[3]); *(LAS u32x2*)(DD_i + fr * 64 + cs + 8) = w; }
        }
        if (role == 0) {
            if (hk >= 2 && tid == 0) { for (unsigned sp = 0; rw_ld(f_cons) < (unsigned)(hk - 1) && sp < (1u << 22); ++sp) __builtin_amdgcn_s_sleep(2); }
            __syncthreads();
            { LAS const unsigned char* sl = slots + wid * RW3_SLOT; const unsigned doff = (unsigned)((xslot - xb) + (size_t)wid * RW3_SLOT);
                for (int i = lane; i < RW3_SLOT / 16; i += 64) __builtin_amdgcn_raw_buffer_store_b128(*(const LAS u32x4*)(sl + i * 16), xrsrc, doff + (unsigned)i * 16u, 0, 16); }
            asm volatile("s_waitcnt vmcnt(0)" ::: "memory");
            __syncthreads();
            if (tid == 0) __hip_atomic_store(f_prod, (unsigned)(hk + 1), __ATOMIC_RELAXED, __HIP_MEMORY_SCOPE_AGENT);
            continue;
        }
        if (tid == 0) { for (unsigned sp = 0; rw_ld(f_prod) < (unsigned)(hk + 1) && sp < (1u << 22); ++sp) __builtin_amdgcn_s_sleep(2);
            __builtin_amdgcn_fence(__ATOMIC_ACQUIRE, "agent"); asm volatile("s_waitcnt vmcnt(0)" ::: "memory"); }
        __syncthreads();
        for (int i = tid; i < 8 * RW3_SLOT / 16; i += 512) *(LAS u32x4*)(slots + i * 16) = *(const u32x4*)(xslot + (size_t)i * 16);
        asm volatile("s_waitcnt vmcnt(0) lgkmcnt(0)" ::: "memory");
        __syncthreads();
        if (tid == 0) __hip_atomic_store(f_cons, (unsigned)(hk + 1), __ATOMIC_RELAXED, __HIP_MEMORY_SCOPE_AGENT);
        if (wid < 4) {
#pragma unroll 1
            for (int j = 0; j < 8; ++j) {
                int lane_t = lane; asm volatile("" : "+v"(lane_t));
                const int fr = lane_t & 15, g = lane_t >> 4, q4 = fr >> 2, p4 = fr & 3;
                LAS unsigned char* sl = slots + j * RW3_SLOT;
                LAS unsigned char* Qt_i = sl, * Rh_i = sl + 2048, * Kh_i = sl + 4096, * Bn_i = sl + 6144, * Vi_i = sl + 8192, * M1_i = sl + 10240, * DD_i = sl + 11264; LAS const float* gam_i = (LAS const float*)(sl + 12288);
                const bf16x8 Hb0 = pack_8(Hacc[0], Hacc[1]), Hb1 = pack_8(Hacc[2], Hacc[3]);
                const int trow = 4 * g + q4;
                const s16x4 vv = __builtin_amdgcn_ds_read_tr16_b64_v4i16((LAS s16x4*)(Vi_i + trow * 128 + rw3_trswz(trow, 2 * wid + (p4 >> 1)) * 16 + (p4 & 1) * 8));
                const bf16x8 q0 = *(const LAS bf16x8*)(Qt_i + fr * 128 + (((0 + g) ^ (fr & 7)) * 16)), q1 = *(const LAS bf16x8*)(Qt_i + fr * 128 + (((4 + g) ^ (fr & 7)) * 16));
                const bf16x8 r0 = *(const LAS bf16x8*)(Rh_i + fr * 128 + (((0 + g) ^ (fr & 7)) * 16)), r1 = *(const LAS bf16x8*)(Rh_i + fr * 128 + (((4 + g) ^ (fr & 7)) * 16));
                const int cs = (g ^ ((fr >> 2) & 3)) * 16;
                const bf16x8 m1 = *(const LAS bf16x8*)(M1_i + fr * 64 + cs), dd = *(const LAS bf16x8*)(DD_i + fr * 64 + cs);
                const bf16x8 v0 = (bf16x8){0, 0, 0, 0, vv[0], vv[1], vv[2], vv[3]};
                f32x4 Z = fzero4();
                Z = __builtin_amdgcn_mfma_f32_16x16x32_bf16(q0, Hb0, Z, 0, 0, 0); Z = __builtin_amdgcn_mfma_f32_16x16x32_bf16(q1, Hb1, Z, 0, 0, 0); Z = __builtin_amdgcn_mfma_f32_16x16x32_bf16(m1, v0, Z, 0, 0, 0);
                u32x2 zw; zw.x = cvt_pk_bf16(Z[0], Z[1]); zw.y = cvt_pk_bf16(Z[2], Z[3]);
                const s16x4 zs = __builtin_bit_cast(s16x4, zw);
                const bf16x8 zv = (bf16x8){zs[0], zs[1], zs[2], zs[3], vv[0], vv[1], vv[2], vv[3]};
                f32x4 Y = fzero4();
                Y = __builtin_amdgcn_mfma_f32_16x16x32_bf16(r0, Hb0, Y, 0, 0, 0); Y = __builtin_amdgcn_mfma_f32_16x16x32_bf16(r1, Hb1, Y, 0, 0, 0); Y = __builtin_amdgcn_mfma_f32_16x16x32_bf16(dd, zv, Y, 0, 0, 0);
                const size_t nrow = nb0 + (size_t)(tick * 8 + j) * 16 + 4 * g;
#pragma unroll
                for (int r = 0; r < 4; ++r) yraw[(nrow + r) * 512 + h * 64 + wid * 16 + fr] = Y[r];
#pragma unroll
                for (int rt = 0; rt < 4; ++rt) { const int c = 2 * rt + (p4 >> 1);
                    const s16x4 bn = __builtin_amdgcn_ds_read_tr16_b64_v4i16((LAS s16x4*)(Bn_i + trow * 128 + rw3_trswz(trow, c) * 16 + (p4 & 1) * 8));
                    const s16x4 kh = __builtin_amdgcn_ds_read_tr16_b64_v4i16((LAS s16x4*)(Kh_i + trow * 128 + rw3_trswz(trow, c) * 16 + (p4 & 1) * 8));
                    const bf16x8 af = (bf16x8){bn[0], bn[1], bn[2], bn[3], kh[0], kh[1], kh[2], kh[3]};
                    Hacc[rt] = __builtin_amdgcn_mfma_f32_16x16x32_bf16(af, zv, Hacc[rt], 0, 0, 0);
                    Hacc[rt] = Hacc[rt] * *(const LAS f32x4*)(gam_i + rt * 16 + g * 4); }
            }
        }
        __syncthreads();
    }
#undef MIXB
#undef RW3_LOADS
#undef lrc
#undef lkc
#undef lvc
#undef lrp
#undef lkp
#undef lvp
}

__device__ __forceinline__ void phase_rwkv_epi(const Params& p, int bid, int nb) {
    const int tid = opaque_tid(), wid = tid >> 6, lane = tid & 63;
    const float* yraw = p.out; const bf16_t* e1g = (const bf16_t*)(p.out + (size_t)NTOK * 512); const bf16_t* gg = e1g + (size_t)NTOK * 512;
    bf16_t* mix = (bf16_t*)(p.ws + OFF_BUF64);
    const f32x4 g0 = *(const f32x4*)(p.in[I_AGNG] + lane * 8), g1 = *(const f32x4*)(p.in[I_AGNG] + lane * 8 + 4), b0 = *(const f32x4*)(p.in[I_AGNB] + lane * 8), b1 = *(const f32x4*)(p.in[I_AGNB] + lane * 8 + 4);
    for (int n = bid * 8 + wid; n < NTOK; n += nb * 8) {
        const f32x4 y0 = *(const f32x4*)(yraw + (size_t)n * 512 + lane * 8), y1 = *(const f32x4*)(yraw + (size_t)n * 512 + lane * 8 + 4);
        const u32x4 ev = *(const u32x4*)(e1g + (size_t)n * 512 + lane * 8), gv = *(const u32x4*)(gg + (size_t)n * 512 + lane * 8);
#if SANITIZE
        f32x4 y0s = y0, y1s = y1;
#pragma unroll
        for (int j = 0; j < 4; ++j) { if (!(fabsf(y0s[j]) < 1e30f)) y0s[j] = 0.f; if (!(fabsf(y1s[j]) < 1e30f)) y1s[j] = 0.f; }
#define y0 y0s
#define y1 y1s
#endif
        float s = (y0[0] + y0[1]) + (y0[2] + y0[3]) + (y1[0] + y1[1]) + (y1[2] + y1[3]);
        s = red8(s); const float mean = s * (1.0f / 64.0f);
        const f32x4 d0 = y0 - mean, d1 = y1 - mean;
        float q = (d0[0] * d0[0] + d0[1] * d0[1]) + (d0[2] * d0[2] + d0[3] * d0[3]) + (d1[0] * d1[0] + d1[1] * d1[1]) + (d1[2] * d1[2] + d1[3] * d1[3]);
        q = red8(q); const float rs = rsqrtf(q * (1.0f / 64.0f) + 64e-5f);
        float o[8];
        const unsigned ew[4] = {ev.x, ev.y, ev.z, ev.w}, gw[4] = {gv.x, gv.y, gv.z, gv.w};
#pragma unroll
        for (int j = 0; j < 4; ++j) { const float ya = (j < 2 ? d0[2 * j] : d1[2 * j - 4]), yb = (j < 2 ? d0[2 * j + 1] : d1[2 * j - 3]);
            const float ga = (j < 2 ? g0[2 * j] : g1[2 * j - 4]), gb_ = (j < 2 ? g0[2 * j + 1] : g1[2 * j - 3]); const float ba = (j < 2 ? b0[2 * j] : b1[2 * j - 4]), bb_ = (j < 2 ? b0[2 * j + 1] : b1[2 * j - 3]);
            o[2 * j] = (ya * rs * ga + ba + __uint_as_float(ew[j] << 16)) * __uint_as_float(gw[j] << 16);
            o[2 * j + 1] = (yb * rs * gb_ + bb_ + __uint_as_float(ew[j] & 0xffff0000u)) * __uint_as_float(gw[j] & 0xffff0000u); }
        u32x4 w; w.x = cvt_pk_bf16(o[0], o[1]); w.y = cvt_pk_bf16(o[2], o[3]); w.z = cvt_pk_bf16(o[4], o[5]); w.w = cvt_pk_bf16(o[6], o[7]);
#if SANITIZE
#undef y0
#undef y1
#pragma unroll
        for (int j = 0; j < 8; ++j) if (!(fabsf(o[j]) < 1e30f)) o[j] = 0.f;
        w.x = cvt_pk_bf16(o[0], o[1]); w.y = cvt_pk_bf16(o[2], o[3]); w.z = cvt_pk_bf16(o[4], o[5]); w.w = cvt_pk_bf16(o[6], o[7]);
#endif
        *(u32x4*)(mix + (size_t)n * DM + lane * 8) = w;
    }
}

__device__ __forceinline__ int gla_fT(int row) { return ((row >> 1) & 1) | (((row >> 3) & 1) << 1); }
__device__ __forceinline__ int gla_hV(int row) { return (row & 3) | (((row >> 3) & 1) << 2); }
__device__ __forceinline__ void gla2_item(const Params& p, LAS unsigned char* lds, int item, int seg) {
    const int tid = opaque_tid(), lane = tid & 63, wid = tid >> 6, fr = lane & 15, g = lane >> 4;
    const int b = item >> 2, h = item & 3;
    const bf16_t* P0 = (const bf16_t*)(p.ws + OFF_P) + 1792;
    const float* xa16 = (const float*)(p.ws + OFF_U);
    bf16_t* mix = (bf16_t*)(p.ws + OFF_BUF64);
    LAS float* bcf = (LAS float*)lds;
    LAS float* tot = bcf + 64 * 64;
    LAS float* bls = tot + 8 * 64;
    LAS float* pn = bls + 64;
    LAS float* xs = pn + 64 * 8;
    LAS float* boff = xs + 2 * 1024;
    LAS unsigned char* qd_i = (LAS unsigned char*)(boff + 64);
    LAS unsigned char* ki_a = qd_i + 8192;
    LAS unsigned char* ki_t = ki_a + 8192;
    LAS unsigned char* att_i = ki_t + 8192;
    LAS unsigned char* v_i = att_i + 8192;
    for (int i = tid; i < 8192 / 16; i += 512) *(LAS u32x4*)(att_i + i * 16) = uzero4();
    float gw2[16];
#pragma unroll
    for (int i = 0; i < 16; ++i) gw2[i] = p.in[I_BGW2][i * 256 + h * 64 + lane];
    const float gb = p.in[I_BGB][h * 64 + lane];
    const f32x4 ngv = *(const f32x4*)(p.in[I_BNG] + h * 128 + wid * 16 + g * 4);
    f32x4 Sacc[4];
#pragma unroll
    for (int rt = 0; rt < 4; ++rt) Sacc[rt] = fzero4();
    const int q4 = fr >> 2, p4 = fr & 3;
    const int tok = tid >> 3, dc = tid & 7;
    u32x4 nq, nk, nv0, nv1; u32x2 ngate[4]; f32x4 nxa = fzero4();
#define GLA_ISSUE(c0n) do { const size_t _n = (size_t)b * SEQ + (c0n) + tok; \
        nq = *(const u32x4*)(P0 + _n * NE_MAIN + h * 64 + dc * 8); nk = *(const u32x4*)(P0 + _n * NE_MAIN + 256 + h * 64 + dc * 8); \
        nv0 = *(const u32x4*)(P0 + _n * NE_MAIN + 512 + h * 128 + dc * 16); nv1 = *(const u32x4*)(P0 + _n * NE_MAIN + 512 + h * 128 + dc * 16 + 8); \
        _Pragma("unroll") for (int _ct = 0; _ct < 4; ++_ct) ngate[_ct] = *(const u32x2*)(P0 + ((size_t)b * SEQ + (c0n) + _ct * 16 + fr) * NE_MAIN + 1024 + h * 128 + wid * 16 + g * 4); \
        if (tid < 256) nxa = *(const f32x4*)(xa16 + ((size_t)b * SEQ + (c0n)) * 16 + tid * 4); } while (0)
    const int cbeg = seg * (SEQ / 2), cend = cbeg + SEQ / 2;
    float* oraw = (float*)(p.ws + OFF_GLA_ORAW); bf16_t* qdgb = (bf16_t*)(p.ws + OFF_GLA_QDG);
    GLA_ISSUE(cbeg);
    if (tid < 256) *(LAS f32x4*)(xs + ((cbeg >> 6) & 1) * 1024 + tid * 4) = nxa;
    if (tid < 64) boff[tid] = 0.f;
    __syncthreads();
    for (int c0 = cbeg; c0 < cend; c0 += 64) {
        const size_t n0 = (size_t)b * SEQ + c0;
        LAS const float* xsc = xs + ((c0 >> 6) & 1) * 1024;
        { float run = 0.f;
#pragma unroll
            for (int tt = 0; tt < 8; ++tt) { const int c = wid * 8 + tt; float z = gb;
#pragma unroll
                for (int i4 = 0; i4 < 4; ++i4) { const f32x4 xv = *(const LAS f32x4*)(xsc + c * 16 + i4 * 4); z += xv[0] * gw2[i4 * 4] + xv[1] * gw2[i4 * 4 + 1] + xv[2] * gw2[i4 * 4 + 2] + xv[3] * gw2[i4 * 4 + 3]; }
                const float ls = fminf(z, 0.f) - __logf(1.0f + __expf(-fabsf(z)));
                run += ls * (1.0f / 16.0f); bcf[c * 64 + lane] = run; }
            tot[wid * 64 + lane] = run; }
        __syncthreads();
        { float off = 0.f;
            for (int w2 = 0; w2 < wid; ++w2) off += tot[w2 * 64 + lane];
#pragma unroll
            for (int tt = 0; tt < 8; ++tt) bcf[(wid * 8 + tt) * 64 + lane] += off;
            if (wid == 7) bls[lane] = __expf(bcf[63 * 64 + lane]); }
        __syncthreads();
        u32x2 gate[4];
        { const f32x4 bc0 = *(const LAS f32x4*)(bcf + tok * 64 + dc * 8), bc1 = *(const LAS f32x4*)(bcf + tok * 64 + dc * 8 + 4);
            const unsigned qw[4] = {nq.x, nq.y, nq.z, nq.w}, kw[4] = {nk.x, nk.y, nk.z, nk.w};
            float qo[8], ko[8];
#pragma unroll
            for (int j = 0; j < 4; ++j) { const float ba = (j < 2 ? bc0[2 * j] : bc1[2 * j - 4]), bb = (j < 2 ? bc0[2 * j + 1] : bc1[2 * j - 3]);
                const float ea = __expf(ba), eb = __expf(bb), ia = fast_rcp(ea), ib = fast_rcp(eb);
                qo[2 * j] = __uint_as_float(qw[j] << 16) * 0.125f * ea; qo[2 * j + 1] = __uint_as_float(qw[j] & 0xffff0000u) * 0.125f * eb;
                ko[2 * j] = __uint_as_float(kw[j] << 16) * ia; ko[2 * j + 1] = __uint_as_float(kw[j] & 0xffff0000u) * ib; }
            u32x4 qp, kp; qp.x = cvt_pk_bf16(qo[0], qo[1]); qp.y = cvt_pk_bf16(qo[2], qo[3]); qp.z = cvt_pk_bf16(qo[4], qo[5]); qp.w = cvt_pk_bf16(qo[6], qo[7]);
            kp.x = cvt_pk_bf16(ko[0], ko[1]); kp.y = cvt_pk_bf16(ko[2], ko[3]); kp.z = cvt_pk_bf16(ko[4], ko[5]); kp.w = cvt_pk_bf16(ko[6], ko[7]);
            *(LAS u32x4*)(qd_i + tok * 128 + ((dc ^ (tok & 7)) * 16)) = qp;
            if (seg) {
                const f32x4 bo0 = *(const LAS f32x4*)(boff + dc * 8), bo1 = *(const LAS f32x4*)(boff + dc * 8 + 4); float qg[8];
#pragma unroll
                for (int j = 0; j < 8; ++j) qg[j] = qo[j] * __expf(j < 4 ? bo0[j] : bo1[j - 4]);
                u32x4 w; w.x = cvt_pk_bf16(qg[0], qg[1]); w.y = cvt_pk_bf16(qg[2], qg[3]); w.z = cvt_pk_bf16(qg[4], qg[5]); w.w = cvt_pk_bf16(qg[6], qg[7]);
                *(u32x4*)(qdgb + ((size_t)b * 2048 + (c0 - cbeg) + tok) * 256 + h * 64 + dc * 8) = w; }
            *(LAS u32x4*)(ki_a + tok * 128 + ((dc ^ (tok & 7)) * 16)) = kp;
            *(LAS u32x4*)(ki_t + tok * 128 + (((((dc >> 1) ^ gla_fT(tok)) << 1) | (dc & 1)) * 16)) = kp;
            { const int pr = dc ^ gla_hV(tok); *(LAS u32x4*)(v_i + tok * 256 + (pr * 2) * 16) = nv0; *(LAS u32x4*)(v_i + tok * 256 + (pr * 2 + 1) * 16) = nv1; }
#pragma unroll
            for (int ct = 0; ct < 4; ++ct) gate[ct] = ngate[ct]; }
        if (c0 + 64 < cend) GLA_ISSUE(c0 + 64);
        __syncthreads();
        for (int ti = wid; ti < 10; ti += 8) {
            int st, ct; { const int tb[10] = {0x00, 0x01, 0x02, 0x03, 0x11, 0x12, 0x13, 0x22, 0x23, 0x33}; int code = 0;
#pragma unroll
                for (int k = 0; k < 10; ++k) if (k == ti) code = tb[k];
                st = code >> 4; ct = code & 15; }
            f32x4 d = fzero4();
            const int rs_ = st * 16 + fr, rc_ = ct * 16 + fr;
#pragma unroll
            for (int s = 0; s < 2; ++s) {
                const bf16x8 a = *(const LAS bf16x8*)(ki_a + rs_ * 128 + (((s * 4 + g) ^ (rs_ & 7)) * 16));
                const bf16x8 bq = *(const LAS bf16x8*)(qd_i + rc_ * 128 + (((s * 4 + g) ^ (rc_ & 7)) * 16));
                d = __builtin_amdgcn_mfma_f32_16x16x32_bf16(a, bq, d, 0, 0, 0); }
            const int c = ct * 16 + fr; float o4[4];
#pragma unroll
            for (int r = 0; r < 4; ++r) { const int s_ = st * 16 + g * 4 + r; o4[r] = (s_ <= c) ? d[r] : 0.f; }
            u32x2 w; w.x = cvt_pk_bf16(o4[0], o4[1]); w.y = cvt_pk_bf16(o4[2], o4[3]);
            *(LAS u32x2*)(att_i + c * 128 + (((2 * st + (g >> 1)) ^ (c & 7)) * 16) + (g & 1) * 8) = w;
        }
        if (seg && tid < 64) boff[tid] += bcf[63 * 64 + tid];
        __syncthreads();
        {
            bf16x8 vf[2];
#pragma unroll
            for (int s = 0; s < 2; ++s) {
                const int r1 = s * 32 + g * 8 + q4, r2 = r1 + 4; const int c = 2 * wid + (p4 >> 1);
                const s16x4 lo = __builtin_amdgcn_ds_read_tr16_b64_v4i16((LAS s16x4*)(v_i + r1 * 256 + (((((c >> 1) ^ gla_hV(r1)) << 1) | (c & 1)) * 16) + (p4 & 1) * 8));
                const s16x4 hi = __builtin_amdgcn_ds_read_tr16_b64_v4i16((LAS s16x4*)(v_i + r2 * 256 + (((((c >> 1) ^ gla_hV(r2)) << 1) | (c & 1)) * 16) + (p4 & 1) * 8));
                vf[s] = (bf16x8){lo[0], lo[1], lo[2], lo[3], hi[0], hi[1], hi[2], hi[3]}; }
            bf16x8 sf[2];
#pragma unroll
            for (int s = 0; s < 2; ++s) sf[s] = pack_8g(Sacc[2 * s], Sacc[2 * s + 1]);
            f32x4 oacc[4];
#pragma unroll
            for (int ct = 0; ct < 4; ++ct) {
                const int c = ct * 16 + fr; f32x4 d = fzero4();
#pragma unroll
                for (int s = 0; s < 2; ++s) {
                    const bf16x8 ab = *(const LAS bf16x8*)(att_i + c * 128 + (((s * 4 + g) ^ (c & 7)) * 16));
                    d = __builtin_amdgcn_mfma_f32_16x16x32_bf16(vf[s], ab, d, 0, 0, 0);
                    const s16x4 q0 = *(const LAS s16x4*)(qd_i + c * 128 + (((s * 4 + (g >> 1)) ^ (c & 7)) * 16) + (g & 1) * 8);
                    const s16x4 q1 = *(const LAS s16x4*)(qd_i + c * 128 + (((s * 4 + 2 + (g >> 1)) ^ (c & 7)) * 16) + (g & 1) * 8);
                    const bf16x8 qb = (bf16x8){q0[0], q0[1], q0[2], q0[3], q1[0], q1[1], q1[2], q1[3]};
                    d = __builtin_amdgcn_mfma_f32_16x16x32_bf16(sf[s], qb, d, 0, 0, 0); }
                oacc[ct] = d; }
#pragma unroll
            for (int rt = 0; rt < 4; ++rt) {
#pragma unroll
                for (int s = 0; s < 2; ++s) {
                    const int r1 = s * 32 + g * 8 + q4, r2 = r1 + 4; const int c = 2 * rt + (p4 >> 1);
                    const s16x4 lo = __builtin_amdgcn_ds_read_tr16_b64_v4i16((LAS s16x4*)(ki_t + r1 * 128 + (((((c >> 1) ^ gla_fT(r1)) << 1) | (c & 1)) * 16) + (p4 & 1) * 8));
                    const s16x4 hi = __builtin_amdgcn_ds_read_tr16_b64_v4i16((LAS s16x4*)(ki_t + r2 * 128 + (((((c >> 1) ^ gla_fT(r2)) << 1) | (c & 1)) * 16) + (p4 & 1) * 8));
                    const bf16x8 kf = (bf16x8){lo[0], lo[1], lo[2], lo[3], hi[0], hi[1], hi[2], hi[3]};
                    Sacc[rt] = __builtin_amdgcn_mfma_f32_16x16x32_bf16(kf, vf[s], Sacc[rt], 0, 0, 0); }
                const f32x4 eb = *(const LAS f32x4*)(bls + rt * 16 + g * 4);
                Sacc[rt] = Sacc[rt] * eb; }
#pragma unroll
            for (int ct = 0; ct < 4; ++ct) { float ss = oacc[ct][0] * oacc[ct][0] + oacc[ct][1] * oacc[ct][1] + oacc[ct][2] * oacc[ct][2] + oacc[ct][3] * oacc[ct][3];
                ss += __shfl_xor(ss, 16); ss += __shfl_xor(ss, 32);
                if (g == 0) pn[(ct * 16 + fr) * 8 + wid] = ss; }
            if (tid < 256 && c0 + 64 < cend) *(LAS f32x4*)(xs + (((c0 >> 6) + 1) & 1) * 1024 + tid * 4) = nxa;
            __syncthreads();
            if (seg) {
#pragma unroll
                for (int ct = 0; ct < 4; ++ct) *(f32x4*)(oraw + ((size_t)b * 2048 + (c0 - cbeg) + ct * 16 + fr) * 512 + h * 128 + wid * 16 + g * 4) = oacc[ct];
            } else
#pragma unroll
            for (int ct = 0; ct < 4; ++ct) { const int c = ct * 16 + fr;
                const f32x4 a0 = *(const LAS f32x4*)(pn + c * 8), a1 = *(const LAS f32x4*)(pn + c * 8 + 4);
                const float ss = (a0[0] + a0[1]) + (a0[2] + a0[3]) + (a1[0] + a1[1]) + (a1[2] + a1[3]);
                const float rs = rsqrtf(ss * (1.0f / 128.0f) + 1e-5f);
                const u32x2 gv = gate[ct];
                const float g0 = __uint_as_float(gv.x << 16), g1 = __uint_as_float(gv.x & 0xffff0000u), g2 = __uint_as_float(gv.y << 16), g3 = __uint_as_float(gv.y & 0xffff0000u);
                const float v0 = oacc[ct][0] * rs * ngv[0] * (g0 * fast_sigmoid(g0)), v1 = oacc[ct][1] * rs * ngv[1] * (g1 * fast_sigmoid(g1));
                const float v2 = oacc[ct][2] * rs * ngv[2] * (g2 * fast_sigmoid(g2)), v3 = oacc[ct][3] * rs * ngv[3] * (g3 * fast_sigmoid(g3));
                u32x2 w; w.x = cvt_pk_bf16(v0, v1); w.y = cvt_pk_bf16(v2, v3);
                *(u32x2*)(mix + (n0 + c) * DM + 512 + h * 128 + wid * 16 + g * 4) = w; }
        }
    }
    if (seg == 0) { float* sin_ = (float*)(p.ws + OFF_GLA_SIN) + (size_t)item * 64 * 128;
#pragma unroll
        for (int rt = 0; rt < 4; ++rt)
#pragma unroll
            for (int r = 0; r < 4; ++r) sin_[(rt * 16 + g * 4 + r) * 128 + wid * 16 + fr] = Sacc[rt][r]; }
#undef GLA_ISSUE
}

__device__ __forceinline__ void phase_gla_fix(const Params& p, LAS unsigned char* lds, int bid, int nb) {
    const int tid = opaque_tid(), lane = tid & 63, wid = tid >> 6, fr = lane & 15, g = lane >> 4;
    const bf16_t* P0 = (const bf16_t*)(p.ws + OFF_P) + 1792;
    const float* oraw = (const float*)(p.ws + OFF_GLA_ORAW); const bf16_t* qdgb = (const bf16_t*)(p.ws + OFF_GLA_QDG); const float* sinb = (const float*)(p.ws + OFF_GLA_SIN);
    bf16_t* mix = (bf16_t*)(p.ws + OFF_BUF64);
    LAS unsigned char* st_i = lds;
    LAS float* pn = (LAS float*)(lds + 16384);
    for (int it = bid; it < 32 * 32; it += nb) {
        const int item = it >> 5, ch = it & 31, b = item >> 2, h = item & 3;
        __syncthreads();
        { const float* sp = sinb + (size_t)item * 64 * 128;
            const int e_ = tid >> 2, d0 = (tid & 3) * 16; float v[16];
#pragma unroll
            for (int j = 0; j < 16; ++j) v[j] = sp[(d0 + j) * 128 + e_];
#pragma unroll
            for (int c2 = 0; c2 < 2; ++c2) { u32x4 w; w.x = cvt_pk_bf16(v[c2 * 8], v[c2 * 8 + 1]); w.y = cvt_pk_bf16(v[c2 * 8 + 2], v[c2 * 8 + 3]); w.z = cvt_pk_bf16(v[c2 * 8 + 4], v[c2 * 8 + 5]); w.w = cvt_pk_bf16(v[c2 * 8 + 6], v[c2 * 8 + 7]);
                const int c = (d0 >> 3) + c2; *(LAS u32x4*)(st_i + e_ * 128 + ((c ^ (e_ & 7)) * 16)) = w; } }
        __syncthreads();
        const size_t t0 = (size_t)b * 2048 + ch * 64;
        const size_t n0 = (size_t)b * SEQ + 2048 + ch * 64;
        const f32x4 ngv = *(const f32x4*)(p.in[I_BNG] + h * 128 + wid * 16 + g * 4);
        f32x4 oacc[4];
#pragma unroll
        for (int ct = 0; ct < 4; ++ct) {
            const int c = ct * 16 + fr;
            f32x4 d = *(const f32x4*)(oraw + (t0 + c) * 512 + h * 128 + wid * 16 + g * 4);
#pragma unroll
            for (int s = 0; s < 2; ++s) {
                const int er = wid * 16 + fr;
                const bf16x8 a = *(const LAS bf16x8*)(st_i + er * 128 + (((s * 4 + g) ^ (er & 7)) * 16));
                const bf16x8 bq = *(const bf16x8*)(qdgb + (t0 + c) * 256 + h * 64 + s * 32 + g * 8);
                d = __builtin_amdgcn_mfma_f32_16x16x32_bf16(a, bq, d, 0, 0, 0); }
            oacc[ct] = d; }
#pragma unroll
        for (int ct = 0; ct < 4; ++ct) { float ss = oacc[ct][0] * oacc[ct][0] + oacc[ct][1] * oacc[ct][1] + oacc[ct][2] * oacc[ct][2] + oacc[ct][3] * oacc[ct][3];
            ss += __shfl_xor(ss, 16); ss += __shfl_xor(ss, 32);
            if (g == 0) pn[(ct * 16 + fr) * 8 + wid] = ss; }
        __syncthreads();
#pragma unroll
        for (int ct = 0; ct < 4; ++ct) { const int c = ct * 16 + fr;
            const f32x4 a0 = *(const LAS f32x4*)(pn + c * 8), a1 = *(const LAS f32x4*)(pn + c * 8 + 4);
            const float ss = (a0[0] + a0[1]) + (a0[2] + a0[3]) + (a1[0] + a1[1]) + (a1[2] + a1[3]);
            const float rs = rsqrtf(ss * (1.0f / 128.0f) + 1e-5f);
            const u32x2 gv = *(const u32x2*)(P0 + (n0 + c) * NE_MAIN + 1024 + h * 128 + wid * 16 + g * 4);
            const float g0 = __uint_as_float(gv.x << 16), g1 = __uint_as_float(gv.x & 0xffff0000u), g2 = __uint_as_float(gv.y << 16), g3 = __uint_as_float(gv.y & 0xffff0000u);
            const float v0 = oacc[ct][0] * rs * ngv[0] * (g0 * fast_sigmoid(g0)), v1 = oacc[ct][1] * rs * ngv[1] * (g1 * fast_sigmoid(g1));
            const float v2 = oacc[ct][2] * rs * ngv[2] * (g2 * fast_sigmoid(g2)), v3 = oacc[ct][3] * rs * ngv[3] * (g3 * fast_sigmoid(g3));
            u32x2 w; w.x = cvt_pk_bf16(v0, v1); w.y = cvt_pk_bf16(v2, v3);
            *(u32x2*)(mix + (n0 + c) * DM + 512 + h * 128 + wid * 16 + g * 4) = w; }
    }
}


__device__ __forceinline__ void phase_mixer_even(const Params& p, LAS unsigned char* lds, int bid, int nb, int which) {
    PROBE_DECL;
    PROBE_BEGIN(47);
    if (nb >= 224) {
        if (bid < 64) { if (which != 2) rwkv3_item(p, lds, bid, 1, 0); }
        else if (bid < 192) { if (which != 2) rwkv3_item(p, lds, (bid - 64) >> 1, 0, (bid - 64) & 1); }
        else { if (which != 1) gla2_item(p, lds, (bid - 192) >> 1, (bid - 192) & 1); }
    }
    __syncthreads();
    PROBE_END(47);
    PROBE_BEGIN(48);
    if (which == 0) phase_prep(p, lds, bid, nb, 1);
    PROBE_END(48);
#if PROBE_ID == 47 || PROBE_ID == 48
    if (bid == PROBE_BLK && opaque_tid() == 0) *(float*)(p.ws + OFF_MISC + MISC_PROBE) = (float)probe_acc * 3e-8f;
#endif
}

__device__ __forceinline__ void phase_rope(const Params& p, int bid, int nb) {
    const int tid = opaque_tid(), wid = tid >> 6, lane = tid & 63;
    unsigned char* ws = p.ws;
    const bf16_t* Pd = (const bf16_t*)(ws + OFF_PD);
    bf16_t* qr = (bf16_t*)(ws + OFF_U); bf16_t* kr = (bf16_t*)(ws + OFF_KR); bf16_t* vv = (bf16_t*)(ws + OFF_VV);
    bf16_t* iqr = (bf16_t*)(ws + OFF_IQR); bf16_t* ikr = (bf16_t*)(ws + OFF_IKR); float* iw = (float*)(ws + OFF_IW);
    const float* c64 = (const float*)(ws + OFF_ROPE); const float* s64 = c64 + 4096 * 64; const float* c32 = s64 + 4096 * 64; const float* s32 = c32 + 4096 * 32;
    const float ikg = p.in[I_CIKG][lane], ikb = p.in[I_CIKB][lane];
    for (int n = bid * 8 + wid; n < NTOK; n += nb * 8) {
        const int pos = n & (SEQ - 1);
        const bf16_t* row = Pd + (size_t)n * NO_MAIN;
#define ROPE8(off1, off2, cs, sn, scale, dst, d1, d2) do { \
            const u32x4 a_ = *(const u32x4*)(row + (off1)), b_ = *(const u32x4*)(row + (off2)); \
            const f32x4 c0_ = *(const f32x4*)(cs), c1_ = *(const f32x4*)((cs) + 4), s0_ = *(const f32x4*)(sn), s1_ = *(const f32x4*)((sn) + 4); \
            const unsigned aw_[4] = {a_.x, a_.y, a_.z, a_.w}, bw_[4] = {b_.x, b_.y, b_.z, b_.w}; float o1_[8], o2_[8]; \
            _Pragma("unroll") for (int j_ = 0; j_ < 4; ++j_) { \
                const float z1a = __uint_as_float(aw_[j_] << 16), z1b = __uint_as_float(aw_[j_] & 0xffff0000u), z2a = __uint_as_float(bw_[j_] << 16), z2b = __uint_as_float(bw_[j_] & 0xffff0000u); \
                const float ca = (j_ < 2 ? c0_[2 * j_] : c1_[2 * j_ - 4]), cb = (j_ < 2 ? c0_[2 * j_ + 1] : c1_[2 * j_ - 3]), sa = (j_ < 2 ? s0_[2 * j_] : s1_[2 * j_ - 4]), sb = (j_ < 2 ? s0_[2 * j_ + 1] : s1_[2 * j_ - 3]); \
                o1_[2 * j_] = (z1a * ca - z2a * sa) * (scale); o1_[2 * j_ + 1] = (z1b * cb - z2b * sb) * (scale); o2_[2 * j_] = (z2a * ca + z1a * sa) * (scale); o2_[2 * j_ + 1] = (z2b * cb + z1b * sb) * (scale); } \
            u32x4 w1_, w2_; w1_.x = cvt_pk_bf16(o1_[0], o1_[1]); w1_.y = cvt_pk_bf16(o1_[2], o1_[3]); w1_.z = cvt_pk_bf16(o1_[4], o1_[5]); w1_.w = cvt_pk_bf16(o1_[6], o1_[7]); \
            w2_.x = cvt_pk_bf16(o2_[0], o2_[1]); w2_.y = cvt_pk_bf16(o2_[2], o2_[3]); w2_.z = cvt_pk_bf16(o2_[4], o2_[5]); w2_.w = cvt_pk_bf16(o2_[6], o2_[7]); \
            *(u32x4*)((dst) + (d1)) = w1_; *(u32x4*)((dst) + (d2)) = w2_; } while (0)
        { const int h = lane >> 3, jb = (lane & 7) * 8;
            ROPE8(h * 128 + jb, h * 128 + 64 + jb, c64 + pos * 64 + jb, s64 + pos * 64 + jb, 0.08838834764831845f, qr + (size_t)n * 1024, h * 128 + jb, h * 128 + 64 + jb); }
        if (lane < 8) { const int jb = lane * 8;
            ROPE8(1024 + jb, 1024 + 64 + jb, c64 + pos * 64 + jb, s64 + pos * 64 + jb, 1.0f, kr + (size_t)n * 128, jb, 64 + jb); }
        else if (lane < 24) { const int c = (lane - 8) * 8;
            *(u32x4*)(vv + (size_t)n * 128 + c) = *(const u32x4*)(row + 1152 + c); }
        else if (lane < 40) { const int h = (lane - 24) >> 2, jb = ((lane - 24) & 3) * 8;
            ROPE8(1280 + h * 64 + jb, 1280 + h * 64 + 32 + jb, c32 + pos * 32 + jb, s32 + pos * 32 + jb, 0.125f, iqr + (size_t)n * 256, h * 64 + jb, h * 64 + 32 + jb); }
#undef ROPE8
        const int j32 = lane & 31; const float cc = c32[pos * 32 + j32], ss = s32[pos * 32 + j32];
        { const float x = bf2f(row[1536 + lane]); const float mean = wave_sum(x) * (1.0f / 64.0f); const float d = x - mean; const float var = wave_sum(d * d) * (1.0f / 64.0f);
            const float y = d * rsqrtf(var + LN_EPS) * ikg + ikb; const float o = __shfl_xor(y, 32);
            const float res = lane < 32 ? (y * cc - o * ss) : (y * cc + o * ss);
            ikr[(size_t)n * 64 + lane] = f2bf(res); }
        if (lane < 4) iw[(size_t)n * 4 + lane] = bf2f(row[1600 + lane]) * 0.5f;
    }
}


__device__ __forceinline__ int opq(int v) { asm volatile("" : "+v"(v)); return v; }
#ifndef ATTX
#define ATTX 0
#endif
template <int MODE>
__device__ __forceinline__ void attn_query(const bf16_t* qr, const bf16_t* kr, const bf16_t* vv, bf16_t* ao, int n, LAS const unsigned short* ks, LAS const unsigned short* ksv, LAS unsigned char* vbuf, int lane PROBE_PARAMS) {
    const int fr = lane & 15, g = lane >> 4, q4 = fr >> 2, p4 = fr & 3;
    const int t = n & (SEQ - 1), b = n >> 12, cnt = (t + 1) < 256 ? (t + 1) : 256;
    {
        bf16x8 qf[4];
#pragma unroll
        for (int s = 0; s < 4; ++s) { qf[s] = (bf16x8){0, 0, 0, 0, 0, 0, 0, 0}; if (fr < 8) qf[s] = *(const bf16x8*)(qr + (size_t)n * 1024 + fr * 128 + s * 32 + g * 8); }
        const bf16_t* kbase = kr + (size_t)b * SEQ * 128; const bf16_t* vbase = vv + (size_t)b * SEQ * 128;
        f32x4 acc[16];
        bf16x8 kf[3][2][4];
        const u32x4 kidx0 = *(LAS const u32x4*)(ks + fr * 16), kidx1 = *(LAS const u32x4*)(ks + fr * 16 + 8);
#define ATT_KLOAD(buf, grp) do { _Pragma("unroll") for (int t2 = 0; t2 < 2; ++t2) { const int tl_ = (grp) * 2 + t2; const int key_ = (int)(((tl_ < 8 ? kidx0 : kidx1)[(tl_ & 7) >> 1] >> ((tl_ & 1) * 16)) & 0xffffu); \
            const bf16_t* kp_ = kbase + (size_t)key_ * 128 + g * 8; _Pragma("unroll") for (int s = 0; s < 4; ++s) kf[buf][t2][s] = *(const bf16x8*)(kp_ + s * 32); } } while (0)
        PROBE_BEGIN(12);
        ATT_KLOAD(0, 0); ATT_KLOAD(1, 1);
#pragma unroll
        for (int grp = 0; grp < 8; ++grp) {
            if (grp + 2 < 8) ATT_KLOAD((grp + 2) % 3, grp + 2);
#pragma unroll
            for (int t2 = 0; t2 < 2; ++t2) { f32x4 a = fzero4();
#pragma unroll
                for (int s = 0; s < 4; ++s) a = __builtin_amdgcn_mfma_f32_16x16x32_bf16(kf[grp % 3][t2][s], qf[s], a, 0, 0, 0);
                acc[grp * 2 + t2] = a; }
        }
#undef ATT_KLOAD
        PROBE_END(12);
        PROBE_BEGIN(13);
        u32x4 vr[3][8];
#define ATT_VLOAD(buf, s) do { unsigned pr_[4]; _Pragma("unroll") for (int i = 0; i < 4; ++i) pr_[i] = *(LAS const unsigned*)(ksv + (i * 4 + g) * 16 + 2 * (s)); \
            _Pragma("unroll") for (int i = 0; i < 8; ++i) { const int kl_ = i * 4 + g; const int key_ = (int)(i < 4 ? (pr_[i & 3] & 0xffffu) : (pr_[i & 3] >> 16)); \
            const int c_ = fr ^ ((kl_ & 7) << 1); vr[buf][i] = *(const u32x4*)(vbase + (size_t)key_ * 128 + c_ * 8); } } while (0)
        ATT_VLOAD(0, 0); ATT_VLOAD(1, 1);
        float m = -INFINITY;
#pragma unroll
        for (int tl = 0; tl < 16; ++tl)
#pragma unroll
            for (int r = 0; r < 4; ++r) { if ((g * 4 + r) * 16 + tl >= cnt) acc[tl][r] = -INFINITY; m = fmaxf(m, acc[tl][r]); }
        m = fmaxf(m, __shfl_xor(m, 16)); m = fmaxf(m, __shfl_xor(m, 32));
        float sum = 0.f;
#pragma unroll
        for (int tl = 0; tl < 16; ++tl)
#pragma unroll
            for (int r = 0; r < 4; ++r) { const float e_ = __expf(acc[tl][r] - m); acc[tl][r] = e_; sum += e_; }
        sum += __shfl_xor(sum, 16); sum += __shfl_xor(sum, 32);
        const float inv = 1.0f / sum;
        bf16x8 pf[8];
#pragma unroll
        for (int s = 0; s < 8; ++s) pf[s] = pack_8g(acc[2 * s], acc[2 * s + 1]);
        PROBE_END(13);
        PROBE_BEGIN(14);
        f32x4 o[8];
#pragma unroll
        for (int dt = 0; dt < 8; ++dt) o[dt] = fzero4();
#pragma unroll
        for (int s = 0; s < 8; ++s) {
            LAS unsigned char* vb = vbuf + (s & 1) * 8192;
            if (s + 2 < 8) ATT_VLOAD((s + 2) % 3, s + 2);
#pragma unroll
            for (int i = 0; i < 8; ++i) { const int kl = i * 4 + g; *(LAS u32x4*)(vb + kl * 256 + fr * 16) = vr[s % 3][i]; }
            const int kl1 = 4 * g + q4, kl2 = 16 + 4 * g + q4;
#pragma unroll
            for (int dt = 0; dt < 8; ++dt) {
                const int c = 2 * dt + (p4 >> 1);
                const s16x4 lo = __builtin_amdgcn_ds_read_tr16_b64_v4i16((LAS s16x4*)(vb + kl1 * 256 + ((c ^ ((kl1 & 7) << 1)) * 16) + (p4 & 1) * 8));
                const s16x4 hi = __builtin_amdgcn_ds_read_tr16_b64_v4i16((LAS s16x4*)(vb + kl2 * 256 + ((c ^ ((kl2 & 7) << 1)) * 16) + (p4 & 1) * 8));
                const bf16x8 af = (bf16x8){lo[0], lo[1], lo[2], lo[3], hi[0], hi[1], hi[2], hi[3]};
                o[dt] = __builtin_amdgcn_mfma_f32_16x16x32_bf16(af, pf[s], o[dt], 0, 0, 0);
            }
        }
#undef ATT_VLOAD
        PROBE_END(14);
        if (fr < 8) {
#pragma unroll
            for (int dt = 0; dt < 8; ++dt) { u32x2 w; w.x = cvt_pk_bf16(o[dt][0] * inv, o[dt][1] * inv); w.y = cvt_pk_bf16(o[dt][2] * inv, o[dt][3] * inv);
                *(u32x2*)(ao + (size_t)n * 1024 + fr * 128 + dt * 16 + g * 4) = w; }
        }
    }
}

__device__ __forceinline__ int idx_bin(float s, float lo, float scale) { int b = (int)((s - lo) * scale); b = b < 0 ? 0 : b; return b > 255 ? 255 : b; }
__device__ __forceinline__ unsigned ord_key(float s) { const unsigned u = __float_as_uint(s); return (u & 0x80000000u) ? ~u : (u | 0x80000000u); }
__device__ __forceinline__ float ord_val(unsigned k) { return __uint_as_float((k & 0x80000000u) ? (k & 0x7fffffffu) : ~k); }
__device__ __forceinline__ void phase_index2(const Params& p, LAS unsigned char* lds, int bid, int nb) {
    const int tid = opaque_tid(), wid = __builtin_amdgcn_readfirstlane(tid >> 6), lane0 = tid & 63;
    unsigned char* ws = p.ws;
    const bf16_t* iqr = (const bf16_t*)(ws + OFF_IQR); const bf16_t* ikr = (const bf16_t*)(ws + OFF_IKR); const float* iw = (const float*)(ws + OFF_IW);
    const bf16_t* qr = (const bf16_t*)(ws + OFF_U); const bf16_t* kr = (const bf16_t*)(ws + OFF_KR); const bf16_t* vv = (const bf16_t*)(ws + OFF_VV); bf16_t* ao = (bf16_t*)(ws + OFF_PD);
    LAS unsigned short* out = (LAS unsigned short*)(lds + 131072 + 24576) + wid * 256;
    LAS float* sc = (LAS float*)lds;
    LAS int* hist = (LAS int*)(lds + 131072) + wid * 256;
    LAS float* candv = (LAS float*)(lds + 131072 + 8192) + wid * 264;
    LAS unsigned short* candi = (LAS unsigned short*)(lds + 131072 + 8192 + 8 * 264 * 4) + wid * 256;
    LAS unsigned* mm = (LAS unsigned*)(lds + 131072 + 8192 + 8 * 264 * 4 + 8 * 512);
    const int ntile = NTOK / 8;
    PROBE_DECL;
    PROBE_BEGIN(9);
    unsigned* tctr = (unsigned*)(ws + OFF_MISC + MISC_PCTR) + 16;
    LAS int* tsh = (LAS int*)(lds + LDS_BYTES - 1536);
    for (;;) {
        __syncthreads();
        if (tid == 0) tsh[0] = (int)__hip_atomic_fetch_add(tctr, 1u, __ATOMIC_RELAXED, __HIP_MEMORY_SCOPE_AGENT);
        __syncthreads();
        const int it = __builtin_amdgcn_readfirstlane(tsh[0]);
        if (it >= ntile) break;
        const int qt = (it & 7) * 512 + (511 - (it >> 3));
        const int n0 = qt * 8, t0 = n0 & (SEQ - 1), b = n0 >> 12;
        int lane = lane0; asm volatile("" : "+v"(lane));
        const int fr = lane & 15, g = lane >> 4; const unsigned long long lt_mask = (1ull << lane) - 1ull;
        asm volatile("" ::: "memory");
        if (tid < 16) mm[tid] = (tid & 1) ? 0u : 0xffffffffu;
        __syncthreads();
        PROBE_BEGIN(1);
#pragma unroll 1
        for (int genrep = 0; genrep < (IDXPROBE == 1 ? 2 : 1); ++genrep)
        if (t0 + 8 > 256) {
            bf16x8 af[2][2];
#pragma unroll
            for (int hh = 0; hh < 2; ++hh)
#pragma unroll
                for (int s = 0; s < 2; ++s) af[hh][s] = *(const bf16x8*)(iqr + (size_t)(n0 + 2 * (fr >> 2) + ((fr >> 1) & 1)) * 256 + (2 * hh + (fr & 1)) * 64 + s * 32 + g * 8);
            const f32x4 wq0 = *(const f32x4*)(iw + (size_t)(n0 + 2 * g) * 4), wq1 = *(const f32x4*)(iw + (size_t)(n0 + 2 * g + 1) * 4);
            float vmin0 = INFINITY, vmax0 = -INFINITY, vmin1 = INFINITY, vmax1 = -INFINITY;
            const int nkt = (t0 + 8 + 15) >> 4;
            const bf16_t* kb = ikr + (size_t)b * SEQ * 64;
            bf16x8 pb0[3], pb1[3];
#pragma unroll
            for (int i = 0; i < 2; ++i) { const int ktp = wid + 8 * i < nkt ? wid + 8 * i : wid; const bf16_t* kp = kb + (size_t)(ktp * 16 + fr) * 64 + g * 8; pb0[i] = *(const bf16x8*)kp; pb1[i] = *(const bf16x8*)(kp + 32); }
            for (int kt = wid; kt < nkt; kt += 8) {
                { const int ktp = kt + 16 < nkt ? kt + 16 : kt; const bf16_t* kp = kb + (size_t)(ktp * 16 + fr) * 64 + g * 8; pb0[2] = *(const bf16x8*)kp; pb1[2] = *(const bf16x8*)(kp + 32); }
                const bf16x8 b0 = pb0[0], b1 = pb1[0];
                pb0[0] = pb0[1]; pb1[0] = pb1[1]; pb0[1] = pb0[2]; pb1[1] = pb1[2];
                f32x4 d0 = fzero4(), d1 = fzero4();
                d0 = __builtin_amdgcn_mfma_f32_16x16x32_bf16(af[0][0], b0, d0, 0, 0, 0); d0 = __builtin_amdgcn_mfma_f32_16x16x32_bf16(af[0][1], b1, d0, 0, 0, 0);
                d1 = __builtin_amdgcn_mfma_f32_16x16x32_bf16(af[1][0], b0, d1, 0, 0, 0); d1 = __builtin_amdgcn_mfma_f32_16x16x32_bf16(af[1][1], b1, d1, 0, 0, 0);
                float s0 = fmaxf(d0[0], 0.f) * wq0[0] + fmaxf(d0[1], 0.f) * wq0[1] + fmaxf(d1[0], 0.f) * wq0[2] + fmaxf(d1[1], 0.f) * wq0[3];
                float s1 = fmaxf(d0[2], 0.f) * wq1[0] + fmaxf(d0[3], 0.f) * wq1[1] + fmaxf(d1[2], 0.f) * wq1[2] + fmaxf(d1[3], 0.f) * wq1[3];
                s0 += 0.0f; s1 += 0.0f;
                vmin0 = fminf(vmin0, s0); vmax0 = fmaxf(vmax0, s0); vmin1 = fminf(vmin1, s1); vmax1 = fmaxf(vmax1, s1);
                sc[(2 * g) * 4096 + kt * 16 + fr] = s0; sc[(2 * g + 1) * 4096 + kt * 16 + fr] = s1;
            }
#pragma unroll
            for (int j = 0; j < 2; ++j) { float mn = j ? vmin1 : vmin0, mx = j ? vmax1 : vmax0;
                mn = fminf(mn, dppf<0xB1>(mn)); mn = fminf(mn, dppf<0x4E>(mn)); mn = fminf(mn, dppf<0x141>(mn)); mn = fminf(mn, dppf<0x140>(mn));
                mx = fmaxf(mx, dppf<0xB1>(mx)); mx = fmaxf(mx, dppf<0x4E>(mx)); mx = fmaxf(mx, dppf<0x141>(mx)); mx = fmaxf(mx, dppf<0x140>(mx));
                if (fr == 0 && mx >= mn) { const int q = 2 * g + j;
                    __hip_atomic_fetch_min(mm + q * 2, ord_key(mn), __ATOMIC_RELAXED, __HIP_MEMORY_SCOPE_WORKGROUP); __hip_atomic_fetch_max(mm + q * 2 + 1, ord_key(mx), __ATOMIC_RELAXED, __HIP_MEMORY_SCOPE_WORKGROUP); } }
        }
        PROBE_END(1);
        PROBE_BEGIN(2);
        __syncthreads();
        PROBE_END(2);
        PROBE_BEGIN(7);
#pragma unroll 1
        for (int selrep = 0; selrep < (IDXPROBE == 2 ? 2 : 1); ++selrep)
        {
            const int n = n0 + wid, t = t0 + wid, nv = t + 1;
            if (nv <= 256) { for (int j = lane; j < 256; j += 64) out[j] = (unsigned short)(j < nv ? j : 0); }
            else {
                LAS const float* srow = sc + wid * 4096;
                const int nvp = (nv + 255) & ~255;
                const unsigned kmax = mm[wid * 2 + 1];
                const int kbase = (int)(kmax >> 19) - 255;
                unsigned P = 0u; int sh = 32;
                bool capped = false;
                float lo = ord_val(mm[wid * 2]), hi = ord_val(mm[wid * 2 + 1]);
                float lo1 = 0.f, sc1 = 0.f, lo2 = 0.f, sc2 = 0.f, lo3 = 0.f, sc3 = 0.f; int b1 = 0, b2 = 0, b3 = 0, nlev = 0;
                int m = nv, need = 256;
#define IDX_HIST_SCAN(bin, nneed, mmc, lumpc) do { int hb[4]; \
                    _Pragma("unroll") for (int j = 0; j < 4; ++j) hb[j] = hist[lane * 4 + j]; \
                    if (lane == 0) hb[0] += (lumpc); \
                    const int tot = hb[0] + hb[1] + hb[2] + hb[3]; int suf = tot; \
                    _Pragma("unroll") for (int off = 1; off < 64; off <<= 1) { const int v = __shfl_down(suf, off); if (lane + off < 64) suf += v; } \
                    const int above = suf - tot; const bool is = (above < need) && (need <= suf); \
                    bin = 0; nneed = 0; mmc = 0; \
                    if (is) { int c = above; \
                        _Pragma("unroll") for (int k = 3; k >= 0; --k) { if (nneed == 0) { if (need <= c + hb[k]) { bin = lane * 4 + k; nneed = need - c; mmc = hb[k]; } else c += hb[k]; } } } \
                    const unsigned long long bal = __ballot(is); const int srcl = __ffsll((long long)bal) - 1; \
                    bin = __shfl(bin, srcl); nneed = __shfl(nneed, srcl); mmc = __shfl(mmc, srcl); } while (0)
#define IDX_ZERO_HIST() do { int z = 0; asm volatile("" : "+v"(z)); _Pragma("unroll") for (int j = 0; j < 4; ++j) hist[lane * 4 + j] = z; } while (0)
                PROBE_BEGIN(3);
                {
                    IDX_ZERO_HIST();
                    int lumpl = 0;
                    for (int c0 = 0; c0 < nvp; c0 += 256) { const f32x4 s4 = *(const LAS f32x4*)(srow + c0 + lane * 4);
#pragma unroll
                        for (int e_ = 0; e_ < 4; ++e_) { const unsigned k = ord_key(s4[e_]); const int bin = (int)(k >> 19) - kbase; const bool valid = c0 + lane * 4 + e_ < nv;
                            if (valid && bin > 0) __hip_atomic_fetch_add(hist + bin, 1, __ATOMIC_RELAXED, __HIP_MEMORY_SCOPE_WORKGROUP);
                            lumpl += (valid && bin <= 0) ? 1 : 0; } }
                    int lump = lumpl;
#pragma unroll
                    for (int o = 32; o > 0; o >>= 1) lump += __shfl_xor(lump, o);
                    int bin, nneed, mmc; IDX_HIST_SCAN(bin, nneed, mmc, lump);
                    need = nneed; m = mmc;
                    if (bin > 0) { P = (unsigned)(kbase + bin); sh = 19; }
                    else { capped = true; hi = ord_val(((unsigned)(kbase + 1) << 19) - 1u); if (hi < lo) hi = lo; }
                }
                PROBE_END(3);
                PROBE_BEGIN(4);
#pragma unroll 1
                while (!capped && m > 128 && sh > 0) {
                    const int nsh = sh > 8 ? sh - 8 : 0; const unsigned dmask = (1u << (sh - nsh)) - 1u;
                    IDX_ZERO_HIST();
                    for (int c0 = 0; c0 < nvp; c0 += 256) { const f32x4 s4 = *(const LAS f32x4*)(srow + c0 + lane * 4);
#pragma unroll
                        for (int e_ = 0; e_ < 4; ++e_) { const unsigned k = ord_key(s4[e_]);
                            if (c0 + lane * 4 + e_ < nv && (k >> sh) == P) __hip_atomic_fetch_add(hist + ((k >> nsh) & dmask), 1, __ATOMIC_RELAXED, __HIP_MEMORY_SCOPE_WORKGROUP); } }
                    int bin, nneed, mmc; IDX_HIST_SCAN(bin, nneed, mmc, 0);
                    P = (P << (sh - nsh)) | (unsigned)bin; sh = nsh; need = nneed; m = mmc;
                }
#define IDX_CLASSIFY(s, cls) do { \
                    if (!capped) { const unsigned kk_ = sh >= 32 ? 0u : (ord_key(s) >> sh); cls = kk_ > P ? 2 : (kk_ == P ? 1 : 0); } \
                    else if ((int)(ord_key(s) >> 19) > kbase) cls = 2; \
                    else { cls = 1; \
                        if (nlev >= 1) { const int bb = idx_bin(s, lo1, sc1); if (bb != b1) cls = bb > b1 ? 2 : 0; } \
                        if (cls == 1 && nlev >= 2) { const int bb = idx_bin(s, lo2, sc2); if (bb != b2) cls = bb > b2 ? 2 : 0; } \
                        if (cls == 1 && nlev >= 3) { const int bb = idx_bin(s, lo3, sc3); if (bb != b3) cls = bb > b3 ? 2 : 0; } } } while (0)
#pragma unroll 1
                while (capped && m > 128 && nlev < 3 && (hi - lo) > 1e-30f) {
                    const float width = hi - lo, scale = 256.0f / width;
                    IDX_ZERO_HIST();
                    for (int c0 = 0; c0 < nvp; c0 += 256) { const f32x4 s4 = *(const LAS f32x4*)(srow + c0 + lane * 4);
#pragma unroll
                        for (int e_ = 0; e_ < 4; ++e_) { const float s = s4[e_]; int cls; IDX_CLASSIFY(s, cls);
                            if (c0 + lane * 4 + e_ < nv && cls == 1) __hip_atomic_fetch_add(hist + idx_bin(s, lo, scale), 1, __ATOMIC_RELAXED, __HIP_MEMORY_SCOPE_WORKGROUP); } }
                    int bin, nneed, mmc; IDX_HIST_SCAN(bin, nneed, mmc, 0);
                    if (nlev == 0) { lo1 = lo; sc1 = scale; b1 = bin; } else if (nlev == 1) { lo2 = lo; sc2 = scale; b2 = bin; } else { lo3 = lo; sc3 = scale; b3 = bin; }
                    ++nlev; need = nneed; m = mmc;
                    const float w = width * (1.0f / 256.0f); lo = lo + (float)bin * w; hi = lo + w;
                }
#undef IDX_HIST_SCAN
#undef IDX_ZERO_HIST
                PROBE_END(4);
                PROBE_BEGIN(5);
                int base = 0, nc = 0;
                for (int c0 = 0; c0 < nvp; c0 += 256) { const f32x4 s4 = *(const LAS f32x4*)(srow + c0 + lane * 4);
                    bool su[4], ca[4]; int nsu = 0, nca = 0;
#pragma unroll
                    for (int e_ = 0; e_ < 4; ++e_) { const bool valid = c0 + lane * 4 + e_ < nv; int cls; IDX_CLASSIFY(s4[e_], cls); su[e_] = valid && cls == 2; ca[e_] = valid && cls == 1; nsu += su[e_] ? 1 : 0; nca += ca[e_] ? 1 : 0; }
                    unsigned long long bs4[4], bc4[4]; int ps = base, pc = nc, tots = 0, totc = 0;
#pragma unroll
                    for (int e_ = 0; e_ < 4; ++e_) { bs4[e_] = __ballot(su[e_]); bc4[e_] = __ballot(ca[e_]); ps += __popcll(bs4[e_] & lt_mask); pc += __popcll(bc4[e_] & lt_mask); tots += __popcll(bs4[e_]); totc += __popcll(bc4[e_]); }
#pragma unroll
                    for (int e_ = 0; e_ < 4; ++e_) { const int key = c0 + lane * 4 + e_;
                        if (su[e_]) { if (ps < 256) out[ps] = (unsigned short)key; ++ps; }
                        if (ca[e_]) { if (pc < 256) { candv[pc] = s4[e_]; candi[pc] = (unsigned short)key; } ++pc; } }
                    base += tots; nc += totc; }
#undef IDX_CLASSIFY
                PROBE_END(5);
                PROBE_BEGIN(6);
                const int mcap = nc < 256 ? nc : 256;
                float T = -INFINITY; int need_t = need;
                if (nc <= 256) {
                    float mine[4]; int cgt[4], cge[4];
#pragma unroll
                    for (int k = 0; k < 4; ++k) { mine[k] = (lane + 64 * k) < mcap ? candv[lane + 64 * k] : -INFINITY; cgt[k] = 0; cge[k] = 0; }
                    if (lane < 4 && mcap + lane < 260) candv[mcap + lane] = -INFINITY;
                    const int nk = (mcap + 63) >> 6;
                    for (int j = 0; j < mcap; j += 4) { const f32x4 vj = *(const LAS f32x4*)(candv + j);
#pragma unroll
                        for (int k = 0; k < 4; ++k) { if (k < nk) {
#pragma unroll
                            for (int e_ = 0; e_ < 4; ++e_) { cgt[k] += vj[e_] > mine[k] ? 1 : 0; cge[k] += vj[e_] >= mine[k] ? 1 : 0; } } } }
                    float tv = -INFINITY; int tg = 0; bool isT = false;
#pragma unroll
                    for (int k = 0; k < 4; ++k) { const bool ok = ((lane + 64 * k) < mcap) && (cgt[k] < need) && (need <= cge[k]); if (ok && !isT) { isT = true; tv = mine[k]; tg = cgt[k]; } }
                    const unsigned long long bT = __ballot(isT);
                    const int sl = __ffsll((long long)bT) - 1;
                    T = __shfl(tv, sl); need_t = need - __shfl(tg, sl);
                }
                int ties = 0;
                for (int c0 = 0; c0 < mcap; c0 += 64) { const int j = c0 + lane; const bool valid = j < mcap; const float s = valid ? candv[j] : -INFINITY;
                    const bool sure = valid && (nc <= 256) && s > T;
                    const bool tie = valid && ((nc <= 256) ? (s == T) : true);
                    const unsigned long long beq = __ballot(tie);
                    const int rank = ties + __popcll(beq & lt_mask);
                    const bool take = sure || (tie && rank < need_t);
                    const unsigned long long bt = __ballot(take);
                    const int pos = base + __popcll(bt & lt_mask);
                    if (take && pos < 256) out[pos] = candi[j];
                    base += __popcll(bt); ties += __popcll(beq); }
                PROBE_END(6);
            }
            PROBE_BEGIN(11);
            attn_query<0>(qr, kr, vv, ao, n, out, out, (LAS unsigned char*)(sc + wid * 4096), lane PROBE_PASS);
            if (ATTX) { asm volatile("" ::: "memory"); for (int j = lane; j < 256; j += 64) candi[j] = (unsigned short)j; asm volatile("" ::: "memory"); attn_query<1>(qr, kr, vv, (bf16_t*)(ws + OFF_U), n, ATTX >= 2 ? candi : out, ATTX >= 3 ? candi : out, (LAS unsigned char*)(sc + wid * 4096), lane PROBE_PASS); }
            PROBE_END(11);
        }
        PROBE_END(7);
        PROBE_BEGIN(8);
        __syncthreads();
        PROBE_END(8);
    }
    PROBE_END(9);
    PROBE_STORE(ws, bid, tid);
}


__device__ __forceinline__ void phase_inproj_even(const Params& p, LAS unsigned char* lds, int bid, int nb) {
    unsigned char* ws = p.ws;
    pg::DenseSched S; S.init(ws + OFF_BUF64, ws + OFF_WINE, NTOK, NE_MAIN, 1024, nb, bid);
    pg::EpiBf16 E; E.O = (bf16_t*)(ws + OFF_P); E.ldc = NE_MAIN;
    pg::gemm_phase(lds, 1024, S, E);
}
__device__ __forceinline__ void phase_inproj_odd(const Params& p, LAS unsigned char* lds, int bid, int nb) {
    unsigned char* ws = p.ws;
    pg::DenseSched S; S.init(ws + OFF_BUF64, ws + OFF_WINO, NTOK, NO_MAIN, 1024, nb, bid);
    pg::EpiBf16 E; E.O = (bf16_t*)(ws + OFF_PD); E.ldc = NO_MAIN;
    pg::gemm_phase(lds, 1024, S, E);
}
__device__ __forceinline__ void phase_outproj(const Params& p, LAS unsigned char* lds, int bid, int nb, size_t aoff, size_t woff, const float* X, const bf16_t* Xb) {
    unsigned char* ws = p.ws;
    pg::DenseSched S; S.init(ws + aoff, ws + woff, NTOK, 1024, 1024, nb, bid);
    pg::EpiResid E; E.X = X; E.Xb = Xb; E.U = (bf16_t*)(ws + OFF_U);
    pg::gemm_phase(lds, 1024, S, E);
}

#define XB_TMO      128
#define XB_XCNT(j)  (256  + 64 * (j))
#define XB_XSUB(j)  (1280 + 64 * (j))
#define XB_XGEN(j)  (2304 + 64 * (j))
#define XB_TOP      3328
#define XB_TOPGEN   3392
#define XCD_BAR_WORDS 3456
#define XB_SPIN_CAP (1u << 20)
__device__ __forceinline__ unsigned xb_ld(unsigned* p)              { return __hip_atomic_load(p, __ATOMIC_RELAXED, __HIP_MEMORY_SCOPE_AGENT); }
__device__ __forceinline__ unsigned xb_add(unsigned* p, unsigned v) { return __hip_atomic_fetch_add(p, v, __ATOMIC_RELAXED, __HIP_MEMORY_SCOPE_AGENT); }
__device__ __forceinline__ unsigned xb_xcc_id() { return (unsigned)__builtin_amdgcn_s_getreg((3 << 11) | 20) & 0xFu; }
#define XB_SPIN(cond, bar) do { unsigned _sp = 0; while (cond) { __builtin_amdgcn_s_sleep(1); \
    if ((++_sp & 255u) == 0u) { if (xb_ld(&(bar)[XB_TMO])) break; if (_sp > XB_SPIN_CAP) { atomicAdd(&(bar)[XB_TMO], 1u); break; } } } } while (0)
__device__ __forceinline__ void xcd_barrier_complete(unsigned* bar, unsigned x, unsigned& nloc, unsigned& nx) {
    const unsigned G = gridDim.x;
    unsigned sum, cnt, mine, sp = 0u;
    for (;;) {
        sum = 0u; cnt = 0u; mine = 0u;
#pragma unroll
        for (unsigned j = 0; j < 16; ++j) { const unsigned c = xb_ld(&bar[XB_XCNT(j)]); sum += c; cnt += (c > 0u) ? 1u : 0u; mine = (j == x) ? c : mine; }
        if (sum == G) break;
        __builtin_amdgcn_s_sleep(1);
        if ((++sp & 255u) == 0u) { if (xb_ld(&bar[XB_TMO])) break; if (sp > XB_SPIN_CAP) { atomicAdd(&bar[XB_TMO], 1u); break; } }
    }
    nloc = mine > 0u ? mine : 1u; nx = cnt > 0u ? cnt : 1u;
}
__device__ __forceinline__ void grid_barrier(unsigned* bar, volatile LAS unsigned* st) {
    asm volatile("s_waitcnt vmcnt(0) lgkmcnt(0)" ::: "memory");
    __syncthreads();
    if (threadIdx.x == 0) {
        const unsigned x = xb_xcc_id();
        __builtin_amdgcn_s_waitcnt(0);
        unsigned nloc = st[0], nx = st[1];
        if (nloc == 0u) { xcd_barrier_complete(bar, x, nloc, nx); st[0] = nloc; st[1] = nx; }
        const unsigned old = xb_add(&bar[XB_XSUB(x)], 1u);
        const unsigned gen = old / nloc;
        if (old + 1u == (gen + 1u) * nloc) {
            __builtin_amdgcn_fence(__ATOMIC_RELEASE, "agent");
            asm volatile("s_waitcnt vmcnt(0)" ::: "memory");
            const unsigned og = xb_add(&bar[XB_TOP], 1u);
            const unsigned tg = og / nx;
            if (og + 1u == (tg + 1u) * nx) xb_add(&bar[XB_TOPGEN], 1u);
            else XB_SPIN(xb_ld(&bar[XB_TOPGEN]) == tg, bar);
            __builtin_amdgcn_fence(__ATOMIC_ACQUIRE, "agent");
            xb_add(&bar[XB_XGEN(x)], 1u);
            asm volatile("s_waitcnt vmcnt(0)" ::: "memory");
        } else {
            XB_SPIN(xb_ld(&bar[XB_XGEN(x)]) == gen, bar);
            __builtin_amdgcn_fence(__ATOMIC_ACQUIRE, "agent");
            asm volatile("s_waitcnt vmcnt(0)" ::: "memory");
        }
    }
    __syncthreads();
}
#ifndef DUP
#define DUP 0
#endif
#define GSYNC() grid_barrier(bar_ctr, (volatile LAS unsigned*)(lds + LDS_BYTES - 1024))
__global__ __launch_bounds__(512, 2) void mega(KArgs a) {
    extern __shared__ __attribute__((aligned(16))) unsigned char smem[];
    LAS unsigned char* lds = (LAS unsigned char*)smem;
    Params p; p.in.t = (LAS const unsigned long long*)(lds + PTAB_OFF); p.out = a.out; p.ws = a.ws;
    if ((threadIdx.x & 63) == 0) ((LAS int*)(lds + WTAB_OFF))[hw_slot()] = threadIdx.x >> 6;
    if (threadIdx.x == 0) { LAS unsigned long long* tw_ = (LAS unsigned long long*)(lds + PTAB_OFF);
#pragma unroll
        for (int i = 0; i < 30; ++i) tw_[i] = (unsigned long long)a.in[i]; }
    __syncthreads();
    cg::grid_group grid = cg::this_grid();
    const int bid0 = blockIdx.x, nb0 = gridDim.x;
    unsigned* bar_ctr = (unsigned*)(p.ws + OFF_MISC + MISC_BAR);
    if (blockIdx.x == 0) for (int i = threadIdx.x; i < XCD_BAR_WORDS; i += 512) __hip_atomic_store(bar_ctr + i, 0u, __ATOMIC_RELAXED, __HIP_MEMORY_SCOPE_AGENT);
    if (threadIdx.x < 2) ((LAS unsigned*)(lds + LDS_BYTES - 1024))[threadIdx.x] = 0u;
    grid.sync();
    if (threadIdx.x == 0) (void)xb_add(&bar_ctr[XB_XCNT(xb_xcc_id())], 1u);
    int bid, nb;
#define FRESH() do { bid = bid0; nb = nb0; asm volatile("" : "+s"(bid), "+s"(nb)); } while (0)
#define PHP(pid, call) do { unsigned long long t0_ = 0; if (PROBE_ID == (pid)) t0_ = __builtin_amdgcn_s_memtime(); call; if (PROBE_ID == (pid) && bid0 == (PROBE_BLK) && opaque_tid() == 0) *(float*)(p.ws + OFF_MISC + MISC_PROBE) = (float)(__builtin_amdgcn_s_memtime() - t0_) * 1.5e-8f; } while (0)
#define RUNP(id, call) do { unsigned long long ts_ = 0; if (PROBE_ID == 200 + (id)) ts_ = __builtin_amdgcn_s_memtime(); FRESH(); call; GSYNC(); if (PROBE_ID == 200 + (id) && bid0 == 7 && opaque_tid() == 0) *(float*)(p.ws + OFF_MISC + MISC_PROBE) = (float)(__builtin_amdgcn_s_memtime() - ts_) * 1.5e-8f; if (DUP == id) { FRESH(); call; GSYNC(); } } while (0)
    RUNP(10, PHP(30, phase_prep(p, lds, bid, nb, 0)));
#if PROBE_ID == 20
    const unsigned long long kstart = __builtin_amdgcn_s_memtime();
#endif
#pragma unroll 1
    for (int layer = 0; layer < 2; ++layer) {
        if (layer == 0) {
            RUNP(31, PHP(31, phase_inproj_even(p, lds, bid, nb)));
            RUNP(21, PHP(44, phase_lora_act(p, bid, nb)));
            PHP(45, RUNP(1, PHP(33, phase_mixer_even(p, lds, bid, nb, 0))));
            FRESH(); PHP(34, phase_rwkv_epi(p, bid, nb));
            RUNP(13, PHP(46, phase_gla_fix(p, lds, bid, nb)));
        } else {
            RUNP(14, PHP(40, phase_inproj_odd(p, lds, bid, nb)));
            RUNP(15, PHP(41, phase_rope(p, bid, nb)));
            RUNP(2, PHP(43, phase_index2(p, lds, bid, nb)));
        }
        RUNP(16, PHP(35, phase_outproj(p, lds, bid, nb, layer ? OFF_PD : OFF_BUF64, layer ? OFF_WOUTO : OFF_WOUTE, p.in[I_X], layer ? (const bf16_t*)(p.ws + OFF_BUF64) : (const bf16_t*)nullptr)));
        RUNP(36, PHP(36, phase_ln_route(p, lds, bid, nb, layer)));
        RUNP(17, PHP(37, phase_moe_gateup(p, lds, bid, nb, layer)));
        RUNP(18, PHP(38, phase_moe_down(p, lds, bid, nb, layer)));
#if PROBE_ID == 20
        if (layer == 1) { if (bid0 == 7 && threadIdx.x == 0) *(float*)(p.ws + OFF_MISC + MISC_PROBE) = (float)(__builtin_amdgcn_s_memtime() - kstart) * 1e-8f; GSYNC(); }
#endif
        RUNP(19, PHP(39, phase_ln2(p, bid, nb, layer, p.out, true)));
    }
}

extern "C" void kernel_launch(void* const* d_in, const int* in_sizes, int n_in, void* d_out, int out_size, void* d_ws, size_t ws_size, hipStream_t stream) {
    if (ws_size < WS_NEED) { fprintf(stderr, "workspace too small: %zu < %zu\n", ws_size, (size_t)WS_NEED); return; }
    KArgs p{};
    for (int i = 0; i < 30; ++i) p.in[i] = (const float*)d_in[i];
    p.out = (float*)d_out; p.ws = (unsigned char*)d_ws;
    static int grid_blocks = 0;
    if (!grid_blocks) {
        (void)hipFuncSetAttribute((const void*)mega, hipFuncAttributeMaxDynamicSharedMemorySize, LDS_BYTES);
        int dev = 0, cus = 0, per_cu = 0;
        (void)hipGetDevice(&dev);
        (void)hipDeviceGetAttribute(&cus, hipDeviceAttributeMultiprocessorCount, dev);
        (void)hipOccupancyMaxActiveBlocksPerMultiprocessor(&per_cu, mega, 512, LDS_BYTES);
        if (per_cu < 1) { fprintf(stderr, "occupancy query returned %d\n", per_cu); per_cu = 1; }
        grid_blocks = cus;
    }
    void* args[] = {&p};
    hipError_t e = hipLaunchCooperativeKernel((void*)mega, dim3(grid_blocks), dim3(512), args, LDS_BYTES, stream);
    if (e != hipSuccess) fprintf(stderr, "cooperative launch failed: %s (grid %d)\n", hipGetErrorString(e), grid_blocks);
}
```
